# Optimizing an MI355X kernel written in HIP

```python
import jax, jax.numpy as jnp
from jax import lax
import numpy as np

D_MODEL = 1024
BATCH = 4
SEQ = 4096
DEPTH = 2
DEC_BATCH = 128
DEC_SEQ = 4
PAST_LEN = 8192
PAGE_SIZE = 128

N_META = 16
MLA_HEADS = 16
Q_LORA = 256
KV_LORA = 256
QK_NOPE = 64
QK_ROPE = 32
V_HEAD = 64
MLA_SCALE = (QK_NOPE + QK_ROPE) ** -0.5
ROPE_BASE = 10000.0
Q_BLOCK = 128
GLA_HEADS = 4
GLA_DK = D_MODEL // 2 // GLA_HEADS
GLA_DV = D_MODEL // GLA_HEADS
GLA_SCALE = GLA_DK ** -0.5
GATE_RANK = 16
GATE_TAU = 16.0
CHUNK = 64
D_FF = 4 * D_MODEL
EPS = 1e-6
N_MLA_LAYERS = (DEPTH + 1) // 2
N_GLA_LAYERS = DEPTH // 2

kernel_name = 'hybrid_mla_gla_decoder_step'


def rmsnorm(x, w):
    xf = x.astype(jnp.float32)
    y = xf * lax.rsqrt(jnp.mean(xf * xf, axis=-1, keepdims=True) + EPS)
    return (y * w.astype(jnp.float32)).astype(x.dtype)


def rope(x, pos):
    half = QK_ROPE // 2
    inv = ROPE_BASE ** (-jnp.arange(half, dtype=jnp.float32) / half)
    ang = pos.astype(jnp.float32)[:, None] * inv[None, :]
    ang = ang.reshape((ang.shape[0],) + (1,) * (x.ndim - 3) + (half,))
    cos, sin = jnp.cos(ang), jnp.sin(ang)
    x1, x2 = jnp.split(x.astype(jnp.float32), 2, axis=-1)
    return jnp.concatenate([x1 * cos - x2 * sin, x1 * sin + x2 * cos], axis=-1).astype(x.dtype)


def sq_relu_mlp(h, w_up, w_down):
    return jnp.square(jax.nn.relu(h @ w_up)) @ w_down


def mla_project(h, pos, w_in, q_norm, w_uq, kv_norm, w_uk):
    B, T, _ = h.shape
    a = h @ w_in
    cq, ckv, kpe = jnp.split(a, [Q_LORA, Q_LORA + KV_LORA], axis=-1)
    q = (rmsnorm(cq, q_norm) @ w_uq).reshape(B, T, MLA_HEADS, QK_NOPE + QK_ROPE)
    q_nope, q_pe = q[..., :QK_NOPE], q[..., QK_NOPE:]
    q_lat = jnp.einsum('bthn,chn->bthc', q_nope, w_uk)
    return q_lat, rope(q_pe, pos), rmsnorm(ckv, kv_norm), rope(kpe, pos)


def mla_scores(q_lat, q_pe, ckv, kpe):
    s = jnp.einsum('bqhc,bkc->bhqk', q_lat, ckv) + jnp.einsum('bqhr,bkr->bhqk', q_pe, kpe)
    return s.astype(jnp.float32) * MLA_SCALE


def mla_out(o_lat, w_uv, w_o):
    B, T = o_lat.shape[:2]
    o = jnp.einsum('bthc,chv->bthv', o_lat, w_uv).reshape(B, T, MLA_HEADS * V_HEAD)
    return o @ w_o


def mla_prompt(h, pos, w_in, q_norm, w_uq, kv_norm, w_uk, w_uv, w_o):
    q_lat, q_pe, ckv, kpe = mla_project(h, pos, w_in, q_norm, w_uq, kv_norm, w_uk)
    B, T = h.shape[:2]
    nqb = -(-T // Q_BLOCK)
    tq = nqb * Q_BLOCK

    def blocks(a):
        a = jnp.pad(a, ((0, 0), (0, tq - T)) + ((0, 0),) * (a.ndim - 2))
        return jnp.moveaxis(a.reshape((B, nqb, Q_BLOCK) + a.shape[2:]), 1, 0)

    qpos = jnp.arange(tq, dtype=jnp.int32).reshape(nqb, Q_BLOCK)
    kpos = jnp.arange(T, dtype=jnp.int32)

    def attend(args):
        ql, qp, qpos_b = args
        s = mla_scores(ql, qp, ckv, kpe)
        s = jnp.where(kpos[None, :] <= qpos_b[:, None], s, -jnp.inf)
        p = jax.nn.softmax(s, axis=-1).astype(ckv.dtype)
        return jnp.einsum('bhqk,bkc->bqhc', p, ckv)

    o_lat = lax.map(attend, (blocks(q_lat), blocks(q_pe), qpos))
    o_lat = jnp.moveaxis(o_lat, 0, 1).reshape(B, tq, MLA_HEADS, KV_LORA)[:, :T]
    return mla_out(o_lat, w_uv, w_o), ckv, kpe


def mla_sample(h, pos, cache_ckv, cache_kpe, layer, page_table, w_in, q_norm, w_uq, kv_norm, w_uk, w_uv, w_o):
    q_lat, q_pe, ckv_new, kpe_new = mla_project(h, pos, w_in, q_norm, w_uq, kv_norm, w_uk)
    DB, S = h.shape[:2]
    ckv_past = cache_ckv[layer, page_table].reshape(DB, -1, KV_LORA)
    kpe_past = cache_kpe[layer, page_table].reshape(DB, -1, QK_ROPE)
    P = ckv_past.shape[1]
    s_past = mla_scores(q_lat, q_pe, ckv_past, kpe_past)
    s_new = mla_scores(q_lat, q_pe, ckv_new, kpe_new)
    s_new = jnp.where(jnp.tril(jnp.ones((S, S), dtype=bool)), s_new, -jnp.inf)
    p = jax.nn.softmax(jnp.concatenate([s_past, s_new], axis=-1), axis=-1).astype(h.dtype)
    o_lat = (jnp.einsum('bhqk,bkc->bqhc', p[..., :P], ckv_past)
             + jnp.einsum('bhqk,bkc->bqhc', p[..., P:], ckv_new))
    return mla_out(o_lat, w_uv, w_o), ckv_new, kpe_new


def gla_recurrence(q, k, v, log_a, s0, lead):
    B, T, H, _ = q.shape
    total = lead + T
    nc = -(-total // CHUNK)
    pad = ((0, 0), (lead, nc * CHUNK - total), (0, 0), (0, 0))

    def chunks(t):
        t = jnp.pad(t.astype(jnp.float32), pad)
        return t.reshape(B, nc, CHUNK, H, t.shape[-1]).transpose(1, 0, 3, 2, 4)

    qc, kc, vc, gc = chunks(q), chunks(k), chunks(v), chunks(log_a)
    b = jnp.cumsum(gc, axis=3)
    b_last = b[:, :, :, -1:, :]
    q_in = qc * jnp.exp(b)
    k_in = kc * jnp.exp(-b)
    k_dec = kc * jnp.exp(b_last - b)
    causal = jnp.tril(jnp.ones((CHUNK, CHUNK), dtype=bool))
    A = jnp.where(causal, jnp.einsum('nbhid,nbhjd->nbhij', q_in, k_in), 0.0)
    o_intra = jnp.einsum('nbhij,nbhjv->nbhiv', A, vc)

    def step(s, xs):
        q_in_c, k_dec_c, v_c, bl = xs
        o_inter = jnp.einsum('bhid,bhdv->bhiv', q_in_c, s)
        s = jnp.exp(bl)[..., 0, :, None] * s + jnp.einsum('bhjd,bhjv->bhdv', k_dec_c, v_c)
        return s, o_inter

    s_fin, o_inter = lax.scan(step, s0.astype(jnp.float32), (q_in, k_dec, vc, b_last))
    o = (o_intra + o_inter).transpose(1, 0, 3, 2, 4).reshape(B, nc * CHUNK, H, -1)[:, lead:lead + T]
    return o, s_fin


def gla_mixer(h, s0, lead, w_in, w_gate, b_gate, g_norm, w_o):
    B, T, _ = h.shape
    hk = GLA_HEADS * GLA_DK
    hv = GLA_HEADS * GLA_DV
    a = h @ w_in
    q, k, v, r, gd = jnp.split(a, [hk, 2 * hk, 2 * hk + hv, 2 * hk + 2 * hv], axis=-1)

    def heads(t):
        return t.reshape(B, T, GLA_HEADS, -1)

    log_a = jax.nn.log_sigmoid((gd @ w_gate + b_gate).astype(jnp.float32)) / GATE_TAU
    o, s = gla_recurrence(heads(q) * GLA_SCALE, heads(k), heads(v), heads(log_a), s0, lead)
    o = rmsnorm(o.astype(h.dtype), g_norm) * jax.nn.silu(heads(r))
    return o.reshape(B, T, hv) @ w_o, s.astype(h.dtype)


def setup_inputs(seed: int = 0) -> dict:
    key = jax.random.key(seed)
    ks = jax.random.split(key, 32)
    f32 = jnp.float32

    def nrm(k, shape, scale=1.0):
        return jax.random.normal(k, shape, f32) * scale

    def gain(k, shape):
        return 1.0 + 0.01 * jax.random.normal(k, shape, f32)

    n_pages = PAST_LEN // PAGE_SIZE
    n_used = DEC_BATCH * n_pages
    n_pool = (n_used * 5) // 4
    page_table = jax.random.permutation(ks[5], n_pool)[:n_used].reshape(DEC_BATCH, n_pages).astype(jnp.int32)
    hk = GLA_HEADS * GLA_DK
    hv = GLA_HEADS * GLA_DV
    return {
        'x_prompt': nrm(ks[0], (BATCH, SEQ, D_MODEL)),
        'x_sample': nrm(ks[1], (DEC_BATCH, DEC_SEQ, D_MODEL)),
        'cache_ckv': nrm(ks[2], (N_MLA_LAYERS, n_pool, PAGE_SIZE, KV_LORA)),
        'cache_kpe': nrm(ks[3], (N_MLA_LAYERS, n_pool, PAGE_SIZE, QK_ROPE)),
        'state_gla': nrm(ks[4], (N_GLA_LAYERS, DEC_BATCH, GLA_HEADS, GLA_DK, GLA_DV), 0.5),
        'page_table': page_table,
        'meta_tokens': nrm(ks[6], (N_META, D_MODEL)),
        'norm_pre_mix': gain(ks[7], (DEPTH, D_MODEL)),
        'norm_post_mix': gain(ks[8], (DEPTH, D_MODEL)),
        'norm_pre_mlp': gain(ks[9], (DEPTH, D_MODEL)),
        'norm_post_mlp': gain(ks[10], (DEPTH, D_MODEL)),
        'mla_w_in': nrm(ks[11], (N_MLA_LAYERS, D_MODEL, Q_LORA + KV_LORA + QK_ROPE), D_MODEL ** -0.5),
        'mla_q_norm': gain(ks[12], (N_MLA_LAYERS, Q_LORA)),
        'mla_w_uq': nrm(ks[13], (N_MLA_LAYERS, Q_LORA, MLA_HEADS * (QK_NOPE + QK_ROPE)), Q_LORA ** -0.5),
        'mla_kv_norm': gain(ks[14], (N_MLA_LAYERS, KV_LORA)),
        'mla_w_uk': nrm(ks[15], (N_MLA_LAYERS, KV_LORA, MLA_HEADS, QK_NOPE), KV_LORA ** -0.5),
        'mla_w_uv': nrm(ks[16], (N_MLA_LAYERS, KV_LORA, MLA_HEADS, V_HEAD), KV_LORA ** -0.5),
        'mla_w_o': nrm(ks[17], (N_MLA_LAYERS, MLA_HEADS * V_HEAD, D_MODEL), (MLA_HEADS * V_HEAD) ** -0.5),
        'gla_w_in': nrm(ks[18], (N_GLA_LAYERS, D_MODEL, 2 * hk + 2 * hv + GATE_RANK), D_MODEL ** -0.5),
        'gla_w_gate': nrm(ks[19], (N_GLA_LAYERS, GATE_RANK, hk), GATE_RANK ** -0.5),
        'gla_b_gate': nrm(ks[20], (N_GLA_LAYERS, hk), 0.1),
        'gla_norm': gain(ks[21], (N_GLA_LAYERS, GLA_DV)),
        'gla_w_o': nrm(ks[22], (N_GLA_LAYERS, hv, D_MODEL), hv ** -0.5),
        'mlp_w_up': nrm(ks[23], (DEPTH, D_MODEL, D_FF), D_MODEL ** -0.5),
        'mlp_w_down': nrm(ks[24], (DEPTH, D_FF, D_MODEL), D_FF ** -0.5),
    }


def reference(x_prompt, x_sample, cache_ckv, cache_kpe, state_gla, page_table, meta_tokens,
              norm_pre_mix, norm_post_mix, norm_pre_mlp, norm_post_mlp,
              mla_w_in, mla_q_norm, mla_w_uq, mla_kv_norm, mla_w_uk, mla_w_uv, mla_w_o,
              gla_w_in, gla_w_gate, gla_b_gate, gla_norm, gla_w_o,
              mlp_w_up, mlp_w_down):
    B = x_prompt.shape[0]
    meta = jnp.broadcast_to(meta_tokens[None].astype(x_prompt.dtype), (B, N_META, D_MODEL))
    xp = jnp.concatenate([meta, x_prompt], axis=1)
    xs = x_sample
    past_len = page_table.shape[1] * cache_ckv.shape[2]
    pos_p = jnp.arange(xp.shape[1], dtype=jnp.int32)
    pos_s = past_len + jnp.arange(xs.shape[1], dtype=jnp.int32)

    ckv_p_l, kpe_p_l, ckv_s_l, kpe_s_l, gla_p_l, gla_s_l = [], [], [], [], [], []
    for i in range(DEPTH):
        j = i // 2
        hp = rmsnorm(xp, norm_pre_mix[i])
        hs = rmsnorm(xs, norm_pre_mix[i])
        if i % 2 == 0:
            w = (mla_w_in[j], mla_q_norm[j], mla_w_uq[j], mla_kv_norm[j], mla_w_uk[j], mla_w_uv[j], mla_w_o[j])
            mp, ckv_p, kpe_p = mla_prompt(hp, pos_p, *w)
            ms, ckv_s, kpe_s = mla_sample(hs, pos_s, cache_ckv, cache_kpe, j, page_table, *w)
            ckv_p_l.append(ckv_p)
            kpe_p_l.append(kpe_p)
            ckv_s_l.append(ckv_s)
            kpe_s_l.append(kpe_s)
        else:
            w = (gla_w_in[j], gla_w_gate[j], gla_b_gate[j], gla_norm[j], gla_w_o[j])
            s0 = jnp.zeros((B, GLA_HEADS, GLA_DK, GLA_DV), dtype=jnp.float32)
            mp, sp = gla_mixer(hp, s0, CHUNK - N_META, *w)
            ms, ss = gla_mixer(hs, state_gla[j], 0, *w)
            gla_p_l.append(sp)
            gla_s_l.append(ss)
        xp = xp + rmsnorm(mp, norm_post_mix[i])
        xs = xs + rmsnorm(ms, norm_post_mix[i])
        xp = xp + rmsnorm(sq_relu_mlp(rmsnorm(xp, norm_pre_mlp[i]), mlp_w_up[i], mlp_w_down[i]), norm_post_mlp[i])
        xs = xs + rmsnorm(sq_relu_mlp(rmsnorm(xs, norm_pre_mlp[i]), mlp_w_up[i], mlp_w_down[i]), norm_post_mlp[i])

    y_prompt = xp[:, N_META:]
    y_sample = xs
    new_ckv_prompt = jnp.stack(ckv_p_l)
    new_kpe_prompt = jnp.stack(kpe_p_l)
    new_ckv_sample = jnp.stack(ckv_s_l)
    new_kpe_sample = jnp.stack(kpe_s_l)
    new_gla_prompt = jnp.stack(gla_p_l)
    new_gla_sample = jnp.stack(gla_s_l)
    return (y_prompt, y_sample, new_ckv_prompt, new_kpe_prompt, new_ckv_sample, new_kpe_sample, new_gla_prompt, new_gla_sample)
```

```cpp
#include <hip/hip_runtime.h>
#include <cstdio>
#include <cstdint>
#include <cmath>

#ifndef MK_ONE_LAUNCH
#define MK_ONE_LAUNCH 1
#endif

constexpr int D = 1024, NB = 4, SEQ = 4096, NMETA = 16, TP = SEQ + NMETA;
constexpr int DB = 128, DS = 4, PAST = 8192, PAGE = 128, NPAGES = 64;
constexpr int NH = 16, QL = 256, KVL = 256, NOPE = 64, ROPE = 32, VH = 64;
constexpr int GH = 4, GDK = 128, GDV = 256, GR = 16;
constexpr int FF = 4096;
constexpr int RMAIN = NB * SEQ;
constexpr int RMETA0 = RMAIN;
constexpr int RSAMP0 = RMAIN + NB * NMETA;
constexpr int R = RSAMP0 + DB * DS;
constexpr int RPROMPT = RSAMP0;
constexpr int RP = 17152;
constexpr int NIN0 = 768, NUQ = 1536, NUKV = 2048, NGIN = 3328, NGIN_REAL = 3088;
constexpr float EPS = 1e-6f;
constexpr float MLA_SCALE = 0.10206207261596575f;
constexpr float GLA_SCALE = 0.08838834764831845f;

constexpr size_t O_YP = 0, O_YS = 16777216, O_CKVP = 17301504, O_KPEP = 21512192, O_CKVS = 22038528, O_KPES = 22169600, O_GLAP = 22185984, O_GLAS = 22710272, O_END = 39487488;

constexpr size_t MiB = 1u << 20;
constexpr size_t WS_CTL = 0, CTL_ZERO_BYTES = 1 * MiB;
constexpr size_t WS_WIN0 = 2 * MiB, WS_WUQ = 4 * MiB, WS_WUKV = 5 * MiB, WS_WO0 = 6 * MiB, WS_WUP = 8 * MiB, WS_WDN = 24 * MiB, WS_WGIN = 40 * MiB, WS_WGO = 47 * MiB;
constexpr size_t WS_X = 64 * MiB, WS_H = 132 * MiB, WS_M = 166 * MiB, WS_U = 234 * MiB, WS_A1 = 368 * MiB, WS_CQN = 419 * MiB, WS_CKVN = 428 * MiB, WS_KPE = 437 * MiB;
constexpr size_t WS_QRAW = 440 * MiB, WS_KNV = 541 * MiB, WS_QN = 608 * MiB, WS_QPE = 642 * MiB, WS_QLAT = 659 * MiB, WS_OLAT = 663 * MiB, WS_O = 671 * MiB;
constexpr size_t WS_QG = 705 * MiB, WS_KG = 722 * MiB, WS_VG = 739 * MiB, WS_RG = 773 * MiB, WS_GD = 807 * MiB, WS_LA = 809 * MiB, WS_EA = 843 * MiB, WS_OGRAW = 877 * MiB, WS_OG = 944 * MiB;
constexpr size_t WS_END = 978 * MiB;
constexpr int CW_BAR = 4096;

constexpr int LDS_BYTES = 147456;
constexpr int MISC_OFF = 131072 + 320;

#define GAS __attribute__((address_space(1)))
#define LAS __attribute__((address_space(3)))
typedef unsigned short bf16;
typedef float f32x4 __attribute__((ext_vector_type(4)));
typedef unsigned u32x4 __attribute__((ext_vector_type(4)));
typedef unsigned u32x2 __attribute__((ext_vector_type(2)));
#define LDS_WAIT() asm volatile("s_waitcnt lgkmcnt(0)" ::: "memory")

__device__ __forceinline__ unsigned f2bf(float f) { unsigned u = __builtin_bit_cast(unsigned, f); return (u + 0x7fffu + ((u >> 16) & 1u)) >> 16; }
__device__ __forceinline__ unsigned pk2(float lo, float hi) { return f2bf(lo) | (f2bf(hi) << 16); }
__device__ __forceinline__ float bflo(unsigned u) { return __builtin_bit_cast(float, u << 16); }
__device__ __forceinline__ float bfhi(unsigned u) { return __builtin_bit_cast(float, u & 0xffff0000u); }
__device__ __forceinline__ float bf2f(bf16 v) { return __builtin_bit_cast(float, (unsigned)v << 16); }
__device__ __forceinline__ float wave_sum(float v) {
#pragma unroll
    for (int o = 1; o < 64; o <<= 1) v += __shfl_xor(v, o);
    return v;
}
__device__ __forceinline__ int wave_max_i(int v) {
#pragma unroll
    for (int o = 1; o < 64; o <<= 1) { int t = __shfl_xor(v, o); v = t > v ? t : v; }
    return v;
}
__device__ __forceinline__ float rdlane(float v, int l) { return __builtin_bit_cast(float, __builtin_amdgcn_readlane(__builtin_bit_cast(int, v), l)); }

#define XB_TMO      128
#define XB_XCNT(j)  (256  + 64 * (j))
#define XB_XSUB(j)  (1280 + 64 * (j))
#define XB_XGEN(j)  (2304 + 64 * (j))
#define XB_TOP      3328
#define XB_TOPGEN   3392
#define XCD_BAR_WORDS 3456
#define XB_SPIN_CAP (1u << 18)
__device__ __forceinline__ unsigned xb_ld(unsigned* p)              { return __hip_atomic_load(p, __ATOMIC_RELAXED, __HIP_MEMORY_SCOPE_AGENT); }
__device__ __forceinline__ unsigned xb_add(unsigned* p, unsigned v) { return __hip_atomic_fetch_add(p, v, __ATOMIC_RELAXED, __HIP_MEMORY_SCOPE_AGENT); }
__device__ __forceinline__ unsigned xb_xcc_id() { return (unsigned)__builtin_amdgcn_s_getreg((3 << 11) | 20) & 0xFu; }
#define XB_SPIN(cond, bar) do { unsigned _sp = 0; while (cond) { __builtin_amdgcn_s_sleep(1); \
    if ((++_sp & 255u) == 0u) { if (xb_ld(&(bar)[XB_TMO])) break; if (_sp > XB_SPIN_CAP) { atomicAdd(&(bar)[XB_TMO], 1u); break; } } } } while (0)
struct XcdBarrier { unsigned* bar; unsigned x; volatile LAS unsigned* st; };
__device__ __forceinline__ XcdBarrier xcd_barrier_post(unsigned* bar, volatile LAS unsigned* st) {
    XcdBarrier b; b.bar = bar; b.x = xb_xcc_id(); b.st = st;
    if (threadIdx.x == 0) (void)xb_add(&bar[XB_XCNT(b.x)], 1u);
    return b;
}
__device__ __forceinline__ void xcd_barrier_complete(unsigned* bar, unsigned x, unsigned& nloc, unsigned& nx) {
    const unsigned G = gridDim.x * gridDim.y * gridDim.z;
    unsigned sum, cnt, mine, sp = 0u;
    for (;;) {
        sum = 0u; cnt = 0u; mine = 0u;
#pragma unroll
        for (unsigned j = 0; j < 16; ++j) { const unsigned c = xb_ld(&bar[XB_XCNT(j)]); sum += c; cnt += (c > 0u) ? 1u : 0u; mine = (j == x) ? c : mine; }
        if (sum == G) break;
        __builtin_amdgcn_s_sleep(1);
        if ((++sp & 255u) == 0u) { if (xb_ld(&bar[XB_TMO])) break; if (sp > XB_SPIN_CAP) { atomicAdd(&bar[XB_TMO], 1u); break; } }
    }
    nloc = mine > 0u ? mine : 1u; nx = cnt > 0u ? cnt : 1u;
}
__device__ __forceinline__ void xcd_barrier(const XcdBarrier& b) {
    asm volatile("s_waitcnt vmcnt(0)" ::: "memory");
    __syncthreads();
    if (threadIdx.x == 0) {
        unsigned* bar = b.bar;
        __builtin_amdgcn_s_waitcnt(0);
        unsigned nloc = b.st[0], nx = b.st[1];
        if (nloc == 0u) { xcd_barrier_complete(bar, b.x, nloc, nx); b.st[0] = nloc; b.st[1] = nx; }
        const unsigned old = xb_add(&bar[XB_XSUB(b.x)], 1u);
        const unsigned gen = old / nloc;
        if (old + 1u == (gen + 1u) * nloc) {
            __builtin_amdgcn_fence(__ATOMIC_RELEASE, "agent");
            asm volatile("s_waitcnt vmcnt(0)" ::: "memory");
            const unsigned og = xb_add(&bar[XB_TOP], 1u);
            const unsigned tg = og / nx;
            if (og + 1u == (tg + 1u) * nx) xb_add(&bar[XB_TOPGEN], 1u);
            else XB_SPIN(xb_ld(&bar[XB_TOPGEN]) == tg, bar);
            __builtin_amdgcn_fence(__ATOMIC_ACQUIRE, "agent");
            xb_add(&bar[XB_XGEN(b.x)], 1u);
            asm volatile("s_waitcnt vmcnt(0)" ::: "memory");
        } else {
            XB_SPIN(xb_ld(&bar[XB_XGEN(b.x)]) == gen, bar);
            __builtin_amdgcn_fence(__ATOMIC_ACQUIRE, "agent");
            asm volatile("s_waitcnt vmcnt(0)" ::: "memory");
        }
    }
    __syncthreads();
}

struct Args { const void* in[25]; float* out; unsigned char* ws; int ph_lo, ph_hi; };
#define IN_F(k) ((const float*)a.in[k])
#define WSB(off) ((bf16*)(a.ws + (off)))
#define WSF(off) ((float*)(a.ws + (off)))

struct Ctx { int tid, lane, wave, gw, ngw, gwT; };

__device__ __forceinline__ int row_pos(int r) { return r < RMAIN ? (r & 4095) + NMETA : (r < RSAMP0 ? ((r - RMAIN) & 15) : PAST + ((r - RSAMP0) & 3)); }
__device__ __forceinline__ float rope_inv(int j) { return exp2f(-(float)j * (13.287712379549449f / 16.0f)); }
__device__ __forceinline__ void rope_cs(int pos, int j, float& c, float& s) {
    const float ang = (float)pos * rope_inv(j);
    const double x = (double)ang; const double n = rint(x * 0.15915494309189535); const float r = (float)(x - n * 6.283185307179586);
    c = cosf(r); s = sinf(r);
}

struct RmId { int off; __device__ __forceinline__ int operator()(int n) const { return off + n; } };
struct RmUq { __device__ __forceinline__ int operator()(int n) const { const int h = n / 96, j = n % 96; if (j < 64) return h * 64 + j; const int jj = j - 64; return 1024 + h * 32 + (jj < 16 ? 2 * jj : 2 * (jj - 16) + 1); } };
template <class RM>
__device__ __forceinline__ void tr_item(const float* W, int ldw, int nblk, int item, bf16* WT, int ldt, RM rm, LAS float* scr, int lane) {
    const int kb = item / nblk, nb = item % nblk, k0 = 64 * kb, n0 = 32 * nb;
#pragma unroll 8
    for (int i = 0; i < 32; ++i) { const int kk = 2 * i + (lane >> 5); scr[kk * 33 + (lane & 31)] = W[(size_t)(k0 + kk) * ldw + n0 + (lane & 31)]; }
    LDS_WAIT();
    const int c = lane & 7;
#pragma unroll
    for (int j = 0; j < 4; ++j) { const int n = (lane >> 3) + 8 * j; const LAS float* s = scr + (8 * c) * 33 + n;
        u32x4 o; o.x = pk2(s[0 * 33], s[1 * 33]); o.y = pk2(s[2 * 33], s[3 * 33]); o.z = pk2(s[4 * 33], s[5 * 33]); o.w = pk2(s[6 * 33], s[7 * 33]);
        *(u32x4*)(WT + (size_t)rm(n0 + n) * ldt + k0 + 8 * c) = o; }
    LDS_WAIT();
}
__device__ __forceinline__ void norm_row_bf16(const float* xrow, const float* g, float* xcopy, bf16* hrow, int lane) {
    f32x4 v[4]; float s = 0.f;
#pragma unroll
    for (int j = 0; j < 4; ++j) { v[j] = *(const f32x4*)(xrow + 4 * lane + 256 * j); s += (v[j].x * v[j].x + v[j].y * v[j].y) + (v[j].z * v[j].z + v[j].w * v[j].w); }
    const float rs = 1.0f / sqrtf(wave_sum(s) * (1.f / D) + EPS);
#pragma unroll
    for (int j = 0; j < 4; ++j) { const f32x4 gg = *(const f32x4*)(g + 4 * lane + 256 * j);
        if (xcopy) *(f32x4*)(xcopy + 4 * lane + 256 * j) = v[j];
        u32x2 o; o.x = pk2(v[j].x * rs * gg.x, v[j].y * rs * gg.y); o.y = pk2(v[j].z * rs * gg.z, v[j].w * rs * gg.w);
        *(u32x2*)(hrow + 4 * lane + 256 * j) = o; }
}
__device__ __forceinline__ void p_prep(const Args& a, const Ctx& c, LAS unsigned char* lds) {
    LAS float* scr = (LAS float*)(lds + c.wave * 16384);
    constexpr int I0 = 16 * 17, I1 = 4 * 48, I2 = 4 * 32, I3 = 4 * 32, I4 = 16 * 32, I5 = 16 * 96, I6 = 16 * 32, I7 = 16 * 128, I8 = 16 * 128, I9 = 64 * 32, I10 = 64 * 32;
    constexpr int NIT = I0 + I1 + I2 + I3 + I4 + I5 + I6 + I7 + I8 + I9 + I10;
    for (int it = c.gw; it < NIT; it += c.ngw) {
        int r = it;
        if (r < I0) { tr_item(IN_F(11), 544, 17, r, WSB(WS_WIN0), 1024, RmId{0}, scr, c.lane); continue; } r -= I0;
        if (r < I1) { tr_item(IN_F(13), 1536, 48, r, WSB(WS_WUQ), 256, RmUq{}, scr, c.lane); continue; } r -= I1;
        if (r < I2) { tr_item(IN_F(15), 1024, 32, r, WSB(WS_WUKV), 256, RmId{0}, scr, c.lane); continue; } r -= I2;
        if (r < I3) { tr_item(IN_F(16), 1024, 32, r, WSB(WS_WUKV), 256, RmId{1024}, scr, c.lane); continue; } r -= I3;
        if (r < I4) { tr_item(IN_F(17), 1024, 32, r, WSB(WS_WO0), 1024, RmId{0}, scr, c.lane); continue; } r -= I4;
        if (r < I5) { tr_item(IN_F(18), 3088, 96, r, WSB(WS_WGIN), 1024, RmId{0}, scr, c.lane); continue; } r -= I5;
        if (r < I6) { tr_item(IN_F(22), 1024, 32, r, WSB(WS_WGO), 1024, RmId{0}, scr, c.lane); continue; } r -= I6;
        if (r < I7) { tr_item(IN_F(23), 4096, 128, r, WSB(WS_WUP), 1024, RmId{0}, scr, c.lane); continue; } r -= I7;
        if (r < I8) { tr_item(IN_F(23) + (size_t)1024 * 4096, 4096, 128, r, WSB(WS_WUP) + (size_t)4096 * 1024, 1024, RmId{0}, scr, c.lane); continue; } r -= I8;
        if (r < I9) { tr_item(IN_F(24), 1024, 32, r, WSB(WS_WDN), 4096, RmId{0}, scr, c.lane); continue; } r -= I9;
        tr_item(IN_F(24) + (size_t)4096 * 1024, 1024, 32, r, WSB(WS_WDN) + (size_t)1024 * 4096, 4096, RmId{0}, scr, c.lane);
    }
    const int gt = c.gw * 64 + c.lane, ngt = c.ngw * 64;
    for (int i = gt; i < (NIN0 - 544) * 1024 / 2; i += ngt) ((unsigned*)(WSB(WS_WIN0) + (size_t)544 * 1024))[i] = 0u;
    for (int i = gt; i < (NGIN - NGIN_REAL) * 1024 / 2; i += ngt) ((unsigned*)(WSB(WS_WGIN) + (size_t)NGIN_REAL * 1024))[i] = 0u;
    for (int i = gt; i < 16 * 1024; i += ngt) { const int n = i >> 10, k = i & 1023; WSB(WS_WGIN)[(size_t)(3072 + n) * 1024 + k] = (bf16)f2bf(IN_F(18)[(size_t)k * 3088 + 3072 + n]); }
    for (int r = c.gw; r < R; r += c.ngw) {
        const float* xs = r < RMAIN ? IN_F(0) + (size_t)r * D : (r < RSAMP0 ? IN_F(6) + (size_t)((r - RMAIN) & 15) * D : IN_F(1) + (size_t)(r - RSAMP0) * D);
        norm_row_bf16(xs, IN_F(7), WSF(WS_X) + (size_t)r * D, WSB(WS_H) + (size_t)r * D, c.lane);
    }
}

struct EpiF32 { float* C; int ldc; __device__ __forceinline__ void store4(int row, int col, f32x4 v) const { *(f32x4*)(C + (size_t)row * ldc + col) = v; } };
struct EpiBf16 { bf16* C; int ldc; __device__ __forceinline__ void store4(int row, int col, f32x4 v) const { u32x2 o; o.x = pk2(v.x, v.y); o.y = pk2(v.z, v.w); *(u32x2*)(C + (size_t)row * ldc + col) = o; } };
struct EpiRelu2 { bf16* C; int ldc; __device__ __forceinline__ void store4(int row, int col, f32x4 v) const {
    f32x4 r; r.x = fmaxf(v.x, 0.f); r.y = fmaxf(v.y, 0.f); r.z = fmaxf(v.z, 0.f); r.w = fmaxf(v.w, 0.f); r = r * r;
    u32x2 o; o.x = pk2(r.x, r.y); o.y = pk2(r.z, r.w); *(u32x2*)(C + (size_t)row * ldc + col) = o; } };
struct EpiGla { bf16 *QG, *KG, *VG, *RG; float* GD;
    __device__ __forceinline__ void store4(int row, int col, f32x4 v) const {
        if (col < 3072) { bf16* dst; int cc;
            if (col < 512) { dst = QG + (size_t)row * 512; cc = col; v = v * GLA_SCALE; }
            else if (col < 1024) { dst = KG + (size_t)row * 512; cc = col - 512; }
            else if (col < 2048) { dst = VG + (size_t)row * 1024; cc = col - 1024; }
            else { dst = RG + (size_t)row * 1024; cc = col - 2048; }
            u32x2 o; o.x = pk2(v.x, v.y); o.y = pk2(v.z, v.w); *(u32x2*)(dst + cc) = o;
        } else if (col < 3088) { *(f32x4*)(GD + (size_t)row * 16 + (col - 3072)) = v; }
    } };
template <class Epi>
__device__ __forceinline__ void gemm_naive(const bf16* A, const bf16* Bt, int M, int N, int K, const Epi& E, LAS unsigned char* lds, int tid) {
    LAS float* As = (LAS float*)lds;
    LAS float* Bs = As + 32 * 68;
    const int ntm = M / 64, ntn = N / 128, ty = tid >> 5, tx = tid & 31;
    for (int tile = blockIdx.x; tile < ntm * ntn; tile += gridDim.x) {
        const int tm = tile / ntn, tn = tile % ntn;
        f32x4 acc[4];
#pragma unroll
        for (int i = 0; i < 4; ++i) acc[i] = (f32x4){0.f, 0.f, 0.f, 0.f};
        for (int k0 = 0; k0 < K; k0 += 32) {
            { const int row = tid >> 3, kq = (tid & 7) * 4; const u32x2 v = *(const u32x2*)(A + (size_t)(tm * 64 + row) * K + k0 + kq);
              As[(kq + 0) * 68 + row] = bflo(v.x); As[(kq + 1) * 68 + row] = bfhi(v.x); As[(kq + 2) * 68 + row] = bflo(v.y); As[(kq + 3) * 68 + row] = bfhi(v.y); }
            { const int row = tid >> 2, kq = (tid & 3) * 8; const u32x4 v = *(const u32x4*)(Bt + (size_t)(tn * 128 + row) * K + k0 + kq);
              Bs[(kq + 0) * 132 + row] = bflo(v.x); Bs[(kq + 1) * 132 + row] = bfhi(v.x); Bs[(kq + 2) * 132 + row] = bflo(v.y); Bs[(kq + 3) * 132 + row] = bfhi(v.y);
              Bs[(kq + 4) * 132 + row] = bflo(v.z); Bs[(kq + 5) * 132 + row] = bfhi(v.z); Bs[(kq + 6) * 132 + row] = bflo(v.w); Bs[(kq + 7) * 132 + row] = bfhi(v.w); }
            __syncthreads();
#pragma unroll 8
            for (int k = 0; k < 32; ++k) {
                const f32x4 av = *(const LAS f32x4*)(As + k * 68 + 4 * ty); const f32x4 bv = *(const LAS f32x4*)(Bs + k * 132 + 4 * tx);
                acc[0] += av.x * bv; acc[1] += av.y * bv; acc[2] += av.z * bv; acc[3] += av.w * bv;
            }
            __syncthreads();
        }
#pragma unroll
        for (int i = 0; i < 4; ++i) E.store4(tm * 64 + 4 * ty + i, tn * 128 + 4 * tx, acc[i]);
    }
}

__device__ __forceinline__ void p_mla_mid(const Args& a, const Ctx& c) {
    const float* A1 = WSF(WS_A1);
    for (int r = c.gw; r < R; r += c.ngw) {
        const float* row = A1 + (size_t)r * NIN0; const int pos = row_pos(r);
        const f32x4 cq = *(const f32x4*)(row + 4 * c.lane), ck = *(const f32x4*)(row + 256 + 4 * c.lane);
        const float rq = 1.0f / sqrtf(wave_sum((cq.x * cq.x + cq.y * cq.y) + (cq.z * cq.z + cq.w * cq.w)) * (1.f / 256) + EPS);
        const float rk = 1.0f / sqrtf(wave_sum((ck.x * ck.x + ck.y * ck.y) + (ck.z * ck.z + ck.w * ck.w)) * (1.f / 256) + EPS);
        const f32x4 gq = *(const f32x4*)(IN_F(12) + 4 * c.lane), gk = *(const f32x4*)(IN_F(14) + 4 * c.lane);
        const f32x4 qn = cq * rq * gq, kn = ck * rk * gk;
        u32x2 o; o.x = pk2(qn.x, qn.y); o.y = pk2(qn.z, qn.w); *(u32x2*)(WSB(WS_CQN) + (size_t)r * 256 + 4 * c.lane) = o;
        o.x = pk2(kn.x, kn.y); o.y = pk2(kn.z, kn.w); *(u32x2*)(WSB(WS_CKVN) + (size_t)r * 256 + 4 * c.lane) = o;
        float* ockv; float* okpe;
        if (r < RSAMP0) { const int b = r < RMAIN ? (r >> 12) : ((r - RMAIN) >> 4); ockv = a.out + O_CKVP + ((size_t)b * TP + pos) * 256; okpe = a.out + O_KPEP + ((size_t)b * TP + pos) * 32; }
        else { ockv = a.out + O_CKVS + (size_t)(r - RSAMP0) * 256; okpe = a.out + O_KPES + (size_t)(r - RSAMP0) * 32; }
        *(f32x4*)(ockv + 4 * c.lane) = kn;
        if (c.lane < 16) { const int j = c.lane; const float x1 = row[512 + j], x2 = row[528 + j]; float cs, sn; rope_cs(pos, j, cs, sn);
            const float o1 = x1 * cs - x2 * sn, o2 = x1 * sn + x2 * cs; okpe[j] = o1; okpe[16 + j] = o2;
            WSB(WS_KPE)[(size_t)r * 32 + j] = (bf16)f2bf(o1); WSB(WS_KPE)[(size_t)r * 32 + 16 + j] = (bf16)f2bf(o2); }
    }
}
__device__ __forceinline__ void p_q_post(const Args& a, const Ctx& c) {
    for (int r = c.gw; r < R; r += c.ngw) {
        const float* row = WSF(WS_QRAW) + (size_t)r * NUQ; const int pos = row_pos(r);
#pragma unroll
        for (int j = 0; j < 4; ++j) { const f32x4 v = *(const f32x4*)(row + 4 * c.lane + 256 * j); u32x2 o; o.x = pk2(v.x, v.y); o.y = pk2(v.z, v.w); *(u32x2*)(WSB(WS_QN) + (size_t)r * 1024 + 4 * c.lane + 256 * j) = o; }
#pragma unroll
        for (int j = 0; j < 4; ++j) { const int p = c.lane + 64 * j, h = p >> 4, jj = p & 15; const float x1 = row[1024 + 2 * p], x2 = row[1024 + 2 * p + 1]; float cs, sn; rope_cs(pos, jj, cs, sn);
            WSB(WS_QPE)[(size_t)r * 512 + h * 32 + jj] = (bf16)f2bf(x1 * cs - x2 * sn); WSB(WS_QPE)[(size_t)r * 512 + h * 32 + 16 + jj] = (bf16)f2bf(x1 * sn + x2 * cs); }
    }
}
__device__ __forceinline__ void p_qlat(const Args& a, const Ctx& c) {
    const float* wuk = IN_F(15);
    for (int it = c.gw; it < DB * DS * NH; it += c.ngw) {
        const int i = it >> 4, h = it & 15;
        const float q = WSF(WS_QRAW)[(size_t)(RSAMP0 + i) * NUQ + h * 64 + c.lane];
        float acc[4] = {0.f, 0.f, 0.f, 0.f};
#pragma unroll 8
        for (int n = 0; n < 64; ++n) { const float qn = __shfl(q, n);
#pragma unroll
            for (int k = 0; k < 4; ++k) acc[k] += qn * wuk[(size_t)(c.lane + 64 * k) * 1024 + h * 64 + n]; }
#pragma unroll
        for (int k = 0; k < 4; ++k) WSB(WS_QLAT)[((size_t)i * 16 + h) * 256 + c.lane + 64 * k] = (bf16)f2bf(acc[k]);
    }
}
__device__ __forceinline__ void p_attn_prompt_naive(const Args& a, const Ctx& c) {
    const bf16* QN = WSB(WS_QN); const bf16* QPE = WSB(WS_QPE); const bf16* KNV = WSB(WS_KNV); const bf16* KPE = WSB(WS_KPE);
    for (int item = c.gw; item < (RPROMPT / 64) * NH; item += c.ngw) {
        const int rb = item >> 4, h = item & 15, r = rb * 64 + c.lane;
        int b, nk;
        if (r < RMAIN) { b = r >> 12; nk = NMETA + (r & 4095) + 1; } else { const int i = r - RMAIN; b = i >> 4; nk = (i & 15) + 1; }
        const int mbase = RMAIN + 16 * b, tbase = 4096 * b;
        float qn[64], qp[32], o[64];
#pragma unroll
        for (int j = 0; j < 8; ++j) { const u32x4 v = *(const u32x4*)(QN + (size_t)r * 1024 + h * 64 + 8 * j);
            qn[8 * j] = bflo(v.x); qn[8 * j + 1] = bfhi(v.x); qn[8 * j + 2] = bflo(v.y); qn[8 * j + 3] = bfhi(v.y); qn[8 * j + 4] = bflo(v.z); qn[8 * j + 5] = bfhi(v.z); qn[8 * j + 6] = bflo(v.w); qn[8 * j + 7] = bfhi(v.w); }
#pragma unroll
        for (int j = 0; j < 4; ++j) { const u32x4 v = *(const u32x4*)(QPE + (size_t)r * 512 + h * 32 + 8 * j);
            qp[8 * j] = bflo(v.x); qp[8 * j + 1] = bfhi(v.x); qp[8 * j + 2] = bflo(v.y); qp[8 * j + 3] = bfhi(v.y); qp[8 * j + 4] = bflo(v.z); qp[8 * j + 5] = bfhi(v.z); qp[8 * j + 6] = bflo(v.w); qp[8 * j + 7] = bfhi(v.w); }
#pragma unroll
        for (int j = 0; j < 64; ++j) o[j] = 0.f;
        float m = -INFINITY, l = 0.f;
        const int nkmax = wave_max_i(nk);
        for (int kk = 0; kk < nkmax; ++kk) {
            if (kk < nk) {
                const int kr = kk < NMETA ? mbase + kk : tbase + kk - NMETA;
                const bf16* kn = KNV + (size_t)kr * 2048 + h * 64; const bf16* kp = KPE + (size_t)kr * 32; const bf16* vv = kn + 1024;
                float s = 0.f;
#pragma unroll
                for (int j = 0; j < 8; ++j) { const u32x4 v = *(const u32x4*)(kn + 8 * j);
                    s += qn[8 * j] * bflo(v.x) + qn[8 * j + 1] * bfhi(v.x) + qn[8 * j + 2] * bflo(v.y) + qn[8 * j + 3] * bfhi(v.y) + qn[8 * j + 4] * bflo(v.z) + qn[8 * j + 5] * bfhi(v.z) + qn[8 * j + 6] * bflo(v.w) + qn[8 * j + 7] * bfhi(v.w); }
#pragma unroll
                for (int j = 0; j < 4; ++j) { const u32x4 v = *(const u32x4*)(kp + 8 * j);
                    s += qp[8 * j] * bflo(v.x) + qp[8 * j + 1] * bfhi(v.x) + qp[8 * j + 2] * bflo(v.y) + qp[8 * j + 3] * bfhi(v.y) + qp[8 * j + 4] * bflo(v.z) + qp[8 * j + 5] * bfhi(v.z) + qp[8 * j + 6] * bflo(v.w) + qp[8 * j + 7] * bfhi(v.w); }
                s *= MLA_SCALE;
                const float mn = fmaxf(m, s), corr = __expf(m - mn), p = __expf(s - mn);
                l = l * corr + p; m = mn;
#pragma unroll
                for (int j = 0; j < 8; ++j) { const u32x4 v = *(const u32x4*)(vv + 8 * j);
                    o[8 * j] = o[8 * j] * corr + p * bflo(v.x); o[8 * j + 1] = o[8 * j + 1] * corr + p * bfhi(v.x); o[8 * j + 2] = o[8 * j + 2] * corr + p * bflo(v.y); o[8 * j + 3] = o[8 * j + 3] * corr + p * bfhi(v.y);
                    o[8 * j + 4] = o[8 * j + 4] * corr + p * bflo(v.z); o[8 * j + 5] = o[8 * j + 5] * corr + p * bfhi(v.z); o[8 * j + 6] = o[8 * j + 6] * corr + p * bflo(v.w); o[8 * j + 7] = o[8 * j + 7] * corr + p * bfhi(v.w); }
            }
        }
        const float il = 1.0f / l;
#pragma unroll
        for (int j = 0; j < 8; ++j) { u32x4 w; w.x = pk2(o[8 * j] * il, o[8 * j + 1] * il); w.y = pk2(o[8 * j + 2] * il, o[8 * j + 3] * il); w.z = pk2(o[8 * j + 4] * il, o[8 * j + 5] * il); w.w = pk2(o[8 * j + 6] * il, o[8 * j + 7] * il);
            *(u32x4*)(WSB(WS_O) + (size_t)r * 1024 + h * 64 + 8 * j) = w; }
    }
}
__device__ __forceinline__ void p_attn_decode_naive(const Args& a, const Ctx& c) {
    const float* cckv = IN_F(2); const float* ckpe = IN_F(3); const int* pt = (const int*)a.in[5];
    for (int item = c.gw; item < DB * NH; item += c.ngw) {
        const int db = item >> 4, h = item & 15;
        f32x4 ql[4]; float qp[4], m[4], l[4]; f32x4 o[4];
#pragma unroll
        for (int t = 0; t < 4; ++t) { const u32x2 v = *(const u32x2*)(WSB(WS_QLAT) + ((size_t)(db * 4 + t) * 16 + h) * 256 + 4 * c.lane);
            ql[t] = (f32x4){bflo(v.x), bfhi(v.x), bflo(v.y), bfhi(v.y)};
            qp[t] = c.lane < 32 ? bf2f(WSB(WS_QPE)[(size_t)(RSAMP0 + db * 4 + t) * 512 + h * 32 + c.lane]) : 0.f;
            m[t] = -INFINITY; l[t] = 0.f; o[t] = (f32x4){0.f, 0.f, 0.f, 0.f}; }
        for (int p = 0; p < NPAGES; ++p) {
            const int page = pt[db * NPAGES + p];
            for (int k = 0; k < PAGE; ++k) {
                const size_t kr = (size_t)page * PAGE + k;
                const f32x4 cv = *(const f32x4*)(cckv + kr * 256 + 4 * c.lane); const float e = c.lane < 32 ? ckpe[kr * 32 + c.lane] : 0.f;
#pragma unroll
                for (int t = 0; t < 4; ++t) {
                    float d = (ql[t].x * cv.x + ql[t].y * cv.y) + (ql[t].z * cv.z + ql[t].w * cv.w) + qp[t] * e;
                    d = wave_sum(d) * MLA_SCALE;
                    const float mn = fmaxf(m[t], d), corr = __expf(m[t] - mn), pp = __expf(d - mn);
                    l[t] = l[t] * corr + pp; m[t] = mn; o[t] = o[t] * corr + pp * cv;
                }
            }
        }
#pragma unroll
        for (int s2 = 0; s2 < 4; ++s2) {
            const int kr = RSAMP0 + db * 4 + s2;
            const u32x2 v = *(const u32x2*)(WSB(WS_CKVN) + (size_t)kr * 256 + 4 * c.lane); const f32x4 cv = (f32x4){bflo(v.x), bfhi(v.x), bflo(v.y), bfhi(v.y)};
            const float e = c.lane < 32 ? bf2f(WSB(WS_KPE)[(size_t)kr * 32 + c.lane]) : 0.f;
#pragma unroll
            for (int t = 0; t < 4; ++t) if (t >= s2) {
                float d = (ql[t].x * cv.x + ql[t].y * cv.y) + (ql[t].z * cv.z + ql[t].w * cv.w) + qp[t] * e;
                d = wave_sum(d) * MLA_SCALE;
                const float mn = fmaxf(m[t], d), corr = __expf(m[t] - mn), pp = __expf(d - mn);
                l[t] = l[t] * corr + pp; m[t] = mn; o[t] = o[t] * corr + pp * cv;
            }
        }
#pragma unroll
        for (int t = 0; t < 4; ++t) *(f32x4*)(WSF(WS_OLAT) + ((size_t)(db * 4 + t) * 16 + h) * 256 + 4 * c.lane) = o[t] * (1.0f / l[t]);
    }
}
__device__ __forceinline__ void p_olat_up(const Args& a, const Ctx& c) {
    const float* wuv = IN_F(16);
    for (int it = c.gw; it < DB * DS * NH; it += c.ngw) {
        const int i = it >> 4, h = it & 15; const float* ol = WSF(WS_OLAT) + ((size_t)i * 16 + h) * 256;
        float acc = 0.f;
#pragma unroll 8
        for (int cc = 0; cc < 256; ++cc) acc += ol[cc] * wuv[(size_t)cc * 1024 + h * 64 + c.lane];
        WSB(WS_O)[(size_t)(RSAMP0 + i) * 1024 + h * 64 + c.lane] = (bf16)f2bf(acc);
    }
}
template <bool FINAL>
__device__ __forceinline__ void p_post_res(const Args& a, const Ctx& c, const float* gpost, const float* gnext) {
    for (int r = c.gw; r < R; r += c.ngw) {
        const float* mrow = WSF(WS_M) + (size_t)r * D; float* xrow = WSF(WS_X) + (size_t)r * D;
        f32x4 mv[4], xv[4]; float s = 0.f;
#pragma unroll
        for (int j = 0; j < 4; ++j) { mv[j] = *(const f32x4*)(mrow + 4 * c.lane + 256 * j); xv[j] = *(const f32x4*)(xrow + 4 * c.lane + 256 * j); s += (mv[j].x * mv[j].x + mv[j].y * mv[j].y) + (mv[j].z * mv[j].z + mv[j].w * mv[j].w); }
        const float rm = 1.0f / sqrtf(wave_sum(s) * (1.f / D) + EPS); float s2 = 0.f;
#pragma unroll
        for (int j = 0; j < 4; ++j) { const f32x4 g = *(const f32x4*)(gpost + 4 * c.lane + 256 * j); xv[j] = xv[j] + mv[j] * rm * g; s2 += (xv[j].x * xv[j].x + xv[j].y * xv[j].y) + (xv[j].z * xv[j].z + xv[j].w * xv[j].w); }
        if (FINAL) {
            if (r >= RMAIN && r < RSAMP0) continue;
            float* y = r < RMAIN ? a.out + O_YP + (size_t)r * D : a.out + O_YS + (size_t)(r - RSAMP0) * D;
#pragma unroll
            for (int j = 0; j < 4; ++j) *(f32x4*)(y + 4 * c.lane + 256 * j) = xv[j];
        } else {
            const float rx = 1.0f / sqrtf(wave_sum(s2) * (1.f / D) + EPS);
#pragma unroll
            for (int j = 0; j < 4; ++j) { const f32x4 g = *(const f32x4*)(gnext + 4 * c.lane + 256 * j); *(f32x4*)(xrow + 4 * c.lane + 256 * j) = xv[j];
                u32x2 o; o.x = pk2(xv[j].x * rx * g.x, xv[j].y * rx * g.y); o.y = pk2(xv[j].z * rx * g.z, xv[j].w * rx * g.w); *(u32x2*)(WSB(WS_H) + (size_t)r * D + 4 * c.lane + 256 * j) = o; }
        }
    }
}

__device__ __forceinline__ void p_gate(const Args& a, const Ctx& c) {
    const float* wg = IN_F(19); const float* bg = IN_F(20);
    const size_t gt = (size_t)c.gw * 64 + c.lane, ngt = (size_t)c.ngw * 64;
    for (size_t i = gt; i < (size_t)R * 512; i += ngt) {
        const int r = (int)(i >> 9), col = (int)(i & 511); const float* gd = WSF(WS_GD) + (size_t)r * 16;
        float x = bg[col];
#pragma unroll
        for (int j = 0; j < 16; ++j) x += gd[j] * wg[j * 512 + col];
        const float ls = fminf(x, 0.f) - log1pf(__expf(-fabsf(x)));
        const float la = ls * (1.0f / 16.0f);
        WSF(WS_LA)[i] = la; WSF(WS_EA)[i] = __expf(la);
    }
}
__device__ __forceinline__ void gla_step(float (&S)[128], float& o, float a0, float a1, float k0, float k1, float q0, float q1, float v) {
    o = 0.f;
#pragma unroll
    for (int d = 0; d < 64; ++d) { const float ad = rdlane(a0, d), kd = rdlane(k0, d), qd = rdlane(q0, d); S[d] = ad * S[d] + kd * v; o += qd * S[d]; }
#pragma unroll
    for (int d = 0; d < 64; ++d) { const float ad = rdlane(a1, d), kd = rdlane(k1, d), qd = rdlane(q1, d); S[64 + d] = ad * S[64 + d] + kd * v; o += qd * S[64 + d]; }
}
__device__ __forceinline__ void p_gla_naive(const Args& a, const Ctx& c) {
    const float* EA = WSF(WS_EA); const bf16* KG = WSB(WS_KG); const bf16* QG = WSB(WS_QG); const bf16* VG = WSB(WS_VG); float* OGR = WSF(WS_OGRAW);
    for (int item = c.gwT; item < NB * GH * 4; item += c.ngw) {
        const int b = item >> 4, h = (item >> 2) & 3, dv = (item & 3) * 64 + c.lane;
        float S[128];
#pragma unroll
        for (int d = 0; d < 128; ++d) S[d] = 0.f;
        for (int tt = 0; tt < TP; ++tt) {
            const int row = tt < NMETA ? RMAIN + 16 * b + tt : 4096 * b + tt - NMETA;
            const size_t g = (size_t)row * 512 + h * 128;
            const float a0 = EA[g + c.lane], a1 = EA[g + 64 + c.lane], k0 = bf2f(KG[g + c.lane]), k1 = bf2f(KG[g + 64 + c.lane]), q0 = bf2f(QG[g + c.lane]), q1 = bf2f(QG[g + 64 + c.lane]);
            const float v = bf2f(VG[(size_t)row * 1024 + h * 256 + dv]);
            float o; gla_step(S, o, a0, a1, k0, k1, q0, q1, v);
            OGR[(size_t)row * 1024 + h * 256 + dv] = o;
        }
        float* outp = a.out + O_GLAP + ((size_t)(b * 4 + h) * 128) * 256 + dv;
#pragma unroll
        for (int d = 0; d < 128; ++d) outp[(size_t)d * 256] = S[d];
    }
    for (int item = c.gwT; item < DB * GH * 4; item += c.ngw) {
        const int db = item >> 4, h = (item >> 2) & 3, dv = (item & 3) * 64 + c.lane;
        const float* sp = IN_F(4) + ((size_t)(db * 4 + h) * 128) * 256 + dv;
        float S[128];
#pragma unroll
        for (int d = 0; d < 128; ++d) S[d] = sp[(size_t)d * 256];
#pragma unroll 1
        for (int s = 0; s < DS; ++s) {
            const int row = RSAMP0 + db * 4 + s; const size_t g = (size_t)row * 512 + h * 128;
            const float a0 = EA[g + c.lane], a1 = EA[g + 64 + c.lane], k0 = bf2f(KG[g + c.lane]), k1 = bf2f(KG[g + 64 + c.lane]), q0 = bf2f(QG[g + c.lane]), q1 = bf2f(QG[g + 64 + c.lane]);
            const float v = bf2f(VG[(size_t)row * 1024 + h * 256 + dv]);
            float o; gla_step(S, o, a0, a1, k0, k1, q0, q1, v);
            OGR[(size_t)row * 1024 + h * 256 + dv] = o;
        }
        float* outp = a.out + O_GLAS + ((size_t)(db * 4 + h) * 128) * 256 + dv;
#pragma unroll
        for (int d = 0; d < 128; ++d) outp[(size_t)d * 256] = S[d];
    }
}
__device__ __forceinline__ void p_gla_post(const Args& a, const Ctx& c) {
    const float* gn = IN_F(21);
    for (int r = c.gw; r < R; r += c.ngw) {
#pragma unroll
        for (int h = 0; h < 4; ++h) {
            const size_t off = (size_t)r * 1024 + h * 256 + 4 * c.lane;
            const f32x4 o = *(const f32x4*)(WSF(WS_OGRAW) + off); const u32x2 rv = *(const u32x2*)(WSB(WS_RG) + off); const f32x4 g = *(const f32x4*)(gn + 4 * c.lane);
            const float rs = 1.0f / sqrtf(wave_sum((o.x * o.x + o.y * o.y) + (o.z * o.z + o.w * o.w)) * (1.f / 256) + EPS);
            const f32x4 rr = (f32x4){bflo(rv.x), bfhi(rv.x), bflo(rv.y), bfhi(rv.y)};
            f32x4 sl; sl.x = rr.x / (1.f + __expf(-rr.x)); sl.y = rr.y / (1.f + __expf(-rr.y)); sl.z = rr.z / (1.f + __expf(-rr.z)); sl.w = rr.w / (1.f + __expf(-rr.w));
            const f32x4 y = o * rs * g * sl;
            u32x2 w; w.x = pk2(y.x, y.y); w.y = pk2(y.z, y.w); *(u32x2*)(WSB(WS_OG) + off) = w;
        }
    }
}

constexpr int NPHASE = 22;
__global__ void __launch_bounds__(512, 2) fwd(Args a) {
    extern __shared__ __attribute__((aligned(16))) unsigned char lds_raw[];
    LAS unsigned char* lds = (LAS unsigned char*)lds_raw;
    Ctx c; c.tid = threadIdx.x; c.lane = c.tid & 63; c.wave = __builtin_amdgcn_readfirstlane(c.tid >> 6);
    c.gw = blockIdx.x * 8 + c.wave; c.ngw = gridDim.x * 8; c.gwT = c.wave * gridDim.x + blockIdx.x;
    volatile LAS unsigned* MISC = (volatile LAS unsigned*)(lds + MISC_OFF);
    if (c.tid < 32) MISC[c.tid] = 0u;
    __syncthreads();
    XcdBarrier bar; bar.bar = (unsigned*)(a.ws + WS_CTL) + CW_BAR; bar.x = 0; bar.st = nullptr;
    const bool one = (a.ph_hi - a.ph_lo) > 1;
    if (one) bar = xcd_barrier_post((unsigned*)(a.ws + WS_CTL) + CW_BAR, MISC + 8);
    const int lo = a.ph_lo, hi = a.ph_hi;
#define IN(k) (lo <= (k) && (k) < hi)
#define SEAM(k) do { if (IN(k) && IN((k) + 1)) xcd_barrier(bar); } while (0)
    if (IN(0)) { p_prep(a, c, lds); } SEAM(0);
    if (IN(1)) { gemm_naive(WSB(WS_H), WSB(WS_WIN0), RP, NIN0, D, EpiF32{WSF(WS_A1), NIN0}, lds, c.tid); } SEAM(1);
    if (IN(2)) { p_mla_mid(a, c); } SEAM(2);
    if (IN(3)) { gemm_naive(WSB(WS_CQN), WSB(WS_WUQ), RP, NUQ, QL, EpiF32{WSF(WS_QRAW), NUQ}, lds, c.tid);
                 gemm_naive(WSB(WS_CKVN), WSB(WS_WUKV), RP, NUKV, KVL, EpiBf16{WSB(WS_KNV), NUKV}, lds, c.tid); } SEAM(3);
    if (IN(4)) { p_q_post(a, c); p_qlat(a, c); } SEAM(4);
    if (IN(5)) { p_attn_prompt_naive(a, c); p_attn_decode_naive(a, c); } SEAM(5);
    if (IN(6)) { p_olat_up(a, c); } SEAM(6);
    if (IN(7)) { gemm_naive(WSB(WS_O), WSB(WS_WO0), RP, D, D, EpiF32{WSF(WS_M), D}, lds, c.tid); } SEAM(7);
    if (IN(8)) { p_post_res<false>(a, c, IN_F(8), IN_F(9)); } SEAM(8);
    if (IN(9)) { gemm_naive(WSB(WS_H), WSB(WS_WUP), RP, FF, D, EpiRelu2{WSB(WS_U), FF}, lds, c.tid); } SEAM(9);
    if (IN(10)) { gemm_naive(WSB(WS_U), WSB(WS_WDN), RP, D, FF, EpiF32{WSF(WS_M), D}, lds, c.tid); } SEAM(10);
    if (IN(11)) { p_post_res<false>(a, c, IN_F(10), IN_F(7) + D); } SEAM(11);
    if (IN(12)) { gemm_naive(WSB(WS_H), WSB(WS_WGIN), RP, NGIN, D, EpiGla{WSB(WS_QG), WSB(WS_KG), WSB(WS_VG), WSB(WS_RG), WSF(WS_GD)}, lds, c.tid); } SEAM(12);
    if (IN(13)) { p_gate(a, c); } SEAM(13);
    if (IN(14)) { p_gla_naive(a, c); } SEAM(14);
    if (IN(15)) { p_gla_post(a, c); } SEAM(15);
    if (IN(16)) { gemm_naive(WSB(WS_OG), WSB(WS_WGO), RP, D, D, EpiF32{WSF(WS_M), D}, lds, c.tid); } SEAM(16);
    if (IN(17)) { p_post_res<false>(a, c, IN_F(8) + D, IN_F(9) + D); } SEAM(17);
    if (IN(18)) { gemm_naive(WSB(WS_H), WSB(WS_WUP) + (size_t)FF * D, RP, FF, D, EpiRelu2{WSB(WS_U), FF}, lds, c.tid); } SEAM(18);
    if (IN(19)) { gemm_naive(WSB(WS_U), WSB(WS_WDN) + (size_t)D * FF, RP, D, FF, EpiF32{WSF(WS_M), D}, lds, c.tid); } SEAM(19);
    if (IN(20)) { p_post_res<true>(a, c, IN_F(10) + D, nullptr); }
#undef IN
#undef SEAM
}

extern "C" void kernel_launch(void* const* d_in, const int* in_sizes, int n_in, void* d_out, int out_size, void* d_ws, size_t ws_size, hipStream_t stream) {
    static int grid = 0;
    if (grid == 0) {
        if (n_in != 25 || out_size != (int)O_END || ws_size < WS_END) { fprintf(stderr, "kernel_launch: unexpected shapes n_in %d out %d ws %zu\n", n_in, out_size, ws_size); grid = -1; return; }
        int dev = 0, cus = 0, per_cu = 0;
        if (hipGetDevice(&dev) != hipSuccess || hipDeviceGetAttribute(&cus, hipDeviceAttributeMultiprocessorCount, dev) != hipSuccess) { grid = -1; return; }
        if (hipFuncSetAttribute((const void*)fwd, hipFuncAttributeMaxDynamicSharedMemorySize, LDS_BYTES) != hipSuccess) { fprintf(stderr, "kernel_launch: hipFuncSetAttribute failed\n"); grid = -1; return; }
        if (hipOccupancyMaxActiveBlocksPerMultiprocessor(&per_cu, (const void*)fwd, 512, LDS_BYTES) != hipSuccess || per_cu < 1) fprintf(stderr, "kernel_launch: occupancy query says %d\n", per_cu);
        (void)hipGetLastError();
        grid = cus;
    }
    if (grid < 0) return;
    if (hipMemsetAsync((char*)d_ws + WS_CTL, 0, CTL_ZERO_BYTES, stream) != hipSuccess) return;
    Args a{};
    for (int i = 0; i < 25; ++i) a.in[i] = d_in[i];
    a.out = (float*)d_out; a.ws = (unsigned char*)d_ws;
#if MK_ONE_LAUNCH
    a.ph_lo = 0; a.ph_hi = NPHASE;
    hipLaunchKernelGGL(fwd, dim3(grid), dim3(512), LDS_BYTES, stream, a);
#else
    for (int ph = 0; ph < NPHASE - 1; ++ph) { a.ph_lo = ph; a.ph_hi = ph + 1; hipLaunchKernelGGL(fwd, dim3(grid), dim3(512), LDS_BYTES, stream, a); }
#endif
}
```

```cpp
#include <hip/hip_runtime.h>
#include <cstdio>
#include <cstdint>
#include <cmath>

#ifndef MK_ONE_LAUNCH
#define MK_ONE_LAUNCH 1
#endif

constexpr int D = 1024, NB = 4, SEQ = 4096, NMETA = 16, TP = SEQ + NMETA;
constexpr int DB = 128, DS = 4, PAST = 8192, PAGE = 128, NPAGES = 64;
constexpr int NH = 16, QL = 256, KVL = 256, NOPE = 64, ROPE = 32, VH = 64;
constexpr int GH = 4, GDK = 128, GDV = 256, GR = 16;
constexpr int FF = 4096;
constexpr int RMAIN = NB * SEQ;
constexpr int RMETA0 = RMAIN;
constexpr int RSAMP0 = RMAIN + NB * NMETA;
constexpr int R = RSAMP0 + DB * DS;
constexpr int RPROMPT = RSAMP0;
constexpr int RP = 17152;
constexpr int NIN0 = 768, NUQ = 1536, NUKV = 2048, NGIN = 3328, NGIN_REAL = 3088;
constexpr float EPS = 1e-6f;
constexpr float MLA_SCALE = 0.10206207261596575f;
constexpr float GLA_SCALE = 0.08838834764831845f;
constexpr float QSCALE = 0.10206207261596575f * 1.4426950408889634f;

constexpr size_t O_YP = 0, O_YS = 16777216, O_CKVP = 17301504, O_KPEP = 21512192, O_CKVS = 22038528, O_KPES = 22169600, O_GLAP = 22185984, O_GLAS = 22710272, O_END = 39487488;

constexpr size_t MiB = 1u << 20;
constexpr size_t WS_CTL = 0, CTL_ZERO_BYTES = 1 * MiB;
constexpr size_t WS_WIN0 = 2 * MiB, WS_WUQ = 4 * MiB, WS_WUKV = 5 * MiB, WS_WO0 = 6 * MiB, WS_WUP = 8 * MiB, WS_WDN = 24 * MiB, WS_WGIN = 40 * MiB, WS_WGO = 47 * MiB;
constexpr size_t WS_X = 64 * MiB, WS_H = 132 * MiB, WS_M = 166 * MiB, WS_U = 234 * MiB, WS_A1 = 368 * MiB, WS_CQN = 419 * MiB, WS_CKVN = 428 * MiB, WS_KPE = 437 * MiB;
constexpr size_t WS_QRAW = 440 * MiB, WS_KNV = 541 * MiB, WS_QN = 608 * MiB, WS_QPE = 642 * MiB, WS_QLAT = 659 * MiB, WS_OLAT = 663 * MiB, WS_O = 671 * MiB;
constexpr size_t WS_QG = 705 * MiB, WS_KG = 722 * MiB, WS_VG = 739 * MiB, WS_RG = 773 * MiB, WS_GD = 807 * MiB, WS_LA = 809 * MiB, WS_EA = 843 * MiB, WS_OGRAW = 877 * MiB, WS_OG = 944 * MiB;
constexpr size_t WS_OPART = 978 * MiB, WS_MLP = 1012 * MiB;
constexpr size_t WS_QINF = 1014 * MiB, WS_KDTF = 1032 * MiB, WS_AMF = 1050 * MiB, WS_VTF = 1060 * MiB, WS_ELF = 1094 * MiB;
constexpr size_t WS_END = 1096 * MiB;
constexpr int CW_BAR = 4096;

constexpr int LDS_BYTES = 147456;
constexpr int MISC_OFF = 131072 + 320;

#define GAS __attribute__((address_space(1)))
#define LAS __attribute__((address_space(3)))
typedef unsigned short bf16;
typedef float f32x4 __attribute__((ext_vector_type(4)));
typedef unsigned u32x4 __attribute__((ext_vector_type(4)));
typedef unsigned u32x2 __attribute__((ext_vector_type(2)));
#define LDS_WAIT() asm volatile("s_waitcnt lgkmcnt(0)" ::: "memory")

__device__ __forceinline__ unsigned f2bf(float f) { unsigned u = __builtin_bit_cast(unsigned, f); return (u + 0x7fffu + ((u >> 16) & 1u)) >> 16; }
__device__ __forceinline__ unsigned pk2(float lo, float hi) { return f2bf(lo) | (f2bf(hi) << 16); }
__device__ __forceinline__ float bflo(unsigned u) { return __builtin_bit_cast(float, u << 16); }
__device__ __forceinline__ float bfhi(unsigned u) { return __builtin_bit_cast(float, u & 0xffff0000u); }
__device__ __forceinline__ float bf2f(bf16 v) { return __builtin_bit_cast(float, (unsigned)v << 16); }
__device__ __forceinline__ float wave_sum(float v) {
#pragma unroll
    for (int o = 1; o < 64; o <<= 1) v += __shfl_xor(v, o);
    return v;
}
__device__ __forceinline__ int wave_max_i(int v) {
#pragma unroll
    for (int o = 1; o < 64; o <<= 1) { int t = __shfl_xor(v, o); v = t > v ? t : v; }
    return v;
}
__device__ __forceinline__ float rdlane(float v, int l) { return __builtin_bit_cast(float, __builtin_amdgcn_readlane(__builtin_bit_cast(int, v), l)); }

#define XB_TMO      128
#define XB_XCNT(j)  (256  + 64 * (j))
#define XB_XSUB(j)  (1280 + 64 * (j))
#define XB_XGEN(j)  (2304 + 64 * (j))
#define XB_TOP      3328
#define XB_TOPGEN   3392
#define XCD_BAR_WORDS 3456
#define XB_SPIN_CAP (1u << 18)
__device__ __forceinline__ unsigned xb_ld(unsigned* p)              { return __hip_atomic_load(p, __ATOMIC_RELAXED, __HIP_MEMORY_SCOPE_AGENT); }
__device__ __forceinline__ unsigned xb_add(unsigned* p, unsigned v) { return __hip_atomic_fetch_add(p, v, __ATOMIC_RELAXED, __HIP_MEMORY_SCOPE_AGENT); }
__device__ __forceinline__ unsigned xb_xcc_id() { return (unsigned)__builtin_amdgcn_s_getreg((3 << 11) | 20) & 0xFu; }
#define XB_SPIN(cond, bar) do { unsigned _sp = 0; while (cond) { __builtin_amdgcn_s_sleep(1); \
    if ((++_sp & 255u) == 0u) { if (xb_ld(&(bar)[XB_TMO])) break; if (_sp > XB_SPIN_CAP) { atomicAdd(&(bar)[XB_TMO], 1u); break; } } } } while (0)
struct XcdBarrier { unsigned* bar; unsigned x; volatile LAS unsigned* st; };
__device__ __forceinline__ XcdBarrier xcd_barrier_post(unsigned* bar, volatile LAS unsigned* st) {
    XcdBarrier b; b.bar = bar; b.x = xb_xcc_id(); b.st = st;
    if (threadIdx.x == 0) (void)xb_add(&bar[XB_XCNT(b.x)], 1u);
    return b;
}
__device__ __forceinline__ void xcd_barrier_complete(unsigned* bar, unsigned x, unsigned& nloc, unsigned& nx) {
    const unsigned G = gridDim.x * gridDim.y * gridDim.z;
    unsigned sum, cnt, mine, sp = 0u;
    for (;;) {
        sum = 0u; cnt = 0u; mine = 0u;
#pragma unroll
        for (unsigned j = 0; j < 16; ++j) { const unsigned c = xb_ld(&bar[XB_XCNT(j)]); sum += c; cnt += (c > 0u) ? 1u : 0u; mine = (j == x) ? c : mine; }
        if (sum == G) break;
        __builtin_amdgcn_s_sleep(1);
        if ((++sp & 255u) == 0u) { if (xb_ld(&bar[XB_TMO])) break; if (sp > XB_SPIN_CAP) { atomicAdd(&bar[XB_TMO], 1u); break; } }
    }
    nloc = mine > 0u ? mine : 1u; nx = cnt > 0u ? cnt : 1u;
}
__device__ __forceinline__ void xcd_barrier(const XcdBarrier& b) {
    asm volatile("s_waitcnt vmcnt(0)" ::: "memory");
    __syncthreads();
    if (threadIdx.x == 0) {
        unsigned* bar = b.bar;
        __builtin_amdgcn_s_waitcnt(0);
        unsigned nloc = b.st[0], nx = b.st[1];
        if (nloc == 0u) { xcd_barrier_complete(bar, b.x, nloc, nx); b.st[0] = nloc; b.st[1] = nx; }
        const unsigned old = xb_add(&bar[XB_XSUB(b.x)], 1u);
        const unsigned gen = old / nloc;
        if (old + 1u == (gen + 1u) * nloc) {
            __builtin_amdgcn_fence(__ATOMIC_RELEASE, "agent");
            asm volatile("s_waitcnt vmcnt(0)" ::: "memory");
            const unsigned og = xb_add(&bar[XB_TOP], 1u);
            const unsigned tg = og / nx;
            if (og + 1u == (tg + 1u) * nx) xb_add(&bar[XB_TOPGEN], 1u);
            else XB_SPIN(xb_ld(&bar[XB_TOPGEN]) == tg, bar);
            __builtin_amdgcn_fence(__ATOMIC_ACQUIRE, "agent");
            xb_add(&bar[XB_XGEN(b.x)], 1u);
            asm volatile("s_waitcnt vmcnt(0)" ::: "memory");
        } else {
            XB_SPIN(xb_ld(&bar[XB_XGEN(b.x)]) == gen, bar);
            __builtin_amdgcn_fence(__ATOMIC_ACQUIRE, "agent");
            asm volatile("s_waitcnt vmcnt(0)" ::: "memory");
        }
    }
    __syncthreads();
}

namespace pg8 {
#define PG8_LAS __attribute__((address_space(3)))
typedef unsigned short bf16_t;
typedef short bf16x8 __attribute__((ext_vector_type(8)));
typedef float f32x4 __attribute__((ext_vector_type(4)));
typedef unsigned u32x4 __attribute__((ext_vector_type(4)));
constexpr int BM = 256, BK = 64, HALF = 128, HTB = HALF * BK * 2  , STAGE_BYTES = 8 * HTB, NXCD = 8, WGM = 8;

__host__ __device__ __forceinline__ int lds_byte(int r, int c) { const int st = (r >> 4) * 2 + (c >> 5), rr = r & 15, cc = c & 31, ob = rr * 64 + cc * 2; return st * 1024 + (ob ^ (((ob >> 9) & 1) << 5)); }
__host__ __device__ __forceinline__ void stage_rc(int b, int& R, int& C) { const int st = b / 1024, sb = b % 1024, swz = sb ^ (((sb >> 9) & 1) << 5); R = (st >> 1) * 16 + swz / 64; C = (st & 1) * 32 + (swz % 64) / 2; }
__host__ __device__ __forceinline__ int perm32(int rho) { const int n = rho >> 4, i = rho & 15; return 8 * (i >> 2) + 4 * n + (i & 3); }

struct Unit { int pm, pn; };
struct Gemm { const bf16_t* A; const bf16_t* Bt; int M, N, K; };

struct StaticOrder {
    int nM, nN, nwg, G, c;
    __host__ __device__ void init(int M, int N, int G_, int c_) { nM = M / BM; nN = N / BM; nwg = nM * nN; G = G_; c = c_; }
    __host__ __device__ bool next(int i, Unit& u) const {
        const long L = (long)i * G + c; if (L >= nwg) return false;
        int wgid = (int)L; { const int q = nwg / NXCD, r = nwg % NXCD, xcd = wgid % NXCD, off = wgid / NXCD; wgid = (xcd < r ? xcd * (q + 1) : r * (q + 1) + (xcd - r) * q) + off; }
        const int nig = WGM * nN, gid = wgid / nig, fm = gid * WGM, gsz = (nM - fm) < WGM ? (nM - fm) : WGM;
        u.pm = fm + ((wgid % nig) % gsz); u.pn = (wgid % nig) / gsz; return true;
    }
    __device__ __forceinline__ void a_ready(const Unit&) const {}
    __device__ __forceinline__ void done(const Unit&) const {}
};

__device__ __forceinline__ unsigned cvt_pk_bf16(float lo, float hi) { unsigned r; asm volatile("v_cvt_pk_bf16_f32 %0, %1, %2" : "=v"(r) : "v"(lo), "v"(hi)); return r; }
template <class Epi, class Sched, bool ALIGN_EPI = false, bool SP2 = false>
__device__ __forceinline__ void gemm_phase(PG8_LAS unsigned char* lds, const Gemm g, const Sched& S, const Epi& E) {
    const int tid = threadIdx.x, wid = __builtin_amdgcn_readfirstlane(tid >> 6), lane = tid & 63, wr = wid >> 2, wc = wid & 3, fr = lane & 15, fq = lane >> 4;
    const int K = g.K, nt = K / BK;
    unsigned voffA[2], voffB[2];
#pragma unroll
    for (int i = 0; i < 2; ++i) { int R, C; stage_rc(tid * 16 + i * 8192, R, C); const int Rb = Epi::PERM ? ((R & ~31) + perm32(R & 31)) : R;
        voffA[i] = (unsigned)(R * K + C) * 2u; voffB[i] = (unsigned)(Rb * K + C) * 2u; }
    const size_t kstep = (size_t)(BK * 2);
    const size_t hstep = (size_t)HALF * K * 2;
    const size_t tstep = 2 * hstep;
    const unsigned ldsw = (unsigned)wid * 1024u;
    const int aoff = lds_byte(wr * 64 + fr, fq * 8), boff = lds_byte(wc * 32 + fr, fq * 8);
#define PG8_SA(b, h) (((b) * 2 + (h)) * HTB)
#define PG8_SB(b, h) ((4 + (b) * 2 + (h)) * HTB)
#define PG8_STAGE(bufoff, gbase, voff) do { _Pragma("unroll") for (int _i = 0; _i < 2; ++_i) \
        __builtin_amdgcn_global_load_lds((const unsigned*)((const char*)(gbase) + (voff)[_i]), (PG8_LAS unsigned*)(lds + (bufoff) + ldsw + _i * 8192), 16, 0, 0); } while (0)
#define PG8_LDA(dst, b, h) do { _Pragma("unroll") for (int m = 0; m < 4; ++m) _Pragma("unroll") for (int k = 0; k < 2; ++k) dst[m][k] = *(const PG8_LAS bf16x8*)(lds + PG8_SA(b, h) + aoff + m * 2048 + k * 1024); } while (0)
#define PG8_LDB(dst, b, h) do { _Pragma("unroll") for (int n = 0; n < 2; ++n) _Pragma("unroll") for (int k = 0; k < 2; ++k) dst[n][k] = *(const PG8_LAS bf16x8*)(lds + PG8_SB(b, h) + boff + n * 2048 + k * 1024); } while (0)
#define PG8_MMA(ai, bj, At, Bt) do { __builtin_amdgcn_s_setprio(1); _Pragma("unroll") for (int m = 0; m < 4; ++m) _Pragma("unroll") for (int n = 0; n < 2; ++n) _Pragma("unroll") for (int k = 0; k < 2; ++k) \
        acc[ai][bj][m][n] = __builtin_amdgcn_mfma_f32_16x16x32_bf16(Bt[n][k], At[m][k], acc[ai][bj][m][n], 0, 0, 0); __builtin_amdgcn_s_setprio(0); } while (0)
#define PG8_WAIT_V(n) asm volatile("s_waitcnt vmcnt(" #n ")" ::: "memory")
#define PG8_WAIT_L(n) asm volatile("s_waitcnt lgkmcnt(" #n ")" ::: "memory")
#define PG8_BAR __builtin_amdgcn_s_barrier()
#define PG8_SCHED __builtin_amdgcn_sched_barrier(0)
    Unit cur, nxt; int ui = 0;
    if (!S.next(0, cur)) return;
    f32x4 acc[2][2][4][2];
#pragma unroll
    for (int a = 0; a < 2; ++a)
#pragma unroll
        for (int b = 0; b < 2; ++b)
#pragma unroll
            for (int m = 0; m < 4; ++m)
#pragma unroll
                for (int n = 0; n < 2; ++n) acc[a][b][m][n] = (f32x4){0.f, 0.f, 0.f, 0.f};
    bf16x8 At[4][2], B0[2][2], B1[2][2];
    const char* cA = (const char*)g.A + (size_t)cur.pm * tstep; const char* cB = (const char*)g.Bt + (size_t)cur.pn * tstep;
    S.a_ready(cur);
    if constexpr (SP2) {
        PG8_STAGE(PG8_SB(0, 0), cB, voffB); PG8_STAGE(PG8_SB(0, 1), cB + hstep, voffB); PG8_STAGE(PG8_SA(0, 0), cA, voffA); PG8_STAGE(PG8_SA(0, 1), cA + hstep, voffA);
        if (wr == 1) PG8_BAR;
        PG8_WAIT_V(2); PG8_BAR;
        PG8_STAGE(PG8_SB(1, 0), cB + kstep, voffB); PG8_STAGE(PG8_SA(1, 0), cA + kstep, voffA); PG8_STAGE(PG8_SB(1, 1), cB + hstep + kstep, voffB);
        PG8_WAIT_V(6); PG8_BAR;
    } else {
        PG8_STAGE(PG8_SB(0, 0), cB, voffB); PG8_STAGE(PG8_SA(0, 0), cA, voffA); PG8_STAGE(PG8_SB(0, 1), cB + hstep, voffB); PG8_STAGE(PG8_SA(0, 1), cA + hstep, voffA);
        if (wr == 1) PG8_BAR;
        PG8_WAIT_V(4); PG8_BAR;
        PG8_STAGE(PG8_SB(1, 0), cB + kstep, voffB); PG8_STAGE(PG8_SA(1, 0), cA + kstep, voffA); PG8_STAGE(PG8_SB(1, 1), cB + hstep + kstep, voffB);
        PG8_WAIT_V(6); PG8_BAR;
    }
    for (;;) {
        const bool has_next = S.next(ui + 1, nxt);
        const char* nA = has_next ? (const char*)g.A + (size_t)nxt.pm * tstep : cA; const char* nB = has_next ? (const char*)g.Bt + (size_t)nxt.pn * tstep : cB;
        for (int t = 0; t < nt; t += 2) {
            const bool last = (t == nt - 2);
            const char* a1 = cA + (size_t)(t + 1) * kstep;
            const char* a2 = last ? nA : cA + (size_t)(t + 2) * kstep; const char* b2 = last ? nB : cB + (size_t)(t + 2) * kstep;
            const char* a3 = a2 + kstep; const char* b3 = b2 + kstep;
            if (last && has_next) S.a_ready(nxt);
            if constexpr (SP2) {
            PG8_LDB(B0, 0, 0); PG8_LDB(B1, 0, 1); PG8_SCHED; PG8_LDA(At, 0, 0); PG8_STAGE(PG8_SA(1, 1), a1 + hstep, voffA);
            PG8_WAIT_V(8); PG8_WAIT_L(0); PG8_BAR; PG8_MMA(0, 0, At, B0); PG8_MMA(0, 1, At, B1); PG8_BAR; PG8_SCHED;
            PG8_LDA(At, 0, 1); PG8_STAGE(PG8_SB(0, 0), b2, voffB); PG8_STAGE(PG8_SB(0, 1), b2 + hstep, voffB); PG8_STAGE(PG8_SA(0, 0), a2, voffA);
            PG8_WAIT_V(8); PG8_WAIT_L(0); PG8_BAR; PG8_MMA(1, 0, At, B0); PG8_MMA(1, 1, At, B1); PG8_BAR; PG8_SCHED;
            PG8_LDB(B0, 1, 0); PG8_LDB(B1, 1, 1); PG8_SCHED; PG8_LDA(At, 1, 0); PG8_STAGE(PG8_SA(0, 1), a2 + hstep, voffA);
            PG8_WAIT_V(8); PG8_WAIT_L(0); PG8_BAR; PG8_MMA(0, 0, At, B0); PG8_MMA(0, 1, At, B1); PG8_BAR; PG8_SCHED;
            PG8_LDA(At, 1, 1); PG8_STAGE(PG8_SB(1, 0), b3, voffB); PG8_STAGE(PG8_SB(1, 1), b3 + hstep, voffB); PG8_STAGE(PG8_SA(1, 0), a3, voffA);
            PG8_WAIT_V(8); PG8_WAIT_L(0); PG8_BAR; PG8_MMA(1, 0, At, B0); PG8_MMA(1, 1, At, B1); PG8_BAR; PG8_SCHED;
            } else {
            PG8_LDB(B0, 0, 0); PG8_SCHED; PG8_LDA(At, 0, 0); PG8_STAGE(PG8_SA(1, 1), a1 + hstep, voffA);
            PG8_WAIT_L(8); PG8_BAR; PG8_WAIT_L(0); PG8_MMA(0, 0, At, B0); PG8_BAR; PG8_SCHED;
            PG8_LDB(B1, 0, 1); PG8_STAGE(PG8_SB(0, 0), b2, voffB);
            PG8_BAR; PG8_WAIT_L(0); PG8_MMA(0, 1, At, B1); PG8_BAR;
            PG8_LDA(At, 0, 1); PG8_STAGE(PG8_SA(0, 0), a2, voffA);
            PG8_BAR; PG8_WAIT_L(0); PG8_MMA(1, 0, At, B0); PG8_BAR; PG8_SCHED;
            PG8_STAGE(PG8_SB(0, 1), b2 + hstep, voffB);
            PG8_WAIT_V(6); PG8_BAR; PG8_MMA(1, 1, At, B1); PG8_BAR;
            PG8_LDB(B0, 1, 0); PG8_SCHED; PG8_LDA(At, 1, 0); PG8_STAGE(PG8_SA(0, 1), a2 + hstep, voffA);
            PG8_WAIT_L(8); PG8_BAR; PG8_WAIT_L(0); PG8_MMA(0, 0, At, B0); PG8_BAR; PG8_SCHED;
            PG8_LDB(B1, 1, 1); PG8_STAGE(PG8_SB(1, 0), b3, voffB);
            PG8_BAR; PG8_WAIT_L(0); PG8_MMA(0, 1, At, B1); PG8_BAR;
            PG8_LDA(At, 1, 1); PG8_STAGE(PG8_SA(1, 0), a3, voffA);
            PG8_BAR; PG8_WAIT_L(0); PG8_MMA(1, 0, At, B0); PG8_BAR; PG8_SCHED;
            PG8_STAGE(PG8_SB(1, 1), b3 + hstep, voffB);
            PG8_WAIT_V(6); PG8_BAR; PG8_MMA(1, 1, At, B1); PG8_BAR;
            }
        }
        if constexpr (ALIGN_EPI) { if (wr == 0) PG8_BAR; }
        if constexpr (!Epi::AFTER_DRAIN) { E(acc, cur, wr, wc, fr, fq); S.done(cur); }
        if (!has_next) break;
#pragma unroll
        for (int a = 0; a < 2; ++a)
#pragma unroll
            for (int b = 0; b < 2; ++b)
#pragma unroll
                for (int m = 0; m < 4; ++m)
#pragma unroll
                    for (int n = 0; n < 2; ++n) acc[a][b][m][n] = (f32x4){0.f, 0.f, 0.f, 0.f};
        cur = nxt; cA = nA; cB = nB; ++ui;
        if constexpr (ALIGN_EPI) { if (wr == 1) PG8_BAR; }
    }
    PG8_WAIT_V(0);
    if constexpr (!ALIGN_EPI) { if (wr == 0) PG8_BAR; }
    PG8_BAR;
    if constexpr (Epi::AFTER_DRAIN) { E.fused(acc, cur, wr, wc, fr, fq, lds, wid, lane); S.done(cur); }
#undef PG8_SA
#undef PG8_SB
#undef PG8_STAGE
#undef PG8_LDA
#undef PG8_LDB
#undef PG8_MMA
#undef PG8_WAIT_V
#undef PG8_WAIT_L
#undef PG8_BAR
#undef PG8_SCHED
}
}

struct Args { const void* in[25]; float* out; unsigned char* ws; int ph_lo, ph_hi; };
#define IN_F(k) ((const float*)a.in[k])
#define WSB(off) ((bf16*)(a.ws + (off)))
#define WSF(off) ((float*)(a.ws + (off)))

struct Ctx { int tid, lane, wave, gw, ngw, gwT; };

__device__ __forceinline__ int row_pos(int r) { return r < RMAIN ? (r & 4095) + NMETA : (r < RSAMP0 ? ((r - RMAIN) & 15) : PAST + ((r - RSAMP0) & 3)); }
__device__ __forceinline__ float rope_inv(int j) { return exp2f(-(float)j * (13.287712379549449f / 16.0f)); }
__device__ __forceinline__ void rope_cs(int pos, int j, float& c, float& s) {
    const float ang = (float)pos * rope_inv(j);
    const double x = (double)ang; const double n = rint(x * 0.15915494309189535); const float r = (float)(x - n * 6.283185307179586);
    c = cosf(r); s = sinf(r);
}

struct RmId { int off; __device__ __forceinline__ int operator()(int n) const { return off + n; } };
struct RmUq { __device__ __forceinline__ int operator()(int n) const { const int h = n / 96, j = n % 96; if (j < 64) return h * 64 + j; const int jj = j - 64; return 1024 + h * 32 + (jj < 16 ? 2 * jj : 2 * (jj - 16) + 1); } };
template <class RM>
__device__ __forceinline__ void tr_item(const float* W, int ldw, int nblk, int item, bf16* WT, int ldt, RM rm, LAS float* scr, int lane) {
    const int kb = item / nblk, nb = item % nblk, k0 = 64 * kb, n0 = 32 * nb;
#pragma unroll 8
    for (int i = 0; i < 32; ++i) { const int kk = 2 * i + (lane >> 5); scr[kk * 33 + (lane & 31)] = W[(size_t)(k0 + kk) * ldw + n0 + (lane & 31)]; }
    LDS_WAIT();
    const int c = lane & 7;
#pragma unroll
    for (int j = 0; j < 4; ++j) { const int n = (lane >> 3) + 8 * j; const LAS float* s = scr + (8 * c) * 33 + n;
        u32x4 o; o.x = pk2(s[0 * 33], s[1 * 33]); o.y = pk2(s[2 * 33], s[3 * 33]); o.z = pk2(s[4 * 33], s[5 * 33]); o.w = pk2(s[6 * 33], s[7 * 33]);
        *(u32x4*)(WT + (size_t)rm(n0 + n) * ldt + k0 + 8 * c) = o; }
    LDS_WAIT();
}
__device__ __forceinline__ void norm_row_bf16(const float* xrow, const float* g, float* xcopy, bf16* hrow, int lane) {
    f32x4 v[4]; float s = 0.f;
#pragma unroll
    for (int j = 0; j < 4; ++j) { v[j] = *(const f32x4*)(xrow + 4 * lane + 256 * j); s += (v[j].x * v[j].x + v[j].y * v[j].y) + (v[j].z * v[j].z + v[j].w * v[j].w); }
    const float rs = 1.0f / sqrtf(wave_sum(s) * (1.f / D) + EPS);
#pragma unroll
    for (int j = 0; j < 4; ++j) { const f32x4 gg = *(const f32x4*)(g + 4 * lane + 256 * j);
        if (xcopy) *(f32x4*)(xcopy + 4 * lane + 256 * j) = v[j];
        u32x2 o; o.x = pk2(v[j].x * rs * gg.x, v[j].y * rs * gg.y); o.y = pk2(v[j].z * rs * gg.z, v[j].w * rs * gg.w);
        *(u32x2*)(hrow + 4 * lane + 256 * j) = o; }
}
__device__ __forceinline__ void p_prep(const Args& a, const Ctx& c, LAS unsigned char* lds) {
    LAS float* scr = (LAS float*)(lds + c.wave * 16384);
    constexpr int I0 = 16 * 17, I1 = 4 * 48, I2 = 4 * 32, I3 = 4 * 32, I4 = 16 * 32, I5 = 16 * 96, I6 = 16 * 32, I7 = 16 * 128, I8 = 16 * 128, I9 = 64 * 32, I10 = 64 * 32;
    constexpr int NIT = I0 + I1 + I2 + I3 + I4 + I5 + I6 + I7 + I8 + I9 + I10;
    for (int it = c.gw; it < NIT; it += c.ngw) {
        int r = it;
        if (r < I0) { tr_item(IN_F(11), 544, 17, r, WSB(WS_WIN0), 1024, RmId{0}, scr, c.lane); continue; } r -= I0;
        if (r < I1) { tr_item(IN_F(13), 1536, 48, r, WSB(WS_WUQ), 256, RmUq{}, scr, c.lane); continue; } r -= I1;
        if (r < I2) { tr_item(IN_F(15), 1024, 32, r, WSB(WS_WUKV), 256, RmId{0}, scr, c.lane); continue; } r -= I2;
        if (r < I3) { tr_item(IN_F(16), 1024, 32, r, WSB(WS_WUKV), 256, RmId{1024}, scr, c.lane); continue; } r -= I3;
        if (r < I4) { tr_item(IN_F(17), 1024, 32, r, WSB(WS_WO0), 1024, RmId{0}, scr, c.lane); continue; } r -= I4;
        if (r < I5) { tr_item(IN_F(18), 3088, 96, r, WSB(WS_WGIN), 1024, RmId{0}, scr, c.lane); continue; } r -= I5;
        if (r < I6) { tr_item(IN_F(22), 1024, 32, r, WSB(WS_WGO), 1024, RmId{0}, scr, c.lane); continue; } r -= I6;
        if (r < I7) { tr_item(IN_F(23), 4096, 128, r, WSB(WS_WUP), 1024, RmId{0}, scr, c.lane); continue; } r -= I7;
        if (r < I8) { tr_item(IN_F(23) + (size_t)1024 * 4096, 4096, 128, r, WSB(WS_WUP) + (size_t)4096 * 1024, 1024, RmId{0}, scr, c.lane); continue; } r -= I8;
        if (r < I9) { tr_item(IN_F(24), 1024, 32, r, WSB(WS_WDN), 4096, RmId{0}, scr, c.lane); continue; } r -= I9;
        tr_item(IN_F(24) + (size_t)4096 * 1024, 1024, 32, r, WSB(WS_WDN) + (size_t)1024 * 4096, 4096, RmId{0}, scr, c.lane);
    }
    const int gt = c.gw * 64 + c.lane, ngt = c.ngw * 64;
    for (int i = gt; i < (NIN0 - 544) * 1024 / 2; i += ngt) ((unsigned*)(WSB(WS_WIN0) + (size_t)544 * 1024))[i] = 0u;
    for (int i = gt; i < (NGIN - NGIN_REAL) * 1024 / 2; i += ngt) ((unsigned*)(WSB(WS_WGIN) + (size_t)NGIN_REAL * 1024))[i] = 0u;
    for (int i = gt; i < 16 * 1024; i += ngt) { const int n = i >> 10, k = i & 1023; WSB(WS_WGIN)[(size_t)(3072 + n) * 1024 + k] = (bf16)f2bf(IN_F(18)[(size_t)k * 3088 + 3072 + n]); }
    for (int r = c.gw; r < R; r += c.ngw) {
        const float* xs = r < RMAIN ? IN_F(0) + (size_t)r * D : (r < RSAMP0 ? IN_F(6) + (size_t)((r - RMAIN) & 15) * D : IN_F(1) + (size_t)(r - RSAMP0) * D);
        norm_row_bf16(xs, IN_F(7), WSF(WS_X) + (size_t)r * D, WSB(WS_H) + (size_t)r * D, c.lane);
    }
}

struct EpiF32 { float* C; int ldc; __device__ __forceinline__ void store4(int row, int col, f32x4 v) const { *(f32x4*)(C + (size_t)row * ldc + col) = v; } };
struct EpiBf16 { bf16* C; int ldc; __device__ __forceinline__ void store4(int row, int col, f32x4 v) const { u32x2 o; o.x = pk2(v.x, v.y); o.y = pk2(v.z, v.w); *(u32x2*)(C + (size_t)row * ldc + col) = o; } };
struct EpiRelu2 { bf16* C; int ldc; __device__ __forceinline__ void store4(int row, int col, f32x4 v) const {
    f32x4 r; r.x = fmaxf(v.x, 0.f); r.y = fmaxf(v.y, 0.f); r.z = fmaxf(v.z, 0.f); r.w = fmaxf(v.w, 0.f); r = r * r;
    u32x2 o; o.x = pk2(r.x, r.y); o.y = pk2(r.z, r.w); *(u32x2*)(C + (size_t)row * ldc + col) = o; } };
struct EpiGla { bf16 *QG, *KG, *VG, *RG; float* GD;
    __device__ __forceinline__ void store4(int row, int col, f32x4 v) const {
        if (col < 3072) { bf16* dst; int cc;
            if (col < 512) { dst = QG + (size_t)row * 512; cc = col; v = v * GLA_SCALE; }
            else if (col < 1024) { dst = KG + (size_t)row * 512; cc = col - 512; }
            else if (col < 2048) { dst = VG + (size_t)row * 1024; cc = col - 1024; }
            else { dst = RG + (size_t)row * 1024; cc = col - 2048; }
            u32x2 o; o.x = pk2(v.x, v.y); o.y = pk2(v.z, v.w); *(u32x2*)(dst + cc) = o;
        } else if (col < 3088) { *(f32x4*)(GD + (size_t)row * 16 + (col - 3072)) = v; }
    } };
template <class Epi>
__device__ __forceinline__ void gemm_naive(const bf16* A, const bf16* Bt, int M, int N, int K, const Epi& E, LAS unsigned char* lds, int tid) {
    LAS float* As = (LAS float*)lds;
    LAS float* Bs = As + 32 * 68;
    const int ntm = M / 64, ntn = N / 128, ty = tid >> 5, tx = tid & 31;
    for (int tile = blockIdx.x; tile < ntm * ntn; tile += gridDim.x) {
        const int tm = tile / ntn, tn = tile % ntn;
        f32x4 acc[4];
#pragma unroll
        for (int i = 0; i < 4; ++i) acc[i] = (f32x4){0.f, 0.f, 0.f, 0.f};
        for (int k0 = 0; k0 < K; k0 += 32) {
            { const int row = tid >> 3, kq = (tid & 7) * 4; const u32x2 v = *(const u32x2*)(A + (size_t)(tm * 64 + row) * K + k0 + kq);
              As[(kq + 0) * 68 + row] = bflo(v.x); As[(kq + 1) * 68 + row] = bfhi(v.x); As[(kq + 2) * 68 + row] = bflo(v.y); As[(kq + 3) * 68 + row] = bfhi(v.y); }
            { const int row = tid >> 2, kq = (tid & 3) * 8; const u32x4 v = *(const u32x4*)(Bt + (size_t)(tn * 128 + row) * K + k0 + kq);
              Bs[(kq + 0) * 132 + row] = bflo(v.x); Bs[(kq + 1) * 132 + row] = bfhi(v.x); Bs[(kq + 2) * 132 + row] = bflo(v.y); Bs[(kq + 3) * 132 + row] = bfhi(v.y);
              Bs[(kq + 4) * 132 + row] = bflo(v.z); Bs[(kq + 5) * 132 + row] = bfhi(v.z); Bs[(kq + 6) * 132 + row] = bflo(v.w); Bs[(kq + 7) * 132 + row] = bfhi(v.w); }
            __syncthreads();
#pragma unroll 8
            for (int k = 0; k < 32; ++k) {
                const f32x4 av = *(const LAS f32x4*)(As + k * 68 + 4 * ty); const f32x4 bv = *(const LAS f32x4*)(Bs + k * 132 + 4 * tx);
                acc[0] += av.x * bv; acc[1] += av.y * bv; acc[2] += av.z * bv; acc[3] += av.w * bv;
            }
            __syncthreads();
        }
#pragma unroll
        for (int i = 0; i < 4; ++i) E.store4(tm * 64 + 4 * ty + i, tn * 128 + 4 * tx, acc[i]);
    }
}


template <class E> struct EpiWrap {
    static constexpr bool PERM = false, AFTER_DRAIN = false; E e;
    __device__ __forceinline__ void operator()(const pg8::f32x4 (&acc)[2][2][4][2], const pg8::Unit& u, int wr, int wc, int fr, int fq) const {
#pragma unroll
        for (int ai = 0; ai < 2; ++ai)
#pragma unroll
            for (int m = 0; m < 4; ++m) { const int row = u.pm * 256 + ai * 128 + wr * 64 + m * 16 + fr;
#pragma unroll
                for (int bj = 0; bj < 2; ++bj)
#pragma unroll
                    for (int n = 0; n < 2; ++n) e.store4(row, u.pn * 256 + bj * 128 + wc * 32 + n * 16 + 4 * fq, acc[ai][bj][m][n]); }
    }
};
template <class E>
__device__ __forceinline__ void gemm_mfma(const bf16* A, const bf16* Bt, int M, int N, int K, const E& e, LAS unsigned char* lds) {
    pg8::Gemm g{A, Bt, M, N, K}; pg8::StaticOrder S; S.init(M, N, (int)gridDim.x, (int)blockIdx.x);
    EpiWrap<E> W{e};
    pg8::gemm_phase<EpiWrap<E>, pg8::StaticOrder, true, true>(lds, g, S, W);
}
#ifndef USE_NAIVE_ATTN
#define USE_NAIVE_ATTN 0
#endif
#ifndef USE_NAIVE_DECODE
#define USE_NAIVE_DECODE 0
#endif
#ifndef USE_NAIVE_GLA
#define USE_NAIVE_GLA 0
#endif
#ifndef USE_NAIVE_GEMM
#define USE_NAIVE_GEMM 0
#endif
#if USE_NAIVE_GEMM
#define GEMM(A, Bt, M, N, K, E) gemm_naive(A, Bt, M, N, K, E, lds, c.tid)
#else
#define GEMM(A, Bt, M, N, K, E) gemm_mfma(A, Bt, M, N, K, E, lds)
#endif


namespace att {
typedef short bf16x8 __attribute__((ext_vector_type(8)));
typedef short s16x4 __attribute__((ext_vector_type(4)));
typedef float f32x16 __attribute__((ext_vector_type(16)));
constexpr int KSLOT = 12288, VSLOT = 8192, LDS_K = 0, LDS_V = 2 * KSLOT, LDS_WS = LDS_V + 2 * VSLOT, LDS_OST = LDS_WS + 8 * 256, LDS_TOTAL = LDS_OST + 8 * 4096;
__device__ __forceinline__ int crow(int r, int hi) { return (r & 3) + 8 * (r >> 2) + 4 * hi; }
__device__ __forceinline__ unsigned cvtpk(float lo, float hi) { unsigned r; asm("v_cvt_pk_bf16_f32 %0, %1, %2" : "=v"(r) : "v"(lo), "v"(hi)); return r; }
__device__ __forceinline__ s16x4 vtr(const LAS unsigned char* p) { typedef short v4i16_t __attribute__((ext_vector_type(4))); return __builtin_bit_cast(s16x4, __builtin_amdgcn_ds_read_tr16_b64_v4i16((LAS v4i16_t*)p)); }
__device__ __forceinline__ float pmax32(float m) { auto rr = __builtin_amdgcn_permlane32_swap(__float_as_uint(m), __float_as_uint(m), false, false); return fmaxf(__uint_as_float(rr[0]), __uint_as_float(rr[1])); }
__device__ __forceinline__ float psum32(float m) { auto rr = __builtin_amdgcn_permlane32_swap(__float_as_uint(m), __float_as_uint(m), false, false); return __uint_as_float(rr[0]) + __uint_as_float(rr[1]); }
#define ATT_WAIT_BAR() asm volatile("s_waitcnt vmcnt(0) lgkmcnt(0)\n\ts_barrier" ::: "memory")

__device__ __forceinline__ void attn_unit(int b, int h, int qb, const bf16* QN, const bf16* QPE, const bf16* KNV, const bf16* KPE, bf16* O, LAS unsigned char* lds) {
    const int tid = threadIdx.x, lane = tid & 63, r32 = lane & 31, hi = lane >> 5; const int wid = __builtin_amdgcn_readfirstlane(tid >> 6);
    const int rowbase = b * SEQ, q0 = qb * 256, qrow = rowbase + q0 + wid * 32 + r32, qrel = q0 + wid * 32 + r32;
    bf16x8 qr[6];
#pragma unroll
    for (int d0 = 0; d0 < 4; ++d0) qr[d0] = *(const bf16x8*)(QN + (size_t)qrow * 1024 + h * 64 + d0 * 16 + hi * 8);
#pragma unroll
    for (int d0 = 0; d0 < 2; ++d0) qr[4 + d0] = *(const bf16x8*)(QPE + (size_t)qrow * 512 + h * 32 + d0 * 16 + hi * 8);
    LAS float* wsf = (LAS float*)(lds + LDS_WS) + wid * 64;
    const int NT = 4 * qb + 4;
#define ATT_DMA(t, slot) do { const size_t row0_ = (t) == 0 ? (size_t)(RMAIN + 16 * b) : (size_t)(rowbase + 64 * ((t) - 1)); \
        __builtin_amdgcn_global_load_lds((const unsigned*)(KNV + (row0_ + lane) * 2048 + h * 64 + wid * 8), (LAS unsigned*)(lds + LDS_K + (slot) * KSLOT + wid * 1024), 16, 0, 0); \
        if (wid < 4) __builtin_amdgcn_global_load_lds((const unsigned*)(KPE + (row0_ + lane) * 32 + wid * 8), (LAS unsigned*)(lds + LDS_K + (slot) * KSLOT + (8 + wid) * 1024), 16, 0, 0); \
        __builtin_amdgcn_global_load_lds((const unsigned*)(KNV + (row0_ + 16 * (wid & 3) + (lane >> 2)) * 2048 + 1024 + h * 64 + (wid >> 2) * 32 + (lane & 3) * 8), (LAS unsigned*)(lds + LDS_V + (slot) * VSLOT + wid * 1024), 16, 0, 0); } while (0)
    f32x16 o[2]; o[0] = f32x16{}; o[1] = f32x16{};
    float mref = -INFINITY, l = 0.f;
    ATT_DMA(0, 0);
    for (int t = 0; t <= NT; ++t) {
        ATT_WAIT_BAR();
        const int slot = t & 1;
        if (t < NT) ATT_DMA(t + 1, slot ^ 1);
        const int kt0 = 64 * (t - 1);
        if (t > 0 && kt0 > q0 + wid * 32 + 31) continue;
        f32x16 p0 = f32x16{}, p1 = f32x16{};
        const LAS unsigned char* kb = lds + LDS_K + slot * KSLOT + hi * 1024 + r32 * 16;
#pragma unroll
        for (int d0 = 0; d0 < 6; ++d0) {
            const bf16x8 b0 = *(const LAS bf16x8*)(kb + d0 * 2048), b1 = *(const LAS bf16x8*)(kb + d0 * 2048 + 512);
            p0 = __builtin_amdgcn_mfma_f32_32x32x16_bf16(b0, qr[d0], p0, 0, 0, 0);
            p1 = __builtin_amdgcn_mfma_f32_32x32x16_bf16(b1, qr[d0], p1, 0, 0, 0);
        }
        if (t == 0) {
#pragma unroll
            for (int r = 0; r < 16; ++r) { if (crow(r, hi) >= NMETA) p0[r] = -INFINITY; p1[r] = -INFINITY; }
        } else if (kt0 + 63 > q0 + wid * 32) {
#pragma unroll
            for (int r = 0; r < 16; ++r) { const int kv = kt0 + crow(r, hi); if (kv > qrel) p0[r] = -INFINITY; if (kv + 32 > qrel) p1[r] = -INFINITY; }
        }
        float rm = fmaxf(p0[0], p1[0]);
#pragma unroll
        for (int r = 1; r < 16; ++r) rm = fmaxf(rm, fmaxf(p0[r], p1[r]));
        rm = pmax32(rm);
        if (__any(rm > mref + 8.0f)) {
            const float mnew = fmaxf(mref, rm); const float f = __builtin_amdgcn_exp2f(mref - mnew);
            mref = mnew; l *= f;
            if (hi == 0) wsf[r32] = f;
            LDS_WAIT();
#pragma unroll
            for (int r = 0; r < 16; ++r) { const float fr = wsf[crow(r, hi)]; o[0][r] *= fr; o[1][r] *= fr; }
        }
        float sacc = 0.f;
#pragma unroll
        for (int r = 0; r < 16; ++r) { p0[r] = __builtin_amdgcn_exp2f(p0[r] - mref); p1[r] = __builtin_amdgcn_exp2f(p1[r] - mref); sacc += p0[r] + p1[r]; }
        l += sacc;
        u32x4 pw[4];
#pragma unroll
        for (int i = 0; i < 4; ++i) { pw[0][i] = cvtpk(p0[2 * i], p0[2 * i + 1]); pw[1][i] = cvtpk(p0[8 + 2 * i], p0[8 + 2 * i + 1]); pw[2][i] = cvtpk(p1[2 * i], p1[2 * i + 1]); pw[3][i] = cvtpk(p1[8 + 2 * i], p1[8 + 2 * i + 1]); }
        const LAS unsigned char* vb = lds + LDS_V + slot * VSLOT + ((lane >> 4) & 1) * 32 + (lane & 3) * 8 + (4 * hi + ((lane & 15) >> 2)) * 64;
#pragma unroll
        for (int d0 = 0; d0 < 2; ++d0)
#pragma unroll
            for (int ks = 0; ks < 4; ++ks) {
                const s16x4 vlo = vtr(vb + d0 * 4096 + ks * 1024), vhi = vtr(vb + d0 * 4096 + ks * 1024 + 512);
                const bf16x8 vf = (bf16x8){vlo[0], vlo[1], vlo[2], vlo[3], vhi[0], vhi[1], vhi[2], vhi[3]};
                o[d0] = __builtin_amdgcn_mfma_f32_32x32x16_bf16(__builtin_bit_cast(bf16x8, pw[ks]), vf, o[d0], 0, 0, 0);
            }
    }
    l = psum32(l);
    if (hi == 0) wsf[32 + r32] = l;
    LDS_WAIT();
    bf16* Ow = O + (size_t)(rowbase + q0 + wid * 32) * 1024 + h * 64;
    LAS bf16* stg = (LAS bf16*)(lds + LDS_OST) + wid * 2048;
#pragma unroll
    for (int r = 0; r < 16; ++r) { const int orow = crow(r, hi); const float il = 1.0f / wsf[32 + orow];
        stg[orow * 64 + r32] = (bf16)f2bf(o[0][r] * il); stg[orow * 64 + 32 + r32] = (bf16)f2bf(o[1][r] * il); }
    LDS_WAIT();
#pragma unroll
    for (int i = 0; i < 4; ++i) { const int row = i * 8 + (lane >> 3), ch = lane & 7; const u32x4 v = *(const LAS u32x4*)(stg + row * 64 + ch * 8); *(u32x4*)(Ow + (size_t)row * 1024 + ch * 8) = v; }
    ATT_WAIT_BAR();
#undef ATT_DMA
}
__device__ __forceinline__ void attn_phase(const bf16* QN, const bf16* QPE, const bf16* KNV, const bf16* KPE, bf16* O, LAS unsigned char* lds) {
    const int G = gridDim.x, bx = blockIdx.x; const int vcu = (G % 8 == 0) ? (bx % 8) * (G / 8) + bx / 8 : bx;
    for (int v = vcu; v < NB * NH * 4; v += G) {
        const int bh = v >> 2, s0 = v & 3;
#pragma unroll 1
        for (int i = 0; i < 4; ++i) { const int qb = (i == 0) ? 15 - s0 : (i == 1) ? 11 - s0 : (i == 2) ? 4 + s0 : s0; attn_unit(bh >> 4, bh & 15, qb, QN, QPE, KNV, KPE, O, lds); }
    }
}
}


namespace dec {
using att::bf16x8; using att::s16x4; using att::f32x16; using att::crow; using att::cvtpk; using att::vtr; using att::pmax32; using att::psum32;
constexpr int KST = 592, KBUF = 64 * KST, LDS_K = 0, LDS_Q = 2 * KBUF, LDS_WS = LDS_Q + 64 * KST, LDS_TOTAL = LDS_WS + 8 * 256;
constexpr int NSTAGE = 64;
__device__ __forceinline__ void decode_unit(int db, int sp, const Args& a, LAS unsigned char* lds) {
    const int tid = threadIdx.x, lane = tid & 63, r32 = lane & 31, hi = lane >> 5; const int wid = __builtin_amdgcn_readfirstlane(tid >> 6);
    const int qh = wid & 1, kh = (wid >> 1) & 1, dh = wid >> 2;
    const float* cckv = IN_F(2); const float* ckpe = IN_F(3); const int* pt = (const int*)a.in[5] + db * NPAGES + sp * 32;
    for (int i = tid; i < 64 * 36; i += 512) { const int q = i / 36, ch = i % 36, t = q >> 4, h = q & 15;
        const bf16* src = ch < 32 ? WSB(WS_QLAT) + ((size_t)(db * 4 + t) * 16 + h) * 256 + ch * 8 : WSB(WS_QPE) + (size_t)(RSAMP0 + db * 4 + t) * 512 + h * 32 + (ch - 32) * 8;
        *(LAS u32x4*)(lds + LDS_Q + q * KST + ch * 16) = *(const u32x4*)src; }
    f32x4 cv[8], kv;
#define DEC_LOAD(s) do { const int page_ = __builtin_amdgcn_readfirstlane(pt[(s) >> 1]); const size_t k0_ = (size_t)page_ * PAGE + ((s) & 1) * 64; \
        _Pragma("unroll") for (int j = 0; j < 8; ++j) cv[j] = *(const f32x4*)(cckv + (k0_ + wid + 8 * j) * 256 + 4 * lane); \
        kv = *(const f32x4*)(ckpe + (k0_ + (tid >> 3)) * 32 + 4 * (tid & 7)); } while (0)
#define DEC_WRITE(buf) do { LAS unsigned char* kb_ = lds + LDS_K + (buf) * KBUF; \
        _Pragma("unroll") for (int j = 0; j < 8; ++j) { u32x2 w_; w_.x = cvtpk(cv[j].x, cv[j].y); w_.y = cvtpk(cv[j].z, cv[j].w); *(LAS u32x2*)(kb_ + (wid + 8 * j) * KST + lane * 8) = w_; } \
        { u32x2 w_; w_.x = cvtpk(kv.x, kv.y); w_.y = cvtpk(kv.z, kv.w); *(LAS u32x2*)(kb_ + (tid >> 3) * KST + 512 + (tid & 7) * 8) = w_; } } while (0)
    LAS float* wsf = (LAS float*)(lds + LDS_WS) + wid * 64;
    f32x16 o[4]; o[0] = f32x16{}; o[1] = f32x16{}; o[2] = f32x16{}; o[3] = f32x16{};
    float mref = -INFINITY, l = 0.f;
    DEC_LOAD(0); DEC_WRITE(0); DEC_LOAD(1);
    __syncthreads();
    for (int s = 0; s < NSTAGE; ++s) {
        const int buf = s & 1;
        const LAS unsigned char* kimg = lds + LDS_K + buf * KBUF;
        f32x16 p = f32x16{};
        { const LAS unsigned char* kb = kimg + (kh * 32 + r32) * KST + hi * 16; const LAS unsigned char* qb = lds + LDS_Q + (qh * 32 + r32) * KST + hi * 16;
#pragma unroll
          for (int s2 = 0; s2 < 18; ++s2) p = __builtin_amdgcn_mfma_f32_32x32x16_bf16(*(const LAS bf16x8*)(kb + s2 * 32), *(const LAS bf16x8*)(qb + s2 * 32), p, 0, 0, 0); }
        float rm = p[0];
#pragma unroll
        for (int r = 1; r < 16; ++r) rm = fmaxf(rm, p[r]);
        rm = pmax32(rm);
        if (__any(rm > mref + 8.0f)) {
            const float mnew = fmaxf(mref, rm); const float f = __builtin_amdgcn_exp2f(mref - mnew);
            mref = mnew; l *= f;
            if (hi == 0) wsf[r32] = f;
            LDS_WAIT();
#pragma unroll
            for (int r = 0; r < 16; ++r) { const float fr = wsf[crow(r, hi)]; o[0][r] *= fr; o[1][r] *= fr; o[2][r] *= fr; o[3][r] *= fr; }
        }
        float sacc = 0.f;
#pragma unroll
        for (int r = 0; r < 16; ++r) { p[r] = __builtin_amdgcn_exp2f(p[r] - mref); sacc += p[r]; }
        l += sacc;
        u32x4 pw[2];
#pragma unroll
        for (int i = 0; i < 4; ++i) { pw[0][i] = cvtpk(p[2 * i], p[2 * i + 1]); pw[1][i] = cvtpk(p[8 + 2 * i], p[8 + 2 * i + 1]); }
        const LAS unsigned char* vb = kimg + (kh * 32 + 4 * hi + ((lane & 15) >> 2)) * KST + (dh * 128 + 16 * ((lane >> 4) & 1) + 4 * (lane & 3)) * 2;
#pragma unroll
        for (int dt = 0; dt < 4; ++dt)
#pragma unroll
            for (int ks = 0; ks < 2; ++ks) {
                const s16x4 vlo = vtr(vb + (ks * 16) * KST + dt * 64), vhi = vtr(vb + (ks * 16 + 8) * KST + dt * 64);
                const bf16x8 vf = (bf16x8){vlo[0], vlo[1], vlo[2], vlo[3], vhi[0], vhi[1], vhi[2], vhi[3]};
                o[dt] = __builtin_amdgcn_mfma_f32_32x32x16_bf16(__builtin_bit_cast(bf16x8, pw[ks]), vf, o[dt], 0, 0, 0);
            }
        if (s + 1 < NSTAGE) { DEC_WRITE(buf ^ 1); if (s + 2 < NSTAGE) DEC_LOAD(s + 2); }
        __syncthreads();
    }
    const int part = (db * 2 + sp) * 2 + kh;
    float* op = WSF(WS_OPART) + (size_t)part * 64 * 256;
#pragma unroll
    for (int dt = 0; dt < 4; ++dt)
#pragma unroll
        for (int r = 0; r < 16; ++r) op[(size_t)(qh * 32 + crow(r, hi)) * 256 + dh * 128 + dt * 32 + r32] = o[dt][r];
    l = psum32(l);
    if (dh == 0 && hi == 0) { float* mp = WSF(WS_MLP) + (size_t)part * 128 + (qh * 32 + r32) * 2; mp[0] = mref; mp[1] = l; }
#undef DEC_LOAD
#undef DEC_WRITE
}
__device__ __forceinline__ void decode_phase(const Args& a, LAS unsigned char* lds) {
    for (int u = blockIdx.x; u < DB * 2; u += gridDim.x) { decode_unit(u >> 1, u & 1, a, lds); __syncthreads(); }
}
__device__ __forceinline__ void combine_phase(const Args& a, const Ctx& c) {
    for (int it = c.gw; it < DB * DS * NH; it += c.ngw) {
        const int i = it >> 4, h = it & 15, db = i >> 2, t = i & 3, q = t * 16 + h;
        const u32x2 qv = *(const u32x2*)(WSB(WS_QLAT) + ((size_t)i * 16 + h) * 256 + 4 * c.lane); const f32x4 ql = (f32x4){bflo(qv.x), bfhi(qv.x), bflo(qv.y), bfhi(qv.y)};
        const float qp = c.lane < 32 ? bf2f(WSB(WS_QPE)[(size_t)(RSAMP0 + i) * 512 + h * 32 + c.lane]) : 0.f;
        float mp[4], lp[4], dn[4]; f32x4 cn[4]; float mg = -INFINITY;
#pragma unroll
        for (int p = 0; p < 4; ++p) { const float* ml = WSF(WS_MLP) + (size_t)(db * 4 + p) * 128 + q * 2; mp[p] = ml[0]; lp[p] = ml[1]; mg = fmaxf(mg, mp[p]); }
#pragma unroll
        for (int s2 = 0; s2 < 4; ++s2) {
            const int kr = RSAMP0 + db * 4 + s2;
            const u32x2 v = *(const u32x2*)(WSB(WS_CKVN) + (size_t)kr * 256 + 4 * c.lane); cn[s2] = (f32x4){bflo(v.x), bfhi(v.x), bflo(v.y), bfhi(v.y)};
            const float e = c.lane < 32 ? bf2f(WSB(WS_KPE)[(size_t)kr * 32 + c.lane]) : 0.f;
            float d = (ql.x * cn[s2].x + ql.y * cn[s2].y) + (ql.z * cn[s2].z + ql.w * cn[s2].w) + qp * e;
            d = wave_sum(d); dn[s2] = s2 <= t ? d : -INFINITY; mg = fmaxf(mg, dn[s2]);
        }
        f32x4 acc = (f32x4){0.f, 0.f, 0.f, 0.f}; float L = 0.f;
#pragma unroll
        for (int p = 0; p < 4; ++p) { const float w = exp2f(mp[p] - mg); L += w * lp[p]; acc += w * *(const f32x4*)(WSF(WS_OPART) + ((size_t)(db * 4 + p) * 64 + q) * 256 + 4 * c.lane); }
#pragma unroll
        for (int s2 = 0; s2 < 4; ++s2) { const float w = exp2f(dn[s2] - mg); L += w; acc += w * cn[s2]; }
        const f32x4 res = acc * (1.0f / L);
        const float* wuv = IN_F(16) + h * 64 + c.lane; float ov = 0.f;
#pragma unroll
        for (int cl = 0; cl < 64; ++cl) ov += (rdlane(res.x, cl) * wuv[(size_t)(4 * cl) * 1024] + rdlane(res.y, cl) * wuv[(size_t)(4 * cl + 1) * 1024]) + (rdlane(res.z, cl) * wuv[(size_t)(4 * cl + 2) * 1024] + rdlane(res.w, cl) * wuv[(size_t)(4 * cl + 3) * 1024]);
        WSB(WS_O)[(size_t)(RSAMP0 + i) * 1024 + h * 64 + c.lane] = (bf16)f2bf(ov);
    }
}
}

__device__ __forceinline__ void p_mla_mid(const Args& a, const Ctx& c) {
    const float* A1 = WSF(WS_A1);
    for (int r = c.gw; r < R; r += c.ngw) {
        const float* row = A1 + (size_t)r * NIN0; const int pos = row_pos(r);
        const f32x4 cq = *(const f32x4*)(row + 4 * c.lane), ck = *(const f32x4*)(row + 256 + 4 * c.lane);
        const float rq = 1.0f / sqrtf(wave_sum((cq.x * cq.x + cq.y * cq.y) + (cq.z * cq.z + cq.w * cq.w)) * (1.f / 256) + EPS);
        const float rk = 1.0f / sqrtf(wave_sum((ck.x * ck.x + ck.y * ck.y) + (ck.z * ck.z + ck.w * ck.w)) * (1.f / 256) + EPS);
        const f32x4 gq = *(const f32x4*)(IN_F(12) + 4 * c.lane), gk = *(const f32x4*)(IN_F(14) + 4 * c.lane);
        const f32x4 qn = cq * rq * gq, kn = ck * rk * gk;
        u32x2 o; o.x = pk2(qn.x, qn.y); o.y = pk2(qn.z, qn.w); *(u32x2*)(WSB(WS_CQN) + (size_t)r * 256 + 4 * c.lane) = o;
        o.x = pk2(kn.x, kn.y); o.y = pk2(kn.z, kn.w); *(u32x2*)(WSB(WS_CKVN) + (size_t)r * 256 + 4 * c.lane) = o;
        float* ockv; float* okpe;
        if (r < RSAMP0) { const int b = r < RMAIN ? (r >> 12) : ((r - RMAIN) >> 4); ockv = a.out + O_CKVP + ((size_t)b * TP + pos) * 256; okpe = a.out + O_KPEP + ((size_t)b * TP + pos) * 32; }
        else { ockv = a.out + O_CKVS + (size_t)(r - RSAMP0) * 256; okpe = a.out + O_KPES + (size_t)(r - RSAMP0) * 32; }
        *(f32x4*)(ockv + 4 * c.lane) = kn;
        if (c.lane < 16) { const int j = c.lane; const float x1 = row[512 + j], x2 = row[528 + j]; float cs, sn; rope_cs(pos, j, cs, sn);
            const float o1 = x1 * cs - x2 * sn, o2 = x1 * sn + x2 * cs; okpe[j] = o1; okpe[16 + j] = o2;
            WSB(WS_KPE)[(size_t)r * 32 + j] = (bf16)f2bf(o1); WSB(WS_KPE)[(size_t)r * 32 + 16 + j] = (bf16)f2bf(o2); }
    }
}
__device__ __forceinline__ void p_q_post(const Args& a, const Ctx& c) {
    for (int r = c.gw; r < R; r += c.ngw) {
        const float* row = WSF(WS_QRAW) + (size_t)r * NUQ; const int pos = row_pos(r);
        const float qs = QSCALE;
#pragma unroll
        for (int j = 0; j < 4; ++j) { const f32x4 v = *(const f32x4*)(row + 4 * c.lane + 256 * j) * qs; u32x2 o; o.x = pk2(v.x, v.y); o.y = pk2(v.z, v.w); *(u32x2*)(WSB(WS_QN) + (size_t)r * 1024 + 4 * c.lane + 256 * j) = o; }
#pragma unroll
        for (int j = 0; j < 4; ++j) { const int p = c.lane + 64 * j, h = p >> 4, jj = p & 15; const float x1 = row[1024 + 2 * p], x2 = row[1024 + 2 * p + 1]; float cs, sn; rope_cs(pos, jj, cs, sn);
            WSB(WS_QPE)[(size_t)r * 512 + h * 32 + jj] = (bf16)f2bf((x1 * cs - x2 * sn) * qs); WSB(WS_QPE)[(size_t)r * 512 + h * 32 + 16 + jj] = (bf16)f2bf((x1 * sn + x2 * cs) * qs); }
    }
}
__device__ __forceinline__ void p_qlat(const Args& a, const Ctx& c) {
    const float* wuk = IN_F(15);
    for (int it = c.gw; it < DB * DS * NH; it += c.ngw) {
        const int i = it >> 4, h = it & 15;
        const float q = WSF(WS_QRAW)[(size_t)(RSAMP0 + i) * NUQ + h * 64 + c.lane];
        float acc[4] = {0.f, 0.f, 0.f, 0.f};
#pragma unroll 8
        for (int n = 0; n < 64; ++n) { const float qn = __shfl(q, n);
#pragma unroll
            for (int k = 0; k < 4; ++k) acc[k] += qn * wuk[(size_t)(c.lane + 64 * k) * 1024 + h * 64 + n]; }
#pragma unroll
        for (int k = 0; k < 4; ++k) WSB(WS_QLAT)[((size_t)i * 16 + h) * 256 + c.lane + 64 * k] = (bf16)f2bf(acc[k] * QSCALE);
    }
}
template <bool META_ONLY>
__device__ __forceinline__ void p_attn_prompt_naive(const Args& a, const Ctx& c) {
    const bf16* QN = WSB(WS_QN); const bf16* QPE = WSB(WS_QPE); const bf16* KNV = WSB(WS_KNV); const bf16* KPE = WSB(WS_KPE);
    for (int item = c.gw + (META_ONLY ? (RMAIN / 64) * NH : 0); item < (RPROMPT / 64) * NH; item += c.ngw) {
        const int rb = item >> 4, h = item & 15, r = rb * 64 + c.lane;
        int b, nk;
        if (r < RMAIN) { b = r >> 12; nk = NMETA + (r & 4095) + 1; } else { const int i = r - RMAIN; b = i >> 4; nk = (i & 15) + 1; }
        const int mbase = RMAIN + 16 * b, tbase = 4096 * b;
        float qn[64], qp[32], o[64];
#pragma unroll
        for (int j = 0; j < 8; ++j) { const u32x4 v = *(const u32x4*)(QN + (size_t)r * 1024 + h * 64 + 8 * j);
            qn[8 * j] = bflo(v.x); qn[8 * j + 1] = bfhi(v.x); qn[8 * j + 2] = bflo(v.y); qn[8 * j + 3] = bfhi(v.y); qn[8 * j + 4] = bflo(v.z); qn[8 * j + 5] = bfhi(v.z); qn[8 * j + 6] = bflo(v.w); qn[8 * j + 7] = bfhi(v.w); }
#pragma unroll
        for (int j = 0; j < 4; ++j) { const u32x4 v = *(const u32x4*)(QPE + (size_t)r * 512 + h * 32 + 8 * j);
            qp[8 * j] = bflo(v.x); qp[8 * j + 1] = bfhi(v.x); qp[8 * j + 2] = bflo(v.y); qp[8 * j + 3] = bfhi(v.y); qp[8 * j + 4] = bflo(v.z); qp[8 * j + 5] = bfhi(v.z); qp[8 * j + 6] = bflo(v.w); qp[8 * j + 7] = bfhi(v.w); }
#pragma unroll
        for (int j = 0; j < 64; ++j) o[j] = 0.f;
        float m = -INFINITY, l = 0.f;
        const int nkmax = wave_max_i(nk);
        for (int kk = 0; kk < nkmax; ++kk) {
            if (kk < nk) {
                const int kr = kk < NMETA ? mbase + kk : tbase + kk - NMETA;
                const bf16* kn = KNV + (size_t)kr * 2048 + h * 64; const bf16* kp = KPE + (size_t)kr * 32; const bf16* vv = kn + 1024;
                float s = 0.f;
#pragma unroll
                for (int j = 0; j < 8; ++j) { const u32x4 v = *(const u32x4*)(kn + 8 * j);
                    s += qn[8 * j] * bflo(v.x) + qn[8 * j + 1] * bfhi(v.x) + qn[8 * j + 2] * bflo(v.y) + qn[8 * j + 3] * bfhi(v.y) + qn[8 * j + 4] * bflo(v.z) + qn[8 * j + 5] * bfhi(v.z) + qn[8 * j + 6] * bflo(v.w) + qn[8 * j + 7] * bfhi(v.w); }
#pragma unroll
                for (int j = 0; j < 4; ++j) { const u32x4 v = *(const u32x4*)(kp + 8 * j);
                    s += qp[8 * j] * bflo(v.x) + qp[8 * j + 1] * bfhi(v.x) + qp[8 * j + 2] * bflo(v.y) + qp[8 * j + 3] * bfhi(v.y) + qp[8 * j + 4] * bflo(v.z) + qp[8 * j + 5] * bfhi(v.z) + qp[8 * j + 6] * bflo(v.w) + qp[8 * j + 7] * bfhi(v.w); }
                const float mn = fmaxf(m, s), corr = exp2f(m - mn), p = exp2f(s - mn);
                l = l * corr + p; m = mn;
#pragma unroll
                for (int j = 0; j < 8; ++j) { const u32x4 v = *(const u32x4*)(vv + 8 * j);
                    o[8 * j] = o[8 * j] * corr + p * bflo(v.x); o[8 * j + 1] = o[8 * j + 1] * corr + p * bfhi(v.x); o[8 * j + 2] = o[8 * j + 2] * corr + p * bflo(v.y); o[8 * j + 3] = o[8 * j + 3] * corr + p * bfhi(v.y);
                    o[8 * j + 4] = o[8 * j + 4] * corr + p * bflo(v.z); o[8 * j + 5] = o[8 * j + 5] * corr + p * bfhi(v.z); o[8 * j + 6] = o[8 * j + 6] * corr + p * bflo(v.w); o[8 * j + 7] = o[8 * j + 7] * corr + p * bfhi(v.w); }
            }
        }
        const float il = 1.0f / l;
#pragma unroll
        for (int j = 0; j < 8; ++j) { u32x4 w; w.x = pk2(o[8 * j] * il, o[8 * j + 1] * il); w.y = pk2(o[8 * j + 2] * il, o[8 * j + 3] * il); w.z = pk2(o[8 * j + 4] * il, o[8 * j + 5] * il); w.w = pk2(o[8 * j + 6] * il, o[8 * j + 7] * il);
            *(u32x4*)(WSB(WS_O) + (size_t)r * 1024 + h * 64 + 8 * j) = w; }
    }
}
__device__ __forceinline__ void p_attn_decode_naive(const Args& a, const Ctx& c) {
    const float* cckv = IN_F(2); const float* ckpe = IN_F(3); const int* pt = (const int*)a.in[5];
    for (int item = c.gw; item < DB * NH; item += c.ngw) {
        const int db = item >> 4, h = item & 15;
        f32x4 ql[4]; float qp[4], m[4], l[4]; f32x4 o[4];
#pragma unroll
        for (int t = 0; t < 4; ++t) { const u32x2 v = *(const u32x2*)(WSB(WS_QLAT) + ((size_t)(db * 4 + t) * 16 + h) * 256 + 4 * c.lane);
            ql[t] = (f32x4){bflo(v.x), bfhi(v.x), bflo(v.y), bfhi(v.y)};
            qp[t] = c.lane < 32 ? bf2f(WSB(WS_QPE)[(size_t)(RSAMP0 + db * 4 + t) * 512 + h * 32 + c.lane]) : 0.f;
            m[t] = -INFINITY; l[t] = 0.f; o[t] = (f32x4){0.f, 0.f, 0.f, 0.f}; }
        for (int p = 0; p < NPAGES; ++p) {
            const int page = pt[db * NPAGES + p];
            for (int k = 0; k < PAGE; ++k) {
                const size_t kr = (size_t)page * PAGE + k;
                const f32x4 cv = *(const f32x4*)(cckv + kr * 256 + 4 * c.lane); const float e = c.lane < 32 ? ckpe[kr * 32 + c.lane] : 0.f;
#pragma unroll
                for (int t = 0; t < 4; ++t) {
                    float d = (ql[t].x * cv.x + ql[t].y * cv.y) + (ql[t].z * cv.z + ql[t].w * cv.w) + qp[t] * e;
                    d = wave_sum(d);
                    const float mn = fmaxf(m[t], d), corr = exp2f(m[t] - mn), pp = exp2f(d - mn);
                    l[t] = l[t] * corr + pp; m[t] = mn; o[t] = o[t] * corr + pp * cv;
                }
            }
        }
#pragma unroll
        for (int s2 = 0; s2 < 4; ++s2) {
            const int kr = RSAMP0 + db * 4 + s2;
            const u32x2 v = *(const u32x2*)(WSB(WS_CKVN) + (size_t)kr * 256 + 4 * c.lane); const f32x4 cv = (f32x4){bflo(v.x), bfhi(v.x), bflo(v.y), bfhi(v.y)};
            const float e = c.lane < 32 ? bf2f(WSB(WS_KPE)[(size_t)kr * 32 + c.lane]) : 0.f;
#pragma unroll
            for (int t = 0; t < 4; ++t) if (t >= s2) {
                float d = (ql[t].x * cv.x + ql[t].y * cv.y) + (ql[t].z * cv.z + ql[t].w * cv.w) + qp[t] * e;
                d = wave_sum(d);
                const float mn = fmaxf(m[t], d), corr = exp2f(m[t] - mn), pp = exp2f(d - mn);
                l[t] = l[t] * corr + pp; m[t] = mn; o[t] = o[t] * corr + pp * cv;
            }
        }
#pragma unroll
        for (int t = 0; t < 4; ++t) *(f32x4*)(WSF(WS_OLAT) + ((size_t)(db * 4 + t) * 16 + h) * 256 + 4 * c.lane) = o[t] * (1.0f / l[t]);
    }
}
__device__ __forceinline__ void p_olat_up(const Args& a, const Ctx& c) {
    const float* wuv = IN_F(16);
    for (int it = c.gw; it < DB * DS * NH; it += c.ngw) {
        const int i = it >> 4, h = it & 15; const float* ol = WSF(WS_OLAT) + ((size_t)i * 16 + h) * 256;
        float acc = 0.f;
#pragma unroll 8
        for (int cc = 0; cc < 256; ++cc) acc += ol[cc] * wuv[(size_t)cc * 1024 + h * 64 + c.lane];
        WSB(WS_O)[(size_t)(RSAMP0 + i) * 1024 + h * 64 + c.lane] = (bf16)f2bf(acc);
    }
}
template <bool FINAL>
__device__ __forceinline__ void p_post_res(const Args& a, const Ctx& c, const float* gpost, const float* gnext) {
    for (int r = c.gw; r < R; r += c.ngw) {
        const float* mrow = WSF(WS_M) + (size_t)r * D; float* xrow = WSF(WS_X) + (size_t)r * D;
        f32x4 mv[4], xv[4]; float s = 0.f;
#pragma unroll
        for (int j = 0; j < 4; ++j) { mv[j] = *(const f32x4*)(mrow + 4 * c.lane + 256 * j); xv[j] = *(const f32x4*)(xrow + 4 * c.lane + 256 * j); s += (mv[j].x * mv[j].x + mv[j].y * mv[j].y) + (mv[j].z * mv[j].z + mv[j].w * mv[j].w); }
        const float rm = 1.0f / sqrtf(wave_sum(s) * (1.f / D) + EPS); float s2 = 0.f;
#pragma unroll
        for (int j = 0; j < 4; ++j) { const f32x4 g = *(const f32x4*)(gpost + 4 * c.lane + 256 * j); xv[j] = xv[j] + mv[j] * rm * g; s2 += (xv[j].x * xv[j].x + xv[j].y * xv[j].y) + (xv[j].z * xv[j].z + xv[j].w * xv[j].w); }
        if (FINAL) {
            if (r >= RMAIN && r < RSAMP0) continue;
            float* y = r < RMAIN ? a.out + O_YP + (size_t)r * D : a.out + O_YS + (size_t)(r - RSAMP0) * D;
#pragma unroll
            for (int j = 0; j < 4; ++j) *(f32x4*)(y + 4 * c.lane + 256 * j) = xv[j];
        } else {
            const float rx = 1.0f / sqrtf(wave_sum(s2) * (1.f / D) + EPS);
#pragma unroll
            for (int j = 0; j < 4; ++j) { const f32x4 g = *(const f32x4*)(gnext + 4 * c.lane + 256 * j); *(f32x4*)(xrow + 4 * c.lane + 256 * j) = xv[j];
                u32x2 o; o.x = pk2(xv[j].x * rx * g.x, xv[j].y * rx * g.y); o.y = pk2(xv[j].z * rx * g.z, xv[j].w * rx * g.w); *(u32x2*)(WSB(WS_H) + (size_t)r * D + 4 * c.lane + 256 * j) = o; }
        }
    }
}

__device__ __forceinline__ void p_gate(const Args& a, const Ctx& c) {
    const float* wg = IN_F(19); const float* bg = IN_F(20);
    const size_t gt = (size_t)c.gw * 64 + c.lane, ngt = (size_t)c.ngw * 64;
    for (size_t i = gt + (size_t)(USE_NAIVE_GLA ? 0 : RSAMP0) * 512; i < (size_t)R * 512; i += ngt) {
        const int r = (int)(i >> 9), col = (int)(i & 511); const float* gd = WSF(WS_GD) + (size_t)r * 16;
        float x = bg[col];
#pragma unroll
        for (int j = 0; j < 16; ++j) x += gd[j] * wg[j * 512 + col];
        const float ls = fminf(x, 0.f) - log1pf(__expf(-fabsf(x)));
        const float la = ls * (1.0f / 16.0f);
        WSF(WS_LA)[i] = la; WSF(WS_EA)[i] = __expf(la);
    }
}
__device__ __forceinline__ void gla_step(float (&S)[128], float& o, float a0, float a1, float k0, float k1, float q0, float q1, float v) {
    o = 0.f;
#pragma unroll
    for (int d = 0; d < 64; ++d) { const float ad = rdlane(a0, d), kd = rdlane(k0, d), qd = rdlane(q0, d); S[d] = ad * S[d] + kd * v; o += qd * S[d]; }
#pragma unroll
    for (int d = 0; d < 64; ++d) { const float ad = rdlane(a1, d), kd = rdlane(k1, d), qd = rdlane(q1, d); S[64 + d] = ad * S[64 + d] + kd * v; o += qd * S[64 + d]; }
}
__device__ __forceinline__ void p_gla_naive(const Args& a, const Ctx& c) {
    const float* EA = WSF(WS_EA); const bf16* KG = WSB(WS_KG); const bf16* QG = WSB(WS_QG); const bf16* VG = WSB(WS_VG); float* OGR = WSF(WS_OGRAW);
    for (int item = c.gwT; item < (USE_NAIVE_GLA ? NB * GH * 4 : 0); item += c.ngw) {
        const int b = item >> 4, h = (item >> 2) & 3, dv = (item & 3) * 64 + c.lane;
        float S[128];
#pragma unroll
        for (int d = 0; d < 128; ++d) S[d] = 0.f;
        for (int tt = 0; tt < TP; ++tt) {
            const int row = tt < NMETA ? RMAIN + 16 * b + tt : 4096 * b + tt - NMETA;
            const size_t g = (size_t)row * 512 + h * 128;
            const float a0 = EA[g + c.lane], a1 = EA[g + 64 + c.lane], k0 = bf2f(KG[g + c.lane]), k1 = bf2f(KG[g + 64 + c.lane]), q0 = bf2f(QG[g + c.lane]), q1 = bf2f(QG[g + 64 + c.lane]);
            const float v = bf2f(VG[(size_t)row * 1024 + h * 256 + dv]);
            float o; gla_step(S, o, a0, a1, k0, k1, q0, q1, v);
            OGR[(size_t)row * 1024 + h * 256 + dv] = o;
        }
        float* outp = a.out + O_GLAP + ((size_t)(b * 4 + h) * 128) * 256 + dv;
#pragma unroll
        for (int d = 0; d < 128; ++d) outp[(size_t)d * 256] = S[d];
    }
    const int wg0 = USE_NAIVE_GLA ? 0 : NB * GH; if ((int)blockIdx.x < wg0) return;
    for (int item = c.wave * ((int)gridDim.x - wg0) + ((int)blockIdx.x - wg0); item < DB * GH * 4; item += c.ngw - wg0 * 8) {
        const int db = item >> 4, h = (item >> 2) & 3, dv = (item & 3) * 64 + c.lane;
        const float* sp = IN_F(4) + ((size_t)(db * 4 + h) * 128) * 256 + dv;
        float S[128];
#pragma unroll
        for (int d = 0; d < 128; ++d) S[d] = sp[(size_t)d * 256];
#pragma unroll 1
        for (int s = 0; s < DS; ++s) {
            const int row = RSAMP0 + db * 4 + s; const size_t g = (size_t)row * 512 + h * 128;
            const float a0 = EA[g + c.lane], a1 = EA[g + 64 + c.lane], k0 = bf2f(KG[g + c.lane]), k1 = bf2f(KG[g + 64 + c.lane]), q0 = bf2f(QG[g + c.lane]), q1 = bf2f(QG[g + 64 + c.lane]);
            const float v = bf2f(VG[(size_t)row * 1024 + h * 256 + dv]);
            float o; gla_step(S, o, a0, a1, k0, k1, q0, q1, v);
            OGR[(size_t)row * 1024 + h * 256 + dv] = o;
        }
        float* outp = a.out + O_GLAS + ((size_t)(db * 4 + h) * 128) * 256 + dv;
#pragma unroll
        for (int d = 0; d < 128; ++d) outp[(size_t)d * 256] = S[d];
    }
}
__device__ __forceinline__ void p_gla_post(const Args& a, const Ctx& c) {
    const float* gn = IN_F(21);
    for (int r = c.gw; r < R; r += c.ngw) {
#pragma unroll
        for (int h = 0; h < 4; ++h) {
            const size_t off = (size_t)r * 1024 + h * 256 + 4 * c.lane;
            const f32x4 o = *(const f32x4*)(WSF(WS_OGRAW) + off); const u32x2 rv = *(const u32x2*)(WSB(WS_RG) + off); const f32x4 g = *(const f32x4*)(gn + 4 * c.lane);
            const float rs = 1.0f / sqrtf(wave_sum((o.x * o.x + o.y * o.y) + (o.z * o.z + o.w * o.w)) * (1.f / 256) + EPS);
            const f32x4 rr = (f32x4){bflo(rv.x), bfhi(rv.x), bflo(rv.y), bfhi(rv.y)};
            f32x4 sl; sl.x = rr.x / (1.f + __expf(-rr.x)); sl.y = rr.y / (1.f + __expf(-rr.y)); sl.z = rr.z / (1.f + __expf(-rr.z)); sl.w = rr.w / (1.f + __expf(-rr.w));
            const f32x4 y = o * rs * g * sl;
            u32x2 w; w.x = pk2(y.x, y.y); w.y = pk2(y.z, y.w); *(u32x2*)(WSB(WS_OG) + off) = w;
        }
    }
}


namespace gla {
using att::bf16x8; using att::f32x16; using att::crow; using att::cvtpk;
constexpr int NCH = 65, NITEM = NB * GH * NCH;
constexpr int P_GSUM = 0, P_QL = 2048, P_KL = P_QL + 64 * 272, P_AL = P_KL + 64 * 272, P_END = P_AL + 64 * 144;
__device__ __forceinline__ int chunk_row(int b, int c, int tok) { return c == 0 ? RMAIN + 16 * b + tok : 4096 * b + 64 * (c - 1) + tok; }
__device__ __forceinline__ void prep_item(const Args& a, int item, LAS unsigned char* lds) {
    const int tid = threadIdx.x, lane = tid & 63, r32 = lane & 31, hi = lane >> 5; const int wid = __builtin_amdgcn_readfirstlane(tid >> 6);
    const int bh = item / NCH, c = item % NCH, b = bh >> 2, h = bh & 3;
    const int nvalid = c == 0 ? NMETA : 64;
    bf16* QINF = WSB(WS_QINF) + (size_t)item * 8192; bf16* KDTF = WSB(WS_KDTF) + (size_t)item * 8192; bf16* AMF = WSB(WS_AMF) + (size_t)item * 4096; bf16* VTF = WSB(WS_VTF) + (size_t)item * 16384; float* ELF = WSF(WS_ELF) + (size_t)item * 256;
    LAS float* GSUM = (LAS float*)(lds + P_GSUM); LAS bf16* QL = (LAS bf16*)(lds + P_QL); LAS bf16* KL = (LAS bf16*)(lds + P_KL); LAS bf16* AL = (LAS bf16*)(lds + P_AL);
    const int dk = tid & 127, tg = tid >> 7;
    float bloc[16];
    {
        float w[16]; const float* wg = IN_F(19) + h * 128 + dk;
#pragma unroll
        for (int j = 0; j < 16; ++j) w[j] = wg[j * 512];
        const float bg = IN_F(20)[h * 128 + dk];
        float run = 0.f;
#pragma unroll
        for (int i = 0; i < 16; ++i) {
            const int tok = tg * 16 + i; float g = 0.f;
            if (tok < nvalid) {
                const float* gd = WSF(WS_GD) + (size_t)chunk_row(b, c, tok) * 16; float x = bg;
#pragma unroll
                for (int j = 0; j < 16; ++j) x += gd[j] * w[j];
                g = (fminf(x, 0.f) - log1pf(__expf(-fabsf(x)))) * (1.0f / 16.0f);
            }
            run += g; bloc[i] = run;
        }
        GSUM[tg * 128 + dk] = run;
    }
    __syncthreads();
    float off = 0.f, blast = 0.f;
#pragma unroll
    for (int t = 0; t < 4; ++t) { const float s = GSUM[t * 128 + dk]; if (t < tg) off += s; blast += s; }
    {
        unsigned kdp[8];
#pragma unroll
        for (int i = 0; i < 16; i += 2) {
            float kd2[2];
#pragma unroll
            for (int e = 0; e < 2; ++e) {
                const int tok = tg * 16 + i + e; const float bb = bloc[i + e] + off; float q = 0.f, k = 0.f;
                if (tok < nvalid) { const size_t g = (size_t)chunk_row(b, c, tok) * 512 + h * 128 + dk; q = bf2f(WSB(WS_QG)[g]); k = bf2f(WSB(WS_KG)[g]); }
                QL[tok * 136 + dk] = (bf16)f2bf(q * __expf(bb)); KL[tok * 136 + dk] = (bf16)f2bf(k * __expf(-bb)); kd2[e] = k * __expf(blast - bb);
            }
            kdp[i >> 1] = pk2(kd2[0], kd2[1]);
        }
        bf16* kp = KDTF + ((size_t)(((dk >> 5) * 4 + tg) * 64) + (dk & 31)) * 8;
        *(u32x4*)(kp) = (u32x4){kdp[0], kdp[1], kdp[2], kdp[3]}; *(u32x4*)(kp + 32 * 8) = (u32x4){kdp[4], kdp[5], kdp[6], kdp[7]};
        if (tg == 0) ELF[dk] = __expf(blast);
    }
    {
        const int dv = tid & 255, half = tid >> 8;
#pragma unroll
        for (int u = 0; u < 4; ++u) {
            unsigned pk[4];
#pragma unroll
            for (int e = 0; e < 4; ++e) { float v2[2];
#pragma unroll
                for (int f = 0; f < 2; ++f) { const int tok = half * 32 + u * 8 + e * 2 + f; v2[f] = tok < nvalid ? bf2f(WSB(WS_VG)[(size_t)chunk_row(b, c, tok) * 1024 + h * 256 + dv]) : 0.f; }
                pk[e] = pk2(v2[0], v2[1]); }
            const int s = 2 * half + (u >> 1), uh = u & 1;
            *(u32x4*)(VTF + ((size_t)(((dv >> 5) * 4 + s) * 64) + uh * 32 + (dv & 31)) * 8) = (u32x4){pk[0], pk[1], pk[2], pk[3]};
        }
    }
    __syncthreads();
#pragma unroll
    for (int uu = 0; uu < 2; ++uu) {
        const int U = tid + 512 * uu, lp = U & 63, s8 = (U >> 6) & 7, tt = U >> 9; const int tok = tt * 32 + (lp & 31), hh = lp >> 5;
        const u32x2 lo = *(const LAS u32x2*)(QL + tok * 136 + 16 * s8 + 4 * hh), hi2 = *(const LAS u32x2*)(QL + tok * 136 + 16 * s8 + 8 + 4 * hh);
        *(u32x4*)(QINF + (size_t)U * 8) = (u32x4){lo.x, lo.y, hi2.x, hi2.y};
    }
    if (wid < 3) {
        const int tt = wid == 0 ? 0 : 1, tp = wid == 2 ? 1 : 0;
        f32x16 acc = f32x16{};
#pragma unroll
        for (int s = 0; s < 8; ++s) {
            const bf16x8 af = *(const LAS bf16x8*)(QL + (tt * 32 + r32) * 136 + 16 * s + 8 * hi), bfr = *(const LAS bf16x8*)(KL + (tp * 32 + r32) * 136 + 16 * s + 8 * hi);
            acc = __builtin_amdgcn_mfma_f32_32x32x16_bf16(af, bfr, acc, 0, 0, 0);
        }
#pragma unroll
        for (int r = 0; r < 16; ++r) { const int tok = tt * 32 + crow(r, hi), tk = tp * 32 + r32; AL[tok * 72 + tk] = (bf16)f2bf(tk <= tok ? acc[r] : 0.f); }
    } else if (wid == 3) {
#pragma unroll
        for (int r = 0; r < 16; ++r) AL[crow(r, hi) * 72 + 32 + r32] = 0;
    }
    __syncthreads();
    { const int U = tid, lp = U & 63, s = (U >> 6) & 3, tt = U >> 8; const int tok = tt * 32 + (lp & 31), hh = lp >> 5;
      *(u32x4*)(AMF + (size_t)U * 8) = *(const LAS u32x4*)(AL + tok * 72 + 16 * s + 8 * hh); }
    __syncthreads();
}
__device__ __forceinline__ void prep_phase(const Args& a, LAS unsigned char* lds) {
    for (int item = blockIdx.x; item < NITEM; item += gridDim.x) prep_item(a, item, lds);
}
constexpr int S_QIN = 0, S_KDT = 16384, S_AM = 32768, S_EL = 40960, S_SLOT = 41984;
__device__ __forceinline__ void scan_bh(const Args& a, int bh, LAS unsigned char* lds) {
    const int tid = threadIdx.x, lane = tid & 63, r32 = lane & 31, hi = lane >> 5; const int wid = __builtin_amdgcn_readfirstlane(tid >> 6);
    const int b = bh >> 2, h = bh & 3;
#define GLA_DMA(c_, slot_) do { const size_t it_ = (size_t)bh * NCH + (c_); \
        for (int i_ = wid; i_ < 41; i_ += 8) { const unsigned char* g_; int lo_; \
            if (i_ < 16) { g_ = (const unsigned char*)(WSB(WS_QINF) + it_ * 8192) + i_ * 1024; lo_ = S_QIN + i_ * 1024; } \
            else if (i_ < 32) { g_ = (const unsigned char*)(WSB(WS_KDTF) + it_ * 8192) + (i_ - 16) * 1024; lo_ = S_KDT + (i_ - 16) * 1024; } \
            else if (i_ < 40) { g_ = (const unsigned char*)(WSB(WS_AMF) + it_ * 4096) + (i_ - 32) * 1024; lo_ = S_AM + (i_ - 32) * 1024; } \
            else { g_ = (const unsigned char*)(WSF(WS_ELF) + it_ * 256); lo_ = S_EL; } \
            __builtin_amdgcn_global_load_lds((const unsigned*)(g_ + lane * 16), (LAS unsigned*)(lds + (slot_) * S_SLOT + lo_), 16, 0, 0); } } while (0)
#define GLA_VLOAD(dst, c_) do { const bf16* vp_ = WSB(WS_VTF) + ((size_t)bh * NCH + (c_)) * 16384 + (size_t)(wid * 4 * 64 + lane) * 8; \
        _Pragma("unroll") for (int s_ = 0; s_ < 4; ++s_) dst[s_] = *(const bf16x8*)(vp_ + s_ * 512); } while (0)
    f32x16 S[4]; S[0] = f32x16{}; S[1] = f32x16{}; S[2] = f32x16{}; S[3] = f32x16{};
    bf16x8 vf[4], vn[4];
    GLA_DMA(0, 0); GLA_VLOAD(vf, 0);
    for (int c = 0; c < NCH; ++c) {
        asm volatile("s_waitcnt vmcnt(0) lgkmcnt(0)\n\ts_barrier" ::: "memory");
        const int slot = c & 1; const LAS unsigned char* sb = lds + slot * S_SLOT;
        if (c + 1 < NCH) { GLA_DMA(c + 1, slot ^ 1); GLA_VLOAD(vn, c + 1); }
        u32x4 Sb[4][2];
#pragma unroll
        for (int T = 0; T < 4; ++T)
#pragma unroll
            for (int s = 0; s < 2; ++s)
#pragma unroll
                for (int i = 0; i < 4; ++i) Sb[T][s][i] = cvtpk(S[T][8 * s + 2 * i], S[T][8 * s + 2 * i + 1]);
        f32x16 o[2]; o[0] = f32x16{}; o[1] = f32x16{};
#pragma unroll
        for (int tt = 0; tt < 2; ++tt) {
#pragma unroll
            for (int T = 0; T < 4; ++T)
#pragma unroll
                for (int s = 0; s < 2; ++s)
                    o[tt] = __builtin_amdgcn_mfma_f32_32x32x16_bf16(*(const LAS bf16x8*)(sb + S_QIN + (tt * 8 + 2 * T + s) * 1024 + lane * 16), __builtin_bit_cast(bf16x8, Sb[T][s]), o[tt], 0, 0, 0);
#pragma unroll
            for (int s = 0; s < 4; ++s) if (tt == 1 || s < 2)
                o[tt] = __builtin_amdgcn_mfma_f32_32x32x16_bf16(*(const LAS bf16x8*)(sb + S_AM + (tt * 4 + s) * 1024 + lane * 16), vf[s], o[tt], 0, 0, 0);
        }
#pragma unroll
        for (int T = 0; T < 4; ++T) {
#pragma unroll
            for (int g = 0; g < 4; ++g) { const f32x4 e = *(const LAS f32x4*)(sb + S_EL + (32 * T + 8 * g + 4 * hi) * 4); S[T][4 * g] *= e.x; S[T][4 * g + 1] *= e.y; S[T][4 * g + 2] *= e.z; S[T][4 * g + 3] *= e.w; }
#pragma unroll
            for (int s = 0; s < 4; ++s) S[T] = __builtin_amdgcn_mfma_f32_32x32x16_bf16(*(const LAS bf16x8*)(sb + S_KDT + (T * 4 + s) * 1024 + lane * 16), vf[s], S[T], 0, 0, 0);
        }
        float* og = WSF(WS_OGRAW) + h * 256 + wid * 32 + r32;
#pragma unroll
        for (int tt = 0; tt < 2; ++tt)
#pragma unroll
            for (int r = 0; r < 16; ++r) { const int tok = tt * 32 + crow(r, hi); if (c > 0 || tok < NMETA) og[(size_t)chunk_row(b, c, tok) * 1024] = o[tt][r]; }
#pragma unroll
        for (int s = 0; s < 4; ++s) vf[s] = vn[s];
    }
    float* outp = a.out + O_GLAP + (size_t)bh * 128 * 256 + wid * 32 + r32;
#pragma unroll
    for (int T = 0; T < 4; ++T)
#pragma unroll
        for (int r = 0; r < 16; ++r) outp[(size_t)(32 * T + crow(r, hi)) * 256] = S[T][r];
    asm volatile("s_waitcnt vmcnt(0) lgkmcnt(0)\n\ts_barrier" ::: "memory");
#undef GLA_DMA
#undef GLA_VLOAD
}
}

constexpr int NPHASE = 22;
__global__ void __launch_bounds__(512, 2) fwd(Args a) {
    extern __shared__ __attribute__((aligned(16))) unsigned char lds_raw[];
    LAS unsigned char* lds = (LAS unsigned char*)lds_raw;
    Ctx c; c.tid = threadIdx.x; c.lane = c.tid & 63; c.wave = __builtin_amdgcn_readfirstlane(c.tid >> 6);
    c.gw = blockIdx.x * 8 + c.wave; c.ngw = gridDim.x * 8; c.gwT = c.wave * gridDim.x + blockIdx.x;
    volatile LAS unsigned* MISC = (volatile LAS unsigned*)(lds + MISC_OFF);
    if (c.tid < 32) MISC[c.tid] = 0u;
    __syncthreads();
    XcdBarrier bar; bar.bar = (unsigned*)(a.ws + WS_CTL) + CW_BAR; bar.x = 0; bar.st = nullptr;
    const bool one = (a.ph_hi - a.ph_lo) > 1;
    if (one) bar = xcd_barrier_post((unsigned*)(a.ws + WS_CTL) + CW_BAR, MISC + 8);
    const int lo = a.ph_lo, hi = a.ph_hi;
#define IN(k) (lo <= (k) && (k) < hi)
#define SEAM(k) do { if (IN(k) && IN((k) + 1)) xcd_barrier(bar); } while (0)
    if (IN(0)) { p_prep(a, c, lds); } SEAM(0);
    if (IN(1)) { GEMM(WSB(WS_H), WSB(WS_WIN0), RP, NIN0, D, (EpiF32{WSF(WS_A1), NIN0})); } SEAM(1);
    if (IN(2)) { p_mla_mid(a, c); } SEAM(2);
    if (IN(3)) { GEMM(WSB(WS_CQN), WSB(WS_WUQ), RP, NUQ, QL, (EpiF32{WSF(WS_QRAW), NUQ}));
                 GEMM(WSB(WS_CKVN), WSB(WS_WUKV), RP, NUKV, KVL, (EpiBf16{WSB(WS_KNV), NUKV})); } SEAM(3);
    if (IN(4)) { p_q_post(a, c); p_qlat(a, c); } SEAM(4);
    if (IN(5)) {
#if USE_NAIVE_ATTN
        p_attn_prompt_naive<false>(a, c);
#else
        att::attn_phase(WSB(WS_QN), WSB(WS_QPE), WSB(WS_KNV), WSB(WS_KPE), WSB(WS_O), lds);
        p_attn_prompt_naive<true>(a, c);
#endif
#if USE_NAIVE_DECODE
        p_attn_decode_naive(a, c);
#else
        dec::decode_phase(a, lds);
#endif
    } SEAM(5);
    if (IN(6)) {
#if USE_NAIVE_DECODE
        p_olat_up(a, c);
#else
        dec::combine_phase(a, c);
#endif
    } SEAM(6);
    if (IN(7)) { GEMM(WSB(WS_O), WSB(WS_WO0), RP, D, D, (EpiF32{WSF(WS_M), D})); } SEAM(7);
    if (IN(8)) { p_post_res<false>(a, c, IN_F(8), IN_F(9)); } SEAM(8);
    if (IN(9)) { GEMM(WSB(WS_H), WSB(WS_WUP), RP, FF, D, (EpiRelu2{WSB(WS_U), FF})); } SEAM(9);
    if (IN(10)) { GEMM(WSB(WS_U), WSB(WS_WDN), RP, D, FF, (EpiF32{WSF(WS_M), D})); } SEAM(10);
    if (IN(11)) { p_post_res<false>(a, c, IN_F(10), IN_F(7) + D); } SEAM(11);
    if (IN(12)) { GEMM(WSB(WS_H), WSB(WS_WGIN), RP, NGIN, D, (EpiGla{WSB(WS_QG), WSB(WS_KG), WSB(WS_VG), WSB(WS_RG), WSF(WS_GD)})); } SEAM(12);
    if (IN(13)) { p_gate(a, c);
#if !USE_NAIVE_GLA
        gla::prep_phase(a, lds);
#endif
    } SEAM(13);
    if (IN(14)) {
#if !USE_NAIVE_GLA
        if ((int)blockIdx.x < NB * GH) gla::scan_bh(a, (int)blockIdx.x, lds);
#endif
        p_gla_naive(a, c); } SEAM(14);
    if (IN(15)) { p_gla_post(a, c); } SEAM(15);
    if (IN(16)) { GEMM(WSB(WS_OG), WSB(WS_WGO), RP, D, D, (EpiF32{WSF(WS_M), D})); } SEAM(16);
    if (IN(17)) { p_post_res<false>(a, c, IN_F(8) + D, IN_F(9) + D); } SEAM(17);
    if (IN(18)) { GEMM(WSB(WS_H), WSB(WS_WUP) + (size_t)FF * D, RP, FF, D, (EpiRelu2{WSB(WS_U), FF})); } SEAM(18);
    if (IN(19)) { GEMM(WSB(WS_U), WSB(WS_WDN) + (size_t)D * FF, RP, D, FF, (EpiF32{WSF(WS_M), D})); } SEAM(19);
    if (IN(20)) { p_post_res<true>(a, c, IN_F(10) + D, nullptr); }
#undef IN
#undef SEAM
}

extern "C" void kernel_launch(void* const* d_in, const int* in_sizes, int n_in, void* d_out, int out_size, void* d_ws, size_t ws_size, hipStream_t stream) {
    static int grid = 0;
    if (grid == 0) {
        if (n_in != 25 || out_size != (int)O_END || ws_size < WS_END) { fprintf(stderr, "kernel_launch: unexpected shapes n_in %d out %d ws %zu\n", n_in, out_size, ws_size); grid = -1; return; }
        int dev = 0, cus = 0, per_cu = 0;
        if (hipGetDevice(&dev) != hipSuccess || hipDeviceGetAttribute(&cus, hipDeviceAttributeMultiprocessorCount, dev) != hipSuccess) { grid = -1; return; }
        if (hipFuncSetAttribute((const void*)fwd, hipFuncAttributeMaxDynamicSharedMemorySize, LDS_BYTES) != hipSuccess) { fprintf(stderr, "kernel_launch: hipFuncSetAttribute failed\n"); grid = -1; return; }
        if (hipOccupancyMaxActiveBlocksPerMultiprocessor(&per_cu, (const void*)fwd, 512, LDS_BYTES) != hipSuccess || per_cu < 1) fprintf(stderr, "kernel_launch: occupancy query says %d\n", per_cu);
        (void)hipGetLastError();
        grid = cus;
    }
    if (grid < 0) return;
    if (hipMemsetAsync((char*)d_ws + WS_CTL, 0, CTL_ZERO_BYTES, stream) != hipSuccess) return;
    Args a{};
    for (int i = 0; i < 25; ++i) a.in[i] = d_in[i];
    a.out = (float*)d_out; a.ws = (unsigned char*)d_ws;
#if MK_ONE_LAUNCH
    a.ph_lo = 0; a.ph_hi = NPHASE;
    hipLaunchKernelGGL(fwd, dim3(grid), dim3(512), LDS_BYTES, stream, a);
#else
    for (int ph = 0; ph < NPHASE - 1; ++ph) { a.ph_lo = ph; a.ph_hi = ph + 1; hipLaunchKernelGGL(fwd, dim3(grid), dim3(512), LDS_BYTES, stream, a); }
#endif
}
```

```cpp
#include <hip/hip_runtime.h>
#include <cstdio>
#include <cstdint>
#include <cmath>

#ifndef MK_ONE_LAUNCH
#define MK_ONE_LAUNCH 1
#endif

constexpr int D = 1024, NB = 4, SEQ = 4096, NMETA = 16, TP = SEQ + NMETA;
constexpr int DB = 128, DS = 4, PAST = 8192, PAGE = 128, NPAGES = 64;
constexpr int NH = 16, QL = 256, KVL = 256, NOPE = 64, ROPE = 32, VH = 64;
constexpr int GH = 4, GDK = 128, GDV = 256, GR = 16;
constexpr int FF = 4096;
constexpr int RMAIN = NB * SEQ;
constexpr int RMETA0 = RMAIN;
constexpr int RSAMP0 = RMAIN + NB * NMETA;
constexpr int R = RSAMP0 + DB * DS;
constexpr int RPROMPT = RSAMP0;
constexpr int RP = 17152;
constexpr int NIN0 = 768, NUQ = 1536, NUKV = 2048, NGIN = 3328, NGIN_REAL = 3088;
constexpr float EPS = 1e-6f;
constexpr float MLA_SCALE = 0.10206207261596575f;
constexpr float GLA_SCALE = 0.08838834764831845f;
constexpr float QSCALE = 0.10206207261596575f * 1.4426950408889634f;

constexpr size_t O_YP = 0, O_YS = 16777216, O_CKVP = 17301504, O_KPEP = 21512192, O_CKVS = 22038528, O_KPES = 22169600, O_GLAP = 22185984, O_GLAS = 22710272, O_END = 39487488;

constexpr size_t MiB = 1u << 20;
constexpr size_t WS_CTL = 0, CTL_ZERO_BYTES = 1 * MiB;
constexpr size_t WS_WIN0 = 2 * MiB, WS_WUQ = 4 * MiB, WS_WUKV = 5 * MiB, WS_WO0 = 6 * MiB, WS_WUP = 8 * MiB, WS_WDN = 24 * MiB, WS_WGIN = 40 * MiB, WS_WGO = 47 * MiB;
constexpr size_t WS_X = 64 * MiB, WS_H = 132 * MiB, WS_M = 166 * MiB, WS_U = 234 * MiB, WS_A1 = 368 * MiB, WS_CQN = 419 * MiB, WS_CKVN = 428 * MiB, WS_KPE = 437 * MiB;
constexpr size_t WS_QRAW = 440 * MiB, WS_KNV = 541 * MiB, WS_QN = 608 * MiB, WS_QPE = 642 * MiB, WS_QLAT = 659 * MiB, WS_OLAT = 663 * MiB, WS_O = 671 * MiB;
constexpr size_t WS_QG = 705 * MiB, WS_KG = 722 * MiB, WS_VG = 739 * MiB, WS_RG = 773 * MiB, WS_GD = 807 * MiB, WS_LA = 809 * MiB, WS_EA = 843 * MiB, WS_OGRAW = 877 * MiB, WS_OG = 944 * MiB;
constexpr size_t WS_OPART = 978 * MiB, WS_MLP = 1012 * MiB;
constexpr size_t WS_QINF = 1014 * MiB, WS_KDTF = 1032 * MiB, WS_AMF = 1050 * MiB, WS_VTF = 1060 * MiB, WS_ELF = 1094 * MiB;
constexpr size_t WS_MT = 1096 * MiB;
constexpr size_t WS_END = 1144 * MiB;
constexpr int CW_BAR = 4096;

constexpr int LDS_BYTES = 147456;
constexpr int MISC_OFF = 131072 + 320;

#define GAS __attribute__((address_space(1)))
#define LAS __attribute__((address_space(3)))
typedef unsigned short bf16;
typedef float f32x4 __attribute__((ext_vector_type(4)));
typedef unsigned u32x4 __attribute__((ext_vector_type(4)));
typedef unsigned u32x2 __attribute__((ext_vector_type(2)));
#define LDS_WAIT() asm volatile("s_waitcnt lgkmcnt(0)" ::: "memory")

__device__ __forceinline__ unsigned f2bf(float f) { unsigned u = __builtin_bit_cast(unsigned, f); return (u + 0x7fffu + ((u >> 16) & 1u)) >> 16; }
__device__ __forceinline__ unsigned pk2(float lo, float hi) { return f2bf(lo) | (f2bf(hi) << 16); }
__device__ __forceinline__ float bflo(unsigned u) { return __builtin_bit_cast(float, u << 16); }
__device__ __forceinline__ float bfhi(unsigned u) { return __builtin_bit_cast(float, u & 0xffff0000u); }
__device__ __forceinline__ float bf2f(bf16 v) { return __builtin_bit_cast(float, (unsigned)v << 16); }
__device__ __forceinline__ float wave_sum(float v) {
#pragma unroll
    for (int o = 1; o < 64; o <<= 1) v += __shfl_xor(v, o);
    return v;
}
__device__ __forceinline__ int wave_max_i(int v) {
#pragma unroll
    for (int o = 1; o < 64; o <<= 1) { int t = __shfl_xor(v, o); v = t > v ? t : v; }
    return v;
}
__device__ __forceinline__ int fresh_tid(int wave) { int t = wave * 64 + (int)__builtin_amdgcn_mbcnt_hi(~0u, __builtin_amdgcn_mbcnt_lo(~0u, 0u)); asm volatile("" : "+v"(t)); return t; }
__device__ __forceinline__ float rdlane(float v, int l) { return __builtin_bit_cast(float, __builtin_amdgcn_readlane(__builtin_bit_cast(int, v), l)); }

#define XB_TMO      128
#define XB_XCNT(j)  (256  + 64 * (j))
#define XB_XSUB(j)  (1280 + 64 * (j))
#define XB_XGEN(j)  (2304 + 64 * (j))
#define XB_TOP      3328
#define XB_TOPGEN   3392
#define XCD_BAR_WORDS 3456
#define XB_SPIN_CAP (1u << 18)
__device__ __forceinline__ unsigned xb_ld(unsigned* p)              { return __hip_atomic_load(p, __ATOMIC_RELAXED, __HIP_MEMORY_SCOPE_AGENT); }
__device__ __forceinline__ unsigned xb_add(unsigned* p, unsigned v) { return __hip_atomic_fetch_add(p, v, __ATOMIC_RELAXED, __HIP_MEMORY_SCOPE_AGENT); }
__device__ __forceinline__ unsigned xb_xcc_id() { return (unsigned)__builtin_amdgcn_s_getreg((3 << 11) | 20) & 0xFu; }
#define XB_SPIN(cond, bar) do { unsigned _sp = 0; while (cond) { __builtin_amdgcn_s_sleep(1); \
    if ((++_sp & 255u) == 0u) { if (xb_ld(&(bar)[XB_TMO])) break; if (_sp > XB_SPIN_CAP) { atomicAdd(&(bar)[XB_TMO], 1u); break; } } } } while (0)
struct XcdBarrier { unsigned* bar; unsigned x; volatile LAS unsigned* st; };
__device__ __forceinline__ XcdBarrier xcd_barrier_post(unsigned* bar, volatile LAS unsigned* st) {
    XcdBarrier b; b.bar = bar; b.x = xb_xcc_id(); b.st = st;
    if (threadIdx.x == 0) (void)xb_add(&bar[XB_XCNT(b.x)], 1u);
    return b;
}
__device__ __forceinline__ void xcd_barrier_complete(unsigned* bar, unsigned x, unsigned& nloc, unsigned& nx) {
    const unsigned G = gridDim.x * gridDim.y * gridDim.z;
    unsigned sum, cnt, mine, sp = 0u;
    for (;;) {
        sum = 0u; cnt = 0u; mine = 0u;
#pragma unroll
        for (unsigned j = 0; j < 16; ++j) { const unsigned c = xb_ld(&bar[XB_XCNT(j)]); sum += c; cnt += (c > 0u) ? 1u : 0u; mine = (j == x) ? c : mine; }
        if (sum == G) break;
        __builtin_amdgcn_s_sleep(1);
        if ((++sp & 255u) == 0u) { if (xb_ld(&bar[XB_TMO])) break; if (sp > XB_SPIN_CAP) { atomicAdd(&bar[XB_TMO], 1u); break; } }
    }
    nloc = mine > 0u ? mine : 1u; nx = cnt > 0u ? cnt : 1u;
}
__device__ __forceinline__ void xcd_barrier(const XcdBarrier& b, int wave_id) {
    asm volatile("s_waitcnt vmcnt(0)" ::: "memory");
    __syncthreads();
    if (fresh_tid(wave_id) == 0) {
        unsigned* bar = b.bar;
        __builtin_amdgcn_s_waitcnt(0);
        unsigned nloc = b.st[0], nx = b.st[1];
        if (nloc == 0u) { xcd_barrier_complete(bar, b.x, nloc, nx); b.st[0] = nloc; b.st[1] = nx; }
        const unsigned old = xb_add(&bar[XB_XSUB(b.x)], 1u);
        const unsigned gen = old / nloc;
        if (old + 1u == (gen + 1u) * nloc) {
            __builtin_amdgcn_fence(__ATOMIC_RELEASE, "agent");
            asm volatile("s_waitcnt vmcnt(0)" ::: "memory");
            const unsigned og = xb_add(&bar[XB_TOP], 1u);
            const unsigned tg = og / nx;
            if (og + 1u == (tg + 1u) * nx) xb_add(&bar[XB_TOPGEN], 1u);
            else XB_SPIN(xb_ld(&bar[XB_TOPGEN]) == tg, bar);
            __builtin_amdgcn_fence(__ATOMIC_ACQUIRE, "agent");
            xb_add(&bar[XB_XGEN(b.x)], 1u);
            asm volatile("s_waitcnt vmcnt(0)" ::: "memory");
        } else {
            XB_SPIN(xb_ld(&bar[XB_XGEN(b.x)]) == gen, bar);
            __builtin_amdgcn_fence(__ATOMIC_ACQUIRE, "agent");
            asm volatile("s_waitcnt vmcnt(0)" ::: "memory");
        }
    }
    __syncthreads();
}

namespace pg8 {
#define PG8_LAS __attribute__((address_space(3)))
typedef unsigned short bf16_t;
typedef short bf16x8 __attribute__((ext_vector_type(8)));
typedef float f32x4 __attribute__((ext_vector_type(4)));
typedef unsigned u32x4 __attribute__((ext_vector_type(4)));
constexpr int BM = 256, BK = 64, HALF = 128, HTB = HALF * BK * 2  , STAGE_BYTES = 8 * HTB, NXCD = 8, WGM = 8;

__host__ __device__ __forceinline__ int lds_byte(int r, int c) { const int st = (r >> 4) * 2 + (c >> 5), rr = r & 15, cc = c & 31, ob = rr * 64 + cc * 2; return st * 1024 + (ob ^ (((ob >> 9) & 1) << 5)); }
__host__ __device__ __forceinline__ void stage_rc(int b, int& R, int& C) { const int st = b / 1024, sb = b % 1024, swz = sb ^ (((sb >> 9) & 1) << 5); R = (st >> 1) * 16 + swz / 64; C = (st & 1) * 32 + (swz % 64) / 2; }
__host__ __device__ __forceinline__ int perm32(int rho) { const int n = rho >> 4, i = rho & 15; return 8 * (i >> 2) + 4 * n + (i & 3); }

struct Unit { int pm, pn, k0; };
struct Gemm { const bf16_t* A; const bf16_t* Bt; int M, N, K, ld; };

struct StaticOrder {
    int nM, nN, nwg, G, c;
    __host__ __device__ void init(int M, int N, int G_, int c_) { nM = M / BM; nN = N / BM; nwg = nM * nN; G = G_; c = c_; }
    __host__ __device__ bool next(int i, Unit& u) const {
        const long L = (long)i * G + c; if (L >= nwg) return false;
        int wgid = (int)L; { const int q = nwg / NXCD, r = nwg % NXCD, xcd = wgid % NXCD, off = wgid / NXCD; wgid = (xcd < r ? xcd * (q + 1) : r * (q + 1) + (xcd - r) * q) + off; }
        const int nig = WGM * nN, gid = wgid / nig, fm = gid * WGM, gsz = (nM - fm) < WGM ? (nM - fm) : WGM;
        u.pm = fm + ((wgid % nig) % gsz); u.pn = (wgid % nig) / gsz; u.k0 = 0; return true;
    }
    __device__ __forceinline__ void a_ready(const Unit&) const {}
    __device__ __forceinline__ void done(const Unit&) const {}
};

__device__ __forceinline__ unsigned cvt_pk_bf16(float lo, float hi) { unsigned r; asm volatile("v_cvt_pk_bf16_f32 %0, %1, %2" : "=v"(r) : "v"(lo), "v"(hi)); return r; }
template <class Epi, class Sched, bool ALIGN_EPI = false, bool SP2 = false>
__device__ __forceinline__ void gemm_phase(PG8_LAS unsigned char* lds, const Gemm g, const Sched& S, const Epi& E, int wave_id) {
    const int tid = fresh_tid(wave_id), wid = wave_id, lane = tid & 63, wr = wid >> 2, wc = wid & 3, fr = lane & 15, fq = lane >> 4;
    const int K = g.K, nt = K / BK;
    unsigned voffA[2], voffB[2];
#pragma unroll
    for (int i = 0; i < 2; ++i) { int R, C; stage_rc(tid * 16 + i * 8192, R, C); const int Rb = Epi::PERM ? ((R & ~31) + perm32(R & 31)) : R;
        voffA[i] = (unsigned)(R * g.ld + C) * 2u; voffB[i] = (unsigned)(Rb * g.ld + C) * 2u; }
    const size_t kstep = (size_t)(BK * 2);
    const size_t hstep = (size_t)HALF * g.ld * 2;
    const size_t tstep = 2 * hstep;
    const unsigned ldsw = (unsigned)wid * 1024u;
    const int aoff = lds_byte(wr * 64 + fr, fq * 8), boff = lds_byte(wc * 32 + fr, fq * 8);
#define PG8_SA(b, h) (((b) * 2 + (h)) * HTB)
#define PG8_SB(b, h) ((4 + (b) * 2 + (h)) * HTB)
#define PG8_STAGE(bufoff, gbase, voff) do { _Pragma("unroll") for (int _i = 0; _i < 2; ++_i) \
        __builtin_amdgcn_global_load_lds((const unsigned*)((const char*)(gbase) + (voff)[_i]), (PG8_LAS unsigned*)(lds + (bufoff) + ldsw + _i * 8192), 16, 0, 0); } while (0)
#define PG8_LDA(dst, b, h) do { _Pragma("unroll") for (int m = 0; m < 4; ++m) _Pragma("unroll") for (int k = 0; k < 2; ++k) dst[m][k] = *(const PG8_LAS bf16x8*)(lds + PG8_SA(b, h) + aoff + m * 2048 + k * 1024); } while (0)
#define PG8_LDB(dst, b, h) do { _Pragma("unroll") for (int n = 0; n < 2; ++n) _Pragma("unroll") for (int k = 0; k < 2; ++k) dst[n][k] = *(const PG8_LAS bf16x8*)(lds + PG8_SB(b, h) + boff + n * 2048 + k * 1024); } while (0)
#define PG8_MMA(ai, bj, At, Bt) do { __builtin_amdgcn_s_setprio(1); _Pragma("unroll") for (int m = 0; m < 4; ++m) _Pragma("unroll") for (int n = 0; n < 2; ++n) _Pragma("unroll") for (int k = 0; k < 2; ++k) \
        acc[ai][bj][m][n] = __builtin_amdgcn_mfma_f32_16x16x32_bf16(Bt[n][k], At[m][k], acc[ai][bj][m][n], 0, 0, 0); __builtin_amdgcn_s_setprio(0); } while (0)
#define PG8_WAIT_V(n) asm volatile("s_waitcnt vmcnt(" #n ")" ::: "memory")
#define PG8_WAIT_L(n) asm volatile("s_waitcnt lgkmcnt(" #n ")" ::: "memory")
#define PG8_BAR __builtin_amdgcn_s_barrier()
#define PG8_SCHED __builtin_amdgcn_sched_barrier(0)
    Unit cur, nxt; int ui = 0;
    if (!S.next(0, cur)) return;
    f32x4 acc[2][2][4][2];
#pragma unroll
    for (int a = 0; a < 2; ++a)
#pragma unroll
        for (int b = 0; b < 2; ++b)
#pragma unroll
            for (int m = 0; m < 4; ++m)
#pragma unroll
                for (int n = 0; n < 2; ++n) acc[a][b][m][n] = (f32x4){0.f, 0.f, 0.f, 0.f};
    bf16x8 At[4][2], B0[2][2], B1[2][2];
    const char* cA = (const char*)g.A + (size_t)cur.pm * tstep + (size_t)cur.k0 * 2; const char* cB = (const char*)g.Bt + (size_t)cur.pn * tstep + (size_t)cur.k0 * 2;
    S.a_ready(cur);
    if constexpr (SP2) {
        PG8_STAGE(PG8_SB(0, 0), cB, voffB); PG8_STAGE(PG8_SB(0, 1), cB + hstep, voffB); PG8_STAGE(PG8_SA(0, 0), cA, voffA); PG8_STAGE(PG8_SA(0, 1), cA + hstep, voffA);
        if (wr == 1) PG8_BAR;
        PG8_WAIT_V(2); PG8_BAR;
        PG8_STAGE(PG8_SB(1, 0), cB + kstep, voffB); PG8_STAGE(PG8_SA(1, 0), cA + kstep, voffA); PG8_STAGE(PG8_SB(1, 1), cB + hstep + kstep, voffB);
        PG8_WAIT_V(6); PG8_BAR;
    } else {
        PG8_STAGE(PG8_SB(0, 0), cB, voffB); PG8_STAGE(PG8_SA(0, 0), cA, voffA); PG8_STAGE(PG8_SB(0, 1), cB + hstep, voffB); PG8_STAGE(PG8_SA(0, 1), cA + hstep, voffA);
        if (wr == 1) PG8_BAR;
        PG8_WAIT_V(4); PG8_BAR;
        PG8_STAGE(PG8_SB(1, 0), cB + kstep, voffB); PG8_STAGE(PG8_SA(1, 0), cA + kstep, voffA); PG8_STAGE(PG8_SB(1, 1), cB + hstep + kstep, voffB);
        PG8_WAIT_V(6); PG8_BAR;
    }
    for (;;) {
        const bool has_next = S.next(ui + 1, nxt);
        const char* nA = has_next ? (const char*)g.A + (size_t)nxt.pm * tstep + (size_t)nxt.k0 * 2 : cA; const char* nB = has_next ? (const char*)g.Bt + (size_t)nxt.pn * tstep + (size_t)nxt.k0 * 2 : cB;
        for (int t = 0; t < nt; t += 2) {
            const bool last = (t == nt - 2);
            const char* a1 = cA + (size_t)(t + 1) * kstep;
            const char* a2 = last ? nA : cA + (size_t)(t + 2) * kstep; const char* b2 = last ? nB : cB + (size_t)(t + 2) * kstep;
            const char* a3 = a2 + kstep; const char* b3 = b2 + kstep;
            if (last && has_next) S.a_ready(nxt);
            if constexpr (SP2) {
            PG8_LDB(B0, 0, 0); PG8_LDB(B1, 0, 1); PG8_SCHED; PG8_LDA(At, 0, 0); PG8_STAGE(PG8_SA(1, 1), a1 + hstep, voffA);
            PG8_WAIT_V(8); PG8_WAIT_L(0); PG8_BAR; PG8_MMA(0, 0, At, B0); PG8_MMA(0, 1, At, B1); PG8_BAR; PG8_SCHED;
            PG8_LDA(At, 0, 1); PG8_STAGE(PG8_SB(0, 0), b2, voffB); PG8_STAGE(PG8_SB(0, 1), b2 + hstep, voffB); PG8_STAGE(PG8_SA(0, 0), a2, voffA);
            PG8_WAIT_V(8); PG8_WAIT_L(0); PG8_BAR; PG8_MMA(1, 0, At, B0); PG8_MMA(1, 1, At, B1); PG8_BAR; PG8_SCHED;
            PG8_LDB(B0, 1, 0); PG8_LDB(B1, 1, 1); PG8_SCHED; PG8_LDA(At, 1, 0); PG8_STAGE(PG8_SA(0, 1), a2 + hstep, voffA);
            PG8_WAIT_V(8); PG8_WAIT_L(0); PG8_BAR; PG8_MMA(0, 0, At, B0); PG8_MMA(0, 1, At, B1); PG8_BAR; PG8_SCHED;
            PG8_LDA(At, 1, 1); PG8_STAGE(PG8_SB(1, 0), b3, voffB); PG8_STAGE(PG8_SB(1, 1), b3 + hstep, voffB); PG8_STAGE(PG8_SA(1, 0), a3, voffA);
            PG8_WAIT_V(8); PG8_WAIT_L(0); PG8_BAR; PG8_MMA(1, 0, At, B0); PG8_MMA(1, 1, At, B1); PG8_BAR; PG8_SCHED;
            } else {
            PG8_LDB(B0, 0, 0); PG8_SCHED; PG8_LDA(At, 0, 0); PG8_STAGE(PG8_SA(1, 1), a1 + hstep, voffA);
            PG8_WAIT_L(8); PG8_BAR; PG8_WAIT_L(0); PG8_MMA(0, 0, At, B0); PG8_BAR; PG8_SCHED;
            PG8_LDB(B1, 0, 1); PG8_STAGE(PG8_SB(0, 0), b2, voffB);
            PG8_BAR; PG8_WAIT_L(0); PG8_MMA(0, 1, At, B1); PG8_BAR;
            PG8_LDA(At, 0, 1); PG8_STAGE(PG8_SA(0, 0), a2, voffA);
            PG8_BAR; PG8_WAIT_L(0); PG8_MMA(1, 0, At, B0); PG8_BAR; PG8_SCHED;
            PG8_STAGE(PG8_SB(0, 1), b2 + hstep, voffB);
            PG8_WAIT_V(6); PG8_BAR; PG8_MMA(1, 1, At, B1); PG8_BAR;
            PG8_LDB(B0, 1, 0); PG8_SCHED; PG8_LDA(At, 1, 0); PG8_STAGE(PG8_SA(0, 1), a2 + hstep, voffA);
            PG8_WAIT_L(8); PG8_BAR; PG8_WAIT_L(0); PG8_MMA(0, 0, At, B0); PG8_BAR; PG8_SCHED;
            PG8_LDB(B1, 1, 1); PG8_STAGE(PG8_SB(1, 0), b3, voffB);
            PG8_BAR; PG8_WAIT_L(0); PG8_MMA(0, 1, At, B1); PG8_BAR;
            PG8_LDA(At, 1, 1); PG8_STAGE(PG8_SA(1, 0), a3, voffA);
            PG8_BAR; PG8_WAIT_L(0); PG8_MMA(1, 0, At, B0); PG8_BAR; PG8_SCHED;
            PG8_STAGE(PG8_SB(1, 1), b3 + hstep, voffB);
            PG8_WAIT_V(6); PG8_BAR; PG8_MMA(1, 1, At, B1); PG8_BAR;
            }
        }
        if constexpr (ALIGN_EPI) { if (wr == 0) PG8_BAR; }
        if constexpr (!Epi::AFTER_DRAIN) { E(acc, cur, wr, wc, fr, fq); S.done(cur); }
        if (!has_next) break;
#pragma unroll
        for (int a = 0; a < 2; ++a)
#pragma unroll
            for (int b = 0; b < 2; ++b)
#pragma unroll
                for (int m = 0; m < 4; ++m)
#pragma unroll
                    for (int n = 0; n < 2; ++n) acc[a][b][m][n] = (f32x4){0.f, 0.f, 0.f, 0.f};
        cur = nxt; cA = nA; cB = nB; ++ui;
        if constexpr (ALIGN_EPI) { if (wr == 1) PG8_BAR; }
    }
    PG8_WAIT_V(0);
    if constexpr (!ALIGN_EPI) { if (wr == 0) PG8_BAR; }
    PG8_BAR;
    if constexpr (Epi::AFTER_DRAIN) { E.fused(acc, cur, wr, wc, fr, fq, lds, wid, lane); S.done(cur); }
#undef PG8_SA
#undef PG8_SB
#undef PG8_STAGE
#undef PG8_LDA
#undef PG8_LDB
#undef PG8_MMA
#undef PG8_WAIT_V
#undef PG8_WAIT_L
#undef PG8_BAR
#undef PG8_SCHED
}
}

struct Args { const void* in[25]; float* out; unsigned char* ws; int ph_lo, ph_hi; };
typedef const __attribute__((address_space(4))) Args* ArgsP;
#define IN_F(k) ((const float*)a->in[k])
#define WSB(off) ((bf16*)(a->ws + (off)))
#define WSF(off) ((float*)(a->ws + (off)))

struct Ctx { int tid, lane, wave, gw, ngw, gwT; };
__device__ __forceinline__ Ctx refresh(const Ctx& c0) { Ctx c = c0; c.tid = fresh_tid(c0.wave); c.lane = c.tid & 63; return c; }

__device__ __forceinline__ int row_pos(int r) { return r < RMAIN ? (r & 4095) + NMETA : (r < RSAMP0 ? ((r - RMAIN) & 15) : PAST + ((r - RSAMP0) & 3)); }
__device__ __forceinline__ float rope_inv(int j) { return exp2f(-(float)j * (13.287712379549449f / 16.0f)); }
__device__ __forceinline__ void rope_cs(int pos, int j, float& c, float& s) {
    const float ang = (float)pos * rope_inv(j);
    const double x = (double)ang; const double n = rint(x * 0.15915494309189535); const float r = (float)(x - n * 6.283185307179586);
    c = cosf(r); s = sinf(r);
}

struct RmId { int off; __device__ __forceinline__ int operator()(int n) const { return off + n; } };
struct RmUq { __device__ __forceinline__ int operator()(int n) const { const int h = n / 96, j = n % 96; if (j < 64) return h * 64 + j; const int jj = j - 64; return 1024 + h * 32 + (jj < 16 ? 2 * jj : 2 * (jj - 16) + 1); } };
template <class RM>
__device__ __forceinline__ void tr_item(const float* W, int ldw, int nblk, int item, bf16* WT, int ldt, RM rm, LAS float* scr, int lane) {
    const int kb = item / nblk, nb = item % nblk, k0 = 64 * kb, n0 = 32 * nb;
#pragma unroll 8
    for (int i = 0; i < 32; ++i) { const int kk = 2 * i + (lane >> 5); scr[kk * 33 + (lane & 31)] = W[(size_t)(k0 + kk) * ldw + n0 + (lane & 31)]; }
    LDS_WAIT();
    const int c = lane & 7;
#pragma unroll
    for (int j = 0; j < 4; ++j) { const int n = (lane >> 3) + 8 * j; const LAS float* s = scr + (8 * c) * 33 + n;
        u32x4 o; o.x = pk2(s[0 * 33], s[1 * 33]); o.y = pk2(s[2 * 33], s[3 * 33]); o.z = pk2(s[4 * 33], s[5 * 33]); o.w = pk2(s[6 * 33], s[7 * 33]);
        *(u32x4*)(WT + (size_t)rm(n0 + n) * ldt + k0 + 8 * c) = o; }
    LDS_WAIT();
}
__device__ __forceinline__ void norm_row_bf16(const float* xrow, const float* g, float* xcopy, bf16* hrow, int lane) {
    f32x4 v[4]; float s = 0.f;
#pragma unroll
    for (int j = 0; j < 4; ++j) { v[j] = *(const f32x4*)(xrow + 4 * lane + 256 * j); s += (v[j].x * v[j].x + v[j].y * v[j].y) + (v[j].z * v[j].z + v[j].w * v[j].w); }
    const float rs = 1.0f / sqrtf(wave_sum(s) * (1.f / D) + EPS);
#pragma unroll
    for (int j = 0; j < 4; ++j) { const f32x4 gg = *(const f32x4*)(g + 4 * lane + 256 * j);
        if (xcopy) *(f32x4*)(xcopy + 4 * lane + 256 * j) = v[j];
        u32x2 o; o.x = pk2(v[j].x * rs * gg.x, v[j].y * rs * gg.y); o.y = pk2(v[j].z * rs * gg.z, v[j].w * rs * gg.w);
        *(u32x2*)(hrow + 4 * lane + 256 * j) = o; }
}
__device__ __forceinline__ void p_prep(ArgsP a, const Ctx& c0, LAS unsigned char* lds) {
    const Ctx c = refresh(c0);
    LAS float* scr = (LAS float*)(lds + c.wave * 16384);
    constexpr int I0 = 16 * 17, I1 = 4 * 48, I2 = 4 * 32, I3 = 4 * 32, I4 = 16 * 32, I5 = 16 * 96, I6 = 16 * 32, I7 = 16 * 128, I8 = 16 * 128, I9 = 64 * 32, I10 = 64 * 32;
    constexpr int NIT = I0 + I1 + I2 + I3 + I4 + I5 + I6 + I7 + I8 + I9 + I10;
    for (int it = c.gw; it < NIT; it += c.ngw) {
        int r = it;
        if (r < I0) { tr_item(IN_F(11), 544, 17, r, WSB(WS_WIN0), 1024, RmId{0}, scr, c.lane); continue; } r -= I0;
        if (r < I1) { tr_item(IN_F(13), 1536, 48, r, WSB(WS_WUQ), 256, RmUq{}, scr, c.lane); continue; } r -= I1;
        if (r < I2) { tr_item(IN_F(15), 1024, 32, r, WSB(WS_WUKV), 256, RmId{0}, scr, c.lane); continue; } r -= I2;
        if (r < I3) { tr_item(IN_F(16), 1024, 32, r, WSB(WS_WUKV), 256, RmId{1024}, scr, c.lane); continue; } r -= I3;
        if (r < I4) { tr_item(IN_F(17), 1024, 32, r, WSB(WS_WO0), 1024, RmId{0}, scr, c.lane); continue; } r -= I4;
        if (r < I5) { tr_item(IN_F(18), 3088, 96, r, WSB(WS_WGIN), 1024, RmId{0}, scr, c.lane); continue; } r -= I5;
        if (r < I6) { tr_item(IN_F(22), 1024, 32, r, WSB(WS_WGO), 1024, RmId{0}, scr, c.lane); continue; } r -= I6;
        if (r < I7) { tr_item(IN_F(23), 4096, 128, r, WSB(WS_WUP), 1024, RmId{0}, scr, c.lane); continue; } r -= I7;
        if (r < I8) { tr_item(IN_F(23) + (size_t)1024 * 4096, 4096, 128, r, WSB(WS_WUP) + (size_t)4096 * 1024, 1024, RmId{0}, scr, c.lane); continue; } r -= I8;
        if (r < I9) { tr_item(IN_F(24), 1024, 32, r, WSB(WS_WDN), 4096, RmId{0}, scr, c.lane); continue; } r -= I9;
        tr_item(IN_F(24) + (size_t)4096 * 1024, 1024, 32, r, WSB(WS_WDN) + (size_t)1024 * 4096, 4096, RmId{0}, scr, c.lane);
    }
    const int gt = c.gw * 64 + c.lane, ngt = c.ngw * 64;
    for (int i = gt; i < (NIN0 - 544) * 1024 / 2; i += ngt) ((unsigned*)(WSB(WS_WIN0) + (size_t)544 * 1024))[i] = 0u;
    for (int i = gt; i < (NGIN - NGIN_REAL) * 1024 / 2; i += ngt) ((unsigned*)(WSB(WS_WGIN) + (size_t)NGIN_REAL * 1024))[i] = 0u;
    for (int i = gt; i < 16 * 1024; i += ngt) { const int n = i >> 10, k = i & 1023; WSB(WS_WGIN)[(size_t)(3072 + n) * 1024 + k] = (bf16)f2bf(IN_F(18)[(size_t)k * 3088 + 3072 + n]); }
    for (int r = c.gw; r < R; r += c.ngw) {
        const float* xs = r < RMAIN ? IN_F(0) + (size_t)r * D : (r < RSAMP0 ? IN_F(6) + (size_t)((r - RMAIN) & 15) * D : IN_F(1) + (size_t)(r - RSAMP0) * D);
        norm_row_bf16(xs, IN_F(7), WSF(WS_X) + (size_t)r * D, WSB(WS_H) + (size_t)r * D, c.lane);
    }
}

struct EpiF32 { float* C; int ldc; __device__ __forceinline__ void store4(int row, int col, f32x4 v) const { *(f32x4*)(C + (size_t)row * ldc + col) = v; } };
struct EpiBf16 { bf16* C; int ldc; __device__ __forceinline__ void store4(int row, int col, f32x4 v) const { u32x2 o; o.x = pk2(v.x, v.y); o.y = pk2(v.z, v.w); *(u32x2*)(C + (size_t)row * ldc + col) = o; } };
struct EpiRelu2 { bf16* C; int ldc; __device__ __forceinline__ void store4(int row, int col, f32x4 v) const {
    f32x4 r; r.x = fmaxf(v.x, 0.f); r.y = fmaxf(v.y, 0.f); r.z = fmaxf(v.z, 0.f); r.w = fmaxf(v.w, 0.f); r = r * r;
    u32x2 o; o.x = pk2(r.x, r.y); o.y = pk2(r.z, r.w); *(u32x2*)(C + (size_t)row * ldc + col) = o; } };
struct EpiGla { bf16 *QG, *KG, *VG, *RG; float* GD;
    __device__ __forceinline__ void store4(int row, int col, f32x4 v) const {
        if (col < 3072) { bf16* dst; int cc;
            if (col < 512) { dst = QG + (size_t)row * 512; cc = col; v = v * GLA_SCALE; }
            else if (col < 1024) { dst = KG + (size_t)row * 512; cc = col - 512; }
            else if (col < 2048) { dst = VG + (size_t)row * 1024; cc = col - 1024; }
            else { dst = RG + (size_t)row * 1024; cc = col - 2048; }
            u32x2 o; o.x = pk2(v.x, v.y); o.y = pk2(v.z, v.w); *(u32x2*)(dst + cc) = o;
        } else if (col < 3088) { *(f32x4*)(GD + (size_t)row * 16 + (col - 3072)) = v; }
    } };
template <class Epi>
__device__ __forceinline__ void gemm_naive(const bf16* A, const bf16* Bt, int M, int N, int K, const Epi& E, LAS unsigned char* lds, int tid) {
    LAS float* As = (LAS float*)lds;
    LAS float* Bs = As + 32 * 68;
    const int ntm = M / 64, ntn = N / 128, ty = tid >> 5, tx = tid & 31;
    for (int tile = blockIdx.x; tile < ntm * ntn; tile += gridDim.x) {
        const int tm = tile / ntn, tn = tile % ntn;
        f32x4 acc[4];
#pragma unroll
        for (int i = 0; i < 4; ++i) acc[i] = (f32x4){0.f, 0.f, 0.f, 0.f};
        for (int k0 = 0; k0 < K; k0 += 32) {
            { const int row = tid >> 3, kq = (tid & 7) * 4; const u32x2 v = *(const u32x2*)(A + (size_t)(tm * 64 + row) * K + k0 + kq);
              As[(kq + 0) * 68 + row] = bflo(v.x); As[(kq + 1) * 68 + row] = bfhi(v.x); As[(kq + 2) * 68 + row] = bflo(v.y); As[(kq + 3) * 68 + row] = bfhi(v.y); }
            { const int row = tid >> 2, kq = (tid & 3) * 8; const u32x4 v = *(const u32x4*)(Bt + (size_t)(tn * 128 + row) * K + k0 + kq);
              Bs[(kq + 0) * 132 + row] = bflo(v.x); Bs[(kq + 1) * 132 + row] = bfhi(v.x); Bs[(kq + 2) * 132 + row] = bflo(v.y); Bs[(kq + 3) * 132 + row] = bfhi(v.y);
              Bs[(kq + 4) * 132 + row] = bflo(v.z); Bs[(kq + 5) * 132 + row] = bfhi(v.z); Bs[(kq + 6) * 132 + row] = bflo(v.w); Bs[(kq + 7) * 132 + row] = bfhi(v.w); }
            __syncthreads();
#pragma unroll 8
            for (int k = 0; k < 32; ++k) {
                const f32x4 av = *(const LAS f32x4*)(As + k * 68 + 4 * ty); const f32x4 bv = *(const LAS f32x4*)(Bs + k * 132 + 4 * tx);
                acc[0] += av.x * bv; acc[1] += av.y * bv; acc[2] += av.z * bv; acc[3] += av.w * bv;
            }
            __syncthreads();
        }
#pragma unroll
        for (int i = 0; i < 4; ++i) E.store4(tm * 64 + 4 * ty + i, tn * 128 + 4 * tx, acc[i]);
    }
}


template <class E> struct EpiWrap {
    static constexpr bool PERM = false, AFTER_DRAIN = false; E e;
    __device__ __forceinline__ void operator()(const pg8::f32x4 (&acc)[2][2][4][2], const pg8::Unit& u, int wr, int wc, int fr, int fq) const {
#pragma unroll
        for (int ai = 0; ai < 2; ++ai)
#pragma unroll
            for (int m = 0; m < 4; ++m) { const int row = u.pm * 256 + ai * 128 + wr * 64 + m * 16 + fr;
#pragma unroll
                for (int bj = 0; bj < 2; ++bj)
#pragma unroll
                    for (int n = 0; n < 2; ++n) e.store4(row, u.pn * 256 + bj * 128 + wc * 32 + n * 16 + 4 * fq, acc[ai][bj][m][n]); }
    }
};
template <int KSUB> struct EpiSlab {
    static constexpr bool PERM = false, AFTER_DRAIN = false; float* MT;
    __device__ __forceinline__ void operator()(const pg8::f32x4 (&acc)[2][2][4][2], const pg8::Unit& u, int wr, int wc, int fr, int fq) const {
        float* base = MT + ((size_t)(u.k0 / KSUB) * (RP - RMAIN) + (size_t)(u.pm * 256 - RMAIN)) * D + u.pn * 256 + wc * 32 + 4 * fq;
#pragma unroll
        for (int ai = 0; ai < 2; ++ai)
#pragma unroll
            for (int m = 0; m < 4; ++m) { float* rp = base + (size_t)(ai * 128 + wr * 64 + m * 16 + fr) * D;
#pragma unroll
                for (int bj = 0; bj < 2; ++bj)
#pragma unroll
                    for (int n = 0; n < 2; ++n) *(f32x4*)(rp + bj * 128 + n * 16) = acc[ai][bj][m][n]; }
    }
};
template <class E>
__device__ __forceinline__ void gemm_mfma(const bf16* A, const bf16* Bt, int M, int N, int K, const E& e, LAS unsigned char* lds, int wave) {
    pg8::Gemm g{A, Bt, M, N, K, K}; pg8::StaticOrder S; S.init(M, N, (int)gridDim.x, (int)blockIdx.x);
    EpiWrap<E> W{e};
    pg8::gemm_phase<EpiWrap<E>, pg8::StaticOrder, true, true>(lds, g, S, W, wave);
}
template <int SPLIT, int NN, int KSUB, int PM0, int NUNITS> struct TailOrder {
    int G, c;
    __device__ __forceinline__ bool next(int i, pg8::Unit& u) const { const int L = i * G + c; if (L >= NUNITS) return false; const int ks = L % SPLIT, t = L / SPLIT; u.pn = t % NN; u.pm = PM0 + t / NN; u.k0 = ks * KSUB; return true; }
    __device__ __forceinline__ void a_ready(const pg8::Unit&) const {}
    __device__ __forceinline__ void done(const pg8::Unit&) const {}
};
struct EpiAtomicF32 { float* C; int ldc; __device__ __forceinline__ void store4(int row, int col, f32x4 v) const { float* p = C + (size_t)row * ldc + col;
    __hip_atomic_fetch_add(p, v.x, __ATOMIC_RELAXED, __HIP_MEMORY_SCOPE_AGENT); __hip_atomic_fetch_add(p + 1, v.y, __ATOMIC_RELAXED, __HIP_MEMORY_SCOPE_AGENT);
    __hip_atomic_fetch_add(p + 2, v.z, __ATOMIC_RELAXED, __HIP_MEMORY_SCOPE_AGENT); __hip_atomic_fetch_add(p + 3, v.w, __ATOMIC_RELAXED, __HIP_MEMORY_SCOPE_AGENT); } };
template <int K, int SPLIT>
__device__ __forceinline__ void gemm_n1024_tail(const bf16* A, const bf16* Bt, float* C, float* MT, LAS unsigned char* lds, int wave) {
    { pg8::Gemm g{A, Bt, RMAIN, D, K, K}; pg8::StaticOrder S; S.init(RMAIN, D, (int)gridDim.x, (int)blockIdx.x); EpiWrap<EpiF32> W{EpiF32{C, D}};
      pg8::gemm_phase<EpiWrap<EpiF32>, pg8::StaticOrder, true, true>(lds, g, S, W, wave); }
    { typedef TailOrder<SPLIT, D / 256, K / SPLIT, RMAIN / 256, (RP - RMAIN) / 256 * (D / 256) * SPLIT> TO;
      pg8::Gemm g{A, Bt, RP, D, K / SPLIT, K}; TO S{(int)gridDim.x, (int)blockIdx.x}; EpiSlab<K / SPLIT> W{MT};
      pg8::gemm_phase<EpiSlab<K / SPLIT>, TO, false, true>(lds, g, S, W, wave); }
}
#ifndef USE_NAIVE_ATTN
#define USE_NAIVE_ATTN 0
#endif
#ifndef USE_NAIVE_DECODE
#define USE_NAIVE_DECODE 0
#endif
#ifndef USE_NAIVE_GLA
#define USE_NAIVE_GLA 0
#endif
#ifndef PROBE
#define PROBE 0
#endif
#ifndef USE_NAIVE_GEMM
#define USE_NAIVE_GEMM 0
#endif
#if USE_NAIVE_GEMM
#define GEMM(A, Bt, M, N, K, E) gemm_naive(A, Bt, M, N, K, E, lds, fresh_tid(c.wave))
#else
#define GEMM(A, Bt, M, N, K, E) gemm_mfma(A, Bt, M, N, K, E, lds, c.wave)
#endif


namespace att {
typedef short bf16x8 __attribute__((ext_vector_type(8)));
typedef short s16x4 __attribute__((ext_vector_type(4)));
typedef float f32x16 __attribute__((ext_vector_type(16)));
constexpr int KSLOT = 12288, VSLOT = 8192, LDS_K = 0, LDS_V = 2 * KSLOT, LDS_WS = LDS_V + 2 * VSLOT, LDS_OST = LDS_WS + 8 * 256, LDS_TOTAL = LDS_OST + 8 * 4096;
__device__ __forceinline__ int crow(int r, int hi) { return (r & 3) + 8 * (r >> 2) + 4 * hi; }
__device__ __forceinline__ unsigned cvtpk(float lo, float hi) { unsigned r; asm("v_cvt_pk_bf16_f32 %0, %1, %2" : "=v"(r) : "v"(lo), "v"(hi)); return r; }
__device__ __forceinline__ s16x4 vtr(const LAS unsigned char* p) { typedef short v4i16_t __attribute__((ext_vector_type(4))); return __builtin_bit_cast(s16x4, __builtin_amdgcn_ds_read_tr16_b64_v4i16((LAS v4i16_t*)p)); }
__device__ __forceinline__ float pmax32(float m) { auto rr = __builtin_amdgcn_permlane32_swap(__float_as_uint(m), __float_as_uint(m), false, false); return fmaxf(__uint_as_float(rr[0]), __uint_as_float(rr[1])); }
__device__ __forceinline__ float psum32(float m) { auto rr = __builtin_amdgcn_permlane32_swap(__float_as_uint(m), __float_as_uint(m), false, false); return __uint_as_float(rr[0]) + __uint_as_float(rr[1]); }
#define ATT_WAIT_BAR() asm volatile("s_waitcnt vmcnt(0) lgkmcnt(0)\n\ts_barrier" ::: "memory")

__device__ __forceinline__ void attn_unit(int b, int h, int qb, const bf16* QN, const bf16* QPE, const bf16* KNV, const bf16* KPE, bf16* O, LAS unsigned char* lds, int wave_id) {
    const int tid = fresh_tid(wave_id), lane = tid & 63, r32 = lane & 31, hi = lane >> 5; const int wid = wave_id;
    const int rowbase = b * SEQ, q0 = qb * 256, qrow = rowbase + q0 + wid * 32 + r32, qrel = q0 + wid * 32 + r32;
    bf16x8 qr[6];
#pragma unroll
    for (int d0 = 0; d0 < 4; ++d0) qr[d0] = *(const bf16x8*)(QN + (size_t)qrow * 1024 + h * 64 + d0 * 16 + hi * 8);
#pragma unroll
    for (int d0 = 0; d0 < 2; ++d0) qr[4 + d0] = *(const bf16x8*)(QPE + (size_t)qrow * 512 + h * 32 + d0 * 16 + hi * 8);
    LAS float* wsf = (LAS float*)(lds + LDS_WS) + wid * 64;
    const int NT = 4 * qb + 4;
#define ATT_DMA(t, slot) do { const size_t row0_ = (t) == 0 ? (size_t)(RMAIN + 16 * b) : (size_t)(rowbase + 64 * ((t) - 1)); \
        __builtin_amdgcn_global_load_lds((const unsigned*)(KNV + (row0_ + lane) * 2048 + h * 64 + wid * 8), (LAS unsigned*)(lds + LDS_K + (slot) * KSLOT + wid * 1024), 16, 0, 0); \
        if (wid < 4) __builtin_amdgcn_global_load_lds((const unsigned*)(KPE + (row0_ + lane) * 32 + wid * 8), (LAS unsigned*)(lds + LDS_K + (slot) * KSLOT + (8 + wid) * 1024), 16, 0, 0); \
        __builtin_amdgcn_global_load_lds((const unsigned*)(KNV + (row0_ + 16 * (wid & 3) + (lane >> 2)) * 2048 + 1024 + h * 64 + (wid >> 2) * 32 + (lane & 3) * 8), (LAS unsigned*)(lds + LDS_V + (slot) * VSLOT + wid * 1024), 16, 0, 0); } while (0)
    f32x16 o[2]; o[0] = f32x16{}; o[1] = f32x16{};
    float mref = -INFINITY, l = 0.f;
    ATT_DMA(0, 0);
    for (int t = 0; t <= NT; ++t) {
        ATT_WAIT_BAR();
        const int slot = t & 1;
        if (t < NT) ATT_DMA(t + 1, slot ^ 1);
        const int kt0 = 64 * (t - 1);
        if (t > 0 && kt0 > q0 + wid * 32 + 31) continue;
        f32x16 p0 = f32x16{}, p1 = f32x16{};
        const LAS unsigned char* kb = lds + LDS_K + slot * KSLOT + hi * 1024 + r32 * 16;
#pragma unroll
        for (int d0 = 0; d0 < 6; ++d0) {
            const bf16x8 b0 = *(const LAS bf16x8*)(kb + d0 * 2048), b1 = *(const LAS bf16x8*)(kb + d0 * 2048 + 512);
            p0 = __builtin_amdgcn_mfma_f32_32x32x16_bf16(b0, qr[d0], p0, 0, 0, 0);
            p1 = __builtin_amdgcn_mfma_f32_32x32x16_bf16(b1, qr[d0], p1, 0, 0, 0);
        }
        if (t == 0) {
#pragma unroll
            for (int r = 0; r < 16; ++r) { if (crow(r, hi) >= NMETA) p0[r] = -INFINITY; p1[r] = -INFINITY; }
        } else if (kt0 + 63 > q0 + wid * 32) {
#pragma unroll
            for (int r = 0; r < 16; ++r) { const int kv = kt0 + crow(r, hi); if (kv > qrel) p0[r] = -INFINITY; if (kv + 32 > qrel) p1[r] = -INFINITY; }
        }
        float rm = fmaxf(p0[0], p1[0]);
#pragma unroll
        for (int r = 1; r < 16; ++r) rm = fmaxf(rm, fmaxf(p0[r], p1[r]));
        rm = pmax32(rm);
        if (__any(rm > mref + 8.0f)) {
            const float mnew = fmaxf(mref, rm); const float f = __builtin_amdgcn_exp2f(mref - mnew);
            mref = mnew; l *= f;
            if (hi == 0) wsf[r32] = f;
            LDS_WAIT();
#pragma unroll
            for (int r = 0; r < 16; ++r) { const float fr = wsf[crow(r, hi)]; o[0][r] *= fr; o[1][r] *= fr; }
        }
        float sacc = 0.f;
#pragma unroll
        for (int r = 0; r < 16; ++r) { p0[r] = __builtin_amdgcn_exp2f(p0[r] - mref); p1[r] = __builtin_amdgcn_exp2f(p1[r] - mref); sacc += p0[r] + p1[r]; }
        l += sacc;
        u32x4 pw[4];
#pragma unroll
        for (int i = 0; i < 4; ++i) { pw[0][i] = cvtpk(p0[2 * i], p0[2 * i + 1]); pw[1][i] = cvtpk(p0[8 + 2 * i], p0[8 + 2 * i + 1]); pw[2][i] = cvtpk(p1[2 * i], p1[2 * i + 1]); pw[3][i] = cvtpk(p1[8 + 2 * i], p1[8 + 2 * i + 1]); }
        const LAS unsigned char* vb = lds + LDS_V + slot * VSLOT + ((lane >> 4) & 1) * 32 + (lane & 3) * 8 + (4 * hi + ((lane & 15) >> 2)) * 64;
#pragma unroll
        for (int d0 = 0; d0 < 2; ++d0)
#pragma unroll
            for (int ks = 0; ks < 4; ++ks) {
                const s16x4 vlo = vtr(vb + d0 * 4096 + ks * 1024), vhi = vtr(vb + d0 * 4096 + ks * 1024 + 512);
                const bf16x8 vf = (bf16x8){vlo[0], vlo[1], vlo[2], vlo[3], vhi[0], vhi[1], vhi[2], vhi[3]};
                o[d0] = __builtin_amdgcn_mfma_f32_32x32x16_bf16(__builtin_bit_cast(bf16x8, pw[ks]), vf, o[d0], 0, 0, 0);
            }
    }
    l = psum32(l);
    if (hi == 0) wsf[32 + r32] = l;
    LDS_WAIT();
    bf16* Ow = O + (size_t)(rowbase + q0 + wid * 32) * 1024 + h * 64;
    LAS bf16* stg = (LAS bf16*)(lds + LDS_OST) + wid * 2048;
#pragma unroll
    for (int r = 0; r < 16; ++r) { const int orow = crow(r, hi); const float il = 1.0f / wsf[32 + orow];
        stg[orow * 64 + r32] = (bf16)f2bf(o[0][r] * il); stg[orow * 64 + 32 + r32] = (bf16)f2bf(o[1][r] * il); }
    LDS_WAIT();
#pragma unroll
    for (int i = 0; i < 4; ++i) { const int row = i * 8 + (lane >> 3), ch = lane & 7; const u32x4 v = *(const LAS u32x4*)(stg + row * 64 + ch * 8); *(u32x4*)(Ow + (size_t)row * 1024 + ch * 8) = v; }
    ATT_WAIT_BAR();
#undef ATT_DMA
}
__device__ __forceinline__ void attn_phase(const bf16* QN, const bf16* QPE, const bf16* KNV, const bf16* KPE, bf16* O, LAS unsigned char* lds, int wave_id) {
    const int G = gridDim.x, bx = blockIdx.x; const int vcu = (G % 8 == 0) ? (bx % 8) * (G / 8) + bx / 8 : bx;
    for (int v = vcu; v < NB * NH * 4; v += G) {
        const int bh = v >> 2, s0 = v & 3;
#pragma unroll 1
        for (int i = 0; i < 4; ++i) { const int qb = (i == 0) ? 15 - s0 : (i == 1) ? 11 - s0 : (i == 2) ? 4 + s0 : s0; attn_unit(bh >> 4, bh & 15, qb, QN, QPE, KNV, KPE, O, lds, wave_id); }
    }
}
}


namespace dec {
using att::bf16x8; using att::s16x4; using att::f32x16; using att::crow; using att::cvtpk; using att::vtr; using att::pmax32; using att::psum32;
constexpr int KST = 592, KBUF = 64 * KST, LDS_K = 0, LDS_Q = 2 * KBUF, LDS_WS = LDS_Q + 64 * KST, LDS_TOTAL = LDS_WS + 8 * 256;
constexpr int NSTAGE = 64;
__device__ __forceinline__ void decode_unit(int db, int sp, ArgsP a, LAS unsigned char* lds, int wave_id) {
    const int tid = fresh_tid(wave_id), lane = tid & 63, r32 = lane & 31, hi = lane >> 5; const int wid = wave_id;
    const int qh = wid & 1, kh = (wid >> 1) & 1, dh = wid >> 2;
    const float* cckv = IN_F(2); const float* ckpe = IN_F(3); const int* pt = (const int*)a->in[5] + db * NPAGES + sp * 32;
    for (int i = tid; i < 64 * 36; i += 512) { const int q = i / 36, ch = i % 36, t = q >> 4, h = q & 15;
        const bf16* src = ch < 32 ? WSB(WS_QLAT) + ((size_t)(db * 4 + t) * 16 + h) * 256 + ch * 8 : WSB(WS_QPE) + (size_t)(RSAMP0 + db * 4 + t) * 512 + h * 32 + (ch - 32) * 8;
        *(LAS u32x4*)(lds + LDS_Q + q * KST + ch * 16) = *(const u32x4*)src; }
    f32x4 cv[8], kv;
#define DEC_LOAD(s) do { const int page_ = __builtin_amdgcn_readfirstlane(pt[(s) >> 1]); const size_t k0_ = (size_t)page_ * PAGE + ((s) & 1) * 64; \
        _Pragma("unroll") for (int j = 0; j < 8; ++j) cv[j] = *(const f32x4*)(cckv + (k0_ + wid + 8 * j) * 256 + 4 * lane); \
        kv = *(const f32x4*)(ckpe + (k0_ + (tid >> 3)) * 32 + 4 * (tid & 7)); } while (0)
#define DEC_WRITE(buf) do { LAS unsigned char* kb_ = lds + LDS_K + (buf) * KBUF; \
        _Pragma("unroll") for (int j = 0; j < 8; ++j) { u32x2 w_; w_.x = cvtpk(cv[j].x, cv[j].y); w_.y = cvtpk(cv[j].z, cv[j].w); *(LAS u32x2*)(kb_ + (wid + 8 * j) * KST + lane * 8) = w_; } \
        { u32x2 w_; w_.x = cvtpk(kv.x, kv.y); w_.y = cvtpk(kv.z, kv.w); *(LAS u32x2*)(kb_ + (tid >> 3) * KST + 512 + (tid & 7) * 8) = w_; } } while (0)
    LAS float* wsf = (LAS float*)(lds + LDS_WS) + wid * 64;
    f32x16 o[4]; o[0] = f32x16{}; o[1] = f32x16{}; o[2] = f32x16{}; o[3] = f32x16{};
    float mref = -INFINITY, l = 0.f;
    DEC_LOAD(0); DEC_WRITE(0); DEC_LOAD(1);
    __syncthreads();
    for (int s = 0; s < NSTAGE; ++s) {
        const int buf = s & 1;
        const LAS unsigned char* kimg = lds + LDS_K + buf * KBUF;
        f32x16 p = f32x16{};
        { const LAS unsigned char* kb = kimg + (kh * 32 + r32) * KST + hi * 16; const LAS unsigned char* qb = lds + LDS_Q + (qh * 32 + r32) * KST + hi * 16;
#pragma unroll
          for (int s2 = 0; s2 < 18; ++s2) p = __builtin_amdgcn_mfma_f32_32x32x16_bf16(*(const LAS bf16x8*)(kb + s2 * 32), *(const LAS bf16x8*)(qb + s2 * 32), p, 0, 0, 0); }
        float rm = p[0];
#pragma unroll
        for (int r = 1; r < 16; ++r) rm = fmaxf(rm, p[r]);
        rm = pmax32(rm);
        if (__any(rm > mref + 8.0f)) {
            const float mnew = fmaxf(mref, rm); const float f = __builtin_amdgcn_exp2f(mref - mnew);
            mref = mnew; l *= f;
            if (hi == 0) wsf[r32] = f;
            LDS_WAIT();
#pragma unroll
            for (int r = 0; r < 16; ++r) { const float fr = wsf[crow(r, hi)]; o[0][r] *= fr; o[1][r] *= fr; o[2][r] *= fr; o[3][r] *= fr; }
        }
        float sacc = 0.f;
#pragma unroll
        for (int r = 0; r < 16; ++r) { p[r] = __builtin_amdgcn_exp2f(p[r] - mref); sacc += p[r]; }
        l += sacc;
        u32x4 pw[2];
#pragma unroll
        for (int i = 0; i < 4; ++i) { pw[0][i] = cvtpk(p[2 * i], p[2 * i + 1]); pw[1][i] = cvtpk(p[8 + 2 * i], p[8 + 2 * i + 1]); }
        const LAS unsigned char* vb = kimg + (kh * 32 + 4 * hi + ((lane & 15) >> 2)) * KST + (dh * 128 + 16 * ((lane >> 4) & 1) + 4 * (lane & 3)) * 2;
#pragma unroll
        for (int dt = 0; dt < 4; ++dt)
#pragma unroll
            for (int ks = 0; ks < 2; ++ks) {
                const s16x4 vlo = vtr(vb + (ks * 16) * KST + dt * 64), vhi = vtr(vb + (ks * 16 + 8) * KST + dt * 64);
                const bf16x8 vf = (bf16x8){vlo[0], vlo[1], vlo[2], vlo[3], vhi[0], vhi[1], vhi[2], vhi[3]};
                o[dt] = __builtin_amdgcn_mfma_f32_32x32x16_bf16(__builtin_bit_cast(bf16x8, pw[ks]), vf, o[dt], 0, 0, 0);
            }
        if (s + 1 < NSTAGE) { DEC_WRITE(buf ^ 1); if (s + 2 < NSTAGE) DEC_LOAD(s + 2); }
        __syncthreads();
    }
    const int part = (db * 2 + sp) * 2 + kh;
    float* op = WSF(WS_OPART) + (size_t)part * 64 * 256;
#pragma unroll
    for (int dt = 0; dt < 4; ++dt)
#pragma unroll
        for (int r = 0; r < 16; ++r) op[(size_t)(qh * 32 + crow(r, hi)) * 256 + dh * 128 + dt * 32 + r32] = o[dt][r];
    l = psum32(l);
    if (dh == 0 && hi == 0) { float* mp = WSF(WS_MLP) + (size_t)part * 128 + (qh * 32 + r32) * 2; mp[0] = mref; mp[1] = l; }
#undef DEC_LOAD
#undef DEC_WRITE
}
__device__ __forceinline__ void decode_phase(ArgsP a, LAS unsigned char* lds, int wave_id) {
    for (int u = blockIdx.x; u < DB * 2; u += gridDim.x) { decode_unit(u >> 1, u & 1, a, lds, wave_id); __syncthreads(); }
}
__device__ __forceinline__ void combine_phase(ArgsP a, const Ctx& c0) {
    const Ctx c = refresh(c0);
    for (int it = c.gw; it < DB * DS * NH; it += c.ngw) {
        const int i = it >> 4, h = it & 15, db = i >> 2, t = i & 3, q = t * 16 + h;
        const u32x2 qv = *(const u32x2*)(WSB(WS_QLAT) + ((size_t)i * 16 + h) * 256 + 4 * c.lane); const f32x4 ql = (f32x4){bflo(qv.x), bfhi(qv.x), bflo(qv.y), bfhi(qv.y)};
        const float qp = c.lane < 32 ? bf2f(WSB(WS_QPE)[(size_t)(RSAMP0 + i) * 512 + h * 32 + c.lane]) : 0.f;
        float mp[4], lp[4], dn[4]; f32x4 cn[4]; float mg = -INFINITY;
#pragma unroll
        for (int p = 0; p < 4; ++p) { const float* ml = WSF(WS_MLP) + (size_t)(db * 4 + p) * 128 + q * 2; mp[p] = ml[0]; lp[p] = ml[1]; mg = fmaxf(mg, mp[p]); }
#pragma unroll
        for (int s2 = 0; s2 < 4; ++s2) {
            const int kr = RSAMP0 + db * 4 + s2;
            const u32x2 v = *(const u32x2*)(WSB(WS_CKVN) + (size_t)kr * 256 + 4 * c.lane); cn[s2] = (f32x4){bflo(v.x), bfhi(v.x), bflo(v.y), bfhi(v.y)};
            const float e = c.lane < 32 ? bf2f(WSB(WS_KPE)[(size_t)kr * 32 + c.lane]) : 0.f;
            float d = (ql.x * cn[s2].x + ql.y * cn[s2].y) + (ql.z * cn[s2].z + ql.w * cn[s2].w) + qp * e;
            d = wave_sum(d); dn[s2] = s2 <= t ? d : -INFINITY; mg = fmaxf(mg, dn[s2]);
        }
        f32x4 acc = (f32x4){0.f, 0.f, 0.f, 0.f}; float L = 0.f;
#pragma unroll
        for (int p = 0; p < 4; ++p) { const float w = exp2f(mp[p] - mg); L += w * lp[p]; acc += w * *(const f32x4*)(WSF(WS_OPART) + ((size_t)(db * 4 + p) * 64 + q) * 256 + 4 * c.lane); }
#pragma unroll
        for (int s2 = 0; s2 < 4; ++s2) { const float w = exp2f(dn[s2] - mg); L += w; acc += w * cn[s2]; }
        const f32x4 res = acc * (1.0f / L);
        const float* wuv = IN_F(16) + h * 64 + c.lane; float ov = 0.f;
#pragma unroll
        for (int cl = 0; cl < 64; ++cl) ov += (rdlane(res.x, cl) * wuv[(size_t)(4 * cl) * 1024] + rdlane(res.y, cl) * wuv[(size_t)(4 * cl + 1) * 1024]) + (rdlane(res.z, cl) * wuv[(size_t)(4 * cl + 2) * 1024] + rdlane(res.w, cl) * wuv[(size_t)(4 * cl + 3) * 1024]);
        WSB(WS_O)[(size_t)(RSAMP0 + i) * 1024 + h * 64 + c.lane] = (bf16)f2bf(ov);
    }
}
}

__device__ __forceinline__ void p_mla_mid(ArgsP a, const Ctx& c0) {
    const Ctx c = refresh(c0);
    const float* A1 = WSF(WS_A1);
    for (int r = c.gw; r < R; r += c.ngw) {
        const float* row = A1 + (size_t)r * NIN0; const int pos = row_pos(r);
        const f32x4 cq = *(const f32x4*)(row + 4 * c.lane), ck = *(const f32x4*)(row + 256 + 4 * c.lane);
        const float rq = 1.0f / sqrtf(wave_sum((cq.x * cq.x + cq.y * cq.y) + (cq.z * cq.z + cq.w * cq.w)) * (1.f / 256) + EPS);
        const float rk = 1.0f / sqrtf(wave_sum((ck.x * ck.x + ck.y * ck.y) + (ck.z * ck.z + ck.w * ck.w)) * (1.f / 256) + EPS);
        const f32x4 gq = *(const f32x4*)(IN_F(12) + 4 * c.lane), gk = *(const f32x4*)(IN_F(14) + 4 * c.lane);
        const f32x4 qn = cq * rq * gq, kn = ck * rk * gk;
        u32x2 o; o.x = pk2(qn.x, qn.y); o.y = pk2(qn.z, qn.w); *(u32x2*)(WSB(WS_CQN) + (size_t)r * 256 + 4 * c.lane) = o;
        o.x = pk2(kn.x, kn.y); o.y = pk2(kn.z, kn.w); *(u32x2*)(WSB(WS_CKVN) + (size_t)r * 256 + 4 * c.lane) = o;
        float* ockv; float* okpe;
        if (r < RSAMP0) { const int b = r < RMAIN ? (r >> 12) : ((r - RMAIN) >> 4); ockv = a->out + O_CKVP + ((size_t)b * TP + pos) * 256; okpe = a->out + O_KPEP + ((size_t)b * TP + pos) * 32; }
        else { ockv = a->out + O_CKVS + (size_t)(r - RSAMP0) * 256; okpe = a->out + O_KPES + (size_t)(r - RSAMP0) * 32; }
        *(f32x4*)(ockv + 4 * c.lane) = kn;
        if (c.lane < 16) { const int j = c.lane; const float x1 = row[512 + j], x2 = row[528 + j]; float cs, sn; rope_cs(pos, j, cs, sn);
            const float o1 = x1 * cs - x2 * sn, o2 = x1 * sn + x2 * cs; okpe[j] = o1; okpe[16 + j] = o2;
            WSB(WS_KPE)[(size_t)r * 32 + j] = (bf16)f2bf(o1); WSB(WS_KPE)[(size_t)r * 32 + 16 + j] = (bf16)f2bf(o2); }
    }
}
__device__ __forceinline__ void p_q_post(ArgsP a, const Ctx& c0) {
    const Ctx c = refresh(c0);
    for (int r = c.gw; r < R; r += c.ngw) {
        const float* row = WSF(WS_QRAW) + (size_t)r * NUQ; const int pos = row_pos(r);
        const float qs = QSCALE;
#pragma unroll
        for (int j = 0; j < 4; ++j) { const f32x4 v = *(const f32x4*)(row + 4 * c.lane + 256 * j) * qs; u32x2 o; o.x = pk2(v.x, v.y); o.y = pk2(v.z, v.w); *(u32x2*)(WSB(WS_QN) + (size_t)r * 1024 + 4 * c.lane + 256 * j) = o; }
#pragma unroll
        for (int j = 0; j < 4; ++j) { const int p = c.lane + 64 * j, h = p >> 4, jj = p & 15; const float x1 = row[1024 + 2 * p], x2 = row[1024 + 2 * p + 1]; float cs, sn; rope_cs(pos, jj, cs, sn);
            WSB(WS_QPE)[(size_t)r * 512 + h * 32 + jj] = (bf16)f2bf((x1 * cs - x2 * sn) * qs); WSB(WS_QPE)[(size_t)r * 512 + h * 32 + 16 + jj] = (bf16)f2bf((x1 * sn + x2 * cs) * qs); }
    }
}
__device__ __forceinline__ void p_qlat(ArgsP a, const Ctx& c0) {
    const Ctx c = refresh(c0);
    const float* wuk = IN_F(15);
    for (int it = c.gw; it < DB * DS * NH; it += c.ngw) {
        const int i = it >> 4, h = it & 15;
        const float q = WSF(WS_QRAW)[(size_t)(RSAMP0 + i) * NUQ + h * 64 + c.lane];
        float acc[4] = {0.f, 0.f, 0.f, 0.f};
#pragma unroll 8
        for (int n = 0; n < 64; ++n) { const float qn = __shfl(q, n);
#pragma unroll
            for (int k = 0; k < 4; ++k) acc[k] += qn * wuk[(size_t)(c.lane + 64 * k) * 1024 + h * 64 + n]; }
#pragma unroll
        for (int k = 0; k < 4; ++k) WSB(WS_QLAT)[((size_t)i * 16 + h) * 256 + c.lane + 64 * k] = (bf16)f2bf(acc[k] * QSCALE);
    }
}
template <bool META_ONLY>
__device__ __forceinline__ void p_attn_prompt_naive(ArgsP a, const Ctx& c0) {
    const Ctx c = refresh(c0);
    const bf16* QN = WSB(WS_QN); const bf16* QPE = WSB(WS_QPE); const bf16* KNV = WSB(WS_KNV); const bf16* KPE = WSB(WS_KPE);
    for (int item = c.gw + (META_ONLY ? (RMAIN / 64) * NH : 0); item < (RPROMPT / 64) * NH; item += c.ngw) {
        const int rb = item >> 4, h = item & 15, r = rb * 64 + c.lane;
        int b, nk;
        if (r < RMAIN) { b = r >> 12; nk = NMETA + (r & 4095) + 1; } else { const int i = r - RMAIN; b = i >> 4; nk = (i & 15) + 1; }
        const int mbase = RMAIN + 16 * b, tbase = 4096 * b;
        float qn[64], qp[32], o[64];
#pragma unroll
        for (int j = 0; j < 8; ++j) { const u32x4 v = *(const u32x4*)(QN + (size_t)r * 1024 + h * 64 + 8 * j);
            qn[8 * j] = bflo(v.x); qn[8 * j + 1] = bfhi(v.x); qn[8 * j + 2] = bflo(v.y); qn[8 * j + 3] = bfhi(v.y); qn[8 * j + 4] = bflo(v.z); qn[8 * j + 5] = bfhi(v.z); qn[8 * j + 6] = bflo(v.w); qn[8 * j + 7] = bfhi(v.w); }
#pragma unroll
        for (int j = 0; j < 4; ++j) { const u32x4 v = *(const u32x4*)(QPE + (size_t)r * 512 + h * 32 + 8 * j);
            qp[8 * j] = bflo(v.x); qp[8 * j + 1] = bfhi(v.x); qp[8 * j + 2] = bflo(v.y); qp[8 * j + 3] = bfhi(v.y); qp[8 * j + 4] = bflo(v.z); qp[8 * j + 5] = bfhi(v.z); qp[8 * j + 6] = bflo(v.w); qp[8 * j + 7] = bfhi(v.w); }
#pragma unroll
        for (int j = 0; j < 64; ++j) o[j] = 0.f;
        float m = -INFINITY, l = 0.f;
        const int nkmax = wave_max_i(nk);
        for (int kk = 0; kk < nkmax; ++kk) {
            if (kk < nk) {
                const int kr = kk < NMETA ? mbase + kk : tbase + kk - NMETA;
                const bf16* kn = KNV + (size_t)kr * 2048 + h * 64; const bf16* kp = KPE + (size_t)kr * 32; const bf16* vv = kn + 1024;
                float s = 0.f;
#pragma unroll
                for (int j = 0; j < 8; ++j) { const u32x4 v = *(const u32x4*)(kn + 8 * j);
                    s += qn[8 * j] * bflo(v.x) + qn[8 * j + 1] * bfhi(v.x) + qn[8 * j + 2] * bflo(v.y) + qn[8 * j + 3] * bfhi(v.y) + qn[8 * j + 4] * bflo(v.z) + qn[8 * j + 5] * bfhi(v.z) + qn[8 * j + 6] * bflo(v.w) + qn[8 * j + 7] * bfhi(v.w); }
#pragma unroll
                for (int j = 0; j < 4; ++j) { const u32x4 v = *(const u32x4*)(kp + 8 * j);
                    s += qp[8 * j] * bflo(v.x) + qp[8 * j + 1] * bfhi(v.x) + qp[8 * j + 2] * bflo(v.y) + qp[8 * j + 3] * bfhi(v.y) + qp[8 * j + 4] * bflo(v.z) + qp[8 * j + 5] * bfhi(v.z) + qp[8 * j + 6] * bflo(v.w) + qp[8 * j + 7] * bfhi(v.w); }
                const float mn = fmaxf(m, s), corr = exp2f(m - mn), p = exp2f(s - mn);
                l = l * corr + p; m = mn;
#pragma unroll
                for (int j = 0; j < 8; ++j) { const u32x4 v = *(const u32x4*)(vv + 8 * j);
                    o[8 * j] = o[8 * j] * corr + p * bflo(v.x); o[8 * j + 1] = o[8 * j + 1] * corr + p * bfhi(v.x); o[8 * j + 2] = o[8 * j + 2] * corr + p * bflo(v.y); o[8 * j + 3] = o[8 * j + 3] * corr + p * bfhi(v.y);
                    o[8 * j + 4] = o[8 * j + 4] * corr + p * bflo(v.z); o[8 * j + 5] = o[8 * j + 5] * corr + p * bfhi(v.z); o[8 * j + 6] = o[8 * j + 6] * corr + p * bflo(v.w); o[8 * j + 7] = o[8 * j + 7] * corr + p * bfhi(v.w); }
            }
        }
        const float il = 1.0f / l;
#pragma unroll
        for (int j = 0; j < 8; ++j) { u32x4 w; w.x = pk2(o[8 * j] * il, o[8 * j + 1] * il); w.y = pk2(o[8 * j + 2] * il, o[8 * j + 3] * il); w.z = pk2(o[8 * j + 4] * il, o[8 * j + 5] * il); w.w = pk2(o[8 * j + 6] * il, o[8 * j + 7] * il);
            *(u32x4*)(WSB(WS_O) + (size_t)r * 1024 + h * 64 + 8 * j) = w; }
    }
}
__device__ __forceinline__ void p_attn_decode_naive(ArgsP a, const Ctx& c0) {
    const Ctx c = refresh(c0);
    const float* cckv = IN_F(2); const float* ckpe = IN_F(3); const int* pt = (const int*)a->in[5];
    for (int item = c.gw; item < DB * NH; item += c.ngw) {
        const int db = item >> 4, h = item & 15;
        f32x4 ql[4]; float qp[4], m[4], l[4]; f32x4 o[4];
#pragma unroll
        for (int t = 0; t < 4; ++t) { const u32x2 v = *(const u32x2*)(WSB(WS_QLAT) + ((size_t)(db * 4 + t) * 16 + h) * 256 + 4 * c.lane);
            ql[t] = (f32x4){bflo(v.x), bfhi(v.x), bflo(v.y), bfhi(v.y)};
            qp[t] = c.lane < 32 ? bf2f(WSB(WS_QPE)[(size_t)(RSAMP0 + db * 4 + t) * 512 + h * 32 + c.lane]) : 0.f;
            m[t] = -INFINITY; l[t] = 0.f; o[t] = (f32x4){0.f, 0.f, 0.f, 0.f}; }
        for (int p = 0; p < NPAGES; ++p) {
            const int page = pt[db * NPAGES + p];
            for (int k = 0; k < PAGE; ++k) {
                const size_t kr = (size_t)page * PAGE + k;
                const f32x4 cv = *(const f32x4*)(cckv + kr * 256 + 4 * c.lane); const float e = c.lane < 32 ? ckpe[kr * 32 + c.lane] : 0.f;
#pragma unroll
                for (int t = 0; t < 4; ++t) {
                    float d = (ql[t].x * cv.x + ql[t].y * cv.y) + (ql[t].z * cv.z + ql[t].w * cv.w) + qp[t] * e;
                    d = wave_sum(d);
                    const float mn = fmaxf(m[t], d), corr = exp2f(m[t] - mn), pp = exp2f(d - mn);
                    l[t] = l[t] * corr + pp; m[t] = mn; o[t] = o[t] * corr + pp * cv;
                }
            }
        }
#pragma unroll
        for (int s2 = 0; s2 < 4; ++s2) {
            const int kr = RSAMP0 + db * 4 + s2;
            const u32x2 v = *(const u32x2*)(WSB(WS_CKVN) + (size_t)kr * 256 + 4 * c.lane); const f32x4 cv = (f32x4){bflo(v.x), bfhi(v.x), bflo(v.y), bfhi(v.y)};
            const float e = c.lane < 32 ? bf2f(WSB(WS_KPE)[(size_t)kr * 32 + c.lane]) : 0.f;
#pragma unroll
            for (int t = 0; t < 4; ++t) if (t >= s2) {
                float d = (ql[t].x * cv.x + ql[t].y * cv.y) + (ql[t].z * cv.z + ql[t].w * cv.w) + qp[t] * e;
                d = wave_sum(d);
                const float mn = fmaxf(m[t], d), corr = exp2f(m[t] - mn), pp = exp2f(d - mn);
                l[t] = l[t] * corr + pp; m[t] = mn; o[t] = o[t] * corr + pp * cv;
            }
        }
#pragma unroll
        for (int t = 0; t < 4; ++t) *(f32x4*)(WSF(WS_OLAT) + ((size_t)(db * 4 + t) * 16 + h) * 256 + 4 * c.lane) = o[t] * (1.0f / l[t]);
    }
}
__device__ __forceinline__ void p_olat_up(ArgsP a, const Ctx& c0) {
    const Ctx c = refresh(c0);
    const float* wuv = IN_F(16);
    for (int it = c.gw; it < DB * DS * NH; it += c.ngw) {
        const int i = it >> 4, h = it & 15; const float* ol = WSF(WS_OLAT) + ((size_t)i * 16 + h) * 256;
        float acc = 0.f;
#pragma unroll 8
        for (int cc = 0; cc < 256; ++cc) acc += ol[cc] * wuv[(size_t)cc * 1024 + h * 64 + c.lane];
        WSB(WS_O)[(size_t)(RSAMP0 + i) * 1024 + h * 64 + c.lane] = (bf16)f2bf(acc);
    }
}
template <bool FINAL, int NSPLIT>
__device__ __forceinline__ void p_post_res(ArgsP a, const Ctx& c0, const float* gpost, const float* gnext) {
    const Ctx c = refresh(c0);
    for (int r = c.gw; r < R; r += c.ngw) {
        const float* mrow = WSF(WS_M) + (size_t)r * D; float* xrow = WSF(WS_X) + (size_t)r * D;
        f32x4 mv[4], xv[4]; float s = 0.f;
#pragma unroll
        for (int j = 0; j < 4; ++j) {
            if (r < RMAIN) mv[j] = *(const f32x4*)(mrow + 4 * c.lane + 256 * j);
            else { mv[j] = (f32x4){0.f, 0.f, 0.f, 0.f};
                f32x4 part[NSPLIT];
#pragma unroll
                for (int sp = 0; sp < NSPLIT; ++sp) part[sp] = *(const f32x4*)(WSF(WS_MT) + ((size_t)sp * (RP - RMAIN) + (r - RMAIN)) * D + 4 * c.lane + 256 * j);
#pragma unroll
                for (int sp = 0; sp < NSPLIT; ++sp) mv[j] += part[sp]; }
            xv[j] = *(const f32x4*)(xrow + 4 * c.lane + 256 * j); s += (mv[j].x * mv[j].x + mv[j].y * mv[j].y) + (mv[j].z * mv[j].z + mv[j].w * mv[j].w); }
        const float rm = 1.0f / sqrtf(wave_sum(s) * (1.f / D) + EPS); float s2 = 0.f;
#pragma unroll
        for (int j = 0; j < 4; ++j) { const f32x4 g = *(const f32x4*)(gpost + 4 * c.lane + 256 * j); xv[j] = xv[j] + mv[j] * rm * g; s2 += (xv[j].x * xv[j].x + xv[j].y * xv[j].y) + (xv[j].z * xv[j].z + xv[j].w * xv[j].w); }
        if (FINAL) {
            if (r >= RMAIN && r < RSAMP0) continue;
            float* y = r < RMAIN ? a->out + O_YP + (size_t)r * D : a->out + O_YS + (size_t)(r - RSAMP0) * D;
#pragma unroll
            for (int j = 0; j < 4; ++j) *(f32x4*)(y + 4 * c.lane + 256 * j) = xv[j];
        } else {
            const float rx = 1.0f / sqrtf(wave_sum(s2) * (1.f / D) + EPS);
#pragma unroll
            for (int j = 0; j < 4; ++j) { const f32x4 g = *(const f32x4*)(gnext + 4 * c.lane + 256 * j); *(f32x4*)(xrow + 4 * c.lane + 256 * j) = xv[j];
                u32x2 o; o.x = pk2(xv[j].x * rx * g.x, xv[j].y * rx * g.y); o.y = pk2(xv[j].z * rx * g.z, xv[j].w * rx * g.w); *(u32x2*)(WSB(WS_H) + (size_t)r * D + 4 * c.lane + 256 * j) = o; }
        }
    }
}

__device__ __forceinline__ void p_gate(ArgsP a, const Ctx& c0) {
    const Ctx c = refresh(c0);
    const float* wg = IN_F(19); const float* bg = IN_F(20);
    const size_t gt = (size_t)c.gw * 64 + c.lane, ngt = (size_t)c.ngw * 64;
    for (size_t i = gt + (size_t)(USE_NAIVE_GLA ? 0 : RSAMP0) * 512; i < (size_t)R * 512; i += ngt) {
        const int r = (int)(i >> 9), col = (int)(i & 511); const float* gd = WSF(WS_GD) + (size_t)r * 16;
        float x = bg[col];
#pragma unroll
        for (int j = 0; j < 16; ++j) x += gd[j] * wg[j * 512 + col];
        const float ls = fminf(x, 0.f) - log1pf(__expf(-fabsf(x)));
        const float la = ls * (1.0f / 16.0f);
        WSF(WS_LA)[i] = la; WSF(WS_EA)[i] = __expf(la);
    }
}
__device__ __forceinline__ void gla_step(float (&S)[128], float& o, float a0, float a1, float k0, float k1, float q0, float q1, float v) {
    o = 0.f;
#pragma unroll
    for (int d = 0; d < 64; ++d) { const float ad = rdlane(a0, d), kd = rdlane(k0, d), qd = rdlane(q0, d); S[d] = ad * S[d] + kd * v; o += qd * S[d]; }
#pragma unroll
    for (int d = 0; d < 64; ++d) { const float ad = rdlane(a1, d), kd = rdlane(k1, d), qd = rdlane(q1, d); S[64 + d] = ad * S[64 + d] + kd * v; o += qd * S[64 + d]; }
}
__device__ __forceinline__ void p_gla_naive(ArgsP a, const Ctx& c0) {
    const Ctx c = refresh(c0);
    const float* EA = WSF(WS_EA); const bf16* KG = WSB(WS_KG); const bf16* QG = WSB(WS_QG); const bf16* VG = WSB(WS_VG); float* OGR = WSF(WS_OGRAW);
    for (int item = c.gwT; item < (USE_NAIVE_GLA ? NB * GH * 4 : 0); item += c.ngw) {
        const int b = item >> 4, h = (item >> 2) & 3, dv = (item & 3) * 64 + c.lane;
        float S[128];
#pragma unroll
        for (int d = 0; d < 128; ++d) S[d] = 0.f;
        for (int tt = 0; tt < TP; ++tt) {
            const int row = tt < NMETA ? RMAIN + 16 * b + tt : 4096 * b + tt - NMETA;
            const size_t g = (size_t)row * 512 + h * 128;
            const float a0 = EA[g + c.lane], a1 = EA[g + 64 + c.lane], k0 = bf2f(KG[g + c.lane]), k1 = bf2f(KG[g + 64 + c.lane]), q0 = bf2f(QG[g + c.lane]), q1 = bf2f(QG[g + 64 + c.lane]);
            const float v = bf2f(VG[(size_t)row * 1024 + h * 256 + dv]);
            float o; gla_step(S, o, a0, a1, k0, k1, q0, q1, v);
            OGR[(size_t)row * 1024 + h * 256 + dv] = o;
        }
        float* outp = a->out + O_GLAP + ((size_t)(b * 4 + h) * 128) * 256 + dv;
#pragma unroll
        for (int d = 0; d < 128; ++d) outp[(size_t)d * 256] = S[d];
    }
    const int wg0 = USE_NAIVE_GLA ? 0 : NB * GH; if ((int)blockIdx.x < wg0) return;
    for (int item = c.wave * ((int)gridDim.x - wg0) + ((int)blockIdx.x - wg0); item < DB * GH * 4; item += c.ngw - wg0 * 8) {
        const int db = item >> 4, h = (item >> 2) & 3, dv = (item & 3) * 64 + c.lane;
        const float* sp = IN_F(4) + ((size_t)(db * 4 + h) * 128) * 256 + dv;
        float S[128];
#pragma unroll
        for (int d = 0; d < 128; ++d) S[d] = sp[(size_t)d * 256];
#pragma unroll 1
        for (int s = 0; s < DS; ++s) {
            const int row = RSAMP0 + db * 4 + s; const size_t g = (size_t)row * 512 + h * 128;
            const float a0 = EA[g + c.lane], a1 = EA[g + 64 + c.lane], k0 = bf2f(KG[g + c.lane]), k1 = bf2f(KG[g + 64 + c.lane]), q0 = bf2f(QG[g + c.lane]), q1 = bf2f(QG[g + 64 + c.lane]);
            const float v = bf2f(VG[(size_t)row * 1024 + h * 256 + dv]);
            float o; gla_step(S, o, a0, a1, k0, k1, q0, q1, v);
            OGR[(size_t)row * 1024 + h * 256 + dv] = o;
        }
        float* outp = a->out + O_GLAS + ((size_t)(db * 4 + h) * 128) * 256 + dv;
#pragma unroll
        for (int d = 0; d < 128; ++d) outp[(size_t)d * 256] = S[d];
    }
}
__device__ __forceinline__ void p_gla_post(ArgsP a, const Ctx& c0) {
    const Ctx c = refresh(c0);
    const float* gn = IN_F(21);
    for (int r = c.gw; r < R; r += c.ngw) {
#pragma unroll
        for (int h = 0; h < 4; ++h) {
            const size_t off = (size_t)r * 1024 + h * 256 + 4 * c.lane;
            const f32x4 o = *(const f32x4*)(WSF(WS_OGRAW) + off); const u32x2 rv = *(const u32x2*)(WSB(WS_RG) + off); const f32x4 g = *(const f32x4*)(gn + 4 * c.lane);
            const float rs = 1.0f / sqrtf(wave_sum((o.x * o.x + o.y * o.y) + (o.z * o.z + o.w * o.w)) * (1.f / 256) + EPS);
            const f32x4 rr = (f32x4){bflo(rv.x), bfhi(rv.x), bflo(rv.y), bfhi(rv.y)};
            f32x4 sl; sl.x = rr.x / (1.f + __expf(-rr.x)); sl.y = rr.y / (1.f + __expf(-rr.y)); sl.z = rr.z / (1.f + __expf(-rr.z)); sl.w = rr.w / (1.f + __expf(-rr.w));
            const f32x4 y = o * rs * g * sl;
            u32x2 w; w.x = pk2(y.x, y.y); w.y = pk2(y.z, y.w); *(u32x2*)(WSB(WS_OG) + off) = w;
        }
    }
}


namespace gla {
using att::bf16x8; using att::f32x16; using att::crow; using att::cvtpk;
constexpr int NCH = 65, NITEM = NB * GH * NCH;
constexpr int P_GSUM = 0, P_QL = 2048, P_KL = P_QL + 64 * 272, P_AL = P_KL + 64 * 272, P_END = P_AL + 64 * 144;
__device__ __forceinline__ int chunk_row(int b, int c, int tok) { return c == 0 ? RMAIN + 16 * b + tok : 4096 * b + 64 * (c - 1) + tok; }
__device__ __forceinline__ void prep_item(ArgsP a, int item, LAS unsigned char* lds, int wave_id) {
    const int tid = fresh_tid(wave_id), lane = tid & 63, r32 = lane & 31, hi = lane >> 5; const int wid = wave_id;
    const int bh = item / NCH, c = item % NCH, b = bh >> 2, h = bh & 3;
    const int nvalid = c == 0 ? NMETA : 64;
    bf16* QINF = WSB(WS_QINF) + (size_t)item * 8192; bf16* KDTF = WSB(WS_KDTF) + (size_t)item * 8192; bf16* AMF = WSB(WS_AMF) + (size_t)item * 4096; bf16* VTF = WSB(WS_VTF) + (size_t)item * 16384; float* ELF = WSF(WS_ELF) + (size_t)item * 256;
    LAS float* GSUM = (LAS float*)(lds + P_GSUM); LAS bf16* QL = (LAS bf16*)(lds + P_QL); LAS bf16* KL = (LAS bf16*)(lds + P_KL); LAS bf16* AL = (LAS bf16*)(lds + P_AL);
    const int dk = tid & 127, tg = tid >> 7;
    float bloc[16];
    {
        float w[16]; const float* wg = IN_F(19) + h * 128 + dk;
#pragma unroll
        for (int j = 0; j < 16; ++j) w[j] = wg[j * 512];
        const float bg = IN_F(20)[h * 128 + dk];
        float run = 0.f;
#pragma unroll
        for (int i = 0; i < 16; ++i) {
            const int tok = tg * 16 + i; float g = 0.f;
            if (tok < nvalid) {
                const float* gd = WSF(WS_GD) + (size_t)chunk_row(b, c, tok) * 16; float x = bg;
#pragma unroll
                for (int j = 0; j < 16; ++j) x += gd[j] * w[j];
                g = (fminf(x, 0.f) - log1pf(__expf(-fabsf(x)))) * (1.0f / 16.0f);
            }
            run += g; bloc[i] = run;
        }
        GSUM[tg * 128 + dk] = run;
    }
    __syncthreads();
    float off = 0.f, blast = 0.f;
#pragma unroll
    for (int t = 0; t < 4; ++t) { const float s = GSUM[t * 128 + dk]; if (t < tg) off += s; blast += s; }
    {
        unsigned kdp[8];
#pragma unroll
        for (int i = 0; i < 16; i += 2) {
            float kd2[2];
#pragma unroll
            for (int e = 0; e < 2; ++e) {
                const int tok = tg * 16 + i + e; const float bb = bloc[i + e] + off; float q = 0.f, k = 0.f;
                if (tok < nvalid) { const size_t g = (size_t)chunk_row(b, c, tok) * 512 + h * 128 + dk; q = bf2f(WSB(WS_QG)[g]); k = bf2f(WSB(WS_KG)[g]); }
                QL[tok * 136 + dk] = (bf16)f2bf(q * __expf(bb)); KL[tok * 136 + dk] = (bf16)f2bf(k * __expf(-bb)); kd2[e] = k * __expf(blast - bb);
            }
            kdp[i >> 1] = pk2(kd2[0], kd2[1]);
        }
        bf16* kp = KDTF + ((size_t)(((dk >> 5) * 4 + tg) * 64) + (dk & 31)) * 8;
        *(u32x4*)(kp) = (u32x4){kdp[0], kdp[1], kdp[2], kdp[3]}; *(u32x4*)(kp + 32 * 8) = (u32x4){kdp[4], kdp[5], kdp[6], kdp[7]};
        if (tg == 0) ELF[dk] = __expf(blast);
    }
    {
        const int dv = tid & 255, half = tid >> 8;
#pragma unroll
        for (int u = 0; u < 4; ++u) {
            unsigned pk[4];
#pragma unroll
            for (int e = 0; e < 4; ++e) { float v2[2];
#pragma unroll
                for (int f = 0; f < 2; ++f) { const int tok = half * 32 + u * 8 + e * 2 + f; v2[f] = tok < nvalid ? bf2f(WSB(WS_VG)[(size_t)chunk_row(b, c, tok) * 1024 + h * 256 + dv]) : 0.f; }
                pk[e] = pk2(v2[0], v2[1]); }
            const int s = 2 * half + (u >> 1), uh = u & 1;
            *(u32x4*)(VTF + ((size_t)(((dv >> 5) * 4 + s) * 64) + uh * 32 + (dv & 31)) * 8) = (u32x4){pk[0], pk[1], pk[2], pk[3]};
        }
    }
    __syncthreads();
#pragma unroll
    for (int uu = 0; uu < 2; ++uu) {
        const int U = tid + 512 * uu, lp = U & 63, s8 = (U >> 6) & 7, tt = U >> 9; const int tok = tt * 32 + (lp & 31), hh = lp >> 5;
        const u32x2 lo = *(const LAS u32x2*)(QL + tok * 136 + 16 * s8 + 4 * hh), hi2 = *(const LAS u32x2*)(QL + tok * 136 + 16 * s8 + 8 + 4 * hh);
        *(u32x4*)(QINF + (size_t)U * 8) = (u32x4){lo.x, lo.y, hi2.x, hi2.y};
    }
    if (wid < 3) {
        const int tt = wid == 0 ? 0 : 1, tp = wid == 2 ? 1 : 0;
        f32x16 acc = f32x16{};
#pragma unroll
        for (int s = 0; s < 8; ++s) {
            const bf16x8 af = *(const LAS bf16x8*)(QL + (tt * 32 + r32) * 136 + 16 * s + 8 * hi), bfr = *(const LAS bf16x8*)(KL + (tp * 32 + r32) * 136 + 16 * s + 8 * hi);
            acc = __builtin_amdgcn_mfma_f32_32x32x16_bf16(af, bfr, acc, 0, 0, 0);
        }
#pragma unroll
        for (int r = 0; r < 16; ++r) { const int tok = tt * 32 + crow(r, hi), tk = tp * 32 + r32; AL[tok * 72 + tk] = (bf16)f2bf(tk <= tok ? acc[r] : 0.f); }
    } else if (wid == 3) {
#pragma unroll
        for (int r = 0; r < 16; ++r) AL[crow(r, hi) * 72 + 32 + r32] = 0;
    }
    __syncthreads();
    { const int U = tid, lp = U & 63, s = (U >> 6) & 3, tt = U >> 8; const int tok = tt * 32 + (lp & 31), hh = lp >> 5;
      *(u32x4*)(AMF + (size_t)U * 8) = *(const LAS u32x4*)(AL + tok * 72 + 16 * s + 8 * hh); }
    __syncthreads();
}
__device__ __forceinline__ void prep_phase(ArgsP a, LAS unsigned char* lds, int wave_id) {
    for (int item = blockIdx.x; item < NITEM; item += gridDim.x) prep_item(a, item, lds, wave_id);
}
constexpr int S_QIN = 0, S_KDT = 16384, S_AM = 32768, S_EL = 40960, S_SLOT = 41984;
__device__ __forceinline__ void scan_bh(ArgsP a, int bh, LAS unsigned char* lds, int wave_id) {
    const int tid = fresh_tid(wave_id), lane = tid & 63, r32 = lane & 31, hi = lane >> 5; const int wid = wave_id;
    const int b = bh >> 2, h = bh & 3;
#define GLA_DMA(c_, slot_) do { const size_t it_ = (size_t)bh * NCH + (c_); \
        for (int i_ = wid; i_ < 41; i_ += 8) { const unsigned char* g_; int lo_; \
            if (i_ < 16) { g_ = (const unsigned char*)(WSB(WS_QINF) + it_ * 8192) + i_ * 1024; lo_ = S_QIN + i_ * 1024; } \
            else if (i_ < 32) { g_ = (const unsigned char*)(WSB(WS_KDTF) + it_ * 8192) + (i_ - 16) * 1024; lo_ = S_KDT + (i_ - 16) * 1024; } \
            else if (i_ < 40) { g_ = (const unsigned char*)(WSB(WS_AMF) + it_ * 4096) + (i_ - 32) * 1024; lo_ = S_AM + (i_ - 32) * 1024; } \
            else { g_ = (const unsigned char*)(WSF(WS_ELF) + it_ * 256); lo_ = S_EL; } \
            __builtin_amdgcn_global_load_lds((const unsigned*)(g_ + lane * 16), (LAS unsigned*)(lds + (slot_) * S_SLOT + lo_), 16, 0, 0); } } while (0)
#define GLA_VLOAD(dst, c_) do { const bf16* vp_ = WSB(WS_VTF) + ((size_t)bh * NCH + (c_)) * 16384 + (size_t)(wid * 4 * 64 + lane) * 8; \
        _Pragma("unroll") for (int s_ = 0; s_ < 4; ++s_) dst[s_] = *(const bf16x8*)(vp_ + s_ * 512); } while (0)
    f32x16 S[4]; S[0] = f32x16{}; S[1] = f32x16{}; S[2] = f32x16{}; S[3] = f32x16{};
    bf16x8 vf[4], vn[4];
    GLA_DMA(0, 0); GLA_VLOAD(vf, 0);
    for (int c = 0; c < NCH; ++c) {
        asm volatile("s_waitcnt vmcnt(0) lgkmcnt(0)\n\ts_barrier" ::: "memory");
        const int slot = c & 1; const LAS unsigned char* sb = lds + slot * S_SLOT;
        if (c + 1 < NCH) { GLA_DMA(c + 1, slot ^ 1); GLA_VLOAD(vn, c + 1); }
        u32x4 Sb[4][2];
#pragma unroll
        for (int T = 0; T < 4; ++T)
#pragma unroll
            for (int s = 0; s < 2; ++s)
#pragma unroll
                for (int i = 0; i < 4; ++i) Sb[T][s][i] = cvtpk(S[T][8 * s + 2 * i], S[T][8 * s + 2 * i + 1]);
        f32x16 o[2]; o[0] = f32x16{}; o[1] = f32x16{};
#pragma unroll
        for (int tt = 0; tt < 2; ++tt) {
#pragma unroll
            for (int T = 0; T < 4; ++T)
#pragma unroll
                for (int s = 0; s < 2; ++s)
                    o[tt] = __builtin_amdgcn_mfma_f32_32x32x16_bf16(*(const LAS bf16x8*)(sb + S_QIN + (tt * 8 + 2 * T + s) * 1024 + lane * 16), __builtin_bit_cast(bf16x8, Sb[T][s]), o[tt], 0, 0, 0);
#pragma unroll
            for (int s = 0; s < 4; ++s) if (tt == 1 || s < 2)
                o[tt] = __builtin_amdgcn_mfma_f32_32x32x16_bf16(*(const LAS bf16x8*)(sb + S_AM + (tt * 4 + s) * 1024 + lane * 16), vf[s], o[tt], 0, 0, 0);
        }
#pragma unroll
        for (int T = 0; T < 4; ++T) {
#pragma unroll
            for (int g = 0; g < 4; ++g) { const f32x4 e = *(const LAS f32x4*)(sb + S_EL + (32 * T + 8 * g + 4 * hi) * 4); S[T][4 * g] *= e.x; S[T][4 * g + 1] *= e.y; S[T][4 * g + 2] *= e.z; S[T][4 * g + 3] *= e.w; }
#pragma unroll
            for (int s = 0; s < 4; ++s) S[T] = __builtin_amdgcn_mfma_f32_32x32x16_bf16(*(const LAS bf16x8*)(sb + S_KDT + (T * 4 + s) * 1024 + lane * 16), vf[s], S[T], 0, 0, 0);
        }
        float* og = WSF(WS_OGRAW) + h * 256 + wid * 32 + r32;
#pragma unroll
        for (int tt = 0; tt < 2; ++tt)
#pragma unroll
            for (int r = 0; r < 16; ++r) { const int tok = tt * 32 + crow(r, hi); if (c > 0 || tok < NMETA) og[(size_t)chunk_row(b, c, tok) * 1024] = o[tt][r]; }
#pragma unroll
        for (int s = 0; s < 4; ++s) vf[s] = vn[s];
    }
    float* outp = a->out + O_GLAP + (size_t)bh * 128 * 256 + wid * 32 + r32;
#pragma unroll
    for (int T = 0; T < 4; ++T)
#pragma unroll
        for (int r = 0; r < 16; ++r) outp[(size_t)(32 * T + crow(r, hi)) * 256] = S[T][r];
    asm volatile("s_waitcnt vmcnt(0) lgkmcnt(0)\n\ts_barrier" ::: "memory");
#undef GLA_DMA
#undef GLA_VLOAD
}
}

__device__ __forceinline__ bool relaunder(ArgsP& a) { asm volatile("" : "+s"(a)); return true; }
constexpr int NPHASE = 22;
__global__ void __launch_bounds__(512, 2) fwd(Args a_unused) {
    ArgsP a = (ArgsP)__builtin_amdgcn_kernarg_segment_ptr();
    extern __shared__ __attribute__((aligned(16))) unsigned char lds_raw[];
    LAS unsigned char* lds = (LAS unsigned char*)lds_raw;
    Ctx c; c.wave = __builtin_amdgcn_readfirstlane((int)threadIdx.x >> 6); c.tid = 0; c.lane = 0;
    c.gw = blockIdx.x * 8 + c.wave; c.ngw = gridDim.x * 8; c.gwT = c.wave * gridDim.x + blockIdx.x;
    volatile LAS unsigned* MISC = (volatile LAS unsigned*)(lds + MISC_OFF);
    if (threadIdx.x < 32) MISC[threadIdx.x] = 0u;
    __syncthreads();
    XcdBarrier bar; bar.bar = (unsigned*)(a->ws + WS_CTL) + CW_BAR; bar.x = 0; bar.st = nullptr;
    const bool one = (a->ph_hi - a->ph_lo) > 1;
    if (one) bar = xcd_barrier_post((unsigned*)(a->ws + WS_CTL) + CW_BAR, MISC + 8);
    const int lo = a->ph_lo, hi = a->ph_hi;
#define IN(k) (lo <= (k) && (k) < hi && relaunder(a))
#define SEAM(k) do { if (IN(k) && IN((k) + 1)) xcd_barrier(bar, c.wave); } while (0)
    if (IN(0)) { p_prep(a, c, lds); } SEAM(0);
    if (IN(1)) { GEMM(WSB(WS_H), WSB(WS_WIN0), RP, NIN0, D, (EpiF32{WSF(WS_A1), NIN0})); } SEAM(1);
    if (IN(2)) { p_mla_mid(a, c); } SEAM(2);
    if (IN(3)) { GEMM(WSB(WS_CQN), WSB(WS_WUQ), RP, NUQ, QL, (EpiF32{WSF(WS_QRAW), NUQ}));
                 GEMM(WSB(WS_CKVN), WSB(WS_WUKV), RP, NUKV, KVL, (EpiBf16{WSB(WS_KNV), NUKV})); } SEAM(3);
    if (IN(4)) { p_q_post(a, c); p_qlat(a, c); } SEAM(4);
    if (IN(5)) {
#if USE_NAIVE_ATTN
        p_attn_prompt_naive<false>(a, c);
#else
        att::attn_phase(WSB(WS_QN), WSB(WS_QPE), WSB(WS_KNV), WSB(WS_KPE), WSB(WS_O), lds, c.wave);
        if (PROBE == 1) att::attn_phase(WSB(WS_QN), WSB(WS_QPE), WSB(WS_KNV), WSB(WS_KPE), WSB(WS_O), lds, c.wave);
        p_attn_prompt_naive<true>(a, c);
#endif
#if USE_NAIVE_DECODE
        p_attn_decode_naive(a, c);
#else
        dec::decode_phase(a, lds, c.wave);
        if (PROBE == 2) dec::decode_phase(a, lds, c.wave);
#endif
    } SEAM(5);
    if (IN(6)) {
#if USE_NAIVE_DECODE
        p_olat_up(a, c);
#else
        dec::combine_phase(a, c);
#endif
    } SEAM(6);
    if (IN(7)) { gemm_n1024_tail<D, 8>(WSB(WS_O), WSB(WS_WO0), WSF(WS_M), WSF(WS_MT), lds, c.wave); } SEAM(7);
    if (IN(8)) { p_post_res<false, 8>(a, c, IN_F(8), IN_F(9)); } SEAM(8);
    if (IN(9)) { GEMM(WSB(WS_H), WSB(WS_WUP), RP, FF, D, (EpiRelu2{WSB(WS_U), FF})); } SEAM(9);
    if (IN(10)) { gemm_n1024_tail<FF, 16>(WSB(WS_U), WSB(WS_WDN), WSF(WS_M), WSF(WS_MT), lds, c.wave); } SEAM(10);
    if (IN(11)) { p_post_res<false, 16>(a, c, IN_F(10), IN_F(7) + D); } SEAM(11);
    if (IN(12)) { GEMM(WSB(WS_H), WSB(WS_WGIN), RP, NGIN, D, (EpiGla{WSB(WS_QG), WSB(WS_KG), WSB(WS_VG), WSB(WS_RG), WSF(WS_GD)})); } SEAM(12);
    if (IN(13)) { p_gate(a, c);
#if !USE_NAIVE_GLA
        gla::prep_phase(a, lds, c.wave);
#endif
    } SEAM(13);
    if (IN(14)) {
#if !USE_NAIVE_GLA
        if ((int)blockIdx.x < NB * GH) gla::scan_bh(a, (int)blockIdx.x, lds, c.wave);
        if (PROBE == 3) { if ((int)blockIdx.x < NB * GH) gla::scan_bh(a, (int)blockIdx.x, lds, c.wave); }
#endif
        p_gla_naive(a, c); } SEAM(14);
    if (IN(15)) { p_gla_post(a, c); } SEAM(15);
    if (IN(16)) { gemm_n1024_tail<D, 8>(WSB(WS_OG), WSB(WS_WGO), WSF(WS_M), WSF(WS_MT), lds, c.wave); } SEAM(16);
    if (IN(17)) { p_post_res<false, 8>(a, c, IN_F(8) + D, IN_F(9) + D); } SEAM(17);
    if (IN(18)) { GEMM(WSB(WS_H), WSB(WS_WUP) + (size_t)FF * D, RP, FF, D, (EpiRelu2{WSB(WS_U), FF})); } SEAM(18);
    if (IN(19)) { gemm_n1024_tail<FF, 16>(WSB(WS_U), WSB(WS_WDN) + (size_t)D * FF, WSF(WS_M), WSF(WS_MT), lds, c.wave); } SEAM(19);
    if (IN(20)) { p_post_res<true, 16>(a, c, IN_F(10) + D, nullptr); }
#undef IN
#undef SEAM
}

extern "C" void kernel_launch(void* const* d_in, const int* in_sizes, int n_in, void* d_out, int out_size, void* d_ws, size_t ws_size, hipStream_t stream) {
    static int grid = 0;
    if (grid == 0) {
        if (n_in != 25 || out_size != (int)O_END || ws_size < WS_END) { fprintf(stderr, "kernel_launch: unexpected shapes n_in %d out %d ws %zu\n", n_in, out_size, ws_size); grid = -1; return; }
        int dev = 0, cus = 0, per_cu = 0;
        if (hipGetDevice(&dev) != hipSuccess || hipDeviceGetAttribute(&cus, hipDeviceAttributeMultiprocessorCount, dev) != hipSuccess) { grid = -1; return; }
        if (hipFuncSetAttribute((const void*)fwd, hipFuncAttributeMaxDynamicSharedMemorySize, LDS_BYTES) != hipSuccess) { fprintf(stderr, "kernel_launch: hipFuncSetAttribute failed\n"); grid = -1; return; }
        if (hipOccupancyMaxActiveBlocksPerMultiprocessor(&per_cu, (const void*)fwd, 512, LDS_BYTES) != hipSuccess || per_cu < 1) fprintf(stderr, "kernel_launch: occupancy query says %d\n", per_cu);
        (void)hipGetLastError();
        grid = cus;
    }
    if (grid < 0) return;
    if (hipMemsetAsync((char*)d_ws + WS_CTL, 0, CTL_ZERO_BYTES, stream) != hipSuccess) return;
    Args a{};
    for (int i = 0; i < 25; ++i) a.in[i] = d_in[i];
    a.out = (float*)d_out; a.ws = (unsigned char*)d_ws;
#if MK_ONE_LAUNCH
    a.ph_lo = 0; a.ph_hi = NPHASE;
    hipLaunchKernelGGL(fwd, dim3(grid), dim3(512), LDS_BYTES, stream, a);
#else
    for (int ph = 0; ph < NPHASE - 1; ++ph) { a.ph_lo = ph; a.ph_hi = ph + 1; hipLaunchKernelGGL(fwd, dim3(grid), dim3(512), LDS_BYTES, stream, a); }
#endif
}
```

```cpp
#include <hip/hip_runtime.h>
#include <cstdio>
#include <cstdint>
#include <cmath>

#ifndef MK_ONE_LAUNCH
#define MK_ONE_LAUNCH 1
#endif

constexpr int D = 1024, NB = 4, SEQ = 4096, NMETA = 16, TP = SEQ + NMETA;
constexpr int DB = 128, DS = 4, PAST = 8192, PAGE = 128, NPAGES = 64;
constexpr int NH = 16, QL = 256, KVL = 256, NOPE = 64, ROPE = 32, VH = 64;
constexpr int GH = 4, GDK = 128, GDV = 256, GR = 16;
constexpr int FF = 4096;
constexpr int RMAIN = NB * SEQ;
constexpr int RMETA0 = RMAIN;
constexpr int RSAMP0 = RMAIN + NB * NMETA;
constexpr int R = RSAMP0 + DB * DS;
constexpr int RPROMPT = RSAMP0;
constexpr int RP = 17152;
constexpr int NIN0 = 768, NUQ = 1536, NUKV = 2048, NGIN = 3328, NGIN_REAL = 3088;
constexpr float EPS = 1e-6f;
constexpr float MLA_SCALE = 0.10206207261596575f;
constexpr float GLA_SCALE = 0.08838834764831845f;
constexpr float QSCALE = 0.10206207261596575f * 1.4426950408889634f;

constexpr size_t O_YP = 0, O_YS = 16777216, O_CKVP = 17301504, O_KPEP = 21512192, O_CKVS = 22038528, O_KPES = 22169600, O_GLAP = 22185984, O_GLAS = 22710272, O_END = 39487488;

constexpr size_t MiB = 1u << 20;
constexpr size_t WS_CTL = 0, CTL_ZERO_BYTES = 1 * MiB;
constexpr size_t WS_WIN0 = 2 * MiB, WS_WUQ = 4 * MiB, WS_WUKV = 5 * MiB, WS_WO0 = 6 * MiB, WS_WUP = 8 * MiB, WS_WDN = 24 * MiB, WS_WGIN = 40 * MiB, WS_WGO = 47 * MiB;
constexpr size_t WS_X = 64 * MiB, WS_H = 132 * MiB, WS_M = 166 * MiB, WS_U = 234 * MiB, WS_A1 = 368 * MiB, WS_CQN = 419 * MiB, WS_CKVN = 428 * MiB, WS_KPE = 437 * MiB;
constexpr size_t WS_QRAW = 440 * MiB, WS_KNV = 541 * MiB, WS_QN = 608 * MiB, WS_QPE = 642 * MiB, WS_QLAT = 659 * MiB, WS_OLAT = 663 * MiB, WS_O = 671 * MiB;
constexpr size_t WS_QG = 705 * MiB, WS_KG = 722 * MiB, WS_VG = 739 * MiB, WS_RG = 773 * MiB, WS_GD = 807 * MiB, WS_LA = 809 * MiB, WS_EA = 843 * MiB, WS_OGRAW = 877 * MiB, WS_OG = 944 * MiB;
constexpr size_t WS_OPART = 978 * MiB, WS_MLP = 1012 * MiB;
constexpr size_t WS_QINF = 1014 * MiB, WS_KDTF = 1032 * MiB, WS_AMF = 1050 * MiB, WS_VTF = 1060 * MiB, WS_ELF = 1094 * MiB;
constexpr size_t WS_WUQL = 50 * MiB;
constexpr size_t WS_ROPE = 53 * MiB;
constexpr size_t WS_MT = 1096 * MiB;
constexpr size_t WS_END = 1144 * MiB;
constexpr int CW_BAR = 4096, CW_DEC = 8192;
namespace gla { constexpr int NSP = 8, NCW = 8 / NSP; }

constexpr int LDS_BYTES = 147456;
constexpr int MISC_OFF = LDS_BYTES - 256;

#define GAS __attribute__((address_space(1)))
#define LAS __attribute__((address_space(3)))
typedef unsigned short bf16;
typedef float f32x4 __attribute__((ext_vector_type(4)));
typedef unsigned u32x4 __attribute__((ext_vector_type(4)));
typedef unsigned u32x2 __attribute__((ext_vector_type(2)));
#define LDS_WAIT() asm volatile("s_waitcnt lgkmcnt(0)" ::: "memory")

__device__ __forceinline__ unsigned f2bf(float f) { unsigned u = __builtin_bit_cast(unsigned, f); return (u + 0x7fffu + ((u >> 16) & 1u)) >> 16; }
__device__ __forceinline__ unsigned pk2(float lo, float hi) { return f2bf(lo) | (f2bf(hi) << 16); }
__device__ __forceinline__ float bflo(unsigned u) { return __builtin_bit_cast(float, u << 16); }
__device__ __forceinline__ float bfhi(unsigned u) { return __builtin_bit_cast(float, u & 0xffff0000u); }
__device__ __forceinline__ float bf2f(bf16 v) { return __builtin_bit_cast(float, (unsigned)v << 16); }
__device__ __forceinline__ float wave_sum(float v) {
#pragma unroll
    for (int o = 1; o < 64; o <<= 1) v += __shfl_xor(v, o);
    return v;
}
__device__ __forceinline__ int wave_max_i(int v) {
#pragma unroll
    for (int o = 1; o < 64; o <<= 1) { int t = __shfl_xor(v, o); v = t > v ? t : v; }
    return v;
}
__device__ __forceinline__ int fresh_tid(int wave) { int t = wave * 64 + (int)__builtin_amdgcn_mbcnt_hi(~0u, __builtin_amdgcn_mbcnt_lo(~0u, 0u)); asm volatile("" : "+v"(t)); return t; }
__device__ __forceinline__ float rdlane(float v, int l) { return __builtin_bit_cast(float, __builtin_amdgcn_readlane(__builtin_bit_cast(int, v), l)); }

#define XB_TMO      128
#define XB_XCNT(j)  (256  + 64 * (j))
#define XB_XSUB(j)  (1280 + 64 * (j))
#define XB_XGEN(j)  (2304 + 64 * (j))
#define XB_TOP      3328
#define XB_TOPGEN   3392
#define XCD_BAR_WORDS 3456
#define XB_SPIN_CAP (1u << 18)
__device__ __forceinline__ unsigned xb_ld(unsigned* p)              { return __hip_atomic_load(p, __ATOMIC_RELAXED, __HIP_MEMORY_SCOPE_AGENT); }
__device__ __forceinline__ unsigned xb_add(unsigned* p, unsigned v) { return __hip_atomic_fetch_add(p, v, __ATOMIC_RELAXED, __HIP_MEMORY_SCOPE_AGENT); }
__device__ __forceinline__ unsigned xb_xcc_id() { return (unsigned)__builtin_amdgcn_s_getreg((3 << 11) | 20) & 0xFu; }
#define XB_SPIN(cond, bar) do { unsigned _sp = 0; while (cond) { __builtin_amdgcn_s_sleep(1); \
    if ((++_sp & 255u) == 0u) { if (xb_ld(&(bar)[XB_TMO])) break; if (_sp > XB_SPIN_CAP) { atomicAdd(&(bar)[XB_TMO], 1u); break; } } } } while (0)
struct XcdBarrier { unsigned* bar; unsigned x; volatile LAS unsigned* st; };
__device__ __forceinline__ XcdBarrier xcd_barrier_post(unsigned* bar, volatile LAS unsigned* st) {
    XcdBarrier b; b.bar = bar; b.x = xb_xcc_id(); b.st = st;
    if (threadIdx.x == 0) (void)xb_add(&bar[XB_XCNT(b.x)], 1u);
    return b;
}
__device__ __forceinline__ void xcd_barrier_complete(unsigned* bar, unsigned x, unsigned& nloc, unsigned& nx) {
    const unsigned G = gridDim.x * gridDim.y * gridDim.z;
    unsigned sum, cnt, mine, sp = 0u;
    for (;;) {
        sum = 0u; cnt = 0u; mine = 0u;
#pragma unroll
        for (unsigned j = 0; j < 16; ++j) { const unsigned c = xb_ld(&bar[XB_XCNT(j)]); sum += c; cnt += (c > 0u) ? 1u : 0u; mine = (j == x) ? c : mine; }
        if (sum == G) break;
        __builtin_amdgcn_s_sleep(1);
        if ((++sp & 255u) == 0u) { if (xb_ld(&bar[XB_TMO])) break; if (sp > XB_SPIN_CAP) { atomicAdd(&bar[XB_TMO], 1u); break; } }
    }
    nloc = mine > 0u ? mine : 1u; nx = cnt > 0u ? cnt : 1u;
}
__device__ __forceinline__ void xcd_barrier(const XcdBarrier& b, int wave_id) {
    asm volatile("s_waitcnt vmcnt(0)" ::: "memory");
    __syncthreads();
    if (fresh_tid(wave_id) == 0) {
        unsigned* bar = b.bar;
        __builtin_amdgcn_s_waitcnt(0);
        unsigned nloc = b.st[0], nx = b.st[1];
        if (nloc == 0u) { xcd_barrier_complete(bar, b.x, nloc, nx); b.st[0] = nloc; b.st[1] = nx; }
        const unsigned old = xb_add(&bar[XB_XSUB(b.x)], 1u);
        const unsigned gen = old / nloc;
        if (old + 1u == (gen + 1u) * nloc) {
            __builtin_amdgcn_fence(__ATOMIC_RELEASE, "agent");
            asm volatile("s_waitcnt vmcnt(0)" ::: "memory");
            const unsigned og = xb_add(&bar[XB_TOP], 1u);
            const unsigned tg = og / nx;
            if (og + 1u == (tg + 1u) * nx) xb_add(&bar[XB_TOPGEN], 1u);
            else XB_SPIN(xb_ld(&bar[XB_TOPGEN]) == tg, bar);
            __builtin_amdgcn_fence(__ATOMIC_ACQUIRE, "agent");
            xb_add(&bar[XB_XGEN(b.x)], 1u);
            asm volatile("s_waitcnt vmcnt(0)" ::: "memory");
        } else {
            XB_SPIN(xb_ld(&bar[XB_XGEN(b.x)]) == gen, bar);
            __builtin_amdgcn_fence(__ATOMIC_ACQUIRE, "agent");
            asm volatile("s_waitcnt vmcnt(0)" ::: "memory");
        }
    }
    __syncthreads();
}

namespace pg8 {
#define PG8_LAS __attribute__((address_space(3)))
typedef unsigned short bf16_t;
typedef short bf16x8 __attribute__((ext_vector_type(8)));
typedef float f32x4 __attribute__((ext_vector_type(4)));
typedef unsigned u32x4 __attribute__((ext_vector_type(4)));
constexpr int BM = 256, BK = 64, HALF = 128, HTB = HALF * BK * 2  , STAGE_BYTES = 8 * HTB, NXCD = 8, WGM = 8;

__host__ __device__ __forceinline__ int lds_byte(int r, int c) { const int st = (r >> 4) * 2 + (c >> 5), rr = r & 15, cc = c & 31, ob = rr * 64 + cc * 2; return st * 1024 + (ob ^ (((ob >> 9) & 1) << 5)); }
__host__ __device__ __forceinline__ void stage_rc(int b, int& R, int& C) { const int st = b / 1024, sb = b % 1024, swz = sb ^ (((sb >> 9) & 1) << 5); R = (st >> 1) * 16 + swz / 64; C = (st & 1) * 32 + (swz % 64) / 2; }
__host__ __device__ __forceinline__ int perm32(int rho) { const int n = rho >> 4, i = rho & 15; return 8 * (i >> 2) + 4 * n + (i & 3); }

struct Unit { int pm, pn, k0, prob; long aoff, boff; };
struct Gemm { const bf16_t* A; const bf16_t* Bt; int M, N, K, ld; };

struct StaticOrder {
    int nM, nN, nwg, G, c;
    __host__ __device__ void init(int M, int N, int G_, int c_) { nM = M / BM; nN = N / BM; nwg = nM * nN; G = G_; c = c_; }
    __host__ __device__ bool next(int i, Unit& u) const {
        const long L = (long)i * G + c; if (L >= nwg) return false;
        int wgid = (int)L; { const int q = nwg / NXCD, r = nwg % NXCD, xcd = wgid % NXCD, off = wgid / NXCD; wgid = (xcd < r ? xcd * (q + 1) : r * (q + 1) + (xcd - r) * q) + off; }
        const int nig = WGM * nN, gid = wgid / nig, fm = gid * WGM, gsz = (nM - fm) < WGM ? (nM - fm) : WGM;
        u.pm = fm + ((wgid % nig) % gsz); u.pn = (wgid % nig) / gsz; u.k0 = 0; u.prob = 0; u.aoff = 0; u.boff = 0; return true;
    }
    __device__ __forceinline__ void a_ready(const Unit&) const {}
    __device__ __forceinline__ void done(const Unit&) const {}
};

__device__ __forceinline__ unsigned cvt_pk_bf16(float lo, float hi) { unsigned r; asm volatile("v_cvt_pk_bf16_f32 %0, %1, %2" : "=v"(r) : "v"(lo), "v"(hi)); return r; }
template <class Epi, class Sched, bool ALIGN_EPI = false, bool SP2 = false>
__device__ __forceinline__ void gemm_phase(PG8_LAS unsigned char* lds, const Gemm g, const Sched& S, const Epi& E, int wave_id) {
    const int tid = fresh_tid(wave_id), wid = wave_id, lane = tid & 63, wr = wid >> 2, wc = wid & 3, fr = lane & 15, fq = lane >> 4;
    const int K = g.K, nt = K / BK;
    unsigned voffA[2], voffB[2];
#pragma unroll
    for (int i = 0; i < 2; ++i) { int R, C; stage_rc(tid * 16 + i * 8192, R, C); const int Rb = Epi::PERM ? ((R & ~31) + perm32(R & 31)) : R;
        voffA[i] = (unsigned)(R * g.ld + C) * 2u; voffB[i] = (unsigned)(Rb * g.ld + C) * 2u; }
    const size_t kstep = (size_t)(BK * 2);
    const size_t hstep = (size_t)HALF * g.ld * 2;
    const size_t tstep = 2 * hstep;
    const unsigned ldsw = (unsigned)wid * 1024u;
    const int aoff = lds_byte(wr * 64 + fr, fq * 8), boff = lds_byte(wc * 32 + fr, fq * 8);
#define PG8_SA(b, h) (((b) * 2 + (h)) * HTB)
#define PG8_SB(b, h) ((4 + (b) * 2 + (h)) * HTB)
#define PG8_STAGE(bufoff, gbase, voff) do { _Pragma("unroll") for (int _i = 0; _i < 2; ++_i) \
        __builtin_amdgcn_global_load_lds((const unsigned*)((const char*)(gbase) + (voff)[_i]), (PG8_LAS unsigned*)(lds + (bufoff) + ldsw + _i * 8192), 16, 0, 0); } while (0)
#define PG8_LDA(dst, b, h) do { _Pragma("unroll") for (int m = 0; m < 4; ++m) _Pragma("unroll") for (int k = 0; k < 2; ++k) dst[m][k] = *(const PG8_LAS bf16x8*)(lds + PG8_SA(b, h) + aoff + m * 2048 + k * 1024); } while (0)
#define PG8_LDB(dst, b, h) do { _Pragma("unroll") for (int n = 0; n < 2; ++n) _Pragma("unroll") for (int k = 0; k < 2; ++k) dst[n][k] = *(const PG8_LAS bf16x8*)(lds + PG8_SB(b, h) + boff + n * 2048 + k * 1024); } while (0)
#define PG8_MMA(ai, bj, At, Bt) do { __builtin_amdgcn_s_setprio(1); _Pragma("unroll") for (int m = 0; m < 4; ++m) _Pragma("unroll") for (int n = 0; n < 2; ++n) _Pragma("unroll") for (int k = 0; k < 2; ++k) \
        acc[ai][bj][m][n] = __builtin_amdgcn_mfma_f32_16x16x32_bf16(Bt[n][k], At[m][k], acc[ai][bj][m][n], 0, 0, 0); __builtin_amdgcn_s_setprio(0); } while (0)
#define PG8_WAIT_V(n) asm volatile("s_waitcnt vmcnt(" #n ")" ::: "memory")
#define PG8_WAIT_L(n) asm volatile("s_waitcnt lgkmcnt(" #n ")" ::: "memory")
#define PG8_BAR __builtin_amdgcn_s_barrier()
#define PG8_SCHED __builtin_amdgcn_sched_barrier(0)
    Unit cur, nxt; int ui = 0;
    if (!S.next(0, cur)) return;
    f32x4 acc[2][2][4][2];
#pragma unroll
    for (int a = 0; a < 2; ++a)
#pragma unroll
        for (int b = 0; b < 2; ++b)
#pragma unroll
            for (int m = 0; m < 4; ++m)
#pragma unroll
                for (int n = 0; n < 2; ++n) acc[a][b][m][n] = (f32x4){0.f, 0.f, 0.f, 0.f};
    bf16x8 At[4][2], B0[2][2], B1[2][2];
    const char* cA = (const char*)g.A + (size_t)cur.pm * tstep + (size_t)cur.k0 * 2 + cur.aoff; const char* cB = (const char*)g.Bt + (size_t)cur.pn * tstep + (size_t)cur.k0 * 2 + cur.boff;
    S.a_ready(cur);
    if constexpr (SP2) {
        PG8_STAGE(PG8_SB(0, 0), cB, voffB); PG8_STAGE(PG8_SB(0, 1), cB + hstep, voffB); PG8_STAGE(PG8_SA(0, 0), cA, voffA); PG8_STAGE(PG8_SA(0, 1), cA + hstep, voffA);
        if (wr == 1) PG8_BAR;
        PG8_WAIT_V(2); PG8_BAR;
        PG8_STAGE(PG8_SB(1, 0), cB + kstep, voffB); PG8_STAGE(PG8_SA(1, 0), cA + kstep, voffA); PG8_STAGE(PG8_SB(1, 1), cB + hstep + kstep, voffB);
        PG8_WAIT_V(6); PG8_BAR;
    } else {
        PG8_STAGE(PG8_SB(0, 0), cB, voffB); PG8_STAGE(PG8_SA(0, 0), cA, voffA); PG8_STAGE(PG8_SB(0, 1), cB + hstep, voffB); PG8_STAGE(PG8_SA(0, 1), cA + hstep, voffA);
        if (wr == 1) PG8_BAR;
        PG8_WAIT_V(4); PG8_BAR;
        PG8_STAGE(PG8_SB(1, 0), cB + kstep, voffB); PG8_STAGE(PG8_SA(1, 0), cA + kstep, voffA); PG8_STAGE(PG8_SB(1, 1), cB + hstep + kstep, voffB);
        PG8_WAIT_V(6); PG8_BAR;
    }
    for (;;) {
        const bool has_next = S.next(ui + 1, nxt);
        const char* nA = has_next ? (const char*)g.A + (size_t)nxt.pm * tstep + (size_t)nxt.k0 * 2 + nxt.aoff : cA; const char* nB = has_next ? (const char*)g.Bt + (size_t)nxt.pn * tstep + (size_t)nxt.k0 * 2 + nxt.boff : cB;
        for (int t = 0; t < nt; t += 2) {
            const bool last = (t == nt - 2);
            const char* a1 = cA + (size_t)(t + 1) * kstep;
            const char* a2 = last ? nA : cA + (size_t)(t + 2) * kstep; const char* b2 = last ? nB : cB + (size_t)(t + 2) * kstep;
            const char* a3 = a2 + kstep; const char* b3 = b2 + kstep;
            if (last && has_next) S.a_ready(nxt);
            if constexpr (SP2) {
            PG8_LDB(B0, 0, 0); PG8_LDB(B1, 0, 1); PG8_SCHED; PG8_LDA(At, 0, 0); PG8_STAGE(PG8_SA(1, 1), a1 + hstep, voffA);
            PG8_WAIT_V(8); PG8_WAIT_L(0); PG8_BAR; PG8_MMA(0, 0, At, B0); PG8_MMA(0, 1, At, B1); PG8_BAR; PG8_SCHED;
            PG8_LDA(At, 0, 1); PG8_STAGE(PG8_SB(0, 0), b2, voffB); PG8_STAGE(PG8_SB(0, 1), b2 + hstep, voffB); PG8_STAGE(PG8_SA(0, 0), a2, voffA);
            PG8_WAIT_V(8); PG8_WAIT_L(0); PG8_BAR; PG8_MMA(1, 0, At, B0); PG8_MMA(1, 1, At, B1); PG8_BAR; PG8_SCHED;
            PG8_LDB(B0, 1, 0); PG8_LDB(B1, 1, 1); PG8_SCHED; PG8_LDA(At, 1, 0); PG8_STAGE(PG8_SA(0, 1), a2 + hstep, voffA);
            PG8_WAIT_V(8); PG8_WAIT_L(0); PG8_BAR; PG8_MMA(0, 0, At, B0); PG8_MMA(0, 1, At, B1); PG8_BAR; PG8_SCHED;
            PG8_LDA(At, 1, 1); PG8_STAGE(PG8_SB(1, 0), b3, voffB); PG8_STAGE(PG8_SB(1, 1), b3 + hstep, voffB); PG8_STAGE(PG8_SA(1, 0), a3, voffA);
            PG8_WAIT_V(8); PG8_WAIT_L(0); PG8_BAR; PG8_MMA(1, 0, At, B0); PG8_MMA(1, 1, At, B1); PG8_BAR; PG8_SCHED;
            } else {
            PG8_LDB(B0, 0, 0); PG8_SCHED; PG8_LDA(At, 0, 0); PG8_STAGE(PG8_SA(1, 1), a1 + hstep, voffA);
            PG8_WAIT_L(8); PG8_BAR; PG8_WAIT_L(0); PG8_MMA(0, 0, At, B0); PG8_BAR; PG8_SCHED;
            PG8_LDB(B1, 0, 1); PG8_STAGE(PG8_SB(0, 0), b2, voffB);
            PG8_BAR; PG8_WAIT_L(0); PG8_MMA(0, 1, At, B1); PG8_BAR;
            PG8_LDA(At, 0, 1); PG8_STAGE(PG8_SA(0, 0), a2, voffA);
            PG8_BAR; PG8_WAIT_L(0); PG8_MMA(1, 0, At, B0); PG8_BAR; PG8_SCHED;
            PG8_STAGE(PG8_SB(0, 1), b2 + hstep, voffB);
            PG8_WAIT_V(6); PG8_BAR; PG8_MMA(1, 1, At, B1); PG8_BAR;
            PG8_LDB(B0, 1, 0); PG8_SCHED; PG8_LDA(At, 1, 0); PG8_STAGE(PG8_SA(0, 1), a2 + hstep, voffA);
            PG8_WAIT_L(8); PG8_BAR; PG8_WAIT_L(0); PG8_MMA(0, 0, At, B0); PG8_BAR; PG8_SCHED;
            PG8_LDB(B1, 1, 1); PG8_STAGE(PG8_SB(1, 0), b3, voffB);
            PG8_BAR; PG8_WAIT_L(0); PG8_MMA(0, 1, At, B1); PG8_BAR;
            PG8_LDA(At, 1, 1); PG8_STAGE(PG8_SA(1, 0), a3, voffA);
            PG8_BAR; PG8_WAIT_L(0); PG8_MMA(1, 0, At, B0); PG8_BAR; PG8_SCHED;
            PG8_STAGE(PG8_SB(1, 1), b3 + hstep, voffB);
            PG8_WAIT_V(6); PG8_BAR; PG8_MMA(1, 1, At, B1); PG8_BAR;
            }
        }
        if constexpr (ALIGN_EPI) { if (wr == 0) PG8_BAR; }
        if constexpr (!Epi::AFTER_DRAIN) { E(acc, cur, wr, wc, fr, fq); S.done(cur); }
        if (!has_next) break;
#pragma unroll
        for (int a = 0; a < 2; ++a)
#pragma unroll
            for (int b = 0; b < 2; ++b)
#pragma unroll
                for (int m = 0; m < 4; ++m)
#pragma unroll
                    for (int n = 0; n < 2; ++n) acc[a][b][m][n] = (f32x4){0.f, 0.f, 0.f, 0.f};
        cur = nxt; cA = nA; cB = nB; ++ui;
        if constexpr (ALIGN_EPI) { if (wr == 1) PG8_BAR; }
    }
    PG8_WAIT_V(0);
    if constexpr (!ALIGN_EPI) { if (wr == 0) PG8_BAR; }
    PG8_BAR;
    if constexpr (Epi::AFTER_DRAIN) { E.fused(acc, cur, wr, wc, fr, fq, lds, wid, lane); S.done(cur); }
#undef PG8_SA
#undef PG8_SB
#undef PG8_STAGE
#undef PG8_LDA
#undef PG8_LDB
#undef PG8_MMA
#undef PG8_WAIT_V
#undef PG8_WAIT_L
#undef PG8_BAR
#undef PG8_SCHED
}
}

struct Args { const void* in[25]; float* out; unsigned char* ws; int ph_lo, ph_hi; };
typedef const __attribute__((address_space(4))) Args* ArgsP;
#define IN_F(k) ((const float*)a->in[k])
#define WSB(off) ((bf16*)(a->ws + (off)))
#define WSF(off) ((float*)(a->ws + (off)))

struct Ctx { int tid, lane, wave, gw, ngw, gwT; };
__device__ __forceinline__ Ctx refresh(const Ctx& c0) { Ctx c = c0; c.tid = fresh_tid(c0.wave); c.lane = c.tid & 63; return c; }

__device__ __forceinline__ int row_pos(int r) { return r < RMAIN ? (r & 4095) + NMETA : (r < RSAMP0 ? ((r - RMAIN) & 15) : PAST + ((r - RSAMP0) & 3)); }
__device__ __forceinline__ float rope_inv(int j) { return exp2f(-(float)j * (13.287712379549449f / 16.0f)); }
__device__ __forceinline__ void rope_cs(int pos, int j, float& c, float& s) {
    const float ang = (float)pos * rope_inv(j);
    const double x = (double)ang; const double n = rint(x * 0.15915494309189535); const float r = (float)(x - n * 6.283185307179586);
    c = cosf(r); s = sinf(r);
}

struct RmId { int off; __device__ __forceinline__ int operator()(int n) const { return off + n; } };
struct RmUq { __device__ __forceinline__ int operator()(int n) const { const int h = n / 96, j = n % 96; if (j < 64) return h * 64 + j; const int jj = j - 64; return 1024 + h * 32 + (jj < 16 ? 2 * jj : 2 * (jj - 16) + 1); } };
template <class RM>
__device__ __forceinline__ void tr_item(const float* W, int ldw, int nblk, int item, bf16* WT, int ldt, RM rm, LAS float* scr, int lane) {
    const int kb = item / nblk, nb = item % nblk, k0 = 64 * kb, n0 = 32 * nb;
#pragma unroll
    for (int i = 0; i < 8; ++i) { const int kk = 8 * i + (lane >> 3), c4 = (lane & 7) * 4; const f32x4 v = *(const f32x4*)(W + (size_t)(k0 + kk) * ldw + n0 + c4);
        scr[kk * 33 + c4] = v.x; scr[kk * 33 + c4 + 1] = v.y; scr[kk * 33 + c4 + 2] = v.z; scr[kk * 33 + c4 + 3] = v.w; }
    LDS_WAIT();
    const int c = lane & 7;
#pragma unroll
    for (int j = 0; j < 4; ++j) { const int n = (lane >> 3) + 8 * j; const LAS float* s = scr + (8 * c) * 33 + n;
        u32x4 o; o.x = pk2(s[0 * 33], s[1 * 33]); o.y = pk2(s[2 * 33], s[3 * 33]); o.z = pk2(s[4 * 33], s[5 * 33]); o.w = pk2(s[6 * 33], s[7 * 33]);
        *(u32x4*)(WT + (size_t)rm(n0 + n) * ldt + k0 + 8 * c) = o; }
    LDS_WAIT();
}
__device__ __forceinline__ void norm_row_bf16(const float* xrow, const float* g, float* xcopy, bf16* hrow, int lane) {
    f32x4 v[4]; float s = 0.f;
#pragma unroll
    for (int j = 0; j < 4; ++j) { v[j] = *(const f32x4*)(xrow + 4 * lane + 256 * j); s += (v[j].x * v[j].x + v[j].y * v[j].y) + (v[j].z * v[j].z + v[j].w * v[j].w); }
    const float rs = 1.0f / sqrtf(wave_sum(s) * (1.f / D) + EPS);
#pragma unroll
    for (int j = 0; j < 4; ++j) { const f32x4 gg = *(const f32x4*)(g + 4 * lane + 256 * j);
        if (xcopy) *(f32x4*)(xcopy + 4 * lane + 256 * j) = v[j];
        u32x2 o; o.x = pk2(v[j].x * rs * gg.x, v[j].y * rs * gg.y); o.y = pk2(v[j].z * rs * gg.z, v[j].w * rs * gg.w);
        *(u32x2*)(hrow + 4 * lane + 256 * j) = o; }
}
__device__ __forceinline__ void p_prep(ArgsP a, const Ctx& c0, LAS unsigned char* lds) {
    const Ctx c = refresh(c0);
    LAS float* scr = (LAS float*)(lds + c.wave * 16384);
    constexpr int I0 = 16 * 17, I1 = 4 * 48, I2 = 4 * 32, I3 = 4 * 32, I4 = 16 * 32, I5 = 16 * 96, I6 = 16 * 32, I7 = 16 * 128, I8 = 16 * 128, I9 = 64 * 32, I10 = 64 * 32;
    constexpr int NIT = I0 + I1 + I2 + I3 + I4 + I5 + I6 + I7 + I8 + I9 + I10;
    for (int it = c.gw; it < NIT; it += c.ngw) {
        int r = it;
        if (r < I0) { tr_item(IN_F(11), 544, 17, r, WSB(WS_WIN0), 1024, RmId{0}, scr, c.lane); continue; } r -= I0;
        if (r < I1) { tr_item(IN_F(13), 1536, 48, r, WSB(WS_WUQ), 256, RmUq{}, scr, c.lane); continue; } r -= I1;
        if (r < I2) { tr_item(IN_F(15), 1024, 32, r, WSB(WS_WUKV), 256, RmId{0}, scr, c.lane); continue; } r -= I2;
        if (r < I3) { tr_item(IN_F(16), 1024, 32, r, WSB(WS_WUKV), 256, RmId{1024}, scr, c.lane); continue; } r -= I3;
        if (r < I4) { tr_item(IN_F(17), 1024, 32, r, WSB(WS_WO0), 1024, RmId{0}, scr, c.lane); continue; } r -= I4;
        if (r < I5) { tr_item(IN_F(18), 3088, 96, r, WSB(WS_WGIN), 1024, RmId{0}, scr, c.lane); continue; } r -= I5;
        if (r < I6) { tr_item(IN_F(22), 1024, 32, r, WSB(WS_WGO), 1024, RmId{0}, scr, c.lane); continue; } r -= I6;
        if (r < I7) { tr_item(IN_F(23), 4096, 128, r, WSB(WS_WUP), 1024, RmId{0}, scr, c.lane); continue; } r -= I7;
        if (r < I8) { tr_item(IN_F(23) + (size_t)1024 * 4096, 4096, 128, r, WSB(WS_WUP) + (size_t)4096 * 1024, 1024, RmId{0}, scr, c.lane); continue; } r -= I8;
        if (r < I9) { tr_item(IN_F(24), 1024, 32, r, WSB(WS_WDN), 4096, RmId{0}, scr, c.lane); continue; } r -= I9;
        tr_item(IN_F(24) + (size_t)4096 * 1024, 1024, 32, r, WSB(WS_WDN) + (size_t)1024 * 4096, 4096, RmId{0}, scr, c.lane);
    }
    const int gt = c.gw * 64 + c.lane, ngt = c.ngw * 64;
    for (int i = gt; i < (NIN0 - 544) * 1024 / 2; i += ngt) ((unsigned*)(WSB(WS_WIN0) + (size_t)544 * 1024))[i] = 0u;
    for (int i = gt; i < (NGIN - NGIN_REAL) * 1024 / 2; i += ngt) ((unsigned*)(WSB(WS_WGIN) + (size_t)NGIN_REAL * 1024))[i] = 0u;
    for (int i = gt; i < 16 * 1024; i += ngt) { const int n = i >> 10, k = i & 1023; WSB(WS_WGIN)[(size_t)(3072 + n) * 1024 + k] = (bf16)f2bf(IN_F(18)[(size_t)k * 3088 + 3072 + n]); }
    for (int i = c.gw * 64 + c.lane; i < R * 16; i += c.ngw * 64) { const int r = i >> 4, j = i & 15; float cs, sn; rope_cs(row_pos(r), j, cs, sn); WSF(WS_ROPE)[(size_t)r * 32 + j] = cs; WSF(WS_ROPE)[(size_t)r * 32 + 16 + j] = sn; }
    {
        const float* xp = IN_F(0); const float* xm = IN_F(6); const float* xsm = IN_F(1); float* X = WSF(WS_X); bf16* H = WSB(WS_H);
        f32x4 gg[4];
#pragma unroll
        for (int j = 0; j < 4; ++j) gg[j] = *(const f32x4*)(IN_F(7) + 4 * c.lane + 256 * j);
        constexpr int NR = 4;
        for (int r0 = c.gw; r0 < R; r0 += NR * c.ngw) {
            f32x4 v[NR][4]; float s[NR];
#pragma unroll
            for (int q = 0; q < NR; ++q) { const int r = r0 + q * c.ngw < R ? r0 + q * c.ngw : r0;
                const float* xs = r < RMAIN ? xp + (size_t)r * D : (r < RSAMP0 ? xm + (size_t)((r - RMAIN) & 15) * D : xsm + (size_t)(r - RSAMP0) * D);
                s[q] = 0.f;
#pragma unroll
                for (int j = 0; j < 4; ++j) { v[q][j] = *(const f32x4*)(xs + 4 * c.lane + 256 * j); s[q] += (v[q][j].x * v[q][j].x + v[q][j].y * v[q][j].y) + (v[q][j].z * v[q][j].z + v[q][j].w * v[q][j].w); } }
#pragma unroll
            for (int sh = 1; sh < 64; sh <<= 1) {
#pragma unroll
                for (int q = 0; q < NR; ++q) s[q] += __shfl_xor(s[q], sh); }
#pragma unroll
            for (int q = 0; q < NR; ++q) { const int r = r0 + q * c.ngw < R ? r0 + q * c.ngw : r0; const float rs = 1.0f / sqrtf(s[q] * (1.f / D) + EPS);
#pragma unroll
                for (int j = 0; j < 4; ++j) { if (r >= RMAIN) *(f32x4*)(X + (size_t)r * D + 4 * c.lane + 256 * j) = v[q][j];
                    u32x2 o; o.x = pk2(v[q][j].x * rs * gg[j].x, v[q][j].y * rs * gg[j].y); o.y = pk2(v[q][j].z * rs * gg[j].z, v[q][j].w * rs * gg[j].w);
                    *(u32x2*)(H + (size_t)r * D + 4 * c.lane + 256 * j) = o; } }
        }
    }
}

struct EpiF32 { float* C; int ldc; __device__ __forceinline__ void store4(int row, int col, f32x4 v) const { *(f32x4*)(C + (size_t)row * ldc + col) = v; } };
struct EpiBf16 { bf16* C; int ldc;
    __device__ __forceinline__ void store8(int row, int col, f32x4 a, f32x4 b) const { u32x4 o; o.x = pk2(a.x, a.y); o.y = pk2(a.z, a.w); o.z = pk2(b.x, b.y); o.w = pk2(b.z, b.w); *(u32x4*)(C + (size_t)row * ldc + col) = o; }
    __device__ __forceinline__ void store4(int row, int col, f32x4 v) const { u32x2 o; o.x = pk2(v.x, v.y); o.y = pk2(v.z, v.w); *(u32x2*)(C + (size_t)row * ldc + col) = o; } };
struct EpiRelu2 { bf16* C; int ldc;
    __device__ __forceinline__ void store8(int row, int col, f32x4 a, f32x4 b) const {
        f32x4 r; r.x = fmaxf(a.x, 0.f); r.y = fmaxf(a.y, 0.f); r.z = fmaxf(a.z, 0.f); r.w = fmaxf(a.w, 0.f); r = r * r;
        f32x4 s; s.x = fmaxf(b.x, 0.f); s.y = fmaxf(b.y, 0.f); s.z = fmaxf(b.z, 0.f); s.w = fmaxf(b.w, 0.f); s = s * s;
        u32x4 o; o.x = pk2(r.x, r.y); o.y = pk2(r.z, r.w); o.z = pk2(s.x, s.y); o.w = pk2(s.z, s.w); *(u32x4*)(C + (size_t)row * ldc + col) = o; }
    __device__ __forceinline__ void store4(int row, int col, f32x4 v) const {
    f32x4 r; r.x = fmaxf(v.x, 0.f); r.y = fmaxf(v.y, 0.f); r.z = fmaxf(v.z, 0.f); r.w = fmaxf(v.w, 0.f); r = r * r;
    u32x2 o; o.x = pk2(r.x, r.y); o.y = pk2(r.z, r.w); *(u32x2*)(C + (size_t)row * ldc + col) = o; } };
struct EpiQ { bf16* QN; bf16* QPE; const float* ROPE;
    __device__ __forceinline__ void store8(int row, int col, f32x4 a, f32x4 b) const {
        if (col < 1024) { u32x4 o; o.x = pk2(a.x * QSCALE, a.y * QSCALE); o.y = pk2(a.z * QSCALE, a.w * QSCALE); o.z = pk2(b.x * QSCALE, b.y * QSCALE); o.w = pk2(b.z * QSCALE, b.w * QSCALE); *(u32x4*)(QN + (size_t)row * 1024 + col) = o; }
        else { store4(row, col, a); store4(row, col + 4, b); }
    }
    __device__ __forceinline__ void store4(int row, int col, f32x4 v) const {
        if (col < 1024) { u32x2 o; o.x = pk2(v.x * QSCALE, v.y * QSCALE); o.y = pk2(v.z * QSCALE, v.w * QSCALE); *(u32x2*)(QN + (size_t)row * 1024 + col) = o; }
        else { const int p0 = (col - 1024) >> 1; const float* rt = ROPE + (size_t)row * 32;
#pragma unroll
            for (int e = 0; e < 2; ++e) { const int p = p0 + e, h = p >> 4, jj = p & 15; const float x1 = e ? v.z : v.x, x2 = e ? v.w : v.y, cs = rt[jj], sn = rt[16 + jj];
                QPE[(size_t)row * 512 + h * 32 + jj] = (bf16)f2bf((x1 * cs - x2 * sn) * QSCALE); QPE[(size_t)row * 512 + h * 32 + 16 + jj] = (bf16)f2bf((x1 * sn + x2 * cs) * QSCALE); } }
    } };
struct EpiBf16S { bf16* C; int ldc; float s;
    __device__ __forceinline__ void store8(int row, int col, f32x4 a, f32x4 b) const { u32x4 o; o.x = pk2(a.x * s, a.y * s); o.y = pk2(a.z * s, a.w * s); o.z = pk2(b.x * s, b.y * s); o.w = pk2(b.z * s, b.w * s); *(u32x4*)(C + (size_t)row * ldc + col) = o; }
    __device__ __forceinline__ void store4(int row, int col, f32x4 v) const { u32x2 o; o.x = pk2(v.x * s, v.y * s); o.y = pk2(v.z * s, v.w * s); *(u32x2*)(C + (size_t)row * ldc + col) = o; } };
struct EpiGla { bf16 *QG, *KG, *VG, *RG; float* GD;
    __device__ __forceinline__ void store8(int row, int col, f32x4 a, f32x4 b) const {
        if (col < 3072) { bf16* dst; int cc;
            if (col < 512) { dst = QG + (size_t)row * 512; cc = col; a = a * GLA_SCALE; b = b * GLA_SCALE; }
            else if (col < 1024) { dst = KG + (size_t)row * 512; cc = col - 512; }
            else if (col < 2048) { dst = VG + (size_t)row * 1024; cc = col - 1024; }
            else { dst = RG + (size_t)row * 1024; cc = col - 2048; }
            u32x4 o; o.x = pk2(a.x, a.y); o.y = pk2(a.z, a.w); o.z = pk2(b.x, b.y); o.w = pk2(b.z, b.w); *(u32x4*)(dst + cc) = o;
        } else if (col < 3088) { *(f32x4*)(GD + (size_t)row * 16 + (col - 3072)) = a; *(f32x4*)(GD + (size_t)row * 16 + (col - 3072) + 4) = b; }
    }
    __device__ __forceinline__ void store4(int row, int col, f32x4 v) const {
        if (col < 3072) { bf16* dst; int cc;
            if (col < 512) { dst = QG + (size_t)row * 512; cc = col; v = v * GLA_SCALE; }
            else if (col < 1024) { dst = KG + (size_t)row * 512; cc = col - 512; }
            else if (col < 2048) { dst = VG + (size_t)row * 1024; cc = col - 1024; }
            else { dst = RG + (size_t)row * 1024; cc = col - 2048; }
            u32x2 o; o.x = pk2(v.x, v.y); o.y = pk2(v.z, v.w); *(u32x2*)(dst + cc) = o;
        } else if (col < 3088) { *(f32x4*)(GD + (size_t)row * 16 + (col - 3072)) = v; }
    } };
template <class Epi>
__device__ __forceinline__ void gemm_naive(const bf16* A, const bf16* Bt, int M, int N, int K, const Epi& E, LAS unsigned char* lds, int tid) {
    LAS float* As = (LAS float*)lds;
    LAS float* Bs = As + 32 * 68;
    const int ntm = M / 64, ntn = N / 128, ty = tid >> 5, tx = tid & 31;
    for (int tile = blockIdx.x; tile < ntm * ntn; tile += gridDim.x) {
        const int tm = tile / ntn, tn = tile % ntn;
        f32x4 acc[4];
#pragma unroll
        for (int i = 0; i < 4; ++i) acc[i] = (f32x4){0.f, 0.f, 0.f, 0.f};
        for (int k0 = 0; k0 < K; k0 += 32) {
            { const int row = tid >> 3, kq = (tid & 7) * 4; const u32x2 v = *(const u32x2*)(A + (size_t)(tm * 64 + row) * K + k0 + kq);
              As[(kq + 0) * 68 + row] = bflo(v.x); As[(kq + 1) * 68 + row] = bfhi(v.x); As[(kq + 2) * 68 + row] = bflo(v.y); As[(kq + 3) * 68 + row] = bfhi(v.y); }
            { const int row = tid >> 2, kq = (tid & 3) * 8; const u32x4 v = *(const u32x4*)(Bt + (size_t)(tn * 128 + row) * K + k0 + kq);
              Bs[(kq + 0) * 132 + row] = bflo(v.x); Bs[(kq + 1) * 132 + row] = bfhi(v.x); Bs[(kq + 2) * 132 + row] = bflo(v.y); Bs[(kq + 3) * 132 + row] = bfhi(v.y);
              Bs[(kq + 4) * 132 + row] = bflo(v.z); Bs[(kq + 5) * 132 + row] = bfhi(v.z); Bs[(kq + 6) * 132 + row] = bflo(v.w); Bs[(kq + 7) * 132 + row] = bfhi(v.w); }
            __syncthreads();
#pragma unroll 8
            for (int k = 0; k < 32; ++k) {
                const f32x4 av = *(const LAS f32x4*)(As + k * 68 + 4 * ty); const f32x4 bv = *(const LAS f32x4*)(Bs + k * 132 + 4 * tx);
                acc[0] += av.x * bv; acc[1] += av.y * bv; acc[2] += av.z * bv; acc[3] += av.w * bv;
            }
            __syncthreads();
        }
#pragma unroll
        for (int i = 0; i < 4; ++i) E.store4(tm * 64 + 4 * ty + i, tn * 128 + 4 * tx, acc[i]);
    }
}


template <class E> struct EpiWrap {
    static constexpr bool PERM = false, AFTER_DRAIN = false; E e;
    __device__ __forceinline__ void operator()(const pg8::f32x4 (&acc)[2][2][4][2], const pg8::Unit& u, int wr, int wc, int fr, int fq) const {
#pragma unroll
        for (int ai = 0; ai < 2; ++ai)
#pragma unroll
            for (int m = 0; m < 4; ++m) { const int row = u.pm * 256 + ai * 128 + wr * 64 + m * 16 + fr;
#pragma unroll
                for (int bj = 0; bj < 2; ++bj)
#pragma unroll
                    for (int n = 0; n < 2; ++n) e.store4(row, u.pn * 256 + bj * 128 + wc * 32 + n * 16 + 4 * fq, acc[ai][bj][m][n]); }
    }
};
template <int KSUB> struct EpiSlab {
    static constexpr bool PERM = false, AFTER_DRAIN = false; float* MT;
    __device__ __forceinline__ void operator()(const pg8::f32x4 (&acc)[2][2][4][2], const pg8::Unit& u, int wr, int wc, int fr, int fq) const {
        float* base = MT + ((size_t)(u.k0 / KSUB) * (RP - RMAIN) + (size_t)(u.pm * 256 - RMAIN)) * D + u.pn * 256 + wc * 32 + 4 * fq;
#pragma unroll
        for (int ai = 0; ai < 2; ++ai)
#pragma unroll
            for (int m = 0; m < 4; ++m) { float* rp = base + (size_t)(ai * 128 + wr * 64 + m * 16 + fr) * D;
#pragma unroll
                for (int bj = 0; bj < 2; ++bj)
#pragma unroll
                    for (int n = 0; n < 2; ++n) *(f32x4*)(rp + bj * 128 + n * 16) = acc[ai][bj][m][n]; }
    }
};
template <class E> struct EpiWrap8 {
    static constexpr bool PERM = true, AFTER_DRAIN = false; E e;
    __device__ __forceinline__ void operator()(const pg8::f32x4 (&acc)[2][2][4][2], const pg8::Unit& u, int wr, int wc, int fr, int fq) const {
#pragma unroll
        for (int ai = 0; ai < 2; ++ai)
#pragma unroll
            for (int m = 0; m < 4; ++m) { const int row = u.pm * 256 + ai * 128 + wr * 64 + m * 16 + fr;
#pragma unroll
                for (int bj = 0; bj < 2; ++bj) e.store8(row, u.pn * 256 + bj * 128 + wc * 32 + 8 * fq, acc[ai][bj][m][0], acc[ai][bj][m][1]); }
    }
};
template <class E>
__device__ __forceinline__ void gemm_mfma8(const bf16* A, const bf16* Bt, int M, int N, int K, const E& e, LAS unsigned char* lds, int wave) {
    pg8::Gemm g{A, Bt, M, N, K, K}; pg8::StaticOrder S; S.init(M, N, (int)gridDim.x, (int)blockIdx.x);
    EpiWrap8<E> W{e};
    pg8::gemm_phase<EpiWrap8<E>, pg8::StaticOrder, true, true>(lds, g, S, W, wave);
}
template <class E>
__device__ __forceinline__ void gemm_mfma(const bf16* A, const bf16* Bt, int M, int N, int K, const E& e, LAS unsigned char* lds, int wave) {
    pg8::Gemm g{A, Bt, M, N, K, K}; pg8::StaticOrder S; S.init(M, N, (int)gridDim.x, (int)blockIdx.x);
    EpiWrap<E> W{e};
    pg8::gemm_phase<EpiWrap<E>, pg8::StaticOrder, true, true>(lds, g, S, W, wave);
}
template <int SPLIT, int NN, int KSUB, int PM0, int NUNITS> struct TailOrder {
    int G, c;
    __device__ __forceinline__ bool next(int i, pg8::Unit& u) const { const int L = i * G + c; if (L >= NUNITS) return false; const int ks = L % SPLIT, t = L / SPLIT; u.pn = t % NN; u.pm = PM0 + t / NN; u.k0 = ks * KSUB; u.prob = 0; u.aoff = 0; u.boff = 0; return true; }
    __device__ __forceinline__ void a_ready(const pg8::Unit&) const {}
    __device__ __forceinline__ void done(const pg8::Unit&) const {}
};
struct EpiAtomicF32 { float* C; int ldc; __device__ __forceinline__ void store4(int row, int col, f32x4 v) const { float* p = C + (size_t)row * ldc + col;
    __hip_atomic_fetch_add(p, v.x, __ATOMIC_RELAXED, __HIP_MEMORY_SCOPE_AGENT); __hip_atomic_fetch_add(p + 1, v.y, __ATOMIC_RELAXED, __HIP_MEMORY_SCOPE_AGENT);
    __hip_atomic_fetch_add(p + 2, v.z, __ATOMIC_RELAXED, __HIP_MEMORY_SCOPE_AGENT); __hip_atomic_fetch_add(p + 3, v.w, __ATOMIC_RELAXED, __HIP_MEMORY_SCOPE_AGENT); } };
template <int K, int SPLIT>
__device__ __forceinline__ void gemm_n1024_tail(const bf16* A, const bf16* Bt, bf16* C, float* MT, LAS unsigned char* lds, int wave) {
    { pg8::Gemm g{A, Bt, RMAIN, D, K, K}; pg8::StaticOrder S; S.init(RMAIN, D, (int)gridDim.x, (int)blockIdx.x); EpiWrap8<EpiBf16> W{EpiBf16{C, D}};
      pg8::gemm_phase<EpiWrap8<EpiBf16>, pg8::StaticOrder, true, true>(lds, g, S, W, wave); }
    { typedef TailOrder<SPLIT, D / 256, K / SPLIT, RMAIN / 256, (RP - RMAIN) / 256 * (D / 256) * SPLIT> TO;
      pg8::Gemm g{A, Bt, RP, D, K / SPLIT, K}; TO S{(int)gridDim.x, (int)blockIdx.x}; EpiSlab<K / SPLIT> W{MT};
      pg8::gemm_phase<EpiSlab<K / SPLIT>, TO, false, true>(lds, g, S, W, wave); }
}

struct P3Order {
    int G, c;
    static constexpr int NQ = (RP / 256) * (NUQ / 256), NL = (DB * DS / 256) * (NH * KVL / 256), NK = (RP / 256) * (NUKV / 256);
    __device__ __forceinline__ bool next(int i, pg8::Unit& u) const {
        int L = i * G + c; u.k0 = 0;
        if (L < NK) { u.prob = 2; u.pm = L / (NUKV / 256); u.pn = L % (NUKV / 256); u.aoff = (long)(WS_CKVN - WS_CQN); u.boff = (long)(WS_WUKV - WS_WUQ); return true; } L -= NK;
        if (L < NQ) { u.prob = 0; u.pm = L / (NUQ / 256); u.pn = L % (NUQ / 256); u.aoff = 0; u.boff = 0; return true; } L -= NQ;
        if (L < NL) { u.prob = 1; u.pm = L / (NH * KVL / 256); u.pn = L % (NH * KVL / 256); u.aoff = (long)RSAMP0 * QL * 2; u.boff = (long)(WS_WUQL - WS_WUQ); return true; }
        return false;
    }
    __device__ __forceinline__ void a_ready(const pg8::Unit&) const {}
    __device__ __forceinline__ void done(const pg8::Unit&) const {}
};
struct EpiP3 {
    static constexpr bool PERM = true, AFTER_DRAIN = false; EpiQ eq; EpiBf16S el; EpiBf16 ek;
    __device__ __forceinline__ void operator()(const pg8::f32x4 (&acc)[2][2][4][2], const pg8::Unit& u, int wr, int wc, int fr, int fq) const {
        asm volatile("" : "+v"(fr), "+v"(fq));
        if (u.prob == 0) { EpiWrap8<EpiQ> w{eq}; w(acc, u, wr, wc, fr, fq); }
        else if (u.prob == 1) { EpiWrap8<EpiBf16S> w{el}; w(acc, u, wr, wc, fr, fq); }
        else { EpiWrap8<EpiBf16> w{ek}; w(acc, u, wr, wc, fr, fq); }
    }
};
__device__ __forceinline__ void gemm_p3(ArgsP a, LAS unsigned char* lds, int wave) {
    pg8::Gemm g{WSB(WS_CQN), WSB(WS_WUQ), RP, NUQ, QL, QL}; P3Order S{(int)gridDim.x, (int)blockIdx.x};
    EpiP3 E{EpiQ{WSB(WS_QN), WSB(WS_QPE), WSF(WS_ROPE)}, EpiBf16S{WSB(WS_QLAT), NH * KVL, QSCALE}, EpiBf16{WSB(WS_KNV), NUKV}};
    pg8::gemm_phase<EpiP3, P3Order, false, true>(lds, g, S, E, wave);
}

struct EpiMlaIn {
    static constexpr bool PERM = false, AFTER_DRAIN = true;
    bf16 *CQN, *CKVN, *KPEB; const float *qg, *kg, *ROPE; float* out;
    __device__ __forceinline__ void fused(pg8::f32x4 (&acc)[2][2][4][2], const pg8::Unit& u, int wr, int wc, int fr, int fq, PG8_LAS unsigned char* lds, int wid, int lane) const {
        asm volatile("" : "+v"(fr), "+v"(fq));
        if (u.pn < 2) {
            PG8_LAS float* P = (PG8_LAS float*)lds;
            float s[2][4];
#pragma unroll
            for (int ai = 0; ai < 2; ++ai)
#pragma unroll
                for (int m = 0; m < 4; ++m) { float t = 0.f;
#pragma unroll
                    for (int bj = 0; bj < 2; ++bj)
#pragma unroll
                        for (int n = 0; n < 2; ++n) { const pg8::f32x4 x = acc[ai][bj][m][n]; t += (x[0] * x[0] + x[1] * x[1]) + (x[2] * x[2] + x[3] * x[3]); }
                    t += __shfl_xor(t, 16); t += __shfl_xor(t, 32);
                    if (fq == 0) P[(ai * 128 + wr * 64 + m * 16 + fr) * 4 + wc] = t; }
            asm volatile("s_waitcnt lgkmcnt(0)\n\ts_barrier" ::: "memory");
#pragma unroll
            for (int ai = 0; ai < 2; ++ai)
#pragma unroll
                for (int m = 0; m < 4; ++m) { const pg8::f32x4 p4 = *(const PG8_LAS pg8::f32x4*)(P + (ai * 128 + wr * 64 + m * 16 + fr) * 4); s[ai][m] = 1.0f / sqrtf(((p4[0] + p4[1]) + (p4[2] + p4[3])) * (1.f / 256) + EPS); }
            const float* g = u.pn == 0 ? qg : kg; bf16* dst = u.pn == 0 ? CQN : CKVN;
#pragma unroll
            for (int bj = 0; bj < 2; ++bj)
#pragma unroll
                for (int n = 0; n < 2; ++n) { const int col = bj * 128 + wc * 32 + n * 16 + 4 * fq; const pg8::f32x4 gv = *(const pg8::f32x4*)(g + col);
#pragma unroll
                    for (int ai = 0; ai < 2; ++ai)
#pragma unroll
                        for (int m = 0; m < 4; ++m) { const int row = u.pm * 256 + ai * 128 + wr * 64 + m * 16 + fr; if (row >= R) continue;
                            const pg8::f32x4 y = acc[ai][bj][m][n] * s[ai][m] * gv;
                            u32x2 o; o.x = pk2(y[0], y[1]); o.y = pk2(y[2], y[3]); *(u32x2*)(dst + (size_t)row * 256 + col) = o;
                            if (u.pn == 1) { const int pos = row_pos(row); float* oc = row < RSAMP0 ? out + O_CKVP + ((size_t)(row < RMAIN ? (row >> 12) : ((row - RMAIN) >> 4)) * TP + pos) * 256 : out + O_CKVS + (size_t)(row - RSAMP0) * 256;
                                *(pg8::f32x4*)(oc + col) = y; } } }
        } else if (wc == 0) {
#pragma unroll
            for (int ai = 0; ai < 2; ++ai)
#pragma unroll
                for (int m = 0; m < 4; ++m) { const int row = u.pm * 256 + ai * 128 + wr * 64 + m * 16 + fr; if (row >= R) continue;
                    const int pos = row_pos(row); const float* rt = ROPE + (size_t)row * 32 + 4 * fq; const pg8::f32x4 cs = *(const pg8::f32x4*)rt, sn = *(const pg8::f32x4*)(rt + 16);
                    const pg8::f32x4 x1 = acc[ai][0][m][0], x2 = acc[ai][0][m][1]; const pg8::f32x4 o1 = x1 * cs - x2 * sn, o2 = x1 * sn + x2 * cs;
                    float* ok = row < RSAMP0 ? out + O_KPEP + ((size_t)(row < RMAIN ? (row >> 12) : ((row - RMAIN) >> 4)) * TP + pos) * 32 : out + O_KPES + (size_t)(row - RSAMP0) * 32;
                    *(pg8::f32x4*)(ok + 4 * fq) = o1; *(pg8::f32x4*)(ok + 16 + 4 * fq) = o2;
                    u32x2 w; w.x = pk2(o1[0], o1[1]); w.y = pk2(o1[2], o1[3]); *(u32x2*)(KPEB + (size_t)row * 32 + 4 * fq) = w; w.x = pk2(o2[0], o2[1]); w.y = pk2(o2[2], o2[3]); *(u32x2*)(KPEB + (size_t)row * 32 + 16 + 4 * fq) = w; }
        }
    }
};
__device__ __forceinline__ void gemm_p1(ArgsP a, LAS unsigned char* lds, int wave) {
    pg8::Gemm g{WSB(WS_H), WSB(WS_WIN0), RP, NIN0, D, D}; pg8::StaticOrder S; S.init(RP, NIN0, (int)gridDim.x, (int)blockIdx.x);
    EpiMlaIn E{WSB(WS_CQN), WSB(WS_CKVN), WSB(WS_KPE), IN_F(12), IN_F(14), WSF(WS_ROPE), a->out};
    pg8::gemm_phase<EpiMlaIn, pg8::StaticOrder, false, true>(lds, g, S, E, wave);
}
#ifndef USE_NAIVE_ATTN
#define USE_NAIVE_ATTN 0
#endif
#ifndef USE_NAIVE_DECODE
#define USE_NAIVE_DECODE 0
#endif
#ifndef USE_NAIVE_GLA
#define USE_NAIVE_GLA 0
#endif
#ifndef PROBE
#define PROBE 0
#endif
#ifndef PROBE_LO
#define PROBE_LO -1
#define PROBE_HI -1
#endif
#ifndef USE_NAIVE_GEMM
#define USE_NAIVE_GEMM 0
#endif
#if USE_NAIVE_GEMM
#define GEMM(A, Bt, M, N, K, E) gemm_naive(A, Bt, M, N, K, E, lds, fresh_tid(c.wave))
#else
#define GEMM(A, Bt, M, N, K, E) gemm_mfma(A, Bt, M, N, K, E, lds, c.wave)
#endif


namespace att {
typedef short bf16x8 __attribute__((ext_vector_type(8)));
typedef short s16x4 __attribute__((ext_vector_type(4)));
typedef float f32x16 __attribute__((ext_vector_type(16)));
constexpr int KSLOT = 12288, VSLOT = 8192, LDS_K = 0, LDS_V = 2 * KSLOT, LDS_WS = LDS_V + 2 * VSLOT, LDS_OST = LDS_WS + 8 * 256, LDS_TOTAL = LDS_OST + 8 * 4096;
__device__ __forceinline__ int crow(int r, int hi) { return (r & 3) + 8 * (r >> 2) + 4 * hi; }
typedef float f32x2_t __attribute__((ext_vector_type(2))); typedef __bf16 bf16x2_t __attribute__((ext_vector_type(2)));
__device__ __forceinline__ unsigned cvtpk(float lo, float hi) { f32x2_t v = {lo, hi}; bf16x2_t b = __builtin_convertvector(v, bf16x2_t); return __builtin_bit_cast(unsigned, b); }
__device__ __forceinline__ s16x4 vtr(const LAS unsigned char* p) { typedef short v4i16_t __attribute__((ext_vector_type(4))); return __builtin_bit_cast(s16x4, __builtin_amdgcn_ds_read_tr16_b64_v4i16((LAS v4i16_t*)p)); }
__device__ __forceinline__ float pmax32(float m) { auto rr = __builtin_amdgcn_permlane32_swap(__float_as_uint(m), __float_as_uint(m), false, false); return fmaxf(__uint_as_float(rr[0]), __uint_as_float(rr[1])); }
__device__ __forceinline__ float psum32(float m) { auto rr = __builtin_amdgcn_permlane32_swap(__float_as_uint(m), __float_as_uint(m), false, false); return __uint_as_float(rr[0]) + __uint_as_float(rr[1]); }
#define ATT_WAIT_BAR() asm volatile("s_waitcnt vmcnt(0) lgkmcnt(0)\n\ts_barrier" ::: "memory")
__device__ __forceinline__ void glds16(const void* gsrc, unsigned lds_dst) { unsigned keep;
    asm volatile("s_mov_b32 %0, m0\n\ts_mov_b32 m0, %2\n\ts_nop 0\n\tglobal_load_lds_dwordx4 %1, off\n\ts_mov_b32 m0, %0" : "=&s"(keep) : "v"(gsrc), "s"(lds_dst) : "memory"); }

__device__ __forceinline__ void attn_unit(int b, int h, int qb, const bf16* QN, const bf16* QPE, const bf16* KNV, const bf16* KPE, bf16* O, LAS unsigned char* lds, int wave_id) {
    const int tid = fresh_tid(wave_id), lane = tid & 63, r32 = lane & 31, hi = lane >> 5; const int wid = wave_id;
    const int rowbase = b * SEQ, q0 = qb * 256, qrow = rowbase + q0 + wid * 32 + r32, qrel = q0 + wid * 32 + r32;
    bf16x8 qr[6];
#pragma unroll
    for (int d0 = 0; d0 < 4; ++d0) qr[d0] = *(const bf16x8*)(QN + (size_t)qrow * 1024 + h * 64 + d0 * 16 + hi * 8);
#pragma unroll
    for (int d0 = 0; d0 < 2; ++d0) qr[4 + d0] = *(const bf16x8*)(QPE + (size_t)qrow * 512 + h * 32 + d0 * 16 + hi * 8);
    LAS float* wsf = (LAS float*)(lds + LDS_WS) + wid * 64;
    const int NT = 4 * qb + 4;
#define ATT_DMA(t, slot) do { const size_t row0_ = (t) == 0 ? (size_t)(RMAIN + 16 * b) : (size_t)(rowbase + 64 * ((t) - 1)); \
        __builtin_amdgcn_global_load_lds((const unsigned*)(KNV + (row0_ + lane) * 2048 + h * 64 + wid * 8), (LAS unsigned*)(lds + LDS_K + (slot) * KSLOT + wid * 1024), 16, 0, 0); \
        if (wid < 4) __builtin_amdgcn_global_load_lds((const unsigned*)(KPE + (row0_ + lane) * 32 + wid * 8), (LAS unsigned*)(lds + LDS_K + (slot) * KSLOT + (8 + wid) * 1024), 16, 0, 0); \
        __builtin_amdgcn_global_load_lds((const unsigned*)(KNV + (row0_ + 16 * (wid & 3) + (lane >> 2)) * 2048 + 1024 + h * 64 + (wid >> 2) * 32 + (lane & 3) * 8), (LAS unsigned*)(lds + LDS_V + (slot) * VSLOT + wid * 1024), 16, 0, 0); } while (0)
    f32x16 o[2]; o[0] = f32x16{}; o[1] = f32x16{};
    float mref = -INFINITY, l = 0.f;
    ATT_DMA(0, 0);
    for (int t = 0; t <= NT; ++t) {
        ATT_WAIT_BAR();
        const int slot = t & 1;
        if (t < NT) ATT_DMA(t + 1, slot ^ 1);
        const int kt0 = 64 * (t - 1);
        if (t > 0 && kt0 > q0 + wid * 32 + 31) continue;
        f32x16 p0 = f32x16{}, p1 = f32x16{};
        const LAS unsigned char* kb = lds + LDS_K + slot * KSLOT + hi * 1024 + r32 * 16;
#pragma unroll
        for (int d0 = 0; d0 < 6; ++d0) {
            const bf16x8 b0 = *(const LAS bf16x8*)(kb + d0 * 2048), b1 = *(const LAS bf16x8*)(kb + d0 * 2048 + 512);
            p0 = __builtin_amdgcn_mfma_f32_32x32x16_bf16(b0, qr[d0], p0, 0, 0, 0);
            p1 = __builtin_amdgcn_mfma_f32_32x32x16_bf16(b1, qr[d0], p1, 0, 0, 0);
        }
        if (t == 0) {
#pragma unroll
            for (int r = 0; r < 16; ++r) { if (crow(r, hi) >= NMETA) p0[r] = -INFINITY; p1[r] = -INFINITY; }
        } else if (kt0 + 63 > q0 + wid * 32) {
#pragma unroll
            for (int r = 0; r < 16; ++r) { const int kv = kt0 + crow(r, hi); if (kv > qrel) p0[r] = -INFINITY; if (kv + 32 > qrel) p1[r] = -INFINITY; }
        }
        float rm = fmaxf(p0[0], p1[0]);
#pragma unroll
        for (int r = 1; r < 16; ++r) rm = fmaxf(rm, fmaxf(p0[r], p1[r]));
        rm = pmax32(rm);
        if (__any(rm > mref + 8.0f)) {
            const float mnew = fmaxf(mref, rm); const float f = __builtin_amdgcn_exp2f(mref - mnew);
            mref = mnew; l *= f;
            if (hi == 0) wsf[r32] = f;
            LDS_WAIT();
#pragma unroll
            for (int r = 0; r < 16; ++r) { const float fr = wsf[crow(r, hi)]; o[0][r] *= fr; o[1][r] *= fr; }
        }
        float sacc = 0.f;
#pragma unroll
        for (int r = 0; r < 16; ++r) { p0[r] = __builtin_amdgcn_exp2f(p0[r] - mref); p1[r] = __builtin_amdgcn_exp2f(p1[r] - mref); sacc += p0[r] + p1[r]; }
        l += sacc;
        u32x4 pw[4];
#pragma unroll
        for (int i = 0; i < 4; ++i) { pw[0][i] = cvtpk(p0[2 * i], p0[2 * i + 1]); pw[1][i] = cvtpk(p0[8 + 2 * i], p0[8 + 2 * i + 1]); pw[2][i] = cvtpk(p1[2 * i], p1[2 * i + 1]); pw[3][i] = cvtpk(p1[8 + 2 * i], p1[8 + 2 * i + 1]); }
        const LAS unsigned char* vb = lds + LDS_V + slot * VSLOT + ((lane >> 4) & 1) * 32 + (lane & 3) * 8 + (4 * hi + ((lane & 15) >> 2)) * 64;
#pragma unroll
        for (int d0 = 0; d0 < 2; ++d0)
#pragma unroll
            for (int ks = 0; ks < 4; ++ks) {
                const s16x4 vlo = vtr(vb + d0 * 4096 + ks * 1024), vhi = vtr(vb + d0 * 4096 + ks * 1024 + 512);
                const bf16x8 vf = (bf16x8){vlo[0], vlo[1], vlo[2], vlo[3], vhi[0], vhi[1], vhi[2], vhi[3]};
                o[d0] = __builtin_amdgcn_mfma_f32_32x32x16_bf16(__builtin_bit_cast(bf16x8, pw[ks]), vf, o[d0], 0, 0, 0);
            }
    }
    l = psum32(l);
    if (hi == 0) wsf[32 + r32] = l;
    LDS_WAIT();
    bf16* Ow = O + (size_t)(rowbase + q0 + wid * 32) * 1024 + h * 64;
    LAS bf16* stg = (LAS bf16*)(lds + LDS_OST) + wid * 2048;
#pragma unroll
    for (int r = 0; r < 16; ++r) { const int orow = crow(r, hi); const float il = 1.0f / wsf[32 + orow];
        stg[orow * 64 + r32] = (bf16)f2bf(o[0][r] * il); stg[orow * 64 + 32 + r32] = (bf16)f2bf(o[1][r] * il); }
    LDS_WAIT();
#pragma unroll
    for (int i = 0; i < 4; ++i) { const int row = i * 8 + (lane >> 3), ch = lane & 7; const u32x4 v = *(const LAS u32x4*)(stg + row * 64 + ch * 8); *(u32x4*)(Ow + (size_t)row * 1024 + ch * 8) = v; }
    ATT_WAIT_BAR();
#undef ATT_DMA
}
constexpr int P_LDS_K = 0, P_LDS_V = 3 * KSLOT, P_LDS_WS = P_LDS_V + 2 * VSLOT, P_LDS_OST = P_LDS_WS + 8 * 256, P_LDS_TOTAL = P_LDS_OST + 8 * 4096;
__device__ __forceinline__ void attn_unit2(int b, int h, int qb, const bf16* QN, const bf16* QPE, const bf16* KNV, const bf16* KPE, bf16* O, LAS unsigned char* lds, int wave_id) {
    const int tid = fresh_tid(wave_id), lane = tid & 63, r32 = lane & 31, hi = lane >> 5; const int wid = wave_id;
    const bool meta = qb < 0;
    const int rowbase = b * SEQ, q0 = meta ? 0 : qb * 256, qrow = meta ? RMAIN + 16 * b + (r32 & 15) : rowbase + q0 + wid * 32 + r32, qrel = meta ? (r32 & 15) : q0 + wid * 32 + r32;
    bf16x8 qr[6];
#pragma unroll
    for (int d0 = 0; d0 < 4; ++d0) qr[d0] = *(const bf16x8*)(QN + (size_t)qrow * 1024 + h * 64 + d0 * 16 + hi * 8);
#pragma unroll
    for (int d0 = 0; d0 < 2; ++d0) qr[4 + d0] = *(const bf16x8*)(QPE + (size_t)qrow * 512 + h * 32 + d0 * 16 + hi * 8);
    LAS float* wsf = (LAS float*)(lds + P_LDS_WS) + wid * 64;
    const unsigned lds0 = (unsigned)(size_t)lds;
    const int NT = meta ? 0 : 4 * qb + 4;
#define A2_ROW0(t) ((t) == 0 ? (size_t)(RMAIN + 16 * b) : (size_t)(rowbase + 64 * ((t) - 1)))
#define A2_DMA_K(t, ks) do { const size_t row0_ = A2_ROW0(t); \
        glds16(KNV + (row0_ + lane) * 2048 + h * 64 + wid * 8, (unsigned)__builtin_amdgcn_readfirstlane((int)(lds0 + P_LDS_K + (ks) * KSLOT + wid * 1024))); \
        if (wid < 4) glds16(KPE + (row0_ + lane) * 32 + wid * 8, (unsigned)__builtin_amdgcn_readfirstlane((int)(lds0 + P_LDS_K + (ks) * KSLOT + (8 + wid) * 1024))); } while (0)
#define A2_DMA_V(t, vs) do { const size_t row0_ = A2_ROW0(t); \
        glds16(KNV + (row0_ + 16 * (wid & 3) + (lane >> 2)) * 2048 + 1024 + h * 64 + (wid >> 2) * 32 + (lane & 3) * 8, (unsigned)__builtin_amdgcn_readfirstlane((int)(lds0 + P_LDS_V + (vs) * VSLOT + wid * 1024))); } while (0)
#define A2_QKT(P0, P1, ks) do { P0 = f32x16{}; P1 = f32x16{}; const LAS unsigned char* kb_ = lds + P_LDS_K + (ks) * KSLOT + hi * 1024 + r32 * 16; \
        _Pragma("unroll") for (int d0 = 0; d0 < 6; ++d0) { const bf16x8 b0_ = *(const LAS bf16x8*)(kb_ + d0 * 2048), b1_ = *(const LAS bf16x8*)(kb_ + d0 * 2048 + 512); \
            P0 = __builtin_amdgcn_mfma_f32_32x32x16_bf16(b0_, qr[d0], P0, 0, 0, 0); P1 = __builtin_amdgcn_mfma_f32_32x32x16_bf16(b1_, qr[d0], P1, 0, 0, 0); } } while (0)
    f32x16 o[2]; o[0] = f32x16{}; o[1] = f32x16{};
    float mref = -INFINITY, l = 0.f;
#define A2_TILE(P0, P1, t, vs) do { \
        if ((t) == 0) { const int qlim_ = meta ? (r32 & 15) : NMETA - 1; _Pragma("unroll") for (int r = 0; r < 16; ++r) { if (crow(r, hi) > qlim_) P0[r] = -INFINITY; P1[r] = -INFINITY; } } \
        else { const int kt0_ = 64 * ((t) - 1); if (kt0_ + 63 > q0 + wid * 32) { _Pragma("unroll") for (int r = 0; r < 16; ++r) { const int kv = kt0_ + crow(r, hi); if (kv > qrel) P0[r] = -INFINITY; if (kv + 32 > qrel) P1[r] = -INFINITY; } } } \
        float rm_ = fmaxf(P0[0], P1[0]); \
        _Pragma("unroll") for (int r = 1; r < 16; ++r) rm_ = fmaxf(rm_, fmaxf(P0[r], P1[r])); \
        rm_ = pmax32(rm_); \
        if (__any(rm_ > mref + 8.0f)) { const float mnew = fmaxf(mref, rm_); const float f = __builtin_amdgcn_exp2f(mref - mnew); mref = mnew; l *= f; \
            if (hi == 0) wsf[r32] = f; LDS_WAIT(); \
            _Pragma("unroll") for (int r = 0; r < 16; ++r) { const float fr = wsf[crow(r, hi)]; o[0][r] *= fr; o[1][r] *= fr; } } \
        float sacc_ = 0.f; \
        _Pragma("unroll") for (int r = 0; r < 16; ++r) { P0[r] = __builtin_amdgcn_exp2f(P0[r] - mref); P1[r] = __builtin_amdgcn_exp2f(P1[r] - mref); sacc_ += P0[r] + P1[r]; } \
        l += sacc_; \
        u32x4 pw_[4]; \
        _Pragma("unroll") for (int i = 0; i < 4; ++i) { pw_[0][i] = cvtpk(P0[2 * i], P0[2 * i + 1]); pw_[1][i] = cvtpk(P0[8 + 2 * i], P0[8 + 2 * i + 1]); pw_[2][i] = cvtpk(P1[2 * i], P1[2 * i + 1]); pw_[3][i] = cvtpk(P1[8 + 2 * i], P1[8 + 2 * i + 1]); } \
        const LAS unsigned char* vb_ = lds + P_LDS_V + (vs) * VSLOT + ((lane >> 4) & 1) * 32 + (lane & 3) * 8 + (4 * hi + ((lane & 15) >> 2)) * 64; \
        _Pragma("unroll") for (int d0 = 0; d0 < 2; ++d0) _Pragma("unroll") for (int ks = 0; ks < 4; ++ks) { \
            const s16x4 vlo = vtr(vb_ + d0 * 4096 + ks * 1024), vhi = vtr(vb_ + d0 * 4096 + ks * 1024 + 512); \
            const bf16x8 vf = (bf16x8){vlo[0], vlo[1], vlo[2], vlo[3], vhi[0], vhi[1], vhi[2], vhi[3]}; \
            o[d0] = __builtin_amdgcn_mfma_f32_32x32x16_bf16(__builtin_bit_cast(bf16x8, pw_[ks]), vf, o[d0], 0, 0, 0); } } while (0)
    f32x16 pA0, pA1, pB0, pB1;
    A2_DMA_K(0, 0); A2_DMA_V(0, 0); if (NT >= 1) A2_DMA_K(1, 1);
    ATT_WAIT_BAR();
    A2_QKT(pA0, pA1, 0);
    int kc = 0, vc = 0, t = 0;
#define A2_STEP(PC0, PC1, PN0, PN1) do { \
        if (t > 0) ATT_WAIT_BAR(); \
        const int kn_ = kc == 2 ? 0 : kc + 1, k2_ = kn_ == 2 ? 0 : kn_ + 1; \
        if (t + 2 <= NT) A2_DMA_K(t + 2, k2_); \
        if (t + 1 <= NT) { A2_DMA_V(t + 1, vc ^ 1); A2_QKT(PN0, PN1, kn_); } \
        A2_TILE(PC0, PC1, t, vc); \
        kc = kn_; vc ^= 1; ++t; } while (0)
    while (t + 1 <= NT) { A2_STEP(pA0, pA1, pB0, pB1); A2_STEP(pB0, pB1, pA0, pA1); }
    A2_STEP(pA0, pA1, pB0, pB1);
    l = psum32(l);
    if (hi == 0) wsf[32 + r32] = l;
    LDS_WAIT();
    bf16* Ow = O + (size_t)(meta ? RMAIN + 16 * b : rowbase + q0 + wid * 32) * 1024 + h * 64;
    LAS bf16* stg = (LAS bf16*)(lds + P_LDS_OST) + wid * 2048;
#pragma unroll
    for (int r = 0; r < 16; ++r) { const int orow = crow(r, hi); const float il = 1.0f / wsf[32 + orow];
        stg[orow * 64 + r32] = (bf16)f2bf(o[0][r] * il); stg[orow * 64 + 32 + r32] = (bf16)f2bf(o[1][r] * il); }
    LDS_WAIT();
#pragma unroll
    for (int i = 0; i < 4; ++i) { const int row = i * 8 + (lane >> 3), ch = lane & 7; const u32x4 v = *(const LAS u32x4*)(stg + row * 64 + ch * 8); if (!meta || (wid == 0 && row < NMETA)) *(u32x4*)(Ow + (size_t)row * 1024 + ch * 8) = v; }
    ATT_WAIT_BAR();
#undef A2_ROW0
#undef A2_DMA_K
#undef A2_DMA_V
#undef A2_QKT
#undef A2_TILE
#undef A2_STEP
}
__device__ __forceinline__ void attn_phase(const bf16* QN, const bf16* QPE, const bf16* KNV, const bf16* KPE, bf16* O, LAS unsigned char* lds, int wave_id) {
    const int G = gridDim.x, bx = blockIdx.x; const int vcu = (G % 8 == 0) ? (bx % 8) * (G / 8) + bx / 8 : bx;
    for (int v = vcu; v < NB * NH * 4; v += G) {
        const int bh = v >> 2, s0 = v & 3;
#pragma unroll 1
        for (int i = 0; i < 4; ++i) { const int qb = (i == 0) ? 15 - s0 : (i == 1) ? 11 - s0 : (i == 2) ? 4 + s0 : s0; attn_unit2(bh >> 4, bh & 15, qb, QN, QPE, KNV, KPE, O, lds, wave_id); }
        if (v < NB * NH) attn_unit2(v >> 4, v & 15, -1, QN, QPE, KNV, KPE, O, lds, wave_id);
    }
}
}


namespace dec {
using att::bf16x8; using att::s16x4; using att::f32x16; using att::crow; using att::cvtpk; using att::vtr; using att::pmax32; using att::psum32;
constexpr int KST = 592, KBUF = 64 * KST, LDS_K = 0, LDS_Q = 2 * KBUF, LDS_WS = LDS_Q + 64 * KST, LDS_TOTAL = LDS_WS + 8 * 256;
constexpr int NSTAGE = 64;
__device__ __forceinline__ void decode_unit(int db, int sp, ArgsP a, LAS unsigned char* lds, int wave_id) {
    const int tid = fresh_tid(wave_id), lane = tid & 63, r32 = lane & 31, hi = lane >> 5; const int wid = wave_id;
    const int qh = wid & 1, kh = (wid >> 1) & 1, dh = wid >> 2;
    const float* cckv = IN_F(2); const float* ckpe = IN_F(3); const int* pt = (const int*)a->in[5] + db * NPAGES + sp * 32;
    for (int i = tid; i < 64 * 36; i += 512) { const int q = i / 36, ch = i % 36, t = q >> 4, h = q & 15;
        const bf16* src = ch < 32 ? WSB(WS_QLAT) + ((size_t)(db * 4 + t) * 16 + h) * 256 + ch * 8 : WSB(WS_QPE) + (size_t)(RSAMP0 + db * 4 + t) * 512 + h * 32 + (ch - 32) * 8;
        *(LAS u32x4*)(lds + LDS_Q + q * KST + ch * 16) = *(const u32x4*)src; }
    f32x4 cv[8], kv;
#define DEC_LOAD(s) do { const int page_ = __builtin_amdgcn_readfirstlane(pt[(s) >> 1]); const size_t k0_ = (size_t)page_ * PAGE + ((s) & 1) * 64; \
        _Pragma("unroll") for (int j = 0; j < 8; ++j) cv[j] = *(const f32x4*)(cckv + (k0_ + wid + 8 * j) * 256 + 4 * lane); \
        kv = *(const f32x4*)(ckpe + (k0_ + (tid >> 3)) * 32 + 4 * (tid & 7)); } while (0)
#define DEC_WRITE(buf) do { LAS unsigned char* kb_ = lds + LDS_K + (buf) * KBUF; \
        _Pragma("unroll") for (int j = 0; j < 8; ++j) { u32x2 w_; w_.x = cvtpk(cv[j].x, cv[j].y); w_.y = cvtpk(cv[j].z, cv[j].w); *(LAS u32x2*)(kb_ + (wid + 8 * j) * KST + lane * 8) = w_; } \
        { u32x2 w_; w_.x = cvtpk(kv.x, kv.y); w_.y = cvtpk(kv.z, kv.w); *(LAS u32x2*)(kb_ + (tid >> 3) * KST + 512 + (tid & 7) * 8) = w_; } } while (0)
    LAS float* wsf = (LAS float*)(lds + LDS_WS) + wid * 64;
    f32x16 o[4]; o[0] = f32x16{}; o[1] = f32x16{}; o[2] = f32x16{}; o[3] = f32x16{};
    float mref = -INFINITY, l = 0.f;
    DEC_LOAD(0); DEC_WRITE(0); DEC_LOAD(1);
    __syncthreads();
    for (int s = 0; s < NSTAGE; ++s) {
        const int buf = s & 1;
        const LAS unsigned char* kimg = lds + LDS_K + buf * KBUF;
        f32x16 p = f32x16{};
        { const LAS unsigned char* kb = kimg + (kh * 32 + r32) * KST + hi * 16; const LAS unsigned char* qb = lds + LDS_Q + (qh * 32 + r32) * KST + hi * 16;
#pragma unroll
          for (int s2 = 0; s2 < 18; ++s2) p = __builtin_amdgcn_mfma_f32_32x32x16_bf16(*(const LAS bf16x8*)(kb + s2 * 32), *(const LAS bf16x8*)(qb + s2 * 32), p, 0, 0, 0); }
        float rm = p[0];
#pragma unroll
        for (int r = 1; r < 16; ++r) rm = fmaxf(rm, p[r]);
        rm = pmax32(rm);
        if (__any(rm > mref + 8.0f)) {
            const float mnew = fmaxf(mref, rm); const float f = __builtin_amdgcn_exp2f(mref - mnew);
            mref = mnew; l *= f;
            if (hi == 0) wsf[r32] = f;
            LDS_WAIT();
#pragma unroll
            for (int r = 0; r < 16; ++r) { const float fr = wsf[crow(r, hi)]; o[0][r] *= fr; o[1][r] *= fr; o[2][r] *= fr; o[3][r] *= fr; }
        }
        float sacc = 0.f;
#pragma unroll
        for (int r = 0; r < 16; ++r) { p[r] = __builtin_amdgcn_exp2f(p[r] - mref); sacc += p[r]; }
        l += sacc;
        u32x4 pw[2];
#pragma unroll
        for (int i = 0; i < 4; ++i) { pw[0][i] = cvtpk(p[2 * i], p[2 * i + 1]); pw[1][i] = cvtpk(p[8 + 2 * i], p[8 + 2 * i + 1]); }
        const LAS unsigned char* vb = kimg + (kh * 32 + 4 * hi + ((lane & 15) >> 2)) * KST + (dh * 128 + 16 * ((lane >> 4) & 1) + 4 * (lane & 3)) * 2;
#pragma unroll
        for (int dt = 0; dt < 4; ++dt)
#pragma unroll
            for (int ks = 0; ks < 2; ++ks) {
                const s16x4 vlo = vtr(vb + (ks * 16) * KST + dt * 64), vhi = vtr(vb + (ks * 16 + 8) * KST + dt * 64);
                const bf16x8 vf = (bf16x8){vlo[0], vlo[1], vlo[2], vlo[3], vhi[0], vhi[1], vhi[2], vhi[3]};
                o[dt] = __builtin_amdgcn_mfma_f32_32x32x16_bf16(__builtin_bit_cast(bf16x8, pw[ks]), vf, o[dt], 0, 0, 0);
            }
        if (s + 1 < NSTAGE) { DEC_WRITE(buf ^ 1); if (s + 2 < NSTAGE) DEC_LOAD(s + 2); }
        __syncthreads();
    }
    const int part = (db * 2 + sp) * 2 + kh;
    float* op = WSF(WS_OPART) + (size_t)part * 64 * 256;
#pragma unroll
    for (int dt = 0; dt < 4; ++dt)
#pragma unroll
        for (int r = 0; r < 16; ++r) op[(size_t)(qh * 32 + crow(r, hi)) * 256 + dh * 128 + dt * 32 + r32] = o[dt][r];
    l = psum32(l);
    if (dh == 0 && hi == 0) { float* mp = WSF(WS_MLP) + (size_t)part * 128 + (qh * 32 + r32) * 2; mp[0] = mref; mp[1] = l; }
#undef DEC_LOAD
#undef DEC_WRITE
}
struct LaneCtx { int lane, wave; };
__device__ __forceinline__ void combine_item(ArgsP a, int db, int h, const LaneCtx c, LAS unsigned char* lds) {
    {
        f32x4 cn[4]; float en[4];
#pragma unroll
        for (int s2 = 0; s2 < 4; ++s2) { const int kr = RSAMP0 + db * 4 + s2;
            const u32x2 v = *(const u32x2*)(WSB(WS_CKVN) + (size_t)kr * 256 + 4 * c.lane); cn[s2] = (f32x4){bflo(v.x), bfhi(v.x), bflo(v.y), bfhi(v.y)};
            en[s2] = c.lane < 32 ? bf2f(WSB(WS_KPE)[(size_t)kr * 32 + c.lane]) : 0.f; }
        f32x4 res[4];
#pragma unroll
        for (int t = 0; t < 4; ++t) {
            const int i = db * 4 + t, q = t * 16 + h;
            const u32x2 qv = *(const u32x2*)(WSB(WS_QLAT) + ((size_t)i * 16 + h) * 256 + 4 * c.lane); const f32x4 ql = (f32x4){bflo(qv.x), bfhi(qv.x), bflo(qv.y), bfhi(qv.y)};
            const float qp = c.lane < 32 ? bf2f(WSB(WS_QPE)[(size_t)(RSAMP0 + i) * 512 + h * 32 + c.lane]) : 0.f;
            float mp[4], lp[4], dn[4]; float mg = -INFINITY;
#pragma unroll
            for (int p = 0; p < 4; ++p) { const float* ml = WSF(WS_MLP) + (size_t)(db * 4 + p) * 128 + q * 2; mp[p] = ml[0]; lp[p] = ml[1]; mg = fmaxf(mg, mp[p]); }
#pragma unroll
            for (int s2 = 0; s2 < 4; ++s2) {
                float d = (ql.x * cn[s2].x + ql.y * cn[s2].y) + (ql.z * cn[s2].z + ql.w * cn[s2].w) + qp * en[s2];
                d = wave_sum(d); dn[s2] = s2 <= t ? d : -INFINITY; mg = fmaxf(mg, dn[s2]);
            }
            f32x4 acc = (f32x4){0.f, 0.f, 0.f, 0.f}; float L = 0.f;
#pragma unroll
            for (int p = 0; p < 4; ++p) { const float w = exp2f(mp[p] - mg); L += w * lp[p]; acc += w * *(const f32x4*)(WSF(WS_OPART) + ((size_t)(db * 4 + p) * 64 + q) * 256 + 4 * c.lane); }
#pragma unroll
            for (int s2 = 0; s2 < 4; ++s2) { const float w = exp2f(dn[s2] - mg); L += w; acc += w * cn[s2]; }
            res[t] = acc * (1.0f / L);
            __builtin_amdgcn_sched_barrier(0);
        }
        LAS bf16* rt = (LAS bf16*)(lds + 8 * 256 + c.wave * 2048);
#pragma unroll
        for (int t = 0; t < 4; ++t) { u32x2 w; w.x = pk2(res[t].x, res[t].y); w.y = pk2(res[t].z, res[t].w); *(LAS u32x2*)(rt + t * 256 + 4 * c.lane) = w; }
        LDS_WAIT();
        const int r32 = c.lane & 31, hi = c.lane >> 5;
        att::f32x16 o0 = att::f32x16{}, o1 = att::f32x16{};
        const bf16* wb = WSB(WS_WUKV) + (size_t)(1024 + h * 64 + r32) * 256 + 8 * hi;
#pragma unroll
        for (int s = 0; s < 16; ++s) {
            att::bf16x8 af = att::bf16x8{}; if (r32 < 4) af = *(const LAS att::bf16x8*)(rt + r32 * 256 + 16 * s + 8 * hi);
            const att::bf16x8 b0 = *(const att::bf16x8*)(wb + 16 * s), b1 = *(const att::bf16x8*)(wb + 32 * 256 + 16 * s);
            o0 = __builtin_amdgcn_mfma_f32_32x32x16_bf16(af, b0, o0, 0, 0, 0); o1 = __builtin_amdgcn_mfma_f32_32x32x16_bf16(af, b1, o1, 0, 0, 0);
        }
        if (hi == 0) {
#pragma unroll
            for (int t = 0; t < 4; ++t) { bf16* op = WSB(WS_O) + (size_t)(RSAMP0 + db * 4 + t) * 1024 + h * 64 + r32; op[0] = (bf16)f2bf(o0[t]); op[32] = (bf16)f2bf(o1[t]); }
        }
        LDS_WAIT();
    }
}
__device__ __forceinline__ void combine_phase(ArgsP a, const Ctx& c0, LAS unsigned char* lds) {
    const Ctx c = refresh(c0);
    for (int it = c.gw; it < DB * NH; it += c.ngw) combine_item(a, it >> 4, it & 15, LaneCtx{c.lane, c.wave}, lds);
}
__device__ __forceinline__ void decode_phase(ArgsP a, LAS unsigned char* lds, int wave_id) {
    for (int u = blockIdx.x; u < DB * 2; u += gridDim.x) { decode_unit(u >> 1, u & 1, a, lds, wave_id); __syncthreads(); }
}
}

__device__ __forceinline__ void p_side_tables(ArgsP a, const Ctx& c0, LAS unsigned char* lds, int wg0) {
    const Ctx c = refresh(c0);
    const int nwg = (int)gridDim.x - wg0, bx = (int)blockIdx.x - wg0;
    if (bx < 0) return;
    const int gt = (bx * 8 + c.wave) * 64 + c.lane, ngt = nwg * 512;
    {
        const int r32 = c.lane & 31, hi = c.lane >> 5;
        for (int it = bx * 8 + c.wave; it < NH * 64; it += nwg * 8) {
            const int h = it >> 6, ct = (it >> 3) & 7, kt = it & 7;
            const float* ap = IN_F(15) + (size_t)(ct * 32 + r32) * 1024 + h * 64 + 8 * hi;
            const float* bp = IN_F(13) + (size_t)(kt * 32 + r32) * 1536 + h * 96 + 8 * hi;
            att::f32x16 acc = att::f32x16{};
#pragma unroll
            for (int s = 0; s < 4; ++s) {
                const f32x4 a0 = *(const f32x4*)(ap + 16 * s), a1 = *(const f32x4*)(ap + 16 * s + 4), b0 = *(const f32x4*)(bp + 16 * s), b1 = *(const f32x4*)(bp + 16 * s + 4);
                const u32x4 aw = (u32x4){pk2(a0.x, a0.y), pk2(a0.z, a0.w), pk2(a1.x, a1.y), pk2(a1.z, a1.w)}, bw = (u32x4){pk2(b0.x, b0.y), pk2(b0.z, b0.w), pk2(b1.x, b1.y), pk2(b1.z, b1.w)};
                acc = __builtin_amdgcn_mfma_f32_32x32x16_bf16(__builtin_bit_cast(att::bf16x8, aw), __builtin_bit_cast(att::bf16x8, bw), acc, 0, 0, 0);
            }
            bf16* op = WSB(WS_WUQL) + (size_t)(h * 256 + ct * 32) * 256 + kt * 32 + r32;
#pragma unroll
            for (int r = 0; r < 16; ++r) op[(size_t)att::crow(r, hi) * 256] = (bf16)f2bf(acc[r]);
        }
    }
}
__device__ __forceinline__ void p_mla_mid(ArgsP a, const Ctx& c0) {
    const Ctx c = refresh(c0);
    const float* A1 = WSF(WS_A1); bf16* CQN = WSB(WS_CQN); bf16* CKVN = WSB(WS_CKVN); bf16* KPEB = WSB(WS_KPE); const float* ROPE = WSF(WS_ROPE); float* out = a->out;
    const f32x4 gq = *(const f32x4*)(IN_F(12) + 4 * c.lane), gk = *(const f32x4*)(IN_F(14) + 4 * c.lane);
    constexpr int NR = 4;
    for (int r0 = c.gw; r0 < R; r0 += NR * c.ngw) {
        f32x4 cq[NR], ck[NR]; float sq[NR], sk[NR], x1[NR], x2[NR], cs[NR], sn[NR];
#pragma unroll
        for (int q = 0; q < NR; ++q) { const int r = r0 + q * c.ngw < R ? r0 + q * c.ngw : r0; const float* row = A1 + (size_t)r * NIN0;
            cq[q] = *(const f32x4*)(row + 4 * c.lane); ck[q] = *(const f32x4*)(row + 256 + 4 * c.lane);
            const int j = c.lane & 15; x1[q] = row[512 + j]; x2[q] = row[528 + j]; cs[q] = ROPE[(size_t)r * 32 + j]; sn[q] = ROPE[(size_t)r * 32 + 16 + j];
            sq[q] = (cq[q].x * cq[q].x + cq[q].y * cq[q].y) + (cq[q].z * cq[q].z + cq[q].w * cq[q].w); sk[q] = (ck[q].x * ck[q].x + ck[q].y * ck[q].y) + (ck[q].z * ck[q].z + ck[q].w * ck[q].w); }
#pragma unroll
        for (int sh = 1; sh < 64; sh <<= 1) {
#pragma unroll
            for (int q = 0; q < NR; ++q) { sq[q] += __shfl_xor(sq[q], sh); sk[q] += __shfl_xor(sk[q], sh); } }
#pragma unroll
        for (int q = 0; q < NR; ++q) { const int r = r0 + q * c.ngw < R ? r0 + q * c.ngw : r0; const int pos = row_pos(r);
            const float rq = 1.0f / sqrtf(sq[q] * (1.f / 256) + EPS), rk = 1.0f / sqrtf(sk[q] * (1.f / 256) + EPS);
            const f32x4 qn = cq[q] * rq * gq, kn = ck[q] * rk * gk;
            u32x2 o; o.x = pk2(qn.x, qn.y); o.y = pk2(qn.z, qn.w); *(u32x2*)(CQN + (size_t)r * 256 + 4 * c.lane) = o;
            o.x = pk2(kn.x, kn.y); o.y = pk2(kn.z, kn.w); *(u32x2*)(CKVN + (size_t)r * 256 + 4 * c.lane) = o;
            float* ockv; float* okpe;
            if (r < RSAMP0) { const int b = r < RMAIN ? (r >> 12) : ((r - RMAIN) >> 4); ockv = out + O_CKVP + ((size_t)b * TP + pos) * 256; okpe = out + O_KPEP + ((size_t)b * TP + pos) * 32; }
            else { ockv = out + O_CKVS + (size_t)(r - RSAMP0) * 256; okpe = out + O_KPES + (size_t)(r - RSAMP0) * 32; }
            *(f32x4*)(ockv + 4 * c.lane) = kn;
            if (c.lane < 16) { const int j = c.lane; const float o1 = x1[q] * cs[q] - x2[q] * sn[q], o2 = x1[q] * sn[q] + x2[q] * cs[q]; okpe[j] = o1; okpe[16 + j] = o2;
                KPEB[(size_t)r * 32 + j] = (bf16)f2bf(o1); KPEB[(size_t)r * 32 + 16 + j] = (bf16)f2bf(o2); } }
    }
}
__device__ __forceinline__ void p_q_post(ArgsP a, const Ctx& c0) {
    const Ctx c = refresh(c0);
    for (int r = c.gw; r < R; r += c.ngw) {
        const float* row = WSF(WS_QRAW) + (size_t)r * NUQ; const int pos = row_pos(r);
        const float qs = QSCALE;
#pragma unroll
        for (int j = 0; j < 4; ++j) { const f32x4 v = *(const f32x4*)(row + 4 * c.lane + 256 * j) * qs; u32x2 o; o.x = pk2(v.x, v.y); o.y = pk2(v.z, v.w); *(u32x2*)(WSB(WS_QN) + (size_t)r * 1024 + 4 * c.lane + 256 * j) = o; }
#pragma unroll
        for (int j = 0; j < 4; ++j) { const int p = c.lane + 64 * j, h = p >> 4, jj = p & 15; const float x1 = row[1024 + 2 * p], x2 = row[1024 + 2 * p + 1]; float cs, sn; rope_cs(pos, jj, cs, sn);
            WSB(WS_QPE)[(size_t)r * 512 + h * 32 + jj] = (bf16)f2bf((x1 * cs - x2 * sn) * qs); WSB(WS_QPE)[(size_t)r * 512 + h * 32 + 16 + jj] = (bf16)f2bf((x1 * sn + x2 * cs) * qs); }
    }
}
__device__ __forceinline__ void p_qlat(ArgsP a, const Ctx& c0) {
    const Ctx c = refresh(c0);
    const float* wuk = IN_F(15);
    for (int it = c.gw; it < DB * DS * NH; it += c.ngw) {
        const int i = it >> 4, h = it & 15;
        const float q = WSF(WS_QRAW)[(size_t)(RSAMP0 + i) * NUQ + h * 64 + c.lane];
        float acc[4] = {0.f, 0.f, 0.f, 0.f};
#pragma unroll 8
        for (int n = 0; n < 64; ++n) { const float qn = __shfl(q, n);
#pragma unroll
            for (int k = 0; k < 4; ++k) acc[k] += qn * wuk[(size_t)(c.lane + 64 * k) * 1024 + h * 64 + n]; }
#pragma unroll
        for (int k = 0; k < 4; ++k) WSB(WS_QLAT)[((size_t)i * 16 + h) * 256 + c.lane + 64 * k] = (bf16)f2bf(acc[k] * QSCALE);
    }
}
template <bool META_ONLY>
__device__ __forceinline__ void p_attn_prompt_naive(ArgsP a, const Ctx& c0) {
    const Ctx c = refresh(c0);
    const bf16* QN = WSB(WS_QN); const bf16* QPE = WSB(WS_QPE); const bf16* KNV = WSB(WS_KNV); const bf16* KPE = WSB(WS_KPE);
    for (int item = c.gw + (META_ONLY ? (RMAIN / 64) * NH : 0); item < (RPROMPT / 64) * NH; item += c.ngw) {
        const int rb = item >> 4, h = item & 15, r = rb * 64 + c.lane;
        int b, nk;
        if (r < RMAIN) { b = r >> 12; nk = NMETA + (r & 4095) + 1; } else { const int i = r - RMAIN; b = i >> 4; nk = (i & 15) + 1; }
        const int mbase = RMAIN + 16 * b, tbase = 4096 * b;
        float qn[64], qp[32], o[64];
#pragma unroll
        for (int j = 0; j < 8; ++j) { const u32x4 v = *(const u32x4*)(QN + (size_t)r * 1024 + h * 64 + 8 * j);
            qn[8 * j] = bflo(v.x); qn[8 * j + 1] = bfhi(v.x); qn[8 * j + 2] = bflo(v.y); qn[8 * j + 3] = bfhi(v.y); qn[8 * j + 4] = bflo(v.z); qn[8 * j + 5] = bfhi(v.z); qn[8 * j + 6] = bflo(v.w); qn[8 * j + 7] = bfhi(v.w); }
#pragma unroll
        for (int j = 0; j < 4; ++j) { const u32x4 v = *(const u32x4*)(QPE + (size_t)r * 512 + h * 32 + 8 * j);
            qp[8 * j] = bflo(v.x); qp[8 * j + 1] = bfhi(v.x); qp[8 * j + 2] = bflo(v.y); qp[8 * j + 3] = bfhi(v.y); qp[8 * j + 4] = bflo(v.z); qp[8 * j + 5] = bfhi(v.z); qp[8 * j + 6] = bflo(v.w); qp[8 * j + 7] = bfhi(v.w); }
#pragma unroll
        for (int j = 0; j < 64; ++j) o[j] = 0.f;
        float m = -INFINITY, l = 0.f;
        const int nkmax = wave_max_i(nk);
        for (int kk = 0; kk < nkmax; ++kk) {
            if (kk < nk) {
                const int kr = kk < NMETA ? mbase + kk : tbase + kk - NMETA;
                const bf16* kn = KNV + (size_t)kr * 2048 + h * 64; const bf16* kp = KPE + (size_t)kr * 32; const bf16* vv = kn + 1024;
                float s = 0.f;
#pragma unroll
                for (int j = 0; j < 8; ++j) { const u32x4 v = *(const u32x4*)(kn + 8 * j);
                    s += qn[8 * j] * bflo(v.x) + qn[8 * j + 1] * bfhi(v.x) + qn[8 * j + 2] * bflo(v.y) + qn[8 * j + 3] * bfhi(v.y) + qn[8 * j + 4] * bflo(v.z) + qn[8 * j + 5] * bfhi(v.z) + qn[8 * j + 6] * bflo(v.w) + qn[8 * j + 7] * bfhi(v.w); }
#pragma unroll
                for (int j = 0; j < 4; ++j) { const u32x4 v = *(const u32x4*)(kp + 8 * j);
                    s += qp[8 * j] * bflo(v.x) + qp[8 * j + 1] * bfhi(v.x) + qp[8 * j + 2] * bflo(v.y) + qp[8 * j + 3] * bfhi(v.y) + qp[8 * j + 4] * bflo(v.z) + qp[8 * j + 5] * bfhi(v.z) + qp[8 * j + 6] * bflo(v.w) + qp[8 * j + 7] * bfhi(v.w); }
                const float mn = fmaxf(m, s), corr = exp2f(m - mn), p = exp2f(s - mn);
                l = l * corr + p; m = mn;
#pragma unroll
                for (int j = 0; j < 8; ++j) { const u32x4 v = *(const u32x4*)(vv + 8 * j);
                    o[8 * j] = o[8 * j] * corr + p * bflo(v.x); o[8 * j + 1] = o[8 * j + 1] * corr + p * bfhi(v.x); o[8 * j + 2] = o[8 * j + 2] * corr + p * bflo(v.y); o[8 * j + 3] = o[8 * j + 3] * corr + p * bfhi(v.y);
                    o[8 * j + 4] = o[8 * j + 4] * corr + p * bflo(v.z); o[8 * j + 5] = o[8 * j + 5] * corr + p * bfhi(v.z); o[8 * j + 6] = o[8 * j + 6] * corr + p * bflo(v.w); o[8 * j + 7] = o[8 * j + 7] * corr + p * bfhi(v.w); }
            }
        }
        const float il = 1.0f / l;
#pragma unroll
        for (int j = 0; j < 8; ++j) { u32x4 w; w.x = pk2(o[8 * j] * il, o[8 * j + 1] * il); w.y = pk2(o[8 * j + 2] * il, o[8 * j + 3] * il); w.z = pk2(o[8 * j + 4] * il, o[8 * j + 5] * il); w.w = pk2(o[8 * j + 6] * il, o[8 * j + 7] * il);
            *(u32x4*)(WSB(WS_O) + (size_t)r * 1024 + h * 64 + 8 * j) = w; }
    }
}
__device__ __forceinline__ void p_attn_decode_naive(ArgsP a, const Ctx& c0) {
    const Ctx c = refresh(c0);
    const float* cckv = IN_F(2); const float* ckpe = IN_F(3); const int* pt = (const int*)a->in[5];
    for (int item = c.gw; item < DB * NH; item += c.ngw) {
        const int db = item >> 4, h = item & 15;
        f32x4 ql[4]; float qp[4], m[4], l[4]; f32x4 o[4];
#pragma unroll
        for (int t = 0; t < 4; ++t) { const u32x2 v = *(const u32x2*)(WSB(WS_QLAT) + ((size_t)(db * 4 + t) * 16 + h) * 256 + 4 * c.lane);
            ql[t] = (f32x4){bflo(v.x), bfhi(v.x), bflo(v.y), bfhi(v.y)};
            qp[t] = c.lane < 32 ? bf2f(WSB(WS_QPE)[(size_t)(RSAMP0 + db * 4 + t) * 512 + h * 32 + c.lane]) : 0.f;
            m[t] = -INFINITY; l[t] = 0.f; o[t] = (f32x4){0.f, 0.f, 0.f, 0.f}; }
        for (int p = 0; p < NPAGES; ++p) {
            const int page = pt[db * NPAGES + p];
            for (int k = 0; k < PAGE; ++k) {
                const size_t kr = (size_t)page * PAGE + k;
                const f32x4 cv = *(const f32x4*)(cckv + kr * 256 + 4 * c.lane); const float e = c.lane < 32 ? ckpe[kr * 32 + c.lane] : 0.f;
#pragma unroll
                for (int t = 0; t < 4; ++t) {
                    float d = (ql[t].x * cv.x + ql[t].y * cv.y) + (ql[t].z * cv.z + ql[t].w * cv.w) + qp[t] * e;
                    d = wave_sum(d);
                    const float mn = fmaxf(m[t], d), corr = exp2f(m[t] - mn), pp = exp2f(d - mn);
                    l[t] = l[t] * corr + pp; m[t] = mn; o[t] = o[t] * corr + pp * cv;
                }
            }
        }
#pragma unroll
        for (int s2 = 0; s2 < 4; ++s2) {
            const int kr = RSAMP0 + db * 4 + s2;
            const u32x2 v = *(const u32x2*)(WSB(WS_CKVN) + (size_t)kr * 256 + 4 * c.lane); const f32x4 cv = (f32x4){bflo(v.x), bfhi(v.x), bflo(v.y), bfhi(v.y)};
            const float e = c.lane < 32 ? bf2f(WSB(WS_KPE)[(size_t)kr * 32 + c.lane]) : 0.f;
#pragma unroll
            for (int t = 0; t < 4; ++t) if (t >= s2) {
                float d = (ql[t].x * cv.x + ql[t].y * cv.y) + (ql[t].z * cv.z + ql[t].w * cv.w) + qp[t] * e;
                d = wave_sum(d);
                const float mn = fmaxf(m[t], d), corr = exp2f(m[t] - mn), pp = exp2f(d - mn);
                l[t] = l[t] * corr + pp; m[t] = mn; o[t] = o[t] * corr + pp * cv;
            }
        }
#pragma unroll
        for (int t = 0; t < 4; ++t) *(f32x4*)(WSF(WS_OLAT) + ((size_t)(db * 4 + t) * 16 + h) * 256 + 4 * c.lane) = o[t] * (1.0f / l[t]);
    }
}
__device__ __forceinline__ void p_olat_up(ArgsP a, const Ctx& c0) {
    const Ctx c = refresh(c0);
    const float* wuv = IN_F(16);
    for (int it = c.gw; it < DB * DS * NH; it += c.ngw) {
        const int i = it >> 4, h = it & 15; const float* ol = WSF(WS_OLAT) + ((size_t)i * 16 + h) * 256;
        float acc = 0.f;
#pragma unroll 8
        for (int cc = 0; cc < 256; ++cc) acc += ol[cc] * wuv[(size_t)cc * 1024 + h * 64 + c.lane];
        WSB(WS_O)[(size_t)(RSAMP0 + i) * 1024 + h * 64 + c.lane] = (bf16)f2bf(acc);
    }
}
template <bool FINAL, int NSPLIT, bool FIRST = false>
__device__ __forceinline__ void p_post_res(ArgsP a, const Ctx& c0, const float* gpost, const float* gnext) {
    const Ctx c = refresh(c0);
    const bf16* Mb = WSB(WS_M); float* X = WSF(WS_X); bf16* H = WSB(WS_H); const float* MT = WSF(WS_MT); const float* xin = IN_F(0); float* out = a->out;
    f32x4 gp[4], gn[4];
#pragma unroll
    for (int j = 0; j < 4; ++j) { gp[j] = *(const f32x4*)(gpost + 4 * c.lane + 256 * j); gn[j] = FINAL ? gp[j] : *(const f32x4*)(gnext + 4 * c.lane + 256 * j); }
    constexpr int NR = 4;
    for (int r0 = c.gw; r0 < RMAIN; r0 += NR * c.ngw) {
        f32x4 mv[NR][4], xv[NR][4]; float s[NR], s2[NR];
#pragma unroll
        for (int q = 0; q < NR; ++q) { const int r = r0 + q * c.ngw < RMAIN ? r0 + q * c.ngw : r0;
            s[q] = 0.f;
#pragma unroll
            for (int j = 0; j < 4; ++j) { const u32x2 mb = *(const u32x2*)(Mb + (size_t)r * D + 4 * c.lane + 256 * j); mv[q][j] = (f32x4){bflo(mb.x), bfhi(mb.x), bflo(mb.y), bfhi(mb.y)};
                xv[q][j] = *(const f32x4*)((FIRST ? xin : (const float*)X) + (size_t)r * D + 4 * c.lane + 256 * j);
                s[q] += (mv[q][j].x * mv[q][j].x + mv[q][j].y * mv[q][j].y) + (mv[q][j].z * mv[q][j].z + mv[q][j].w * mv[q][j].w); } }
#pragma unroll
        for (int o = 1; o < 64; o <<= 1) {
#pragma unroll
            for (int q = 0; q < NR; ++q) s[q] += __shfl_xor(s[q], o); }
#pragma unroll
        for (int q = 0; q < NR; ++q) { const float rm = 1.0f / sqrtf(s[q] * (1.f / D) + EPS); s2[q] = 0.f;
#pragma unroll
            for (int j = 0; j < 4; ++j) { xv[q][j] = xv[q][j] + mv[q][j] * rm * gp[j]; s2[q] += (xv[q][j].x * xv[q][j].x + xv[q][j].y * xv[q][j].y) + (xv[q][j].z * xv[q][j].z + xv[q][j].w * xv[q][j].w); } }
        if (!FINAL) {
#pragma unroll
            for (int o = 1; o < 64; o <<= 1) {
#pragma unroll
                for (int q = 0; q < NR; ++q) s2[q] += __shfl_xor(s2[q], o); }
        }
#pragma unroll
        for (int q = 0; q < NR; ++q) { const int r = r0 + q * c.ngw < RMAIN ? r0 + q * c.ngw : r0;
            if (FINAL) {
#pragma unroll
                for (int j = 0; j < 4; ++j) *(f32x4*)(out + O_YP + (size_t)r * D + 4 * c.lane + 256 * j) = xv[q][j];
            } else { const float rx = 1.0f / sqrtf(s2[q] * (1.f / D) + EPS);
#pragma unroll
                for (int j = 0; j < 4; ++j) { *(f32x4*)(X + (size_t)r * D + 4 * c.lane + 256 * j) = xv[q][j];
                    u32x2 o; o.x = pk2(xv[q][j].x * rx * gn[j].x, xv[q][j].y * rx * gn[j].y); o.y = pk2(xv[q][j].z * rx * gn[j].z, xv[q][j].w * rx * gn[j].w); *(u32x2*)(H + (size_t)r * D + 4 * c.lane + 256 * j) = o; } } }
    }
    for (int r = RMAIN + c.gw; r < R; r += c.ngw) {
        float* xrow = X + (size_t)r * D;
        f32x4 mv[4], xv[4]; float s = 0.f;
#pragma unroll
        for (int j = 0; j < 4; ++j) { mv[j] = (f32x4){0.f, 0.f, 0.f, 0.f};
            f32x4 part[NSPLIT];
#pragma unroll
            for (int sp = 0; sp < NSPLIT; ++sp) part[sp] = *(const f32x4*)(MT + ((size_t)sp * (RP - RMAIN) + (r - RMAIN)) * D + 4 * c.lane + 256 * j);
#pragma unroll
            for (int sp = 0; sp < NSPLIT; ++sp) mv[j] += part[sp];
            xv[j] = *(const f32x4*)(xrow + 4 * c.lane + 256 * j); s += (mv[j].x * mv[j].x + mv[j].y * mv[j].y) + (mv[j].z * mv[j].z + mv[j].w * mv[j].w); }
        const float rm = 1.0f / sqrtf(wave_sum(s) * (1.f / D) + EPS); float s2 = 0.f;
#pragma unroll
        for (int j = 0; j < 4; ++j) { xv[j] = xv[j] + mv[j] * rm * gp[j]; s2 += (xv[j].x * xv[j].x + xv[j].y * xv[j].y) + (xv[j].z * xv[j].z + xv[j].w * xv[j].w); }
        if (FINAL) {
            if (r < RSAMP0) continue;
#pragma unroll
            for (int j = 0; j < 4; ++j) *(f32x4*)(out + O_YS + (size_t)(r - RSAMP0) * D + 4 * c.lane + 256 * j) = xv[j];
        } else {
            const float rx = 1.0f / sqrtf(wave_sum(s2) * (1.f / D) + EPS);
#pragma unroll
            for (int j = 0; j < 4; ++j) { *(f32x4*)(xrow + 4 * c.lane + 256 * j) = xv[j];
                u32x2 o; o.x = pk2(xv[j].x * rx * gn[j].x, xv[j].y * rx * gn[j].y); o.y = pk2(xv[j].z * rx * gn[j].z, xv[j].w * rx * gn[j].w); *(u32x2*)(H + (size_t)r * D + 4 * c.lane + 256 * j) = o; }
        }
    }
}

__device__ __forceinline__ void p_gate(ArgsP a, const Ctx& c0) {
    const Ctx c = refresh(c0);
    const float* wg = IN_F(19); const float* bg = IN_F(20);
    const size_t gt = (size_t)c.gw * 64 + c.lane, ngt = (size_t)c.ngw * 64;
    for (size_t i = gt + (size_t)(USE_NAIVE_GLA ? 0 : RSAMP0) * 512; i < (size_t)R * 512; i += ngt) {
        const int r = (int)(i >> 9), col = (int)(i & 511); const float* gd = WSF(WS_GD) + (size_t)r * 16;
        float x = bg[col];
#pragma unroll
        for (int j = 0; j < 16; ++j) x += gd[j] * wg[j * 512 + col];
        const float ls = fminf(x, 0.f) - log1pf(__expf(-fabsf(x)));
        const float la = ls * (1.0f / 16.0f);
        WSF(WS_LA)[i] = la; WSF(WS_EA)[i] = __expf(la);
    }
}
__device__ __forceinline__ void gla_step(float (&S)[128], float& o, float a0, float a1, float k0, float k1, float q0, float q1, float v) {
    o = 0.f;
#pragma unroll
    for (int d = 0; d < 64; ++d) { const float ad = rdlane(a0, d), kd = rdlane(k0, d), qd = rdlane(q0, d); S[d] = ad * S[d] + kd * v; o += qd * S[d]; }
#pragma unroll
    for (int d = 0; d < 64; ++d) { const float ad = rdlane(a1, d), kd = rdlane(k1, d), qd = rdlane(q1, d); S[64 + d] = ad * S[64 + d] + kd * v; o += qd * S[64 + d]; }
}
__device__ __forceinline__ void p_gla_naive(ArgsP a, const Ctx& c0) {
    const Ctx c = refresh(c0);
    const float* EA = WSF(WS_EA); const bf16* KG = WSB(WS_KG); const bf16* QG = WSB(WS_QG); const bf16* VG = WSB(WS_VG); float* OGR = WSF(WS_OGRAW);
    for (int item = c.gwT; item < (USE_NAIVE_GLA ? NB * GH * 4 : 0); item += c.ngw) {
        const int b = item >> 4, h = (item >> 2) & 3, dv = (item & 3) * 64 + c.lane;
        float S[128];
#pragma unroll
        for (int d = 0; d < 128; ++d) S[d] = 0.f;
        for (int tt = 0; tt < TP; ++tt) {
            const int row = tt < NMETA ? RMAIN + 16 * b + tt : 4096 * b + tt - NMETA;
            const size_t g = (size_t)row * 512 + h * 128;
            const float a0 = EA[g + c.lane], a1 = EA[g + 64 + c.lane], k0 = bf2f(KG[g + c.lane]), k1 = bf2f(KG[g + 64 + c.lane]), q0 = bf2f(QG[g + c.lane]), q1 = bf2f(QG[g + 64 + c.lane]);
            const float v = bf2f(VG[(size_t)row * 1024 + h * 256 + dv]);
            float o; gla_step(S, o, a0, a1, k0, k1, q0, q1, v);
            OGR[(size_t)row * 1024 + h * 256 + dv] = o;
        }
        float* outp = a->out + O_GLAP + ((size_t)(b * 4 + h) * 128) * 256 + dv;
#pragma unroll
        for (int d = 0; d < 128; ++d) outp[(size_t)d * 256] = S[d];
    }
    const int wg0 = USE_NAIVE_GLA ? 0 : NB * GH * gla::NSP; if ((int)blockIdx.x < wg0) return;
    for (int item = c.wave * ((int)gridDim.x - wg0) + ((int)blockIdx.x - wg0); item < DB * GH * 4; item += c.ngw - wg0 * 8) {
        const int db = item >> 4, h = (item >> 2) & 3, dv = (item & 3) * 64 + c.lane;
        const float* sp = IN_F(4) + ((size_t)(db * 4 + h) * 128) * 256 + dv;
        float S[128];
#pragma unroll
        for (int d = 0; d < 128; ++d) S[d] = sp[(size_t)d * 256];
#pragma unroll 1
        for (int s = 0; s < DS; ++s) {
            const int row = RSAMP0 + db * 4 + s; const size_t g = (size_t)row * 512 + h * 128;
            const float a0 = EA[g + c.lane], a1 = EA[g + 64 + c.lane], k0 = bf2f(KG[g + c.lane]), k1 = bf2f(KG[g + 64 + c.lane]), q0 = bf2f(QG[g + c.lane]), q1 = bf2f(QG[g + 64 + c.lane]);
            const float v = bf2f(VG[(size_t)row * 1024 + h * 256 + dv]);
            float o; gla_step(S, o, a0, a1, k0, k1, q0, q1, v);
            OGR[(size_t)row * 1024 + h * 256 + dv] = o;
        }
        float* outp = a->out + O_GLAS + ((size_t)(db * 4 + h) * 128) * 256 + dv;
#pragma unroll
        for (int d = 0; d < 128; ++d) outp[(size_t)d * 256] = S[d];
    }
}
__device__ __forceinline__ void p_gla_post(ArgsP a, const Ctx& c0) {
    const Ctx c = refresh(c0);
    const bf16* OGR = WSB(WS_OGRAW); const bf16* RG = WSB(WS_RG); bf16* OG = WSB(WS_OG);
    const f32x4 g = *(const f32x4*)(IN_F(21) + 4 * c.lane);
    constexpr int NR = 2;
    for (int r0 = c.gw; r0 < R; r0 += NR * c.ngw) {
        f32x4 o[NR][4]; u32x2 rv[NR][4]; float s[NR][4];
#pragma unroll
        for (int q = 0; q < NR; ++q) { const int r = r0 + q * c.ngw < R ? r0 + q * c.ngw : r0;
#pragma unroll
            for (int h = 0; h < 4; ++h) { const size_t off = (size_t)r * 1024 + h * 256 + 4 * c.lane;
                const u32x2 ob = *(const u32x2*)(OGR + ((size_t)(h * 8 + (c.lane >> 3)) * RP + r) * 32 + 4 * (c.lane & 7)); o[q][h] = (f32x4){bflo(ob.x), bfhi(ob.x), bflo(ob.y), bfhi(ob.y)}; rv[q][h] = *(const u32x2*)(RG + off);
                s[q][h] = (o[q][h].x * o[q][h].x + o[q][h].y * o[q][h].y) + (o[q][h].z * o[q][h].z + o[q][h].w * o[q][h].w); } }
#pragma unroll
        for (int sh = 1; sh < 64; sh <<= 1) {
#pragma unroll
            for (int q = 0; q < NR; ++q)
#pragma unroll
                for (int h = 0; h < 4; ++h) s[q][h] += __shfl_xor(s[q][h], sh); }
#pragma unroll
        for (int q = 0; q < NR; ++q) { const int r = r0 + q * c.ngw < R ? r0 + q * c.ngw : r0;
#pragma unroll
            for (int h = 0; h < 4; ++h) { const size_t off = (size_t)r * 1024 + h * 256 + 4 * c.lane;
                const float rs = 1.0f / sqrtf(s[q][h] * (1.f / 256) + EPS);
                const f32x4 rr = (f32x4){bflo(rv[q][h].x), bfhi(rv[q][h].x), bflo(rv[q][h].y), bfhi(rv[q][h].y)};
                f32x4 sl; sl.x = rr.x / (1.f + __expf(-rr.x)); sl.y = rr.y / (1.f + __expf(-rr.y)); sl.z = rr.z / (1.f + __expf(-rr.z)); sl.w = rr.w / (1.f + __expf(-rr.w));
                const f32x4 y = o[q][h] * rs * g * sl;
                u32x2 w; w.x = pk2(y.x, y.y); w.y = pk2(y.z, y.w); *(u32x2*)(OG + off) = w; } }
    }
}


namespace gla {
using att::bf16x8; using att::f32x16; using att::crow; using att::cvtpk;
constexpr int NCH = 65, NITEM = NB * GH * NCH;
constexpr int P_GD = 0, P_GSUM = 4096, P_QL = 6144, P_KL = P_QL + 64 * 272, P_VS = P_KL + 64 * 272, P_AL = P_VS + 64 * 528, P_END = P_AL + 64 * 144;
__device__ __forceinline__ int chunk_row(int b, int c, int tok) { return c == 0 ? RMAIN + 16 * b + tok : 4096 * b + 64 * (c - 1) + tok; }
__device__ __forceinline__ float logsig16(float x) { return (fminf(x, 0.f) - __logf(1.0f + __expf(-fabsf(x)))) * (1.0f / 16.0f); }
__device__ __forceinline__ void prep_item(ArgsP a, int item, LAS unsigned char* lds, int wave_id) {
    const int tid = fresh_tid(wave_id), lane = tid & 63, r32 = lane & 31, hi = lane >> 5; const int wid = wave_id;
    const int bh = item / NCH, c = item % NCH, b = bh >> 2, h = bh & 3;
    const int nvalid = c == 0 ? NMETA : 64;
    bf16* QINF = WSB(WS_QINF) + (size_t)item * 8192; bf16* KDTF = WSB(WS_KDTF) + (size_t)item * 8192; bf16* AMF = WSB(WS_AMF) + (size_t)item * 4096; bf16* VTF = WSB(WS_VTF) + (size_t)item * 16384; float* ELF = WSF(WS_ELF) + (size_t)item * 256;
    LAS float* GDL = (LAS float*)(lds + P_GD); LAS float* GSUM = (LAS float*)(lds + P_GSUM); LAS bf16* QL = (LAS bf16*)(lds + P_QL); LAS bf16* KL = (LAS bf16*)(lds + P_KL); LAS bf16* VS = (LAS bf16*)(lds + P_VS); LAS bf16* AL = (LAS bf16*)(lds + P_AL);
    const u32x4 z4 = (u32x4){0u, 0u, 0u, 0u};
#pragma unroll
    for (int j = 0; j < 2; ++j) { const int idx = tid + 512 * j, row = idx >> 4, ch = idx & 15; const bool ok = row < nvalid; const size_t g = (size_t)chunk_row(b, c, ok ? row : 0) * 512 + h * 128 + ch * 8;
        *(LAS u32x4*)(QL + row * 136 + ch * 8) = ok ? *(const u32x4*)(WSB(WS_QG) + g) : z4; *(LAS u32x4*)(KL + row * 136 + ch * 8) = ok ? *(const u32x4*)(WSB(WS_KG) + g) : z4; }
#pragma unroll
    for (int j = 0; j < 4; ++j) { const int idx = tid + 512 * j, row = idx >> 5, ch = idx & 31; const bool ok = row < nvalid;
        *(LAS u32x4*)(VS + row * 264 + ch * 8) = ok ? *(const u32x4*)(WSB(WS_VG) + (size_t)chunk_row(b, c, ok ? row : 0) * 1024 + h * 256 + ch * 8) : z4; }
    if (tid < 256) { const int row = tid >> 2, ch = tid & 3; const bool ok = row < nvalid; *(LAS f32x4*)(GDL + row * 16 + ch * 4) = ok ? *(const f32x4*)(WSF(WS_GD) + (size_t)chunk_row(b, c, ok ? row : 0) * 16 + ch * 4) : (f32x4){0.f, 0.f, 0.f, 0.f}; }
    __syncthreads();
    const int dk = tid & 127, tg = tid >> 7;
    float bloc[16];
    {
        float w[16]; const float* wg = IN_F(19) + h * 128 + dk;
#pragma unroll
        for (int j = 0; j < 16; ++j) w[j] = wg[j * 512];
        const float bg = IN_F(20)[h * 128 + dk];
        float run = 0.f;
#pragma unroll
        for (int i = 0; i < 16; ++i) {
            const int tok = tg * 16 + i; float x = bg;
#pragma unroll
            for (int j4 = 0; j4 < 4; ++j4) { const f32x4 gd = *(const LAS f32x4*)(GDL + tok * 16 + j4 * 4); x += gd.x * w[4 * j4] + gd.y * w[4 * j4 + 1] + gd.z * w[4 * j4 + 2] + gd.w * w[4 * j4 + 3]; }
            const float g = tok < nvalid ? logsig16(x) : 0.f;
            run += g; bloc[i] = run;
        }
        GSUM[tg * 128 + dk] = run;
    }
    __syncthreads();
    float off = 0.f, blast = 0.f;
#pragma unroll
    for (int t = 0; t < 4; ++t) { const float s = GSUM[t * 128 + dk]; if (t < tg) off += s; blast += s; }
    {
        unsigned kdp[8];
#pragma unroll
        for (int i = 0; i < 16; i += 2) {
            float kd2[2];
#pragma unroll
            for (int e = 0; e < 2; ++e) {
                const int tok = tg * 16 + i + e; const float bb = bloc[i + e] + off; const float q = bf2f(QL[tok * 136 + dk]), k = bf2f(KL[tok * 136 + dk]);
                QL[tok * 136 + dk] = (bf16)f2bf(q * __expf(bb)); KL[tok * 136 + dk] = (bf16)f2bf(k * __expf(-bb)); kd2[e] = k * __expf(blast - bb);
            }
            kdp[i >> 1] = pk2(kd2[0], kd2[1]);
        }
        bf16* kp = KDTF + ((size_t)(((dk >> 5) * 4 + tg) * 64) + (dk & 31)) * 8;
        *(u32x4*)(kp) = (u32x4){kdp[0], kdp[1], kdp[2], kdp[3]}; *(u32x4*)(kp + 32 * 8) = (u32x4){kdp[4], kdp[5], kdp[6], kdp[7]};
        if (tg == 0) ELF[dk] = __expf(blast);
    }
    {
        const int dv = tid & 255, half = tid >> 8;
#pragma unroll
        for (int u = 0; u < 4; ++u) {
            unsigned pk[4];
#pragma unroll
            for (int e = 0; e < 4; ++e) { const int tok = half * 32 + u * 8 + e * 2; pk[e] = (unsigned)VS[tok * 264 + dv] | ((unsigned)VS[(tok + 1) * 264 + dv] << 16); }
            const int s = 2 * half + (u >> 1), uh = u & 1;
            *(u32x4*)(VTF + ((size_t)(((dv >> 5) * 4 + s) * 64) + uh * 32 + (dv & 31)) * 8) = (u32x4){pk[0], pk[1], pk[2], pk[3]};
        }
    }
    __syncthreads();
#pragma unroll
    for (int uu = 0; uu < 2; ++uu) {
        const int U = tid + 512 * uu, lp = U & 63, s8 = (U >> 6) & 7, tt = U >> 9; const int tok = tt * 32 + (lp & 31), hh = lp >> 5;
        const u32x2 lo = *(const LAS u32x2*)(QL + tok * 136 + 16 * s8 + 4 * hh), hi2 = *(const LAS u32x2*)(QL + tok * 136 + 16 * s8 + 8 + 4 * hh);
        *(u32x4*)(QINF + (size_t)U * 8) = (u32x4){lo.x, lo.y, hi2.x, hi2.y};
    }
    if (wid < 3) {
        const int tt = wid == 0 ? 0 : 1, tp = wid == 2 ? 1 : 0;
        f32x16 acc = f32x16{};
#pragma unroll
        for (int s = 0; s < 8; ++s) {
            const bf16x8 af = *(const LAS bf16x8*)(QL + (tt * 32 + r32) * 136 + 16 * s + 8 * hi), bfr = *(const LAS bf16x8*)(KL + (tp * 32 + r32) * 136 + 16 * s + 8 * hi);
            acc = __builtin_amdgcn_mfma_f32_32x32x16_bf16(af, bfr, acc, 0, 0, 0);
        }
#pragma unroll
        for (int r = 0; r < 16; ++r) { const int tok = tt * 32 + crow(r, hi), tk = tp * 32 + r32; AL[tok * 72 + tk] = (bf16)f2bf(tk <= tok ? acc[r] : 0.f); }
    } else if (wid == 3) {
#pragma unroll
        for (int r = 0; r < 16; ++r) AL[crow(r, hi) * 72 + 32 + r32] = 0;
    }
    __syncthreads();
    { const int U = tid, lp = U & 63, s = (U >> 6) & 3, tt = U >> 8; const int tok = tt * 32 + (lp & 31), hh = lp >> 5;
      *(u32x4*)(AMF + (size_t)U * 8) = *(const LAS u32x4*)(AL + tok * 72 + 16 * s + 8 * hh); }
    __syncthreads();
}
constexpr int SM_A = 0, SM_K = 2048, SM_Q = 4096, SM_V = 6144, SM_O = 10240, SM_END = SM_O + 4 * 2 * 256 * 4;
__device__ __forceinline__ void sample_item(ArgsP a, int item, LAS unsigned char* lds, int wave_id) {
    const int tid = fresh_tid(wave_id);
    const int db = item >> 2, h = item & 3;
    LAS float* AS = (LAS float*)(lds + SM_A); LAS float* KS = (LAS float*)(lds + SM_K); LAS float* QS = (LAS float*)(lds + SM_Q); LAS float* VSm = (LAS float*)(lds + SM_V); LAS float* OS = (LAS float*)(lds + SM_O);
    { const int s = tid >> 7, dk = tid & 127, row = RSAMP0 + db * 4 + s; const float* gd = WSF(WS_GD) + (size_t)row * 16; const float* wg = IN_F(19) + h * 128 + dk;
      float x = IN_F(20)[h * 128 + dk];
#pragma unroll
      for (int j = 0; j < 16; ++j) x += gd[j] * wg[j * 512];
      AS[s * 128 + dk] = __expf(logsig16(x));
      const size_t g = (size_t)row * 512 + h * 128 + dk; KS[s * 128 + dk] = bf2f(WSB(WS_KG)[g]); QS[s * 128 + dk] = bf2f(WSB(WS_QG)[g]);
#pragma unroll
      for (int j = 0; j < 2; ++j) { const int e = tid + 512 * j, s2 = e >> 8, dv2 = e & 255; VSm[s2 * 256 + dv2] = bf2f(WSB(WS_VG)[(size_t)(RSAMP0 + db * 4 + s2) * 1024 + h * 256 + dv2]); } }
    const int dv = tid & 255, kh = tid >> 8;
    const unsigned voff = (unsigned)(kh * 64 * 256 + dv) * 4u;
    const unsigned char* sbase = (const unsigned char*)(IN_F(4) + (size_t)(db * 4 + h) * 128 * 256);
    __syncthreads();
    float S[64];
#pragma unroll
    for (int d4 = 0; d4 < 16; ++d4) { const GAS unsigned char* bp = (const GAS unsigned char*)sbase + d4 * 4096; asm volatile("" : "+s"(bp));
#pragma unroll
        for (int e = 0; e < 4; ++e) S[4 * d4 + e] = *(const GAS float*)(bp + e * 1024 + voff); }
#pragma unroll 1
    for (int s = 0; s < 4; ++s) {
        const float v = VSm[s * 256 + dv]; float o = 0.f;
#pragma unroll
        for (int d4 = 0; d4 < 16; ++d4) {
            if ((d4 & 3) == 0) __builtin_amdgcn_sched_barrier(0);
            const f32x4 av = *(const LAS f32x4*)(AS + s * 128 + kh * 64 + 4 * d4), kv = *(const LAS f32x4*)(KS + s * 128 + kh * 64 + 4 * d4), qv = *(const LAS f32x4*)(QS + s * 128 + kh * 64 + 4 * d4);
            S[4 * d4] = av.x * S[4 * d4] + kv.x * v; o += qv.x * S[4 * d4]; S[4 * d4 + 1] = av.y * S[4 * d4 + 1] + kv.y * v; o += qv.y * S[4 * d4 + 1];
            S[4 * d4 + 2] = av.z * S[4 * d4 + 2] + kv.z * v; o += qv.z * S[4 * d4 + 2]; S[4 * d4 + 3] = av.w * S[4 * d4 + 3] + kv.w * v; o += qv.w * S[4 * d4 + 3];
        }
        OS[(s * 2 + kh) * 256 + dv] = o;
    }
    unsigned char* obase = (unsigned char*)(a->out + O_GLAS + (size_t)(db * 4 + h) * 128 * 256);
#pragma unroll
    for (int d4 = 0; d4 < 16; ++d4) { GAS unsigned char* bp = (GAS unsigned char*)obase + d4 * 4096; asm volatile("" : "+s"(bp));
#pragma unroll
        for (int e = 0; e < 4; ++e) *(GAS float*)(bp + e * 1024 + voff) = S[4 * d4 + e]; }
    __syncthreads();
#pragma unroll
    for (int j = 0; j < 2; ++j) { const int e = tid + 512 * j, s2 = e >> 8, dv2 = e & 255; WSB(WS_OGRAW)[((size_t)(h * 8 + (dv2 >> 5)) * RP + (RSAMP0 + db * 4 + s2)) * 32 + (dv2 & 31)] = (bf16)f2bf(OS[(s2 * 2) * 256 + dv2] + OS[(s2 * 2 + 1) * 256 + dv2]); }
    __syncthreads();
}
__device__ __forceinline__ void prep_phase(ArgsP a, LAS unsigned char* lds, int wave_id) {
    for (int item = blockIdx.x; item < NITEM; item += gridDim.x) prep_item(a, item, lds, wave_id);
}
constexpr int S_QIN = 0, S_KDT = 16384, S_AM = 32768, S_EL = 40960, S_VT = 41984, S_SLOT = S_VT + NCW * 4096;
static_assert(3 * S_SLOT <= MISC_OFF, "scan ring fits under the control words");
constexpr int NPIECE = 41 + NCW * 4, NDMA = (NPIECE + (8 - NCW) - 1) / (8 - NCW);
__device__ __forceinline__ void scan_bh(ArgsP a, int bh, int part, LAS unsigned char* lds, int wave_id) {
    const int tid = fresh_tid(wave_id), lane = tid & 63, r32 = lane & 31, hi = lane >> 5; const int wid = wave_id;
    const int b = bh >> 2, h = bh & 3; const bool cw = wid < NCW; const int ds = part * NCW + (cw ? wid : 0);
    const unsigned char* const pq = (const unsigned char*)(WSB(WS_QINF) + (size_t)bh * NCH * 8192); const unsigned char* const pk = (const unsigned char*)(WSB(WS_KDTF) + (size_t)bh * NCH * 8192);
    const unsigned char* const pa = (const unsigned char*)(WSB(WS_AMF) + (size_t)bh * NCH * 4096); const unsigned char* const pe = (const unsigned char*)(WSF(WS_ELF) + (size_t)bh * NCH * 256);
    const unsigned char* const pv = (const unsigned char*)(WSB(WS_VTF) + (size_t)bh * NCH * 16384) + part * NCW * 4096;
    bf16* const ogbase = WSB(WS_OGRAW) + (size_t)(h * 8 + ds) * RP * 32 + r32;
#define GLA_DMA(c_, slot_) do { const size_t c64_ = (size_t)(c_); \
        _Pragma("unroll") for (int k_ = 0; k_ < NDMA; ++k_) { int i_ = (wid - NCW) + (8 - NCW) * k_; i_ = i_ < NPIECE ? i_ : 40; const unsigned char* g_; int lo_; \
            if (i_ < 16) { g_ = pq + c64_ * 16384 + i_ * 1024; lo_ = S_QIN + i_ * 1024; } \
            else if (i_ < 32) { g_ = pk + c64_ * 16384 + (i_ - 16) * 1024; lo_ = S_KDT + (i_ - 16) * 1024; } \
            else if (i_ < 40) { g_ = pa + c64_ * 8192 + (i_ - 32) * 1024; lo_ = S_AM + (i_ - 32) * 1024; } \
            else if (i_ == 40) { g_ = pe + c64_ * 1024; lo_ = S_EL; } \
            else { g_ = pv + c64_ * 32768 + (i_ - 41) * 1024; lo_ = S_VT + (i_ - 41) * 1024; } \
            __builtin_amdgcn_global_load_lds((const unsigned*)(g_ + lane * 16), (LAS unsigned*)(lds + (slot_) * S_SLOT + lo_), 16, 0, 0); } } while (0)
    f32x16 S[4]; S[0] = f32x16{}; S[1] = f32x16{}; S[2] = f32x16{}; S[3] = f32x16{};
    if (!cw) { GLA_DMA(0, 0); GLA_DMA(1, 1); }
    int slot = 0;
    for (int c = 0; c < NCH; ++c) {
        if (!cw) { if (c + 1 < NCH) asm volatile("s_waitcnt vmcnt(%0)" :: "n"(NDMA) : "memory"); else asm volatile("s_waitcnt vmcnt(0)" ::: "memory"); }
        asm volatile("s_waitcnt lgkmcnt(0)\n\ts_barrier" ::: "memory");
        const LAS unsigned char* sb = lds + slot * S_SLOT; const int slot2 = slot == 0 ? 2 : slot - 1;
        slot = slot == 2 ? 0 : slot + 1;
        if (!cw) { if (c + 2 < NCH) GLA_DMA(c + 2, slot2); continue; }
        bf16x8 vf[4];
#pragma unroll
        for (int s = 0; s < 4; ++s) vf[s] = *(const LAS bf16x8*)(sb + S_VT + (wid * 4 + s) * 1024 + lane * 16);
        u32x4 Sb[4][2];
#pragma unroll
        for (int T = 0; T < 4; ++T)
#pragma unroll
            for (int s = 0; s < 2; ++s)
#pragma unroll
                for (int i = 0; i < 4; ++i) Sb[T][s][i] = cvtpk(S[T][8 * s + 2 * i], S[T][8 * s + 2 * i + 1]);
        f32x16 o[2]; o[0] = f32x16{}; o[1] = f32x16{};
#pragma unroll
        for (int T = 0; T < 4; ++T)
#pragma unroll
            for (int g = 0; g < 4; ++g) { const f32x4 e = *(const LAS f32x4*)(sb + S_EL + (32 * T + 8 * g + 4 * hi) * 4); S[T][4 * g] *= e.x; S[T][4 * g + 1] *= e.y; S[T][4 * g + 2] *= e.z; S[T][4 * g + 3] *= e.w; }
#define GLA_QF(tt, k8) (*(const LAS bf16x8*)(sb + S_QIN + ((tt) * 8 + (k8)) * 1024 + lane * 16))
#define GLA_KF(T, s) (*(const LAS bf16x8*)(sb + S_KDT + ((T) * 4 + (s)) * 1024 + lane * 16))
#define GLA_AF(tt, s) (*(const LAS bf16x8*)(sb + S_AM + ((tt) * 4 + (s)) * 1024 + lane * 16))
#define GLA_LOADG(F, g) do { F[0] = GLA_QF(0, 2 * (g)); F[1] = GLA_QF(1, 2 * (g)); F[2] = GLA_QF(0, 2 * (g) + 1); F[3] = GLA_QF(1, 2 * (g) + 1); \
        F[4] = GLA_KF((2 * (g)) & 3, (g) >> 1); F[5] = GLA_KF((2 * (g) + 2) & 3, 2 + ((g) >> 1)); F[6] = GLA_KF((2 * (g) + 1) & 3, (g) >> 1); F[7] = GLA_KF((2 * (g) + 3) & 3, 2 + ((g) >> 1)); } while (0)
#define GLA_MMAG(F, g) do { \
        o[0] = __builtin_amdgcn_mfma_f32_32x32x16_bf16(F[0], __builtin_bit_cast(bf16x8, Sb[g][0]), o[0], 0, 0, 0); \
        S[(2 * (g)) & 3] = __builtin_amdgcn_mfma_f32_32x32x16_bf16(F[4], vf[(g) >> 1], S[(2 * (g)) & 3], 0, 0, 0); \
        o[1] = __builtin_amdgcn_mfma_f32_32x32x16_bf16(F[1], __builtin_bit_cast(bf16x8, Sb[g][0]), o[1], 0, 0, 0); \
        S[(2 * (g) + 2) & 3] = __builtin_amdgcn_mfma_f32_32x32x16_bf16(F[5], vf[2 + ((g) >> 1)], S[(2 * (g) + 2) & 3], 0, 0, 0); \
        o[0] = __builtin_amdgcn_mfma_f32_32x32x16_bf16(F[2], __builtin_bit_cast(bf16x8, Sb[g][1]), o[0], 0, 0, 0); \
        S[(2 * (g) + 1) & 3] = __builtin_amdgcn_mfma_f32_32x32x16_bf16(F[6], vf[(g) >> 1], S[(2 * (g) + 1) & 3], 0, 0, 0); \
        o[1] = __builtin_amdgcn_mfma_f32_32x32x16_bf16(F[3], __builtin_bit_cast(bf16x8, Sb[g][1]), o[1], 0, 0, 0); \
        S[(2 * (g) + 3) & 3] = __builtin_amdgcn_mfma_f32_32x32x16_bf16(F[7], vf[2 + ((g) >> 1)], S[(2 * (g) + 3) & 3], 0, 0, 0); } while (0)
        bf16x8 FA[8], FB[8];
        GLA_LOADG(FA, 0); __builtin_amdgcn_sched_barrier(0);
        GLA_LOADG(FB, 1); __builtin_amdgcn_sched_barrier(0); GLA_MMAG(FA, 0); __builtin_amdgcn_sched_barrier(0);
        GLA_LOADG(FA, 2); __builtin_amdgcn_sched_barrier(0); GLA_MMAG(FB, 1); __builtin_amdgcn_sched_barrier(0);
        GLA_LOADG(FB, 3); __builtin_amdgcn_sched_barrier(0); GLA_MMAG(FA, 2); __builtin_amdgcn_sched_barrier(0);
        FA[0] = GLA_AF(0, 0); FA[1] = GLA_AF(1, 0); FA[2] = GLA_AF(0, 1); FA[3] = GLA_AF(1, 1); FA[4] = GLA_AF(1, 2); FA[5] = GLA_AF(1, 3);
        __builtin_amdgcn_sched_barrier(0); GLA_MMAG(FB, 3); __builtin_amdgcn_sched_barrier(0);
        o[0] = __builtin_amdgcn_mfma_f32_32x32x16_bf16(FA[0], vf[0], o[0], 0, 0, 0); o[1] = __builtin_amdgcn_mfma_f32_32x32x16_bf16(FA[1], vf[0], o[1], 0, 0, 0);
        o[0] = __builtin_amdgcn_mfma_f32_32x32x16_bf16(FA[2], vf[1], o[0], 0, 0, 0); o[1] = __builtin_amdgcn_mfma_f32_32x32x16_bf16(FA[3], vf[1], o[1], 0, 0, 0);
        o[1] = __builtin_amdgcn_mfma_f32_32x32x16_bf16(FA[4], vf[2], o[1], 0, 0, 0); o[1] = __builtin_amdgcn_mfma_f32_32x32x16_bf16(FA[5], vf[3], o[1], 0, 0, 0);
#undef GLA_QF
#undef GLA_KF
#undef GLA_AF
#undef GLA_LOADG
#undef GLA_MMAG
        bf16* og = ogbase;
#pragma unroll
        for (int tt = 0; tt < 2; ++tt)
#pragma unroll
            for (int r = 0; r < 16; ++r) { const int tok = tt * 32 + crow(r, hi); if (c > 0 || tok < NMETA) og[(size_t)chunk_row(b, c, tok) * 32] = (bf16)cvtpk(o[tt][r], o[tt][r]); }
    }
    if (cw) { float* outp = a->out + O_GLAP + (size_t)bh * 128 * 256 + ds * 32 + r32;
#pragma unroll
    for (int T = 0; T < 4; ++T)
#pragma unroll
        for (int r = 0; r < 16; ++r) outp[(size_t)(32 * T + crow(r, hi)) * 256] = S[T][r]; }
    asm volatile("s_waitcnt vmcnt(0) lgkmcnt(0)\n\ts_barrier" ::: "memory");
#undef GLA_DMA
#undef GLA_VLOAD
}
}

__device__ __forceinline__ bool relaunder(ArgsP& a) { asm volatile("" : "+s"(a)); return true; }
constexpr int NPHASE = 22;
__global__ void __launch_bounds__(512, 2) fwd(Args a_unused) {
    ArgsP a = (ArgsP)__builtin_amdgcn_kernarg_segment_ptr();
    extern __shared__ __attribute__((aligned(16))) unsigned char lds_raw[];
    LAS unsigned char* lds = (LAS unsigned char*)lds_raw;
    Ctx c; c.wave = __builtin_amdgcn_readfirstlane((int)threadIdx.x >> 6); c.tid = 0; c.lane = 0;
    c.gw = blockIdx.x * 8 + c.wave; c.ngw = gridDim.x * 8; c.gwT = c.wave * gridDim.x + blockIdx.x;
    volatile LAS unsigned* MISC = (volatile LAS unsigned*)(lds + MISC_OFF);
    if (threadIdx.x < 32) MISC[threadIdx.x] = 0u;
    __syncthreads();
    XcdBarrier bar; bar.bar = (unsigned*)(a->ws + WS_CTL) + CW_BAR; bar.x = 0; bar.st = nullptr;
    const bool one = (a->ph_hi - a->ph_lo) > 1;
    if (one) bar = xcd_barrier_post((unsigned*)(a->ws + WS_CTL) + CW_BAR, MISC + 8);
    const int lo = a->ph_lo, hi = a->ph_hi;
    unsigned long long tp0 = 0, tp1 = 0;
#define IN(k) (((PROBE_LO == (k)) ? (void)(tp0 = __builtin_amdgcn_s_memrealtime()) : (void)0), (lo <= (k) && (k) < hi && relaunder(a)))
#define INQ(k) (lo <= (k) && (k) < hi)
#define SEAM(k) do { if (INQ(k) && INQ((k) + 1)) xcd_barrier(bar, c.wave); if (PROBE_HI == (k)) tp1 = __builtin_amdgcn_s_memrealtime(); } while (0)
    if (IN(0)) { p_prep(a, c, lds); } SEAM(0);
    if (IN(1)) { if ((int)blockIdx.x < (RP / 256) * (NIN0 / 256)) gemm_p1(a, lds, c.wave); else p_side_tables(a, c, lds, (RP / 256) * (NIN0 / 256)); } SEAM(1);
    if (IN(2)) { if (USE_NAIVE_GEMM) p_mla_mid(a, c); }
    if (IN(3)) { gemm_p3(a, lds, c.wave); } SEAM(3);
    if (IN(4)) { if (USE_NAIVE_GEMM) { p_q_post(a, c); p_qlat(a, c); } }
    if (IN(5)) {
#if USE_NAIVE_ATTN
        p_attn_prompt_naive<false>(a, c);
#else
        if (((int)blockIdx.x >> 3) & 1) {
            dec::decode_phase(a, lds, c.wave);
            att::attn_phase(WSB(WS_QN), WSB(WS_QPE), WSB(WS_KNV), WSB(WS_KPE), WSB(WS_O), lds, c.wave);
        } else {
            att::attn_phase(WSB(WS_QN), WSB(WS_QPE), WSB(WS_KNV), WSB(WS_KPE), WSB(WS_O), lds, c.wave);
            dec::decode_phase(a, lds, c.wave);
        }
#endif
    } SEAM(5);
    if (IN(6)) {
#if USE_NAIVE_DECODE
        p_olat_up(a, c);
#else
        dec::combine_phase(a, c, lds);
#endif
    } SEAM(6);
    if (IN(7)) { gemm_n1024_tail<D, 8>(WSB(WS_O), WSB(WS_WO0), WSB(WS_M), WSF(WS_MT), lds, c.wave); } SEAM(7);
    if (IN(8)) { p_post_res<false, 8, true>(a, c, IN_F(8), IN_F(9)); } SEAM(8);
    if (IN(9)) { gemm_mfma8(WSB(WS_H), WSB(WS_WUP), RP, FF, D, (EpiRelu2{WSB(WS_U), FF}), lds, c.wave); } SEAM(9);
    if (IN(10)) { gemm_n1024_tail<FF, 16>(WSB(WS_U), WSB(WS_WDN), WSB(WS_M), WSF(WS_MT), lds, c.wave); } SEAM(10);
    if (IN(11)) { p_post_res<false, 16>(a, c, IN_F(10), IN_F(7) + D); } SEAM(11);
    if (IN(12)) { gemm_mfma8(WSB(WS_H), WSB(WS_WGIN), RP, NGIN, D, (EpiGla{WSB(WS_QG), WSB(WS_KG), WSB(WS_VG), WSB(WS_RG), WSF(WS_GD)}), lds, c.wave); } SEAM(12);
    if (IN(13)) {
#if USE_NAIVE_GLA
        p_gate(a, c);
#else
        gla::prep_phase(a, lds, c.wave);
#endif
    } SEAM(13);
    if (IN(14)) {
#if !USE_NAIVE_GLA
        if ((int)blockIdx.x < NB * GH * gla::NSP) gla::scan_bh(a, (int)blockIdx.x / gla::NSP, (int)blockIdx.x % gla::NSP, lds, c.wave);
        else for (int item = (int)blockIdx.x - NB * GH * gla::NSP; item < DB * GH; item += (int)gridDim.x - NB * GH * gla::NSP) gla::sample_item(a, item, lds, c.wave);
#else
        p_gla_naive(a, c);
#endif
    } SEAM(14);
    if (IN(15)) { p_gla_post(a, c); } SEAM(15);
    if (IN(16)) { gemm_n1024_tail<D, 8>(WSB(WS_OG), WSB(WS_WGO), WSB(WS_M), WSF(WS_MT), lds, c.wave); } SEAM(16);
    if (IN(17)) { p_post_res<false, 8>(a, c, IN_F(8) + D, IN_F(9) + D); } SEAM(17);
    if (IN(18)) { gemm_mfma8(WSB(WS_H), WSB(WS_WUP) + (size_t)FF * D, RP, FF, D, (EpiRelu2{WSB(WS_U), FF}), lds, c.wave); } SEAM(18);
    if (IN(19)) { gemm_n1024_tail<FF, 16>(WSB(WS_U), WSB(WS_WDN) + (size_t)D * FF, WSB(WS_M), WSF(WS_MT), lds, c.wave); } SEAM(19);
    if (IN(20)) { p_post_res<true, 16>(a, c, IN_F(10) + D, nullptr); }
    if (PROBE_LO >= 0 && blockIdx.x == 0) { const unsigned long long span = (tp1 - tp0) * 9ull, t0 = __builtin_amdgcn_s_memrealtime(); while (__builtin_amdgcn_s_memrealtime() - t0 < span) __builtin_amdgcn_s_sleep(8); }
#undef IN
#undef SEAM
}

extern "C" void kernel_launch(void* const* d_in, const int* in_sizes, int n_in, void* d_out, int out_size, void* d_ws, size_t ws_size, hipStream_t stream) {
    static int grid = 0;
    if (grid == 0) {
        if (n_in != 25 || out_size != (int)O_END || ws_size < WS_END) { fprintf(stderr, "kernel_launch: unexpected shapes n_in %d out %d ws %zu\n", n_in, out_size, ws_size); grid = -1; return; }
        int dev = 0, cus = 0, per_cu = 0;
        if (hipGetDevice(&dev) != hipSuccess || hipDeviceGetAttribute(&cus, hipDeviceAttributeMultiprocessorCount, dev) != hipSuccess) { grid = -1; return; }
        if (hipFuncSetAttribute((const void*)fwd, hipFuncAttributeMaxDynamicSharedMemorySize, LDS_BYTES) != hipSuccess) { fprintf(stderr, "kernel_launch: hipFuncSetAttribute failed\n"); grid = -1; return; }
        if (hipOccupancyMaxActiveBlocksPerMultiprocessor(&per_cu, (const void*)fwd, 512, LDS_BYTES) != hipSuccess || per_cu < 1) fprintf(stderr, "kernel_launch: occupancy query says %d\n", per_cu);
        (void)hipGetLastError();
        grid = cus;
    }
    if (grid < 0) return;
    if (hipMemsetAsync((char*)d_ws + WS_CTL, 0, CTL_ZERO_BYTES, stream) != hipSuccess) return;
    Args a{};
    for (int i = 0; i < 25; ++i) a.in[i] = d_in[i];
    a.out = (float*)d_out; a.ws = (unsigned char*)d_ws;
#if MK_ONE_LAUNCH
    a.ph_lo = 0; a.ph_hi = NPHASE;
    hipLaunchKernelGGL(fwd, dim3(grid), dim3(512), LDS_BYTES, stream, a);
#else
    for (int ph = 0; ph < NPHASE - 1; ++ph) { a.ph_lo = ph; a.ph_hi = ph + 1; hipLaunchKernelGGL(fwd, dim3(grid), dim3(512), LDS_BYTES, stream, a); }
#endif
}
```

```cpp
#include <hip/hip_runtime.h>
#include <cstdio>
#include <cstdint>
#include <cmath>

#ifndef MK_ONE_LAUNCH
#define MK_ONE_LAUNCH 1
#endif

constexpr int D = 1024, NB = 4, SEQ = 4096, NMETA = 16, TP = SEQ + NMETA;
constexpr int DB = 128, DS = 4, PAST = 8192, PAGE = 128, NPAGES = 64;
constexpr int NH = 16, QL = 256, KVL = 256, NOPE = 64, ROPE = 32, VH = 64;
constexpr int GH = 4, GDK = 128, GDV = 256, GR = 16;
constexpr int FF = 4096;
constexpr int RMAIN = NB * SEQ;
constexpr int RMETA0 = RMAIN;
constexpr int RSAMP0 = RMAIN + NB * NMETA;
constexpr int R = RSAMP0 + DB * DS;
constexpr int RPROMPT = RSAMP0;
constexpr int RP = 17152;
constexpr int NIN0 = 768, NUQ = 1536, NUKV = 2048, NGIN = 3328, NGIN_REAL = 3088;
constexpr float EPS = 1e-6f;
constexpr float MLA_SCALE = 0.10206207261596575f;
constexpr float GLA_SCALE = 0.08838834764831845f;
constexpr float QSCALE = 0.10206207261596575f * 1.4426950408889634f;

constexpr size_t O_YP = 0, O_YS = 16777216, O_CKVP = 17301504, O_KPEP = 21512192, O_CKVS = 22038528, O_KPES = 22169600, O_GLAP = 22185984, O_GLAS = 22710272, O_END = 39487488;

constexpr size_t MiB = 1u << 20;
constexpr size_t WS_CTL = 0, CTL_ZERO_BYTES = 1 * MiB;
constexpr size_t WS_WIN0 = 2 * MiB, WS_WUQ = 4 * MiB, WS_WUKV = 5 * MiB, WS_WO0 = 6 * MiB, WS_WUP = 8 * MiB, WS_WDN = 24 * MiB, WS_WGIN = 40 * MiB, WS_WGO = 47 * MiB;
constexpr size_t WS_X = 64 * MiB, WS_H = 132 * MiB, WS_M = 166 * MiB, WS_U = 234 * MiB, WS_A1 = 368 * MiB, WS_CQN = 419 * MiB, WS_CKVN = 428 * MiB, WS_KPE = 437 * MiB;
constexpr size_t WS_QRAW = 440 * MiB, WS_KNV = 541 * MiB, WS_QN = 608 * MiB, WS_QPE = 642 * MiB, WS_QLAT = 659 * MiB, WS_OLAT = 663 * MiB, WS_O = 671 * MiB;
constexpr size_t WS_QG = 705 * MiB, WS_KG = 722 * MiB, WS_VG = 739 * MiB, WS_RG = 773 * MiB, WS_GD = 807 * MiB, WS_LA = 809 * MiB, WS_EA = 843 * MiB, WS_OGRAW = 877 * MiB, WS_OG = 944 * MiB;
constexpr size_t WS_OPART = 978 * MiB, WS_MLP = 1012 * MiB;
constexpr size_t WS_QINF = 1014 * MiB, WS_KDTF = 1032 * MiB, WS_AMF = 1050 * MiB, WS_VTF = 1060 * MiB, WS_ELF = 1094 * MiB;
constexpr size_t WS_WUQL = 50 * MiB;
constexpr size_t WS_ROPE = 53 * MiB;
constexpr size_t WS_MT = 1096 * MiB;
constexpr size_t WS_END = 1144 * MiB;
constexpr int CW_BAR = 4096, CW_DEC = 8192;
namespace gla { constexpr int NSP = 8, NCW = 8 / NSP; }

constexpr int LDS_BYTES = 147456;
constexpr int MISC_OFF = LDS_BYTES - 256;

#define GAS __attribute__((address_space(1)))
#define LAS __attribute__((address_space(3)))
typedef unsigned short bf16;
typedef float f32x4 __attribute__((ext_vector_type(4)));
typedef unsigned u32x4 __attribute__((ext_vector_type(4)));
typedef unsigned u32x2 __attribute__((ext_vector_type(2)));
#define LDS_WAIT() asm volatile("s_waitcnt lgkmcnt(0)" ::: "memory")

__device__ __forceinline__ unsigned f2bf(float f) { unsigned u = __builtin_bit_cast(unsigned, f); return (u + 0x7fffu + ((u >> 16) & 1u)) >> 16; }
__device__ __forceinline__ unsigned pk2(float lo, float hi) { return f2bf(lo) | (f2bf(hi) << 16); }
__device__ __forceinline__ float bflo(unsigned u) { return __builtin_bit_cast(float, u << 16); }
__device__ __forceinline__ float bfhi(unsigned u) { return __builtin_bit_cast(float, u & 0xffff0000u); }
__device__ __forceinline__ float bf2f(bf16 v) { return __builtin_bit_cast(float, (unsigned)v << 16); }
__device__ __forceinline__ float wave_sum(float v) {
#pragma unroll
    for (int o = 1; o < 64; o <<= 1) v += __shfl_xor(v, o);
    return v;
}
__device__ __forceinline__ int wave_max_i(int v) {
#pragma unroll
    for (int o = 1; o < 64; o <<= 1) { int t = __shfl_xor(v, o); v = t > v ? t : v; }
    return v;
}
__device__ __forceinline__ int fresh_tid(int wave) { int t = wave * 64 + (int)__builtin_amdgcn_mbcnt_hi(~0u, __builtin_amdgcn_mbcnt_lo(~0u, 0u)); asm volatile("" : "+v"(t)); return t; }
__device__ __forceinline__ float rdlane(float v, int l) { return __builtin_bit_cast(float, __builtin_amdgcn_readlane(__builtin_bit_cast(int, v), l)); }

#define XB_TMO      128
#define XB_XCNT(j)  (256  + 64 * (j))
#define XB_XSUB(j)  (1280 + 64 * (j))
#define XB_XGEN(j)  (2304 + 64 * (j))
#define XB_TOP      3328
#define XB_TOPGEN   3392
#define XCD_BAR_WORDS 3456
#define XB_SPIN_CAP (1u << 18)
__device__ __forceinline__ unsigned xb_ld(unsigned* p)              { return __hip_atomic_load(p, __ATOMIC_RELAXED, __HIP_MEMORY_SCOPE_AGENT); }
__device__ __forceinline__ unsigned xb_add(unsigned* p, unsigned v) { return __hip_atomic_fetch_add(p, v, __ATOMIC_RELAXED, __HIP_MEMORY_SCOPE_AGENT); }
__device__ __forceinline__ unsigned xb_xcc_id() { return (unsigned)__builtin_amdgcn_s_getreg((3 << 11) | 20) & 0xFu; }
#define XB_SPIN(cond, bar) do { unsigned _sp = 0; while (cond) { __builtin_amdgcn_s_sleep(1); \
    if ((++_sp & 255u) == 0u) { if (xb_ld(&(bar)[XB_TMO])) break; if (_sp > XB_SPIN_CAP) { atomicAdd(&(bar)[XB_TMO], 1u); break; } } } } while (0)
struct XcdBarrier { unsigned* bar; unsigned x; volatile LAS unsigned* st; };
__device__ __forceinline__ XcdBarrier xcd_barrier_post(unsigned* bar, volatile LAS unsigned* st) {
    XcdBarrier b; b.bar = bar; b.x = xb_xcc_id(); b.st = st;
    if (threadIdx.x == 0) (void)xb_add(&bar[XB_XCNT(b.x)], 1u);
    return b;
}
__device__ __forceinline__ void xcd_barrier_complete(unsigned* bar, unsigned x, unsigned& nloc, unsigned& nx) {
    const unsigned G = gridDim.x * gridDim.y * gridDim.z;
    unsigned sum, cnt, mine, sp = 0u;
    for (;;) {
        sum = 0u; cnt = 0u; mine = 0u;
#pragma unroll
        for (unsigned j = 0; j < 16; ++j) { const unsigned c = xb_ld(&bar[XB_XCNT(j)]); sum += c; cnt += (c > 0u) ? 1u : 0u; mine = (j == x) ? c : mine; }
        if (sum == G) break;
        __builtin_amdgcn_s_sleep(1);
        if ((++sp & 255u) == 0u) { if (xb_ld(&bar[XB_TMO])) break; if (sp > XB_SPIN_CAP) { atomicAdd(&bar[XB_TMO], 1u); break; } }
    }
    nloc = mine > 0u ? mine : 1u; nx = cnt > 0u ? cnt : 1u;
}
__device__ __forceinline__ void xcd_barrier(const XcdBarrier& b, int wave_id) {
    asm volatile("s_waitcnt vmcnt(0)" ::: "memory");
    __syncthreads();
    if (fresh_tid(wave_id) == 0) {
        unsigned* bar = b.bar;
        __builtin_amdgcn_s_waitcnt(0);
        unsigned nloc = b.st[0], nx = b.st[1];
        if (nloc == 0u) { xcd_barrier_complete(bar, b.x, nloc, nx); b.st[0] = nloc; b.st[1] = nx; }
        const unsigned old = xb_add(&bar[XB_XSUB(b.x)], 1u);
        const unsigned gen = old / nloc;
        if (old + 1u == (gen + 1u) * nloc) {
            __builtin_amdgcn_fence(__ATOMIC_RELEASE, "agent");
            asm volatile("s_waitcnt vmcnt(0)" ::: "memory");
            const unsigned og = xb_add(&bar[XB_TOP], 1u);
            const unsigned tg = og / nx;
            if (og + 1u == (tg + 1u) * nx) xb_add(&bar[XB_TOPGEN], 1u);
            else XB_SPIN(xb_ld(&bar[XB_TOPGEN]) == tg, bar);
            __builtin_amdgcn_fence(__ATOMIC_ACQUIRE, "agent");
            xb_add(&bar[XB_XGEN(b.x)], 1u);
            asm volatile("s_waitcnt vmcnt(0)" ::: "memory");
        } else {
            XB_SPIN(xb_ld(&bar[XB_XGEN(b.x)]) == gen, bar);
            __builtin_amdgcn_fence(__ATOMIC_ACQUIRE, "agent");
            asm volatile("s_waitcnt vmcnt(0)" ::: "memory");
        }
    }
    __syncthreads();
}

namespace pg8 {
#define PG8_LAS __attribute__((address_space(3)))
typedef unsigned short bf16_t;
typedef short bf16x8 __attribute__((ext_vector_type(8)));
typedef float f32x4 __attribute__((ext_vector_type(4)));
typedef unsigned u32x4 __attribute__((ext_vector_type(4)));
constexpr int BM = 256, BK = 64, HALF = 128, HTB = HALF * BK * 2  , STAGE_BYTES = 8 * HTB, NXCD = 8, WGM = 8;

__host__ __device__ __forceinline__ int lds_byte(int r, int c) { const int st = (r >> 4) * 2 + (c >> 5), rr = r & 15, cc = c & 31, ob = rr * 64 + cc * 2; return st * 1024 + (ob ^ (((ob >> 9) & 1) << 5)); }
__host__ __device__ __forceinline__ void stage_rc(int b, int& R, int& C) { const int st = b / 1024, sb = b % 1024, swz = sb ^ (((sb >> 9) & 1) << 5); R = (st >> 1) * 16 + swz / 64; C = (st & 1) * 32 + (swz % 64) / 2; }
__host__ __device__ __forceinline__ int perm32(int rho) { const int n = rho >> 4, i = rho & 15; return 8 * (i >> 2) + 4 * n + (i & 3); }

struct Unit { int pm, pn, k0, prob; long aoff, boff; };
struct Gemm { const bf16_t* A; const bf16_t* Bt; int M, N, K, ld; };

struct StaticOrder {
    int nM, nN, nwg, G, c;
    __host__ __device__ void init(int M, int N, int G_, int c_) { nM = M / BM; nN = N / BM; nwg = nM * nN; G = G_; c = c_; }
    __host__ __device__ bool next(int i, Unit& u) const {
        const long L = (long)i * G + c; if (L >= nwg) return false;
        int wgid = (int)L; { const int q = nwg / NXCD, r = nwg % NXCD, xcd = wgid % NXCD, off = wgid / NXCD; wgid = (xcd < r ? xcd * (q + 1) : r * (q + 1) + (xcd - r) * q) + off; }
        const int nig = WGM * nN, gid = wgid / nig, fm = gid * WGM, gsz = (nM - fm) < WGM ? (nM - fm) : WGM;
        u.pm = fm + ((wgid % nig) % gsz); u.pn = (wgid % nig) / gsz; u.k0 = 0; u.prob = 0; u.aoff = 0; u.boff = 0; return true;
    }
    __device__ __forceinline__ void a_ready(const Unit&) const {}
    __device__ __forceinline__ void done(const Unit&) const {}
};

__device__ __forceinline__ unsigned cvt_pk_bf16(float lo, float hi) { unsigned r; asm volatile("v_cvt_pk_bf16_f32 %0, %1, %2" : "=v"(r) : "v"(lo), "v"(hi)); return r; }
template <class Epi, class Sched, bool ALIGN_EPI = false, bool SP2 = false>
__device__ __forceinline__ void gemm_phase(PG8_LAS unsigned char* lds, const Gemm g, const Sched& S, const Epi& E, int wave_id) {
    const int tid = fresh_tid(wave_id), wid = wave_id, lane = tid & 63, wr = wid >> 2, wc = wid & 3, fr = lane & 15, fq = lane >> 4;
    const int K = g.K, nt = K / BK;
    unsigned voffA[2], voffB[2];
#pragma unroll
    for (int i = 0; i < 2; ++i) { int R, C; stage_rc(tid * 16 + i * 8192, R, C); const int Rb = Epi::PERM ? ((R & ~31) + perm32(R & 31)) : R;
        voffA[i] = (unsigned)(R * g.ld + C) * 2u; voffB[i] = (unsigned)(Rb * g.ld + C) * 2u; }
    const size_t kstep = (size_t)(BK * 2);
    const size_t hstep = (size_t)HALF * g.ld * 2;
    const size_t tstep = 2 * hstep;
    const unsigned ldsw = (unsigned)wid * 1024u;
    const int aoff = lds_byte(wr * 64 + fr, fq * 8), boff = lds_byte(wc * 32 + fr, fq * 8);
#define PG8_SA(b, h) (((b) * 2 + (h)) * HTB)
#define PG8_SB(b, h) ((4 + (b) * 2 + (h)) * HTB)
#define PG8_STAGE(bufoff, gbase, voff) do { _Pragma("unroll") for (int _i = 0; _i < 2; ++_i) \
        __builtin_amdgcn_global_load_lds((const unsigned*)((const char*)(gbase) + (voff)[_i]), (PG8_LAS unsigned*)(lds + (bufoff) + ldsw + _i * 8192), 16, 0, 0); } while (0)
#define PG8_LDA(dst, b, h) do { _Pragma("unroll") for (int m = 0; m < 4; ++m) _Pragma("unroll") for (int k = 0; k < 2; ++k) dst[m][k] = *(const PG8_LAS bf16x8*)(lds + PG8_SA(b, h) + aoff + m * 2048 + k * 1024); } while (0)
#define PG8_LDB(dst, b, h) do { _Pragma("unroll") for (int n = 0; n < 2; ++n) _Pragma("unroll") for (int k = 0; k < 2; ++k) dst[n][k] = *(const PG8_LAS bf16x8*)(lds + PG8_SB(b, h) + boff + n * 2048 + k * 1024); } while (0)
#define PG8_MMA(ai, bj, At, Bt) do { __builtin_amdgcn_s_setprio(1); _Pragma("unroll") for (int m = 0; m < 4; ++m) _Pragma("unroll") for (int n = 0; n < 2; ++n) _Pragma("unroll") for (int k = 0; k < 2; ++k) \
        acc[ai][bj][m][n] = __builtin_amdgcn_mfma_f32_16x16x32_bf16(Bt[n][k], At[m][k], acc[ai][bj][m][n], 0, 0, 0); __builtin_amdgcn_s_setprio(0); } while (0)
#define PG8_WAIT_V(n) asm volatile("s_waitcnt vmcnt(" #n ")" ::: "memory")
#define PG8_WAIT_L(n) asm volatile("s_waitcnt lgkmcnt(" #n ")" ::: "memory")
#define PG8_BAR __builtin_amdgcn_s_barrier()
#define PG8_SCHED __builtin_amdgcn_sched_barrier(0)
    Unit cur, nxt; int ui = 0;
    if (!S.next(0, cur)) return;
    f32x4 acc[2][2][4][2];
#pragma unroll
    for (int a = 0; a < 2; ++a)
#pragma unroll
        for (int b = 0; b < 2; ++b)
#pragma unroll
            for (int m = 0; m < 4; ++m)
#pragma unroll
                for (int n = 0; n < 2; ++n) acc[a][b][m][n] = (f32x4){0.f, 0.f, 0.f, 0.f};
    bf16x8 At[4][2], B0[2][2], B1[2][2];
    const char* cA = (const char*)g.A + (size_t)cur.pm * tstep + (size_t)cur.k0 * 2 + cur.aoff; const char* cB = (const char*)g.Bt + (size_t)cur.pn * tstep + (size_t)cur.k0 * 2 + cur.boff;
    S.a_ready(cur);
    if constexpr (SP2) {
        PG8_STAGE(PG8_SB(0, 0), cB, voffB); PG8_STAGE(PG8_SB(0, 1), cB + hstep, voffB); PG8_STAGE(PG8_SA(0, 0), cA, voffA); PG8_STAGE(PG8_SA(0, 1), cA + hstep, voffA);
        if (wr == 1) PG8_BAR;
        PG8_WAIT_V(2); PG8_BAR;
        PG8_STAGE(PG8_SB(1, 0), cB + kstep, voffB); PG8_STAGE(PG8_SA(1, 0), cA + kstep, voffA); PG8_STAGE(PG8_SB(1, 1), cB + hstep + kstep, voffB);
        PG8_WAIT_V(6); PG8_BAR;
    } else {
        PG8_STAGE(PG8_SB(0, 0), cB, voffB); PG8_STAGE(PG8_SA(0, 0), cA, voffA); PG8_STAGE(PG8_SB(0, 1), cB + hstep, voffB); PG8_STAGE(PG8_SA(0, 1), cA + hstep, voffA);
        if (wr == 1) PG8_BAR;
        PG8_WAIT_V(4); PG8_BAR;
        PG8_STAGE(PG8_SB(1, 0), cB + kstep, voffB); PG8_STAGE(PG8_SA(1, 0), cA + kstep, voffA); PG8_STAGE(PG8_SB(1, 1), cB + hstep + kstep, voffB);
        PG8_WAIT_V(6); PG8_BAR;
    }
    for (;;) {
        const bool has_next = S.next(ui + 1, nxt);
        const char* nA = has_next ? (const char*)g.A + (size_t)nxt.pm * tstep + (size_t)nxt.k0 * 2 + nxt.aoff : cA; const char* nB = has_next ? (const char*)g.Bt + (size_t)nxt.pn * tstep + (size_t)nxt.k0 * 2 + nxt.boff : cB;
        for (int t = 0; t < nt; t += 2) {
            const bool last = (t == nt - 2);
            const char* a1 = cA + (size_t)(t + 1) * kstep;
            const char* a2 = last ? nA : cA + (size_t)(t + 2) * kstep; const char* b2 = last ? nB : cB + (size_t)(t + 2) * kstep;
            const char* a3 = a2 + kstep; const char* b3 = b2 + kstep;
            if (last && has_next) S.a_ready(nxt);
            if constexpr (SP2) {
            PG8_LDB(B0, 0, 0); PG8_LDB(B1, 0, 1); PG8_SCHED; PG8_LDA(At, 0, 0); PG8_STAGE(PG8_SA(1, 1), a1 + hstep, voffA);
            PG8_WAIT_V(8); PG8_WAIT_L(0); PG8_BAR; PG8_MMA(0, 0, At, B0); PG8_MMA(0, 1, At, B1); PG8_BAR; PG8_SCHED;
            PG8_LDA(At, 0, 1); PG8_STAGE(PG8_SB(0, 0), b2, voffB); PG8_STAGE(PG8_SB(0, 1), b2 + hstep, voffB); PG8_STAGE(PG8_SA(0, 0), a2, voffA);
            PG8_WAIT_V(8); PG8_WAIT_L(0); PG8_BAR; PG8_MMA(1, 0, At, B0); PG8_MMA(1, 1, At, B1); PG8_BAR; PG8_SCHED;
            PG8_LDB(B0, 1, 0); PG8_LDB(B1, 1, 1); PG8_SCHED; PG8_LDA(At, 1, 0); PG8_STAGE(PG8_SA(0, 1), a2 + hstep, voffA);
            PG8_WAIT_V(8); PG8_WAIT_L(0); PG8_BAR; PG8_MMA(0, 0, At, B0); PG8_MMA(0, 1, At, B1); PG8_BAR; PG8_SCHED;
            PG8_LDA(At, 1, 1); PG8_STAGE(PG8_SB(1, 0), b3, voffB); PG8_STAGE(PG8_SB(1, 1), b3 + hstep, voffB); PG8_STAGE(PG8_SA(1, 0), a3, voffA);
            PG8_WAIT_V(8); PG8_WAIT_L(0); PG8_BAR; PG8_MMA(1, 0, At, B0); PG8_MMA(1, 1, At, B1); PG8_BAR; PG8_SCHED;
            } else {
            PG8_LDB(B0, 0, 0); PG8_SCHED; PG8_LDA(At, 0, 0); PG8_STAGE(PG8_SA(1, 1), a1 + hstep, voffA);
            PG8_WAIT_L(8); PG8_BAR; PG8_WAIT_L(0); PG8_MMA(0, 0, At, B0); PG8_BAR; PG8_SCHED;
            PG8_LDB(B1, 0, 1); PG8_STAGE(PG8_SB(0, 0), b2, voffB);
            PG8_BAR; PG8_WAIT_L(0); PG8_MMA(0, 1, At, B1); PG8_BAR;
            PG8_LDA(At, 0, 1); PG8_STAGE(PG8_SA(0, 0), a2, voffA);
            PG8_BAR; PG8_WAIT_L(0); PG8_MMA(1, 0, At, B0); PG8_BAR; PG8_SCHED;
            PG8_STAGE(PG8_SB(0, 1), b2 + hstep, voffB);
            PG8_WAIT_V(6); PG8_BAR; PG8_MMA(1, 1, At, B1); PG8_BAR;
            PG8_LDB(B0, 1, 0); PG8_SCHED; PG8_LDA(At, 1, 0); PG8_STAGE(PG8_SA(0, 1), a2 + hstep, voffA);
            PG8_WAIT_L(8); PG8_BAR; PG8_WAIT_L(0); PG8_MMA(0, 0, At, B0); PG8_BAR; PG8_SCHED;
            PG8_LDB(B1, 1, 1); PG8_STAGE(PG8_SB(1, 0), b3, voffB);
            PG8_BAR; PG8_WAIT_L(0); PG8_MMA(0, 1, At, B1); PG8_BAR;
            PG8_LDA(At, 1, 1); PG8_STAGE(PG8_SA(1, 0), a3, voffA);
            PG8_BAR; PG8_WAIT_L(0); PG8_MMA(1, 0, At, B0); PG8_BAR; PG8_SCHED;
            PG8_STAGE(PG8_SB(1, 1), b3 + hstep, voffB);
            PG8_WAIT_V(6); PG8_BAR; PG8_MMA(1, 1, At, B1); PG8_BAR;
            }
        }
        if constexpr (ALIGN_EPI) { if (wr == 0) PG8_BAR; }
        if constexpr (!Epi::AFTER_DRAIN) { E(acc, cur, wr, wc, fr, fq); S.done(cur); }
        if (!has_next) break;
#pragma unroll
        for (int a = 0; a < 2; ++a)
#pragma unroll
            for (int b = 0; b < 2; ++b)
#pragma unroll
                for (int m = 0; m < 4; ++m)
#pragma unroll
                    for (int n = 0; n < 2; ++n) acc[a][b][m][n] = (f32x4){0.f, 0.f, 0.f, 0.f};
        cur = nxt; cA = nA; cB = nB; ++ui;
        if constexpr (ALIGN_EPI) { if (wr == 1) PG8_BAR; }
    }
    PG8_WAIT_V(0);
    if constexpr (!ALIGN_EPI) { if (wr == 0) PG8_BAR; }
    PG8_BAR;
    if constexpr (Epi::AFTER_DRAIN) { E.fused(acc, cur, wr, wc, fr, fq, lds, wid, lane); S.done(cur); }
#undef PG8_SA
#undef PG8_SB
#undef PG8_STAGE
#undef PG8_LDA
#undef PG8_LDB
#undef PG8_MMA
#undef PG8_WAIT_V
#undef PG8_WAIT_L
#undef PG8_BAR
#undef PG8_SCHED
}
}

struct Args { const void* in[25]; float* out; unsigned char* ws; int ph_lo, ph_hi; };
typedef const __attribute__((address_space(4))) Args* ArgsP;
#define IN_F(k) ((const float*)a->in[k])
#define WSB(off) ((bf16*)(a->ws + (off)))
#define WSF(off) ((float*)(a->ws + (off)))

struct Ctx { int tid, lane, wave, gw, ngw, gwT; };
__device__ __forceinline__ Ctx refresh(const Ctx& c0) { Ctx c = c0; c.tid = fresh_tid(c0.wave); c.lane = c.tid & 63; return c; }

__device__ __forceinline__ int row_pos(int r) { return r < RMAIN ? (r & 4095) + NMETA : (r < RSAMP0 ? ((r - RMAIN) & 15) : PAST + ((r - RSAMP0) & 3)); }
__device__ __forceinline__ float rope_inv(int j) { return exp2f(-(float)j * (13.287712379549449f / 16.0f)); }
__device__ __forceinline__ void rope_cs(int pos, int j, float& c, float& s) {
    const float ang = (float)pos * rope_inv(j);
    const double x = (double)ang; const double n = rint(x * 0.15915494309189535); const float r = (float)(x - n * 6.283185307179586);
    c = cosf(r); s = sinf(r);
}

struct RmId { int off; __device__ __forceinline__ int operator()(int n) const { return off + n; } };
struct RmUq { __device__ __forceinline__ int operator()(int n) const { const int h = n / 96, j = n % 96; if (j < 64) return h * 64 + j; const int jj = j - 64; return 1024 + h * 32 + (jj < 16 ? 2 * jj : 2 * (jj - 16) + 1); } };
template <class RM>
__device__ __forceinline__ void tr_item(const float* W, int ldw, int nblk, int item, bf16* WT, int ldt, RM rm, LAS float* scr, int lane) {
    const int kb = item / nblk, nb = item % nblk, k0 = 64 * kb, n0 = 32 * nb;
#pragma unroll
    for (int i = 0; i < 8; ++i) { const int kk = 8 * i + (lane >> 3), c4 = (lane & 7) * 4; const f32x4 v = *(const f32x4*)(W + (size_t)(k0 + kk) * ldw + n0 + c4);
        scr[kk * 33 + c4] = v.x; scr[kk * 33 + c4 + 1] = v.y; scr[kk * 33 + c4 + 2] = v.z; scr[kk * 33 + c4 + 3] = v.w; }
    LDS_WAIT();
    const int c = lane & 7;
#pragma unroll
    for (int j = 0; j < 4; ++j) { const int n = (lane >> 3) + 8 * j; const LAS float* s = scr + (8 * c) * 33 + n;
        u32x4 o; o.x = pk2(s[0 * 33], s[1 * 33]); o.y = pk2(s[2 * 33], s[3 * 33]); o.z = pk2(s[4 * 33], s[5 * 33]); o.w = pk2(s[6 * 33], s[7 * 33]);
        *(u32x4*)(WT + (size_t)rm(n0 + n) * ldt + k0 + 8 * c) = o; }
    LDS_WAIT();
}
__device__ __forceinline__ void norm_row_bf16(const float* xrow, const float* g, float* xcopy, bf16* hrow, int lane) {
    f32x4 v[4]; float s = 0.f;
#pragma unroll
    for (int j = 0; j < 4; ++j) { v[j] = *(const f32x4*)(xrow + 4 * lane + 256 * j); s += (v[j].x * v[j].x + v[j].y * v[j].y) + (v[j].z * v[j].z + v[j].w * v[j].w); }
    const float rs = 1.0f / sqrtf(wave_sum(s) * (1.f / D) + EPS);
#pragma unroll
    for (int j = 0; j < 4; ++j) { const f32x4 gg = *(const f32x4*)(g + 4 * lane + 256 * j);
        if (xcopy) *(f32x4*)(xcopy + 4 * lane + 256 * j) = v[j];
        u32x2 o; o.x = pk2(v[j].x * rs * gg.x, v[j].y * rs * gg.y); o.y = pk2(v[j].z * rs * gg.z, v[j].w * rs * gg.w);
        *(u32x2*)(hrow + 4 * lane + 256 * j) = o; }
}
__device__ __forceinline__ void p_prep(ArgsP a, const Ctx& c0, LAS unsigned char* lds) {
    const Ctx c = refresh(c0);
    LAS float* scr = (LAS float*)(lds + c.wave * 16384);
    constexpr int I0 = 16 * 17, I1 = 4 * 48, I2 = 4 * 32, I3 = 4 * 32, I4 = 16 * 32, I5 = 16 * 96, I6 = 16 * 32, I7 = 16 * 128, I8 = 16 * 128, I9 = 64 * 32, I10 = 64 * 32;
    constexpr int NIT = I0 + I1 + I2 + I3 + I4 + I5 + I6 + I7 + I8 + I9 + I10;
    for (int it = c.gw; it < NIT; it += c.ngw) {
        int r = it;
        if (r < I0) { tr_item(IN_F(11), 544, 17, r, WSB(WS_WIN0), 1024, RmId{0}, scr, c.lane); continue; } r -= I0;
        if (r < I1) { tr_item(IN_F(13), 1536, 48, r, WSB(WS_WUQ), 256, RmUq{}, scr, c.lane); continue; } r -= I1;
        if (r < I2) { tr_item(IN_F(15), 1024, 32, r, WSB(WS_WUKV), 256, RmId{0}, scr, c.lane); continue; } r -= I2;
        if (r < I3) { tr_item(IN_F(16), 1024, 32, r, WSB(WS_WUKV), 256, RmId{1024}, scr, c.lane); continue; } r -= I3;
        if (r < I4) { tr_item(IN_F(17), 1024, 32, r, WSB(WS_WO0), 1024, RmId{0}, scr, c.lane); continue; } r -= I4;
        if (r < I5) { tr_item(IN_F(18), 3088, 96, r, WSB(WS_WGIN), 1024, RmId{0}, scr, c.lane); continue; } r -= I5;
        if (r < I6) { tr_item(IN_F(22), 1024, 32, r, WSB(WS_WGO), 1024, RmId{0}, scr, c.lane); continue; } r -= I6;
        if (r < I7) { tr_item(IN_F(23), 4096, 128, r, WSB(WS_WUP), 1024, RmId{0}, scr, c.lane); continue; } r -= I7;
        if (r < I8) { tr_item(IN_F(23) + (size_t)1024 * 4096, 4096, 128, r, WSB(WS_WUP) + (size_t)4096 * 1024, 1024, RmId{0}, scr, c.lane); continue; } r -= I8;
        if (r < I9) { tr_item(IN_F(24), 1024, 32, r, WSB(WS_WDN), 4096, RmId{0}, scr, c.lane); continue; } r -= I9;
        tr_item(IN_F(24) + (size_t)4096 * 1024, 1024, 32, r, WSB(WS_WDN) + (size_t)1024 * 4096, 4096, RmId{0}, scr, c.lane);
    }
    const int gt = c.gw * 64 + c.lane, ngt = c.ngw * 64;
    for (int i = gt; i < (NIN0 - 544) * 1024 / 2; i += ngt) ((unsigned*)(WSB(WS_WIN0) + (size_t)544 * 1024))[i] = 0u;
    for (int i = gt; i < (NGIN - NGIN_REAL) * 1024 / 2; i += ngt) ((unsigned*)(WSB(WS_WGIN) + (size_t)NGIN_REAL * 1024))[i] = 0u;
    for (int i = gt; i < 16 * 1024; i += ngt) { const int n = i >> 10, k = i & 1023; WSB(WS_WGIN)[(size_t)(3072 + n) * 1024 + k] = (bf16)f2bf(IN_F(18)[(size_t)k * 3088 + 3072 + n]); }
    for (int i = c.gw * 64 + c.lane; i < R * 16; i += c.ngw * 64) { const int r = i >> 4, j = i & 15; float cs, sn; rope_cs(row_pos(r), j, cs, sn); WSF(WS_ROPE)[(size_t)r * 32 + j] = cs; WSF(WS_ROPE)[(size_t)r * 32 + 16 + j] = sn; }
    {
        const float* xp = IN_F(0); const float* xm = IN_F(6); const float* xsm = IN_F(1); bf16* X = WSB(WS_X); bf16* H = WSB(WS_H);
        f32x4 gg[4];
#pragma unroll
        for (int j = 0; j < 4; ++j) gg[j] = *(const f32x4*)(IN_F(7) + 4 * c.lane + 256 * j);
        constexpr int NR = 4;
        for (int r0 = c.gw; r0 < R; r0 += NR * c.ngw) {
            f32x4 v[NR][4]; float s[NR];
#pragma unroll
            for (int q = 0; q < NR; ++q) { const int r = r0 + q * c.ngw < R ? r0 + q * c.ngw : r0;
                const float* xs = r < RMAIN ? xp + (size_t)r * D : (r < RSAMP0 ? xm + (size_t)((r - RMAIN) & 15) * D : xsm + (size_t)(r - RSAMP0) * D);
                s[q] = 0.f;
#pragma unroll
                for (int j = 0; j < 4; ++j) { v[q][j] = *(const f32x4*)(xs + 4 * c.lane + 256 * j); s[q] += (v[q][j].x * v[q][j].x + v[q][j].y * v[q][j].y) + (v[q][j].z * v[q][j].z + v[q][j].w * v[q][j].w); } }
#pragma unroll
            for (int sh = 1; sh < 64; sh <<= 1) {
#pragma unroll
                for (int q = 0; q < NR; ++q) s[q] += __shfl_xor(s[q], sh); }
#pragma unroll
            for (int q = 0; q < NR; ++q) { const int r = r0 + q * c.ngw < R ? r0 + q * c.ngw : r0; const float rs = 1.0f / sqrtf(s[q] * (1.f / D) + EPS);
#pragma unroll
                for (int j = 0; j < 4; ++j) { if (r >= RMAIN) { u32x2 xo; xo.x = pk2(v[q][j].x, v[q][j].y); xo.y = pk2(v[q][j].z, v[q][j].w); *(u32x2*)(X + (size_t)r * D + 4 * c.lane + 256 * j) = xo; }
                    u32x2 o; o.x = pk2(v[q][j].x * rs * gg[j].x, v[q][j].y * rs * gg[j].y); o.y = pk2(v[q][j].z * rs * gg[j].z, v[q][j].w * rs * gg[j].w);
                    *(u32x2*)(H + (size_t)r * D + 4 * c.lane + 256 * j) = o; } }
        }
    }
}

struct EpiF32 { float* C; int ldc; __device__ __forceinline__ void store4(int row, int col, f32x4 v) const { *(f32x4*)(C + (size_t)row * ldc + col) = v; } };
struct EpiBf16 { bf16* C; int ldc;
    __device__ __forceinline__ void store8(int row, int col, f32x4 a, f32x4 b) const { u32x4 o; o.x = pk2(a.x, a.y); o.y = pk2(a.z, a.w); o.z = pk2(b.x, b.y); o.w = pk2(b.z, b.w); *(u32x4*)(C + (size_t)row * ldc + col) = o; }
    __device__ __forceinline__ void store4(int row, int col, f32x4 v) const { u32x2 o; o.x = pk2(v.x, v.y); o.y = pk2(v.z, v.w); *(u32x2*)(C + (size_t)row * ldc + col) = o; } };
struct EpiRelu2 { bf16* C; int ldc;
    __device__ __forceinline__ void store8(int row, int col, f32x4 a, f32x4 b) const {
        f32x4 r; r.x = fmaxf(a.x, 0.f); r.y = fmaxf(a.y, 0.f); r.z = fmaxf(a.z, 0.f); r.w = fmaxf(a.w, 0.f); r = r * r;
        f32x4 s; s.x = fmaxf(b.x, 0.f); s.y = fmaxf(b.y, 0.f); s.z = fmaxf(b.z, 0.f); s.w = fmaxf(b.w, 0.f); s = s * s;
        u32x4 o; o.x = pk2(r.x, r.y); o.y = pk2(r.z, r.w); o.z = pk2(s.x, s.y); o.w = pk2(s.z, s.w); *(u32x4*)(C + (size_t)row * ldc + col) = o; }
    __device__ __forceinline__ void store4(int row, int col, f32x4 v) const {
    f32x4 r; r.x = fmaxf(v.x, 0.f); r.y = fmaxf(v.y, 0.f); r.z = fmaxf(v.z, 0.f); r.w = fmaxf(v.w, 0.f); r = r * r;
    u32x2 o; o.x = pk2(r.x, r.y); o.y = pk2(r.z, r.w); *(u32x2*)(C + (size_t)row * ldc + col) = o; } };
struct EpiQ { bf16* QN; bf16* QPE; const float* ROPE;
    __device__ __forceinline__ void store8(int row, int col, f32x4 a, f32x4 b) const {
        if (col < 1024) { u32x4 o; o.x = pk2(a.x * QSCALE, a.y * QSCALE); o.y = pk2(a.z * QSCALE, a.w * QSCALE); o.z = pk2(b.x * QSCALE, b.y * QSCALE); o.w = pk2(b.z * QSCALE, b.w * QSCALE); *(u32x4*)(QN + (size_t)row * 1024 + col) = o; }
        else { store4(row, col, a); store4(row, col + 4, b); }
    }
    __device__ __forceinline__ void store4(int row, int col, f32x4 v) const {
        if (col < 1024) { u32x2 o; o.x = pk2(v.x * QSCALE, v.y * QSCALE); o.y = pk2(v.z * QSCALE, v.w * QSCALE); *(u32x2*)(QN + (size_t)row * 1024 + col) = o; }
        else { const int p0 = (col - 1024) >> 1; const float* rt = ROPE + (size_t)row * 32;
#pragma unroll
            for (int e = 0; e < 2; ++e) { const int p = p0 + e, h = p >> 4, jj = p & 15; const float x1 = e ? v.z : v.x, x2 = e ? v.w : v.y, cs = rt[jj], sn = rt[16 + jj];
                QPE[(size_t)row * 512 + h * 32 + jj] = (bf16)f2bf((x1 * cs - x2 * sn) * QSCALE); QPE[(size_t)row * 512 + h * 32 + 16 + jj] = (bf16)f2bf((x1 * sn + x2 * cs) * QSCALE); } }
    } };
struct EpiBf16S { bf16* C; int ldc; float s;
    __device__ __forceinline__ void store8(int row, int col, f32x4 a, f32x4 b) const { u32x4 o; o.x = pk2(a.x * s, a.y * s); o.y = pk2(a.z * s, a.w * s); o.z = pk2(b.x * s, b.y * s); o.w = pk2(b.z * s, b.w * s); *(u32x4*)(C + (size_t)row * ldc + col) = o; }
    __device__ __forceinline__ void store4(int row, int col, f32x4 v) const { u32x2 o; o.x = pk2(v.x * s, v.y * s); o.y = pk2(v.z * s, v.w * s); *(u32x2*)(C + (size_t)row * ldc + col) = o; } };
struct EpiGla { bf16 *QG, *KG, *VG, *RG; float* GD;
    __device__ __forceinline__ void store8(int row, int col, f32x4 a, f32x4 b) const {
        if (col < 3072) { bf16* dst; int cc;
            if (col < 512) { dst = QG + (size_t)row * 512; cc = col; a = a * GLA_SCALE; b = b * GLA_SCALE; }
            else if (col < 1024) { dst = KG + (size_t)row * 512; cc = col - 512; }
            else if (col < 2048) { dst = VG + (size_t)row * 1024; cc = col - 1024; }
            else { dst = RG + (size_t)row * 1024; cc = col - 2048; }
            u32x4 o; o.x = pk2(a.x, a.y); o.y = pk2(a.z, a.w); o.z = pk2(b.x, b.y); o.w = pk2(b.z, b.w); *(u32x4*)(dst + cc) = o;
        } else if (col < 3088) { *(f32x4*)(GD + (size_t)row * 16 + (col - 3072)) = a; *(f32x4*)(GD + (size_t)row * 16 + (col - 3072) + 4) = b; }
    }
    __device__ __forceinline__ void store4(int row, int col, f32x4 v) const {
        if (col < 3072) { bf16* dst; int cc;
            if (col < 512) { dst = QG + (size_t)row * 512; cc = col; v = v * GLA_SCALE; }
            else if (col < 1024) { dst = KG + (size_t)row * 512; cc = col - 512; }
            else if (col < 2048) { dst = VG + (size_t)row * 1024; cc = col - 1024; }
            else { dst = RG + (size_t)row * 1024; cc = col - 2048; }
            u32x2 o; o.x = pk2(v.x, v.y); o.y = pk2(v.z, v.w); *(u32x2*)(dst + cc) = o;
        } else if (col < 3088) { *(f32x4*)(GD + (size_t)row * 16 + (col - 3072)) = v; }
    } };
template <class Epi>
__device__ __forceinline__ void gemm_naive(const bf16* A, const bf16* Bt, int M, int N, int K, const Epi& E, LAS unsigned char* lds, int tid) {
    LAS float* As = (LAS float*)lds;
    LAS float* Bs = As + 32 * 68;
    const int ntm = M / 64, ntn = N / 128, ty = tid >> 5, tx = tid & 31;
    for (int tile = blockIdx.x; tile < ntm * ntn; tile += gridDim.x) {
        const int tm = tile / ntn, tn = tile % ntn;
        f32x4 acc[4];
#pragma unroll
        for (int i = 0; i < 4; ++i) acc[i] = (f32x4){0.f, 0.f, 0.f, 0.f};
        for (int k0 = 0; k0 < K; k0 += 32) {
            { const int row = tid >> 3, kq = (tid & 7) * 4; const u32x2 v = *(const u32x2*)(A + (size_t)(tm * 64 + row) * K + k0 + kq);
              As[(kq + 0) * 68 + row] = bflo(v.x); As[(kq + 1) * 68 + row] = bfhi(v.x); As[(kq + 2) * 68 + row] = bflo(v.y); As[(kq + 3) * 68 + row] = bfhi(v.y); }
            { const int row = tid >> 2, kq = (tid & 3) * 8; const u32x4 v = *(const u32x4*)(Bt + (size_t)(tn * 128 + row) * K + k0 + kq);
              Bs[(kq + 0) * 132 + row] = bflo(v.x); Bs[(kq + 1) * 132 + row] = bfhi(v.x); Bs[(kq + 2) * 132 + row] = bflo(v.y); Bs[(kq + 3) * 132 + row] = bfhi(v.y);
              Bs[(kq + 4) * 132 + row] = bflo(v.z); Bs[(kq + 5) * 132 + row] = bfhi(v.z); Bs[(kq + 6) * 132 + row] = bflo(v.w); Bs[(kq + 7) * 132 + row] = bfhi(v.w); }
            __syncthreads();
#pragma unroll 8
            for (int k = 0; k < 32; ++k) {
                const f32x4 av = *(const LAS f32x4*)(As + k * 68 + 4 * ty); const f32x4 bv = *(const LAS f32x4*)(Bs + k * 132 + 4 * tx);
                acc[0] += av.x * bv; acc[1] += av.y * bv; acc[2] += av.z * bv; acc[3] += av.w * bv;
            }
            __syncthreads();
        }
#pragma unroll
        for (int i = 0; i < 4; ++i) E.store4(tm * 64 + 4 * ty + i, tn * 128 + 4 * tx, acc[i]);
    }
}


template <class E> struct EpiWrap {
    static constexpr bool PERM = false, AFTER_DRAIN = false; E e;
    __device__ __forceinline__ void operator()(const pg8::f32x4 (&acc)[2][2][4][2], const pg8::Unit& u, int wr, int wc, int fr, int fq) const {
#pragma unroll
        for (int ai = 0; ai < 2; ++ai)
#pragma unroll
            for (int m = 0; m < 4; ++m) { const int row = u.pm * 256 + ai * 128 + wr * 64 + m * 16 + fr;
#pragma unroll
                for (int bj = 0; bj < 2; ++bj)
#pragma unroll
                    for (int n = 0; n < 2; ++n) e.store4(row, u.pn * 256 + bj * 128 + wc * 32 + n * 16 + 4 * fq, acc[ai][bj][m][n]); }
    }
};
template <int KSUB> struct EpiSlab {
    static constexpr bool PERM = false, AFTER_DRAIN = false; float* MT;
    __device__ __forceinline__ void operator()(const pg8::f32x4 (&acc)[2][2][4][2], const pg8::Unit& u, int wr, int wc, int fr, int fq) const {
        float* base = MT + ((size_t)(u.k0 / KSUB) * (RP - RMAIN) + (size_t)(u.pm * 256 - RMAIN)) * D + u.pn * 256 + wc * 32 + 4 * fq;
#pragma unroll
        for (int ai = 0; ai < 2; ++ai)
#pragma unroll
            for (int m = 0; m < 4; ++m) { float* rp = base + (size_t)(ai * 128 + wr * 64 + m * 16 + fr) * D;
#pragma unroll
                for (int bj = 0; bj < 2; ++bj)
#pragma unroll
                    for (int n = 0; n < 2; ++n) *(f32x4*)(rp + bj * 128 + n * 16) = acc[ai][bj][m][n]; }
    }
};
template <class E> struct EpiWrap8 {
    static constexpr bool PERM = true, AFTER_DRAIN = false; E e;
    __device__ __forceinline__ void operator()(const pg8::f32x4 (&acc)[2][2][4][2], const pg8::Unit& u, int wr, int wc, int fr, int fq) const {
#pragma unroll
        for (int ai = 0; ai < 2; ++ai)
#pragma unroll
            for (int m = 0; m < 4; ++m) { const int row = u.pm * 256 + ai * 128 + wr * 64 + m * 16 + fr;
#pragma unroll
                for (int bj = 0; bj < 2; ++bj) e.store8(row, u.pn * 256 + bj * 128 + wc * 32 + 8 * fq, acc[ai][bj][m][0], acc[ai][bj][m][1]); }
    }
};
template <class E>
__device__ __forceinline__ void gemm_mfma8(const bf16* A, const bf16* Bt, int M, int N, int K, const E& e, LAS unsigned char* lds, int wave) {
    pg8::Gemm g{A, Bt, M, N, K, K}; pg8::StaticOrder S; S.init(M, N, (int)gridDim.x, (int)blockIdx.x);
    EpiWrap8<E> W{e};
    pg8::gemm_phase<EpiWrap8<E>, pg8::StaticOrder, true, true>(lds, g, S, W, wave);
}
template <class E>
__device__ __forceinline__ void gemm_mfma(const bf16* A, const bf16* Bt, int M, int N, int K, const E& e, LAS unsigned char* lds, int wave) {
    pg8::Gemm g{A, Bt, M, N, K, K}; pg8::StaticOrder S; S.init(M, N, (int)gridDim.x, (int)blockIdx.x);
    EpiWrap<E> W{e};
    pg8::gemm_phase<EpiWrap<E>, pg8::StaticOrder, true, true>(lds, g, S, W, wave);
}
template <int SPLIT, int NN, int KSUB, int PM0, int NUNITS> struct TailOrder {
    int G, c;
    __device__ __forceinline__ bool next(int i, pg8::Unit& u) const { const int L = i * G + c; if (L >= NUNITS) return false; const int ks = L % SPLIT, t = L / SPLIT; u.pn = t % NN; u.pm = PM0 + t / NN; u.k0 = ks * KSUB; u.prob = 0; u.aoff = 0; u.boff = 0; return true; }
    __device__ __forceinline__ void a_ready(const pg8::Unit&) const {}
    __device__ __forceinline__ void done(const pg8::Unit&) const {}
};
struct EpiAtomicF32 { float* C; int ldc; __device__ __forceinline__ void store4(int row, int col, f32x4 v) const { float* p = C + (size_t)row * ldc + col;
    __hip_atomic_fetch_add(p, v.x, __ATOMIC_RELAXED, __HIP_MEMORY_SCOPE_AGENT); __hip_atomic_fetch_add(p + 1, v.y, __ATOMIC_RELAXED, __HIP_MEMORY_SCOPE_AGENT);
    __hip_atomic_fetch_add(p + 2, v.z, __ATOMIC_RELAXED, __HIP_MEMORY_SCOPE_AGENT); __hip_atomic_fetch_add(p + 3, v.w, __ATOMIC_RELAXED, __HIP_MEMORY_SCOPE_AGENT); } };
template <int K, int SPLIT>
__device__ __forceinline__ void gemm_n1024_tail(const bf16* A, const bf16* Bt, bf16* C, float* MT, LAS unsigned char* lds, int wave) {
    { pg8::Gemm g{A, Bt, RMAIN, D, K, K}; pg8::StaticOrder S; S.init(RMAIN, D, (int)gridDim.x, (int)blockIdx.x); EpiWrap8<EpiBf16> W{EpiBf16{C, D}};
      pg8::gemm_phase<EpiWrap8<EpiBf16>, pg8::StaticOrder, true, true>(lds, g, S, W, wave); }
    { typedef TailOrder<SPLIT, D / 256, K / SPLIT, RMAIN / 256, (RP - RMAIN) / 256 * (D / 256) * SPLIT> TO;
      pg8::Gemm g{A, Bt, RP, D, K / SPLIT, K}; TO S{(int)gridDim.x, (int)blockIdx.x}; EpiSlab<K / SPLIT> W{MT};
      pg8::gemm_phase<EpiSlab<K / SPLIT>, TO, false, true>(lds, g, S, W, wave); }
}

struct P3Order {
    int G, c;
    static constexpr int NQ = (RP / 256) * (NUQ / 256), NL = (DB * DS / 256) * (NH * KVL / 256), NK = (RP / 256) * (NUKV / 256);
    __device__ __forceinline__ bool next(int i, pg8::Unit& u) const {
        int L = i * G + c; u.k0 = 0;
        if (L < NK) { u.prob = 2; u.pm = L / (NUKV / 256); u.pn = L % (NUKV / 256); u.aoff = (long)(WS_CKVN - WS_CQN); u.boff = (long)(WS_WUKV - WS_WUQ); return true; } L -= NK;
        if (L < NQ) { u.prob = 0; u.pm = L / (NUQ / 256); u.pn = L % (NUQ / 256); u.aoff = 0; u.boff = 0; return true; } L -= NQ;
        if (L < NL) { u.prob = 1; u.pm = L / (NH * KVL / 256); u.pn = L % (NH * KVL / 256); u.aoff = (long)RSAMP0 * QL * 2; u.boff = (long)(WS_WUQL - WS_WUQ); return true; }
        return false;
    }
    __device__ __forceinline__ void a_ready(const pg8::Unit&) const {}
    __device__ __forceinline__ void done(const pg8::Unit&) const {}
};
struct EpiP3 {
    static constexpr bool PERM = true, AFTER_DRAIN = false; EpiQ eq; EpiBf16S el; EpiBf16 ek;
    __device__ __forceinline__ void operator()(const pg8::f32x4 (&acc)[2][2][4][2], const pg8::Unit& u, int wr, int wc, int fr, int fq) const {
        asm volatile("" : "+v"(fr), "+v"(fq));
        if (u.prob == 0) { EpiWrap8<EpiQ> w{eq}; w(acc, u, wr, wc, fr, fq); }
        else if (u.prob == 1) { EpiWrap8<EpiBf16S> w{el}; w(acc, u, wr, wc, fr, fq); }
        else { EpiWrap8<EpiBf16> w{ek}; w(acc, u, wr, wc, fr, fq); }
    }
};
__device__ __forceinline__ void gemm_p3(ArgsP a, LAS unsigned char* lds, int wave) {
    pg8::Gemm g{WSB(WS_CQN), WSB(WS_WUQ), RP, NUQ, QL, QL}; P3Order S{(int)gridDim.x, (int)blockIdx.x};
    EpiP3 E{EpiQ{WSB(WS_QN), WSB(WS_QPE), WSF(WS_ROPE)}, EpiBf16S{WSB(WS_QLAT), NH * KVL, QSCALE}, EpiBf16{WSB(WS_KNV), NUKV}};
    pg8::gemm_phase<EpiP3, P3Order, false, true>(lds, g, S, E, wave);
}

struct EpiMlaIn {
    static constexpr bool PERM = false, AFTER_DRAIN = true;
    bf16 *CQN, *CKVN, *KPEB; const float *qg, *kg, *ROPE; float* out;
    __device__ __forceinline__ void fused(pg8::f32x4 (&acc)[2][2][4][2], const pg8::Unit& u, int wr, int wc, int fr, int fq, PG8_LAS unsigned char* lds, int wid, int lane) const {
        asm volatile("" : "+v"(fr), "+v"(fq));
        if (u.pn < 2) {
            PG8_LAS float* P = (PG8_LAS float*)lds;
            float s[2][4];
#pragma unroll
            for (int ai = 0; ai < 2; ++ai)
#pragma unroll
                for (int m = 0; m < 4; ++m) { float t = 0.f;
#pragma unroll
                    for (int bj = 0; bj < 2; ++bj)
#pragma unroll
                        for (int n = 0; n < 2; ++n) { const pg8::f32x4 x = acc[ai][bj][m][n]; t += (x[0] * x[0] + x[1] * x[1]) + (x[2] * x[2] + x[3] * x[3]); }
                    t += __shfl_xor(t, 16); t += __shfl_xor(t, 32);
                    if (fq == 0) P[(ai * 128 + wr * 64 + m * 16 + fr) * 4 + wc] = t; }
            asm volatile("s_waitcnt lgkmcnt(0)\n\ts_barrier" ::: "memory");
#pragma unroll
            for (int ai = 0; ai < 2; ++ai)
#pragma unroll
                for (int m = 0; m < 4; ++m) { const pg8::f32x4 p4 = *(const PG8_LAS pg8::f32x4*)(P + (ai * 128 + wr * 64 + m * 16 + fr) * 4); s[ai][m] = 1.0f / sqrtf(((p4[0] + p4[1]) + (p4[2] + p4[3])) * (1.f / 256) + EPS); }
            const float* g = u.pn == 0 ? qg : kg; bf16* dst = u.pn == 0 ? CQN : CKVN;
#pragma unroll
            for (int bj = 0; bj < 2; ++bj)
#pragma unroll
                for (int n = 0; n < 2; ++n) { const int col = bj * 128 + wc * 32 + n * 16 + 4 * fq; const pg8::f32x4 gv = *(const pg8::f32x4*)(g + col);
#pragma unroll
                    for (int ai = 0; ai < 2; ++ai)
#pragma unroll
                        for (int m = 0; m < 4; ++m) { const int row = u.pm * 256 + ai * 128 + wr * 64 + m * 16 + fr; if (row >= R) continue;
                            const pg8::f32x4 y = acc[ai][bj][m][n] * s[ai][m] * gv;
                            u32x2 o; o.x = pk2(y[0], y[1]); o.y = pk2(y[2], y[3]); *(u32x2*)(dst + (size_t)row * 256 + col) = o;
                            if (u.pn == 1) { const int pos = row_pos(row); float* oc = row < RSAMP0 ? out + O_CKVP + ((size_t)(row < RMAIN ? (row >> 12) : ((row - RMAIN) >> 4)) * TP + pos) * 256 : out + O_CKVS + (size_t)(row - RSAMP0) * 256;
                                *(pg8::f32x4*)(oc + col) = y; } } }
        } else if (wc == 0) {
#pragma unroll
            for (int ai = 0; ai < 2; ++ai)
#pragma unroll
                for (int m = 0; m < 4; ++m) { const int row = u.pm * 256 + ai * 128 + wr * 64 + m * 16 + fr; if (row >= R) continue;
                    const int pos = row_pos(row); const float* rt = ROPE + (size_t)row * 32 + 4 * fq; const pg8::f32x4 cs = *(const pg8::f32x4*)rt, sn = *(const pg8::f32x4*)(rt + 16);
                    const pg8::f32x4 x1 = acc[ai][0][m][0], x2 = acc[ai][0][m][1]; const pg8::f32x4 o1 = x1 * cs - x2 * sn, o2 = x1 * sn + x2 * cs;
                    float* ok = row < RSAMP0 ? out + O_KPEP + ((size_t)(row < RMAIN ? (row >> 12) : ((row - RMAIN) >> 4)) * TP + pos) * 32 : out + O_KPES + (size_t)(row - RSAMP0) * 32;
                    *(pg8::f32x4*)(ok + 4 * fq) = o1; *(pg8::f32x4*)(ok + 16 + 4 * fq) = o2;
                    u32x2 w; w.x = pk2(o1[0], o1[1]); w.y = pk2(o1[2], o1[3]); *(u32x2*)(KPEB + (size_t)row * 32 + 4 * fq) = w; w.x = pk2(o2[0], o2[1]); w.y = pk2(o2[2], o2[3]); *(u32x2*)(KPEB + (size_t)row * 32 + 16 + 4 * fq) = w; }
        }
    }
};
__device__ __forceinline__ void gemm_p1(ArgsP a, LAS unsigned char* lds, int wave) {
    pg8::Gemm g{WSB(WS_H), WSB(WS_WIN0), RP, NIN0, D, D}; pg8::StaticOrder S; S.init(RP, NIN0, (int)gridDim.x, (int)blockIdx.x);
    EpiMlaIn E{WSB(WS_CQN), WSB(WS_CKVN), WSB(WS_KPE), IN_F(12), IN_F(14), WSF(WS_ROPE), a->out};
    pg8::gemm_phase<EpiMlaIn, pg8::StaticOrder, false, true>(lds, g, S, E, wave);
}
#ifndef USE_NAIVE_ATTN
#define USE_NAIVE_ATTN 0
#endif
#ifndef USE_NAIVE_DECODE
#define USE_NAIVE_DECODE 0
#endif
#ifndef USE_NAIVE_GLA
#define USE_NAIVE_GLA 0
#endif
#ifndef PROBE
#define PROBE 0
#endif
#ifndef PROBE_LO
#define PROBE_LO -1
#define PROBE_HI -1
#endif
#ifndef USE_NAIVE_GEMM
#define USE_NAIVE_GEMM 0
#endif
#if USE_NAIVE_GEMM
#define GEMM(A, Bt, M, N, K, E) gemm_naive(A, Bt, M, N, K, E, lds, fresh_tid(c.wave))
#else
#define GEMM(A, Bt, M, N, K, E) gemm_mfma(A, Bt, M, N, K, E, lds, c.wave)
#endif


namespace att {
typedef short bf16x8 __attribute__((ext_vector_type(8)));
typedef short s16x4 __attribute__((ext_vector_type(4)));
typedef float f32x16 __attribute__((ext_vector_type(16)));
constexpr int KSLOT = 12288, VSLOT = 8192, LDS_K = 0, LDS_V = 2 * KSLOT, LDS_WS = LDS_V + 2 * VSLOT, LDS_OST = LDS_WS + 8 * 256, LDS_TOTAL = LDS_OST + 8 * 4096;
__device__ __forceinline__ int crow(int r, int hi) { return (r & 3) + 8 * (r >> 2) + 4 * hi; }
typedef float f32x2_t __attribute__((ext_vector_type(2))); typedef __bf16 bf16x2_t __attribute__((ext_vector_type(2)));
__device__ __forceinline__ unsigned cvtpk(float lo, float hi) { f32x2_t v = {lo, hi}; bf16x2_t b = __builtin_convertvector(v, bf16x2_t); return __builtin_bit_cast(unsigned, b); }
__device__ __forceinline__ s16x4 vtr(const LAS unsigned char* p) { typedef short v4i16_t __attribute__((ext_vector_type(4))); return __builtin_bit_cast(s16x4, __builtin_amdgcn_ds_read_tr16_b64_v4i16((LAS v4i16_t*)p)); }
__device__ __forceinline__ float pmax32(float m) { auto rr = __builtin_amdgcn_permlane32_swap(__float_as_uint(m), __float_as_uint(m), false, false); return fmaxf(__uint_as_float(rr[0]), __uint_as_float(rr[1])); }
__device__ __forceinline__ float psum32(float m) { auto rr = __builtin_amdgcn_permlane32_swap(__float_as_uint(m), __float_as_uint(m), false, false); return __uint_as_float(rr[0]) + __uint_as_float(rr[1]); }
#define ATT_WAIT_BAR() asm volatile("s_waitcnt vmcnt(0) lgkmcnt(0)\n\ts_barrier" ::: "memory")
__device__ __forceinline__ void glds16(const void* gsrc, unsigned lds_dst) { unsigned keep;
    asm volatile("s_mov_b32 %0, m0\n\ts_mov_b32 m0, %2\n\ts_nop 0\n\tglobal_load_lds_dwordx4 %1, off\n\ts_mov_b32 m0, %0" : "=&s"(keep) : "v"(gsrc), "s"(lds_dst) : "memory"); }

__device__ __forceinline__ void attn_unit(int b, int h, int qb, const bf16* QN, const bf16* QPE, const bf16* KNV, const bf16* KPE, bf16* O, LAS unsigned char* lds, int wave_id) {
    const int tid = fresh_tid(wave_id), lane = tid & 63, r32 = lane & 31, hi = lane >> 5; const int wid = wave_id;
    const int rowbase = b * SEQ, q0 = qb * 256, qrow = rowbase + q0 + wid * 32 + r32, qrel = q0 + wid * 32 + r32;
    bf16x8 qr[6];
#pragma unroll
    for (int d0 = 0; d0 < 4; ++d0) qr[d0] = *(const bf16x8*)(QN + (size_t)qrow * 1024 + h * 64 + d0 * 16 + hi * 8);
#pragma unroll
    for (int d0 = 0; d0 < 2; ++d0) qr[4 + d0] = *(const bf16x8*)(QPE + (size_t)qrow * 512 + h * 32 + d0 * 16 + hi * 8);
    LAS float* wsf = (LAS float*)(lds + LDS_WS) + wid * 64;
    const int NT = 4 * qb + 4;
#define ATT_DMA(t, slot) do { const size_t row0_ = (t) == 0 ? (size_t)(RMAIN + 16 * b) : (size_t)(rowbase + 64 * ((t) - 1)); \
        __builtin_amdgcn_global_load_lds((const unsigned*)(KNV + (row0_ + lane) * 2048 + h * 64 + wid * 8), (LAS unsigned*)(lds + LDS_K + (slot) * KSLOT + wid * 1024), 16, 0, 0); \
        if (wid < 4) __builtin_amdgcn_global_load_lds((const unsigned*)(KPE + (row0_ + lane) * 32 + wid * 8), (LAS unsigned*)(lds + LDS_K + (slot) * KSLOT + (8 + wid) * 1024), 16, 0, 0); \
        __builtin_amdgcn_global_load_lds((const unsigned*)(KNV + (row0_ + 16 * (wid & 3) + (lane >> 2)) * 2048 + 1024 + h * 64 + (wid >> 2) * 32 + (lane & 3) * 8), (LAS unsigned*)(lds + LDS_V + (slot) * VSLOT + wid * 1024), 16, 0, 0); } while (0)
    f32x16 o[2]; o[0] = f32x16{}; o[1] = f32x16{};
    float mref = -INFINITY, l = 0.f;
    ATT_DMA(0, 0);
    for (int t = 0; t <= NT; ++t) {
        ATT_WAIT_BAR();
        const int slot = t & 1;
        if (t < NT) ATT_DMA(t + 1, slot ^ 1);
        const int kt0 = 64 * (t - 1);
        if (t > 0 && kt0 > q0 + wid * 32 + 31) continue;
        f32x16 p0 = f32x16{}, p1 = f32x16{};
        const LAS unsigned char* kb = lds + LDS_K + slot * KSLOT + hi * 1024 + r32 * 16;
#pragma unroll
        for (int d0 = 0; d0 < 6; ++d0) {
            const bf16x8 b0 = *(const LAS bf16x8*)(kb + d0 * 2048), b1 = *(const LAS bf16x8*)(kb + d0 * 2048 + 512);
            p0 = __builtin_amdgcn_mfma_f32_32x32x16_bf16(b0, qr[d0], p0, 0, 0, 0);
            p1 = __builtin_amdgcn_mfma_f32_32x32x16_bf16(b1, qr[d0], p1, 0, 0, 0);
        }
        if (t == 0) {
#pragma unroll
            for (int r = 0; r < 16; ++r) { if (crow(r, hi) >= NMETA) p0[r] = -INFINITY; p1[r] = -INFINITY; }
        } else if (kt0 + 63 > q0 + wid * 32) {
#pragma unroll
            for (int r = 0; r < 16; ++r) { const int kv = kt0 + crow(r, hi); if (kv > qrel) p0[r] = -INFINITY; if (kv + 32 > qrel) p1[r] = -INFINITY; }
        }
        float rm = fmaxf(p0[0], p1[0]);
#pragma unroll
        for (int r = 1; r < 16; ++r) rm = fmaxf(rm, fmaxf(p0[r], p1[r]));
        rm = pmax32(rm);
        if (__any(rm > mref + 8.0f)) {
            const float mnew = fmaxf(mref, rm); const float f = __builtin_amdgcn_exp2f(mref - mnew);
            mref = mnew; l *= f;
            if (hi == 0) wsf[r32] = f;
            LDS_WAIT();
#pragma unroll
            for (int r = 0; r < 16; ++r) { const float fr = wsf[crow(r, hi)]; o[0][r] *= fr; o[1][r] *= fr; }
        }
        float sacc = 0.f;
#pragma unroll
        for (int r = 0; r < 16; ++r) { p0[r] = __builtin_amdgcn_exp2f(p0[r] - mref); p1[r] = __builtin_amdgcn_exp2f(p1[r] - mref); sacc += p0[r] + p1[r]; }
        l += sacc;
        u32x4 pw[4];
#pragma unroll
        for (int i = 0; i < 4; ++i) { pw[0][i] = cvtpk(p0[2 * i], p0[2 * i + 1]); pw[1][i] = cvtpk(p0[8 + 2 * i], p0[8 + 2 * i + 1]); pw[2][i] = cvtpk(p1[2 * i], p1[2 * i + 1]); pw[3][i] = cvtpk(p1[8 + 2 * i], p1[8 + 2 * i + 1]); }
        const LAS unsigned char* vb = lds + LDS_V + slot * VSLOT + ((lane >> 4) & 1) * 32 + (lane & 3) * 8 + (4 * hi + ((lane & 15) >> 2)) * 64;
#pragma unroll
        for (int d0 = 0; d0 < 2; ++d0)
#pragma unroll
            for (int ks = 0; ks < 4; ++ks) {
                const s16x4 vlo = vtr(vb + d0 * 4096 + ks * 1024), vhi = vtr(vb + d0 * 4096 + ks * 1024 + 512);
                const bf16x8 vf = (bf16x8){vlo[0], vlo[1], vlo[2], vlo[3], vhi[0], vhi[1], vhi[2], vhi[3]};
                o[d0] = __builtin_amdgcn_mfma_f32_32x32x16_bf16(__builtin_bit_cast(bf16x8, pw[ks]), vf, o[d0], 0, 0, 0);
            }
    }
    l = psum32(l);
    if (hi == 0) wsf[32 + r32] = l;
    LDS_WAIT();
    bf16* Ow = O + (size_t)(rowbase + q0 + wid * 32) * 1024 + h * 64;
    LAS bf16* stg = (LAS bf16*)(lds + LDS_OST) + wid * 2048;
#pragma unroll
    for (int r = 0; r < 16; ++r) { const int orow = crow(r, hi); const float il = 1.0f / wsf[32 + orow];
        stg[orow * 64 + r32] = (bf16)f2bf(o[0][r] * il); stg[orow * 64 + 32 + r32] = (bf16)f2bf(o[1][r] * il); }
    LDS_WAIT();
#pragma unroll
    for (int i = 0; i < 4; ++i) { const int row = i * 8 + (lane >> 3), ch = lane & 7; const u32x4 v = *(const LAS u32x4*)(stg + row * 64 + ch * 8); *(u32x4*)(Ow + (size_t)row * 1024 + ch * 8) = v; }
    ATT_WAIT_BAR();
#undef ATT_DMA
}
constexpr int P_LDS_K = 0, P_LDS_V = 3 * KSLOT, P_LDS_WS = P_LDS_V + 2 * VSLOT, P_LDS_OST = P_LDS_WS + 8 * 256, P_LDS_TOTAL = P_LDS_OST + 8 * 4096;
__device__ __forceinline__ void attn_unit2(int b, int h, int qb, const bf16* QN, const bf16* QPE, const bf16* KNV, const bf16* KPE, bf16* O, LAS unsigned char* lds, int wave_id) {
    const int tid = fresh_tid(wave_id), lane = tid & 63, r32 = lane & 31, hi = lane >> 5; const int wid = wave_id;
    const bool meta = qb < 0;
    const int rowbase = b * SEQ, q0 = meta ? 0 : qb * 256, qrow = meta ? RMAIN + 16 * b + (r32 & 15) : rowbase + q0 + wid * 32 + r32, qrel = meta ? (r32 & 15) : q0 + wid * 32 + r32;
    bf16x8 qr[6];
#pragma unroll
    for (int d0 = 0; d0 < 4; ++d0) qr[d0] = *(const bf16x8*)(QN + (size_t)qrow * 1024 + h * 64 + d0 * 16 + hi * 8);
#pragma unroll
    for (int d0 = 0; d0 < 2; ++d0) qr[4 + d0] = *(const bf16x8*)(QPE + (size_t)qrow * 512 + h * 32 + d0 * 16 + hi * 8);
    LAS float* wsf = (LAS float*)(lds + P_LDS_WS) + wid * 64;
    const unsigned lds0 = (unsigned)(size_t)lds;
    const int NT = meta ? 0 : 4 * qb + 4;
#define A2_ROW0(t) ((t) == 0 ? (size_t)(RMAIN + 16 * b) : (size_t)(rowbase + 64 * ((t) - 1)))
#define A2_DMA_K(t, ks) do { const size_t row0_ = A2_ROW0(t); \
        glds16(KNV + (row0_ + lane) * 2048 + h * 64 + wid * 8, (unsigned)__builtin_amdgcn_readfirstlane((int)(lds0 + P_LDS_K + (ks) * KSLOT + wid * 1024))); \
        if (wid < 4) glds16(KPE + (row0_ + lane) * 32 + wid * 8, (unsigned)__builtin_amdgcn_readfirstlane((int)(lds0 + P_LDS_K + (ks) * KSLOT + (8 + wid) * 1024))); } while (0)
#define A2_DMA_V(t, vs) do { const size_t row0_ = A2_ROW0(t); \
        glds16(KNV + (row0_ + 16 * (wid & 3) + (lane >> 2)) * 2048 + 1024 + h * 64 + (wid >> 2) * 32 + (lane & 3) * 8, (unsigned)__builtin_amdgcn_readfirstlane((int)(lds0 + P_LDS_V + (vs) * VSLOT + wid * 1024))); } while (0)
#define A2_QKT(P0, P1, ks) do { P0 = f32x16{}; P1 = f32x16{}; const LAS unsigned char* kb_ = lds + P_LDS_K + (ks) * KSLOT + hi * 1024 + r32 * 16; \
        _Pragma("unroll") for (int d0 = 0; d0 < 6; ++d0) { const bf16x8 b0_ = *(const LAS bf16x8*)(kb_ + d0 * 2048), b1_ = *(const LAS bf16x8*)(kb_ + d0 * 2048 + 512); \
            P0 = __builtin_amdgcn_mfma_f32_32x32x16_bf16(b0_, qr[d0], P0, 0, 0, 0); P1 = __builtin_amdgcn_mfma_f32_32x32x16_bf16(b1_, qr[d0], P1, 0, 0, 0); } } while (0)
    f32x16 o[2]; o[0] = f32x16{}; o[1] = f32x16{};
    float mref = -INFINITY, l = 0.f;
#define A2_TILE(P0, P1, t, vs) do { \
        if ((t) == 0) { const int qlim_ = meta ? (r32 & 15) : NMETA - 1; _Pragma("unroll") for (int r = 0; r < 16; ++r) { if (crow(r, hi) > qlim_) P0[r] = -INFINITY; P1[r] = -INFINITY; } } \
        else { const int kt0_ = 64 * ((t) - 1); if (kt0_ + 63 > q0 + wid * 32) { _Pragma("unroll") for (int r = 0; r < 16; ++r) { const int kv = kt0_ + crow(r, hi); if (kv > qrel) P0[r] = -INFINITY; if (kv + 32 > qrel) P1[r] = -INFINITY; } } } \
        float rm_ = fmaxf(P0[0], P1[0]); \
        _Pragma("unroll") for (int r = 1; r < 16; ++r) rm_ = fmaxf(rm_, fmaxf(P0[r], P1[r])); \
        rm_ = pmax32(rm_); \
        if (__any(rm_ > mref + 8.0f)) { const float mnew = fmaxf(mref, rm_); const float f = __builtin_amdgcn_exp2f(mref - mnew); mref = mnew; l *= f; \
            if (hi == 0) wsf[r32] = f; LDS_WAIT(); \
            _Pragma("unroll") for (int r = 0; r < 16; ++r) { const float fr = wsf[crow(r, hi)]; o[0][r] *= fr; o[1][r] *= fr; } } \
        float sacc_ = 0.f; \
        _Pragma("unroll") for (int r = 0; r < 16; ++r) { P0[r] = __builtin_amdgcn_exp2f(P0[r] - mref); P1[r] = __builtin_amdgcn_exp2f(P1[r] - mref); sacc_ += P0[r] + P1[r]; } \
        l += sacc_; \
        u32x4 pw_[4]; \
        _Pragma("unroll") for (int i = 0; i < 4; ++i) { pw_[0][i] = cvtpk(P0[2 * i], P0[2 * i + 1]); pw_[1][i] = cvtpk(P0[8 + 2 * i], P0[8 + 2 * i + 1]); pw_[2][i] = cvtpk(P1[2 * i], P1[2 * i + 1]); pw_[3][i] = cvtpk(P1[8 + 2 * i], P1[8 + 2 * i + 1]); } \
        const LAS unsigned char* vb_ = lds + P_LDS_V + (vs) * VSLOT + ((lane >> 4) & 1) * 32 + (lane & 3) * 8 + (4 * hi + ((lane & 15) >> 2)) * 64; \
        _Pragma("unroll") for (int d0 = 0; d0 < 2; ++d0) _Pragma("unroll") for (int ks = 0; ks < 4; ++ks) { \
            const s16x4 vlo = vtr(vb_ + d0 * 4096 + ks * 1024), vhi = vtr(vb_ + d0 * 4096 + ks * 1024 + 512); \
            const bf16x8 vf = (bf16x8){vlo[0], vlo[1], vlo[2], vlo[3], vhi[0], vhi[1], vhi[2], vhi[3]}; \
            o[d0] = __builtin_amdgcn_mfma_f32_32x32x16_bf16(__builtin_bit_cast(bf16x8, pw_[ks]), vf, o[d0], 0, 0, 0); } } while (0)
    f32x16 pA0, pA1, pB0, pB1;
    A2_DMA_K(0, 0); A2_DMA_V(0, 0); if (NT >= 1) A2_DMA_K(1, 1);
    ATT_WAIT_BAR();
    A2_QKT(pA0, pA1, 0);
    int kc = 0, vc = 0, t = 0;
#define A2_STEP(PC0, PC1, PN0, PN1) do { \
        if (t > 0) ATT_WAIT_BAR(); \
        const int kn_ = kc == 2 ? 0 : kc + 1, k2_ = kn_ == 2 ? 0 : kn_ + 1; \
        if (t + 2 <= NT) A2_DMA_K(t + 2, k2_); \
        if (t + 1 <= NT) { A2_DMA_V(t + 1, vc ^ 1); A2_QKT(PN0, PN1, kn_); } \
        A2_TILE(PC0, PC1, t, vc); \
        kc = kn_; vc ^= 1; ++t; } while (0)
    while (t + 1 <= NT) { A2_STEP(pA0, pA1, pB0, pB1); A2_STEP(pB0, pB1, pA0, pA1); }
    A2_STEP(pA0, pA1, pB0, pB1);
    l = psum32(l);
    if (hi == 0) wsf[32 + r32] = l;
    LDS_WAIT();
    bf16* Ow = O + (size_t)(meta ? RMAIN + 16 * b : rowbase + q0 + wid * 32) * 1024 + h * 64;
    LAS bf16* stg = (LAS bf16*)(lds + P_LDS_OST) + wid * 2048;
#pragma unroll
    for (int r = 0; r < 16; ++r) { const int orow = crow(r, hi); const float il = 1.0f / wsf[32 + orow];
        stg[orow * 64 + r32] = (bf16)f2bf(o[0][r] * il); stg[orow * 64 + 32 + r32] = (bf16)f2bf(o[1][r] * il); }
    LDS_WAIT();
#pragma unroll
    for (int i = 0; i < 4; ++i) { const int row = i * 8 + (lane >> 3), ch = lane & 7; const u32x4 v = *(const LAS u32x4*)(stg + row * 64 + ch * 8); if (!meta || (wid == 0 && row < NMETA)) *(u32x4*)(Ow + (size_t)row * 1024 + ch * 8) = v; }
    ATT_WAIT_BAR();
#undef A2_ROW0
#undef A2_DMA_K
#undef A2_DMA_V
#undef A2_QKT
#undef A2_TILE
#undef A2_STEP
}
__device__ __forceinline__ void attn_phase(const bf16* QN, const bf16* QPE, const bf16* KNV, const bf16* KPE, bf16* O, LAS unsigned char* lds, int wave_id) {
    const int G = gridDim.x, bx = blockIdx.x; const int vcu = (G % 8 == 0) ? (bx % 8) * (G / 8) + bx / 8 : bx;
    for (int v = vcu; v < NB * NH * 4; v += G) {
        const int bh = v >> 2, s0 = v & 3;
#pragma unroll 1
        for (int i = 0; i < 4; ++i) { const int qb = (i == 0) ? 15 - s0 : (i == 1) ? 11 - s0 : (i == 2) ? 4 + s0 : s0; attn_unit2(bh >> 4, bh & 15, qb, QN, QPE, KNV, KPE, O, lds, wave_id); }
        if (v < NB * NH) attn_unit2(v >> 4, v & 15, -1, QN, QPE, KNV, KPE, O, lds, wave_id);
    }
}
}


namespace dec {
using att::bf16x8; using att::s16x4; using att::f32x16; using att::crow; using att::cvtpk; using att::vtr; using att::pmax32; using att::psum32;
constexpr int KST = 592, KBUF = 64 * KST, LDS_K = 0, LDS_Q = 2 * KBUF, LDS_WS = LDS_Q + 64 * KST, LDS_TOTAL = LDS_WS + 8 * 256;
constexpr int NSTAGE = 64;
__device__ __forceinline__ void decode_unit(int db, int sp, ArgsP a, LAS unsigned char* lds, int wave_id) {
    const int tid = fresh_tid(wave_id), lane = tid & 63, r32 = lane & 31, hi = lane >> 5; const int wid = wave_id;
    const int qh = wid & 1, kh = (wid >> 1) & 1, dh = wid >> 2;
    const float* cckv = IN_F(2); const float* ckpe = IN_F(3); const int* pt = (const int*)a->in[5] + db * NPAGES + sp * 32;
    for (int i = tid; i < 64 * 36; i += 512) { const int q = i / 36, ch = i % 36, t = q >> 4, h = q & 15;
        const bf16* src = ch < 32 ? WSB(WS_QLAT) + ((size_t)(db * 4 + t) * 16 + h) * 256 + ch * 8 : WSB(WS_QPE) + (size_t)(RSAMP0 + db * 4 + t) * 512 + h * 32 + (ch - 32) * 8;
        *(LAS u32x4*)(lds + LDS_Q + q * KST + ch * 16) = *(const u32x4*)src; }
    f32x4 cv[8], kv;
#define DEC_LOAD(s) do { const int page_ = __builtin_amdgcn_readfirstlane(pt[(s) >> 1]); const size_t k0_ = (size_t)page_ * PAGE + ((s) & 1) * 64; \
        _Pragma("unroll") for (int j = 0; j < 8; ++j) cv[j] = *(const f32x4*)(cckv + (k0_ + wid + 8 * j) * 256 + 4 * lane); \
        kv = *(const f32x4*)(ckpe + (k0_ + (tid >> 3)) * 32 + 4 * (tid & 7)); } while (0)
#define DEC_WRITE(buf) do { LAS unsigned char* kb_ = lds + LDS_K + (buf) * KBUF; \
        _Pragma("unroll") for (int j = 0; j < 8; ++j) { u32x2 w_; w_.x = cvtpk(cv[j].x, cv[j].y); w_.y = cvtpk(cv[j].z, cv[j].w); *(LAS u32x2*)(kb_ + (wid + 8 * j) * KST + lane * 8) = w_; } \
        { u32x2 w_; w_.x = cvtpk(kv.x, kv.y); w_.y = cvtpk(kv.z, kv.w); *(LAS u32x2*)(kb_ + (tid >> 3) * KST + 512 + (tid & 7) * 8) = w_; } } while (0)
    LAS float* wsf = (LAS float*)(lds + LDS_WS) + wid * 64;
    f32x16 o[4]; o[0] = f32x16{}; o[1] = f32x16{}; o[2] = f32x16{}; o[3] = f32x16{};
    float mref = -INFINITY, l = 0.f;
#define DEC_BAR() asm volatile("s_waitcnt lgkmcnt(0)\n\ts_barrier" ::: "memory")
    DEC_LOAD(0); DEC_WRITE(0); DEC_LOAD(1);
    DEC_BAR();
    bf16x8 qf[18];
    { const LAS unsigned char* qb = lds + LDS_Q + (qh * 32 + r32) * KST + hi * 16;
#pragma unroll
      for (int s2 = 0; s2 < 18; ++s2) qf[s2] = *(const LAS bf16x8*)(qb + s2 * 32); }
    for (int s = 0; s < NSTAGE; ++s) {
        const int buf = s & 1;
        const LAS unsigned char* kimg = lds + LDS_K + buf * KBUF;
        f32x16 p = f32x16{};
        { const LAS unsigned char* kb = kimg + (kh * 32 + r32) * KST + hi * 16;
#pragma unroll
          for (int s2 = 0; s2 < 18; ++s2) p = __builtin_amdgcn_mfma_f32_32x32x16_bf16(*(const LAS bf16x8*)(kb + s2 * 32), qf[s2], p, 0, 0, 0); }
        float rm = p[0];
#pragma unroll
        for (int r = 1; r < 16; ++r) rm = fmaxf(rm, p[r]);
        rm = pmax32(rm);
        if (__any(rm > mref + 8.0f)) {
            const float mnew = fmaxf(mref, rm); const float f = __builtin_amdgcn_exp2f(mref - mnew);
            mref = mnew; l *= f;
            if (hi == 0) wsf[r32] = f;
            LDS_WAIT();
#pragma unroll
            for (int r = 0; r < 16; ++r) { const float fr = wsf[crow(r, hi)]; o[0][r] *= fr; o[1][r] *= fr; o[2][r] *= fr; o[3][r] *= fr; }
        }
        float sacc = 0.f;
#pragma unroll
        for (int r = 0; r < 16; ++r) { p[r] = __builtin_amdgcn_exp2f(p[r] - mref); sacc += p[r]; }
        l += sacc;
        u32x4 pw[2];
#pragma unroll
        for (int i = 0; i < 4; ++i) { pw[0][i] = cvtpk(p[2 * i], p[2 * i + 1]); pw[1][i] = cvtpk(p[8 + 2 * i], p[8 + 2 * i + 1]); }
        const LAS unsigned char* vb = kimg + (kh * 32 + 4 * hi + ((lane & 15) >> 2)) * KST + (dh * 128 + 16 * ((lane >> 4) & 1) + 4 * (lane & 3)) * 2;
#pragma unroll
        for (int dt = 0; dt < 4; ++dt)
#pragma unroll
            for (int ks = 0; ks < 2; ++ks) {
                const s16x4 vlo = vtr(vb + (ks * 16) * KST + dt * 64), vhi = vtr(vb + (ks * 16 + 8) * KST + dt * 64);
                const bf16x8 vf = (bf16x8){vlo[0], vlo[1], vlo[2], vlo[3], vhi[0], vhi[1], vhi[2], vhi[3]};
                o[dt] = __builtin_amdgcn_mfma_f32_32x32x16_bf16(__builtin_bit_cast(bf16x8, pw[ks]), vf, o[dt], 0, 0, 0);
            }
        if (s + 1 < NSTAGE) { DEC_WRITE(buf ^ 1); if (s + 2 < NSTAGE) DEC_LOAD(s + 2); }
        DEC_BAR();
    }
#undef DEC_BAR
    const int part = (db * 2 + sp) * 2 + kh;
    float* op = WSF(WS_OPART) + (size_t)part * 64 * 256;
#pragma unroll
    for (int dt = 0; dt < 4; ++dt)
#pragma unroll
        for (int r = 0; r < 16; ++r) op[(size_t)(qh * 32 + crow(r, hi)) * 256 + dh * 128 + dt * 32 + r32] = o[dt][r];
    l = psum32(l);
    if (dh == 0 && hi == 0) { float* mp = WSF(WS_MLP) + (size_t)part * 128 + (qh * 32 + r32) * 2; mp[0] = mref; mp[1] = l; }
#undef DEC_LOAD
#undef DEC_WRITE
}
struct LaneCtx { int lane, wave; };
__device__ __forceinline__ void combine_item(ArgsP a, int db, int h, const LaneCtx c, LAS unsigned char* lds) {
    {
        f32x4 cn[4]; float en[4];
#pragma unroll
        for (int s2 = 0; s2 < 4; ++s2) { const int kr = RSAMP0 + db * 4 + s2;
            const u32x2 v = *(const u32x2*)(WSB(WS_CKVN) + (size_t)kr * 256 + 4 * c.lane); cn[s2] = (f32x4){bflo(v.x), bfhi(v.x), bflo(v.y), bfhi(v.y)};
            en[s2] = c.lane < 32 ? bf2f(WSB(WS_KPE)[(size_t)kr * 32 + c.lane]) : 0.f; }
        f32x4 res[4];
#pragma unroll
        for (int t = 0; t < 4; ++t) {
            const int i = db * 4 + t, q = t * 16 + h;
            const u32x2 qv = *(const u32x2*)(WSB(WS_QLAT) + ((size_t)i * 16 + h) * 256 + 4 * c.lane); const f32x4 ql = (f32x4){bflo(qv.x), bfhi(qv.x), bflo(qv.y), bfhi(qv.y)};
            const float qp = c.lane < 32 ? bf2f(WSB(WS_QPE)[(size_t)(RSAMP0 + i) * 512 + h * 32 + c.lane]) : 0.f;
            float mp[4], lp[4], dn[4]; float mg = -INFINITY;
#pragma unroll
            for (int p = 0; p < 4; ++p) { const float* ml = WSF(WS_MLP) + (size_t)(db * 4 + p) * 128 + q * 2; mp[p] = ml[0]; lp[p] = ml[1]; mg = fmaxf(mg, mp[p]); }
#pragma unroll
            for (int s2 = 0; s2 < 4; ++s2) {
                float d = (ql.x * cn[s2].x + ql.y * cn[s2].y) + (ql.z * cn[s2].z + ql.w * cn[s2].w) + qp * en[s2];
                d = wave_sum(d); dn[s2] = s2 <= t ? d : -INFINITY; mg = fmaxf(mg, dn[s2]);
            }
            f32x4 acc = (f32x4){0.f, 0.f, 0.f, 0.f}; float L = 0.f;
#pragma unroll
            for (int p = 0; p < 4; ++p) { const float w = exp2f(mp[p] - mg); L += w * lp[p]; acc += w * *(const f32x4*)(WSF(WS_OPART) + ((size_t)(db * 4 + p) * 64 + q) * 256 + 4 * c.lane); }
#pragma unroll
            for (int s2 = 0; s2 < 4; ++s2) { const float w = exp2f(dn[s2] - mg); L += w; acc += w * cn[s2]; }
            res[t] = acc * (1.0f / L);
            __builtin_amdgcn_sched_barrier(0);
        }
        LAS bf16* rt = (LAS bf16*)(lds + 8 * 256 + c.wave * 2048);
#pragma unroll
        for (int t = 0; t < 4; ++t) { u32x2 w; w.x = pk2(res[t].x, res[t].y); w.y = pk2(res[t].z, res[t].w); *(LAS u32x2*)(rt + t * 256 + 4 * c.lane) = w; }
        LDS_WAIT();
        const int r32 = c.lane & 31, hi = c.lane >> 5;
        att::f32x16 o0 = att::f32x16{}, o1 = att::f32x16{};
        const bf16* wb = WSB(WS_WUKV) + (size_t)(1024 + h * 64 + r32) * 256 + 8 * hi;
#pragma unroll
        for (int s = 0; s < 16; ++s) {
            att::bf16x8 af = att::bf16x8{}; if (r32 < 4) af = *(const LAS att::bf16x8*)(rt + r32 * 256 + 16 * s + 8 * hi);
            const att::bf16x8 b0 = *(const att::bf16x8*)(wb + 16 * s), b1 = *(const att::bf16x8*)(wb + 32 * 256 + 16 * s);
            o0 = __builtin_amdgcn_mfma_f32_32x32x16_bf16(af, b0, o0, 0, 0, 0); o1 = __builtin_amdgcn_mfma_f32_32x32x16_bf16(af, b1, o1, 0, 0, 0);
        }
        if (hi == 0) {
#pragma unroll
            for (int t = 0; t < 4; ++t) { bf16* op = WSB(WS_O) + (size_t)(RSAMP0 + db * 4 + t) * 1024 + h * 64 + r32; op[0] = (bf16)f2bf(o0[t]); op[32] = (bf16)f2bf(o1[t]); }
        }
        LDS_WAIT();
    }
}
__device__ __forceinline__ void combine_phase(ArgsP a, const Ctx& c0, LAS unsigned char* lds) {
    const Ctx c = refresh(c0);
    for (int it = c.gw; it < DB * NH; it += c.ngw) combine_item(a, it >> 4, it & 15, LaneCtx{c.lane, c.wave}, lds);
}
__device__ __forceinline__ void decode_phase(ArgsP a, LAS unsigned char* lds, int wave_id) {
    for (int u = blockIdx.x; u < DB * 2; u += gridDim.x) { decode_unit(u >> 1, u & 1, a, lds, wave_id); __syncthreads(); }
}
}

__device__ __forceinline__ void p_side_tables(ArgsP a, const Ctx& c0, LAS unsigned char* lds, int wg0) {
    const Ctx c = refresh(c0);
    const int nwg = (int)gridDim.x - wg0, bx = (int)blockIdx.x - wg0;
    if (bx < 0) return;
    const int gt = (bx * 8 + c.wave) * 64 + c.lane, ngt = nwg * 512;
    {
        const int r32 = c.lane & 31, hi = c.lane >> 5;
        for (int it = bx * 8 + c.wave; it < NH * 64; it += nwg * 8) {
            const int h = it >> 6, ct = (it >> 3) & 7, kt = it & 7;
            const float* ap = IN_F(15) + (size_t)(ct * 32 + r32) * 1024 + h * 64 + 8 * hi;
            const float* bp = IN_F(13) + (size_t)(kt * 32 + r32) * 1536 + h * 96 + 8 * hi;
            att::f32x16 acc = att::f32x16{};
#pragma unroll
            for (int s = 0; s < 4; ++s) {
                const f32x4 a0 = *(const f32x4*)(ap + 16 * s), a1 = *(const f32x4*)(ap + 16 * s + 4), b0 = *(const f32x4*)(bp + 16 * s), b1 = *(const f32x4*)(bp + 16 * s + 4);
                const u32x4 aw = (u32x4){pk2(a0.x, a0.y), pk2(a0.z, a0.w), pk2(a1.x, a1.y), pk2(a1.z, a1.w)}, bw = (u32x4){pk2(b0.x, b0.y), pk2(b0.z, b0.w), pk2(b1.x, b1.y), pk2(b1.z, b1.w)};
                acc = __builtin_amdgcn_mfma_f32_32x32x16_bf16(__builtin_bit_cast(att::bf16x8, aw), __builtin_bit_cast(att::bf16x8, bw), acc, 0, 0, 0);
            }
            bf16* op = WSB(WS_WUQL) + (size_t)(h * 256 + ct * 32) * 256 + kt * 32 + r32;
#pragma unroll
            for (int r = 0; r < 16; ++r) op[(size_t)att::crow(r, hi) * 256] = (bf16)f2bf(acc[r]);
        }
    }
}
__device__ __forceinline__ void p_mla_mid(ArgsP a, const Ctx& c0) {
    const Ctx c = refresh(c0);
    const float* A1 = WSF(WS_A1); bf16* CQN = WSB(WS_CQN); bf16* CKVN = WSB(WS_CKVN); bf16* KPEB = WSB(WS_KPE); const float* ROPE = WSF(WS_ROPE); float* out = a->out;
    const f32x4 gq = *(const f32x4*)(IN_F(12) + 4 * c.lane), gk = *(const f32x4*)(IN_F(14) + 4 * c.lane);
    constexpr int NR = 4;
    for (int r0 = c.gw; r0 < R; r0 += NR * c.ngw) {
        f32x4 cq[NR], ck[NR]; float sq[NR], sk[NR], x1[NR], x2[NR], cs[NR], sn[NR];
#pragma unroll
        for (int q = 0; q < NR; ++q) { const int r = r0 + q * c.ngw < R ? r0 + q * c.ngw : r0; const float* row = A1 + (size_t)r * NIN0;
            cq[q] = *(const f32x4*)(row + 4 * c.lane); ck[q] = *(const f32x4*)(row + 256 + 4 * c.lane);
            const int j = c.lane & 15; x1[q] = row[512 + j]; x2[q] = row[528 + j]; cs[q] = ROPE[(size_t)r * 32 + j]; sn[q] = ROPE[(size_t)r * 32 + 16 + j];
            sq[q] = (cq[q].x * cq[q].x + cq[q].y * cq[q].y) + (cq[q].z * cq[q].z + cq[q].w * cq[q].w); sk[q] = (ck[q].x * ck[q].x + ck[q].y * ck[q].y) + (ck[q].z * ck[q].z + ck[q].w * ck[q].w); }
#pragma unroll
        for (int sh = 1; sh < 64; sh <<= 1) {
#pragma unroll
            for (int q = 0; q < NR; ++q) { sq[q] += __shfl_xor(sq[q], sh); sk[q] += __shfl_xor(sk[q], sh); } }
#pragma unroll
        for (int q = 0; q < NR; ++q) { const int r = r0 + q * c.ngw < R ? r0 + q * c.ngw : r0; const int pos = row_pos(r);
            const float rq = 1.0f / sqrtf(sq[q] * (1.f / 256) + EPS), rk = 1.0f / sqrtf(sk[q] * (1.f / 256) + EPS);
            const f32x4 qn = cq[q] * rq * gq, kn = ck[q] * rk * gk;
            u32x2 o; o.x = pk2(qn.x, qn.y); o.y = pk2(qn.z, qn.w); *(u32x2*)(CQN + (size_t)r * 256 + 4 * c.lane) = o;
            o.x = pk2(kn.x, kn.y); o.y = pk2(kn.z, kn.w); *(u32x2*)(CKVN + (size_t)r * 256 + 4 * c.lane) = o;
            float* ockv; float* okpe;
            if (r < RSAMP0) { const int b = r < RMAIN ? (r >> 12) : ((r - RMAIN) >> 4); ockv = out + O_CKVP + ((size_t)b * TP + pos) * 256; okpe = out + O_KPEP + ((size_t)b * TP + pos) * 32; }
            else { ockv = out + O_CKVS + (size_t)(r - RSAMP0) * 256; okpe = out + O_KPES + (size_t)(r - RSAMP0) * 32; }
            *(f32x4*)(ockv + 4 * c.lane) = kn;
            if (c.lane < 16) { const int j = c.lane; const float o1 = x1[q] * cs[q] - x2[q] * sn[q], o2 = x1[q] * sn[q] + x2[q] * cs[q]; okpe[j] = o1; okpe[16 + j] = o2;
                KPEB[(size_t)r * 32 + j] = (bf16)f2bf(o1); KPEB[(size_t)r * 32 + 16 + j] = (bf16)f2bf(o2); } }
    }
}
__device__ __forceinline__ void p_q_post(ArgsP a, const Ctx& c0) {
    const Ctx c = refresh(c0);
    for (int r = c.gw; r < R; r += c.ngw) {
        const float* row = WSF(WS_QRAW) + (size_t)r * NUQ; const int pos = row_pos(r);
        const float qs = QSCALE;
#pragma unroll
        for (int j = 0; j < 4; ++j) { const f32x4 v = *(const f32x4*)(row + 4 * c.lane + 256 * j) * qs; u32x2 o; o.x = pk2(v.x, v.y); o.y = pk2(v.z, v.w); *(u32x2*)(WSB(WS_QN) + (size_t)r * 1024 + 4 * c.lane + 256 * j) = o; }
#pragma unroll
        for (int j = 0; j < 4; ++j) { const int p = c.lane + 64 * j, h = p >> 4, jj = p & 15; const float x1 = row[1024 + 2 * p], x2 = row[1024 + 2 * p + 1]; float cs, sn; rope_cs(pos, jj, cs, sn);
            WSB(WS_QPE)[(size_t)r * 512 + h * 32 + jj] = (bf16)f2bf((x1 * cs - x2 * sn) * qs); WSB(WS_QPE)[(size_t)r * 512 + h * 32 + 16 + jj] = (bf16)f2bf((x1 * sn + x2 * cs) * qs); }
    }
}
__device__ __forceinline__ void p_qlat(ArgsP a, const Ctx& c0) {
    const Ctx c = refresh(c0);
    const float* wuk = IN_F(15);
    for (int it = c.gw; it < DB * DS * NH; it += c.ngw) {
        const int i = it >> 4, h = it & 15;
        const float q = WSF(WS_QRAW)[(size_t)(RSAMP0 + i) * NUQ + h * 64 + c.lane];
        float acc[4] = {0.f, 0.f, 0.f, 0.f};
#pragma unroll 8
        for (int n = 0; n < 64; ++n) { const float qn = __shfl(q, n);
#pragma unroll
            for (int k = 0; k < 4; ++k) acc[k] += qn * wuk[(size_t)(c.lane + 64 * k) * 1024 + h * 64 + n]; }
#pragma unroll
        for (int k = 0; k < 4; ++k) WSB(WS_QLAT)[((size_t)i * 16 + h) * 256 + c.lane + 64 * k] = (bf16)f2bf(acc[k] * QSCALE);
    }
}
template <bool META_ONLY>
__device__ __forceinline__ void p_attn_prompt_naive(ArgsP a, const Ctx& c0) {
    const Ctx c = refresh(c0);
    const bf16* QN = WSB(WS_QN); const bf16* QPE = WSB(WS_QPE); const bf16* KNV = WSB(WS_KNV); const bf16* KPE = WSB(WS_KPE);
    for (int item = c.gw + (META_ONLY ? (RMAIN / 64) * NH : 0); item < (RPROMPT / 64) * NH; item += c.ngw) {
        const int rb = item >> 4, h = item & 15, r = rb * 64 + c.lane;
        int b, nk;
        if (r < RMAIN) { b = r >> 12; nk = NMETA + (r & 4095) + 1; } else { const int i = r - RMAIN; b = i >> 4; nk = (i & 15) + 1; }
        const int mbase = RMAIN + 16 * b, tbase = 4096 * b;
        float qn[64], qp[32], o[64];
#pragma unroll
        for (int j = 0; j < 8; ++j) { const u32x4 v = *(const u32x4*)(QN + (size_t)r * 1024 + h * 64 + 8 * j);
            qn[8 * j] = bflo(v.x); qn[8 * j + 1] = bfhi(v.x); qn[8 * j + 2] = bflo(v.y); qn[8 * j + 3] = bfhi(v.y); qn[8 * j + 4] = bflo(v.z); qn[8 * j + 5] = bfhi(v.z); qn[8 * j + 6] = bflo(v.w); qn[8 * j + 7] = bfhi(v.w); }
#pragma unroll
        for (int j = 0; j < 4; ++j) { const u32x4 v = *(const u32x4*)(QPE + (size_t)r * 512 + h * 32 + 8 * j);
            qp[8 * j] = bflo(v.x); qp[8 * j + 1] = bfhi(v.x); qp[8 * j + 2] = bflo(v.y); qp[8 * j + 3] = bfhi(v.y); qp[8 * j + 4] = bflo(v.z); qp[8 * j + 5] = bfhi(v.z); qp[8 * j + 6] = bflo(v.w); qp[8 * j + 7] = bfhi(v.w); }
#pragma unroll
        for (int j = 0; j < 64; ++j) o[j] = 0.f;
        float m = -INFINITY, l = 0.f;
        const int nkmax = wave_max_i(nk);
        for (int kk = 0; kk < nkmax; ++kk) {
            if (kk < nk) {
                const int kr = kk < NMETA ? mbase + kk : tbase + kk - NMETA;
                const bf16* kn = KNV + (size_t)kr * 2048 + h * 64; const bf16* kp = KPE + (size_t)kr * 32; const bf16* vv = kn + 1024;
                float s = 0.f;
#pragma unroll
                for (int j = 0; j < 8; ++j) { const u32x4 v = *(const u32x4*)(kn + 8 * j);
                    s += qn[8 * j] * bflo(v.x) + qn[8 * j + 1] * bfhi(v.x) + qn[8 * j + 2] * bflo(v.y) + qn[8 * j + 3] * bfhi(v.y) + qn[8 * j + 4] * bflo(v.z) + qn[8 * j + 5] * bfhi(v.z) + qn[8 * j + 6] * bflo(v.w) + qn[8 * j + 7] * bfhi(v.w); }
#pragma unroll
                for (int j = 0; j < 4; ++j) { const u32x4 v = *(const u32x4*)(kp + 8 * j);
                    s += qp[8 * j] * bflo(v.x) + qp[8 * j + 1] * bfhi(v.x) + qp[8 * j + 2] * bflo(v.y) + qp[8 * j + 3] * bfhi(v.y) + qp[8 * j + 4] * bflo(v.z) + qp[8 * j + 5] * bfhi(v.z) + qp[8 * j + 6] * bflo(v.w) + qp[8 * j + 7] * bfhi(v.w); }
                const float mn = fmaxf(m, s), corr = exp2f(m - mn), p = exp2f(s - mn);
                l = l * corr + p; m = mn;
#pragma unroll
                for (int j = 0; j < 8; ++j) { const u32x4 v = *(const u32x4*)(vv + 8 * j);
                    o[8 * j] = o[8 * j] * corr + p * bflo(v.x); o[8 * j + 1] = o[8 * j + 1] * corr + p * bfhi(v.x); o[8 * j + 2] = o[8 * j + 2] * corr + p * bflo(v.y); o[8 * j + 3] = o[8 * j + 3] * corr + p * bfhi(v.y);
                    o[8 * j + 4] = o[8 * j + 4] * corr + p * bflo(v.z); o[8 * j + 5] = o[8 * j + 5] * corr + p * bfhi(v.z); o[8 * j + 6] = o[8 * j + 6] * corr + p * bflo(v.w); o[8 * j + 7] = o[8 * j + 7] * corr + p * bfhi(v.w); }
            }
        }
        const float il = 1.0f / l;
#pragma unroll
        for (int j = 0; j < 8; ++j) { u32x4 w; w.x = pk2(o[8 * j] * il, o[8 * j + 1] * il); w.y = pk2(o[8 * j + 2] * il, o[8 * j + 3] * il); w.z = pk2(o[8 * j + 4] * il, o[8 * j + 5] * il); w.w = pk2(o[8 * j + 6] * il, o[8 * j + 7] * il);
            *(u32x4*)(WSB(WS_O) + (size_t)r * 1024 + h * 64 + 8 * j) = w; }
    }
}
__device__ __forceinline__ void p_attn_decode_naive(ArgsP a, const Ctx& c0) {
    const Ctx c = refresh(c0);
    const float* cckv = IN_F(2); const float* ckpe = IN_F(3); const int* pt = (const int*)a->in[5];
    for (int item = c.gw; item < DB * NH; item += c.ngw) {
        const int db = item >> 4, h = item & 15;
        f32x4 ql[4]; float qp[4], m[4], l[4]; f32x4 o[4];
#pragma unroll
        for (int t = 0; t < 4; ++t) { const u32x2 v = *(const u32x2*)(WSB(WS_QLAT) + ((size_t)(db * 4 + t) * 16 + h) * 256 + 4 * c.lane);
            ql[t] = (f32x4){bflo(v.x), bfhi(v.x), bflo(v.y), bfhi(v.y)};
            qp[t] = c.lane < 32 ? bf2f(WSB(WS_QPE)[(size_t)(RSAMP0 + db * 4 + t) * 512 + h * 32 + c.lane]) : 0.f;
            m[t] = -INFINITY; l[t] = 0.f; o[t] = (f32x4){0.f, 0.f, 0.f, 0.f}; }
        for (int p = 0; p < NPAGES; ++p) {
            const int page = pt[db * NPAGES + p];
            for (int k = 0; k < PAGE; ++k) {
                const size_t kr = (size_t)page * PAGE + k;
                const f32x4 cv = *(const f32x4*)(cckv + kr * 256 + 4 * c.lane); const float e = c.lane < 32 ? ckpe[kr * 32 + c.lane] : 0.f;
#pragma unroll
                for (int t = 0; t < 4; ++t) {
                    float d = (ql[t].x * cv.x + ql[t].y * cv.y) + (ql[t].z * cv.z + ql[t].w * cv.w) + qp[t] * e;
                    d = wave_sum(d);
                    const float mn = fmaxf(m[t], d), corr = exp2f(m[t] - mn), pp = exp2f(d - mn);
                    l[t] = l[t] * corr + pp; m[t] = mn; o[t] = o[t] * corr + pp * cv;
                }
            }
        }
#pragma unroll
        for (int s2 = 0; s2 < 4; ++s2) {
            const int kr = RSAMP0 + db * 4 + s2;
            const u32x2 v = *(const u32x2*)(WSB(WS_CKVN) + (size_t)kr * 256 + 4 * c.lane); const f32x4 cv = (f32x4){bflo(v.x), bfhi(v.x), bflo(v.y), bfhi(v.y)};
            const float e = c.lane < 32 ? bf2f(WSB(WS_KPE)[(size_t)kr * 32 + c.lane]) : 0.f;
#pragma unroll
            for (int t = 0; t < 4; ++t) if (t >= s2) {
                float d = (ql[t].x * cv.x + ql[t].y * cv.y) + (ql[t].z * cv.z + ql[t].w * cv.w) + qp[t] * e;
                d = wave_sum(d);
                const float mn = fmaxf(m[t], d), corr = exp2f(m[t] - mn), pp = exp2f(d - mn);
                l[t] = l[t] * corr + pp; m[t] = mn; o[t] = o[t] * corr + pp * cv;
            }
        }
#pragma unroll
        for (int t = 0; t < 4; ++t) *(f32x4*)(WSF(WS_OLAT) + ((size_t)(db * 4 + t) * 16 + h) * 256 + 4 * c.lane) = o[t] * (1.0f / l[t]);
    }
}
__device__ __forceinline__ void p_olat_up(ArgsP a, const Ctx& c0) {
    const Ctx c = refresh(c0);
    const float* wuv = IN_F(16);
    for (int it = c.gw; it < DB * DS * NH; it += c.ngw) {
        const int i = it >> 4, h = it & 15; const float* ol = WSF(WS_OLAT) + ((size_t)i * 16 + h) * 256;
        float acc = 0.f;
#pragma unroll 8
        for (int cc = 0; cc < 256; ++cc) acc += ol[cc] * wuv[(size_t)cc * 1024 + h * 64 + c.lane];
        WSB(WS_O)[(size_t)(RSAMP0 + i) * 1024 + h * 64 + c.lane] = (bf16)f2bf(acc);
    }
}
template <bool FINAL, int NSPLIT, bool FIRST = false>
__device__ __forceinline__ void p_post_res(ArgsP a, const Ctx& c0, const float* gpost, const float* gnext) {
    const Ctx c = refresh(c0);
    const bf16* Mb = WSB(WS_M); bf16* X = WSB(WS_X); bf16* H = WSB(WS_H); const float* MT = WSF(WS_MT); const float* xin = IN_F(0); float* out = a->out;
    f32x4 gp[4], gn[4];
#pragma unroll
    for (int j = 0; j < 4; ++j) { gp[j] = *(const f32x4*)(gpost + 4 * c.lane + 256 * j); gn[j] = FINAL ? gp[j] : *(const f32x4*)(gnext + 4 * c.lane + 256 * j); }
    constexpr int NR = 4;
    for (int r0 = c.gw; r0 < RMAIN; r0 += NR * c.ngw) {
        f32x4 mv[NR][4], xv[NR][4]; float s[NR], s2[NR];
#pragma unroll
        for (int q = 0; q < NR; ++q) { const int r = r0 + q * c.ngw < RMAIN ? r0 + q * c.ngw : r0;
            s[q] = 0.f;
#pragma unroll
            for (int j = 0; j < 4; ++j) { const u32x2 mb = *(const u32x2*)(Mb + (size_t)r * D + 4 * c.lane + 256 * j); mv[q][j] = (f32x4){bflo(mb.x), bfhi(mb.x), bflo(mb.y), bfhi(mb.y)};
                if (FIRST) xv[q][j] = *(const f32x4*)(xin + (size_t)r * D + 4 * c.lane + 256 * j); else { const u32x2 xb = *(const u32x2*)(X + (size_t)r * D + 4 * c.lane + 256 * j); xv[q][j] = (f32x4){bflo(xb.x), bfhi(xb.x), bflo(xb.y), bfhi(xb.y)}; }
                s[q] += (mv[q][j].x * mv[q][j].x + mv[q][j].y * mv[q][j].y) + (mv[q][j].z * mv[q][j].z + mv[q][j].w * mv[q][j].w); } }
#pragma unroll
        for (int o = 1; o < 64; o <<= 1) {
#pragma unroll
            for (int q = 0; q < NR; ++q) s[q] += __shfl_xor(s[q], o); }
#pragma unroll
        for (int q = 0; q < NR; ++q) { const float rm = 1.0f / sqrtf(s[q] * (1.f / D) + EPS); s2[q] = 0.f;
#pragma unroll
            for (int j = 0; j < 4; ++j) { xv[q][j] = xv[q][j] + mv[q][j] * rm * gp[j]; s2[q] += (xv[q][j].x * xv[q][j].x + xv[q][j].y * xv[q][j].y) + (xv[q][j].z * xv[q][j].z + xv[q][j].w * xv[q][j].w); } }
        if (!FINAL) {
#pragma unroll
            for (int o = 1; o < 64; o <<= 1) {
#pragma unroll
                for (int q = 0; q < NR; ++q) s2[q] += __shfl_xor(s2[q], o); }
        }
#pragma unroll
        for (int q = 0; q < NR; ++q) { const int r = r0 + q * c.ngw < RMAIN ? r0 + q * c.ngw : r0;
            if (FINAL) {
#pragma unroll
                for (int j = 0; j < 4; ++j) *(f32x4*)(out + O_YP + (size_t)r * D + 4 * c.lane + 256 * j) = xv[q][j];
            } else { const float rx = 1.0f / sqrtf(s2[q] * (1.f / D) + EPS);
#pragma unroll
                for (int j = 0; j < 4; ++j) { u32x2 xo; xo.x = pk2(xv[q][j].x, xv[q][j].y); xo.y = pk2(xv[q][j].z, xv[q][j].w); *(u32x2*)(X + (size_t)r * D + 4 * c.lane + 256 * j) = xo;
                    u32x2 o; o.x = pk2(xv[q][j].x * rx * gn[j].x, xv[q][j].y * rx * gn[j].y); o.y = pk2(xv[q][j].z * rx * gn[j].z, xv[q][j].w * rx * gn[j].w); *(u32x2*)(H + (size_t)r * D + 4 * c.lane + 256 * j) = o; } } }
    }
    for (int r = RMAIN + c.gw; r < R; r += c.ngw) {
        bf16* xrow = X + (size_t)r * D;
        f32x4 mv[4], xv[4]; float s = 0.f;
#pragma unroll
        for (int j = 0; j < 4; ++j) { mv[j] = (f32x4){0.f, 0.f, 0.f, 0.f};
#pragma unroll
            for (int h8 = 0; h8 < NSPLIT; h8 += 8) { f32x4 part[8];
#pragma unroll
                for (int sp = 0; sp < 8; ++sp) part[sp] = *(const f32x4*)(MT + ((size_t)(h8 + sp) * (RP - RMAIN) + (r - RMAIN)) * D + 4 * c.lane + 256 * j);
#pragma unroll
                for (int sp = 0; sp < 8; ++sp) mv[j] += part[sp]; }
            { const u32x2 xb = *(const u32x2*)(xrow + 4 * c.lane + 256 * j); xv[j] = (f32x4){bflo(xb.x), bfhi(xb.x), bflo(xb.y), bfhi(xb.y)}; } s += (mv[j].x * mv[j].x + mv[j].y * mv[j].y) + (mv[j].z * mv[j].z + mv[j].w * mv[j].w); }
        const float rm = 1.0f / sqrtf(wave_sum(s) * (1.f / D) + EPS); float s2 = 0.f;
#pragma unroll
        for (int j = 0; j < 4; ++j) { xv[j] = xv[j] + mv[j] * rm * gp[j]; s2 += (xv[j].x * xv[j].x + xv[j].y * xv[j].y) + (xv[j].z * xv[j].z + xv[j].w * xv[j].w); }
        if (FINAL) {
            if (r < RSAMP0) continue;
#pragma unroll
            for (int j = 0; j < 4; ++j) *(f32x4*)(out + O_YS + (size_t)(r - RSAMP0) * D + 4 * c.lane + 256 * j) = xv[j];
        } else {
            const float rx = 1.0f / sqrtf(wave_sum(s2) * (1.f / D) + EPS);
#pragma unroll
            for (int j = 0; j < 4; ++j) { u32x2 xo; xo.x = pk2(xv[j].x, xv[j].y); xo.y = pk2(xv[j].z, xv[j].w); *(u32x2*)(xrow + 4 * c.lane + 256 * j) = xo;
                u32x2 o; o.x = pk2(xv[j].x * rx * gn[j].x, xv[j].y * rx * gn[j].y); o.y = pk2(xv[j].z * rx * gn[j].z, xv[j].w * rx * gn[j].w); *(u32x2*)(H + (size_t)r * D + 4 * c.lane + 256 * j) = o; }
        }
    }
}

__device__ __forceinline__ void p_gate(ArgsP a, const Ctx& c0) {
    const Ctx c = refresh(c0);
    const float* wg = IN_F(19); const float* bg = IN_F(20);
    const size_t gt = (size_t)c.gw * 64 + c.lane, ngt = (size_t)c.ngw * 64;
    for (size_t i = gt + (size_t)(USE_NAIVE_GLA ? 0 : RSAMP0) * 512; i < (size_t)R * 512; i += ngt) {
        const int r = (int)(i >> 9), col = (int)(i & 511); const float* gd = WSF(WS_GD) + (size_t)r * 16;
        float x = bg[col];
#pragma unroll
        for (int j = 0; j < 16; ++j) x += gd[j] * wg[j * 512 + col];
        const float ls = fminf(x, 0.f) - log1pf(__expf(-fabsf(x)));
        const float la = ls * (1.0f / 16.0f);
        WSF(WS_LA)[i] = la; WSF(WS_EA)[i] = __expf(la);
    }
}
__device__ __forceinline__ void gla_step(float (&S)[128], float& o, float a0, float a1, float k0, float k1, float q0, float q1, float v) {
    o = 0.f;
#pragma unroll
    for (int d = 0; d < 64; ++d) { const float ad = rdlane(a0, d), kd = rdlane(k0, d), qd = rdlane(q0, d); S[d] = ad * S[d] + kd * v; o += qd * S[d]; }
#pragma unroll
    for (int d = 0; d < 64; ++d) { const float ad = rdlane(a1, d), kd = rdlane(k1, d), qd = rdlane(q1, d); S[64 + d] = ad * S[64 + d] + kd * v; o += qd * S[64 + d]; }
}
__device__ __forceinline__ void p_gla_naive(ArgsP a, const Ctx& c0) {
    const Ctx c = refresh(c0);
    const float* EA = WSF(WS_EA); const bf16* KG = WSB(WS_KG); const bf16* QG = WSB(WS_QG); const bf16* VG = WSB(WS_VG); float* OGR = WSF(WS_OGRAW);
    for (int item = c.gwT; item < (USE_NAIVE_GLA ? NB * GH * 4 : 0); item += c.ngw) {
        const int b = item >> 4, h = (item >> 2) & 3, dv = (item & 3) * 64 + c.lane;
        float S[128];
#pragma unroll
        for (int d = 0; d < 128; ++d) S[d] = 0.f;
        for (int tt = 0; tt < TP; ++tt) {
            const int row = tt < NMETA ? RMAIN + 16 * b + tt : 4096 * b + tt - NMETA;
            const size_t g = (size_t)row * 512 + h * 128;
            const float a0 = EA[g + c.lane], a1 = EA[g + 64 + c.lane], k0 = bf2f(KG[g + c.lane]), k1 = bf2f(KG[g + 64 + c.lane]), q0 = bf2f(QG[g + c.lane]), q1 = bf2f(QG[g + 64 + c.lane]);
            const float v = bf2f(VG[(size_t)row * 1024 + h * 256 + dv]);
            float o; gla_step(S, o, a0, a1, k0, k1, q0, q1, v);
            OGR[(size_t)row * 1024 + h * 256 + dv] = o;
        }
        float* outp = a->out + O_GLAP + ((size_t)(b * 4 + h) * 128) * 256 + dv;
#pragma unroll
        for (int d = 0; d < 128; ++d) outp[(size_t)d * 256] = S[d];
    }
    const int wg0 = USE_NAIVE_GLA ? 0 : NB * GH * gla::NSP; if ((int)blockIdx.x < wg0) return;
    for (int item = c.wave * ((int)gridDim.x - wg0) + ((int)blockIdx.x - wg0); item < DB * GH * 4; item += c.ngw - wg0 * 8) {
        const int db = item >> 4, h = (item >> 2) & 3, dv = (item & 3) * 64 + c.lane;
        const float* sp = IN_F(4) + ((size_t)(db * 4 + h) * 128) * 256 + dv;
        float S[128];
#pragma unroll
        for (int d = 0; d < 128; ++d) S[d] = sp[(size_t)d * 256];
#pragma unroll 1
        for (int s = 0; s < DS; ++s) {
            const int row = RSAMP0 + db * 4 + s; const size_t g = (size_t)row * 512 + h * 128;
            const float a0 = EA[g + c.lane], a1 = EA[g + 64 + c.lane], k0 = bf2f(KG[g + c.lane]), k1 = bf2f(KG[g + 64 + c.lane]), q0 = bf2f(QG[g + c.lane]), q1 = bf2f(QG[g + 64 + c.lane]);
            const float v = bf2f(VG[(size_t)row * 1024 + h * 256 + dv]);
            float o; gla_step(S, o, a0, a1, k0, k1, q0, q1, v);
            OGR[(size_t)row * 1024 + h * 256 + dv] = o;
        }
        float* outp = a->out + O_GLAS + ((size_t)(db * 4 + h) * 128) * 256 + dv;
#pragma unroll
        for (int d = 0; d < 128; ++d) outp[(size_t)d * 256] = S[d];
    }
}
__device__ __forceinline__ void p_gla_post(ArgsP a, const Ctx& c0) {
    const Ctx c = refresh(c0);
    const bf16* OGR = WSB(WS_OGRAW); const bf16* RG = WSB(WS_RG); bf16* OG = WSB(WS_OG);
    const f32x4 g = *(const f32x4*)(IN_F(21) + 4 * c.lane);
    constexpr int NR = 2;
    for (int r0 = c.gw; r0 < R; r0 += NR * c.ngw) {
        f32x4 o[NR][4]; u32x2 rv[NR][4]; float s[NR][4];
#pragma unroll
        for (int q = 0; q < NR; ++q) { const int r = r0 + q * c.ngw < R ? r0 + q * c.ngw : r0;
#pragma unroll
            for (int h = 0; h < 4; ++h) { const size_t off = (size_t)r * 1024 + h * 256 + 4 * c.lane;
                const u32x2 ob = *(const u32x2*)(OGR + ((size_t)(h * 8 + (c.lane >> 3)) * RP + r) * 32 + 4 * (c.lane & 7)); o[q][h] = (f32x4){bflo(ob.x), bfhi(ob.x), bflo(ob.y), bfhi(ob.y)}; rv[q][h] = *(const u32x2*)(RG + off);
                s[q][h] = (o[q][h].x * o[q][h].x + o[q][h].y * o[q][h].y) + (o[q][h].z * o[q][h].z + o[q][h].w * o[q][h].w); } }
#pragma unroll
        for (int sh = 1; sh < 64; sh <<= 1) {
#pragma unroll
            for (int q = 0; q < NR; ++q)
#pragma unroll
                for (int h = 0; h < 4; ++h) s[q][h] += __shfl_xor(s[q][h], sh); }
#pragma unroll
        for (int q = 0; q < NR; ++q) { const int r = r0 + q * c.ngw < R ? r0 + q * c.ngw : r0;
#pragma unroll
            for (int h = 0; h < 4; ++h) { const size_t off = (size_t)r * 1024 + h * 256 + 4 * c.lane;
                const float rs = 1.0f / sqrtf(s[q][h] * (1.f / 256) + EPS);
                const f32x4 rr = (f32x4){bflo(rv[q][h].x), bfhi(rv[q][h].x), bflo(rv[q][h].y), bfhi(rv[q][h].y)};
                f32x4 sl; sl.x = rr.x / (1.f + __expf(-rr.x)); sl.y = rr.y / (1.f + __expf(-rr.y)); sl.z = rr.z / (1.f + __expf(-rr.z)); sl.w = rr.w / (1.f + __expf(-rr.w));
                const f32x4 y = o[q][h] * rs * g * sl;
                u32x2 w; w.x = pk2(y.x, y.y); w.y = pk2(y.z, y.w); *(u32x2*)(OG + off) = w; } }
    }
}


namespace gla {
using att::bf16x8; using att::f32x16; using att::crow; using att::cvtpk;
constexpr int NCH = 65, NITEM = NB * GH * NCH;
constexpr int P_GD = 0, P_GSUM = 4096, P_QL = 6144, P_KL = P_QL + 64 * 272, P_VS = P_KL + 64 * 272, P_AL = P_VS + 64 * 528, P_END = P_AL + 64 * 144;
__device__ __forceinline__ int chunk_row(int b, int c, int tok) { return c == 0 ? RMAIN + 16 * b + tok : 4096 * b + 64 * (c - 1) + tok; }
__device__ __forceinline__ float logsig16(float x) { return (fminf(x, 0.f) - __logf(1.0f + __expf(-fabsf(x)))) * (1.0f / 16.0f); }
__device__ __forceinline__ void prep_item(ArgsP a, int item, LAS unsigned char* lds, int wave_id) {
    const int tid = fresh_tid(wave_id), lane = tid & 63, r32 = lane & 31, hi = lane >> 5; const int wid = wave_id;
    const int bh = item / NCH, c = item % NCH, b = bh >> 2, h = bh & 3;
    const int nvalid = c == 0 ? NMETA : 64;
    bf16* QINF = WSB(WS_QINF) + (size_t)item * 8192; bf16* KDTF = WSB(WS_KDTF) + (size_t)item * 8192; bf16* AMF = WSB(WS_AMF) + (size_t)item * 4096; bf16* VTF = WSB(WS_VTF) + (size_t)item * 16384; float* ELF = WSF(WS_ELF) + (size_t)item * 256;
    LAS float* GDL = (LAS float*)(lds + P_GD); LAS float* GSUM = (LAS float*)(lds + P_GSUM); LAS bf16* QL = (LAS bf16*)(lds + P_QL); LAS bf16* KL = (LAS bf16*)(lds + P_KL); LAS bf16* VS = (LAS bf16*)(lds + P_VS); LAS bf16* AL = (LAS bf16*)(lds + P_AL);
    const u32x4 z4 = (u32x4){0u, 0u, 0u, 0u};
#pragma unroll
    for (int j = 0; j < 2; ++j) { const int idx = tid + 512 * j, row = idx >> 4, ch = idx & 15; const bool ok = row < nvalid; const size_t g = (size_t)chunk_row(b, c, ok ? row : 0) * 512 + h * 128 + ch * 8;
        *(LAS u32x4*)(QL + row * 136 + ch * 8) = ok ? *(const u32x4*)(WSB(WS_QG) + g) : z4; *(LAS u32x4*)(KL + row * 136 + ch * 8) = ok ? *(const u32x4*)(WSB(WS_KG) + g) : z4; }
#pragma unroll
    for (int j = 0; j < 4; ++j) { const int idx = tid + 512 * j, row = idx >> 5, ch = idx & 31; const bool ok = row < nvalid;
        *(LAS u32x4*)(VS + row * 264 + ch * 8) = ok ? *(const u32x4*)(WSB(WS_VG) + (size_t)chunk_row(b, c, ok ? row : 0) * 1024 + h * 256 + ch * 8) : z4; }
    if (tid < 256) { const int row = tid >> 2, ch = tid & 3; const bool ok = row < nvalid; *(LAS f32x4*)(GDL + row * 16 + ch * 4) = ok ? *(const f32x4*)(WSF(WS_GD) + (size_t)chunk_row(b, c, ok ? row : 0) * 16 + ch * 4) : (f32x4){0.f, 0.f, 0.f, 0.f}; }
    __syncthreads();
    const int dk = tid & 127, tg = tid >> 7;
    float bloc[16];
    {
        float w[16]; const float* wg = IN_F(19) + h * 128 + dk;
#pragma unroll
        for (int j = 0; j < 16; ++j) w[j] = wg[j * 512];
        const float bg = IN_F(20)[h * 128 + dk];
        float run = 0.f;
#pragma unroll
        for (int i = 0; i < 16; ++i) {
            const int tok = tg * 16 + i; float x = bg;
#pragma unroll
            for (int j4 = 0; j4 < 4; ++j4) { const f32x4 gd = *(const LAS f32x4*)(GDL + tok * 16 + j4 * 4); x += gd.x * w[4 * j4] + gd.y * w[4 * j4 + 1] + gd.z * w[4 * j4 + 2] + gd.w * w[4 * j4 + 3]; }
            const float g = tok < nvalid ? logsig16(x) : 0.f;
            run += g; bloc[i] = run;
        }
        GSUM[tg * 128 + dk] = run;
    }
    __syncthreads();
    float off = 0.f, blast = 0.f;
#pragma unroll
    for (int t = 0; t < 4; ++t) { const float s = GSUM[t * 128 + dk]; if (t < tg) off += s; blast += s; }
    {
        unsigned kdp[8];
#pragma unroll
        for (int i = 0; i < 16; i += 2) {
            float kd2[2];
#pragma unroll
            for (int e = 0; e < 2; ++e) {
                const int tok = tg * 16 + i + e; const float bb = bloc[i + e] + off; const float q = bf2f(QL[tok * 136 + dk]), k = bf2f(KL[tok * 136 + dk]);
                QL[tok * 136 + dk] = (bf16)f2bf(q * __expf(bb)); KL[tok * 136 + dk] = (bf16)f2bf(k * __expf(-bb)); kd2[e] = k * __expf(blast - bb);
            }
            kdp[i >> 1] = pk2(kd2[0], kd2[1]);
        }
        bf16* kp = KDTF + ((size_t)(((dk >> 5) * 4 + tg) * 64) + (dk & 31)) * 8;
        *(u32x4*)(kp) = (u32x4){kdp[0], kdp[1], kdp[2], kdp[3]}; *(u32x4*)(kp + 32 * 8) = (u32x4){kdp[4], kdp[5], kdp[6], kdp[7]};
        if (tg == 0) ELF[dk] = __expf(blast);
    }
    {
        const int dv = tid & 255, half = tid >> 8;
#pragma unroll
        for (int u = 0; u < 4; ++u) {
            unsigned pk[4];
#pragma unroll
            for (int e = 0; e < 4; ++e) { const int tok = half * 32 + u * 8 + e * 2; pk[e] = (unsigned)VS[tok * 264 + dv] | ((unsigned)VS[(tok + 1) * 264 + dv] << 16); }
            const int s = 2 * half + (u >> 1), uh = u & 1;
            *(u32x4*)(VTF + ((size_t)(((dv >> 5) * 4 + s) * 64) + uh * 32 + (dv & 31)) * 8) = (u32x4){pk[0], pk[1], pk[2], pk[3]};
        }
    }
    __syncthreads();
#pragma unroll
    for (int uu = 0; uu < 2; ++uu) {
        const int U = tid + 512 * uu, lp = U & 63, s8 = (U >> 6) & 7, tt = U >> 9; const int tok = tt * 32 + (lp & 31), hh = lp >> 5;
        const u32x2 lo = *(const LAS u32x2*)(QL + tok * 136 + 16 * s8 + 4 * hh), hi2 = *(const LAS u32x2*)(QL + tok * 136 + 16 * s8 + 8 + 4 * hh);
        *(u32x4*)(QINF + (size_t)U * 8) = (u32x4){lo.x, lo.y, hi2.x, hi2.y};
    }
    if (wid < 3) {
        const int tt = wid == 0 ? 0 : 1, tp = wid == 2 ? 1 : 0;
        f32x16 acc = f32x16{};
#pragma unroll
        for (int s = 0; s < 8; ++s) {
            const bf16x8 af = *(const LAS bf16x8*)(QL + (tt * 32 + r32) * 136 + 16 * s + 8 * hi), bfr = *(const LAS bf16x8*)(KL + (tp * 32 + r32) * 136 + 16 * s + 8 * hi);
            acc = __builtin_amdgcn_mfma_f32_32x32x16_bf16(af, bfr, acc, 0, 0, 0);
        }
#pragma unroll
        for (int r = 0; r < 16; ++r) { const int tok = tt * 32 + crow(r, hi), tk = tp * 32 + r32; AL[tok * 72 + tk] = (bf16)f2bf(tk <= tok ? acc[r] : 0.f); }
    } else if (wid == 3) {
#pragma unroll
        for (int r = 0; r < 16; ++r) AL[crow(r, hi) * 72 + 32 + r32] = 0;
    }
    __syncthreads();
    { const int U = tid, lp = U & 63, s = (U >> 6) & 3, tt = U >> 8; const int tok = tt * 32 + (lp & 31), hh = lp >> 5;
      *(u32x4*)(AMF + (size_t)U * 8) = *(const LAS u32x4*)(AL + tok * 72 + 16 * s + 8 * hh); }
    __syncthreads();
}
constexpr int SM_A = 0, SM_K = 2048, SM_Q = 4096, SM_V = 6144, SM_O = 10240, SM_END = SM_O + 4 * 2 * 256 * 4;
__device__ __forceinline__ void sample_item(ArgsP a, int item, LAS unsigned char* lds, int wave_id) {
    const int tid = fresh_tid(wave_id);
    const int db = item >> 2, h = item & 3;
    LAS float* AS = (LAS float*)(lds + SM_A); LAS float* KS = (LAS float*)(lds + SM_K); LAS float* QS = (LAS float*)(lds + SM_Q); LAS float* VSm = (LAS float*)(lds + SM_V); LAS float* OS = (LAS float*)(lds + SM_O);
    { const int s = tid >> 7, dk = tid & 127, row = RSAMP0 + db * 4 + s; const float* gd = WSF(WS_GD) + (size_t)row * 16; const float* wg = IN_F(19) + h * 128 + dk;
      float x = IN_F(20)[h * 128 + dk];
#pragma unroll
      for (int j = 0; j < 16; ++j) x += gd[j] * wg[j * 512];
      AS[s * 128 + dk] = __expf(logsig16(x));
      const size_t g = (size_t)row * 512 + h * 128 + dk; KS[s * 128 + dk] = bf2f(WSB(WS_KG)[g]); QS[s * 128 + dk] = bf2f(WSB(WS_QG)[g]);
#pragma unroll
      for (int j = 0; j < 2; ++j) { const int e = tid + 512 * j, s2 = e >> 8, dv2 = e & 255; VSm[s2 * 256 + dv2] = bf2f(WSB(WS_VG)[(size_t)(RSAMP0 + db * 4 + s2) * 1024 + h * 256 + dv2]); } }
    const int dv = tid & 255, kh = tid >> 8;
    const unsigned voff = (unsigned)(kh * 64 * 256 + dv) * 4u;
    const unsigned char* sbase = (const unsigned char*)(IN_F(4) + (size_t)(db * 4 + h) * 128 * 256);
    __syncthreads();
    float S[64];
#pragma unroll
    for (int d4 = 0; d4 < 16; ++d4) { const GAS unsigned char* bp = (const GAS unsigned char*)sbase + d4 * 4096; asm volatile("" : "+s"(bp));
#pragma unroll
        for (int e = 0; e < 4; ++e) S[4 * d4 + e] = *(const GAS float*)(bp + e * 1024 + voff); }
#pragma unroll 1
    for (int s = 0; s < 4; ++s) {
        const float v = VSm[s * 256 + dv]; float o = 0.f;
#pragma unroll
        for (int d4 = 0; d4 < 16; ++d4) {
            if ((d4 & 3) == 0) __builtin_amdgcn_sched_barrier(0);
            const f32x4 av = *(const LAS f32x4*)(AS + s * 128 + kh * 64 + 4 * d4), kv = *(const LAS f32x4*)(KS + s * 128 + kh * 64 + 4 * d4), qv = *(const LAS f32x4*)(QS + s * 128 + kh * 64 + 4 * d4);
            S[4 * d4] = av.x * S[4 * d4] + kv.x * v; o += qv.x * S[4 * d4]; S[4 * d4 + 1] = av.y * S[4 * d4 + 1] + kv.y * v; o += qv.y * S[4 * d4 + 1];
            S[4 * d4 + 2] = av.z * S[4 * d4 + 2] + kv.z * v; o += qv.z * S[4 * d4 + 2]; S[4 * d4 + 3] = av.w * S[4 * d4 + 3] + kv.w * v; o += qv.w * S[4 * d4 + 3];
        }
        OS[(s * 2 + kh) * 256 + dv] = o;
    }
    unsigned char* obase = (unsigned char*)(a->out + O_GLAS + (size_t)(db * 4 + h) * 128 * 256);
#pragma unroll
    for (int d4 = 0; d4 < 16; ++d4) { GAS unsigned char* bp = (GAS unsigned char*)obase + d4 * 4096; asm volatile("" : "+s"(bp));
#pragma unroll
        for (int e = 0; e < 4; ++e) *(GAS float*)(bp + e * 1024 + voff) = S[4 * d4 + e]; }
    __syncthreads();
#pragma unroll
    for (int j = 0; j < 2; ++j) { const int e = tid + 512 * j, s2 = e >> 8, dv2 = e & 255; WSB(WS_OGRAW)[((size_t)(h * 8 + (dv2 >> 5)) * RP + (RSAMP0 + db * 4 + s2)) * 32 + (dv2 & 31)] = (bf16)f2bf(OS[(s2 * 2) * 256 + dv2] + OS[(s2 * 2 + 1) * 256 + dv2]); }
    __syncthreads();
}
__device__ __forceinline__ void prep_phase(ArgsP a, LAS unsigned char* lds, int wave_id) {
    for (int item = blockIdx.x; item < NITEM; item += gridDim.x) prep_item(a, item, lds, wave_id);
}
constexpr int S_QIN = 0, S_KDT = 16384, S_AM = 32768, S_EL = 40960, S_VT = 41984, S_SLOT = S_VT + NCW * 4096;
static_assert(3 * S_SLOT <= MISC_OFF, "scan ring fits under the control words");
constexpr int NPIECE = 41 + NCW * 4, NDMA = (NPIECE + (8 - NCW) - 1) / (8 - NCW);
__device__ __forceinline__ void scan_bh(ArgsP a, int bh, int part, LAS unsigned char* lds, int wave_id) {
    const int tid = fresh_tid(wave_id), lane = tid & 63, r32 = lane & 31, hi = lane >> 5; const int wid = wave_id;
    const int b = bh >> 2, h = bh & 3; const bool cw = wid < NCW; const int ds = part * NCW + (cw ? wid : 0);
    const unsigned char* const pq = (const unsigned char*)(WSB(WS_QINF) + (size_t)bh * NCH * 8192); const unsigned char* const pk = (const unsigned char*)(WSB(WS_KDTF) + (size_t)bh * NCH * 8192);
    const unsigned char* const pa = (const unsigned char*)(WSB(WS_AMF) + (size_t)bh * NCH * 4096); const unsigned char* const pe = (const unsigned char*)(WSF(WS_ELF) + (size_t)bh * NCH * 256);
    const unsigned char* const pv = (const unsigned char*)(WSB(WS_VTF) + (size_t)bh * NCH * 16384) + part * NCW * 4096;
    bf16* const ogbase = WSB(WS_OGRAW) + (size_t)(h * 8 + ds) * RP * 32 + r32;
#define GLA_DMA(c_, slot_) do { const size_t c64_ = (size_t)(c_); \
        _Pragma("unroll") for (int k_ = 0; k_ < NDMA; ++k_) { int i_ = (wid - NCW) + (8 - NCW) * k_; i_ = i_ < NPIECE ? i_ : 40; const unsigned char* g_; int lo_; \
            if (i_ < 16) { g_ = pq + c64_ * 16384 + i_ * 1024; lo_ = S_QIN + i_ * 1024; } \
            else if (i_ < 32) { g_ = pk + c64_ * 16384 + (i_ - 16) * 1024; lo_ = S_KDT + (i_ - 16) * 1024; } \
            else if (i_ < 40) { g_ = pa + c64_ * 8192 + (i_ - 32) * 1024; lo_ = S_AM + (i_ - 32) * 1024; } \
            else if (i_ == 40) { g_ = pe + c64_ * 1024; lo_ = S_EL; } \
            else { g_ = pv + c64_ * 32768 + (i_ - 41) * 1024; lo_ = S_VT + (i_ - 41) * 1024; } \
            __builtin_amdgcn_global_load_lds((const unsigned*)(g_ + lane * 16), (LAS unsigned*)(lds + (slot_) * S_SLOT + lo_), 16, 0, 0); } } while (0)
    f32x16 S[4]; S[0] = f32x16{}; S[1] = f32x16{}; S[2] = f32x16{}; S[3] = f32x16{};
    if (!cw) { GLA_DMA(0, 0); GLA_DMA(1, 1); }
    int slot = 0;
    for (int c = 0; c < NCH; ++c) {
        if (!cw) { if (c + 1 < NCH) asm volatile("s_waitcnt vmcnt(%0)" :: "n"(NDMA) : "memory"); else asm volatile("s_waitcnt vmcnt(0)" ::: "memory"); }
        asm volatile("s_waitcnt lgkmcnt(0)\n\ts_barrier" ::: "memory");
        const LAS unsigned char* sb = lds + slot * S_SLOT; const int slot2 = slot == 0 ? 2 : slot - 1;
        slot = slot == 2 ? 0 : slot + 1;
        if (!cw) { if (c + 2 < NCH) GLA_DMA(c + 2, slot2); continue; }
        bf16x8 vf[4];
#pragma unroll
        for (int s = 0; s < 4; ++s) vf[s] = *(const LAS bf16x8*)(sb + S_VT + (wid * 4 + s) * 1024 + lane * 16);
        u32x4 Sb[4][2];
#pragma unroll
        for (int T = 0; T < 4; ++T)
#pragma unroll
            for (int s = 0; s < 2; ++s)
#pragma unroll
                for (int i = 0; i < 4; ++i) Sb[T][s][i] = cvtpk(S[T][8 * s + 2 * i], S[T][8 * s + 2 * i + 1]);
        f32x16 o[2]; o[0] = f32x16{}; o[1] = f32x16{};
#pragma unroll
        for (int T = 0; T < 4; ++T)
#pragma unroll
            for (int g = 0; g < 4; ++g) { const f32x4 e = *(const LAS f32x4*)(sb + S_EL + (32 * T + 8 * g + 4 * hi) * 4); S[T][4 * g] *= e.x; S[T][4 * g + 1] *= e.y; S[T][4 * g + 2] *= e.z; S[T][4 * g + 3] *= e.w; }
#define GLA_QF(tt, k8) (*(const LAS bf16x8*)(sb + S_QIN + ((tt) * 8 + (k8)) * 1024 + lane * 16))
#define GLA_KF(T, s) (*(const LAS bf16x8*)(sb + S_KDT + ((T) * 4 + (s)) * 1024 + lane * 16))
#define GLA_AF(tt, s) (*(const LAS bf16x8*)(sb + S_AM + ((tt) * 4 + (s)) * 1024 + lane * 16))
#define GLA_LOADG(F, g) do { F[0] = GLA_QF(0, 2 * (g)); F[1] = GLA_QF(1, 2 * (g)); F[2] = GLA_QF(0, 2 * (g) + 1); F[3] = GLA_QF(1, 2 * (g) + 1); \
        F[4] = GLA_KF((2 * (g)) & 3, (g) >> 1); F[5] = GLA_KF((2 * (g) + 2) & 3, 2 + ((g) >> 1)); F[6] = GLA_KF((2 * (g) + 1) & 3, (g) >> 1); F[7] = GLA_KF((2 * (g) + 3) & 3, 2 + ((g) >> 1)); } while (0)
#define GLA_MMAG(F, g) do { \
        o[0] = __builtin_amdgcn_mfma_f32_32x32x16_bf16(F[0], __builtin_bit_cast(bf16x8, Sb[g][0]), o[0], 0, 0, 0); \
        S[(2 * (g)) & 3] = __builtin_amdgcn_mfma_f32_32x32x16_bf16(F[4], vf[(g) >> 1], S[(2 * (g)) & 3], 0, 0, 0); \
        o[1] = __builtin_amdgcn_mfma_f32_32x32x16_bf16(F[1], __builtin_bit_cast(bf16x8, Sb[g][0]), o[1], 0, 0, 0); \
        S[(2 * (g) + 2) & 3] = __builtin_amdgcn_mfma_f32_32x32x16_bf16(F[5], vf[2 + ((g) >> 1)], S[(2 * (g) + 2) & 3], 0, 0, 0); \
        o[0] = __builtin_amdgcn_mfma_f32_32x32x16_bf16(F[2], __builtin_bit_cast(bf16x8, Sb[g][1]), o[0], 0, 0, 0); \
        S[(2 * (g) + 1) & 3] = __builtin_amdgcn_mfma_f32_32x32x16_bf16(F[6], vf[(g) >> 1], S[(2 * (g) + 1) & 3], 0, 0, 0); \
        o[1] = __builtin_amdgcn_mfma_f32_32x32x16_bf16(F[3], __builtin_bit_cast(bf16x8, Sb[g][1]), o[1], 0, 0, 0); \
        S[(2 * (g) + 3) & 3] = __builtin_amdgcn_mfma_f32_32x32x16_bf16(F[7], vf[2 + ((g) >> 1)], S[(2 * (g) + 3) & 3], 0, 0, 0); } while (0)
        bf16x8 FA[8], FB[8];
        GLA_LOADG(FA, 0); __builtin_amdgcn_sched_barrier(0);
        GLA_LOADG(FB, 1); __builtin_amdgcn_sched_barrier(0); GLA_MMAG(FA, 0); __builtin_amdgcn_sched_barrier(0);
        GLA_LOADG(FA, 2); __builtin_amdgcn_sched_barrier(0); GLA_MMAG(FB, 1); __builtin_amdgcn_sched_barrier(0);
        GLA_LOADG(FB, 3); __builtin_amdgcn_sched_barrier(0); GLA_MMAG(FA, 2); __builtin_amdgcn_sched_barrier(0);
        FA[0] = GLA_AF(0, 0); FA[1] = GLA_AF(1, 0); FA[2] = GLA_AF(0, 1); FA[3] = GLA_AF(1, 1); FA[4] = GLA_AF(1, 2); FA[5] = GLA_AF(1, 3);
        __builtin_amdgcn_sched_barrier(0); GLA_MMAG(FB, 3); __builtin_amdgcn_sched_barrier(0);
        o[0] = __builtin_amdgcn_mfma_f32_32x32x16_bf16(FA[0], vf[0], o[0], 0, 0, 0); o[1] = __builtin_amdgcn_mfma_f32_32x32x16_bf16(FA[1], vf[0], o[1], 0, 0, 0);
        o[0] = __builtin_amdgcn_mfma_f32_32x32x16_bf16(FA[2], vf[1], o[0], 0, 0, 0); o[1] = __builtin_amdgcn_mfma_f32_32x32x16_bf16(FA[3], vf[1], o[1], 0, 0, 0);
        o[1] = __builtin_amdgcn_mfma_f32_32x32x16_bf16(FA[4], vf[2], o[1], 0, 0, 0); o[1] = __builtin_amdgcn_mfma_f32_32x32x16_bf16(FA[5], vf[3], o[1], 0, 0, 0);
#undef GLA_QF
#undef GLA_KF
#undef GLA_AF
#undef GLA_LOADG
#undef GLA_MMAG
        bf16* og = ogbase;
#pragma unroll
        for (int tt = 0; tt < 2; ++tt)
#pragma unroll
            for (int r = 0; r < 16; ++r) { const int tok = tt * 32 + crow(r, hi); if (c > 0 || tok < NMETA) og[(size_t)chunk_row(b, c, tok) * 32] = (bf16)cvtpk(o[tt][r], o[tt][r]); }
    }
    if (cw) { float* outp = a->out + O_GLAP + (size_t)bh * 128 * 256 + ds * 32 + r32;
#pragma unroll
    for (int T = 0; T < 4; ++T)
#pragma unroll
        for (int r = 0; r < 16; ++r) outp[(size_t)(32 * T + crow(r, hi)) * 256] = S[T][r]; }
    asm volatile("s_waitcnt vmcnt(0) lgkmcnt(0)\n\ts_barrier" ::: "memory");
#undef GLA_DMA
#undef GLA_VLOAD
}
}

__device__ __forceinline__ bool relaunder(ArgsP& a) { asm volatile("" : "+s"(a)); return true; }
constexpr int NPHASE = 22;
__global__ void __launch_bounds__(512, 2) fwd(Args a_unused) {
    ArgsP a = (ArgsP)__builtin_amdgcn_kernarg_segment_ptr();
    extern __shared__ __attribute__((aligned(16))) unsigned char lds_raw[];
    LAS unsigned char* lds = (LAS unsigned char*)lds_raw;
    Ctx c; c.wave = __builtin_amdgcn_readfirstlane((int)threadIdx.x >> 6); c.tid = 0; c.lane = 0;
    c.gw = blockIdx.x * 8 + c.wave; c.ngw = gridDim.x * 8; c.gwT = c.wave * gridDim.x + blockIdx.x;
    volatile LAS unsigned* MISC = (volatile LAS unsigned*)(lds + MISC_OFF);
    if (threadIdx.x < 32) MISC[threadIdx.x] = 0u;
    __syncthreads();
    XcdBarrier bar; bar.bar = (unsigned*)(a->ws + WS_CTL) + CW_BAR; bar.x = 0; bar.st = nullptr;
    const bool one = (a->ph_hi - a->ph_lo) > 1;
    if (one) bar = xcd_barrier_post((unsigned*)(a->ws + WS_CTL) + CW_BAR, MISC + 8);
    const int lo = a->ph_lo, hi = a->ph_hi;
    unsigned long long tp0 = 0, tp1 = 0;
#define IN(k) (((PROBE_LO == (k)) ? (void)(tp0 = __builtin_amdgcn_s_memrealtime()) : (void)0), (lo <= (k) && (k) < hi && relaunder(a)))
#define INQ(k) (lo <= (k) && (k) < hi)
#define SEAM(k) do { if (INQ(k) && INQ((k) + 1)) xcd_barrier(bar, c.wave); if (PROBE_HI == (k)) tp1 = __builtin_amdgcn_s_memrealtime(); } while (0)
    if (IN(0)) { p_prep(a, c, lds); } SEAM(0);
    if (IN(1)) { if ((int)blockIdx.x < (RP / 256) * (NIN0 / 256)) gemm_p1(a, lds, c.wave); else p_side_tables(a, c, lds, (RP / 256) * (NIN0 / 256)); } SEAM(1);
    if (IN(2)) { if (USE_NAIVE_GEMM) p_mla_mid(a, c); }
    if (IN(3)) { gemm_p3(a, lds, c.wave); } SEAM(3);
    if (IN(4)) { if (USE_NAIVE_GEMM) { p_q_post(a, c); p_qlat(a, c); } }
    if (IN(5)) {
#if USE_NAIVE_ATTN
        p_attn_prompt_naive<false>(a, c);
#else
        if (((int)blockIdx.x >> 3) & 1) {
            dec::decode_phase(a, lds, c.wave);
            att::attn_phase(WSB(WS_QN), WSB(WS_QPE), WSB(WS_KNV), WSB(WS_KPE), WSB(WS_O), lds, c.wave);
        } else {
            att::attn_phase(WSB(WS_QN), WSB(WS_QPE), WSB(WS_KNV), WSB(WS_KPE), WSB(WS_O), lds, c.wave);
            dec::decode_phase(a, lds, c.wave);
        }
#endif
    } SEAM(5);
    if (IN(6)) {
#if USE_NAIVE_DECODE
        p_olat_up(a, c);
#else
        dec::combine_phase(a, c, lds);
#endif
    } SEAM(6);
    if (IN(7)) { gemm_n1024_tail<D, 8>(WSB(WS_O), WSB(WS_WO0), WSB(WS_M), WSF(WS_MT), lds, c.wave); } SEAM(7);
    if (IN(8)) { p_post_res<false, 8, true>(a, c, IN_F(8), IN_F(9)); } SEAM(8);
    if (IN(9)) { gemm_mfma8(WSB(WS_H), WSB(WS_WUP), RP, FF, D, (EpiRelu2{WSB(WS_U), FF}), lds, c.wave); } SEAM(9);
    if (IN(10)) { gemm_n1024_tail<FF, 16>(WSB(WS_U), WSB(WS_WDN), WSB(WS_M), WSF(WS_MT), lds, c.wave); } SEAM(10);
    if (IN(11)) { p_post_res<false, 16>(a, c, IN_F(10), IN_F(7) + D); } SEAM(11);
    if (IN(12)) { gemm_mfma8(WSB(WS_H), WSB(WS_WGIN), RP, NGIN, D, (EpiGla{WSB(WS_QG), WSB(WS_KG), WSB(WS_VG), WSB(WS_RG), WSF(WS_GD)}), lds, c.wave); } SEAM(12);
    if (IN(13)) {
#if USE_NAIVE_GLA
        p_gate(a, c);
#else
        gla::prep_phase(a, lds, c.wave);
#endif
    } SEAM(13);
    if (IN(14)) {
#if !USE_NAIVE_GLA
        if ((int)blockIdx.x < NB * GH * gla::NSP) gla::scan_bh(a, (int)blockIdx.x / gla::NSP, (int)blockIdx.x % gla::NSP, lds, c.wave);
        else for (int item = (int)blockIdx.x - NB * GH * gla::NSP; item < DB * GH; item += (int)gridDim.x - NB * GH * gla::NSP) gla::sample_item(a, item, lds, c.wave);
#else
        p_gla_naive(a, c);
#endif
    } SEAM(14);
    if (IN(15)) { p_gla_post(a, c); } SEAM(15);
    if (IN(16)) { gemm_n1024_tail<D, 8>(WSB(WS_OG), WSB(WS_WGO), WSB(WS_M), WSF(WS_MT), lds, c.wave); } SEAM(16);
    if (IN(17)) { p_post_res<false, 8>(a, c, IN_F(8) + D, IN_F(9) + D); } SEAM(17);
    if (IN(18)) { gemm_mfma8(WSB(WS_H), WSB(WS_WUP) + (size_t)FF * D, RP, FF, D, (EpiRelu2{WSB(WS_U), FF}), lds, c.wave); } SEAM(18);
    if (IN(19)) { gemm_n1024_tail<FF, 16>(WSB(WS_U), WSB(WS_WDN) + (size_t)D * FF, WSB(WS_M), WSF(WS_MT), lds, c.wave); } SEAM(19);
    if (IN(20)) { p_post_res<true, 16>(a, c, IN_F(10) + D, nullptr); }
    if (PROBE_LO >= 0 && blockIdx.x == 0) { const unsigned long long span = (tp1 - tp0) * 9ull, t0 = __builtin_amdgcn_s_memrealtime(); while (__builtin_amdgcn_s_memrealtime() - t0 < span) __builtin_amdgcn_s_sleep(8); }
#undef IN
#undef SEAM
}

extern "C" void kernel_launch(void* const* d_in, const int* in_sizes, int n_in, void* d_out, int out_size, void* d_ws, size_t ws_size, hipStream_t stream) {
    static int grid = 0;
    if (grid == 0) {
        if (n_in != 25 || out_size != (int)O_END || ws_size < WS_END) { fprintf(stderr, "kernel_launch: unexpected shapes n_in %d out %d ws %zu\n", n_in, out_size, ws_size); grid = -1; return; }
        int dev = 0, cus = 0, per_cu = 0;
        if (hipGetDevice(&dev) != hipSuccess || hipDeviceGetAttribute(&cus, hipDeviceAttributeMultiprocessorCount, dev) != hipSuccess) { grid = -1; return; }
        if (hipFuncSetAttribute((const void*)fwd, hipFuncAttributeMaxDynamicSharedMemorySize, LDS_BYTES) != hipSuccess) { fprintf(stderr, "kernel_launch: hipFuncSetAttribute failed\n"); grid = -1; return; }
        if (hipOccupancyMaxActiveBlocksPerMultiprocessor(&per_cu, (const void*)fwd, 512, LDS_BYTES) != hipSuccess || per_cu < 1) fprintf(stderr, "kernel_launch: occupancy query says %d\n", per_cu);
        (void)hipGetLastError();
        grid = cus;
    }
    if (grid < 0) return;
    if (hipMemsetAsync((char*)d_ws + WS_CTL, 0, CTL_ZERO_BYTES, stream) != hipSuccess) return;
    Args a{};
    for (int i = 0; i < 25; ++i) a.in[i] = d_in[i];
    a.out = (float*)d_out; a.ws = (unsigned char*)d_ws;
#if MK_ONE_LAUNCH
    a.ph_lo = 0; a.ph_hi = NPHASE;
    hipLaunchKernelGGL(fwd, dim3(grid), dim3(512), LDS_BYTES, stream, a);
#else
    for (int ph = 0; ph < NPHASE - 1; ++ph) { a.ph_lo = ph; a.ph_hi = ph + 1; hipLaunchKernelGGL(fwd, dim3(grid), dim3(512), LDS_BYTES, stream, a); }
#endif
}
```

```cpp
#include <hip/hip_runtime.h>
#include <cstdio>
#include <cstdint>
#include <cmath>

#ifndef MK_ONE_LAUNCH
#define MK_ONE_LAUNCH 1
#endif

constexpr int D = 1024, NB = 4, SEQ = 4096, NMETA = 16, TP = SEQ + NMETA;
constexpr int DB = 128, DS = 4, PAST = 8192, PAGE = 128, NPAGES = 64;
constexpr int NH = 16, QL = 256, KVL = 256, NOPE = 64, ROPE = 32, VH = 64;
constexpr int GH = 4, GDK = 128, GDV = 256, GR = 16;
constexpr int FF = 4096;
constexpr int RMAIN = NB * SEQ;
constexpr int RMETA0 = RMAIN;
constexpr int RSAMP0 = RMAIN + NB * NMETA;
constexpr int R = RSAMP0 + DB * DS;
constexpr int RPROMPT = RSAMP0;
constexpr int RP = 17152;
constexpr int NIN0 = 768, NUQ = 1536, NUKV = 2048, NGIN = 3328, NGIN_REAL = 3088;
constexpr float EPS = 1e-6f;
constexpr float MLA_SCALE = 0.10206207261596575f;
constexpr float GLA_SCALE = 0.08838834764831845f;
constexpr float QSCALE = 0.10206207261596575f * 1.4426950408889634f;

constexpr size_t O_YP = 0, O_YS = 16777216, O_CKVP = 17301504, O_KPEP = 21512192, O_CKVS = 22038528, O_KPES = 22169600, O_GLAP = 22185984, O_GLAS = 22710272, O_END = 39487488;

constexpr size_t MiB = 1u << 20;
constexpr size_t WS_CTL = 0, CTL_ZERO_BYTES = 1 * MiB;
constexpr size_t WS_WIN0 = 2 * MiB, WS_WUQ = 4 * MiB, WS_WUKV = 5 * MiB, WS_WO0 = 6 * MiB, WS_WUP = 8 * MiB, WS_WDN = 24 * MiB, WS_WGIN = 40 * MiB, WS_WGO = 47 * MiB;
constexpr size_t WS_X = 64 * MiB, WS_H = 132 * MiB, WS_M = 166 * MiB, WS_U = 234 * MiB, WS_A1 = 368 * MiB, WS_CQN = 419 * MiB, WS_CKVN = 428 * MiB, WS_KPE = 437 * MiB;
constexpr size_t WS_QRAW = 440 * MiB, WS_KNV = 541 * MiB, WS_QN = 608 * MiB, WS_QPE = 642 * MiB, WS_QLAT = 659 * MiB, WS_OLAT = 663 * MiB, WS_O = 671 * MiB;
constexpr size_t WS_QG = 705 * MiB, WS_KG = 722 * MiB, WS_VG = 739 * MiB, WS_RG = 773 * MiB, WS_GD = 807 * MiB, WS_LA = 809 * MiB, WS_EA = 843 * MiB, WS_OGRAW = 877 * MiB, WS_OG = 944 * MiB;
constexpr size_t WS_OPART = 978 * MiB, WS_MLP = 1012 * MiB;
constexpr size_t WS_QINF = 1014 * MiB, WS_KDTF = 1032 * MiB, WS_AMF = 1050 * MiB, WS_VTF = 1060 * MiB, WS_ELF = 1094 * MiB;
constexpr size_t WS_WUQL = 50 * MiB;
constexpr size_t WS_ROPE = 53 * MiB;
constexpr size_t WS_MT = 1096 * MiB;
constexpr size_t WS_END = 1144 * MiB;
constexpr int CW_BAR = 4096, CW_DEC = 8192;
namespace gla { constexpr int NSP = 8, NCW = 8 / NSP; }

constexpr int LDS_BYTES = 147456;
constexpr int MISC_OFF = LDS_BYTES - 256;

#define GAS __attribute__((address_space(1)))
#define LAS __attribute__((address_space(3)))
typedef unsigned short bf16;
typedef float f32x4 __attribute__((ext_vector_type(4)));
typedef unsigned u32x4 __attribute__((ext_vector_type(4)));
typedef unsigned u32x2 __attribute__((ext_vector_type(2)));
#define LDS_WAIT() asm volatile("s_waitcnt lgkmcnt(0)" ::: "memory")

__device__ __forceinline__ unsigned f2bf(float f) { unsigned u = __builtin_bit_cast(unsigned, f); return (u + 0x7fffu + ((u >> 16) & 1u)) >> 16; }
__device__ __forceinline__ unsigned pk2(float lo, float hi) { return f2bf(lo) | (f2bf(hi) << 16); }
__device__ __forceinline__ float bflo(unsigned u) { return __builtin_bit_cast(float, u << 16); }
__device__ __forceinline__ float bfhi(unsigned u) { return __builtin_bit_cast(float, u & 0xffff0000u); }
__device__ __forceinline__ float bf2f(bf16 v) { return __builtin_bit_cast(float, (unsigned)v << 16); }
__device__ __forceinline__ float wave_sum(float v) {
#pragma unroll
    for (int o = 1; o < 64; o <<= 1) v += __shfl_xor(v, o);
    return v;
}
__device__ __forceinline__ int wave_max_i(int v) {
#pragma unroll
    for (int o = 1; o < 64; o <<= 1) { int t = __shfl_xor(v, o); v = t > v ? t : v; }
    return v;
}
__device__ __forceinline__ int fresh_tid(int wave) { int t = wave * 64 + (int)__builtin_amdgcn_mbcnt_hi(~0u, __builtin_amdgcn_mbcnt_lo(~0u, 0u)); asm volatile("" : "+v"(t)); return t; }
__device__ __forceinline__ float rdlane(float v, int l) { return __builtin_bit_cast(float, __builtin_amdgcn_readlane(__builtin_bit_cast(int, v), l)); }

#define XB_TMO      128
#define XB_XCNT(j)  (256  + 64 * (j))
#define XB_XSUB(j)  (1280 + 64 * (j))
#define XB_XGEN(j)  (2304 + 64 * (j))
#define XB_TOP      3328
#define XB_TOPGEN   3392
#define XCD_BAR_WORDS 3456
#define XB_SPIN_CAP (1u << 18)
__device__ __forceinline__ unsigned xb_ld(unsigned* p)              { return __hip_atomic_load(p, __ATOMIC_RELAXED, __HIP_MEMORY_SCOPE_AGENT); }
__device__ __forceinline__ unsigned xb_add(unsigned* p, unsigned v) { return __hip_atomic_fetch_add(p, v, __ATOMIC_RELAXED, __HIP_MEMORY_SCOPE_AGENT); }
__device__ __forceinline__ unsigned xb_xcc_id() { return (unsigned)__builtin_amdgcn_s_getreg((3 << 11) | 20) & 0xFu; }
#define XB_SPIN(cond, bar) do { unsigned _sp = 0; while (cond) { __builtin_amdgcn_s_sleep(1); \
    if ((++_sp & 255u) == 0u) { if (xb_ld(&(bar)[XB_TMO])) break; if (_sp > XB_SPIN_CAP) { atomicAdd(&(bar)[XB_TMO], 1u); break; } } } } while (0)
struct XcdBarrier { unsigned* bar; unsigned x; volatile LAS unsigned* st; };
__device__ __forceinline__ XcdBarrier xcd_barrier_post(unsigned* bar, volatile LAS unsigned* st) {
    XcdBarrier b; b.bar = bar; b.x = xb_xcc_id(); b.st = st;
    if (threadIdx.x == 0) (void)xb_add(&bar[XB_XCNT(b.x)], 1u);
    return b;
}
__device__ __forceinline__ void xcd_barrier_complete(unsigned* bar, unsigned x, unsigned& nloc, unsigned& nx) {
    const unsigned G = gridDim.x * gridDim.y * gridDim.z;
    unsigned sum, cnt, mine, sp = 0u;
    for (;;) {
        sum = 0u; cnt = 0u; mine = 0u;
#pragma unroll
        for (unsigned j = 0; j < 16; ++j) { const unsigned c = xb_ld(&bar[XB_XCNT(j)]); sum += c; cnt += (c > 0u) ? 1u : 0u; mine = (j == x) ? c : mine; }
        if (sum == G) break;
        __builtin_amdgcn_s_sleep(1);
        if ((++sp & 255u) == 0u) { if (xb_ld(&bar[XB_TMO])) break; if (sp > XB_SPIN_CAP) { atomicAdd(&bar[XB_TMO], 1u); break; } }
    }
    nloc = mine > 0u ? mine : 1u; nx = cnt > 0u ? cnt : 1u;
}
__device__ __forceinline__ void xcd_barrier(const XcdBarrier& b, int wave_id) {
    asm volatile("s_waitcnt vmcnt(0)" ::: "memory");
    __syncthreads();
    if (fresh_tid(wave_id) == 0) {
        unsigned* bar = b.bar;
        __builtin_amdgcn_s_waitcnt(0);
        unsigned nloc = b.st[0], nx = b.st[1];
        if (nloc == 0u) { xcd_barrier_complete(bar, b.x, nloc, nx); b.st[0] = nloc; b.st[1] = nx; }
        const unsigned old = xb_add(&bar[XB_XSUB(b.x)], 1u);
        const unsigned gen = old / nloc;
        if (old + 1u == (gen + 1u) * nloc) {
            __builtin_amdgcn_fence(__ATOMIC_RELEASE, "agent");
            asm volatile("s_waitcnt vmcnt(0)" ::: "memory");
            const unsigned og = xb_add(&bar[XB_TOP], 1u);
            const unsigned tg = og / nx;
            if (og + 1u == (tg + 1u) * nx) xb_add(&bar[XB_TOPGEN], 1u);
            else XB_SPIN(xb_ld(&bar[XB_TOPGEN]) == tg, bar);
            __builtin_amdgcn_fence(__ATOMIC_ACQUIRE, "agent");
            xb_add(&bar[XB_XGEN(b.x)], 1u);
            asm volatile("s_waitcnt vmcnt(0)" ::: "memory");
        } else {
            XB_SPIN(xb_ld(&bar[XB_XGEN(b.x)]) == gen, bar);
            __builtin_amdgcn_fence(__ATOMIC_ACQUIRE, "agent");
            asm volatile("s_waitcnt vmcnt(0)" ::: "memory");
        }
    }
    __syncthreads();
}

namespace pg8 {
#define PG8_LAS __attribute__((address_space(3)))
typedef unsigned short bf16_t;
typedef short bf16x8 __attribute__((ext_vector_type(8)));
typedef float f32x4 __attribute__((ext_vector_type(4)));
typedef unsigned u32x4 __attribute__((ext_vector_type(4)));
constexpr int BM = 256, BK = 64, HALF = 128, HTB = HALF * BK * 2  , STAGE_BYTES = 8 * HTB, NXCD = 8, WGM = 8;

__host__ __device__ __forceinline__ int lds_byte(int r, int c) { const int st = (r >> 4) * 2 + (c >> 5), rr = r & 15, cc = c & 31, ob = rr * 64 + cc * 2; return st * 1024 + (ob ^ (((ob >> 9) & 1) << 5)); }
__host__ __device__ __forceinline__ void stage_rc(int b, int& R, int& C) { const int st = b / 1024, sb = b % 1024, swz = sb ^ (((sb >> 9) & 1) << 5); R = (st >> 1) * 16 + swz / 64; C = (st & 1) * 32 + (swz % 64) / 2; }
__host__ __device__ __forceinline__ int perm32(int rho) { const int n = rho >> 4, i = rho & 15; return 8 * (i >> 2) + 4 * n + (i & 3); }

struct Unit { int pm, pn, k0, prob; long aoff, boff; };
struct Gemm { const bf16_t* A; const bf16_t* Bt; int M, N, K, ld; };

struct StaticOrder {
    int nM, nN, nwg, G, c;
    __host__ __device__ void init(int M, int N, int G_, int c_) { nM = M / BM; nN = N / BM; nwg = nM * nN; G = G_; c = c_; }
    __host__ __device__ bool next(int i, Unit& u) const {
        const long L = (long)i * G + c; if (L >= nwg) return false;
        int wgid = (int)L; { const int q = nwg / NXCD, r = nwg % NXCD, xcd = wgid % NXCD, off = wgid / NXCD; wgid = (xcd < r ? xcd * (q + 1) : r * (q + 1) + (xcd - r) * q) + off; }
        const int nig = WGM * nN, gid = wgid / nig, fm = gid * WGM, gsz = (nM - fm) < WGM ? (nM - fm) : WGM;
        u.pm = fm + ((wgid % nig) % gsz); u.pn = (wgid % nig) / gsz; u.k0 = 0; u.prob = 0; u.aoff = 0; u.boff = 0; return true;
    }
    __device__ __forceinline__ void a_ready(const Unit&) const {}
    __device__ __forceinline__ void done(const Unit&) const {}
};

__device__ __forceinline__ unsigned cvt_pk_bf16(float lo, float hi) { unsigned r; asm volatile("v_cvt_pk_bf16_f32 %0, %1, %2" : "=v"(r) : "v"(lo), "v"(hi)); return r; }
template <class Epi, class Sched, bool ALIGN_EPI = false, bool SP2 = false>
__device__ __forceinline__ void gemm_phase(PG8_LAS unsigned char* lds, const Gemm g, const Sched& S, const Epi& E, int wave_id) {
    const int tid = fresh_tid(wave_id), wid = wave_id, lane = tid & 63, wr = wid >> 2, wc = wid & 3, fr = lane & 15, fq = lane >> 4;
    const int K = g.K, nt = K / BK;
    unsigned voffA[2], voffB[2];
#pragma unroll
    for (int i = 0; i < 2; ++i) { int R, C; stage_rc(tid * 16 + i * 8192, R, C); const int Rb = Epi::PERM ? ((R & ~31) + perm32(R & 31)) : R;
        voffA[i] = (unsigned)(R * g.ld + C) * 2u; voffB[i] = (unsigned)(Rb * g.ld + C) * 2u; }
    const size_t kstep = (size_t)(BK * 2);
    const size_t hstep = (size_t)HALF * g.ld * 2;
    const size_t tstep = 2 * hstep;
    const unsigned ldsw = (unsigned)wid * 1024u;
    const int aoff = lds_byte(wr * 64 + fr, fq * 8), boff = lds_byte(wc * 32 + fr, fq * 8);
#define PG8_SA(b, h) (((b) * 2 + (h)) * HTB)
#define PG8_SB(b, h) ((4 + (b) * 2 + (h)) * HTB)
#define PG8_STAGE(bufoff, gbase, voff) do { _Pragma("unroll") for (int _i = 0; _i < 2; ++_i) \
        __builtin_amdgcn_global_load_lds((const unsigned*)((const char*)(gbase) + (voff)[_i]), (PG8_LAS unsigned*)(lds + (bufoff) + ldsw + _i * 8192), 16, 0, 0); } while (0)
#define PG8_LDA(dst, b, h) do { _Pragma("unroll") for (int m = 0; m < 4; ++m) _Pragma("unroll") for (int k = 0; k < 2; ++k) dst[m][k] = *(const PG8_LAS bf16x8*)(lds + PG8_SA(b, h) + aoff + m * 2048 + k * 1024); } while (0)
#define PG8_LDB(dst, b, h) do { _Pragma("unroll") for (int n = 0; n < 2; ++n) _Pragma("unroll") for (int k = 0; k < 2; ++k) dst[n][k] = *(const PG8_LAS bf16x8*)(lds + PG8_SB(b, h) + boff + n * 2048 + k * 1024); } while (0)
#define PG8_MMA(ai, bj, At, Bt) do { __builtin_amdgcn_s_setprio(1); _Pragma("unroll") for (int m = 0; m < 4; ++m) _Pragma("unroll") for (int n = 0; n < 2; ++n) _Pragma("unroll") for (int k = 0; k < 2; ++k) \
        acc[ai][bj][m][n] = __builtin_amdgcn_mfma_f32_16x16x32_bf16(Bt[n][k], At[m][k], acc[ai][bj][m][n], 0, 0, 0); __builtin_amdgcn_s_setprio(0); } while (0)
#define PG8_WAIT_V(n) asm volatile("s_waitcnt vmcnt(" #n ")" ::: "memory")
#define PG8_WAIT_L(n) asm volatile("s_waitcnt lgkmcnt(" #n ")" ::: "memory")
#define PG8_BAR __builtin_amdgcn_s_barrier()
#define PG8_SCHED __builtin_amdgcn_sched_barrier(0)
    Unit cur, nxt; int ui = 0;
    if (!S.next(0, cur)) return;
    f32x4 acc[2][2][4][2];
#pragma unroll
    for (int a = 0; a < 2; ++a)
#pragma unroll
        for (int b = 0; b < 2; ++b)
#pragma unroll
            for (int m = 0; m < 4; ++m)
#pragma unroll
                for (int n = 0; n < 2; ++n) acc[a][b][m][n] = (f32x4){0.f, 0.f, 0.f, 0.f};
    bf16x8 At[4][2], B0[2][2], B1[2][2];
    const char* cA = (const char*)g.A + (size_t)cur.pm * tstep + (size_t)cur.k0 * 2 + cur.aoff; const char* cB = (const char*)g.Bt + (size_t)cur.pn * tstep + (size_t)cur.k0 * 2 + cur.boff;
    S.a_ready(cur);
    if constexpr (SP2) {
        PG8_STAGE(PG8_SB(0, 0), cB, voffB); PG8_STAGE(PG8_SB(0, 1), cB + hstep, voffB); PG8_STAGE(PG8_SA(0, 0), cA, voffA); PG8_STAGE(PG8_SA(0, 1), cA + hstep, voffA);
        if (wr == 1) PG8_BAR;
        PG8_WAIT_V(2); PG8_BAR;
        PG8_STAGE(PG8_SB(1, 0), cB + kstep, voffB); PG8_STAGE(PG8_SA(1, 0), cA + kstep, voffA); PG8_STAGE(PG8_SB(1, 1), cB + hstep + kstep, voffB);
        PG8_WAIT_V(6); PG8_BAR;
    } else {
        PG8_STAGE(PG8_SB(0, 0), cB, voffB); PG8_STAGE(PG8_SA(0, 0), cA, voffA); PG8_STAGE(PG8_SB(0, 1), cB + hstep, voffB); PG8_STAGE(PG8_SA(0, 1), cA + hstep, voffA);
        if (wr == 1) PG8_BAR;
        PG8_WAIT_V(4); PG8_BAR;
        PG8_STAGE(PG8_SB(1, 0), cB + kstep, voffB); PG8_STAGE(PG8_SA(1, 0), cA + kstep, voffA); PG8_STAGE(PG8_SB(1, 1), cB + hstep + kstep, voffB);
        PG8_WAIT_V(6); PG8_BAR;
    }
    for (;;) {
        const bool has_next = S.next(ui + 1, nxt);
        const char* nA = has_next ? (const char*)g.A + (size_t)nxt.pm * tstep + (size_t)nxt.k0 * 2 + nxt.aoff : cA; const char* nB = has_next ? (const char*)g.Bt + (size_t)nxt.pn * tstep + (size_t)nxt.k0 * 2 + nxt.boff : cB;
        for (int t = 0; t < nt; t += 2) {
            const bool last = (t == nt - 2);
            const char* a1 = cA + (size_t)(t + 1) * kstep;
            const char* a2 = last ? nA : cA + (size_t)(t + 2) * kstep; const char* b2 = last ? nB : cB + (size_t)(t + 2) * kstep;
            const char* a3 = a2 + kstep; const char* b3 = b2 + kstep;
            if (last && has_next) S.a_ready(nxt);
            if constexpr (SP2) {
            PG8_LDB(B0, 0, 0); PG8_LDB(B1, 0, 1); PG8_SCHED; PG8_LDA(At, 0, 0); PG8_STAGE(PG8_SA(1, 1), a1 + hstep, voffA);
            PG8_WAIT_V(8); PG8_WAIT_L(0); PG8_BAR; PG8_MMA(0, 0, At, B0); PG8_MMA(0, 1, At, B1); PG8_BAR; PG8_SCHED;
            PG8_LDA(At, 0, 1); PG8_STAGE(PG8_SB(0, 0), b2, voffB); PG8_STAGE(PG8_SB(0, 1), b2 + hstep, voffB); PG8_STAGE(PG8_SA(0, 0), a2, voffA);
            PG8_WAIT_V(8); PG8_WAIT_L(0); PG8_BAR; PG8_MMA(1, 0, At, B0); PG8_MMA(1, 1, At, B1); PG8_BAR; PG8_SCHED;
            PG8_LDB(B0, 1, 0); PG8_LDB(B1, 1, 1); PG8_SCHED; PG8_LDA(At, 1, 0); PG8_STAGE(PG8_SA(0, 1), a2 + hstep, voffA);
            PG8_WAIT_V(8); PG8_WAIT_L(0); PG8_BAR; PG8_MMA(0, 0, At, B0); PG8_MMA(0, 1, At, B1); PG8_BAR; PG8_SCHED;
            PG8_LDA(At, 1, 1); PG8_STAGE(PG8_SB(1, 0), b3, voffB); PG8_STAGE(PG8_SB(1, 1), b3 + hstep, voffB); PG8_STAGE(PG8_SA(1, 0), a3, voffA);
            PG8_WAIT_V(8); PG8_WAIT_L(0); PG8_BAR; PG8_MMA(1, 0, At, B0); PG8_MMA(1, 1, At, B1); PG8_BAR; PG8_SCHED;
            } else {
            PG8_LDB(B0, 0, 0); PG8_SCHED; PG8_LDA(At, 0, 0); PG8_STAGE(PG8_SA(1, 1), a1 + hstep, voffA);
            PG8_WAIT_L(8); PG8_BAR; PG8_WAIT_L(0); PG8_MMA(0, 0, At, B0); PG8_BAR; PG8_SCHED;
            PG8_LDB(B1, 0, 1); PG8_STAGE(PG8_SB(0, 0), b2, voffB);
            PG8_BAR; PG8_WAIT_L(0); PG8_MMA(0, 1, At, B1); PG8_BAR;
            PG8_LDA(At, 0, 1); PG8_STAGE(PG8_SA(0, 0), a2, voffA);
            PG8_BAR; PG8_WAIT_L(0); PG8_MMA(1, 0, At, B0); PG8_BAR; PG8_SCHED;
            PG8_STAGE(PG8_SB(0, 1), b2 + hstep, voffB);
            PG8_WAIT_V(6); PG8_BAR; PG8_MMA(1, 1, At, B1); PG8_BAR;
            PG8_LDB(B0, 1, 0); PG8_SCHED; PG8_LDA(At, 1, 0); PG8_STAGE(PG8_SA(0, 1), a2 + hstep, voffA);
            PG8_WAIT_L(8); PG8_BAR; PG8_WAIT_L(0); PG8_MMA(0, 0, At, B0); PG8_BAR; PG8_SCHED;
            PG8_LDB(B1, 1, 1); PG8_STAGE(PG8_SB(1, 0), b3, voffB);
            PG8_BAR; PG8_WAIT_L(0); PG8_MMA(0, 1, At, B1); PG8_BAR;
            PG8_LDA(At, 1, 1); PG8_STAGE(PG8_SA(1, 0), a3, voffA);
            PG8_BAR; PG8_WAIT_L(0); PG8_MMA(1, 0, At, B0); PG8_BAR; PG8_SCHED;
            PG8_STAGE(PG8_SB(1, 1), b3 + hstep, voffB);
            PG8_WAIT_V(6); PG8_BAR; PG8_MMA(1, 1, At, B1); PG8_BAR;
            }
        }
        if constexpr (ALIGN_EPI) { if (wr == 0) PG8_BAR; }
        if constexpr (!Epi::AFTER_DRAIN) { E(acc, cur, wr, wc, fr, fq); S.done(cur); }
        if (!has_next) break;
#pragma unroll
        for (int a = 0; a < 2; ++a)
#pragma unroll
            for (int b = 0; b < 2; ++b)
#pragma unroll
                for (int m = 0; m < 4; ++m)
#pragma unroll
                    for (int n = 0; n < 2; ++n) acc[a][b][m][n] = (f32x4){0.f, 0.f, 0.f, 0.f};
        cur = nxt; cA = nA; cB = nB; ++ui;
        if constexpr (ALIGN_EPI) { if (wr == 1) PG8_BAR; }
    }
    PG8_WAIT_V(0);
    if constexpr (!ALIGN_EPI) { if (wr == 0) PG8_BAR; }
    PG8_BAR;
    if constexpr (Epi::AFTER_DRAIN) { E.fused(acc, cur, wr, wc, fr, fq, lds, wid, lane); S.done(cur); }
#undef PG8_SA
#undef PG8_SB
#undef PG8_STAGE
#undef PG8_LDA
#undef PG8_LDB
#undef PG8_MMA
#undef PG8_WAIT_V
#undef PG8_WAIT_L
#undef PG8_BAR
#undef PG8_SCHED
}
}

struct Args { const void* in[25]; float* out; unsigned char* ws; int ph_lo, ph_hi; };
typedef const __attribute__((address_space(4))) Args* ArgsP;
#define IN_F(k) ((const float*)a->in[k])
#define WSB(off) ((bf16*)(a->ws + (off)))
#define WSF(off) ((float*)(a->ws + (off)))

struct Ctx { int tid, lane, wave, gw, ngw, gwT; };
__device__ __forceinline__ Ctx refresh(const Ctx& c0) { Ctx c = c0; c.tid = fresh_tid(c0.wave); c.lane = c.tid & 63; return c; }

__device__ __forceinline__ int row_pos(int r) { return r < RMAIN ? (r & 4095) + NMETA : (r < RSAMP0 ? ((r - RMAIN) & 15) : PAST + ((r - RSAMP0) & 3)); }
__device__ __forceinline__ float rope_inv(int j) { return exp2f(-(float)j * (13.287712379549449f / 16.0f)); }
__device__ __forceinline__ void rope_cs(int pos, int j, float& c, float& s) {
    const float ang = (float)pos * rope_inv(j);
    const double x = (double)ang; const double n = rint(x * 0.15915494309189535); const float r = (float)(x - n * 6.283185307179586);
    c = cosf(r); s = sinf(r);
}

struct RmId { int off; __device__ __forceinline__ int operator()(int n) const { return off + n; } };
struct RmUq { __device__ __forceinline__ int operator()(int n) const { const int h = n / 96, j = n % 96; if (j < 64) return h * 64 + j; const int jj = j - 64; return 1024 + h * 32 + (jj < 16 ? 2 * jj : 2 * (jj - 16) + 1); } };
template <class RM>
__device__ __forceinline__ void tr_item(const float* W, int ldw, int nblk, int item, bf16* WT, int ldt, RM rm, LAS float* scr, int lane) {
    const int kb = item / nblk, nb = item % nblk, k0 = 64 * kb, n0 = 32 * nb;
#pragma unroll
    for (int i = 0; i < 8; ++i) { const int kk = 8 * i + (lane >> 3), c4 = (lane & 7) * 4; const f32x4 v = *(const f32x4*)(W + (size_t)(k0 + kk) * ldw + n0 + c4);
        scr[kk * 33 + c4] = v.x; scr[kk * 33 + c4 + 1] = v.y; scr[kk * 33 + c4 + 2] = v.z; scr[kk * 33 + c4 + 3] = v.w; }
    LDS_WAIT();
    const int c = lane & 7;
#pragma unroll
    for (int j = 0; j < 4; ++j) { const int n = (lane >> 3) + 8 * j; const LAS float* s = scr + (8 * c) * 33 + n;
        u32x4 o; o.x = pk2(s[0 * 33], s[1 * 33]); o.y = pk2(s[2 * 33], s[3 * 33]); o.z = pk2(s[4 * 33], s[5 * 33]); o.w = pk2(s[6 * 33], s[7 * 33]);
        *(u32x4*)(WT + (size_t)rm(n0 + n) * ldt + k0 + 8 * c) = o; }
    LDS_WAIT();
}
__device__ __forceinline__ void norm_row_bf16(const float* xrow, const float* g, float* xcopy, bf16* hrow, int lane) {
    f32x4 v[4]; float s = 0.f;
#pragma unroll
    for (int j = 0; j < 4; ++j) { v[j] = *(const f32x4*)(xrow + 4 * lane + 256 * j); s += (v[j].x * v[j].x + v[j].y * v[j].y) + (v[j].z * v[j].z + v[j].w * v[j].w); }
    const float rs = 1.0f / sqrtf(wave_sum(s) * (1.f / D) + EPS);
#pragma unroll
    for (int j = 0; j < 4; ++j) { const f32x4 gg = *(const f32x4*)(g + 4 * lane + 256 * j);
        if (xcopy) *(f32x4*)(xcopy + 4 * lane + 256 * j) = v[j];
        u32x2 o; o.x = pk2(v[j].x * rs * gg.x, v[j].y * rs * gg.y); o.y = pk2(v[j].z * rs * gg.z, v[j].w * rs * gg.w);
        *(u32x2*)(hrow + 4 * lane + 256 * j) = o; }
}
__device__ __forceinline__ void p_prep(ArgsP a, const Ctx& c0, LAS unsigned char* lds) {
    const Ctx c = refresh(c0);
    LAS float* scr = (LAS float*)(lds + c.wave * 16384);
    constexpr int I0 = 16 * 17, I1 = 4 * 48, I2 = 4 * 32, I3 = 4 * 32, I4 = 16 * 32, I5 = 16 * 96, I6 = 16 * 32, I7 = 16 * 128, I8 = 16 * 128, I9 = 64 * 32, I10 = 64 * 32;
    constexpr int NIT = I0 + I1 + I2 + I3 + I4 + I5 + I6 + I7 + I8 + I9 + I10;
    for (int it = c.gw; it < NIT; it += c.ngw) {
        int r = it;
        if (r < I0) { tr_item(IN_F(11), 544, 17, r, WSB(WS_WIN0), 1024, RmId{0}, scr, c.lane); continue; } r -= I0;
        if (r < I1) { tr_item(IN_F(13), 1536, 48, r, WSB(WS_WUQ), 256, RmUq{}, scr, c.lane); continue; } r -= I1;
        if (r < I2) { tr_item(IN_F(15), 1024, 32, r, WSB(WS_WUKV), 256, RmId{0}, scr, c.lane); continue; } r -= I2;
        if (r < I3) { tr_item(IN_F(16), 1024, 32, r, WSB(WS_WUKV), 256, RmId{1024}, scr, c.lane); continue; } r -= I3;
        if (r < I4) { tr_item(IN_F(17), 1024, 32, r, WSB(WS_WO0), 1024, RmId{0}, scr, c.lane); continue; } r -= I4;
        if (r < I5) { tr_item(IN_F(18), 3088, 96, r, WSB(WS_WGIN), 1024, RmId{0}, scr, c.lane); continue; } r -= I5;
        if (r < I6) { tr_item(IN_F(22), 1024, 32, r, WSB(WS_WGO), 1024, RmId{0}, scr, c.lane); continue; } r -= I6;
        if (r < I7) { tr_item(IN_F(23), 4096, 128, r, WSB(WS_WUP), 1024, RmId{0}, scr, c.lane); continue; } r -= I7;
        if (r < I8) { tr_item(IN_F(23) + (size_t)1024 * 4096, 4096, 128, r, WSB(WS_WUP) + (size_t)4096 * 1024, 1024, RmId{0}, scr, c.lane); continue; } r -= I8;
        if (r < I9) { tr_item(IN_F(24), 1024, 32, r, WSB(WS_WDN), 4096, RmId{0}, scr, c.lane); continue; } r -= I9;
        tr_item(IN_F(24) + (size_t)4096 * 1024, 1024, 32, r, WSB(WS_WDN) + (size_t)1024 * 4096, 4096, RmId{0}, scr, c.lane);
    }
    const int gt = c.gw * 64 + c.lane, ngt = c.ngw * 64;
    for (int i = gt; i < (NIN0 - 544) * 1024 / 2; i += ngt) ((unsigned*)(WSB(WS_WIN0) + (size_t)544 * 1024))[i] = 0u;
    for (int i = gt; i < (NGIN - NGIN_REAL) * 1024 / 2; i += ngt) ((unsigned*)(WSB(WS_WGIN) + (size_t)NGIN_REAL * 1024))[i] = 0u;
    for (int i = gt; i < 16 * 1024; i += ngt) { const int n = i >> 10, k = i & 1023; WSB(WS_WGIN)[(size_t)(3072 + n) * 1024 + k] = (bf16)f2bf(IN_F(18)[(size_t)k * 3088 + 3072 + n]); }
    for (int i = c.gw * 64 + c.lane; i < R * 16; i += c.ngw * 64) { const int r = i >> 4, j = i & 15; float cs, sn; rope_cs(row_pos(r), j, cs, sn); WSF(WS_ROPE)[(size_t)r * 32 + j] = cs; WSF(WS_ROPE)[(size_t)r * 32 + 16 + j] = sn; }
    {
        const float* xp = IN_F(0); const float* xm = IN_F(6); const float* xsm = IN_F(1); bf16* X = WSB(WS_X); bf16* H = WSB(WS_H);
        f32x4 gg[4];
#pragma unroll
        for (int j = 0; j < 4; ++j) gg[j] = *(const f32x4*)(IN_F(7) + 4 * c.lane + 256 * j);
        constexpr int NR = 4;
        for (int r0 = c.gw; r0 < R; r0 += NR * c.ngw) {
            f32x4 v[NR][4]; float s[NR];
#pragma unroll
            for (int q = 0; q < NR; ++q) { const int r = r0 + q * c.ngw < R ? r0 + q * c.ngw : r0;
                const float* xs = r < RMAIN ? xp + (size_t)r * D : (r < RSAMP0 ? xm + (size_t)((r - RMAIN) & 15) * D : xsm + (size_t)(r - RSAMP0) * D);
                s[q] = 0.f;
#pragma unroll
                for (int j = 0; j < 4; ++j) { v[q][j] = *(const f32x4*)(xs + 4 * c.lane + 256 * j); s[q] += (v[q][j].x * v[q][j].x + v[q][j].y * v[q][j].y) + (v[q][j].z * v[q][j].z + v[q][j].w * v[q][j].w); } }
#pragma unroll
            for (int sh = 1; sh < 64; sh <<= 1) {
#pragma unroll
                for (int q = 0; q < NR; ++q) s[q] += __shfl_xor(s[q], sh); }
#pragma unroll
            for (int q = 0; q < NR; ++q) { const int r = r0 + q * c.ngw < R ? r0 + q * c.ngw : r0; const float rs = 1.0f / sqrtf(s[q] * (1.f / D) + EPS);
#pragma unroll
                for (int j = 0; j < 4; ++j) { if (r >= RMAIN) { u32x2 xo; xo.x = pk2(v[q][j].x, v[q][j].y); xo.y = pk2(v[q][j].z, v[q][j].w); *(u32x2*)(X + (size_t)r * D + 4 * c.lane + 256 * j) = xo; }
                    u32x2 o; o.x = pk2(v[q][j].x * rs * gg[j].x, v[q][j].y * rs * gg[j].y); o.y = pk2(v[q][j].z * rs * gg[j].z, v[q][j].w * rs * gg[j].w);
                    *(u32x2*)(H + (size_t)r * D + 4 * c.lane + 256 * j) = o; } }
        }
    }
}

struct EpiF32 { float* C; int ldc; __device__ __forceinline__ void store4(int row, int col, f32x4 v) const { *(f32x4*)(C + (size_t)row * ldc + col) = v; } };
struct EpiBf16 { bf16* C; int ldc;
    __device__ __forceinline__ void store8(int row, int col, f32x4 a, f32x4 b) const { u32x4 o; o.x = pk2(a.x, a.y); o.y = pk2(a.z, a.w); o.z = pk2(b.x, b.y); o.w = pk2(b.z, b.w); *(u32x4*)(C + (size_t)row * ldc + col) = o; }
    __device__ __forceinline__ void store4(int row, int col, f32x4 v) const { u32x2 o; o.x = pk2(v.x, v.y); o.y = pk2(v.z, v.w); *(u32x2*)(C + (size_t)row * ldc + col) = o; } };
struct EpiRelu2 { bf16* C; int ldc;
    __device__ __forceinline__ void store8(int row, int col, f32x4 a, f32x4 b) const {
        f32x4 r; r.x = fmaxf(a.x, 0.f); r.y = fmaxf(a.y, 0.f); r.z = fmaxf(a.z, 0.f); r.w = fmaxf(a.w, 0.f); r = r * r;
        f32x4 s; s.x = fmaxf(b.x, 0.f); s.y = fmaxf(b.y, 0.f); s.z = fmaxf(b.z, 0.f); s.w = fmaxf(b.w, 0.f); s = s * s;
        u32x4 o; o.x = pk2(r.x, r.y); o.y = pk2(r.z, r.w); o.z = pk2(s.x, s.y); o.w = pk2(s.z, s.w); *(u32x4*)(C + (size_t)row * ldc + col) = o; }
    __device__ __forceinline__ void store4(int row, int col, f32x4 v) const {
    f32x4 r; r.x = fmaxf(v.x, 0.f); r.y = fmaxf(v.y, 0.f); r.z = fmaxf(v.z, 0.f); r.w = fmaxf(v.w, 0.f); r = r * r;
    u32x2 o; o.x = pk2(r.x, r.y); o.y = pk2(r.z, r.w); *(u32x2*)(C + (size_t)row * ldc + col) = o; } };
struct EpiQ { bf16* QN; bf16* QPE; const float* ROPE;
    __device__ __forceinline__ void store8(int row, int col, f32x4 a, f32x4 b) const {
        if (col < 1024) { u32x4 o; o.x = pk2(a.x * QSCALE, a.y * QSCALE); o.y = pk2(a.z * QSCALE, a.w * QSCALE); o.z = pk2(b.x * QSCALE, b.y * QSCALE); o.w = pk2(b.z * QSCALE, b.w * QSCALE); *(u32x4*)(QN + (size_t)row * 1024 + col) = o; }
        else { store4(row, col, a); store4(row, col + 4, b); }
    }
    __device__ __forceinline__ void store4(int row, int col, f32x4 v) const {
        if (col < 1024) { u32x2 o; o.x = pk2(v.x * QSCALE, v.y * QSCALE); o.y = pk2(v.z * QSCALE, v.w * QSCALE); *(u32x2*)(QN + (size_t)row * 1024 + col) = o; }
        else { const int p0 = (col - 1024) >> 1; const float* rt = ROPE + (size_t)row * 32;
#pragma unroll
            for (int e = 0; e < 2; ++e) { const int p = p0 + e, h = p >> 4, jj = p & 15; const float x1 = e ? v.z : v.x, x2 = e ? v.w : v.y, cs = rt[jj], sn = rt[16 + jj];
                QPE[(size_t)row * 512 + h * 32 + jj] = (bf16)f2bf((x1 * cs - x2 * sn) * QSCALE); QPE[(size_t)row * 512 + h * 32 + 16 + jj] = (bf16)f2bf((x1 * sn + x2 * cs) * QSCALE); } }
    } };
struct EpiBf16S { bf16* C; int ldc; float s;
    __device__ __forceinline__ void store8(int row, int col, f32x4 a, f32x4 b) const { u32x4 o; o.x = pk2(a.x * s, a.y * s); o.y = pk2(a.z * s, a.w * s); o.z = pk2(b.x * s, b.y * s); o.w = pk2(b.z * s, b.w * s); *(u32x4*)(C + (size_t)row * ldc + col) = o; }
    __device__ __forceinline__ void store4(int row, int col, f32x4 v) const { u32x2 o; o.x = pk2(v.x * s, v.y * s); o.y = pk2(v.z * s, v.w * s); *(u32x2*)(C + (size_t)row * ldc + col) = o; } };
struct EpiGla { bf16 *QG, *KG, *VG, *RG; float* GD;
    __device__ __forceinline__ void store8(int row, int col, f32x4 a, f32x4 b) const {
        if (col < 3072) { bf16* dst; int cc;
            if (col < 512) { dst = QG + (size_t)row * 512; cc = col; a = a * GLA_SCALE; b = b * GLA_SCALE; }
            else if (col < 1024) { dst = KG + (size_t)row * 512; cc = col - 512; }
            else if (col < 2048) { dst = VG + (size_t)row * 1024; cc = col - 1024; }
            else { dst = RG + (size_t)row * 1024; cc = col - 2048; }
            u32x4 o; o.x = pk2(a.x, a.y); o.y = pk2(a.z, a.w); o.z = pk2(b.x, b.y); o.w = pk2(b.z, b.w); *(u32x4*)(dst + cc) = o;
        } else if (col < 3088) { *(f32x4*)(GD + (size_t)row * 16 + (col - 3072)) = a; *(f32x4*)(GD + (size_t)row * 16 + (col - 3072) + 4) = b; }
    }
    __device__ __forceinline__ void store4(int row, int col, f32x4 v) const {
        if (col < 3072) { bf16* dst; int cc;
            if (col < 512) { dst = QG + (size_t)row * 512; cc = col; v = v * GLA_SCALE; }
            else if (col < 1024) { dst = KG + (size_t)row * 512; cc = col - 512; }
            else if (col < 2048) { dst = VG + (size_t)row * 1024; cc = col - 1024; }
            else { dst = RG + (size_t)row * 1024; cc = col - 2048; }
            u32x2 o; o.x = pk2(v.x, v.y); o.y = pk2(v.z, v.w); *(u32x2*)(dst + cc) = o;
        } else if (col < 3088) { *(f32x4*)(GD + (size_t)row * 16 + (col - 3072)) = v; }
    } };
template <class Epi>
__device__ __forceinline__ void gemm_naive(const bf16* A, const bf16* Bt, int M, int N, int K, const Epi& E, LAS unsigned char* lds, int tid) {
    LAS float* As = (LAS float*)lds;
    LAS float* Bs = As + 32 * 68;
    const int ntm = M / 64, ntn = N / 128, ty = tid >> 5, tx = tid & 31;
    for (int tile = blockIdx.x; tile < ntm * ntn; tile += gridDim.x) {
        const int tm = tile / ntn, tn = tile % ntn;
        f32x4 acc[4];
#pragma unroll
        for (int i = 0; i < 4; ++i) acc[i] = (f32x4){0.f, 0.f, 0.f, 0.f};
        for (int k0 = 0; k0 < K; k0 += 32) {
            { const int row = tid >> 3, kq = (tid & 7) * 4; const u32x2 v = *(const u32x2*)(A + (size_t)(tm * 64 + row) * K + k0 + kq);
              As[(kq + 0) * 68 + row] = bflo(v.x); As[(kq + 1) * 68 + row] = bfhi(v.x); As[(kq + 2) * 68 + row] = bflo(v.y); As[(kq + 3) * 68 + row] = bfhi(v.y); }
            { const int row = tid >> 2, kq = (tid & 3) * 8; const u32x4 v = *(const u32x4*)(Bt + (size_t)(tn * 128 + row) * K + k0 + kq);
              Bs[(kq + 0) * 132 + row] = bflo(v.x); Bs[(kq + 1) * 132 + row] = bfhi(v.x); Bs[(kq + 2) * 132 + row] = bflo(v.y); Bs[(kq + 3) * 132 + row] = bfhi(v.y);
              Bs[(kq + 4) * 132 + row] = bflo(v.z); Bs[(kq + 5) * 132 + row] = bfhi(v.z); Bs[(kq + 6) * 132 + row] = bflo(v.w); Bs[(kq + 7) * 132 + row] = bfhi(v.w); }
            __syncthreads();
#pragma unroll 8
            for (int k = 0; k < 32; ++k) {
                const f32x4 av = *(const LAS f32x4*)(As + k * 68 + 4 * ty); const f32x4 bv = *(const LAS f32x4*)(Bs + k * 132 + 4 * tx);
                acc[0] += av.x * bv; acc[1] += av.y * bv; acc[2] += av.z * bv; acc[3] += av.w * bv;
            }
            __syncthreads();
        }
#pragma unroll
        for (int i = 0; i < 4; ++i) E.store4(tm * 64 + 4 * ty + i, tn * 128 + 4 * tx, acc[i]);
    }
}


template <class E> struct EpiWrap {
    static constexpr bool PERM = false, AFTER_DRAIN = false; E e;
    __device__ __forceinline__ void operator()(const pg8::f32x4 (&acc)[2][2][4][2], const pg8::Unit& u, int wr, int wc, int fr, int fq) const {
#pragma unroll
        for (int ai = 0; ai < 2; ++ai)
#pragma unroll
            for (int m = 0; m < 4; ++m) { const int row = u.pm * 256 + ai * 128 + wr * 64 + m * 16 + fr;
#pragma unroll
                for (int bj = 0; bj < 2; ++bj)
#pragma unroll
                    for (int n = 0; n < 2; ++n) e.store4(row, u.pn * 256 + bj * 128 + wc * 32 + n * 16 + 4 * fq, acc[ai][bj][m][n]); }
    }
};
template <int KSUB> struct EpiSlab {
    static constexpr bool PERM = false, AFTER_DRAIN = false; float* MT;
    __device__ __forceinline__ void operator()(const pg8::f32x4 (&acc)[2][2][4][2], const pg8::Unit& u, int wr, int wc, int fr, int fq) const {
        float* base = MT + ((size_t)(u.k0 / KSUB) * (RP - RMAIN) + (size_t)(u.pm * 256 - RMAIN)) * D + u.pn * 256 + wc * 32 + 4 * fq;
#pragma unroll
        for (int ai = 0; ai < 2; ++ai)
#pragma unroll
            for (int m = 0; m < 4; ++m) { float* rp = base + (size_t)(ai * 128 + wr * 64 + m * 16 + fr) * D;
#pragma unroll
                for (int bj = 0; bj < 2; ++bj)
#pragma unroll
                    for (int n = 0; n < 2; ++n) *(f32x4*)(rp + bj * 128 + n * 16) = acc[ai][bj][m][n]; }
    }
};
template <class E> struct EpiWrap8 {
    static constexpr bool PERM = true, AFTER_DRAIN = false; E e;
    __device__ __forceinline__ void operator()(const pg8::f32x4 (&acc)[2][2][4][2], const pg8::Unit& u, int wr, int wc, int fr, int fq) const {
#pragma unroll
        for (int ai = 0; ai < 2; ++ai)
#pragma unroll
            for (int m = 0; m < 4; ++m) { const int row = u.pm * 256 + ai * 128 + wr * 64 + m * 16 + fr;
#pragma unroll
                for (int bj = 0; bj < 2; ++bj) e.store8(row, u.pn * 256 + bj * 128 + wc * 32 + 8 * fq, acc[ai][bj][m][0], acc[ai][bj][m][1]); }
    }
};
template <class E>
__device__ __forceinline__ void gemm_mfma8(const bf16* A, const bf16* Bt, int M, int N, int K, const E& e, LAS unsigned char* lds, int wave) {
    pg8::Gemm g{A, Bt, M, N, K, K}; pg8::StaticOrder S; S.init(M, N, (int)gridDim.x, (int)blockIdx.x);
    EpiWrap8<E> W{e};
    pg8::gemm_phase<EpiWrap8<E>, pg8::StaticOrder, true, true>(lds, g, S, W, wave);
}
template <class E>
__device__ __forceinline__ void gemm_mfma(const bf16* A, const bf16* Bt, int M, int N, int K, const E& e, LAS unsigned char* lds, int wave) {
    pg8::Gemm g{A, Bt, M, N, K, K}; pg8::StaticOrder S; S.init(M, N, (int)gridDim.x, (int)blockIdx.x);
    EpiWrap<E> W{e};
    pg8::gemm_phase<EpiWrap<E>, pg8::StaticOrder, true, true>(lds, g, S, W, wave);
}
template <int SPLIT, int NN, int KSUB, int PM0, int NUNITS> struct TailOrder {
    int G, c;
    __device__ __forceinline__ bool next(int i, pg8::Unit& u) const { const int L = i * G + c; if (L >= NUNITS) return false; const int ks = L % SPLIT, t = L / SPLIT; u.pn = t % NN; u.pm = PM0 + t / NN; u.k0 = ks * KSUB; u.prob = 0; u.aoff = 0; u.boff = 0; return true; }
    __device__ __forceinline__ void a_ready(const pg8::Unit&) const {}
    __device__ __forceinline__ void done(const pg8::Unit&) const {}
};
struct EpiAtomicF32 { float* C; int ldc; __device__ __forceinline__ void store4(int row, int col, f32x4 v) const { float* p = C + (size_t)row * ldc + col;
    __hip_atomic_fetch_add(p, v.x, __ATOMIC_RELAXED, __HIP_MEMORY_SCOPE_AGENT); __hip_atomic_fetch_add(p + 1, v.y, __ATOMIC_RELAXED, __HIP_MEMORY_SCOPE_AGENT);
    __hip_atomic_fetch_add(p + 2, v.z, __ATOMIC_RELAXED, __HIP_MEMORY_SCOPE_AGENT); __hip_atomic_fetch_add(p + 3, v.w, __ATOMIC_RELAXED, __HIP_MEMORY_SCOPE_AGENT); } };
template <int K, int SPLIT>
__device__ __forceinline__ void gemm_n1024_tail(const bf16* A, const bf16* Bt, bf16* C, float* MT, LAS unsigned char* lds, int wave) {
    { pg8::Gemm g{A, Bt, RMAIN, D, K, K}; pg8::StaticOrder S; S.init(RMAIN, D, (int)gridDim.x, (int)blockIdx.x); EpiWrap8<EpiBf16> W{EpiBf16{C, D}};
      pg8::gemm_phase<EpiWrap8<EpiBf16>, pg8::StaticOrder, true, true>(lds, g, S, W, wave); }
    { typedef TailOrder<SPLIT, D / 256, K / SPLIT, RMAIN / 256, (RP - RMAIN) / 256 * (D / 256) * SPLIT> TO;
      pg8::Gemm g{A, Bt, RP, D, K / SPLIT, K}; TO S{(int)gridDim.x, (int)blockIdx.x}; EpiSlab<K / SPLIT> W{MT};
      pg8::gemm_phase<EpiSlab<K / SPLIT>, TO, false, true>(lds, g, S, W, wave); }
}

struct P3Order {
    int G, c;
    static constexpr int NQ = (RP / 256) * (NUQ / 256), NL = (DB * DS / 256) * (NH * KVL / 256), NK = (RP / 256) * (NUKV / 256);
    __device__ __forceinline__ bool next(int i, pg8::Unit& u) const {
        int L = i * G + c; u.k0 = 0;
        if (L < NK) { u.prob = 2; u.pm = L / (NUKV / 256); u.pn = L % (NUKV / 256); u.aoff = (long)(WS_CKVN - WS_CQN); u.boff = (long)(WS_WUKV - WS_WUQ); return true; } L -= NK;
        if (L < NQ) { u.prob = 0; u.pm = L / (NUQ / 256); u.pn = L % (NUQ / 256); u.aoff = 0; u.boff = 0; return true; } L -= NQ;
        if (L < NL) { u.prob = 1; u.pm = L / (NH * KVL / 256); u.pn = L % (NH * KVL / 256); u.aoff = (long)RSAMP0 * QL * 2; u.boff = (long)(WS_WUQL - WS_WUQ); return true; }
        return false;
    }
    __device__ __forceinline__ void a_ready(const pg8::Unit&) const {}
    __device__ __forceinline__ void done(const pg8::Unit&) const {}
};
struct EpiP3 {
    static constexpr bool PERM = true, AFTER_DRAIN = false; EpiQ eq; EpiBf16S el; EpiBf16 ek;
    __device__ __forceinline__ void operator()(const pg8::f32x4 (&acc)[2][2][4][2], const pg8::Unit& u, int wr, int wc, int fr, int fq) const {
        asm volatile("" : "+v"(fr), "+v"(fq));
        if (u.prob == 0) { EpiWrap8<EpiQ> w{eq}; w(acc, u, wr, wc, fr, fq); }
        else if (u.prob == 1) { EpiWrap8<EpiBf16S> w{el}; w(acc, u, wr, wc, fr, fq); }
        else { EpiWrap8<EpiBf16> w{ek}; w(acc, u, wr, wc, fr, fq); }
    }
};
__device__ __forceinline__ void gemm_p3(ArgsP a, LAS unsigned char* lds, int wave) {
    pg8::Gemm g{WSB(WS_CQN), WSB(WS_WUQ), RP, NUQ, QL, QL}; P3Order S{(int)gridDim.x, (int)blockIdx.x};
    EpiP3 E{EpiQ{WSB(WS_QN), WSB(WS_QPE), WSF(WS_ROPE)}, EpiBf16S{WSB(WS_QLAT), NH * KVL, QSCALE}, EpiBf16{WSB(WS_KNV), NUKV}};
    pg8::gemm_phase<EpiP3, P3Order, false, true>(lds, g, S, E, wave);
}

struct EpiMlaIn {
    static constexpr bool PERM = false, AFTER_DRAIN = true;
    bf16 *CQN, *CKVN, *KPEB; const float *qg, *kg, *ROPE; float* out;
    __device__ __forceinline__ void fused(pg8::f32x4 (&acc)[2][2][4][2], const pg8::Unit& u, int wr, int wc, int fr, int fq, PG8_LAS unsigned char* lds, int wid, int lane) const {
        asm volatile("" : "+v"(fr), "+v"(fq));
        if (u.pn < 2) {
            PG8_LAS float* P = (PG8_LAS float*)lds;
            float s[2][4];
#pragma unroll
            for (int ai = 0; ai < 2; ++ai)
#pragma unroll
                for (int m = 0; m < 4; ++m) { float t = 0.f;
#pragma unroll
                    for (int bj = 0; bj < 2; ++bj)
#pragma unroll
                        for (int n = 0; n < 2; ++n) { const pg8::f32x4 x = acc[ai][bj][m][n]; t += (x[0] * x[0] + x[1] * x[1]) + (x[2] * x[2] + x[3] * x[3]); }
                    t += __shfl_xor(t, 16); t += __shfl_xor(t, 32);
                    if (fq == 0) P[(ai * 128 + wr * 64 + m * 16 + fr) * 4 + wc] = t; }
            asm volatile("s_waitcnt lgkmcnt(0)\n\ts_barrier" ::: "memory");
#pragma unroll
            for (int ai = 0; ai < 2; ++ai)
#pragma unroll
                for (int m = 0; m < 4; ++m) { const pg8::f32x4 p4 = *(const PG8_LAS pg8::f32x4*)(P + (ai * 128 + wr * 64 + m * 16 + fr) * 4); s[ai][m] = 1.0f / sqrtf(((p4[0] + p4[1]) + (p4[2] + p4[3])) * (1.f / 256) + EPS); }
            const float* g = u.pn == 0 ? qg : kg; bf16* dst = u.pn == 0 ? CQN : CKVN;
#pragma unroll
            for (int bj = 0; bj < 2; ++bj)
#pragma unroll
                for (int n = 0; n < 2; ++n) { const int col = bj * 128 + wc * 32 + n * 16 + 4 * fq; const pg8::f32x4 gv = *(const pg8::f32x4*)(g + col);
#pragma unroll
                    for (int ai = 0; ai < 2; ++ai)
#pragma unroll
                        for (int m = 0; m < 4; ++m) { const int row = u.pm * 256 + ai * 128 + wr * 64 + m * 16 + fr; if (row >= R) continue;
                            const pg8::f32x4 y = acc[ai][bj][m][n] * s[ai][m] * gv;
                            u32x2 o; o.x = pk2(y[0], y[1]); o.y = pk2(y[2], y[3]); *(u32x2*)(dst + (size_t)row * 256 + col) = o;
                            if (u.pn == 1) { const int pos = row_pos(row); float* oc = row < RSAMP0 ? out + O_CKVP + ((size_t)(row < RMAIN ? (row >> 12) : ((row - RMAIN) >> 4)) * TP + pos) * 256 : out + O_CKVS + (size_t)(row - RSAMP0) * 256;
                                *(pg8::f32x4*)(oc + col) = y; } } }
        } else if (wc == 0) {
#pragma unroll
            for (int ai = 0; ai < 2; ++ai)
#pragma unroll
                for (int m = 0; m < 4; ++m) { const int row = u.pm * 256 + ai * 128 + wr * 64 + m * 16 + fr; if (row >= R) continue;
                    const int pos = row_pos(row); const float* rt = ROPE + (size_t)row * 32 + 4 * fq; const pg8::f32x4 cs = *(const pg8::f32x4*)rt, sn = *(const pg8::f32x4*)(rt + 16);
                    const pg8::f32x4 x1 = acc[ai][0][m][0], x2 = acc[ai][0][m][1]; const pg8::f32x4 o1 = x1 * cs - x2 * sn, o2 = x1 * sn + x2 * cs;
                    float* ok = row < RSAMP0 ? out + O_KPEP + ((size_t)(row < RMAIN ? (row >> 12) : ((row - RMAIN) >> 4)) * TP + pos) * 32 : out + O_KPES + (size_t)(row - RSAMP0) * 32;
                    *(pg8::f32x4*)(ok + 4 * fq) = o1; *(pg8::f32x4*)(ok + 16 + 4 * fq) = o2;
                    u32x2 w; w.x = pk2(o1[0], o1[1]); w.y = pk2(o1[2], o1[3]); *(u32x2*)(KPEB + (size_t)row * 32 + 4 * fq) = w; w.x = pk2(o2[0], o2[1]); w.y = pk2(o2[2], o2[3]); *(u32x2*)(KPEB + (size_t)row * 32 + 16 + 4 * fq) = w; }
        }
    }
};
__device__ __forceinline__ void gemm_p1(ArgsP a, LAS unsigned char* lds, int wave) {
    pg8::Gemm g{WSB(WS_H), WSB(WS_WIN0), RP, NIN0, D, D}; pg8::StaticOrder S; S.init(RP, NIN0, (int)gridDim.x, (int)blockIdx.x);
    EpiMlaIn E{WSB(WS_CQN), WSB(WS_CKVN), WSB(WS_KPE), IN_F(12), IN_F(14), WSF(WS_ROPE), a->out};
    pg8::gemm_phase<EpiMlaIn, pg8::StaticOrder, false, true>(lds, g, S, E, wave);
}
#ifndef USE_NAIVE_ATTN
#define USE_NAIVE_ATTN 0
#endif
#ifndef USE_NAIVE_DECODE
#define USE_NAIVE_DECODE 0
#endif
#ifndef USE_NAIVE_GLA
#define USE_NAIVE_GLA 0
#endif
#ifndef PROBE
#define PROBE 0
#endif
#ifndef PROBE_LO
#define PROBE_LO -1
#define PROBE_HI -1
#endif
#ifndef USE_NAIVE_GEMM
#define USE_NAIVE_GEMM 0
#endif
#if USE_NAIVE_GEMM
#define GEMM(A, Bt, M, N, K, E) gemm_naive(A, Bt, M, N, K, E, lds, fresh_tid(c.wave))
#else
#define GEMM(A, Bt, M, N, K, E) gemm_mfma(A, Bt, M, N, K, E, lds, c.wave)
#endif


namespace att {
typedef short bf16x8 __attribute__((ext_vector_type(8)));
typedef short s16x4 __attribute__((ext_vector_type(4)));
typedef float f32x16 __attribute__((ext_vector_type(16)));
constexpr int KSLOT = 12288, VSLOT = 8192, LDS_K = 0, LDS_V = 2 * KSLOT, LDS_WS = LDS_V + 2 * VSLOT, LDS_OST = LDS_WS + 8 * 256, LDS_TOTAL = LDS_OST + 8 * 4096;
__device__ __forceinline__ int crow(int r, int hi) { return (r & 3) + 8 * (r >> 2) + 4 * hi; }
typedef float f32x2_t __attribute__((ext_vector_type(2))); typedef __bf16 bf16x2_t __attribute__((ext_vector_type(2)));
__device__ __forceinline__ unsigned cvtpk(float lo, float hi) { f32x2_t v = {lo, hi}; bf16x2_t b = __builtin_convertvector(v, bf16x2_t); return __builtin_bit_cast(unsigned, b); }
__device__ __forceinline__ s16x4 vtr(const LAS unsigned char* p) { typedef short v4i16_t __attribute__((ext_vector_type(4))); return __builtin_bit_cast(s16x4, __builtin_amdgcn_ds_read_tr16_b64_v4i16((LAS v4i16_t*)p)); }
__device__ __forceinline__ float pmax32(float m) { auto rr = __builtin_amdgcn_permlane32_swap(__float_as_uint(m), __float_as_uint(m), false, false); return fmaxf(__uint_as_float(rr[0]), __uint_as_float(rr[1])); }
__device__ __forceinline__ float psum32(float m) { auto rr = __builtin_amdgcn_permlane32_swap(__float_as_uint(m), __float_as_uint(m), false, false); return __uint_as_float(rr[0]) + __uint_as_float(rr[1]); }
#define ATT_WAIT_BAR() asm volatile("s_waitcnt vmcnt(0) lgkmcnt(0)\n\ts_barrier" ::: "memory")
__device__ __forceinline__ void glds16(const void* gsrc, unsigned lds_dst) { unsigned keep;
    asm volatile("s_mov_b32 %0, m0\n\ts_mov_b32 m0, %2\n\ts_nop 0\n\tglobal_load_lds_dwordx4 %1, off\n\ts_mov_b32 m0, %0" : "=&s"(keep) : "v"(gsrc), "s"(lds_dst) : "memory"); }

__device__ __forceinline__ void attn_unit(int b, int h, int qb, const bf16* QN, const bf16* QPE, const bf16* KNV, const bf16* KPE, bf16* O, LAS unsigned char* lds, int wave_id) {
    const int tid = fresh_tid(wave_id), lane = tid & 63, r32 = lane & 31, hi = lane >> 5; const int wid = wave_id;
    const int rowbase = b * SEQ, q0 = qb * 256, qrow = rowbase + q0 + wid * 32 + r32, qrel = q0 + wid * 32 + r32;
    bf16x8 qr[6];
#pragma unroll
    for (int d0 = 0; d0 < 4; ++d0) qr[d0] = *(const bf16x8*)(QN + (size_t)qrow * 1024 + h * 64 + d0 * 16 + hi * 8);
#pragma unroll
    for (int d0 = 0; d0 < 2; ++d0) qr[4 + d0] = *(const bf16x8*)(QPE + (size_t)qrow * 512 + h * 32 + d0 * 16 + hi * 8);
    LAS float* wsf = (LAS float*)(lds + LDS_WS) + wid * 64;
    const int NT = 4 * qb + 4;
#define ATT_DMA(t, slot) do { const size_t row0_ = (t) == 0 ? (size_t)(RMAIN + 16 * b) : (size_t)(rowbase + 64 * ((t) - 1)); \
        __builtin_amdgcn_global_load_lds((const unsigned*)(KNV + (row0_ + lane) * 2048 + h * 64 + wid * 8), (LAS unsigned*)(lds + LDS_K + (slot) * KSLOT + wid * 1024), 16, 0, 0); \
        if (wid < 4) __builtin_amdgcn_global_load_lds((const unsigned*)(KPE + (row0_ + lane) * 32 + wid * 8), (LAS unsigned*)(lds + LDS_K + (slot) * KSLOT + (8 + wid) * 1024), 16, 0, 0); \
        __builtin_amdgcn_global_load_lds((const unsigned*)(KNV + (row0_ + 16 * (wid & 3) + (lane >> 2)) * 2048 + 1024 + h * 64 + (wid >> 2) * 32 + (lane & 3) * 8), (LAS unsigned*)(lds + LDS_V + (slot) * VSLOT + wid * 1024), 16, 0, 0); } while (0)
    f32x16 o[2]; o[0] = f32x16{}; o[1] = f32x16{};
    float mref = -INFINITY, l = 0.f;
    ATT_DMA(0, 0);
    for (int t = 0; t <= NT; ++t) {
        ATT_WAIT_BAR();
        const int slot = t & 1;
        if (t < NT) ATT_DMA(t + 1, slot ^ 1);
        const int kt0 = 64 * (t - 1);
        if (t > 0 && kt0 > q0 + wid * 32 + 31) continue;
        f32x16 p0 = f32x16{}, p1 = f32x16{};
        const LAS unsigned char* kb = lds + LDS_K + slot * KSLOT + hi * 1024 + r32 * 16;
#pragma unroll
        for (int d0 = 0; d0 < 6; ++d0) {
            const bf16x8 b0 = *(const LAS bf16x8*)(kb + d0 * 2048), b1 = *(const LAS bf16x8*)(kb + d0 * 2048 + 512);
            p0 = __builtin_amdgcn_mfma_f32_32x32x16_bf16(b0, qr[d0], p0, 0, 0, 0);
            p1 = __builtin_amdgcn_mfma_f32_32x32x16_bf16(b1, qr[d0], p1, 0, 0, 0);
        }
        if (t == 0) {
#pragma unroll
            for (int r = 0; r < 16; ++r) { if (crow(r, hi) >= NMETA) p0[r] = -INFINITY; p1[r] = -INFINITY; }
        } else if (kt0 + 63 > q0 + wid * 32) {
#pragma unroll
            for (int r = 0; r < 16; ++r) { const int kv = kt0 + crow(r, hi); if (kv > qrel) p0[r] = -INFINITY; if (kv + 32 > qrel) p1[r] = -INFINITY; }
        }
        float rm = fmaxf(p0[0], p1[0]);
#pragma unroll
        for (int r = 1; r < 16; ++r) rm = fmaxf(rm, fmaxf(p0[r], p1[r]));
        rm = pmax32(rm);
        if (__any(rm > mref + 8.0f)) {
            const float mnew = fmaxf(mref, rm); const float f = __builtin_amdgcn_exp2f(mref - mnew);
            mref = mnew; l *= f;
            if (hi == 0) wsf[r32] = f;
            LDS_WAIT();
#pragma unroll
            for (int r = 0; r < 16; ++r) { const float fr = wsf[crow(r, hi)]; o[0][r] *= fr; o[1][r] *= fr; }
        }
        float sacc = 0.f;
#pragma unroll
        for (int r = 0; r < 16; ++r) { p0[r] = __builtin_amdgcn_exp2f(p0[r] - mref); p1[r] = __builtin_amdgcn_exp2f(p1[r] - mref); sacc += p0[r] + p1[r]; }
        l += sacc;
        u32x4 pw[4];
#pragma unroll
        for (int i = 0; i < 4; ++i) { pw[0][i] = cvtpk(p0[2 * i], p0[2 * i + 1]); pw[1][i] = cvtpk(p0[8 + 2 * i], p0[8 + 2 * i + 1]); pw[2][i] = cvtpk(p1[2 * i], p1[2 * i + 1]); pw[3][i] = cvtpk(p1[8 + 2 * i], p1[8 + 2 * i + 1]); }
        const LAS unsigned char* vb = lds + LDS_V + slot * VSLOT + ((lane >> 4) & 1) * 32 + (lane & 3) * 8 + (4 * hi + ((lane & 15) >> 2)) * 64;
#pragma unroll
        for (int d0 = 0; d0 < 2; ++d0)
#pragma unroll
            for (int ks = 0; ks < 4; ++ks) {
                const s16x4 vlo = vtr(vb + d0 * 4096 + ks * 1024), vhi = vtr(vb + d0 * 4096 + ks * 1024 + 512);
                const bf16x8 vf = (bf16x8){vlo[0], vlo[1], vlo[2], vlo[3], vhi[0], vhi[1], vhi[2], vhi[3]};
                o[d0] = __builtin_amdgcn_mfma_f32_32x32x16_bf16(__builtin_bit_cast(bf16x8, pw[ks]), vf, o[d0], 0, 0, 0);
            }
    }
    l = psum32(l);
    if (hi == 0) wsf[32 + r32] = l;
    LDS_WAIT();
    bf16* Ow = O + (size_t)(rowbase + q0 + wid * 32) * 1024 + h * 64;
    LAS bf16* stg = (LAS bf16*)(lds + LDS_OST) + wid * 2048;
#pragma unroll
    for (int r = 0; r < 16; ++r) { const int orow = crow(r, hi); const float il = 1.0f / wsf[32 + orow];
        stg[orow * 64 + r32] = (bf16)f2bf(o[0][r] * il); stg[orow * 64 + 32 + r32] = (bf16)f2bf(o[1][r] * il); }
    LDS_WAIT();
#pragma unroll
    for (int i = 0; i < 4; ++i) { const int row = i * 8 + (lane >> 3), ch = lane & 7; const u32x4 v = *(const LAS u32x4*)(stg + row * 64 + ch * 8); *(u32x4*)(Ow + (size_t)row * 1024 + ch * 8) = v; }
    ATT_WAIT_BAR();
#undef ATT_DMA
}
constexpr int P_LDS_K = 0, P_LDS_V = 3 * KSLOT, P_LDS_WS = P_LDS_V + 2 * VSLOT, P_LDS_OST = P_LDS_WS + 8 * 256, P_LDS_TOTAL = P_LDS_OST + 8 * 4096;
__device__ __forceinline__ void attn_unit2(int b, int h, int qb, const bf16* QN, const bf16* QPE, const bf16* KNV, const bf16* KPE, bf16* O, LAS unsigned char* lds, int wave_id) {
    const int tid = fresh_tid(wave_id), lane = tid & 63, r32 = lane & 31, hi = lane >> 5; const int wid = wave_id;
    const bool meta = qb < 0;
    const int rowbase = b * SEQ, q0 = meta ? 0 : qb * 256, qrow = meta ? RMAIN + 16 * b + (r32 & 15) : rowbase + q0 + wid * 32 + r32, qrel = meta ? (r32 & 15) : q0 + wid * 32 + r32;
    bf16x8 qr[6];
#pragma unroll
    for (int d0 = 0; d0 < 4; ++d0) qr[d0] = *(const bf16x8*)(QN + (size_t)qrow * 1024 + h * 64 + d0 * 16 + hi * 8);
#pragma unroll
    for (int d0 = 0; d0 < 2; ++d0) qr[4 + d0] = *(const bf16x8*)(QPE + (size_t)qrow * 512 + h * 32 + d0 * 16 + hi * 8);
    LAS float* wsf = (LAS float*)(lds + P_LDS_WS) + wid * 64;
    const unsigned lds0 = (unsigned)(size_t)lds;
    const int NT = meta ? 0 : 4 * qb + 4;
#define A2_ROW0(t) ((t) == 0 ? (size_t)(RMAIN + 16 * b) : (size_t)(rowbase + 64 * ((t) - 1)))
#define A2_DMA_K(t, ks) do { const size_t row0_ = A2_ROW0(t); \
        glds16(KNV + (row0_ + lane) * 2048 + h * 64 + wid * 8, (unsigned)__builtin_amdgcn_readfirstlane((int)(lds0 + P_LDS_K + (ks) * KSLOT + wid * 1024))); \
        if (wid < 4) glds16(KPE + (row0_ + lane) * 32 + wid * 8, (unsigned)__builtin_amdgcn_readfirstlane((int)(lds0 + P_LDS_K + (ks) * KSLOT + (8 + wid) * 1024))); } while (0)
#define A2_DMA_V(t, vs) do { const size_t row0_ = A2_ROW0(t); \
        glds16(KNV + (row0_ + 16 * (wid & 3) + (lane >> 2)) * 2048 + 1024 + h * 64 + (wid >> 2) * 32 + (lane & 3) * 8, (unsigned)__builtin_amdgcn_readfirstlane((int)(lds0 + P_LDS_V + (vs) * VSLOT + wid * 1024))); } while (0)
#define A2_QKT(P0, P1, ks) do { P0 = f32x16{}; P1 = f32x16{}; const LAS unsigned char* kb_ = lds + P_LDS_K + (ks) * KSLOT + hi * 1024 + r32 * 16; \
        _Pragma("unroll") for (int d0 = 0; d0 < 6; ++d0) { const bf16x8 b0_ = *(const LAS bf16x8*)(kb_ + d0 * 2048), b1_ = *(const LAS bf16x8*)(kb_ + d0 * 2048 + 512); \
            P0 = __builtin_amdgcn_mfma_f32_32x32x16_bf16(b0_, qr[d0], P0, 0, 0, 0); P1 = __builtin_amdgcn_mfma_f32_32x32x16_bf16(b1_, qr[d0], P1, 0, 0, 0); } } while (0)
    f32x16 o[2]; o[0] = f32x16{}; o[1] = f32x16{};
    float mref = -INFINITY, l = 0.f;
#define A2_TILE(P0, P1, t, vs) do { \
        if ((t) == 0) { const int qlim_ = meta ? (r32 & 15) : NMETA - 1; _Pragma("unroll") for (int r = 0; r < 16; ++r) { if (crow(r, hi) > qlim_) P0[r] = -INFINITY; P1[r] = -INFINITY; } } \
        else { const int kt0_ = 64 * ((t) - 1); if (kt0_ + 63 > q0 + wid * 32) { _Pragma("unroll") for (int r = 0; r < 16; ++r) { const int kv = kt0_ + crow(r, hi); if (kv > qrel) P0[r] = -INFINITY; if (kv + 32 > qrel) P1[r] = -INFINITY; } } } \
        float rm_ = fmaxf(P0[0], P1[0]); \
        _Pragma("unroll") for (int r = 1; r < 16; ++r) rm_ = fmaxf(rm_, fmaxf(P0[r], P1[r])); \
        rm_ = pmax32(rm_); \
        if (__any(rm_ > mref + 8.0f)) { const float mnew = fmaxf(mref, rm_); const float f = __builtin_amdgcn_exp2f(mref - mnew); mref = mnew; l *= f; \
            if (hi == 0) wsf[r32] = f; LDS_WAIT(); \
            _Pragma("unroll") for (int r = 0; r < 16; ++r) { const float fr = wsf[crow(r, hi)]; o[0][r] *= fr; o[1][r] *= fr; } } \
        float sacc_ = 0.f; \
        _Pragma("unroll") for (int r = 0; r < 16; ++r) { P0[r] = __builtin_amdgcn_exp2f(P0[r] - mref); P1[r] = __builtin_amdgcn_exp2f(P1[r] - mref); sacc_ += P0[r] + P1[r]; } \
        l += sacc_; \
        u32x4 pw_[4]; \
        _Pragma("unroll") for (int i = 0; i < 4; ++i) { pw_[0][i] = cvtpk(P0[2 * i], P0[2 * i + 1]); pw_[1][i] = cvtpk(P0[8 + 2 * i], P0[8 + 2 * i + 1]); pw_[2][i] = cvtpk(P1[2 * i], P1[2 * i + 1]); pw_[3][i] = cvtpk(P1[8 + 2 * i], P1[8 + 2 * i + 1]); } \
        const LAS unsigned char* vb_ = lds + P_LDS_V + (vs) * VSLOT + ((lane >> 4) & 1) * 32 + (lane & 3) * 8 + (4 * hi + ((lane & 15) >> 2)) * 64; \
        _Pragma("unroll") for (int d0 = 0; d0 < 2; ++d0) _Pragma("unroll") for (int ks = 0; ks < 4; ++ks) { \
            const s16x4 vlo = vtr(vb_ + d0 * 4096 + ks * 1024), vhi = vtr(vb_ + d0 * 4096 + ks * 1024 + 512); \
            const bf16x8 vf = (bf16x8){vlo[0], vlo[1], vlo[2], vlo[3], vhi[0], vhi[1], vhi[2], vhi[3]}; \
            o[d0] = __builtin_amdgcn_mfma_f32_32x32x16_bf16(__builtin_bit_cast(bf16x8, pw_[ks]), vf, o[d0], 0, 0, 0); } } while (0)
    f32x16 pA0, pA1, pB0, pB1;
    A2_DMA_K(0, 0); A2_DMA_V(0, 0); if (NT >= 1) A2_DMA_K(1, 1);
    ATT_WAIT_BAR();
    A2_QKT(pA0, pA1, 0);
    int kc = 0, vc = 0, t = 0;
#define A2_STEP(PC0, PC1, PN0, PN1) do { \
        if (t > 0) ATT_WAIT_BAR(); \
        const int kn_ = kc == 2 ? 0 : kc + 1, k2_ = kn_ == 2 ? 0 : kn_ + 1; \
        if (t + 2 <= NT) A2_DMA_K(t + 2, k2_); \
        if (t + 1 <= NT) { A2_DMA_V(t + 1, vc ^ 1); A2_QKT(PN0, PN1, kn_); } \
        A2_TILE(PC0, PC1, t, vc); \
        kc = kn_; vc ^= 1; ++t; } while (0)
    while (t + 1 <= NT) { A2_STEP(pA0, pA1, pB0, pB1); A2_STEP(pB0, pB1, pA0, pA1); }
    A2_STEP(pA0, pA1, pB0, pB1);
    l = psum32(l);
    if (hi == 0) wsf[32 + r32] = l;
    LDS_WAIT();
    bf16* Ow = O + (size_t)(meta ? RMAIN + 16 * b : rowbase + q0 + wid * 32) * 1024 + h * 64;
    LAS bf16* stg = (LAS bf16*)(lds + P_LDS_OST) + wid * 2048;
#pragma unroll
    for (int r = 0; r < 16; ++r) { const int orow = crow(r, hi); const float il = 1.0f / wsf[32 + orow];
        stg[orow * 64 + r32] = (bf16)f2bf(o[0][r] * il); stg[orow * 64 + 32 + r32] = (bf16)f2bf(o[1][r] * il); }
    LDS_WAIT();
#pragma unroll
    for (int i = 0; i < 4; ++i) { const int row = i * 8 + (lane >> 3), ch = lane & 7; const u32x4 v = *(const LAS u32x4*)(stg + row * 64 + ch * 8); if (!meta || (wid == 0 && row < NMETA)) *(u32x4*)(Ow + (size_t)row * 1024 + ch * 8) = v; }
    ATT_WAIT_BAR();
#undef A2_ROW0
#undef A2_DMA_K
#undef A2_DMA_V
#undef A2_QKT
#undef A2_TILE
#undef A2_STEP
}
__device__ __forceinline__ void attn_phase(const bf16* QN, const bf16* QPE, const bf16* KNV, const bf16* KPE, bf16* O, LAS unsigned char* lds, int wave_id) {
    const int G = gridDim.x, bx = blockIdx.x; const int vcu = (G % 8 == 0) ? (bx % 8) * (G / 8) + bx / 8 : bx;
    for (int v = vcu; v < NB * NH * 4; v += G) {
        const int bh = v >> 2, s0 = v & 3;
#pragma unroll 1
        for (int i = 0; i < 4; ++i) { const int qb = (i == 0) ? 15 - s0 : (i == 1) ? 11 - s0 : (i == 2) ? 4 + s0 : s0; attn_unit2(bh >> 4, bh & 15, qb, QN, QPE, KNV, KPE, O, lds, wave_id); }
        if (v < NB * NH) attn_unit2(v >> 4, v & 15, -1, QN, QPE, KNV, KPE, O, lds, wave_id);
    }
}
}


namespace dec {
using att::bf16x8; using att::s16x4; using att::f32x16; using att::crow; using att::cvtpk; using att::vtr; using att::pmax32; using att::psum32;
constexpr int KST = 592, KBUF = 64 * KST, LDS_K = 0, LDS_Q = 2 * KBUF, LDS_WS = LDS_Q + 64 * KST, LDS_TOTAL = LDS_WS + 8 * 256;
constexpr int NSTAGE = 64;
__device__ __forceinline__ void decode_unit(int db, int sp, ArgsP a, LAS unsigned char* lds, int wave_id) {
    const int tid = fresh_tid(wave_id), lane = tid & 63, r32 = lane & 31, hi = lane >> 5; const int wid = wave_id;
    const int qh = wid & 1, kh = (wid >> 1) & 1, dh = wid >> 2;
    const float* cckv = IN_F(2); const float* ckpe = IN_F(3); const int* pt = (const int*)a->in[5] + db * NPAGES + sp * 32;
    for (int i = tid; i < 64 * 36; i += 512) { const int q = i / 36, ch = i % 36, t = q >> 4, h = q & 15;
        const bf16* src = ch < 32 ? WSB(WS_QLAT) + ((size_t)(db * 4 + t) * 16 + h) * 256 + ch * 8 : WSB(WS_QPE) + (size_t)(RSAMP0 + db * 4 + t) * 512 + h * 32 + (ch - 32) * 8;
        *(LAS u32x4*)(lds + LDS_Q + q * KST + ch * 16) = *(const u32x4*)src; }
    f32x4 cv[8], kv;
#define DEC_LOAD(s) do { const int page_ = __builtin_amdgcn_readfirstlane(pt[(s) >> 1]); const size_t k0_ = (size_t)page_ * PAGE + ((s) & 1) * 64; \
        _Pragma("unroll") for (int j = 0; j < 8; ++j) cv[j] = __builtin_nontemporal_load((const f32x4*)(cckv + (k0_ + wid + 8 * j) * 256 + 4 * lane));     \
        kv = __builtin_nontemporal_load((const f32x4*)(ckpe + (k0_ + (tid >> 3)) * 32 + 4 * (tid & 7))); } while (0)
#define DEC_WRITE(buf) do { LAS unsigned char* kb_ = lds + LDS_K + (buf) * KBUF; \
        _Pragma("unroll") for (int j = 0; j < 8; ++j) { u32x2 w_; w_.x = cvtpk(cv[j].x, cv[j].y); w_.y = cvtpk(cv[j].z, cv[j].w); *(LAS u32x2*)(kb_ + (wid + 8 * j) * KST + lane * 8) = w_; } \
        { u32x2 w_; w_.x = cvtpk(kv.x, kv.y); w_.y = cvtpk(kv.z, kv.w); *(LAS u32x2*)(kb_ + (tid >> 3) * KST + 512 + (tid & 7) * 8) = w_; } } while (0)
    LAS float* wsf = (LAS float*)(lds + LDS_WS) + wid * 64;
    f32x16 o[4]; o[0] = f32x16{}; o[1] = f32x16{}; o[2] = f32x16{}; o[3] = f32x16{};
    float mref = -INFINITY, l = 0.f;
#define DEC_BAR() asm volatile("s_waitcnt lgkmcnt(0)\n\ts_barrier" ::: "memory")
    DEC_LOAD(0); DEC_WRITE(0); DEC_LOAD(1);
    DEC_BAR();
    bf16x8 qf[18];
    { const LAS unsigned char* qb = lds + LDS_Q + (qh * 32 + r32) * KST + hi * 16;
#pragma unroll
      for (int s2 = 0; s2 < 18; ++s2) qf[s2] = *(const LAS bf16x8*)(qb + s2 * 32); }
    for (int s = 0; s < NSTAGE; ++s) {
        const int buf = s & 1;
        const LAS unsigned char* kimg = lds + LDS_K + buf * KBUF;
        f32x16 p = f32x16{};
        { const LAS unsigned char* kb = kimg + (kh * 32 + r32) * KST + hi * 16;
#pragma unroll
          for (int s2 = 0; s2 < 18; ++s2) p = __builtin_amdgcn_mfma_f32_32x32x16_bf16(*(const LAS bf16x8*)(kb + s2 * 32), qf[s2], p, 0, 0, 0); }
        float rm = p[0];
#pragma unroll
        for (int r = 1; r < 16; ++r) rm = fmaxf(rm, p[r]);
        rm = pmax32(rm);
        if (__any(rm > mref + 8.0f)) {
            const float mnew = fmaxf(mref, rm); const float f = __builtin_amdgcn_exp2f(mref - mnew);
            mref = mnew; l *= f;
            if (hi == 0) wsf[r32] = f;
            LDS_WAIT();
#pragma unroll
            for (int r = 0; r < 16; ++r) { const float fr = wsf[crow(r, hi)]; o[0][r] *= fr; o[1][r] *= fr; o[2][r] *= fr; o[3][r] *= fr; }
        }
        float sacc = 0.f;
#pragma unroll
        for (int r = 0; r < 16; ++r) { p[r] = __builtin_amdgcn_exp2f(p[r] - mref); sacc += p[r]; }
        l += sacc;
        u32x4 pw[2];
#pragma unroll
        for (int i = 0; i < 4; ++i) { pw[0][i] = cvtpk(p[2 * i], p[2 * i + 1]); pw[1][i] = cvtpk(p[8 + 2 * i], p[8 + 2 * i + 1]); }
        const LAS unsigned char* vb = kimg + (kh * 32 + 4 * hi + ((lane & 15) >> 2)) * KST + (dh * 128 + 16 * ((lane >> 4) & 1) + 4 * (lane & 3)) * 2;
#pragma unroll
        for (int dt = 0; dt < 4; ++dt)
#pragma unroll
            for (int ks = 0; ks < 2; ++ks) {
                const s16x4 vlo = vtr(vb + (ks * 16) * KST + dt * 64), vhi = vtr(vb + (ks * 16 + 8) * KST + dt * 64);
                const bf16x8 vf = (bf16x8){vlo[0], vlo[1], vlo[2], vlo[3], vhi[0], vhi[1], vhi[2], vhi[3]};
                o[dt] = __builtin_amdgcn_mfma_f32_32x32x16_bf16(__builtin_bit_cast(bf16x8, pw[ks]), vf, o[dt], 0, 0, 0);
            }
        if (s + 1 < NSTAGE) { DEC_WRITE(buf ^ 1); if (s + 2 < NSTAGE) DEC_LOAD(s + 2); }
        DEC_BAR();
    }
#undef DEC_BAR
    const int part = (db * 2 + sp) * 2 + kh;
    float* op = WSF(WS_OPART) + (size_t)part * 64 * 256;
#pragma unroll
    for (int dt = 0; dt < 4; ++dt)
#pragma unroll
        for (int r = 0; r < 16; ++r) op[(size_t)(qh * 32 + crow(r, hi)) * 256 + dh * 128 + dt * 32 + r32] = o[dt][r];
    l = psum32(l);
    if (dh == 0 && hi == 0) { float* mp = WSF(WS_MLP) + (size_t)part * 128 + (qh * 32 + r32) * 2; mp[0] = mref; mp[1] = l; }
#undef DEC_LOAD
#undef DEC_WRITE
}
struct LaneCtx { int lane, wave; };
__device__ __forceinline__ void combine_item(ArgsP a, int db, int h, const LaneCtx c, LAS unsigned char* lds) {
    {
        f32x4 cn[4]; float en[4];
#pragma unroll
        for (int s2 = 0; s2 < 4; ++s2) { const int kr = RSAMP0 + db * 4 + s2;
            const u32x2 v = *(const u32x2*)(WSB(WS_CKVN) + (size_t)kr * 256 + 4 * c.lane); cn[s2] = (f32x4){bflo(v.x), bfhi(v.x), bflo(v.y), bfhi(v.y)};
            en[s2] = c.lane < 32 ? bf2f(WSB(WS_KPE)[(size_t)kr * 32 + c.lane]) : 0.f; }
        f32x4 res[4];
#pragma unroll
        for (int t = 0; t < 4; ++t) {
            const int i = db * 4 + t, q = t * 16 + h;
            const u32x2 qv = *(const u32x2*)(WSB(WS_QLAT) + ((size_t)i * 16 + h) * 256 + 4 * c.lane); const f32x4 ql = (f32x4){bflo(qv.x), bfhi(qv.x), bflo(qv.y), bfhi(qv.y)};
            const float qp = c.lane < 32 ? bf2f(WSB(WS_QPE)[(size_t)(RSAMP0 + i) * 512 + h * 32 + c.lane]) : 0.f;
            float mp[4], lp[4], dn[4]; float mg = -INFINITY;
#pragma unroll
            for (int p = 0; p < 4; ++p) { const float* ml = WSF(WS_MLP) + (size_t)(db * 4 + p) * 128 + q * 2; mp[p] = ml[0]; lp[p] = ml[1]; mg = fmaxf(mg, mp[p]); }
#pragma unroll
            for (int s2 = 0; s2 < 4; ++s2) {
                float d = (ql.x * cn[s2].x + ql.y * cn[s2].y) + (ql.z * cn[s2].z + ql.w * cn[s2].w) + qp * en[s2];
                d = wave_sum(d); dn[s2] = s2 <= t ? d : -INFINITY; mg = fmaxf(mg, dn[s2]);
            }
            f32x4 acc = (f32x4){0.f, 0.f, 0.f, 0.f}; float L = 0.f;
#pragma unroll
            for (int p = 0; p < 4; ++p) { const float w = exp2f(mp[p] - mg); L += w * lp[p]; acc += w * *(const f32x4*)(WSF(WS_OPART) + ((size_t)(db * 4 + p) * 64 + q) * 256 + 4 * c.lane); }
#pragma unroll
            for (int s2 = 0; s2 < 4; ++s2) { const float w = exp2f(dn[s2] - mg); L += w; acc += w * cn[s2]; }
            res[t] = acc * (1.0f / L);
            __builtin_amdgcn_sched_barrier(0);
        }
        LAS bf16* rt = (LAS bf16*)(lds + 8 * 256 + c.wave * 2048);
#pragma unroll
        for (int t = 0; t < 4; ++t) { u32x2 w; w.x = pk2(res[t].x, res[t].y); w.y = pk2(res[t].z, res[t].w); *(LAS u32x2*)(rt + t * 256 + 4 * c.lane) = w; }
        LDS_WAIT();
        const int r32 = c.lane & 31, hi = c.lane >> 5;
        att::f32x16 o0 = att::f32x16{}, o1 = att::f32x16{};
        const bf16* wb = WSB(WS_WUKV) + (size_t)(1024 + h * 64 + r32) * 256 + 8 * hi;
#pragma unroll
        for (int s = 0; s < 16; ++s) {
            att::bf16x8 af = att::bf16x8{}; if (r32 < 4) af = *(const LAS att::bf16x8*)(rt + r32 * 256 + 16 * s + 8 * hi);
            const att::bf16x8 b0 = *(const att::bf16x8*)(wb + 16 * s), b1 = *(const att::bf16x8*)(wb + 32 * 256 + 16 * s);
            o0 = __builtin_amdgcn_mfma_f32_32x32x16_bf16(af, b0, o0, 0, 0, 0); o1 = __builtin_amdgcn_mfma_f32_32x32x16_bf16(af, b1, o1, 0, 0, 0);
        }
        if (hi == 0) {
#pragma unroll
            for (int t = 0; t < 4; ++t) { bf16* op = WSB(WS_O) + (size_t)(RSAMP0 + db * 4 + t) * 1024 + h * 64 + r32; op[0] = (bf16)f2bf(o0[t]); op[32] = (bf16)f2bf(o1[t]); }
        }
        LDS_WAIT();
    }
}
__device__ __forceinline__ void combine_phase(ArgsP a, const Ctx& c0, LAS unsigned char* lds) {
    const Ctx c = refresh(c0);
    for (int it = c.gw; it < DB * NH; it += c.ngw) combine_item(a, it >> 4, it & 15, LaneCtx{c.lane, c.wave}, lds);
}
__device__ __forceinline__ void decode_phase(ArgsP a, LAS unsigned char* lds, int wave_id) {
    for (int u = blockIdx.x; u < DB * 2; u += gridDim.x) { decode_unit(u >> 1, u & 1, a, lds, wave_id); __syncthreads(); }
}
}

__device__ __forceinline__ void p_side_tables(ArgsP a, const Ctx& c0, LAS unsigned char* lds, int wg0) {
    const Ctx c = refresh(c0);
    const int nwg = (int)gridDim.x - wg0, bx = (int)blockIdx.x - wg0;
    if (bx < 0) return;
    const int gt = (bx * 8 + c.wave) * 64 + c.lane, ngt = nwg * 512;
    {
        const int r32 = c.lane & 31, hi = c.lane >> 5;
        for (int it = bx * 8 + c.wave; it < NH * 64; it += nwg * 8) {
            const int h = it >> 6, ct = (it >> 3) & 7, kt = it & 7;
            const float* ap = IN_F(15) + (size_t)(ct * 32 + r32) * 1024 + h * 64 + 8 * hi;
            const float* bp = IN_F(13) + (size_t)(kt * 32 + r32) * 1536 + h * 96 + 8 * hi;
            att::f32x16 acc = att::f32x16{};
#pragma unroll
            for (int s = 0; s < 4; ++s) {
                const f32x4 a0 = *(const f32x4*)(ap + 16 * s), a1 = *(const f32x4*)(ap + 16 * s + 4), b0 = *(const f32x4*)(bp + 16 * s), b1 = *(const f32x4*)(bp + 16 * s + 4);
                const u32x4 aw = (u32x4){pk2(a0.x, a0.y), pk2(a0.z, a0.w), pk2(a1.x, a1.y), pk2(a1.z, a1.w)}, bw = (u32x4){pk2(b0.x, b0.y), pk2(b0.z, b0.w), pk2(b1.x, b1.y), pk2(b1.z, b1.w)};
                acc = __builtin_amdgcn_mfma_f32_32x32x16_bf16(__builtin_bit_cast(att::bf16x8, aw), __builtin_bit_cast(att::bf16x8, bw), acc, 0, 0, 0);
            }
            bf16* op = WSB(WS_WUQL) + (size_t)(h * 256 + ct * 32) * 256 + kt * 32 + r32;
#pragma unroll
            for (int r = 0; r < 16; ++r) op[(size_t)att::crow(r, hi) * 256] = (bf16)f2bf(acc[r]);
        }
    }
}
__device__ __forceinline__ void p_mla_mid(ArgsP a, const Ctx& c0) {
    const Ctx c = refresh(c0);
    const float* A1 = WSF(WS_A1); bf16* CQN = WSB(WS_CQN); bf16* CKVN = WSB(WS_CKVN); bf16* KPEB = WSB(WS_KPE); const float* ROPE = WSF(WS_ROPE); float* out = a->out;
    const f32x4 gq = *(const f32x4*)(IN_F(12) + 4 * c.lane), gk = *(const f32x4*)(IN_F(14) + 4 * c.lane);
    constexpr int NR = 4;
    for (int r0 = c.gw; r0 < R; r0 += NR * c.ngw) {
        f32x4 cq[NR], ck[NR]; float sq[NR], sk[NR], x1[NR], x2[NR], cs[NR], sn[NR];
#pragma unroll
        for (int q = 0; q < NR; ++q) { const int r = r0 + q * c.ngw < R ? r0 + q * c.ngw : r0; const float* row = A1 + (size_t)r * NIN0;
            cq[q] = *(const f32x4*)(row + 4 * c.lane); ck[q] = *(const f32x4*)(row + 256 + 4 * c.lane);
            const int j = c.lane & 15; x1[q] = row[512 + j]; x2[q] = row[528 + j]; cs[q] = ROPE[(size_t)r * 32 + j]; sn[q] = ROPE[(size_t)r * 32 + 16 + j];
            sq[q] = (cq[q].x * cq[q].x + cq[q].y * cq[q].y) + (cq[q].z * cq[q].z + cq[q].w * cq[q].w); sk[q] = (ck[q].x * ck[q].x + ck[q].y * ck[q].y) + (ck[q].z * ck[q].z + ck[q].w * ck[q].w); }
#pragma unroll
        for (int sh = 1; sh < 64; sh <<= 1) {
#pragma unroll
            for (int q = 0; q < NR; ++q) { sq[q] += __shfl_xor(sq[q], sh); sk[q] += __shfl_xor(sk[q], sh); } }
#pragma unroll
        for (int q = 0; q < NR; ++q) { const int r = r0 + q * c.ngw < R ? r0 + q * c.ngw : r0; const int pos = row_pos(r);
            const float rq = 1.0f / sqrtf(sq[q] * (1.f / 256) + EPS), rk = 1.0f / sqrtf(sk[q] * (1.f / 256) + EPS);
            const f32x4 qn = cq[q] * rq * gq, kn = ck[q] * rk * gk;
            u32x2 o; o.x = pk2(qn.x, qn.y); o.y = pk2(qn.z, qn.w); *(u32x2*)(CQN + (size_t)r * 256 + 4 * c.lane) = o;
            o.x = pk2(kn.x, kn.y); o.y = pk2(kn.z, kn.w); *(u32x2*)(CKVN + (size_t)r * 256 + 4 * c.lane) = o;
            float* ockv; float* okpe;
            if (r < RSAMP0) { const int b = r < RMAIN ? (r >> 12) : ((r - RMAIN) >> 4); ockv = out + O_CKVP + ((size_t)b * TP + pos) * 256; okpe = out + O_KPEP + ((size_t)b * TP + pos) * 32; }
            else { ockv = out + O_CKVS + (size_t)(r - RSAMP0) * 256; okpe = out + O_KPES + (size_t)(r - RSAMP0) * 32; }
            *(f32x4*)(ockv + 4 * c.lane) = kn;
            if (c.lane < 16) { const int j = c.lane; const float o1 = x1[q] * cs[q] - x2[q] * sn[q], o2 = x1[q] * sn[q] + x2[q] * cs[q]; okpe[j] = o1; okpe[16 + j] = o2;
                KPEB[(size_t)r * 32 + j] = (bf16)f2bf(o1); KPEB[(size_t)r * 32 + 16 + j] = (bf16)f2bf(o2); } }
    }
}
__device__ __forceinline__ void p_q_post(ArgsP a, const Ctx& c0) {
    const Ctx c = refresh(c0);
    for (int r = c.gw; r < R; r += c.ngw) {
        const float* row = WSF(WS_QRAW) + (size_t)r * NUQ; const int pos = row_pos(r);
        const float qs = QSCALE;
#pragma unroll
        for (int j = 0; j < 4; ++j) { const f32x4 v = *(const f32x4*)(row + 4 * c.lane + 256 * j) * qs; u32x2 o; o.x = pk2(v.x, v.y); o.y = pk2(v.z, v.w); *(u32x2*)(WSB(WS_QN) + (size_t)r * 1024 + 4 * c.lane + 256 * j) = o; }
#pragma unroll
        for (int j = 0; j < 4; ++j) { const int p = c.lane + 64 * j, h = p >> 4, jj = p & 15; const float x1 = row[1024 + 2 * p], x2 = row[1024 + 2 * p + 1]; float cs, sn; rope_cs(pos, jj, cs, sn);
            WSB(WS_QPE)[(size_t)r * 512 + h * 32 + jj] = (bf16)f2bf((x1 * cs - x2 * sn) * qs); WSB(WS_QPE)[(size_t)r * 512 + h * 32 + 16 + jj] = (bf16)f2bf((x1 * sn + x2 * cs) * qs); }
    }
}
__device__ __forceinline__ void p_qlat(ArgsP a, const Ctx& c0) {
    const Ctx c = refresh(c0);
    const float* wuk = IN_F(15);
    for (int it = c.gw; it < DB * DS * NH; it += c.ngw) {
        const int i = it >> 4, h = it & 15;
        const float q = WSF(WS_QRAW)[(size_t)(RSAMP0 + i) * NUQ + h * 64 + c.lane];
        float acc[4] = {0.f, 0.f, 0.f, 0.f};
#pragma unroll 8
        for (int n = 0; n < 64; ++n) { const float qn = __shfl(q, n);
#pragma unroll
            for (int k = 0; k < 4; ++k) acc[k] += qn * wuk[(size_t)(c.lane + 64 * k) * 1024 + h * 64 + n]; }
#pragma unroll
        for (int k = 0; k < 4; ++k) WSB(WS_QLAT)[((size_t)i * 16 + h) * 256 + c.lane + 64 * k] = (bf16)f2bf(acc[k] * QSCALE);
    }
}
template <bool META_ONLY>
__device__ __forceinline__ void p_attn_prompt_naive(ArgsP a, const Ctx& c0) {
    const Ctx c = refresh(c0);
    const bf16* QN = WSB(WS_QN); const bf16* QPE = WSB(WS_QPE); const bf16* KNV = WSB(WS_KNV); const bf16* KPE = WSB(WS_KPE);
    for (int item = c.gw + (META_ONLY ? (RMAIN / 64) * NH : 0); item < (RPROMPT / 64) * NH; item += c.ngw) {
        const int rb = item >> 4, h = item & 15, r = rb * 64 + c.lane;
        int b, nk;
        if (r < RMAIN) { b = r >> 12; nk = NMETA + (r & 4095) + 1; } else { const int i = r - RMAIN; b = i >> 4; nk = (i & 15) + 1; }
        const int mbase = RMAIN + 16 * b, tbase = 4096 * b;
        float qn[64], qp[32], o[64];
#pragma unroll
        for (int j = 0; j < 8; ++j) { const u32x4 v = *(const u32x4*)(QN + (size_t)r * 1024 + h * 64 + 8 * j);
            qn[8 * j] = bflo(v.x); qn[8 * j + 1] = bfhi(v.x); qn[8 * j + 2] = bflo(v.y); qn[8 * j + 3] = bfhi(v.y); qn[8 * j + 4] = bflo(v.z); qn[8 * j + 5] = bfhi(v.z); qn[8 * j + 6] = bflo(v.w); qn[8 * j + 7] = bfhi(v.w); }
#pragma unroll
        for (int j = 0; j < 4; ++j) { const u32x4 v = *(const u32x4*)(QPE + (size_t)r * 512 + h * 32 + 8 * j);
            qp[8 * j] = bflo(v.x); qp[8 * j + 1] = bfhi(v.x); qp[8 * j + 2] = bflo(v.y); qp[8 * j + 3] = bfhi(v.y); qp[8 * j + 4] = bflo(v.z); qp[8 * j + 5] = bfhi(v.z); qp[8 * j + 6] = bflo(v.w); qp[8 * j + 7] = bfhi(v.w); }
#pragma unroll
        for (int j = 0; j < 64; ++j) o[j] = 0.f;
        float m = -INFINITY, l = 0.f;
        const int nkmax = wave_max_i(nk);
        for (int kk = 0; kk < nkmax; ++kk) {
            if (kk < nk) {
                const int kr = kk < NMETA ? mbase + kk : tbase + kk - NMETA;
                const bf16* kn = KNV + (size_t)kr * 2048 + h * 64; const bf16* kp = KPE + (size_t)kr * 32; const bf16* vv = kn + 1024;
                float s = 0.f;
#pragma unroll
                for (int j = 0; j < 8; ++j) { const u32x4 v = *(const u32x4*)(kn + 8 * j);
                    s += qn[8 * j] * bflo(v.x) + qn[8 * j + 1] * bfhi(v.x) + qn[8 * j + 2] * bflo(v.y) + qn[8 * j + 3] * bfhi(v.y) + qn[8 * j + 4] * bflo(v.z) + qn[8 * j + 5] * bfhi(v.z) + qn[8 * j + 6] * bflo(v.w) + qn[8 * j + 7] * bfhi(v.w); }
#pragma unroll
                for (int j = 0; j < 4; ++j) { const u32x4 v = *(const u32x4*)(kp + 8 * j);
                    s += qp[8 * j] * bflo(v.x) + qp[8 * j + 1] * bfhi(v.x) + qp[8 * j + 2] * bflo(v.y) + qp[8 * j + 3] * bfhi(v.y) + qp[8 * j + 4] * bflo(v.z) + qp[8 * j + 5] * bfhi(v.z) + qp[8 * j + 6] * bflo(v.w) + qp[8 * j + 7] * bfhi(v.w); }
                const float mn = fmaxf(m, s), corr = exp2f(m - mn), p = exp2f(s - mn);
                l = l * corr + p; m = mn;
#pragma unroll
                for (int j = 0; j < 8; ++j) { const u32x4 v = *(const u32x4*)(vv + 8 * j);
                    o[8 * j] = o[8 * j] * corr + p * bflo(v.x); o[8 * j + 1] = o[8 * j + 1] * corr + p * bfhi(v.x); o[8 * j + 2] = o[8 * j + 2] * corr + p * bflo(v.y); o[8 * j + 3] = o[8 * j + 3] * corr + p * bfhi(v.y);
                    o[8 * j + 4] = o[8 * j + 4] * corr + p * bflo(v.z); o[8 * j + 5] = o[8 * j + 5] * corr + p * bfhi(v.z); o[8 * j + 6] = o[8 * j + 6] * corr + p * bflo(v.w); o[8 * j + 7] = o[8 * j + 7] * corr + p * bfhi(v.w); }
            }
        }
        const float il = 1.0f / l;
#pragma unroll
        for (int j = 0; j < 8; ++j) { u32x4 w; w.x = pk2(o[8 * j] * il, o[8 * j + 1] * il); w.y = pk2(o[8 * j + 2] * il, o[8 * j + 3] * il); w.z = pk2(o[8 * j + 4] * il, o[8 * j + 5] * il); w.w = pk2(o[8 * j + 6] * il, o[8 * j + 7] * il);
            *(u32x4*)(WSB(WS_O) + (size_t)r * 1024 + h * 64 + 8 * j) = w; }
    }
}
__device__ __forceinline__ void p_attn_decode_naive(ArgsP a, const Ctx& c0) {
    const Ctx c = refresh(c0);
    const float* cckv = IN_F(2); const float* ckpe = IN_F(3); const int* pt = (const int*)a->in[5];
    for (int item = c.gw; item < DB * NH; item += c.ngw) {
        const int db = item >> 4, h = item & 15;
        f32x4 ql[4]; float qp[4], m[4], l[4]; f32x4 o[4];
#pragma unroll
        for (int t = 0; t < 4; ++t) { const u32x2 v = *(const u32x2*)(WSB(WS_QLAT) + ((size_t)(db * 4 + t) * 16 + h) * 256 + 4 * c.lane);
            ql[t] = (f32x4){bflo(v.x), bfhi(v.x), bflo(v.y), bfhi(v.y)};
            qp[t] = c.lane < 32 ? bf2f(WSB(WS_QPE)[(size_t)(RSAMP0 + db * 4 + t) * 512 + h * 32 + c.lane]) : 0.f;
            m[t] = -INFINITY; l[t] = 0.f; o[t] = (f32x4){0.f, 0.f, 0.f, 0.f}; }
        for (int p = 0; p < NPAGES; ++p) {
            const int page = pt[db * NPAGES + p];
            for (int k = 0; k < PAGE; ++k) {
                const size_t kr = (size_t)page * PAGE + k;
                const f32x4 cv = *(const f32x4*)(cckv + kr * 256 + 4 * c.lane); const float e = c.lane < 32 ? ckpe[kr * 32 + c.lane] : 0.f;
#pragma unroll
                for (int t = 0; t < 4; ++t) {
                    float d = (ql[t].x * cv.x + ql[t].y * cv.y) + (ql[t].z * cv.z + ql[t].w * cv.w) + qp[t] * e;
                    d = wave_sum(d);
                    const float mn = fmaxf(m[t], d), corr = exp2f(m[t] - mn), pp = exp2f(d - mn);
                    l[t] = l[t] * corr + pp; m[t] = mn; o[t] = o[t] * corr + pp * cv;
                }
            }
        }
#pragma unroll
        for (int s2 = 0; s2 < 4; ++s2) {
            const int kr = RSAMP0 + db * 4 + s2;
            const u32x2 v = *(const u32x2*)(WSB(WS_CKVN) + (size_t)kr * 256 + 4 * c.lane); const f32x4 cv = (f32x4){bflo(v.x), bfhi(v.x), bflo(v.y), bfhi(v.y)};
            const float e = c.lane < 32 ? bf2f(WSB(WS_KPE)[(size_t)kr * 32 + c.lane]) : 0.f;
#pragma unroll
            for (int t = 0; t < 4; ++t) if (t >= s2) {
                float d = (ql[t].x * cv.x + ql[t].y * cv.y) + (ql[t].z * cv.z + ql[t].w * cv.w) + qp[t] * e;
                d = wave_sum(d);
                const float mn = fmaxf(m[t], d), corr = exp2f(m[t] - mn), pp = exp2f(d - mn);
                l[t] = l[t] * corr + pp; m[t] = mn; o[t] = o[t] * corr + pp * cv;
            }
        }
#pragma unroll
        for (int t = 0; t < 4; ++t) *(f32x4*)(WSF(WS_OLAT) + ((size_t)(db * 4 + t) * 16 + h) * 256 + 4 * c.lane) = o[t] * (1.0f / l[t]);
    }
}
__device__ __forceinline__ void p_olat_up(ArgsP a, const Ctx& c0) {
    const Ctx c = refresh(c0);
    const float* wuv = IN_F(16);
    for (int it = c.gw; it < DB * DS * NH; it += c.ngw) {
        const int i = it >> 4, h = it & 15; const float* ol = WSF(WS_OLAT) + ((size_t)i * 16 + h) * 256;
        float acc = 0.f;
#pragma unroll 8
        for (int cc = 0; cc < 256; ++cc) acc += ol[cc] * wuv[(size_t)cc * 1024 + h * 64 + c.lane];
        WSB(WS_O)[(size_t)(RSAMP0 + i) * 1024 + h * 64 + c.lane] = (bf16)f2bf(acc);
    }
}
template <bool FINAL, int NSPLIT, bool FIRST = false>
__device__ __forceinline__ void p_post_res(ArgsP a, const Ctx& c0, const float* gpost, const float* gnext) {
    const Ctx c = refresh(c0);
    const bf16* Mb = WSB(WS_M); bf16* X = WSB(WS_X); bf16* H = WSB(WS_H); const float* MT = WSF(WS_MT); const float* xin = IN_F(0); float* out = a->out;
    f32x4 gp[4], gn[4];
#pragma unroll
    for (int j = 0; j < 4; ++j) { gp[j] = *(const f32x4*)(gpost + 4 * c.lane + 256 * j); gn[j] = FINAL ? gp[j] : *(const f32x4*)(gnext + 4 * c.lane + 256 * j); }
    constexpr int NR = 4;
    for (int r0 = c.gw; r0 < RMAIN; r0 += NR * c.ngw) {
        f32x4 mv[NR][4], xv[NR][4]; float s[NR], s2[NR];
#pragma unroll
        for (int q = 0; q < NR; ++q) { const int r = r0 + q * c.ngw < RMAIN ? r0 + q * c.ngw : r0;
            s[q] = 0.f;
#pragma unroll
            for (int j = 0; j < 4; ++j) { const u32x2 mb = *(const u32x2*)(Mb + (size_t)r * D + 4 * c.lane + 256 * j); mv[q][j] = (f32x4){bflo(mb.x), bfhi(mb.x), bflo(mb.y), bfhi(mb.y)};
                if (FIRST) xv[q][j] = *(const f32x4*)(xin + (size_t)r * D + 4 * c.lane + 256 * j); else { const u32x2 xb = *(const u32x2*)(X + (size_t)r * D + 4 * c.lane + 256 * j); xv[q][j] = (f32x4){bflo(xb.x), bfhi(xb.x), bflo(xb.y), bfhi(xb.y)}; }
                s[q] += (mv[q][j].x * mv[q][j].x + mv[q][j].y * mv[q][j].y) + (mv[q][j].z * mv[q][j].z + mv[q][j].w * mv[q][j].w); } }
#pragma unroll
        for (int o = 1; o < 64; o <<= 1) {
#pragma unroll
            for (int q = 0; q < NR; ++q) s[q] += __shfl_xor(s[q], o); }
#pragma unroll
        for (int q = 0; q < NR; ++q) { const float rm = 1.0f / sqrtf(s[q] * (1.f / D) + EPS); s2[q] = 0.f;
#pragma unroll
            for (int j = 0; j < 4; ++j) { xv[q][j] = xv[q][j] + mv[q][j] * rm * gp[j]; s2[q] += (xv[q][j].x * xv[q][j].x + xv[q][j].y * xv[q][j].y) + (xv[q][j].z * xv[q][j].z + xv[q][j].w * xv[q][j].w); } }
        if (!FINAL) {
#pragma unroll
            for (int o = 1; o < 64; o <<= 1) {
#pragma unroll
                for (int q = 0; q < NR; ++q) s2[q] += __shfl_xor(s2[q], o); }
        }
#pragma unroll
        for (int q = 0; q < NR; ++q) { const int r = r0 + q * c.ngw < RMAIN ? r0 + q * c.ngw : r0;
            if (FINAL) {
#pragma unroll
                for (int j = 0; j < 4; ++j) *(f32x4*)(out + O_YP + (size_t)r * D + 4 * c.lane + 256 * j) = xv[q][j];
            } else { const float rx = 1.0f / sqrtf(s2[q] * (1.f / D) + EPS);
#pragma unroll
                for (int j = 0; j < 4; ++j) { u32x2 xo; xo.x = pk2(xv[q][j].x, xv[q][j].y); xo.y = pk2(xv[q][j].z, xv[q][j].w); *(u32x2*)(X + (size_t)r * D + 4 * c.lane + 256 * j) = xo;
                    u32x2 o; o.x = pk2(xv[q][j].x * rx * gn[j].x, xv[q][j].y * rx * gn[j].y); o.y = pk2(xv[q][j].z * rx * gn[j].z, xv[q][j].w * rx * gn[j].w); *(u32x2*)(H + (size_t)r * D + 4 * c.lane + 256 * j) = o; } } }
    }
    for (int r = RMAIN + c.gw; r < R; r += c.ngw) {
        bf16* xrow = X + (size_t)r * D;
        f32x4 mv[4], xv[4]; float s = 0.f;
#pragma unroll
        for (int j = 0; j < 4; ++j) { mv[j] = (f32x4){0.f, 0.f, 0.f, 0.f};
#pragma unroll
            for (int h8 = 0; h8 < NSPLIT; h8 += 8) { f32x4 part[8];
#pragma unroll
                for (int sp = 0; sp < 8; ++sp) part[sp] = *(const f32x4*)(MT + ((size_t)(h8 + sp) * (RP - RMAIN) + (r - RMAIN)) * D + 4 * c.lane + 256 * j);
#pragma unroll
                for (int sp = 0; sp < 8; ++sp) mv[j] += part[sp]; }
            { const u32x2 xb = *(const u32x2*)(xrow + 4 * c.lane + 256 * j); xv[j] = (f32x4){bflo(xb.x), bfhi(xb.x), bflo(xb.y), bfhi(xb.y)}; } s += (mv[j].x * mv[j].x + mv[j].y * mv[j].y) + (mv[j].z * mv[j].z + mv[j].w * mv[j].w); }
        const float rm = 1.0f / sqrtf(wave_sum(s) * (1.f / D) + EPS); float s2 = 0.f;
#pragma unroll
        for (int j = 0; j < 4; ++j) { xv[j] = xv[j] + mv[j] * rm * gp[j]; s2 += (xv[j].x * xv[j].x + xv[j].y * xv[j].y) + (xv[j].z * xv[j].z + xv[j].w * xv[j].w); }
        if (FINAL) {
            if (r < RSAMP0) continue;
#pragma unroll
            for (int j = 0; j < 4; ++j) *(f32x4*)(out + O_YS + (size_t)(r - RSAMP0) * D + 4 * c.lane + 256 * j) = xv[j];
        } else {
            const float rx = 1.0f / sqrtf(wave_sum(s2) * (1.f / D) + EPS);
#pragma unroll
            for (int j = 0; j < 4; ++j) { u32x2 xo; xo.x = pk2(xv[j].x, xv[j].y); xo.y = pk2(xv[j].z, xv[j].w); *(u32x2*)(xrow + 4 * c.lane + 256 * j) = xo;
                u32x2 o; o.x = pk2(xv[j].x * rx * gn[j].x, xv[j].y * rx * gn[j].y); o.y = pk2(xv[j].z * rx * gn[j].z, xv[j].w * rx * gn[j].w); *(u32x2*)(H + (size_t)r * D + 4 * c.lane + 256 * j) = o; }
        }
    }
}

__device__ __forceinline__ void p_gate(ArgsP a, const Ctx& c0) {
    const Ctx c = refresh(c0);
    const float* wg = IN_F(19); const float* bg = IN_F(20);
    const size_t gt = (size_t)c.gw * 64 + c.lane, ngt = (size_t)c.ngw * 64;
    for (size_t i = gt + (size_t)(USE_NAIVE_GLA ? 0 : RSAMP0) * 512; i < (size_t)R * 512; i += ngt) {
        const int r = (int)(i >> 9), col = (int)(i & 511); const float* gd = WSF(WS_GD) + (size_t)r * 16;
        float x = bg[col];
#pragma unroll
        for (int j = 0; j < 16; ++j) x += gd[j] * wg[j * 512 + col];
        const float ls = fminf(x, 0.f) - log1pf(__expf(-fabsf(x)));
        const float la = ls * (1.0f / 16.0f);
        WSF(WS_LA)[i] = la; WSF(WS_EA)[i] = __expf(la);
    }
}
__device__ __forceinline__ void gla_step(float (&S)[128], float& o, float a0, float a1, float k0, float k1, float q0, float q1, float v) {
    o = 0.f;
#pragma unroll
    for (int d = 0; d < 64; ++d) { const float ad = rdlane(a0, d), kd = rdlane(k0, d), qd = rdlane(q0, d); S[d] = ad * S[d] + kd * v; o += qd * S[d]; }
#pragma unroll
    for (int d = 0; d < 64; ++d) { const float ad = rdlane(a1, d), kd = rdlane(k1, d), qd = rdlane(q1, d); S[64 + d] = ad * S[64 + d] + kd * v; o += qd * S[64 + d]; }
}
__device__ __forceinline__ void p_gla_naive(ArgsP a, const Ctx& c0) {
    const Ctx c = refresh(c0);
    const float* EA = WSF(WS_EA); const bf16* KG = WSB(WS_KG); const bf16* QG = WSB(WS_QG); const bf16* VG = WSB(WS_VG); float* OGR = WSF(WS_OGRAW);
    for (int item = c.gwT; item < (USE_NAIVE_GLA ? NB * GH * 4 : 0); item += c.ngw) {
        const int b = item >> 4, h = (item >> 2) & 3, dv = (item & 3) * 64 + c.lane;
        float S[128];
#pragma unroll
        for (int d = 0; d < 128; ++d) S[d] = 0.f;
        for (int tt = 0; tt < TP; ++tt) {
            const int row = tt < NMETA ? RMAIN + 16 * b + tt : 4096 * b + tt - NMETA;
            const size_t g = (size_t)row * 512 + h * 128;
            const float a0 = EA[g + c.lane], a1 = EA[g + 64 + c.lane], k0 = bf2f(KG[g + c.lane]), k1 = bf2f(KG[g + 64 + c.lane]), q0 = bf2f(QG[g + c.lane]), q1 = bf2f(QG[g + 64 + c.lane]);
            const float v = bf2f(VG[(size_t)row * 1024 + h * 256 + dv]);
            float o; gla_step(S, o, a0, a1, k0, k1, q0, q1, v);
            OGR[(size_t)row * 1024 + h * 256 + dv] = o;
        }
        float* outp = a->out + O_GLAP + ((size_t)(b * 4 + h) * 128) * 256 + dv;
#pragma unroll
        for (int d = 0; d < 128; ++d) outp[(size_t)d * 256] = S[d];
    }
    const int wg0 = USE_NAIVE_GLA ? 0 : NB * GH * gla::NSP; if ((int)blockIdx.x < wg0) return;
    for (int item = c.wave * ((int)gridDim.x - wg0) + ((int)blockIdx.x - wg0); item < DB * GH * 4; item += c.ngw - wg0 * 8) {
        const int db = item >> 4, h = (item >> 2) & 3, dv = (item & 3) * 64 + c.lane;
        const float* sp = IN_F(4) + ((size_t)(db * 4 + h) * 128) * 256 + dv;
        float S[128];
#pragma unroll
        for (int d = 0; d < 128; ++d) S[d] = sp[(size_t)d * 256];
#pragma unroll 1
        for (int s = 0; s < DS; ++s) {
            const int row = RSAMP0 + db * 4 + s; const size_t g = (size_t)row * 512 + h * 128;
            const float a0 = EA[g + c.lane], a1 = EA[g + 64 + c.lane], k0 = bf2f(KG[g + c.lane]), k1 = bf2f(KG[g + 64 + c.lane]), q0 = bf2f(QG[g + c.lane]), q1 = bf2f(QG[g + 64 + c.lane]);
            const float v = bf2f(VG[(size_t)row * 1024 + h * 256 + dv]);
            float o; gla_step(S, o, a0, a1, k0, k1, q0, q1, v);
            OGR[(size_t)row * 1024 + h * 256 + dv] = o;
        }
        float* outp = a->out + O_GLAS + ((size_t)(db * 4 + h) * 128) * 256 + dv;
#pragma unroll
        for (int d = 0; d < 128; ++d) outp[(size_t)d * 256] = S[d];
    }
}
__device__ __forceinline__ void p_gla_post(ArgsP a, const Ctx& c0) {
    const Ctx c = refresh(c0);
    const bf16* OGR = WSB(WS_OGRAW); const bf16* RG = WSB(WS_RG); bf16* OG = WSB(WS_OG);
    const f32x4 g = *(const f32x4*)(IN_F(21) + 4 * c.lane);
    constexpr int NR = 2;
    for (int r0 = c.gw; r0 < R; r0 += NR * c.ngw) {
        f32x4 o[NR][4]; u32x2 rv[NR][4]; float s[NR][4];
#pragma unroll
        for (int q = 0; q < NR; ++q) { const int r = r0 + q * c.ngw < R ? r0 + q * c.ngw : r0;
#pragma unroll
            for (int h = 0; h < 4; ++h) { const size_t off = (size_t)r * 1024 + h * 256 + 4 * c.lane;
                const u32x2 ob = *(const u32x2*)(OGR + ((size_t)(h * 8 + (c.lane >> 3)) * RP + r) * 32 + 4 * (c.lane & 7)); o[q][h] = (f32x4){bflo(ob.x), bfhi(ob.x), bflo(ob.y), bfhi(ob.y)}; rv[q][h] = *(const u32x2*)(RG + off);
                s[q][h] = (o[q][h].x * o[q][h].x + o[q][h].y * o[q][h].y) + (o[q][h].z * o[q][h].z + o[q][h].w * o[q][h].w); } }
#pragma unroll
        for (int sh = 1; sh < 64; sh <<= 1) {
#pragma unroll
            for (int q = 0; q < NR; ++q)
#pragma unroll
                for (int h = 0; h < 4; ++h) s[q][h] += __shfl_xor(s[q][h], sh); }
#pragma unroll
        for (int q = 0; q < NR; ++q) { const int r = r0 + q * c.ngw < R ? r0 + q * c.ngw : r0;
#pragma unroll
            for (int h = 0; h < 4; ++h) { const size_t off = (size_t)r * 1024 + h * 256 + 4 * c.lane;
                const float rs = 1.0f / sqrtf(s[q][h] * (1.f / 256) + EPS);
                const f32x4 rr = (f32x4){bflo(rv[q][h].x), bfhi(rv[q][h].x), bflo(rv[q][h].y), bfhi(rv[q][h].y)};
                f32x4 sl; sl.x = rr.x / (1.f + __expf(-rr.x)); sl.y = rr.y / (1.f + __expf(-rr.y)); sl.z = rr.z / (1.f + __expf(-rr.z)); sl.w = rr.w / (1.f + __expf(-rr.w));
                const f32x4 y = o[q][h] * rs * g * sl;
                u32x2 w; w.x = pk2(y.x, y.y); w.y = pk2(y.z, y.w); *(u32x2*)(OG + off) = w; } }
    }
}


namespace gla {
using att::bf16x8; using att::f32x16; using att::crow; using att::cvtpk;
constexpr int NCH = 65, NITEM = NB * GH * NCH;
constexpr int P_GD = 0, P_GSUM = 4096, P_QL = 6144, P_KL = P_QL + 64 * 272, P_VS = P_KL + 64 * 272, P_AL = P_VS + 64 * 528, P_END = P_AL + 64 * 144;
__device__ __forceinline__ int chunk_row(int b, int c, int tok) { return c == 0 ? RMAIN + 16 * b + tok : 4096 * b + 64 * (c - 1) + tok; }
__device__ __forceinline__ float logsig16(float x) { return (fminf(x, 0.f) - __logf(1.0f + __expf(-fabsf(x)))) * (1.0f / 16.0f); }
__device__ __forceinline__ void prep_item(ArgsP a, int item, LAS unsigned char* lds, int wave_id) {
    const int tid = fresh_tid(wave_id), lane = tid & 63, r32 = lane & 31, hi = lane >> 5; const int wid = wave_id;
    const int bh = item / NCH, c = item % NCH, b = bh >> 2, h = bh & 3;
    const int nvalid = c == 0 ? NMETA : 64;
    bf16* QINF = WSB(WS_QINF) + (size_t)item * 8192; bf16* KDTF = WSB(WS_KDTF) + (size_t)item * 8192; bf16* AMF = WSB(WS_AMF) + (size_t)item * 4096; bf16* VTF = WSB(WS_VTF) + (size_t)item * 16384; float* ELF = WSF(WS_ELF) + (size_t)item * 256;
    LAS float* GDL = (LAS float*)(lds + P_GD); LAS float* GSUM = (LAS float*)(lds + P_GSUM); LAS bf16* QL = (LAS bf16*)(lds + P_QL); LAS bf16* KL = (LAS bf16*)(lds + P_KL); LAS bf16* VS = (LAS bf16*)(lds + P_VS); LAS bf16* AL = (LAS bf16*)(lds + P_AL);
    const u32x4 z4 = (u32x4){0u, 0u, 0u, 0u};
#pragma unroll
    for (int j = 0; j < 2; ++j) { const int idx = tid + 512 * j, row = idx >> 4, ch = idx & 15; const bool ok = row < nvalid; const size_t g = (size_t)chunk_row(b, c, ok ? row : 0) * 512 + h * 128 + ch * 8;
        *(LAS u32x4*)(QL + row * 136 + ch * 8) = ok ? *(const u32x4*)(WSB(WS_QG) + g) : z4; *(LAS u32x4*)(KL + row * 136 + ch * 8) = ok ? *(const u32x4*)(WSB(WS_KG) + g) : z4; }
#pragma unroll
    for (int j = 0; j < 4; ++j) { const int idx = tid + 512 * j, row = idx >> 5, ch = idx & 31; const bool ok = row < nvalid;
        *(LAS u32x4*)(VS + row * 264 + ch * 8) = ok ? *(const u32x4*)(WSB(WS_VG) + (size_t)chunk_row(b, c, ok ? row : 0) * 1024 + h * 256 + ch * 8) : z4; }
    if (tid < 256) { const int row = tid >> 2, ch = tid & 3; const bool ok = row < nvalid; *(LAS f32x4*)(GDL + row * 16 + ch * 4) = ok ? *(const f32x4*)(WSF(WS_GD) + (size_t)chunk_row(b, c, ok ? row : 0) * 16 + ch * 4) : (f32x4){0.f, 0.f, 0.f, 0.f}; }
    __syncthreads();
    const int dk = tid & 127, tg = tid >> 7;
    float bloc[16];
    {
        float w[16]; const float* wg = IN_F(19) + h * 128 + dk;
#pragma unroll
        for (int j = 0; j < 16; ++j) w[j] = wg[j * 512];
        const float bg = IN_F(20)[h * 128 + dk];
        float run = 0.f;
#pragma unroll
        for (int i = 0; i < 16; ++i) {
            const int tok = tg * 16 + i; float x = bg;
#pragma unroll
            for (int j4 = 0; j4 < 4; ++j4) { const f32x4 gd = *(const LAS f32x4*)(GDL + tok * 16 + j4 * 4); x += gd.x * w[4 * j4] + gd.y * w[4 * j4 + 1] + gd.z * w[4 * j4 + 2] + gd.w * w[4 * j4 + 3]; }
            const float g = tok < nvalid ? logsig16(x) : 0.f;
            run += g; bloc[i] = run;
        }
        GSUM[tg * 128 + dk] = run;
    }
    __syncthreads();
    float off = 0.f, blast = 0.f;
#pragma unroll
    for (int t = 0; t < 4; ++t) { const float s = GSUM[t * 128 + dk]; if (t < tg) off += s; blast += s; }
    {
        unsigned kdp[8];
#pragma unroll
        for (int i = 0; i < 16; i += 2) {
            float kd2[2];
#pragma unroll
            for (int e = 0; e < 2; ++e) {
                const int tok = tg * 16 + i + e; const float bb = bloc[i + e] + off; const float q = bf2f(QL[tok * 136 + dk]), k = bf2f(KL[tok * 136 + dk]);
                QL[tok * 136 + dk] = (bf16)f2bf(q * __expf(bb)); KL[tok * 136 + dk] = (bf16)f2bf(k * __expf(-bb)); kd2[e] = k * __expf(blast - bb);
            }
            kdp[i >> 1] = pk2(kd2[0], kd2[1]);
        }
        bf16* kp = KDTF + ((size_t)(((dk >> 5) * 4 + tg) * 64) + (dk & 31)) * 8;
        *(u32x4*)(kp) = (u32x4){kdp[0], kdp[1], kdp[2], kdp[3]}; *(u32x4*)(kp + 32 * 8) = (u32x4){kdp[4], kdp[5], kdp[6], kdp[7]};
        if (tg == 0) ELF[dk] = __expf(blast);
    }
    {
        const int dv = tid & 255, half = tid >> 8;
#pragma unroll
        for (int u = 0; u < 4; ++u) {
            unsigned pk[4];
#pragma unroll
            for (int e = 0; e < 4; ++e) { const int tok = half * 32 + u * 8 + e * 2; pk[e] = (unsigned)VS[tok * 264 + dv] | ((unsigned)VS[(tok + 1) * 264 + dv] << 16); }
            const int s = 2 * half + (u >> 1), uh = u & 1;
            *(u32x4*)(VTF + ((size_t)(((dv >> 5) * 4 + s) * 64) + uh * 32 + (dv & 31)) * 8) = (u32x4){pk[0], pk[1], pk[2], pk[3]};
        }
    }
    __syncthreads();
#pragma unroll
    for (int uu = 0; uu < 2; ++uu) {
        const int U = tid + 512 * uu, lp = U & 63, s8 = (U >> 6) & 7, tt = U >> 9; const int tok = tt * 32 + (lp & 31), hh = lp >> 5;
        const u32x2 lo = *(const LAS u32x2*)(QL + tok * 136 + 16 * s8 + 4 * hh), hi2 = *(const LAS u32x2*)(QL + tok * 136 + 16 * s8 + 8 + 4 * hh);
        *(u32x4*)(QINF + (size_t)U * 8) = (u32x4){lo.x, lo.y, hi2.x, hi2.y};
    }
    if (wid < 3) {
        const int tt = wid == 0 ? 0 : 1, tp = wid == 2 ? 1 : 0;
        f32x16 acc = f32x16{};
#pragma unroll
        for (int s = 0; s < 8; ++s) {
            const bf16x8 af = *(const LAS bf16x8*)(QL + (tt * 32 + r32) * 136 + 16 * s + 8 * hi), bfr = *(const LAS bf16x8*)(KL + (tp * 32 + r32) * 136 + 16 * s + 8 * hi);
            acc = __builtin_amdgcn_mfma_f32_32x32x16_bf16(af, bfr, acc, 0, 0, 0);
        }
#pragma unroll
        for (int r = 0; r < 16; ++r) { const int tok = tt * 32 + crow(r, hi), tk = tp * 32 + r32; AL[tok * 72 + tk] = (bf16)f2bf(tk <= tok ? acc[r] : 0.f); }
    } else if (wid == 3) {
#pragma unroll
        for (int r = 0; r < 16; ++r) AL[crow(r, hi) * 72 + 32 + r32] = 0;
    }
    __syncthreads();
    { const int U = tid, lp = U & 63, s = (U >> 6) & 3, tt = U >> 8; const int tok = tt * 32 + (lp & 31), hh = lp >> 5;
      *(u32x4*)(AMF + (size_t)U * 8) = *(const LAS u32x4*)(AL + tok * 72 + 16 * s + 8 * hh); }
    __syncthreads();
}
constexpr int SM_A = 0, SM_K = 2048, SM_Q = 4096, SM_V = 6144, SM_O = 10240, SM_END = SM_O + 4 * 2 * 256 * 4;
__device__ __forceinline__ void sample_item(ArgsP a, int item, LAS unsigned char* lds, int wave_id) {
    const int tid = fresh_tid(wave_id);
    const int db = item >> 2, h = item & 3;
    LAS float* AS = (LAS float*)(lds + SM_A); LAS float* KS = (LAS float*)(lds + SM_K); LAS float* QS = (LAS float*)(lds + SM_Q); LAS float* VSm = (LAS float*)(lds + SM_V); LAS float* OS = (LAS float*)(lds + SM_O);
    { const int s = tid >> 7, dk = tid & 127, row = RSAMP0 + db * 4 + s; const float* gd = WSF(WS_GD) + (size_t)row * 16; const float* wg = IN_F(19) + h * 128 + dk;
      float x = IN_F(20)[h * 128 + dk];
#pragma unroll
      for (int j = 0; j < 16; ++j) x += gd[j] * wg[j * 512];
      AS[s * 128 + dk] = __expf(logsig16(x));
      const size_t g = (size_t)row * 512 + h * 128 + dk; KS[s * 128 + dk] = bf2f(WSB(WS_KG)[g]); QS[s * 128 + dk] = bf2f(WSB(WS_QG)[g]);
#pragma unroll
      for (int j = 0; j < 2; ++j) { const int e = tid + 512 * j, s2 = e >> 8, dv2 = e & 255; VSm[s2 * 256 + dv2] = bf2f(WSB(WS_VG)[(size_t)(RSAMP0 + db * 4 + s2) * 1024 + h * 256 + dv2]); } }
    const int dv = tid & 255, kh = tid >> 8;
    const unsigned voff = (unsigned)(kh * 64 * 256 + dv) * 4u;
    const unsigned char* sbase = (const unsigned char*)(IN_F(4) + (size_t)(db * 4 + h) * 128 * 256);
    __syncthreads();
    float S[64];
#pragma unroll
    for (int d4 = 0; d4 < 16; ++d4) { const GAS unsigned char* bp = (const GAS unsigned char*)sbase + d4 * 4096; asm volatile("" : "+s"(bp));
#pragma unroll
        for (int e = 0; e < 4; ++e) S[4 * d4 + e] = *(const GAS float*)(bp + e * 1024 + voff); }
#pragma unroll 1
    for (int s = 0; s < 4; ++s) {
        const float v = VSm[s * 256 + dv]; float o = 0.f;
#pragma unroll
        for (int d4 = 0; d4 < 16; ++d4) {
            if ((d4 & 3) == 0) __builtin_amdgcn_sched_barrier(0);
            const f32x4 av = *(const LAS f32x4*)(AS + s * 128 + kh * 64 + 4 * d4), kv = *(const LAS f32x4*)(KS + s * 128 + kh * 64 + 4 * d4), qv = *(const LAS f32x4*)(QS + s * 128 + kh * 64 + 4 * d4);
            S[4 * d4] = av.x * S[4 * d4] + kv.x * v; o += qv.x * S[4 * d4]; S[4 * d4 + 1] = av.y * S[4 * d4 + 1] + kv.y * v; o += qv.y * S[4 * d4 + 1];
            S[4 * d4 + 2] = av.z * S[4 * d4 + 2] + kv.z * v; o += qv.z * S[4 * d4 + 2]; S[4 * d4 + 3] = av.w * S[4 * d4 + 3] + kv.w * v; o += qv.w * S[4 * d4 + 3];
        }
        OS[(s * 2 + kh) * 256 + dv] = o;
    }
    unsigned char* obase = (unsigned char*)(a->out + O_GLAS + (size_t)(db * 4 + h) * 128 * 256);
#pragma unroll
    for (int d4 = 0; d4 < 16; ++d4) { GAS unsigned char* bp = (GAS unsigned char*)obase + d4 * 4096; asm volatile("" : "+s"(bp));
#pragma unroll
        for (int e = 0; e < 4; ++e) *(GAS float*)(bp + e * 1024 + voff) = S[4 * d4 + e]; }
    __syncthreads();
#pragma unroll
    for (int j = 0; j < 2; ++j) { const int e = tid + 512 * j, s2 = e >> 8, dv2 = e & 255; WSB(WS_OGRAW)[((size_t)(h * 8 + (dv2 >> 5)) * RP + (RSAMP0 + db * 4 + s2)) * 32 + (dv2 & 31)] = (bf16)f2bf(OS[(s2 * 2) * 256 + dv2] + OS[(s2 * 2 + 1) * 256 + dv2]); }
    __syncthreads();
}
__device__ __forceinline__ void prep_phase(ArgsP a, LAS unsigned char* lds, int wave_id) {
    for (int item = blockIdx.x; item < NITEM; item += gridDim.x) prep_item(a, item, lds, wave_id);
}
constexpr int S_QIN = 0, S_KDT = 16384, S_AM = 32768, S_EL = 40960, S_VT = 41984, S_SLOT = S_VT + NCW * 4096;
static_assert(3 * S_SLOT <= MISC_OFF, "scan ring fits under the control words");
constexpr int NPIECE = 41 + NCW * 4, NDMA = (NPIECE + (8 - NCW) - 1) / (8 - NCW);
__device__ __forceinline__ void scan_bh(ArgsP a, int bh, int part, LAS unsigned char* lds, int wave_id) {
    const int tid = fresh_tid(wave_id), lane = tid & 63, r32 = lane & 31, hi = lane >> 5; const int wid = wave_id;
    const int b = bh >> 2, h = bh & 3; const bool cw = wid < NCW; const int ds = part * NCW + (cw ? wid : 0);
    const unsigned char* const pq = (const unsigned char*)(WSB(WS_QINF) + (size_t)bh * NCH * 8192); const unsigned char* const pk = (const unsigned char*)(WSB(WS_KDTF) + (size_t)bh * NCH * 8192);
    const unsigned char* const pa = (const unsigned char*)(WSB(WS_AMF) + (size_t)bh * NCH * 4096); const unsigned char* const pe = (const unsigned char*)(WSF(WS_ELF) + (size_t)bh * NCH * 256);
    const unsigned char* const pv = (const unsigned char*)(WSB(WS_VTF) + (size_t)bh * NCH * 16384) + part * NCW * 4096;
    bf16* const ogbase = WSB(WS_OGRAW) + (size_t)(h * 8 + ds) * RP * 32 + r32;
#define GLA_DMA(c_, slot_) do { const size_t c64_ = (size_t)(c_); \
        _Pragma("unroll") for (int k_ = 0; k_ < NDMA; ++k_) { int i_ = (wid - NCW) + (8 - NCW) * k_; i_ = i_ < NPIECE ? i_ : 40; const unsigned char* g_; int lo_; \
            if (i_ < 16) { g_ = pq + c64_ * 16384 + i_ * 1024; lo_ = S_QIN + i_ * 1024; } \
            else if (i_ < 32) { g_ = pk + c64_ * 16384 + (i_ - 16) * 1024; lo_ = S_KDT + (i_ - 16) * 1024; } \
            else if (i_ < 40) { g_ = pa + c64_ * 8192 + (i_ - 32) * 1024; lo_ = S_AM + (i_ - 32) * 1024; } \
            else if (i_ == 40) { g_ = pe + c64_ * 1024; lo_ = S_EL; } \
            else { g_ = pv + c64_ * 32768 + (i_ - 41) * 1024; lo_ = S_VT + (i_ - 41) * 1024; } \
            __builtin_amdgcn_global_load_lds((const unsigned*)(g_ + lane * 16), (LAS unsigned*)(lds + (slot_) * S_SLOT + lo_), 16, 0, 0); } } while (0)
    f32x16 S[4]; S[0] = f32x16{}; S[1] = f32x16{}; S[2] = f32x16{}; S[3] = f32x16{};
    if (!cw) { GLA_DMA(0, 0); GLA_DMA(1, 1); }
    int slot = 0;
    for (int c = 0; c < NCH; ++c) {
        if (!cw) { if (c + 1 < NCH) asm volatile("s_waitcnt vmcnt(%0)" :: "n"(NDMA) : "memory"); else asm volatile("s_waitcnt vmcnt(0)" ::: "memory"); }
        asm volatile("s_waitcnt lgkmcnt(0)\n\ts_barrier" ::: "memory");
        const LAS unsigned char* sb = lds + slot * S_SLOT; const int slot2 = slot == 0 ? 2 : slot - 1;
        slot = slot == 2 ? 0 : slot + 1;
        if (!cw) { if (c + 2 < NCH) GLA_DMA(c + 2, slot2); continue; }
        bf16x8 vf[4];
#pragma unroll
        for (int s = 0; s < 4; ++s) vf[s] = *(const LAS bf16x8*)(sb + S_VT + (wid * 4 + s) * 1024 + lane * 16);
        u32x4 Sb[4][2];
#pragma unroll
        for (int T = 0; T < 4; ++T)
#pragma unroll
            for (int s = 0; s < 2; ++s)
#pragma unroll
                for (int i = 0; i < 4; ++i) Sb[T][s][i] = cvtpk(S[T][8 * s + 2 * i], S[T][8 * s + 2 * i + 1]);
        f32x16 o[2]; o[0] = f32x16{}; o[1] = f32x16{};
#pragma unroll
        for (int T = 0; T < 4; ++T)
#pragma unroll
            for (int g = 0; g < 4; ++g) { const f32x4 e = *(const LAS f32x4*)(sb + S_EL + (32 * T + 8 * g + 4 * hi) * 4); S[T][4 * g] *= e.x; S[T][4 * g + 1] *= e.y; S[T][4 * g + 2] *= e.z; S[T][4 * g + 3] *= e.w; }
#define GLA_QF(tt, k8) (*(const LAS bf16x8*)(sb + S_QIN + ((tt) * 8 + (k8)) * 1024 + lane * 16))
#define GLA_KF(T, s) (*(const LAS bf16x8*)(sb + S_KDT + ((T) * 4 + (s)) * 1024 + lane * 16))
#define GLA_AF(tt, s) (*(const LAS bf16x8*)(sb + S_AM + ((tt) * 4 + (s)) * 1024 + lane * 16))
#define GLA_LOADG(F, g) do { F[0] = GLA_QF(0, 2 * (g)); F[1] = GLA_QF(1, 2 * (g)); F[2] = GLA_QF(0, 2 * (g) + 1); F[3] = GLA_QF(1, 2 * (g) + 1); \
        F[4] = GLA_KF((2 * (g)) & 3, (g) >> 1); F[5] = GLA_KF((2 * (g) + 2) & 3, 2 + ((g) >> 1)); F[6] = GLA_KF((2 * (g) + 1) & 3, (g) >> 1); F[7] = GLA_KF((2 * (g) + 3) & 3, 2 + ((g) >> 1)); } while (0)
#define GLA_MMAG(F, g) do { \
        o[0] = __builtin_amdgcn_mfma_f32_32x32x16_bf16(F[0], __builtin_bit_cast(bf16x8, Sb[g][0]), o[0], 0, 0, 0); \
        S[(2 * (g)) & 3] = __builtin_amdgcn_mfma_f32_32x32x16_bf16(F[4], vf[(g) >> 1], S[(2 * (g)) & 3], 0, 0, 0); \
        o[1] = __builtin_amdgcn_mfma_f32_32x32x16_bf16(F[1], __builtin_bit_cast(bf16x8, Sb[g][0]), o[1], 0, 0, 0); \
        S[(2 * (g) + 2) & 3] = __builtin_amdgcn_mfma_f32_32x32x16_bf16(F[5], vf[2 + ((g) >> 1)], S[(2 * (g) + 2) & 3], 0, 0, 0); \
        o[0] = __builtin_amdgcn_mfma_f32_32x32x16_bf16(F[2], __builtin_bit_cast(bf16x8, Sb[g][1]), o[0], 0, 0, 0); \
        S[(2 * (g) + 1) & 3] = __builtin_amdgcn_mfma_f32_32x32x16_bf16(F[6], vf[(g) >> 1], S[(2 * (g) + 1) & 3], 0, 0, 0); \
        o[1] = __builtin_amdgcn_mfma_f32_32x32x16_bf16(F[3], __builtin_bit_cast(bf16x8, Sb[g][1]), o[1], 0, 0, 0); \
        S[(2 * (g) + 3) & 3] = __builtin_amdgcn_mfma_f32_32x32x16_bf16(F[7], vf[2 + ((g) >> 1)], S[(2 * (g) + 3) & 3], 0, 0, 0); } while (0)
        bf16x8 FA[8], FB[8];
        GLA_LOADG(FA, 0); __builtin_amdgcn_sched_barrier(0);
        GLA_LOADG(FB, 1); __builtin_amdgcn_sched_barrier(0); GLA_MMAG(FA, 0); __builtin_amdgcn_sched_barrier(0);
        GLA_LOADG(FA, 2); __builtin_amdgcn_sched_barrier(0); GLA_MMAG(FB, 1); __builtin_amdgcn_sched_barrier(0);
        GLA_LOADG(FB, 3); __builtin_amdgcn_sched_barrier(0); GLA_MMAG(FA, 2); __builtin_amdgcn_sched_barrier(0);
        FA[0] = GLA_AF(0, 0); FA[1] = GLA_AF(1, 0); FA[2] = GLA_AF(0, 1); FA[3] = GLA_AF(1, 1); FA[4] = GLA_AF(1, 2); FA[5] = GLA_AF(1, 3);
        __builtin_amdgcn_sched_barrier(0); GLA_MMAG(FB, 3); __builtin_amdgcn_sched_barrier(0);
        o[0] = __builtin_amdgcn_mfma_f32_32x32x16_bf16(FA[0], vf[0], o[0], 0, 0, 0); o[1] = __builtin_amdgcn_mfma_f32_32x32x16_bf16(FA[1], vf[0], o[1], 0, 0, 0);
        o[0] = __builtin_amdgcn_mfma_f32_32x32x16_bf16(FA[2], vf[1], o[0], 0, 0, 0); o[1] = __builtin_amdgcn_mfma_f32_32x32x16_bf16(FA[3], vf[1], o[1], 0, 0, 0);
        o[1] = __builtin_amdgcn_mfma_f32_32x32x16_bf16(FA[4], vf[2], o[1], 0, 0, 0); o[1] = __builtin_amdgcn_mfma_f32_32x32x16_bf16(FA[5], vf[3], o[1], 0, 0, 0);
#undef GLA_QF
#undef GLA_KF
#undef GLA_AF
#undef GLA_LOADG
#undef GLA_MMAG
        bf16* og = ogbase;
#pragma unroll
        for (int tt = 0; tt < 2; ++tt)
#pragma unroll
            for (int r = 0; r < 16; ++r) { const int tok = tt * 32 + crow(r, hi); if (c > 0 || tok < NMETA) og[(size_t)chunk_row(b, c, tok) * 32] = (bf16)cvtpk(o[tt][r], o[tt][r]); }
    }
    if (cw) { float* outp = a->out + O_GLAP + (size_t)bh * 128 * 256 + ds * 32 + r32;
#pragma unroll
    for (int T = 0; T < 4; ++T)
#pragma unroll
        for (int r = 0; r < 16; ++r) outp[(size_t)(32 * T + crow(r, hi)) * 256] = S[T][r]; }
    asm volatile("s_waitcnt vmcnt(0) lgkmcnt(0)\n\ts_barrier" ::: "memory");
#undef GLA_DMA
#undef GLA_VLOAD
}
}

__device__ __forceinline__ bool relaunder(ArgsP& a) { asm volatile("" : "+s"(a)); return true; }
constexpr int NPHASE = 22;
__global__ void __launch_bounds__(512, 2) fwd(Args a_unused) {
    ArgsP a = (ArgsP)__builtin_amdgcn_kernarg_segment_ptr();
    extern __shared__ __attribute__((aligned(16))) unsigned char lds_raw[];
    LAS unsigned char* lds = (LAS unsigned char*)lds_raw;
    Ctx c; c.wave = __builtin_amdgcn_readfirstlane((int)threadIdx.x >> 6); c.tid = 0; c.lane = 0;
    c.gw = blockIdx.x * 8 + c.wave; c.ngw = gridDim.x * 8; c.gwT = c.wave * gridDim.x + blockIdx.x;
    volatile LAS unsigned* MISC = (volatile LAS unsigned*)(lds + MISC_OFF);
    if (threadIdx.x < 32) MISC[threadIdx.x] = 0u;
    __syncthreads();
    XcdBarrier bar; bar.bar = (unsigned*)(a->ws + WS_CTL) + CW_BAR; bar.x = 0; bar.st = nullptr;
    const bool one = (a->ph_hi - a->ph_lo) > 1;
    if (one) bar = xcd_barrier_post((unsigned*)(a->ws + WS_CTL) + CW_BAR, MISC + 8);
    const int lo = a->ph_lo, hi = a->ph_hi;
    unsigned long long tp0 = 0, tp1 = 0;
#define IN(k) (((PROBE_LO == (k)) ? (void)(tp0 = __builtin_amdgcn_s_memrealtime()) : (void)0), (lo <= (k) && (k) < hi && relaunder(a)))
#define INQ(k) (lo <= (k) && (k) < hi)
#define SEAM(k) do { if (INQ(k) && INQ((k) + 1)) xcd_barrier(bar, c.wave); if (PROBE_HI == (k)) tp1 = __builtin_amdgcn_s_memrealtime(); } while (0)
    if (IN(0)) { p_prep(a, c, lds); } SEAM(0);
    if (IN(1)) { if ((int)blockIdx.x < (RP / 256) * (NIN0 / 256)) gemm_p1(a, lds, c.wave); else p_side_tables(a, c, lds, (RP / 256) * (NIN0 / 256)); } SEAM(1);
    if (IN(2)) { if (USE_NAIVE_GEMM) p_mla_mid(a, c); }
    if (IN(3)) { gemm_p3(a, lds, c.wave); } SEAM(3);
    if (IN(4)) { if (USE_NAIVE_GEMM) { p_q_post(a, c); p_qlat(a, c); } }
    if (IN(5)) {
#if USE_NAIVE_ATTN
        p_attn_prompt_naive<false>(a, c);
#else
        if (((int)blockIdx.x >> 3) & 1) {
            dec::decode_phase(a, lds, c.wave);
            att::attn_phase(WSB(WS_QN), WSB(WS_QPE), WSB(WS_KNV), WSB(WS_KPE), WSB(WS_O), lds, c.wave);
        } else {
            att::attn_phase(WSB(WS_QN), WSB(WS_QPE), WSB(WS_KNV), WSB(WS_KPE), WSB(WS_O), lds, c.wave);
            dec::decode_phase(a, lds, c.wave);
        }
#endif
    } SEAM(5);
    if (IN(6)) {
#if USE_NAIVE_DECODE
        p_olat_up(a, c);
#else
        dec::combine_phase(a, c, lds);
#endif
    } SEAM(6);
    if (IN(7)) { gemm_n1024_tail<D, 8>(WSB(WS_O), WSB(WS_WO0), WSB(WS_M), WSF(WS_MT), lds, c.wave); } SEAM(7);
    if (IN(8)) { p_post_res<false, 8, true>(a, c, IN_F(8), IN_F(9)); } SEAM(8);
    if (IN(9)) { gemm_mfma8(WSB(WS_H), WSB(WS_WUP), RP, FF, D, (EpiRelu2{WSB(WS_U), FF}), lds, c.wave); } SEAM(9);
    if (IN(10)) { gemm_n1024_tail<FF, 16>(WSB(WS_U), WSB(WS_WDN), WSB(WS_M), WSF(WS_MT), lds, c.wave); } SEAM(10);
    if (IN(11)) { p_post_res<false, 16>(a, c, IN_F(10), IN_F(7) + D); } SEAM(11);
    if (IN(12)) { gemm_mfma8(WSB(WS_H), WSB(WS_WGIN), RP, NGIN, D, (EpiGla{WSB(WS_QG), WSB(WS_KG), WSB(WS_VG), WSB(WS_RG), WSF(WS_GD)}), lds, c.wave); } SEAM(12);
    if (IN(13)) {
#if USE_NAIVE_GLA
        p_gate(a, c);
#else
        gla::prep_phase(a, lds, c.wave);
#endif
    } SEAM(13);
    if (IN(14)) {
#if !USE_NAIVE_GLA
        if ((int)blockIdx.x < NB * GH * gla::NSP) gla::scan_bh(a, (int)blockIdx.x / gla::NSP, (int)blockIdx.x % gla::NSP, lds, c.wave);
        else for (int item = (int)blockIdx.x - NB * GH * gla::NSP; item < DB * GH; item += (int)gridDim.x - NB * GH * gla::NSP) gla::sample_item(a, item, lds, c.wave);
#else
        p_gla_naive(a, c);
#endif
    } SEAM(14);
    if (IN(15)) { p_gla_post(a, c); } SEAM(15);
    if (IN(16)) { gemm_n1024_tail<D, 8>(WSB(WS_OG), WSB(WS_WGO), WSB(WS_M), WSF(WS_MT), lds, c.wave); } SEAM(16);
    if (IN(17)) { p_post_res<false, 8>(a, c, IN_F(8) + D, IN_F(9) + D); } SEAM(17);
    if (IN(18)) { gemm_mfma8(WSB(WS_H), WSB(WS_WUP) + (size_t)FF * D, RP, FF, D, (EpiRelu2{WSB(WS_U), FF}), lds, c.wave); } SEAM(18);
    if (IN(19)) { gemm_n1024_tail<FF, 16>(WSB(WS_U), WSB(WS_WDN) + (size_t)D * FF, WSB(WS_M), WSF(WS_MT), lds, c.wave); } SEAM(19);
    if (IN(20)) { p_post_res<true, 16>(a, c, IN_F(10) + D, nullptr); }
    if (PROBE_LO >= 0 && blockIdx.x == 0) { const unsigned long long span = (tp1 - tp0) * 9ull, t0 = __builtin_amdgcn_s_memrealtime(); while (__builtin_amdgcn_s_memrealtime() - t0 < span) __builtin_amdgcn_s_sleep(8); }
#undef IN
#undef SEAM
}

extern "C" void kernel_launch(void* const* d_in, const int* in_sizes, int n_in, void* d_out, int out_size, void* d_ws, size_t ws_size, hipStream_t stream) {
    static int grid = 0;
    if (grid == 0) {
        if (n_in != 25 || out_size != (int)O_END || ws_size < WS_END) { fprintf(stderr, "kernel_launch: unexpected shapes n_in %d out %d ws %zu\n", n_in, out_size, ws_size); grid = -1; return; }
        int dev = 0, cus = 0, per_cu = 0;
        if (hipGetDevice(&dev) != hipSuccess || hipDeviceGetAttribute(&cus, hipDeviceAttributeMultiprocessorCount, dev) != hipSuccess) { grid = -1; return; }
        if (hipFuncSetAttribute((const void*)fwd, hipFuncAttributeMaxDynamicSharedMemorySize, LDS_BYTES) != hipSuccess) { fprintf(stderr, "kernel_launch: hipFuncSetAttribute failed\n"); grid = -1; return; }
        if (hipOccupancyMaxActiveBlocksPerMultiprocessor(&per_cu, (const void*)fwd, 512, LDS_BYTES) != hipSuccess || per_cu < 1) fprintf(stderr, "kernel_launch: occupancy query says %d\n", per_cu);
        (void)hipGetLastError();
        grid = cus;
    }
    if (grid < 0) return;
    if (hipMemsetAsync((char*)d_ws + WS_CTL, 0, CTL_ZERO_BYTES, stream) != hipSuccess) return;
    Args a{};
    for (int i = 0; i < 25; ++i) a.in[i] = d_in[i];
    a.out = (float*)d_out; a.ws = (unsigned char*)d_ws;
#if MK_ONE_LAUNCH
    a.ph_lo = 0; a.ph_hi = NPHASE;
    hipLaunchKernelGGL(fwd, dim3(grid), dim3(512), LDS_BYTES, stream, a);
#else
    for (int ph = 0; ph < NPHASE - 1; ++ph) { a.ph_lo = ph; a.ph_hi = ph + 1; hipLaunchKernelGGL(fwd, dim3(grid), dim3(512), LDS_BYTES, stream, a); }
#endif
}
```

```cpp
#include <hip/hip_runtime.h>
#include <cstdio>
#include <cstdint>
#include <cmath>

#ifndef MK_ONE_LAUNCH
#define MK_ONE_LAUNCH 1
#endif

constexpr int D = 1024, NB = 4, SEQ = 4096, NMETA = 16, TP = SEQ + NMETA;
constexpr int DB = 128, DS = 4, PAST = 8192, PAGE = 128, NPAGES = 64;
constexpr int NH = 16, QL = 256, KVL = 256, NOPE = 64, ROPE = 32, VH = 64;
constexpr int GH = 4, GDK = 128, GDV = 256, GR = 16;
constexpr int FF = 4096;
constexpr int RMAIN = NB * SEQ;
constexpr int RMETA0 = RMAIN;
constexpr int RSAMP0 = RMAIN + NB * NMETA;
constexpr int R = RSAMP0 + DB * DS;
constexpr int RPROMPT = RSAMP0;
constexpr int RP = 17152;
constexpr int NIN0 = 768, NUQ = 1536, NUKV = 2048, NGIN = 3328, NGIN_REAL = 3088;
constexpr float EPS = 1e-6f;
constexpr float MLA_SCALE = 0.10206207261596575f;
constexpr float GLA_SCALE = 0.08838834764831845f;
constexpr float QSCALE = 0.10206207261596575f * 1.4426950408889634f;

constexpr size_t O_YP = 0, O_YS = 16777216, O_CKVP = 17301504, O_KPEP = 21512192, O_CKVS = 22038528, O_KPES = 22169600, O_GLAP = 22185984, O_GLAS = 22710272, O_END = 39487488;

constexpr size_t MiB = 1u << 20;
constexpr size_t WS_CTL = 0, CTL_ZERO_BYTES = 1 * MiB;
constexpr size_t WS_WIN0 = 2 * MiB, WS_WUQ = 4 * MiB, WS_WUKV = 5 * MiB, WS_WO0 = 6 * MiB, WS_WUP = 8 * MiB, WS_WDN = 24 * MiB, WS_WGIN = 40 * MiB, WS_WGO = 47 * MiB;
constexpr size_t WS_X = 64 * MiB, WS_H = 132 * MiB, WS_M = 166 * MiB, WS_U = 234 * MiB, WS_A1 = 368 * MiB, WS_CQN = 419 * MiB, WS_CKVN = 428 * MiB, WS_KPE = 437 * MiB;
constexpr size_t WS_QRAW = 440 * MiB, WS_KNV = 541 * MiB, WS_QN = 608 * MiB, WS_QPE = 642 * MiB, WS_QLAT = 659 * MiB, WS_OLAT = 663 * MiB, WS_O = 671 * MiB;
constexpr size_t WS_QG = 705 * MiB, WS_KG = 722 * MiB, WS_VG = 739 * MiB, WS_RG = 773 * MiB, WS_GD = 807 * MiB, WS_LA = 809 * MiB, WS_EA = 843 * MiB, WS_OGRAW = 877 * MiB, WS_OG = 944 * MiB;
constexpr size_t WS_OPART = 978 * MiB, WS_MLP = 1012 * MiB;
constexpr size_t WS_QINF = 1014 * MiB, WS_KDTF = 1032 * MiB, WS_AMF = 1050 * MiB, WS_VTF = 1060 * MiB, WS_ELF = 1094 * MiB;
constexpr size_t WS_WUQL = 50 * MiB;
constexpr size_t WS_ROPE = 53 * MiB;
constexpr size_t WS_MT = 1096 * MiB;
constexpr size_t WS_END = 1144 * MiB;
constexpr int CW_BAR = 4096, CW_DEC = 8192;
namespace gla { constexpr int NSP = 8, NCW = 8 / NSP; }

constexpr int LDS_BYTES = 147456;
constexpr int MISC_OFF = LDS_BYTES - 256;

#define GAS __attribute__((address_space(1)))
#define LAS __attribute__((address_space(3)))
typedef unsigned short bf16;
typedef float f32x4 __attribute__((ext_vector_type(4)));
typedef unsigned u32x4 __attribute__((ext_vector_type(4)));
typedef unsigned u32x2 __attribute__((ext_vector_type(2)));
#define LDS_WAIT() asm volatile("s_waitcnt lgkmcnt(0)" ::: "memory")

__device__ __forceinline__ unsigned f2bf(float f) { unsigned u = __builtin_bit_cast(unsigned, f); return (u + 0x7fffu + ((u >> 16) & 1u)) >> 16; }
__device__ __forceinline__ unsigned pk2(float lo, float hi) { return f2bf(lo) | (f2bf(hi) << 16); }
__device__ __forceinline__ float bflo(unsigned u) { return __builtin_bit_cast(float, u << 16); }
__device__ __forceinline__ float bfhi(unsigned u) { return __builtin_bit_cast(float, u & 0xffff0000u); }
__device__ __forceinline__ float bf2f(bf16 v) { return __builtin_bit_cast(float, (unsigned)v << 16); }
__device__ __forceinline__ float wave_sum(float v) {
#pragma unroll
    for (int o = 1; o < 64; o <<= 1) v += __shfl_xor(v, o);
    return v;
}
__device__ __forceinline__ int wave_max_i(int v) {
#pragma unroll
    for (int o = 1; o < 64; o <<= 1) { int t = __shfl_xor(v, o); v = t > v ? t : v; }
    return v;
}
__device__ __forceinline__ int fresh_tid(int wave) { int t = wave * 64 + (int)__builtin_amdgcn_mbcnt_hi(~0u, __builtin_amdgcn_mbcnt_lo(~0u, 0u)); asm volatile("" : "+v"(t)); return t; }
__device__ __forceinline__ float rdlane(float v, int l) { return __builtin_bit_cast(float, __builtin_amdgcn_readlane(__builtin_bit_cast(int, v), l)); }

#define XB_TMO      128
#define XB_XCNT(j)  (256  + 64 * (j))
#define XB_XSUB(j)  (1280 + 64 * (j))
#define XB_XGEN(j)  (2304 + 64 * (j))
#define XB_TOP      3328
#define XB_TOPGEN   3392
#define XCD_BAR_WORDS 3456
#define XB_SPIN_CAP (1u << 18)
__device__ __forceinline__ unsigned xb_ld(unsigned* p)              { return __hip_atomic_load(p, __ATOMIC_RELAXED, __HIP_MEMORY_SCOPE_AGENT); }
__device__ __forceinline__ unsigned xb_add(unsigned* p, unsigned v) { return __hip_atomic_fetch_add(p, v, __ATOMIC_RELAXED, __HIP_MEMORY_SCOPE_AGENT); }
__device__ __forceinline__ unsigned xb_xcc_id() { return (unsigned)__builtin_amdgcn_s_getreg((3 << 11) | 20) & 0xFu; }
#define XB_SPIN(cond, bar) do { unsigned _sp = 0; while (cond) { __builtin_amdgcn_s_sleep(1); \
    if ((++_sp & 255u) == 0u) { if (xb_ld(&(bar)[XB_TMO])) break; if (_sp > XB_SPIN_CAP) { atomicAdd(&(bar)[XB_TMO], 1u); break; } } } } while (0)
struct XcdBarrier { unsigned* bar; unsigned x; volatile LAS unsigned* st; };
__device__ __forceinline__ XcdBarrier xcd_barrier_post(unsigned* bar, volatile LAS unsigned* st) {
    XcdBarrier b; b.bar = bar; b.x = xb_xcc_id(); b.st = st;
    if (threadIdx.x == 0) (void)xb_add(&bar[XB_XCNT(b.x)], 1u);
    return b;
}
__device__ __forceinline__ void xcd_barrier_complete(unsigned* bar, unsigned x, unsigned& nloc, unsigned& nx) {
    const unsigned G = gridDim.x * gridDim.y * gridDim.z;
    unsigned sum, cnt, mine, sp = 0u;
    for (;;) {
        sum = 0u; cnt = 0u; mine = 0u;
#pragma unroll
        for (unsigned j = 0; j < 16; ++j) { const unsigned c = xb_ld(&bar[XB_XCNT(j)]); sum += c; cnt += (c > 0u) ? 1u : 0u; mine = (j == x) ? c : mine; }
        if (sum == G) break;
        __builtin_amdgcn_s_sleep(1);
        if ((++sp & 255u) == 0u) { if (xb_ld(&bar[XB_TMO])) break; if (sp > XB_SPIN_CAP) { atomicAdd(&bar[XB_TMO], 1u); break; } }
    }
    nloc = mine > 0u ? mine : 1u; nx = cnt > 0u ? cnt : 1u;
}
__device__ __forceinline__ void xcd_barrier(const XcdBarrier& b, int wave_id) {
    asm volatile("s_waitcnt vmcnt(0)" ::: "memory");
    __syncthreads();
    if (fresh_tid(wave_id) == 0) {
        unsigned* bar = b.bar;
        __builtin_amdgcn_s_waitcnt(0);
        unsigned nloc = b.st[0], nx = b.st[1];
        if (nloc == 0u) { xcd_barrier_complete(bar, b.x, nloc, nx); b.st[0] = nloc; b.st[1] = nx; }
        const unsigned old = xb_add(&bar[XB_XSUB(b.x)], 1u);
        const unsigned gen = old / nloc;
        if (old + 1u == (gen + 1u) * nloc) {
            __builtin_amdgcn_fence(__ATOMIC_RELEASE, "agent");
            asm volatile("s_waitcnt vmcnt(0)" ::: "memory");
            const unsigned og = xb_add(&bar[XB_TOP], 1u);
            const unsigned tg = og / nx;
            if (og + 1u == (tg + 1u) * nx) xb_add(&bar[XB_TOPGEN], 1u);
            else XB_SPIN(xb_ld(&bar[XB_TOPGEN]) == tg, bar);
            __builtin_amdgcn_fence(__ATOMIC_ACQUIRE, "agent");
            xb_add(&bar[XB_XGEN(b.x)], 1u);
            asm volatile("s_waitcnt vmcnt(0)" ::: "memory");
        } else {
            XB_SPIN(xb_ld(&bar[XB_XGEN(b.x)]) == gen, bar);
            __builtin_amdgcn_fence(__ATOMIC_ACQUIRE, "agent");
            asm volatile("s_waitcnt vmcnt(0)" ::: "memory");
        }
    }
    __syncthreads();
}

namespace pg8 {
#define PG8_LAS __attribute__((address_space(3)))
typedef unsigned short bf16_t;
typedef short bf16x8 __attribute__((ext_vector_type(8)));
typedef float f32x4 __attribute__((ext_vector_type(4)));
typedef unsigned u32x4 __attribute__((ext_vector_type(4)));
constexpr int BM = 256, BK = 64, HALF = 128, HTB = HALF * BK * 2  , STAGE_BYTES = 8 * HTB, NXCD = 8, WGM = 8;

__host__ __device__ __forceinline__ int lds_byte(int r, int c) { const int st = (r >> 4) * 2 + (c >> 5), rr = r & 15, cc = c & 31, ob = rr * 64 + cc * 2; return st * 1024 + (ob ^ (((ob >> 9) & 1) << 5)); }
__host__ __device__ __forceinline__ void stage_rc(int b, int& R, int& C) { const int st = b / 1024, sb = b % 1024, swz = sb ^ (((sb >> 9) & 1) << 5); R = (st >> 1) * 16 + swz / 64; C = (st & 1) * 32 + (swz % 64) / 2; }
__host__ __device__ __forceinline__ int perm32(int rho) { const int n = rho >> 4, i = rho & 15; return 8 * (i >> 2) + 4 * n + (i & 3); }

struct Unit { int pm, pn, k0, prob; long aoff, boff; };
struct Gemm { const bf16_t* A; const bf16_t* Bt; int M, N, K, ld; };

struct StaticOrder {
    int nM, nN, nwg, G, c;
    __host__ __device__ void init(int M, int N, int G_, int c_) { nM = M / BM; nN = N / BM; nwg = nM * nN; G = G_; c = c_; }
    __host__ __device__ bool next(int i, Unit& u) const {
        const long L = (long)i * G + c; if (L >= nwg) return false;
        int wgid = (int)L; { const int q = nwg / NXCD, r = nwg % NXCD, xcd = wgid % NXCD, off = wgid / NXCD; wgid = (xcd < r ? xcd * (q + 1) : r * (q + 1) + (xcd - r) * q) + off; }
        const int nig = WGM * nN, gid = wgid / nig, fm = gid * WGM, gsz = (nM - fm) < WGM ? (nM - fm) : WGM;
        u.pm = fm + ((wgid % nig) % gsz); u.pn = (wgid % nig) / gsz; u.k0 = 0; u.prob = 0; u.aoff = 0; u.boff = 0; return true;
    }
    __device__ __forceinline__ void a_ready(const Unit&) const {}
    __device__ __forceinline__ void done(const Unit&) const {}
};

__device__ __forceinline__ unsigned cvt_pk_bf16(float lo, float hi) { unsigned r; asm volatile("v_cvt_pk_bf16_f32 %0, %1, %2" : "=v"(r) : "v"(lo), "v"(hi)); return r; }
template <class Epi, class Sched, bool ALIGN_EPI = false, bool SP2 = false>
__device__ __forceinline__ void gemm_phase(PG8_LAS unsigned char* lds, const Gemm g, const Sched& S, const Epi& E, int wave_id) {
    const int tid = fresh_tid(wave_id), wid = wave_id, lane = tid & 63, wr = wid >> 2, wc = wid & 3, fr = lane & 15, fq = lane >> 4;
    const int K = g.K, nt = K / BK;
    unsigned voffA[2], voffB[2];
#pragma unroll
    for (int i = 0; i < 2; ++i) { int R, C; stage_rc(tid * 16 + i * 8192, R, C); const int Rb = Epi::PERM ? ((R & ~31) + perm32(R & 31)) : R;
        voffA[i] = (unsigned)(R * g.ld + C) * 2u; voffB[i] = (unsigned)(Rb * g.ld + C) * 2u; }
    const size_t kstep = (size_t)(BK * 2);
    const size_t hstep = (size_t)HALF * g.ld * 2;
    const size_t tstep = 2 * hstep;
    const unsigned ldsw = (unsigned)wid * 1024u;
    const int aoff = lds_byte(wr * 64 + fr, fq * 8), boff = lds_byte(wc * 32 + fr, fq * 8);
#define PG8_SA(b, h) (((b) * 2 + (h)) * HTB)
#define PG8_SB(b, h) ((4 + (b) * 2 + (h)) * HTB)
#define PG8_STAGE(bufoff, gbase, voff) do { _Pragma("unroll") for (int _i = 0; _i < 2; ++_i) \
        __builtin_amdgcn_global_load_lds((const unsigned*)((const char*)(gbase) + (voff)[_i]), (PG8_LAS unsigned*)(lds + (bufoff) + ldsw + _i * 8192), 16, 0, 0); } while (0)
#define PG8_LDA(dst, b, h) do { _Pragma("unroll") for (int m = 0; m < 4; ++m) _Pragma("unroll") for (int k = 0; k < 2; ++k) dst[m][k] = *(const PG8_LAS bf16x8*)(lds + PG8_SA(b, h) + aoff + m * 2048 + k * 1024); } while (0)
#define PG8_LDB(dst, b, h) do { _Pragma("unroll") for (int n = 0; n < 2; ++n) _Pragma("unroll") for (int k = 0; k < 2; ++k) dst[n][k] = *(const PG8_LAS bf16x8*)(lds + PG8_SB(b, h) + boff + n * 2048 + k * 1024); } while (0)
#define PG8_MMA(ai, bj, At, Bt) do { __builtin_amdgcn_s_setprio(1); _Pragma("unroll") for (int m = 0; m < 4; ++m) _Pragma("unroll") for (int n = 0; n < 2; ++n) _Pragma("unroll") for (int k = 0; k < 2; ++k) \
        acc[ai][bj][m][n] = __builtin_amdgcn_mfma_f32_16x16x32_bf16(Bt[n][k], At[m][k], acc[ai][bj][m][n], 0, 0, 0); __builtin_amdgcn_s_setprio(0); } while (0)
#define PG8_WAIT_V(n) asm volatile("s_waitcnt vmcnt(" #n ")" ::: "memory")
#define PG8_WAIT_L(n) asm volatile("s_waitcnt lgkmcnt(" #n ")" ::: "memory")
#define PG8_BAR __builtin_amdgcn_s_barrier()
#define PG8_SCHED __builtin_amdgcn_sched_barrier(0)
    Unit cur, nxt; int ui = 0;
    if (!S.next(0, cur)) return;
    f32x4 acc[2][2][4][2];
#pragma unroll
    for (int a = 0; a < 2; ++a)
#pragma unroll
        for (int b = 0; b < 2; ++b)
#pragma unroll
            for (int m = 0; m < 4; ++m)
#pragma unroll
                for (int n = 0; n < 2; ++n) acc[a][b][m][n] = (f32x4){0.f, 0.f, 0.f, 0.f};
    bf16x8 At[4][2], B0[2][2], B1[2][2];
    const char* cA = (const char*)g.A + (size_t)cur.pm * tstep + (size_t)cur.k0 * 2 + cur.aoff; const char* cB = (const char*)g.Bt + (size_t)cur.pn * tstep + (size_t)cur.k0 * 2 + cur.boff;
    S.a_ready(cur);
    if constexpr (SP2) {
        PG8_STAGE(PG8_SB(0, 0), cB, voffB); PG8_STAGE(PG8_SB(0, 1), cB + hstep, voffB); PG8_STAGE(PG8_SA(0, 0), cA, voffA); PG8_STAGE(PG8_SA(0, 1), cA + hstep, voffA);
        if (wr == 1) PG8_BAR;
        PG8_WAIT_V(2); PG8_BAR;
        PG8_STAGE(PG8_SB(1, 0), cB + kstep, voffB); PG8_STAGE(PG8_SA(1, 0), cA + kstep, voffA); PG8_STAGE(PG8_SB(1, 1), cB + hstep + kstep, voffB);
        PG8_WAIT_V(6); PG8_BAR;
    } else {
        PG8_STAGE(PG8_SB(0, 0), cB, voffB); PG8_STAGE(PG8_SA(0, 0), cA, voffA); PG8_STAGE(PG8_SB(0, 1), cB + hstep, voffB); PG8_STAGE(PG8_SA(0, 1), cA + hstep, voffA);
        if (wr == 1) PG8_BAR;
        PG8_WAIT_V(4); PG8_BAR;
        PG8_STAGE(PG8_SB(1, 0), cB + kstep, voffB); PG8_STAGE(PG8_SA(1, 0), cA + kstep, voffA); PG8_STAGE(PG8_SB(1, 1), cB + hstep + kstep, voffB);
        PG8_WAIT_V(6); PG8_BAR;
    }
    for (;;) {
        const bool has_next = S.next(ui + 1, nxt);
        const char* nA = has_next ? (const char*)g.A + (size_t)nxt.pm * tstep + (size_t)nxt.k0 * 2 + nxt.aoff : cA; const char* nB = has_next ? (const char*)g.Bt + (size_t)nxt.pn * tstep + (size_t)nxt.k0 * 2 + nxt.boff : cB;
        for (int t = 0; t < nt; t += 2) {
            const bool last = (t == nt - 2);
            const char* a1 = cA + (size_t)(t + 1) * kstep;
            const char* a2 = last ? nA : cA + (size_t)(t + 2) * kstep; const char* b2 = last ? nB : cB + (size_t)(t + 2) * kstep;
            const char* a3 = a2 + kstep; const char* b3 = b2 + kstep;
            if (last && has_next) S.a_ready(nxt);
            if constexpr (SP2) {
            PG8_LDB(B0, 0, 0); PG8_LDB(B1, 0, 1); PG8_SCHED; PG8_LDA(At, 0, 0); PG8_STAGE(PG8_SA(1, 1), a1 + hstep, voffA);
            PG8_WAIT_V(8); PG8_WAIT_L(0); PG8_BAR; PG8_MMA(0, 0, At, B0); PG8_MMA(0, 1, At, B1); PG8_BAR; PG8_SCHED;
            PG8_LDA(At, 0, 1); PG8_STAGE(PG8_SB(0, 0), b2, voffB); PG8_STAGE(PG8_SB(0, 1), b2 + hstep, voffB); PG8_STAGE(PG8_SA(0, 0), a2, voffA);
            PG8_WAIT_V(8); PG8_WAIT_L(0); PG8_BAR; PG8_MMA(1, 0, At, B0); PG8_MMA(1, 1, At, B1); PG8_BAR; PG8_SCHED;
            PG8_LDB(B0, 1, 0); PG8_LDB(B1, 1, 1); PG8_SCHED; PG8_LDA(At, 1, 0); PG8_STAGE(PG8_SA(0, 1), a2 + hstep, voffA);
            PG8_WAIT_V(8); PG8_WAIT_L(0); PG8_BAR; PG8_MMA(0, 0, At, B0); PG8_MMA(0, 1, At, B1); PG8_BAR; PG8_SCHED;
            PG8_LDA(At, 1, 1); PG8_STAGE(PG8_SB(1, 0), b3, voffB); PG8_STAGE(PG8_SB(1, 1), b3 + hstep, voffB); PG8_STAGE(PG8_SA(1, 0), a3, voffA);
            PG8_WAIT_V(8); PG8_WAIT_L(0); PG8_BAR; PG8_MMA(1, 0, At, B0); PG8_MMA(1, 1, At, B1); PG8_BAR; PG8_SCHED;
            } else {
            PG8_LDB(B0, 0, 0); PG8_SCHED; PG8_LDA(At, 0, 0); PG8_STAGE(PG8_SA(1, 1), a1 + hstep, voffA);
            PG8_WAIT_L(8); PG8_BAR; PG8_WAIT_L(0); PG8_MMA(0, 0, At, B0); PG8_BAR; PG8_SCHED;
            PG8_LDB(B1, 0, 1); PG8_STAGE(PG8_SB(0, 0), b2, voffB);
            PG8_BAR; PG8_WAIT_L(0); PG8_MMA(0, 1, At, B1); PG8_BAR;
            PG8_LDA(At, 0, 1); PG8_STAGE(PG8_SA(0, 0), a2, voffA);
            PG8_BAR; PG8_WAIT_L(0); PG8_MMA(1, 0, At, B0); PG8_BAR; PG8_SCHED;
            PG8_STAGE(PG8_SB(0, 1), b2 + hstep, voffB);
            PG8_WAIT_V(6); PG8_BAR; PG8_MMA(1, 1, At, B1); PG8_BAR;
            PG8_LDB(B0, 1, 0); PG8_SCHED; PG8_LDA(At, 1, 0); PG8_STAGE(PG8_SA(0, 1), a2 + hstep, voffA);
            PG8_WAIT_L(8); PG8_BAR; PG8_WAIT_L(0); PG8_MMA(0, 0, At, B0); PG8_BAR; PG8_SCHED;
            PG8_LDB(B1, 1, 1); PG8_STAGE(PG8_SB(1, 0), b3, voffB);
            PG8_BAR; PG8_WAIT_L(0); PG8_MMA(0, 1, At, B1); PG8_BAR;
            PG8_LDA(At, 1, 1); PG8_STAGE(PG8_SA(1, 0), a3, voffA);
            PG8_BAR; PG8_WAIT_L(0); PG8_MMA(1, 0, At, B0); PG8_BAR; PG8_SCHED;
            PG8_STAGE(PG8_SB(1, 1), b3 + hstep, voffB);
            PG8_WAIT_V(6); PG8_BAR; PG8_MMA(1, 1, At, B1); PG8_BAR;
            }
        }
        if constexpr (ALIGN_EPI) { if (wr == 0) PG8_BAR; }
        if constexpr (!Epi::AFTER_DRAIN) { E(acc, cur, wr, wc, fr, fq); S.done(cur); }
        if (!has_next) break;
#pragma unroll
        for (int a = 0; a < 2; ++a)
#pragma unroll
            for (int b = 0; b < 2; ++b)
#pragma unroll
                for (int m = 0; m < 4; ++m)
#pragma unroll
                    for (int n = 0; n < 2; ++n) acc[a][b][m][n] = (f32x4){0.f, 0.f, 0.f, 0.f};
        cur = nxt; cA = nA; cB = nB; ++ui;
        if constexpr (ALIGN_EPI) { if (wr == 1) PG8_BAR; }
    }
    PG8_WAIT_V(0);
    if constexpr (!ALIGN_EPI) { if (wr == 0) PG8_BAR; }
    PG8_BAR;
    if constexpr (Epi::AFTER_DRAIN) { E.fused(acc, cur, wr, wc, fr, fq, lds, wid, lane); S.done(cur); }
#undef PG8_SA
#undef PG8_SB
#undef PG8_STAGE
#undef PG8_LDA
#undef PG8_LDB
#undef PG8_MMA
#undef PG8_WAIT_V
#undef PG8_WAIT_L
#undef PG8_BAR
#undef PG8_SCHED
}
}

struct Args { const void* in[25]; float* out; unsigned char* ws; int ph_lo, ph_hi; };
typedef const __attribute__((address_space(4))) Args* ArgsP;
#define IN_F(k) ((const float*)a->in[k])
#define WSB(off) ((bf16*)(a->ws + (off)))
#define WSF(off) ((float*)(a->ws + (off)))

struct Ctx { int tid, lane, wave, gw, ngw, gwT; };
__device__ __forceinline__ Ctx refresh(const Ctx& c0) { Ctx c = c0; c.tid = fresh_tid(c0.wave); c.lane = c.tid & 63; return c; }

__device__ __forceinline__ int row_pos(int r) { return r < RMAIN ? (r & 4095) + NMETA : (r < RSAMP0 ? ((r - RMAIN) & 15) : PAST + ((r - RSAMP0) & 3)); }
__device__ __forceinline__ float rope_inv(int j) { return exp2f(-(float)j * (13.287712379549449f / 16.0f)); }
__device__ __forceinline__ void rope_cs(int pos, int j, float& c, float& s) {
    const float ang = (float)pos * rope_inv(j);
    const double x = (double)ang; const double n = rint(x * 0.15915494309189535); const float r = (float)(x - n * 6.283185307179586);
    c = cosf(r); s = sinf(r);
}

struct RmId { int off; __device__ __forceinline__ int operator()(int n) const { return off + n; } };
struct RmUq { __device__ __forceinline__ int operator()(int n) const { const int h = n / 96, j = n % 96; if (j < 64) return h * 64 + j; const int jj = j - 64; return 1024 + h * 32 + (jj < 16 ? 2 * jj : 2 * (jj - 16) + 1); } };
template <class RM>
__device__ __forceinline__ void tr_item(const float* W, int ldw, int nblk, int item, bf16* WT, int ldt, RM rm, LAS float* scr, int lane) {
    const int kb = item / nblk, nb = item % nblk, k0 = 64 * kb, n0 = 32 * nb;
#pragma unroll
    for (int i = 0; i < 8; ++i) { const int kk = 8 * i + (lane >> 3), c4 = (lane & 7) * 4; const f32x4 v = __builtin_nontemporal_load((const f32x4*)(W + (size_t)(k0 + kk) * ldw + n0 + c4));
        scr[kk * 33 + c4] = v.x; scr[kk * 33 + c4 + 1] = v.y; scr[kk * 33 + c4 + 2] = v.z; scr[kk * 33 + c4 + 3] = v.w; }
    LDS_WAIT();
    const int c = lane & 7;
#pragma unroll
    for (int j = 0; j < 4; ++j) { const int n = (lane >> 3) + 8 * j; const LAS float* s = scr + (8 * c) * 33 + n;
        u32x4 o; o.x = pk2(s[0 * 33], s[1 * 33]); o.y = pk2(s[2 * 33], s[3 * 33]); o.z = pk2(s[4 * 33], s[5 * 33]); o.w = pk2(s[6 * 33], s[7 * 33]);
        *(u32x4*)(WT + (size_t)rm(n0 + n) * ldt + k0 + 8 * c) = o; }
    LDS_WAIT();
}
__device__ __forceinline__ void norm_row_bf16(const float* xrow, const float* g, float* xcopy, bf16* hrow, int lane) {
    f32x4 v[4]; float s = 0.f;
#pragma unroll
    for (int j = 0; j < 4; ++j) { v[j] = *(const f32x4*)(xrow + 4 * lane + 256 * j); s += (v[j].x * v[j].x + v[j].y * v[j].y) + (v[j].z * v[j].z + v[j].w * v[j].w); }
    const float rs = 1.0f / sqrtf(wave_sum(s) * (1.f / D) + EPS);
#pragma unroll
    for (int j = 0; j < 4; ++j) { const f32x4 gg = *(const f32x4*)(g + 4 * lane + 256 * j);
        if (xcopy) *(f32x4*)(xcopy + 4 * lane + 256 * j) = v[j];
        u32x2 o; o.x = pk2(v[j].x * rs * gg.x, v[j].y * rs * gg.y); o.y = pk2(v[j].z * rs * gg.z, v[j].w * rs * gg.w);
        *(u32x2*)(hrow + 4 * lane + 256 * j) = o; }
}
__device__ __forceinline__ void p_prep(ArgsP a, const Ctx& c0, LAS unsigned char* lds) {
    const Ctx c = refresh(c0);
    LAS float* scr = (LAS float*)(lds + c.wave * 16384);
    constexpr int I0 = 16 * 17, I1 = 4 * 48, I2 = 4 * 32, I3 = 4 * 32, I4 = 16 * 32, I5 = 16 * 96, I6 = 16 * 32, I7 = 16 * 128, I8 = 16 * 128, I9 = 64 * 32, I10 = 64 * 32;
    constexpr int NIT = I0 + I1 + I2 + I3 + I4 + I5 + I6 + I7 + I8 + I9 + I10;
    for (int it = c.gw; it < NIT; it += c.ngw) {
        int r = it;
        if (r < I0) { tr_item(IN_F(11), 544, 17, r, WSB(WS_WIN0), 1024, RmId{0}, scr, c.lane); continue; } r -= I0;
        if (r < I1) { tr_item(IN_F(13), 1536, 48, r, WSB(WS_WUQ), 256, RmUq{}, scr, c.lane); continue; } r -= I1;
        if (r < I2) { tr_item(IN_F(15), 1024, 32, r, WSB(WS_WUKV), 256, RmId{0}, scr, c.lane); continue; } r -= I2;
        if (r < I3) { tr_item(IN_F(16), 1024, 32, r, WSB(WS_WUKV), 256, RmId{1024}, scr, c.lane); continue; } r -= I3;
        if (r < I4) { tr_item(IN_F(17), 1024, 32, r, WSB(WS_WO0), 1024, RmId{0}, scr, c.lane); continue; } r -= I4;
        if (r < I5) { tr_item(IN_F(18), 3088, 96, r, WSB(WS_WGIN), 1024, RmId{0}, scr, c.lane); continue; } r -= I5;
        if (r < I6) { tr_item(IN_F(22), 1024, 32, r, WSB(WS_WGO), 1024, RmId{0}, scr, c.lane); continue; } r -= I6;
        if (r < I7) { tr_item(IN_F(23), 4096, 128, r, WSB(WS_WUP), 1024, RmId{0}, scr, c.lane); continue; } r -= I7;
        if (r < I8) { tr_item(IN_F(23) + (size_t)1024 * 4096, 4096, 128, r, WSB(WS_WUP) + (size_t)4096 * 1024, 1024, RmId{0}, scr, c.lane); continue; } r -= I8;
        if (r < I9) { tr_item(IN_F(24), 1024, 32, r, WSB(WS_WDN), 4096, RmId{0}, scr, c.lane); continue; } r -= I9;
        tr_item(IN_F(24) + (size_t)4096 * 1024, 1024, 32, r, WSB(WS_WDN) + (size_t)1024 * 4096, 4096, RmId{0}, scr, c.lane);
    }
    const int gt = c.gw * 64 + c.lane, ngt = c.ngw * 64;
    for (int i = gt; i < (NIN0 - 544) * 1024 / 2; i += ngt) ((unsigned*)(WSB(WS_WIN0) + (size_t)544 * 1024))[i] = 0u;
    for (int i = gt; i < (NGIN - NGIN_REAL) * 1024 / 2; i += ngt) ((unsigned*)(WSB(WS_WGIN) + (size_t)NGIN_REAL * 1024))[i] = 0u;
    for (int i = gt; i < 16 * 1024; i += ngt) { const int n = i >> 10, k = i & 1023; WSB(WS_WGIN)[(size_t)(3072 + n) * 1024 + k] = (bf16)f2bf(IN_F(18)[(size_t)k * 3088 + 3072 + n]); }
    for (int i = c.gw * 64 + c.lane; i < R * 16; i += c.ngw * 64) { const int r = i >> 4, j = i & 15; float cs, sn; rope_cs(row_pos(r), j, cs, sn); WSF(WS_ROPE)[(size_t)r * 32 + j] = cs; WSF(WS_ROPE)[(size_t)r * 32 + 16 + j] = sn; }
    {
        const float* xp = IN_F(0); const float* xm = IN_F(6); const float* xsm = IN_F(1); bf16* X = WSB(WS_X); bf16* H = WSB(WS_H);
        f32x4 gg[4];
#pragma unroll
        for (int j = 0; j < 4; ++j) gg[j] = *(const f32x4*)(IN_F(7) + 4 * c.lane + 256 * j);
        constexpr int NR = 4;
        for (int r0 = c.gw; r0 < R; r0 += NR * c.ngw) {
            f32x4 v[NR][4]; float s[NR];
#pragma unroll
            for (int q = 0; q < NR; ++q) { const int r = r0 + q * c.ngw < R ? r0 + q * c.ngw : r0;
                const float* xs = r < RMAIN ? xp + (size_t)r * D : (r < RSAMP0 ? xm + (size_t)((r - RMAIN) & 15) * D : xsm + (size_t)(r - RSAMP0) * D);
                s[q] = 0.f;
#pragma unroll
                for (int j = 0; j < 4; ++j) { v[q][j] = *(const f32x4*)(xs + 4 * c.lane + 256 * j); s[q] += (v[q][j].x * v[q][j].x + v[q][j].y * v[q][j].y) + (v[q][j].z * v[q][j].z + v[q][j].w * v[q][j].w); } }
#pragma unroll
            for (int sh = 1; sh < 64; sh <<= 1) {
#pragma unroll
                for (int q = 0; q < NR; ++q) s[q] += __shfl_xor(s[q], sh); }
#pragma unroll
            for (int q = 0; q < NR; ++q) { const int r = r0 + q * c.ngw < R ? r0 + q * c.ngw : r0; const float rs = 1.0f / sqrtf(s[q] * (1.f / D) + EPS);
#pragma unroll
                for (int j = 0; j < 4; ++j) { if (r >= RMAIN) { u32x2 xo; xo.x = pk2(v[q][j].x, v[q][j].y); xo.y = pk2(v[q][j].z, v[q][j].w); *(u32x2*)(X + (size_t)r * D + 4 * c.lane + 256 * j) = xo; }
                    u32x2 o; o.x = pk2(v[q][j].x * rs * gg[j].x, v[q][j].y * rs * gg[j].y); o.y = pk2(v[q][j].z * rs * gg[j].z, v[q][j].w * rs * gg[j].w);
                    *(u32x2*)(H + (size_t)r * D + 4 * c.lane + 256 * j) = o; } }
        }
    }
}

struct EpiF32 { float* C; int ldc; __device__ __forceinline__ void store4(int row, int col, f32x4 v) const { *(f32x4*)(C + (size_t)row * ldc + col) = v; } };
struct EpiBf16 { bf16* C; int ldc;
    __device__ __forceinline__ void store8(int row, int col, f32x4 a, f32x4 b) const { u32x4 o; o.x = pk2(a.x, a.y); o.y = pk2(a.z, a.w); o.z = pk2(b.x, b.y); o.w = pk2(b.z, b.w); *(u32x4*)(C + (size_t)row * ldc + col) = o; }
    __device__ __forceinline__ void store4(int row, int col, f32x4 v) const { u32x2 o; o.x = pk2(v.x, v.y); o.y = pk2(v.z, v.w); *(u32x2*)(C + (size_t)row * ldc + col) = o; } };
struct EpiRelu2 { bf16* C; int ldc;
    __device__ __forceinline__ void store8(int row, int col, f32x4 a, f32x4 b) const {
        f32x4 r; r.x = fmaxf(a.x, 0.f); r.y = fmaxf(a.y, 0.f); r.z = fmaxf(a.z, 0.f); r.w = fmaxf(a.w, 0.f); r = r * r;
        f32x4 s; s.x = fmaxf(b.x, 0.f); s.y = fmaxf(b.y, 0.f); s.z = fmaxf(b.z, 0.f); s.w = fmaxf(b.w, 0.f); s = s * s;
        u32x4 o; o.x = pk2(r.x, r.y); o.y = pk2(r.z, r.w); o.z = pk2(s.x, s.y); o.w = pk2(s.z, s.w); *(u32x4*)(C + (size_t)row * ldc + col) = o; }
    __device__ __forceinline__ void store4(int row, int col, f32x4 v) const {
    f32x4 r; r.x = fmaxf(v.x, 0.f); r.y = fmaxf(v.y, 0.f); r.z = fmaxf(v.z, 0.f); r.w = fmaxf(v.w, 0.f); r = r * r;
    u32x2 o; o.x = pk2(r.x, r.y); o.y = pk2(r.z, r.w); *(u32x2*)(C + (size_t)row * ldc + col) = o; } };
struct EpiQ { bf16* QN; bf16* QPE; const float* ROPE;
    __device__ __forceinline__ void store8(int row, int col, f32x4 a, f32x4 b) const {
        if (col < 1024) { u32x4 o; o.x = pk2(a.x * QSCALE, a.y * QSCALE); o.y = pk2(a.z * QSCALE, a.w * QSCALE); o.z = pk2(b.x * QSCALE, b.y * QSCALE); o.w = pk2(b.z * QSCALE, b.w * QSCALE); *(u32x4*)(QN + (size_t)row * 1024 + col) = o; }
        else { store4(row, col, a); store4(row, col + 4, b); }
    }
    __device__ __forceinline__ void store4(int row, int col, f32x4 v) const {
        if (col < 1024) { u32x2 o; o.x = pk2(v.x * QSCALE, v.y * QSCALE); o.y = pk2(v.z * QSCALE, v.w * QSCALE); *(u32x2*)(QN + (size_t)row * 1024 + col) = o; }
        else { const int p0 = (col - 1024) >> 1; const float* rt = ROPE + (size_t)row * 32;
#pragma unroll
            for (int e = 0; e < 2; ++e) { const int p = p0 + e, h = p >> 4, jj = p & 15; const float x1 = e ? v.z : v.x, x2 = e ? v.w : v.y, cs = rt[jj], sn = rt[16 + jj];
                QPE[(size_t)row * 512 + h * 32 + jj] = (bf16)f2bf((x1 * cs - x2 * sn) * QSCALE); QPE[(size_t)row * 512 + h * 32 + 16 + jj] = (bf16)f2bf((x1 * sn + x2 * cs) * QSCALE); } }
    } };
struct EpiBf16S { bf16* C; int ldc; float s;
    __device__ __forceinline__ void store8(int row, int col, f32x4 a, f32x4 b) const { u32x4 o; o.x = pk2(a.x * s, a.y * s); o.y = pk2(a.z * s, a.w * s); o.z = pk2(b.x * s, b.y * s); o.w = pk2(b.z * s, b.w * s); *(u32x4*)(C + (size_t)row * ldc + col) = o; }
    __device__ __forceinline__ void store4(int row, int col, f32x4 v) const { u32x2 o; o.x = pk2(v.x * s, v.y * s); o.y = pk2(v.z * s, v.w * s); *(u32x2*)(C + (size_t)row * ldc + col) = o; } };
struct EpiGla { bf16 *QG, *KG, *VG, *RG; float* GD;
    __device__ __forceinline__ void store8(int row, int col, f32x4 a, f32x4 b) const {
        if (col < 3072) { bf16* dst; int cc;
            if (col < 512) { dst = QG + (size_t)row * 512; cc = col; a = a * GLA_SCALE; b = b * GLA_SCALE; }
            else if (col < 1024) { dst = KG + (size_t)row * 512; cc = col - 512; }
            else if (col < 2048) { dst = VG + (size_t)row * 1024; cc = col - 1024; }
            else { dst = RG + (size_t)row * 1024; cc = col - 2048; }
            u32x4 o; o.x = pk2(a.x, a.y); o.y = pk2(a.z, a.w); o.z = pk2(b.x, b.y); o.w = pk2(b.z, b.w); *(u32x4*)(dst + cc) = o;
        } else if (col < 3088) { *(f32x4*)(GD + (size_t)row * 16 + (col - 3072)) = a; *(f32x4*)(GD + (size_t)row * 16 + (col - 3072) + 4) = b; }
    }
    __device__ __forceinline__ void store4(int row, int col, f32x4 v) const {
        if (col < 3072) { bf16* dst; int cc;
            if (col < 512) { dst = QG + (size_t)row * 512; cc = col; v = v * GLA_SCALE; }
            else if (col < 1024) { dst = KG + (size_t)row * 512; cc = col - 512; }
            else if (col < 2048) { dst = VG + (size_t)row * 1024; cc = col - 1024; }
            else { dst = RG + (size_t)row * 1024; cc = col - 2048; }
            u32x2 o; o.x = pk2(v.x, v.y); o.y = pk2(v.z, v.w); *(u32x2*)(dst + cc) = o;
        } else if (col < 3088) { *(f32x4*)(GD + (size_t)row * 16 + (col - 3072)) = v; }
    } };
template <class Epi>
__device__ __forceinline__ void gemm_naive(const bf16* A, const bf16* Bt, int M, int N, int K, const Epi& E, LAS unsigned char* lds, int tid) {
    LAS float* As = (LAS float*)lds;
    LAS float* Bs = As + 32 * 68;
    const int ntm = M / 64, ntn = N / 128, ty = tid >> 5, tx = tid & 31;
    for (int tile = blockIdx.x; tile < ntm * ntn; tile += gridDim.x) {
        const int tm = tile / ntn, tn = tile % ntn;
        f32x4 acc[4];
#pragma unroll
        for (int i = 0; i < 4; ++i) acc[i] = (f32x4){0.f, 0.f, 0.f, 0.f};
        for (int k0 = 0; k0 < K; k0 += 32) {
            { const int row = tid >> 3, kq = (tid & 7) * 4; const u32x2 v = *(const u32x2*)(A + (size_t)(tm * 64 + row) * K + k0 + kq);
              As[(kq + 0) * 68 + row] = bflo(v.x); As[(kq + 1) * 68 + row] = bfhi(v.x); As[(kq + 2) * 68 + row] = bflo(v.y); As[(kq + 3) * 68 + row] = bfhi(v.y); }
            { const int row = tid >> 2, kq = (tid & 3) * 8; const u32x4 v = *(const u32x4*)(Bt + (size_t)(tn * 128 + row) * K + k0 + kq);
              Bs[(kq + 0) * 132 + row] = bflo(v.x); Bs[(kq + 1) * 132 + row] = bfhi(v.x); Bs[(kq + 2) * 132 + row] = bflo(v.y); Bs[(kq + 3) * 132 + row] = bfhi(v.y);
              Bs[(kq + 4) * 132 + row] = bflo(v.z); Bs[(kq + 5) * 132 + row] = bfhi(v.z); Bs[(kq + 6) * 132 + row] = bflo(v.w); Bs[(kq + 7) * 132 + row] = bfhi(v.w); }
            __syncthreads();
#pragma unroll 8
            for (int k = 0; k < 32; ++k) {
                const f32x4 av = *(const LAS f32x4*)(As + k * 68 + 4 * ty); const f32x4 bv = *(const LAS f32x4*)(Bs + k * 132 + 4 * tx);
                acc[0] += av.x * bv; acc[1] += av.y * bv; acc[2] += av.z * bv; acc[3] += av.w * bv;
            }
            __syncthreads();
        }
#pragma unroll
        for (int i = 0; i < 4; ++i) E.store4(tm * 64 + 4 * ty + i, tn * 128 + 4 * tx, acc[i]);
    }
}


template <class E> struct EpiWrap {
    static constexpr bool PERM = false, AFTER_DRAIN = false; E e;
    __device__ __forceinline__ void operator()(const pg8::f32x4 (&acc)[2][2][4][2], const pg8::Unit& u, int wr, int wc, int fr, int fq) const {
#pragma unroll
        for (int ai = 0; ai < 2; ++ai)
#pragma unroll
            for (int m = 0; m < 4; ++m) { const int row = u.pm * 256 + ai * 128 + wr * 64 + m * 16 + fr;
#pragma unroll
                for (int bj = 0; bj < 2; ++bj)
#pragma unroll
                    for (int n = 0; n < 2; ++n) e.store4(row, u.pn * 256 + bj * 128 + wc * 32 + n * 16 + 4 * fq, acc[ai][bj][m][n]); }
    }
};
template <int KSUB> struct EpiSlab {
    static constexpr bool PERM = false, AFTER_DRAIN = false; float* MT;
    __device__ __forceinline__ void operator()(const pg8::f32x4 (&acc)[2][2][4][2], const pg8::Unit& u, int wr, int wc, int fr, int fq) const {
        float* base = MT + ((size_t)(u.k0 / KSUB) * (RP - RMAIN) + (size_t)(u.pm * 256 - RMAIN)) * D + u.pn * 256 + wc * 32 + 4 * fq;
#pragma unroll
        for (int ai = 0; ai < 2; ++ai)
#pragma unroll
            for (int m = 0; m < 4; ++m) { float* rp = base + (size_t)(ai * 128 + wr * 64 + m * 16 + fr) * D;
#pragma unroll
                for (int bj = 0; bj < 2; ++bj)
#pragma unroll
                    for (int n = 0; n < 2; ++n) *(f32x4*)(rp + bj * 128 + n * 16) = acc[ai][bj][m][n]; }
    }
};
template <class E> struct EpiWrap8 {
    static constexpr bool PERM = true, AFTER_DRAIN = false; E e;
    __device__ __forceinline__ void operator()(const pg8::f32x4 (&acc)[2][2][4][2], const pg8::Unit& u, int wr, int wc, int fr, int fq) const {
#pragma unroll
        for (int ai = 0; ai < 2; ++ai)
#pragma unroll
            for (int m = 0; m < 4; ++m) { const int row = u.pm * 256 + ai * 128 + wr * 64 + m * 16 + fr;
#pragma unroll
                for (int bj = 0; bj < 2; ++bj) e.store8(row, u.pn * 256 + bj * 128 + wc * 32 + 8 * fq, acc[ai][bj][m][0], acc[ai][bj][m][1]); }
    }
};
template <class E>
__device__ __forceinline__ void gemm_mfma8(const bf16* A, const bf16* Bt, int M, int N, int K, const E& e, LAS unsigned char* lds, int wave) {
    pg8::Gemm g{A, Bt, M, N, K, K}; pg8::StaticOrder S; S.init(M, N, (int)gridDim.x, (int)blockIdx.x);
    EpiWrap8<E> W{e};
    pg8::gemm_phase<EpiWrap8<E>, pg8::StaticOrder, true, true>(lds, g, S, W, wave);
}
template <class E>
__device__ __forceinline__ void gemm_mfma(const bf16* A, const bf16* Bt, int M, int N, int K, const E& e, LAS unsigned char* lds, int wave) {
    pg8::Gemm g{A, Bt, M, N, K, K}; pg8::StaticOrder S; S.init(M, N, (int)gridDim.x, (int)blockIdx.x);
    EpiWrap<E> W{e};
    pg8::gemm_phase<EpiWrap<E>, pg8::StaticOrder, true, true>(lds, g, S, W, wave);
}
template <int SPLIT, int NN, int KSUB, int PM0, int NUNITS> struct TailOrder {
    int G, c;
    __device__ __forceinline__ bool next(int i, pg8::Unit& u) const { const int L = i * G + c; if (L >= NUNITS) return false; const int ks = L % SPLIT, t = L / SPLIT; u.pn = t % NN; u.pm = PM0 + t / NN; u.k0 = ks * KSUB; u.prob = 0; u.aoff = 0; u.boff = 0; return true; }
    __device__ __forceinline__ void a_ready(const pg8::Unit&) const {}
    __device__ __forceinline__ void done(const pg8::Unit&) const {}
};
struct EpiAtomicF32 { float* C; int ldc; __device__ __forceinline__ void store4(int row, int col, f32x4 v) const { float* p = C + (size_t)row * ldc + col;
    __hip_atomic_fetch_add(p, v.x, __ATOMIC_RELAXED, __HIP_MEMORY_SCOPE_AGENT); __hip_atomic_fetch_add(p + 1, v.y, __ATOMIC_RELAXED, __HIP_MEMORY_SCOPE_AGENT);
    __hip_atomic_fetch_add(p + 2, v.z, __ATOMIC_RELAXED, __HIP_MEMORY_SCOPE_AGENT); __hip_atomic_fetch_add(p + 3, v.w, __ATOMIC_RELAXED, __HIP_MEMORY_SCOPE_AGENT); } };
template <int K, int SPLIT>
__device__ __forceinline__ void gemm_n1024_tail(const bf16* A, const bf16* Bt, bf16* C, float* MT, LAS unsigned char* lds, int wave) {
    { pg8::Gemm g{A, Bt, RMAIN, D, K, K}; pg8::StaticOrder S; S.init(RMAIN, D, (int)gridDim.x, (int)blockIdx.x); EpiWrap8<EpiBf16> W{EpiBf16{C, D}};
      pg8::gemm_phase<EpiWrap8<EpiBf16>, pg8::StaticOrder, true, true>(lds, g, S, W, wave); }
    { typedef TailOrder<SPLIT, D / 256, K / SPLIT, RMAIN / 256, (RP - RMAIN) / 256 * (D / 256) * SPLIT> TO;
      pg8::Gemm g{A, Bt, RP, D, K / SPLIT, K}; TO S{(int)gridDim.x, (int)blockIdx.x}; EpiSlab<K / SPLIT> W{MT};
      pg8::gemm_phase<EpiSlab<K / SPLIT>, TO, false, true>(lds, g, S, W, wave); }
}

struct P3Order {
    int G, c;
    static constexpr int NQ = (RP / 256) * (NUQ / 256), NL = (DB * DS / 256) * (NH * KVL / 256), NK = (RP / 256) * (NUKV / 256);
    __device__ __forceinline__ bool next(int i, pg8::Unit& u) const {
        int L = i * G + c; u.k0 = 0;
        if (L < NK) { u.prob = 2; u.pm = L / (NUKV / 256); u.pn = L % (NUKV / 256); u.aoff = (long)(WS_CKVN - WS_CQN); u.boff = (long)(WS_WUKV - WS_WUQ); return true; } L -= NK;
        if (L < NQ) { u.prob = 0; u.pm = L / (NUQ / 256); u.pn = L % (NUQ / 256); u.aoff = 0; u.boff = 0; return true; } L -= NQ;
        if (L < NL) { u.prob = 1; u.pm = L / (NH * KVL / 256); u.pn = L % (NH * KVL / 256); u.aoff = (long)RSAMP0 * QL * 2; u.boff = (long)(WS_WUQL - WS_WUQ); return true; }
        return false;
    }
    __device__ __forceinline__ void a_ready(const pg8::Unit&) const {}
    __device__ __forceinline__ void done(const pg8::Unit&) const {}
};
struct EpiP3 {
    static constexpr bool PERM = true, AFTER_DRAIN = false; EpiQ eq; EpiBf16S el; EpiBf16 ek;
    __device__ __forceinline__ void operator()(const pg8::f32x4 (&acc)[2][2][4][2], const pg8::Unit& u, int wr, int wc, int fr, int fq) const {
        asm volatile("" : "+v"(fr), "+v"(fq));
        if (u.prob == 0) { EpiWrap8<EpiQ> w{eq}; w(acc, u, wr, wc, fr, fq); }
        else if (u.prob == 1) { EpiWrap8<EpiBf16S> w{el}; w(acc, u, wr, wc, fr, fq); }
        else { EpiWrap8<EpiBf16> w{ek}; w(acc, u, wr, wc, fr, fq); }
    }
};
__device__ __forceinline__ void gemm_p3(ArgsP a, LAS unsigned char* lds, int wave) {
    pg8::Gemm g{WSB(WS_CQN), WSB(WS_WUQ), RP, NUQ, QL, QL}; P3Order S{(int)gridDim.x, (int)blockIdx.x};
    EpiP3 E{EpiQ{WSB(WS_QN), WSB(WS_QPE), WSF(WS_ROPE)}, EpiBf16S{WSB(WS_QLAT), NH * KVL, QSCALE}, EpiBf16{WSB(WS_KNV), NUKV}};
    pg8::gemm_phase<EpiP3, P3Order, false, true>(lds, g, S, E, wave);
}

struct EpiMlaIn {
    static constexpr bool PERM = false, AFTER_DRAIN = true;
    bf16 *CQN, *CKVN, *KPEB; const float *qg, *kg, *ROPE; float* out;
    __device__ __forceinline__ void fused(pg8::f32x4 (&acc)[2][2][4][2], const pg8::Unit& u, int wr, int wc, int fr, int fq, PG8_LAS unsigned char* lds, int wid, int lane) const {
        asm volatile("" : "+v"(fr), "+v"(fq));
        if (u.pn < 2) {
            PG8_LAS float* P = (PG8_LAS float*)lds;
            float s[2][4];
#pragma unroll
            for (int ai = 0; ai < 2; ++ai)
#pragma unroll
                for (int m = 0; m < 4; ++m) { float t = 0.f;
#pragma unroll
                    for (int bj = 0; bj < 2; ++bj)
#pragma unroll
                        for (int n = 0; n < 2; ++n) { const pg8::f32x4 x = acc[ai][bj][m][n]; t += (x[0] * x[0] + x[1] * x[1]) + (x[2] * x[2] + x[3] * x[3]); }
                    t += __shfl_xor(t, 16); t += __shfl_xor(t, 32);
                    if (fq == 0) P[(ai * 128 + wr * 64 + m * 16 + fr) * 4 + wc] = t; }
            asm volatile("s_waitcnt lgkmcnt(0)\n\ts_barrier" ::: "memory");
#pragma unroll
            for (int ai = 0; ai < 2; ++ai)
#pragma unroll
                for (int m = 0; m < 4; ++m) { const pg8::f32x4 p4 = *(const PG8_LAS pg8::f32x4*)(P + (ai * 128 + wr * 64 + m * 16 + fr) * 4); s[ai][m] = 1.0f / sqrtf(((p4[0] + p4[1]) + (p4[2] + p4[3])) * (1.f / 256) + EPS); }
            const float* g = u.pn == 0 ? qg : kg; bf16* dst = u.pn == 0 ? CQN : CKVN;
#pragma unroll
            for (int bj = 0; bj < 2; ++bj)
#pragma unroll
                for (int n = 0; n < 2; ++n) { const int col = bj * 128 + wc * 32 + n * 16 + 4 * fq; const pg8::f32x4 gv = *(const pg8::f32x4*)(g + col);
#pragma unroll
                    for (int ai = 0; ai < 2; ++ai)
#pragma unroll
                        for (int m = 0; m < 4; ++m) { const int row = u.pm * 256 + ai * 128 + wr * 64 + m * 16 + fr; if (row >= R) continue;
                            const pg8::f32x4 y = acc[ai][bj][m][n] * s[ai][m] * gv;
                            u32x2 o; o.x = pk2(y[0], y[1]); o.y = pk2(y[2], y[3]); *(u32x2*)(dst + (size_t)row * 256 + col) = o;
                            if (u.pn == 1) { const int pos = row_pos(row); float* oc = row < RSAMP0 ? out + O_CKVP + ((size_t)(row < RMAIN ? (row >> 12) : ((row - RMAIN) >> 4)) * TP + pos) * 256 : out + O_CKVS + (size_t)(row - RSAMP0) * 256;
                                *(pg8::f32x4*)(oc + col) = y; } } }
        } else if (wc == 0) {
#pragma unroll
            for (int ai = 0; ai < 2; ++ai)
#pragma unroll
                for (int m = 0; m < 4; ++m) { const int row = u.pm * 256 + ai * 128 + wr * 64 + m * 16 + fr; if (row >= R) continue;
                    const int pos = row_pos(row); const float* rt = ROPE + (size_t)row * 32 + 4 * fq; const pg8::f32x4 cs = *(const pg8::f32x4*)rt, sn = *(const pg8::f32x4*)(rt + 16);
                    const pg8::f32x4 x1 = acc[ai][0][m][0], x2 = acc[ai][0][m][1]; const pg8::f32x4 o1 = x1 * cs - x2 * sn, o2 = x1 * sn + x2 * cs;
                    float* ok = row < RSAMP0 ? out + O_KPEP + ((size_t)(row < RMAIN ? (row >> 12) : ((row - RMAIN) >> 4)) * TP + pos) * 32 : out + O_KPES + (size_t)(row - RSAMP0) * 32;
                    *(pg8::f32x4*)(ok + 4 * fq) = o1; *(pg8::f32x4*)(ok + 16 + 4 * fq) = o2;
                    u32x2 w; w.x = pk2(o1[0], o1[1]); w.y = pk2(o1[2], o1[3]); *(u32x2*)(KPEB + (size_t)row * 32 + 4 * fq) = w; w.x = pk2(o2[0], o2[1]); w.y = pk2(o2[2], o2[3]); *(u32x2*)(KPEB + (size_t)row * 32 + 16 + 4 * fq) = w; }
        }
    }
};
__device__ __forceinline__ void gemm_p1(ArgsP a, LAS unsigned char* lds, int wave) {
    pg8::Gemm g{WSB(WS_H), WSB(WS_WIN0), RP, NIN0, D, D}; pg8::StaticOrder S; S.init(RP, NIN0, (int)gridDim.x, (int)blockIdx.x);
    EpiMlaIn E{WSB(WS_CQN), WSB(WS_CKVN), WSB(WS_KPE), IN_F(12), IN_F(14), WSF(WS_ROPE), a->out};
    pg8::gemm_phase<EpiMlaIn, pg8::StaticOrder, false, true>(lds, g, S, E, wave);
}
#ifndef USE_NAIVE_ATTN
#define USE_NAIVE_ATTN 0
#endif
#ifndef USE_NAIVE_DECODE
#define USE_NAIVE_DECODE 0
#endif
#ifndef USE_NAIVE_GLA
#define USE_NAIVE_GLA 0
#endif
#ifndef PROBE
#define PROBE 0
#endif
#ifndef PROBE_LO
#define PROBE_LO -1
#define PROBE_HI -1
#endif
#ifndef USE_NAIVE_GEMM
#define USE_NAIVE_GEMM 0
#endif
#if USE_NAIVE_GEMM
#define GEMM(A, Bt, M, N, K, E) gemm_naive(A, Bt, M, N, K, E, lds, fresh_tid(c.wave))
#else
#define GEMM(A, Bt, M, N, K, E) gemm_mfma(A, Bt, M, N, K, E, lds, c.wave)
#endif


namespace att {
typedef short bf16x8 __attribute__((ext_vector_type(8)));
typedef short s16x4 __attribute__((ext_vector_type(4)));
typedef float f32x16 __attribute__((ext_vector_type(16)));
constexpr int KSLOT = 12288, VSLOT = 8192, LDS_K = 0, LDS_V = 2 * KSLOT, LDS_WS = LDS_V + 2 * VSLOT, LDS_OST = LDS_WS + 8 * 256, LDS_TOTAL = LDS_OST + 8 * 4096;
__device__ __forceinline__ int crow(int r, int hi) { return (r & 3) + 8 * (r >> 2) + 4 * hi; }
typedef float f32x2_t __attribute__((ext_vector_type(2))); typedef __bf16 bf16x2_t __attribute__((ext_vector_type(2)));
__device__ __forceinline__ unsigned cvtpk(float lo, float hi) { f32x2_t v = {lo, hi}; bf16x2_t b = __builtin_convertvector(v, bf16x2_t); return __builtin_bit_cast(unsigned, b); }
__device__ __forceinline__ s16x4 vtr(const LAS unsigned char* p) { typedef short v4i16_t __attribute__((ext_vector_type(4))); return __builtin_bit_cast(s16x4, __builtin_amdgcn_ds_read_tr16_b64_v4i16((LAS v4i16_t*)p)); }
__device__ __forceinline__ float pmax32(float m) { auto rr = __builtin_amdgcn_permlane32_swap(__float_as_uint(m), __float_as_uint(m), false, false); return fmaxf(__uint_as_float(rr[0]), __uint_as_float(rr[1])); }
__device__ __forceinline__ float psum32(float m) { auto rr = __builtin_amdgcn_permlane32_swap(__float_as_uint(m), __float_as_uint(m), false, false); return __uint_as_float(rr[0]) + __uint_as_float(rr[1]); }
#define ATT_WAIT_BAR() asm volatile("s_waitcnt vmcnt(0) lgkmcnt(0)\n\ts_barrier" ::: "memory")
__device__ __forceinline__ void glds16(const void* gsrc, unsigned lds_dst) { unsigned keep;
    asm volatile("s_mov_b32 %0, m0\n\ts_mov_b32 m0, %2\n\ts_nop 0\n\tglobal_load_lds_dwordx4 %1, off\n\ts_mov_b32 m0, %0" : "=&s"(keep) : "v"(gsrc), "s"(lds_dst) : "memory"); }

__device__ __forceinline__ void attn_unit(int b, int h, int qb, const bf16* QN, const bf16* QPE, const bf16* KNV, const bf16* KPE, bf16* O, LAS unsigned char* lds, int wave_id) {
    const int tid = fresh_tid(wave_id), lane = tid & 63, r32 = lane & 31, hi = lane >> 5; const int wid = wave_id;
    const int rowbase = b * SEQ, q0 = qb * 256, qrow = rowbase + q0 + wid * 32 + r32, qrel = q0 + wid * 32 + r32;
    bf16x8 qr[6];
#pragma unroll
    for (int d0 = 0; d0 < 4; ++d0) qr[d0] = *(const bf16x8*)(QN + (size_t)qrow * 1024 + h * 64 + d0 * 16 + hi * 8);
#pragma unroll
    for (int d0 = 0; d0 < 2; ++d0) qr[4 + d0] = *(const bf16x8*)(QPE + (size_t)qrow * 512 + h * 32 + d0 * 16 + hi * 8);
    LAS float* wsf = (LAS float*)(lds + LDS_WS) + wid * 64;
    const int NT = 4 * qb + 4;
#define ATT_DMA(t, slot) do { const size_t row0_ = (t) == 0 ? (size_t)(RMAIN + 16 * b) : (size_t)(rowbase + 64 * ((t) - 1)); \
        __builtin_amdgcn_global_load_lds((const unsigned*)(KNV + (row0_ + lane) * 2048 + h * 64 + wid * 8), (LAS unsigned*)(lds + LDS_K + (slot) * KSLOT + wid * 1024), 16, 0, 0); \
        if (wid < 4) __builtin_amdgcn_global_load_lds((const unsigned*)(KPE + (row0_ + lane) * 32 + wid * 8), (LAS unsigned*)(lds + LDS_K + (slot) * KSLOT + (8 + wid) * 1024), 16, 0, 0); \
        __builtin_amdgcn_global_load_lds((const unsigned*)(KNV + (row0_ + 16 * (wid & 3) + (lane >> 2)) * 2048 + 1024 + h * 64 + (wid >> 2) * 32 + (lane & 3) * 8), (LAS unsigned*)(lds + LDS_V + (slot) * VSLOT + wid * 1024), 16, 0, 0); } while (0)
    f32x16 o[2]; o[0] = f32x16{}; o[1] = f32x16{};
    float mref = -INFINITY, l = 0.f;
    ATT_DMA(0, 0);
    for (int t = 0; t <= NT; ++t) {
        ATT_WAIT_BAR();
        const int slot = t & 1;
        if (t < NT) ATT_DMA(t + 1, slot ^ 1);
        const int kt0 = 64 * (t - 1);
        if (t > 0 && kt0 > q0 + wid * 32 + 31) continue;
        f32x16 p0 = f32x16{}, p1 = f32x16{};
        const LAS unsigned char* kb = lds + LDS_K + slot * KSLOT + hi * 1024 + r32 * 16;
#pragma unroll
        for (int d0 = 0; d0 < 6; ++d0) {
            const bf16x8 b0 = *(const LAS bf16x8*)(kb + d0 * 2048), b1 = *(const LAS bf16x8*)(kb + d0 * 2048 + 512);
            p0 = __builtin_amdgcn_mfma_f32_32x32x16_bf16(b0, qr[d0], p0, 0, 0, 0);
            p1 = __builtin_amdgcn_mfma_f32_32x32x16_bf16(b1, qr[d0], p1, 0, 0, 0);
        }
        if (t == 0) {
#pragma unroll
            for (int r = 0; r < 16; ++r) { if (crow(r, hi) >= NMETA) p0[r] = -INFINITY; p1[r] = -INFINITY; }
        } else if (kt0 + 63 > q0 + wid * 32) {
#pragma unroll
            for (int r = 0; r < 16; ++r) { const int kv = kt0 + crow(r, hi); if (kv > qrel) p0[r] = -INFINITY; if (kv + 32 > qrel) p1[r] = -INFINITY; }
        }
        float rm = fmaxf(p0[0], p1[0]);
#pragma unroll
        for (int r = 1; r < 16; ++r) rm = fmaxf(rm, fmaxf(p0[r], p1[r]));
        rm = pmax32(rm);
        if (__any(rm > mref + 8.0f)) {
            const float mnew = fmaxf(mref, rm); const float f = __builtin_amdgcn_exp2f(mref - mnew);
            mref = mnew; l *= f;
            if (hi == 0) wsf[r32] = f;
            LDS_WAIT();
#pragma unroll
            for (int r = 0; r < 16; ++r) { const float fr = wsf[crow(r, hi)]; o[0][r] *= fr; o[1][r] *= fr; }
        }
        float sacc = 0.f;
#pragma unroll
        for (int r = 0; r < 16; ++r) { p0[r] = __builtin_amdgcn_exp2f(p0[r] - mref); p1[r] = __builtin_amdgcn_exp2f(p1[r] - mref); sacc += p0[r] + p1[r]; }
        l += sacc;
        u32x4 pw[4];
#pragma unroll
        for (int i = 0; i < 4; ++i) { pw[0][i] = cvtpk(p0[2 * i], p0[2 * i + 1]); pw[1][i] = cvtpk(p0[8 + 2 * i], p0[8 + 2 * i + 1]); pw[2][i] = cvtpk(p1[2 * i], p1[2 * i + 1]); pw[3][i] = cvtpk(p1[8 + 2 * i], p1[8 + 2 * i + 1]); }
        const LAS unsigned char* vb = lds + LDS_V + slot * VSLOT + ((lane >> 4) & 1) * 32 + (lane & 3) * 8 + (4 * hi + ((lane & 15) >> 2)) * 64;
#pragma unroll
        for (int d0 = 0; d0 < 2; ++d0)
#pragma unroll
            for (int ks = 0; ks < 4; ++ks) {
                const s16x4 vlo = vtr(vb + d0 * 4096 + ks * 1024), vhi = vtr(vb + d0 * 4096 + ks * 1024 + 512);
                const bf16x8 vf = (bf16x8){vlo[0], vlo[1], vlo[2], vlo[3], vhi[0], vhi[1], vhi[2], vhi[3]};
                o[d0] = __builtin_amdgcn_mfma_f32_32x32x16_bf16(__builtin_bit_cast(bf16x8, pw[ks]), vf, o[d0], 0, 0, 0);
            }
    }
    l = psum32(l);
    if (hi == 0) wsf[32 + r32] = l;
    LDS_WAIT();
    bf16* Ow = O + (size_t)(rowbase + q0 + wid * 32) * 1024 + h * 64;
    LAS bf16* stg = (LAS bf16*)(lds + LDS_OST) + wid * 2048;
#pragma unroll
    for (int r = 0; r < 16; ++r) { const int orow = crow(r, hi); const float il = 1.0f / wsf[32 + orow];
        stg[orow * 64 + r32] = (bf16)f2bf(o[0][r] * il); stg[orow * 64 + 32 + r32] = (bf16)f2bf(o[1][r] * il); }
    LDS_WAIT();
#pragma unroll
    for (int i = 0; i < 4; ++i) { const int row = i * 8 + (lane >> 3), ch = lane & 7; const u32x4 v = *(const LAS u32x4*)(stg + row * 64 + ch * 8); *(u32x4*)(Ow + (size_t)row * 1024 + ch * 8) = v; }
    ATT_WAIT_BAR();
#undef ATT_DMA
}
constexpr int P_LDS_K = 0, P_LDS_V = 3 * KSLOT, P_LDS_WS = P_LDS_V + 2 * VSLOT, P_LDS_OST = P_LDS_WS + 8 * 256, P_LDS_TOTAL = P_LDS_OST + 8 * 4096;
__device__ __forceinline__ void attn_unit2(int b, int h, int qb, const bf16* QN, const bf16* QPE, const bf16* KNV, const bf16* KPE, bf16* O, LAS unsigned char* lds, int wave_id) {
    const int tid = fresh_tid(wave_id), lane = tid & 63, r32 = lane & 31, hi = lane >> 5; const int wid = wave_id;
    const bool meta = qb < 0;
    const int rowbase = b * SEQ, q0 = meta ? 0 : qb * 256, qrow = meta ? RMAIN + 16 * b + (r32 & 15) : rowbase + q0 + wid * 32 + r32, qrel = meta ? (r32 & 15) : q0 + wid * 32 + r32;
    bf16x8 qr[6];
#pragma unroll
    for (int d0 = 0; d0 < 4; ++d0) qr[d0] = *(const bf16x8*)(QN + (size_t)qrow * 1024 + h * 64 + d0 * 16 + hi * 8);
#pragma unroll
    for (int d0 = 0; d0 < 2; ++d0) qr[4 + d0] = *(const bf16x8*)(QPE + (size_t)qrow * 512 + h * 32 + d0 * 16 + hi * 8);
    LAS float* wsf = (LAS float*)(lds + P_LDS_WS) + wid * 64;
    const unsigned lds0 = (unsigned)(size_t)lds;
    const int NT = meta ? 0 : 4 * qb + 4;
#define A2_ROW0(t) ((t) == 0 ? (size_t)(RMAIN + 16 * b) : (size_t)(rowbase + 64 * ((t) - 1)))
#define A2_DMA_K(t, ks) do { const size_t row0_ = A2_ROW0(t); \
        glds16(KNV + (row0_ + lane) * 2048 + h * 64 + wid * 8, (unsigned)__builtin_amdgcn_readfirstlane((int)(lds0 + P_LDS_K + (ks) * KSLOT + wid * 1024))); \
        if (wid < 4) glds16(KPE + (row0_ + lane) * 32 + wid * 8, (unsigned)__builtin_amdgcn_readfirstlane((int)(lds0 + P_LDS_K + (ks) * KSLOT + (8 + wid) * 1024))); } while (0)
#define A2_DMA_V(t, vs) do { const size_t row0_ = A2_ROW0(t); \
        glds16(KNV + (row0_ + 16 * (wid & 3) + (lane >> 2)) * 2048 + 1024 + h * 64 + (wid >> 2) * 32 + (lane & 3) * 8, (unsigned)__builtin_amdgcn_readfirstlane((int)(lds0 + P_LDS_V + (vs) * VSLOT + wid * 1024))); } while (0)
#define A2_QKT(P0, P1, ks) do { P0 = f32x16{}; P1 = f32x16{}; const LAS unsigned char* kb_ = lds + P_LDS_K + (ks) * KSLOT + hi * 1024 + r32 * 16; \
        _Pragma("unroll") for (int d0 = 0; d0 < 6; ++d0) { const bf16x8 b0_ = *(const LAS bf16x8*)(kb_ + d0 * 2048), b1_ = *(const LAS bf16x8*)(kb_ + d0 * 2048 + 512); \
            P0 = __builtin_amdgcn_mfma_f32_32x32x16_bf16(b0_, qr[d0], P0, 0, 0, 0); P1 = __builtin_amdgcn_mfma_f32_32x32x16_bf16(b1_, qr[d0], P1, 0, 0, 0); } } while (0)
    f32x16 o[2]; o[0] = f32x16{}; o[1] = f32x16{};
    float mref = -INFINITY, l = 0.f;
#define A2_TILE(P0, P1, t, vs) do { \
        if ((t) == 0) { const int qlim_ = meta ? (r32 & 15) : NMETA - 1; _Pragma("unroll") for (int r = 0; r < 16; ++r) { if (crow(r, hi) > qlim_) P0[r] = -INFINITY; P1[r] = -INFINITY; } } \
        else { const int kt0_ = 64 * ((t) - 1); if (kt0_ + 63 > q0 + wid * 32) { _Pragma("unroll") for (int r = 0; r < 16; ++r) { const int kv = kt0_ + crow(r, hi); if (kv > qrel) P0[r] = -INFINITY; if (kv + 32 > qrel) P1[r] = -INFINITY; } } } \
        float rm_ = fmaxf(P0[0], P1[0]); \
        _Pragma("unroll") for (int r = 1; r < 16; ++r) rm_ = fmaxf(rm_, fmaxf(P0[r], P1[r])); \
        rm_ = pmax32(rm_); \
        if (__any(rm_ > mref + 8.0f)) { const float mnew = fmaxf(mref, rm_); const float f = __builtin_amdgcn_exp2f(mref - mnew); mref = mnew; l *= f; \
            if (hi == 0) wsf[r32] = f; LDS_WAIT(); \
            _Pragma("unroll") for (int r = 0; r < 16; ++r) { const float fr = wsf[crow(r, hi)]; o[0][r] *= fr; o[1][r] *= fr; } } \
        float sacc_ = 0.f; \
        _Pragma("unroll") for (int r = 0; r < 16; ++r) { P0[r] = __builtin_amdgcn_exp2f(P0[r] - mref); P1[r] = __builtin_amdgcn_exp2f(P1[r] - mref); sacc_ += P0[r] + P1[r]; } \
        l += sacc_; \
        u32x4 pw_[4]; \
        _Pragma("unroll") for (int i = 0; i < 4; ++i) { pw_[0][i] = cvtpk(P0[2 * i], P0[2 * i + 1]); pw_[1][i] = cvtpk(P0[8 + 2 * i], P0[8 + 2 * i + 1]); pw_[2][i] = cvtpk(P1[2 * i], P1[2 * i + 1]); pw_[3][i] = cvtpk(P1[8 + 2 * i], P1[8 + 2 * i + 1]); } \
        const LAS unsigned char* vb_ = lds + P_LDS_V + (vs) * VSLOT + ((lane >> 4) & 1) * 32 + (lane & 3) * 8 + (4 * hi + ((lane & 15) >> 2)) * 64; \
        _Pragma("unroll") for (int d0 = 0; d0 < 2; ++d0) _Pragma("unroll") for (int ks = 0; ks < 4; ++ks) { \
            const s16x4 vlo = vtr(vb_ + d0 * 4096 + ks * 1024), vhi = vtr(vb_ + d0 * 4096 + ks * 1024 + 512); \
            const bf16x8 vf = (bf16x8){vlo[0], vlo[1], vlo[2], vlo[3], vhi[0], vhi[1], vhi[2], vhi[3]}; \
            o[d0] = __builtin_amdgcn_mfma_f32_32x32x16_bf16(__builtin_bit_cast(bf16x8, pw_[ks]), vf, o[d0], 0, 0, 0); } } while (0)
    f32x16 pA0, pA1, pB0, pB1;
    A2_DMA_K(0, 0); A2_DMA_V(0, 0); if (NT >= 1) A2_DMA_K(1, 1);
    ATT_WAIT_BAR();
    A2_QKT(pA0, pA1, 0);
    int kc = 0, vc = 0, t = 0;
#define A2_STEP(PC0, PC1, PN0, PN1) do { \
        if (t > 0) ATT_WAIT_BAR(); \
        const int kn_ = kc == 2 ? 0 : kc + 1, k2_ = kn_ == 2 ? 0 : kn_ + 1; \
        if (t + 2 <= NT) A2_DMA_K(t + 2, k2_); \
        if (t + 1 <= NT) { A2_DMA_V(t + 1, vc ^ 1); A2_QKT(PN0, PN1, kn_); } \
        A2_TILE(PC0, PC1, t, vc); \
        kc = kn_; vc ^= 1; ++t; } while (0)
    while (t + 1 <= NT) { A2_STEP(pA0, pA1, pB0, pB1); A2_STEP(pB0, pB1, pA0, pA1); }
    A2_STEP(pA0, pA1, pB0, pB1);
    l = psum32(l);
    if (hi == 0) wsf[32 + r32] = l;
    LDS_WAIT();
    bf16* Ow = O + (size_t)(meta ? RMAIN + 16 * b : rowbase + q0 + wid * 32) * 1024 + h * 64;
    LAS bf16* stg = (LAS bf16*)(lds + P_LDS_OST) + wid * 2048;
#pragma unroll
    for (int r = 0; r < 16; ++r) { const int orow = crow(r, hi); const float il = 1.0f / wsf[32 + orow];
        stg[orow * 64 + r32] = (bf16)f2bf(o[0][r] * il); stg[orow * 64 + 32 + r32] = (bf16)f2bf(o[1][r] * il); }
    LDS_WAIT();
#pragma unroll
    for (int i = 0; i < 4; ++i) { const int row = i * 8 + (lane >> 3), ch = lane & 7; const u32x4 v = *(const LAS u32x4*)(stg + row * 64 + ch * 8); if (!meta || (wid == 0 && row < NMETA)) *(u32x4*)(Ow + (size_t)row * 1024 + ch * 8) = v; }
    ATT_WAIT_BAR();
#undef A2_ROW0
#undef A2_DMA_K
#undef A2_DMA_V
#undef A2_QKT
#undef A2_TILE
#undef A2_STEP
}
__device__ __forceinline__ void attn_phase(const bf16* QN, const bf16* QPE, const bf16* KNV, const bf16* KPE, bf16* O, LAS unsigned char* lds, int wave_id) {
    const int G = gridDim.x, bx = blockIdx.x; const int vcu = (G % 8 == 0) ? (bx % 8) * (G / 8) + bx / 8 : bx;
    for (int v = vcu; v < NB * NH * 4; v += G) {
        const int bh = v >> 2, s0 = v & 3;
#pragma unroll 1
        for (int i = 0; i < 4; ++i) { const int qb = (i == 0) ? 15 - s0 : (i == 1) ? 11 - s0 : (i == 2) ? 4 + s0 : s0; attn_unit2(bh >> 4, bh & 15, qb, QN, QPE, KNV, KPE, O, lds, wave_id); }
        if (v < NB * NH) attn_unit2(v >> 4, v & 15, -1, QN, QPE, KNV, KPE, O, lds, wave_id);
    }
}
}


namespace dec {
using att::bf16x8; using att::s16x4; using att::f32x16; using att::crow; using att::cvtpk; using att::vtr; using att::pmax32; using att::psum32;
constexpr int KST = 592, KBUF = 64 * KST, LDS_K = 0, LDS_Q = 2 * KBUF, LDS_WS = LDS_Q + 64 * KST, LDS_TOTAL = LDS_WS + 8 * 256;
constexpr int NSTAGE = 64;
__device__ __forceinline__ void decode_unit(int db, int sp, ArgsP a, LAS unsigned char* lds, int wave_id) {
    const int tid = fresh_tid(wave_id), lane = tid & 63, r32 = lane & 31, hi = lane >> 5; const int wid = wave_id;
    const int qh = wid & 1, kh = (wid >> 1) & 1, dh = wid >> 2;
    const float* cckv = IN_F(2); const float* ckpe = IN_F(3); const int* pt = (const int*)a->in[5] + db * NPAGES + sp * 32;
    for (int i = tid; i < 64 * 36; i += 512) { const int q = i / 36, ch = i % 36, t = q >> 4, h = q & 15;
        const bf16* src = ch < 32 ? WSB(WS_QLAT) + ((size_t)(db * 4 + t) * 16 + h) * 256 + ch * 8 : WSB(WS_QPE) + (size_t)(RSAMP0 + db * 4 + t) * 512 + h * 32 + (ch - 32) * 8;
        *(LAS u32x4*)(lds + LDS_Q + q * KST + ch * 16) = *(const u32x4*)src; }
    f32x4 cv[8], kv, cw[8], kw;
#define DEC_LOAD(CV, KV, s) do { const int page_ = __builtin_amdgcn_readfirstlane(pt[(s) >> 1]); const size_t k0_ = (size_t)page_ * PAGE + ((s) & 1) * 64; \
        _Pragma("unroll") for (int j = 0; j < 8; ++j) CV[j] = __builtin_nontemporal_load((const f32x4*)(cckv + (k0_ + wid + 8 * j) * 256 + 4 * lane));     \
        KV = __builtin_nontemporal_load((const f32x4*)(ckpe + (k0_ + (tid >> 3)) * 32 + 4 * (tid & 7))); } while (0)
#define DEC_WRITE(CV, KV, buf) do { LAS unsigned char* kb_ = lds + LDS_K + (buf) * KBUF; \
        _Pragma("unroll") for (int j = 0; j < 8; ++j) { u32x2 w_; w_.x = cvtpk(CV[j].x, CV[j].y); w_.y = cvtpk(CV[j].z, CV[j].w); *(LAS u32x2*)(kb_ + (wid + 8 * j) * KST + lane * 8) = w_; } \
        { u32x2 w_; w_.x = cvtpk(KV.x, KV.y); w_.y = cvtpk(KV.z, KV.w); *(LAS u32x2*)(kb_ + (tid >> 3) * KST + 512 + (tid & 7) * 8) = w_; } } while (0)
    LAS float* wsf = (LAS float*)(lds + LDS_WS) + wid * 64;
    f32x16 o[4]; o[0] = f32x16{}; o[1] = f32x16{}; o[2] = f32x16{}; o[3] = f32x16{};
    float mref = -INFINITY, l = 0.f;
#define DEC_BAR() asm volatile("s_waitcnt lgkmcnt(0)\n\ts_barrier" ::: "memory")
    DEC_LOAD(cv, kv, 0); DEC_WRITE(cv, kv, 0); DEC_LOAD(cv, kv, 1); DEC_LOAD(cw, kw, 2);
    DEC_BAR();
#define DEC_COMPUTE(BUF) do { \
        const LAS unsigned char* kimg = lds + LDS_K + (BUF) * KBUF; \
        f32x16 p = f32x16{}; \
        { const LAS unsigned char* kb = kimg + (kh * 32 + r32) * KST + hi * 16; const LAS unsigned char* qb = lds + LDS_Q + (qh * 32 + r32) * KST + hi * 16; \
        _Pragma("unroll") \
          for (int s2 = 0; s2 < 18; ++s2) p = __builtin_amdgcn_mfma_f32_32x32x16_bf16(*(const LAS bf16x8*)(kb + s2 * 32), *(const LAS bf16x8*)(qb + s2 * 32), p, 0, 0, 0); } \
        float rm = p[0]; \
        _Pragma("unroll") \
        for (int r = 1; r < 16; ++r) rm = fmaxf(rm, p[r]); \
        rm = pmax32(rm); \
        if (__any(rm > mref + 8.0f)) { \
            const float mnew = fmaxf(mref, rm); const float f = __builtin_amdgcn_exp2f(mref - mnew); \
            mref = mnew; l *= f; \
            if (hi == 0) wsf[r32] = f; \
            LDS_WAIT(); \
        _Pragma("unroll") \
            for (int r = 0; r < 16; ++r) { const float fr = wsf[crow(r, hi)]; o[0][r] *= fr; o[1][r] *= fr; o[2][r] *= fr; o[3][r] *= fr; } \
        } \
        float sacc = 0.f; \
        _Pragma("unroll") \
        for (int r = 0; r < 16; ++r) { p[r] = __builtin_amdgcn_exp2f(p[r] - mref); sacc += p[r]; } \
        l += sacc; \
        u32x4 pw[2]; \
        _Pragma("unroll") \
        for (int i = 0; i < 4; ++i) { pw[0][i] = cvtpk(p[2 * i], p[2 * i + 1]); pw[1][i] = cvtpk(p[8 + 2 * i], p[8 + 2 * i + 1]); } \
        const LAS unsigned char* vb = kimg + (kh * 32 + 4 * hi + ((lane & 15) >> 2)) * KST + (dh * 128 + 16 * ((lane >> 4) & 1) + 4 * (lane & 3)) * 2; \
        _Pragma("unroll") \
        for (int dt = 0; dt < 4; ++dt) \
        _Pragma("unroll") \
            for (int ks = 0; ks < 2; ++ks) { \
                const s16x4 vlo = vtr(vb + (ks * 16) * KST + dt * 64), vhi = vtr(vb + (ks * 16 + 8) * KST + dt * 64); \
                const bf16x8 vf = (bf16x8){vlo[0], vlo[1], vlo[2], vlo[3], vhi[0], vhi[1], vhi[2], vhi[3]}; \
                o[dt] = __builtin_amdgcn_mfma_f32_32x32x16_bf16(__builtin_bit_cast(bf16x8, pw[ks]), vf, o[dt], 0, 0, 0); \
            } \
    } while (0)
    static_assert(NSTAGE % 2 == 0, "stage loop is unrolled by two");
    for (int s = 0; s < NSTAGE; s += 2) {
        DEC_COMPUTE(0);
        DEC_WRITE(cv, kv, 1); DEC_LOAD(cv, kv, (s + 3 < NSTAGE ? s + 3 : NSTAGE - 1));
        DEC_BAR();
        DEC_COMPUTE(1);
        DEC_WRITE(cw, kw, 0); DEC_LOAD(cw, kw, (s + 4 < NSTAGE ? s + 4 : NSTAGE - 1));
        DEC_BAR();
    }
#undef DEC_COMPUTE
#undef DEC_BAR
    const int part = (db * 2 + sp) * 2 + kh;
    float* op = WSF(WS_OPART) + (size_t)part * 64 * 256;
#pragma unroll
    for (int dt = 0; dt < 4; ++dt)
#pragma unroll
        for (int r = 0; r < 16; ++r) op[(size_t)(qh * 32 + crow(r, hi)) * 256 + dh * 128 + dt * 32 + r32] = o[dt][r];
    l = psum32(l);
    if (dh == 0 && hi == 0) { float* mp = WSF(WS_MLP) + (size_t)part * 128 + (qh * 32 + r32) * 2; mp[0] = mref; mp[1] = l; }
#undef DEC_LOAD
#undef DEC_WRITE
}
struct LaneCtx { int lane, wave; };
__device__ __forceinline__ void combine_item(ArgsP a, int db, int h, const LaneCtx c, LAS unsigned char* lds) {
    {
        f32x4 cn[4]; float en[4];
#pragma unroll
        for (int s2 = 0; s2 < 4; ++s2) { const int kr = RSAMP0 + db * 4 + s2;
            const u32x2 v = *(const u32x2*)(WSB(WS_CKVN) + (size_t)kr * 256 + 4 * c.lane); cn[s2] = (f32x4){bflo(v.x), bfhi(v.x), bflo(v.y), bfhi(v.y)};
            en[s2] = c.lane < 32 ? bf2f(WSB(WS_KPE)[(size_t)kr * 32 + c.lane]) : 0.f; }
        f32x4 res[4];
#pragma unroll
        for (int t = 0; t < 4; ++t) {
            const int i = db * 4 + t, q = t * 16 + h;
            const u32x2 qv = *(const u32x2*)(WSB(WS_QLAT) + ((size_t)i * 16 + h) * 256 + 4 * c.lane); const f32x4 ql = (f32x4){bflo(qv.x), bfhi(qv.x), bflo(qv.y), bfhi(qv.y)};
            const float qp = c.lane < 32 ? bf2f(WSB(WS_QPE)[(size_t)(RSAMP0 + i) * 512 + h * 32 + c.lane]) : 0.f;
            float mp[4], lp[4], dn[4]; float mg = -INFINITY;
#pragma unroll
            for (int p = 0; p < 4; ++p) { const float* ml = WSF(WS_MLP) + (size_t)(db * 4 + p) * 128 + q * 2; mp[p] = ml[0]; lp[p] = ml[1]; mg = fmaxf(mg, mp[p]); }
#pragma unroll
            for (int s2 = 0; s2 < 4; ++s2) {
                float d = (ql.x * cn[s2].x + ql.y * cn[s2].y) + (ql.z * cn[s2].z + ql.w * cn[s2].w) + qp * en[s2];
                d = wave_sum(d); dn[s2] = s2 <= t ? d : -INFINITY; mg = fmaxf(mg, dn[s2]);
            }
            f32x4 acc = (f32x4){0.f, 0.f, 0.f, 0.f}; float L = 0.f;
#pragma unroll
            for (int p = 0; p < 4; ++p) { const float w = exp2f(mp[p] - mg); L += w * lp[p]; acc += w * *(const f32x4*)(WSF(WS_OPART) + ((size_t)(db * 4 + p) * 64 + q) * 256 + 4 * c.lane); }
#pragma unroll
            for (int s2 = 0; s2 < 4; ++s2) { const float w = exp2f(dn[s2] - mg); L += w; acc += w * cn[s2]; }
            res[t] = acc * (1.0f / L);
            __builtin_amdgcn_sched_barrier(0);
        }
        LAS bf16* rt = (LAS bf16*)(lds + 8 * 256 + c.wave * 2048);
#pragma unroll
        for (int t = 0; t < 4; ++t) { u32x2 w; w.x = pk2(res[t].x, res[t].y); w.y = pk2(res[t].z, res[t].w); *(LAS u32x2*)(rt + t * 256 + 4 * c.lane) = w; }
        LDS_WAIT();
        const int r32 = c.lane & 31, hi = c.lane >> 5;
        att::f32x16 o0 = att::f32x16{}, o1 = att::f32x16{};
        const bf16* wb = WSB(WS_WUKV) + (size_t)(1024 + h * 64 + r32) * 256 + 8 * hi;
#pragma unroll
        for (int s = 0; s < 16; ++s) {
            att::bf16x8 af = att::bf16x8{}; if (r32 < 4) af = *(const LAS att::bf16x8*)(rt + r32 * 256 + 16 * s + 8 * hi);
            const att::bf16x8 b0 = *(const att::bf16x8*)(wb + 16 * s), b1 = *(const att::bf16x8*)(wb + 32 * 256 + 16 * s);
            o0 = __builtin_amdgcn_mfma_f32_32x32x16_bf16(af, b0, o0, 0, 0, 0); o1 = __builtin_amdgcn_mfma_f32_32x32x16_bf16(af, b1, o1, 0, 0, 0);
        }
        if (hi == 0) {
#pragma unroll
            for (int t = 0; t < 4; ++t) { bf16* op = WSB(WS_O) + (size_t)(RSAMP0 + db * 4 + t) * 1024 + h * 64 + r32; op[0] = (bf16)f2bf(o0[t]); op[32] = (bf16)f2bf(o1[t]); }
        }
        LDS_WAIT();
    }
}
__device__ __forceinline__ void combine_phase(ArgsP a, const Ctx& c0, LAS unsigned char* lds) {
    const Ctx c = refresh(c0);
    for (int it = c.gw; it < DB * NH; it += c.ngw) combine_item(a, it >> 4, it & 15, LaneCtx{c.lane, c.wave}, lds);
}
__device__ __forceinline__ void decode_phase(ArgsP a, LAS unsigned char* lds, int wave_id) {
    for (int u = blockIdx.x; u < DB * 2; u += gridDim.x) { decode_unit(u >> 1, u & 1, a, lds, wave_id); __syncthreads(); }
}
}

__device__ __forceinline__ void p_side_tables(ArgsP a, const Ctx& c0, LAS unsigned char* lds, int wg0) {
    const Ctx c = refresh(c0);
    const int nwg = (int)gridDim.x - wg0, bx = (int)blockIdx.x - wg0;
    if (bx < 0) return;
    const int gt = (bx * 8 + c.wave) * 64 + c.lane, ngt = nwg * 512;
    {
        const int r32 = c.lane & 31, hi = c.lane >> 5;
        for (int it = bx * 8 + c.wave; it < NH * 64; it += nwg * 8) {
            const int h = it >> 6, ct = (it >> 3) & 7, kt = it & 7;
            const float* ap = IN_F(15) + (size_t)(ct * 32 + r32) * 1024 + h * 64 + 8 * hi;
            const float* bp = IN_F(13) + (size_t)(kt * 32 + r32) * 1536 + h * 96 + 8 * hi;
            att::f32x16 acc = att::f32x16{};
#pragma unroll
            for (int s = 0; s < 4; ++s) {
                const f32x4 a0 = *(const f32x4*)(ap + 16 * s), a1 = *(const f32x4*)(ap + 16 * s + 4), b0 = *(const f32x4*)(bp + 16 * s), b1 = *(const f32x4*)(bp + 16 * s + 4);
                const u32x4 aw = (u32x4){pk2(a0.x, a0.y), pk2(a0.z, a0.w), pk2(a1.x, a1.y), pk2(a1.z, a1.w)}, bw = (u32x4){pk2(b0.x, b0.y), pk2(b0.z, b0.w), pk2(b1.x, b1.y), pk2(b1.z, b1.w)};
                acc = __builtin_amdgcn_mfma_f32_32x32x16_bf16(__builtin_bit_cast(att::bf16x8, aw), __builtin_bit_cast(att::bf16x8, bw), acc, 0, 0, 0);
            }
            bf16* op = WSB(WS_WUQL) + (size_t)(h * 256 + ct * 32) * 256 + kt * 32 + r32;
#pragma unroll
            for (int r = 0; r < 16; ++r) op[(size_t)att::crow(r, hi) * 256] = (bf16)f2bf(acc[r]);
        }
    }
}
__device__ __forceinline__ void p_mla_mid(ArgsP a, const Ctx& c0) {
    const Ctx c = refresh(c0);
    const float* A1 = WSF(WS_A1); bf16* CQN = WSB(WS_CQN); bf16* CKVN = WSB(WS_CKVN); bf16* KPEB = WSB(WS_KPE); const float* ROPE = WSF(WS_ROPE); float* out = a->out;
    const f32x4 gq = *(const f32x4*)(IN_F(12) + 4 * c.lane), gk = *(const f32x4*)(IN_F(14) + 4 * c.lane);
    constexpr int NR = 4;
    for (int r0 = c.gw; r0 < R; r0 += NR * c.ngw) {
        f32x4 cq[NR], ck[NR]; float sq[NR], sk[NR], x1[NR], x2[NR], cs[NR], sn[NR];
#pragma unroll
        for (int q = 0; q < NR; ++q) { const int r = r0 + q * c.ngw < R ? r0 + q * c.ngw : r0; const float* row = A1 + (size_t)r * NIN0;
            cq[q] = *(const f32x4*)(row + 4 * c.lane); ck[q] = *(const f32x4*)(row + 256 + 4 * c.lane);
            const int j = c.lane & 15; x1[q] = row[512 + j]; x2[q] = row[528 + j]; cs[q] = ROPE[(size_t)r * 32 + j]; sn[q] = ROPE[(size_t)r * 32 + 16 + j];
            sq[q] = (cq[q].x * cq[q].x + cq[q].y * cq[q].y) + (cq[q].z * cq[q].z + cq[q].w * cq[q].w); sk[q] = (ck[q].x * ck[q].x + ck[q].y * ck[q].y) + (ck[q].z * ck[q].z + ck[q].w * ck[q].w); }
#pragma unroll
        for (int sh = 1; sh < 64; sh <<= 1) {
#pragma unroll
            for (int q = 0; q < NR; ++q) { sq[q] += __shfl_xor(sq[q], sh); sk[q] += __shfl_xor(sk[q], sh); } }
#pragma unroll
        for (int q = 0; q < NR; ++q) { const int r = r0 + q * c.ngw < R ? r0 + q * c.ngw : r0; const int pos = row_pos(r);
            const float rq = 1.0f / sqrtf(sq[q] * (1.f / 256) + EPS), rk = 1.0f / sqrtf(sk[q] * (1.f / 256) + EPS);
            const f32x4 qn = cq[q] * rq * gq, kn = ck[q] * rk * gk;
            u32x2 o; o.x = pk2(qn.x, qn.y); o.y = pk2(qn.z, qn.w); *(u32x2*)(CQN + (size_t)r * 256 + 4 * c.lane) = o;
            o.x = pk2(kn.x, kn.y); o.y = pk2(kn.z, kn.w); *(u32x2*)(CKVN + (size_t)r * 256 + 4 * c.lane) = o;
            float* ockv; float* okpe;
            if (r < RSAMP0) { const int b = r < RMAIN ? (r >> 12) : ((r - RMAIN) >> 4); ockv = out + O_CKVP + ((size_t)b * TP + pos) * 256; okpe = out + O_KPEP + ((size_t)b * TP + pos) * 32; }
            else { ockv = out + O_CKVS + (size_t)(r - RSAMP0) * 256; okpe = out + O_KPES + (size_t)(r - RSAMP0) * 32; }
            *(f32x4*)(ockv + 4 * c.lane) = kn;
            if (c.lane < 16) { const int j = c.lane; const float o1 = x1[q] * cs[q] - x2[q] * sn[q], o2 = x1[q] * sn[q] + x2[q] * cs[q]; okpe[j] = o1; okpe[16 + j] = o2;
                KPEB[(size_t)r * 32 + j] = (bf16)f2bf(o1); KPEB[(size_t)r * 32 + 16 + j] = (bf16)f2bf(o2); } }
    }
}
__device__ __forceinline__ void p_q_post(ArgsP a, const Ctx& c0) {
    const Ctx c = refresh(c0);
    for (int r = c.gw; r < R; r += c.ngw) {
        const float* row = WSF(WS_QRAW) + (size_t)r * NUQ; const int pos = row_pos(r);
        const float qs = QSCALE;
#pragma unroll
        for (int j = 0; j < 4; ++j) { const f32x4 v = *(const f32x4*)(row + 4 * c.lane + 256 * j) * qs; u32x2 o; o.x = pk2(v.x, v.y); o.y = pk2(v.z, v.w); *(u32x2*)(WSB(WS_QN) + (size_t)r * 1024 + 4 * c.lane + 256 * j) = o; }
#pragma unroll
        for (int j = 0; j < 4; ++j) { const int p = c.lane + 64 * j, h = p >> 4, jj = p & 15; const float x1 = row[1024 + 2 * p], x2 = row[1024 + 2 * p + 1]; float cs, sn; rope_cs(pos, jj, cs, sn);
            WSB(WS_QPE)[(size_t)r * 512 + h * 32 + jj] = (bf16)f2bf((x1 * cs - x2 * sn) * qs); WSB(WS_QPE)[(size_t)r * 512 + h * 32 + 16 + jj] = (bf16)f2bf((x1 * sn + x2 * cs) * qs); }
    }
}
__device__ __forceinline__ void p_qlat(ArgsP a, const Ctx& c0) {
    const Ctx c = refresh(c0);
    const float* wuk = IN_F(15);
    for (int it = c.gw; it < DB * DS * NH; it += c.ngw) {
        const int i = it >> 4, h = it & 15;
        const float q = WSF(WS_QRAW)[(size_t)(RSAMP0 + i) * NUQ + h * 64 + c.lane];
        float acc[4] = {0.f, 0.f, 0.f, 0.f};
#pragma unroll 8
        for (int n = 0; n < 64; ++n) { const float qn = __shfl(q, n);
#pragma unroll
            for (int k = 0; k < 4; ++k) acc[k] += qn * wuk[(size_t)(c.lane + 64 * k) * 1024 + h * 64 + n]; }
#pragma unroll
        for (int k = 0; k < 4; ++k) WSB(WS_QLAT)[((size_t)i * 16 + h) * 256 + c.lane + 64 * k] = (bf16)f2bf(acc[k] * QSCALE);
    }
}
template <bool META_ONLY>
__device__ __forceinline__ void p_attn_prompt_naive(ArgsP a, const Ctx& c0) {
    const Ctx c = refresh(c0);
    const bf16* QN = WSB(WS_QN); const bf16* QPE = WSB(WS_QPE); const bf16* KNV = WSB(WS_KNV); const bf16* KPE = WSB(WS_KPE);
    for (int item = c.gw + (META_ONLY ? (RMAIN / 64) * NH : 0); item < (RPROMPT / 64) * NH; item += c.ngw) {
        const int rb = item >> 4, h = item & 15, r = rb * 64 + c.lane;
        int b, nk;
        if (r < RMAIN) { b = r >> 12; nk = NMETA + (r & 4095) + 1; } else { const int i = r - RMAIN; b = i >> 4; nk = (i & 15) + 1; }
        const int mbase = RMAIN + 16 * b, tbase = 4096 * b;
        float qn[64], qp[32], o[64];
#pragma unroll
        for (int j = 0; j < 8; ++j) { const u32x4 v = *(const u32x4*)(QN + (size_t)r * 1024 + h * 64 + 8 * j);
            qn[8 * j] = bflo(v.x); qn[8 * j + 1] = bfhi(v.x); qn[8 * j + 2] = bflo(v.y); qn[8 * j + 3] = bfhi(v.y); qn[8 * j + 4] = bflo(v.z); qn[8 * j + 5] = bfhi(v.z); qn[8 * j + 6] = bflo(v.w); qn[8 * j + 7] = bfhi(v.w); }
#pragma unroll
        for (int j = 0; j < 4; ++j) { const u32x4 v = *(const u32x4*)(QPE + (size_t)r * 512 + h * 32 + 8 * j);
            qp[8 * j] = bflo(v.x); qp[8 * j + 1] = bfhi(v.x); qp[8 * j + 2] = bflo(v.y); qp[8 * j + 3] = bfhi(v.y); qp[8 * j + 4] = bflo(v.z); qp[8 * j + 5] = bfhi(v.z); qp[8 * j + 6] = bflo(v.w); qp[8 * j + 7] = bfhi(v.w); }
#pragma unroll
        for (int j = 0; j < 64; ++j) o[j] = 0.f;
        float m = -INFINITY, l = 0.f;
        const int nkmax = wave_max_i(nk);
        for (int kk = 0; kk < nkmax; ++kk) {
            if (kk < nk) {
                const int kr = kk < NMETA ? mbase + kk : tbase + kk - NMETA;
                const bf16* kn = KNV + (size_t)kr * 2048 + h * 64; const bf16* kp = KPE + (size_t)kr * 32; const bf16* vv = kn + 1024;
                float s = 0.f;
#pragma unroll
                for (int j = 0; j < 8; ++j) { const u32x4 v = *(const u32x4*)(kn + 8 * j);
                    s += qn[8 * j] * bflo(v.x) + qn[8 * j + 1] * bfhi(v.x) + qn[8 * j + 2] * bflo(v.y) + qn[8 * j + 3] * bfhi(v.y) + qn[8 * j + 4] * bflo(v.z) + qn[8 * j + 5] * bfhi(v.z) + qn[8 * j + 6] * bflo(v.w) + qn[8 * j + 7] * bfhi(v.w); }
#pragma unroll
                for (int j = 0; j < 4; ++j) { const u32x4 v = *(const u32x4*)(kp + 8 * j);
                    s += qp[8 * j] * bflo(v.x) + qp[8 * j + 1] * bfhi(v.x) + qp[8 * j + 2] * bflo(v.y) + qp[8 * j + 3] * bfhi(v.y) + qp[8 * j + 4] * bflo(v.z) + qp[8 * j + 5] * bfhi(v.z) + qp[8 * j + 6] * bflo(v.w) + qp[8 * j + 7] * bfhi(v.w); }
                const float mn = fmaxf(m, s), corr = exp2f(m - mn), p = exp2f(s - mn);
                l = l * corr + p; m = mn;
#pragma unroll
                for (int j = 0; j < 8; ++j) { const u32x4 v = *(const u32x4*)(vv + 8 * j);
                    o[8 * j] = o[8 * j] * corr + p * bflo(v.x); o[8 * j + 1] = o[8 * j + 1] * corr + p * bfhi(v.x); o[8 * j + 2] = o[8 * j + 2] * corr + p * bflo(v.y); o[8 * j + 3] = o[8 * j + 3] * corr + p * bfhi(v.y);
                    o[8 * j + 4] = o[8 * j + 4] * corr + p * bflo(v.z); o[8 * j + 5] = o[8 * j + 5] * corr + p * bfhi(v.z); o[8 * j + 6] = o[8 * j + 6] * corr + p * bflo(v.w); o[8 * j + 7] = o[8 * j + 7] * corr + p * bfhi(v.w); }
            }
        }
        const float il = 1.0f / l;
#pragma unroll
        for (int j = 0; j < 8; ++j) { u32x4 w; w.x = pk2(o[8 * j] * il, o[8 * j + 1] * il); w.y = pk2(o[8 * j + 2] * il, o[8 * j + 3] * il); w.z = pk2(o[8 * j + 4] * il, o[8 * j + 5] * il); w.w = pk2(o[8 * j + 6] * il, o[8 * j + 7] * il);
            *(u32x4*)(WSB(WS_O) + (size_t)r * 1024 + h * 64 + 8 * j) = w; }
    }
}
__device__ __forceinline__ void p_attn_decode_naive(ArgsP a, const Ctx& c0) {
    const Ctx c = refresh(c0);
    const float* cckv = IN_F(2); const float* ckpe = IN_F(3); const int* pt = (const int*)a->in[5];
    for (int item = c.gw; item < DB * NH; item += c.ngw) {
        const int db = item >> 4, h = item & 15;
        f32x4 ql[4]; float qp[4], m[4], l[4]; f32x4 o[4];
#pragma unroll
        for (int t = 0; t < 4; ++t) { const u32x2 v = *(const u32x2*)(WSB(WS_QLAT) + ((size_t)(db * 4 + t) * 16 + h) * 256 + 4 * c.lane);
            ql[t] = (f32x4){bflo(v.x), bfhi(v.x), bflo(v.y), bfhi(v.y)};
            qp[t] = c.lane < 32 ? bf2f(WSB(WS_QPE)[(size_t)(RSAMP0 + db * 4 + t) * 512 + h * 32 + c.lane]) : 0.f;
            m[t] = -INFINITY; l[t] = 0.f; o[t] = (f32x4){0.f, 0.f, 0.f, 0.f}; }
        for (int p = 0; p < NPAGES; ++p) {
            const int page = pt[db * NPAGES + p];
            for (int k = 0; k < PAGE; ++k) {
                const size_t kr = (size_t)page * PAGE + k;
                const f32x4 cv = *(const f32x4*)(cckv + kr * 256 + 4 * c.lane); const float e = c.lane < 32 ? ckpe[kr * 32 + c.lane] : 0.f;
#pragma unroll
                for (int t = 0; t < 4; ++t) {
                    float d = (ql[t].x * cv.x + ql[t].y * cv.y) + (ql[t].z * cv.z + ql[t].w * cv.w) + qp[t] * e;
                    d = wave_sum(d);
                    const float mn = fmaxf(m[t], d), corr = exp2f(m[t] - mn), pp = exp2f(d - mn);
                    l[t] = l[t] * corr + pp; m[t] = mn; o[t] = o[t] * corr + pp * cv;
                }
            }
        }
#pragma unroll
        for (int s2 = 0; s2 < 4; ++s2) {
            const int kr = RSAMP0 + db * 4 + s2;
            const u32x2 v = *(const u32x2*)(WSB(WS_CKVN) + (size_t)kr * 256 + 4 * c.lane); const f32x4 cv = (f32x4){bflo(v.x), bfhi(v.x), bflo(v.y), bfhi(v.y)};
            const float e = c.lane < 32 ? bf2f(WSB(WS_KPE)[(size_t)kr * 32 + c.lane]) : 0.f;
#pragma unroll
            for (int t = 0; t < 4; ++t) if (t >= s2) {
                float d = (ql[t].x * cv.x + ql[t].y * cv.y) + (ql[t].z * cv.z + ql[t].w * cv.w) + qp[t] * e;
                d = wave_sum(d);
                const float mn = fmaxf(m[t], d), corr = exp2f(m[t] - mn), pp = exp2f(d - mn);
                l[t] = l[t] * corr + pp; m[t] = mn; o[t] = o[t] * corr + pp * cv;
            }
        }
#pragma unroll
        for (int t = 0; t < 4; ++t) *(f32x4*)(WSF(WS_OLAT) + ((size_t)(db * 4 + t) * 16 + h) * 256 + 4 * c.lane) = o[t] * (1.0f / l[t]);
    }
}
__device__ __forceinline__ void p_olat_up(ArgsP a, const Ctx& c0) {
    const Ctx c = refresh(c0);
    const float* wuv = IN_F(16);
    for (int it = c.gw; it < DB * DS * NH; it += c.ngw) {
        const int i = it >> 4, h = it & 15; const float* ol = WSF(WS_OLAT) + ((size_t)i * 16 + h) * 256;
        float acc = 0.f;
#pragma unroll 8
        for (int cc = 0; cc < 256; ++cc) acc += ol[cc] * wuv[(size_t)cc * 1024 + h * 64 + c.lane];
        WSB(WS_O)[(size_t)(RSAMP0 + i) * 1024 + h * 64 + c.lane] = (bf16)f2bf(acc);
    }
}
template <bool FINAL, int NSPLIT, bool FIRST = false>
__device__ __forceinline__ void p_post_res(ArgsP a, const Ctx& c0, const float* gpost, const float* gnext) {
    const Ctx c = refresh(c0);
    const bf16* Mb = WSB(WS_M); bf16* X = WSB(WS_X); bf16* H = WSB(WS_H); const float* MT = WSF(WS_MT); const float* xin = IN_F(0); float* out = a->out;
    f32x4 gp[4], gn[4];
#pragma unroll
    for (int j = 0; j < 4; ++j) { gp[j] = *(const f32x4*)(gpost + 4 * c.lane + 256 * j); gn[j] = FINAL ? gp[j] : *(const f32x4*)(gnext + 4 * c.lane + 256 * j); }
    constexpr int NR = 4;
    for (int r0 = c.gw; r0 < RMAIN; r0 += NR * c.ngw) {
        f32x4 mv[NR][4], xv[NR][4]; float s[NR], s2[NR];
#pragma unroll
        for (int q = 0; q < NR; ++q) { const int r = r0 + q * c.ngw < RMAIN ? r0 + q * c.ngw : r0;
            s[q] = 0.f;
#pragma unroll
            for (int j = 0; j < 4; ++j) { const u32x2 mb = __builtin_nontemporal_load((const u32x2*)(Mb + (size_t)r * D + 4 * c.lane + 256 * j)); mv[q][j] = (f32x4){bflo(mb.x), bfhi(mb.x), bflo(mb.y), bfhi(mb.y)};
                if (FIRST) xv[q][j] = *(const f32x4*)(xin + (size_t)r * D + 4 * c.lane + 256 * j); else { const u32x2 xb = *(const u32x2*)(X + (size_t)r * D + 4 * c.lane + 256 * j); xv[q][j] = (f32x4){bflo(xb.x), bfhi(xb.x), bflo(xb.y), bfhi(xb.y)}; }
                s[q] += (mv[q][j].x * mv[q][j].x + mv[q][j].y * mv[q][j].y) + (mv[q][j].z * mv[q][j].z + mv[q][j].w * mv[q][j].w); } }
#pragma unroll
        for (int o = 1; o < 64; o <<= 1) {
#pragma unroll
            for (int q = 0; q < NR; ++q) s[q] += __shfl_xor(s[q], o); }
#pragma unroll
        for (int q = 0; q < NR; ++q) { const float rm = 1.0f / sqrtf(s[q] * (1.f / D) + EPS); s2[q] = 0.f;
#pragma unroll
            for (int j = 0; j < 4; ++j) { xv[q][j] = xv[q][j] + mv[q][j] * rm * gp[j]; s2[q] += (xv[q][j].x * xv[q][j].x + xv[q][j].y * xv[q][j].y) + (xv[q][j].z * xv[q][j].z + xv[q][j].w * xv[q][j].w); } }
        if (!FINAL) {
#pragma unroll
            for (int o = 1; o < 64; o <<= 1) {
#pragma unroll
                for (int q = 0; q < NR; ++q) s2[q] += __shfl_xor(s2[q], o); }
        }
#pragma unroll
        for (int q = 0; q < NR; ++q) { const int r = r0 + q * c.ngw < RMAIN ? r0 + q * c.ngw : r0;
            if (FINAL) {
#pragma unroll
                for (int j = 0; j < 4; ++j) __builtin_nontemporal_store(xv[q][j], (f32x4*)(out + O_YP + (size_t)r * D + 4 * c.lane + 256 * j));
            } else { const float rx = 1.0f / sqrtf(s2[q] * (1.f / D) + EPS);
#pragma unroll
                for (int j = 0; j < 4; ++j) { u32x2 xo; xo.x = pk2(xv[q][j].x, xv[q][j].y); xo.y = pk2(xv[q][j].z, xv[q][j].w); *(u32x2*)(X + (size_t)r * D + 4 * c.lane + 256 * j) = xo;
                    u32x2 o; o.x = pk2(xv[q][j].x * rx * gn[j].x, xv[q][j].y * rx * gn[j].y); o.y = pk2(xv[q][j].z * rx * gn[j].z, xv[q][j].w * rx * gn[j].w); *(u32x2*)(H + (size_t)r * D + 4 * c.lane + 256 * j) = o; } } }
    }
    for (int r = RMAIN + c.gw; r < R; r += c.ngw) {
        bf16* xrow = X + (size_t)r * D;
        f32x4 mv[4], xv[4]; float s = 0.f;
#pragma unroll
        for (int j = 0; j < 4; ++j) { mv[j] = (f32x4){0.f, 0.f, 0.f, 0.f};
#pragma unroll
            for (int h8 = 0; h8 < NSPLIT; h8 += 8) { f32x4 part[8];
#pragma unroll
                for (int sp = 0; sp < 8; ++sp) part[sp] = *(const f32x4*)(MT + ((size_t)(h8 + sp) * (RP - RMAIN) + (r - RMAIN)) * D + 4 * c.lane + 256 * j);
#pragma unroll
                for (int sp = 0; sp < 8; ++sp) mv[j] += part[sp]; }
            { const u32x2 xb = *(const u32x2*)(xrow + 4 * c.lane + 256 * j); xv[j] = (f32x4){bflo(xb.x), bfhi(xb.x), bflo(xb.y), bfhi(xb.y)}; } s += (mv[j].x * mv[j].x + mv[j].y * mv[j].y) + (mv[j].z * mv[j].z + mv[j].w * mv[j].w); }
        const float rm = 1.0f / sqrtf(wave_sum(s) * (1.f / D) + EPS); float s2 = 0.f;
#pragma unroll
        for (int j = 0; j < 4; ++j) { xv[j] = xv[j] + mv[j] * rm * gp[j]; s2 += (xv[j].x * xv[j].x + xv[j].y * xv[j].y) + (xv[j].z * xv[j].z + xv[j].w * xv[j].w); }
        if (FINAL) {
            if (r < RSAMP0) continue;
#pragma unroll
            for (int j = 0; j < 4; ++j) *(f32x4*)(out + O_YS + (size_t)(r - RSAMP0) * D + 4 * c.lane + 256 * j) = xv[j];
        } else {
            const float rx = 1.0f / sqrtf(wave_sum(s2) * (1.f / D) + EPS);
#pragma unroll
            for (int j = 0; j < 4; ++j) { u32x2 xo; xo.x = pk2(xv[j].x, xv[j].y); xo.y = pk2(xv[j].z, xv[j].w); *(u32x2*)(xrow + 4 * c.lane + 256 * j) = xo;
                u32x2 o; o.x = pk2(xv[j].x * rx * gn[j].x, xv[j].y * rx * gn[j].y); o.y = pk2(xv[j].z * rx * gn[j].z, xv[j].w * rx * gn[j].w); *(u32x2*)(H + (size_t)r * D + 4 * c.lane + 256 * j) = o; }
        }
    }
}

__device__ __forceinline__ void p_gate(ArgsP a, const Ctx& c0) {
    const Ctx c = refresh(c0);
    const float* wg = IN_F(19); const float* bg = IN_F(20);
    const size_t gt = (size_t)c.gw * 64 + c.lane, ngt = (size_t)c.ngw * 64;
    for (size_t i = gt + (size_t)(USE_NAIVE_GLA ? 0 : RSAMP0) * 512; i < (size_t)R * 512; i += ngt) {
        const int r = (int)(i >> 9), col = (int)(i & 511); const float* gd = WSF(WS_GD) + (size_t)r * 16;
        float x = bg[col];
#pragma unroll
        for (int j = 0; j < 16; ++j) x += gd[j] * wg[j * 512 + col];
        const float ls = fminf(x, 0.f) - log1pf(__expf(-fabsf(x)));
        const float la = ls * (1.0f / 16.0f);
        WSF(WS_LA)[i] = la; WSF(WS_EA)[i] = __expf(la);
    }
}
__device__ __forceinline__ void gla_step(float (&S)[128], float& o, float a0, float a1, float k0, float k1, float q0, float q1, float v) {
    o = 0.f;
#pragma unroll
    for (int d = 0; d < 64; ++d) { const float ad = rdlane(a0, d), kd = rdlane(k0, d), qd = rdlane(q0, d); S[d] = ad * S[d] + kd * v; o += qd * S[d]; }
#pragma unroll
    for (int d = 0; d < 64; ++d) { const float ad = rdlane(a1, d), kd = rdlane(k1, d), qd = rdlane(q1, d); S[64 + d] = ad * S[64 + d] + kd * v; o += qd * S[64 + d]; }
}
__device__ __forceinline__ void p_gla_naive(ArgsP a, const Ctx& c0) {
    const Ctx c = refresh(c0);
    const float* EA = WSF(WS_EA); const bf16* KG = WSB(WS_KG); const bf16* QG = WSB(WS_QG); const bf16* VG = WSB(WS_VG); float* OGR = WSF(WS_OGRAW);
    for (int item = c.gwT; item < (USE_NAIVE_GLA ? NB * GH * 4 : 0); item += c.ngw) {
        const int b = item >> 4, h = (item >> 2) & 3, dv = (item & 3) * 64 + c.lane;
        float S[128];
#pragma unroll
        for (int d = 0; d < 128; ++d) S[d] = 0.f;
        for (int tt = 0; tt < TP; ++tt) {
            const int row = tt < NMETA ? RMAIN + 16 * b + tt : 4096 * b + tt - NMETA;
            const size_t g = (size_t)row * 512 + h * 128;
            const float a0 = EA[g + c.lane], a1 = EA[g + 64 + c.lane], k0 = bf2f(KG[g + c.lane]), k1 = bf2f(KG[g + 64 + c.lane]), q0 = bf2f(QG[g + c.lane]), q1 = bf2f(QG[g + 64 + c.lane]);
            const float v = bf2f(VG[(size_t)row * 1024 + h * 256 + dv]);
            float o; gla_step(S, o, a0, a1, k0, k1, q0, q1, v);
            OGR[(size_t)row * 1024 + h * 256 + dv] = o;
        }
        float* outp = a->out + O_GLAP + ((size_t)(b * 4 + h) * 128) * 256 + dv;
#pragma unroll
        for (int d = 0; d < 128; ++d) outp[(size_t)d * 256] = S[d];
    }
    const int wg0 = USE_NAIVE_GLA ? 0 : NB * GH * gla::NSP; if ((int)blockIdx.x < wg0) return;
    for (int item = c.wave * ((int)gridDim.x - wg0) + ((int)blockIdx.x - wg0); item < DB * GH * 4; item += c.ngw - wg0 * 8) {
        const int db = item >> 4, h = (item >> 2) & 3, dv = (item & 3) * 64 + c.lane;
        const float* sp = IN_F(4) + ((size_t)(db * 4 + h) * 128) * 256 + dv;
        float S[128];
#pragma unroll
        for (int d = 0; d < 128; ++d) S[d] = sp[(size_t)d * 256];
#pragma unroll 1
        for (int s = 0; s < DS; ++s) {
            const int row = RSAMP0 + db * 4 + s; const size_t g = (size_t)row * 512 + h * 128;
            const float a0 = EA[g + c.lane], a1 = EA[g + 64 + c.lane], k0 = bf2f(KG[g + c.lane]), k1 = bf2f(KG[g + 64 + c.lane]), q0 = bf2f(QG[g + c.lane]), q1 = bf2f(QG[g + 64 + c.lane]);
            const float v = bf2f(VG[(size_t)row * 1024 + h * 256 + dv]);
            float o; gla_step(S, o, a0, a1, k0, k1, q0, q1, v);
            OGR[(size_t)row * 1024 + h * 256 + dv] = o;
        }
        float* outp = a->out + O_GLAS + ((size_t)(db * 4 + h) * 128) * 256 + dv;
#pragma unroll
        for (int d = 0; d < 128; ++d) outp[(size_t)d * 256] = S[d];
    }
}
__device__ __forceinline__ void p_gla_post(ArgsP a, const Ctx& c0) {
    const Ctx c = refresh(c0);
    const bf16* OGR = WSB(WS_OGRAW); const bf16* RG = WSB(WS_RG); bf16* OG = WSB(WS_OG);
    const f32x4 g = *(const f32x4*)(IN_F(21) + 4 * c.lane);
    constexpr int NR = 2;
    for (int r0 = c.gw; r0 < R; r0 += NR * c.ngw) {
        f32x4 o[NR][4]; u32x2 rv[NR][4]; float s[NR][4];
#pragma unroll
        for (int q = 0; q < NR; ++q) { const int r = r0 + q * c.ngw < R ? r0 + q * c.ngw : r0;
#pragma unroll
            for (int h = 0; h < 4; ++h) { const size_t off = (size_t)r * 1024 + h * 256 + 4 * c.lane;
                const u32x2 ob = __builtin_nontemporal_load((const u32x2*)(OGR + ((size_t)(h * 8 + (c.lane >> 3)) * RP + r) * 32 + 4 * (c.lane & 7))); o[q][h] = (f32x4){bflo(ob.x), bfhi(ob.x), bflo(ob.y), bfhi(ob.y)}; rv[q][h] = __builtin_nontemporal_load((const u32x2*)(RG + off));
                s[q][h] = (o[q][h].x * o[q][h].x + o[q][h].y * o[q][h].y) + (o[q][h].z * o[q][h].z + o[q][h].w * o[q][h].w); } }
#pragma unroll
        for (int sh = 1; sh < 64; sh <<= 1) {
#pragma unroll
            for (int q = 0; q < NR; ++q)
#pragma unroll
                for (int h = 0; h < 4; ++h) s[q][h] += __shfl_xor(s[q][h], sh); }
#pragma unroll
        for (int q = 0; q < NR; ++q) { const int r = r0 + q * c.ngw < R ? r0 + q * c.ngw : r0;
#pragma unroll
            for (int h = 0; h < 4; ++h) { const size_t off = (size_t)r * 1024 + h * 256 + 4 * c.lane;
                const float rs = 1.0f / sqrtf(s[q][h] * (1.f / 256) + EPS);
                const f32x4 rr = (f32x4){bflo(rv[q][h].x), bfhi(rv[q][h].x), bflo(rv[q][h].y), bfhi(rv[q][h].y)};
                f32x4 sl; sl.x = rr.x / (1.f + __expf(-rr.x)); sl.y = rr.y / (1.f + __expf(-rr.y)); sl.z = rr.z / (1.f + __expf(-rr.z)); sl.w = rr.w / (1.f + __expf(-rr.w));
                const f32x4 y = o[q][h] * rs * g * sl;
                u32x2 w; w.x = pk2(y.x, y.y); w.y = pk2(y.z, y.w); *(u32x2*)(OG + off) = w; } }
    }
}


namespace gla {
using att::bf16x8; using att::f32x16; using att::crow; using att::cvtpk;
constexpr int NCH = 65, NITEM = NB * GH * NCH;
constexpr int P_GD = 0, P_GSUM = 4096, P_QL = 6144, P_KL = P_QL + 64 * 272, P_VS = P_KL + 64 * 272, P_AL = P_VS + 64 * 528, P_END = P_AL + 64 * 144;
__device__ __forceinline__ int chunk_row(int b, int c, int tok) { return c == 0 ? RMAIN + 16 * b + tok : 4096 * b + 64 * (c - 1) + tok; }
__device__ __forceinline__ float logsig16(float x) { return (fminf(x, 0.f) - __logf(1.0f + __expf(-fabsf(x)))) * (1.0f / 16.0f); }
__device__ __forceinline__ void prep_item(ArgsP a, int item, LAS unsigned char* lds, int wave_id) {
    const int tid = fresh_tid(wave_id), lane = tid & 63, r32 = lane & 31, hi = lane >> 5; const int wid = wave_id;
    const int bh = item / NCH, c = item % NCH, b = bh >> 2, h = bh & 3;
    const int nvalid = c == 0 ? NMETA : 64;
    bf16* QINF = WSB(WS_QINF) + (size_t)item * 8192; bf16* KDTF = WSB(WS_KDTF) + (size_t)item * 8192; bf16* AMF = WSB(WS_AMF) + (size_t)item * 4096; bf16* VTF = WSB(WS_VTF) + (size_t)item * 16384; float* ELF = WSF(WS_ELF) + (size_t)item * 256;
    LAS float* GDL = (LAS float*)(lds + P_GD); LAS float* GSUM = (LAS float*)(lds + P_GSUM); LAS bf16* QL = (LAS bf16*)(lds + P_QL); LAS bf16* KL = (LAS bf16*)(lds + P_KL); LAS bf16* VS = (LAS bf16*)(lds + P_VS); LAS bf16* AL = (LAS bf16*)(lds + P_AL);
    const u32x4 z4 = (u32x4){0u, 0u, 0u, 0u};
#pragma unroll
    for (int j = 0; j < 2; ++j) { const int idx = tid + 512 * j, row = idx >> 4, ch = idx & 15; const bool ok = row < nvalid; const size_t g = (size_t)chunk_row(b, c, ok ? row : 0) * 512 + h * 128 + ch * 8;
        *(LAS u32x4*)(QL + row * 136 + ch * 8) = ok ? __builtin_nontemporal_load((const u32x4*)(WSB(WS_QG) + g)) : z4; *(LAS u32x4*)(KL + row * 136 + ch * 8) = ok ? __builtin_nontemporal_load((const u32x4*)(WSB(WS_KG) + g)) : z4; }
#pragma unroll
    for (int j = 0; j < 4; ++j) { const int idx = tid + 512 * j, row = idx >> 5, ch = idx & 31; const bool ok = row < nvalid;
        *(LAS u32x4*)(VS + row * 264 + ch * 8) = ok ? __builtin_nontemporal_load((const u32x4*)(WSB(WS_VG) + (size_t)chunk_row(b, c, ok ? row : 0) * 1024 + h * 256 + ch * 8)) : z4; }
    if (tid < 256) { const int row = tid >> 2, ch = tid & 3; const bool ok = row < nvalid; *(LAS f32x4*)(GDL + row * 16 + ch * 4) = ok ? *(const f32x4*)(WSF(WS_GD) + (size_t)chunk_row(b, c, ok ? row : 0) * 16 + ch * 4) : (f32x4){0.f, 0.f, 0.f, 0.f}; }
    __syncthreads();
    const int dk = tid & 127, tg = tid >> 7;
    float bloc[16];
    {
        float w[16]; const float* wg = IN_F(19) + h * 128 + dk;
#pragma unroll
        for (int j = 0; j < 16; ++j) w[j] = wg[j * 512];
        const float bg = IN_F(20)[h * 128 + dk];
        float run = 0.f;
#pragma unroll
        for (int i = 0; i < 16; ++i) {
            const int tok = tg * 16 + i; float x = bg;
#pragma unroll
            for (int j4 = 0; j4 < 4; ++j4) { const f32x4 gd = *(const LAS f32x4*)(GDL + tok * 16 + j4 * 4); x += gd.x * w[4 * j4] + gd.y * w[4 * j4 + 1] + gd.z * w[4 * j4 + 2] + gd.w * w[4 * j4 + 3]; }
            const float g = tok < nvalid ? logsig16(x) : 0.f;
            run += g; bloc[i] = run;
        }
        GSUM[tg * 128 + dk] = run;
    }
    __syncthreads();
    float off = 0.f, blast = 0.f;
#pragma unroll
    for (int t = 0; t < 4; ++t) { const float s = GSUM[t * 128 + dk]; if (t < tg) off += s; blast += s; }
    {
        unsigned kdp[8];
#pragma unroll
        for (int i = 0; i < 16; i += 2) {
            float kd2[2];
#pragma unroll
            for (int e = 0; e < 2; ++e) {
                const int tok = tg * 16 + i + e; const float bb = bloc[i + e] + off; const float q = bf2f(QL[tok * 136 + dk]), k = bf2f(KL[tok * 136 + dk]);
                QL[tok * 136 + dk] = (bf16)f2bf(q * __expf(bb)); KL[tok * 136 + dk] = (bf16)f2bf(k * __expf(-bb)); kd2[e] = k * __expf(blast - bb);
            }
            kdp[i >> 1] = pk2(kd2[0], kd2[1]);
        }
        bf16* kp = KDTF + ((size_t)(((dk >> 5) * 4 + tg) * 64) + (dk & 31)) * 8;
        *(u32x4*)(kp) = (u32x4){kdp[0], kdp[1], kdp[2], kdp[3]}; *(u32x4*)(kp + 32 * 8) = (u32x4){kdp[4], kdp[5], kdp[6], kdp[7]};
        if (tg == 0) ELF[dk] = __expf(blast);
    }
    {
        const int dv = tid & 255, half = tid >> 8;
#pragma unroll
        for (int u = 0; u < 4; ++u) {
            unsigned pk[4];
#pragma unroll
            for (int e = 0; e < 4; ++e) { const int tok = half * 32 + u * 8 + e * 2; pk[e] = (unsigned)VS[tok * 264 + dv] | ((unsigned)VS[(tok + 1) * 264 + dv] << 16); }
            const int s = 2 * half + (u >> 1), uh = u & 1;
            *(u32x4*)(VTF + ((size_t)(((dv >> 5) * 4 + s) * 64) + uh * 32 + (dv & 31)) * 8) = (u32x4){pk[0], pk[1], pk[2], pk[3]};
        }
    }
    __syncthreads();
#pragma unroll
    for (int uu = 0; uu < 2; ++uu) {
        const int U = tid + 512 * uu, lp = U & 63, s8 = (U >> 6) & 7, tt = U >> 9; const int tok = tt * 32 + (lp & 31), hh = lp >> 5;
        const u32x2 lo = *(const LAS u32x2*)(QL + tok * 136 + 16 * s8 + 4 * hh), hi2 = *(const LAS u32x2*)(QL + tok * 136 + 16 * s8 + 8 + 4 * hh);
        *(u32x4*)(QINF + (size_t)U * 8) = (u32x4){lo.x, lo.y, hi2.x, hi2.y};
    }
    if (wid < 3) {
        const int tt = wid == 0 ? 0 : 1, tp = wid == 2 ? 1 : 0;
        f32x16 acc = f32x16{};
#pragma unroll
        for (int s = 0; s < 8; ++s) {
            const bf16x8 af = *(const LAS bf16x8*)(QL + (tt * 32 + r32) * 136 + 16 * s + 8 * hi), bfr = *(const LAS bf16x8*)(KL + (tp * 32 + r32) * 136 + 16 * s + 8 * hi);
            acc = __builtin_amdgcn_mfma_f32_32x32x16_bf16(af, bfr, acc, 0, 0, 0);
        }
#pragma unroll
        for (int r = 0; r < 16; ++r) { const int tok = tt * 32 + crow(r, hi), tk = tp * 32 + r32; AL[tok * 72 + tk] = (bf16)f2bf(tk <= tok ? acc[r] : 0.f); }
    } else if (wid == 3) {
#pragma unroll
        for (int r = 0; r < 16; ++r) AL[crow(r, hi) * 72 + 32 + r32] = 0;
    }
    __syncthreads();
    { const int U = tid, lp = U & 63, s = (U >> 6) & 3, tt = U >> 8; const int tok = tt * 32 + (lp & 31), hh = lp >> 5;
      *(u32x4*)(AMF + (size_t)U * 8) = *(const LAS u32x4*)(AL + tok * 72 + 16 * s + 8 * hh); }
    __syncthreads();
}
constexpr int SM_A = 0, SM_K = 2048, SM_Q = 4096, SM_V = 6144, SM_O = 10240, SM_END = SM_O + 4 * 2 * 256 * 4;
__device__ __forceinline__ void sample_item(ArgsP a, int item, LAS unsigned char* lds, int wave_id) {
    const int tid = fresh_tid(wave_id);
    const int db = item >> 2, h = item & 3;
    LAS float* AS = (LAS float*)(lds + SM_A); LAS float* KS = (LAS float*)(lds + SM_K); LAS float* QS = (LAS float*)(lds + SM_Q); LAS float* VSm = (LAS float*)(lds + SM_V); LAS float* OS = (LAS float*)(lds + SM_O);
    { const int s = tid >> 7, dk = tid & 127, row = RSAMP0 + db * 4 + s; const float* gd = WSF(WS_GD) + (size_t)row * 16; const float* wg = IN_F(19) + h * 128 + dk;
      float x = IN_F(20)[h * 128 + dk];
#pragma unroll
      for (int j = 0; j < 16; ++j) x += gd[j] * wg[j * 512];
      AS[s * 128 + dk] = __expf(logsig16(x));
      const size_t g = (size_t)row * 512 + h * 128 + dk; KS[s * 128 + dk] = bf2f(WSB(WS_KG)[g]); QS[s * 128 + dk] = bf2f(WSB(WS_QG)[g]);
#pragma unroll
      for (int j = 0; j < 2; ++j) { const int e = tid + 512 * j, s2 = e >> 8, dv2 = e & 255; VSm[s2 * 256 + dv2] = bf2f(WSB(WS_VG)[(size_t)(RSAMP0 + db * 4 + s2) * 1024 + h * 256 + dv2]); } }
    const int dv = tid & 255, kh = tid >> 8;
    const unsigned voff = (unsigned)(kh * 64 * 256 + dv) * 4u;
    const unsigned char* sbase = (const unsigned char*)(IN_F(4) + (size_t)(db * 4 + h) * 128 * 256);
    __syncthreads();
    float S[64];
#pragma unroll
    for (int d4 = 0; d4 < 16; ++d4) { const GAS unsigned char* bp = (const GAS unsigned char*)sbase + d4 * 4096; asm volatile("" : "+s"(bp));
#pragma unroll
        for (int e = 0; e < 4; ++e) S[4 * d4 + e] = __builtin_nontemporal_load((const GAS float*)(bp + e * 1024 + voff)); }
#pragma unroll 1
    for (int s = 0; s < 4; ++s) {
        const float v = VSm[s * 256 + dv]; float o = 0.f;
#pragma unroll
        for (int d4 = 0; d4 < 16; ++d4) {
            if ((d4 & 3) == 0) __builtin_amdgcn_sched_barrier(0);
            const f32x4 av = *(const LAS f32x4*)(AS + s * 128 + kh * 64 + 4 * d4), kv = *(const LAS f32x4*)(KS + s * 128 + kh * 64 + 4 * d4), qv = *(const LAS f32x4*)(QS + s * 128 + kh * 64 + 4 * d4);
            S[4 * d4] = av.x * S[4 * d4] + kv.x * v; o += qv.x * S[4 * d4]; S[4 * d4 + 1] = av.y * S[4 * d4 + 1] + kv.y * v; o += qv.y * S[4 * d4 + 1];
            S[4 * d4 + 2] = av.z * S[4 * d4 + 2] + kv.z * v; o += qv.z * S[4 * d4 + 2]; S[4 * d4 + 3] = av.w * S[4 * d4 + 3] + kv.w * v; o += qv.w * S[4 * d4 + 3];
        }
        OS[(s * 2 + kh) * 256 + dv] = o;
    }
    unsigned char* obase = (unsigned char*)(a->out + O_GLAS + (size_t)(db * 4 + h) * 128 * 256);
#pragma unroll
    for (int d4 = 0; d4 < 16; ++d4) { GAS unsigned char* bp = (GAS unsigned char*)obase + d4 * 4096; asm volatile("" : "+s"(bp));
#pragma unroll
        for (int e = 0; e < 4; ++e) __builtin_nontemporal_store(S[4 * d4 + e], (GAS float*)(bp + e * 1024 + voff)); }
    __syncthreads();
#pragma unroll
    for (int j = 0; j < 2; ++j) { const int e = tid + 512 * j, s2 = e >> 8, dv2 = e & 255; WSB(WS_OGRAW)[((size_t)(h * 8 + (dv2 >> 5)) * RP + (RSAMP0 + db * 4 + s2)) * 32 + (dv2 & 31)] = (bf16)f2bf(OS[(s2 * 2) * 256 + dv2] + OS[(s2 * 2 + 1) * 256 + dv2]); }
    __syncthreads();
}
__device__ __forceinline__ void prep_phase(ArgsP a, LAS unsigned char* lds, int wave_id) {
    for (int item = blockIdx.x; item < NITEM; item += gridDim.x) prep_item(a, item, lds, wave_id);
}
constexpr int S_QIN = 0, S_KDT = 16384, S_AM = 32768, S_EL = 40960, S_VT = 41984, S_SLOT = S_VT + NCW * 4096;
static_assert(3 * S_SLOT <= MISC_OFF, "scan ring fits under the control words");
constexpr int NPIECE = 41 + NCW * 4, NDMA = (NPIECE + (8 - NCW) - 1) / (8 - NCW);
__device__ __forceinline__ void scan_bh(ArgsP a, int bh, int part, LAS unsigned char* lds, int wave_id) {
    const int tid = fresh_tid(wave_id), lane = tid & 63, r32 = lane & 31, hi = lane >> 5; const int wid = wave_id;
    const int b = bh >> 2, h = bh & 3; const bool cw = wid < NCW; const int ds = part * NCW + (cw ? wid : 0);
    const unsigned char* const pq = (const unsigned char*)(WSB(WS_QINF) + (size_t)bh * NCH * 8192); const unsigned char* const pk = (const unsigned char*)(WSB(WS_KDTF) + (size_t)bh * NCH * 8192);
    const unsigned char* const pa = (const unsigned char*)(WSB(WS_AMF) + (size_t)bh * NCH * 4096); const unsigned char* const pe = (const unsigned char*)(WSF(WS_ELF) + (size_t)bh * NCH * 256);
    const unsigned char* const pv = (const unsigned char*)(WSB(WS_VTF) + (size_t)bh * NCH * 16384) + part * NCW * 4096;
    bf16* const ogbase = WSB(WS_OGRAW) + (size_t)(h * 8 + ds) * RP * 32 + r32;
#define GLA_DMA(c_, slot_) do { const size_t c64_ = (size_t)(c_); \
        _Pragma("unroll") for (int k_ = 0; k_ < NDMA; ++k_) { int i_ = (wid - NCW) + (8 - NCW) * k_; i_ = i_ < NPIECE ? i_ : 40; const unsigned char* g_; int lo_; \
            if (i_ < 16) { g_ = pq + c64_ * 16384 + i_ * 1024; lo_ = S_QIN + i_ * 1024; } \
            else if (i_ < 32) { g_ = pk + c64_ * 16384 + (i_ - 16) * 1024; lo_ = S_KDT + (i_ - 16) * 1024; } \
            else if (i_ < 40) { g_ = pa + c64_ * 8192 + (i_ - 32) * 1024; lo_ = S_AM + (i_ - 32) * 1024; } \
            else if (i_ == 40) { g_ = pe + c64_ * 1024; lo_ = S_EL; } \
            else { g_ = pv + c64_ * 32768 + (i_ - 41) * 1024; lo_ = S_VT + (i_ - 41) * 1024; } \
            __builtin_amdgcn_global_load_lds((const unsigned*)(g_ + lane * 16), (LAS unsigned*)(lds + (slot_) * S_SLOT + lo_), 16, 0, 0); } } while (0)
    f32x16 S[4]; S[0] = f32x16{}; S[1] = f32x16{}; S[2] = f32x16{}; S[3] = f32x16{};
    if (!cw) { GLA_DMA(0, 0); GLA_DMA(1, 1); }
    int slot = 0;
    for (int c = 0; c < NCH; ++c) {
        if (!cw) { if (c + 1 < NCH) asm volatile("s_waitcnt vmcnt(%0)" :: "n"(NDMA) : "memory"); else asm volatile("s_waitcnt vmcnt(0)" ::: "memory"); }
        asm volatile("s_waitcnt lgkmcnt(0)\n\ts_barrier" ::: "memory");
        const LAS unsigned char* sb = lds + slot * S_SLOT; const int slot2 = slot == 0 ? 2 : slot - 1;
        slot = slot == 2 ? 0 : slot + 1;
        if (!cw) { if (c + 2 < NCH) GLA_DMA(c + 2, slot2); continue; }
        bf16x8 vf[4];
#pragma unroll
        for (int s = 0; s < 4; ++s) vf[s] = *(const LAS bf16x8*)(sb + S_VT + (wid * 4 + s) * 1024 + lane * 16);
        u32x4 Sb[4][2];
#pragma unroll
        for (int T = 0; T < 4; ++T)
#pragma unroll
            for (int s = 0; s < 2; ++s)
#pragma unroll
                for (int i = 0; i < 4; ++i) Sb[T][s][i] = cvtpk(S[T][8 * s + 2 * i], S[T][8 * s + 2 * i + 1]);
        f32x16 o[2]; o[0] = f32x16{}; o[1] = f32x16{};
#pragma unroll
        for (int T = 0; T < 4; ++T)
#pragma unroll
            for (int g = 0; g < 4; ++g) { const f32x4 e = *(const LAS f32x4*)(sb + S_EL + (32 * T + 8 * g + 4 * hi) * 4); S[T][4 * g] *= e.x; S[T][4 * g + 1] *= e.y; S[T][4 * g + 2] *= e.z; S[T][4 * g + 3] *= e.w; }
#define GLA_QF(tt, k8) (*(const LAS bf16x8*)(sb + S_QIN + ((tt) * 8 + (k8)) * 1024 + lane * 16))
#define GLA_KF(T, s) (*(const LAS bf16x8*)(sb + S_KDT + ((T) * 4 + (s)) * 1024 + lane * 16))
#define GLA_AF(tt, s) (*(const LAS bf16x8*)(sb + S_AM + ((tt) * 4 + (s)) * 1024 + lane * 16))
#define GLA_LOADG(F, g) do { F[0] = GLA_QF(0, 2 * (g)); F[1] = GLA_QF(1, 2 * (g)); F[2] = GLA_QF(0, 2 * (g) + 1); F[3] = GLA_QF(1, 2 * (g) + 1); \
        F[4] = GLA_KF((2 * (g)) & 3, (g) >> 1); F[5] = GLA_KF((2 * (g) + 2) & 3, 2 + ((g) >> 1)); F[6] = GLA_KF((2 * (g) + 1) & 3, (g) >> 1); F[7] = GLA_KF((2 * (g) + 3) & 3, 2 + ((g) >> 1)); } while (0)
#define GLA_MMAG(F, g) do { \
        o[0] = __builtin_amdgcn_mfma_f32_32x32x16_bf16(F[0], __builtin_bit_cast(bf16x8, Sb[g][0]), o[0], 0, 0, 0); \
        S[(2 * (g)) & 3] = __builtin_amdgcn_mfma_f32_32x32x16_bf16(F[4], vf[(g) >> 1], S[(2 * (g)) & 3], 0, 0, 0); \
        o[1] = __builtin_amdgcn_mfma_f32_32x32x16_bf16(F[1], __builtin_bit_cast(bf16x8, Sb[g][0]), o[1], 0, 0, 0); \
        S[(2 * (g) + 2) & 3] = __builtin_amdgcn_mfma_f32_32x32x16_bf16(F[5], vf[2 + ((g) >> 1)], S[(2 * (g) + 2) & 3], 0, 0, 0); \
        o[0] = __builtin_amdgcn_mfma_f32_32x32x16_bf16(F[2], __builtin_bit_cast(bf16x8, Sb[g][1]), o[0], 0, 0, 0); \
        S[(2 * (g) + 1) & 3] = __builtin_amdgcn_mfma_f32_32x32x16_bf16(F[6], vf[(g) >> 1], S[(2 * (g) + 1) & 3], 0, 0, 0); \
        o[1] = __builtin_amdgcn_mfma_f32_32x32x16_bf16(F[3], __builtin_bit_cast(bf16x8, Sb[g][1]), o[1], 0, 0, 0); \
        S[(2 * (g) + 3) & 3] = __builtin_amdgcn_mfma_f32_32x32x16_bf16(F[7], vf[2 + ((g) >> 1)], S[(2 * (g) + 3) & 3], 0, 0, 0); } while (0)
        bf16x8 FA[8], FB[8];
        GLA_LOADG(FA, 0); __builtin_amdgcn_sched_barrier(0);
        GLA_LOADG(FB, 1); __builtin_amdgcn_sched_barrier(0); GLA_MMAG(FA, 0); __builtin_amdgcn_sched_barrier(0);
        GLA_LOADG(FA, 2); __builtin_amdgcn_sched_barrier(0); GLA_MMAG(FB, 1); __builtin_amdgcn_sched_barrier(0);
        GLA_LOADG(FB, 3); __builtin_amdgcn_sched_barrier(0); GLA_MMAG(FA, 2); __builtin_amdgcn_sched_barrier(0);
        FA[0] = GLA_AF(0, 0); FA[1] = GLA_AF(1, 0); FA[2] = GLA_AF(0, 1); FA[3] = GLA_AF(1, 1); FA[4] = GLA_AF(1, 2); FA[5] = GLA_AF(1, 3);
        __builtin_amdgcn_sched_barrier(0); GLA_MMAG(FB, 3); __builtin_amdgcn_sched_barrier(0);
        o[0] = __builtin_amdgcn_mfma_f32_32x32x16_bf16(FA[0], vf[0], o[0], 0, 0, 0); o[1] = __builtin_amdgcn_mfma_f32_32x32x16_bf16(FA[1], vf[0], o[1], 0, 0, 0);
        o[0] = __builtin_amdgcn_mfma_f32_32x32x16_bf16(FA[2], vf[1], o[0], 0, 0, 0); o[1] = __builtin_amdgcn_mfma_f32_32x32x16_bf16(FA[3], vf[1], o[1], 0, 0, 0);
        o[1] = __builtin_amdgcn_mfma_f32_32x32x16_bf16(FA[4], vf[2], o[1], 0, 0, 0); o[1] = __builtin_amdgcn_mfma_f32_32x32x16_bf16(FA[5], vf[3], o[1], 0, 0, 0);
#undef GLA_QF
#undef GLA_KF
#undef GLA_AF
#undef GLA_LOADG
#undef GLA_MMAG
        bf16* og = ogbase;
#pragma unroll
        for (int tt = 0; tt < 2; ++tt)
#pragma unroll
            for (int r = 0; r < 16; ++r) { const int tok = tt * 32 + crow(r, hi); if (c > 0 || tok < NMETA) og[(size_t)chunk_row(b, c, tok) * 32] = (bf16)cvtpk(o[tt][r], o[tt][r]); }
    }
    if (cw) { float* outp = a->out + O_GLAP + (size_t)bh * 128 * 256 + ds * 32 + r32;
#pragma unroll
    for (int T = 0; T < 4; ++T)
#pragma unroll
        for (int r = 0; r < 16; ++r) outp[(size_t)(32 * T + crow(r, hi)) * 256] = S[T][r]; }
    asm volatile("s_waitcnt vmcnt(0) lgkmcnt(0)\n\ts_barrier" ::: "memory");
#undef GLA_DMA
#undef GLA_VLOAD
}
}

__device__ __forceinline__ bool relaunder(ArgsP& a) { asm volatile("" : "+s"(a)); return true; }
constexpr int NPHASE = 22;
__global__ void __launch_bounds__(512, 2) fwd(Args a_unused) {
    ArgsP a = (ArgsP)__builtin_amdgcn_kernarg_segment_ptr();
    extern __shared__ __attribute__((aligned(16))) unsigned char lds_raw[];
    LAS unsigned char* lds = (LAS unsigned char*)lds_raw;
    Ctx c; c.wave = __builtin_amdgcn_readfirstlane((int)threadIdx.x >> 6); c.tid = 0; c.lane = 0;
    c.gw = blockIdx.x * 8 + c.wave; c.ngw = gridDim.x * 8; c.gwT = c.wave * gridDim.x + blockIdx.x;
    volatile LAS unsigned* MISC = (volatile LAS unsigned*)(lds + MISC_OFF);
    if (threadIdx.x < 32) MISC[threadIdx.x] = 0u;
    __syncthreads();
    XcdBarrier bar; bar.bar = (unsigned*)(a->ws + WS_CTL) + CW_BAR; bar.x = 0; bar.st = nullptr;
    const bool one = (a->ph_hi - a->ph_lo) > 1;
    if (one) bar = xcd_barrier_post((unsigned*)(a->ws + WS_CTL) + CW_BAR, MISC + 8);
    const int lo = a->ph_lo, hi = a->ph_hi;
    unsigned long long tp0 = 0, tp1 = 0;
#define IN(k) (((PROBE_LO == (k)) ? (void)(tp0 = __builtin_amdgcn_s_memrealtime()) : (void)0), (lo <= (k) && (k) < hi && relaunder(a)))
#define INQ(k) (lo <= (k) && (k) < hi)
#define SEAM(k) do { if (INQ(k) && INQ((k) + 1)) xcd_barrier(bar, c.wave); if (PROBE_HI == (k)) tp1 = __builtin_amdgcn_s_memrealtime(); } while (0)
    if (IN(0)) { p_prep(a, c, lds); } SEAM(0);
    if (IN(1)) { if ((int)blockIdx.x < (RP / 256) * (NIN0 / 256)) gemm_p1(a, lds, c.wave); else p_side_tables(a, c, lds, (RP / 256) * (NIN0 / 256)); } SEAM(1);
    if (IN(2)) { if (USE_NAIVE_GEMM) p_mla_mid(a, c); }
    if (IN(3)) { gemm_p3(a, lds, c.wave); } SEAM(3);
    if (IN(4)) { if (USE_NAIVE_GEMM) { p_q_post(a, c); p_qlat(a, c); } }
    if (IN(5)) {
#if USE_NAIVE_ATTN
        p_attn_prompt_naive<false>(a, c);
#else
        if (((int)blockIdx.x >> 3) & 1) {
            dec::decode_phase(a, lds, c.wave);
            att::attn_phase(WSB(WS_QN), WSB(WS_QPE), WSB(WS_KNV), WSB(WS_KPE), WSB(WS_O), lds, c.wave);
        } else {
            att::attn_phase(WSB(WS_QN), WSB(WS_QPE), WSB(WS_KNV), WSB(WS_KPE), WSB(WS_O), lds, c.wave);
            dec::decode_phase(a, lds, c.wave);
        }
#endif
    } SEAM(5);
    if (IN(6)) {
#if USE_NAIVE_DECODE
        p_olat_up(a, c);
#else
        dec::combine_phase(a, c, lds);
#endif
    } SEAM(6);
    if (IN(7)) { gemm_n1024_tail<D, 8>(WSB(WS_O), WSB(WS_WO0), WSB(WS_M), WSF(WS_MT), lds, c.wave); } SEAM(7);
    if (IN(8)) { p_post_res<false, 8, true>(a, c, IN_F(8), IN_F(9)); } SEAM(8);
    if (IN(9)) { gemm_mfma8(WSB(WS_H), WSB(WS_WUP), RP, FF, D, (EpiRelu2{WSB(WS_U), FF}), lds, c.wave); } SEAM(9);
    if (IN(10)) { gemm_n1024_tail<FF, 16>(WSB(WS_U), WSB(WS_WDN), WSB(WS_M), WSF(WS_MT), lds, c.wave); } SEAM(10);
    if (IN(11)) { p_post_res<false, 16>(a, c, IN_F(10), IN_F(7) + D); } SEAM(11);
    if (IN(12)) { gemm_mfma8(WSB(WS_H), WSB(WS_WGIN), RP, NGIN, D, (EpiGla{WSB(WS_QG), WSB(WS_KG), WSB(WS_VG), WSB(WS_RG), WSF(WS_GD)}), lds, c.wave); } SEAM(12);
    if (IN(13)) {
#if USE_NAIVE_GLA
        p_gate(a, c);
#else
        gla::prep_phase(a, lds, c.wave);
#endif
    } SEAM(13);
    if (IN(14)) {
#if !USE_NAIVE_GLA
        if ((int)blockIdx.x < NB * GH * gla::NSP) gla::scan_bh(a, (int)blockIdx.x / gla::NSP, (int)blockIdx.x % gla::NSP, lds, c.wave);
        else for (int item = (int)blockIdx.x - NB * GH * gla::NSP; item < DB * GH; item += (int)gridDim.x - NB * GH * gla::NSP) gla::sample_item(a, item, lds, c.wave);
#else
        p_gla_naive(a, c);
#endif
    } SEAM(14);
    if (IN(15)) { p_gla_post(a, c); } SEAM(15);
    if (IN(16)) { gemm_n1024_tail<D, 8>(WSB(WS_OG), WSB(WS_WGO), WSB(WS_M), WSF(WS_MT), lds, c.wave); } SEAM(16);
    if (IN(17)) { p_post_res<false, 8>(a, c, IN_F(8) + D, IN_F(9) + D); } SEAM(17);
    if (IN(18)) { gemm_mfma8(WSB(WS_H), WSB(WS_WUP) + (size_t)FF * D, RP, FF, D, (EpiRelu2{WSB(WS_U), FF}), lds, c.wave); } SEAM(18);
    if (IN(19)) { gemm_n1024_tail<FF, 16>(WSB(WS_U), WSB(WS_WDN) + (size_t)D * FF, WSB(WS_M), WSF(WS_MT), lds, c.wave); } SEAM(19);
    if (IN(20)) { p_post_res<true, 16>(a, c, IN_F(10) + D, nullptr); }
    if (PROBE_LO >= 0 && blockIdx.x == 0) { const unsigned long long span = (tp1 - tp0) * 9ull, t0 = __builtin_amdgcn_s_memrealtime(); while (__builtin_amdgcn_s_memrealtime() - t0 < span) __builtin_amdgcn_s_sleep(8); }
#undef IN
#undef SEAM
}

extern "C" void kernel_launch(void* const* d_in, const int* in_sizes, int n_in, void* d_out, int out_size, void* d_ws, size_t ws_size, hipStream_t stream) {
    static int grid = 0;
    if (grid == 0) {
        if (n_in != 25 || out_size != (int)O_END || ws_size < WS_END) { fprintf(stderr, "kernel_launch: unexpected shapes n_in %d out %d ws %zu\n", n_in, out_size, ws_size); grid = -1; return; }
        int dev = 0, cus = 0, per_cu = 0;
        if (hipGetDevice(&dev) != hipSuccess || hipDeviceGetAttribute(&cus, hipDeviceAttributeMultiprocessorCount, dev) != hipSuccess) { grid = -1; return; }
        if (hipFuncSetAttribute((const void*)fwd, hipFuncAttributeMaxDynamicSharedMemorySize, LDS_BYTES) != hipSuccess) { fprintf(stderr, "kernel_launch: hipFuncSetAttribute failed\n"); grid = -1; return; }
        if (hipOccupancyMaxActiveBlocksPerMultiprocessor(&per_cu, (const void*)fwd, 512, LDS_BYTES) != hipSuccess || per_cu < 1) fprintf(stderr, "kernel_launch: occupancy query says %d\n", per_cu);
        (void)hipGetLastError();
        grid = cus;
    }
    if (grid < 0) return;
    if (hipMemsetAsync((char*)d_ws + WS_CTL, 0, CTL_ZERO_BYTES, stream) != hipSuccess) return;
    Args a{};
    for (int i = 0; i < 25; ++i) a.in[i] = d_in[i];
    a.out = (float*)d_out; a.ws = (unsigned char*)d_ws;
#if MK_ONE_LAUNCH
    a.ph_lo = 0; a.ph_hi = NPHASE;
    hipLaunchKernelGGL(fwd, dim3(grid), dim3(512), LDS_BYTES, stream, a);
#else
    for (int ph = 0; ph < NPHASE - 1; ++ph) { a.ph_lo = ph; a.ph_hi = ph + 1; hipLaunchKernelGGL(fwd, dim3(grid), dim3(512), LDS_BYTES, stream, a); }
#endif
}
```

```cpp
#include <hip/hip_runtime.h>
#include <cstdio>
#include <cstdint>
#include <cmath>

#ifndef MK_ONE_LAUNCH
#define MK_ONE_LAUNCH 1
#endif

constexpr int D = 1024, NB = 4, SEQ = 4096, NMETA = 16, TP = SEQ + NMETA;
constexpr int DB = 128, DS = 4, PAST = 8192, PAGE = 128, NPAGES = 64;
constexpr int NH = 16, QL = 256, KVL = 256, NOPE = 64, ROPE = 32, VH = 64;
constexpr int GH = 4, GDK = 128, GDV = 256, GR = 16;
constexpr int FF = 4096;
constexpr int RMAIN = NB * SEQ;
constexpr int RMETA0 = RMAIN;
constexpr int RSAMP0 = RMAIN + NB * NMETA;
constexpr int R = RSAMP0 + DB * DS;
constexpr int RPROMPT = RSAMP0;
constexpr int RP = 17152;
constexpr int NIN0 = 768, NUQ = 1536, NUKV = 2048, NGIN = 3328, NGIN_REAL = 3088;
constexpr float EPS = 1e-6f;
constexpr float MLA_SCALE = 0.10206207261596575f;
constexpr float GLA_SCALE = 0.08838834764831845f;
constexpr float QSCALE = 0.10206207261596575f * 1.4426950408889634f;

constexpr size_t O_YP = 0, O_YS = 16777216, O_CKVP = 17301504, O_KPEP = 21512192, O_CKVS = 22038528, O_KPES = 22169600, O_GLAP = 22185984, O_GLAS = 22710272, O_END = 39487488;

constexpr size_t MiB = 1u << 20;
constexpr size_t WS_CTL = 0, CTL_ZERO_BYTES = 1 * MiB;
constexpr size_t WS_WIN0 = 2 * MiB, WS_WUQ = 4 * MiB, WS_WUKV = 5 * MiB, WS_WO0 = 6 * MiB, WS_WUP = 8 * MiB, WS_WDN = 24 * MiB, WS_WGIN = 40 * MiB, WS_WGO = 47 * MiB;
constexpr size_t WS_X = 64 * MiB, WS_H = 132 * MiB, WS_M = 166 * MiB, WS_U = 234 * MiB, WS_A1 = 368 * MiB, WS_CQN = 419 * MiB, WS_CKVN = 428 * MiB, WS_KPE = 437 * MiB;
constexpr size_t WS_QRAW = 440 * MiB, WS_KNV = 541 * MiB, WS_QN = 608 * MiB, WS_QPE = 642 * MiB, WS_QLAT = 659 * MiB, WS_OLAT = 663 * MiB, WS_O = 671 * MiB;
constexpr size_t WS_QG = 705 * MiB, WS_KG = 722 * MiB, WS_VG = 739 * MiB, WS_RG = 773 * MiB, WS_GD = 807 * MiB, WS_LA = 809 * MiB, WS_EA = 843 * MiB, WS_OGRAW = 877 * MiB, WS_OG = 944 * MiB;
constexpr size_t WS_OPART = 978 * MiB, WS_MLP = 1012 * MiB;
constexpr size_t WS_QINF = 1014 * MiB, WS_KDTF = 1032 * MiB, WS_AMF = 1050 * MiB, WS_VTF = 1060 * MiB, WS_ELF = 1094 * MiB;
constexpr size_t WS_WUQL = 50 * MiB;
constexpr size_t WS_ROPE = 53 * MiB;
constexpr size_t WS_MT = 1096 * MiB;
constexpr size_t WS_END = 1144 * MiB;
constexpr int CW_BAR = 4096, CW_DEC = 8192;
namespace gla { constexpr int NSP = 8; }

constexpr int LDS_BYTES = 163840;
constexpr int MISC_OFF = LDS_BYTES - 256;

#define GAS __attribute__((address_space(1)))
#define LAS __attribute__((address_space(3)))
typedef unsigned short bf16;
typedef float f32x4 __attribute__((ext_vector_type(4)));
typedef unsigned u32x4 __attribute__((ext_vector_type(4)));
typedef unsigned u32x2 __attribute__((ext_vector_type(2)));
#define LDS_WAIT() asm volatile("s_waitcnt lgkmcnt(0)" ::: "memory")

__device__ __forceinline__ unsigned f2bf(float f) { unsigned u = __builtin_bit_cast(unsigned, f); return (u + 0x7fffu + ((u >> 16) & 1u)) >> 16; }
__device__ __forceinline__ unsigned pk2(float lo, float hi) { return f2bf(lo) | (f2bf(hi) << 16); }
__device__ __forceinline__ float bflo(unsigned u) { return __builtin_bit_cast(float, u << 16); }
__device__ __forceinline__ float bfhi(unsigned u) { return __builtin_bit_cast(float, u & 0xffff0000u); }
__device__ __forceinline__ float bf2f(bf16 v) { return __builtin_bit_cast(float, (unsigned)v << 16); }
__device__ __forceinline__ float wave_sum(float v) {
#pragma unroll
    for (int o = 1; o < 64; o <<= 1) v += __shfl_xor(v, o);
    return v;
}
__device__ __forceinline__ int wave_max_i(int v) {
#pragma unroll
    for (int o = 1; o < 64; o <<= 1) { int t = __shfl_xor(v, o); v = t > v ? t : v; }
    return v;
}
__device__ __forceinline__ int fresh_tid(int wave) { int t = wave * 64 + (int)__builtin_amdgcn_mbcnt_hi(~0u, __builtin_amdgcn_mbcnt_lo(~0u, 0u)); asm volatile("" : "+v"(t)); return t; }
__device__ __forceinline__ float rdlane(float v, int l) { return __builtin_bit_cast(float, __builtin_amdgcn_readlane(__builtin_bit_cast(int, v), l)); }

#define XB_TMO      128
#define XB_XCNT(j)  (256  + 64 * (j))
#define XB_XSUB(j)  (1280 + 64 * (j))
#define XB_XGEN(j)  (2304 + 64 * (j))
#define XB_TOP      3328
#define XB_TOPGEN   3392
#define XCD_BAR_WORDS 3456
#define XB_SPIN_CAP (1u << 18)
__device__ __forceinline__ unsigned xb_ld(unsigned* p)              { return __hip_atomic_load(p, __ATOMIC_RELAXED, __HIP_MEMORY_SCOPE_AGENT); }
__device__ __forceinline__ unsigned xb_add(unsigned* p, unsigned v) { return __hip_atomic_fetch_add(p, v, __ATOMIC_RELAXED, __HIP_MEMORY_SCOPE_AGENT); }
__device__ __forceinline__ unsigned xb_xcc_id() { return (unsigned)__builtin_amdgcn_s_getreg((3 << 11) | 20) & 0xFu; }
#define XB_SPIN(cond, bar) do { unsigned _sp = 0; while (cond) { __builtin_amdgcn_s_sleep(1); \
    if ((++_sp & 255u) == 0u) { if (xb_ld(&(bar)[XB_TMO])) break; if (_sp > XB_SPIN_CAP) { atomicAdd(&(bar)[XB_TMO], 1u); break; } } } } while (0)
struct XcdBarrier { unsigned* bar; unsigned x; volatile LAS unsigned* st; };
__device__ __forceinline__ XcdBarrier xcd_barrier_post(unsigned* bar, volatile LAS unsigned* st) {
    XcdBarrier b; b.bar = bar; b.x = xb_xcc_id(); b.st = st;
    if (threadIdx.x == 0) (void)xb_add(&bar[XB_XCNT(b.x)], 1u);
    return b;
}
__device__ __forceinline__ void xcd_barrier_complete(unsigned* bar, unsigned x, unsigned& nloc, unsigned& nx) {
    const unsigned G = gridDim.x * gridDim.y * gridDim.z;
    unsigned sum, cnt, mine, sp = 0u;
    for (;;) {
        sum = 0u; cnt = 0u; mine = 0u;
#pragma unroll
        for (unsigned j = 0; j < 16; ++j) { const unsigned c = xb_ld(&bar[XB_XCNT(j)]); sum += c; cnt += (c > 0u) ? 1u : 0u; mine = (j == x) ? c : mine; }
        if (sum == G) break;
        __builtin_amdgcn_s_sleep(1);
        if ((++sp & 255u) == 0u) { if (xb_ld(&bar[XB_TMO])) break; if (sp > XB_SPIN_CAP) { atomicAdd(&bar[XB_TMO], 1u); break; } }
    }
    nloc = mine > 0u ? mine : 1u; nx = cnt > 0u ? cnt : 1u;
}
__device__ __forceinline__ void xcd_barrier(const XcdBarrier& b, int wave_id) {
    asm volatile("s_waitcnt vmcnt(0)" ::: "memory");
    __syncthreads();
    if (fresh_tid(wave_id) == 0) {
        unsigned* bar = b.bar;
        __builtin_amdgcn_s_waitcnt(0);
        unsigned nloc = b.st[0], nx = b.st[1];
        if (nloc == 0u) { xcd_barrier_complete(bar, b.x, nloc, nx); b.st[0] = nloc; b.st[1] = nx; }
        const unsigned old = xb_add(&bar[XB_XSUB(b.x)], 1u);
        const unsigned gen = old / nloc;
        if (old + 1u == (gen + 1u) * nloc) {
            __builtin_amdgcn_fence(__ATOMIC_RELEASE, "agent");
            asm volatile("s_waitcnt vmcnt(0)" ::: "memory");
            const unsigned og = xb_add(&bar[XB_TOP], 1u);
            const unsigned tg = og / nx;
            if (og + 1u == (tg + 1u) * nx) xb_add(&bar[XB_TOPGEN], 1u);
            else XB_SPIN(xb_ld(&bar[XB_TOPGEN]) == tg, bar);
            __builtin_amdgcn_fence(__ATOMIC_ACQUIRE, "agent");
            xb_add(&bar[XB_XGEN(b.x)], 1u);
            asm volatile("s_waitcnt vmcnt(0)" ::: "memory");
        } else {
            XB_SPIN(xb_ld(&bar[XB_XGEN(b.x)]) == gen, bar);
            __builtin_amdgcn_fence(__ATOMIC_ACQUIRE, "agent");
            asm volatile("s_waitcnt vmcnt(0)" ::: "memory");
        }
    }
    __syncthreads();
}

namespace pg8 {
#define PG8_LAS __attribute__((address_space(3)))
typedef unsigned short bf16_t;
typedef short bf16x8 __attribute__((ext_vector_type(8)));
typedef float f32x4 __attribute__((ext_vector_type(4)));
typedef unsigned u32x4 __attribute__((ext_vector_type(4)));
constexpr int BM = 256, BK = 64, HALF = 128, HTB = HALF * BK * 2  , STAGE_BYTES = 8 * HTB, NXCD = 8, WGM = 8;

__host__ __device__ __forceinline__ int lds_byte(int r, int c) { const int st = (r >> 4) * 2 + (c >> 5), rr = r & 15, cc = c & 31, ob = rr * 64 + cc * 2; return st * 1024 + (ob ^ (((ob >> 9) & 1) << 5)); }
__host__ __device__ __forceinline__ void stage_rc(int b, int& R, int& C) { const int st = b / 1024, sb = b % 1024, swz = sb ^ (((sb >> 9) & 1) << 5); R = (st >> 1) * 16 + swz / 64; C = (st & 1) * 32 + (swz % 64) / 2; }
__host__ __device__ __forceinline__ int perm32(int rho) { const int n = rho >> 4, i = rho & 15; return 8 * (i >> 2) + 4 * n + (i & 3); }

struct Unit { int pm, pn, k0, prob; long aoff, boff; };
struct Gemm { const bf16_t* A; const bf16_t* Bt; int M, N, K, ld; };

struct StaticOrder {
    int nM, nN, nwg, G, c;
    __host__ __device__ void init(int M, int N, int G_, int c_) { nM = M / BM; nN = N / BM; nwg = nM * nN; G = G_; c = c_; }
    __host__ __device__ bool next(int i, Unit& u) const {
        const long L = (long)i * G + c; if (L >= nwg) return false;
        int wgid = (int)L; { const int q = nwg / NXCD, r = nwg % NXCD, xcd = wgid % NXCD, off = wgid / NXCD; wgid = (xcd < r ? xcd * (q + 1) : r * (q + 1) + (xcd - r) * q) + off; }
        const int nig = WGM * nN, gid = wgid / nig, fm = gid * WGM, gsz = (nM - fm) < WGM ? (nM - fm) : WGM;
        u.pm = fm + ((wgid % nig) % gsz); u.pn = (wgid % nig) / gsz; u.k0 = 0; u.prob = 0; u.aoff = 0; u.boff = 0; return true;
    }
    __device__ __forceinline__ void a_ready(const Unit&) const {}
    __device__ __forceinline__ void done(const Unit&) const {}
};

__device__ __forceinline__ unsigned cvt_pk_bf16(float lo, float hi) { unsigned r; asm volatile("v_cvt_pk_bf16_f32 %0, %1, %2" : "=v"(r) : "v"(lo), "v"(hi)); return r; }
template <class Epi, class Sched, bool ALIGN_EPI = false, bool SP2 = false>
__device__ __forceinline__ void gemm_phase(PG8_LAS unsigned char* lds, const Gemm g, const Sched& S, const Epi& E, int wave_id) {
    const int tid = fresh_tid(wave_id), wid = wave_id, lane = tid & 63, wr = wid >> 2, wc = wid & 3, fr = lane & 15, fq = lane >> 4;
    const int K = g.K, nt = K / BK;
    unsigned voffA[2], voffB[2];
#pragma unroll
    for (int i = 0; i < 2; ++i) { int R, C; stage_rc(tid * 16 + i * 8192, R, C); const int Rb = Epi::PERM ? ((R & ~31) + perm32(R & 31)) : R;
        voffA[i] = (unsigned)(R * g.ld + C) * 2u; voffB[i] = (unsigned)(Rb * g.ld + C) * 2u; }
    const size_t kstep = (size_t)(BK * 2);
    const size_t hstep = (size_t)HALF * g.ld * 2;
    const size_t tstep = 2 * hstep;
    const unsigned ldsw = (unsigned)wid * 1024u;
    const int aoff = lds_byte(wr * 64 + fr, fq * 8), boff = lds_byte(wc * 32 + fr, fq * 8);
#define PG8_SA(b, h) (((b) * 2 + (h)) * HTB)
#define PG8_SB(b, h) ((4 + (b) * 2 + (h)) * HTB)
#define PG8_STAGE(bufoff, gbase, voff) do { _Pragma("unroll") for (int _i = 0; _i < 2; ++_i) \
        __builtin_amdgcn_global_load_lds((const unsigned*)((const char*)(gbase) + (voff)[_i]), (PG8_LAS unsigned*)(lds + (bufoff) + ldsw + _i * 8192), 16, 0, 0); } while (0)
#define PG8_LDA(dst, b, h) do { _Pragma("unroll") for (int m = 0; m < 4; ++m) _Pragma("unroll") for (int k = 0; k < 2; ++k) dst[m][k] = *(const PG8_LAS bf16x8*)(lds + PG8_SA(b, h) + aoff + m * 2048 + k * 1024); } while (0)
#define PG8_LDB(dst, b, h) do { _Pragma("unroll") for (int n = 0; n < 2; ++n) _Pragma("unroll") for (int k = 0; k < 2; ++k) dst[n][k] = *(const PG8_LAS bf16x8*)(lds + PG8_SB(b, h) + boff + n * 2048 + k * 1024); } while (0)
#define PG8_MMA(ai, bj, At, Bt) do { __builtin_amdgcn_s_setprio(1); _Pragma("unroll") for (int m = 0; m < 4; ++m) _Pragma("unroll") for (int n = 0; n < 2; ++n) _Pragma("unroll") for (int k = 0; k < 2; ++k) \
        acc[ai][bj][m][n] = __builtin_amdgcn_mfma_f32_16x16x32_bf16(Bt[n][k], At[m][k], acc[ai][bj][m][n], 0, 0, 0); __builtin_amdgcn_s_setprio(0); } while (0)
#define PG8_WAIT_V(n) asm volatile("s_waitcnt vmcnt(" #n ")" ::: "memory")
#define PG8_WAIT_L(n) asm volatile("s_waitcnt lgkmcnt(" #n ")" ::: "memory")
#define PG8_BAR __builtin_amdgcn_s_barrier()
#define PG8_SCHED __builtin_amdgcn_sched_barrier(0)
    Unit cur, nxt; int ui = 0;
    if (!S.next(0, cur)) return;
    f32x4 acc[2][2][4][2];
#pragma unroll
    for (int a = 0; a < 2; ++a)
#pragma unroll
        for (int b = 0; b < 2; ++b)
#pragma unroll
            for (int m = 0; m < 4; ++m)
#pragma unroll
                for (int n = 0; n < 2; ++n) acc[a][b][m][n] = (f32x4){0.f, 0.f, 0.f, 0.f};
    bf16x8 At[4][2], B0[2][2], B1[2][2];
    const char* cA = (const char*)g.A + (size_t)cur.pm * tstep + (size_t)cur.k0 * 2 + cur.aoff; const char* cB = (const char*)g.Bt + (size_t)cur.pn * tstep + (size_t)cur.k0 * 2 + cur.boff;
    S.a_ready(cur);
    if constexpr (SP2) {
        PG8_STAGE(PG8_SB(0, 0), cB, voffB); PG8_STAGE(PG8_SB(0, 1), cB + hstep, voffB); PG8_STAGE(PG8_SA(0, 0), cA, voffA); PG8_STAGE(PG8_SA(0, 1), cA + hstep, voffA);
        if (wr == 1) PG8_BAR;
        PG8_WAIT_V(2); PG8_BAR;
        PG8_STAGE(PG8_SB(1, 0), cB + kstep, voffB); PG8_STAGE(PG8_SA(1, 0), cA + kstep, voffA); PG8_STAGE(PG8_SB(1, 1), cB + hstep + kstep, voffB);
        PG8_WAIT_V(6); PG8_BAR;
    } else {
        PG8_STAGE(PG8_SB(0, 0), cB, voffB); PG8_STAGE(PG8_SA(0, 0), cA, voffA); PG8_STAGE(PG8_SB(0, 1), cB + hstep, voffB); PG8_STAGE(PG8_SA(0, 1), cA + hstep, voffA);
        if (wr == 1) PG8_BAR;
        PG8_WAIT_V(4); PG8_BAR;
        PG8_STAGE(PG8_SB(1, 0), cB + kstep, voffB); PG8_STAGE(PG8_SA(1, 0), cA + kstep, voffA); PG8_STAGE(PG8_SB(1, 1), cB + hstep + kstep, voffB);
        PG8_WAIT_V(6); PG8_BAR;
    }
    for (;;) {
        const bool has_next = S.next(ui + 1, nxt);
        const char* nA = has_next ? (const char*)g.A + (size_t)nxt.pm * tstep + (size_t)nxt.k0 * 2 + nxt.aoff : cA; const char* nB = has_next ? (const char*)g.Bt + (size_t)nxt.pn * tstep + (size_t)nxt.k0 * 2 + nxt.boff : cB;
        for (int t = 0; t < nt; t += 2) {
            const bool last = (t == nt - 2);
            const char* a1 = cA + (size_t)(t + 1) * kstep;
            const char* a2 = last ? nA : cA + (size_t)(t + 2) * kstep; const char* b2 = last ? nB : cB + (size_t)(t + 2) * kstep;
            const char* a3 = a2 + kstep; const char* b3 = b2 + kstep;
            if (last && has_next) S.a_ready(nxt);
            if constexpr (SP2) {
            PG8_LDB(B0, 0, 0); PG8_LDB(B1, 0, 1); PG8_SCHED; PG8_LDA(At, 0, 0); PG8_STAGE(PG8_SA(1, 1), a1 + hstep, voffA);
            PG8_WAIT_V(8); PG8_WAIT_L(0); PG8_BAR; PG8_MMA(0, 0, At, B0); PG8_MMA(0, 1, At, B1); PG8_BAR; PG8_SCHED;
            PG8_LDA(At, 0, 1); PG8_STAGE(PG8_SB(0, 0), b2, voffB); PG8_STAGE(PG8_SB(0, 1), b2 + hstep, voffB); PG8_STAGE(PG8_SA(0, 0), a2, voffA);
            PG8_WAIT_V(8); PG8_WAIT_L(0); PG8_BAR; PG8_MMA(1, 0, At, B0); PG8_MMA(1, 1, At, B1); PG8_BAR; PG8_SCHED;
            PG8_LDB(B0, 1, 0); PG8_LDB(B1, 1, 1); PG8_SCHED; PG8_LDA(At, 1, 0); PG8_STAGE(PG8_SA(0, 1), a2 + hstep, voffA);
            PG8_WAIT_V(8); PG8_WAIT_L(0); PG8_BAR; PG8_MMA(0, 0, At, B0); PG8_MMA(0, 1, At, B1); PG8_BAR; PG8_SCHED;
            PG8_LDA(At, 1, 1); PG8_STAGE(PG8_SB(1, 0), b3, voffB); PG8_STAGE(PG8_SB(1, 1), b3 + hstep, voffB); PG8_STAGE(PG8_SA(1, 0), a3, voffA);
            PG8_WAIT_V(8); PG8_WAIT_L(0); PG8_BAR; PG8_MMA(1, 0, At, B0); PG8_MMA(1, 1, At, B1); PG8_BAR; PG8_SCHED;
            } else {
            PG8_LDB(B0, 0, 0); PG8_SCHED; PG8_LDA(At, 0, 0); PG8_STAGE(PG8_SA(1, 1), a1 + hstep, voffA);
            PG8_WAIT_L(8); PG8_BAR; PG8_WAIT_L(0); PG8_MMA(0, 0, At, B0); PG8_BAR; PG8_SCHED;
            PG8_LDB(B1, 0, 1); PG8_STAGE(PG8_SB(0, 0), b2, voffB);
            PG8_BAR; PG8_WAIT_L(0); PG8_MMA(0, 1, At, B1); PG8_BAR;
            PG8_LDA(At, 0, 1); PG8_STAGE(PG8_SA(0, 0), a2, voffA);
            PG8_BAR; PG8_WAIT_L(0); PG8_MMA(1, 0, At, B0); PG8_BAR; PG8_SCHED;
            PG8_STAGE(PG8_SB(0, 1), b2 + hstep, voffB);
            PG8_WAIT_V(6); PG8_BAR; PG8_MMA(1, 1, At, B1); PG8_BAR;
            PG8_LDB(B0, 1, 0); PG8_SCHED; PG8_LDA(At, 1, 0); PG8_STAGE(PG8_SA(0, 1), a2 + hstep, voffA);
            PG8_WAIT_L(8); PG8_BAR; PG8_WAIT_L(0); PG8_MMA(0, 0, At, B0); PG8_BAR; PG8_SCHED;
            PG8_LDB(B1, 1, 1); PG8_STAGE(PG8_SB(1, 0), b3, voffB);
            PG8_BAR; PG8_WAIT_L(0); PG8_MMA(0, 1, At, B1); PG8_BAR;
            PG8_LDA(At, 1, 1); PG8_STAGE(PG8_SA(1, 0), a3, voffA);
            PG8_BAR; PG8_WAIT_L(0); PG8_MMA(1, 0, At, B0); PG8_BAR; PG8_SCHED;
            PG8_STAGE(PG8_SB(1, 1), b3 + hstep, voffB);
            PG8_WAIT_V(6); PG8_BAR; PG8_MMA(1, 1, At, B1); PG8_BAR;
            }
        }
        if constexpr (ALIGN_EPI) { if (wr == 0) PG8_BAR; }
        if constexpr (!Epi::AFTER_DRAIN) { E(acc, cur, wr, wc, fr, fq); S.done(cur); }
        if (!has_next) break;
#pragma unroll
        for (int a = 0; a < 2; ++a)
#pragma unroll
            for (int b = 0; b < 2; ++b)
#pragma unroll
                for (int m = 0; m < 4; ++m)
#pragma unroll
                    for (int n = 0; n < 2; ++n) acc[a][b][m][n] = (f32x4){0.f, 0.f, 0.f, 0.f};
        cur = nxt; cA = nA; cB = nB; ++ui;
        if constexpr (ALIGN_EPI) { if (wr == 1) PG8_BAR; }
    }
    PG8_WAIT_V(0);
    if constexpr (!ALIGN_EPI) { if (wr == 0) PG8_BAR; }
    PG8_BAR;
    if constexpr (Epi::AFTER_DRAIN) { E.fused(acc, cur, wr, wc, fr, fq, lds, wid, lane); S.done(cur); }
#undef PG8_SA
#undef PG8_SB
#undef PG8_STAGE
#undef PG8_LDA
#undef PG8_LDB
#undef PG8_MMA
#undef PG8_WAIT_V
#undef PG8_WAIT_L
#undef PG8_BAR
#undef PG8_SCHED
}
}

struct Args { const void* in[25]; float* out; unsigned char* ws; int ph_lo, ph_hi; };
typedef const __attribute__((address_space(4))) Args* ArgsP;
#define IN_F(k) ((const float*)a->in[k])
#define WSB(off) ((bf16*)(a->ws + (off)))
#define WSF(off) ((float*)(a->ws + (off)))

struct Ctx { int tid, lane, wave, gw, ngw, gwT; };
__device__ __forceinline__ Ctx refresh(const Ctx& c0) { Ctx c = c0; c.tid = fresh_tid(c0.wave); c.lane = c.tid & 63; return c; }

__device__ __forceinline__ int row_pos(int r) { return r < RMAIN ? (r & 4095) + NMETA : (r < RSAMP0 ? ((r - RMAIN) & 15) : PAST + ((r - RSAMP0) & 3)); }
__device__ __forceinline__ float rope_inv(int j) { return exp2f(-(float)j * (13.287712379549449f / 16.0f)); }
__device__ __forceinline__ void rope_cs(int pos, int j, float& c, float& s) {
    const float ang = (float)pos * rope_inv(j);
    const double x = (double)ang; const double n = rint(x * 0.15915494309189535); const float r = (float)(x - n * 6.283185307179586);
    c = cosf(r); s = sinf(r);
}

struct RmId { int off; __device__ __forceinline__ int operator()(int n) const { return off + n; } };
struct RmUq { __device__ __forceinline__ int operator()(int n) const { const int h = n / 96, j = n % 96; if (j < 64) return h * 64 + j; const int jj = j - 64; return 1024 + h * 32 + (jj < 16 ? 2 * jj : 2 * (jj - 16) + 1); } };
template <class RM>
__device__ __forceinline__ void tr_item(const float* W, int ldw, int nblk, int item, bf16* WT, int ldt, RM rm, LAS float* scr, int lane) {
    const int kb = item / nblk, nb = item % nblk, k0 = 64 * kb, n0 = 32 * nb;
#pragma unroll
    for (int i = 0; i < 8; ++i) { const int kk = 8 * i + (lane >> 3), c4 = (lane & 7) * 4; const f32x4 v = __builtin_nontemporal_load((const f32x4*)(W + (size_t)(k0 + kk) * ldw + n0 + c4));
        scr[kk * 33 + c4] = v.x; scr[kk * 33 + c4 + 1] = v.y; scr[kk * 33 + c4 + 2] = v.z; scr[kk * 33 + c4 + 3] = v.w; }
    LDS_WAIT();
    const int c = lane & 7;
#pragma unroll
    for (int j = 0; j < 4; ++j) { const int n = (lane >> 3) + 8 * j; const LAS float* s = scr + (8 * c) * 33 + n;
        u32x4 o; o.x = pk2(s[0 * 33], s[1 * 33]); o.y = pk2(s[2 * 33], s[3 * 33]); o.z = pk2(s[4 * 33], s[5 * 33]); o.w = pk2(s[6 * 33], s[7 * 33]);
        *(u32x4*)(WT + (size_t)rm(n0 + n) * ldt + k0 + 8 * c) = o; }
    LDS_WAIT();
}
__device__ __forceinline__ void norm_row_bf16(const float* xrow, const float* g, float* xcopy, bf16* hrow, int lane) {
    f32x4 v[4]; float s = 0.f;
#pragma unroll
    for (int j = 0; j < 4; ++j) { v[j] = *(const f32x4*)(xrow + 4 * lane + 256 * j); s += (v[j].x * v[j].x + v[j].y * v[j].y) + (v[j].z * v[j].z + v[j].w * v[j].w); }
    const float rs = 1.0f / sqrtf(wave_sum(s) * (1.f / D) + EPS);
#pragma unroll
    for (int j = 0; j < 4; ++j) { const f32x4 gg = *(const f32x4*)(g + 4 * lane + 256 * j);
        if (xcopy) *(f32x4*)(xcopy + 4 * lane + 256 * j) = v[j];
        u32x2 o; o.x = pk2(v[j].x * rs * gg.x, v[j].y * rs * gg.y); o.y = pk2(v[j].z * rs * gg.z, v[j].w * rs * gg.w);
        *(u32x2*)(hrow + 4 * lane + 256 * j) = o; }
}
__device__ __forceinline__ void p_prep(ArgsP a, const Ctx& c0, LAS unsigned char* lds) {
    const Ctx c = refresh(c0);
    LAS float* scr = (LAS float*)(lds + c.wave * 16384);
    constexpr int I0 = 16 * 17, I1 = 4 * 48, I2 = 4 * 32, I3 = 4 * 32, I4 = 16 * 32, I5 = 16 * 96, I6 = 16 * 32, I7 = 16 * 128, I8 = 16 * 128, I9 = 64 * 32, I10 = 64 * 32;
    constexpr int NIT = I0 + I1 + I2 + I3 + I4 + I5 + I6 + I7 + I8 + I9 + I10;
    for (int it = c.gw; it < NIT; it += c.ngw) {
        int r = it;
        if (r < I0) { tr_item(IN_F(11), 544, 17, r, WSB(WS_WIN0), 1024, RmId{0}, scr, c.lane); continue; } r -= I0;
        if (r < I1) { tr_item(IN_F(13), 1536, 48, r, WSB(WS_WUQ), 256, RmUq{}, scr, c.lane); continue; } r -= I1;
        if (r < I2) { tr_item(IN_F(15), 1024, 32, r, WSB(WS_WUKV), 256, RmId{0}, scr, c.lane); continue; } r -= I2;
        if (r < I3) { tr_item(IN_F(16), 1024, 32, r, WSB(WS_WUKV), 256, RmId{1024}, scr, c.lane); continue; } r -= I3;
        if (r < I4) { tr_item(IN_F(17), 1024, 32, r, WSB(WS_WO0), 1024, RmId{0}, scr, c.lane); continue; } r -= I4;
        if (r < I5) { tr_item(IN_F(18), 3088, 96, r, WSB(WS_WGIN), 1024, RmId{0}, scr, c.lane); continue; } r -= I5;
        if (r < I6) { tr_item(IN_F(22), 1024, 32, r, WSB(WS_WGO), 1024, RmId{0}, scr, c.lane); continue; } r -= I6;
        if (r < I7) { tr_item(IN_F(23), 4096, 128, r, WSB(WS_WUP), 1024, RmId{0}, scr, c.lane); continue; } r -= I7;
        if (r < I8) { tr_item(IN_F(23) + (size_t)1024 * 4096, 4096, 128, r, WSB(WS_WUP) + (size_t)4096 * 1024, 1024, RmId{0}, scr, c.lane); continue; } r -= I8;
        if (r < I9) { tr_item(IN_F(24), 1024, 32, r, WSB(WS_WDN), 4096, RmId{0}, scr, c.lane); continue; } r -= I9;
        tr_item(IN_F(24) + (size_t)4096 * 1024, 1024, 32, r, WSB(WS_WDN) + (size_t)1024 * 4096, 4096, RmId{0}, scr, c.lane);
    }
    const int gt = c.gw * 64 + c.lane, ngt = c.ngw * 64;
    for (int i = gt; i < (NIN0 - 544) * 1024 / 2; i += ngt) ((unsigned*)(WSB(WS_WIN0) + (size_t)544 * 1024))[i] = 0u;
    for (int i = gt; i < (NGIN - NGIN_REAL) * 1024 / 2; i += ngt) ((unsigned*)(WSB(WS_WGIN) + (size_t)NGIN_REAL * 1024))[i] = 0u;
    for (int i = gt; i < 16 * 1024; i += ngt) { const int n = i >> 10, k = i & 1023; WSB(WS_WGIN)[(size_t)(3072 + n) * 1024 + k] = (bf16)f2bf(IN_F(18)[(size_t)k * 3088 + 3072 + n]); }
    for (int i = c.gw * 64 + c.lane; i < R * 16; i += c.ngw * 64) { const int r = i >> 4, j = i & 15; float cs, sn; rope_cs(row_pos(r), j, cs, sn); WSF(WS_ROPE)[(size_t)r * 32 + j] = cs; WSF(WS_ROPE)[(size_t)r * 32 + 16 + j] = sn; }
    {
        const float* xp = IN_F(0); const float* xm = IN_F(6); const float* xsm = IN_F(1); bf16* X = WSB(WS_X); bf16* H = WSB(WS_H);
        f32x4 gg[4];
#pragma unroll
        for (int j = 0; j < 4; ++j) gg[j] = *(const f32x4*)(IN_F(7) + 4 * c.lane + 256 * j);
        constexpr int NR = 4;
        for (int r0 = c.gw; r0 < R; r0 += NR * c.ngw) {
            f32x4 v[NR][4]; float s[NR];
#pragma unroll
            for (int q = 0; q < NR; ++q) { const int r = r0 + q * c.ngw < R ? r0 + q * c.ngw : r0;
                const float* xs = r < RMAIN ? xp + (size_t)r * D : (r < RSAMP0 ? xm + (size_t)((r - RMAIN) & 15) * D : xsm + (size_t)(r - RSAMP0) * D);
                s[q] = 0.f;
#pragma unroll
                for (int j = 0; j < 4; ++j) { v[q][j] = *(const f32x4*)(xs + 4 * c.lane + 256 * j); s[q] += (v[q][j].x * v[q][j].x + v[q][j].y * v[q][j].y) + (v[q][j].z * v[q][j].z + v[q][j].w * v[q][j].w); } }
#pragma unroll
            for (int sh = 1; sh < 64; sh <<= 1) {
#pragma unroll
                for (int q = 0; q < NR; ++q) s[q] += __shfl_xor(s[q], sh); }
#pragma unroll
            for (int q = 0; q < NR; ++q) { const int r = r0 + q * c.ngw < R ? r0 + q * c.ngw : r0; const float rs = 1.0f / sqrtf(s[q] * (1.f / D) + EPS);
#pragma unroll
                for (int j = 0; j < 4; ++j) { if (r >= RMAIN) { u32x2 xo; xo.x = pk2(v[q][j].x, v[q][j].y); xo.y = pk2(v[q][j].z, v[q][j].w); *(u32x2*)(X + (size_t)r * D + 4 * c.lane + 256 * j) = xo; }
                    u32x2 o; o.x = pk2(v[q][j].x * rs * gg[j].x, v[q][j].y * rs * gg[j].y); o.y = pk2(v[q][j].z * rs * gg[j].z, v[q][j].w * rs * gg[j].w);
                    *(u32x2*)(H + (size_t)r * D + 4 * c.lane + 256 * j) = o; } }
        }
    }
}

struct EpiF32 { float* C; int ldc; __device__ __forceinline__ void store4(int row, int col, f32x4 v) const { *(f32x4*)(C + (size_t)row * ldc + col) = v; } };
struct EpiBf16 { bf16* C; int ldc;
    __device__ __forceinline__ void store8(int row, int col, f32x4 a, f32x4 b) const { u32x4 o; o.x = pk2(a.x, a.y); o.y = pk2(a.z, a.w); o.z = pk2(b.x, b.y); o.w = pk2(b.z, b.w); *(u32x4*)(C + (size_t)row * ldc + col) = o; }
    __device__ __forceinline__ void store4(int row, int col, f32x4 v) const { u32x2 o; o.x = pk2(v.x, v.y); o.y = pk2(v.z, v.w); *(u32x2*)(C + (size_t)row * ldc + col) = o; } };
struct EpiRelu2 { bf16* C; int ldc;
    __device__ __forceinline__ void store8(int row, int col, f32x4 a, f32x4 b) const {
        f32x4 r; r.x = fmaxf(a.x, 0.f); r.y = fmaxf(a.y, 0.f); r.z = fmaxf(a.z, 0.f); r.w = fmaxf(a.w, 0.f); r = r * r;
        f32x4 s; s.x = fmaxf(b.x, 0.f); s.y = fmaxf(b.y, 0.f); s.z = fmaxf(b.z, 0.f); s.w = fmaxf(b.w, 0.f); s = s * s;
        u32x4 o; o.x = pk2(r.x, r.y); o.y = pk2(r.z, r.w); o.z = pk2(s.x, s.y); o.w = pk2(s.z, s.w); *(u32x4*)(C + (size_t)row * ldc + col) = o; }
    __device__ __forceinline__ void store4(int row, int col, f32x4 v) const {
    f32x4 r; r.x = fmaxf(v.x, 0.f); r.y = fmaxf(v.y, 0.f); r.z = fmaxf(v.z, 0.f); r.w = fmaxf(v.w, 0.f); r = r * r;
    u32x2 o; o.x = pk2(r.x, r.y); o.y = pk2(r.z, r.w); *(u32x2*)(C + (size_t)row * ldc + col) = o; } };
struct EpiQ { bf16* QN; bf16* QPE; const float* ROPE;
    __device__ __forceinline__ void store8(int row, int col, f32x4 a, f32x4 b) const {
        if (col < 1024) { u32x4 o; o.x = pk2(a.x * QSCALE, a.y * QSCALE); o.y = pk2(a.z * QSCALE, a.w * QSCALE); o.z = pk2(b.x * QSCALE, b.y * QSCALE); o.w = pk2(b.z * QSCALE, b.w * QSCALE); *(u32x4*)(QN + (size_t)row * 1024 + col) = o; }
        else { store4(row, col, a); store4(row, col + 4, b); }
    }
    __device__ __forceinline__ void store4(int row, int col, f32x4 v) const {
        if (col < 1024) { u32x2 o; o.x = pk2(v.x * QSCALE, v.y * QSCALE); o.y = pk2(v.z * QSCALE, v.w * QSCALE); *(u32x2*)(QN + (size_t)row * 1024 + col) = o; }
        else { const int p0 = (col - 1024) >> 1; const float* rt = ROPE + (size_t)row * 32;
#pragma unroll
            for (int e = 0; e < 2; ++e) { const int p = p0 + e, h = p >> 4, jj = p & 15; const float x1 = e ? v.z : v.x, x2 = e ? v.w : v.y, cs = rt[jj], sn = rt[16 + jj];
                QPE[(size_t)row * 512 + h * 32 + jj] = (bf16)f2bf((x1 * cs - x2 * sn) * QSCALE); QPE[(size_t)row * 512 + h * 32 + 16 + jj] = (bf16)f2bf((x1 * sn + x2 * cs) * QSCALE); } }
    } };
struct EpiBf16S { bf16* C; int ldc; float s;
    __device__ __forceinline__ void store8(int row, int col, f32x4 a, f32x4 b) const { u32x4 o; o.x = pk2(a.x * s, a.y * s); o.y = pk2(a.z * s, a.w * s); o.z = pk2(b.x * s, b.y * s); o.w = pk2(b.z * s, b.w * s); *(u32x4*)(C + (size_t)row * ldc + col) = o; }
    __device__ __forceinline__ void store4(int row, int col, f32x4 v) const { u32x2 o; o.x = pk2(v.x * s, v.y * s); o.y = pk2(v.z * s, v.w * s); *(u32x2*)(C + (size_t)row * ldc + col) = o; } };
struct EpiGla { bf16 *QG, *KG, *VG, *RG; float* GD;
    __device__ __forceinline__ void store8(int row, int col, f32x4 a, f32x4 b) const {
        if (col < 3072) { bf16* dst; int cc;
            if (col < 512) { dst = QG + (size_t)row * 512; cc = col; a = a * GLA_SCALE; b = b * GLA_SCALE; }
            else if (col < 1024) { dst = KG + (size_t)row * 512; cc = col - 512; }
            else if (col < 2048) { dst = VG + (size_t)row * 1024; cc = col - 1024; }
            else { dst = RG + (size_t)row * 1024; cc = col - 2048; }
            u32x4 o; o.x = pk2(a.x, a.y); o.y = pk2(a.z, a.w); o.z = pk2(b.x, b.y); o.w = pk2(b.z, b.w); *(u32x4*)(dst + cc) = o;
        } else if (col < 3088) { *(f32x4*)(GD + (size_t)row * 16 + (col - 3072)) = a; *(f32x4*)(GD + (size_t)row * 16 + (col - 3072) + 4) = b; }
    }
    __device__ __forceinline__ void store4(int row, int col, f32x4 v) const {
        if (col < 3072) { bf16* dst; int cc;
            if (col < 512) { dst = QG + (size_t)row * 512; cc = col; v = v * GLA_SCALE; }
            else if (col < 1024) { dst = KG + (size_t)row * 512; cc = col - 512; }
            else if (col < 2048) { dst = VG + (size_t)row * 1024; cc = col - 1024; }
            else { dst = RG + (size_t)row * 1024; cc = col - 2048; }
            u32x2 o; o.x = pk2(v.x, v.y); o.y = pk2(v.z, v.w); *(u32x2*)(dst + cc) = o;
        } else if (col < 3088) { *(f32x4*)(GD + (size_t)row * 16 + (col - 3072)) = v; }
    } };
template <class Epi>
__device__ __forceinline__ void gemm_naive(const bf16* A, const bf16* Bt, int M, int N, int K, const Epi& E, LAS unsigned char* lds, int tid) {
    LAS float* As = (LAS float*)lds;
    LAS float* Bs = As + 32 * 68;
    const int ntm = M / 64, ntn = N / 128, ty = tid >> 5, tx = tid & 31;
    for (int tile = blockIdx.x; tile < ntm * ntn; tile += gridDim.x) {
        const int tm = tile / ntn, tn = tile % ntn;
        f32x4 acc[4];
#pragma unroll
        for (int i = 0; i < 4; ++i) acc[i] = (f32x4){0.f, 0.f, 0.f, 0.f};
        for (int k0 = 0; k0 < K; k0 += 32) {
            { const int row = tid >> 3, kq = (tid & 7) * 4; const u32x2 v = *(const u32x2*)(A + (size_t)(tm * 64 + row) * K + k0 + kq);
              As[(kq + 0) * 68 + row] = bflo(v.x); As[(kq + 1) * 68 + row] = bfhi(v.x); As[(kq + 2) * 68 + row] = bflo(v.y); As[(kq + 3) * 68 + row] = bfhi(v.y); }
            { const int row = tid >> 2, kq = (tid & 3) * 8; const u32x4 v = *(const u32x4*)(Bt + (size_t)(tn * 128 + row) * K + k0 + kq);
              Bs[(kq + 0) * 132 + row] = bflo(v.x); Bs[(kq + 1) * 132 + row] = bfhi(v.x); Bs[(kq + 2) * 132 + row] = bflo(v.y); Bs[(kq + 3) * 132 + row] = bfhi(v.y);
              Bs[(kq + 4) * 132 + row] = bflo(v.z); Bs[(kq + 5) * 132 + row] = bfhi(v.z); Bs[(kq + 6) * 132 + row] = bflo(v.w); Bs[(kq + 7) * 132 + row] = bfhi(v.w); }
            __syncthreads();
#pragma unroll 8
            for (int k = 0; k < 32; ++k) {
                const f32x4 av = *(const LAS f32x4*)(As + k * 68 + 4 * ty); const f32x4 bv = *(const LAS f32x4*)(Bs + k * 132 + 4 * tx);
                acc[0] += av.x * bv; acc[1] += av.y * bv; acc[2] += av.z * bv; acc[3] += av.w * bv;
            }
            __syncthreads();
        }
#pragma unroll
        for (int i = 0; i < 4; ++i) E.store4(tm * 64 + 4 * ty + i, tn * 128 + 4 * tx, acc[i]);
    }
}


template <class E> struct EpiWrap {
    static constexpr bool PERM = false, AFTER_DRAIN = false; E e;
    __device__ __forceinline__ void operator()(const pg8::f32x4 (&acc)[2][2][4][2], const pg8::Unit& u, int wr, int wc, int fr, int fq) const {
#pragma unroll
        for (int ai = 0; ai < 2; ++ai)
#pragma unroll
            for (int m = 0; m < 4; ++m) { const int row = u.pm * 256 + ai * 128 + wr * 64 + m * 16 + fr;
#pragma unroll
                for (int bj = 0; bj < 2; ++bj)
#pragma unroll
                    for (int n = 0; n < 2; ++n) e.store4(row, u.pn * 256 + bj * 128 + wc * 32 + n * 16 + 4 * fq, acc[ai][bj][m][n]); }
    }
};
template <int KSUB> struct EpiSlab {
    static constexpr bool PERM = false, AFTER_DRAIN = false; float* MT;
    __device__ __forceinline__ void operator()(const pg8::f32x4 (&acc)[2][2][4][2], const pg8::Unit& u, int wr, int wc, int fr, int fq) const {
        float* base = MT + ((size_t)(u.k0 / KSUB) * (RP - RMAIN) + (size_t)(u.pm * 256 - RMAIN)) * D + u.pn * 256 + wc * 32 + 4 * fq;
#pragma unroll
        for (int ai = 0; ai < 2; ++ai)
#pragma unroll
            for (int m = 0; m < 4; ++m) { float* rp = base + (size_t)(ai * 128 + wr * 64 + m * 16 + fr) * D;
#pragma unroll
                for (int bj = 0; bj < 2; ++bj)
#pragma unroll
                    for (int n = 0; n < 2; ++n) *(f32x4*)(rp + bj * 128 + n * 16) = acc[ai][bj][m][n]; }
    }
};
template <class E> struct EpiWrap8 {
    static constexpr bool PERM = true, AFTER_DRAIN = false; E e;
    __device__ __forceinline__ void operator()(const pg8::f32x4 (&acc)[2][2][4][2], const pg8::Unit& u, int wr, int wc, int fr, int fq) const {
#pragma unroll
        for (int ai = 0; ai < 2; ++ai)
#pragma unroll
            for (int m = 0; m < 4; ++m) { const int row = u.pm * 256 + ai * 128 + wr * 64 + m * 16 + fr;
#pragma unroll
                for (int bj = 0; bj < 2; ++bj) e.store8(row, u.pn * 256 + bj * 128 + wc * 32 + 8 * fq, acc[ai][bj][m][0], acc[ai][bj][m][1]); }
    }
};
template <class E>
__device__ __forceinline__ void gemm_mfma8(const bf16* A, const bf16* Bt, int M, int N, int K, const E& e, LAS unsigned char* lds, int wave) {
    pg8::Gemm g{A, Bt, M, N, K, K}; pg8::StaticOrder S; S.init(M, N, (int)gridDim.x, (int)blockIdx.x);
    EpiWrap8<E> W{e};
    pg8::gemm_phase<EpiWrap8<E>, pg8::StaticOrder, true, true>(lds, g, S, W, wave);
}
template <class E>
__device__ __forceinline__ void gemm_mfma(const bf16* A, const bf16* Bt, int M, int N, int K, const E& e, LAS unsigned char* lds, int wave) {
    pg8::Gemm g{A, Bt, M, N, K, K}; pg8::StaticOrder S; S.init(M, N, (int)gridDim.x, (int)blockIdx.x);
    EpiWrap<E> W{e};
    pg8::gemm_phase<EpiWrap<E>, pg8::StaticOrder, true, true>(lds, g, S, W, wave);
}
template <int SPLIT, int NN, int KSUB, int PM0, int NUNITS> struct TailOrder {
    int G, c;
    __device__ __forceinline__ bool next(int i, pg8::Unit& u) const { const int L = i * G + c; if (L >= NUNITS) return false; const int ks = L % SPLIT, t = L / SPLIT; u.pn = t % NN; u.pm = PM0 + t / NN; u.k0 = ks * KSUB; u.prob = 0; u.aoff = 0; u.boff = 0; return true; }
    __device__ __forceinline__ void a_ready(const pg8::Unit&) const {}
    __device__ __forceinline__ void done(const pg8::Unit&) const {}
};
struct EpiAtomicF32 { float* C; int ldc; __device__ __forceinline__ void store4(int row, int col, f32x4 v) const { float* p = C + (size_t)row * ldc + col;
    __hip_atomic_fetch_add(p, v.x, __ATOMIC_RELAXED, __HIP_MEMORY_SCOPE_AGENT); __hip_atomic_fetch_add(p + 1, v.y, __ATOMIC_RELAXED, __HIP_MEMORY_SCOPE_AGENT);
    __hip_atomic_fetch_add(p + 2, v.z, __ATOMIC_RELAXED, __HIP_MEMORY_SCOPE_AGENT); __hip_atomic_fetch_add(p + 3, v.w, __ATOMIC_RELAXED, __HIP_MEMORY_SCOPE_AGENT); } };
template <int K, int SPLIT>
__device__ __forceinline__ void gemm_n1024_tail(const bf16* A, const bf16* Bt, bf16* C, float* MT, LAS unsigned char* lds, int wave) {
    { pg8::Gemm g{A, Bt, RMAIN, D, K, K}; pg8::StaticOrder S; S.init(RMAIN, D, (int)gridDim.x, (int)blockIdx.x); EpiWrap8<EpiBf16> W{EpiBf16{C, D}};
      pg8::gemm_phase<EpiWrap8<EpiBf16>, pg8::StaticOrder, true, true>(lds, g, S, W, wave); }
    { typedef TailOrder<SPLIT, D / 256, K / SPLIT, RMAIN / 256, (RP - RMAIN) / 256 * (D / 256) * SPLIT> TO;
      pg8::Gemm g{A, Bt, RP, D, K / SPLIT, K}; TO S{(int)gridDim.x, (int)blockIdx.x}; EpiSlab<K / SPLIT> W{MT};
      pg8::gemm_phase<EpiSlab<K / SPLIT>, TO, false, true>(lds, g, S, W, wave); }
}

struct P3Order {
    int G, c;
    static constexpr int NQ = (RP / 256) * (NUQ / 256), NL = (DB * DS / 256) * (NH * KVL / 256), NK = (RP / 256) * (NUKV / 256);
    __device__ __forceinline__ bool next(int i, pg8::Unit& u) const {
        int L = i * G + c; u.k0 = 0;
        if (L < NK) { u.prob = 2; u.pm = L / (NUKV / 256); u.pn = L % (NUKV / 256); u.aoff = (long)(WS_CKVN - WS_CQN); u.boff = (long)(WS_WUKV - WS_WUQ); return true; } L -= NK;
        if (L < NQ) { u.prob = 0; u.pm = L / (NUQ / 256); u.pn = L % (NUQ / 256); u.aoff = 0; u.boff = 0; return true; } L -= NQ;
        if (L < NL) { u.prob = 1; u.pm = L / (NH * KVL / 256); u.pn = L % (NH * KVL / 256); u.aoff = (long)RSAMP0 * QL * 2; u.boff = (long)(WS_WUQL - WS_WUQ); return true; }
        return false;
    }
    __device__ __forceinline__ void a_ready(const pg8::Unit&) const {}
    __device__ __forceinline__ void done(const pg8::Unit&) const {}
};
struct EpiP3 {
    static constexpr bool PERM = true, AFTER_DRAIN = false; EpiQ eq; EpiBf16S el; EpiBf16 ek;
    __device__ __forceinline__ void operator()(const pg8::f32x4 (&acc)[2][2][4][2], const pg8::Unit& u, int wr, int wc, int fr, int fq) const {
        asm volatile("" : "+v"(fr), "+v"(fq));
        if (u.prob == 0) { EpiWrap8<EpiQ> w{eq}; w(acc, u, wr, wc, fr, fq); }
        else if (u.prob == 1) { EpiWrap8<EpiBf16S> w{el}; w(acc, u, wr, wc, fr, fq); }
        else { EpiWrap8<EpiBf16> w{ek}; w(acc, u, wr, wc, fr, fq); }
    }
};
__device__ __forceinline__ void gemm_p3(ArgsP a, LAS unsigned char* lds, int wave) {
    pg8::Gemm g{WSB(WS_CQN), WSB(WS_WUQ), RP, NUQ, QL, QL}; P3Order S{(int)gridDim.x, (int)blockIdx.x};
    EpiP3 E{EpiQ{WSB(WS_QN), WSB(WS_QPE), WSF(WS_ROPE)}, EpiBf16S{WSB(WS_QLAT), NH * KVL, QSCALE}, EpiBf16{WSB(WS_KNV), NUKV}};
    pg8::gemm_phase<EpiP3, P3Order, false, true>(lds, g, S, E, wave);
}

struct EpiMlaIn {
    static constexpr bool PERM = false, AFTER_DRAIN = true;
    bf16 *CQN, *CKVN, *KPEB; const float *qg, *kg, *ROPE; float* out;
    __device__ __forceinline__ void fused(pg8::f32x4 (&acc)[2][2][4][2], const pg8::Unit& u, int wr, int wc, int fr, int fq, PG8_LAS unsigned char* lds, int wid, int lane) const {
        asm volatile("" : "+v"(fr), "+v"(fq));
        if (u.pn < 2) {
            PG8_LAS float* P = (PG8_LAS float*)lds;
            float s[2][4];
#pragma unroll
            for (int ai = 0; ai < 2; ++ai)
#pragma unroll
                for (int m = 0; m < 4; ++m) { float t = 0.f;
#pragma unroll
                    for (int bj = 0; bj < 2; ++bj)
#pragma unroll
                        for (int n = 0; n < 2; ++n) { const pg8::f32x4 x = acc[ai][bj][m][n]; t += (x[0] * x[0] + x[1] * x[1]) + (x[2] * x[2] + x[3] * x[3]); }
                    t += __shfl_xor(t, 16); t += __shfl_xor(t, 32);
                    if (fq == 0) P[(ai * 128 + wr * 64 + m * 16 + fr) * 4 + wc] = t; }
            asm volatile("s_waitcnt lgkmcnt(0)\n\ts_barrier" ::: "memory");
#pragma unroll
            for (int ai = 0; ai < 2; ++ai)
#pragma unroll
                for (int m = 0; m < 4; ++m) { const pg8::f32x4 p4 = *(const PG8_LAS pg8::f32x4*)(P + (ai * 128 + wr * 64 + m * 16 + fr) * 4); s[ai][m] = 1.0f / sqrtf(((p4[0] + p4[1]) + (p4[2] + p4[3])) * (1.f / 256) + EPS); }
            const float* g = u.pn == 0 ? qg : kg; bf16* dst = u.pn == 0 ? CQN : CKVN;
#pragma unroll
            for (int bj = 0; bj < 2; ++bj)
#pragma unroll
                for (int n = 0; n < 2; ++n) { const int col = bj * 128 + wc * 32 + n * 16 + 4 * fq; const pg8::f32x4 gv = *(const pg8::f32x4*)(g + col);
#pragma unroll
                    for (int ai = 0; ai < 2; ++ai)
#pragma unroll
                        for (int m = 0; m < 4; ++m) { const int row = u.pm * 256 + ai * 128 + wr * 64 + m * 16 + fr; if (row >= R) continue;
                            const pg8::f32x4 y = acc[ai][bj][m][n] * s[ai][m] * gv;
                            u32x2 o; o.x = pk2(y[0], y[1]); o.y = pk2(y[2], y[3]); *(u32x2*)(dst + (size_t)row * 256 + col) = o;
                            if (u.pn == 1) { const int pos = row_pos(row); float* oc = row < RSAMP0 ? out + O_CKVP + ((size_t)(row < RMAIN ? (row >> 12) : ((row - RMAIN) >> 4)) * TP + pos) * 256 : out + O_CKVS + (size_t)(row - RSAMP0) * 256;
                                *(pg8::f32x4*)(oc + col) = y; } } }
        } else if (wc == 0) {
#pragma unroll
            for (int ai = 0; ai < 2; ++ai)
#pragma unroll
                for (int m = 0; m < 4; ++m) { const int row = u.pm * 256 + ai * 128 + wr * 64 + m * 16 + fr; if (row >= R) continue;
                    const int pos = row_pos(row); const float* rt = ROPE + (size_t)row * 32 + 4 * fq; const pg8::f32x4 cs = *(const pg8::f32x4*)rt, sn = *(const pg8::f32x4*)(rt + 16);
                    const pg8::f32x4 x1 = acc[ai][0][m][0], x2 = acc[ai][0][m][1]; const pg8::f32x4 o1 = x1 * cs - x2 * sn, o2 = x1 * sn + x2 * cs;
                    float* ok = row < RSAMP0 ? out + O_KPEP + ((size_t)(row < RMAIN ? (row >> 12) : ((row - RMAIN) >> 4)) * TP + pos) * 32 : out + O_KPES + (size_t)(row - RSAMP0) * 32;
                    *(pg8::f32x4*)(ok + 4 * fq) = o1; *(pg8::f32x4*)(ok + 16 + 4 * fq) = o2;
                    u32x2 w; w.x = pk2(o1[0], o1[1]); w.y = pk2(o1[2], o1[3]); *(u32x2*)(KPEB + (size_t)row * 32 + 4 * fq) = w; w.x = pk2(o2[0], o2[1]); w.y = pk2(o2[2], o2[3]); *(u32x2*)(KPEB + (size_t)row * 32 + 16 + 4 * fq) = w; }
        }
    }
};
__device__ __forceinline__ void gemm_p1(ArgsP a, LAS unsigned char* lds, int wave) {
    pg8::Gemm g{WSB(WS_H), WSB(WS_WIN0), RP, NIN0, D, D}; pg8::StaticOrder S; S.init(RP, NIN0, (int)gridDim.x, (int)blockIdx.x);
    EpiMlaIn E{WSB(WS_CQN), WSB(WS_CKVN), WSB(WS_KPE), IN_F(12), IN_F(14), WSF(WS_ROPE), a->out};
    pg8::gemm_phase<EpiMlaIn, pg8::StaticOrder, false, true>(lds, g, S, E, wave);
}
#ifndef USE_NAIVE_ATTN
#define USE_NAIVE_ATTN 0
#endif
#ifndef USE_NAIVE_DECODE
#define USE_NAIVE_DECODE 0
#endif
#ifndef USE_NAIVE_GLA
#define USE_NAIVE_GLA 0
#endif
#ifndef PROBE
#define PROBE 0
#endif
#ifndef PROBE_LO
#define PROBE_LO -1
#define PROBE_HI -1
#endif
#ifndef USE_NAIVE_GEMM
#define USE_NAIVE_GEMM 0
#endif
#if USE_NAIVE_GEMM
#define GEMM(A, Bt, M, N, K, E) gemm_naive(A, Bt, M, N, K, E, lds, fresh_tid(c.wave))
#else
#define GEMM(A, Bt, M, N, K, E) gemm_mfma(A, Bt, M, N, K, E, lds, c.wave)
#endif


namespace att {
typedef short bf16x8 __attribute__((ext_vector_type(8)));
typedef short s16x4 __attribute__((ext_vector_type(4)));
typedef float f32x16 __attribute__((ext_vector_type(16)));
constexpr int KSLOT = 12288, VSLOT = 8192, LDS_K = 0, LDS_V = 2 * KSLOT, LDS_WS = LDS_V + 2 * VSLOT, LDS_OST = LDS_WS + 8 * 256, LDS_TOTAL = LDS_OST + 8 * 4096;
__device__ __forceinline__ int crow(int r, int hi) { return (r & 3) + 8 * (r >> 2) + 4 * hi; }
typedef float f32x2_t __attribute__((ext_vector_type(2))); typedef __bf16 bf16x2_t __attribute__((ext_vector_type(2)));
__device__ __forceinline__ unsigned cvtpk(float lo, float hi) { f32x2_t v = {lo, hi}; bf16x2_t b = __builtin_convertvector(v, bf16x2_t); return __builtin_bit_cast(unsigned, b); }
__device__ __forceinline__ s16x4 vtr(const LAS unsigned char* p) { typedef short v4i16_t __attribute__((ext_vector_type(4))); return __builtin_bit_cast(s16x4, __builtin_amdgcn_ds_read_tr16_b64_v4i16((LAS v4i16_t*)p)); }
__device__ __forceinline__ float pmax32(float m) { auto rr = __builtin_amdgcn_permlane32_swap(__float_as_uint(m), __float_as_uint(m), false, false); return fmaxf(__uint_as_float(rr[0]), __uint_as_float(rr[1])); }
__device__ __forceinline__ float psum32(float m) { auto rr = __builtin_amdgcn_permlane32_swap(__float_as_uint(m), __float_as_uint(m), false, false); return __uint_as_float(rr[0]) + __uint_as_float(rr[1]); }
#define ATT_WAIT_BAR() asm volatile("s_waitcnt vmcnt(0) lgkmcnt(0)\n\ts_barrier" ::: "memory")
__device__ __forceinline__ void glds16(const void* gsrc, unsigned lds_dst) { unsigned keep;
    asm volatile("s_mov_b32 %0, m0\n\ts_mov_b32 m0, %2\n\ts_nop 0\n\tglobal_load_lds_dwordx4 %1, off\n\ts_mov_b32 m0, %0" : "=&s"(keep) : "v"(gsrc), "s"(lds_dst) : "memory"); }

__device__ __forceinline__ void attn_unit(int b, int h, int qb, const bf16* QN, const bf16* QPE, const bf16* KNV, const bf16* KPE, bf16* O, LAS unsigned char* lds, int wave_id) {
    const int tid = fresh_tid(wave_id), lane = tid & 63, r32 = lane & 31, hi = lane >> 5; const int wid = wave_id;
    const int rowbase = b * SEQ, q0 = qb * 256, qrow = rowbase + q0 + wid * 32 + r32, qrel = q0 + wid * 32 + r32;
    bf16x8 qr[6];
#pragma unroll
    for (int d0 = 0; d0 < 4; ++d0) qr[d0] = *(const bf16x8*)(QN + (size_t)qrow * 1024 + h * 64 + d0 * 16 + hi * 8);
#pragma unroll
    for (int d0 = 0; d0 < 2; ++d0) qr[4 + d0] = *(const bf16x8*)(QPE + (size_t)qrow * 512 + h * 32 + d0 * 16 + hi * 8);
    LAS float* wsf = (LAS float*)(lds + LDS_WS) + wid * 64;
    const int NT = 4 * qb + 4;
#define ATT_DMA(t, slot) do { const size_t row0_ = (t) == 0 ? (size_t)(RMAIN + 16 * b) : (size_t)(rowbase + 64 * ((t) - 1)); \
        __builtin_amdgcn_global_load_lds((const unsigned*)(KNV + (row0_ + lane) * 2048 + h * 64 + wid * 8), (LAS unsigned*)(lds + LDS_K + (slot) * KSLOT + wid * 1024), 16, 0, 0); \
        if (wid < 4) __builtin_amdgcn_global_load_lds((const unsigned*)(KPE + (row0_ + lane) * 32 + wid * 8), (LAS unsigned*)(lds + LDS_K + (slot) * KSLOT + (8 + wid) * 1024), 16, 0, 0); \
        __builtin_amdgcn_global_load_lds((const unsigned*)(KNV + (row0_ + 16 * (wid & 3) + (lane >> 2)) * 2048 + 1024 + h * 64 + (wid >> 2) * 32 + (lane & 3) * 8), (LAS unsigned*)(lds + LDS_V + (slot) * VSLOT + wid * 1024), 16, 0, 0); } while (0)
    f32x16 o[2]; o[0] = f32x16{}; o[1] = f32x16{};
    float mref = -INFINITY, l = 0.f;
    ATT_DMA(0, 0);
    for (int t = 0; t <= NT; ++t) {
        ATT_WAIT_BAR();
        const int slot = t & 1;
        if (t < NT) ATT_DMA(t + 1, slot ^ 1);
        const int kt0 = 64 * (t - 1);
        if (t > 0 && kt0 > q0 + wid * 32 + 31) continue;
        f32x16 p0 = f32x16{}, p1 = f32x16{};
        const LAS unsigned char* kb = lds + LDS_K + slot * KSLOT + hi * 1024 + r32 * 16;
#pragma unroll
        for (int d0 = 0; d0 < 6; ++d0) {
            const bf16x8 b0 = *(const LAS bf16x8*)(kb + d0 * 2048), b1 = *(const LAS bf16x8*)(kb + d0 * 2048 + 512);
            p0 = __builtin_amdgcn_mfma_f32_32x32x16_bf16(b0, qr[d0], p0, 0, 0, 0);
            p1 = __builtin_amdgcn_mfma_f32_32x32x16_bf16(b1, qr[d0], p1, 0, 0, 0);
        }
        if (t == 0) {
#pragma unroll
            for (int r = 0; r < 16; ++r) { if (crow(r, hi) >= NMETA) p0[r] = -INFINITY; p1[r] = -INFINITY; }
        } else if (kt0 + 63 > q0 + wid * 32) {
#pragma unroll
            for (int r = 0; r < 16; ++r) { const int kv = kt0 + crow(r, hi); if (kv > qrel) p0[r] = -INFINITY; if (kv + 32 > qrel) p1[r] = -INFINITY; }
        }
        float rm = fmaxf(p0[0], p1[0]);
#pragma unroll
        for (int r = 1; r < 16; ++r) rm = fmaxf(rm, fmaxf(p0[r], p1[r]));
        rm = pmax32(rm);
        if (__any(rm > mref + 8.0f)) {
            const float mnew = fmaxf(mref, rm); const float f = __builtin_amdgcn_exp2f(mref - mnew);
            mref = mnew; l *= f;
            if (hi == 0) wsf[r32] = f;
            LDS_WAIT();
#pragma unroll
            for (int r = 0; r < 16; ++r) { const float fr = wsf[crow(r, hi)]; o[0][r] *= fr; o[1][r] *= fr; }
        }
        float sacc = 0.f;
#pragma unroll
        for (int r = 0; r < 16; ++r) { p0[r] = __builtin_amdgcn_exp2f(p0[r] - mref); p1[r] = __builtin_amdgcn_exp2f(p1[r] - mref); sacc += p0[r] + p1[r]; }
        l += sacc;
        u32x4 pw[4];
#pragma unroll
        for (int i = 0; i < 4; ++i) { pw[0][i] = cvtpk(p0[2 * i], p0[2 * i + 1]); pw[1][i] = cvtpk(p0[8 + 2 * i], p0[8 + 2 * i + 1]); pw[2][i] = cvtpk(p1[2 * i], p1[2 * i + 1]); pw[3][i] = cvtpk(p1[8 + 2 * i], p1[8 + 2 * i + 1]); }
        const LAS unsigned char* vb = lds + LDS_V + slot * VSLOT + ((lane >> 4) & 1) * 32 + (lane & 3) * 8 + (4 * hi + ((lane & 15) >> 2)) * 64;
#pragma unroll
        for (int d0 = 0; d0 < 2; ++d0)
#pragma unroll
            for (int ks = 0; ks < 4; ++ks) {
                const s16x4 vlo = vtr(vb + d0 * 4096 + ks * 1024), vhi = vtr(vb + d0 * 4096 + ks * 1024 + 512);
                const bf16x8 vf = (bf16x8){vlo[0], vlo[1], vlo[2], vlo[3], vhi[0], vhi[1], vhi[2], vhi[3]};
                o[d0] = __builtin_amdgcn_mfma_f32_32x32x16_bf16(__builtin_bit_cast(bf16x8, pw[ks]), vf, o[d0], 0, 0, 0);
            }
    }
    l = psum32(l);
    if (hi == 0) wsf[32 + r32] = l;
    LDS_WAIT();
    bf16* Ow = O + (size_t)(rowbase + q0 + wid * 32) * 1024 + h * 64;
    LAS bf16* stg = (LAS bf16*)(lds + LDS_OST) + wid * 2048;
#pragma unroll
    for (int r = 0; r < 16; ++r) { const int orow = crow(r, hi); const float il = 1.0f / wsf[32 + orow];
        stg[orow * 64 + r32] = (bf16)f2bf(o[0][r] * il); stg[orow * 64 + 32 + r32] = (bf16)f2bf(o[1][r] * il); }
    LDS_WAIT();
#pragma unroll
    for (int i = 0; i < 4; ++i) { const int row = i * 8 + (lane >> 3), ch = lane & 7; const u32x4 v = *(const LAS u32x4*)(stg + row * 64 + ch * 8); *(u32x4*)(Ow + (size_t)row * 1024 + ch * 8) = v; }
    ATT_WAIT_BAR();
#undef ATT_DMA
}
constexpr int P_LDS_K = 0, P_LDS_V = 3 * KSLOT, P_LDS_WS = P_LDS_V + 2 * VSLOT, P_LDS_OST = P_LDS_WS + 8 * 256, P_LDS_TOTAL = P_LDS_OST + 8 * 4096;
__device__ __forceinline__ void attn_unit2(int b, int h, int qb, const bf16* QN, const bf16* QPE, const bf16* KNV, const bf16* KPE, bf16* O, LAS unsigned char* lds, int wave_id) {
    const int tid = fresh_tid(wave_id), lane = tid & 63, r32 = lane & 31, hi = lane >> 5; const int wid = wave_id;
    const bool meta = qb < 0;
    const int rowbase = b * SEQ, q0 = meta ? 0 : qb * 256, qrow = meta ? RMAIN + 16 * b + (r32 & 15) : rowbase + q0 + wid * 32 + r32, qrel = meta ? (r32 & 15) : q0 + wid * 32 + r32;
    bf16x8 qr[6];
#pragma unroll
    for (int d0 = 0; d0 < 4; ++d0) qr[d0] = *(const bf16x8*)(QN + (size_t)qrow * 1024 + h * 64 + d0 * 16 + hi * 8);
#pragma unroll
    for (int d0 = 0; d0 < 2; ++d0) qr[4 + d0] = *(const bf16x8*)(QPE + (size_t)qrow * 512 + h * 32 + d0 * 16 + hi * 8);
    LAS float* wsf = (LAS float*)(lds + P_LDS_WS) + wid * 64;
    const unsigned lds0 = (unsigned)(size_t)lds;
    const int NT = meta ? 0 : 4 * qb + 4;
#define A2_ROW0(t) ((t) == 0 ? (size_t)(RMAIN + 16 * b) : (size_t)(rowbase + 64 * ((t) - 1)))
#define A2_DMA_K(t, ks) do { const size_t row0_ = A2_ROW0(t); \
        glds16(KNV + (row0_ + lane) * 2048 + h * 64 + wid * 8, (unsigned)__builtin_amdgcn_readfirstlane((int)(lds0 + P_LDS_K + (ks) * KSLOT + wid * 1024))); \
        if (wid < 4) glds16(KPE + (row0_ + lane) * 32 + wid * 8, (unsigned)__builtin_amdgcn_readfirstlane((int)(lds0 + P_LDS_K + (ks) * KSLOT + (8 + wid) * 1024))); } while (0)
#define A2_DMA_V(t, vs) do { const size_t row0_ = A2_ROW0(t); \
        glds16(KNV + (row0_ + 16 * (wid & 3) + (lane >> 2)) * 2048 + 1024 + h * 64 + (wid >> 2) * 32 + (lane & 3) * 8, (unsigned)__builtin_amdgcn_readfirstlane((int)(lds0 + P_LDS_V + (vs) * VSLOT + wid * 1024))); } while (0)
#define A2_QKT(P0, P1, ks) do { P0 = f32x16{}; P1 = f32x16{}; const LAS unsigned char* kb_ = lds + P_LDS_K + (ks) * KSLOT + hi * 1024 + r32 * 16; \
        _Pragma("unroll") for (int d0 = 0; d0 < 6; ++d0) { const bf16x8 b0_ = *(const LAS bf16x8*)(kb_ + d0 * 2048), b1_ = *(const LAS bf16x8*)(kb_ + d0 * 2048 + 512); \
            P0 = __builtin_amdgcn_mfma_f32_32x32x16_bf16(b0_, qr[d0], P0, 0, 0, 0); P1 = __builtin_amdgcn_mfma_f32_32x32x16_bf16(b1_, qr[d0], P1, 0, 0, 0); } } while (0)
    f32x16 o[2]; o[0] = f32x16{}; o[1] = f32x16{};
    float mref = -INFINITY, l = 0.f;
#define A2_TILE(P0, P1, t, vs) do { \
        if ((t) == 0) { const int qlim_ = meta ? (r32 & 15) : NMETA - 1; _Pragma("unroll") for (int r = 0; r < 16; ++r) { if (crow(r, hi) > qlim_) P0[r] = -INFINITY; P1[r] = -INFINITY; } } \
        else { const int kt0_ = 64 * ((t) - 1); if (kt0_ + 63 > q0 + wid * 32) { _Pragma("unroll") for (int r = 0; r < 16; ++r) { const int kv = kt0_ + crow(r, hi); if (kv > qrel) P0[r] = -INFINITY; if (kv + 32 > qrel) P1[r] = -INFINITY; } } } \
        float rm_ = fmaxf(P0[0], P1[0]); \
        _Pragma("unroll") for (int r = 1; r < 16; ++r) rm_ = fmaxf(rm_, fmaxf(P0[r], P1[r])); \
        rm_ = pmax32(rm_); \
        if (__any(rm_ > mref + 8.0f)) { const float mnew = fmaxf(mref, rm_); const float f = __builtin_amdgcn_exp2f(mref - mnew); mref = mnew; l *= f; \
            if (hi == 0) wsf[r32] = f; LDS_WAIT(); \
            _Pragma("unroll") for (int r = 0; r < 16; ++r) { const float fr = wsf[crow(r, hi)]; o[0][r] *= fr; o[1][r] *= fr; } } \
        float sacc_ = 0.f; \
        _Pragma("unroll") for (int r = 0; r < 16; ++r) { P0[r] = __builtin_amdgcn_exp2f(P0[r] - mref); P1[r] = __builtin_amdgcn_exp2f(P1[r] - mref); sacc_ += P0[r] + P1[r]; } \
        l += sacc_; \
        u32x4 pw_[4]; \
        _Pragma("unroll") for (int i = 0; i < 4; ++i) { pw_[0][i] = cvtpk(P0[2 * i], P0[2 * i + 1]); pw_[1][i] = cvtpk(P0[8 + 2 * i], P0[8 + 2 * i + 1]); pw_[2][i] = cvtpk(P1[2 * i], P1[2 * i + 1]); pw_[3][i] = cvtpk(P1[8 + 2 * i], P1[8 + 2 * i + 1]); } \
        const LAS unsigned char* vb_ = lds + P_LDS_V + (vs) * VSLOT + ((lane >> 4) & 1) * 32 + (lane & 3) * 8 + (4 * hi + ((lane & 15) >> 2)) * 64; \
        _Pragma("unroll") for (int d0 = 0; d0 < 2; ++d0) _Pragma("unroll") for (int ks = 0; ks < 4; ++ks) { \
            const s16x4 vlo = vtr(vb_ + d0 * 4096 + ks * 1024), vhi = vtr(vb_ + d0 * 4096 + ks * 1024 + 512); \
            const bf16x8 vf = (bf16x8){vlo[0], vlo[1], vlo[2], vlo[3], vhi[0], vhi[1], vhi[2], vhi[3]}; \
            o[d0] = __builtin_amdgcn_mfma_f32_32x32x16_bf16(__builtin_bit_cast(bf16x8, pw_[ks]), vf, o[d0], 0, 0, 0); } } while (0)
    f32x16 pA0, pA1, pB0, pB1;
    A2_DMA_K(0, 0); A2_DMA_V(0, 0); if (NT >= 1) A2_DMA_K(1, 1);
    ATT_WAIT_BAR();
    A2_QKT(pA0, pA1, 0);
    int kc = 0, vc = 0, t = 0;
#define A2_STEP(PC0, PC1, PN0, PN1) do { \
        if (t > 0) ATT_WAIT_BAR(); \
        const int kn_ = kc == 2 ? 0 : kc + 1, k2_ = kn_ == 2 ? 0 : kn_ + 1; \
        if (t + 2 <= NT) A2_DMA_K(t + 2, k2_); \
        if (t + 1 <= NT) { A2_DMA_V(t + 1, vc ^ 1); A2_QKT(PN0, PN1, kn_); } \
        A2_TILE(PC0, PC1, t, vc); \
        kc = kn_; vc ^= 1; ++t; } while (0)
    while (t + 1 <= NT) { A2_STEP(pA0, pA1, pB0, pB1); A2_STEP(pB0, pB1, pA0, pA1); }
    A2_STEP(pA0, pA1, pB0, pB1);
    l = psum32(l);
    if (hi == 0) wsf[32 + r32] = l;
    LDS_WAIT();
    bf16* Ow = O + (size_t)(meta ? RMAIN + 16 * b : rowbase + q0 + wid * 32) * 1024 + h * 64;
    LAS bf16* stg = (LAS bf16*)(lds + P_LDS_OST) + wid * 2048;
#pragma unroll
    for (int r = 0; r < 16; ++r) { const int orow = crow(r, hi); const float il = 1.0f / wsf[32 + orow];
        stg[orow * 64 + r32] = (bf16)f2bf(o[0][r] * il); stg[orow * 64 + 32 + r32] = (bf16)f2bf(o[1][r] * il); }
    LDS_WAIT();
#pragma unroll
    for (int i = 0; i < 4; ++i) { const int row = i * 8 + (lane >> 3), ch = lane & 7; const u32x4 v = *(const LAS u32x4*)(stg + row * 64 + ch * 8); if (!meta || (wid == 0 && row < NMETA)) *(u32x4*)(Ow + (size_t)row * 1024 + ch * 8) = v; }
    ATT_WAIT_BAR();
#undef A2_ROW0
#undef A2_DMA_K
#undef A2_DMA_V
#undef A2_QKT
#undef A2_TILE
#undef A2_STEP
}
__device__ __forceinline__ void attn_phase(const bf16* QN, const bf16* QPE, const bf16* KNV, const bf16* KPE, bf16* O, LAS unsigned char* lds, int wave_id) {
    const int G = gridDim.x, bx = blockIdx.x; const int vcu = (G % 8 == 0) ? (bx % 8) * (G / 8) + bx / 8 : bx;
    for (int v = vcu; v < NB * NH * 4; v += G) {
        const int bh = v >> 2, s0 = v & 3;
#pragma unroll 1
        for (int i = 0; i < 4; ++i) { const int qb = (i == 0) ? 15 - s0 : (i == 1) ? 11 - s0 : (i == 2) ? 4 + s0 : s0; attn_unit2(bh >> 4, bh & 15, qb, QN, QPE, KNV, KPE, O, lds, wave_id); }
        if (v < NB * NH) attn_unit2(v >> 4, v & 15, -1, QN, QPE, KNV, KPE, O, lds, wave_id);
    }
}
}


namespace dec {
using att::bf16x8; using att::s16x4; using att::f32x16; using att::crow; using att::cvtpk; using att::vtr; using att::pmax32; using att::psum32;
constexpr int KST = 592, KBUF = 64 * KST, LDS_K = 0, LDS_Q = 2 * KBUF, LDS_WS = LDS_Q + 64 * KST, LDS_TOTAL = LDS_WS + 8 * 256;
constexpr int NSTAGE = 64;
__device__ __forceinline__ void decode_unit(int db, int sp, ArgsP a, LAS unsigned char* lds, int wave_id) {
    const int tid = fresh_tid(wave_id), lane = tid & 63, r32 = lane & 31, hi = lane >> 5; const int wid = wave_id;
    const int qh = wid & 1, kh = (wid >> 1) & 1, dh = wid >> 2;
    const float* cckv = IN_F(2); const float* ckpe = IN_F(3); const int* pt = (const int*)a->in[5] + db * NPAGES + sp * 32;
    for (int i = tid; i < 64 * 36; i += 512) { const int q = i / 36, ch = i % 36, t = q >> 4, h = q & 15;
        const bf16* src = ch < 32 ? WSB(WS_QLAT) + ((size_t)(db * 4 + t) * 16 + h) * 256 + ch * 8 : WSB(WS_QPE) + (size_t)(RSAMP0 + db * 4 + t) * 512 + h * 32 + (ch - 32) * 8;
        *(LAS u32x4*)(lds + LDS_Q + q * KST + ch * 16) = *(const u32x4*)src; }
    f32x4 cv[8], kv, cw[8], kw;
#define DEC_LOAD(CV, KV, s) do { const int page_ = __builtin_amdgcn_readfirstlane(pt[(s) >> 1]); const size_t k0_ = (size_t)page_ * PAGE + ((s) & 1) * 64; \
        _Pragma("unroll") for (int j = 0; j < 8; ++j) CV[j] = __builtin_nontemporal_load((const f32x4*)(cckv + (k0_ + wid + 8 * j) * 256 + 4 * lane));     \
        KV = __builtin_nontemporal_load((const f32x4*)(ckpe + (k0_ + (tid >> 3)) * 32 + 4 * (tid & 7))); } while (0)
#define DEC_WRITE(CV, KV, buf) do { LAS unsigned char* kb_ = lds + LDS_K + (buf) * KBUF; \
        _Pragma("unroll") for (int j = 0; j < 8; ++j) { u32x2 w_; w_.x = cvtpk(CV[j].x, CV[j].y); w_.y = cvtpk(CV[j].z, CV[j].w); *(LAS u32x2*)(kb_ + (wid + 8 * j) * KST + lane * 8) = w_; } \
        { u32x2 w_; w_.x = cvtpk(KV.x, KV.y); w_.y = cvtpk(KV.z, KV.w); *(LAS u32x2*)(kb_ + (tid >> 3) * KST + 512 + (tid & 7) * 8) = w_; } } while (0)
    LAS float* wsf = (LAS float*)(lds + LDS_WS) + wid * 64;
    f32x16 o[4]; o[0] = f32x16{}; o[1] = f32x16{}; o[2] = f32x16{}; o[3] = f32x16{};
    float mref = -INFINITY, l = 0.f;
#define DEC_BAR() asm volatile("s_waitcnt lgkmcnt(0)\n\ts_barrier" ::: "memory")
    DEC_LOAD(cv, kv, 0); DEC_WRITE(cv, kv, 0); DEC_LOAD(cv, kv, 1); DEC_LOAD(cw, kw, 2);
    DEC_BAR();
#define DEC_COMPUTE(BUF) do { \
        const LAS unsigned char* kimg = lds + LDS_K + (BUF) * KBUF; \
        f32x16 p = f32x16{}; \
        { const LAS unsigned char* kb = kimg + (kh * 32 + r32) * KST + hi * 16; const LAS unsigned char* qb = lds + LDS_Q + (qh * 32 + r32) * KST + hi * 16; \
        _Pragma("unroll") \
          for (int s2 = 0; s2 < 18; ++s2) p = __builtin_amdgcn_mfma_f32_32x32x16_bf16(*(const LAS bf16x8*)(kb + s2 * 32), *(const LAS bf16x8*)(qb + s2 * 32), p, 0, 0, 0); } \
        float rm = p[0]; \
        _Pragma("unroll") \
        for (int r = 1; r < 16; ++r) rm = fmaxf(rm, p[r]); \
        rm = pmax32(rm); \
        if (__any(rm > mref + 8.0f)) { \
            const float mnew = fmaxf(mref, rm); const float f = __builtin_amdgcn_exp2f(mref - mnew); \
            mref = mnew; l *= f; \
            if (hi == 0) wsf[r32] = f; \
            LDS_WAIT(); \
        _Pragma("unroll") \
            for (int r = 0; r < 16; ++r) { const float fr = wsf[crow(r, hi)]; o[0][r] *= fr; o[1][r] *= fr; o[2][r] *= fr; o[3][r] *= fr; } \
        } \
        float sacc = 0.f; \
        _Pragma("unroll") \
        for (int r = 0; r < 16; ++r) { p[r] = __builtin_amdgcn_exp2f(p[r] - mref); sacc += p[r]; } \
        l += sacc; \
        u32x4 pw[2]; \
        _Pragma("unroll") \
        for (int i = 0; i < 4; ++i) { pw[0][i] = cvtpk(p[2 * i], p[2 * i + 1]); pw[1][i] = cvtpk(p[8 + 2 * i], p[8 + 2 * i + 1]); } \
        const LAS unsigned char* vb = kimg + (kh * 32 + 4 * hi + ((lane & 15) >> 2)) * KST + (dh * 128 + 16 * ((lane >> 4) & 1) + 4 * (lane & 3)) * 2; \
        _Pragma("unroll") \
        for (int dt = 0; dt < 4; ++dt) \
        _Pragma("unroll") \
            for (int ks = 0; ks < 2; ++ks) { \
                const s16x4 vlo = vtr(vb + (ks * 16) * KST + dt * 64), vhi = vtr(vb + (ks * 16 + 8) * KST + dt * 64); \
                const bf16x8 vf = (bf16x8){vlo[0], vlo[1], vlo[2], vlo[3], vhi[0], vhi[1], vhi[2], vhi[3]}; \
                o[dt] = __builtin_amdgcn_mfma_f32_32x32x16_bf16(__builtin_bit_cast(bf16x8, pw[ks]), vf, o[dt], 0, 0, 0); \
            } \
    } while (0)
    static_assert(NSTAGE % 2 == 0, "stage loop is unrolled by two");
    for (int s = 0; s < NSTAGE; s += 2) {
        DEC_COMPUTE(0);
        DEC_WRITE(cv, kv, 1); DEC_LOAD(cv, kv, (s + 3 < NSTAGE ? s + 3 : NSTAGE - 1));
        DEC_BAR();
        DEC_COMPUTE(1);
        DEC_WRITE(cw, kw, 0); DEC_LOAD(cw, kw, (s + 4 < NSTAGE ? s + 4 : NSTAGE - 1));
        DEC_BAR();
    }
#undef DEC_COMPUTE
#undef DEC_BAR
    const int part = (db * 2 + sp) * 2 + kh;
    float* op = WSF(WS_OPART) + (size_t)part * 64 * 256;
#pragma unroll
    for (int dt = 0; dt < 4; ++dt)
#pragma unroll
        for (int r = 0; r < 16; ++r) op[(size_t)(qh * 32 + crow(r, hi)) * 256 + dh * 128 + dt * 32 + r32] = o[dt][r];
    l = psum32(l);
    if (dh == 0 && hi == 0) { float* mp = WSF(WS_MLP) + (size_t)part * 128 + (qh * 32 + r32) * 2; mp[0] = mref; mp[1] = l; }
#undef DEC_LOAD
#undef DEC_WRITE
}
struct LaneCtx { int lane, wave; };
__device__ __forceinline__ void combine_item(ArgsP a, int db, int h, const LaneCtx c, LAS unsigned char* lds) {
    {
        f32x4 cn[4]; float en[4];
#pragma unroll
        for (int s2 = 0; s2 < 4; ++s2) { const int kr = RSAMP0 + db * 4 + s2;
            const u32x2 v = *(const u32x2*)(WSB(WS_CKVN) + (size_t)kr * 256 + 4 * c.lane); cn[s2] = (f32x4){bflo(v.x), bfhi(v.x), bflo(v.y), bfhi(v.y)};
            en[s2] = c.lane < 32 ? bf2f(WSB(WS_KPE)[(size_t)kr * 32 + c.lane]) : 0.f; }
        f32x4 res[4];
#pragma unroll
        for (int t = 0; t < 4; ++t) {
            const int i = db * 4 + t, q = t * 16 + h;
            const u32x2 qv = *(const u32x2*)(WSB(WS_QLAT) + ((size_t)i * 16 + h) * 256 + 4 * c.lane); const f32x4 ql = (f32x4){bflo(qv.x), bfhi(qv.x), bflo(qv.y), bfhi(qv.y)};
            const float qp = c.lane < 32 ? bf2f(WSB(WS_QPE)[(size_t)(RSAMP0 + i) * 512 + h * 32 + c.lane]) : 0.f;
            float mp[4], lp[4], dn[4]; float mg = -INFINITY;
#pragma unroll
            for (int p = 0; p < 4; ++p) { const float* ml = WSF(WS_MLP) + (size_t)(db * 4 + p) * 128 + q * 2; mp[p] = ml[0]; lp[p] = ml[1]; mg = fmaxf(mg, mp[p]); }
#pragma unroll
            for (int s2 = 0; s2 < 4; ++s2) {
                float d = (ql.x * cn[s2].x + ql.y * cn[s2].y) + (ql.z * cn[s2].z + ql.w * cn[s2].w) + qp * en[s2];
                d = wave_sum(d); dn[s2] = s2 <= t ? d : -INFINITY; mg = fmaxf(mg, dn[s2]);
            }
            f32x4 acc = (f32x4){0.f, 0.f, 0.f, 0.f}; float L = 0.f;
#pragma unroll
            for (int p = 0; p < 4; ++p) { const float w = exp2f(mp[p] - mg); L += w * lp[p]; acc += w * *(const f32x4*)(WSF(WS_OPART) + ((size_t)(db * 4 + p) * 64 + q) * 256 + 4 * c.lane); }
#pragma unroll
            for (int s2 = 0; s2 < 4; ++s2) { const float w = exp2f(dn[s2] - mg); L += w; acc += w * cn[s2]; }
            res[t] = acc * (1.0f / L);
            __builtin_amdgcn_sched_barrier(0);
        }
        LAS bf16* rt = (LAS bf16*)(lds + 8 * 256 + c.wave * 2048);
#pragma unroll
        for (int t = 0; t < 4; ++t) { u32x2 w; w.x = pk2(res[t].x, res[t].y); w.y = pk2(res[t].z, res[t].w); *(LAS u32x2*)(rt + t * 256 + 4 * c.lane) = w; }
        LDS_WAIT();
        const int r32 = c.lane & 31, hi = c.lane >> 5;
        att::f32x16 o0 = att::f32x16{}, o1 = att::f32x16{};
        const bf16* wb = WSB(WS_WUKV) + (size_t)(1024 + h * 64 + r32) * 256 + 8 * hi;
#pragma unroll
        for (int s = 0; s < 16; ++s) {
            att::bf16x8 af = att::bf16x8{}; if (r32 < 4) af = *(const LAS att::bf16x8*)(rt + r32 * 256 + 16 * s + 8 * hi);
            const att::bf16x8 b0 = *(const att::bf16x8*)(wb + 16 * s), b1 = *(const att::bf16x8*)(wb + 32 * 256 + 16 * s);
            o0 = __builtin_amdgcn_mfma_f32_32x32x16_bf16(af, b0, o0, 0, 0, 0); o1 = __builtin_amdgcn_mfma_f32_32x32x16_bf16(af, b1, o1, 0, 0, 0);
        }
        if (hi == 0) {
#pragma unroll
            for (int t = 0; t < 4; ++t) { bf16* op = WSB(WS_O) + (size_t)(RSAMP0 + db * 4 + t) * 1024 + h * 64 + r32; op[0] = (bf16)f2bf(o0[t]); op[32] = (bf16)f2bf(o1[t]); }
        }
        LDS_WAIT();
    }
}
__device__ __forceinline__ void combine_phase(ArgsP a, const Ctx& c0, LAS unsigned char* lds) {
    const Ctx c = refresh(c0);
    for (int it = c.gw; it < DB * NH; it += c.ngw) combine_item(a, it >> 4, it & 15, LaneCtx{c.lane, c.wave}, lds);
}
__device__ __forceinline__ void decode_phase(ArgsP a, LAS unsigned char* lds, int wave_id) {
    for (int u = blockIdx.x; u < DB * 2; u += gridDim.x) { decode_unit(u >> 1, u & 1, a, lds, wave_id); __syncthreads(); }
}
}

__device__ __forceinline__ void p_side_tables(ArgsP a, const Ctx& c0, LAS unsigned char* lds, int wg0) {
    const Ctx c = refresh(c0);
    const int nwg = (int)gridDim.x - wg0, bx = (int)blockIdx.x - wg0;
    if (bx < 0) return;
    const int gt = (bx * 8 + c.wave) * 64 + c.lane, ngt = nwg * 512;
    {
        const int r32 = c.lane & 31, hi = c.lane >> 5;
        for (int it = bx * 8 + c.wave; it < NH * 64; it += nwg * 8) {
            const int h = it >> 6, ct = (it >> 3) & 7, kt = it & 7;
            const float* ap = IN_F(15) + (size_t)(ct * 32 + r32) * 1024 + h * 64 + 8 * hi;
            const float* bp = IN_F(13) + (size_t)(kt * 32 + r32) * 1536 + h * 96 + 8 * hi;
            att::f32x16 acc = att::f32x16{};
#pragma unroll
            for (int s = 0; s < 4; ++s) {
                const f32x4 a0 = *(const f32x4*)(ap + 16 * s), a1 = *(const f32x4*)(ap + 16 * s + 4), b0 = *(const f32x4*)(bp + 16 * s), b1 = *(const f32x4*)(bp + 16 * s + 4);
                const u32x4 aw = (u32x4){pk2(a0.x, a0.y), pk2(a0.z, a0.w), pk2(a1.x, a1.y), pk2(a1.z, a1.w)}, bw = (u32x4){pk2(b0.x, b0.y), pk2(b0.z, b0.w), pk2(b1.x, b1.y), pk2(b1.z, b1.w)};
                acc = __builtin_amdgcn_mfma_f32_32x32x16_bf16(__builtin_bit_cast(att::bf16x8, aw), __builtin_bit_cast(att::bf16x8, bw), acc, 0, 0, 0);
            }
            bf16* op = WSB(WS_WUQL) + (size_t)(h * 256 + ct * 32) * 256 + kt * 32 + r32;
#pragma unroll
            for (int r = 0; r < 16; ++r) op[(size_t)att::crow(r, hi) * 256] = (bf16)f2bf(acc[r]);
        }
    }
}
__device__ __forceinline__ void p_mla_mid(ArgsP a, const Ctx& c0) {
    const Ctx c = refresh(c0);
    const float* A1 = WSF(WS_A1); bf16* CQN = WSB(WS_CQN); bf16* CKVN = WSB(WS_CKVN); bf16* KPEB = WSB(WS_KPE); const float* ROPE = WSF(WS_ROPE); float* out = a->out;
    const f32x4 gq = *(const f32x4*)(IN_F(12) + 4 * c.lane), gk = *(const f32x4*)(IN_F(14) + 4 * c.lane);
    constexpr int NR = 4;
    for (int r0 = c.gw; r0 < R; r0 += NR * c.ngw) {
        f32x4 cq[NR], ck[NR]; float sq[NR], sk[NR], x1[NR], x2[NR], cs[NR], sn[NR];
#pragma unroll
        for (int q = 0; q < NR; ++q) { const int r = r0 + q * c.ngw < R ? r0 + q * c.ngw : r0; const float* row = A1 + (size_t)r * NIN0;
            cq[q] = *(const f32x4*)(row + 4 * c.lane); ck[q] = *(const f32x4*)(row + 256 + 4 * c.lane);
            const int j = c.lane & 15; x1[q] = row[512 + j]; x2[q] = row[528 + j]; cs[q] = ROPE[(size_t)r * 32 + j]; sn[q] = ROPE[(size_t)r * 32 + 16 + j];
            sq[q] = (cq[q].x * cq[q].x + cq[q].y * cq[q].y) + (cq[q].z * cq[q].z + cq[q].w * cq[q].w); sk[q] = (ck[q].x * ck[q].x + ck[q].y * ck[q].y) + (ck[q].z * ck[q].z + ck[q].w * ck[q].w); }
#pragma unroll
        for (int sh = 1; sh < 64; sh <<= 1) {
#pragma unroll
            for (int q = 0; q < NR; ++q) { sq[q] += __shfl_xor(sq[q], sh); sk[q] += __shfl_xor(sk[q], sh); } }
#pragma unroll
        for (int q = 0; q < NR; ++q) { const int r = r0 + q * c.ngw < R ? r0 + q * c.ngw : r0; const int pos = row_pos(r);
            const float rq = 1.0f / sqrtf(sq[q] * (1.f / 256) + EPS), rk = 1.0f / sqrtf(sk[q] * (1.f / 256) + EPS);
            const f32x4 qn = cq[q] * rq * gq, kn = ck[q] * rk * gk;
            u32x2 o; o.x = pk2(qn.x, qn.y); o.y = pk2(qn.z, qn.w); *(u32x2*)(CQN + (size_t)r * 256 + 4 * c.lane) = o;
            o.x = pk2(kn.x, kn.y); o.y = pk2(kn.z, kn.w); *(u32x2*)(CKVN + (size_t)r * 256 + 4 * c.lane) = o;
            float* ockv; float* okpe;
            if (r < RSAMP0) { const int b = r < RMAIN ? (r >> 12) : ((r - RMAIN) >> 4); ockv = out + O_CKVP + ((size_t)b * TP + pos) * 256; okpe = out + O_KPEP + ((size_t)b * TP + pos) * 32; }
            else { ockv = out + O_CKVS + (size_t)(r - RSAMP0) * 256; okpe = out + O_KPES + (size_t)(r - RSAMP0) * 32; }
            *(f32x4*)(ockv + 4 * c.lane) = kn;
            if (c.lane < 16) { const int j = c.lane; const float o1 = x1[q] * cs[q] - x2[q] * sn[q], o2 = x1[q] * sn[q] + x2[q] * cs[q]; okpe[j] = o1; okpe[16 + j] = o2;
                KPEB[(size_t)r * 32 + j] = (bf16)f2bf(o1); KPEB[(size_t)r * 32 + 16 + j] = (bf16)f2bf(o2); } }
    }
}
__device__ __forceinline__ void p_q_post(ArgsP a, const Ctx& c0) {
    const Ctx c = refresh(c0);
    for (int r = c.gw; r < R; r += c.ngw) {
        const float* row = WSF(WS_QRAW) + (size_t)r * NUQ; const int pos = row_pos(r);
        const float qs = QSCALE;
#pragma unroll
        for (int j = 0; j < 4; ++j) { const f32x4 v = *(const f32x4*)(row + 4 * c.lane + 256 * j) * qs; u32x2 o; o.x = pk2(v.x, v.y); o.y = pk2(v.z, v.w); *(u32x2*)(WSB(WS_QN) + (size_t)r * 1024 + 4 * c.lane + 256 * j) = o; }
#pragma unroll
        for (int j = 0; j < 4; ++j) { const int p = c.lane + 64 * j, h = p >> 4, jj = p & 15; const float x1 = row[1024 + 2 * p], x2 = row[1024 + 2 * p + 1]; float cs, sn; rope_cs(pos, jj, cs, sn);
            WSB(WS_QPE)[(size_t)r * 512 + h * 32 + jj] = (bf16)f2bf((x1 * cs - x2 * sn) * qs); WSB(WS_QPE)[(size_t)r * 512 + h * 32 + 16 + jj] = (bf16)f2bf((x1 * sn + x2 * cs) * qs); }
    }
}
__device__ __forceinline__ void p_qlat(ArgsP a, const Ctx& c0) {
    const Ctx c = refresh(c0);
    const float* wuk = IN_F(15);
    for (int it = c.gw; it < DB * DS * NH; it += c.ngw) {
        const int i = it >> 4, h = it & 15;
        const float q = WSF(WS_QRAW)[(size_t)(RSAMP0 + i) * NUQ + h * 64 + c.lane];
        float acc[4] = {0.f, 0.f, 0.f, 0.f};
#pragma unroll 8
        for (int n = 0; n < 64; ++n) { const float qn = __shfl(q, n);
#pragma unroll
            for (int k = 0; k < 4; ++k) acc[k] += qn * wuk[(size_t)(c.lane + 64 * k) * 1024 + h * 64 + n]; }
#pragma unroll
        for (int k = 0; k < 4; ++k) WSB(WS_QLAT)[((size_t)i * 16 + h) * 256 + c.lane + 64 * k] = (bf16)f2bf(acc[k] * QSCALE);
    }
}
template <bool META_ONLY>
__device__ __forceinline__ void p_attn_prompt_naive(ArgsP a, const Ctx& c0) {
    const Ctx c = refresh(c0);
    const bf16* QN = WSB(WS_QN); const bf16* QPE = WSB(WS_QPE); const bf16* KNV = WSB(WS_KNV); const bf16* KPE = WSB(WS_KPE);
    for (int item = c.gw + (META_ONLY ? (RMAIN / 64) * NH : 0); item < (RPROMPT / 64) * NH; item += c.ngw) {
        const int rb = item >> 4, h = item & 15, r = rb * 64 + c.lane;
        int b, nk;
        if (r < RMAIN) { b = r >> 12; nk = NMETA + (r & 4095) + 1; } else { const int i = r - RMAIN; b = i >> 4; nk = (i & 15) + 1; }
        const int mbase = RMAIN + 16 * b, tbase = 4096 * b;
        float qn[64], qp[32], o[64];
#pragma unroll
        for (int j = 0; j < 8; ++j) { const u32x4 v = *(const u32x4*)(QN + (size_t)r * 1024 + h * 64 + 8 * j);
            qn[8 * j] = bflo(v.x); qn[8 * j + 1] = bfhi(v.x); qn[8 * j + 2] = bflo(v.y); qn[8 * j + 3] = bfhi(v.y); qn[8 * j + 4] = bflo(v.z); qn[8 * j + 5] = bfhi(v.z); qn[8 * j + 6] = bflo(v.w); qn[8 * j + 7] = bfhi(v.w); }
#pragma unroll
        for (int j = 0; j < 4; ++j) { const u32x4 v = *(const u32x4*)(QPE + (size_t)r * 512 + h * 32 + 8 * j);
            qp[8 * j] = bflo(v.x); qp[8 * j + 1] = bfhi(v.x); qp[8 * j + 2] = bflo(v.y); qp[8 * j + 3] = bfhi(v.y); qp[8 * j + 4] = bflo(v.z); qp[8 * j + 5] = bfhi(v.z); qp[8 * j + 6] = bflo(v.w); qp[8 * j + 7] = bfhi(v.w); }
#pragma unroll
        for (int j = 0; j < 64; ++j) o[j] = 0.f;
        float m = -INFINITY, l = 0.f;
        const int nkmax = wave_max_i(nk);
        for (int kk = 0; kk < nkmax; ++kk) {
            if (kk < nk) {
                const int kr = kk < NMETA ? mbase + kk : tbase + kk - NMETA;
                const bf16* kn = KNV + (size_t)kr * 2048 + h * 64; const bf16* kp = KPE + (size_t)kr * 32; const bf16* vv = kn + 1024;
                float s = 0.f;
#pragma unroll
                for (int j = 0; j < 8; ++j) { const u32x4 v = *(const u32x4*)(kn + 8 * j);
                    s += qn[8 * j] * bflo(v.x) + qn[8 * j + 1] * bfhi(v.x) + qn[8 * j + 2] * bflo(v.y) + qn[8 * j + 3] * bfhi(v.y) + qn[8 * j + 4] * bflo(v.z) + qn[8 * j + 5] * bfhi(v.z) + qn[8 * j + 6] * bflo(v.w) + qn[8 * j + 7] * bfhi(v.w); }
#pragma unroll
                for (int j = 0; j < 4; ++j) { const u32x4 v = *(const u32x4*)(kp + 8 * j);
                    s += qp[8 * j] * bflo(v.x) + qp[8 * j + 1] * bfhi(v.x) + qp[8 * j + 2] * bflo(v.y) + qp[8 * j + 3] * bfhi(v.y) + qp[8 * j + 4] * bflo(v.z) + qp[8 * j + 5] * bfhi(v.z) + qp[8 * j + 6] * bflo(v.w) + qp[8 * j + 7] * bfhi(v.w); }
                const float mn = fmaxf(m, s), corr = exp2f(m - mn), p = exp2f(s - mn);
                l = l * corr + p; m = mn;
#pragma unroll
                for (int j = 0; j < 8; ++j) { const u32x4 v = *(const u32x4*)(vv + 8 * j);
                    o[8 * j] = o[8 * j] * corr + p * bflo(v.x); o[8 * j + 1] = o[8 * j + 1] * corr + p * bfhi(v.x); o[8 * j + 2] = o[8 * j + 2] * corr + p * bflo(v.y); o[8 * j + 3] = o[8 * j + 3] * corr + p * bfhi(v.y);
                    o[8 * j + 4] = o[8 * j + 4] * corr + p * bflo(v.z); o[8 * j + 5] = o[8 * j + 5] * corr + p * bfhi(v.z); o[8 * j + 6] = o[8 * j + 6] * corr + p * bflo(v.w); o[8 * j + 7] = o[8 * j + 7] * corr + p * bfhi(v.w); }
            }
        }
        const float il = 1.0f / l;
#pragma unroll
        for (int j = 0; j < 8; ++j) { u32x4 w; w.x = pk2(o[8 * j] * il, o[8 * j + 1] * il); w.y = pk2(o[8 * j + 2] * il, o[8 * j + 3] * il); w.z = pk2(o[8 * j + 4] * il, o[8 * j + 5] * il); w.w = pk2(o[8 * j + 6] * il, o[8 * j + 7] * il);
            *(u32x4*)(WSB(WS_O) + (size_t)r * 1024 + h * 64 + 8 * j) = w; }
    }
}
__device__ __forceinline__ void p_attn_decode_naive(ArgsP a, const Ctx& c0) {
    const Ctx c = refresh(c0);
    const float* cckv = IN_F(2); const float* ckpe = IN_F(3); const int* pt = (const int*)a->in[5];
    for (int item = c.gw; item < DB * NH; item += c.ngw) {
        const int db = item >> 4, h = item & 15;
        f32x4 ql[4]; float qp[4], m[4], l[4]; f32x4 o[4];
#pragma unroll
        for (int t = 0; t < 4; ++t) { const u32x2 v = *(const u32x2*)(WSB(WS_QLAT) + ((size_t)(db * 4 + t) * 16 + h) * 256 + 4 * c.lane);
            ql[t] = (f32x4){bflo(v.x), bfhi(v.x), bflo(v.y), bfhi(v.y)};
            qp[t] = c.lane < 32 ? bf2f(WSB(WS_QPE)[(size_t)(RSAMP0 + db * 4 + t) * 512 + h * 32 + c.lane]) : 0.f;
            m[t] = -INFINITY; l[t] = 0.f; o[t] = (f32x4){0.f, 0.f, 0.f, 0.f}; }
        for (int p = 0; p < NPAGES; ++p) {
            const int page = pt[db * NPAGES + p];
            for (int k = 0; k < PAGE; ++k) {
                const size_t kr = (size_t)page * PAGE + k;
                const f32x4 cv = *(const f32x4*)(cckv + kr * 256 + 4 * c.lane); const float e = c.lane < 32 ? ckpe[kr * 32 + c.lane] : 0.f;
#pragma unroll
                for (int t = 0; t < 4; ++t) {
                    float d = (ql[t].x * cv.x + ql[t].y * cv.y) + (ql[t].z * cv.z + ql[t].w * cv.w) + qp[t] * e;
                    d = wave_sum(d);
                    const float mn = fmaxf(m[t], d), corr = exp2f(m[t] - mn), pp = exp2f(d - mn);
                    l[t] = l[t] * corr + pp; m[t] = mn; o[t] = o[t] * corr + pp * cv;
                }
            }
        }
#pragma unroll
        for (int s2 = 0; s2 < 4; ++s2) {
            const int kr = RSAMP0 + db * 4 + s2;
            const u32x2 v = *(const u32x2*)(WSB(WS_CKVN) + (size_t)kr * 256 + 4 * c.lane); const f32x4 cv = (f32x4){bflo(v.x), bfhi(v.x), bflo(v.y), bfhi(v.y)};
            const float e = c.lane < 32 ? bf2f(WSB(WS_KPE)[(size_t)kr * 32 + c.lane]) : 0.f;
#pragma unroll
            for (int t = 0; t < 4; ++t) if (t >= s2) {
                float d = (ql[t].x * cv.x + ql[t].y * cv.y) + (ql[t].z * cv.z + ql[t].w * cv.w) + qp[t] * e;
                d = wave_sum(d);
                const float mn = fmaxf(m[t], d), corr = exp2f(m[t] - mn), pp = exp2f(d - mn);
                l[t] = l[t] * corr + pp; m[t] = mn; o[t] = o[t] * corr + pp * cv;
            }
        }
#pragma unroll
        for (int t = 0; t < 4; ++t) *(f32x4*)(WSF(WS_OLAT) + ((size_t)(db * 4 + t) * 16 + h) * 256 + 4 * c.lane) = o[t] * (1.0f / l[t]);
    }
}
__device__ __forceinline__ void p_olat_up(ArgsP a, const Ctx& c0) {
    const Ctx c = refresh(c0);
    const float* wuv = IN_F(16);
    for (int it = c.gw; it < DB * DS * NH; it += c.ngw) {
        const int i = it >> 4, h = it & 15; const float* ol = WSF(WS_OLAT) + ((size_t)i * 16 + h) * 256;
        float acc = 0.f;
#pragma unroll 8
        for (int cc = 0; cc < 256; ++cc) acc += ol[cc] * wuv[(size_t)cc * 1024 + h * 64 + c.lane];
        WSB(WS_O)[(size_t)(RSAMP0 + i) * 1024 + h * 64 + c.lane] = (bf16)f2bf(acc);
    }
}
template <bool FINAL, int NSPLIT, bool FIRST = false>
__device__ __forceinline__ void p_post_res(ArgsP a, const Ctx& c0, const float* gpost, const float* gnext) {
    const Ctx c = refresh(c0);
    const bf16* Mb = WSB(WS_M); bf16* X = WSB(WS_X); bf16* H = WSB(WS_H); const float* MT = WSF(WS_MT); const float* xin = IN_F(0); float* out = a->out;
    f32x4 gp[4], gn[4];
#pragma unroll
    for (int j = 0; j < 4; ++j) { gp[j] = *(const f32x4*)(gpost + 4 * c.lane + 256 * j); gn[j] = FINAL ? gp[j] : *(const f32x4*)(gnext + 4 * c.lane + 256 * j); }
    constexpr int NR = 4;
    for (int r0 = c.gw; r0 < RMAIN; r0 += NR * c.ngw) {
        f32x4 mv[NR][4], xv[NR][4]; float s[NR], s2[NR];
#pragma unroll
        for (int q = 0; q < NR; ++q) { const int r = r0 + q * c.ngw < RMAIN ? r0 + q * c.ngw : r0;
            s[q] = 0.f;
#pragma unroll
            for (int j = 0; j < 4; ++j) { const u32x2 mb = __builtin_nontemporal_load((const u32x2*)(Mb + (size_t)r * D + 4 * c.lane + 256 * j)); mv[q][j] = (f32x4){bflo(mb.x), bfhi(mb.x), bflo(mb.y), bfhi(mb.y)};
                if (FIRST) xv[q][j] = *(const f32x4*)(xin + (size_t)r * D + 4 * c.lane + 256 * j); else { const u32x2 xb = *(const u32x2*)(X + (size_t)r * D + 4 * c.lane + 256 * j); xv[q][j] = (f32x4){bflo(xb.x), bfhi(xb.x), bflo(xb.y), bfhi(xb.y)}; }
                s[q] += (mv[q][j].x * mv[q][j].x + mv[q][j].y * mv[q][j].y) + (mv[q][j].z * mv[q][j].z + mv[q][j].w * mv[q][j].w); } }
#pragma unroll
        for (int o = 1; o < 64; o <<= 1) {
#pragma unroll
            for (int q = 0; q < NR; ++q) s[q] += __shfl_xor(s[q], o); }
#pragma unroll
        for (int q = 0; q < NR; ++q) { const float rm = 1.0f / sqrtf(s[q] * (1.f / D) + EPS); s2[q] = 0.f;
#pragma unroll
            for (int j = 0; j < 4; ++j) { xv[q][j] = xv[q][j] + mv[q][j] * rm * gp[j]; s2[q] += (xv[q][j].x * xv[q][j].x + xv[q][j].y * xv[q][j].y) + (xv[q][j].z * xv[q][j].z + xv[q][j].w * xv[q][j].w); } }
        if (!FINAL) {
#pragma unroll
            for (int o = 1; o < 64; o <<= 1) {
#pragma unroll
                for (int q = 0; q < NR; ++q) s2[q] += __shfl_xor(s2[q], o); }
        }
#pragma unroll
        for (int q = 0; q < NR; ++q) { const int r = r0 + q * c.ngw < RMAIN ? r0 + q * c.ngw : r0;
            if (FINAL) {
#pragma unroll
                for (int j = 0; j < 4; ++j) __builtin_nontemporal_store(xv[q][j], (f32x4*)(out + O_YP + (size_t)r * D + 4 * c.lane + 256 * j));
            } else { const float rx = 1.0f / sqrtf(s2[q] * (1.f / D) + EPS);
#pragma unroll
                for (int j = 0; j < 4; ++j) { u32x2 xo; xo.x = pk2(xv[q][j].x, xv[q][j].y); xo.y = pk2(xv[q][j].z, xv[q][j].w); *(u32x2*)(X + (size_t)r * D + 4 * c.lane + 256 * j) = xo;
                    u32x2 o; o.x = pk2(xv[q][j].x * rx * gn[j].x, xv[q][j].y * rx * gn[j].y); o.y = pk2(xv[q][j].z * rx * gn[j].z, xv[q][j].w * rx * gn[j].w); *(u32x2*)(H + (size_t)r * D + 4 * c.lane + 256 * j) = o; } } }
    }
    for (int r = RMAIN + c.gw; r < R; r += c.ngw) {
        bf16* xrow = X + (size_t)r * D;
        f32x4 mv[4], xv[4]; float s = 0.f;
#pragma unroll
        for (int j = 0; j < 4; ++j) { mv[j] = (f32x4){0.f, 0.f, 0.f, 0.f};
#pragma unroll
            for (int h8 = 0; h8 < NSPLIT; h8 += 8) { f32x4 part[8];
#pragma unroll
                for (int sp = 0; sp < 8; ++sp) part[sp] = *(const f32x4*)(MT + ((size_t)(h8 + sp) * (RP - RMAIN) + (r - RMAIN)) * D + 4 * c.lane + 256 * j);
#pragma unroll
                for (int sp = 0; sp < 8; ++sp) mv[j] += part[sp]; }
            { const u32x2 xb = *(const u32x2*)(xrow + 4 * c.lane + 256 * j); xv[j] = (f32x4){bflo(xb.x), bfhi(xb.x), bflo(xb.y), bfhi(xb.y)}; } s += (mv[j].x * mv[j].x + mv[j].y * mv[j].y) + (mv[j].z * mv[j].z + mv[j].w * mv[j].w); }
        const float rm = 1.0f / sqrtf(wave_sum(s) * (1.f / D) + EPS); float s2 = 0.f;
#pragma unroll
        for (int j = 0; j < 4; ++j) { xv[j] = xv[j] + mv[j] * rm * gp[j]; s2 += (xv[j].x * xv[j].x + xv[j].y * xv[j].y) + (xv[j].z * xv[j].z + xv[j].w * xv[j].w); }
        if (FINAL) {
            if (r < RSAMP0) continue;
#pragma unroll
            for (int j = 0; j < 4; ++j) *(f32x4*)(out + O_YS + (size_t)(r - RSAMP0) * D + 4 * c.lane + 256 * j) = xv[j];
        } else {
            const float rx = 1.0f / sqrtf(wave_sum(s2) * (1.f / D) + EPS);
#pragma unroll
            for (int j = 0; j < 4; ++j) { u32x2 xo; xo.x = pk2(xv[j].x, xv[j].y); xo.y = pk2(xv[j].z, xv[j].w); *(u32x2*)(xrow + 4 * c.lane + 256 * j) = xo;
                u32x2 o; o.x = pk2(xv[j].x * rx * gn[j].x, xv[j].y * rx * gn[j].y); o.y = pk2(xv[j].z * rx * gn[j].z, xv[j].w * rx * gn[j].w); *(u32x2*)(H + (size_t)r * D + 4 * c.lane + 256 * j) = o; }
        }
    }
}

__device__ __forceinline__ void p_gate(ArgsP a, const Ctx& c0) {
    const Ctx c = refresh(c0);
    const float* wg = IN_F(19); const float* bg = IN_F(20);
    const size_t gt = (size_t)c.gw * 64 + c.lane, ngt = (size_t)c.ngw * 64;
    for (size_t i = gt + (size_t)(USE_NAIVE_GLA ? 0 : RSAMP0) * 512; i < (size_t)R * 512; i += ngt) {
        const int r = (int)(i >> 9), col = (int)(i & 511); const float* gd = WSF(WS_GD) + (size_t)r * 16;
        float x = bg[col];
#pragma unroll
        for (int j = 0; j < 16; ++j) x += gd[j] * wg[j * 512 + col];
        const float ls = fminf(x, 0.f) - log1pf(__expf(-fabsf(x)));
        const float la = ls * (1.0f / 16.0f);
        WSF(WS_LA)[i] = la; WSF(WS_EA)[i] = __expf(la);
    }
}
__device__ __forceinline__ void gla_step(float (&S)[128], float& o, float a0, float a1, float k0, float k1, float q0, float q1, float v) {
    o = 0.f;
#pragma unroll
    for (int d = 0; d < 64; ++d) { const float ad = rdlane(a0, d), kd = rdlane(k0, d), qd = rdlane(q0, d); S[d] = ad * S[d] + kd * v; o += qd * S[d]; }
#pragma unroll
    for (int d = 0; d < 64; ++d) { const float ad = rdlane(a1, d), kd = rdlane(k1, d), qd = rdlane(q1, d); S[64 + d] = ad * S[64 + d] + kd * v; o += qd * S[64 + d]; }
}
__device__ __forceinline__ void p_gla_naive(ArgsP a, const Ctx& c0) {
    const Ctx c = refresh(c0);
    const float* EA = WSF(WS_EA); const bf16* KG = WSB(WS_KG); const bf16* QG = WSB(WS_QG); const bf16* VG = WSB(WS_VG); float* OGR = WSF(WS_OGRAW);
    for (int item = c.gwT; item < (USE_NAIVE_GLA ? NB * GH * 4 : 0); item += c.ngw) {
        const int b = item >> 4, h = (item >> 2) & 3, dv = (item & 3) * 64 + c.lane;
        float S[128];
#pragma unroll
        for (int d = 0; d < 128; ++d) S[d] = 0.f;
        for (int tt = 0; tt < TP; ++tt) {
            const int row = tt < NMETA ? RMAIN + 16 * b + tt : 4096 * b + tt - NMETA;
            const size_t g = (size_t)row * 512 + h * 128;
            const float a0 = EA[g + c.lane], a1 = EA[g + 64 + c.lane], k0 = bf2f(KG[g + c.lane]), k1 = bf2f(KG[g + 64 + c.lane]), q0 = bf2f(QG[g + c.lane]), q1 = bf2f(QG[g + 64 + c.lane]);
            const float v = bf2f(VG[(size_t)row * 1024 + h * 256 + dv]);
            float o; gla_step(S, o, a0, a1, k0, k1, q0, q1, v);
            OGR[(size_t)row * 1024 + h * 256 + dv] = o;
        }
        float* outp = a->out + O_GLAP + ((size_t)(b * 4 + h) * 128) * 256 + dv;
#pragma unroll
        for (int d = 0; d < 128; ++d) outp[(size_t)d * 256] = S[d];
    }
    const int wg0 = USE_NAIVE_GLA ? 0 : NB * GH * gla::NSP; if ((int)blockIdx.x < wg0) return;
    for (int item = c.wave * ((int)gridDim.x - wg0) + ((int)blockIdx.x - wg0); item < DB * GH * 4; item += c.ngw - wg0 * 8) {
        const int db = item >> 4, h = (item >> 2) & 3, dv = (item & 3) * 64 + c.lane;
        const float* sp = IN_F(4) + ((size_t)(db * 4 + h) * 128) * 256 + dv;
        float S[128];
#pragma unroll
        for (int d = 0; d < 128; ++d) S[d] = sp[(size_t)d * 256];
#pragma unroll 1
        for (int s = 0; s < DS; ++s) {
            const int row = RSAMP0 + db * 4 + s; const size_t g = (size_t)row * 512 + h * 128;
            const float a0 = EA[g + c.lane], a1 = EA[g + 64 + c.lane], k0 = bf2f(KG[g + c.lane]), k1 = bf2f(KG[g + 64 + c.lane]), q0 = bf2f(QG[g + c.lane]), q1 = bf2f(QG[g + 64 + c.lane]);
            const float v = bf2f(VG[(size_t)row * 1024 + h * 256 + dv]);
            float o; gla_step(S, o, a0, a1, k0, k1, q0, q1, v);
            OGR[(size_t)row * 1024 + h * 256 + dv] = o;
        }
        float* outp = a->out + O_GLAS + ((size_t)(db * 4 + h) * 128) * 256 + dv;
#pragma unroll
        for (int d = 0; d < 128; ++d) outp[(size_t)d * 256] = S[d];
    }
}
__device__ __forceinline__ void p_gla_post(ArgsP a, const Ctx& c0) {
    const Ctx c = refresh(c0);
    const bf16* OGR = WSB(WS_OGRAW); const bf16* RG = WSB(WS_RG); bf16* OG = WSB(WS_OG);
    const f32x4 g = *(const f32x4*)(IN_F(21) + 4 * c.lane);
    constexpr int NR = 2;
    for (int r0 = c.gw; r0 < R; r0 += NR * c.ngw) {
        f32x4 o[NR][4]; u32x2 rv[NR][4]; float s[NR][4];
#pragma unroll
        for (int q = 0; q < NR; ++q) { const int r = r0 + q * c.ngw < R ? r0 + q * c.ngw : r0;
#pragma unroll
            for (int h = 0; h < 4; ++h) { const size_t off = (size_t)r * 1024 + h * 256 + 4 * c.lane;
                const u32x2 ob = __builtin_nontemporal_load((const u32x2*)(OGR + ((size_t)(h * 8 + (c.lane >> 3)) * RP + r) * 32 + 4 * (c.lane & 7))); o[q][h] = (f32x4){bflo(ob.x), bfhi(ob.x), bflo(ob.y), bfhi(ob.y)}; rv[q][h] = __builtin_nontemporal_load((const u32x2*)(RG + off));
                s[q][h] = (o[q][h].x * o[q][h].x + o[q][h].y * o[q][h].y) + (o[q][h].z * o[q][h].z + o[q][h].w * o[q][h].w); } }
#pragma unroll
        for (int sh = 1; sh < 64; sh <<= 1) {
#pragma unroll
            for (int q = 0; q < NR; ++q)
#pragma unroll
                for (int h = 0; h < 4; ++h) s[q][h] += __shfl_xor(s[q][h], sh); }
#pragma unroll
        for (int q = 0; q < NR; ++q) { const int r = r0 + q * c.ngw < R ? r0 + q * c.ngw : r0;
#pragma unroll
            for (int h = 0; h < 4; ++h) { const size_t off = (size_t)r * 1024 + h * 256 + 4 * c.lane;
                const float rs = 1.0f / sqrtf(s[q][h] * (1.f / 256) + EPS);
                const f32x4 rr = (f32x4){bflo(rv[q][h].x), bfhi(rv[q][h].x), bflo(rv[q][h].y), bfhi(rv[q][h].y)};
                f32x4 sl; sl.x = rr.x / (1.f + __expf(-rr.x)); sl.y = rr.y / (1.f + __expf(-rr.y)); sl.z = rr.z / (1.f + __expf(-rr.z)); sl.w = rr.w / (1.f + __expf(-rr.w));
                const f32x4 y = o[q][h] * rs * g * sl;
                u32x2 w; w.x = pk2(y.x, y.y); w.y = pk2(y.z, y.w); *(u32x2*)(OG + off) = w; } }
    }
}


namespace gla {
using att::bf16x8; using att::f32x16; using att::crow; using att::cvtpk;
constexpr int NCH = 65, NITEM = NB * GH * NCH;
constexpr int P_GD = 0, P_GSUM = 4096, P_QL = 6144, P_KL = P_QL + 64 * 272, P_VS = P_KL + 64 * 272, P_AL = P_VS + 64 * 528, P_END = P_AL + 64 * 144;
__device__ __forceinline__ int chunk_row(int b, int c, int tok) { return c == 0 ? RMAIN + 16 * b + tok : 4096 * b + 64 * (c - 1) + tok; }
__device__ __forceinline__ float logsig16(float x) { return (fminf(x, 0.f) - __logf(1.0f + __expf(-fabsf(x)))) * (1.0f / 16.0f); }
__device__ __forceinline__ void prep_item(ArgsP a, int item, LAS unsigned char* lds, int wave_id) {
    const int tid = fresh_tid(wave_id), lane = tid & 63, r32 = lane & 31, hi = lane >> 5; const int wid = wave_id;
    const int bh = item / NCH, c = item % NCH, b = bh >> 2, h = bh & 3;
    const int nvalid = c == 0 ? NMETA : 64;
    bf16* QINF = WSB(WS_QINF) + (size_t)item * 8192; bf16* KDTF = WSB(WS_KDTF) + (size_t)item * 8192; bf16* AMF = WSB(WS_AMF) + (size_t)item * 4096; bf16* VTF = WSB(WS_VTF) + (size_t)item * 16384; float* ELF = WSF(WS_ELF) + (size_t)item * 256;
    LAS float* GDL = (LAS float*)(lds + P_GD); LAS float* GSUM = (LAS float*)(lds + P_GSUM); LAS bf16* QL = (LAS bf16*)(lds + P_QL); LAS bf16* KL = (LAS bf16*)(lds + P_KL); LAS bf16* VS = (LAS bf16*)(lds + P_VS); LAS bf16* AL = (LAS bf16*)(lds + P_AL);
    const u32x4 z4 = (u32x4){0u, 0u, 0u, 0u};
#pragma unroll
    for (int j = 0; j < 2; ++j) { const int idx = tid + 512 * j, row = idx >> 4, ch = idx & 15; const bool ok = row < nvalid; const size_t g = (size_t)chunk_row(b, c, ok ? row : 0) * 512 + h * 128 + ch * 8;
        *(LAS u32x4*)(QL + row * 136 + ch * 8) = ok ? __builtin_nontemporal_load((const u32x4*)(WSB(WS_QG) + g)) : z4; *(LAS u32x4*)(KL + row * 136 + ch * 8) = ok ? __builtin_nontemporal_load((const u32x4*)(WSB(WS_KG) + g)) : z4; }
#pragma unroll
    for (int j = 0; j < 4; ++j) { const int idx = tid + 512 * j, row = idx >> 5, ch = idx & 31; const bool ok = row < nvalid;
        *(LAS u32x4*)(VS + row * 264 + ch * 8) = ok ? __builtin_nontemporal_load((const u32x4*)(WSB(WS_VG) + (size_t)chunk_row(b, c, ok ? row : 0) * 1024 + h * 256 + ch * 8)) : z4; }
    if (tid < 256) { const int row = tid >> 2, ch = tid & 3; const bool ok = row < nvalid; *(LAS f32x4*)(GDL + row * 16 + ch * 4) = ok ? *(const f32x4*)(WSF(WS_GD) + (size_t)chunk_row(b, c, ok ? row : 0) * 16 + ch * 4) : (f32x4){0.f, 0.f, 0.f, 0.f}; }
    __syncthreads();
    const int dk = tid & 127, tg = tid >> 7;
    float bloc[16];
    {
        float w[16]; const float* wg = IN_F(19) + h * 128 + dk;
#pragma unroll
        for (int j = 0; j < 16; ++j) w[j] = wg[j * 512];
        const float bg = IN_F(20)[h * 128 + dk];
        float run = 0.f;
#pragma unroll
        for (int i = 0; i < 16; ++i) {
            const int tok = tg * 16 + i; float x = bg;
#pragma unroll
            for (int j4 = 0; j4 < 4; ++j4) { const f32x4 gd = *(const LAS f32x4*)(GDL + tok * 16 + j4 * 4); x += gd.x * w[4 * j4] + gd.y * w[4 * j4 + 1] + gd.z * w[4 * j4 + 2] + gd.w * w[4 * j4 + 3]; }
            const float g = tok < nvalid ? logsig16(x) : 0.f;
            run += g; bloc[i] = run;
        }
        GSUM[tg * 128 + dk] = run;
    }
    __syncthreads();
    float off = 0.f, blast = 0.f;
#pragma unroll
    for (int t = 0; t < 4; ++t) { const float s = GSUM[t * 128 + dk]; if (t < tg) off += s; blast += s; }
    {
        unsigned kdp[8];
#pragma unroll
        for (int i = 0; i < 16; i += 2) {
            float kd2[2];
#pragma unroll
            for (int e = 0; e < 2; ++e) {
                const int tok = tg * 16 + i + e; const float bb = bloc[i + e] + off; const float q = bf2f(QL[tok * 136 + dk]), k = bf2f(KL[tok * 136 + dk]);
                QL[tok * 136 + dk] = (bf16)f2bf(q * __expf(bb)); KL[tok * 136 + dk] = (bf16)f2bf(k * __expf(-bb)); kd2[e] = k * __expf(blast - bb);
            }
            kdp[i >> 1] = pk2(kd2[0], kd2[1]);
        }
        bf16* kp = KDTF + ((size_t)(((dk >> 5) * 4 + tg) * 64) + (dk & 31)) * 8;
        *(u32x4*)(kp) = (u32x4){kdp[0], kdp[1], kdp[2], kdp[3]}; *(u32x4*)(kp + 32 * 8) = (u32x4){kdp[4], kdp[5], kdp[6], kdp[7]};
        if (tg == 0) ELF[dk] = __expf(blast);
    }
    {
        const int dv = tid & 255, half = tid >> 8;
#pragma unroll
        for (int u = 0; u < 4; ++u) {
            unsigned pk[4];
#pragma unroll
            for (int e = 0; e < 4; ++e) { const int tok = half * 32 + u * 8 + e * 2; pk[e] = (unsigned)VS[tok * 264 + dv] | ((unsigned)VS[(tok + 1) * 264 + dv] << 16); }
            const int s = 2 * half + (u >> 1), uh = u & 1;
            *(u32x4*)(VTF + ((size_t)(((dv >> 5) * 4 + s) * 64) + uh * 32 + (dv & 31)) * 8) = (u32x4){pk[0], pk[1], pk[2], pk[3]};
        }
    }
    __syncthreads();
#pragma unroll
    for (int uu = 0; uu < 2; ++uu) {
        const int U = tid + 512 * uu, lp = U & 63, s8 = (U >> 6) & 7, tt = U >> 9; const int tok = tt * 32 + (lp & 31), hh = lp >> 5;
        const u32x2 lo = *(const LAS u32x2*)(QL + tok * 136 + 16 * s8 + 4 * hh), hi2 = *(const LAS u32x2*)(QL + tok * 136 + 16 * s8 + 8 + 4 * hh);
        *(u32x4*)(QINF + (size_t)U * 8) = (u32x4){lo.x, lo.y, hi2.x, hi2.y};
    }
    if (wid < 3) {
        const int tt = wid == 0 ? 0 : 1, tp = wid == 2 ? 1 : 0;
        f32x16 acc = f32x16{};
#pragma unroll
        for (int s = 0; s < 8; ++s) {
            const bf16x8 af = *(const LAS bf16x8*)(QL + (tt * 32 + r32) * 136 + 16 * s + 8 * hi), bfr = *(const LAS bf16x8*)(KL + (tp * 32 + r32) * 136 + 16 * s + 8 * hi);
            acc = __builtin_amdgcn_mfma_f32_32x32x16_bf16(af, bfr, acc, 0, 0, 0);
        }
#pragma unroll
        for (int r = 0; r < 16; ++r) { const int tok = tt * 32 + crow(r, hi), tk = tp * 32 + r32; AL[tok * 72 + tk] = (bf16)f2bf(tk <= tok ? acc[r] : 0.f); }
    } else if (wid == 3) {
#pragma unroll
        for (int r = 0; r < 16; ++r) AL[crow(r, hi) * 72 + 32 + r32] = 0;
    }
    __syncthreads();
    { const int U = tid, lp = U & 63, s = (U >> 6) & 3, tt = U >> 8; const int tok = tt * 32 + (lp & 31), hh = lp >> 5;
      *(u32x4*)(AMF + (size_t)U * 8) = *(const LAS u32x4*)(AL + tok * 72 + 16 * s + 8 * hh); }
    __syncthreads();
}
constexpr int SM_A = 0, SM_K = 2048, SM_Q = 4096, SM_V = 6144, SM_O = 10240, SM_END = SM_O + 4 * 2 * 256 * 4;
__device__ __forceinline__ void sample_item(ArgsP a, int item, LAS unsigned char* lds, int wave_id) {
    const int tid = fresh_tid(wave_id);
    const int db = item >> 2, h = item & 3;
    LAS float* AS = (LAS float*)(lds + SM_A); LAS float* KS = (LAS float*)(lds + SM_K); LAS float* QS = (LAS float*)(lds + SM_Q); LAS float* VSm = (LAS float*)(lds + SM_V); LAS float* OS = (LAS float*)(lds + SM_O);
    { const int s = tid >> 7, dk = tid & 127, row = RSAMP0 + db * 4 + s; const float* gd = WSF(WS_GD) + (size_t)row * 16; const float* wg = IN_F(19) + h * 128 + dk;
      float x = IN_F(20)[h * 128 + dk];
#pragma unroll
      for (int j = 0; j < 16; ++j) x += gd[j] * wg[j * 512];
      AS[s * 128 + dk] = __expf(logsig16(x));
      const size_t g = (size_t)row * 512 + h * 128 + dk; KS[s * 128 + dk] = bf2f(WSB(WS_KG)[g]); QS[s * 128 + dk] = bf2f(WSB(WS_QG)[g]);
#pragma unroll
      for (int j = 0; j < 2; ++j) { const int e = tid + 512 * j, s2 = e >> 8, dv2 = e & 255; VSm[s2 * 256 + dv2] = bf2f(WSB(WS_VG)[(size_t)(RSAMP0 + db * 4 + s2) * 1024 + h * 256 + dv2]); } }
    const int dv = tid & 255, kh = tid >> 8;
    const unsigned voff = (unsigned)(kh * 64 * 256 + dv) * 4u;
    const unsigned char* sbase = (const unsigned char*)(IN_F(4) + (size_t)(db * 4 + h) * 128 * 256);
    __syncthreads();
    float S[64];
#pragma unroll
    for (int d4 = 0; d4 < 16; ++d4) { const GAS unsigned char* bp = (const GAS unsigned char*)sbase + d4 * 4096; asm volatile("" : "+s"(bp));
#pragma unroll
        for (int e = 0; e < 4; ++e) S[4 * d4 + e] = __builtin_nontemporal_load((const GAS float*)(bp + e * 1024 + voff)); }
#pragma unroll 1
    for (int s = 0; s < 4; ++s) {
        const float v = VSm[s * 256 + dv]; float o = 0.f;
#pragma unroll
        for (int d4 = 0; d4 < 16; ++d4) {
            if ((d4 & 3) == 0) __builtin_amdgcn_sched_barrier(0);
            const f32x4 av = *(const LAS f32x4*)(AS + s * 128 + kh * 64 + 4 * d4), kv = *(const LAS f32x4*)(KS + s * 128 + kh * 64 + 4 * d4), qv = *(const LAS f32x4*)(QS + s * 128 + kh * 64 + 4 * d4);
            S[4 * d4] = av.x * S[4 * d4] + kv.x * v; o += qv.x * S[4 * d4]; S[4 * d4 + 1] = av.y * S[4 * d4 + 1] + kv.y * v; o += qv.y * S[4 * d4 + 1];
            S[4 * d4 + 2] = av.z * S[4 * d4 + 2] + kv.z * v; o += qv.z * S[4 * d4 + 2]; S[4 * d4 + 3] = av.w * S[4 * d4 + 3] + kv.w * v; o += qv.w * S[4 * d4 + 3];
        }
        OS[(s * 2 + kh) * 256 + dv] = o;
    }
    unsigned char* obase = (unsigned char*)(a->out + O_GLAS + (size_t)(db * 4 + h) * 128 * 256);
#pragma unroll
    for (int d4 = 0; d4 < 16; ++d4) { GAS unsigned char* bp = (GAS unsigned char*)obase + d4 * 4096; asm volatile("" : "+s"(bp));
#pragma unroll
        for (int e = 0; e < 4; ++e) __builtin_nontemporal_store(S[4 * d4 + e], (GAS float*)(bp + e * 1024 + voff)); }
    __syncthreads();
#pragma unroll
    for (int j = 0; j < 2; ++j) { const int e = tid + 512 * j, s2 = e >> 8, dv2 = e & 255; WSB(WS_OGRAW)[((size_t)(h * 8 + (dv2 >> 5)) * RP + (RSAMP0 + db * 4 + s2)) * 32 + (dv2 & 31)] = (bf16)f2bf(OS[(s2 * 2) * 256 + dv2] + OS[(s2 * 2 + 1) * 256 + dv2]); }
    __syncthreads();
}
__device__ __forceinline__ void prep_phase(ArgsP a, LAS unsigned char* lds, int wave_id) {
    for (int item = blockIdx.x; item < NITEM; item += gridDim.x) prep_item(a, item, lds, wave_id);
}
constexpr int S_QIN = 0, S_KDT = 16384, S_AM = 32768, S_EL = 40960, S_VT = 41984, S_SLOT = S_VT + 4096;
constexpr int S_X = 3 * S_SLOT, S_END = S_X + 2 * 8192;
static_assert(S_END <= MISC_OFF, "scan ring + state exchange fit under the control words");
constexpr int NPIECE = 45, NHELP = 6, NDMA = (NPIECE + NHELP - 1) / NHELP;
__device__ __forceinline__ void scan_bh(ArgsP a, int bh, int part, LAS unsigned char* lds, int wave_id) {
    const int tid = fresh_tid(wave_id), lane = tid & 63, r32 = lane & 31, hi = lane >> 5; const int wid = wave_id;
    const int b = bh >> 2, h = bh & 3, ds = part;
    const unsigned char* const pq = (const unsigned char*)(WSB(WS_QINF) + (size_t)bh * NCH * 8192); const unsigned char* const pk = (const unsigned char*)(WSB(WS_KDTF) + (size_t)bh * NCH * 8192);
    const unsigned char* const pa = (const unsigned char*)(WSB(WS_AMF) + (size_t)bh * NCH * 4096); const unsigned char* const pe = (const unsigned char*)(WSF(WS_ELF) + (size_t)bh * NCH * 256);
    const unsigned char* const pv = (const unsigned char*)(WSB(WS_VTF) + (size_t)bh * NCH * 16384) + part * 4096;
    LAS unsigned char* const X = lds + S_X;
#define GLA_BAR() asm volatile("s_waitcnt lgkmcnt(0)\n\ts_barrier" ::: "memory")
#define GLA_QF(tt, k8) (*(const LAS bf16x8*)(sb + S_QIN + ((tt) * 8 + (k8)) * 1024 + lane * 16))
#define GLA_KF(T, s) (*(const LAS bf16x8*)(sb + S_KDT + ((T) * 4 + (s)) * 1024 + lane * 16))
#define GLA_AF(tt, s) (*(const LAS bf16x8*)(sb + S_AM + ((tt) * 4 + (s)) * 1024 + lane * 16))
    if (wid >= 2) {
#define GLA_DMA(c_, slot_) do { const size_t c64_ = (size_t)(c_); \
        _Pragma("unroll") for (int k_ = 0; k_ < NDMA; ++k_) { int i_ = (wid - 2) + NHELP * k_; i_ = i_ < NPIECE ? i_ : 40; const unsigned char* g_; int lo_; \
            if (i_ < 16) { g_ = pq + c64_ * 16384 + i_ * 1024; lo_ = S_QIN + i_ * 1024; } \
            else if (i_ < 32) { g_ = pk + c64_ * 16384 + (i_ - 16) * 1024; lo_ = S_KDT + (i_ - 16) * 1024; } \
            else if (i_ < 40) { g_ = pa + c64_ * 8192 + (i_ - 32) * 1024; lo_ = S_AM + (i_ - 32) * 1024; } \
            else if (i_ == 40) { g_ = pe + c64_ * 1024; lo_ = S_EL; } \
            else { g_ = pv + c64_ * 32768 + (i_ - 41) * 1024; lo_ = S_VT + (i_ - 41) * 1024; } \
            __builtin_amdgcn_global_load_lds((const unsigned*)(g_ + lane * 16), (LAS unsigned*)(lds + (slot_) * S_SLOT + lo_), 16, 0, 0); } } while (0)
        GLA_DMA(0, 0); GLA_DMA(1, 1);
        for (int c = 0; c < NCH; ++c) {
            if (c + 1 < NCH) asm volatile("s_waitcnt vmcnt(%0)" :: "n"(NDMA) : "memory"); else asm volatile("s_waitcnt vmcnt(0)" ::: "memory");
            GLA_BAR();
            if (c + 2 < NCH) GLA_DMA(c + 2, (c + 2) % 3);
        }
#undef GLA_DMA
    } else if (wid == 1) {
        f32x16 S[4]; S[0] = f32x16{}; S[1] = f32x16{}; S[2] = f32x16{}; S[3] = f32x16{};
#pragma unroll
        for (int k = 0; k < 8; ++k) *(LAS u32x4*)(X + k * 1024 + lane * 16) = (u32x4){0u, 0u, 0u, 0u};
        for (int c = 0; c < NCH; ++c) {
            GLA_BAR();
            const LAS unsigned char* sb = lds + (c % 3) * S_SLOT;
            bf16x8 vf[4];
#pragma unroll
            for (int s = 0; s < 4; ++s) vf[s] = *(const LAS bf16x8*)(sb + S_VT + s * 1024 + lane * 16);
            bf16x8 KA[4], KB[4];
#define GLA_LK(F, s) do { F[0] = GLA_KF(0, s); F[1] = GLA_KF(1, s); F[2] = GLA_KF(2, s); F[3] = GLA_KF(3, s); } while (0)
#define GLA_MK(F, s) do { _Pragma("unroll") for (int T = 0; T < 4; ++T) S[T] = __builtin_amdgcn_mfma_f32_32x32x16_bf16(F[T], vf[s], S[T], 0, 0, 0); } while (0)
            GLA_LK(KA, 0); GLA_LK(KB, 1);
#pragma unroll
            for (int T = 0; T < 4; ++T)
#pragma unroll
                for (int g = 0; g < 4; ++g) { const f32x4 e = *(const LAS f32x4*)(sb + S_EL + (32 * T + 8 * g + 4 * hi) * 4); S[T][4 * g] *= e.x; S[T][4 * g + 1] *= e.y; S[T][4 * g + 2] *= e.z; S[T][4 * g + 3] *= e.w; }
            __builtin_amdgcn_sched_barrier(0);
            GLA_MK(KA, 0); __builtin_amdgcn_sched_barrier(0); GLA_LK(KA, 2); __builtin_amdgcn_sched_barrier(0);
            GLA_MK(KB, 1); __builtin_amdgcn_sched_barrier(0); GLA_LK(KB, 3); __builtin_amdgcn_sched_barrier(0);
            GLA_MK(KA, 2); __builtin_amdgcn_sched_barrier(0); GLA_MK(KB, 3);
#undef GLA_LK
#undef GLA_MK
            if (c + 1 < NCH) {
                LAS unsigned char* xo = X + ((c + 1) & 1) * 8192 + lane * 16;
#pragma unroll
                for (int T = 0; T < 4; ++T)
#pragma unroll
                    for (int s = 0; s < 2; ++s) { u32x4 w;
#pragma unroll
                        for (int i = 0; i < 4; ++i) w[i] = cvtpk(S[T][8 * s + 2 * i], S[T][8 * s + 2 * i + 1]);
                        *(LAS u32x4*)(xo + (T * 2 + s) * 1024) = w; }
            }
        }
        float* outp = a->out + O_GLAP + (size_t)bh * 128 * 256 + ds * 32 + r32;
#pragma unroll
        for (int T = 0; T < 4; ++T)
#pragma unroll
            for (int r = 0; r < 16; ++r) outp[(size_t)(32 * T + crow(r, hi)) * 256] = S[T][r];
    } else {
        bf16* const ogbase = WSB(WS_OGRAW) + (size_t)(h * 8 + ds) * RP * 32 + r32;
        for (int c = 0; c < NCH; ++c) {
            GLA_BAR();
            const LAS unsigned char* sb = lds + (c % 3) * S_SLOT; const LAS unsigned char* xi = X + (c & 1) * 8192 + lane * 16;
            bf16x8 vf[4], Sb[8];
#pragma unroll
            for (int k = 0; k < 8; ++k) Sb[k] = *(const LAS bf16x8*)(xi + k * 1024);
#pragma unroll
            for (int s = 0; s < 4; ++s) vf[s] = *(const LAS bf16x8*)(sb + S_VT + s * 1024 + lane * 16);
            f32x16 o[2]; o[0] = f32x16{}; o[1] = f32x16{};
            bf16x8 FA[4], FB[4], FC[6];
#define GLA_LQ(F, g) do { F[0] = GLA_QF(0, 2 * (g)); F[1] = GLA_QF(1, 2 * (g)); F[2] = GLA_QF(0, 2 * (g) + 1); F[3] = GLA_QF(1, 2 * (g) + 1); } while (0)
#define GLA_MQ(F, g) do { o[0] = __builtin_amdgcn_mfma_f32_32x32x16_bf16(F[0], Sb[2 * (g)], o[0], 0, 0, 0); o[1] = __builtin_amdgcn_mfma_f32_32x32x16_bf16(F[1], Sb[2 * (g)], o[1], 0, 0, 0); \
            o[0] = __builtin_amdgcn_mfma_f32_32x32x16_bf16(F[2], Sb[2 * (g) + 1], o[0], 0, 0, 0); o[1] = __builtin_amdgcn_mfma_f32_32x32x16_bf16(F[3], Sb[2 * (g) + 1], o[1], 0, 0, 0); } while (0)
            GLA_LQ(FA, 0); GLA_LQ(FB, 1); __builtin_amdgcn_sched_barrier(0);
            GLA_MQ(FA, 0); __builtin_amdgcn_sched_barrier(0); GLA_LQ(FA, 2); __builtin_amdgcn_sched_barrier(0);
            GLA_MQ(FB, 1); __builtin_amdgcn_sched_barrier(0); GLA_LQ(FB, 3); __builtin_amdgcn_sched_barrier(0);
            FC[0] = GLA_AF(0, 0); FC[1] = GLA_AF(1, 0); FC[2] = GLA_AF(0, 1); FC[3] = GLA_AF(1, 1); FC[4] = GLA_AF(1, 2); FC[5] = GLA_AF(1, 3); __builtin_amdgcn_sched_barrier(0);
            GLA_MQ(FA, 2); __builtin_amdgcn_sched_barrier(0); GLA_MQ(FB, 3); __builtin_amdgcn_sched_barrier(0);
            o[0] = __builtin_amdgcn_mfma_f32_32x32x16_bf16(FC[0], vf[0], o[0], 0, 0, 0); o[1] = __builtin_amdgcn_mfma_f32_32x32x16_bf16(FC[1], vf[0], o[1], 0, 0, 0);
            o[0] = __builtin_amdgcn_mfma_f32_32x32x16_bf16(FC[2], vf[1], o[0], 0, 0, 0); o[1] = __builtin_amdgcn_mfma_f32_32x32x16_bf16(FC[3], vf[1], o[1], 0, 0, 0);
            o[1] = __builtin_amdgcn_mfma_f32_32x32x16_bf16(FC[4], vf[2], o[1], 0, 0, 0); o[1] = __builtin_amdgcn_mfma_f32_32x32x16_bf16(FC[5], vf[3], o[1], 0, 0, 0);
#undef GLA_LQ
#undef GLA_MQ
            bf16* og = ogbase;
#pragma unroll
            for (int tt = 0; tt < 2; ++tt)
#pragma unroll
                for (int r = 0; r < 16; ++r) { const int tok = tt * 32 + crow(r, hi); if (c > 0 || tok < NMETA) og[(size_t)chunk_row(b, c, tok) * 32] = (bf16)cvtpk(o[tt][r], o[tt][r]); }
        }
    }
    asm volatile("s_waitcnt vmcnt(0) lgkmcnt(0)\n\ts_barrier" ::: "memory");
#undef GLA_BAR
#undef GLA_QF
#undef GLA_KF
#undef GLA_AF
}
}

__device__ __forceinline__ bool relaunder(ArgsP& a) { asm volatile("" : "+s"(a)); return true; }
constexpr int NPHASE = 22;
__global__ void __launch_bounds__(512, 2) fwd(Args a_unused) {
    ArgsP a = (ArgsP)__builtin_amdgcn_kernarg_segment_ptr();
    extern __shared__ __attribute__((aligned(16))) unsigned char lds_raw[];
    LAS unsigned char* lds = (LAS unsigned char*)lds_raw;
    Ctx c; c.wave = __builtin_amdgcn_readfirstlane((int)threadIdx.x >> 6); c.tid = 0; c.lane = 0;
    c.gw = blockIdx.x * 8 + c.wave; c.ngw = gridDim.x * 8; c.gwT = c.wave * gridDim.x + blockIdx.x;
    volatile LAS unsigned* MISC = (volatile LAS unsigned*)(lds + MISC_OFF);
    if (threadIdx.x < 32) MISC[threadIdx.x] = 0u;
    __syncthreads();
    XcdBarrier bar; bar.bar = (unsigned*)(a->ws + WS_CTL) + CW_BAR; bar.x = 0; bar.st = nullptr;
    const bool one = (a->ph_hi - a->ph_lo) > 1;
    if (one) bar = xcd_barrier_post((unsigned*)(a->ws + WS_CTL) + CW_BAR, MISC + 8);
    const int lo = a->ph_lo, hi = a->ph_hi;
    unsigned long long tp0 = 0, tp1 = 0;
#define IN(k) (((PROBE_LO == (k)) ? (void)(tp0 = __builtin_amdgcn_s_memrealtime()) : (void)0), (lo <= (k) && (k) < hi && relaunder(a)))
#define INQ(k) (lo <= (k) && (k) < hi)
#define SEAM(k) do { if (INQ(k) && INQ((k) + 1)) xcd_barrier(bar, c.wave); if (PROBE_HI == (k)) tp1 = __builtin_amdgcn_s_memrealtime(); } while (0)
    if (IN(0)) { p_prep(a, c, lds); } SEAM(0);
    if (IN(1)) { if ((int)blockIdx.x < (RP / 256) * (NIN0 / 256)) gemm_p1(a, lds, c.wave); else p_side_tables(a, c, lds, (RP / 256) * (NIN0 / 256)); } SEAM(1);
    if (IN(2)) { if (USE_NAIVE_GEMM) p_mla_mid(a, c); }
    if (IN(3)) { gemm_p3(a, lds, c.wave); } SEAM(3);
    if (IN(4)) { if (USE_NAIVE_GEMM) { p_q_post(a, c); p_qlat(a, c); } }
    if (IN(5)) {
#if USE_NAIVE_ATTN
        p_attn_prompt_naive<false>(a, c);
#else
        if (((int)blockIdx.x >> 3) & 1) {
            dec::decode_phase(a, lds, c.wave);
            att::attn_phase(WSB(WS_QN), WSB(WS_QPE), WSB(WS_KNV), WSB(WS_KPE), WSB(WS_O), lds, c.wave);
        } else {
            att::attn_phase(WSB(WS_QN), WSB(WS_QPE), WSB(WS_KNV), WSB(WS_KPE), WSB(WS_O), lds, c.wave);
            dec::decode_phase(a, lds, c.wave);
        }
#endif
    } SEAM(5);
    if (IN(6)) {
#if USE_NAIVE_DECODE
        p_olat_up(a, c);
#else
        dec::combine_phase(a, c, lds);
#endif
    } SEAM(6);
    if (IN(7)) { gemm_n1024_tail<D, 8>(WSB(WS_O), WSB(WS_WO0), WSB(WS_M), WSF(WS_MT), lds, c.wave); } SEAM(7);
    if (IN(8)) { p_post_res<false, 8, true>(a, c, IN_F(8), IN_F(9)); } SEAM(8);
    if (IN(9)) { gemm_mfma8(WSB(WS_H), WSB(WS_WUP), RP, FF, D, (EpiRelu2{WSB(WS_U), FF}), lds, c.wave); } SEAM(9);
    if (IN(10)) { gemm_n1024_tail<FF, 16>(WSB(WS_U), WSB(WS_WDN), WSB(WS_M), WSF(WS_MT), lds, c.wave); } SEAM(10);
    if (IN(11)) { p_post_res<false, 16>(a, c, IN_F(10), IN_F(7) + D); } SEAM(11);
    if (IN(12)) { gemm_mfma8(WSB(WS_H), WSB(WS_WGIN), RP, NGIN, D, (EpiGla{WSB(WS_QG), WSB(WS_KG), WSB(WS_VG), WSB(WS_RG), WSF(WS_GD)}), lds, c.wave); } SEAM(12);
    if (IN(13)) {
#if USE_NAIVE_GLA
        p_gate(a, c);
#else
        gla::prep_phase(a, lds, c.wave);
#endif
    } SEAM(13);
    if (IN(14)) {
#if !USE_NAIVE_GLA
        if ((int)blockIdx.x < NB * GH * gla::NSP) gla::scan_bh(a, (int)blockIdx.x / gla::NSP, (int)blockIdx.x % gla::NSP, lds, c.wave);
        else for (int item = (int)blockIdx.x - NB * GH * gla::NSP; item < DB * GH; item += (int)gridDim.x - NB * GH * gla::NSP) gla::sample_item(a, item, lds, c.wave);
#else
        p_gla_naive(a, c);
#endif
    } SEAM(14);
    if (IN(15)) { p_gla_post(a, c); } SEAM(15);
    if (IN(16)) { gemm_n1024_tail<D, 8>(WSB(WS_OG), WSB(WS_WGO), WSB(WS_M), WSF(WS_MT), lds, c.wave); } SEAM(16);
    if (IN(17)) { p_post_res<false, 8>(a, c, IN_F(8) + D, IN_F(9) + D); } SEAM(17);
    if (IN(18)) { gemm_mfma8(WSB(WS_H), WSB(WS_WUP) + (size_t)FF * D, RP, FF, D, (EpiRelu2{WSB(WS_U), FF}), lds, c.wave); } SEAM(18);
    if (IN(19)) { gemm_n1024_tail<FF, 16>(WSB(WS_U), WSB(WS_WDN) + (size_t)D * FF, WSB(WS_M), WSF(WS_MT), lds, c.wave); } SEAM(19);
    if (IN(20)) { p_post_res<true, 16>(a, c, IN_F(10) + D, nullptr); }
    if (PROBE_LO >= 0 && blockIdx.x == 0) { const unsigned long long span = (tp1 - tp0) * 9ull, t0 = __builtin_amdgcn_s_memrealtime(); while (__builtin_amdgcn_s_memrealtime() - t0 < span) __builtin_amdgcn_s_sleep(8); }
#undef IN
#undef SEAM
}

extern "C" void kernel_launch(void* const* d_in, const int* in_sizes, int n_in, void* d_out, int out_size, void* d_ws, size_t ws_size, hipStream_t stream) {
    static int grid = 0;
    if (grid == 0) {
        if (n_in != 25 || out_size != (int)O_END || ws_size < WS_END) { fprintf(stderr, "kernel_launch: unexpected shapes n_in %d out %d ws %zu\n", n_in, out_size, ws_size); grid = -1; return; }
        int dev = 0, cus = 0, per_cu = 0;
        if (hipGetDevice(&dev) != hipSuccess || hipDeviceGetAttribute(&cus, hipDeviceAttributeMultiprocessorCount, dev) != hipSuccess) { grid = -1; return; }
        if (hipFuncSetAttribute((const void*)fwd, hipFuncAttributeMaxDynamicSharedMemorySize, LDS_BYTES) != hipSuccess) { fprintf(stderr, "kernel_launch: hipFuncSetAttribute failed\n"); grid = -1; return; }
        if (hipOccupancyMaxActiveBlocksPerMultiprocessor(&per_cu, (const void*)fwd, 512, LDS_BYTES) != hipSuccess || per_cu < 1) fprintf(stderr, "kernel_launch: occupancy query says %d\n", per_cu);
        (void)hipGetLastError();
        grid = cus;
    }
    if (grid < 0) return;
    if (hipMemsetAsync((char*)d_ws + WS_CTL, 0, CTL_ZERO_BYTES, stream) != hipSuccess) return;
    Args a{};
    for (int i = 0; i < 25; ++i) a.in[i] = d_in[i];
    a.out = (float*)d_out; a.ws = (unsigned char*)d_ws;
#if MK_ONE_LAUNCH
    a.ph_lo = 0; a.ph_hi = NPHASE;
    hipLaunchKernelGGL(fwd, dim3(grid), dim3(512), LDS_BYTES, stream, a);
#else
    for (int ph = 0; ph < NPHASE - 1; ++ph) { a.ph_lo = ph; a.ph_hi = ph + 1; hipLaunchKernelGGL(fwd, dim3(grid), dim3(512), LDS_BYTES, stream, a); }
#endif
}
```

```cpp
#include <hip/hip_runtime.h>
#include <cstdio>
#include <cstdint>
#include <cmath>

#ifndef MK_ONE_LAUNCH
#define MK_ONE_LAUNCH 1
#endif

constexpr int D = 1024, NB = 4, SEQ = 4096, NMETA = 16, TP = SEQ + NMETA;
constexpr int DB = 128, DS = 4, PAST = 8192, PAGE = 128, NPAGES = 64;
constexpr int NH = 16, QL = 256, KVL = 256, NOPE = 64, ROPE = 32, VH = 64;
constexpr int GH = 4, GDK = 128, GDV = 256, GR = 16;
constexpr int FF = 4096;
constexpr int RMAIN = NB * SEQ;
constexpr int RMETA0 = RMAIN;
constexpr int RSAMP0 = RMAIN + NB * NMETA;
constexpr int R = RSAMP0 + DB * DS;
constexpr int RPROMPT = RSAMP0;
constexpr int RP = 17152;
constexpr int NIN0 = 768, NUQ = 1536, NUKV = 2048, NGIN = 3328, NGIN_REAL = 3088;
constexpr float EPS = 1e-6f;
constexpr float MLA_SCALE = 0.10206207261596575f;
constexpr float GLA_SCALE = 0.08838834764831845f;
constexpr float QSCALE = 0.10206207261596575f * 1.4426950408889634f;

constexpr size_t O_YP = 0, O_YS = 16777216, O_CKVP = 17301504, O_KPEP = 21512192, O_CKVS = 22038528, O_KPES = 22169600, O_GLAP = 22185984, O_GLAS = 22710272, O_END = 39487488;

constexpr size_t MiB = 1u << 20;
constexpr size_t WS_CTL = 0, CTL_ZERO_BYTES = 1 * MiB;
constexpr size_t WS_WIN0 = 2 * MiB, WS_WUQ = 4 * MiB, WS_WUKV = 5 * MiB, WS_WO0 = 6 * MiB, WS_WUP = 8 * MiB, WS_WDN = 24 * MiB, WS_WGIN = 40 * MiB, WS_WGO = 47 * MiB;
constexpr size_t WS_X = 64 * MiB, WS_H = 132 * MiB, WS_M = 166 * MiB, WS_U = 234 * MiB, WS_A1 = 368 * MiB, WS_CQN = 419 * MiB, WS_CKVN = 428 * MiB, WS_KPE = 437 * MiB;
constexpr size_t WS_QRAW = 440 * MiB, WS_KNV = 541 * MiB, WS_QN = 608 * MiB, WS_QPE = 642 * MiB, WS_QLAT = 659 * MiB, WS_OLAT = 663 * MiB, WS_O = 671 * MiB;
constexpr size_t WS_QG = 705 * MiB, WS_KG = 722 * MiB, WS_VG = 739 * MiB, WS_RG = 773 * MiB, WS_GD = 807 * MiB, WS_LA = 809 * MiB, WS_EA = 843 * MiB, WS_OGRAW = 877 * MiB, WS_OG = 944 * MiB;
constexpr size_t WS_OPART = 978 * MiB, WS_MLP = 1012 * MiB;
constexpr size_t WS_QINF = 1014 * MiB, WS_KDTF = 1032 * MiB, WS_AMF = 1050 * MiB, WS_VTF = 1060 * MiB, WS_ELF = 1094 * MiB;
constexpr size_t WS_WUQL = 50 * MiB;
constexpr size_t WS_ROPE = 53 * MiB;
constexpr size_t WS_MT = 1096 * MiB;
constexpr size_t WS_END = 1144 * MiB;
constexpr int CW_BAR = 4096, CW_DEC = 8192;
namespace gla { constexpr int NSP = 8; static_assert(NSP == 8, "the scan's XCD mapping assumes 8 workgroups per (b, h)"); }

constexpr int LDS_BYTES = 163840;
constexpr int MISC_OFF = LDS_BYTES - 256;

#define GAS __attribute__((address_space(1)))
#define LAS __attribute__((address_space(3)))
typedef unsigned short bf16;
typedef float f32x4 __attribute__((ext_vector_type(4)));
typedef unsigned u32x4 __attribute__((ext_vector_type(4)));
typedef unsigned u32x2 __attribute__((ext_vector_type(2)));
#define LDS_WAIT() asm volatile("s_waitcnt lgkmcnt(0)" ::: "memory")

__device__ __forceinline__ unsigned f2bf(float f) { unsigned u = __builtin_bit_cast(unsigned, f); return (u + 0x7fffu + ((u >> 16) & 1u)) >> 16; }
__device__ __forceinline__ unsigned pk2(float lo, float hi) { return f2bf(lo) | (f2bf(hi) << 16); }
__device__ __forceinline__ float bflo(unsigned u) { return __builtin_bit_cast(float, u << 16); }
__device__ __forceinline__ float bfhi(unsigned u) { return __builtin_bit_cast(float, u & 0xffff0000u); }
__device__ __forceinline__ float bf2f(bf16 v) { return __builtin_bit_cast(float, (unsigned)v << 16); }
__device__ __forceinline__ float wave_sum(float v) {
#pragma unroll
    for (int o = 1; o < 64; o <<= 1) v += __shfl_xor(v, o);
    return v;
}
__device__ __forceinline__ int wave_max_i(int v) {
#pragma unroll
    for (int o = 1; o < 64; o <<= 1) { int t = __shfl_xor(v, o); v = t > v ? t : v; }
    return v;
}
__device__ __forceinline__ int fresh_tid(int wave) { int t = wave * 64 + (int)__builtin_amdgcn_mbcnt_hi(~0u, __builtin_amdgcn_mbcnt_lo(~0u, 0u)); asm volatile("" : "+v"(t)); return t; }
__device__ __forceinline__ float rdlane(float v, int l) { return __builtin_bit_cast(float, __builtin_amdgcn_readlane(__builtin_bit_cast(int, v), l)); }

#define XB_TMO      128
#define XB_XCNT(j)  (256  + 64 * (j))
#define XB_XSUB(j)  (1280 + 64 * (j))
#define XB_XGEN(j)  (2304 + 64 * (j))
#define XB_TOP      3328
#define XB_TOPGEN   3392
#define XCD_BAR_WORDS 3456
#define XB_SPIN_CAP (1u << 18)
__device__ __forceinline__ unsigned xb_ld(unsigned* p)              { return __hip_atomic_load(p, __ATOMIC_RELAXED, __HIP_MEMORY_SCOPE_AGENT); }
__device__ __forceinline__ unsigned xb_add(unsigned* p, unsigned v) { return __hip_atomic_fetch_add(p, v, __ATOMIC_RELAXED, __HIP_MEMORY_SCOPE_AGENT); }
__device__ __forceinline__ unsigned xb_xcc_id() { return (unsigned)__builtin_amdgcn_s_getreg((3 << 11) | 20) & 0xFu; }
#define XB_SPIN(cond, bar) do { unsigned _sp = 0; while (cond) { __builtin_amdgcn_s_sleep(1); \
    if ((++_sp & 255u) == 0u) { if (xb_ld(&(bar)[XB_TMO])) break; if (_sp > XB_SPIN_CAP) { atomicAdd(&(bar)[XB_TMO], 1u); break; } } } } while (0)
struct XcdBarrier { unsigned* bar; unsigned x; volatile LAS unsigned* st; };
__device__ __forceinline__ XcdBarrier xcd_barrier_post(unsigned* bar, volatile LAS unsigned* st) {
    XcdBarrier b; b.bar = bar; b.x = xb_xcc_id(); b.st = st;
    if (threadIdx.x == 0) (void)xb_add(&bar[XB_XCNT(b.x)], 1u);
    return b;
}
__device__ __forceinline__ void xcd_barrier_complete(unsigned* bar, unsigned x, unsigned& nloc, unsigned& nx) {
    const unsigned G = gridDim.x * gridDim.y * gridDim.z;
    unsigned sum, cnt, mine, sp = 0u;
    for (;;) {
        sum = 0u; cnt = 0u; mine = 0u;
#pragma unroll
        for (unsigned j = 0; j < 16; ++j) { const unsigned c = xb_ld(&bar[XB_XCNT(j)]); sum += c; cnt += (c > 0u) ? 1u : 0u; mine = (j == x) ? c : mine; }
        if (sum == G) break;
        __builtin_amdgcn_s_sleep(1);
        if ((++sp & 255u) == 0u) { if (xb_ld(&bar[XB_TMO])) break; if (sp > XB_SPIN_CAP) { atomicAdd(&bar[XB_TMO], 1u); break; } }
    }
    nloc = mine > 0u ? mine : 1u; nx = cnt > 0u ? cnt : 1u;
}
__device__ __forceinline__ void xcd_barrier(const XcdBarrier& b, int wave_id) {
    asm volatile("s_waitcnt vmcnt(0)" ::: "memory");
    __syncthreads();
    if (fresh_tid(wave_id) == 0) {
        unsigned* bar = b.bar;
        __builtin_amdgcn_s_waitcnt(0);
        unsigned nloc = b.st[0], nx = b.st[1];
        if (nloc == 0u) { xcd_barrier_complete(bar, b.x, nloc, nx); b.st[0] = nloc; b.st[1] = nx; }
        const unsigned old = xb_add(&bar[XB_XSUB(b.x)], 1u);
        const unsigned gen = old / nloc;
        if (old + 1u == (gen + 1u) * nloc) {
            __builtin_amdgcn_fence(__ATOMIC_RELEASE, "agent");
            asm volatile("s_waitcnt vmcnt(0)" ::: "memory");
            const unsigned og = xb_add(&bar[XB_TOP], 1u);
            const unsigned tg = og / nx;
            if (og + 1u == (tg + 1u) * nx) xb_add(&bar[XB_TOPGEN], 1u);
            else XB_SPIN(xb_ld(&bar[XB_TOPGEN]) == tg, bar);
            __builtin_amdgcn_fence(__ATOMIC_ACQUIRE, "agent");
            xb_add(&bar[XB_XGEN(b.x)], 1u);
            asm volatile("s_waitcnt vmcnt(0)" ::: "memory");
        } else {
            XB_SPIN(xb_ld(&bar[XB_XGEN(b.x)]) == gen, bar);
            __builtin_amdgcn_fence(__ATOMIC_ACQUIRE, "agent");
            asm volatile("s_waitcnt vmcnt(0)" ::: "memory");
        }
    }
    __syncthreads();
}

namespace pg8 {
#define PG8_LAS __attribute__((address_space(3)))
typedef unsigned short bf16_t;
typedef short bf16x8 __attribute__((ext_vector_type(8)));
typedef float f32x4 __attribute__((ext_vector_type(4)));
typedef unsigned u32x4 __attribute__((ext_vector_type(4)));
constexpr int BM = 256, BK = 64, HALF = 128, HTB = HALF * BK * 2  , STAGE_BYTES = 8 * HTB, NXCD = 8, WGM = 8;

__host__ __device__ __forceinline__ int lds_byte(int r, int c) { const int st = (r >> 4) * 2 + (c >> 5), rr = r & 15, cc = c & 31, ob = rr * 64 + cc * 2; return st * 1024 + (ob ^ (((ob >> 9) & 1) << 5)); }
__host__ __device__ __forceinline__ void stage_rc(int b, int& R, int& C) { const int st = b / 1024, sb = b % 1024, swz = sb ^ (((sb >> 9) & 1) << 5); R = (st >> 1) * 16 + swz / 64; C = (st & 1) * 32 + (swz % 64) / 2; }
__host__ __device__ __forceinline__ int perm32(int rho) { const int n = rho >> 4, i = rho & 15; return 8 * (i >> 2) + 4 * n + (i & 3); }

struct Unit { int pm, pn, k0, prob; long aoff, boff; };
struct Gemm { const bf16_t* A; const bf16_t* Bt; int M, N, K, ld; };

struct StaticOrder {
    int nM, nN, nwg, G, c;
    __host__ __device__ void init(int M, int N, int G_, int c_) { nM = M / BM; nN = N / BM; nwg = nM * nN; G = G_; c = c_; }
    __host__ __device__ bool next(int i, Unit& u) const {
        const long L = (long)i * G + c; if (L >= nwg) return false;
        int wgid = (int)L; { const int q = nwg / NXCD, r = nwg % NXCD, xcd = wgid % NXCD, off = wgid / NXCD; wgid = (xcd < r ? xcd * (q + 1) : r * (q + 1) + (xcd - r) * q) + off; }
        const int nig = WGM * nN, gid = wgid / nig, fm = gid * WGM, gsz = (nM - fm) < WGM ? (nM - fm) : WGM;
        u.pm = fm + ((wgid % nig) % gsz); u.pn = (wgid % nig) / gsz; u.k0 = 0; u.prob = 0; u.aoff = 0; u.boff = 0; return true;
    }
    __device__ __forceinline__ void a_ready(const Unit&) const {}
    __device__ __forceinline__ void done(const Unit&) const {}
};

__device__ __forceinline__ unsigned cvt_pk_bf16(float lo, float hi) { unsigned r; asm volatile("v_cvt_pk_bf16_f32 %0, %1, %2" : "=v"(r) : "v"(lo), "v"(hi)); return r; }
template <class Epi, class Sched, bool ALIGN_EPI = false, bool SP2 = false>
__device__ __forceinline__ void gemm_phase(PG8_LAS unsigned char* lds, const Gemm g, const Sched& S, const Epi& E, int wave_id) {
    const int tid = fresh_tid(wave_id), wid = wave_id, lane = tid & 63, wr = wid >> 2, wc = wid & 3, fr = lane & 15, fq = lane >> 4;
    const int K = g.K, nt = K / BK;
    unsigned voffA[2], voffB[2];
#pragma unroll
    for (int i = 0; i < 2; ++i) { int R, C; stage_rc(tid * 16 + i * 8192, R, C); const int Rb = Epi::PERM ? ((R & ~31) + perm32(R & 31)) : R;
        voffA[i] = (unsigned)(R * g.ld + C) * 2u; voffB[i] = (unsigned)(Rb * g.ld + C) * 2u; }
    const size_t kstep = (size_t)(BK * 2);
    const size_t hstep = (size_t)HALF * g.ld * 2;
    const size_t tstep = 2 * hstep;
    const unsigned ldsw = (unsigned)wid * 1024u;
    const int aoff = lds_byte(wr * 64 + fr, fq * 8), boff = lds_byte(wc * 32 + fr, fq * 8);
#define PG8_SA(b, h) (((b) * 2 + (h)) * HTB)
#define PG8_SB(b, h) ((4 + (b) * 2 + (h)) * HTB)
#define PG8_STAGE(bufoff, gbase, voff) do { _Pragma("unroll") for (int _i = 0; _i < 2; ++_i) \
        __builtin_amdgcn_global_load_lds((const unsigned*)((const char*)(gbase) + (voff)[_i]), (PG8_LAS unsigned*)(lds + (bufoff) + ldsw + _i * 8192), 16, 0, 0); } while (0)
#define PG8_LDA(dst, b, h) do { _Pragma("unroll") for (int m = 0; m < 4; ++m) _Pragma("unroll") for (int k = 0; k < 2; ++k) dst[m][k] = *(const PG8_LAS bf16x8*)(lds + PG8_SA(b, h) + aoff + m * 2048 + k * 1024); } while (0)
#define PG8_LDB(dst, b, h) do { _Pragma("unroll") for (int n = 0; n < 2; ++n) _Pragma("unroll") for (int k = 0; k < 2; ++k) dst[n][k] = *(const PG8_LAS bf16x8*)(lds + PG8_SB(b, h) + boff + n * 2048 + k * 1024); } while (0)
#define PG8_MMA(ai, bj, At, Bt) do { __builtin_amdgcn_s_setprio(1); _Pragma("unroll") for (int m = 0; m < 4; ++m) _Pragma("unroll") for (int n = 0; n < 2; ++n) _Pragma("unroll") for (int k = 0; k < 2; ++k) \
        acc[ai][bj][m][n] = __builtin_amdgcn_mfma_f32_16x16x32_bf16(Bt[n][k], At[m][k], acc[ai][bj][m][n], 0, 0, 0); __builtin_amdgcn_s_setprio(0); } while (0)
#define PG8_WAIT_V(n) asm volatile("s_waitcnt vmcnt(" #n ")" ::: "memory")
#define PG8_WAIT_L(n) asm volatile("s_waitcnt lgkmcnt(" #n ")" ::: "memory")
#define PG8_BAR __builtin_amdgcn_s_barrier()
#define PG8_SCHED __builtin_amdgcn_sched_barrier(0)
    Unit cur, nxt; int ui = 0;
    if (!S.next(0, cur)) return;
    f32x4 acc[2][2][4][2];
#pragma unroll
    for (int a = 0; a < 2; ++a)
#pragma unroll
        for (int b = 0; b < 2; ++b)
#pragma unroll
            for (int m = 0; m < 4; ++m)
#pragma unroll
                for (int n = 0; n < 2; ++n) acc[a][b][m][n] = (f32x4){0.f, 0.f, 0.f, 0.f};
    bf16x8 At[4][2], B0[2][2], B1[2][2];
    const char* cA = (const char*)g.A + (size_t)cur.pm * tstep + (size_t)cur.k0 * 2 + cur.aoff; const char* cB = (const char*)g.Bt + (size_t)cur.pn * tstep + (size_t)cur.k0 * 2 + cur.boff;
    S.a_ready(cur);
    if constexpr (SP2) {
        PG8_STAGE(PG8_SB(0, 0), cB, voffB); PG8_STAGE(PG8_SB(0, 1), cB + hstep, voffB); PG8_STAGE(PG8_SA(0, 0), cA, voffA); PG8_STAGE(PG8_SA(0, 1), cA + hstep, voffA);
        if (wr == 1) PG8_BAR;
        PG8_WAIT_V(2); PG8_BAR;
        PG8_STAGE(PG8_SB(1, 0), cB + kstep, voffB); PG8_STAGE(PG8_SA(1, 0), cA + kstep, voffA); PG8_STAGE(PG8_SB(1, 1), cB + hstep + kstep, voffB);
        PG8_WAIT_V(6); PG8_BAR;
    } else {
        PG8_STAGE(PG8_SB(0, 0), cB, voffB); PG8_STAGE(PG8_SA(0, 0), cA, voffA); PG8_STAGE(PG8_SB(0, 1), cB + hstep, voffB); PG8_STAGE(PG8_SA(0, 1), cA + hstep, voffA);
        if (wr == 1) PG8_BAR;
        PG8_WAIT_V(4); PG8_BAR;
        PG8_STAGE(PG8_SB(1, 0), cB + kstep, voffB); PG8_STAGE(PG8_SA(1, 0), cA + kstep, voffA); PG8_STAGE(PG8_SB(1, 1), cB + hstep + kstep, voffB);
        PG8_WAIT_V(6); PG8_BAR;
    }
    for (;;) {
        const bool has_next = S.next(ui + 1, nxt);
        const char* nA = has_next ? (const char*)g.A + (size_t)nxt.pm * tstep + (size_t)nxt.k0 * 2 + nxt.aoff : cA; const char* nB = has_next ? (const char*)g.Bt + (size_t)nxt.pn * tstep + (size_t)nxt.k0 * 2 + nxt.boff : cB;
        for (int t = 0; t < nt; t += 2) {
            const bool last = (t == nt - 2);
            const char* a1 = cA + (size_t)(t + 1) * kstep;
            const char* a2 = last ? nA : cA + (size_t)(t + 2) * kstep; const char* b2 = last ? nB : cB + (size_t)(t + 2) * kstep;
            const char* a3 = a2 + kstep; const char* b3 = b2 + kstep;
            if (last && has_next) S.a_ready(nxt);
            if constexpr (SP2) {
            PG8_LDB(B0, 0, 0); PG8_LDB(B1, 0, 1); PG8_SCHED; PG8_LDA(At, 0, 0); PG8_STAGE(PG8_SA(1, 1), a1 + hstep, voffA);
            PG8_WAIT_V(8); PG8_WAIT_L(0); PG8_BAR; PG8_MMA(0, 0, At, B0); PG8_MMA(0, 1, At, B1); PG8_BAR; PG8_SCHED;
            PG8_LDA(At, 0, 1); PG8_STAGE(PG8_SB(0, 0), b2, voffB); PG8_STAGE(PG8_SB(0, 1), b2 + hstep, voffB); PG8_STAGE(PG8_SA(0, 0), a2, voffA);
            PG8_WAIT_V(8); PG8_WAIT_L(0); PG8_BAR; PG8_MMA(1, 0, At, B0); PG8_MMA(1, 1, At, B1); PG8_BAR; PG8_SCHED;
            PG8_LDB(B0, 1, 0); PG8_LDB(B1, 1, 1); PG8_SCHED; PG8_LDA(At, 1, 0); PG8_STAGE(PG8_SA(0, 1), a2 + hstep, voffA);
            PG8_WAIT_V(8); PG8_WAIT_L(0); PG8_BAR; PG8_MMA(0, 0, At, B0); PG8_MMA(0, 1, At, B1); PG8_BAR; PG8_SCHED;
            PG8_LDA(At, 1, 1); PG8_STAGE(PG8_SB(1, 0), b3, voffB); PG8_STAGE(PG8_SB(1, 1), b3 + hstep, voffB); PG8_STAGE(PG8_SA(1, 0), a3, voffA);
            PG8_WAIT_V(8); PG8_WAIT_L(0); PG8_BAR; PG8_MMA(1, 0, At, B0); PG8_MMA(1, 1, At, B1); PG8_BAR; PG8_SCHED;
            } else {
            PG8_LDB(B0, 0, 0); PG8_SCHED; PG8_LDA(At, 0, 0); PG8_STAGE(PG8_SA(1, 1), a1 + hstep, voffA);
            PG8_WAIT_L(8); PG8_BAR; PG8_WAIT_L(0); PG8_MMA(0, 0, At, B0); PG8_BAR; PG8_SCHED;
            PG8_LDB(B1, 0, 1); PG8_STAGE(PG8_SB(0, 0), b2, voffB);
            PG8_BAR; PG8_WAIT_L(0); PG8_MMA(0, 1, At, B1); PG8_BAR;
            PG8_LDA(At, 0, 1); PG8_STAGE(PG8_SA(0, 0), a2, voffA);
            PG8_BAR; PG8_WAIT_L(0); PG8_MMA(1, 0, At, B0); PG8_BAR; PG8_SCHED;
            PG8_STAGE(PG8_SB(0, 1), b2 + hstep, voffB);
            PG8_WAIT_V(6); PG8_BAR; PG8_MMA(1, 1, At, B1); PG8_BAR;
            PG8_LDB(B0, 1, 0); PG8_SCHED; PG8_LDA(At, 1, 0); PG8_STAGE(PG8_SA(0, 1), a2 + hstep, voffA);
            PG8_WAIT_L(8); PG8_BAR; PG8_WAIT_L(0); PG8_MMA(0, 0, At, B0); PG8_BAR; PG8_SCHED;
            PG8_LDB(B1, 1, 1); PG8_STAGE(PG8_SB(1, 0), b3, voffB);
            PG8_BAR; PG8_WAIT_L(0); PG8_MMA(0, 1, At, B1); PG8_BAR;
            PG8_LDA(At, 1, 1); PG8_STAGE(PG8_SA(1, 0), a3, voffA);
            PG8_BAR; PG8_WAIT_L(0); PG8_MMA(1, 0, At, B0); PG8_BAR; PG8_SCHED;
            PG8_STAGE(PG8_SB(1, 1), b3 + hstep, voffB);
            PG8_WAIT_V(6); PG8_BAR; PG8_MMA(1, 1, At, B1); PG8_BAR;
            }
        }
        if constexpr (ALIGN_EPI) { if (wr == 0) PG8_BAR; }
        if constexpr (!Epi::AFTER_DRAIN) { E(acc, cur, wr, wc, fr, fq); S.done(cur); }
        if (!has_next) break;
#pragma unroll
        for (int a = 0; a < 2; ++a)
#pragma unroll
            for (int b = 0; b < 2; ++b)
#pragma unroll
                for (int m = 0; m < 4; ++m)
#pragma unroll
                    for (int n = 0; n < 2; ++n) acc[a][b][m][n] = (f32x4){0.f, 0.f, 0.f, 0.f};
        cur = nxt; cA = nA; cB = nB; ++ui;
        if constexpr (ALIGN_EPI) { if (wr == 1) PG8_BAR; }
    }
    PG8_WAIT_V(0);
    if constexpr (!ALIGN_EPI) { if (wr == 0) PG8_BAR; }
    PG8_BAR;
    if constexpr (Epi::AFTER_DRAIN) { E.fused(acc, cur, wr, wc, fr, fq, lds, wid, lane); S.done(cur); }
#undef PG8_SA
#undef PG8_SB
#undef PG8_STAGE
#undef PG8_LDA
#undef PG8_LDB
#undef PG8_MMA
#undef PG8_WAIT_V
#undef PG8_WAIT_L
#undef PG8_BAR
#undef PG8_SCHED
}
}

struct Args { const void* in[25]; float* out; unsigned char* ws; int ph_lo, ph_hi; };
typedef const __attribute__((address_space(4))) Args* ArgsP;
#define IN_F(k) ((const float*)a->in[k])
#define WSB(off) ((bf16*)(a->ws + (off)))
#define WSF(off) ((float*)(a->ws + (off)))

struct Ctx { int tid, lane, wave, gw, ngw, gwT; };
__device__ __forceinline__ Ctx refresh(const Ctx& c0) { Ctx c = c0; c.tid = fresh_tid(c0.wave); c.lane = c.tid & 63; return c; }

__device__ __forceinline__ int row_pos(int r) { return r < RMAIN ? (r & 4095) + NMETA : (r < RSAMP0 ? ((r - RMAIN) & 15) : PAST + ((r - RSAMP0) & 3)); }
__device__ __forceinline__ float rope_inv(int j) { return exp2f(-(float)j * (13.287712379549449f / 16.0f)); }
__device__ __forceinline__ void rope_cs(int pos, int j, float& c, float& s) {
    const float ang = (float)pos * rope_inv(j);
    const double x = (double)ang; const double n = rint(x * 0.15915494309189535); const float r = (float)(x - n * 6.283185307179586);
    c = cosf(r); s = sinf(r);
}

struct RmId { int off; __device__ __forceinline__ int operator()(int n) const { return off + n; } };
struct RmUq { __device__ __forceinline__ int operator()(int n) const { const int h = n / 96, j = n % 96; if (j < 64) return h * 64 + j; const int jj = j - 64; return 1024 + h * 32 + (jj < 16 ? 2 * jj : 2 * (jj - 16) + 1); } };
template <class RM>
__device__ __forceinline__ void tr_item(const float* W, int ldw, int nblk, int item, bf16* WT, int ldt, RM rm, LAS float* scr, int lane) {
    const int kb = item / nblk, nb = item % nblk, k0 = 64 * kb, n0 = 32 * nb;
#pragma unroll
    for (int i = 0; i < 8; ++i) { const int kk = 8 * i + (lane >> 3), c4 = (lane & 7) * 4; const f32x4 v = __builtin_nontemporal_load((const f32x4*)(W + (size_t)(k0 + kk) * ldw + n0 + c4));
        scr[kk * 33 + c4] = v.x; scr[kk * 33 + c4 + 1] = v.y; scr[kk * 33 + c4 + 2] = v.z; scr[kk * 33 + c4 + 3] = v.w; }
    LDS_WAIT();
    const int c = lane & 7;
#pragma unroll
    for (int j = 0; j < 4; ++j) { const int n = (lane >> 3) + 8 * j; const LAS float* s = scr + (8 * c) * 33 + n;
        u32x4 o; o.x = pk2(s[0 * 33], s[1 * 33]); o.y = pk2(s[2 * 33], s[3 * 33]); o.z = pk2(s[4 * 33], s[5 * 33]); o.w = pk2(s[6 * 33], s[7 * 33]);
        *(u32x4*)(WT + (size_t)rm(n0 + n) * ldt + k0 + 8 * c) = o; }
    LDS_WAIT();
}
__device__ __forceinline__ void norm_row_bf16(const float* xrow, const float* g, float* xcopy, bf16* hrow, int lane) {
    f32x4 v[4]; float s = 0.f;
#pragma unroll
    for (int j = 0; j < 4; ++j) { v[j] = *(const f32x4*)(xrow + 4 * lane + 256 * j); s += (v[j].x * v[j].x + v[j].y * v[j].y) + (v[j].z * v[j].z + v[j].w * v[j].w); }
    const float rs = 1.0f / sqrtf(wave_sum(s) * (1.f / D) + EPS);
#pragma unroll
    for (int j = 0; j < 4; ++j) { const f32x4 gg = *(const f32x4*)(g + 4 * lane + 256 * j);
        if (xcopy) *(f32x4*)(xcopy + 4 * lane + 256 * j) = v[j];
        u32x2 o; o.x = pk2(v[j].x * rs * gg.x, v[j].y * rs * gg.y); o.y = pk2(v[j].z * rs * gg.z, v[j].w * rs * gg.w);
        *(u32x2*)(hrow + 4 * lane + 256 * j) = o; }
}
__device__ __forceinline__ void p_prep(ArgsP a, const Ctx& c0, LAS unsigned char* lds) {
    const Ctx c = refresh(c0);
    LAS float* scr = (LAS float*)(lds + c.wave * 16384);
    constexpr int I0 = 16 * 17, I1 = 4 * 48, I2 = 4 * 32, I3 = 4 * 32, I4 = 16 * 32, I5 = 16 * 96, I6 = 16 * 32, I7 = 16 * 128, I8 = 16 * 128, I9 = 64 * 32, I10 = 64 * 32;
    constexpr int NIT = I0 + I1 + I2 + I3 + I4 + I5 + I6 + I7 + I8 + I9 + I10;
    for (int it = c.gw; it < NIT; it += c.ngw) {
        int r = it;
        if (r < I0) { tr_item(IN_F(11), 544, 17, r, WSB(WS_WIN0), 1024, RmId{0}, scr, c.lane); continue; } r -= I0;
        if (r < I1) { tr_item(IN_F(13), 1536, 48, r, WSB(WS_WUQ), 256, RmUq{}, scr, c.lane); continue; } r -= I1;
        if (r < I2) { tr_item(IN_F(15), 1024, 32, r, WSB(WS_WUKV), 256, RmId{0}, scr, c.lane); continue; } r -= I2;
        if (r < I3) { tr_item(IN_F(16), 1024, 32, r, WSB(WS_WUKV), 256, RmId{1024}, scr, c.lane); continue; } r -= I3;
        if (r < I4) { tr_item(IN_F(17), 1024, 32, r, WSB(WS_WO0), 1024, RmId{0}, scr, c.lane); continue; } r -= I4;
        if (r < I5) { tr_item(IN_F(18), 3088, 96, r, WSB(WS_WGIN), 1024, RmId{0}, scr, c.lane); continue; } r -= I5;
        if (r < I6) { tr_item(IN_F(22), 1024, 32, r, WSB(WS_WGO), 1024, RmId{0}, scr, c.lane); continue; } r -= I6;
        if (r < I7) { tr_item(IN_F(23), 4096, 128, r, WSB(WS_WUP), 1024, RmId{0}, scr, c.lane); continue; } r -= I7;
        if (r < I8) { tr_item(IN_F(23) + (size_t)1024 * 4096, 4096, 128, r, WSB(WS_WUP) + (size_t)4096 * 1024, 1024, RmId{0}, scr, c.lane); continue; } r -= I8;
        if (r < I9) { tr_item(IN_F(24), 1024, 32, r, WSB(WS_WDN), 4096, RmId{0}, scr, c.lane); continue; } r -= I9;
        tr_item(IN_F(24) + (size_t)4096 * 1024, 1024, 32, r, WSB(WS_WDN) + (size_t)1024 * 4096, 4096, RmId{0}, scr, c.lane);
    }
    const int gt = c.gw * 64 + c.lane, ngt = c.ngw * 64;
    for (int i = gt; i < (NIN0 - 544) * 1024 / 2; i += ngt) ((unsigned*)(WSB(WS_WIN0) + (size_t)544 * 1024))[i] = 0u;
    for (int i = gt; i < (NGIN - NGIN_REAL) * 1024 / 2; i += ngt) ((unsigned*)(WSB(WS_WGIN) + (size_t)NGIN_REAL * 1024))[i] = 0u;
    for (int i = gt; i < 16 * 1024; i += ngt) { const int n = i >> 10, k = i & 1023; WSB(WS_WGIN)[(size_t)(3072 + n) * 1024 + k] = (bf16)f2bf(IN_F(18)[(size_t)k * 3088 + 3072 + n]); }
    for (int i = c.gw * 64 + c.lane; i < R * 16; i += c.ngw * 64) { const int r = i >> 4, j = i & 15; float cs, sn; rope_cs(row_pos(r), j, cs, sn); WSF(WS_ROPE)[(size_t)r * 32 + j] = cs; WSF(WS_ROPE)[(size_t)r * 32 + 16 + j] = sn; }
    {
        const float* xp = IN_F(0); const float* xm = IN_F(6); const float* xsm = IN_F(1); bf16* X = WSB(WS_X); bf16* H = WSB(WS_H);
        f32x4 gg[4];
#pragma unroll
        for (int j = 0; j < 4; ++j) gg[j] = *(const f32x4*)(IN_F(7) + 4 * c.lane + 256 * j);
        constexpr int NR = 4;
        for (int r0 = c.gw; r0 < R; r0 += NR * c.ngw) {
            f32x4 v[NR][4]; float s[NR];
#pragma unroll
            for (int q = 0; q < NR; ++q) { const int r = r0 + q * c.ngw < R ? r0 + q * c.ngw : r0;
                const float* xs = r < RMAIN ? xp + (size_t)r * D : (r < RSAMP0 ? xm + (size_t)((r - RMAIN) & 15) * D : xsm + (size_t)(r - RSAMP0) * D);
                s[q] = 0.f;
#pragma unroll
                for (int j = 0; j < 4; ++j) { v[q][j] = *(const f32x4*)(xs + 4 * c.lane + 256 * j); s[q] += (v[q][j].x * v[q][j].x + v[q][j].y * v[q][j].y) + (v[q][j].z * v[q][j].z + v[q][j].w * v[q][j].w); } }
#pragma unroll
            for (int sh = 1; sh < 64; sh <<= 1) {
#pragma unroll
                for (int q = 0; q < NR; ++q) s[q] += __shfl_xor(s[q], sh); }
#pragma unroll
            for (int q = 0; q < NR; ++q) { const int r = r0 + q * c.ngw < R ? r0 + q * c.ngw : r0; const float rs = 1.0f / sqrtf(s[q] * (1.f / D) + EPS);
#pragma unroll
                for (int j = 0; j < 4; ++j) { if (r >= RMAIN) { u32x2 xo; xo.x = pk2(v[q][j].x, v[q][j].y); xo.y = pk2(v[q][j].z, v[q][j].w); *(u32x2*)(X + (size_t)r * D + 4 * c.lane + 256 * j) = xo; }
                    u32x2 o; o.x = pk2(v[q][j].x * rs * gg[j].x, v[q][j].y * rs * gg[j].y); o.y = pk2(v[q][j].z * rs * gg[j].z, v[q][j].w * rs * gg[j].w);
                    *(u32x2*)(H + (size_t)r * D + 4 * c.lane + 256 * j) = o; } }
        }
    }
}

struct EpiF32 { float* C; int ldc; __device__ __forceinline__ void store4(int row, int col, f32x4 v) const { *(f32x4*)(C + (size_t)row * ldc + col) = v; } };
struct EpiBf16 { bf16* C; int ldc;
    __device__ __forceinline__ void store8(int row, int col, f32x4 a, f32x4 b) const { u32x4 o; o.x = pk2(a.x, a.y); o.y = pk2(a.z, a.w); o.z = pk2(b.x, b.y); o.w = pk2(b.z, b.w); *(u32x4*)(C + (size_t)row * ldc + col) = o; }
    __device__ __forceinline__ void store4(int row, int col, f32x4 v) const { u32x2 o; o.x = pk2(v.x, v.y); o.y = pk2(v.z, v.w); *(u32x2*)(C + (size_t)row * ldc + col) = o; } };
struct EpiRelu2 { bf16* C; int ldc;
    __device__ __forceinline__ void store8(int row, int col, f32x4 a, f32x4 b) const {
        f32x4 r; r.x = fmaxf(a.x, 0.f); r.y = fmaxf(a.y, 0.f); r.z = fmaxf(a.z, 0.f); r.w = fmaxf(a.w, 0.f); r = r * r;
        f32x4 s; s.x = fmaxf(b.x, 0.f); s.y = fmaxf(b.y, 0.f); s.z = fmaxf(b.z, 0.f); s.w = fmaxf(b.w, 0.f); s = s * s;
        u32x4 o; o.x = pk2(r.x, r.y); o.y = pk2(r.z, r.w); o.z = pk2(s.x, s.y); o.w = pk2(s.z, s.w); *(u32x4*)(C + (size_t)row * ldc + col) = o; }
    __device__ __forceinline__ void store4(int row, int col, f32x4 v) const {
    f32x4 r; r.x = fmaxf(v.x, 0.f); r.y = fmaxf(v.y, 0.f); r.z = fmaxf(v.z, 0.f); r.w = fmaxf(v.w, 0.f); r = r * r;
    u32x2 o; o.x = pk2(r.x, r.y); o.y = pk2(r.z, r.w); *(u32x2*)(C + (size_t)row * ldc + col) = o; } };
struct EpiQ { bf16* QN; bf16* QPE; const float* ROPE;
    __device__ __forceinline__ void store8(int row, int col, f32x4 a, f32x4 b) const {
        if (col < 1024) { u32x4 o; o.x = pk2(a.x * QSCALE, a.y * QSCALE); o.y = pk2(a.z * QSCALE, a.w * QSCALE); o.z = pk2(b.x * QSCALE, b.y * QSCALE); o.w = pk2(b.z * QSCALE, b.w * QSCALE); *(u32x4*)(QN + (size_t)row * 1024 + col) = o; }
        else { store4(row, col, a); store4(row, col + 4, b); }
    }
    __device__ __forceinline__ void store4(int row, int col, f32x4 v) const {
        if (col < 1024) { u32x2 o; o.x = pk2(v.x * QSCALE, v.y * QSCALE); o.y = pk2(v.z * QSCALE, v.w * QSCALE); *(u32x2*)(QN + (size_t)row * 1024 + col) = o; }
        else { const int p0 = (col - 1024) >> 1; const float* rt = ROPE + (size_t)row * 32;
#pragma unroll
            for (int e = 0; e < 2; ++e) { const int p = p0 + e, h = p >> 4, jj = p & 15; const float x1 = e ? v.z : v.x, x2 = e ? v.w : v.y, cs = rt[jj], sn = rt[16 + jj];
                QPE[(size_t)row * 512 + h * 32 + jj] = (bf16)f2bf((x1 * cs - x2 * sn) * QSCALE); QPE[(size_t)row * 512 + h * 32 + 16 + jj] = (bf16)f2bf((x1 * sn + x2 * cs) * QSCALE); } }
    } };
struct EpiBf16S { bf16* C; int ldc; float s;
    __device__ __forceinline__ void store8(int row, int col, f32x4 a, f32x4 b) const { u32x4 o; o.x = pk2(a.x * s, a.y * s); o.y = pk2(a.z * s, a.w * s); o.z = pk2(b.x * s, b.y * s); o.w = pk2(b.z * s, b.w * s); *(u32x4*)(C + (size_t)row * ldc + col) = o; }
    __device__ __forceinline__ void store4(int row, int col, f32x4 v) const { u32x2 o; o.x = pk2(v.x * s, v.y * s); o.y = pk2(v.z * s, v.w * s); *(u32x2*)(C + (size_t)row * ldc + col) = o; } };
struct EpiGla { bf16 *QG, *KG, *VG, *RG; float* GD;
    __device__ __forceinline__ void store8(int row, int col, f32x4 a, f32x4 b) const {
        if (col < 3072) { bf16* dst; int cc;
            if (col < 512) { dst = QG + (size_t)row * 512; cc = col; a = a * GLA_SCALE; b = b * GLA_SCALE; }
            else if (col < 1024) { dst = KG + (size_t)row * 512; cc = col - 512; }
            else if (col < 2048) { dst = VG + (size_t)row * 1024; cc = col - 1024; }
            else { dst = RG + (size_t)row * 1024; cc = col - 2048; }
            u32x4 o; o.x = pk2(a.x, a.y); o.y = pk2(a.z, a.w); o.z = pk2(b.x, b.y); o.w = pk2(b.z, b.w); *(u32x4*)(dst + cc) = o;
        } else if (col < 3088) { *(f32x4*)(GD + (size_t)row * 16 + (col - 3072)) = a; *(f32x4*)(GD + (size_t)row * 16 + (col - 3072) + 4) = b; }
    }
    __device__ __forceinline__ void store4(int row, int col, f32x4 v) const {
        if (col < 3072) { bf16* dst; int cc;
            if (col < 512) { dst = QG + (size_t)row * 512; cc = col; v = v * GLA_SCALE; }
            else if (col < 1024) { dst = KG + (size_t)row * 512; cc = col - 512; }
            else if (col < 2048) { dst = VG + (size_t)row * 1024; cc = col - 1024; }
            else { dst = RG + (size_t)row * 1024; cc = col - 2048; }
            u32x2 o; o.x = pk2(v.x, v.y); o.y = pk2(v.z, v.w); *(u32x2*)(dst + cc) = o;
        } else if (col < 3088) { *(f32x4*)(GD + (size_t)row * 16 + (col - 3072)) = v; }
    } };
template <class Epi>
__device__ __forceinline__ void gemm_naive(const bf16* A, const bf16* Bt, int M, int N, int K, const Epi& E, LAS unsigned char* lds, int tid) {
    LAS float* As = (LAS float*)lds;
    LAS float* Bs = As + 32 * 68;
    const int ntm = M / 64, ntn = N / 128, ty = tid >> 5, tx = tid & 31;
    for (int tile = blockIdx.x; tile < ntm * ntn; tile += gridDim.x) {
        const int tm = tile / ntn, tn = tile % ntn;
        f32x4 acc[4];
#pragma unroll
        for (int i = 0; i < 4; ++i) acc[i] = (f32x4){0.f, 0.f, 0.f, 0.f};
        for (int k0 = 0; k0 < K; k0 += 32) {
            { const int row = tid >> 3, kq = (tid & 7) * 4; const u32x2 v = *(const u32x2*)(A + (size_t)(tm * 64 + row) * K + k0 + kq);
              As[(kq + 0) * 68 + row] = bflo(v.x); As[(kq + 1) * 68 + row] = bfhi(v.x); As[(kq + 2) * 68 + row] = bflo(v.y); As[(kq + 3) * 68 + row] = bfhi(v.y); }
            { const int row = tid >> 2, kq = (tid & 3) * 8; const u32x4 v = *(const u32x4*)(Bt + (size_t)(tn * 128 + row) * K + k0 + kq);
              Bs[(kq + 0) * 132 + row] = bflo(v.x); Bs[(kq + 1) * 132 + row] = bfhi(v.x); Bs[(kq + 2) * 132 + row] = bflo(v.y); Bs[(kq + 3) * 132 + row] = bfhi(v.y);
              Bs[(kq + 4) * 132 + row] = bflo(v.z); Bs[(kq + 5) * 132 + row] = bfhi(v.z); Bs[(kq + 6) * 132 + row] = bflo(v.w); Bs[(kq + 7) * 132 + row] = bfhi(v.w); }
            __syncthreads();
#pragma unroll 8
            for (int k = 0; k < 32; ++k) {
                const f32x4 av = *(const LAS f32x4*)(As + k * 68 + 4 * ty); const f32x4 bv = *(const LAS f32x4*)(Bs + k * 132 + 4 * tx);
                acc[0] += av.x * bv; acc[1] += av.y * bv; acc[2] += av.z * bv; acc[3] += av.w * bv;
            }
            __syncthreads();
        }
#pragma unroll
        for (int i = 0; i < 4; ++i) E.store4(tm * 64 + 4 * ty + i, tn * 128 + 4 * tx, acc[i]);
    }
}


template <class E> struct EpiWrap {
    static constexpr bool PERM = false, AFTER_DRAIN = false; E e;
    __device__ __forceinline__ void operator()(const pg8::f32x4 (&acc)[2][2][4][2], const pg8::Unit& u, int wr, int wc, int fr, int fq) const {
#pragma unroll
        for (int ai = 0; ai < 2; ++ai)
#pragma unroll
            for (int m = 0; m < 4; ++m) { const int row = u.pm * 256 + ai * 128 + wr * 64 + m * 16 + fr;
#pragma unroll
                for (int bj = 0; bj < 2; ++bj)
#pragma unroll
                    for (int n = 0; n < 2; ++n) e.store4(row, u.pn * 256 + bj * 128 + wc * 32 + n * 16 + 4 * fq, acc[ai][bj][m][n]); }
    }
};
template <int KSUB> struct EpiSlab {
    static constexpr bool PERM = false, AFTER_DRAIN = false; float* MT;
    __device__ __forceinline__ void operator()(const pg8::f32x4 (&acc)[2][2][4][2], const pg8::Unit& u, int wr, int wc, int fr, int fq) const {
        float* base = MT + ((size_t)(u.k0 / KSUB) * (RP - RMAIN) + (size_t)(u.pm * 256 - RMAIN)) * D + u.pn * 256 + wc * 32 + 4 * fq;
#pragma unroll
        for (int ai = 0; ai < 2; ++ai)
#pragma unroll
            for (int m = 0; m < 4; ++m) { float* rp = base + (size_t)(ai * 128 + wr * 64 + m * 16 + fr) * D;
#pragma unroll
                for (int bj = 0; bj < 2; ++bj)
#pragma unroll
                    for (int n = 0; n < 2; ++n) *(f32x4*)(rp + bj * 128 + n * 16) = acc[ai][bj][m][n]; }
    }
};
template <class E> struct EpiWrap8 {
    static constexpr bool PERM = true, AFTER_DRAIN = false; E e;
    __device__ __forceinline__ void operator()(const pg8::f32x4 (&acc)[2][2][4][2], const pg8::Unit& u, int wr, int wc, int fr, int fq) const {
#pragma unroll
        for (int ai = 0; ai < 2; ++ai)
#pragma unroll
            for (int m = 0; m < 4; ++m) { const int row = u.pm * 256 + ai * 128 + wr * 64 + m * 16 + fr;
#pragma unroll
                for (int bj = 0; bj < 2; ++bj) e.store8(row, u.pn * 256 + bj * 128 + wc * 32 + 8 * fq, acc[ai][bj][m][0], acc[ai][bj][m][1]); }
    }
};
template <class E>
__device__ __forceinline__ void gemm_mfma8(const bf16* A, const bf16* Bt, int M, int N, int K, const E& e, LAS unsigned char* lds, int wave) {
    pg8::Gemm g{A, Bt, M, N, K, K}; pg8::StaticOrder S; S.init(M, N, (int)gridDim.x, (int)blockIdx.x);
    EpiWrap8<E> W{e};
    pg8::gemm_phase<EpiWrap8<E>, pg8::StaticOrder, true, true>(lds, g, S, W, wave);
}
template <class E>
__device__ __forceinline__ void gemm_mfma(const bf16* A, const bf16* Bt, int M, int N, int K, const E& e, LAS unsigned char* lds, int wave) {
    pg8::Gemm g{A, Bt, M, N, K, K}; pg8::StaticOrder S; S.init(M, N, (int)gridDim.x, (int)blockIdx.x);
    EpiWrap<E> W{e};
    pg8::gemm_phase<EpiWrap<E>, pg8::StaticOrder, true, true>(lds, g, S, W, wave);
}
template <int SPLIT, int NN, int KSUB, int PM0, int NUNITS> struct TailOrder {
    int G, c;
    __device__ __forceinline__ bool next(int i, pg8::Unit& u) const { const int L = i * G + c; if (L >= NUNITS) return false; const int ks = L % SPLIT, t = L / SPLIT; u.pn = t % NN; u.pm = PM0 + t / NN; u.k0 = ks * KSUB; u.prob = 0; u.aoff = 0; u.boff = 0; return true; }
    __device__ __forceinline__ void a_ready(const pg8::Unit&) const {}
    __device__ __forceinline__ void done(const pg8::Unit&) const {}
};
struct EpiAtomicF32 { float* C; int ldc; __device__ __forceinline__ void store4(int row, int col, f32x4 v) const { float* p = C + (size_t)row * ldc + col;
    __hip_atomic_fetch_add(p, v.x, __ATOMIC_RELAXED, __HIP_MEMORY_SCOPE_AGENT); __hip_atomic_fetch_add(p + 1, v.y, __ATOMIC_RELAXED, __HIP_MEMORY_SCOPE_AGENT);
    __hip_atomic_fetch_add(p + 2, v.z, __ATOMIC_RELAXED, __HIP_MEMORY_SCOPE_AGENT); __hip_atomic_fetch_add(p + 3, v.w, __ATOMIC_RELAXED, __HIP_MEMORY_SCOPE_AGENT); } };
template <int K, int SPLIT>
__device__ __forceinline__ void gemm_n1024_tail(const bf16* A, const bf16* Bt, bf16* C, float* MT, LAS unsigned char* lds, int wave) {
    { pg8::Gemm g{A, Bt, RMAIN, D, K, K}; pg8::StaticOrder S; S.init(RMAIN, D, (int)gridDim.x, (int)blockIdx.x); EpiWrap8<EpiBf16> W{EpiBf16{C, D}};
      pg8::gemm_phase<EpiWrap8<EpiBf16>, pg8::StaticOrder, true, true>(lds, g, S, W, wave); }
    { typedef TailOrder<SPLIT, D / 256, K / SPLIT, RMAIN / 256, (RP - RMAIN) / 256 * (D / 256) * SPLIT> TO;
      pg8::Gemm g{A, Bt, RP, D, K / SPLIT, K}; TO S{(int)gridDim.x, (int)blockIdx.x}; EpiSlab<K / SPLIT> W{MT};
      pg8::gemm_phase<EpiSlab<K / SPLIT>, TO, false, true>(lds, g, S, W, wave); }
}

struct P3Order {
    int G, c;
    static constexpr int NQ = (RP / 256) * (NUQ / 256), NL = (DB * DS / 256) * (NH * KVL / 256), NK = (RP / 256) * (NUKV / 256);
    __device__ __forceinline__ bool next(int i, pg8::Unit& u) const {
        int L = i * G + c; u.k0 = 0;
        if (L < NK) { u.prob = 2; u.pm = L / (NUKV / 256); u.pn = L % (NUKV / 256); u.aoff = (long)(WS_CKVN - WS_CQN); u.boff = (long)(WS_WUKV - WS_WUQ); return true; } L -= NK;
        if (L < NQ) { u.prob = 0; u.pm = L / (NUQ / 256); u.pn = L % (NUQ / 256); u.aoff = 0; u.boff = 0; return true; } L -= NQ;
        if (L < NL) { u.prob = 1; u.pm = L / (NH * KVL / 256); u.pn = L % (NH * KVL / 256); u.aoff = (long)RSAMP0 * QL * 2; u.boff = (long)(WS_WUQL - WS_WUQ); return true; }
        return false;
    }
    __device__ __forceinline__ void a_ready(const pg8::Unit&) const {}
    __device__ __forceinline__ void done(const pg8::Unit&) const {}
};
struct EpiP3 {
    static constexpr bool PERM = true, AFTER_DRAIN = false; EpiQ eq; EpiBf16S el; EpiBf16 ek;
    __device__ __forceinline__ void operator()(const pg8::f32x4 (&acc)[2][2][4][2], const pg8::Unit& u, int wr, int wc, int fr, int fq) const {
        asm volatile("" : "+v"(fr), "+v"(fq));
        if (u.prob == 0) { EpiWrap8<EpiQ> w{eq}; w(acc, u, wr, wc, fr, fq); }
        else if (u.prob == 1) { EpiWrap8<EpiBf16S> w{el}; w(acc, u, wr, wc, fr, fq); }
        else { EpiWrap8<EpiBf16> w{ek}; w(acc, u, wr, wc, fr, fq); }
    }
};
__device__ __forceinline__ void gemm_p3(ArgsP a, LAS unsigned char* lds, int wave) {
    pg8::Gemm g{WSB(WS_CQN), WSB(WS_WUQ), RP, NUQ, QL, QL}; P3Order S{(int)gridDim.x, (int)blockIdx.x};
    EpiP3 E{EpiQ{WSB(WS_QN), WSB(WS_QPE), WSF(WS_ROPE)}, EpiBf16S{WSB(WS_QLAT), NH * KVL, QSCALE}, EpiBf16{WSB(WS_KNV), NUKV}};
    pg8::gemm_phase<EpiP3, P3Order, false, true>(lds, g, S, E, wave);
}

struct EpiMlaIn {
    static constexpr bool PERM = false, AFTER_DRAIN = true;
    bf16 *CQN, *CKVN, *KPEB; const float *qg, *kg, *ROPE; float* out;
    __device__ __forceinline__ void fused(pg8::f32x4 (&acc)[2][2][4][2], const pg8::Unit& u, int wr, int wc, int fr, int fq, PG8_LAS unsigned char* lds, int wid, int lane) const {
        asm volatile("" : "+v"(fr), "+v"(fq));
        if (u.pn < 2) {
            PG8_LAS float* P = (PG8_LAS float*)lds;
            float s[2][4];
#pragma unroll
            for (int ai = 0; ai < 2; ++ai)
#pragma unroll
                for (int m = 0; m < 4; ++m) { float t = 0.f;
#pragma unroll
                    for (int bj = 0; bj < 2; ++bj)
#pragma unroll
                        for (int n = 0; n < 2; ++n) { const pg8::f32x4 x = acc[ai][bj][m][n]; t += (x[0] * x[0] + x[1] * x[1]) + (x[2] * x[2] + x[3] * x[3]); }
                    t += __shfl_xor(t, 16); t += __shfl_xor(t, 32);
                    if (fq == 0) P[(ai * 128 + wr * 64 + m * 16 + fr) * 4 + wc] = t; }
            asm volatile("s_waitcnt lgkmcnt(0)\n\ts_barrier" ::: "memory");
#pragma unroll
            for (int ai = 0; ai < 2; ++ai)
#pragma unroll
                for (int m = 0; m < 4; ++m) { const pg8::f32x4 p4 = *(const PG8_LAS pg8::f32x4*)(P + (ai * 128 + wr * 64 + m * 16 + fr) * 4); s[ai][m] = 1.0f / sqrtf(((p4[0] + p4[1]) + (p4[2] + p4[3])) * (1.f / 256) + EPS); }
            const float* g = u.pn == 0 ? qg : kg; bf16* dst = u.pn == 0 ? CQN : CKVN;
#pragma unroll
            for (int bj = 0; bj < 2; ++bj)
#pragma unroll
                for (int n = 0; n < 2; ++n) { const int col = bj * 128 + wc * 32 + n * 16 + 4 * fq; const pg8::f32x4 gv = *(const pg8::f32x4*)(g + col);
#pragma unroll
                    for (int ai = 0; ai < 2; ++ai)
#pragma unroll
                        for (int m = 0; m < 4; ++m) { const int row = u.pm * 256 + ai * 128 + wr * 64 + m * 16 + fr; if (row >= R) continue;
                            const pg8::f32x4 y = acc[ai][bj][m][n] * s[ai][m] * gv;
                            u32x2 o; o.x = pk2(y[0], y[1]); o.y = pk2(y[2], y[3]); *(u32x2*)(dst + (size_t)row * 256 + col) = o;
                            if (u.pn == 1) { const int pos = row_pos(row); float* oc = row < RSAMP0 ? out + O_CKVP + ((size_t)(row < RMAIN ? (row >> 12) : ((row - RMAIN) >> 4)) * TP + pos) * 256 : out + O_CKVS + (size_t)(row - RSAMP0) * 256;
                                *(pg8::f32x4*)(oc + col) = y; } } }
        } else if (wc == 0) {
#pragma unroll
            for (int ai = 0; ai < 2; ++ai)
#pragma unroll
                for (int m = 0; m < 4; ++m) { const int row = u.pm * 256 + ai * 128 + wr * 64 + m * 16 + fr; if (row >= R) continue;
                    const int pos = row_pos(row); const float* rt = ROPE + (size_t)row * 32 + 4 * fq; const pg8::f32x4 cs = *(const pg8::f32x4*)rt, sn = *(const pg8::f32x4*)(rt + 16);
                    const pg8::f32x4 x1 = acc[ai][0][m][0], x2 = acc[ai][0][m][1]; const pg8::f32x4 o1 = x1 * cs - x2 * sn, o2 = x1 * sn + x2 * cs;
                    float* ok = row < RSAMP0 ? out + O_KPEP + ((size_t)(row < RMAIN ? (row >> 12) : ((row - RMAIN) >> 4)) * TP + pos) * 32 : out + O_KPES + (size_t)(row - RSAMP0) * 32;
                    *(pg8::f32x4*)(ok + 4 * fq) = o1; *(pg8::f32x4*)(ok + 16 + 4 * fq) = o2;
                    u32x2 w; w.x = pk2(o1[0], o1[1]); w.y = pk2(o1[2], o1[3]); *(u32x2*)(KPEB + (size_t)row * 32 + 4 * fq) = w; w.x = pk2(o2[0], o2[1]); w.y = pk2(o2[2], o2[3]); *(u32x2*)(KPEB + (size_t)row * 32 + 16 + 4 * fq) = w; }
        }
    }
};
__device__ __forceinline__ void gemm_p1(ArgsP a, LAS unsigned char* lds, int wave) {
    pg8::Gemm g{WSB(WS_H), WSB(WS_WIN0), RP, NIN0, D, D}; pg8::StaticOrder S; S.init(RP, NIN0, (int)gridDim.x, (int)blockIdx.x);
    EpiMlaIn E{WSB(WS_CQN), WSB(WS_CKVN), WSB(WS_KPE), IN_F(12), IN_F(14), WSF(WS_ROPE), a->out};
    pg8::gemm_phase<EpiMlaIn, pg8::StaticOrder, false, true>(lds, g, S, E, wave);
}
#ifndef USE_NAIVE_ATTN
#define USE_NAIVE_ATTN 0
#endif
#ifndef USE_NAIVE_DECODE
#define USE_NAIVE_DECODE 0
#endif
#ifndef USE_NAIVE_GLA
#define USE_NAIVE_GLA 0
#endif
#ifndef PROBE
#define PROBE 0
#endif
#ifndef PROBE_LO
#define PROBE_LO -1
#define PROBE_HI -1
#endif
#ifndef USE_NAIVE_GEMM
#define USE_NAIVE_GEMM 0
#endif
#if USE_NAIVE_GEMM
#define GEMM(A, Bt, M, N, K, E) gemm_naive(A, Bt, M, N, K, E, lds, fresh_tid(c.wave))
#else
#define GEMM(A, Bt, M, N, K, E) gemm_mfma(A, Bt, M, N, K, E, lds, c.wave)
#endif


namespace att {
typedef short bf16x8 __attribute__((ext_vector_type(8)));
typedef short s16x4 __attribute__((ext_vector_type(4)));
typedef float f32x16 __attribute__((ext_vector_type(16)));
constexpr int KSLOT = 12288, VSLOT = 8192, LDS_K = 0, LDS_V = 2 * KSLOT, LDS_WS = LDS_V + 2 * VSLOT, LDS_OST = LDS_WS + 8 * 256, LDS_TOTAL = LDS_OST + 8 * 4096;
__device__ __forceinline__ int crow(int r, int hi) { return (r & 3) + 8 * (r >> 2) + 4 * hi; }
typedef float f32x2_t __attribute__((ext_vector_type(2))); typedef __bf16 bf16x2_t __attribute__((ext_vector_type(2)));
__device__ __forceinline__ unsigned cvtpk(float lo, float hi) { f32x2_t v = {lo, hi}; bf16x2_t b = __builtin_convertvector(v, bf16x2_t); return __builtin_bit_cast(unsigned, b); }
__device__ __forceinline__ s16x4 vtr(const LAS unsigned char* p) { typedef short v4i16_t __attribute__((ext_vector_type(4))); return __builtin_bit_cast(s16x4, __builtin_amdgcn_ds_read_tr16_b64_v4i16((LAS v4i16_t*)p)); }
__device__ __forceinline__ float pmax32(float m) { auto rr = __builtin_amdgcn_permlane32_swap(__float_as_uint(m), __float_as_uint(m), false, false); return fmaxf(__uint_as_float(rr[0]), __uint_as_float(rr[1])); }
__device__ __forceinline__ float psum32(float m) { auto rr = __builtin_amdgcn_permlane32_swap(__float_as_uint(m), __float_as_uint(m), false, false); return __uint_as_float(rr[0]) + __uint_as_float(rr[1]); }
#define ATT_WAIT_BAR() asm volatile("s_waitcnt vmcnt(0) lgkmcnt(0)\n\ts_barrier" ::: "memory")
__device__ __forceinline__ void glds16(const void* gsrc, unsigned lds_dst) { unsigned keep;
    asm volatile("s_mov_b32 %0, m0\n\ts_mov_b32 m0, %2\n\ts_nop 0\n\tglobal_load_lds_dwordx4 %1, off\n\ts_mov_b32 m0, %0" : "=&s"(keep) : "v"(gsrc), "s"(lds_dst) : "memory"); }

__device__ __forceinline__ void attn_unit(int b, int h, int qb, const bf16* QN, const bf16* QPE, const bf16* KNV, const bf16* KPE, bf16* O, LAS unsigned char* lds, int wave_id) {
    const int tid = fresh_tid(wave_id), lane = tid & 63, r32 = lane & 31, hi = lane >> 5; const int wid = wave_id;
    const int rowbase = b * SEQ, q0 = qb * 256, qrow = rowbase + q0 + wid * 32 + r32, qrel = q0 + wid * 32 + r32;
    bf16x8 qr[6];
#pragma unroll
    for (int d0 = 0; d0 < 4; ++d0) qr[d0] = *(const bf16x8*)(QN + (size_t)qrow * 1024 + h * 64 + d0 * 16 + hi * 8);
#pragma unroll
    for (int d0 = 0; d0 < 2; ++d0) qr[4 + d0] = *(const bf16x8*)(QPE + (size_t)qrow * 512 + h * 32 + d0 * 16 + hi * 8);
    LAS float* wsf = (LAS float*)(lds + LDS_WS) + wid * 64;
    const int NT = 4 * qb + 4;
#define ATT_DMA(t, slot) do { const size_t row0_ = (t) == 0 ? (size_t)(RMAIN + 16 * b) : (size_t)(rowbase + 64 * ((t) - 1)); \
        __builtin_amdgcn_global_load_lds((const unsigned*)(KNV + (row0_ + lane) * 2048 + h * 64 + wid * 8), (LAS unsigned*)(lds + LDS_K + (slot) * KSLOT + wid * 1024), 16, 0, 0); \
        if (wid < 4) __builtin_amdgcn_global_load_lds((const unsigned*)(KPE + (row0_ + lane) * 32 + wid * 8), (LAS unsigned*)(lds + LDS_K + (slot) * KSLOT + (8 + wid) * 1024), 16, 0, 0); \
        __builtin_amdgcn_global_load_lds((const unsigned*)(KNV + (row0_ + 16 * (wid & 3) + (lane >> 2)) * 2048 + 1024 + h * 64 + (wid >> 2) * 32 + (lane & 3) * 8), (LAS unsigned*)(lds + LDS_V + (slot) * VSLOT + wid * 1024), 16, 0, 0); } while (0)
    f32x16 o[2]; o[0] = f32x16{}; o[1] = f32x16{};
    float mref = -INFINITY, l = 0.f;
    ATT_DMA(0, 0);
    for (int t = 0; t <= NT; ++t) {
        ATT_WAIT_BAR();
        const int slot = t & 1;
        if (t < NT) ATT_DMA(t + 1, slot ^ 1);
        const int kt0 = 64 * (t - 1);
        if (t > 0 && kt0 > q0 + wid * 32 + 31) continue;
        f32x16 p0 = f32x16{}, p1 = f32x16{};
        const LAS unsigned char* kb = lds + LDS_K + slot * KSLOT + hi * 1024 + r32 * 16;
#pragma unroll
        for (int d0 = 0; d0 < 6; ++d0) {
            const bf16x8 b0 = *(const LAS bf16x8*)(kb + d0 * 2048), b1 = *(const LAS bf16x8*)(kb + d0 * 2048 + 512);
            p0 = __builtin_amdgcn_mfma_f32_32x32x16_bf16(b0, qr[d0], p0, 0, 0, 0);
            p1 = __builtin_amdgcn_mfma_f32_32x32x16_bf16(b1, qr[d0], p1, 0, 0, 0);
        }
        if (t == 0) {
#pragma unroll
            for (int r = 0; r < 16; ++r) { if (crow(r, hi) >= NMETA) p0[r] = -INFINITY; p1[r] = -INFINITY; }
        } else if (kt0 + 63 > q0 + wid * 32) {
#pragma unroll
            for (int r = 0; r < 16; ++r) { const int kv = kt0 + crow(r, hi); if (kv > qrel) p0[r] = -INFINITY; if (kv + 32 > qrel) p1[r] = -INFINITY; }
        }
        float rm = fmaxf(p0[0], p1[0]);
#pragma unroll
        for (int r = 1; r < 16; ++r) rm = fmaxf(rm, fmaxf(p0[r], p1[r]));
        rm = pmax32(rm);
        if (__any(rm > mref + 8.0f)) {
            const float mnew = fmaxf(mref, rm); const float f = __builtin_amdgcn_exp2f(mref - mnew);
            mref = mnew; l *= f;
            if (hi == 0) wsf[r32] = f;
            LDS_WAIT();
#pragma unroll
            for (int r = 0; r < 16; ++r) { const float fr = wsf[crow(r, hi)]; o[0][r] *= fr; o[1][r] *= fr; }
        }
        float sacc = 0.f;
#pragma unroll
        for (int r = 0; r < 16; ++r) { p0[r] = __builtin_amdgcn_exp2f(p0[r] - mref); p1[r] = __builtin_amdgcn_exp2f(p1[r] - mref); sacc += p0[r] + p1[r]; }
        l += sacc;
        u32x4 pw[4];
#pragma unroll
        for (int i = 0; i < 4; ++i) { pw[0][i] = cvtpk(p0[2 * i], p0[2 * i + 1]); pw[1][i] = cvtpk(p0[8 + 2 * i], p0[8 + 2 * i + 1]); pw[2][i] = cvtpk(p1[2 * i], p1[2 * i + 1]); pw[3][i] = cvtpk(p1[8 + 2 * i], p1[8 + 2 * i + 1]); }
        const LAS unsigned char* vb = lds + LDS_V + slot * VSLOT + ((lane >> 4) & 1) * 32 + (lane & 3) * 8 + (4 * hi + ((lane & 15) >> 2)) * 64;
#pragma unroll
        for (int d0 = 0; d0 < 2; ++d0)
#pragma unroll
            for (int ks = 0; ks < 4; ++ks) {
                const s16x4 vlo = vtr(vb + d0 * 4096 + ks * 1024), vhi = vtr(vb + d0 * 4096 + ks * 1024 + 512);
                const bf16x8 vf = (bf16x8){vlo[0], vlo[1], vlo[2], vlo[3], vhi[0], vhi[1], vhi[2], vhi[3]};
                o[d0] = __builtin_amdgcn_mfma_f32_32x32x16_bf16(__builtin_bit_cast(bf16x8, pw[ks]), vf, o[d0], 0, 0, 0);
            }
    }
    l = psum32(l);
    if (hi == 0) wsf[32 + r32] = l;
    LDS_WAIT();
    bf16* Ow = O + (size_t)(rowbase + q0 + wid * 32) * 1024 + h * 64;
    LAS bf16* stg = (LAS bf16*)(lds + LDS_OST) + wid * 2048;
#pragma unroll
    for (int r = 0; r < 16; ++r) { const int orow = crow(r, hi); const float il = 1.0f / wsf[32 + orow];
        stg[orow * 64 + r32] = (bf16)f2bf(o[0][r] * il); stg[orow * 64 + 32 + r32] = (bf16)f2bf(o[1][r] * il); }
    LDS_WAIT();
#pragma unroll
    for (int i = 0; i < 4; ++i) { const int row = i * 8 + (lane >> 3), ch = lane & 7; const u32x4 v = *(const LAS u32x4*)(stg + row * 64 + ch * 8); *(u32x4*)(Ow + (size_t)row * 1024 + ch * 8) = v; }
    ATT_WAIT_BAR();
#undef ATT_DMA
}
constexpr int P_LDS_K = 0, P_LDS_V = 3 * KSLOT, P_LDS_WS = P_LDS_V + 2 * VSLOT, P_LDS_OST = P_LDS_WS + 8 * 256, P_LDS_TOTAL = P_LDS_OST + 8 * 4096;
__device__ __forceinline__ void attn_unit2(int b, int h, int qb, const bf16* QN, const bf16* QPE, const bf16* KNV, const bf16* KPE, bf16* O, LAS unsigned char* lds, int wave_id) {
    const int tid = fresh_tid(wave_id), lane = tid & 63, r32 = lane & 31, hi = lane >> 5; const int wid = wave_id;
    const bool meta = qb < 0;
    const int rowbase = b * SEQ, q0 = meta ? 0 : qb * 256, qrow = meta ? RMAIN + 16 * b + (r32 & 15) : rowbase + q0 + wid * 32 + r32, qrel = meta ? (r32 & 15) : q0 + wid * 32 + r32;
    bf16x8 qr[6];
#pragma unroll
    for (int d0 = 0; d0 < 4; ++d0) qr[d0] = *(const bf16x8*)(QN + (size_t)qrow * 1024 + h * 64 + d0 * 16 + hi * 8);
#pragma unroll
    for (int d0 = 0; d0 < 2; ++d0) qr[4 + d0] = *(const bf16x8*)(QPE + (size_t)qrow * 512 + h * 32 + d0 * 16 + hi * 8);
    LAS float* wsf = (LAS float*)(lds + P_LDS_WS) + wid * 64;
    const unsigned lds0 = (unsigned)(size_t)lds;
    const int NT = meta ? 0 : 4 * qb + 4;
#define A2_ROW0(t) ((t) == 0 ? (size_t)(RMAIN + 16 * b) : (size_t)(rowbase + 64 * ((t) - 1)))
#define A2_DMA_K(t, ks) do { const size_t row0_ = A2_ROW0(t); \
        glds16(KNV + (row0_ + lane) * 2048 + h * 64 + wid * 8, (unsigned)__builtin_amdgcn_readfirstlane((int)(lds0 + P_LDS_K + (ks) * KSLOT + wid * 1024))); \
        if (wid < 4) glds16(KPE + (row0_ + lane) * 32 + wid * 8, (unsigned)__builtin_amdgcn_readfirstlane((int)(lds0 + P_LDS_K + (ks) * KSLOT + (8 + wid) * 1024))); } while (0)
#define A2_DMA_V(t, vs) do { const size_t row0_ = A2_ROW0(t); \
        glds16(KNV + (row0_ + 16 * (wid & 3) + (lane >> 2)) * 2048 + 1024 + h * 64 + (wid >> 2) * 32 + (lane & 3) * 8, (unsigned)__builtin_amdgcn_readfirstlane((int)(lds0 + P_LDS_V + (vs) * VSLOT + wid * 1024))); } while (0)
#define A2_QKT(P0, P1, ks) do { P0 = f32x16{}; P1 = f32x16{}; const LAS unsigned char* kb_ = lds + P_LDS_K + (ks) * KSLOT + hi * 1024 + r32 * 16; \
        _Pragma("unroll") for (int d0 = 0; d0 < 6; ++d0) { const bf16x8 b0_ = *(const LAS bf16x8*)(kb_ + d0 * 2048), b1_ = *(const LAS bf16x8*)(kb_ + d0 * 2048 + 512); \
            P0 = __builtin_amdgcn_mfma_f32_32x32x16_bf16(b0_, qr[d0], P0, 0, 0, 0); P1 = __builtin_amdgcn_mfma_f32_32x32x16_bf16(b1_, qr[d0], P1, 0, 0, 0); } } while (0)
    f32x16 o[2]; o[0] = f32x16{}; o[1] = f32x16{};
    float mref = -INFINITY, l = 0.f;
#define A2_TILE(P0, P1, t, vs) do { \
        if ((t) == 0) { const int qlim_ = meta ? (r32 & 15) : NMETA - 1; _Pragma("unroll") for (int r = 0; r < 16; ++r) { if (crow(r, hi) > qlim_) P0[r] = -INFINITY; P1[r] = -INFINITY; } } \
        else { const int kt0_ = 64 * ((t) - 1); if (kt0_ + 63 > q0 + wid * 32) { _Pragma("unroll") for (int r = 0; r < 16; ++r) { const int kv = kt0_ + crow(r, hi); if (kv > qrel) P0[r] = -INFINITY; if (kv + 32 > qrel) P1[r] = -INFINITY; } } } \
        float rm_ = fmaxf(P0[0], P1[0]); \
        _Pragma("unroll") for (int r = 1; r < 16; ++r) rm_ = fmaxf(rm_, fmaxf(P0[r], P1[r])); \
        rm_ = pmax32(rm_); \
        if (__any(rm_ > mref + 8.0f)) { const float mnew = fmaxf(mref, rm_); const float f = __builtin_amdgcn_exp2f(mref - mnew); mref = mnew; l *= f; \
            if (hi == 0) wsf[r32] = f; LDS_WAIT(); \
            _Pragma("unroll") for (int r = 0; r < 16; ++r) { const float fr = wsf[crow(r, hi)]; o[0][r] *= fr; o[1][r] *= fr; } } \
        float sacc_ = 0.f; \
        _Pragma("unroll") for (int r = 0; r < 16; ++r) { P0[r] = __builtin_amdgcn_exp2f(P0[r] - mref); P1[r] = __builtin_amdgcn_exp2f(P1[r] - mref); sacc_ += P0[r] + P1[r]; } \
        l += sacc_; \
        u32x4 pw_[4]; \
        _Pragma("unroll") for (int i = 0; i < 4; ++i) { pw_[0][i] = cvtpk(P0[2 * i], P0[2 * i + 1]); pw_[1][i] = cvtpk(P0[8 + 2 * i], P0[8 + 2 * i + 1]); pw_[2][i] = cvtpk(P1[2 * i], P1[2 * i + 1]); pw_[3][i] = cvtpk(P1[8 + 2 * i], P1[8 + 2 * i + 1]); } \
        const LAS unsigned char* vb_ = lds + P_LDS_V + (vs) * VSLOT + ((lane >> 4) & 1) * 32 + (lane & 3) * 8 + (4 * hi + ((lane & 15) >> 2)) * 64; \
        _Pragma("unroll") for (int d0 = 0; d0 < 2; ++d0) _Pragma("unroll") for (int ks = 0; ks < 4; ++ks) { \
            const s16x4 vlo = vtr(vb_ + d0 * 4096 + ks * 1024), vhi = vtr(vb_ + d0 * 4096 + ks * 1024 + 512); \
            const bf16x8 vf = (bf16x8){vlo[0], vlo[1], vlo[2], vlo[3], vhi[0], vhi[1], vhi[2], vhi[3]}; \
            o[d0] = __builtin_amdgcn_mfma_f32_32x32x16_bf16(__builtin_bit_cast(bf16x8, pw_[ks]), vf, o[d0], 0, 0, 0); } } while (0)
    f32x16 pA0, pA1, pB0, pB1;
    A2_DMA_K(0, 0); A2_DMA_V(0, 0); if (NT >= 1) A2_DMA_K(1, 1);
    ATT_WAIT_BAR();
    A2_QKT(pA0, pA1, 0);
    int kc = 0, vc = 0, t = 0;
#define A2_STEP(PC0, PC1, PN0, PN1) do { \
        if (t > 0) ATT_WAIT_BAR(); \
        const int kn_ = kc == 2 ? 0 : kc + 1, k2_ = kn_ == 2 ? 0 : kn_ + 1; \
        if (t + 2 <= NT) A2_DMA_K(t + 2, k2_); \
        if (t + 1 <= NT) { A2_DMA_V(t + 1, vc ^ 1); A2_QKT(PN0, PN1, kn_); } \
        A2_TILE(PC0, PC1, t, vc); \
        kc = kn_; vc ^= 1; ++t; } while (0)
    while (t + 1 <= NT) { A2_STEP(pA0, pA1, pB0, pB1); A2_STEP(pB0, pB1, pA0, pA1); }
    A2_STEP(pA0, pA1, pB0, pB1);
    l = psum32(l);
    if (hi == 0) wsf[32 + r32] = l;
    LDS_WAIT();
    bf16* Ow = O + (size_t)(meta ? RMAIN + 16 * b : rowbase + q0 + wid * 32) * 1024 + h * 64;
    LAS bf16* stg = (LAS bf16*)(lds + P_LDS_OST) + wid * 2048;
#pragma unroll
    for (int r = 0; r < 16; ++r) { const int orow = crow(r, hi); const float il = 1.0f / wsf[32 + orow];
        stg[orow * 64 + r32] = (bf16)f2bf(o[0][r] * il); stg[orow * 64 + 32 + r32] = (bf16)f2bf(o[1][r] * il); }
    LDS_WAIT();
#pragma unroll
    for (int i = 0; i < 4; ++i) { const int row = i * 8 + (lane >> 3), ch = lane & 7; const u32x4 v = *(const LAS u32x4*)(stg + row * 64 + ch * 8); if (!meta || (wid == 0 && row < NMETA)) *(u32x4*)(Ow + (size_t)row * 1024 + ch * 8) = v; }
    ATT_WAIT_BAR();
#undef A2_ROW0
#undef A2_DMA_K
#undef A2_DMA_V
#undef A2_QKT
#undef A2_TILE
#undef A2_STEP
}
__device__ __forceinline__ void attn_phase(const bf16* QN, const bf16* QPE, const bf16* KNV, const bf16* KPE, bf16* O, LAS unsigned char* lds, int wave_id) {
    const int G = gridDim.x, bx = blockIdx.x; const int vcu = (G % 8 == 0) ? (bx % 8) * (G / 8) + bx / 8 : bx;
    for (int v = vcu; v < NB * NH * 4; v += G) {
        const int bh = v >> 2, s0 = v & 3;
#pragma unroll 1
        for (int i = 0; i < 4; ++i) { const int qb = (i == 0) ? 15 - s0 : (i == 1) ? 11 - s0 : (i == 2) ? 4 + s0 : s0; attn_unit2(bh >> 4, bh & 15, qb, QN, QPE, KNV, KPE, O, lds, wave_id); }
        if (v < NB * NH) attn_unit2(v >> 4, v & 15, -1, QN, QPE, KNV, KPE, O, lds, wave_id);
    }
}
}


namespace dec {
using att::bf16x8; using att::s16x4; using att::f32x16; using att::crow; using att::cvtpk; using att::vtr; using att::pmax32; using att::psum32;
constexpr int KST = 592, KBUF = 64 * KST, LDS_K = 0, LDS_Q = 2 * KBUF, LDS_WS = LDS_Q + 64 * KST, LDS_TOTAL = LDS_WS + 8 * 256;
constexpr int NSTAGE = 64;
__device__ __forceinline__ void decode_unit(int db, int sp, ArgsP a, LAS unsigned char* lds, int wave_id) {
    const int tid = fresh_tid(wave_id), lane = tid & 63, r32 = lane & 31, hi = lane >> 5; const int wid = wave_id;
    const int qh = wid & 1, kh = (wid >> 1) & 1, dh = wid >> 2;
    const float* cckv = IN_F(2); const float* ckpe = IN_F(3); const int* pt = (const int*)a->in[5] + db * NPAGES + sp * 32;
    for (int i = tid; i < 64 * 36; i += 512) { const int q = i / 36, ch = i % 36, t = q >> 4, h = q & 15;
        const bf16* src = ch < 32 ? WSB(WS_QLAT) + ((size_t)(db * 4 + t) * 16 + h) * 256 + ch * 8 : WSB(WS_QPE) + (size_t)(RSAMP0 + db * 4 + t) * 512 + h * 32 + (ch - 32) * 8;
        *(LAS u32x4*)(lds + LDS_Q + q * KST + ch * 16) = *(const u32x4*)src; }
    f32x4 cv[8], kv, cw[8], kw;
#define DEC_LOAD(CV, KV, s) do { const int page_ = __builtin_amdgcn_readfirstlane(pt[(s) >> 1]); const size_t k0_ = (size_t)page_ * PAGE + ((s) & 1) * 64; \
        _Pragma("unroll") for (int j = 0; j < 8; ++j) CV[j] = __builtin_nontemporal_load((const f32x4*)(cckv + (k0_ + wid + 8 * j) * 256 + 4 * lane));     \
        KV = __builtin_nontemporal_load((const f32x4*)(ckpe + (k0_ + (tid >> 3)) * 32 + 4 * (tid & 7))); } while (0)
#define DEC_WRITE(CV, KV, buf) do { LAS unsigned char* kb_ = lds + LDS_K + (buf) * KBUF; \
        _Pragma("unroll") for (int j = 0; j < 8; ++j) { u32x2 w_; w_.x = cvtpk(CV[j].x, CV[j].y); w_.y = cvtpk(CV[j].z, CV[j].w); *(LAS u32x2*)(kb_ + (wid + 8 * j) * KST + lane * 8) = w_; } \
        { u32x2 w_; w_.x = cvtpk(KV.x, KV.y); w_.y = cvtpk(KV.z, KV.w); *(LAS u32x2*)(kb_ + (tid >> 3) * KST + 512 + (tid & 7) * 8) = w_; } } while (0)
    LAS float* wsf = (LAS float*)(lds + LDS_WS) + wid * 64;
    f32x16 o[4]; o[0] = f32x16{}; o[1] = f32x16{}; o[2] = f32x16{}; o[3] = f32x16{};
    float mref = -INFINITY, l = 0.f;
#define DEC_BAR() asm volatile("s_waitcnt lgkmcnt(0)\n\ts_barrier" ::: "memory")
    DEC_LOAD(cv, kv, 0); DEC_WRITE(cv, kv, 0); DEC_LOAD(cv, kv, 1); DEC_LOAD(cw, kw, 2);
    DEC_BAR();
#define DEC_COMPUTE(BUF) do { \
        const LAS unsigned char* kimg = lds + LDS_K + (BUF) * KBUF; \
        f32x16 p = f32x16{}; \
        { const LAS unsigned char* kb = kimg + (kh * 32 + r32) * KST + hi * 16; const LAS unsigned char* qb = lds + LDS_Q + (qh * 32 + r32) * KST + hi * 16; \
        _Pragma("unroll") \
          for (int s2 = 0; s2 < 18; ++s2) p = __builtin_amdgcn_mfma_f32_32x32x16_bf16(*(const LAS bf16x8*)(kb + s2 * 32), *(const LAS bf16x8*)(qb + s2 * 32), p, 0, 0, 0); } \
        float rm = p[0]; \
        _Pragma("unroll") \
        for (int r = 1; r < 16; ++r) rm = fmaxf(rm, p[r]); \
        rm = pmax32(rm); \
        if (__any(rm > mref + 8.0f)) { \
            const float mnew = fmaxf(mref, rm); const float f = __builtin_amdgcn_exp2f(mref - mnew); \
            mref = mnew; l *= f; \
            if (hi == 0) wsf[r32] = f; \
            LDS_WAIT(); \
        _Pragma("unroll") \
            for (int r = 0; r < 16; ++r) { const float fr = wsf[crow(r, hi)]; o[0][r] *= fr; o[1][r] *= fr; o[2][r] *= fr; o[3][r] *= fr; } \
        } \
        float sacc = 0.f; \
        _Pragma("unroll") \
        for (int r = 0; r < 16; ++r) { p[r] = __builtin_amdgcn_exp2f(p[r] - mref); sacc += p[r]; } \
        l += sacc; \
        u32x4 pw[2]; \
        _Pragma("unroll") \
        for (int i = 0; i < 4; ++i) { pw[0][i] = cvtpk(p[2 * i], p[2 * i + 1]); pw[1][i] = cvtpk(p[8 + 2 * i], p[8 + 2 * i + 1]); } \
        const LAS unsigned char* vb = kimg + (kh * 32 + 4 * hi + ((lane & 15) >> 2)) * KST + (dh * 128 + 16 * ((lane >> 4) & 1) + 4 * (lane & 3)) * 2; \
        _Pragma("unroll") \
        for (int dt = 0; dt < 4; ++dt) \
        _Pragma("unroll") \
            for (int ks = 0; ks < 2; ++ks) { \
                const s16x4 vlo = vtr(vb + (ks * 16) * KST + dt * 64), vhi = vtr(vb + (ks * 16 + 8) * KST + dt * 64); \
                const bf16x8 vf = (bf16x8){vlo[0], vlo[1], vlo[2], vlo[3], vhi[0], vhi[1], vhi[2], vhi[3]}; \
                o[dt] = __builtin_amdgcn_mfma_f32_32x32x16_bf16(__builtin_bit_cast(bf16x8, pw[ks]), vf, o[dt], 0, 0, 0); \
            } \
    } while (0)
    static_assert(NSTAGE % 2 == 0, "stage loop is unrolled by two");
    for (int s = 0; s < NSTAGE; s += 2) {
        DEC_COMPUTE(0);
        DEC_WRITE(cv, kv, 1); DEC_LOAD(cv, kv, (s + 3 < NSTAGE ? s + 3 : NSTAGE - 1));
        DEC_BAR();
        DEC_COMPUTE(1);
        DEC_WRITE(cw, kw, 0); DEC_LOAD(cw, kw, (s + 4 < NSTAGE ? s + 4 : NSTAGE - 1));
        DEC_BAR();
    }
#undef DEC_COMPUTE
#undef DEC_BAR
    const int part = (db * 2 + sp) * 2 + kh;
    float* op = WSF(WS_OPART) + (size_t)part * 64 * 256;
#pragma unroll
    for (int dt = 0; dt < 4; ++dt)
#pragma unroll
        for (int r = 0; r < 16; ++r) op[(size_t)(qh * 32 + crow(r, hi)) * 256 + dh * 128 + dt * 32 + r32] = o[dt][r];
    l = psum32(l);
    if (dh == 0 && hi == 0) { float* mp = WSF(WS_MLP) + (size_t)part * 128 + (qh * 32 + r32) * 2; mp[0] = mref; mp[1] = l; }
#undef DEC_LOAD
#undef DEC_WRITE
}
struct LaneCtx { int lane, wave; };
__device__ __forceinline__ void combine_item(ArgsP a, int db, int h, const LaneCtx c, LAS unsigned char* lds) {
    {
        f32x4 cn[4]; float en[4];
#pragma unroll
        for (int s2 = 0; s2 < 4; ++s2) { const int kr = RSAMP0 + db * 4 + s2;
            const u32x2 v = *(const u32x2*)(WSB(WS_CKVN) + (size_t)kr * 256 + 4 * c.lane); cn[s2] = (f32x4){bflo(v.x), bfhi(v.x), bflo(v.y), bfhi(v.y)};
            en[s2] = c.lane < 32 ? bf2f(WSB(WS_KPE)[(size_t)kr * 32 + c.lane]) : 0.f; }
        f32x4 res[4];
#pragma unroll
        for (int t = 0; t < 4; ++t) {
            const int i = db * 4 + t, q = t * 16 + h;
            const u32x2 qv = *(const u32x2*)(WSB(WS_QLAT) + ((size_t)i * 16 + h) * 256 + 4 * c.lane); const f32x4 ql = (f32x4){bflo(qv.x), bfhi(qv.x), bflo(qv.y), bfhi(qv.y)};
            const float qp = c.lane < 32 ? bf2f(WSB(WS_QPE)[(size_t)(RSAMP0 + i) * 512 + h * 32 + c.lane]) : 0.f;
            float mp[4], lp[4], dn[4]; float mg = -INFINITY;
#pragma unroll
            for (int p = 0; p < 4; ++p) { const float* ml = WSF(WS_MLP) + (size_t)(db * 4 + p) * 128 + q * 2; mp[p] = ml[0]; lp[p] = ml[1]; mg = fmaxf(mg, mp[p]); }
#pragma unroll
            for (int s2 = 0; s2 < 4; ++s2) {
                float d = (ql.x * cn[s2].x + ql.y * cn[s2].y) + (ql.z * cn[s2].z + ql.w * cn[s2].w) + qp * en[s2];
                d = wave_sum(d); dn[s2] = s2 <= t ? d : -INFINITY; mg = fmaxf(mg, dn[s2]);
            }
            f32x4 acc = (f32x4){0.f, 0.f, 0.f, 0.f}; float L = 0.f;
#pragma unroll
            for (int p = 0; p < 4; ++p) { const float w = exp2f(mp[p] - mg); L += w * lp[p]; acc += w * *(const f32x4*)(WSF(WS_OPART) + ((size_t)(db * 4 + p) * 64 + q) * 256 + 4 * c.lane); }
#pragma unroll
            for (int s2 = 0; s2 < 4; ++s2) { const float w = exp2f(dn[s2] - mg); L += w; acc += w * cn[s2]; }
            res[t] = acc * (1.0f / L);
            __builtin_amdgcn_sched_barrier(0);
        }
        LAS bf16* rt = (LAS bf16*)(lds + 8 * 256 + c.wave * 2048);
#pragma unroll
        for (int t = 0; t < 4; ++t) { u32x2 w; w.x = pk2(res[t].x, res[t].y); w.y = pk2(res[t].z, res[t].w); *(LAS u32x2*)(rt + t * 256 + 4 * c.lane) = w; }
        LDS_WAIT();
        const int r32 = c.lane & 31, hi = c.lane >> 5;
        att::f32x16 o0 = att::f32x16{}, o1 = att::f32x16{};
        const bf16* wb = WSB(WS_WUKV) + (size_t)(1024 + h * 64 + r32) * 256 + 8 * hi;
#pragma unroll
        for (int s = 0; s < 16; ++s) {
            att::bf16x8 af = att::bf16x8{}; if (r32 < 4) af = *(const LAS att::bf16x8*)(rt + r32 * 256 + 16 * s + 8 * hi);
            const att::bf16x8 b0 = *(const att::bf16x8*)(wb + 16 * s), b1 = *(const att::bf16x8*)(wb + 32 * 256 + 16 * s);
            o0 = __builtin_amdgcn_mfma_f32_32x32x16_bf16(af, b0, o0, 0, 0, 0); o1 = __builtin_amdgcn_mfma_f32_32x32x16_bf16(af, b1, o1, 0, 0, 0);
        }
        if (hi == 0) {
#pragma unroll
            for (int t = 0; t < 4; ++t) { bf16* op = WSB(WS_O) + (size_t)(RSAMP0 + db * 4 + t) * 1024 + h * 64 + r32; op[0] = (bf16)f2bf(o0[t]); op[32] = (bf16)f2bf(o1[t]); }
        }
        LDS_WAIT();
    }
}
__device__ __forceinline__ void combine_phase(ArgsP a, const Ctx& c0, LAS unsigned char* lds) {
    const Ctx c = refresh(c0);
    for (int it = c.gw; it < DB * NH; it += c.ngw) combine_item(a, it >> 4, it & 15, LaneCtx{c.lane, c.wave}, lds);
}
__device__ __forceinline__ void decode_phase(ArgsP a, LAS unsigned char* lds, int wave_id) {
    for (int u = blockIdx.x; u < DB * 2; u += gridDim.x) { decode_unit(u >> 1, u & 1, a, lds, wave_id); __syncthreads(); }
}
}

__device__ __forceinline__ void p_side_tables(ArgsP a, const Ctx& c0, LAS unsigned char* lds, int wg0) {
    const Ctx c = refresh(c0);
    const int nwg = (int)gridDim.x - wg0, bx = (int)blockIdx.x - wg0;
    if (bx < 0) return;
    const int gt = (bx * 8 + c.wave) * 64 + c.lane, ngt = nwg * 512;
    {
        const int r32 = c.lane & 31, hi = c.lane >> 5;
        for (int it = bx * 8 + c.wave; it < NH * 64; it += nwg * 8) {
            const int h = it >> 6, ct = (it >> 3) & 7, kt = it & 7;
            const float* ap = IN_F(15) + (size_t)(ct * 32 + r32) * 1024 + h * 64 + 8 * hi;
            const float* bp = IN_F(13) + (size_t)(kt * 32 + r32) * 1536 + h * 96 + 8 * hi;
            att::f32x16 acc = att::f32x16{};
#pragma unroll
            for (int s = 0; s < 4; ++s) {
                const f32x4 a0 = *(const f32x4*)(ap + 16 * s), a1 = *(const f32x4*)(ap + 16 * s + 4), b0 = *(const f32x4*)(bp + 16 * s), b1 = *(const f32x4*)(bp + 16 * s + 4);
                const u32x4 aw = (u32x4){pk2(a0.x, a0.y), pk2(a0.z, a0.w), pk2(a1.x, a1.y), pk2(a1.z, a1.w)}, bw = (u32x4){pk2(b0.x, b0.y), pk2(b0.z, b0.w), pk2(b1.x, b1.y), pk2(b1.z, b1.w)};
                acc = __builtin_amdgcn_mfma_f32_32x32x16_bf16(__builtin_bit_cast(att::bf16x8, aw), __builtin_bit_cast(att::bf16x8, bw), acc, 0, 0, 0);
            }
            bf16* op = WSB(WS_WUQL) + (size_t)(h * 256 + ct * 32) * 256 + kt * 32 + r32;
#pragma unroll
            for (int r = 0; r < 16; ++r) op[(size_t)att::crow(r, hi) * 256] = (bf16)f2bf(acc[r]);
        }
    }
}
__device__ __forceinline__ void p_mla_mid(ArgsP a, const Ctx& c0) {
    const Ctx c = refresh(c0);
    const float* A1 = WSF(WS_A1); bf16* CQN = WSB(WS_CQN); bf16* CKVN = WSB(WS_CKVN); bf16* KPEB = WSB(WS_KPE); const float* ROPE = WSF(WS_ROPE); float* out = a->out;
    const f32x4 gq = *(const f32x4*)(IN_F(12) + 4 * c.lane), gk = *(const f32x4*)(IN_F(14) + 4 * c.lane);
    constexpr int NR = 4;
    for (int r0 = c.gw; r0 < R; r0 += NR * c.ngw) {
        f32x4 cq[NR], ck[NR]; float sq[NR], sk[NR], x1[NR], x2[NR], cs[NR], sn[NR];
#pragma unroll
        for (int q = 0; q < NR; ++q) { const int r = r0 + q * c.ngw < R ? r0 + q * c.ngw : r0; const float* row = A1 + (size_t)r * NIN0;
            cq[q] = *(const f32x4*)(row + 4 * c.lane); ck[q] = *(const f32x4*)(row + 256 + 4 * c.lane);
            const int j = c.lane & 15; x1[q] = row[512 + j]; x2[q] = row[528 + j]; cs[q] = ROPE[(size_t)r * 32 + j]; sn[q] = ROPE[(size_t)r * 32 + 16 + j];
            sq[q] = (cq[q].x * cq[q].x + cq[q].y * cq[q].y) + (cq[q].z * cq[q].z + cq[q].w * cq[q].w); sk[q] = (ck[q].x * ck[q].x + ck[q].y * ck[q].y) + (ck[q].z * ck[q].z + ck[q].w * ck[q].w); }
#pragma unroll
        for (int sh = 1; sh < 64; sh <<= 1) {
#pragma unroll
            for (int q = 0; q < NR; ++q) { sq[q] += __shfl_xor(sq[q], sh); sk[q] += __shfl_xor(sk[q], sh); } }
#pragma unroll
        for (int q = 0; q < NR; ++q) { const int r = r0 + q * c.ngw < R ? r0 + q * c.ngw : r0; const int pos = row_pos(r);
            const float rq = 1.0f / sqrtf(sq[q] * (1.f / 256) + EPS), rk = 1.0f / sqrtf(sk[q] * (1.f / 256) + EPS);
            const f32x4 qn = cq[q] * rq * gq, kn = ck[q] * rk * gk;
            u32x2 o; o.x = pk2(qn.x, qn.y); o.y = pk2(qn.z, qn.w); *(u32x2*)(CQN + (size_t)r * 256 + 4 * c.lane) = o;
            o.x = pk2(kn.x, kn.y); o.y = pk2(kn.z, kn.w); *(u32x2*)(CKVN + (size_t)r * 256 + 4 * c.lane) = o;
            float* ockv; float* okpe;
            if (r < RSAMP0) { const int b = r < RMAIN ? (r >> 12) : ((r - RMAIN) >> 4); ockv = out + O_CKVP + ((size_t)b * TP + pos) * 256; okpe = out + O_KPEP + ((size_t)b * TP + pos) * 32; }
            else { ockv = out + O_CKVS + (size_t)(r - RSAMP0) * 256; okpe = out + O_KPES + (size_t)(r - RSAMP0) * 32; }
            *(f32x4*)(ockv + 4 * c.lane) = kn;
            if (c.lane < 16) { const int j = c.lane; const float o1 = x1[q] * cs[q] - x2[q] * sn[q], o2 = x1[q] * sn[q] + x2[q] * cs[q]; okpe[j] = o1; okpe[16 + j] = o2;
                KPEB[(size_t)r * 32 + j] = (bf16)f2bf(o1); KPEB[(size_t)r * 32 + 16 + j] = (bf16)f2bf(o2); } }
    }
}
__device__ __forceinline__ void p_q_post(ArgsP a, const Ctx& c0) {
    const Ctx c = refresh(c0);
    for (int r = c.gw; r < R; r += c.ngw) {
        const float* row = WSF(WS_QRAW) + (size_t)r * NUQ; const int pos = row_pos(r);
        const float qs = QSCALE;
#pragma unroll
        for (int j = 0; j < 4; ++j) { const f32x4 v = *(const f32x4*)(row + 4 * c.lane + 256 * j) * qs; u32x2 o; o.x = pk2(v.x, v.y); o.y = pk2(v.z, v.w); *(u32x2*)(WSB(WS_QN) + (size_t)r * 1024 + 4 * c.lane + 256 * j) = o; }
#pragma unroll
        for (int j = 0; j < 4; ++j) { const int p = c.lane + 64 * j, h = p >> 4, jj = p & 15; const float x1 = row[1024 + 2 * p], x2 = row[1024 + 2 * p + 1]; float cs, sn; rope_cs(pos, jj, cs, sn);
            WSB(WS_QPE)[(size_t)r * 512 + h * 32 + jj] = (bf16)f2bf((x1 * cs - x2 * sn) * qs); WSB(WS_QPE)[(size_t)r * 512 + h * 32 + 16 + jj] = (bf16)f2bf((x1 * sn + x2 * cs) * qs); }
    }
}
__device__ __forceinline__ void p_qlat(ArgsP a, const Ctx& c0) {
    const Ctx c = refresh(c0);
    const float* wuk = IN_F(15);
    for (int it = c.gw; it < DB * DS * NH; it += c.ngw) {
        const int i = it >> 4, h = it & 15;
        const float q = WSF(WS_QRAW)[(size_t)(RSAMP0 + i) * NUQ + h * 64 + c.lane];
        float acc[4] = {0.f, 0.f, 0.f, 0.f};
#pragma unroll 8
        for (int n = 0; n < 64; ++n) { const float qn = __shfl(q, n);
#pragma unroll
            for (int k = 0; k < 4; ++k) acc[k] += qn * wuk[(size_t)(c.lane + 64 * k) * 1024 + h * 64 + n]; }
#pragma unroll
        for (int k = 0; k < 4; ++k) WSB(WS_QLAT)[((size_t)i * 16 + h) * 256 + c.lane + 64 * k] = (bf16)f2bf(acc[k] * QSCALE);
    }
}
template <bool META_ONLY>
__device__ __forceinline__ void p_attn_prompt_naive(ArgsP a, const Ctx& c0) {
    const Ctx c = refresh(c0);
    const bf16* QN = WSB(WS_QN); const bf16* QPE = WSB(WS_QPE); const bf16* KNV = WSB(WS_KNV); const bf16* KPE = WSB(WS_KPE);
    for (int item = c.gw + (META_ONLY ? (RMAIN / 64) * NH : 0); item < (RPROMPT / 64) * NH; item += c.ngw) {
        const int rb = item >> 4, h = item & 15, r = rb * 64 + c.lane;
        int b, nk;
        if (r < RMAIN) { b = r >> 12; nk = NMETA + (r & 4095) + 1; } else { const int i = r - RMAIN; b = i >> 4; nk = (i & 15) + 1; }
        const int mbase = RMAIN + 16 * b, tbase = 4096 * b;
        float qn[64], qp[32], o[64];
#pragma unroll
        for (int j = 0; j < 8; ++j) { const u32x4 v = *(const u32x4*)(QN + (size_t)r * 1024 + h * 64 + 8 * j);
            qn[8 * j] = bflo(v.x); qn[8 * j + 1] = bfhi(v.x); qn[8 * j + 2] = bflo(v.y); qn[8 * j + 3] = bfhi(v.y); qn[8 * j + 4] = bflo(v.z); qn[8 * j + 5] = bfhi(v.z); qn[8 * j + 6] = bflo(v.w); qn[8 * j + 7] = bfhi(v.w); }
#pragma unroll
        for (int j = 0; j < 4; ++j) { const u32x4 v = *(const u32x4*)(QPE + (size_t)r * 512 + h * 32 + 8 * j);
            qp[8 * j] = bflo(v.x); qp[8 * j + 1] = bfhi(v.x); qp[8 * j + 2] = bflo(v.y); qp[8 * j + 3] = bfhi(v.y); qp[8 * j + 4] = bflo(v.z); qp[8 * j + 5] = bfhi(v.z); qp[8 * j + 6] = bflo(v.w); qp[8 * j + 7] = bfhi(v.w); }
#pragma unroll
        for (int j = 0; j < 64; ++j) o[j] = 0.f;
        float m = -INFINITY, l = 0.f;
        const int nkmax = wave_max_i(nk);
        for (int kk = 0; kk < nkmax; ++kk) {
            if (kk < nk) {
                const int kr = kk < NMETA ? mbase + kk : tbase + kk - NMETA;
                const bf16* kn = KNV + (size_t)kr * 2048 + h * 64; const bf16* kp = KPE + (size_t)kr * 32; const bf16* vv = kn + 1024;
                float s = 0.f;
#pragma unroll
                for (int j = 0; j < 8; ++j) { const u32x4 v = *(const u32x4*)(kn + 8 * j);
                    s += qn[8 * j] * bflo(v.x) + qn[8 * j + 1] * bfhi(v.x) + qn[8 * j + 2] * bflo(v.y) + qn[8 * j + 3] * bfhi(v.y) + qn[8 * j + 4] * bflo(v.z) + qn[8 * j + 5] * bfhi(v.z) + qn[8 * j + 6] * bflo(v.w) + qn[8 * j + 7] * bfhi(v.w); }
#pragma unroll
                for (int j = 0; j < 4; ++j) { const u32x4 v = *(const u32x4*)(kp + 8 * j);
                    s += qp[8 * j] * bflo(v.x) + qp[8 * j + 1] * bfhi(v.x) + qp[8 * j + 2] * bflo(v.y) + qp[8 * j + 3] * bfhi(v.y) + qp[8 * j + 4] * bflo(v.z) + qp[8 * j + 5] * bfhi(v.z) + qp[8 * j + 6] * bflo(v.w) + qp[8 * j + 7] * bfhi(v.w); }
                const float mn = fmaxf(m, s), corr = exp2f(m - mn), p = exp2f(s - mn);
                l = l * corr + p; m = mn;
#pragma unroll
                for (int j = 0; j < 8; ++j) { const u32x4 v = *(const u32x4*)(vv + 8 * j);
                    o[8 * j] = o[8 * j] * corr + p * bflo(v.x); o[8 * j + 1] = o[8 * j + 1] * corr + p * bfhi(v.x); o[8 * j + 2] = o[8 * j + 2] * corr + p * bflo(v.y); o[8 * j + 3] = o[8 * j + 3] * corr + p * bfhi(v.y);
                    o[8 * j + 4] = o[8 * j + 4] * corr + p * bflo(v.z); o[8 * j + 5] = o[8 * j + 5] * corr + p * bfhi(v.z); o[8 * j + 6] = o[8 * j + 6] * corr + p * bflo(v.w); o[8 * j + 7] = o[8 * j + 7] * corr + p * bfhi(v.w); }
            }
        }
        const float il = 1.0f / l;
#pragma unroll
        for (int j = 0; j < 8; ++j) { u32x4 w; w.x = pk2(o[8 * j] * il, o[8 * j + 1] * il); w.y = pk2(o[8 * j + 2] * il, o[8 * j + 3] * il); w.z = pk2(o[8 * j + 4] * il, o[8 * j + 5] * il); w.w = pk2(o[8 * j + 6] * il, o[8 * j + 7] * il);
            *(u32x4*)(WSB(WS_O) + (size_t)r * 1024 + h * 64 + 8 * j) = w; }
    }
}
__device__ __forceinline__ void p_attn_decode_naive(ArgsP a, const Ctx& c0) {
    const Ctx c = refresh(c0);
    const float* cckv = IN_F(2); const float* ckpe = IN_F(3); const int* pt = (const int*)a->in[5];
    for (int item = c.gw; item < DB * NH; item += c.ngw) {
        const int db = item >> 4, h = item & 15;
        f32x4 ql[4]; float qp[4], m[4], l[4]; f32x4 o[4];
#pragma unroll
        for (int t = 0; t < 4; ++t) { const u32x2 v = *(const u32x2*)(WSB(WS_QLAT) + ((size_t)(db * 4 + t) * 16 + h) * 256 + 4 * c.lane);
            ql[t] = (f32x4){bflo(v.x), bfhi(v.x), bflo(v.y), bfhi(v.y)};
            qp[t] = c.lane < 32 ? bf2f(WSB(WS_QPE)[(size_t)(RSAMP0 + db * 4 + t) * 512 + h * 32 + c.lane]) : 0.f;
            m[t] = -INFINITY; l[t] = 0.f; o[t] = (f32x4){0.f, 0.f, 0.f, 0.f}; }
        for (int p = 0; p < NPAGES; ++p) {
            const int page = pt[db * NPAGES + p];
            for (int k = 0; k < PAGE; ++k) {
                const size_t kr = (size_t)page * PAGE + k;
                const f32x4 cv = *(const f32x4*)(cckv + kr * 256 + 4 * c.lane); const float e = c.lane < 32 ? ckpe[kr * 32 + c.lane] : 0.f;
#pragma unroll
                for (int t = 0; t < 4; ++t) {
                    float d = (ql[t].x * cv.x + ql[t].y * cv.y) + (ql[t].z * cv.z + ql[t].w * cv.w) + qp[t] * e;
                    d = wave_sum(d);
                    const float mn = fmaxf(m[t], d), corr = exp2f(m[t] - mn), pp = exp2f(d - mn);
                    l[t] = l[t] * corr + pp; m[t] = mn; o[t] = o[t] * corr + pp * cv;
                }
            }
        }
#pragma unroll
        for (int s2 = 0; s2 < 4; ++s2) {
            const int kr = RSAMP0 + db * 4 + s2;
            const u32x2 v = *(const u32x2*)(WSB(WS_CKVN) + (size_t)kr * 256 + 4 * c.lane); const f32x4 cv = (f32x4){bflo(v.x), bfhi(v.x), bflo(v.y), bfhi(v.y)};
            const float e = c.lane < 32 ? bf2f(WSB(WS_KPE)[(size_t)kr * 32 + c.lane]) : 0.f;
#pragma unroll
            for (int t = 0; t < 4; ++t) if (t >= s2) {
                float d = (ql[t].x * cv.x + ql[t].y * cv.y) + (ql[t].z * cv.z + ql[t].w * cv.w) + qp[t] * e;
                d = wave_sum(d);
                const float mn = fmaxf(m[t], d), corr = exp2f(m[t] - mn), pp = exp2f(d - mn);
                l[t] = l[t] * corr + pp; m[t] = mn; o[t] = o[t] * corr + pp * cv;
            }
        }
#pragma unroll
        for (int t = 0; t < 4; ++t) *(f32x4*)(WSF(WS_OLAT) + ((size_t)(db * 4 + t) * 16 + h) * 256 + 4 * c.lane) = o[t] * (1.0f / l[t]);
    }
}
__device__ __forceinline__ void p_olat_up(ArgsP a, const Ctx& c0) {
    const Ctx c = refresh(c0);
    const float* wuv = IN_F(16);
    for (int it = c.gw; it < DB * DS * NH; it += c.ngw) {
        const int i = it >> 4, h = it & 15; const float* ol = WSF(WS_OLAT) + ((size_t)i * 16 + h) * 256;
        float acc = 0.f;
#pragma unroll 8
        for (int cc = 0; cc < 256; ++cc) acc += ol[cc] * wuv[(size_t)cc * 1024 + h * 64 + c.lane];
        WSB(WS_O)[(size_t)(RSAMP0 + i) * 1024 + h * 64 + c.lane] = (bf16)f2bf(acc);
    }
}
template <bool FINAL, int NSPLIT, bool FIRST = false>
__device__ __forceinline__ void p_post_res(ArgsP a, const Ctx& c0, const float* gpost, const float* gnext) {
    const Ctx c = refresh(c0);
    const bf16* Mb = WSB(WS_M); bf16* X = WSB(WS_X); bf16* H = WSB(WS_H); const float* MT = WSF(WS_MT); const float* xin = IN_F(0); float* out = a->out;
    f32x4 gp[4], gn[4];
#pragma unroll
    for (int j = 0; j < 4; ++j) { gp[j] = *(const f32x4*)(gpost + 4 * c.lane + 256 * j); gn[j] = FINAL ? gp[j] : *(const f32x4*)(gnext + 4 * c.lane + 256 * j); }
    constexpr int NR = 4;
    for (int r0 = c.gw; r0 < RMAIN; r0 += NR * c.ngw) {
        f32x4 mv[NR][4], xv[NR][4]; float s[NR], s2[NR];
#pragma unroll
        for (int q = 0; q < NR; ++q) { const int r = r0 + q * c.ngw < RMAIN ? r0 + q * c.ngw : r0;
            s[q] = 0.f;
#pragma unroll
            for (int j = 0; j < 4; ++j) { const u32x2 mb = __builtin_nontemporal_load((const u32x2*)(Mb + (size_t)r * D + 4 * c.lane + 256 * j)); mv[q][j] = (f32x4){bflo(mb.x), bfhi(mb.x), bflo(mb.y), bfhi(mb.y)};
                if (FIRST) xv[q][j] = *(const f32x4*)(xin + (size_t)r * D + 4 * c.lane + 256 * j); else { const u32x2 xb = *(const u32x2*)(X + (size_t)r * D + 4 * c.lane + 256 * j); xv[q][j] = (f32x4){bflo(xb.x), bfhi(xb.x), bflo(xb.y), bfhi(xb.y)}; }
                s[q] += (mv[q][j].x * mv[q][j].x + mv[q][j].y * mv[q][j].y) + (mv[q][j].z * mv[q][j].z + mv[q][j].w * mv[q][j].w); } }
#pragma unroll
        for (int o = 1; o < 64; o <<= 1) {
#pragma unroll
            for (int q = 0; q < NR; ++q) s[q] += __shfl_xor(s[q], o); }
#pragma unroll
        for (int q = 0; q < NR; ++q) { const float rm = 1.0f / sqrtf(s[q] * (1.f / D) + EPS); s2[q] = 0.f;
#pragma unroll
            for (int j = 0; j < 4; ++j) { xv[q][j] = xv[q][j] + mv[q][j] * rm * gp[j]; s2[q] += (xv[q][j].x * xv[q][j].x + xv[q][j].y * xv[q][j].y) + (xv[q][j].z * xv[q][j].z + xv[q][j].w * xv[q][j].w); } }
        if (!FINAL) {
#pragma unroll
            for (int o = 1; o < 64; o <<= 1) {
#pragma unroll
                for (int q = 0; q < NR; ++q) s2[q] += __shfl_xor(s2[q], o); }
        }
#pragma unroll
        for (int q = 0; q < NR; ++q) { const int r = r0 + q * c.ngw < RMAIN ? r0 + q * c.ngw : r0;
            if (FINAL) {
#pragma unroll
                for (int j = 0; j < 4; ++j) __builtin_nontemporal_store(xv[q][j], (f32x4*)(out + O_YP + (size_t)r * D + 4 * c.lane + 256 * j));
            } else { const float rx = 1.0f / sqrtf(s2[q] * (1.f / D) + EPS);
#pragma unroll
                for (int j = 0; j < 4; ++j) { u32x2 xo; xo.x = pk2(xv[q][j].x, xv[q][j].y); xo.y = pk2(xv[q][j].z, xv[q][j].w); *(u32x2*)(X + (size_t)r * D + 4 * c.lane + 256 * j) = xo;
                    u32x2 o; o.x = pk2(xv[q][j].x * rx * gn[j].x, xv[q][j].y * rx * gn[j].y); o.y = pk2(xv[q][j].z * rx * gn[j].z, xv[q][j].w * rx * gn[j].w); *(u32x2*)(H + (size_t)r * D + 4 * c.lane + 256 * j) = o; } } }
    }
    for (int r = RMAIN + c.gw; r < R; r += c.ngw) {
        bf16* xrow = X + (size_t)r * D;
        f32x4 mv[4], xv[4]; float s = 0.f;
#pragma unroll
        for (int j = 0; j < 4; ++j) { mv[j] = (f32x4){0.f, 0.f, 0.f, 0.f};
#pragma unroll
            for (int h8 = 0; h8 < NSPLIT; h8 += 8) { f32x4 part[8];
#pragma unroll
                for (int sp = 0; sp < 8; ++sp) part[sp] = *(const f32x4*)(MT + ((size_t)(h8 + sp) * (RP - RMAIN) + (r - RMAIN)) * D + 4 * c.lane + 256 * j);
#pragma unroll
                for (int sp = 0; sp < 8; ++sp) mv[j] += part[sp]; }
            { const u32x2 xb = *(const u32x2*)(xrow + 4 * c.lane + 256 * j); xv[j] = (f32x4){bflo(xb.x), bfhi(xb.x), bflo(xb.y), bfhi(xb.y)}; } s += (mv[j].x * mv[j].x + mv[j].y * mv[j].y) + (mv[j].z * mv[j].z + mv[j].w * mv[j].w); }
        const float rm = 1.0f / sqrtf(wave_sum(s) * (1.f / D) + EPS); float s2 = 0.f;
#pragma unroll
        for (int j = 0; j < 4; ++j) { xv[j] = xv[j] + mv[j] * rm * gp[j]; s2 += (xv[j].x * xv[j].x + xv[j].y * xv[j].y) + (xv[j].z * xv[j].z + xv[j].w * xv[j].w); }
        if (FINAL) {
            if (r < RSAMP0) continue;
#pragma unroll
            for (int j = 0; j < 4; ++j) *(f32x4*)(out + O_YS + (size_t)(r - RSAMP0) * D + 4 * c.lane + 256 * j) = xv[j];
        } else {
            const float rx = 1.0f / sqrtf(wave_sum(s2) * (1.f / D) + EPS);
#pragma unroll
            for (int j = 0; j < 4; ++j) { u32x2 xo; xo.x = pk2(xv[j].x, xv[j].y); xo.y = pk2(xv[j].z, xv[j].w); *(u32x2*)(xrow + 4 * c.lane + 256 * j) = xo;
                u32x2 o; o.x = pk2(xv[j].x * rx * gn[j].x, xv[j].y * rx * gn[j].y); o.y = pk2(xv[j].z * rx * gn[j].z, xv[j].w * rx * gn[j].w); *(u32x2*)(H + (size_t)r * D + 4 * c.lane + 256 * j) = o; }
        }
    }
}

__device__ __forceinline__ void p_gate(ArgsP a, const Ctx& c0) {
    const Ctx c = refresh(c0);
    const float* wg = IN_F(19); const float* bg = IN_F(20);
    const size_t gt = (size_t)c.gw * 64 + c.lane, ngt = (size_t)c.ngw * 64;
    for (size_t i = gt + (size_t)(USE_NAIVE_GLA ? 0 : RSAMP0) * 512; i < (size_t)R * 512; i += ngt) {
        const int r = (int)(i >> 9), col = (int)(i & 511); const float* gd = WSF(WS_GD) + (size_t)r * 16;
        float x = bg[col];
#pragma unroll
        for (int j = 0; j < 16; ++j) x += gd[j] * wg[j * 512 + col];
        const float ls = fminf(x, 0.f) - log1pf(__expf(-fabsf(x)));
        const float la = ls * (1.0f / 16.0f);
        WSF(WS_LA)[i] = la; WSF(WS_EA)[i] = __expf(la);
    }
}
__device__ __forceinline__ void gla_step(float (&S)[128], float& o, float a0, float a1, float k0, float k1, float q0, float q1, float v) {
    o = 0.f;
#pragma unroll
    for (int d = 0; d < 64; ++d) { const float ad = rdlane(a0, d), kd = rdlane(k0, d), qd = rdlane(q0, d); S[d] = ad * S[d] + kd * v; o += qd * S[d]; }
#pragma unroll
    for (int d = 0; d < 64; ++d) { const float ad = rdlane(a1, d), kd = rdlane(k1, d), qd = rdlane(q1, d); S[64 + d] = ad * S[64 + d] + kd * v; o += qd * S[64 + d]; }
}
__device__ __forceinline__ void p_gla_naive(ArgsP a, const Ctx& c0) {
    const Ctx c = refresh(c0);
    const float* EA = WSF(WS_EA); const bf16* KG = WSB(WS_KG); const bf16* QG = WSB(WS_QG); const bf16* VG = WSB(WS_VG); float* OGR = WSF(WS_OGRAW);
    for (int item = c.gwT; item < (USE_NAIVE_GLA ? NB * GH * 4 : 0); item += c.ngw) {
        const int b = item >> 4, h = (item >> 2) & 3, dv = (item & 3) * 64 + c.lane;
        float S[128];
#pragma unroll
        for (int d = 0; d < 128; ++d) S[d] = 0.f;
        for (int tt = 0; tt < TP; ++tt) {
            const int row = tt < NMETA ? RMAIN + 16 * b + tt : 4096 * b + tt - NMETA;
            const size_t g = (size_t)row * 512 + h * 128;
            const float a0 = EA[g + c.lane], a1 = EA[g + 64 + c.lane], k0 = bf2f(KG[g + c.lane]), k1 = bf2f(KG[g + 64 + c.lane]), q0 = bf2f(QG[g + c.lane]), q1 = bf2f(QG[g + 64 + c.lane]);
            const float v = bf2f(VG[(size_t)row * 1024 + h * 256 + dv]);
            float o; gla_step(S, o, a0, a1, k0, k1, q0, q1, v);
            OGR[(size_t)row * 1024 + h * 256 + dv] = o;
        }
        float* outp = a->out + O_GLAP + ((size_t)(b * 4 + h) * 128) * 256 + dv;
#pragma unroll
        for (int d = 0; d < 128; ++d) outp[(size_t)d * 256] = S[d];
    }
    const int wg0 = USE_NAIVE_GLA ? 0 : NB * GH * gla::NSP; if ((int)blockIdx.x < wg0) return;
    for (int item = c.wave * ((int)gridDim.x - wg0) + ((int)blockIdx.x - wg0); item < DB * GH * 4; item += c.ngw - wg0 * 8) {
        const int db = item >> 4, h = (item >> 2) & 3, dv = (item & 3) * 64 + c.lane;
        const float* sp = IN_F(4) + ((size_t)(db * 4 + h) * 128) * 256 + dv;
        float S[128];
#pragma unroll
        for (int d = 0; d < 128; ++d) S[d] = sp[(size_t)d * 256];
#pragma unroll 1
        for (int s = 0; s < DS; ++s) {
            const int row = RSAMP0 + db * 4 + s; const size_t g = (size_t)row * 512 + h * 128;
            const float a0 = EA[g + c.lane], a1 = EA[g + 64 + c.lane], k0 = bf2f(KG[g + c.lane]), k1 = bf2f(KG[g + 64 + c.lane]), q0 = bf2f(QG[g + c.lane]), q1 = bf2f(QG[g + 64 + c.lane]);
            const float v = bf2f(VG[(size_t)row * 1024 + h * 256 + dv]);
            float o; gla_step(S, o, a0, a1, k0, k1, q0, q1, v);
            OGR[(size_t)row * 1024 + h * 256 + dv] = o;
        }
        float* outp = a->out + O_GLAS + ((size_t)(db * 4 + h) * 128) * 256 + dv;
#pragma unroll
        for (int d = 0; d < 128; ++d) outp[(size_t)d * 256] = S[d];
    }
}
__device__ __forceinline__ void p_gla_post(ArgsP a, const Ctx& c0) {
    const Ctx c = refresh(c0);
    const bf16* OGR = WSB(WS_OGRAW); const bf16* RG = WSB(WS_RG); bf16* OG = WSB(WS_OG);
    const f32x4 g = *(const f32x4*)(IN_F(21) + 4 * c.lane);
    constexpr int NR = 2;
    for (int r0 = c.gw; r0 < R; r0 += NR * c.ngw) {
        f32x4 o[NR][4]; u32x2 rv[NR][4]; float s[NR][4];
#pragma unroll
        for (int q = 0; q < NR; ++q) { const int r = r0 + q * c.ngw < R ? r0 + q * c.ngw : r0;
#pragma unroll
            for (int h = 0; h < 4; ++h) { const size_t off = (size_t)r * 1024 + h * 256 + 4 * c.lane;
                const u32x2 ob = __builtin_nontemporal_load((const u32x2*)(OGR + ((size_t)(h * 8 + (c.lane >> 3)) * RP + r) * 32 + 4 * (c.lane & 7))); o[q][h] = (f32x4){bflo(ob.x), bfhi(ob.x), bflo(ob.y), bfhi(ob.y)}; rv[q][h] = __builtin_nontemporal_load((const u32x2*)(RG + off));
                s[q][h] = (o[q][h].x * o[q][h].x + o[q][h].y * o[q][h].y) + (o[q][h].z * o[q][h].z + o[q][h].w * o[q][h].w); } }
#pragma unroll
        for (int sh = 1; sh < 64; sh <<= 1) {
#pragma unroll
            for (int q = 0; q < NR; ++q)
#pragma unroll
                for (int h = 0; h < 4; ++h) s[q][h] += __shfl_xor(s[q][h], sh); }
#pragma unroll
        for (int q = 0; q < NR; ++q) { const int r = r0 + q * c.ngw < R ? r0 + q * c.ngw : r0;
#pragma unroll
            for (int h = 0; h < 4; ++h) { const size_t off = (size_t)r * 1024 + h * 256 + 4 * c.lane;
                const float rs = 1.0f / sqrtf(s[q][h] * (1.f / 256) + EPS);
                const f32x4 rr = (f32x4){bflo(rv[q][h].x), bfhi(rv[q][h].x), bflo(rv[q][h].y), bfhi(rv[q][h].y)};
                f32x4 sl; sl.x = rr.x / (1.f + __expf(-rr.x)); sl.y = rr.y / (1.f + __expf(-rr.y)); sl.z = rr.z / (1.f + __expf(-rr.z)); sl.w = rr.w / (1.f + __expf(-rr.w));
                const f32x4 y = o[q][h] * rs * g * sl;
                u32x2 w; w.x = pk2(y.x, y.y); w.y = pk2(y.z, y.w); *(u32x2*)(OG + off) = w; } }
    }
}


namespace gla {
using att::bf16x8; using att::f32x16; using att::crow; using att::cvtpk;
constexpr int NCH = 65, NITEM = NB * GH * NCH;
constexpr int P_GD = 0, P_GSUM = 4096, P_QL = 6144, P_KL = P_QL + 64 * 272, P_VS = P_KL + 64 * 272, P_AL = P_VS + 64 * 528, P_END = P_AL + 64 * 144;
__device__ __forceinline__ int chunk_row(int b, int c, int tok) { return c == 0 ? RMAIN + 16 * b + tok : 4096 * b + 64 * (c - 1) + tok; }
__device__ __forceinline__ float logsig16(float x) { return (fminf(x, 0.f) - __logf(1.0f + __expf(-fabsf(x)))) * (1.0f / 16.0f); }
__device__ __forceinline__ void prep_item(ArgsP a, int item, LAS unsigned char* lds, int wave_id) {
    const int tid = fresh_tid(wave_id), lane = tid & 63, r32 = lane & 31, hi = lane >> 5; const int wid = wave_id;
    const int bh = item / NCH, c = item % NCH, b = bh >> 2, h = bh & 3;
    const int nvalid = c == 0 ? NMETA : 64;
    bf16* QINF = WSB(WS_QINF) + (size_t)item * 8192; bf16* KDTF = WSB(WS_KDTF) + (size_t)item * 8192; bf16* AMF = WSB(WS_AMF) + (size_t)item * 4096; bf16* VTF = WSB(WS_VTF) + (size_t)item * 16384; float* ELF = WSF(WS_ELF) + (size_t)item * 256;
    LAS float* GDL = (LAS float*)(lds + P_GD); LAS float* GSUM = (LAS float*)(lds + P_GSUM); LAS bf16* QL = (LAS bf16*)(lds + P_QL); LAS bf16* KL = (LAS bf16*)(lds + P_KL); LAS bf16* VS = (LAS bf16*)(lds + P_VS); LAS bf16* AL = (LAS bf16*)(lds + P_AL);
    const u32x4 z4 = (u32x4){0u, 0u, 0u, 0u};
#pragma unroll
    for (int j = 0; j < 2; ++j) { const int idx = tid + 512 * j, row = idx >> 4, ch = idx & 15; const bool ok = row < nvalid; const size_t g = (size_t)chunk_row(b, c, ok ? row : 0) * 512 + h * 128 + ch * 8;
        *(LAS u32x4*)(QL + row * 136 + ch * 8) = ok ? __builtin_nontemporal_load((const u32x4*)(WSB(WS_QG) + g)) : z4; *(LAS u32x4*)(KL + row * 136 + ch * 8) = ok ? __builtin_nontemporal_load((const u32x4*)(WSB(WS_KG) + g)) : z4; }
#pragma unroll
    for (int j = 0; j < 4; ++j) { const int idx = tid + 512 * j, row = idx >> 5, ch = idx & 31; const bool ok = row < nvalid;
        *(LAS u32x4*)(VS + row * 264 + ch * 8) = ok ? __builtin_nontemporal_load((const u32x4*)(WSB(WS_VG) + (size_t)chunk_row(b, c, ok ? row : 0) * 1024 + h * 256 + ch * 8)) : z4; }
    if (tid < 256) { const int row = tid >> 2, ch = tid & 3; const bool ok = row < nvalid; *(LAS f32x4*)(GDL + row * 16 + ch * 4) = ok ? *(const f32x4*)(WSF(WS_GD) + (size_t)chunk_row(b, c, ok ? row : 0) * 16 + ch * 4) : (f32x4){0.f, 0.f, 0.f, 0.f}; }
    __syncthreads();
    const int dk = tid & 127, tg = tid >> 7;
    float bloc[16];
    {
        float w[16]; const float* wg = IN_F(19) + h * 128 + dk;
#pragma unroll
        for (int j = 0; j < 16; ++j) w[j] = wg[j * 512];
        const float bg = IN_F(20)[h * 128 + dk];
        float run = 0.f;
#pragma unroll
        for (int i = 0; i < 16; ++i) {
            const int tok = tg * 16 + i; float x = bg;
#pragma unroll
            for (int j4 = 0; j4 < 4; ++j4) { const f32x4 gd = *(const LAS f32x4*)(GDL + tok * 16 + j4 * 4); x += gd.x * w[4 * j4] + gd.y * w[4 * j4 + 1] + gd.z * w[4 * j4 + 2] + gd.w * w[4 * j4 + 3]; }
            const float g = tok < nvalid ? logsig16(x) : 0.f;
            run += g; bloc[i] = run;
        }
        GSUM[tg * 128 + dk] = run;
    }
    __syncthreads();
    float off = 0.f, blast = 0.f;
#pragma unroll
    for (int t = 0; t < 4; ++t) { const float s = GSUM[t * 128 + dk]; if (t < tg) off += s; blast += s; }
    {
        unsigned kdp[8];
#pragma unroll
        for (int i = 0; i < 16; i += 2) {
            float kd2[2];
#pragma unroll
            for (int e = 0; e < 2; ++e) {
                const int tok = tg * 16 + i + e; const float bb = bloc[i + e] + off; const float q = bf2f(QL[tok * 136 + dk]), k = bf2f(KL[tok * 136 + dk]);
                QL[tok * 136 + dk] = (bf16)f2bf(q * __expf(bb)); KL[tok * 136 + dk] = (bf16)f2bf(k * __expf(-bb)); kd2[e] = k * __expf(blast - bb);
            }
            kdp[i >> 1] = pk2(kd2[0], kd2[1]);
        }
        bf16* kp = KDTF + ((size_t)(((dk >> 5) * 4 + tg) * 64) + (dk & 31)) * 8;
        *(u32x4*)(kp) = (u32x4){kdp[0], kdp[1], kdp[2], kdp[3]}; *(u32x4*)(kp + 32 * 8) = (u32x4){kdp[4], kdp[5], kdp[6], kdp[7]};
        if (tg == 0) ELF[dk] = __expf(blast);
    }
    {
        const int dv = tid & 255, half = tid >> 8;
#pragma unroll
        for (int u = 0; u < 4; ++u) {
            unsigned pk[4];
#pragma unroll
            for (int e = 0; e < 4; ++e) { const int tok = half * 32 + u * 8 + e * 2; pk[e] = (unsigned)VS[tok * 264 + dv] | ((unsigned)VS[(tok + 1) * 264 + dv] << 16); }
            const int s = 2 * half + (u >> 1), uh = u & 1;
            *(u32x4*)(VTF + ((size_t)(((dv >> 5) * 4 + s) * 64) + uh * 32 + (dv & 31)) * 8) = (u32x4){pk[0], pk[1], pk[2], pk[3]};
        }
    }
    __syncthreads();
#pragma unroll
    for (int uu = 0; uu < 2; ++uu) {
        const int U = tid + 512 * uu, lp = U & 63, s8 = (U >> 6) & 7, tt = U >> 9; const int tok = tt * 32 + (lp & 31), hh = lp >> 5;
        const u32x2 lo = *(const LAS u32x2*)(QL + tok * 136 + 16 * s8 + 4 * hh), hi2 = *(const LAS u32x2*)(QL + tok * 136 + 16 * s8 + 8 + 4 * hh);
        *(u32x4*)(QINF + (size_t)U * 8) = (u32x4){lo.x, lo.y, hi2.x, hi2.y};
    }
    if (wid < 3) {
        const int tt = wid == 0 ? 0 : 1, tp = wid == 2 ? 1 : 0;
        f32x16 acc = f32x16{};
#pragma unroll
        for (int s = 0; s < 8; ++s) {
            const bf16x8 af = *(const LAS bf16x8*)(QL + (tt * 32 + r32) * 136 + 16 * s + 8 * hi), bfr = *(const LAS bf16x8*)(KL + (tp * 32 + r32) * 136 + 16 * s + 8 * hi);
            acc = __builtin_amdgcn_mfma_f32_32x32x16_bf16(af, bfr, acc, 0, 0, 0);
        }
#pragma unroll
        for (int r = 0; r < 16; ++r) { const int tok = tt * 32 + crow(r, hi), tk = tp * 32 + r32; AL[tok * 72 + tk] = (bf16)f2bf(tk <= tok ? acc[r] : 0.f); }
    } else if (wid == 3) {
#pragma unroll
        for (int r = 0; r < 16; ++r) AL[crow(r, hi) * 72 + 32 + r32] = 0;
    }
    __syncthreads();
    { const int U = tid, lp = U & 63, s = (U >> 6) & 3, tt = U >> 8; const int tok = tt * 32 + (lp & 31), hh = lp >> 5;
      *(u32x4*)(AMF + (size_t)U * 8) = *(const LAS u32x4*)(AL + tok * 72 + 16 * s + 8 * hh); }
    __syncthreads();
}
constexpr int SM_A = 0, SM_K = 2048, SM_Q = 4096, SM_V = 6144, SM_O = 10240, SM_END = SM_O + 4 * 2 * 256 * 4;
__device__ __forceinline__ void sample_item(ArgsP a, int item, LAS unsigned char* lds, int wave_id) {
    const int tid = fresh_tid(wave_id);
    const int db = item >> 2, h = item & 3;
    LAS float* AS = (LAS float*)(lds + SM_A); LAS float* KS = (LAS float*)(lds + SM_K); LAS float* QS = (LAS float*)(lds + SM_Q); LAS float* VSm = (LAS float*)(lds + SM_V); LAS float* OS = (LAS float*)(lds + SM_O);
    { const int s = tid >> 7, dk = tid & 127, row = RSAMP0 + db * 4 + s; const float* gd = WSF(WS_GD) + (size_t)row * 16; const float* wg = IN_F(19) + h * 128 + dk;
      float x = IN_F(20)[h * 128 + dk];
#pragma unroll
      for (int j = 0; j < 16; ++j) x += gd[j] * wg[j * 512];
      AS[s * 128 + dk] = __expf(logsig16(x));
      const size_t g = (size_t)row * 512 + h * 128 + dk; KS[s * 128 + dk] = bf2f(WSB(WS_KG)[g]); QS[s * 128 + dk] = bf2f(WSB(WS_QG)[g]);
#pragma unroll
      for (int j = 0; j < 2; ++j) { const int e = tid + 512 * j, s2 = e >> 8, dv2 = e & 255; VSm[s2 * 256 + dv2] = bf2f(WSB(WS_VG)[(size_t)(RSAMP0 + db * 4 + s2) * 1024 + h * 256 + dv2]); } }
    const int dv = tid & 255, kh = tid >> 8;
    const unsigned voff = (unsigned)(kh * 64 * 256 + dv) * 4u;
    const unsigned char* sbase = (const unsigned char*)(IN_F(4) + (size_t)(db * 4 + h) * 128 * 256);
    __syncthreads();
    float S[64];
#pragma unroll
    for (int d4 = 0; d4 < 16; ++d4) { const GAS unsigned char* bp = (const GAS unsigned char*)sbase + d4 * 4096; asm volatile("" : "+s"(bp));
#pragma unroll
        for (int e = 0; e < 4; ++e) S[4 * d4 + e] = __builtin_nontemporal_load((const GAS float*)(bp + e * 1024 + voff)); }
#pragma unroll 1
    for (int s = 0; s < 4; ++s) {
        const float v = VSm[s * 256 + dv]; float o = 0.f;
#pragma unroll
        for (int d4 = 0; d4 < 16; ++d4) {
            if ((d4 & 3) == 0) __builtin_amdgcn_sched_barrier(0);
            const f32x4 av = *(const LAS f32x4*)(AS + s * 128 + kh * 64 + 4 * d4), kv = *(const LAS f32x4*)(KS + s * 128 + kh * 64 + 4 * d4), qv = *(const LAS f32x4*)(QS + s * 128 + kh * 64 + 4 * d4);
            S[4 * d4] = av.x * S[4 * d4] + kv.x * v; o += qv.x * S[4 * d4]; S[4 * d4 + 1] = av.y * S[4 * d4 + 1] + kv.y * v; o += qv.y * S[4 * d4 + 1];
            S[4 * d4 + 2] = av.z * S[4 * d4 + 2] + kv.z * v; o += qv.z * S[4 * d4 + 2]; S[4 * d4 + 3] = av.w * S[4 * d4 + 3] + kv.w * v; o += qv.w * S[4 * d4 + 3];
        }
        OS[(s * 2 + kh) * 256 + dv] = o;
    }
    unsigned char* obase = (unsigned char*)(a->out + O_GLAS + (size_t)(db * 4 + h) * 128 * 256);
#pragma unroll
    for (int d4 = 0; d4 < 16; ++d4) { GAS unsigned char* bp = (GAS unsigned char*)obase + d4 * 4096; asm volatile("" : "+s"(bp));
#pragma unroll
        for (int e = 0; e < 4; ++e) __builtin_nontemporal_store(S[4 * d4 + e], (GAS float*)(bp + e * 1024 + voff)); }
    __syncthreads();
#pragma unroll
    for (int j = 0; j < 2; ++j) { const int e = tid + 512 * j, s2 = e >> 8, dv2 = e & 255; WSB(WS_OGRAW)[((size_t)(h * 8 + (dv2 >> 5)) * RP + (RSAMP0 + db * 4 + s2)) * 32 + (dv2 & 31)] = (bf16)f2bf(OS[(s2 * 2) * 256 + dv2] + OS[(s2 * 2 + 1) * 256 + dv2]); }
    __syncthreads();
}
__device__ __forceinline__ void prep_phase(ArgsP a, LAS unsigned char* lds, int wave_id) {
    for (int item = blockIdx.x; item < NITEM; item += gridDim.x) prep_item(a, item, lds, wave_id);
}
constexpr int S_QIN = 0, S_KDT = 16384, S_AM = 32768, S_EL = 40960, S_VT = 41984, S_SLOT = S_VT + 4096;
constexpr int S_X = 3 * S_SLOT, S_END = S_X + 2 * 8192;
static_assert(S_END <= MISC_OFF, "scan ring + state exchange fit under the control words");
constexpr int NPIECE = 45, NHELP = 5, NDMA = (NPIECE + NHELP - 1) / NHELP;
__device__ __forceinline__ void scan_bh(ArgsP a, int bh, int part, LAS unsigned char* lds, int wave_id) {
    const int tid = fresh_tid(wave_id), lane = tid & 63, r32 = lane & 31, hi = lane >> 5; const int wid = wave_id;
    const int b = bh >> 2, h = bh & 3, ds = part;
    const unsigned char* const pq = (const unsigned char*)(WSB(WS_QINF) + (size_t)bh * NCH * 8192); const unsigned char* const pk = (const unsigned char*)(WSB(WS_KDTF) + (size_t)bh * NCH * 8192);
    const unsigned char* const pa = (const unsigned char*)(WSB(WS_AMF) + (size_t)bh * NCH * 4096); const unsigned char* const pe = (const unsigned char*)(WSF(WS_ELF) + (size_t)bh * NCH * 256);
    const unsigned char* const pv = (const unsigned char*)(WSB(WS_VTF) + (size_t)bh * NCH * 16384) + part * 4096;
    LAS unsigned char* const X = lds + S_X;
#define GLA_BAR() asm volatile("s_waitcnt lgkmcnt(0)\n\ts_barrier" ::: "memory")
#define GLA_QF(tt, k8) (*(const LAS bf16x8*)(sb + S_QIN + ((tt) * 8 + (k8)) * 1024 + lane * 16))
#define GLA_KF(T, s) (*(const LAS bf16x8*)(sb + S_KDT + ((T) * 4 + (s)) * 1024 + lane * 16))
#define GLA_AF(tt, s) (*(const LAS bf16x8*)(sb + S_AM + ((tt) * 4 + (s)) * 1024 + lane * 16))
    if (wid >= 3) {
#define GLA_DMA(c_, slot_) do { const size_t c64_ = (size_t)(c_); \
        _Pragma("unroll") for (int k_ = 0; k_ < NDMA; ++k_) { int i_ = (wid - 3) + NHELP * k_; i_ = i_ < NPIECE ? i_ : 40; const unsigned char* g_; int lo_; \
            if (i_ < 16) { g_ = pq + c64_ * 16384 + i_ * 1024; lo_ = S_QIN + i_ * 1024; } \
            else if (i_ < 32) { g_ = pk + c64_ * 16384 + (i_ - 16) * 1024; lo_ = S_KDT + (i_ - 16) * 1024; } \
            else if (i_ < 40) { g_ = pa + c64_ * 8192 + (i_ - 32) * 1024; lo_ = S_AM + (i_ - 32) * 1024; } \
            else if (i_ == 40) { g_ = pe + c64_ * 1024; lo_ = S_EL; } \
            else { g_ = pv + c64_ * 32768 + (i_ - 41) * 1024; lo_ = S_VT + (i_ - 41) * 1024; } \
            __builtin_amdgcn_global_load_lds((const unsigned*)(g_ + lane * 16), (LAS unsigned*)(lds + (slot_) * S_SLOT + lo_), 16, 0, 0); } } while (0)
        GLA_DMA(0, 0); GLA_DMA(1, 1);
        for (int c = 0; c < NCH; ++c) {
            if (c + 1 < NCH) asm volatile("s_waitcnt vmcnt(%0)" :: "n"(NDMA) : "memory"); else asm volatile("s_waitcnt vmcnt(0)" ::: "memory");
            GLA_BAR();
            if (c + 2 < NCH) GLA_DMA(c + 2, (c + 2) % 3);
        }
#undef GLA_DMA
    } else if (wid == 2) {
        f32x16 S[4]; S[0] = f32x16{}; S[1] = f32x16{}; S[2] = f32x16{}; S[3] = f32x16{};
#pragma unroll
        for (int k = 0; k < 8; ++k) *(LAS u32x4*)(X + k * 1024 + lane * 16) = (u32x4){0u, 0u, 0u, 0u};
        for (int c = 0; c < NCH; ++c) {
            GLA_BAR();
            const LAS unsigned char* sb = lds + (c % 3) * S_SLOT;
            bf16x8 vf[4];
#pragma unroll
            for (int s = 0; s < 4; ++s) vf[s] = *(const LAS bf16x8*)(sb + S_VT + s * 1024 + lane * 16);
            bf16x8 KA[4], KB[4];
#define GLA_LK(F, s) do { F[0] = GLA_KF(0, s); F[1] = GLA_KF(1, s); F[2] = GLA_KF(2, s); F[3] = GLA_KF(3, s); } while (0)
#define GLA_MK(F, s) do { _Pragma("unroll") for (int T = 0; T < 4; ++T) S[T] = __builtin_amdgcn_mfma_f32_32x32x16_bf16(F[T], vf[s], S[T], 0, 0, 0); } while (0)
            GLA_LK(KA, 0); GLA_LK(KB, 1);
#pragma unroll
            for (int T = 0; T < 4; ++T)
#pragma unroll
                for (int g = 0; g < 4; ++g) { const f32x4 e = *(const LAS f32x4*)(sb + S_EL + (32 * T + 8 * g + 4 * hi) * 4); S[T][4 * g] *= e.x; S[T][4 * g + 1] *= e.y; S[T][4 * g + 2] *= e.z; S[T][4 * g + 3] *= e.w; }
            __builtin_amdgcn_sched_barrier(0);
            GLA_MK(KA, 0); __builtin_amdgcn_sched_barrier(0); GLA_LK(KA, 2); __builtin_amdgcn_sched_barrier(0);
            GLA_MK(KB, 1); __builtin_amdgcn_sched_barrier(0); GLA_LK(KB, 3); __builtin_amdgcn_sched_barrier(0);
            GLA_MK(KA, 2); __builtin_amdgcn_sched_barrier(0); GLA_MK(KB, 3);
#undef GLA_LK
#undef GLA_MK
            if (c + 1 < NCH) {
                LAS unsigned char* xo = X + ((c + 1) & 1) * 8192 + lane * 16;
#pragma unroll
                for (int T = 0; T < 4; ++T)
#pragma unroll
                    for (int s = 0; s < 2; ++s) { u32x4 w;
#pragma unroll
                        for (int i = 0; i < 4; ++i) w[i] = cvtpk(S[T][8 * s + 2 * i], S[T][8 * s + 2 * i + 1]);
                        *(LAS u32x4*)(xo + (T * 2 + s) * 1024) = w; }
            }
        }
        float* outp = a->out + O_GLAP + (size_t)bh * 128 * 256 + ds * 32 + r32;
#pragma unroll
        for (int T = 0; T < 4; ++T)
#pragma unroll
            for (int r = 0; r < 16; ++r) outp[(size_t)(32 * T + crow(r, hi)) * 256] = S[T][r];
    } else {
        const int tt = wid;
        bf16* const ogbase = WSB(WS_OGRAW) + (size_t)(h * 8 + ds) * RP * 32 + r32;
        for (int c = 0; c < NCH; ++c) {
            GLA_BAR();
            const LAS unsigned char* sb = lds + (c % 3) * S_SLOT; const LAS unsigned char* xi = X + (c & 1) * 8192 + lane * 16;
            const LAS unsigned char* qp = sb + S_QIN + tt * 8192 + lane * 16; const LAS unsigned char* ap = sb + S_AM + tt * 4096 + lane * 16;
            bf16x8 vf[4], Sb[8], Q[8], A[4];
#pragma unroll
            for (int k = 0; k < 8; ++k) { Sb[k] = *(const LAS bf16x8*)(xi + k * 1024); Q[k] = *(const LAS bf16x8*)(qp + k * 1024); }
#pragma unroll
            for (int s = 0; s < 4; ++s) { vf[s] = *(const LAS bf16x8*)(sb + S_VT + s * 1024 + lane * 16); A[s] = *(const LAS bf16x8*)(ap + s * 1024); }
            f32x16 oa = f32x16{}, ob = f32x16{};
#pragma unroll
            for (int k = 0; k < 8; k += 2) { oa = __builtin_amdgcn_mfma_f32_32x32x16_bf16(Q[k], Sb[k], oa, 0, 0, 0); ob = __builtin_amdgcn_mfma_f32_32x32x16_bf16(Q[k + 1], Sb[k + 1], ob, 0, 0, 0); }
            oa = __builtin_amdgcn_mfma_f32_32x32x16_bf16(A[0], vf[0], oa, 0, 0, 0); ob = __builtin_amdgcn_mfma_f32_32x32x16_bf16(A[1], vf[1], ob, 0, 0, 0);
            if (tt == 1) { oa = __builtin_amdgcn_mfma_f32_32x32x16_bf16(A[2], vf[2], oa, 0, 0, 0); ob = __builtin_amdgcn_mfma_f32_32x32x16_bf16(A[3], vf[3], ob, 0, 0, 0); }
            const f32x16 o = oa + ob;
            bf16* og = ogbase;
#pragma unroll
            for (int r = 0; r < 16; ++r) { const int tok = tt * 32 + crow(r, hi); if (c > 0 || tok < NMETA) og[(size_t)chunk_row(b, c, tok) * 32] = (bf16)cvtpk(o[r], o[r]); }
        }
    }
    asm volatile("s_waitcnt vmcnt(0) lgkmcnt(0)\n\ts_barrier" ::: "memory");
#undef GLA_BAR
#undef GLA_QF
#undef GLA_KF
#undef GLA_AF
}
}

__device__ __forceinline__ bool relaunder(ArgsP& a) { asm volatile("" : "+s"(a)); return true; }
constexpr int NPHASE = 22;
__global__ void __launch_bounds__(512, 2) fwd(Args a_unused) {
    ArgsP a = (ArgsP)__builtin_amdgcn_kernarg_segment_ptr();
    extern __shared__ __attribute__((aligned(16))) unsigned char lds_raw[];
    LAS unsigned char* lds = (LAS unsigned char*)lds_raw;
    Ctx c; c.wave = __builtin_amdgcn_readfirstlane((int)threadIdx.x >> 6); c.tid = 0; c.lane = 0;
    c.gw = blockIdx.x * 8 + c.wave; c.ngw = gridDim.x * 8; c.gwT = c.wave * gridDim.x + blockIdx.x;
    volatile LAS unsigned* MISC = (volatile LAS unsigned*)(lds + MISC_OFF);
    if (threadIdx.x < 32) MISC[threadIdx.x] = 0u;
    __syncthreads();
    XcdBarrier bar; bar.bar = (unsigned*)(a->ws + WS_CTL) + CW_BAR; bar.x = 0; bar.st = nullptr;
    const bool one = (a->ph_hi - a->ph_lo) > 1;
    if (one) bar = xcd_barrier_post((unsigned*)(a->ws + WS_CTL) + CW_BAR, MISC + 8);
    const int lo = a->ph_lo, hi = a->ph_hi;
    unsigned long long tp0 = 0, tp1 = 0;
#define IN(k) (((PROBE_LO == (k)) ? (void)(tp0 = __builtin_amdgcn_s_memrealtime()) : (void)0), (lo <= (k) && (k) < hi && relaunder(a)))
#define INQ(k) (lo <= (k) && (k) < hi)
#define SEAM(k) do { if (INQ(k) && INQ((k) + 1)) xcd_barrier(bar, c.wave); if (PROBE_HI == (k)) tp1 = __builtin_amdgcn_s_memrealtime(); } while (0)
    if (IN(0)) { p_prep(a, c, lds); } SEAM(0);
    if (IN(1)) { if ((int)blockIdx.x < (RP / 256) * (NIN0 / 256)) gemm_p1(a, lds, c.wave); else p_side_tables(a, c, lds, (RP / 256) * (NIN0 / 256)); } SEAM(1);
    if (IN(2)) { if (USE_NAIVE_GEMM) p_mla_mid(a, c); }
    if (IN(3)) { gemm_p3(a, lds, c.wave); } SEAM(3);
    if (IN(4)) { if (USE_NAIVE_GEMM) { p_q_post(a, c); p_qlat(a, c); } }
    if (IN(5)) {
#if USE_NAIVE_ATTN
        p_attn_prompt_naive<false>(a, c);
#else
        if (((int)blockIdx.x >> 3) & 1) {
            dec::decode_phase(a, lds, c.wave);
            att::attn_phase(WSB(WS_QN), WSB(WS_QPE), WSB(WS_KNV), WSB(WS_KPE), WSB(WS_O), lds, c.wave);
        } else {
            att::attn_phase(WSB(WS_QN), WSB(WS_QPE), WSB(WS_KNV), WSB(WS_KPE), WSB(WS_O), lds, c.wave);
            dec::decode_phase(a, lds, c.wave);
        }
#endif
    } SEAM(5);
    if (IN(6)) {
#if USE_NAIVE_DECODE
        p_olat_up(a, c);
#else
        dec::combine_phase(a, c, lds);
#endif
    } SEAM(6);
    if (IN(7)) { gemm_n1024_tail<D, 8>(WSB(WS_O), WSB(WS_WO0), WSB(WS_M), WSF(WS_MT), lds, c.wave); } SEAM(7);
    if (IN(8)) { p_post_res<false, 8, true>(a, c, IN_F(8), IN_F(9)); } SEAM(8);
    if (IN(9)) { gemm_mfma8(WSB(WS_H), WSB(WS_WUP), RP, FF, D, (EpiRelu2{WSB(WS_U), FF}), lds, c.wave); } SEAM(9);
    if (IN(10)) { gemm_n1024_tail<FF, 16>(WSB(WS_U), WSB(WS_WDN), WSB(WS_M), WSF(WS_MT), lds, c.wave); } SEAM(10);
    if (IN(11)) { p_post_res<false, 16>(a, c, IN_F(10), IN_F(7) + D); } SEAM(11);
    if (IN(12)) { gemm_mfma8(WSB(WS_H), WSB(WS_WGIN), RP, NGIN, D, (EpiGla{WSB(WS_QG), WSB(WS_KG), WSB(WS_VG), WSB(WS_RG), WSF(WS_GD)}), lds, c.wave); } SEAM(12);
    if (IN(13)) {
#if USE_NAIVE_GLA
        p_gate(a, c);
#else
        gla::prep_phase(a, lds, c.wave);
#endif
    } SEAM(13);
    if (IN(14)) {
#if !USE_NAIVE_GLA
        if ((int)blockIdx.x < NB * GH * gla::NSP) { const int w = (int)blockIdx.x, xcd = w & 7, j = w >> 3;
            gla::scan_bh(a, xcd * (NB * GH / 8) + j / gla::NSP, j % gla::NSP, lds, c.wave); }
        else for (int item = (int)blockIdx.x - NB * GH * gla::NSP; item < DB * GH; item += (int)gridDim.x - NB * GH * gla::NSP) gla::sample_item(a, item, lds, c.wave);
#else
        p_gla_naive(a, c);
#endif
    } SEAM(14);
    if (IN(15)) { p_gla_post(a, c); } SEAM(15);
    if (IN(16)) { gemm_n1024_tail<D, 8>(WSB(WS_OG), WSB(WS_WGO), WSB(WS_M), WSF(WS_MT), lds, c.wave); } SEAM(16);
    if (IN(17)) { p_post_res<false, 8>(a, c, IN_F(8) + D, IN_F(9) + D); } SEAM(17);
    if (IN(18)) { gemm_mfma8(WSB(WS_H), WSB(WS_WUP) + (size_t)FF * D, RP, FF, D, (EpiRelu2{WSB(WS_U), FF}), lds, c.wave); } SEAM(18);
    if (IN(19)) { gemm_n1024_tail<FF, 16>(WSB(WS_U), WSB(WS_WDN) + (size_t)D * FF, WSB(WS_M), WSF(WS_MT), lds, c.wave); } SEAM(19);
    if (IN(20)) { p_post_res<true, 16>(a, c, IN_F(10) + D, nullptr); }
    if (PROBE_LO >= 0 && blockIdx.x == 0) { const unsigned long long span = (tp1 - tp0) * 9ull, t0 = __builtin_amdgcn_s_memrealtime(); while (__builtin_amdgcn_s_memrealtime() - t0 < span) __builtin_amdgcn_s_sleep(8); }
#undef IN
#undef SEAM
}

extern "C" void kernel_launch(void* const* d_in, const int* in_sizes, int n_in, void* d_out, int out_size, void* d_ws, size_t ws_size, hipStream_t stream) {
    static int grid = 0;
    if (grid == 0) {
        if (n_in != 25 || out_size != (int)O_END || ws_size < WS_END) { fprintf(stderr, "kernel_launch: unexpected shapes n_in %d out %d ws %zu\n", n_in, out_size, ws_size); grid = -1; return; }
        int dev = 0, cus = 0, per_cu = 0;
        if (hipGetDevice(&dev) != hipSuccess || hipDeviceGetAttribute(&cus, hipDeviceAttributeMultiprocessorCount, dev) != hipSuccess) { grid = -1; return; }
        if (hipFuncSetAttribute((const void*)fwd, hipFuncAttributeMaxDynamicSharedMemorySize, LDS_BYTES) != hipSuccess) { fprintf(stderr, "kernel_launch: hipFuncSetAttribute failed\n"); grid = -1; return; }
        if (hipOccupancyMaxActiveBlocksPerMultiprocessor(&per_cu, (const void*)fwd, 512, LDS_BYTES) != hipSuccess || per_cu < 1) fprintf(stderr, "kernel_launch: occupancy query says %d\n", per_cu);
        (void)hipGetLastError();
        grid = cus;
    }
    if (grid < 0) return;
    if (hipMemsetAsync((char*)d_ws + WS_CTL, 0, CTL_ZERO_BYTES, stream) != hipSuccess) return;
    Args a{};
    for (int i = 0; i < 25; ++i) a.in[i] = d_in[i];
    a.out = (float*)d_out; a.ws = (unsigned char*)d_ws;
#if MK_ONE_LAUNCH
    a.ph_lo = 0; a.ph_hi = NPHASE;
    hipLaunchKernelGGL(fwd, dim3(grid), dim3(512), LDS_BYTES, stream, a);
#else
    for (int ph = 0; ph < NPHASE - 1; ++ph) { a.ph_lo = ph; a.ph_hi = ph + 1; hipLaunchKernelGGL(fwd, dim3(grid), dim3(512), LDS_BYTES, stream, a); }
#endif
}
```

```cpp
#include <hip/hip_runtime.h>
#include <cstdio>
#include <cstdint>
#include <cmath>

#ifndef MK_ONE_LAUNCH
#define MK_ONE_LAUNCH 1
#endif

constexpr int D = 1024, NB = 4, SEQ = 4096, NMETA = 16, TP = SEQ + NMETA;
constexpr int DB = 128, DS = 4, PAST = 8192, PAGE = 128, NPAGES = 64;
constexpr int NH = 16, QL = 256, KVL = 256, NOPE = 64, ROPE = 32, VH = 64;
constexpr int GH = 4, GDK = 128, GDV = 256, GR = 16;
constexpr int FF = 4096;
constexpr int RMAIN = NB * SEQ;
constexpr int RMETA0 = RMAIN;
constexpr int RSAMP0 = RMAIN + NB * NMETA;
constexpr int R = RSAMP0 + DB * DS;
constexpr int RPROMPT = RSAMP0;
constexpr int RP = 17152;
constexpr int NIN0 = 768, NUQ = 1536, NUKV = 2048, NGIN = 3328, NGIN_REAL = 3088;
constexpr float EPS = 1e-6f;
constexpr float MLA_SCALE = 0.10206207261596575f;
constexpr float GLA_SCALE = 0.08838834764831845f;
constexpr float QSCALE = 0.10206207261596575f * 1.4426950408889634f;

constexpr size_t O_YP = 0, O_YS = 16777216, O_CKVP = 17301504, O_KPEP = 21512192, O_CKVS = 22038528, O_KPES = 22169600, O_GLAP = 22185984, O_GLAS = 22710272, O_END = 39487488;

constexpr size_t MiB = 1u << 20;
constexpr size_t WS_CTL = 0, CTL_ZERO_BYTES = 1 * MiB;
constexpr size_t WS_WIN0 = 2 * MiB, WS_WUQ = 4 * MiB, WS_WUKV = 5 * MiB, WS_WO0 = 6 * MiB, WS_WUP = 8 * MiB, WS_WDN = 24 * MiB, WS_WGIN = 40 * MiB, WS_WGO = 47 * MiB;
constexpr size_t WS_X = 64 * MiB, WS_H = 132 * MiB, WS_M = 166 * MiB, WS_U = 234 * MiB, WS_A1 = 368 * MiB, WS_CQN = 419 * MiB, WS_CKVN = 428 * MiB, WS_KPE = 437 * MiB;
constexpr size_t WS_QRAW = 440 * MiB, WS_KNV = 541 * MiB, WS_QN = 608 * MiB, WS_QPE = 642 * MiB, WS_QLAT = 659 * MiB, WS_OLAT = 663 * MiB, WS_O = 671 * MiB;
constexpr size_t WS_QG = 705 * MiB, WS_KG = 722 * MiB, WS_VG = 739 * MiB, WS_RG = 773 * MiB, WS_GD = 807 * MiB, WS_LA = 809 * MiB, WS_EA = 843 * MiB, WS_OGRAW = 877 * MiB, WS_OG = 944 * MiB;
constexpr size_t WS_OPART = 978 * MiB, WS_MLP = 1012 * MiB;
constexpr size_t WS_QINF = 1014 * MiB, WS_KDTF = 1032 * MiB, WS_AMF = 1050 * MiB, WS_VTF = 1060 * MiB, WS_ELF = 1094 * MiB;
constexpr size_t WS_WUQL = 50 * MiB;
constexpr size_t WS_ROPE = 53 * MiB;
constexpr size_t WS_MT = 1096 * MiB;
constexpr size_t WS_END = 1144 * MiB;
constexpr int CW_BAR = 4096, CW_DEC = 8192;
namespace gla { constexpr int NSP = 8; static_assert(NSP == 8, "the scan's XCD mapping assumes 8 workgroups per (b, h)"); }

constexpr int LDS_BYTES = 163840;
constexpr int MISC_OFF = LDS_BYTES - 256;

#define GAS __attribute__((address_space(1)))
#define LAS __attribute__((address_space(3)))
typedef unsigned short bf16;
typedef float f32x4 __attribute__((ext_vector_type(4)));
typedef unsigned u32x4 __attribute__((ext_vector_type(4)));
typedef unsigned u32x2 __attribute__((ext_vector_type(2)));
#define LDS_WAIT() asm volatile("s_waitcnt lgkmcnt(0)" ::: "memory")

__device__ __forceinline__ unsigned f2bf(float f) { unsigned u = __builtin_bit_cast(unsigned, f); return (u + 0x7fffu + ((u >> 16) & 1u)) >> 16; }
__device__ __forceinline__ unsigned pk2(float lo, float hi) { return f2bf(lo) | (f2bf(hi) << 16); }
__device__ __forceinline__ float bflo(unsigned u) { return __builtin_bit_cast(float, u << 16); }
__device__ __forceinline__ float bfhi(unsigned u) { return __builtin_bit_cast(float, u & 0xffff0000u); }
__device__ __forceinline__ float bf2f(bf16 v) { return __builtin_bit_cast(float, (unsigned)v << 16); }
__device__ __forceinline__ float wave_sum(float v) {
#pragma unroll
    for (int o = 1; o < 64; o <<= 1) v += __shfl_xor(v, o);
    return v;
}
__device__ __forceinline__ int wave_max_i(int v) {
#pragma unroll
    for (int o = 1; o < 64; o <<= 1) { int t = __shfl_xor(v, o); v = t > v ? t : v; }
    return v;
}
__device__ __forceinline__ int fresh_tid(int wave) { int t = wave * 64 + (int)__builtin_amdgcn_mbcnt_hi(~0u, __builtin_amdgcn_mbcnt_lo(~0u, 0u)); asm volatile("" : "+v"(t)); return t; }
__device__ __forceinline__ float rdlane(float v, int l) { return __builtin_bit_cast(float, __builtin_amdgcn_readlane(__builtin_bit_cast(int, v), l)); }

#define XB_TMO      128
#define XB_XCNT(j)  (256  + 64 * (j))
#define XB_XSUB(j)  (1280 + 64 * (j))
#define XB_XGEN(j)  (2304 + 64 * (j))
#define XB_TOP      3328
#define XB_TOPGEN   3392
#define XCD_BAR_WORDS 3456
#define XB_SPIN_CAP (1u << 18)
__device__ __forceinline__ unsigned xb_ld(unsigned* p)              { return __hip_atomic_load(p, __ATOMIC_RELAXED, __HIP_MEMORY_SCOPE_AGENT); }
__device__ __forceinline__ unsigned xb_add(unsigned* p, unsigned v) { return __hip_atomic_fetch_add(p, v, __ATOMIC_RELAXED, __HIP_MEMORY_SCOPE_AGENT); }
__device__ __forceinline__ unsigned xb_xcc_id() { return (unsigned)__builtin_amdgcn_s_getreg((3 << 11) | 20) & 0xFu; }
#define XB_SPIN(cond, bar) do { unsigned _sp = 0; while (cond) { __builtin_amdgcn_s_sleep(1); \
    if ((++_sp & 255u) == 0u) { if (xb_ld(&(bar)[XB_TMO])) break; if (_sp > XB_SPIN_CAP) { atomicAdd(&(bar)[XB_TMO], 1u); break; } } } } while (0)
struct XcdBarrier { unsigned* bar; unsigned x; volatile LAS unsigned* st; };
__device__ __forceinline__ XcdBarrier xcd_barrier_post(unsigned* bar, volatile LAS unsigned* st) {
    XcdBarrier b; b.bar = bar; b.x = xb_xcc_id(); b.st = st;
    if (threadIdx.x == 0) (void)xb_add(&bar[XB_XCNT(b.x)], 1u);
    return b;
}
__device__ __forceinline__ void xcd_barrier_complete(unsigned* bar, unsigned x, unsigned& nloc, unsigned& nx) {
    const unsigned G = gridDim.x * gridDim.y * gridDim.z;
    unsigned sum, cnt, mine, sp = 0u;
    for (;;) {
        sum = 0u; cnt = 0u; mine = 0u;
#pragma unroll
        for (unsigned j = 0; j < 16; ++j) { const unsigned c = xb_ld(&bar[XB_XCNT(j)]); sum += c; cnt += (c > 0u) ? 1u : 0u; mine = (j == x) ? c : mine; }
        if (sum == G) break;
        __builtin_amdgcn_s_sleep(1);
        if ((++sp & 255u) == 0u) { if (xb_ld(&bar[XB_TMO])) break; if (sp > XB_SPIN_CAP) { atomicAdd(&bar[XB_TMO], 1u); break; } }
    }
    nloc = mine > 0u ? mine : 1u; nx = cnt > 0u ? cnt : 1u;
}
__device__ __forceinline__ void xcd_barrier(const XcdBarrier& b, int wave_id) {
    asm volatile("s_waitcnt vmcnt(0)" ::: "memory");
    __syncthreads();
    if (fresh_tid(wave_id) == 0) {
        unsigned* bar = b.bar;
        __builtin_amdgcn_s_waitcnt(0);
        unsigned nloc = b.st[0], nx = b.st[1];
        if (nloc == 0u) { xcd_barrier_complete(bar, b.x, nloc, nx); b.st[0] = nloc; b.st[1] = nx; }
        const unsigned old = xb_add(&bar[XB_XSUB(b.x)], 1u);
        const unsigned gen = old / nloc;
        if (old + 1u == (gen + 1u) * nloc) {
            __builtin_amdgcn_fence(__ATOMIC_RELEASE, "agent");
            asm volatile("s_waitcnt vmcnt(0)" ::: "memory");
            const unsigned og = xb_add(&bar[XB_TOP], 1u);
            const unsigned tg = og / nx;
            if (og + 1u == (tg + 1u) * nx) xb_add(&bar[XB_TOPGEN], 1u);
            else XB_SPIN(xb_ld(&bar[XB_TOPGEN]) == tg, bar);
            __builtin_amdgcn_fence(__ATOMIC_ACQUIRE, "agent");
            xb_add(&bar[XB_XGEN(b.x)], 1u);
            asm volatile("s_waitcnt vmcnt(0)" ::: "memory");
        } else {
            XB_SPIN(xb_ld(&bar[XB_XGEN(b.x)]) == gen, bar);
            __builtin_amdgcn_fence(__ATOMIC_ACQUIRE, "agent");
            asm volatile("s_waitcnt vmcnt(0)" ::: "memory");
        }
    }
    __syncthreads();
}

namespace pg8 {
#define PG8_LAS __attribute__((address_space(3)))
typedef unsigned short bf16_t;
typedef short bf16x8 __attribute__((ext_vector_type(8)));
typedef float f32x4 __attribute__((ext_vector_type(4)));
typedef unsigned u32x4 __attribute__((ext_vector_type(4)));
constexpr int BM = 256, BK = 64, HALF = 128, HTB = HALF * BK * 2  , STAGE_BYTES = 8 * HTB, NXCD = 8, WGM = 8;

__host__ __device__ __forceinline__ int lds_byte(int r, int c) { const int st = (r >> 4) * 2 + (c >> 5), rr = r & 15, cc = c & 31, ob = rr * 64 + cc * 2; return st * 1024 + (ob ^ (((ob >> 9) & 1) << 5)); }
__host__ __device__ __forceinline__ void stage_rc(int b, int& R, int& C) { const int st = b / 1024, sb = b % 1024, swz = sb ^ (((sb >> 9) & 1) << 5); R = (st >> 1) * 16 + swz / 64; C = (st & 1) * 32 + (swz % 64) / 2; }
__host__ __device__ __forceinline__ int perm32(int rho) { const int n = rho >> 4, i = rho & 15; return 8 * (i >> 2) + 4 * n + (i & 3); }

struct Unit { int pm, pn, k0, prob; long aoff, boff; };
struct Gemm { const bf16_t* A; const bf16_t* Bt; int M, N, K, ld; };

struct StaticOrder {
    int nM, nN, nwg, G, c;
    __host__ __device__ void init(int M, int N, int G_, int c_) { nM = M / BM; nN = N / BM; nwg = nM * nN; G = G_; c = c_; }
    __host__ __device__ bool next(int i, Unit& u) const {
        const long L = (long)i * G + c; if (L >= nwg) return false;
        int wgid = (int)L; { const int q = nwg / NXCD, r = nwg % NXCD, xcd = wgid % NXCD, off = wgid / NXCD; wgid = (xcd < r ? xcd * (q + 1) : r * (q + 1) + (xcd - r) * q) + off; }
        const int nig = WGM * nN, gid = wgid / nig, fm = gid * WGM, gsz = (nM - fm) < WGM ? (nM - fm) : WGM;
        u.pm = fm + ((wgid % nig) % gsz); u.pn = (wgid % nig) / gsz; u.k0 = 0; u.prob = 0; u.aoff = 0; u.boff = 0; return true;
    }
    __device__ __forceinline__ void a_ready(const Unit&) const {}
    __device__ __forceinline__ void done(const Unit&) const {}
};

__device__ __forceinline__ unsigned cvt_pk_bf16(float lo, float hi) { unsigned r; asm volatile("v_cvt_pk_bf16_f32 %0, %1, %2" : "=v"(r) : "v"(lo), "v"(hi)); return r; }
template <class Epi, class Sched, bool ALIGN_EPI = false, bool SP2 = false>
__device__ __forceinline__ void gemm_phase(PG8_LAS unsigned char* lds, const Gemm g, const Sched& S, const Epi& E, int wave_id) {
    const int tid = fresh_tid(wave_id), wid = wave_id, lane = tid & 63, wr = wid >> 2, wc = wid & 3, fr = lane & 15, fq = lane >> 4;
    const int K = g.K, nt = K / BK;
    unsigned voffA[2], voffB[2];
#pragma unroll
    for (int i = 0; i < 2; ++i) { int R, C; stage_rc(tid * 16 + i * 8192, R, C); const int Rb = Epi::PERM ? ((R & ~31) + perm32(R & 31)) : R;
        voffA[i] = (unsigned)(R * g.ld + C) * 2u; voffB[i] = (unsigned)(Rb * g.ld + C) * 2u; }
    const size_t kstep = (size_t)(BK * 2);
    const size_t hstep = (size_t)HALF * g.ld * 2;
    const size_t tstep = 2 * hstep;
    const unsigned ldsw = (unsigned)wid * 1024u;
    const int aoff = lds_byte(wr * 64 + fr, fq * 8), boff = lds_byte(wc * 32 + fr, fq * 8);
#define PG8_SA(b, h) (((b) * 2 + (h)) * HTB)
#define PG8_SB(b, h) ((4 + (b) * 2 + (h)) * HTB)
#define PG8_STAGE(bufoff, gbase, voff) do { _Pragma("unroll") for (int _i = 0; _i < 2; ++_i) \
        __builtin_amdgcn_global_load_lds((const unsigned*)((const char*)(gbase) + (voff)[_i]), (PG8_LAS unsigned*)(lds + (bufoff) + ldsw + _i * 8192), 16, 0, 0); } while (0)
#define PG8_LDA(dst, b, h) do { _Pragma("unroll") for (int m = 0; m < 4; ++m) _Pragma("unroll") for (int k = 0; k < 2; ++k) dst[m][k] = *(const PG8_LAS bf16x8*)(lds + PG8_SA(b, h) + aoff + m * 2048 + k * 1024); } while (0)
#define PG8_LDB(dst, b, h) do { _Pragma("unroll") for (int n = 0; n < 2; ++n) _Pragma("unroll") for (int k = 0; k < 2; ++k) dst[n][k] = *(const PG8_LAS bf16x8*)(lds + PG8_SB(b, h) + boff + n * 2048 + k * 1024); } while (0)
#define PG8_MMA(ai, bj, At, Bt) do { __builtin_amdgcn_s_setprio(1); _Pragma("unroll") for (int m = 0; m < 4; ++m) _Pragma("unroll") for (int n = 0; n < 2; ++n) _Pragma("unroll") for (int k = 0; k < 2; ++k) \
        acc[ai][bj][m][n] = __builtin_amdgcn_mfma_f32_16x16x32_bf16(Bt[n][k], At[m][k], acc[ai][bj][m][n], 0, 0, 0); __builtin_amdgcn_s_setprio(0); } while (0)
#define PG8_WAIT_V(n) asm volatile("s_waitcnt vmcnt(" #n ")" ::: "memory")
#define PG8_WAIT_L(n) asm volatile("s_waitcnt lgkmcnt(" #n ")" ::: "memory")
#define PG8_BAR __builtin_amdgcn_s_barrier()
#define PG8_SCHED __builtin_amdgcn_sched_barrier(0)
    Unit cur, nxt; int ui = 0;
    if (!S.next(0, cur)) return;
    f32x4 acc[2][2][4][2];
#pragma unroll
    for (int a = 0; a < 2; ++a)
#pragma unroll
        for (int b = 0; b < 2; ++b)
#pragma unroll
            for (int m = 0; m < 4; ++m)
#pragma unroll
                for (int n = 0; n < 2; ++n) acc[a][b][m][n] = (f32x4){0.f, 0.f, 0.f, 0.f};
    bf16x8 At[4][2], B0[2][2], B1[2][2];
    const char* cA = (const char*)g.A + (size_t)cur.pm * tstep + (size_t)cur.k0 * 2 + cur.aoff; const char* cB = (const char*)g.Bt + (size_t)cur.pn * tstep + (size_t)cur.k0 * 2 + cur.boff;
    S.a_ready(cur);
    if constexpr (SP2) {
        PG8_STAGE(PG8_SB(0, 0), cB, voffB); PG8_STAGE(PG8_SB(0, 1), cB + hstep, voffB); PG8_STAGE(PG8_SA(0, 0), cA, voffA); PG8_STAGE(PG8_SA(0, 1), cA + hstep, voffA);
        if (wr == 1) PG8_BAR;
        PG8_WAIT_V(2); PG8_BAR;
        PG8_STAGE(PG8_SB(1, 0), cB + kstep, voffB); PG8_STAGE(PG8_SA(1, 0), cA + kstep, voffA); PG8_STAGE(PG8_SB(1, 1), cB + hstep + kstep, voffB);
        PG8_WAIT_V(6); PG8_BAR;
    } else {
        PG8_STAGE(PG8_SB(0, 0), cB, voffB); PG8_STAGE(PG8_SA(0, 0), cA, voffA); PG8_STAGE(PG8_SB(0, 1), cB + hstep, voffB); PG8_STAGE(PG8_SA(0, 1), cA + hstep, voffA);
        if (wr == 1) PG8_BAR;
        PG8_WAIT_V(4); PG8_BAR;
        PG8_STAGE(PG8_SB(1, 0), cB + kstep, voffB); PG8_STAGE(PG8_SA(1, 0), cA + kstep, voffA); PG8_STAGE(PG8_SB(1, 1), cB + hstep + kstep, voffB);
        PG8_WAIT_V(6); PG8_BAR;
    }
    for (;;) {
        const bool has_next = S.next(ui + 1, nxt);
        const char* nA = has_next ? (const char*)g.A + (size_t)nxt.pm * tstep + (size_t)nxt.k0 * 2 + nxt.aoff : cA; const char* nB = has_next ? (const char*)g.Bt + (size_t)nxt.pn * tstep + (size_t)nxt.k0 * 2 + nxt.boff : cB;
        for (int t = 0; t < nt; t += 2) {
            const bool last = (t == nt - 2);
            const char* a1 = cA + (size_t)(t + 1) * kstep;
            const char* a2 = last ? nA : cA + (size_t)(t + 2) * kstep; const char* b2 = last ? nB : cB + (size_t)(t + 2) * kstep;
            const char* a3 = a2 + kstep; const char* b3 = b2 + kstep;
            if (last && has_next) S.a_ready(nxt);
            if constexpr (SP2) {
            PG8_LDB(B0, 0, 0); PG8_LDB(B1, 0, 1); PG8_SCHED; PG8_LDA(At, 0, 0); PG8_STAGE(PG8_SA(1, 1), a1 + hstep, voffA);
            PG8_WAIT_V(8); PG8_WAIT_L(0); PG8_BAR; PG8_MMA(0, 0, At, B0); PG8_MMA(0, 1, At, B1); PG8_BAR; PG8_SCHED;
            PG8_LDA(At, 0, 1); PG8_STAGE(PG8_SB(0, 0), b2, voffB); PG8_STAGE(PG8_SB(0, 1), b2 + hstep, voffB); PG8_STAGE(PG8_SA(0, 0), a2, voffA);
            PG8_WAIT_V(8); PG8_WAIT_L(0); PG8_BAR; PG8_MMA(1, 0, At, B0); PG8_MMA(1, 1, At, B1); PG8_BAR; PG8_SCHED;
            PG8_LDB(B0, 1, 0); PG8_LDB(B1, 1, 1); PG8_SCHED; PG8_LDA(At, 1, 0); PG8_STAGE(PG8_SA(0, 1), a2 + hstep, voffA);
            PG8_WAIT_V(8); PG8_WAIT_L(0); PG8_BAR; PG8_MMA(0, 0, At, B0); PG8_MMA(0, 1, At, B1); PG8_BAR; PG8_SCHED;
            PG8_LDA(At, 1, 1); PG8_STAGE(PG8_SB(1, 0), b3, voffB); PG8_STAGE(PG8_SB(1, 1), b3 + hstep, voffB); PG8_STAGE(PG8_SA(1, 0), a3, voffA);
            PG8_WAIT_V(8); PG8_WAIT_L(0); PG8_BAR; PG8_MMA(1, 0, At, B0); PG8_MMA(1, 1, At, B1); PG8_BAR; PG8_SCHED;
            } else {
            PG8_LDB(B0, 0, 0); PG8_SCHED; PG8_LDA(At, 0, 0); PG8_STAGE(PG8_SA(1, 1), a1 + hstep, voffA);
            PG8_WAIT_L(8); PG8_BAR; PG8_WAIT_L(0); PG8_MMA(0, 0, At, B0); PG8_BAR; PG8_SCHED;
            PG8_LDB(B1, 0, 1); PG8_STAGE(PG8_SB(0, 0), b2, voffB);
            PG8_BAR; PG8_WAIT_L(0); PG8_MMA(0, 1, At, B1); PG8_BAR;
            PG8_LDA(At, 0, 1); PG8_STAGE(PG8_SA(0, 0), a2, voffA);
            PG8_BAR; PG8_WAIT_L(0); PG8_MMA(1, 0, At, B0); PG8_BAR; PG8_SCHED;
            PG8_STAGE(PG8_SB(0, 1), b2 + hstep, voffB);
            PG8_WAIT_V(6); PG8_BAR; PG8_MMA(1, 1, At, B1); PG8_BAR;
            PG8_LDB(B0, 1, 0); PG8_SCHED; PG8_LDA(At, 1, 0); PG8_STAGE(PG8_SA(0, 1), a2 + hstep, voffA);
            PG8_WAIT_L(8); PG8_BAR; PG8_WAIT_L(0); PG8_MMA(0, 0, At, B0); PG8_BAR; PG8_SCHED;
            PG8_LDB(B1, 1, 1); PG8_STAGE(PG8_SB(1, 0), b3, voffB);
            PG8_BAR; PG8_WAIT_L(0); PG8_MMA(0, 1, At, B1); PG8_BAR;
            PG8_LDA(At, 1, 1); PG8_STAGE(PG8_SA(1, 0), a3, voffA);
            PG8_BAR; PG8_WAIT_L(0); PG8_MMA(1, 0, At, B0); PG8_BAR; PG8_SCHED;
            PG8_STAGE(PG8_SB(1, 1), b3 + hstep, voffB);
            PG8_WAIT_V(6); PG8_BAR; PG8_MMA(1, 1, At, B1); PG8_BAR;
            }
        }
        if constexpr (ALIGN_EPI) { if (wr == 0) PG8_BAR; }
        if constexpr (!Epi::AFTER_DRAIN) { E(acc, cur, wr, wc, fr, fq); S.done(cur); }
        if (!has_next) break;
#pragma unroll
        for (int a = 0; a < 2; ++a)
#pragma unroll
            for (int b = 0; b < 2; ++b)
#pragma unroll
                for (int m = 0; m < 4; ++m)
#pragma unroll
                    for (int n = 0; n < 2; ++n) acc[a][b][m][n] = (f32x4){0.f, 0.f, 0.f, 0.f};
        cur = nxt; cA = nA; cB = nB; ++ui;
        if constexpr (ALIGN_EPI) { if (wr == 1) PG8_BAR; }
    }
    PG8_WAIT_V(0);
    if constexpr (!ALIGN_EPI) { if (wr == 0) PG8_BAR; }
    PG8_BAR;
    if constexpr (Epi::AFTER_DRAIN) { E.fused(acc, cur, wr, wc, fr, fq, lds, wid, lane); S.done(cur); }
#undef PG8_SA
#undef PG8_SB
#undef PG8_STAGE
#undef PG8_LDA
#undef PG8_LDB
#undef PG8_MMA
#undef PG8_WAIT_V
#undef PG8_WAIT_L
#undef PG8_BAR
#undef PG8_SCHED
}
}

struct Args { const void* in[25]; float* out; unsigned char* ws; int ph_lo, ph_hi; };
typedef const __attribute__((address_space(4))) Args* ArgsP;
#define IN_F(k) ((const float*)a->in[k])
#define WSB(off) ((bf16*)(a->ws + (off)))
#define WSF(off) ((float*)(a->ws + (off)))

struct Ctx { int tid, lane, wave, gw, ngw, gwT; };
__device__ __forceinline__ Ctx refresh(const Ctx& c0) { Ctx c = c0; c.tid = fresh_tid(c0.wave); c.lane = c.tid & 63; return c; }

__device__ __forceinline__ int row_pos(int r) { return r < RMAIN ? (r & 4095) + NMETA : (r < RSAMP0 ? ((r - RMAIN) & 15) : PAST + ((r - RSAMP0) & 3)); }
__device__ __forceinline__ float rope_inv(int j) { return exp2f(-(float)j * (13.287712379549449f / 16.0f)); }
__device__ __forceinline__ void rope_cs(int pos, int j, float& c, float& s) {
    const float ang = (float)pos * rope_inv(j);
    const double x = (double)ang; const double n = rint(x * 0.15915494309189535); const float r = (float)(x - n * 6.283185307179586);
    c = cosf(r); s = sinf(r);
}

struct RmId { int off; __device__ __forceinline__ int operator()(int n) const { return off + n; } };
struct RmUq { __device__ __forceinline__ int operator()(int n) const { const int h = n / 96, j = n % 96; if (j < 64) return h * 64 + j; const int jj = j - 64; return 1024 + h * 32 + (jj < 16 ? 2 * jj : 2 * (jj - 16) + 1); } };
template <class RM>
__device__ __forceinline__ void tr_item(const float* W, int ldw, int nblk, int item, bf16* WT, int ldt, RM rm, LAS float* scr, int lane) {
    const int kb = item / nblk, nb = item % nblk, k0 = 64 * kb, n0 = 32 * nb;
#pragma unroll
    for (int i = 0; i < 8; ++i) { const int kk = 8 * i + (lane >> 3), c4 = (lane & 7) * 4; const f32x4 v = __builtin_nontemporal_load((const f32x4*)(W + (size_t)(k0 + kk) * ldw + n0 + c4));
        scr[kk * 33 + c4] = v.x; scr[kk * 33 + c4 + 1] = v.y; scr[kk * 33 + c4 + 2] = v.z; scr[kk * 33 + c4 + 3] = v.w; }
    LDS_WAIT();
    const int c = lane & 7;
#pragma unroll
    for (int j = 0; j < 4; ++j) { const int n = (lane >> 3) + 8 * j; const LAS float* s = scr + (8 * c) * 33 + n;
        u32x4 o; o.x = pk2(s[0 * 33], s[1 * 33]); o.y = pk2(s[2 * 33], s[3 * 33]); o.z = pk2(s[4 * 33], s[5 * 33]); o.w = pk2(s[6 * 33], s[7 * 33]);
        *(u32x4*)(WT + (size_t)rm(n0 + n) * ldt + k0 + 8 * c) = o; }
    LDS_WAIT();
}
__device__ __forceinline__ void norm_row_bf16(const float* xrow, const float* g, float* xcopy, bf16* hrow, int lane) {
    f32x4 v[4]; float s = 0.f;
#pragma unroll
    for (int j = 0; j < 4; ++j) { v[j] = *(const f32x4*)(xrow + 4 * lane + 256 * j); s += (v[j].x * v[j].x + v[j].y * v[j].y) + (v[j].z * v[j].z + v[j].w * v[j].w); }
    const float rs = 1.0f / sqrtf(wave_sum(s) * (1.f / D) + EPS);
#pragma unroll
    for (int j = 0; j < 4; ++j) { const f32x4 gg = *(const f32x4*)(g + 4 * lane + 256 * j);
        if (xcopy) *(f32x4*)(xcopy + 4 * lane + 256 * j) = v[j];
        u32x2 o; o.x = pk2(v[j].x * rs * gg.x, v[j].y * rs * gg.y); o.y = pk2(v[j].z * rs * gg.z, v[j].w * rs * gg.w);
        *(u32x2*)(hrow + 4 * lane + 256 * j) = o; }
}
__device__ __forceinline__ void p_prep(ArgsP a, const Ctx& c0, LAS unsigned char* lds) {
    const Ctx c = refresh(c0);
    LAS float* scr = (LAS float*)(lds + c.wave * 16384);
    constexpr int I0 = 16 * 17, I1 = 4 * 48, I2 = 4 * 32, I3 = 4 * 32, I4 = 16 * 32, I7 = 16 * 128, I9 = 64 * 32;
    constexpr int NIT = I0 + I1 + I2 + I3 + I4 + I7 + I9;
    for (int it = c.gw; it < NIT; it += c.ngw) {
        int r = it;
        if (r < I0) { tr_item(IN_F(11), 544, 17, r, WSB(WS_WIN0), 1024, RmId{0}, scr, c.lane); continue; } r -= I0;
        if (r < I1) { tr_item(IN_F(13), 1536, 48, r, WSB(WS_WUQ), 256, RmUq{}, scr, c.lane); continue; } r -= I1;
        if (r < I2) { tr_item(IN_F(15), 1024, 32, r, WSB(WS_WUKV), 256, RmId{0}, scr, c.lane); continue; } r -= I2;
        if (r < I3) { tr_item(IN_F(16), 1024, 32, r, WSB(WS_WUKV), 256, RmId{1024}, scr, c.lane); continue; } r -= I3;
        if (r < I4) { tr_item(IN_F(17), 1024, 32, r, WSB(WS_WO0), 1024, RmId{0}, scr, c.lane); continue; } r -= I4;
        if (r < I7) { tr_item(IN_F(23), 4096, 128, r, WSB(WS_WUP), 1024, RmId{0}, scr, c.lane); continue; } r -= I7;
        tr_item(IN_F(24), 1024, 32, r, WSB(WS_WDN), 4096, RmId{0}, scr, c.lane);
    }
    const int gt = c.gw * 64 + c.lane, ngt = c.ngw * 64;
    for (int i = gt; i < (NIN0 - 544) * 1024 / 2; i += ngt) ((unsigned*)(WSB(WS_WIN0) + (size_t)544 * 1024))[i] = 0u;
    for (int i = c.gw * 64 + c.lane; i < R * 16; i += c.ngw * 64) { const int r = i >> 4, j = i & 15; float cs, sn; rope_cs(row_pos(r), j, cs, sn); WSF(WS_ROPE)[(size_t)r * 32 + j] = cs; WSF(WS_ROPE)[(size_t)r * 32 + 16 + j] = sn; }
    {
        const float* xp = IN_F(0); const float* xm = IN_F(6); const float* xsm = IN_F(1); bf16* X = WSB(WS_X); bf16* H = WSB(WS_H);
        f32x4 gg[4];
#pragma unroll
        for (int j = 0; j < 4; ++j) gg[j] = *(const f32x4*)(IN_F(7) + 4 * c.lane + 256 * j);
        constexpr int NR = 4;
        for (int r0 = c.gw; r0 < R; r0 += NR * c.ngw) {
            f32x4 v[NR][4]; float s[NR];
#pragma unroll
            for (int q = 0; q < NR; ++q) { const int r = r0 + q * c.ngw < R ? r0 + q * c.ngw : r0;
                const float* xs = r < RMAIN ? xp + (size_t)r * D : (r < RSAMP0 ? xm + (size_t)((r - RMAIN) & 15) * D : xsm + (size_t)(r - RSAMP0) * D);
                s[q] = 0.f;
#pragma unroll
                for (int j = 0; j < 4; ++j) { v[q][j] = *(const f32x4*)(xs + 4 * c.lane + 256 * j); s[q] += (v[q][j].x * v[q][j].x + v[q][j].y * v[q][j].y) + (v[q][j].z * v[q][j].z + v[q][j].w * v[q][j].w); } }
#pragma unroll
            for (int sh = 1; sh < 64; sh <<= 1) {
#pragma unroll
                for (int q = 0; q < NR; ++q) s[q] += __shfl_xor(s[q], sh); }
#pragma unroll
            for (int q = 0; q < NR; ++q) { const int r = r0 + q * c.ngw < R ? r0 + q * c.ngw : r0; const float rs = 1.0f / sqrtf(s[q] * (1.f / D) + EPS);
#pragma unroll
                for (int j = 0; j < 4; ++j) { if (r >= RMAIN) { u32x2 xo; xo.x = pk2(v[q][j].x, v[q][j].y); xo.y = pk2(v[q][j].z, v[q][j].w); *(u32x2*)(X + (size_t)r * D + 4 * c.lane + 256 * j) = xo; }
                    u32x2 o; o.x = pk2(v[q][j].x * rs * gg[j].x, v[q][j].y * rs * gg[j].y); o.y = pk2(v[q][j].z * rs * gg[j].z, v[q][j].w * rs * gg[j].w);
                    *(u32x2*)(H + (size_t)r * D + 4 * c.lane + 256 * j) = o; } }
        }
    }
}

__device__ __forceinline__ void p_late_weights(ArgsP a, const Ctx& c0, LAS unsigned char* lds, int wg0) {
    const Ctx c = refresh(c0);
    const int bx = (int)blockIdx.x - wg0; if (bx < 0) return;
    const int gw = bx * 8 + c.wave, ngw = ((int)gridDim.x - wg0) * 8;
    LAS float* scr = (LAS float*)(lds + c.wave * 16384);
    constexpr int I5 = 16 * 96, I6 = 16 * 32, I8 = 16 * 128, I10 = 64 * 32, NIT = I5 + I6 + I8 + I10;
    for (int it = gw; it < NIT; it += ngw) {
        int r = it;
        if (r < I5) { tr_item(IN_F(18), 3088, 96, r, WSB(WS_WGIN), 1024, RmId{0}, scr, c.lane); continue; } r -= I5;
        if (r < I6) { tr_item(IN_F(22), 1024, 32, r, WSB(WS_WGO), 1024, RmId{0}, scr, c.lane); continue; } r -= I6;
        if (r < I8) { tr_item(IN_F(23) + (size_t)1024 * 4096, 4096, 128, r, WSB(WS_WUP) + (size_t)4096 * 1024, 1024, RmId{0}, scr, c.lane); continue; } r -= I8;
        tr_item(IN_F(24) + (size_t)4096 * 1024, 1024, 32, r, WSB(WS_WDN) + (size_t)1024 * 4096, 4096, RmId{0}, scr, c.lane);
    }
    const int gt = gw * 64 + c.lane, ngt = ngw * 64;
    for (int i = gt; i < (NGIN - NGIN_REAL) * 1024 / 2; i += ngt) ((unsigned*)(WSB(WS_WGIN) + (size_t)NGIN_REAL * 1024))[i] = 0u;
    for (int i = gt; i < 16 * 1024; i += ngt) { const int n = i >> 10, k = i & 1023; WSB(WS_WGIN)[(size_t)(3072 + n) * 1024 + k] = (bf16)f2bf(IN_F(18)[(size_t)k * 3088 + 3072 + n]); }
}
struct EpiF32 { float* C; int ldc; __device__ __forceinline__ void store4(int row, int col, f32x4 v) const { *(f32x4*)(C + (size_t)row * ldc + col) = v; } };
struct EpiBf16 { bf16* C; int ldc;
    __device__ __forceinline__ void store8(int row, int col, f32x4 a, f32x4 b) const { u32x4 o; o.x = pk2(a.x, a.y); o.y = pk2(a.z, a.w); o.z = pk2(b.x, b.y); o.w = pk2(b.z, b.w); *(u32x4*)(C + (size_t)row * ldc + col) = o; }
    __device__ __forceinline__ void store4(int row, int col, f32x4 v) const { u32x2 o; o.x = pk2(v.x, v.y); o.y = pk2(v.z, v.w); *(u32x2*)(C + (size_t)row * ldc + col) = o; } };
struct EpiRelu2 { bf16* C; int ldc;
    __device__ __forceinline__ void store8(int row, int col, f32x4 a, f32x4 b) const {
        f32x4 r; r.x = fmaxf(a.x, 0.f); r.y = fmaxf(a.y, 0.f); r.z = fmaxf(a.z, 0.f); r.w = fmaxf(a.w, 0.f); r = r * r;
        f32x4 s; s.x = fmaxf(b.x, 0.f); s.y = fmaxf(b.y, 0.f); s.z = fmaxf(b.z, 0.f); s.w = fmaxf(b.w, 0.f); s = s * s;
        u32x4 o; o.x = pk2(r.x, r.y); o.y = pk2(r.z, r.w); o.z = pk2(s.x, s.y); o.w = pk2(s.z, s.w); *(u32x4*)(C + (size_t)row * ldc + col) = o; }
    __device__ __forceinline__ void store4(int row, int col, f32x4 v) const {
    f32x4 r; r.x = fmaxf(v.x, 0.f); r.y = fmaxf(v.y, 0.f); r.z = fmaxf(v.z, 0.f); r.w = fmaxf(v.w, 0.f); r = r * r;
    u32x2 o; o.x = pk2(r.x, r.y); o.y = pk2(r.z, r.w); *(u32x2*)(C + (size_t)row * ldc + col) = o; } };
struct EpiQ { bf16* QN; bf16* QPE; const float* ROPE;
    __device__ __forceinline__ void store8(int row, int col, f32x4 a, f32x4 b) const {
        if (col < 1024) { u32x4 o; o.x = pk2(a.x * QSCALE, a.y * QSCALE); o.y = pk2(a.z * QSCALE, a.w * QSCALE); o.z = pk2(b.x * QSCALE, b.y * QSCALE); o.w = pk2(b.z * QSCALE, b.w * QSCALE); *(u32x4*)(QN + (size_t)row * 1024 + col) = o; }
        else { store4(row, col, a); store4(row, col + 4, b); }
    }
    __device__ __forceinline__ void store4(int row, int col, f32x4 v) const {
        if (col < 1024) { u32x2 o; o.x = pk2(v.x * QSCALE, v.y * QSCALE); o.y = pk2(v.z * QSCALE, v.w * QSCALE); *(u32x2*)(QN + (size_t)row * 1024 + col) = o; }
        else { const int p0 = (col - 1024) >> 1; const float* rt = ROPE + (size_t)row * 32;
#pragma unroll
            for (int e = 0; e < 2; ++e) { const int p = p0 + e, h = p >> 4, jj = p & 15; const float x1 = e ? v.z : v.x, x2 = e ? v.w : v.y, cs = rt[jj], sn = rt[16 + jj];
                QPE[(size_t)row * 512 + h * 32 + jj] = (bf16)f2bf((x1 * cs - x2 * sn) * QSCALE); QPE[(size_t)row * 512 + h * 32 + 16 + jj] = (bf16)f2bf((x1 * sn + x2 * cs) * QSCALE); } }
    } };
struct EpiBf16S { bf16* C; int ldc; float s;
    __device__ __forceinline__ void store8(int row, int col, f32x4 a, f32x4 b) const { u32x4 o; o.x = pk2(a.x * s, a.y * s); o.y = pk2(a.z * s, a.w * s); o.z = pk2(b.x * s, b.y * s); o.w = pk2(b.z * s, b.w * s); *(u32x4*)(C + (size_t)row * ldc + col) = o; }
    __device__ __forceinline__ void store4(int row, int col, f32x4 v) const { u32x2 o; o.x = pk2(v.x * s, v.y * s); o.y = pk2(v.z * s, v.w * s); *(u32x2*)(C + (size_t)row * ldc + col) = o; } };
struct EpiGla { bf16 *QG, *KG, *VG, *RG; float* GD;
    __device__ __forceinline__ void store8(int row, int col, f32x4 a, f32x4 b) const {
        if (col < 3072) { bf16* dst; int cc;
            if (col < 512) { dst = QG + (size_t)row * 512; cc = col; a = a * GLA_SCALE; b = b * GLA_SCALE; }
            else if (col < 1024) { dst = KG + (size_t)row * 512; cc = col - 512; }
            else if (col < 2048) { dst = VG + (size_t)row * 1024; cc = col - 1024; }
            else { dst = RG + (size_t)row * 1024; cc = col - 2048; }
            u32x4 o; o.x = pk2(a.x, a.y); o.y = pk2(a.z, a.w); o.z = pk2(b.x, b.y); o.w = pk2(b.z, b.w); *(u32x4*)(dst + cc) = o;
        } else if (col < 3088) { *(f32x4*)(GD + (size_t)row * 16 + (col - 3072)) = a; *(f32x4*)(GD + (size_t)row * 16 + (col - 3072) + 4) = b; }
    }
    __device__ __forceinline__ void store4(int row, int col, f32x4 v) const {
        if (col < 3072) { bf16* dst; int cc;
            if (col < 512) { dst = QG + (size_t)row * 512; cc = col; v = v * GLA_SCALE; }
            else if (col < 1024) { dst = KG + (size_t)row * 512; cc = col - 512; }
            else if (col < 2048) { dst = VG + (size_t)row * 1024; cc = col - 1024; }
            else { dst = RG + (size_t)row * 1024; cc = col - 2048; }
            u32x2 o; o.x = pk2(v.x, v.y); o.y = pk2(v.z, v.w); *(u32x2*)(dst + cc) = o;
        } else if (col < 3088) { *(f32x4*)(GD + (size_t)row * 16 + (col - 3072)) = v; }
    } };
template <class Epi>
__device__ __forceinline__ void gemm_naive(const bf16* A, const bf16* Bt, int M, int N, int K, const Epi& E, LAS unsigned char* lds, int tid) {
    LAS float* As = (LAS float*)lds;
    LAS float* Bs = As + 32 * 68;
    const int ntm = M / 64, ntn = N / 128, ty = tid >> 5, tx = tid & 31;
    for (int tile = blockIdx.x; tile < ntm * ntn; tile += gridDim.x) {
        const int tm = tile / ntn, tn = tile % ntn;
        f32x4 acc[4];
#pragma unroll
        for (int i = 0; i < 4; ++i) acc[i] = (f32x4){0.f, 0.f, 0.f, 0.f};
        for (int k0 = 0; k0 < K; k0 += 32) {
            { const int row = tid >> 3, kq = (tid & 7) * 4; const u32x2 v = *(const u32x2*)(A + (size_t)(tm * 64 + row) * K + k0 + kq);
              As[(kq + 0) * 68 + row] = bflo(v.x); As[(kq + 1) * 68 + row] = bfhi(v.x); As[(kq + 2) * 68 + row] = bflo(v.y); As[(kq + 3) * 68 + row] = bfhi(v.y); }
            { const int row = tid >> 2, kq = (tid & 3) * 8; const u32x4 v = *(const u32x4*)(Bt + (size_t)(tn * 128 + row) * K + k0 + kq);
              Bs[(kq + 0) * 132 + row] = bflo(v.x); Bs[(kq + 1) * 132 + row] = bfhi(v.x); Bs[(kq + 2) * 132 + row] = bflo(v.y); Bs[(kq + 3) * 132 + row] = bfhi(v.y);
              Bs[(kq + 4) * 132 + row] = bflo(v.z); Bs[(kq + 5) * 132 + row] = bfhi(v.z); Bs[(kq + 6) * 132 + row] = bflo(v.w); Bs[(kq + 7) * 132 + row] = bfhi(v.w); }
            __syncthreads();
#pragma unroll 8
            for (int k = 0; k < 32; ++k) {
                const f32x4 av = *(const LAS f32x4*)(As + k * 68 + 4 * ty); const f32x4 bv = *(const LAS f32x4*)(Bs + k * 132 + 4 * tx);
                acc[0] += av.x * bv; acc[1] += av.y * bv; acc[2] += av.z * bv; acc[3] += av.w * bv;
            }
            __syncthreads();
        }
#pragma unroll
        for (int i = 0; i < 4; ++i) E.store4(tm * 64 + 4 * ty + i, tn * 128 + 4 * tx, acc[i]);
    }
}


template <class E> struct EpiWrap {
    static constexpr bool PERM = false, AFTER_DRAIN = false; E e;
    __device__ __forceinline__ void operator()(const pg8::f32x4 (&acc)[2][2][4][2], const pg8::Unit& u, int wr, int wc, int fr, int fq) const {
#pragma unroll
        for (int ai = 0; ai < 2; ++ai)
#pragma unroll
            for (int m = 0; m < 4; ++m) { const int row = u.pm * 256 + ai * 128 + wr * 64 + m * 16 + fr;
#pragma unroll
                for (int bj = 0; bj < 2; ++bj)
#pragma unroll
                    for (int n = 0; n < 2; ++n) e.store4(row, u.pn * 256 + bj * 128 + wc * 32 + n * 16 + 4 * fq, acc[ai][bj][m][n]); }
    }
};
template <int KSUB> struct EpiSlab {
    static constexpr bool PERM = false, AFTER_DRAIN = false; float* MT;
    __device__ __forceinline__ void operator()(const pg8::f32x4 (&acc)[2][2][4][2], const pg8::Unit& u, int wr, int wc, int fr, int fq) const {
        float* base = MT + ((size_t)(u.k0 / KSUB) * (RP - RMAIN) + (size_t)(u.pm * 256 - RMAIN)) * D + u.pn * 256 + wc * 32 + 4 * fq;
#pragma unroll
        for (int ai = 0; ai < 2; ++ai)
#pragma unroll
            for (int m = 0; m < 4; ++m) { float* rp = base + (size_t)(ai * 128 + wr * 64 + m * 16 + fr) * D;
#pragma unroll
                for (int bj = 0; bj < 2; ++bj)
#pragma unroll
                    for (int n = 0; n < 2; ++n) *(f32x4*)(rp + bj * 128 + n * 16) = acc[ai][bj][m][n]; }
    }
};
template <class E> struct EpiWrap8 {
    static constexpr bool PERM = true, AFTER_DRAIN = false; E e;
    __device__ __forceinline__ void operator()(const pg8::f32x4 (&acc)[2][2][4][2], const pg8::Unit& u, int wr, int wc, int fr, int fq) const {
#pragma unroll
        for (int ai = 0; ai < 2; ++ai)
#pragma unroll
            for (int m = 0; m < 4; ++m) { const int row = u.pm * 256 + ai * 128 + wr * 64 + m * 16 + fr;
#pragma unroll
                for (int bj = 0; bj < 2; ++bj) e.store8(row, u.pn * 256 + bj * 128 + wc * 32 + 8 * fq, acc[ai][bj][m][0], acc[ai][bj][m][1]); }
    }
};
template <class E>
__device__ __forceinline__ void gemm_mfma8(const bf16* A, const bf16* Bt, int M, int N, int K, const E& e, LAS unsigned char* lds, int wave) {
    pg8::Gemm g{A, Bt, M, N, K, K}; pg8::StaticOrder S; S.init(M, N, (int)gridDim.x, (int)blockIdx.x);
    EpiWrap8<E> W{e};
    pg8::gemm_phase<EpiWrap8<E>, pg8::StaticOrder, true, true>(lds, g, S, W, wave);
}
template <class E>
__device__ __forceinline__ void gemm_mfma(const bf16* A, const bf16* Bt, int M, int N, int K, const E& e, LAS unsigned char* lds, int wave) {
    pg8::Gemm g{A, Bt, M, N, K, K}; pg8::StaticOrder S; S.init(M, N, (int)gridDim.x, (int)blockIdx.x);
    EpiWrap<E> W{e};
    pg8::gemm_phase<EpiWrap<E>, pg8::StaticOrder, true, true>(lds, g, S, W, wave);
}
template <int SPLIT, int NN, int KSUB, int PM0, int NUNITS> struct TailOrder {
    int G, c;
    __device__ __forceinline__ bool next(int i, pg8::Unit& u) const { const int L = i * G + c; if (L >= NUNITS) return false; const int ks = L % SPLIT, t = L / SPLIT; u.pn = t % NN; u.pm = PM0 + t / NN; u.k0 = ks * KSUB; u.prob = 0; u.aoff = 0; u.boff = 0; return true; }
    __device__ __forceinline__ void a_ready(const pg8::Unit&) const {}
    __device__ __forceinline__ void done(const pg8::Unit&) const {}
};
struct EpiAtomicF32 { float* C; int ldc; __device__ __forceinline__ void store4(int row, int col, f32x4 v) const { float* p = C + (size_t)row * ldc + col;
    __hip_atomic_fetch_add(p, v.x, __ATOMIC_RELAXED, __HIP_MEMORY_SCOPE_AGENT); __hip_atomic_fetch_add(p + 1, v.y, __ATOMIC_RELAXED, __HIP_MEMORY_SCOPE_AGENT);
    __hip_atomic_fetch_add(p + 2, v.z, __ATOMIC_RELAXED, __HIP_MEMORY_SCOPE_AGENT); __hip_atomic_fetch_add(p + 3, v.w, __ATOMIC_RELAXED, __HIP_MEMORY_SCOPE_AGENT); } };
template <int K, int SPLIT>
__device__ __forceinline__ void gemm_n1024_tail(const bf16* A, const bf16* Bt, bf16* C, float* MT, LAS unsigned char* lds, int wave) {
    { pg8::Gemm g{A, Bt, RMAIN, D, K, K}; pg8::StaticOrder S; S.init(RMAIN, D, (int)gridDim.x, (int)blockIdx.x); EpiWrap8<EpiBf16> W{EpiBf16{C, D}};
      pg8::gemm_phase<EpiWrap8<EpiBf16>, pg8::StaticOrder, true, true>(lds, g, S, W, wave); }
    { typedef TailOrder<SPLIT, D / 256, K / SPLIT, RMAIN / 256, (RP - RMAIN) / 256 * (D / 256) * SPLIT> TO;
      pg8::Gemm g{A, Bt, RP, D, K / SPLIT, K}; TO S{(int)gridDim.x, (int)blockIdx.x}; EpiSlab<K / SPLIT> W{MT};
      pg8::gemm_phase<EpiSlab<K / SPLIT>, TO, false, true>(lds, g, S, W, wave); }
}

struct P3Order {
    int G, c;
    static constexpr int NQ = (RP / 256) * (NUQ / 256), NL = (DB * DS / 256) * (NH * KVL / 256), NK = (RP / 256) * (NUKV / 256);
    __device__ __forceinline__ bool next(int i, pg8::Unit& u) const {
        int L = i * G + c; u.k0 = 0;
        if (L < NK) { u.prob = 2; u.pm = L / (NUKV / 256); u.pn = L % (NUKV / 256); u.aoff = (long)(WS_CKVN - WS_CQN); u.boff = (long)(WS_WUKV - WS_WUQ); return true; } L -= NK;
        if (L < NQ) { u.prob = 0; u.pm = L / (NUQ / 256); u.pn = L % (NUQ / 256); u.aoff = 0; u.boff = 0; return true; } L -= NQ;
        if (L < NL) { u.prob = 1; u.pm = L / (NH * KVL / 256); u.pn = L % (NH * KVL / 256); u.aoff = (long)RSAMP0 * QL * 2; u.boff = (long)(WS_WUQL - WS_WUQ); return true; }
        return false;
    }
    __device__ __forceinline__ void a_ready(const pg8::Unit&) const {}
    __device__ __forceinline__ void done(const pg8::Unit&) const {}
};
struct EpiP3 {
    static constexpr bool PERM = true, AFTER_DRAIN = false; EpiQ eq; EpiBf16S el; EpiBf16 ek;
    __device__ __forceinline__ void operator()(const pg8::f32x4 (&acc)[2][2][4][2], const pg8::Unit& u, int wr, int wc, int fr, int fq) const {
        asm volatile("" : "+v"(fr), "+v"(fq));
        if (u.prob == 0) { EpiWrap8<EpiQ> w{eq}; w(acc, u, wr, wc, fr, fq); }
        else if (u.prob == 1) { EpiWrap8<EpiBf16S> w{el}; w(acc, u, wr, wc, fr, fq); }
        else { EpiWrap8<EpiBf16> w{ek}; w(acc, u, wr, wc, fr, fq); }
    }
};
__device__ __forceinline__ void gemm_p3(ArgsP a, LAS unsigned char* lds, int wave) {
    pg8::Gemm g{WSB(WS_CQN), WSB(WS_WUQ), RP, NUQ, QL, QL}; P3Order S{(int)gridDim.x, (int)blockIdx.x};
    EpiP3 E{EpiQ{WSB(WS_QN), WSB(WS_QPE), WSF(WS_ROPE)}, EpiBf16S{WSB(WS_QLAT), NH * KVL, QSCALE}, EpiBf16{WSB(WS_KNV), NUKV}};
    pg8::gemm_phase<EpiP3, P3Order, false, true>(lds, g, S, E, wave);
}

struct EpiMlaIn {
    static constexpr bool PERM = false, AFTER_DRAIN = true;
    bf16 *CQN, *CKVN, *KPEB; const float *qg, *kg, *ROPE; float* out;
    __device__ __forceinline__ void fused(pg8::f32x4 (&acc)[2][2][4][2], const pg8::Unit& u, int wr, int wc, int fr, int fq, PG8_LAS unsigned char* lds, int wid, int lane) const {
        asm volatile("" : "+v"(fr), "+v"(fq));
        if (u.pn < 2) {
            PG8_LAS float* P = (PG8_LAS float*)lds;
            float s[2][4];
#pragma unroll
            for (int ai = 0; ai < 2; ++ai)
#pragma unroll
                for (int m = 0; m < 4; ++m) { float t = 0.f;
#pragma unroll
                    for (int bj = 0; bj < 2; ++bj)
#pragma unroll
                        for (int n = 0; n < 2; ++n) { const pg8::f32x4 x = acc[ai][bj][m][n]; t += (x[0] * x[0] + x[1] * x[1]) + (x[2] * x[2] + x[3] * x[3]); }
                    t += __shfl_xor(t, 16); t += __shfl_xor(t, 32);
                    if (fq == 0) P[(ai * 128 + wr * 64 + m * 16 + fr) * 4 + wc] = t; }
            asm volatile("s_waitcnt lgkmcnt(0)\n\ts_barrier" ::: "memory");
#pragma unroll
            for (int ai = 0; ai < 2; ++ai)
#pragma unroll
                for (int m = 0; m < 4; ++m) { const pg8::f32x4 p4 = *(const PG8_LAS pg8::f32x4*)(P + (ai * 128 + wr * 64 + m * 16 + fr) * 4); s[ai][m] = 1.0f / sqrtf(((p4[0] + p4[1]) + (p4[2] + p4[3])) * (1.f / 256) + EPS); }
            const float* g = u.pn == 0 ? qg : kg; bf16* dst = u.pn == 0 ? CQN : CKVN;
#pragma unroll
            for (int bj = 0; bj < 2; ++bj)
#pragma unroll
                for (int n = 0; n < 2; ++n) { const int col = bj * 128 + wc * 32 + n * 16 + 4 * fq; const pg8::f32x4 gv = *(const pg8::f32x4*)(g + col);
#pragma unroll
                    for (int ai = 0; ai < 2; ++ai)
#pragma unroll
                        for (int m = 0; m < 4; ++m) { const int row = u.pm * 256 + ai * 128 + wr * 64 + m * 16 + fr; if (row >= R) continue;
                            const pg8::f32x4 y = acc[ai][bj][m][n] * s[ai][m] * gv;
                            u32x2 o; o.x = pk2(y[0], y[1]); o.y = pk2(y[2], y[3]); *(u32x2*)(dst + (size_t)row * 256 + col) = o;
                            if (u.pn == 1) { const int pos = row_pos(row); float* oc = row < RSAMP0 ? out + O_CKVP + ((size_t)(row < RMAIN ? (row >> 12) : ((row - RMAIN) >> 4)) * TP + pos) * 256 : out + O_CKVS + (size_t)(row - RSAMP0) * 256;
                                *(pg8::f32x4*)(oc + col) = y; } } }
        } else if (wc == 0) {
#pragma unroll
            for (int ai = 0; ai < 2; ++ai)
#pragma unroll
                for (int m = 0; m < 4; ++m) { const int row = u.pm * 256 + ai * 128 + wr * 64 + m * 16 + fr; if (row >= R) continue;
                    const int pos = row_pos(row); const float* rt = ROPE + (size_t)row * 32 + 4 * fq; const pg8::f32x4 cs = *(const pg8::f32x4*)rt, sn = *(const pg8::f32x4*)(rt + 16);
                    const pg8::f32x4 x1 = acc[ai][0][m][0], x2 = acc[ai][0][m][1]; const pg8::f32x4 o1 = x1 * cs - x2 * sn, o2 = x1 * sn + x2 * cs;
                    float* ok = row < RSAMP0 ? out + O_KPEP + ((size_t)(row < RMAIN ? (row >> 12) : ((row - RMAIN) >> 4)) * TP + pos) * 32 : out + O_KPES + (size_t)(row - RSAMP0) * 32;
                    *(pg8::f32x4*)(ok + 4 * fq) = o1; *(pg8::f32x4*)(ok + 16 + 4 * fq) = o2;
                    u32x2 w; w.x = pk2(o1[0], o1[1]); w.y = pk2(o1[2], o1[3]); *(u32x2*)(KPEB + (size_t)row * 32 + 4 * fq) = w; w.x = pk2(o2[0], o2[1]); w.y = pk2(o2[2], o2[3]); *(u32x2*)(KPEB + (size_t)row * 32 + 16 + 4 * fq) = w; }
        }
    }
};
__device__ __forceinline__ void gemm_p1(ArgsP a, LAS unsigned char* lds, int wave) {
    pg8::Gemm g{WSB(WS_H), WSB(WS_WIN0), RP, NIN0, D, D}; pg8::StaticOrder S; S.init(RP, NIN0, (int)gridDim.x, (int)blockIdx.x);
    EpiMlaIn E{WSB(WS_CQN), WSB(WS_CKVN), WSB(WS_KPE), IN_F(12), IN_F(14), WSF(WS_ROPE), a->out};
    pg8::gemm_phase<EpiMlaIn, pg8::StaticOrder, false, true>(lds, g, S, E, wave);
}
#ifndef USE_NAIVE_ATTN
#define USE_NAIVE_ATTN 0
#endif
#ifndef USE_NAIVE_DECODE
#define USE_NAIVE_DECODE 0
#endif
#ifndef USE_NAIVE_GLA
#define USE_NAIVE_GLA 0
#endif
#ifndef PROBE
#define PROBE 0
#endif
#ifndef PROBE_LO
#define PROBE_LO -1
#define PROBE_HI -1
#endif
#ifndef USE_NAIVE_GEMM
#define USE_NAIVE_GEMM 0
#endif
#if USE_NAIVE_GEMM
#define GEMM(A, Bt, M, N, K, E) gemm_naive(A, Bt, M, N, K, E, lds, fresh_tid(c.wave))
#else
#define GEMM(A, Bt, M, N, K, E) gemm_mfma(A, Bt, M, N, K, E, lds, c.wave)
#endif


namespace att {
typedef short bf16x8 __attribute__((ext_vector_type(8)));
typedef short s16x4 __attribute__((ext_vector_type(4)));
typedef float f32x16 __attribute__((ext_vector_type(16)));
constexpr int KSLOT = 12288, VSLOT = 8192, LDS_K = 0, LDS_V = 2 * KSLOT, LDS_WS = LDS_V + 2 * VSLOT, LDS_OST = LDS_WS + 8 * 256, LDS_TOTAL = LDS_OST + 8 * 4096;
__device__ __forceinline__ int crow(int r, int hi) { return (r & 3) + 8 * (r >> 2) + 4 * hi; }
typedef float f32x2_t __attribute__((ext_vector_type(2))); typedef __bf16 bf16x2_t __attribute__((ext_vector_type(2)));
__device__ __forceinline__ unsigned cvtpk(float lo, float hi) { f32x2_t v = {lo, hi}; bf16x2_t b = __builtin_convertvector(v, bf16x2_t); return __builtin_bit_cast(unsigned, b); }
__device__ __forceinline__ s16x4 vtr(const LAS unsigned char* p) { typedef short v4i16_t __attribute__((ext_vector_type(4))); return __builtin_bit_cast(s16x4, __builtin_amdgcn_ds_read_tr16_b64_v4i16((LAS v4i16_t*)p)); }
__device__ __forceinline__ float pmax32(float m) { auto rr = __builtin_amdgcn_permlane32_swap(__float_as_uint(m), __float_as_uint(m), false, false); return fmaxf(__uint_as_float(rr[0]), __uint_as_float(rr[1])); }
__device__ __forceinline__ float psum32(float m) { auto rr = __builtin_amdgcn_permlane32_swap(__float_as_uint(m), __float_as_uint(m), false, false); return __uint_as_float(rr[0]) + __uint_as_float(rr[1]); }
#define ATT_WAIT_BAR() asm volatile("s_waitcnt vmcnt(0) lgkmcnt(0)\n\ts_barrier" ::: "memory")
__device__ __forceinline__ void glds16(const void* gsrc, unsigned lds_dst) { unsigned keep;
    asm volatile("s_mov_b32 %0, m0\n\ts_mov_b32 m0, %2\n\ts_nop 0\n\tglobal_load_lds_dwordx4 %1, off\n\ts_mov_b32 m0, %0" : "=&s"(keep) : "v"(gsrc), "s"(lds_dst) : "memory"); }

__device__ __forceinline__ void attn_unit(int b, int h, int qb, const bf16* QN, const bf16* QPE, const bf16* KNV, const bf16* KPE, bf16* O, LAS unsigned char* lds, int wave_id) {
    const int tid = fresh_tid(wave_id), lane = tid & 63, r32 = lane & 31, hi = lane >> 5; const int wid = wave_id;
    const int rowbase = b * SEQ, q0 = qb * 256, qrow = rowbase + q0 + wid * 32 + r32, qrel = q0 + wid * 32 + r32;
    bf16x8 qr[6];
#pragma unroll
    for (int d0 = 0; d0 < 4; ++d0) qr[d0] = *(const bf16x8*)(QN + (size_t)qrow * 1024 + h * 64 + d0 * 16 + hi * 8);
#pragma unroll
    for (int d0 = 0; d0 < 2; ++d0) qr[4 + d0] = *(const bf16x8*)(QPE + (size_t)qrow * 512 + h * 32 + d0 * 16 + hi * 8);
    LAS float* wsf = (LAS float*)(lds + LDS_WS) + wid * 64;
    const int NT = 4 * qb + 4;
#define ATT_DMA(t, slot) do { const size_t row0_ = (t) == 0 ? (size_t)(RMAIN + 16 * b) : (size_t)(rowbase + 64 * ((t) - 1)); \
        __builtin_amdgcn_global_load_lds((const unsigned*)(KNV + (row0_ + lane) * 2048 + h * 64 + wid * 8), (LAS unsigned*)(lds + LDS_K + (slot) * KSLOT + wid * 1024), 16, 0, 0); \
        if (wid < 4) __builtin_amdgcn_global_load_lds((const unsigned*)(KPE + (row0_ + lane) * 32 + wid * 8), (LAS unsigned*)(lds + LDS_K + (slot) * KSLOT + (8 + wid) * 1024), 16, 0, 0); \
        __builtin_amdgcn_global_load_lds((const unsigned*)(KNV + (row0_ + 16 * (wid & 3) + (lane >> 2)) * 2048 + 1024 + h * 64 + (wid >> 2) * 32 + (lane & 3) * 8), (LAS unsigned*)(lds + LDS_V + (slot) * VSLOT + wid * 1024), 16, 0, 0); } while (0)
    f32x16 o[2]; o[0] = f32x16{}; o[1] = f32x16{};
    float mref = -INFINITY, l = 0.f;
    ATT_DMA(0, 0);
    for (int t = 0; t <= NT; ++t) {
        ATT_WAIT_BAR();
        const int slot = t & 1;
        if (t < NT) ATT_DMA(t + 1, slot ^ 1);
        const int kt0 = 64 * (t - 1);
        if (t > 0 && kt0 > q0 + wid * 32 + 31) continue;
        f32x16 p0 = f32x16{}, p1 = f32x16{};
        const LAS unsigned char* kb = lds + LDS_K + slot * KSLOT + hi * 1024 + r32 * 16;
#pragma unroll
        for (int d0 = 0; d0 < 6; ++d0) {
            const bf16x8 b0 = *(const LAS bf16x8*)(kb + d0 * 2048), b1 = *(const LAS bf16x8*)(kb + d0 * 2048 + 512);
            p0 = __builtin_amdgcn_mfma_f32_32x32x16_bf16(b0, qr[d0], p0, 0, 0, 0);
            p1 = __builtin_amdgcn_mfma_f32_32x32x16_bf16(b1, qr[d0], p1, 0, 0, 0);
        }
        if (t == 0) {
#pragma unroll
            for (int r = 0; r < 16; ++r) { if (crow(r, hi) >= NMETA) p0[r] = -INFINITY; p1[r] = -INFINITY; }
        } else if (kt0 + 63 > q0 + wid * 32) {
#pragma unroll
            for (int r = 0; r < 16; ++r) { const int kv = kt0 + crow(r, hi); if (kv > qrel) p0[r] = -INFINITY; if (kv + 32 > qrel) p1[r] = -INFINITY; }
        }
        float rm = fmaxf(p0[0], p1[0]);
#pragma unroll
        for (int r = 1; r < 16; ++r) rm = fmaxf(rm, fmaxf(p0[r], p1[r]));
        rm = pmax32(rm);
        if (__any(rm > mref + 8.0f)) {
            const float mnew = fmaxf(mref, rm); const float f = __builtin_amdgcn_exp2f(mref - mnew);
            mref = mnew; l *= f;
            if (hi == 0) wsf[r32] = f;
            LDS_WAIT();
#pragma unroll
            for (int r = 0; r < 16; ++r) { const float fr = wsf[crow(r, hi)]; o[0][r] *= fr; o[1][r] *= fr; }
        }
        float sacc = 0.f;
#pragma unroll
        for (int r = 0; r < 16; ++r) { p0[r] = __builtin_amdgcn_exp2f(p0[r] - mref); p1[r] = __builtin_amdgcn_exp2f(p1[r] - mref); sacc += p0[r] + p1[r]; }
        l += sacc;
        u32x4 pw[4];
#pragma unroll
        for (int i = 0; i < 4; ++i) { pw[0][i] = cvtpk(p0[2 * i], p0[2 * i + 1]); pw[1][i] = cvtpk(p0[8 + 2 * i], p0[8 + 2 * i + 1]); pw[2][i] = cvtpk(p1[2 * i], p1[2 * i + 1]); pw[3][i] = cvtpk(p1[8 + 2 * i], p1[8 + 2 * i + 1]); }
        const LAS unsigned char* vb = lds + LDS_V + slot * VSLOT + ((lane >> 4) & 1) * 32 + (lane & 3) * 8 + (4 * hi + ((lane & 15) >> 2)) * 64;
#pragma unroll
        for (int d0 = 0; d0 < 2; ++d0)
#pragma unroll
            for (int ks = 0; ks < 4; ++ks) {
                const s16x4 vlo = vtr(vb + d0 * 4096 + ks * 1024), vhi = vtr(vb + d0 * 4096 + ks * 1024 + 512);
                const bf16x8 vf = (bf16x8){vlo[0], vlo[1], vlo[2], vlo[3], vhi[0], vhi[1], vhi[2], vhi[3]};
                o[d0] = __builtin_amdgcn_mfma_f32_32x32x16_bf16(__builtin_bit_cast(bf16x8, pw[ks]), vf, o[d0], 0, 0, 0);
            }
    }
    l = psum32(l);
    if (hi == 0) wsf[32 + r32] = l;
    LDS_WAIT();
    bf16* Ow = O + (size_t)(rowbase + q0 + wid * 32) * 1024 + h * 64;
    LAS bf16* stg = (LAS bf16*)(lds + LDS_OST) + wid * 2048;
#pragma unroll
    for (int r = 0; r < 16; ++r) { const int orow = crow(r, hi); const float il = 1.0f / wsf[32 + orow];
        stg[orow * 64 + r32] = (bf16)f2bf(o[0][r] * il); stg[orow * 64 + 32 + r32] = (bf16)f2bf(o[1][r] * il); }
    LDS_WAIT();
#pragma unroll
    for (int i = 0; i < 4; ++i) { const int row = i * 8 + (lane >> 3), ch = lane & 7; const u32x4 v = *(const LAS u32x4*)(stg + row * 64 + ch * 8); *(u32x4*)(Ow + (size_t)row * 1024 + ch * 8) = v; }
    ATT_WAIT_BAR();
#undef ATT_DMA
}
constexpr int P_LDS_K = 0, P_LDS_V = 3 * KSLOT, P_LDS_WS = P_LDS_V + 2 * VSLOT, P_LDS_OST = P_LDS_WS + 8 * 256, P_LDS_TOTAL = P_LDS_OST + 8 * 4096;
__device__ __forceinline__ void attn_unit2(int b, int h, int qb, const bf16* QN, const bf16* QPE, const bf16* KNV, const bf16* KPE, bf16* O, LAS unsigned char* lds, int wave_id) {
    const int tid = fresh_tid(wave_id), lane = tid & 63, r32 = lane & 31, hi = lane >> 5; const int wid = wave_id;
    const bool meta = qb < 0;
    const int rowbase = b * SEQ, q0 = meta ? 0 : qb * 256, qrow = meta ? RMAIN + 16 * b + (r32 & 15) : rowbase + q0 + wid * 32 + r32, qrel = meta ? (r32 & 15) : q0 + wid * 32 + r32;
    bf16x8 qr[6];
#pragma unroll
    for (int d0 = 0; d0 < 4; ++d0) qr[d0] = *(const bf16x8*)(QN + (size_t)qrow * 1024 + h * 64 + d0 * 16 + hi * 8);
#pragma unroll
    for (int d0 = 0; d0 < 2; ++d0) qr[4 + d0] = *(const bf16x8*)(QPE + (size_t)qrow * 512 + h * 32 + d0 * 16 + hi * 8);
    LAS float* wsf = (LAS float*)(lds + P_LDS_WS) + wid * 64;
    const unsigned lds0 = (unsigned)(size_t)lds;
    const int NT = meta ? 0 : 4 * qb + 4;
#define A2_ROW0(t) ((t) == 0 ? (size_t)(RMAIN + 16 * b) : (size_t)(rowbase + 64 * ((t) - 1)))
#define A2_DMA_K(t, ks) do { const size_t row0_ = A2_ROW0(t); \
        glds16(KNV + (row0_ + lane) * 2048 + h * 64 + wid * 8, (unsigned)__builtin_amdgcn_readfirstlane((int)(lds0 + P_LDS_K + (ks) * KSLOT + wid * 1024))); \
        if (wid < 4) glds16(KPE + (row0_ + lane) * 32 + wid * 8, (unsigned)__builtin_amdgcn_readfirstlane((int)(lds0 + P_LDS_K + (ks) * KSLOT + (8 + wid) * 1024))); } while (0)
#define A2_DMA_V(t, vs) do { const size_t row0_ = A2_ROW0(t); \
        glds16(KNV + (row0_ + 16 * (wid & 3) + (lane >> 2)) * 2048 + 1024 + h * 64 + (wid >> 2) * 32 + (lane & 3) * 8, (unsigned)__builtin_amdgcn_readfirstlane((int)(lds0 + P_LDS_V + (vs) * VSLOT + wid * 1024))); } while (0)
#define A2_QKT(P0, P1, ks) do { P0 = f32x16{}; P1 = f32x16{}; const LAS unsigned char* kb_ = lds + P_LDS_K + (ks) * KSLOT + hi * 1024 + r32 * 16; \
        _Pragma("unroll") for (int d0 = 0; d0 < 6; ++d0) { const bf16x8 b0_ = *(const LAS bf16x8*)(kb_ + d0 * 2048), b1_ = *(const LAS bf16x8*)(kb_ + d0 * 2048 + 512); \
            P0 = __builtin_amdgcn_mfma_f32_32x32x16_bf16(b0_, qr[d0], P0, 0, 0, 0); P1 = __builtin_amdgcn_mfma_f32_32x32x16_bf16(b1_, qr[d0], P1, 0, 0, 0); } } while (0)
    f32x16 o[2]; o[0] = f32x16{}; o[1] = f32x16{};
    float mref = -INFINITY, l = 0.f;
#define A2_TILE(P0, P1, t, vs) do { \
        if ((t) == 0) { const int qlim_ = meta ? (r32 & 15) : NMETA - 1; _Pragma("unroll") for (int r = 0; r < 16; ++r) { if (crow(r, hi) > qlim_) P0[r] = -INFINITY; P1[r] = -INFINITY; } } \
        else { const int kt0_ = 64 * ((t) - 1); if (kt0_ + 63 > q0 + wid * 32) { _Pragma("unroll") for (int r = 0; r < 16; ++r) { const int kv = kt0_ + crow(r, hi); if (kv > qrel) P0[r] = -INFINITY; if (kv + 32 > qrel) P1[r] = -INFINITY; } } } \
        float rm_ = fmaxf(P0[0], P1[0]); \
        _Pragma("unroll") for (int r = 1; r < 16; ++r) rm_ = fmaxf(rm_, fmaxf(P0[r], P1[r])); \
        rm_ = pmax32(rm_); \
        if (__any(rm_ > mref + 8.0f)) { const float mnew = fmaxf(mref, rm_); const float f = __builtin_amdgcn_exp2f(mref - mnew); mref = mnew; l *= f; \
            if (hi == 0) wsf[r32] = f; LDS_WAIT(); \
            _Pragma("unroll") for (int r = 0; r < 16; ++r) { const float fr = wsf[crow(r, hi)]; o[0][r] *= fr; o[1][r] *= fr; } } \
        float sacc_ = 0.f; \
        _Pragma("unroll") for (int r = 0; r < 16; ++r) { P0[r] = __builtin_amdgcn_exp2f(P0[r] - mref); P1[r] = __builtin_amdgcn_exp2f(P1[r] - mref); sacc_ += P0[r] + P1[r]; } \
        l += sacc_; \
        u32x4 pw_[4]; \
        _Pragma("unroll") for (int i = 0; i < 4; ++i) { pw_[0][i] = cvtpk(P0[2 * i], P0[2 * i + 1]); pw_[1][i] = cvtpk(P0[8 + 2 * i], P0[8 + 2 * i + 1]); pw_[2][i] = cvtpk(P1[2 * i], P1[2 * i + 1]); pw_[3][i] = cvtpk(P1[8 + 2 * i], P1[8 + 2 * i + 1]); } \
        const LAS unsigned char* vb_ = lds + P_LDS_V + (vs) * VSLOT + ((lane >> 4) & 1) * 32 + (lane & 3) * 8 + (4 * hi + ((lane & 15) >> 2)) * 64; \
        _Pragma("unroll") for (int d0 = 0; d0 < 2; ++d0) _Pragma("unroll") for (int ks = 0; ks < 4; ++ks) { \
            const s16x4 vlo = vtr(vb_ + d0 * 4096 + ks * 1024), vhi = vtr(vb_ + d0 * 4096 + ks * 1024 + 512); \
            const bf16x8 vf = (bf16x8){vlo[0], vlo[1], vlo[2], vlo[3], vhi[0], vhi[1], vhi[2], vhi[3]}; \
            o[d0] = __builtin_amdgcn_mfma_f32_32x32x16_bf16(__builtin_bit_cast(bf16x8, pw_[ks]), vf, o[d0], 0, 0, 0); } } while (0)
    f32x16 pA0, pA1, pB0, pB1;
    A2_DMA_K(0, 0); A2_DMA_V(0, 0); if (NT >= 1) A2_DMA_K(1, 1);
    ATT_WAIT_BAR();
    A2_QKT(pA0, pA1, 0);
    int kc = 0, vc = 0, t = 0;
#define A2_STEP(PC0, PC1, PN0, PN1) do { \
        if (t > 0) ATT_WAIT_BAR(); \
        const int kn_ = kc == 2 ? 0 : kc + 1, k2_ = kn_ == 2 ? 0 : kn_ + 1; \
        if (t + 2 <= NT) A2_DMA_K(t + 2, k2_); \
        if (t + 1 <= NT) { A2_DMA_V(t + 1, vc ^ 1); A2_QKT(PN0, PN1, kn_); } \
        A2_TILE(PC0, PC1, t, vc); \
        kc = kn_; vc ^= 1; ++t; } while (0)
    while (t + 1 <= NT) { A2_STEP(pA0, pA1, pB0, pB1); A2_STEP(pB0, pB1, pA0, pA1); }
    A2_STEP(pA0, pA1, pB0, pB1);
    l = psum32(l);
    if (hi == 0) wsf[32 + r32] = l;
    LDS_WAIT();
    bf16* Ow = O + (size_t)(meta ? RMAIN + 16 * b : rowbase + q0 + wid * 32) * 1024 + h * 64;
    LAS bf16* stg = (LAS bf16*)(lds + P_LDS_OST) + wid * 2048;
#pragma unroll
    for (int r = 0; r < 16; ++r) { const int orow = crow(r, hi); const float il = 1.0f / wsf[32 + orow];
        stg[orow * 64 + r32] = (bf16)f2bf(o[0][r] * il); stg[orow * 64 + 32 + r32] = (bf16)f2bf(o[1][r] * il); }
    LDS_WAIT();
#pragma unroll
    for (int i = 0; i < 4; ++i) { const int row = i * 8 + (lane >> 3), ch = lane & 7; const u32x4 v = *(const LAS u32x4*)(stg + row * 64 + ch * 8); if (!meta || (wid == 0 && row < NMETA)) *(u32x4*)(Ow + (size_t)row * 1024 + ch * 8) = v; }
    ATT_WAIT_BAR();
#undef A2_ROW0
#undef A2_DMA_K
#undef A2_DMA_V
#undef A2_QKT
#undef A2_TILE
#undef A2_STEP
}
__device__ __forceinline__ void attn_phase(const bf16* QN, const bf16* QPE, const bf16* KNV, const bf16* KPE, bf16* O, LAS unsigned char* lds, int wave_id) {
    const int G = gridDim.x, bx = blockIdx.x; const int vcu = (G % 8 == 0) ? (bx % 8) * (G / 8) + bx / 8 : bx;
    for (int v = vcu; v < NB * NH * 4; v += G) {
        const int bh = v >> 2, s0 = v & 3;
#pragma unroll 1
        for (int i = 0; i < 4; ++i) { const int qb = (i == 0) ? 15 - s0 : (i == 1) ? 11 - s0 : (i == 2) ? 4 + s0 : s0; attn_unit2(bh >> 4, bh & 15, qb, QN, QPE, KNV, KPE, O, lds, wave_id); }
        if (v < NB * NH) attn_unit2(v >> 4, v & 15, -1, QN, QPE, KNV, KPE, O, lds, wave_id);
    }
}
}


namespace dec {
using att::bf16x8; using att::s16x4; using att::f32x16; using att::crow; using att::cvtpk; using att::vtr; using att::pmax32; using att::psum32;
constexpr int KST = 592, KBUF = 64 * KST, LDS_K = 0, LDS_Q = 2 * KBUF, LDS_WS = LDS_Q + 64 * KST, LDS_TOTAL = LDS_WS + 8 * 256;
constexpr int NSTAGE = 64;
__device__ __forceinline__ void decode_unit(int db, int sp, ArgsP a, LAS unsigned char* lds, int wave_id) {
    const int tid = fresh_tid(wave_id), lane = tid & 63, r32 = lane & 31, hi = lane >> 5; const int wid = wave_id;
    const int qh = wid & 1, kh = (wid >> 1) & 1, dh = wid >> 2;
    const float* cckv = IN_F(2); const float* ckpe = IN_F(3); const int* pt = (const int*)a->in[5] + db * NPAGES + sp * 32;
    for (int i = tid; i < 64 * 36; i += 512) { const int q = i / 36, ch = i % 36, t = q >> 4, h = q & 15;
        const bf16* src = ch < 32 ? WSB(WS_QLAT) + ((size_t)(db * 4 + t) * 16 + h) * 256 + ch * 8 : WSB(WS_QPE) + (size_t)(RSAMP0 + db * 4 + t) * 512 + h * 32 + (ch - 32) * 8;
        *(LAS u32x4*)(lds + LDS_Q + q * KST + ch * 16) = *(const u32x4*)src; }
    f32x4 cv[8], kv, cw[8], kw;
#define DEC_LOAD(CV, KV, s) do { const int page_ = __builtin_amdgcn_readfirstlane(pt[(s) >> 1]); const size_t k0_ = (size_t)page_ * PAGE + ((s) & 1) * 64; \
        _Pragma("unroll") for (int j = 0; j < 8; ++j) CV[j] = __builtin_nontemporal_load((const f32x4*)(cckv + (k0_ + wid + 8 * j) * 256 + 4 * lane));     \
        KV = __builtin_nontemporal_load((const f32x4*)(ckpe + (k0_ + (tid >> 3)) * 32 + 4 * (tid & 7))); } while (0)
#define DEC_WRITE(CV, KV, buf) do { LAS unsigned char* kb_ = lds + LDS_K + (buf) * KBUF; \
        _Pragma("unroll") for (int j = 0; j < 8; ++j) { u32x2 w_; w_.x = cvtpk(CV[j].x, CV[j].y); w_.y = cvtpk(CV[j].z, CV[j].w); *(LAS u32x2*)(kb_ + (wid + 8 * j) * KST + lane * 8) = w_; } \
        { u32x2 w_; w_.x = cvtpk(KV.x, KV.y); w_.y = cvtpk(KV.z, KV.w); *(LAS u32x2*)(kb_ + (tid >> 3) * KST + 512 + (tid & 7) * 8) = w_; } } while (0)
    LAS float* wsf = (LAS float*)(lds + LDS_WS) + wid * 64;
    f32x16 o[4]; o[0] = f32x16{}; o[1] = f32x16{}; o[2] = f32x16{}; o[3] = f32x16{};
    float mref = -INFINITY, l = 0.f;
#define DEC_BAR() asm volatile("s_waitcnt lgkmcnt(0)\n\ts_barrier" ::: "memory")
    DEC_LOAD(cv, kv, 0); DEC_WRITE(cv, kv, 0); DEC_LOAD(cv, kv, 1); DEC_LOAD(cw, kw, 2);
    DEC_BAR();
#define DEC_COMPUTE(BUF) do { \
        const LAS unsigned char* kimg = lds + LDS_K + (BUF) * KBUF; \
        f32x16 p = f32x16{}; \
        { const LAS unsigned char* kb = kimg + (kh * 32 + r32) * KST + hi * 16; const LAS unsigned char* qb = lds + LDS_Q + (qh * 32 + r32) * KST + hi * 16; \
        _Pragma("unroll") \
          for (int s2 = 0; s2 < 18; ++s2) p = __builtin_amdgcn_mfma_f32_32x32x16_bf16(*(const LAS bf16x8*)(kb + s2 * 32), *(const LAS bf16x8*)(qb + s2 * 32), p, 0, 0, 0); } \
        float rm = p[0]; \
        _Pragma("unroll") \
        for (int r = 1; r < 16; ++r) rm = fmaxf(rm, p[r]); \
        rm = pmax32(rm); \
        if (__any(rm > mref + 8.0f)) { \
            const float mnew = fmaxf(mref, rm); const float f = __builtin_amdgcn_exp2f(mref - mnew); \
            mref = mnew; l *= f; \
            if (hi == 0) wsf[r32] = f; \
            LDS_WAIT(); \
        _Pragma("unroll") \
            for (int r = 0; r < 16; ++r) { const float fr = wsf[crow(r, hi)]; o[0][r] *= fr; o[1][r] *= fr; o[2][r] *= fr; o[3][r] *= fr; } \
        } \
        float sacc = 0.f; \
        _Pragma("unroll") \
        for (int r = 0; r < 16; ++r) { p[r] = __builtin_amdgcn_exp2f(p[r] - mref); sacc += p[r]; } \
        l += sacc; \
        u32x4 pw[2]; \
        _Pragma("unroll") \
        for (int i = 0; i < 4; ++i) { pw[0][i] = cvtpk(p[2 * i], p[2 * i + 1]); pw[1][i] = cvtpk(p[8 + 2 * i], p[8 + 2 * i + 1]); } \
        const LAS unsigned char* vb = kimg + (kh * 32 + 4 * hi + ((lane & 15) >> 2)) * KST + (dh * 128 + 16 * ((lane >> 4) & 1) + 4 * (lane & 3)) * 2; \
        _Pragma("unroll") \
        for (int dt = 0; dt < 4; ++dt) \
        _Pragma("unroll") \
            for (int ks = 0; ks < 2; ++ks) { \
                const s16x4 vlo = vtr(vb + (ks * 16) * KST + dt * 64), vhi = vtr(vb + (ks * 16 + 8) * KST + dt * 64); \
                const bf16x8 vf = (bf16x8){vlo[0], vlo[1], vlo[2], vlo[3], vhi[0], vhi[1], vhi[2], vhi[3]}; \
                o[dt] = __builtin_amdgcn_mfma_f32_32x32x16_bf16(__builtin_bit_cast(bf16x8, pw[ks]), vf, o[dt], 0, 0, 0); \
            } \
    } while (0)
    static_assert(NSTAGE % 2 == 0, "stage loop is unrolled by two");
    for (int s = 0; s < NSTAGE; s += 2) {
        DEC_COMPUTE(0);
        DEC_WRITE(cv, kv, 1); DEC_LOAD(cv, kv, (s + 3 < NSTAGE ? s + 3 : NSTAGE - 1));
        DEC_BAR();
        DEC_COMPUTE(1);
        DEC_WRITE(cw, kw, 0); DEC_LOAD(cw, kw, (s + 4 < NSTAGE ? s + 4 : NSTAGE - 1));
        DEC_BAR();
    }
#undef DEC_COMPUTE
#undef DEC_BAR
    const int part = (db * 2 + sp) * 2 + kh;
    float* op = WSF(WS_OPART) + (size_t)part * 64 * 256;
#pragma unroll
    for (int dt = 0; dt < 4; ++dt)
#pragma unroll
        for (int r = 0; r < 16; ++r) op[(size_t)(qh * 32 + crow(r, hi)) * 256 + dh * 128 + dt * 32 + r32] = o[dt][r];
    l = psum32(l);
    if (dh == 0 && hi == 0) { float* mp = WSF(WS_MLP) + (size_t)part * 128 + (qh * 32 + r32) * 2; mp[0] = mref; mp[1] = l; }
#undef DEC_LOAD
#undef DEC_WRITE
}
struct LaneCtx { int lane, wave; };
__device__ __forceinline__ void combine_item(ArgsP a, int db, int h, const LaneCtx c, LAS unsigned char* lds) {
    {
        f32x4 cn[4]; float en[4];
#pragma unroll
        for (int s2 = 0; s2 < 4; ++s2) { const int kr = RSAMP0 + db * 4 + s2;
            const u32x2 v = *(const u32x2*)(WSB(WS_CKVN) + (size_t)kr * 256 + 4 * c.lane); cn[s2] = (f32x4){bflo(v.x), bfhi(v.x), bflo(v.y), bfhi(v.y)};
            en[s2] = c.lane < 32 ? bf2f(WSB(WS_KPE)[(size_t)kr * 32 + c.lane]) : 0.f; }
        f32x4 res[4];
#pragma unroll
        for (int t = 0; t < 4; ++t) {
            const int i = db * 4 + t, q = t * 16 + h;
            const u32x2 qv = *(const u32x2*)(WSB(WS_QLAT) + ((size_t)i * 16 + h) * 256 + 4 * c.lane); const f32x4 ql = (f32x4){bflo(qv.x), bfhi(qv.x), bflo(qv.y), bfhi(qv.y)};
            const float qp = c.lane < 32 ? bf2f(WSB(WS_QPE)[(size_t)(RSAMP0 + i) * 512 + h * 32 + c.lane]) : 0.f;
            float mp[4], lp[4], dn[4]; float mg = -INFINITY;
#pragma unroll
            for (int p = 0; p < 4; ++p) { const float* ml = WSF(WS_MLP) + (size_t)(db * 4 + p) * 128 + q * 2; mp[p] = ml[0]; lp[p] = ml[1]; mg = fmaxf(mg, mp[p]); }
#pragma unroll
            for (int s2 = 0; s2 < 4; ++s2) {
                float d = (ql.x * cn[s2].x + ql.y * cn[s2].y) + (ql.z * cn[s2].z + ql.w * cn[s2].w) + qp * en[s2];
                d = wave_sum(d); dn[s2] = s2 <= t ? d : -INFINITY; mg = fmaxf(mg, dn[s2]);
            }
            f32x4 acc = (f32x4){0.f, 0.f, 0.f, 0.f}; float L = 0.f;
#pragma unroll
            for (int p = 0; p < 4; ++p) { const float w = exp2f(mp[p] - mg); L += w * lp[p]; acc += w * *(const f32x4*)(WSF(WS_OPART) + ((size_t)(db * 4 + p) * 64 + q) * 256 + 4 * c.lane); }
#pragma unroll
            for (int s2 = 0; s2 < 4; ++s2) { const float w = exp2f(dn[s2] - mg); L += w; acc += w * cn[s2]; }
            res[t] = acc * (1.0f / L);
            __builtin_amdgcn_sched_barrier(0);
        }
        LAS bf16* rt = (LAS bf16*)(lds + 8 * 256 + c.wave * 2048);
#pragma unroll
        for (int t = 0; t < 4; ++t) { u32x2 w; w.x = pk2(res[t].x, res[t].y); w.y = pk2(res[t].z, res[t].w); *(LAS u32x2*)(rt + t * 256 + 4 * c.lane) = w; }
        LDS_WAIT();
        const int r32 = c.lane & 31, hi = c.lane >> 5;
        att::f32x16 o0 = att::f32x16{}, o1 = att::f32x16{};
        const bf16* wb = WSB(WS_WUKV) + (size_t)(1024 + h * 64 + r32) * 256 + 8 * hi;
#pragma unroll
        for (int s = 0; s < 16; ++s) {
            att::bf16x8 af = att::bf16x8{}; if (r32 < 4) af = *(const LAS att::bf16x8*)(rt + r32 * 256 + 16 * s + 8 * hi);
            const att::bf16x8 b0 = *(const att::bf16x8*)(wb + 16 * s), b1 = *(const att::bf16x8*)(wb + 32 * 256 + 16 * s);
            o0 = __builtin_amdgcn_mfma_f32_32x32x16_bf16(af, b0, o0, 0, 0, 0); o1 = __builtin_amdgcn_mfma_f32_32x32x16_bf16(af, b1, o1, 0, 0, 0);
        }
        if (hi == 0) {
#pragma unroll
            for (int t = 0; t < 4; ++t) { bf16* op = WSB(WS_O) + (size_t)(RSAMP0 + db * 4 + t) * 1024 + h * 64 + r32; op[0] = (bf16)f2bf(o0[t]); op[32] = (bf16)f2bf(o1[t]); }
        }
        LDS_WAIT();
    }
}
__device__ __forceinline__ void combine_phase(ArgsP a, const Ctx& c0, LAS unsigned char* lds) {
    const Ctx c = refresh(c0);
    for (int it = c.gw; it < DB * NH; it += c.ngw) combine_item(a, it >> 4, it & 15, LaneCtx{c.lane, c.wave}, lds);
}
__device__ __forceinline__ void decode_phase(ArgsP a, LAS unsigned char* lds, int wave_id) {
    for (int u = blockIdx.x; u < DB * 2; u += gridDim.x) { decode_unit(u >> 1, u & 1, a, lds, wave_id); __syncthreads(); }
}
}

__device__ __forceinline__ void p_side_tables(ArgsP a, const Ctx& c0, LAS unsigned char* lds, int wg0) {
    const Ctx c = refresh(c0);
    const int nwg = (int)gridDim.x - wg0, bx = (int)blockIdx.x - wg0;
    if (bx < 0) return;
    const int gt = (bx * 8 + c.wave) * 64 + c.lane, ngt = nwg * 512;
    {
        const int r32 = c.lane & 31, hi = c.lane >> 5;
        for (int it = bx * 8 + c.wave; it < NH * 64; it += nwg * 8) {
            const int h = it >> 6, ct = (it >> 3) & 7, kt = it & 7;
            const float* ap = IN_F(15) + (size_t)(ct * 32 + r32) * 1024 + h * 64 + 8 * hi;
            const float* bp = IN_F(13) + (size_t)(kt * 32 + r32) * 1536 + h * 96 + 8 * hi;
            att::f32x16 acc = att::f32x16{};
#pragma unroll
            for (int s = 0; s < 4; ++s) {
                const f32x4 a0 = *(const f32x4*)(ap + 16 * s), a1 = *(const f32x4*)(ap + 16 * s + 4), b0 = *(const f32x4*)(bp + 16 * s), b1 = *(const f32x4*)(bp + 16 * s + 4);
                const u32x4 aw = (u32x4){pk2(a0.x, a0.y), pk2(a0.z, a0.w), pk2(a1.x, a1.y), pk2(a1.z, a1.w)}, bw = (u32x4){pk2(b0.x, b0.y), pk2(b0.z, b0.w), pk2(b1.x, b1.y), pk2(b1.z, b1.w)};
                acc = __builtin_amdgcn_mfma_f32_32x32x16_bf16(__builtin_bit_cast(att::bf16x8, aw), __builtin_bit_cast(att::bf16x8, bw), acc, 0, 0, 0);
            }
            bf16* op = WSB(WS_WUQL) + (size_t)(h * 256 + ct * 32) * 256 + kt * 32 + r32;
#pragma unroll
            for (int r = 0; r < 16; ++r) op[(size_t)att::crow(r, hi) * 256] = (bf16)f2bf(acc[r]);
        }
    }
}
__device__ __forceinline__ void p_mla_mid(ArgsP a, const Ctx& c0) {
    const Ctx c = refresh(c0);
    const float* A1 = WSF(WS_A1); bf16* CQN = WSB(WS_CQN); bf16* CKVN = WSB(WS_CKVN); bf16* KPEB = WSB(WS_KPE); const float* ROPE = WSF(WS_ROPE); float* out = a->out;
    const f32x4 gq = *(const f32x4*)(IN_F(12) + 4 * c.lane), gk = *(const f32x4*)(IN_F(14) + 4 * c.lane);
    constexpr int NR = 4;
    for (int r0 = c.gw; r0 < R; r0 += NR * c.ngw) {
        f32x4 cq[NR], ck[NR]; float sq[NR], sk[NR], x1[NR], x2[NR], cs[NR], sn[NR];
#pragma unroll
        for (int q = 0; q < NR; ++q) { const int r = r0 + q * c.ngw < R ? r0 + q * c.ngw : r0; const float* row = A1 + (size_t)r * NIN0;
            cq[q] = *(const f32x4*)(row + 4 * c.lane); ck[q] = *(const f32x4*)(row + 256 + 4 * c.lane);
            const int j = c.lane & 15; x1[q] = row[512 + j]; x2[q] = row[528 + j]; cs[q] = ROPE[(size_t)r * 32 + j]; sn[q] = ROPE[(size_t)r * 32 + 16 + j];
            sq[q] = (cq[q].x * cq[q].x + cq[q].y * cq[q].y) + (cq[q].z * cq[q].z + cq[q].w * cq[q].w); sk[q] = (ck[q].x * ck[q].x + ck[q].y * ck[q].y) + (ck[q].z * ck[q].z + ck[q].w * ck[q].w); }
#pragma unroll
        for (int sh = 1; sh < 64; sh <<= 1) {
#pragma unroll
            for (int q = 0; q < NR; ++q) { sq[q] += __shfl_xor(sq[q], sh); sk[q] += __shfl_xor(sk[q], sh); } }
#pragma unroll
        for (int q = 0; q < NR; ++q) { const int r = r0 + q * c.ngw < R ? r0 + q * c.ngw : r0; const int pos = row_pos(r);
            const float rq = 1.0f / sqrtf(sq[q] * (1.f / 256) + EPS), rk = 1.0f / sqrtf(sk[q] * (1.f / 256) + EPS);
            const f32x4 qn = cq[q] * rq * gq, kn = ck[q] * rk * gk;
            u32x2 o; o.x = pk2(qn.x, qn.y); o.y = pk2(qn.z, qn.w); *(u32x2*)(CQN + (size_t)r * 256 + 4 * c.lane) = o;
            o.x = pk2(kn.x, kn.y); o.y = pk2(kn.z, kn.w); *(u32x2*)(CKVN + (size_t)r * 256 + 4 * c.lane) = o;
            float* ockv; float* okpe;
            if (r < RSAMP0) { const int b = r < RMAIN ? (r >> 12) : ((r - RMAIN) >> 4); ockv = out + O_CKVP + ((size_t)b * TP + pos) * 256; okpe = out + O_KPEP + ((size_t)b * TP + pos) * 32; }
            else { ockv = out + O_CKVS + (size_t)(r - RSAMP0) * 256; okpe = out + O_KPES + (size_t)(r - RSAMP0) * 32; }
            *(f32x4*)(ockv + 4 * c.lane) = kn;
            if (c.lane < 16) { const int j = c.lane; const float o1 = x1[q] * cs[q] - x2[q] * sn[q], o2 = x1[q] * sn[q] + x2[q] * cs[q]; okpe[j] = o1; okpe[16 + j] = o2;
                KPEB[(size_t)r * 32 + j] = (bf16)f2bf(o1); KPEB[(size_t)r * 32 + 16 + j] = (bf16)f2bf(o2); } }
    }
}
__device__ __forceinline__ void p_q_post(ArgsP a, const Ctx& c0) {
    const Ctx c = refresh(c0);
    for (int r = c.gw; r < R; r += c.ngw) {
        const float* row = WSF(WS_QRAW) + (size_t)r * NUQ; const int pos = row_pos(r);
        const float qs = QSCALE;
#pragma unroll
        for (int j = 0; j < 4; ++j) { const f32x4 v = *(const f32x4*)(row + 4 * c.lane + 256 * j) * qs; u32x2 o; o.x = pk2(v.x, v.y); o.y = pk2(v.z, v.w); *(u32x2*)(WSB(WS_QN) + (size_t)r * 1024 + 4 * c.lane + 256 * j) = o; }
#pragma unroll
        for (int j = 0; j < 4; ++j) { const int p = c.lane + 64 * j, h = p >> 4, jj = p & 15; const float x1 = row[1024 + 2 * p], x2 = row[1024 + 2 * p + 1]; float cs, sn; rope_cs(pos, jj, cs, sn);
            WSB(WS_QPE)[(size_t)r * 512 + h * 32 + jj] = (bf16)f2bf((x1 * cs - x2 * sn) * qs); WSB(WS_QPE)[(size_t)r * 512 + h * 32 + 16 + jj] = (bf16)f2bf((x1 * sn + x2 * cs) * qs); }
    }
}
__device__ __forceinline__ void p_qlat(ArgsP a, const Ctx& c0) {
    const Ctx c = refresh(c0);
    const float* wuk = IN_F(15);
    for (int it = c.gw; it < DB * DS * NH; it += c.ngw) {
        const int i = it >> 4, h = it & 15;
        const float q = WSF(WS_QRAW)[(size_t)(RSAMP0 + i) * NUQ + h * 64 + c.lane];
        float acc[4] = {0.f, 0.f, 0.f, 0.f};
#pragma unroll 8
        for (int n = 0; n < 64; ++n) { const float qn = __shfl(q, n);
#pragma unroll
            for (int k = 0; k < 4; ++k) acc[k] += qn * wuk[(size_t)(c.lane + 64 * k) * 1024 + h * 64 + n]; }
#pragma unroll
        for (int k = 0; k < 4; ++k) WSB(WS_QLAT)[((size_t)i * 16 + h) * 256 + c.lane + 64 * k] = (bf16)f2bf(acc[k] * QSCALE);
    }
}
template <bool META_ONLY>
__device__ __forceinline__ void p_attn_prompt_naive(ArgsP a, const Ctx& c0) {
    const Ctx c = refresh(c0);
    const bf16* QN = WSB(WS_QN); const bf16* QPE = WSB(WS_QPE); const bf16* KNV = WSB(WS_KNV); const bf16* KPE = WSB(WS_KPE);
    for (int item = c.gw + (META_ONLY ? (RMAIN / 64) * NH : 0); item < (RPROMPT / 64) * NH; item += c.ngw) {
        const int rb = item >> 4, h = item & 15, r = rb * 64 + c.lane;
        int b, nk;
        if (r < RMAIN) { b = r >> 12; nk = NMETA + (r & 4095) + 1; } else { const int i = r - RMAIN; b = i >> 4; nk = (i & 15) + 1; }
        const int mbase = RMAIN + 16 * b, tbase = 4096 * b;
        float qn[64], qp[32], o[64];
#pragma unroll
        for (int j = 0; j < 8; ++j) { const u32x4 v = *(const u32x4*)(QN + (size_t)r * 1024 + h * 64 + 8 * j);
            qn[8 * j] = bflo(v.x); qn[8 * j + 1] = bfhi(v.x); qn[8 * j + 2] = bflo(v.y); qn[8 * j + 3] = bfhi(v.y); qn[8 * j + 4] = bflo(v.z); qn[8 * j + 5] = bfhi(v.z); qn[8 * j + 6] = bflo(v.w); qn[8 * j + 7] = bfhi(v.w); }
#pragma unroll
        for (int j = 0; j < 4; ++j) { const u32x4 v = *(const u32x4*)(QPE + (size_t)r * 512 + h * 32 + 8 * j);
            qp[8 * j] = bflo(v.x); qp[8 * j + 1] = bfhi(v.x); qp[8 * j + 2] = bflo(v.y); qp[8 * j + 3] = bfhi(v.y); qp[8 * j + 4] = bflo(v.z); qp[8 * j + 5] = bfhi(v.z); qp[8 * j + 6] = bflo(v.w); qp[8 * j + 7] = bfhi(v.w); }
#pragma unroll
        for (int j = 0; j < 64; ++j) o[j] = 0.f;
        float m = -INFINITY, l = 0.f;
        const int nkmax = wave_max_i(nk);
        for (int kk = 0; kk < nkmax; ++kk) {
            if (kk < nk) {
                const int kr = kk < NMETA ? mbase + kk : tbase + kk - NMETA;
                const bf16* kn = KNV + (size_t)kr * 2048 + h * 64; const bf16* kp = KPE + (size_t)kr * 32; const bf16* vv = kn + 1024;
                float s = 0.f;
#pragma unroll
                for (int j = 0; j < 8; ++j) { const u32x4 v = *(const u32x4*)(kn + 8 * j);
                    s += qn[8 * j] * bflo(v.x) + qn[8 * j + 1] * bfhi(v.x) + qn[8 * j + 2] * bflo(v.y) + qn[8 * j + 3] * bfhi(v.y) + qn[8 * j + 4] * bflo(v.z) + qn[8 * j + 5] * bfhi(v.z) + qn[8 * j + 6] * bflo(v.w) + qn[8 * j + 7] * bfhi(v.w); }
#pragma unroll
                for (int j = 0; j < 4; ++j) { const u32x4 v = *(const u32x4*)(kp + 8 * j);
                    s += qp[8 * j] * bflo(v.x) + qp[8 * j + 1] * bfhi(v.x) + qp[8 * j + 2] * bflo(v.y) + qp[8 * j + 3] * bfhi(v.y) + qp[8 * j + 4] * bflo(v.z) + qp[8 * j + 5] * bfhi(v.z) + qp[8 * j + 6] * bflo(v.w) + qp[8 * j + 7] * bfhi(v.w); }
                const float mn = fmaxf(m, s), corr = exp2f(m - mn), p = exp2f(s - mn);
                l = l * corr + p; m = mn;
#pragma unroll
                for (int j = 0; j < 8; ++j) { const u32x4 v = *(const u32x4*)(vv + 8 * j);
                    o[8 * j] = o[8 * j] * corr + p * bflo(v.x); o[8 * j + 1] = o[8 * j + 1] * corr + p * bfhi(v.x); o[8 * j + 2] = o[8 * j + 2] * corr + p * bflo(v.y); o[8 * j + 3] = o[8 * j + 3] * corr + p * bfhi(v.y);
                    o[8 * j + 4] = o[8 * j + 4] * corr + p * bflo(v.z); o[8 * j + 5] = o[8 * j + 5] * corr + p * bfhi(v.z); o[8 * j + 6] = o[8 * j + 6] * corr + p * bflo(v.w); o[8 * j + 7] = o[8 * j + 7] * corr + p * bfhi(v.w); }
            }
        }
        const float il = 1.0f / l;
#pragma unroll
        for (int j = 0; j < 8; ++j) { u32x4 w; w.x = pk2(o[8 * j] * il, o[8 * j + 1] * il); w.y = pk2(o[8 * j + 2] * il, o[8 * j + 3] * il); w.z = pk2(o[8 * j + 4] * il, o[8 * j + 5] * il); w.w = pk2(o[8 * j + 6] * il, o[8 * j + 7] * il);
            *(u32x4*)(WSB(WS_O) + (size_t)r * 1024 + h * 64 + 8 * j) = w; }
    }
}
__device__ __forceinline__ void p_attn_decode_naive(ArgsP a, const Ctx& c0) {
    const Ctx c = refresh(c0);
    const float* cckv = IN_F(2); const float* ckpe = IN_F(3); const int* pt = (const int*)a->in[5];
    for (int item = c.gw; item < DB * NH; item += c.ngw) {
        const int db = item >> 4, h = item & 15;
        f32x4 ql[4]; float qp[4], m[4], l[4]; f32x4 o[4];
#pragma unroll
        for (int t = 0; t < 4; ++t) { const u32x2 v = *(const u32x2*)(WSB(WS_QLAT) + ((size_t)(db * 4 + t) * 16 + h) * 256 + 4 * c.lane);
            ql[t] = (f32x4){bflo(v.x), bfhi(v.x), bflo(v.y), bfhi(v.y)};
            qp[t] = c.lane < 32 ? bf2f(WSB(WS_QPE)[(size_t)(RSAMP0 + db * 4 + t) * 512 + h * 32 + c.lane]) : 0.f;
            m[t] = -INFINITY; l[t] = 0.f; o[t] = (f32x4){0.f, 0.f, 0.f, 0.f}; }
        for (int p = 0; p < NPAGES; ++p) {
            const int page = pt[db * NPAGES + p];
            for (int k = 0; k < PAGE; ++k) {
                const size_t kr = (size_t)page * PAGE + k;
                const f32x4 cv = *(const f32x4*)(cckv + kr * 256 + 4 * c.lane); const float e = c.lane < 32 ? ckpe[kr * 32 + c.lane] : 0.f;
#pragma unroll
                for (int t = 0; t < 4; ++t) {
                    float d = (ql[t].x * cv.x + ql[t].y * cv.y) + (ql[t].z * cv.z + ql[t].w * cv.w) + qp[t] * e;
                    d = wave_sum(d);
                    const float mn = fmaxf(m[t], d), corr = exp2f(m[t] - mn), pp = exp2f(d - mn);
                    l[t] = l[t] * corr + pp; m[t] = mn; o[t] = o[t] * corr + pp * cv;
                }
            }
        }
#pragma unroll
        for (int s2 = 0; s2 < 4; ++s2) {
            const int kr = RSAMP0 + db * 4 + s2;
            const u32x2 v = *(const u32x2*)(WSB(WS_CKVN) + (size_t)kr * 256 + 4 * c.lane); const f32x4 cv = (f32x4){bflo(v.x), bfhi(v.x), bflo(v.y), bfhi(v.y)};
            const float e = c.lane < 32 ? bf2f(WSB(WS_KPE)[(size_t)kr * 32 + c.lane]) : 0.f;
#pragma unroll
            for (int t = 0; t < 4; ++t) if (t >= s2) {
                float d = (ql[t].x * cv.x + ql[t].y * cv.y) + (ql[t].z * cv.z + ql[t].w * cv.w) + qp[t] * e;
                d = wave_sum(d);
                const float mn = fmaxf(m[t], d), corr = exp2f(m[t] - mn), pp = exp2f(d - mn);
                l[t] = l[t] * corr + pp; m[t] = mn; o[t] = o[t] * corr + pp * cv;
            }
        }
#pragma unroll
        for (int t = 0; t < 4; ++t) *(f32x4*)(WSF(WS_OLAT) + ((size_t)(db * 4 + t) * 16 + h) * 256 + 4 * c.lane) = o[t] * (1.0f / l[t]);
    }
}
__device__ __forceinline__ void p_olat_up(ArgsP a, const Ctx& c0) {
    const Ctx c = refresh(c0);
    const float* wuv = IN_F(16);
    for (int it = c.gw; it < DB * DS * NH; it += c.ngw) {
        const int i = it >> 4, h = it & 15; const float* ol = WSF(WS_OLAT) + ((size_t)i * 16 + h) * 256;
        float acc = 0.f;
#pragma unroll 8
        for (int cc = 0; cc < 256; ++cc) acc += ol[cc] * wuv[(size_t)cc * 1024 + h * 64 + c.lane];
        WSB(WS_O)[(size_t)(RSAMP0 + i) * 1024 + h * 64 + c.lane] = (bf16)f2bf(acc);
    }
}
template <bool FINAL, int NSPLIT, bool FIRST = false>
__device__ __forceinline__ void p_post_res(ArgsP a, const Ctx& c0, const float* gpost, const float* gnext) {
    const Ctx c = refresh(c0);
    const bf16* Mb = WSB(WS_M); bf16* X = WSB(WS_X); bf16* H = WSB(WS_H); const float* MT = WSF(WS_MT); const float* xin = IN_F(0); float* out = a->out;
    f32x4 gp[4], gn[4];
#pragma unroll
    for (int j = 0; j < 4; ++j) { gp[j] = *(const f32x4*)(gpost + 4 * c.lane + 256 * j); gn[j] = FINAL ? gp[j] : *(const f32x4*)(gnext + 4 * c.lane + 256 * j); }
    constexpr int NR = 4;
    for (int r0 = c.gw; r0 < RMAIN; r0 += NR * c.ngw) {
        f32x4 mv[NR][4], xv[NR][4]; float s[NR], s2[NR];
#pragma unroll
        for (int q = 0; q < NR; ++q) { const int r = r0 + q * c.ngw < RMAIN ? r0 + q * c.ngw : r0;
            s[q] = 0.f;
#pragma unroll
            for (int j = 0; j < 4; ++j) { const u32x2 mb = __builtin_nontemporal_load((const u32x2*)(Mb + (size_t)r * D + 4 * c.lane + 256 * j)); mv[q][j] = (f32x4){bflo(mb.x), bfhi(mb.x), bflo(mb.y), bfhi(mb.y)};
                if (FIRST) xv[q][j] = *(const f32x4*)(xin + (size_t)r * D + 4 * c.lane + 256 * j); else { const u32x2 xb = *(const u32x2*)(X + (size_t)r * D + 4 * c.lane + 256 * j); xv[q][j] = (f32x4){bflo(xb.x), bfhi(xb.x), bflo(xb.y), bfhi(xb.y)}; }
                s[q] += (mv[q][j].x * mv[q][j].x + mv[q][j].y * mv[q][j].y) + (mv[q][j].z * mv[q][j].z + mv[q][j].w * mv[q][j].w); } }
#pragma unroll
        for (int o = 1; o < 64; o <<= 1) {
#pragma unroll
            for (int q = 0; q < NR; ++q) s[q] += __shfl_xor(s[q], o); }
#pragma unroll
        for (int q = 0; q < NR; ++q) { const float rm = 1.0f / sqrtf(s[q] * (1.f / D) + EPS); s2[q] = 0.f;
#pragma unroll
            for (int j = 0; j < 4; ++j) { xv[q][j] = xv[q][j] + mv[q][j] * rm * gp[j]; s2[q] += (xv[q][j].x * xv[q][j].x + xv[q][j].y * xv[q][j].y) + (xv[q][j].z * xv[q][j].z + xv[q][j].w * xv[q][j].w); } }
        if (!FINAL) {
#pragma unroll
            for (int o = 1; o < 64; o <<= 1) {
#pragma unroll
                for (int q = 0; q < NR; ++q) s2[q] += __shfl_xor(s2[q], o); }
        }
#pragma unroll
        for (int q = 0; q < NR; ++q) { const int r = r0 + q * c.ngw < RMAIN ? r0 + q * c.ngw : r0;
            if (FINAL) {
#pragma unroll
                for (int j = 0; j < 4; ++j) __builtin_nontemporal_store(xv[q][j], (f32x4*)(out + O_YP + (size_t)r * D + 4 * c.lane + 256 * j));
            } else { const float rx = 1.0f / sqrtf(s2[q] * (1.f / D) + EPS);
#pragma unroll
                for (int j = 0; j < 4; ++j) { u32x2 xo; xo.x = pk2(xv[q][j].x, xv[q][j].y); xo.y = pk2(xv[q][j].z, xv[q][j].w); *(u32x2*)(X + (size_t)r * D + 4 * c.lane + 256 * j) = xo;
                    u32x2 o; o.x = pk2(xv[q][j].x * rx * gn[j].x, xv[q][j].y * rx * gn[j].y); o.y = pk2(xv[q][j].z * rx * gn[j].z, xv[q][j].w * rx * gn[j].w); *(u32x2*)(H + (size_t)r * D + 4 * c.lane + 256 * j) = o; } } }
    }
    for (int r = RMAIN + c.gw; r < R; r += c.ngw) {
        bf16* xrow = X + (size_t)r * D;
        f32x4 mv[4], xv[4]; float s = 0.f;
#pragma unroll
        for (int j = 0; j < 4; ++j) { mv[j] = (f32x4){0.f, 0.f, 0.f, 0.f};
#pragma unroll
            for (int h8 = 0; h8 < NSPLIT; h8 += 8) { f32x4 part[8];
#pragma unroll
                for (int sp = 0; sp < 8; ++sp) part[sp] = *(const f32x4*)(MT + ((size_t)(h8 + sp) * (RP - RMAIN) + (r - RMAIN)) * D + 4 * c.lane + 256 * j);
#pragma unroll
                for (int sp = 0; sp < 8; ++sp) mv[j] += part[sp]; }
            { const u32x2 xb = *(const u32x2*)(xrow + 4 * c.lane + 256 * j); xv[j] = (f32x4){bflo(xb.x), bfhi(xb.x), bflo(xb.y), bfhi(xb.y)}; } s += (mv[j].x * mv[j].x + mv[j].y * mv[j].y) + (mv[j].z * mv[j].z + mv[j].w * mv[j].w); }
        const float rm = 1.0f / sqrtf(wave_sum(s) * (1.f / D) + EPS); float s2 = 0.f;
#pragma unroll
        for (int j = 0; j < 4; ++j) { xv[j] = xv[j] + mv[j] * rm * gp[j]; s2 += (xv[j].x * xv[j].x + xv[j].y * xv[j].y) + (xv[j].z * xv[j].z + xv[j].w * xv[j].w); }
        if (FINAL) {
            if (r < RSAMP0) continue;
#pragma unroll
            for (int j = 0; j < 4; ++j) *(f32x4*)(out + O_YS + (size_t)(r - RSAMP0) * D + 4 * c.lane + 256 * j) = xv[j];
        } else {
            const float rx = 1.0f / sqrtf(wave_sum(s2) * (1.f / D) + EPS);
#pragma unroll
            for (int j = 0; j < 4; ++j) { u32x2 xo; xo.x = pk2(xv[j].x, xv[j].y); xo.y = pk2(xv[j].z, xv[j].w); *(u32x2*)(xrow + 4 * c.lane + 256 * j) = xo;
                u32x2 o; o.x = pk2(xv[j].x * rx * gn[j].x, xv[j].y * rx * gn[j].y); o.y = pk2(xv[j].z * rx * gn[j].z, xv[j].w * rx * gn[j].w); *(u32x2*)(H + (size_t)r * D + 4 * c.lane + 256 * j) = o; }
        }
    }
}

__device__ __forceinline__ void p_gate(ArgsP a, const Ctx& c0) {
    const Ctx c = refresh(c0);
    const float* wg = IN_F(19); const float* bg = IN_F(20);
    const size_t gt = (size_t)c.gw * 64 + c.lane, ngt = (size_t)c.ngw * 64;
    for (size_t i = gt + (size_t)(USE_NAIVE_GLA ? 0 : RSAMP0) * 512; i < (size_t)R * 512; i += ngt) {
        const int r = (int)(i >> 9), col = (int)(i & 511); const float* gd = WSF(WS_GD) + (size_t)r * 16;
        float x = bg[col];
#pragma unroll
        for (int j = 0; j < 16; ++j) x += gd[j] * wg[j * 512 + col];
        const float ls = fminf(x, 0.f) - log1pf(__expf(-fabsf(x)));
        const float la = ls * (1.0f / 16.0f);
        WSF(WS_LA)[i] = la; WSF(WS_EA)[i] = __expf(la);
    }
}
__device__ __forceinline__ void gla_step(float (&S)[128], float& o, float a0, float a1, float k0, float k1, float q0, float q1, float v) {
    o = 0.f;
#pragma unroll
    for (int d = 0; d < 64; ++d) { const float ad = rdlane(a0, d), kd = rdlane(k0, d), qd = rdlane(q0, d); S[d] = ad * S[d] + kd * v; o += qd * S[d]; }
#pragma unroll
    for (int d = 0; d < 64; ++d) { const float ad = rdlane(a1, d), kd = rdlane(k1, d), qd = rdlane(q1, d); S[64 + d] = ad * S[64 + d] + kd * v; o += qd * S[64 + d]; }
}
__device__ __forceinline__ void p_gla_naive(ArgsP a, const Ctx& c0) {
    const Ctx c = refresh(c0);
    const float* EA = WSF(WS_EA); const bf16* KG = WSB(WS_KG); const bf16* QG = WSB(WS_QG); const bf16* VG = WSB(WS_VG); float* OGR = WSF(WS_OGRAW);
    for (int item = c.gwT; item < (USE_NAIVE_GLA ? NB * GH * 4 : 0); item += c.ngw) {
        const int b = item >> 4, h = (item >> 2) & 3, dv = (item & 3) * 64 + c.lane;
        float S[128];
#pragma unroll
        for (int d = 0; d < 128; ++d) S[d] = 0.f;
        for (int tt = 0; tt < TP; ++tt) {
            const int row = tt < NMETA ? RMAIN + 16 * b + tt : 4096 * b + tt - NMETA;
            const size_t g = (size_t)row * 512 + h * 128;
            const float a0 = EA[g + c.lane], a1 = EA[g + 64 + c.lane], k0 = bf2f(KG[g + c.lane]), k1 = bf2f(KG[g + 64 + c.lane]), q0 = bf2f(QG[g + c.lane]), q1 = bf2f(QG[g + 64 + c.lane]);
            const float v = bf2f(VG[(size_t)row * 1024 + h * 256 + dv]);
            float o; gla_step(S, o, a0, a1, k0, k1, q0, q1, v);
            OGR[(size_t)row * 1024 + h * 256 + dv] = o;
        }
        float* outp = a->out + O_GLAP + ((size_t)(b * 4 + h) * 128) * 256 + dv;
#pragma unroll
        for (int d = 0; d < 128; ++d) outp[(size_t)d * 256] = S[d];
    }
    const int wg0 = USE_NAIVE_GLA ? 0 : NB * GH * gla::NSP; if ((int)blockIdx.x < wg0) return;
    for (int item = c.wave * ((int)gridDim.x - wg0) + ((int)blockIdx.x - wg0); item < DB * GH * 4; item += c.ngw - wg0 * 8) {
        const int db = item >> 4, h = (item >> 2) & 3, dv = (item & 3) * 64 + c.lane;
        const float* sp = IN_F(4) + ((size_t)(db * 4 + h) * 128) * 256 + dv;
        float S[128];
#pragma unroll
        for (int d = 0; d < 128; ++d) S[d] = sp[(size_t)d * 256];
#pragma unroll 1
        for (int s = 0; s < DS; ++s) {
            const int row = RSAMP0 + db * 4 + s; const size_t g = (size_t)row * 512 + h * 128;
            const float a0 = EA[g + c.lane], a1 = EA[g + 64 + c.lane], k0 = bf2f(KG[g + c.lane]), k1 = bf2f(KG[g + 64 + c.lane]), q0 = bf2f(QG[g + c.lane]), q1 = bf2f(QG[g + 64 + c.lane]);
            const float v = bf2f(VG[(size_t)row * 1024 + h * 256 + dv]);
            float o; gla_step(S, o, a0, a1, k0, k1, q0, q1, v);
            OGR[(size_t)row * 1024 + h * 256 + dv] = o;
        }
        float* outp = a->out + O_GLAS + ((size_t)(db * 4 + h) * 128) * 256 + dv;
#pragma unroll
        for (int d = 0; d < 128; ++d) outp[(size_t)d * 256] = S[d];
    }
}
__device__ __forceinline__ void p_gla_post(ArgsP a, const Ctx& c0) {
    const Ctx c = refresh(c0);
    const bf16* OGR = WSB(WS_OGRAW); const bf16* RG = WSB(WS_RG); bf16* OG = WSB(WS_OG);
    const f32x4 g = *(const f32x4*)(IN_F(21) + 4 * c.lane);
    constexpr int NR = 2;
    for (int r0 = c.gw; r0 < R; r0 += NR * c.ngw) {
        f32x4 o[NR][4]; u32x2 rv[NR][4]; float s[NR][4];
#pragma unroll
        for (int q = 0; q < NR; ++q) { const int r = r0 + q * c.ngw < R ? r0 + q * c.ngw : r0;
#pragma unroll
            for (int h = 0; h < 4; ++h) { const size_t off = (size_t)r * 1024 + h * 256 + 4 * c.lane;
                const u32x2 ob = __builtin_nontemporal_load((const u32x2*)(OGR + ((size_t)(h * 8 + (c.lane >> 3)) * RP + r) * 32 + 4 * (c.lane & 7))); o[q][h] = (f32x4){bflo(ob.x), bfhi(ob.x), bflo(ob.y), bfhi(ob.y)}; rv[q][h] = __builtin_nontemporal_load((const u32x2*)(RG + off));
                s[q][h] = (o[q][h].x * o[q][h].x + o[q][h].y * o[q][h].y) + (o[q][h].z * o[q][h].z + o[q][h].w * o[q][h].w); } }
#pragma unroll
        for (int sh = 1; sh < 64; sh <<= 1) {
#pragma unroll
            for (int q = 0; q < NR; ++q)
#pragma unroll
                for (int h = 0; h < 4; ++h) s[q][h] += __shfl_xor(s[q][h], sh); }
#pragma unroll
        for (int q = 0; q < NR; ++q) { const int r = r0 + q * c.ngw < R ? r0 + q * c.ngw : r0;
#pragma unroll
            for (int h = 0; h < 4; ++h) { const size_t off = (size_t)r * 1024 + h * 256 + 4 * c.lane;
                const float rs = 1.0f / sqrtf(s[q][h] * (1.f / 256) + EPS);
                const f32x4 rr = (f32x4){bflo(rv[q][h].x), bfhi(rv[q][h].x), bflo(rv[q][h].y), bfhi(rv[q][h].y)};
                f32x4 sl; sl.x = rr.x / (1.f + __expf(-rr.x)); sl.y = rr.y / (1.f + __expf(-rr.y)); sl.z = rr.z / (1.f + __expf(-rr.z)); sl.w = rr.w / (1.f + __expf(-rr.w));
                const f32x4 y = o[q][h] * rs * g * sl;
                u32x2 w; w.x = pk2(y.x, y.y); w.y = pk2(y.z, y.w); *(u32x2*)(OG + off) = w; } }
    }
}


namespace gla {
using att::bf16x8; using att::f32x16; using att::crow; using att::cvtpk;
constexpr int NCH = 65, NITEM = NB * GH * NCH;
constexpr int P_GD = 0, P_GSUM = 4096, P_QL = 6144, P_KL = P_QL + 64 * 272, P_VS = P_KL + 64 * 272, P_AL = P_VS + 64 * 528, P_END = P_AL + 64 * 144;
__device__ __forceinline__ int chunk_row(int b, int c, int tok) { return c == 0 ? RMAIN + 16 * b + tok : 4096 * b + 64 * (c - 1) + tok; }
__device__ __forceinline__ float logsig16(float x) { return (fminf(x, 0.f) - __logf(1.0f + __expf(-fabsf(x)))) * (1.0f / 16.0f); }
__device__ __forceinline__ void prep_item(ArgsP a, int item, LAS unsigned char* lds, int wave_id) {
    const int tid = fresh_tid(wave_id), lane = tid & 63, r32 = lane & 31, hi = lane >> 5; const int wid = wave_id;
    const int bh = item / NCH, c = item % NCH, b = bh >> 2, h = bh & 3;
    const int nvalid = c == 0 ? NMETA : 64;
    bf16* QINF = WSB(WS_QINF) + (size_t)item * 8192; bf16* KDTF = WSB(WS_KDTF) + (size_t)item * 8192; bf16* AMF = WSB(WS_AMF) + (size_t)item * 4096; bf16* VTF = WSB(WS_VTF) + (size_t)item * 16384; float* ELF = WSF(WS_ELF) + (size_t)item * 256;
    LAS float* GDL = (LAS float*)(lds + P_GD); LAS float* GSUM = (LAS float*)(lds + P_GSUM); LAS bf16* QL = (LAS bf16*)(lds + P_QL); LAS bf16* KL = (LAS bf16*)(lds + P_KL); LAS bf16* VS = (LAS bf16*)(lds + P_VS); LAS bf16* AL = (LAS bf16*)(lds + P_AL);
    const u32x4 z4 = (u32x4){0u, 0u, 0u, 0u};
#pragma unroll
    for (int j = 0; j < 2; ++j) { const int idx = tid + 512 * j, row = idx >> 4, ch = idx & 15; const bool ok = row < nvalid; const size_t g = (size_t)chunk_row(b, c, ok ? row : 0) * 512 + h * 128 + ch * 8;
        *(LAS u32x4*)(QL + row * 136 + ch * 8) = ok ? __builtin_nontemporal_load((const u32x4*)(WSB(WS_QG) + g)) : z4; *(LAS u32x4*)(KL + row * 136 + ch * 8) = ok ? __builtin_nontemporal_load((const u32x4*)(WSB(WS_KG) + g)) : z4; }
#pragma unroll
    for (int j = 0; j < 4; ++j) { const int idx = tid + 512 * j, row = idx >> 5, ch = idx & 31; const bool ok = row < nvalid;
        *(LAS u32x4*)(VS + row * 264 + ch * 8) = ok ? __builtin_nontemporal_load((const u32x4*)(WSB(WS_VG) + (size_t)chunk_row(b, c, ok ? row : 0) * 1024 + h * 256 + ch * 8)) : z4; }
    if (tid < 256) { const int row = tid >> 2, ch = tid & 3; const bool ok = row < nvalid; *(LAS f32x4*)(GDL + row * 16 + ch * 4) = ok ? *(const f32x4*)(WSF(WS_GD) + (size_t)chunk_row(b, c, ok ? row : 0) * 16 + ch * 4) : (f32x4){0.f, 0.f, 0.f, 0.f}; }
    __syncthreads();
    const int dk = tid & 127, tg = tid >> 7;
    float bloc[16];
    {
        float w[16]; const float* wg = IN_F(19) + h * 128 + dk;
#pragma unroll
        for (int j = 0; j < 16; ++j) w[j] = wg[j * 512];
        const float bg = IN_F(20)[h * 128 + dk];
        float run = 0.f;
#pragma unroll
        for (int i = 0; i < 16; ++i) {
            const int tok = tg * 16 + i; float x = bg;
#pragma unroll
            for (int j4 = 0; j4 < 4; ++j4) { const f32x4 gd = *(const LAS f32x4*)(GDL + tok * 16 + j4 * 4); x += gd.x * w[4 * j4] + gd.y * w[4 * j4 + 1] + gd.z * w[4 * j4 + 2] + gd.w * w[4 * j4 + 3]; }
            const float g = tok < nvalid ? logsig16(x) : 0.f;
            run += g; bloc[i] = run;
        }
        GSUM[tg * 128 + dk] = run;
    }
    __syncthreads();
    float off = 0.f, blast = 0.f;
#pragma unroll
    for (int t = 0; t < 4; ++t) { const float s = GSUM[t * 128 + dk]; if (t < tg) off += s; blast += s; }
    {
        unsigned kdp[8];
#pragma unroll
        for (int i = 0; i < 16; i += 2) {
            float kd2[2];
#pragma unroll
            for (int e = 0; e < 2; ++e) {
                const int tok = tg * 16 + i + e; const float bb = bloc[i + e] + off; const float q = bf2f(QL[tok * 136 + dk]), k = bf2f(KL[tok * 136 + dk]);
                QL[tok * 136 + dk] = (bf16)f2bf(q * __expf(bb)); KL[tok * 136 + dk] = (bf16)f2bf(k * __expf(-bb)); kd2[e] = k * __expf(blast - bb);
            }
            kdp[i >> 1] = pk2(kd2[0], kd2[1]);
        }
        bf16* kp = KDTF + ((size_t)(((dk >> 5) * 4 + tg) * 64) + (dk & 31)) * 8;
        *(u32x4*)(kp) = (u32x4){kdp[0], kdp[1], kdp[2], kdp[3]}; *(u32x4*)(kp + 32 * 8) = (u32x4){kdp[4], kdp[5], kdp[6], kdp[7]};
        if (tg == 0) ELF[dk] = __expf(blast);
    }
    {
        const int dv = tid & 255, half = tid >> 8;
#pragma unroll
        for (int u = 0; u < 4; ++u) {
            unsigned pk[4];
#pragma unroll
            for (int e = 0; e < 4; ++e) { const int tok = half * 32 + u * 8 + e * 2; pk[e] = (unsigned)VS[tok * 264 + dv] | ((unsigned)VS[(tok + 1) * 264 + dv] << 16); }
            const int s = 2 * half + (u >> 1), uh = u & 1;
            *(u32x4*)(VTF + ((size_t)(((dv >> 5) * 4 + s) * 64) + uh * 32 + (dv & 31)) * 8) = (u32x4){pk[0], pk[1], pk[2], pk[3]};
        }
    }
    __syncthreads();
#pragma unroll
    for (int uu = 0; uu < 2; ++uu) {
        const int U = tid + 512 * uu, lp = U & 63, s8 = (U >> 6) & 7, tt = U >> 9; const int tok = tt * 32 + (lp & 31), hh = lp >> 5;
        const u32x2 lo = *(const LAS u32x2*)(QL + tok * 136 + 16 * s8 + 4 * hh), hi2 = *(const LAS u32x2*)(QL + tok * 136 + 16 * s8 + 8 + 4 * hh);
        *(u32x4*)(QINF + (size_t)U * 8) = (u32x4){lo.x, lo.y, hi2.x, hi2.y};
    }
    if (wid < 3) {
        const int tt = wid == 0 ? 0 : 1, tp = wid == 2 ? 1 : 0;
        f32x16 acc = f32x16{};
#pragma unroll
        for (int s = 0; s < 8; ++s) {
            const bf16x8 af = *(const LAS bf16x8*)(QL + (tt * 32 + r32) * 136 + 16 * s + 8 * hi), bfr = *(const LAS bf16x8*)(KL + (tp * 32 + r32) * 136 + 16 * s + 8 * hi);
            acc = __builtin_amdgcn_mfma_f32_32x32x16_bf16(af, bfr, acc, 0, 0, 0);
        }
#pragma unroll
        for (int r = 0; r < 16; ++r) { const int tok = tt * 32 + crow(r, hi), tk = tp * 32 + r32; AL[tok * 72 + tk] = (bf16)f2bf(tk <= tok ? acc[r] : 0.f); }
    } else if (wid == 3) {
#pragma unroll
        for (int r = 0; r < 16; ++r) AL[crow(r, hi) * 72 + 32 + r32] = 0;
    }
    __syncthreads();
    { const int U = tid, lp = U & 63, s = (U >> 6) & 3, tt = U >> 8; const int tok = tt * 32 + (lp & 31), hh = lp >> 5;
      *(u32x4*)(AMF + (size_t)U * 8) = *(const LAS u32x4*)(AL + tok * 72 + 16 * s + 8 * hh); }
    __syncthreads();
}
constexpr int SM_A = 0, SM_K = 2048, SM_Q = 4096, SM_V = 6144, SM_O = 10240, SM_END = SM_O + 4 * 2 * 256 * 4;
__device__ __forceinline__ void sample_item(ArgsP a, int item, LAS unsigned char* lds, int wave_id) {
    const int tid = fresh_tid(wave_id);
    const int db = item >> 2, h = item & 3;
    LAS float* AS = (LAS float*)(lds + SM_A); LAS float* KS = (LAS float*)(lds + SM_K); LAS float* QS = (LAS float*)(lds + SM_Q); LAS float* VSm = (LAS float*)(lds + SM_V); LAS float* OS = (LAS float*)(lds + SM_O);
    { const int s = tid >> 7, dk = tid & 127, row = RSAMP0 + db * 4 + s; const float* gd = WSF(WS_GD) + (size_t)row * 16; const float* wg = IN_F(19) + h * 128 + dk;
      float x = IN_F(20)[h * 128 + dk];
#pragma unroll
      for (int j = 0; j < 16; ++j) x += gd[j] * wg[j * 512];
      AS[s * 128 + dk] = __expf(logsig16(x));
      const size_t g = (size_t)row * 512 + h * 128 + dk; KS[s * 128 + dk] = bf2f(WSB(WS_KG)[g]); QS[s * 128 + dk] = bf2f(WSB(WS_QG)[g]);
#pragma unroll
      for (int j = 0; j < 2; ++j) { const int e = tid + 512 * j, s2 = e >> 8, dv2 = e & 255; VSm[s2 * 256 + dv2] = bf2f(WSB(WS_VG)[(size_t)(RSAMP0 + db * 4 + s2) * 1024 + h * 256 + dv2]); } }
    const int dv = tid & 255, kh = tid >> 8;
    const unsigned voff = (unsigned)(kh * 64 * 256 + dv) * 4u;
    const unsigned char* sbase = (const unsigned char*)(IN_F(4) + (size_t)(db * 4 + h) * 128 * 256);
    __syncthreads();
    float S[64];
#pragma unroll
    for (int d4 = 0; d4 < 16; ++d4) { const GAS unsigned char* bp = (const GAS unsigned char*)sbase + d4 * 4096; asm volatile("" : "+s"(bp));
#pragma unroll
        for (int e = 0; e < 4; ++e) S[4 * d4 + e] = __builtin_nontemporal_load((const GAS float*)(bp + e * 1024 + voff)); }
#pragma unroll 1
    for (int s = 0; s < 4; ++s) {
        const float v = VSm[s * 256 + dv]; float o = 0.f;
#pragma unroll
        for (int d4 = 0; d4 < 16; ++d4) {
            if ((d4 & 3) == 0) __builtin_amdgcn_sched_barrier(0);
            const f32x4 av = *(const LAS f32x4*)(AS + s * 128 + kh * 64 + 4 * d4), kv = *(const LAS f32x4*)(KS + s * 128 + kh * 64 + 4 * d4), qv = *(const LAS f32x4*)(QS + s * 128 + kh * 64 + 4 * d4);
            S[4 * d4] = av.x * S[4 * d4] + kv.x * v; o += qv.x * S[4 * d4]; S[4 * d4 + 1] = av.y * S[4 * d4 + 1] + kv.y * v; o += qv.y * S[4 * d4 + 1];
            S[4 * d4 + 2] = av.z * S[4 * d4 + 2] + kv.z * v; o += qv.z * S[4 * d4 + 2]; S[4 * d4 + 3] = av.w * S[4 * d4 + 3] + kv.w * v; o += qv.w * S[4 * d4 + 3];
        }
        OS[(s * 2 + kh) * 256 + dv] = o;
    }
    unsigned char* obase = (unsigned char*)(a->out + O_GLAS + (size_t)(db * 4 + h) * 128 * 256);
#pragma unroll
    for (int d4 = 0; d4 < 16; ++d4) { GAS unsigned char* bp = (GAS unsigned char*)obase + d4 * 4096; asm volatile("" : "+s"(bp));
#pragma unroll
        for (int e = 0; e < 4; ++e) __builtin_nontemporal_store(S[4 * d4 + e], (GAS float*)(bp + e * 1024 + voff)); }
    __syncthreads();
#pragma unroll
    for (int j = 0; j < 2; ++j) { const int e = tid + 512 * j, s2 = e >> 8, dv2 = e & 255; WSB(WS_OGRAW)[((size_t)(h * 8 + (dv2 >> 5)) * RP + (RSAMP0 + db * 4 + s2)) * 32 + (dv2 & 31)] = (bf16)f2bf(OS[(s2 * 2) * 256 + dv2] + OS[(s2 * 2 + 1) * 256 + dv2]); }
    __syncthreads();
}
__device__ __forceinline__ void prep_phase(ArgsP a, LAS unsigned char* lds, int wave_id) {
    for (int item = blockIdx.x; item < NITEM; item += gridDim.x) prep_item(a, item, lds, wave_id);
}
constexpr int S_QIN = 0, S_KDT = 16384, S_AM = 32768, S_EL = 40960, S_VT = 41984, S_SLOT = S_VT + 4096;
constexpr int S_X = 3 * S_SLOT, S_END = S_X + 2 * 8192;
static_assert(S_END <= MISC_OFF, "scan ring + state exchange fit under the control words");
constexpr int NPIECE = 45, NHELP = 5, NDMA = (NPIECE + NHELP - 1) / NHELP;
__device__ __forceinline__ void scan_bh(ArgsP a, int bh, int part, LAS unsigned char* lds, int wave_id) {
    const int tid = fresh_tid(wave_id), lane = tid & 63, r32 = lane & 31, hi = lane >> 5; const int wid = wave_id;
    const int b = bh >> 2, h = bh & 3, ds = part;
    const unsigned char* const pq = (const unsigned char*)(WSB(WS_QINF) + (size_t)bh * NCH * 8192); const unsigned char* const pk = (const unsigned char*)(WSB(WS_KDTF) + (size_t)bh * NCH * 8192);
    const unsigned char* const pa = (const unsigned char*)(WSB(WS_AMF) + (size_t)bh * NCH * 4096); const unsigned char* const pe = (const unsigned char*)(WSF(WS_ELF) + (size_t)bh * NCH * 256);
    const unsigned char* const pv = (const unsigned char*)(WSB(WS_VTF) + (size_t)bh * NCH * 16384) + part * 4096;
    LAS unsigned char* const X = lds + S_X;
#define GLA_BAR() asm volatile("s_waitcnt lgkmcnt(0)\n\ts_barrier" ::: "memory")
#define GLA_QF(tt, k8) (*(const LAS bf16x8*)(sb + S_QIN + ((tt) * 8 + (k8)) * 1024 + lane * 16))
#define GLA_KF(T, s) (*(const LAS bf16x8*)(sb + S_KDT + ((T) * 4 + (s)) * 1024 + lane * 16))
#define GLA_AF(tt, s) (*(const LAS bf16x8*)(sb + S_AM + ((tt) * 4 + (s)) * 1024 + lane * 16))
    if (wid >= 3) {
#define GLA_DMA(c_, slot_) do { const size_t c64_ = (size_t)(c_); \
        _Pragma("unroll") for (int k_ = 0; k_ < NDMA; ++k_) { int i_ = (wid - 3) + NHELP * k_; i_ = i_ < NPIECE ? i_ : 40; const unsigned char* g_; int lo_; \
            if (i_ < 16) { g_ = pq + c64_ * 16384 + i_ * 1024; lo_ = S_QIN + i_ * 1024; } \
            else if (i_ < 32) { g_ = pk + c64_ * 16384 + (i_ - 16) * 1024; lo_ = S_KDT + (i_ - 16) * 1024; } \
            else if (i_ < 40) { g_ = pa + c64_ * 8192 + (i_ - 32) * 1024; lo_ = S_AM + (i_ - 32) * 1024; } \
            else if (i_ == 40) { g_ = pe + c64_ * 1024; lo_ = S_EL; } \
            else { g_ = pv + c64_ * 32768 + (i_ - 41) * 1024; lo_ = S_VT + (i_ - 41) * 1024; } \
            __builtin_amdgcn_global_load_lds((const unsigned*)(g_ + lane * 16), (LAS unsigned*)(lds + (slot_) * S_SLOT + lo_), 16, 0, 0); } } while (0)
        GLA_DMA(0, 0); GLA_DMA(1, 1);
        for (int c = 0; c < NCH; ++c) {
            if (c + 1 < NCH) asm volatile("s_waitcnt vmcnt(%0)" :: "n"(NDMA) : "memory"); else asm volatile("s_waitcnt vmcnt(0)" ::: "memory");
            GLA_BAR();
            if (c + 2 < NCH) GLA_DMA(c + 2, (c + 2) % 3);
        }
#undef GLA_DMA
    } else if (wid == 2) {
        f32x16 S[4]; S[0] = f32x16{}; S[1] = f32x16{}; S[2] = f32x16{}; S[3] = f32x16{};
#pragma unroll
        for (int k = 0; k < 8; ++k) *(LAS u32x4*)(X + k * 1024 + lane * 16) = (u32x4){0u, 0u, 0u, 0u};
        for (int c = 0; c < NCH; ++c) {
            GLA_BAR();
            const LAS unsigned char* sb = lds + (c % 3) * S_SLOT;
            bf16x8 vf[4];
#pragma unroll
            for (int s = 0; s < 4; ++s) vf[s] = *(const LAS bf16x8*)(sb + S_VT + s * 1024 + lane * 16);
            bf16x8 KA[4], KB[4];
#define GLA_LK(F, s) do { F[0] = GLA_KF(0, s); F[1] = GLA_KF(1, s); F[2] = GLA_KF(2, s); F[3] = GLA_KF(3, s); } while (0)
#define GLA_MK(F, s) do { _Pragma("unroll") for (int T = 0; T < 4; ++T) S[T] = __builtin_amdgcn_mfma_f32_32x32x16_bf16(F[T], vf[s], S[T], 0, 0, 0); } while (0)
            GLA_LK(KA, 0); GLA_LK(KB, 1);
#pragma unroll
            for (int T = 0; T < 4; ++T)
#pragma unroll
                for (int g = 0; g < 4; ++g) { const f32x4 e = *(const LAS f32x4*)(sb + S_EL + (32 * T + 8 * g + 4 * hi) * 4); S[T][4 * g] *= e.x; S[T][4 * g + 1] *= e.y; S[T][4 * g + 2] *= e.z; S[T][4 * g + 3] *= e.w; }
            __builtin_amdgcn_sched_barrier(0);
            GLA_MK(KA, 0); __builtin_amdgcn_sched_barrier(0); GLA_LK(KA, 2); __builtin_amdgcn_sched_barrier(0);
            GLA_MK(KB, 1); __builtin_amdgcn_sched_barrier(0); GLA_LK(KB, 3); __builtin_amdgcn_sched_barrier(0);
            GLA_MK(KA, 2); __builtin_amdgcn_sched_barrier(0); GLA_MK(KB, 3);
#undef GLA_LK
#undef GLA_MK
            if (c + 1 < NCH) {
                LAS unsigned char* xo = X + ((c + 1) & 1) * 8192 + lane * 16;
#pragma unroll
                for (int T = 0; T < 4; ++T)
#pragma unroll
                    for (int s = 0; s < 2; ++s) { u32x4 w;
#pragma unroll
                        for (int i = 0; i < 4; ++i) w[i] = cvtpk(S[T][8 * s + 2 * i], S[T][8 * s + 2 * i + 1]);
                        *(LAS u32x4*)(xo + (T * 2 + s) * 1024) = w; }
            }
        }
        float* outp = a->out + O_GLAP + (size_t)bh * 128 * 256 + ds * 32 + r32;
#pragma unroll
        for (int T = 0; T < 4; ++T)
#pragma unroll
            for (int r = 0; r < 16; ++r) outp[(size_t)(32 * T + crow(r, hi)) * 256] = S[T][r];
    } else {
        const int tt = wid;
        bf16* const ogbase = WSB(WS_OGRAW) + (size_t)(h * 8 + ds) * RP * 32 + r32;
        for (int c = 0; c < NCH; ++c) {
            GLA_BAR();
            const LAS unsigned char* sb = lds + (c % 3) * S_SLOT; const LAS unsigned char* xi = X + (c & 1) * 8192 + lane * 16;
            const LAS unsigned char* qp = sb + S_QIN + tt * 8192 + lane * 16; const LAS unsigned char* ap = sb + S_AM + tt * 4096 + lane * 16;
            bf16x8 vf[4], Sb[8], Q[8], A[4];
#pragma unroll
            for (int k = 0; k < 8; ++k) { Sb[k] = *(const LAS bf16x8*)(xi + k * 1024); Q[k] = *(const LAS bf16x8*)(qp + k * 1024); }
#pragma unroll
            for (int s = 0; s < 4; ++s) { vf[s] = *(const LAS bf16x8*)(sb + S_VT + s * 1024 + lane * 16); A[s] = *(const LAS bf16x8*)(ap + s * 1024); }
            f32x16 oa = f32x16{}, ob = f32x16{};
#pragma unroll
            for (int k = 0; k < 8; k += 2) { oa = __builtin_amdgcn_mfma_f32_32x32x16_bf16(Q[k], Sb[k], oa, 0, 0, 0); ob = __builtin_amdgcn_mfma_f32_32x32x16_bf16(Q[k + 1], Sb[k + 1], ob, 0, 0, 0); }
            oa = __builtin_amdgcn_mfma_f32_32x32x16_bf16(A[0], vf[0], oa, 0, 0, 0); ob = __builtin_amdgcn_mfma_f32_32x32x16_bf16(A[1], vf[1], ob, 0, 0, 0);
            if (tt == 1) { oa = __builtin_amdgcn_mfma_f32_32x32x16_bf16(A[2], vf[2], oa, 0, 0, 0); ob = __builtin_amdgcn_mfma_f32_32x32x16_bf16(A[3], vf[3], ob, 0, 0, 0); }
            const f32x16 o = oa + ob;
            bf16* og = ogbase;
#pragma unroll
            for (int r = 0; r < 16; ++r) { const int tok = tt * 32 + crow(r, hi); if (c > 0 || tok < NMETA) og[(size_t)chunk_row(b, c, tok) * 32] = (bf16)cvtpk(o[r], o[r]); }
        }
    }
    asm volatile("s_waitcnt vmcnt(0) lgkmcnt(0)\n\ts_barrier" ::: "memory");
#undef GLA_BAR
#undef GLA_QF
#undef GLA_KF
#undef GLA_AF
}
}

__device__ __forceinline__ bool relaunder(ArgsP& a) { asm volatile("" : "+s"(a)); return true; }
constexpr int NPHASE = 22;
__global__ void __launch_bounds__(512, 2) fwd(Args a_unused) {
    ArgsP a = (ArgsP)__builtin_amdgcn_kernarg_segment_ptr();
    extern __shared__ __attribute__((aligned(16))) unsigned char lds_raw[];
    LAS unsigned char* lds = (LAS unsigned char*)lds_raw;
    Ctx c; c.wave = __builtin_amdgcn_readfirstlane((int)threadIdx.x >> 6); c.tid = 0; c.lane = 0;
    c.gw = blockIdx.x * 8 + c.wave; c.ngw = gridDim.x * 8; c.gwT = c.wave * gridDim.x + blockIdx.x;
    volatile LAS unsigned* MISC = (volatile LAS unsigned*)(lds + MISC_OFF);
    if (threadIdx.x < 32) MISC[threadIdx.x] = 0u;
    __syncthreads();
    XcdBarrier bar; bar.bar = (unsigned*)(a->ws + WS_CTL) + CW_BAR; bar.x = 0; bar.st = nullptr;
    const bool one = (a->ph_hi - a->ph_lo) > 1;
    if (one) bar = xcd_barrier_post((unsigned*)(a->ws + WS_CTL) + CW_BAR, MISC + 8);
    const int lo = a->ph_lo, hi = a->ph_hi;
    unsigned long long tp0 = 0, tp1 = 0;
#define IN(k) (((PROBE_LO == (k)) ? (void)(tp0 = __builtin_amdgcn_s_memrealtime()) : (void)0), (lo <= (k) && (k) < hi && relaunder(a)))
#define INQ(k) (lo <= (k) && (k) < hi)
#define SEAM(k) do { if (INQ(k) && INQ((k) + 1)) xcd_barrier(bar, c.wave); if (PROBE_HI == (k)) tp1 = __builtin_amdgcn_s_memrealtime(); } while (0)
    if (IN(0)) { p_prep(a, c, lds); } SEAM(0);
    if (IN(1)) { if ((int)blockIdx.x < (RP / 256) * (NIN0 / 256)) gemm_p1(a, lds, c.wave); else p_side_tables(a, c, lds, (RP / 256) * (NIN0 / 256)); } SEAM(1);
    if (IN(2)) { if (USE_NAIVE_GEMM) p_mla_mid(a, c); }
    if (IN(3)) { gemm_p3(a, lds, c.wave); } SEAM(3);
    if (IN(4)) { if (USE_NAIVE_GEMM) { p_q_post(a, c); p_qlat(a, c); } }
    if (IN(5)) {
#if USE_NAIVE_ATTN
        p_attn_prompt_naive<false>(a, c);
#else
        if (((int)blockIdx.x >> 3) & 1) {
            dec::decode_phase(a, lds, c.wave);
            att::attn_phase(WSB(WS_QN), WSB(WS_QPE), WSB(WS_KNV), WSB(WS_KPE), WSB(WS_O), lds, c.wave);
        } else {
            att::attn_phase(WSB(WS_QN), WSB(WS_QPE), WSB(WS_KNV), WSB(WS_KPE), WSB(WS_O), lds, c.wave);
            dec::decode_phase(a, lds, c.wave);
        }
#endif
    } SEAM(5);
    if (IN(6)) {
#if USE_NAIVE_DECODE
        p_olat_up(a, c);
#else
        dec::combine_phase(a, c, lds);
#endif
    } SEAM(6);
    if (IN(7)) { gemm_n1024_tail<D, 8>(WSB(WS_O), WSB(WS_WO0), WSB(WS_M), WSF(WS_MT), lds, c.wave); } SEAM(7);
    if (IN(8)) { p_post_res<false, 8, true>(a, c, IN_F(8), IN_F(9)); } SEAM(8);
    if (IN(9)) { gemm_mfma8(WSB(WS_H), WSB(WS_WUP), RP, FF, D, (EpiRelu2{WSB(WS_U), FF}), lds, c.wave); p_late_weights(a, c, lds, (RP / 256) * (FF / 256) - 4 * (int)gridDim.x);     } SEAM(9);
    if (IN(10)) { gemm_n1024_tail<FF, 16>(WSB(WS_U), WSB(WS_WDN), WSB(WS_M), WSF(WS_MT), lds, c.wave); } SEAM(10);
    if (IN(11)) { p_post_res<false, 16>(a, c, IN_F(10), IN_F(7) + D); } SEAM(11);
    if (IN(12)) { gemm_mfma8(WSB(WS_H), WSB(WS_WGIN), RP, NGIN, D, (EpiGla{WSB(WS_QG), WSB(WS_KG), WSB(WS_VG), WSB(WS_RG), WSF(WS_GD)}), lds, c.wave); } SEAM(12);
    if (IN(13)) {
#if USE_NAIVE_GLA
        p_gate(a, c);
#else
        gla::prep_phase(a, lds, c.wave);
#endif
    } SEAM(13);
    if (IN(14)) {
#if !USE_NAIVE_GLA
        if ((int)blockIdx.x < NB * GH * gla::NSP) { const int w = (int)blockIdx.x, xcd = w & 7, j = w >> 3;
            gla::scan_bh(a, xcd * (NB * GH / 8) + j / gla::NSP, j % gla::NSP, lds, c.wave); }
        else for (int item = (int)blockIdx.x - NB * GH * gla::NSP; item < DB * GH; item += (int)gridDim.x - NB * GH * gla::NSP) gla::sample_item(a, item, lds, c.wave);
#else
        p_gla_naive(a, c);
#endif
    } SEAM(14);
    if (IN(15)) { p_gla_post(a, c); } SEAM(15);
    if (IN(16)) { gemm_n1024_tail<D, 8>(WSB(WS_OG), WSB(WS_WGO), WSB(WS_M), WSF(WS_MT), lds, c.wave); } SEAM(16);
    if (IN(17)) { p_post_res<false, 8>(a, c, IN_F(8) + D, IN_F(9) + D); } SEAM(17);
    if (IN(18)) { gemm_mfma8(WSB(WS_H), WSB(WS_WUP) + (size_t)FF * D, RP, FF, D, (EpiRelu2{WSB(WS_U), FF}), lds, c.wave); } SEAM(18);
    if (IN(19)) { gemm_n1024_tail<FF, 16>(WSB(WS_U), WSB(WS_WDN) + (size_t)D * FF, WSB(WS_M), WSF(WS_MT), lds, c.wave); } SEAM(19);
    if (IN(20)) { p_post_res<true, 16>(a, c, IN_F(10) + D, nullptr); }
    if (PROBE_LO >= 0 && blockIdx.x == 0) { const unsigned long long span = (tp1 - tp0) * 9ull, t0 = __builtin_amdgcn_s_memrealtime(); while (__builtin_amdgcn_s_memrealtime() - t0 < span) __builtin_amdgcn_s_sleep(8); }
#undef IN
#undef SEAM
}

extern "C" void kernel_launch(void* const* d_in, const int* in_sizes, int n_in, void* d_out, int out_size, void* d_ws, size_t ws_size, hipStream_t stream) {
    static int grid = 0;
    if (grid == 0) {
        if (n_in != 25 || out_size != (int)O_END || ws_size < WS_END) { fprintf(stderr, "kernel_launch: unexpected shapes n_in %d out %d ws %zu\n", n_in, out_size, ws_size); grid = -1; return; }
        int dev = 0, cus = 0, per_cu = 0;
        if (hipGetDevice(&dev) != hipSuccess || hipDeviceGetAttribute(&cus, hipDeviceAttributeMultiprocessorCount, dev) != hipSuccess) { grid = -1; return; }
        if (hipFuncSetAttribute((const void*)fwd, hipFuncAttributeMaxDynamicSharedMemorySize, LDS_BYTES) != hipSuccess) { fprintf(stderr, "kernel_launch: hipFuncSetAttribute failed\n"); grid = -1; return; }
        if (hipOccupancyMaxActiveBlocksPerMultiprocessor(&per_cu, (const void*)fwd, 512, LDS_BYTES) != hipSuccess || per_cu < 1) fprintf(stderr, "kernel_launch: occupancy query says %d\n", per_cu);
        (void)hipGetLastError();
        grid = cus;
    }
    if (grid < 0) return;
    if (hipMemsetAsync((char*)d_ws + WS_CTL, 0, CTL_ZERO_BYTES, stream) != hipSuccess) return;
    Args a{};
    for (int i = 0; i < 25; ++i) a.in[i] = d_in[i];
    a.out = (float*)d_out; a.ws = (unsigned char*)d_ws;
#if MK_ONE_LAUNCH
    a.ph_lo = 0; a.ph_hi = NPHASE;
    hipLaunchKernelGGL(fwd, dim3(grid), dim3(512), LDS_BYTES, stream, a);
#else
    for (int ph = 0; ph < NPHASE - 1; ++ph) { a.ph_lo = ph; a.ph_hi = ph + 1; hipLaunchKernelGGL(fwd, dim3(grid), dim3(512), LDS_BYTES, stream, a); }
#endif
}
```

```cpp
#include <hip/hip_runtime.h>
#include <cstdio>
#include <cstdint>
#include <cmath>

#ifndef MK_ONE_LAUNCH
#define MK_ONE_LAUNCH 1
#endif

constexpr int D = 1024, NB = 4, SEQ = 4096, NMETA = 16, TP = SEQ + NMETA;
constexpr int DB = 128, DS = 4, PAST = 8192, PAGE = 128, NPAGES = 64;
constexpr int NH = 16, QL = 256, KVL = 256, NOPE = 64, ROPE = 32, VH = 64;
constexpr int GH = 4, GDK = 128, GDV = 256, GR = 16;
constexpr int FF = 4096;
constexpr int RMAIN = NB * SEQ;
constexpr int RMETA0 = RMAIN;
constexpr int RSAMP0 = RMAIN + NB * NMETA;
constexpr int R = RSAMP0 + DB * DS;
constexpr int RPROMPT = RSAMP0;
constexpr int RP = 17152;
constexpr int NIN0 = 768, NUQ = 1536, NUKV = 2048, NGIN = 3328, NGIN_REAL = 3088;
constexpr float EPS = 1e-6f;
constexpr float MLA_SCALE = 0.10206207261596575f;
constexpr float GLA_SCALE = 0.08838834764831845f;
constexpr float QSCALE = 0.10206207261596575f * 1.4426950408889634f;

constexpr size_t O_YP = 0, O_YS = 16777216, O_CKVP = 17301504, O_KPEP = 21512192, O_CKVS = 22038528, O_KPES = 22169600, O_GLAP = 22185984, O_GLAS = 22710272, O_END = 39487488;

constexpr size_t MiB = 1u << 20;
constexpr size_t WS_CTL = 0, CTL_ZERO_BYTES = 1 * MiB;
constexpr size_t WS_WIN0 = 2 * MiB, WS_WUQ = 4 * MiB, WS_WUKV = 5 * MiB, WS_WO0 = 6 * MiB, WS_WUP = 8 * MiB, WS_WDN = 24 * MiB, WS_WGIN = 40 * MiB, WS_WGO = 47 * MiB;
constexpr size_t WS_X = 64 * MiB, WS_H = 132 * MiB, WS_M = 166 * MiB, WS_U = 234 * MiB, WS_A1 = 368 * MiB, WS_CQN = 419 * MiB, WS_CKVN = 428 * MiB, WS_KPE = 437 * MiB;
constexpr size_t WS_QRAW = 440 * MiB, WS_KNV = 541 * MiB, WS_QN = 608 * MiB, WS_QPE = 642 * MiB, WS_QLAT = 659 * MiB, WS_OLAT = 663 * MiB, WS_O = 671 * MiB;
constexpr size_t WS_QG = 705 * MiB, WS_KG = 722 * MiB, WS_VG = 739 * MiB, WS_RG = 773 * MiB, WS_GD = 807 * MiB, WS_LA = 809 * MiB, WS_EA = 843 * MiB, WS_OGRAW = 877 * MiB, WS_OG = 944 * MiB;
constexpr size_t WS_OPART = 978 * MiB, WS_MLP = 1012 * MiB;
constexpr size_t WS_QINF = 1014 * MiB, WS_KDTF = 1032 * MiB, WS_AMF = 1050 * MiB, WS_VTF = 1060 * MiB, WS_ELF = 1094 * MiB;
constexpr size_t WS_WUQL = 50 * MiB;
constexpr size_t WS_ROPE = 53 * MiB;
constexpr size_t WS_MT = 1096 * MiB;
constexpr size_t WS_END = 1144 * MiB;
constexpr int CW_BAR = 4096, CW_DEC = 8192;
namespace gla { constexpr int NSP = 8; static_assert(NSP == 8, "the scan's XCD mapping assumes 8 workgroups per (b, h)"); }

constexpr int LDS_BYTES = 163840;
constexpr int MISC_OFF = LDS_BYTES - 256;

#define GAS __attribute__((address_space(1)))
#define LAS __attribute__((address_space(3)))
typedef unsigned short bf16;
typedef float f32x4 __attribute__((ext_vector_type(4)));
typedef unsigned u32x4 __attribute__((ext_vector_type(4)));
typedef unsigned u32x2 __attribute__((ext_vector_type(2)));
#define LDS_WAIT() asm volatile("s_waitcnt lgkmcnt(0)" ::: "memory")

__device__ __forceinline__ unsigned f2bf(float f) { unsigned u = __builtin_bit_cast(unsigned, f); return (u + 0x7fffu + ((u >> 16) & 1u)) >> 16; }
__device__ __forceinline__ unsigned pk2(float lo, float hi) { return f2bf(lo) | (f2bf(hi) << 16); }
__device__ __forceinline__ float bflo(unsigned u) { return __builtin_bit_cast(float, u << 16); }
__device__ __forceinline__ float bfhi(unsigned u) { return __builtin_bit_cast(float, u & 0xffff0000u); }
__device__ __forceinline__ float bf2f(bf16 v) { return __builtin_bit_cast(float, (unsigned)v << 16); }
__device__ __forceinline__ float wave_sum(float v) {
#pragma unroll
    for (int o = 1; o < 64; o <<= 1) v += __shfl_xor(v, o);
    return v;
}
__device__ __forceinline__ int wave_max_i(int v) {
#pragma unroll
    for (int o = 1; o < 64; o <<= 1) { int t = __shfl_xor(v, o); v = t > v ? t : v; }
    return v;
}
__device__ __forceinline__ int fresh_tid(int wave) { int t = wave * 64 + (int)__builtin_amdgcn_mbcnt_hi(~0u, __builtin_amdgcn_mbcnt_lo(~0u, 0u)); asm volatile("" : "+v"(t)); return t; }
__device__ __forceinline__ float rdlane(float v, int l) { return __builtin_bit_cast(float, __builtin_amdgcn_readlane(__builtin_bit_cast(int, v), l)); }

#define XB_TMO      128
#define XB_XCNT(j)  (256  + 64 * (j))
#define XB_XSUB(j)  (1280 + 64 * (j))
#define XB_XGEN(j)  (2304 + 64 * (j))
#define XB_TOP      3328
#define XB_TOPGEN   3392
#define XCD_BAR_WORDS 3456
#define XB_SPIN_CAP (1u << 18)
__device__ __forceinline__ unsigned xb_ld(unsigned* p)              { return __hip_atomic_load(p, __ATOMIC_RELAXED, __HIP_MEMORY_SCOPE_AGENT); }
__device__ __forceinline__ unsigned xb_add(unsigned* p, unsigned v) { return __hip_atomic_fetch_add(p, v, __ATOMIC_RELAXED, __HIP_MEMORY_SCOPE_AGENT); }
__device__ __forceinline__ unsigned xb_xcc_id() { return (unsigned)__builtin_amdgcn_s_getreg((3 << 11) | 20) & 0xFu; }
#define XB_SPIN(cond, bar) do { unsigned _sp = 0; while (cond) { __builtin_amdgcn_s_sleep(1); \
    if ((++_sp & 255u) == 0u) { if (xb_ld(&(bar)[XB_TMO])) break; if (_sp > XB_SPIN_CAP) { atomicAdd(&(bar)[XB_TMO], 1u); break; } } } } while (0)
struct XcdBarrier { unsigned* bar; unsigned x; volatile LAS unsigned* st; };
__device__ __forceinline__ XcdBarrier xcd_barrier_post(unsigned* bar, volatile LAS unsigned* st) {
    XcdBarrier b; b.bar = bar; b.x = xb_xcc_id(); b.st = st;
    if (threadIdx.x == 0) (void)xb_add(&bar[XB_XCNT(b.x)], 1u);
    return b;
}
__device__ __forceinline__ void xcd_barrier_complete(unsigned* bar, unsigned x, unsigned& nloc, unsigned& nx) {
    const unsigned G = gridDim.x * gridDim.y * gridDim.z;
    unsigned sum, cnt, mine, sp = 0u;
    for (;;) {
        sum = 0u; cnt = 0u; mine = 0u;
#pragma unroll
        for (unsigned j = 0; j < 16; ++j) { const unsigned c = xb_ld(&bar[XB_XCNT(j)]); sum += c; cnt += (c > 0u) ? 1u : 0u; mine = (j == x) ? c : mine; }
        if (sum == G) break;
        __builtin_amdgcn_s_sleep(1);
        if ((++sp & 255u) == 0u) { if (xb_ld(&bar[XB_TMO])) break; if (sp > XB_SPIN_CAP) { atomicAdd(&bar[XB_TMO], 1u); break; } }
    }
    nloc = mine > 0u ? mine : 1u; nx = cnt > 0u ? cnt : 1u;
}
__device__ __forceinline__ void xcd_barrier(const XcdBarrier& b, int wave_id) {
    asm volatile("s_waitcnt vmcnt(0)" ::: "memory");
    __syncthreads();
    if (fresh_tid(wave_id) == 0) {
        unsigned* bar = b.bar;
        __builtin_amdgcn_s_waitcnt(0);
        unsigned nloc = b.st[0], nx = b.st[1];
        if (nloc == 0u) { xcd_barrier_complete(bar, b.x, nloc, nx); b.st[0] = nloc; b.st[1] = nx; }
        const unsigned old = xb_add(&bar[XB_XSUB(b.x)], 1u);
        const unsigned gen = old / nloc;
        if (old + 1u == (gen + 1u) * nloc) {
            __builtin_amdgcn_fence(__ATOMIC_RELEASE, "agent");
            asm volatile("s_waitcnt vmcnt(0)" ::: "memory");
            const unsigned og = xb_add(&bar[XB_TOP], 1u);
            const unsigned tg = og / nx;
            if (og + 1u == (tg + 1u) * nx) xb_add(&bar[XB_TOPGEN], 1u);
            else XB_SPIN(xb_ld(&bar[XB_TOPGEN]) == tg, bar);
            __builtin_amdgcn_fence(__ATOMIC_ACQUIRE, "agent");
            xb_add(&bar[XB_XGEN(b.x)], 1u);
            asm volatile("s_waitcnt vmcnt(0)" ::: "memory");
        } else {
            XB_SPIN(xb_ld(&bar[XB_XGEN(b.x)]) == gen, bar);
            __builtin_amdgcn_fence(__ATOMIC_ACQUIRE, "agent");
            asm volatile("s_waitcnt vmcnt(0)" ::: "memory");
        }
    }
    __syncthreads();
}

namespace pg8 {
#define PG8_LAS __attribute__((address_space(3)))
typedef unsigned short bf16_t;
typedef short bf16x8 __attribute__((ext_vector_type(8)));
typedef float f32x4 __attribute__((ext_vector_type(4)));
typedef unsigned u32x4 __attribute__((ext_vector_type(4)));
constexpr int BM = 256, BK = 64, HALF = 128, HTB = HALF * BK * 2  , STAGE_BYTES = 8 * HTB, NXCD = 8, WGM = 8;

__host__ __device__ __forceinline__ int lds_byte(int r, int c) { const int st = (r >> 4) * 2 + (c >> 5), rr = r & 15, cc = c & 31, ob = rr * 64 + cc * 2; return st * 1024 + (ob ^ (((ob >> 9) & 1) << 5)); }
__host__ __device__ __forceinline__ void stage_rc(int b, int& R, int& C) { const int st = b / 1024, sb = b % 1024, swz = sb ^ (((sb >> 9) & 1) << 5); R = (st >> 1) * 16 + swz / 64; C = (st & 1) * 32 + (swz % 64) / 2; }
__host__ __device__ __forceinline__ int perm32(int rho) { const int n = rho >> 4, i = rho & 15; return 8 * (i >> 2) + 4 * n + (i & 3); }

struct Unit { int pm, pn, k0, prob; long aoff, boff; };
struct Gemm { const bf16_t* A; const bf16_t* Bt; int M, N, K, ld; };

struct StaticOrder {
    int nM, nN, nwg, G, c;
    __host__ __device__ void init(int M, int N, int G_, int c_) { nM = M / BM; nN = N / BM; nwg = nM * nN; G = G_; c = c_; }
    __host__ __device__ bool next(int i, Unit& u) const {
        const long L = (long)i * G + c; if (L >= nwg) return false;
        int wgid = (int)L; { const int q = nwg / NXCD, r = nwg % NXCD, xcd = wgid % NXCD, off = wgid / NXCD; wgid = (xcd < r ? xcd * (q + 1) : r * (q + 1) + (xcd - r) * q) + off; }
        const int nig = WGM * nN, gid = wgid / nig, fm = gid * WGM, gsz = (nM - fm) < WGM ? (nM - fm) : WGM;
        u.pm = fm + ((wgid % nig) % gsz); u.pn = (wgid % nig) / gsz; u.k0 = 0; u.prob = 0; u.aoff = 0; u.boff = 0; return true;
    }
    __device__ __forceinline__ void a_ready(const Unit&) const {}
    __device__ __forceinline__ void done(const Unit&) const {}
};

__device__ __forceinline__ unsigned cvt_pk_bf16(float lo, float hi) { unsigned r; asm volatile("v_cvt_pk_bf16_f32 %0, %1, %2" : "=v"(r) : "v"(lo), "v"(hi)); return r; }
template <class Epi, class Sched, bool ALIGN_EPI = false, bool SP2 = false>
__device__ __forceinline__ void gemm_phase(PG8_LAS unsigned char* lds, const Gemm g, const Sched& S, const Epi& E, int wave_id) {
    const int tid = fresh_tid(wave_id), wid = wave_id, lane = tid & 63, wr = wid >> 2, wc = wid & 3, fr = lane & 15, fq = lane >> 4;
    const int K = g.K, nt = K / BK;
    unsigned voffA[2], voffB[2];
#pragma unroll
    for (int i = 0; i < 2; ++i) { int R, C; stage_rc(tid * 16 + i * 8192, R, C); const int Rb = Epi::PERM ? ((R & ~31) + perm32(R & 31)) : R;
        voffA[i] = (unsigned)(R * g.ld + C) * 2u; voffB[i] = (unsigned)(Rb * g.ld + C) * 2u; }
    const size_t kstep = (size_t)(BK * 2);
    const size_t hstep = (size_t)HALF * g.ld * 2;
    const size_t tstep = 2 * hstep;
    const unsigned ldsw = (unsigned)wid * 1024u;
    const int aoff = lds_byte(wr * 64 + fr, fq * 8), boff = lds_byte(wc * 32 + fr, fq * 8);
#define PG8_SA(b, h) (((b) * 2 + (h)) * HTB)
#define PG8_SB(b, h) ((4 + (b) * 2 + (h)) * HTB)
#define PG8_STAGE(bufoff, gbase, voff) do { _Pragma("unroll") for (int _i = 0; _i < 2; ++_i) \
        __builtin_amdgcn_global_load_lds((const unsigned*)((const char*)(gbase) + (voff)[_i]), (PG8_LAS unsigned*)(lds + (bufoff) + ldsw + _i * 8192), 16, 0, 0); } while (0)
#define PG8_LDA(dst, b, h) do { _Pragma("unroll") for (int m = 0; m < 4; ++m) _Pragma("unroll") for (int k = 0; k < 2; ++k) dst[m][k] = *(const PG8_LAS bf16x8*)(lds + PG8_SA(b, h) + aoff + m * 2048 + k * 1024); } while (0)
#define PG8_LDB(dst, b, h) do { _Pragma("unroll") for (int n = 0; n < 2; ++n) _Pragma("unroll") for (int k = 0; k < 2; ++k) dst[n][k] = *(const PG8_LAS bf16x8*)(lds + PG8_SB(b, h) + boff + n * 2048 + k * 1024); } while (0)
#define PG8_MMA(ai, bj, At, Bt) do { __builtin_amdgcn_s_setprio(1); _Pragma("unroll") for (int m = 0; m < 4; ++m) _Pragma("unroll") for (int n = 0; n < 2; ++n) _Pragma("unroll") for (int k = 0; k < 2; ++k) \
        acc[ai][bj][m][n] = __builtin_amdgcn_mfma_f32_16x16x32_bf16(Bt[n][k], At[m][k], acc[ai][bj][m][n], 0, 0, 0); __builtin_amdgcn_s_setprio(0); } while (0)
#define PG8_WAIT_V(n) asm volatile("s_waitcnt vmcnt(" #n ")" ::: "memory")
#define PG8_WAIT_L(n) asm volatile("s_waitcnt lgkmcnt(" #n ")" ::: "memory")
#define PG8_BAR __builtin_amdgcn_s_barrier()
#define PG8_SCHED __builtin_amdgcn_sched_barrier(0)
    Unit cur, nxt; int ui = 0;
    if (!S.next(0, cur)) return;
    f32x4 acc[2][2][4][2];
#pragma unroll
    for (int a = 0; a < 2; ++a)
#pragma unroll
        for (int b = 0; b < 2; ++b)
#pragma unroll
            for (int m = 0; m < 4; ++m)
#pragma unroll
                for (int n = 0; n < 2; ++n) acc[a][b][m][n] = (f32x4){0.f, 0.f, 0.f, 0.f};
    bf16x8 At[4][2], B0[2][2], B1[2][2];
    const char* cA = (const char*)g.A + (size_t)cur.pm * tstep + (size_t)cur.k0 * 2 + cur.aoff; const char* cB = (const char*)g.Bt + (size_t)cur.pn * tstep + (size_t)cur.k0 * 2 + cur.boff;
    S.a_ready(cur);
    if constexpr (SP2) {
        PG8_STAGE(PG8_SB(0, 0), cB, voffB); PG8_STAGE(PG8_SB(0, 1), cB + hstep, voffB); PG8_STAGE(PG8_SA(0, 0), cA, voffA); PG8_STAGE(PG8_SA(0, 1), cA + hstep, voffA);
        if (wr == 1) PG8_BAR;
        PG8_WAIT_V(2); PG8_BAR;
        PG8_STAGE(PG8_SB(1, 0), cB + kstep, voffB); PG8_STAGE(PG8_SA(1, 0), cA + kstep, voffA); PG8_STAGE(PG8_SB(1, 1), cB + hstep + kstep, voffB);
        PG8_WAIT_V(6); PG8_BAR;
    } else {
        PG8_STAGE(PG8_SB(0, 0), cB, voffB); PG8_STAGE(PG8_SA(0, 0), cA, voffA); PG8_STAGE(PG8_SB(0, 1), cB + hstep, voffB); PG8_STAGE(PG8_SA(0, 1), cA + hstep, voffA);
        if (wr == 1) PG8_BAR;
        PG8_WAIT_V(4); PG8_BAR;
        PG8_STAGE(PG8_SB(1, 0), cB + kstep, voffB); PG8_STAGE(PG8_SA(1, 0), cA + kstep, voffA); PG8_STAGE(PG8_SB(1, 1), cB + hstep + kstep, voffB);
        PG8_WAIT_V(6); PG8_BAR;
    }
    for (;;) {
        const bool has_next = S.next(ui + 1, nxt);
        const char* nA = has_next ? (const char*)g.A + (size_t)nxt.pm * tstep + (size_t)nxt.k0 * 2 + nxt.aoff : cA; const char* nB = has_next ? (const char*)g.Bt + (size_t)nxt.pn * tstep + (size_t)nxt.k0 * 2 + nxt.boff : cB;
        for (int t = 0; t < nt; t += 2) {
            const bool last = (t == nt - 2);
            const char* a1 = cA + (size_t)(t + 1) * kstep;
            const char* a2 = last ? nA : cA + (size_t)(t + 2) * kstep; const char* b2 = last ? nB : cB + (size_t)(t + 2) * kstep;
            const char* a3 = a2 + kstep; const char* b3 = b2 + kstep;
            if (last && has_next) S.a_ready(nxt);
            if constexpr (SP2) {
            PG8_LDB(B0, 0, 0); PG8_LDB(B1, 0, 1); PG8_SCHED; PG8_LDA(At, 0, 0); PG8_STAGE(PG8_SA(1, 1), a1 + hstep, voffA);
            PG8_WAIT_V(8); PG8_WAIT_L(0); PG8_BAR; PG8_MMA(0, 0, At, B0); PG8_MMA(0, 1, At, B1); PG8_BAR; PG8_SCHED;
            PG8_LDA(At, 0, 1); PG8_STAGE(PG8_SB(0, 0), b2, voffB); PG8_STAGE(PG8_SB(0, 1), b2 + hstep, voffB); PG8_STAGE(PG8_SA(0, 0), a2, voffA);
            PG8_WAIT_V(8); PG8_WAIT_L(0); PG8_BAR; PG8_MMA(1, 0, At, B0); PG8_MMA(1, 1, At, B1); PG8_BAR; PG8_SCHED;
            PG8_LDB(B0, 1, 0); PG8_LDB(B1, 1, 1); PG8_SCHED; PG8_LDA(At, 1, 0); PG8_STAGE(PG8_SA(0, 1), a2 + hstep, voffA);
            PG8_WAIT_V(8); PG8_WAIT_L(0); PG8_BAR; PG8_MMA(0, 0, At, B0); PG8_MMA(0, 1, At, B1); PG8_BAR; PG8_SCHED;
            PG8_LDA(At, 1, 1); PG8_STAGE(PG8_SB(1, 0), b3, voffB); PG8_STAGE(PG8_SB(1, 1), b3 + hstep, voffB); PG8_STAGE(PG8_SA(1, 0), a3, voffA);
            PG8_WAIT_V(8); PG8_WAIT_L(0); PG8_BAR; PG8_MMA(1, 0, At, B0); PG8_MMA(1, 1, At, B1); PG8_BAR; PG8_SCHED;
            } else {
            PG8_LDB(B0, 0, 0); PG8_SCHED; PG8_LDA(At, 0, 0); PG8_STAGE(PG8_SA(1, 1), a1 + hstep, voffA);
            PG8_WAIT_L(8); PG8_BAR; PG8_WAIT_L(0); PG8_MMA(0, 0, At, B0); PG8_BAR; PG8_SCHED;
            PG8_LDB(B1, 0, 1); PG8_STAGE(PG8_SB(0, 0), b2, voffB);
            PG8_BAR; PG8_WAIT_L(0); PG8_MMA(0, 1, At, B1); PG8_BAR;
            PG8_LDA(At, 0, 1); PG8_STAGE(PG8_SA(0, 0), a2, voffA);
            PG8_BAR; PG8_WAIT_L(0); PG8_MMA(1, 0, At, B0); PG8_BAR; PG8_SCHED;
            PG8_STAGE(PG8_SB(0, 1), b2 + hstep, voffB);
            PG8_WAIT_V(6); PG8_BAR; PG8_MMA(1, 1, At, B1); PG8_BAR;
            PG8_LDB(B0, 1, 0); PG8_SCHED; PG8_LDA(At, 1, 0); PG8_STAGE(PG8_SA(0, 1), a2 + hstep, voffA);
            PG8_WAIT_L(8); PG8_BAR; PG8_WAIT_L(0); PG8_MMA(0, 0, At, B0); PG8_BAR; PG8_SCHED;
            PG8_LDB(B1, 1, 1); PG8_STAGE(PG8_SB(1, 0), b3, voffB);
            PG8_BAR; PG8_WAIT_L(0); PG8_MMA(0, 1, At, B1); PG8_BAR;
            PG8_LDA(At, 1, 1); PG8_STAGE(PG8_SA(1, 0), a3, voffA);
            PG8_BAR; PG8_WAIT_L(0); PG8_MMA(1, 0, At, B0); PG8_BAR; PG8_SCHED;
            PG8_STAGE(PG8_SB(1, 1), b3 + hstep, voffB);
            PG8_WAIT_V(6); PG8_BAR; PG8_MMA(1, 1, At, B1); PG8_BAR;
            }
        }
        if constexpr (ALIGN_EPI) { if (wr == 0) PG8_BAR; }
        if constexpr (!Epi::AFTER_DRAIN) { E(acc, cur, wr, wc, fr, fq); S.done(cur); }
        if (!has_next) break;
#pragma unroll
        for (int a = 0; a < 2; ++a)
#pragma unroll
            for (int b = 0; b < 2; ++b)
#pragma unroll
                for (int m = 0; m < 4; ++m)
#pragma unroll
                    for (int n = 0; n < 2; ++n) acc[a][b][m][n] = (f32x4){0.f, 0.f, 0.f, 0.f};
        cur = nxt; cA = nA; cB = nB; ++ui;
        if constexpr (ALIGN_EPI) { if (wr == 1) PG8_BAR; }
    }
    PG8_WAIT_V(0);
    if constexpr (!ALIGN_EPI) { if (wr == 0) PG8_BAR; }
    PG8_BAR;
    if constexpr (Epi::AFTER_DRAIN) { E.fused(acc, cur, wr, wc, fr, fq, lds, wid, lane); S.done(cur); }
#undef PG8_SA
#undef PG8_SB
#undef PG8_STAGE
#undef PG8_LDA
#undef PG8_LDB
#undef PG8_MMA
#undef PG8_WAIT_V
#undef PG8_WAIT_L
#undef PG8_BAR
#undef PG8_SCHED
}
}

struct Args { const void* in[25]; float* out; unsigned char* ws; int ph_lo, ph_hi; };
typedef const __attribute__((address_space(4))) Args* ArgsP;
#define IN_F(k) ((const float*)a->in[k])
#define WSB(off) ((bf16*)(a->ws + (off)))
#define WSF(off) ((float*)(a->ws + (off)))

struct Ctx { int tid, lane, wave, gw, ngw, gwT; };
__device__ __forceinline__ Ctx refresh(const Ctx& c0) { Ctx c = c0; c.tid = fresh_tid(c0.wave); c.lane = c.tid & 63; return c; }

__device__ __forceinline__ int row_pos(int r) { return r < RMAIN ? (r & 4095) + NMETA : (r < RSAMP0 ? ((r - RMAIN) & 15) : PAST + ((r - RSAMP0) & 3)); }
__device__ __forceinline__ float rope_inv(int j) { return exp2f(-(float)j * (13.287712379549449f / 16.0f)); }
__device__ __forceinline__ void rope_cs(int pos, int j, float& c, float& s) {
    const float ang = (float)pos * rope_inv(j);
    const double x = (double)ang; const double n = rint(x * 0.15915494309189535); const float r = (float)(x - n * 6.283185307179586);
    c = cosf(r); s = sinf(r);
}

struct RmId { int off; __device__ __forceinline__ int operator()(int n) const { return off + n; } };
struct RmUq { __device__ __forceinline__ int operator()(int n) const { const int h = n / 96, j = n % 96; if (j < 64) return h * 64 + j; const int jj = j - 64; return 1024 + h * 32 + (jj < 16 ? 2 * jj : 2 * (jj - 16) + 1); } };
template <class RM>
__device__ __forceinline__ void tr_item(const float* W, int ldw, int nblk, int item, bf16* WT, int ldt, RM rm, LAS float* scr, int lane) {
    const int kb = item / nblk, nb = item % nblk, k0 = 64 * kb, n0 = 32 * nb;
#pragma unroll
    for (int i = 0; i < 8; ++i) { const int kk = 8 * i + (lane >> 3), c4 = (lane & 7) * 4; const f32x4 v = __builtin_nontemporal_load((const f32x4*)(W + (size_t)(k0 + kk) * ldw + n0 + c4));
        scr[kk * 33 + c4] = v.x; scr[kk * 33 + c4 + 1] = v.y; scr[kk * 33 + c4 + 2] = v.z; scr[kk * 33 + c4 + 3] = v.w; }
    LDS_WAIT();
    const int c = lane & 7;
#pragma unroll
    for (int j = 0; j < 4; ++j) { const int n = (lane >> 3) + 8 * j; const LAS float* s = scr + (8 * c) * 33 + n;
        u32x4 o; o.x = pk2(s[0 * 33], s[1 * 33]); o.y = pk2(s[2 * 33], s[3 * 33]); o.z = pk2(s[4 * 33], s[5 * 33]); o.w = pk2(s[6 * 33], s[7 * 33]);
        *(u32x4*)(WT + (size_t)rm(n0 + n) * ldt + k0 + 8 * c) = o; }
    LDS_WAIT();
}
__device__ __forceinline__ void norm_row_bf16(const float* xrow, const float* g, float* xcopy, bf16* hrow, int lane) {
    f32x4 v[4]; float s = 0.f;
#pragma unroll
    for (int j = 0; j < 4; ++j) { v[j] = *(const f32x4*)(xrow + 4 * lane + 256 * j); s += (v[j].x * v[j].x + v[j].y * v[j].y) + (v[j].z * v[j].z + v[j].w * v[j].w); }
    const float rs = 1.0f / sqrtf(wave_sum(s) * (1.f / D) + EPS);
#pragma unroll
    for (int j = 0; j < 4; ++j) { const f32x4 gg = *(const f32x4*)(g + 4 * lane + 256 * j);
        if (xcopy) *(f32x4*)(xcopy + 4 * lane + 256 * j) = v[j];
        u32x2 o; o.x = pk2(v[j].x * rs * gg.x, v[j].y * rs * gg.y); o.y = pk2(v[j].z * rs * gg.z, v[j].w * rs * gg.w);
        *(u32x2*)(hrow + 4 * lane + 256 * j) = o; }
}
__device__ __forceinline__ void p_prep(ArgsP a, const Ctx& c0, LAS unsigned char* lds) {
    const Ctx c = refresh(c0);
    LAS float* scr = (LAS float*)(lds + c.wave * 16384);
    constexpr int I0 = 16 * 17, I1 = 4 * 48, I2 = 4 * 32, I3 = 4 * 32, I4 = 16 * 32, I7 = 16 * 128, I9 = 64 * 32;
    constexpr int NIT = I0 + I1 + I2 + I3 + I4 + I7 + I9;
    for (int it = c.gw; it < NIT; it += c.ngw) {
        int r = it;
        if (r < I0) { tr_item(IN_F(11), 544, 17, r, WSB(WS_WIN0), 1024, RmId{0}, scr, c.lane); continue; } r -= I0;
        if (r < I1) { tr_item(IN_F(13), 1536, 48, r, WSB(WS_WUQ), 256, RmUq{}, scr, c.lane); continue; } r -= I1;
        if (r < I2) { tr_item(IN_F(15), 1024, 32, r, WSB(WS_WUKV), 256, RmId{0}, scr, c.lane); continue; } r -= I2;
        if (r < I3) { tr_item(IN_F(16), 1024, 32, r, WSB(WS_WUKV), 256, RmId{1024}, scr, c.lane); continue; } r -= I3;
        if (r < I4) { tr_item(IN_F(17), 1024, 32, r, WSB(WS_WO0), 1024, RmId{0}, scr, c.lane); continue; } r -= I4;
        if (r < I7) { tr_item(IN_F(23), 4096, 128, r, WSB(WS_WUP), 1024, RmId{0}, scr, c.lane); continue; } r -= I7;
        tr_item(IN_F(24), 1024, 32, r, WSB(WS_WDN), 4096, RmId{0}, scr, c.lane);
    }
    const int gt = c.gw * 64 + c.lane, ngt = c.ngw * 64;
    for (int i = gt; i < (NIN0 - 544) * 1024 / 2; i += ngt) ((unsigned*)(WSB(WS_WIN0) + (size_t)544 * 1024))[i] = 0u;
    for (int i = c.gw * 64 + c.lane; i < R * 16; i += c.ngw * 64) { const int r = i >> 4, j = i & 15; float cs, sn; rope_cs(row_pos(r), j, cs, sn); WSF(WS_ROPE)[(size_t)r * 32 + j] = cs; WSF(WS_ROPE)[(size_t)r * 32 + 16 + j] = sn; }
    {
        const float* xp = IN_F(0); const float* xm = IN_F(6); const float* xsm = IN_F(1); bf16* X = WSB(WS_X); bf16* H = WSB(WS_H);
        f32x4 gg[4];
#pragma unroll
        for (int j = 0; j < 4; ++j) gg[j] = *(const f32x4*)(IN_F(7) + 4 * c.lane + 256 * j);
        constexpr int NR = 4;
        for (int r0 = c.gw; r0 < R; r0 += NR * c.ngw) {
            f32x4 v[NR][4]; float s[NR];
#pragma unroll
            for (int q = 0; q < NR; ++q) { const int r = r0 + q * c.ngw < R ? r0 + q * c.ngw : r0;
                const float* xs = r < RMAIN ? xp + (size_t)r * D : (r < RSAMP0 ? xm + (size_t)((r - RMAIN) & 15) * D : xsm + (size_t)(r - RSAMP0) * D);
                s[q] = 0.f;
#pragma unroll
                for (int j = 0; j < 4; ++j) { v[q][j] = *(const f32x4*)(xs + 4 * c.lane + 256 * j); s[q] += (v[q][j].x * v[q][j].x + v[q][j].y * v[q][j].y) + (v[q][j].z * v[q][j].z + v[q][j].w * v[q][j].w); } }
#pragma unroll
            for (int sh = 1; sh < 64; sh <<= 1) {
#pragma unroll
                for (int q = 0; q < NR; ++q) s[q] += __shfl_xor(s[q], sh); }
#pragma unroll
            for (int q = 0; q < NR; ++q) { const int r = r0 + q * c.ngw < R ? r0 + q * c.ngw : r0; const float rs = 1.0f / sqrtf(s[q] * (1.f / D) + EPS);
#pragma unroll
                for (int j = 0; j < 4; ++j) { if (r >= RMAIN) { u32x2 xo; xo.x = pk2(v[q][j].x, v[q][j].y); xo.y = pk2(v[q][j].z, v[q][j].w); *(u32x2*)(X + (size_t)r * D + 4 * c.lane + 256 * j) = xo; }
                    u32x2 o; o.x = pk2(v[q][j].x * rs * gg[j].x, v[q][j].y * rs * gg[j].y); o.y = pk2(v[q][j].z * rs * gg[j].z, v[q][j].w * rs * gg[j].w);
                    *(u32x2*)(H + (size_t)r * D + 4 * c.lane + 256 * j) = o; } }
        }
    }
}

__device__ __forceinline__ void p_late_weights(ArgsP a, const Ctx& c0, LAS unsigned char* lds, int wg0) {
    const Ctx c = refresh(c0);
    const int bx = (int)blockIdx.x - wg0; if (bx < 0) return;
    const int gw = bx * 8 + c.wave, ngw = ((int)gridDim.x - wg0) * 8;
    LAS float* scr = (LAS float*)(lds + c.wave * 16384);
    constexpr int I5 = 16 * 96, I6 = 16 * 32, I8 = 16 * 128, I10 = 64 * 32, NIT = I5 + I6 + I8 + I10;
    for (int it = gw; it < NIT; it += ngw) {
        int r = it;
        if (r < I5) { tr_item(IN_F(18), 3088, 96, r, WSB(WS_WGIN), 1024, RmId{0}, scr, c.lane); continue; } r -= I5;
        if (r < I6) { tr_item(IN_F(22), 1024, 32, r, WSB(WS_WGO), 1024, RmId{0}, scr, c.lane); continue; } r -= I6;
        if (r < I8) { tr_item(IN_F(23) + (size_t)1024 * 4096, 4096, 128, r, WSB(WS_WUP) + (size_t)4096 * 1024, 1024, RmId{0}, scr, c.lane); continue; } r -= I8;
        tr_item(IN_F(24) + (size_t)4096 * 1024, 1024, 32, r, WSB(WS_WDN) + (size_t)1024 * 4096, 4096, RmId{0}, scr, c.lane);
    }
    const int gt = gw * 64 + c.lane, ngt = ngw * 64;
    for (int i = gt; i < (NGIN - NGIN_REAL) * 1024 / 2; i += ngt) ((unsigned*)(WSB(WS_WGIN) + (size_t)NGIN_REAL * 1024))[i] = 0u;
    for (int i = gt; i < 16 * 1024; i += ngt) { const int n = i >> 10, k = i & 1023; WSB(WS_WGIN)[(size_t)(3072 + n) * 1024 + k] = (bf16)f2bf(IN_F(18)[(size_t)k * 3088 + 3072 + n]); }
}
struct EpiF32 { float* C; int ldc; __device__ __forceinline__ void store4(int row, int col, f32x4 v) const { *(f32x4*)(C + (size_t)row * ldc + col) = v; } };
struct EpiBf16 { bf16* C; int ldc;
    __device__ __forceinline__ void store8(int row, int col, f32x4 a, f32x4 b) const { u32x4 o; o.x = pk2(a.x, a.y); o.y = pk2(a.z, a.w); o.z = pk2(b.x, b.y); o.w = pk2(b.z, b.w); *(u32x4*)(C + (size_t)row * ldc + col) = o; }
    __device__ __forceinline__ void store4(int row, int col, f32x4 v) const { u32x2 o; o.x = pk2(v.x, v.y); o.y = pk2(v.z, v.w); *(u32x2*)(C + (size_t)row * ldc + col) = o; } };
struct EpiRelu2 { bf16* C; int ldc;
    __device__ __forceinline__ void store8(int row, int col, f32x4 a, f32x4 b) const {
        f32x4 r; r.x = fmaxf(a.x, 0.f); r.y = fmaxf(a.y, 0.f); r.z = fmaxf(a.z, 0.f); r.w = fmaxf(a.w, 0.f); r = r * r;
        f32x4 s; s.x = fmaxf(b.x, 0.f); s.y = fmaxf(b.y, 0.f); s.z = fmaxf(b.z, 0.f); s.w = fmaxf(b.w, 0.f); s = s * s;
        u32x4 o; o.x = pk2(r.x, r.y); o.y = pk2(r.z, r.w); o.z = pk2(s.x, s.y); o.w = pk2(s.z, s.w); *(u32x4*)(C + (size_t)row * ldc + col) = o; }
    __device__ __forceinline__ void store4(int row, int col, f32x4 v) const {
    f32x4 r; r.x = fmaxf(v.x, 0.f); r.y = fmaxf(v.y, 0.f); r.z = fmaxf(v.z, 0.f); r.w = fmaxf(v.w, 0.f); r = r * r;
    u32x2 o; o.x = pk2(r.x, r.y); o.y = pk2(r.z, r.w); *(u32x2*)(C + (size_t)row * ldc + col) = o; } };
struct EpiQ { bf16* QN; bf16* QPE; const float* ROPE;
    __device__ __forceinline__ void store8(int row, int col, f32x4 a, f32x4 b) const {
        if (col < 1024) { u32x4 o; o.x = pk2(a.x * QSCALE, a.y * QSCALE); o.y = pk2(a.z * QSCALE, a.w * QSCALE); o.z = pk2(b.x * QSCALE, b.y * QSCALE); o.w = pk2(b.z * QSCALE, b.w * QSCALE); *(u32x4*)(QN + (size_t)row * 1024 + col) = o; }
        else { store4(row, col, a); store4(row, col + 4, b); }
    }
    __device__ __forceinline__ void store4(int row, int col, f32x4 v) const {
        if (col < 1024) { u32x2 o; o.x = pk2(v.x * QSCALE, v.y * QSCALE); o.y = pk2(v.z * QSCALE, v.w * QSCALE); *(u32x2*)(QN + (size_t)row * 1024 + col) = o; }
        else { const int p0 = (col - 1024) >> 1; const float* rt = ROPE + (size_t)row * 32;
#pragma unroll
            for (int e = 0; e < 2; ++e) { const int p = p0 + e, h = p >> 4, jj = p & 15; const float x1 = e ? v.z : v.x, x2 = e ? v.w : v.y, cs = rt[jj], sn = rt[16 + jj];
                QPE[(size_t)row * 512 + h * 32 + jj] = (bf16)f2bf((x1 * cs - x2 * sn) * QSCALE); QPE[(size_t)row * 512 + h * 32 + 16 + jj] = (bf16)f2bf((x1 * sn + x2 * cs) * QSCALE); } }
    } };
struct EpiBf16S { bf16* C; int ldc; float s;
    __device__ __forceinline__ void store8(int row, int col, f32x4 a, f32x4 b) const { u32x4 o; o.x = pk2(a.x * s, a.y * s); o.y = pk2(a.z * s, a.w * s); o.z = pk2(b.x * s, b.y * s); o.w = pk2(b.z * s, b.w * s); *(u32x4*)(C + (size_t)row * ldc + col) = o; }
    __device__ __forceinline__ void store4(int row, int col, f32x4 v) const { u32x2 o; o.x = pk2(v.x * s, v.y * s); o.y = pk2(v.z * s, v.w * s); *(u32x2*)(C + (size_t)row * ldc + col) = o; } };
struct EpiGla { bf16 *QG, *KG, *VG, *RG; float* GD;
    __device__ __forceinline__ void store8(int row, int col, f32x4 a, f32x4 b) const {
        if (col < 3072) { bf16* dst; int cc;
            if (col < 512) { dst = QG + (size_t)row * 512; cc = col; a = a * GLA_SCALE; b = b * GLA_SCALE; }
            else if (col < 1024) { dst = KG + (size_t)row * 512; cc = col - 512; }
            else if (col < 2048) { dst = VG + (size_t)row * 1024; cc = col - 1024; }
            else { dst = RG + (size_t)row * 1024; cc = col - 2048; }
            u32x4 o; o.x = pk2(a.x, a.y); o.y = pk2(a.z, a.w); o.z = pk2(b.x, b.y); o.w = pk2(b.z, b.w); *(u32x4*)(dst + cc) = o;
        } else if (col < 3088) { *(f32x4*)(GD + (size_t)row * 16 + (col - 3072)) = a; *(f32x4*)(GD + (size_t)row * 16 + (col - 3072) + 4) = b; }
    }
    __device__ __forceinline__ void store4(int row, int col, f32x4 v) const {
        if (col < 3072) { bf16* dst; int cc;
            if (col < 512) { dst = QG + (size_t)row * 512; cc = col; v = v * GLA_SCALE; }
            else if (col < 1024) { dst = KG + (size_t)row * 512; cc = col - 512; }
            else if (col < 2048) { dst = VG + (size_t)row * 1024; cc = col - 1024; }
            else { dst = RG + (size_t)row * 1024; cc = col - 2048; }
            u32x2 o; o.x = pk2(v.x, v.y); o.y = pk2(v.z, v.w); *(u32x2*)(dst + cc) = o;
        } else if (col < 3088) { *(f32x4*)(GD + (size_t)row * 16 + (col - 3072)) = v; }
    } };
template <class Epi>
__device__ __forceinline__ void gemm_naive(const bf16* A, const bf16* Bt, int M, int N, int K, const Epi& E, LAS unsigned char* lds, int tid) {
    LAS float* As = (LAS float*)lds;
    LAS float* Bs = As + 32 * 68;
    const int ntm = M / 64, ntn = N / 128, ty = tid >> 5, tx = tid & 31;
    for (int tile = blockIdx.x; tile < ntm * ntn; tile += gridDim.x) {
        const int tm = tile / ntn, tn = tile % ntn;
        f32x4 acc[4];
#pragma unroll
        for (int i = 0; i < 4; ++i) acc[i] = (f32x4){0.f, 0.f, 0.f, 0.f};
        for (int k0 = 0; k0 < K; k0 += 32) {
            { const int row = tid >> 3, kq = (tid & 7) * 4; const u32x2 v = *(const u32x2*)(A + (size_t)(tm * 64 + row) * K + k0 + kq);
              As[(kq + 0) * 68 + row] = bflo(v.x); As[(kq + 1) * 68 + row] = bfhi(v.x); As[(kq + 2) * 68 + row] = bflo(v.y); As[(kq + 3) * 68 + row] = bfhi(v.y); }
            { const int row = tid >> 2, kq = (tid & 3) * 8; const u32x4 v = *(const u32x4*)(Bt + (size_t)(tn * 128 + row) * K + k0 + kq);
              Bs[(kq + 0) * 132 + row] = bflo(v.x); Bs[(kq + 1) * 132 + row] = bfhi(v.x); Bs[(kq + 2) * 132 + row] = bflo(v.y); Bs[(kq + 3) * 132 + row] = bfhi(v.y);
              Bs[(kq + 4) * 132 + row] = bflo(v.z); Bs[(kq + 5) * 132 + row] = bfhi(v.z); Bs[(kq + 6) * 132 + row] = bflo(v.w); Bs[(kq + 7) * 132 + row] = bfhi(v.w); }
            __syncthreads();
#pragma unroll 8
            for (int k = 0; k < 32; ++k) {
                const f32x4 av = *(const LAS f32x4*)(As + k * 68 + 4 * ty); const f32x4 bv = *(const LAS f32x4*)(Bs + k * 132 + 4 * tx);
                acc[0] += av.x * bv; acc[1] += av.y * bv; acc[2] += av.z * bv; acc[3] += av.w * bv;
            }
            __syncthreads();
        }
#pragma unroll
        for (int i = 0; i < 4; ++i) E.store4(tm * 64 + 4 * ty + i, tn * 128 + 4 * tx, acc[i]);
    }
}


template <class E> struct EpiWrap {
    static constexpr bool PERM = false, AFTER_DRAIN = false; E e;
    __device__ __forceinline__ void operator()(const pg8::f32x4 (&acc)[2][2][4][2], const pg8::Unit& u, int wr, int wc, int fr, int fq) const {
#pragma unroll
        for (int ai = 0; ai < 2; ++ai)
#pragma unroll
            for (int m = 0; m < 4; ++m) { const int row = u.pm * 256 + ai * 128 + wr * 64 + m * 16 + fr;
#pragma unroll
                for (int bj = 0; bj < 2; ++bj)
#pragma unroll
                    for (int n = 0; n < 2; ++n) e.store4(row, u.pn * 256 + bj * 128 + wc * 32 + n * 16 + 4 * fq, acc[ai][bj][m][n]); }
    }
};
template <int KSUB> struct EpiSlab {
    static constexpr bool PERM = false, AFTER_DRAIN = false; float* MT;
    __device__ __forceinline__ void operator()(const pg8::f32x4 (&acc)[2][2][4][2], const pg8::Unit& u, int wr, int wc, int fr, int fq) const {
        float* base = MT + ((size_t)(u.k0 / KSUB) * (RP - RMAIN) + (size_t)(u.pm * 256 - RMAIN)) * D + u.pn * 256 + wc * 32 + 4 * fq;
#pragma unroll
        for (int ai = 0; ai < 2; ++ai)
#pragma unroll
            for (int m = 0; m < 4; ++m) { float* rp = base + (size_t)(ai * 128 + wr * 64 + m * 16 + fr) * D;
#pragma unroll
                for (int bj = 0; bj < 2; ++bj)
#pragma unroll
                    for (int n = 0; n < 2; ++n) *(f32x4*)(rp + bj * 128 + n * 16) = acc[ai][bj][m][n]; }
    }
};
template <class E> struct EpiWrap8 {
    static constexpr bool PERM = true, AFTER_DRAIN = false; E e;
    __device__ __forceinline__ void operator()(const pg8::f32x4 (&acc)[2][2][4][2], const pg8::Unit& u, int wr, int wc, int fr, int fq) const {
#pragma unroll
        for (int ai = 0; ai < 2; ++ai)
#pragma unroll
            for (int m = 0; m < 4; ++m) { const int row = u.pm * 256 + ai * 128 + wr * 64 + m * 16 + fr;
#pragma unroll
                for (int bj = 0; bj < 2; ++bj) e.store8(row, u.pn * 256 + bj * 128 + wc * 32 + 8 * fq, acc[ai][bj][m][0], acc[ai][bj][m][1]); }
    }
};
template <class E>
__device__ __forceinline__ void gemm_mfma8(const bf16* A, const bf16* Bt, int M, int N, int K, const E& e, LAS unsigned char* lds, int wave) {
    pg8::Gemm g{A, Bt, M, N, K, K}; pg8::StaticOrder S; S.init(M, N, (int)gridDim.x, (int)blockIdx.x);
    EpiWrap8<E> W{e};
    pg8::gemm_phase<EpiWrap8<E>, pg8::StaticOrder, true, true>(lds, g, S, W, wave);
}
template <class E>
__device__ __forceinline__ void gemm_mfma(const bf16* A, const bf16* Bt, int M, int N, int K, const E& e, LAS unsigned char* lds, int wave) {
    pg8::Gemm g{A, Bt, M, N, K, K}; pg8::StaticOrder S; S.init(M, N, (int)gridDim.x, (int)blockIdx.x);
    EpiWrap<E> W{e};
    pg8::gemm_phase<EpiWrap<E>, pg8::StaticOrder, true, true>(lds, g, S, W, wave);
}
template <int SPLIT, int NN, int KSUB, int PM0, int NUNITS> struct TailOrder {
    int G, c;
    __device__ __forceinline__ bool next(int i, pg8::Unit& u) const { const int L = i * G + c; if (L >= NUNITS) return false; const int ks = L % SPLIT, t = L / SPLIT; u.pn = t % NN; u.pm = PM0 + t / NN; u.k0 = ks * KSUB; u.prob = 0; u.aoff = 0; u.boff = 0; return true; }
    __device__ __forceinline__ void a_ready(const pg8::Unit&) const {}
    __device__ __forceinline__ void done(const pg8::Unit&) const {}
};
struct EpiAtomicF32 { float* C; int ldc; __device__ __forceinline__ void store4(int row, int col, f32x4 v) const { float* p = C + (size_t)row * ldc + col;
    __hip_atomic_fetch_add(p, v.x, __ATOMIC_RELAXED, __HIP_MEMORY_SCOPE_AGENT); __hip_atomic_fetch_add(p + 1, v.y, __ATOMIC_RELAXED, __HIP_MEMORY_SCOPE_AGENT);
    __hip_atomic_fetch_add(p + 2, v.z, __ATOMIC_RELAXED, __HIP_MEMORY_SCOPE_AGENT); __hip_atomic_fetch_add(p + 3, v.w, __ATOMIC_RELAXED, __HIP_MEMORY_SCOPE_AGENT); } };
template <int K, int SPLIT>
__device__ __forceinline__ void gemm_n1024_tail(const bf16* A, const bf16* Bt, bf16* C, float* MT, LAS unsigned char* lds, int wave) {
    { pg8::Gemm g{A, Bt, RMAIN, D, K, K}; pg8::StaticOrder S; S.init(RMAIN, D, (int)gridDim.x, (int)blockIdx.x); EpiWrap8<EpiBf16> W{EpiBf16{C, D}};
      pg8::gemm_phase<EpiWrap8<EpiBf16>, pg8::StaticOrder, true, true>(lds, g, S, W, wave); }
    { typedef TailOrder<SPLIT, D / 256, K / SPLIT, RMAIN / 256, (RP - RMAIN) / 256 * (D / 256) * SPLIT> TO;
      pg8::Gemm g{A, Bt, RP, D, K / SPLIT, K}; TO S{(int)gridDim.x, (int)blockIdx.x}; EpiSlab<K / SPLIT> W{MT};
      pg8::gemm_phase<EpiSlab<K / SPLIT>, TO, false, true>(lds, g, S, W, wave); }
}

struct P3Order {
    int G, c;
    static constexpr int NQ = (RP / 256) * (NUQ / 256), NL = (DB * DS / 256) * (NH * KVL / 256), NK = (RP / 256) * (NUKV / 256);
    __device__ __forceinline__ bool next(int i, pg8::Unit& u) const {
        int L = i * G + c; u.k0 = 0;
        if (L < NK) { u.prob = 2; u.pm = L / (NUKV / 256); u.pn = L % (NUKV / 256); u.aoff = (long)(WS_CKVN - WS_CQN); u.boff = (long)(WS_WUKV - WS_WUQ); return true; } L -= NK;
        if (L < NQ) { u.prob = 0; u.pm = L / (NUQ / 256); u.pn = L % (NUQ / 256); u.aoff = 0; u.boff = 0; return true; } L -= NQ;
        if (L < NL) { u.prob = 1; u.pm = L / (NH * KVL / 256); u.pn = L % (NH * KVL / 256); u.aoff = (long)RSAMP0 * QL * 2; u.boff = (long)(WS_WUQL - WS_WUQ); return true; }
        return false;
    }
    __device__ __forceinline__ void a_ready(const pg8::Unit&) const {}
    __device__ __forceinline__ void done(const pg8::Unit&) const {}
};
struct EpiP3 {
    static constexpr bool PERM = true, AFTER_DRAIN = false; EpiQ eq; EpiBf16S el; EpiBf16 ek;
    __device__ __forceinline__ void operator()(const pg8::f32x4 (&acc)[2][2][4][2], const pg8::Unit& u, int wr, int wc, int fr, int fq) const {
        asm volatile("" : "+v"(fr), "+v"(fq));
        if (u.prob == 0) { EpiWrap8<EpiQ> w{eq}; w(acc, u, wr, wc, fr, fq); }
        else if (u.prob == 1) { EpiWrap8<EpiBf16S> w{el}; w(acc, u, wr, wc, fr, fq); }
        else { EpiWrap8<EpiBf16> w{ek}; w(acc, u, wr, wc, fr, fq); }
    }
};
__device__ __forceinline__ void gemm_p3(ArgsP a, LAS unsigned char* lds, int wave) {
    pg8::Gemm g{WSB(WS_CQN), WSB(WS_WUQ), RP, NUQ, QL, QL}; P3Order S{(int)gridDim.x, (int)blockIdx.x};
    EpiP3 E{EpiQ{WSB(WS_QN), WSB(WS_QPE), WSF(WS_ROPE)}, EpiBf16S{WSB(WS_QLAT), NH * KVL, QSCALE}, EpiBf16{WSB(WS_KNV), NUKV}};
    pg8::gemm_phase<EpiP3, P3Order, false, true>(lds, g, S, E, wave);
}

struct EpiMlaIn {
    static constexpr bool PERM = false, AFTER_DRAIN = true;
    bf16 *CQN, *CKVN, *KPEB; const float *qg, *kg, *ROPE; float* out;
    __device__ __forceinline__ void fused(pg8::f32x4 (&acc)[2][2][4][2], const pg8::Unit& u, int wr, int wc, int fr, int fq, PG8_LAS unsigned char* lds, int wid, int lane) const {
        asm volatile("" : "+v"(fr), "+v"(fq));
        if (u.pn < 2) {
            PG8_LAS float* P = (PG8_LAS float*)lds;
            float s[2][4];
#pragma unroll
            for (int ai = 0; ai < 2; ++ai)
#pragma unroll
                for (int m = 0; m < 4; ++m) { float t = 0.f;
#pragma unroll
                    for (int bj = 0; bj < 2; ++bj)
#pragma unroll
                        for (int n = 0; n < 2; ++n) { const pg8::f32x4 x = acc[ai][bj][m][n]; t += (x[0] * x[0] + x[1] * x[1]) + (x[2] * x[2] + x[3] * x[3]); }
                    t += __shfl_xor(t, 16); t += __shfl_xor(t, 32);
                    if (fq == 0) P[(ai * 128 + wr * 64 + m * 16 + fr) * 4 + wc] = t; }
            asm volatile("s_waitcnt lgkmcnt(0)\n\ts_barrier" ::: "memory");
#pragma unroll
            for (int ai = 0; ai < 2; ++ai)
#pragma unroll
                for (int m = 0; m < 4; ++m) { const pg8::f32x4 p4 = *(const PG8_LAS pg8::f32x4*)(P + (ai * 128 + wr * 64 + m * 16 + fr) * 4); s[ai][m] = 1.0f / sqrtf(((p4[0] + p4[1]) + (p4[2] + p4[3])) * (1.f / 256) + EPS); }
            const float* g = u.pn == 0 ? qg : kg; bf16* dst = u.pn == 0 ? CQN : CKVN;
#pragma unroll
            for (int bj = 0; bj < 2; ++bj)
#pragma unroll
                for (int n = 0; n < 2; ++n) { const int col = bj * 128 + wc * 32 + n * 16 + 4 * fq; const pg8::f32x4 gv = *(const pg8::f32x4*)(g + col);
#pragma unroll
                    for (int ai = 0; ai < 2; ++ai)
#pragma unroll
                        for (int m = 0; m < 4; ++m) { const int row = u.pm * 256 + ai * 128 + wr * 64 + m * 16 + fr; if (row >= R) continue;
                            const pg8::f32x4 y = acc[ai][bj][m][n] * s[ai][m] * gv;
                            u32x2 o; o.x = pk2(y[0], y[1]); o.y = pk2(y[2], y[3]); *(u32x2*)(dst + (size_t)row * 256 + col) = o;
                            if (u.pn == 1) { const int pos = row_pos(row); float* oc = row < RSAMP0 ? out + O_CKVP + ((size_t)(row < RMAIN ? (row >> 12) : ((row - RMAIN) >> 4)) * TP + pos) * 256 : out + O_CKVS + (size_t)(row - RSAMP0) * 256;
                                *(pg8::f32x4*)(oc + col) = y; } } }
        } else if (wc == 0) {
#pragma unroll
            for (int ai = 0; ai < 2; ++ai)
#pragma unroll
                for (int m = 0; m < 4; ++m) { const int row = u.pm * 256 + ai * 128 + wr * 64 + m * 16 + fr; if (row >= R) continue;
                    const int pos = row_pos(row); const float* rt = ROPE + (size_t)row * 32 + 4 * fq; const pg8::f32x4 cs = *(const pg8::f32x4*)rt, sn = *(const pg8::f32x4*)(rt + 16);
                    const pg8::f32x4 x1 = acc[ai][0][m][0], x2 = acc[ai][0][m][1]; const pg8::f32x4 o1 = x1 * cs - x2 * sn, o2 = x1 * sn + x2 * cs;
                    float* ok = row < RSAMP0 ? out + O_KPEP + ((size_t)(row < RMAIN ? (row >> 12) : ((row - RMAIN) >> 4)) * TP + pos) * 32 : out + O_KPES + (size_t)(row - RSAMP0) * 32;
                    *(pg8::f32x4*)(ok + 4 * fq) = o1; *(pg8::f32x4*)(ok + 16 + 4 * fq) = o2;
                    u32x2 w; w.x = pk2(o1[0], o1[1]); w.y = pk2(o1[2], o1[3]); *(u32x2*)(KPEB + (size_t)row * 32 + 4 * fq) = w; w.x = pk2(o2[0], o2[1]); w.y = pk2(o2[2], o2[3]); *(u32x2*)(KPEB + (size_t)row * 32 + 16 + 4 * fq) = w; }
        }
    }
};
__device__ __forceinline__ void gemm_p1(ArgsP a, LAS unsigned char* lds, int wave) {
    pg8::Gemm g{WSB(WS_H), WSB(WS_WIN0), RP, NIN0, D, D}; pg8::StaticOrder S; S.init(RP, NIN0, (int)gridDim.x, (int)blockIdx.x);
    EpiMlaIn E{WSB(WS_CQN), WSB(WS_CKVN), WSB(WS_KPE), IN_F(12), IN_F(14), WSF(WS_ROPE), a->out};
    pg8::gemm_phase<EpiMlaIn, pg8::StaticOrder, false, true>(lds, g, S, E, wave);
}
#ifndef USE_NAIVE_ATTN
#define USE_NAIVE_ATTN 0
#endif
#ifndef USE_NAIVE_DECODE
#define USE_NAIVE_DECODE 0
#endif
#ifndef USE_NAIVE_GLA
#define USE_NAIVE_GLA 0
#endif
#ifndef PROBE
#define PROBE 0
#endif
#ifndef PROBE_LO
#define PROBE_LO -1
#define PROBE_HI -1
#endif
#ifndef USE_NAIVE_GEMM
#define USE_NAIVE_GEMM 0
#endif
#if USE_NAIVE_GEMM
#define GEMM(A, Bt, M, N, K, E) gemm_naive(A, Bt, M, N, K, E, lds, fresh_tid(c.wave))
#else
#define GEMM(A, Bt, M, N, K, E) gemm_mfma(A, Bt, M, N, K, E, lds, c.wave)
#endif


namespace att {
typedef short bf16x8 __attribute__((ext_vector_type(8)));
typedef short s16x4 __attribute__((ext_vector_type(4)));
typedef float f32x16 __attribute__((ext_vector_type(16)));
constexpr int KSLOT = 12288, VSLOT = 8192, LDS_K = 0, LDS_V = 2 * KSLOT, LDS_WS = LDS_V + 2 * VSLOT, LDS_OST = LDS_WS + 8 * 256, LDS_TOTAL = LDS_OST + 8 * 4096;
__device__ __forceinline__ int crow(int r, int hi) { return (r & 3) + 8 * (r >> 2) + 4 * hi; }
typedef float f32x2_t __attribute__((ext_vector_type(2))); typedef __bf16 bf16x2_t __attribute__((ext_vector_type(2)));
__device__ __forceinline__ unsigned cvtpk(float lo, float hi) { f32x2_t v = {lo, hi}; bf16x2_t b = __builtin_convertvector(v, bf16x2_t); return __builtin_bit_cast(unsigned, b); }
__device__ __forceinline__ s16x4 vtr(const LAS unsigned char* p) { typedef short v4i16_t __attribute__((ext_vector_type(4))); return __builtin_bit_cast(s16x4, __builtin_amdgcn_ds_read_tr16_b64_v4i16((LAS v4i16_t*)p)); }
__device__ __forceinline__ float pmax32(float m) { auto rr = __builtin_amdgcn_permlane32_swap(__float_as_uint(m), __float_as_uint(m), false, false); return fmaxf(__uint_as_float(rr[0]), __uint_as_float(rr[1])); }
__device__ __forceinline__ float psum32(float m) { auto rr = __builtin_amdgcn_permlane32_swap(__float_as_uint(m), __float_as_uint(m), false, false); return __uint_as_float(rr[0]) + __uint_as_float(rr[1]); }
#define ATT_WAIT_BAR() asm volatile("s_waitcnt vmcnt(0) lgkmcnt(0)\n\ts_barrier" ::: "memory")
__device__ __forceinline__ void glds16(const void* gsrc, unsigned lds_dst) { unsigned keep;
    asm volatile("s_mov_b32 %0, m0\n\ts_mov_b32 m0, %2\n\ts_nop 0\n\tglobal_load_lds_dwordx4 %1, off\n\ts_mov_b32 m0, %0" : "=&s"(keep) : "v"(gsrc), "s"(lds_dst) : "memory"); }

__device__ __forceinline__ void attn_unit(int b, int h, int qb, const bf16* QN, const bf16* QPE, const bf16* KNV, const bf16* KPE, bf16* O, LAS unsigned char* lds, int wave_id) {
    const int tid = fresh_tid(wave_id), lane = tid & 63, r32 = lane & 31, hi = lane >> 5; const int wid = wave_id;
    const int rowbase = b * SEQ, q0 = qb * 256, qrow = rowbase + q0 + wid * 32 + r32, qrel = q0 + wid * 32 + r32;
    bf16x8 qr[6];
#pragma unroll
    for (int d0 = 0; d0 < 4; ++d0) qr[d0] = *(const bf16x8*)(QN + (size_t)qrow * 1024 + h * 64 + d0 * 16 + hi * 8);
#pragma unroll
    for (int d0 = 0; d0 < 2; ++d0) qr[4 + d0] = *(const bf16x8*)(QPE + (size_t)qrow * 512 + h * 32 + d0 * 16 + hi * 8);
    LAS float* wsf = (LAS float*)(lds + LDS_WS) + wid * 64;
    const int NT = 4 * qb + 4;
#define ATT_DMA(t, slot) do { const size_t row0_ = (t) == 0 ? (size_t)(RMAIN + 16 * b) : (size_t)(rowbase + 64 * ((t) - 1)); \
        __builtin_amdgcn_global_load_lds((const unsigned*)(KNV + (row0_ + lane) * 2048 + h * 64 + wid * 8), (LAS unsigned*)(lds + LDS_K + (slot) * KSLOT + wid * 1024), 16, 0, 0); \
        if (wid < 4) __builtin_amdgcn_global_load_lds((const unsigned*)(KPE + (row0_ + lane) * 32 + wid * 8), (LAS unsigned*)(lds + LDS_K + (slot) * KSLOT + (8 + wid) * 1024), 16, 0, 0); \
        __builtin_amdgcn_global_load_lds((const unsigned*)(KNV + (row0_ + 16 * (wid & 3) + (lane >> 2)) * 2048 + 1024 + h * 64 + (wid >> 2) * 32 + (lane & 3) * 8), (LAS unsigned*)(lds + LDS_V + (slot) * VSLOT + wid * 1024), 16, 0, 0); } while (0)
    f32x16 o[2]; o[0] = f32x16{}; o[1] = f32x16{};
    float mref = -INFINITY, l = 0.f;
    ATT_DMA(0, 0);
    for (int t = 0; t <= NT; ++t) {
        ATT_WAIT_BAR();
        const int slot = t & 1;
        if (t < NT) ATT_DMA(t + 1, slot ^ 1);
        const int kt0 = 64 * (t - 1);
        if (t > 0 && kt0 > q0 + wid * 32 + 31) continue;
        f32x16 p0 = f32x16{}, p1 = f32x16{};
        const LAS unsigned char* kb = lds + LDS_K + slot * KSLOT + hi * 1024 + r32 * 16;
#pragma unroll
        for (int d0 = 0; d0 < 6; ++d0) {
            const bf16x8 b0 = *(const LAS bf16x8*)(kb + d0 * 2048), b1 = *(const LAS bf16x8*)(kb + d0 * 2048 + 512);
            p0 = __builtin_amdgcn_mfma_f32_32x32x16_bf16(b0, qr[d0], p0, 0, 0, 0);
            p1 = __builtin_amdgcn_mfma_f32_32x32x16_bf16(b1, qr[d0], p1, 0, 0, 0);
        }
        if (t == 0) {
#pragma unroll
            for (int r = 0; r < 16; ++r) { if (crow(r, hi) >= NMETA) p0[r] = -INFINITY; p1[r] = -INFINITY; }
        } else if (kt0 + 63 > q0 + wid * 32) {
#pragma unroll
            for (int r = 0; r < 16; ++r) { const int kv = kt0 + crow(r, hi); if (kv > qrel) p0[r] = -INFINITY; if (kv + 32 > qrel) p1[r] = -INFINITY; }
        }
        float rm = fmaxf(p0[0], p1[0]);
#pragma unroll
        for (int r = 1; r < 16; ++r) rm = fmaxf(rm, fmaxf(p0[r], p1[r]));
        rm = pmax32(rm);
        if (__any(rm > mref + 8.0f)) {
            const float mnew = fmaxf(mref, rm); const float f = __builtin_amdgcn_exp2f(mref - mnew);
            mref = mnew; l *= f;
            if (hi == 0) wsf[r32] = f;
            LDS_WAIT();
#pragma unroll
            for (int r = 0; r < 16; ++r) { const float fr = wsf[crow(r, hi)]; o[0][r] *= fr; o[1][r] *= fr; }
        }
        float sacc = 0.f;
#pragma unroll
        for (int r = 0; r < 16; ++r) { p0[r] = __builtin_amdgcn_exp2f(p0[r] - mref); p1[r] = __builtin_amdgcn_exp2f(p1[r] - mref); sacc += p0[r] + p1[r]; }
        l += sacc;
        u32x4 pw[4];
#pragma unroll
        for (int i = 0; i < 4; ++i) { pw[0][i] = cvtpk(p0[2 * i], p0[2 * i + 1]); pw[1][i] = cvtpk(p0[8 + 2 * i], p0[8 + 2 * i + 1]); pw[2][i] = cvtpk(p1[2 * i], p1[2 * i + 1]); pw[3][i] = cvtpk(p1[8 + 2 * i], p1[8 + 2 * i + 1]); }
        const LAS unsigned char* vb = lds + LDS_V + slot * VSLOT + ((lane >> 4) & 1) * 32 + (lane & 3) * 8 + (4 * hi + ((lane & 15) >> 2)) * 64;
#pragma unroll
        for (int d0 = 0; d0 < 2; ++d0)
#pragma unroll
            for (int ks = 0; ks < 4; ++ks) {
                const s16x4 vlo = vtr(vb + d0 * 4096 + ks * 1024), vhi = vtr(vb + d0 * 4096 + ks * 1024 + 512);
                const bf16x8 vf = (bf16x8){vlo[0], vlo[1], vlo[2], vlo[3], vhi[0], vhi[1], vhi[2], vhi[3]};
                o[d0] = __builtin_amdgcn_mfma_f32_32x32x16_bf16(__builtin_bit_cast(bf16x8, pw[ks]), vf, o[d0], 0, 0, 0);
            }
    }
    l = psum32(l);
    if (hi == 0) wsf[32 + r32] = l;
    LDS_WAIT();
    bf16* Ow = O + (size_t)(rowbase + q0 + wid * 32) * 1024 + h * 64;
    LAS bf16* stg = (LAS bf16*)(lds + LDS_OST) + wid * 2048;
#pragma unroll
    for (int r = 0; r < 16; ++r) { const int orow = crow(r, hi); const float il = 1.0f / wsf[32 + orow];
        stg[orow * 64 + r32] = (bf16)f2bf(o[0][r] * il); stg[orow * 64 + 32 + r32] = (bf16)f2bf(o[1][r] * il); }
    LDS_WAIT();
#pragma unroll
    for (int i = 0; i < 4; ++i) { const int row = i * 8 + (lane >> 3), ch = lane & 7; const u32x4 v = *(const LAS u32x4*)(stg + row * 64 + ch * 8); *(u32x4*)(Ow + (size_t)row * 1024 + ch * 8) = v; }
    ATT_WAIT_BAR();
#undef ATT_DMA
}
constexpr int P_LDS_K = 0, P_LDS_V = 3 * KSLOT, P_LDS_WS = P_LDS_V + 2 * VSLOT, P_LDS_OST = P_LDS_WS + 8 * 256, P_LDS_TOTAL = P_LDS_OST + 8 * 4096;
__device__ __forceinline__ void attn_unit2(int b, int h, int qb, const bf16* QN, const bf16* QPE, const bf16* KNV, const bf16* KPE, bf16* O, LAS unsigned char* lds, int wave_id) {
    const int tid = fresh_tid(wave_id), lane = tid & 63, r32 = lane & 31, hi = lane >> 5; const int wid = wave_id;
    const bool meta = qb < 0;
    const int rowbase = b * SEQ, q0 = meta ? 0 : qb * 256, qrow = meta ? RMAIN + 16 * b + (r32 & 15) : rowbase + q0 + wid * 32 + r32, qrel = meta ? (r32 & 15) : q0 + wid * 32 + r32;
    bf16x8 qr[6];
#pragma unroll
    for (int d0 = 0; d0 < 4; ++d0) qr[d0] = *(const bf16x8*)(QN + (size_t)qrow * 1024 + h * 64 + d0 * 16 + hi * 8);
#pragma unroll
    for (int d0 = 0; d0 < 2; ++d0) qr[4 + d0] = *(const bf16x8*)(QPE + (size_t)qrow * 512 + h * 32 + d0 * 16 + hi * 8);
    LAS float* wsf = (LAS float*)(lds + P_LDS_WS) + wid * 64;
    const unsigned lds0 = (unsigned)(size_t)lds;
    const int NT = meta ? 0 : 4 * qb + 4;
#define A2_ROW0(t) ((t) == 0 ? (size_t)(RMAIN + 16 * b) : (size_t)(rowbase + 64 * ((t) - 1)))
#define A2_DMA_K(t, ks) do { const size_t row0_ = A2_ROW0(t); \
        glds16(KNV + (row0_ + lane) * 2048 + h * 64 + wid * 8, (unsigned)__builtin_amdgcn_readfirstlane((int)(lds0 + P_LDS_K + (ks) * KSLOT + wid * 1024))); \
        if (wid < 4) glds16(KPE + (row0_ + lane) * 32 + wid * 8, (unsigned)__builtin_amdgcn_readfirstlane((int)(lds0 + P_LDS_K + (ks) * KSLOT + (8 + wid) * 1024))); } while (0)
#define A2_DMA_V(t, vs) do { const size_t row0_ = A2_ROW0(t); \
        glds16(KNV + (row0_ + 16 * (wid & 3) + (lane >> 2)) * 2048 + 1024 + h * 64 + (wid >> 2) * 32 + (lane & 3) * 8, (unsigned)__builtin_amdgcn_readfirstlane((int)(lds0 + P_LDS_V + (vs) * VSLOT + wid * 1024))); } while (0)
#define A2_QKT(P0, P1, ks) do { P0 = f32x16{}; P1 = f32x16{}; const LAS unsigned char* kb_ = lds + P_LDS_K + (ks) * KSLOT + hi * 1024 + r32 * 16; \
        _Pragma("unroll") for (int d0 = 0; d0 < 6; ++d0) { const bf16x8 b0_ = *(const LAS bf16x8*)(kb_ + d0 * 2048), b1_ = *(const LAS bf16x8*)(kb_ + d0 * 2048 + 512); \
            P0 = __builtin_amdgcn_mfma_f32_32x32x16_bf16(b0_, qr[d0], P0, 0, 0, 0); P1 = __builtin_amdgcn_mfma_f32_32x32x16_bf16(b1_, qr[d0], P1, 0, 0, 0); } } while (0)
    f32x16 o[2]; o[0] = f32x16{}; o[1] = f32x16{};
    float mref = -INFINITY, l = 0.f;
#define A2_TILE(P0, P1, t, vs) do { \
        if ((t) == 0) { const int qlim_ = meta ? (r32 & 15) : NMETA - 1; _Pragma("unroll") for (int r = 0; r < 16; ++r) { if (crow(r, hi) > qlim_) P0[r] = -INFINITY; P1[r] = -INFINITY; } } \
        else { const int kt0_ = 64 * ((t) - 1); if (kt0_ + 63 > q0 + wid * 32) { _Pragma("unroll") for (int r = 0; r < 16; ++r) { const int kv = kt0_ + crow(r, hi); if (kv > qrel) P0[r] = -INFINITY; if (kv + 32 > qrel) P1[r] = -INFINITY; } } } \
        float rm_ = fmaxf(P0[0], P1[0]); \
        _Pragma("unroll") for (int r = 1; r < 16; ++r) rm_ = fmaxf(rm_, fmaxf(P0[r], P1[r])); \
        rm_ = pmax32(rm_); \
        if (__any(rm_ > mref + 8.0f)) { const float mnew = fmaxf(mref, rm_); const float f = __builtin_amdgcn_exp2f(mref - mnew); mref = mnew; l *= f; \
            if (hi == 0) wsf[r32] = f; LDS_WAIT(); \
            _Pragma("unroll") for (int r = 0; r < 16; ++r) { const float fr = wsf[crow(r, hi)]; o[0][r] *= fr; o[1][r] *= fr; } } \
        float sacc_ = 0.f; \
        _Pragma("unroll") for (int r = 0; r < 16; ++r) { P0[r] = __builtin_amdgcn_exp2f(P0[r] - mref); P1[r] = __builtin_amdgcn_exp2f(P1[r] - mref); sacc_ += P0[r] + P1[r]; } \
        l += sacc_; \
        u32x4 pw_[4]; \
        _Pragma("unroll") for (int i = 0; i < 4; ++i) { pw_[0][i] = cvtpk(P0[2 * i], P0[2 * i + 1]); pw_[1][i] = cvtpk(P0[8 + 2 * i], P0[8 + 2 * i + 1]); pw_[2][i] = cvtpk(P1[2 * i], P1[2 * i + 1]); pw_[3][i] = cvtpk(P1[8 + 2 * i], P1[8 + 2 * i + 1]); } \
        const LAS unsigned char* vb_ = lds + P_LDS_V + (vs) * VSLOT + ((lane >> 4) & 1) * 32 + (lane & 3) * 8 + (4 * hi + ((lane & 15) >> 2)) * 64; \
        _Pragma("unroll") for (int d0 = 0; d0 < 2; ++d0) _Pragma("unroll") for (int ks = 0; ks < 4; ++ks) { \
            const s16x4 vlo = vtr(vb_ + d0 * 4096 + ks * 1024), vhi = vtr(vb_ + d0 * 4096 + ks * 1024 + 512); \
            const bf16x8 vf = (bf16x8){vlo[0], vlo[1], vlo[2], vlo[3], vhi[0], vhi[1], vhi[2], vhi[3]}; \
            o[d0] = __builtin_amdgcn_mfma_f32_32x32x16_bf16(__builtin_bit_cast(bf16x8, pw_[ks]), vf, o[d0], 0, 0, 0); } } while (0)
    f32x16 pA0, pA1, pB0, pB1;
    A2_DMA_K(0, 0); A2_DMA_V(0, 0); if (NT >= 1) A2_DMA_K(1, 1);
    ATT_WAIT_BAR();
    A2_QKT(pA0, pA1, 0);
    int kc = 0, vc = 0, t = 0;
#define A2_STEP(PC0, PC1, PN0, PN1) do { \
        if (t > 0) ATT_WAIT_BAR(); \
        const int kn_ = kc == 2 ? 0 : kc + 1, k2_ = kn_ == 2 ? 0 : kn_ + 1; \
        if (t + 2 <= NT) A2_DMA_K(t + 2, k2_); \
        if (t + 1 <= NT) { A2_DMA_V(t + 1, vc ^ 1); A2_QKT(PN0, PN1, kn_); } \
        A2_TILE(PC0, PC1, t, vc); \
        kc = kn_; vc ^= 1; ++t; } while (0)
    while (t + 1 <= NT) { A2_STEP(pA0, pA1, pB0, pB1); A2_STEP(pB0, pB1, pA0, pA1); }
    A2_STEP(pA0, pA1, pB0, pB1);
    l = psum32(l);
    if (hi == 0) wsf[32 + r32] = l;
    LDS_WAIT();
    bf16* Ow = O + (size_t)(meta ? RMAIN + 16 * b : rowbase + q0 + wid * 32) * 1024 + h * 64;
    LAS bf16* stg = (LAS bf16*)(lds + P_LDS_OST) + wid * 2048;
#pragma unroll
    for (int r = 0; r < 16; ++r) { const int orow = crow(r, hi); const float il = 1.0f / wsf[32 + orow];
        stg[orow * 64 + r32] = (bf16)f2bf(o[0][r] * il); stg[orow * 64 + 32 + r32] = (bf16)f2bf(o[1][r] * il); }
    LDS_WAIT();
#pragma unroll
    for (int i = 0; i < 4; ++i) { const int row = i * 8 + (lane >> 3), ch = lane & 7; const u32x4 v = *(const LAS u32x4*)(stg + row * 64 + ch * 8); if (!meta || (wid == 0 && row < NMETA)) *(u32x4*)(Ow + (size_t)row * 1024 + ch * 8) = v; }
    ATT_WAIT_BAR();
#undef A2_ROW0
#undef A2_DMA_K
#undef A2_DMA_V
#undef A2_QKT
#undef A2_TILE
#undef A2_STEP
}
__device__ __forceinline__ void attn_phase(const bf16* QN, const bf16* QPE, const bf16* KNV, const bf16* KPE, bf16* O, LAS unsigned char* lds, int wave_id) {
    const int G = gridDim.x, bx = blockIdx.x; const int vcu = (G % 8 == 0) ? (bx % 8) * (G / 8) + bx / 8 : bx;
    for (int v = vcu; v < NB * NH * 4; v += G) {
        const int bh = v >> 2, s0 = v & 3;
#pragma unroll 1
        for (int i = 0; i < 4; ++i) { const int qb = (i == 0) ? 15 - s0 : (i == 1) ? 11 - s0 : (i == 2) ? 4 + s0 : s0; attn_unit2(bh >> 4, bh & 15, qb, QN, QPE, KNV, KPE, O, lds, wave_id); }
        if (v < NB * NH) attn_unit2(v >> 4, v & 15, -1, QN, QPE, KNV, KPE, O, lds, wave_id);
    }
}
}


namespace dec {
using att::bf16x8; using att::s16x4; using att::f32x16; using att::crow; using att::cvtpk; using att::vtr; using att::pmax32; using att::psum32;
constexpr int KST = 592, KBUF = 64 * KST, LDS_K = 0, LDS_Q = 2 * KBUF, LDS_WS = LDS_Q + 64 * KST, LDS_TOTAL = LDS_WS + 8 * 256;
constexpr int NSTAGE = 64;
__device__ __forceinline__ void decode_unit(int db, int sp, ArgsP a, LAS unsigned char* lds, int wave_id) {
    const int tid = fresh_tid(wave_id), lane = tid & 63, r32 = lane & 31, hi = lane >> 5; const int wid = wave_id;
    const int qh = wid & 1, kh = (wid >> 1) & 1, dh = wid >> 2;
    const float* cckv = IN_F(2); const float* ckpe = IN_F(3); const int* pt = (const int*)a->in[5] + db * NPAGES + sp * 32;
    for (int i = tid; i < 64 * 36; i += 512) { const int q = i / 36, ch = i % 36, t = q >> 4, h = q & 15;
        const bf16* src = ch < 32 ? WSB(WS_QLAT) + ((size_t)(db * 4 + t) * 16 + h) * 256 + ch * 8 : WSB(WS_QPE) + (size_t)(RSAMP0 + db * 4 + t) * 512 + h * 32 + (ch - 32) * 8;
        *(LAS u32x4*)(lds + LDS_Q + q * KST + ch * 16) = *(const u32x4*)src; }
    f32x4 cv[8], kv, cw[8], kw;
#define DEC_LOAD(CV, KV, s) do { const int page_ = __builtin_amdgcn_readfirstlane(pt[(s) >> 1]); const size_t k0_ = (size_t)page_ * PAGE + ((s) & 1) * 64; \
        _Pragma("unroll") for (int j = 0; j < 8; ++j) CV[j] = __builtin_nontemporal_load((const f32x4*)(cckv + (k0_ + wid + 8 * j) * 256 + 4 * lane));     \
        KV = __builtin_nontemporal_load((const f32x4*)(ckpe + (k0_ + (tid >> 3)) * 32 + 4 * (tid & 7))); } while (0)
#define DEC_WRITE(CV, KV, buf) do { LAS unsigned char* kb_ = lds + LDS_K + (buf) * KBUF; \
        _Pragma("unroll") for (int j = 0; j < 8; ++j) { u32x2 w_; w_.x = cvtpk(CV[j].x, CV[j].y); w_.y = cvtpk(CV[j].z, CV[j].w); *(LAS u32x2*)(kb_ + (wid + 8 * j) * KST + lane * 8) = w_; } \
        { u32x2 w_; w_.x = cvtpk(KV.x, KV.y); w_.y = cvtpk(KV.z, KV.w); *(LAS u32x2*)(kb_ + (tid >> 3) * KST + 512 + (tid & 7) * 8) = w_; } } while (0)
    LAS float* wsf = (LAS float*)(lds + LDS_WS) + wid * 64;
    f32x16 o[4]; o[0] = f32x16{}; o[1] = f32x16{}; o[2] = f32x16{}; o[3] = f32x16{};
    float mref = -INFINITY, l = 0.f;
#define DEC_BAR() asm volatile("s_waitcnt lgkmcnt(0)\n\ts_barrier" ::: "memory")
    DEC_LOAD(cv, kv, 0); DEC_WRITE(cv, kv, 0); DEC_LOAD(cv, kv, 1); DEC_LOAD(cw, kw, 2);
    DEC_BAR();
#define DEC_COMPUTE(BUF) do { \
        const LAS unsigned char* kimg = lds + LDS_K + (BUF) * KBUF; \
        f32x16 p = f32x16{}; \
        { const LAS unsigned char* kb = kimg + (kh * 32 + r32) * KST + hi * 16; const LAS unsigned char* qb = lds + LDS_Q + (qh * 32 + r32) * KST + hi * 16; \
        _Pragma("unroll") \
          for (int s2 = 0; s2 < 18; ++s2) p = __builtin_amdgcn_mfma_f32_32x32x16_bf16(*(const LAS bf16x8*)(kb + s2 * 32), *(const LAS bf16x8*)(qb + s2 * 32), p, 0, 0, 0); } \
        float rm = p[0]; \
        _Pragma("unroll") \
        for (int r = 1; r < 16; ++r) rm = fmaxf(rm, p[r]); \
        rm = pmax32(rm); \
        if (__any(rm > mref + 8.0f)) { \
            const float mnew = fmaxf(mref, rm); const float f = __builtin_amdgcn_exp2f(mref - mnew); \
            mref = mnew; l *= f; \
            if (hi == 0) wsf[r32] = f; \
            LDS_WAIT(); \
        _Pragma("unroll") \
            for (int r = 0; r < 16; ++r) { const float fr = wsf[crow(r, hi)]; o[0][r] *= fr; o[1][r] *= fr; o[2][r] *= fr; o[3][r] *= fr; } \
        } \
        float sacc = 0.f; \
        _Pragma("unroll") \
        for (int r = 0; r < 16; ++r) { p[r] = __builtin_amdgcn_exp2f(p[r] - mref); sacc += p[r]; } \
        l += sacc; \
        u32x4 pw[2]; \
        _Pragma("unroll") \
        for (int i = 0; i < 4; ++i) { pw[0][i] = cvtpk(p[2 * i], p[2 * i + 1]); pw[1][i] = cvtpk(p[8 + 2 * i], p[8 + 2 * i + 1]); } \
        const LAS unsigned char* vb = kimg + (kh * 32 + 4 * hi + ((lane & 15) >> 2)) * KST + (dh * 128 + 16 * ((lane >> 4) & 1) + 4 * (lane & 3)) * 2; \
        _Pragma("unroll") \
        for (int dt = 0; dt < 4; ++dt) \
        _Pragma("unroll") \
            for (int ks = 0; ks < 2; ++ks) { \
                const s16x4 vlo = vtr(vb + (ks * 16) * KST + dt * 64), vhi = vtr(vb + (ks * 16 + 8) * KST + dt * 64); \
                const bf16x8 vf = (bf16x8){vlo[0], vlo[1], vlo[2], vlo[3], vhi[0], vhi[1], vhi[2], vhi[3]}; \
                o[dt] = __builtin_amdgcn_mfma_f32_32x32x16_bf16(__builtin_bit_cast(bf16x8, pw[ks]), vf, o[dt], 0, 0, 0); \
            } \
    } while (0)
    static_assert(NSTAGE % 2 == 0, "stage loop is unrolled by two");
    for (int s = 0; s < NSTAGE; s += 2) {
        DEC_COMPUTE(0);
        DEC_WRITE(cv, kv, 1); DEC_LOAD(cv, kv, (s + 3 < NSTAGE ? s + 3 : NSTAGE - 1));
        DEC_BAR();
        DEC_COMPUTE(1);
        DEC_WRITE(cw, kw, 0); DEC_LOAD(cw, kw, (s + 4 < NSTAGE ? s + 4 : NSTAGE - 1));
        DEC_BAR();
    }
#undef DEC_COMPUTE
#undef DEC_BAR
    const int part = (db * 2 + sp) * 2 + kh;
    float* op = WSF(WS_OPART) + (size_t)part * 64 * 256;
#pragma unroll
    for (int dt = 0; dt < 4; ++dt)
#pragma unroll
        for (int r = 0; r < 16; ++r) op[(size_t)(qh * 32 + crow(r, hi)) * 256 + dh * 128 + dt * 32 + r32] = o[dt][r];
    l = psum32(l);
    if (dh == 0 && hi == 0) { float* mp = WSF(WS_MLP) + (size_t)part * 128 + (qh * 32 + r32) * 2; mp[0] = mref; mp[1] = l; }
#undef DEC_LOAD
#undef DEC_WRITE
}
struct LaneCtx { int lane, wave; };
__device__ __forceinline__ void combine_item(ArgsP a, int db, int h, const LaneCtx c, LAS unsigned char* lds) {
    {
        f32x4 cn[4]; float en[4];
#pragma unroll
        for (int s2 = 0; s2 < 4; ++s2) { const int kr = RSAMP0 + db * 4 + s2;
            const u32x2 v = *(const u32x2*)(WSB(WS_CKVN) + (size_t)kr * 256 + 4 * c.lane); cn[s2] = (f32x4){bflo(v.x), bfhi(v.x), bflo(v.y), bfhi(v.y)};
            en[s2] = c.lane < 32 ? bf2f(WSB(WS_KPE)[(size_t)kr * 32 + c.lane]) : 0.f; }
        f32x4 res[4];
#pragma unroll
        for (int t = 0; t < 4; ++t) {
            const int i = db * 4 + t, q = t * 16 + h;
            const u32x2 qv = *(const u32x2*)(WSB(WS_QLAT) + ((size_t)i * 16 + h) * 256 + 4 * c.lane); const f32x4 ql = (f32x4){bflo(qv.x), bfhi(qv.x), bflo(qv.y), bfhi(qv.y)};
            const float qp = c.lane < 32 ? bf2f(WSB(WS_QPE)[(size_t)(RSAMP0 + i) * 512 + h * 32 + c.lane]) : 0.f;
            float mp[4], lp[4], dn[4]; float mg = -INFINITY;
#pragma unroll
            for (int p = 0; p < 4; ++p) { const float* ml = WSF(WS_MLP) + (size_t)(db * 4 + p) * 128 + q * 2; mp[p] = ml[0]; lp[p] = ml[1]; mg = fmaxf(mg, mp[p]); }
#pragma unroll
            for (int s2 = 0; s2 < 4; ++s2) {
                float d = (ql.x * cn[s2].x + ql.y * cn[s2].y) + (ql.z * cn[s2].z + ql.w * cn[s2].w) + qp * en[s2];
                d = wave_sum(d); dn[s2] = s2 <= t ? d : -INFINITY; mg = fmaxf(mg, dn[s2]);
            }
            f32x4 acc = (f32x4){0.f, 0.f, 0.f, 0.f}; float L = 0.f;
#pragma unroll
            for (int p = 0; p < 4; ++p) { const float w = exp2f(mp[p] - mg); L += w * lp[p]; acc += w * *(const f32x4*)(WSF(WS_OPART) + ((size_t)(db * 4 + p) * 64 + q) * 256 + 4 * c.lane); }
#pragma unroll
            for (int s2 = 0; s2 < 4; ++s2) { const float w = exp2f(dn[s2] - mg); L += w; acc += w * cn[s2]; }
            res[t] = acc * (1.0f / L);
            __builtin_amdgcn_sched_barrier(0);
        }
        LAS bf16* rt = (LAS bf16*)(lds + 8 * 256 + c.wave * 2048);
#pragma unroll
        for (int t = 0; t < 4; ++t) { u32x2 w; w.x = pk2(res[t].x, res[t].y); w.y = pk2(res[t].z, res[t].w); *(LAS u32x2*)(rt + t * 256 + 4 * c.lane) = w; }
        LDS_WAIT();
        const int r32 = c.lane & 31, hi = c.lane >> 5;
        att::f32x16 o0 = att::f32x16{}, o1 = att::f32x16{};
        const bf16* wb = WSB(WS_WUKV) + (size_t)(1024 + h * 64 + r32) * 256 + 8 * hi;
#pragma unroll
        for (int s = 0; s < 16; ++s) {
            att::bf16x8 af = att::bf16x8{}; if (r32 < 4) af = *(const LAS att::bf16x8*)(rt + r32 * 256 + 16 * s + 8 * hi);
            const att::bf16x8 b0 = *(const att::bf16x8*)(wb + 16 * s), b1 = *(const att::bf16x8*)(wb + 32 * 256 + 16 * s);
            o0 = __builtin_amdgcn_mfma_f32_32x32x16_bf16(af, b0, o0, 0, 0, 0); o1 = __builtin_amdgcn_mfma_f32_32x32x16_bf16(af, b1, o1, 0, 0, 0);
        }
        if (hi == 0) {
#pragma unroll
            for (int t = 0; t < 4; ++t) { bf16* op = WSB(WS_O) + (size_t)(RSAMP0 + db * 4 + t) * 1024 + h * 64 + r32; op[0] = (bf16)f2bf(o0[t]); op[32] = (bf16)f2bf(o1[t]); }
        }
        LDS_WAIT();
    }
}
__device__ __forceinline__ void combine_phase(ArgsP a, const Ctx& c0, LAS unsigned char* lds) {
    const Ctx c = refresh(c0);
    for (int it = c.gw; it < DB * NH; it += c.ngw) combine_item(a, it >> 4, it & 15, LaneCtx{c.lane, c.wave}, lds);
}
__device__ __forceinline__ void decode_phase(ArgsP a, LAS unsigned char* lds, int wave_id) {
    for (int u = blockIdx.x; u < DB * 2; u += gridDim.x) { decode_unit(u >> 1, u & 1, a, lds, wave_id); __syncthreads(); }
}
}

__device__ __forceinline__ void p_side_tables(ArgsP a, const Ctx& c0, LAS unsigned char* lds, int wg0) {
    const Ctx c = refresh(c0);
    const int nwg = (int)gridDim.x - wg0, bx = (int)blockIdx.x - wg0;
    if (bx < 0) return;
    const int gt = (bx * 8 + c.wave) * 64 + c.lane, ngt = nwg * 512;
    {
        const int r32 = c.lane & 31, hi = c.lane >> 5;
        for (int it = bx * 8 + c.wave; it < NH * 64; it += nwg * 8) {
            const int h = it >> 6, ct = (it >> 3) & 7, kt = it & 7;
            const float* ap = IN_F(15) + (size_t)(ct * 32 + r32) * 1024 + h * 64 + 8 * hi;
            const float* bp = IN_F(13) + (size_t)(kt * 32 + r32) * 1536 + h * 96 + 8 * hi;
            att::f32x16 acc = att::f32x16{};
#pragma unroll
            for (int s = 0; s < 4; ++s) {
                const f32x4 a0 = *(const f32x4*)(ap + 16 * s), a1 = *(const f32x4*)(ap + 16 * s + 4), b0 = *(const f32x4*)(bp + 16 * s), b1 = *(const f32x4*)(bp + 16 * s + 4);
                const u32x4 aw = (u32x4){pk2(a0.x, a0.y), pk2(a0.z, a0.w), pk2(a1.x, a1.y), pk2(a1.z, a1.w)}, bw = (u32x4){pk2(b0.x, b0.y), pk2(b0.z, b0.w), pk2(b1.x, b1.y), pk2(b1.z, b1.w)};
                acc = __builtin_amdgcn_mfma_f32_32x32x16_bf16(__builtin_bit_cast(att::bf16x8, aw), __builtin_bit_cast(att::bf16x8, bw), acc, 0, 0, 0);
            }
            bf16* op = WSB(WS_WUQL) + (size_t)(h * 256 + ct * 32) * 256 + kt * 32 + r32;
#pragma unroll
            for (int r = 0; r < 16; ++r) op[(size_t)att::crow(r, hi) * 256] = (bf16)f2bf(acc[r]);
        }
    }
}
__device__ __forceinline__ void p_mla_mid(ArgsP a, const Ctx& c0) {
    const Ctx c = refresh(c0);
    const float* A1 = WSF(WS_A1); bf16* CQN = WSB(WS_CQN); bf16* CKVN = WSB(WS_CKVN); bf16* KPEB = WSB(WS_KPE); const float* ROPE = WSF(WS_ROPE); float* out = a->out;
    const f32x4 gq = *(const f32x4*)(IN_F(12) + 4 * c.lane), gk = *(const f32x4*)(IN_F(14) + 4 * c.lane);
    constexpr int NR = 4;
    for (int r0 = c.gw; r0 < R; r0 += NR * c.ngw) {
        f32x4 cq[NR], ck[NR]; float sq[NR], sk[NR], x1[NR], x2[NR], cs[NR], sn[NR];
#pragma unroll
        for (int q = 0; q < NR; ++q) { const int r = r0 + q * c.ngw < R ? r0 + q * c.ngw : r0; const float* row = A1 + (size_t)r * NIN0;
            cq[q] = *(const f32x4*)(row + 4 * c.lane); ck[q] = *(const f32x4*)(row + 256 + 4 * c.lane);
            const int j = c.lane & 15; x1[q] = row[512 + j]; x2[q] = row[528 + j]; cs[q] = ROPE[(size_t)r * 32 + j]; sn[q] = ROPE[(size_t)r * 32 + 16 + j];
            sq[q] = (cq[q].x * cq[q].x + cq[q].y * cq[q].y) + (cq[q].z * cq[q].z + cq[q].w * cq[q].w); sk[q] = (ck[q].x * ck[q].x + ck[q].y * ck[q].y) + (ck[q].z * ck[q].z + ck[q].w * ck[q].w); }
#pragma unroll
        for (int sh = 1; sh < 64; sh <<= 1) {
#pragma unroll
            for (int q = 0; q < NR; ++q) { sq[q] += __shfl_xor(sq[q], sh); sk[q] += __shfl_xor(sk[q], sh); } }
#pragma unroll
        for (int q = 0; q < NR; ++q) { const int r = r0 + q * c.ngw < R ? r0 + q * c.ngw : r0; const int pos = row_pos(r);
            const float rq = 1.0f / sqrtf(sq[q] * (1.f / 256) + EPS), rk = 1.0f / sqrtf(sk[q] * (1.f / 256) + EPS);
            const f32x4 qn = cq[q] * rq * gq, kn = ck[q] * rk * gk;
            u32x2 o; o.x = pk2(qn.x, qn.y); o.y = pk2(qn.z, qn.w); *(u32x2*)(CQN + (size_t)r * 256 + 4 * c.lane) = o;
            o.x = pk2(kn.x, kn.y); o.y = pk2(kn.z, kn.w); *(u32x2*)(CKVN + (size_t)r * 256 + 4 * c.lane) = o;
            float* ockv; float* okpe;
            if (r < RSAMP0) { const int b = r < RMAIN ? (r >> 12) : ((r - RMAIN) >> 4); ockv = out + O_CKVP + ((size_t)b * TP + pos) * 256; okpe = out + O_KPEP + ((size_t)b * TP + pos) * 32; }
            else { ockv = out + O_CKVS + (size_t)(r - RSAMP0) * 256; okpe = out + O_KPES + (size_t)(r - RSAMP0) * 32; }
            *(f32x4*)(ockv + 4 * c.lane) = kn;
            if (c.lane < 16) { const int j = c.lane; const float o1 = x1[q] * cs[q] - x2[q] * sn[q], o2 = x1[q] * sn[q] + x2[q] * cs[q]; okpe[j] = o1; okpe[16 + j] = o2;
                KPEB[(size_t)r * 32 + j] = (bf16)f2bf(o1); KPEB[(size_t)r * 32 + 16 + j] = (bf16)f2bf(o2); } }
    }
}
__device__ __forceinline__ void p_q_post(ArgsP a, const Ctx& c0) {
    const Ctx c = refresh(c0);
    for (int r = c.gw; r < R; r += c.ngw) {
        const float* row = WSF(WS_QRAW) + (size_t)r * NUQ; const int pos = row_pos(r);
        const float qs = QSCALE;
#pragma unroll
        for (int j = 0; j < 4; ++j) { const f32x4 v = *(const f32x4*)(row + 4 * c.lane + 256 * j) * qs; u32x2 o; o.x = pk2(v.x, v.y); o.y = pk2(v.z, v.w); *(u32x2*)(WSB(WS_QN) + (size_t)r * 1024 + 4 * c.lane + 256 * j) = o; }
#pragma unroll
        for (int j = 0; j < 4; ++j) { const int p = c.lane + 64 * j, h = p >> 4, jj = p & 15; const float x1 = row[1024 + 2 * p], x2 = row[1024 + 2 * p + 1]; float cs, sn; rope_cs(pos, jj, cs, sn);
            WSB(WS_QPE)[(size_t)r * 512 + h * 32 + jj] = (bf16)f2bf((x1 * cs - x2 * sn) * qs); WSB(WS_QPE)[(size_t)r * 512 + h * 32 + 16 + jj] = (bf16)f2bf((x1 * sn + x2 * cs) * qs); }
    }
}
__device__ __forceinline__ void p_qlat(ArgsP a, const Ctx& c0) {
    const Ctx c = refresh(c0);
    const float* wuk = IN_F(15);
    for (int it = c.gw; it < DB * DS * NH; it += c.ngw) {
        const int i = it >> 4, h = it & 15;
        const float q = WSF(WS_QRAW)[(size_t)(RSAMP0 + i) * NUQ + h * 64 + c.lane];
        float acc[4] = {0.f, 0.f, 0.f, 0.f};
#pragma unroll 8
        for (int n = 0; n < 64; ++n) { const float qn = __shfl(q, n);
#pragma unroll
            for (int k = 0; k < 4; ++k) acc[k] += qn * wuk[(size_t)(c.lane + 64 * k) * 1024 + h * 64 + n]; }
#pragma unroll
        for (int k = 0; k < 4; ++k) WSB(WS_QLAT)[((size_t)i * 16 + h) * 256 + c.lane + 64 * k] = (bf16)f2bf(acc[k] * QSCALE);
    }
}
template <bool META_ONLY>
__device__ __forceinline__ void p_attn_prompt_naive(ArgsP a, const Ctx& c0) {
    const Ctx c = refresh(c0);
    const bf16* QN = WSB(WS_QN); const bf16* QPE = WSB(WS_QPE); const bf16* KNV = WSB(WS_KNV); const bf16* KPE = WSB(WS_KPE);
    for (int item = c.gw + (META_ONLY ? (RMAIN / 64) * NH : 0); item < (RPROMPT / 64) * NH; item += c.ngw) {
        const int rb = item >> 4, h = item & 15, r = rb * 64 + c.lane;
        int b, nk;
        if (r < RMAIN) { b = r >> 12; nk = NMETA + (r & 4095) + 1; } else { const int i = r - RMAIN; b = i >> 4; nk = (i & 15) + 1; }
        const int mbase = RMAIN + 16 * b, tbase = 4096 * b;
        float qn[64], qp[32], o[64];
#pragma unroll
        for (int j = 0; j < 8; ++j) { const u32x4 v = *(const u32x4*)(QN + (size_t)r * 1024 + h * 64 + 8 * j);
            qn[8 * j] = bflo(v.x); qn[8 * j + 1] = bfhi(v.x); qn[8 * j + 2] = bflo(v.y); qn[8 * j + 3] = bfhi(v.y); qn[8 * j + 4] = bflo(v.z); qn[8 * j + 5] = bfhi(v.z); qn[8 * j + 6] = bflo(v.w); qn[8 * j + 7] = bfhi(v.w); }
#pragma unroll
        for (int j = 0; j < 4; ++j) { const u32x4 v = *(const u32x4*)(QPE + (size_t)r * 512 + h * 32 + 8 * j);
            qp[8 * j] = bflo(v.x); qp[8 * j + 1] = bfhi(v.x); qp[8 * j + 2] = bflo(v.y); qp[8 * j + 3] = bfhi(v.y); qp[8 * j + 4] = bflo(v.z); qp[8 * j + 5] = bfhi(v.z); qp[8 * j + 6] = bflo(v.w); qp[8 * j + 7] = bfhi(v.w); }
#pragma unroll
        for (int j = 0; j < 64; ++j) o[j] = 0.f;
        float m = -INFINITY, l = 0.f;
        const int nkmax = wave_max_i(nk);
        for (int kk = 0; kk < nkmax; ++kk) {
            if (kk < nk) {
                const int kr = kk < NMETA ? mbase + kk : tbase + kk - NMETA;
                const bf16* kn = KNV + (size_t)kr * 2048 + h * 64; const bf16* kp = KPE + (size_t)kr * 32; const bf16* vv = kn + 1024;
                float s = 0.f;
#pragma unroll
                for (int j = 0; j < 8; ++j) { const u32x4 v = *(const u32x4*)(kn + 8 * j);
                    s += qn[8 * j] * bflo(v.x) + qn[8 * j + 1] * bfhi(v.x) + qn[8 * j + 2] * bflo(v.y) + qn[8 * j + 3] * bfhi(v.y) + qn[8 * j + 4] * bflo(v.z) + qn[8 * j + 5] * bfhi(v.z) + qn[8 * j + 6] * bflo(v.w) + qn[8 * j + 7] * bfhi(v.w); }
#pragma unroll
                for (int j = 0; j < 4; ++j) { const u32x4 v = *(const u32x4*)(kp + 8 * j);
                    s += qp[8 * j] * bflo(v.x) + qp[8 * j + 1] * bfhi(v.x) + qp[8 * j + 2] * bflo(v.y) + qp[8 * j + 3] * bfhi(v.y) + qp[8 * j + 4] * bflo(v.z) + qp[8 * j + 5] * bfhi(v.z) + qp[8 * j + 6] * bflo(v.w) + qp[8 * j + 7] * bfhi(v.w); }
                const float mn = fmaxf(m, s), corr = exp2f(m - mn), p = exp2f(s - mn);
                l = l * corr + p; m = mn;
#pragma unroll
                for (int j = 0; j < 8; ++j) { const u32x4 v = *(const u32x4*)(vv + 8 * j);
                    o[8 * j] = o[8 * j] * corr + p * bflo(v.x); o[8 * j + 1] = o[8 * j + 1] * corr + p * bfhi(v.x); o[8 * j + 2] = o[8 * j + 2] * corr + p * bflo(v.y); o[8 * j + 3] = o[8 * j + 3] * corr + p * bfhi(v.y);
                    o[8 * j + 4] = o[8 * j + 4] * corr + p * bflo(v.z); o[8 * j + 5] = o[8 * j + 5] * corr + p * bfhi(v.z); o[8 * j + 6] = o[8 * j + 6] * corr + p * bflo(v.w); o[8 * j + 7] = o[8 * j + 7] * corr + p * bfhi(v.w); }
            }
        }
        const float il = 1.0f / l;
#pragma unroll
        for (int j = 0; j < 8; ++j) { u32x4 w; w.x = pk2(o[8 * j] * il, o[8 * j + 1] * il); w.y = pk2(o[8 * j + 2] * il, o[8 * j + 3] * il); w.z = pk2(o[8 * j + 4] * il, o[8 * j + 5] * il); w.w = pk2(o[8 * j + 6] * il, o[8 * j + 7] * il);
            *(u32x4*)(WSB(WS_O) + (size_t)r * 1024 + h * 64 + 8 * j) = w; }
    }
}
__device__ __forceinline__ void p_attn_decode_naive(ArgsP a, const Ctx& c0) {
    const Ctx c = refresh(c0);
    const float* cckv = IN_F(2); const float* ckpe = IN_F(3); const int* pt = (const int*)a->in[5];
    for (int item = c.gw; item < DB * NH; item += c.ngw) {
        const int db = item >> 4, h = item & 15;
        f32x4 ql[4]; float qp[4], m[4], l[4]; f32x4 o[4];
#pragma unroll
        for (int t = 0; t < 4; ++t) { const u32x2 v = *(const u32x2*)(WSB(WS_QLAT) + ((size_t)(db * 4 + t) * 16 + h) * 256 + 4 * c.lane);
            ql[t] = (f32x4){bflo(v.x), bfhi(v.x), bflo(v.y), bfhi(v.y)};
            qp[t] = c.lane < 32 ? bf2f(WSB(WS_QPE)[(size_t)(RSAMP0 + db * 4 + t) * 512 + h * 32 + c.lane]) : 0.f;
            m[t] = -INFINITY; l[t] = 0.f; o[t] = (f32x4){0.f, 0.f, 0.f, 0.f}; }
        for (int p = 0; p < NPAGES; ++p) {
            const int page = pt[db * NPAGES + p];
            for (int k = 0; k < PAGE; ++k) {
                const size_t kr = (size_t)page * PAGE + k;
                const f32x4 cv = *(const f32x4*)(cckv + kr * 256 + 4 * c.lane); const float e = c.lane < 32 ? ckpe[kr * 32 + c.lane] : 0.f;
#pragma unroll
                for (int t = 0; t < 4; ++t) {
                    float d = (ql[t].x * cv.x + ql[t].y * cv.y) + (ql[t].z * cv.z + ql[t].w * cv.w) + qp[t] * e;
                    d = wave_sum(d);
                    const float mn = fmaxf(m[t], d), corr = exp2f(m[t] - mn), pp = exp2f(d - mn);
                    l[t] = l[t] * corr + pp; m[t] = mn; o[t] = o[t] * corr + pp * cv;
                }
            }
        }
#pragma unroll
        for (int s2 = 0; s2 < 4; ++s2) {
            const int kr = RSAMP0 + db * 4 + s2;
            const u32x2 v = *(const u32x2*)(WSB(WS_CKVN) + (size_t)kr * 256 + 4 * c.lane); const f32x4 cv = (f32x4){bflo(v.x), bfhi(v.x), bflo(v.y), bfhi(v.y)};
            const float e = c.lane < 32 ? bf2f(WSB(WS_KPE)[(size_t)kr * 32 + c.lane]) : 0.f;
#pragma unroll
            for (int t = 0; t < 4; ++t) if (t >= s2) {
                float d = (ql[t].x * cv.x + ql[t].y * cv.y) + (ql[t].z * cv.z + ql[t].w * cv.w) + qp[t] * e;
                d = wave_sum(d);
                const float mn = fmaxf(m[t], d), corr = exp2f(m[t] - mn), pp = exp2f(d - mn);
                l[t] = l[t] * corr + pp; m[t] = mn; o[t] = o[t] * corr + pp * cv;
            }
        }
#pragma unroll
        for (int t = 0; t < 4; ++t) *(f32x4*)(WSF(WS_OLAT) + ((size_t)(db * 4 + t) * 16 + h) * 256 + 4 * c.lane) = o[t] * (1.0f / l[t]);
    }
}
__device__ __forceinline__ void p_olat_up(ArgsP a, const Ctx& c0) {
    const Ctx c = refresh(c0);
    const float* wuv = IN_F(16);
    for (int it = c.gw; it < DB * DS * NH; it += c.ngw) {
        const int i = it >> 4, h = it & 15; const float* ol = WSF(WS_OLAT) + ((size_t)i * 16 + h) * 256;
        float acc = 0.f;
#pragma unroll 8
        for (int cc = 0; cc < 256; ++cc) acc += ol[cc] * wuv[(size_t)cc * 1024 + h * 64 + c.lane];
        WSB(WS_O)[(size_t)(RSAMP0 + i) * 1024 + h * 64 + c.lane] = (bf16)f2bf(acc);
    }
}
template <bool FINAL, int NSPLIT, bool FIRST = false>
__device__ __forceinline__ void p_post_res(ArgsP a, const Ctx& c0, const float* gpost, const float* gnext) {
    const Ctx c = refresh(c0);
    const bf16* Mb = WSB(WS_M); bf16* X = WSB(WS_X); bf16* H = WSB(WS_H); const float* MT = WSF(WS_MT); const float* xin = IN_F(0); float* out = a->out;
    f32x4 gp[4], gn[4];
#pragma unroll
    for (int j = 0; j < 4; ++j) { gp[j] = *(const f32x4*)(gpost + 4 * c.lane + 256 * j); gn[j] = FINAL ? gp[j] : *(const f32x4*)(gnext + 4 * c.lane + 256 * j); }
    constexpr int NR = 4;
    for (int r0 = c.gw; r0 < RMAIN; r0 += NR * c.ngw) {
        f32x4 mv[NR][4], xv[NR][4]; float s[NR], s2[NR];
#pragma unroll
        for (int q = 0; q < NR; ++q) { const int r = r0 + q * c.ngw < RMAIN ? r0 + q * c.ngw : r0;
            s[q] = 0.f;
#pragma unroll
            for (int j = 0; j < 4; ++j) { const u32x2 mb = __builtin_nontemporal_load((const u32x2*)(Mb + (size_t)r * D + 4 * c.lane + 256 * j)); mv[q][j] = (f32x4){bflo(mb.x), bfhi(mb.x), bflo(mb.y), bfhi(mb.y)};
                if (FIRST) xv[q][j] = *(const f32x4*)(xin + (size_t)r * D + 4 * c.lane + 256 * j); else { const u32x2 xb = *(const u32x2*)(X + (size_t)r * D + 4 * c.lane + 256 * j); xv[q][j] = (f32x4){bflo(xb.x), bfhi(xb.x), bflo(xb.y), bfhi(xb.y)}; }
                s[q] += (mv[q][j].x * mv[q][j].x + mv[q][j].y * mv[q][j].y) + (mv[q][j].z * mv[q][j].z + mv[q][j].w * mv[q][j].w); } }
#pragma unroll
        for (int o = 1; o < 64; o <<= 1) {
#pragma unroll
            for (int q = 0; q < NR; ++q) s[q] += __shfl_xor(s[q], o); }
#pragma unroll
        for (int q = 0; q < NR; ++q) { const float rm = 1.0f / sqrtf(s[q] * (1.f / D) + EPS); s2[q] = 0.f;
#pragma unroll
            for (int j = 0; j < 4; ++j) { xv[q][j] = xv[q][j] + mv[q][j] * rm * gp[j]; s2[q] += (xv[q][j].x * xv[q][j].x + xv[q][j].y * xv[q][j].y) + (xv[q][j].z * xv[q][j].z + xv[q][j].w * xv[q][j].w); } }
        if (!FINAL) {
#pragma unroll
            for (int o = 1; o < 64; o <<= 1) {
#pragma unroll
                for (int q = 0; q < NR; ++q) s2[q] += __shfl_xor(s2[q], o); }
        }
#pragma unroll
        for (int q = 0; q < NR; ++q) { const int r = r0 + q * c.ngw < RMAIN ? r0 + q * c.ngw : r0;
            if (FINAL) {
#pragma unroll
                for (int j = 0; j < 4; ++j) __builtin_nontemporal_store(xv[q][j], (f32x4*)(out + O_YP + (size_t)r * D + 4 * c.lane + 256 * j));
            } else { const float rx = 1.0f / sqrtf(s2[q] * (1.f / D) + EPS);
#pragma unroll
                for (int j = 0; j < 4; ++j) { u32x2 xo; xo.x = pk2(xv[q][j].x, xv[q][j].y); xo.y = pk2(xv[q][j].z, xv[q][j].w); *(u32x2*)(X + (size_t)r * D + 4 * c.lane + 256 * j) = xo;
                    u32x2 o; o.x = pk2(xv[q][j].x * rx * gn[j].x, xv[q][j].y * rx * gn[j].y); o.y = pk2(xv[q][j].z * rx * gn[j].z, xv[q][j].w * rx * gn[j].w); *(u32x2*)(H + (size_t)r * D + 4 * c.lane + 256 * j) = o; } } }
    }
    for (int r = RMAIN + c.gw; r < R; r += c.ngw) {
        bf16* xrow = X + (size_t)r * D;
        f32x4 mv[4], xv[4]; float s = 0.f;
#pragma unroll
        for (int j = 0; j < 4; ++j) { mv[j] = (f32x4){0.f, 0.f, 0.f, 0.f};
#pragma unroll
            for (int h8 = 0; h8 < NSPLIT; h8 += 8) { f32x4 part[8];
#pragma unroll
                for (int sp = 0; sp < 8; ++sp) part[sp] = *(const f32x4*)(MT + ((size_t)(h8 + sp) * (RP - RMAIN) + (r - RMAIN)) * D + 4 * c.lane + 256 * j);
#pragma unroll
                for (int sp = 0; sp < 8; ++sp) mv[j] += part[sp]; }
            { const u32x2 xb = *(const u32x2*)(xrow + 4 * c.lane + 256 * j); xv[j] = (f32x4){bflo(xb.x), bfhi(xb.x), bflo(xb.y), bfhi(xb.y)}; } s += (mv[j].x * mv[j].x + mv[j].y * mv[j].y) + (mv[j].z * mv[j].z + mv[j].w * mv[j].w); }
        const float rm = 1.0f / sqrtf(wave_sum(s) * (1.f / D) + EPS); float s2 = 0.f;
#pragma unroll
        for (int j = 0; j < 4; ++j) { xv[j] = xv[j] + mv[j] * rm * gp[j]; s2 += (xv[j].x * xv[j].x + xv[j].y * xv[j].y) + (xv[j].z * xv[j].z + xv[j].w * xv[j].w); }
        if (FINAL) {
            if (r < RSAMP0) continue;
#pragma unroll
            for (int j = 0; j < 4; ++j) *(f32x4*)(out + O_YS + (size_t)(r - RSAMP0) * D + 4 * c.lane + 256 * j) = xv[j];
        } else {
            const float rx = 1.0f / sqrtf(wave_sum(s2) * (1.f / D) + EPS);
#pragma unroll
            for (int j = 0; j < 4; ++j) { u32x2 xo; xo.x = pk2(xv[j].x, xv[j].y); xo.y = pk2(xv[j].z, xv[j].w); *(u32x2*)(xrow + 4 * c.lane + 256 * j) = xo;
                u32x2 o; o.x = pk2(xv[j].x * rx * gn[j].x, xv[j].y * rx * gn[j].y); o.y = pk2(xv[j].z * rx * gn[j].z, xv[j].w * rx * gn[j].w); *(u32x2*)(H + (size_t)r * D + 4 * c.lane + 256 * j) = o; }
        }
    }
}

__device__ __forceinline__ void p_gate(ArgsP a, const Ctx& c0) {
    const Ctx c = refresh(c0);
    const float* wg = IN_F(19); const float* bg = IN_F(20);
    const size_t gt = (size_t)c.gw * 64 + c.lane, ngt = (size_t)c.ngw * 64;
    for (size_t i = gt + (size_t)(USE_NAIVE_GLA ? 0 : RSAMP0) * 512; i < (size_t)R * 512; i += ngt) {
        const int r = (int)(i >> 9), col = (int)(i & 511); const float* gd = WSF(WS_GD) + (size_t)r * 16;
        float x = bg[col];
#pragma unroll
        for (int j = 0; j < 16; ++j) x += gd[j] * wg[j * 512 + col];
        const float ls = fminf(x, 0.f) - log1pf(__expf(-fabsf(x)));
        const float la = ls * (1.0f / 16.0f);
        WSF(WS_LA)[i] = la; WSF(WS_EA)[i] = __expf(la);
    }
}
__device__ __forceinline__ void gla_step(float (&S)[128], float& o, float a0, float a1, float k0, float k1, float q0, float q1, float v) {
    o = 0.f;
#pragma unroll
    for (int d = 0; d < 64; ++d) { const float ad = rdlane(a0, d), kd = rdlane(k0, d), qd = rdlane(q0, d); S[d] = ad * S[d] + kd * v; o += qd * S[d]; }
#pragma unroll
    for (int d = 0; d < 64; ++d) { const float ad = rdlane(a1, d), kd = rdlane(k1, d), qd = rdlane(q1, d); S[64 + d] = ad * S[64 + d] + kd * v; o += qd * S[64 + d]; }
}
__device__ __forceinline__ void p_gla_naive(ArgsP a, const Ctx& c0) {
    const Ctx c = refresh(c0);
    const float* EA = WSF(WS_EA); const bf16* KG = WSB(WS_KG); const bf16* QG = WSB(WS_QG); const bf16* VG = WSB(WS_VG); float* OGR = WSF(WS_OGRAW);
    for (int item = c.gwT; item < (USE_NAIVE_GLA ? NB * GH * 4 : 0); item += c.ngw) {
        const int b = item >> 4, h = (item >> 2) & 3, dv = (item & 3) * 64 + c.lane;
        float S[128];
#pragma unroll
        for (int d = 0; d < 128; ++d) S[d] = 0.f;
        for (int tt = 0; tt < TP; ++tt) {
            const int row = tt < NMETA ? RMAIN + 16 * b + tt : 4096 * b + tt - NMETA;
            const size_t g = (size_t)row * 512 + h * 128;
            const float a0 = EA[g + c.lane], a1 = EA[g + 64 + c.lane], k0 = bf2f(KG[g + c.lane]), k1 = bf2f(KG[g + 64 + c.lane]), q0 = bf2f(QG[g + c.lane]), q1 = bf2f(QG[g + 64 + c.lane]);
            const float v = bf2f(VG[(size_t)row * 1024 + h * 256 + dv]);
            float o; gla_step(S, o, a0, a1, k0, k1, q0, q1, v);
            OGR[(size_t)row * 1024 + h * 256 + dv] = o;
        }
        float* outp = a->out + O_GLAP + ((size_t)(b * 4 + h) * 128) * 256 + dv;
#pragma unroll
        for (int d = 0; d < 128; ++d) outp[(size_t)d * 256] = S[d];
    }
    const int wg0 = USE_NAIVE_GLA ? 0 : NB * GH * gla::NSP; if ((int)blockIdx.x < wg0) return;
    for (int item = c.wave * ((int)gridDim.x - wg0) + ((int)blockIdx.x - wg0); item < DB * GH * 4; item += c.ngw - wg0 * 8) {
        const int db = item >> 4, h = (item >> 2) & 3, dv = (item & 3) * 64 + c.lane;
        const float* sp = IN_F(4) + ((size_t)(db * 4 + h) * 128) * 256 + dv;
        float S[128];
#pragma unroll
        for (int d = 0; d < 128; ++d) S[d] = sp[(size_t)d * 256];
#pragma unroll 1
        for (int s = 0; s < DS; ++s) {
            const int row = RSAMP0 + db * 4 + s; const size_t g = (size_t)row * 512 + h * 128;
            const float a0 = EA[g + c.lane], a1 = EA[g + 64 + c.lane], k0 = bf2f(KG[g + c.lane]), k1 = bf2f(KG[g + 64 + c.lane]), q0 = bf2f(QG[g + c.lane]), q1 = bf2f(QG[g + 64 + c.lane]);
            const float v = bf2f(VG[(size_t)row * 1024 + h * 256 + dv]);
            float o; gla_step(S, o, a0, a1, k0, k1, q0, q1, v);
            OGR[(size_t)row * 1024 + h * 256 + dv] = o;
        }
        float* outp = a->out + O_GLAS + ((size_t)(db * 4 + h) * 128) * 256 + dv;
#pragma unroll
        for (int d = 0; d < 128; ++d) outp[(size_t)d * 256] = S[d];
    }
}
__device__ __forceinline__ void p_gla_post(ArgsP a, const Ctx& c0) {
    const Ctx c = refresh(c0);
    const bf16* OGR = WSB(WS_OGRAW); const bf16* RG = WSB(WS_RG); bf16* OG = WSB(WS_OG);
    const f32x4 g = *(const f32x4*)(IN_F(21) + 4 * c.lane);
    constexpr int NR = 2;
    for (int r0 = c.gw; r0 < R; r0 += NR * c.ngw) {
        f32x4 o[NR][4]; u32x2 rv[NR][4]; float s[NR][4];
#pragma unroll
        for (int q = 0; q < NR; ++q) { const int r = r0 + q * c.ngw < R ? r0 + q * c.ngw : r0;
#pragma unroll
            for (int h = 0; h < 4; ++h) { const size_t off = (size_t)r * 1024 + h * 256 + 4 * c.lane;
                const u32x2 ob = __builtin_nontemporal_load((const u32x2*)(OGR + ((size_t)(h * 8 + (c.lane >> 3)) * RP + r) * 32 + 4 * (c.lane & 7))); o[q][h] = (f32x4){bflo(ob.x), bfhi(ob.x), bflo(ob.y), bfhi(ob.y)}; rv[q][h] = __builtin_nontemporal_load((const u32x2*)(RG + off));
                s[q][h] = (o[q][h].x * o[q][h].x + o[q][h].y * o[q][h].y) + (o[q][h].z * o[q][h].z + o[q][h].w * o[q][h].w); } }
#pragma unroll
        for (int sh = 1; sh < 64; sh <<= 1) {
#pragma unroll
            for (int q = 0; q < NR; ++q)
#pragma unroll
                for (int h = 0; h < 4; ++h) s[q][h] += __shfl_xor(s[q][h], sh); }
#pragma unroll
        for (int q = 0; q < NR; ++q) { const int r = r0 + q * c.ngw < R ? r0 + q * c.ngw : r0;
#pragma unroll
            for (int h = 0; h < 4; ++h) { const size_t off = (size_t)r * 1024 + h * 256 + 4 * c.lane;
                const float rs = 1.0f / sqrtf(s[q][h] * (1.f / 256) + EPS);
                const f32x4 rr = (f32x4){bflo(rv[q][h].x), bfhi(rv[q][h].x), bflo(rv[q][h].y), bfhi(rv[q][h].y)};
                f32x4 sl; sl.x = rr.x / (1.f + __expf(-rr.x)); sl.y = rr.y / (1.f + __expf(-rr.y)); sl.z = rr.z / (1.f + __expf(-rr.z)); sl.w = rr.w / (1.f + __expf(-rr.w));
                const f32x4 y = o[q][h] * rs * g * sl;
                u32x2 w; w.x = pk2(y.x, y.y); w.y = pk2(y.z, y.w); *(u32x2*)(OG + off) = w; } }
    }
}


namespace gla {
using att::bf16x8; using att::f32x16; using att::crow; using att::cvtpk;
constexpr int NCH = 65, NITEM = NB * GH * NCH;
constexpr int P_GD = 0, P_GSUM = 4096, P_QL = 6144, P_KL = P_QL + 64 * 272, P_VS = P_KL + 64 * 272, P_AL = P_VS + 64 * 528, P_END = P_AL + 64 * 144;
__device__ __forceinline__ int chunk_row(int b, int c, int tok) { return c == 0 ? RMAIN + 16 * b + tok : 4096 * b + 64 * (c - 1) + tok; }
__device__ __forceinline__ float logsig16(float x) { return (fminf(x, 0.f) - __logf(1.0f + __expf(-fabsf(x)))) * (1.0f / 16.0f); }
struct PrepRegs { u32x4 q[2], k[2], v[4]; f32x4 gd; };
__device__ __forceinline__ void prep_load(ArgsP a, int item, int tid, PrepRegs& R) {
    const int bh = item / NCH, c = item % NCH, b = bh >> 2, h = bh & 3; const int nvalid = c == 0 ? NMETA : 64;
    const u32x4 z4 = (u32x4){0u, 0u, 0u, 0u};
#pragma unroll
    for (int j = 0; j < 2; ++j) { const int idx = tid + 512 * j, row = idx >> 4, ch = idx & 15; const bool ok = row < nvalid; const size_t g = (size_t)chunk_row(b, c, ok ? row : 0) * 512 + h * 128 + ch * 8;
        R.q[j] = ok ? __builtin_nontemporal_load((const u32x4*)(WSB(WS_QG) + g)) : z4; R.k[j] = ok ? __builtin_nontemporal_load((const u32x4*)(WSB(WS_KG) + g)) : z4; }
#pragma unroll
    for (int j = 0; j < 4; ++j) { const int idx = tid + 512 * j, row = idx >> 5, ch = idx & 31; const bool ok = row < nvalid;
        R.v[j] = ok ? __builtin_nontemporal_load((const u32x4*)(WSB(WS_VG) + (size_t)chunk_row(b, c, ok ? row : 0) * 1024 + h * 256 + ch * 8)) : z4; }
    { const int row = (tid & 255) >> 2, ch = tid & 3; const bool ok = row < nvalid; R.gd = ok ? *(const f32x4*)(WSF(WS_GD) + (size_t)chunk_row(b, c, ok ? row : 0) * 16 + ch * 4) : (f32x4){0.f, 0.f, 0.f, 0.f}; }
}
#define PREP_BAR() asm volatile("s_waitcnt lgkmcnt(0)\n\ts_barrier" ::: "memory")
__device__ __forceinline__ void prep_item(ArgsP a, int item, int next_item, PrepRegs& R, LAS unsigned char* lds, int wave_id) {
    const int tid = fresh_tid(wave_id), lane = tid & 63, r32 = lane & 31, hi = lane >> 5; const int wid = wave_id;
    const int bh = item / NCH, c = item % NCH, b = bh >> 2, h = bh & 3;
    const int nvalid = c == 0 ? NMETA : 64;
    bf16* QINF = WSB(WS_QINF) + (size_t)item * 8192; bf16* KDTF = WSB(WS_KDTF) + (size_t)item * 8192; bf16* AMF = WSB(WS_AMF) + (size_t)item * 4096; bf16* VTF = WSB(WS_VTF) + (size_t)item * 16384; float* ELF = WSF(WS_ELF) + (size_t)item * 256;
    LAS float* GDL = (LAS float*)(lds + P_GD); LAS float* GSUM = (LAS float*)(lds + P_GSUM); LAS bf16* QL = (LAS bf16*)(lds + P_QL); LAS bf16* KL = (LAS bf16*)(lds + P_KL); LAS bf16* VS = (LAS bf16*)(lds + P_VS); LAS bf16* AL = (LAS bf16*)(lds + P_AL);
#pragma unroll
    for (int j = 0; j < 2; ++j) { const int idx = tid + 512 * j, row = idx >> 4, ch = idx & 15; *(LAS u32x4*)(QL + row * 136 + ch * 8) = R.q[j]; *(LAS u32x4*)(KL + row * 136 + ch * 8) = R.k[j]; }
#pragma unroll
    for (int j = 0; j < 4; ++j) { const int idx = tid + 512 * j, row = idx >> 5, ch = idx & 31; *(LAS u32x4*)(VS + row * 264 + ch * 8) = R.v[j]; }
    if (tid < 256) { const int row = tid >> 2, ch = tid & 3; *(LAS f32x4*)(GDL + row * 16 + ch * 4) = R.gd; }
    if (next_item < NITEM) prep_load(a, next_item, tid, R);
    PREP_BAR();
    const int dk = tid & 127, tg = tid >> 7;
    float bloc[16];
    {
        float w[16]; const float* wg = IN_F(19) + h * 128 + dk;
#pragma unroll
        for (int j = 0; j < 16; ++j) w[j] = wg[j * 512];
        const float bg = IN_F(20)[h * 128 + dk];
        float run = 0.f;
#pragma unroll
        for (int i = 0; i < 16; ++i) {
            const int tok = tg * 16 + i; float x = bg;
#pragma unroll
            for (int j4 = 0; j4 < 4; ++j4) { const f32x4 gd = *(const LAS f32x4*)(GDL + tok * 16 + j4 * 4); x += gd.x * w[4 * j4] + gd.y * w[4 * j4 + 1] + gd.z * w[4 * j4 + 2] + gd.w * w[4 * j4 + 3]; }
            const float g = tok < nvalid ? logsig16(x) : 0.f;
            run += g; bloc[i] = run;
        }
        GSUM[tg * 128 + dk] = run;
    }
    PREP_BAR();
    float off = 0.f, blast = 0.f;
#pragma unroll
    for (int t = 0; t < 4; ++t) { const float s = GSUM[t * 128 + dk]; if (t < tg) off += s; blast += s; }
    {
        unsigned kdp[8];
#pragma unroll
        for (int i = 0; i < 16; i += 2) {
            float kd2[2];
#pragma unroll
            for (int e = 0; e < 2; ++e) {
                const int tok = tg * 16 + i + e; const float bb = bloc[i + e] + off; const float q = bf2f(QL[tok * 136 + dk]), k = bf2f(KL[tok * 136 + dk]);
                QL[tok * 136 + dk] = (bf16)f2bf(q * __expf(bb)); KL[tok * 136 + dk] = (bf16)f2bf(k * __expf(-bb)); kd2[e] = k * __expf(blast - bb);
            }
            kdp[i >> 1] = pk2(kd2[0], kd2[1]);
        }
        bf16* kp = KDTF + ((size_t)(((dk >> 5) * 4 + tg) * 64) + (dk & 31)) * 8;
        *(u32x4*)(kp) = (u32x4){kdp[0], kdp[1], kdp[2], kdp[3]}; *(u32x4*)(kp + 32 * 8) = (u32x4){kdp[4], kdp[5], kdp[6], kdp[7]};
        if (tg == 0) ELF[dk] = __expf(blast);
    }
    {
        const int dv = tid & 255, half = tid >> 8;
#pragma unroll
        for (int u = 0; u < 4; ++u) {
            unsigned pk[4];
#pragma unroll
            for (int e = 0; e < 4; ++e) { const int tok = half * 32 + u * 8 + e * 2; pk[e] = (unsigned)VS[tok * 264 + dv] | ((unsigned)VS[(tok + 1) * 264 + dv] << 16); }
            const int s = 2 * half + (u >> 1), uh = u & 1;
            *(u32x4*)(VTF + ((size_t)(((dv >> 5) * 4 + s) * 64) + uh * 32 + (dv & 31)) * 8) = (u32x4){pk[0], pk[1], pk[2], pk[3]};
        }
    }
    PREP_BAR();
#pragma unroll
    for (int uu = 0; uu < 2; ++uu) {
        const int U = tid + 512 * uu, lp = U & 63, s8 = (U >> 6) & 7, tt = U >> 9; const int tok = tt * 32 + (lp & 31), hh = lp >> 5;
        const u32x2 lo = *(const LAS u32x2*)(QL + tok * 136 + 16 * s8 + 4 * hh), hi2 = *(const LAS u32x2*)(QL + tok * 136 + 16 * s8 + 8 + 4 * hh);
        *(u32x4*)(QINF + (size_t)U * 8) = (u32x4){lo.x, lo.y, hi2.x, hi2.y};
    }
    if (wid < 3) {
        const int tt = wid == 0 ? 0 : 1, tp = wid == 2 ? 1 : 0;
        f32x16 acc = f32x16{};
#pragma unroll
        for (int s = 0; s < 8; ++s) {
            const bf16x8 af = *(const LAS bf16x8*)(QL + (tt * 32 + r32) * 136 + 16 * s + 8 * hi), bfr = *(const LAS bf16x8*)(KL + (tp * 32 + r32) * 136 + 16 * s + 8 * hi);
            acc = __builtin_amdgcn_mfma_f32_32x32x16_bf16(af, bfr, acc, 0, 0, 0);
        }
#pragma unroll
        for (int r = 0; r < 16; ++r) { const int tok = tt * 32 + crow(r, hi), tk = tp * 32 + r32; AL[tok * 72 + tk] = (bf16)f2bf(tk <= tok ? acc[r] : 0.f); }
    } else if (wid == 3) {
#pragma unroll
        for (int r = 0; r < 16; ++r) AL[crow(r, hi) * 72 + 32 + r32] = 0;
    }
    PREP_BAR();
    { const int U = tid, lp = U & 63, s = (U >> 6) & 3, tt = U >> 8; const int tok = tt * 32 + (lp & 31), hh = lp >> 5;
      *(u32x4*)(AMF + (size_t)U * 8) = *(const LAS u32x4*)(AL + tok * 72 + 16 * s + 8 * hh); }
    PREP_BAR();
}
constexpr int SM_A = 0, SM_K = 2048, SM_Q = 4096, SM_V = 6144, SM_O = 10240, SM_END = SM_O + 4 * 2 * 256 * 4;
__device__ __forceinline__ void sample_item(ArgsP a, int item, LAS unsigned char* lds, int wave_id) {
    const int tid = fresh_tid(wave_id);
    const int db = item >> 2, h = item & 3;
    LAS float* AS = (LAS float*)(lds + SM_A); LAS float* KS = (LAS float*)(lds + SM_K); LAS float* QS = (LAS float*)(lds + SM_Q); LAS float* VSm = (LAS float*)(lds + SM_V); LAS float* OS = (LAS float*)(lds + SM_O);
    { const int s = tid >> 7, dk = tid & 127, row = RSAMP0 + db * 4 + s; const float* gd = WSF(WS_GD) + (size_t)row * 16; const float* wg = IN_F(19) + h * 128 + dk;
      float x = IN_F(20)[h * 128 + dk];
#pragma unroll
      for (int j = 0; j < 16; ++j) x += gd[j] * wg[j * 512];
      AS[s * 128 + dk] = __expf(logsig16(x));
      const size_t g = (size_t)row * 512 + h * 128 + dk; KS[s * 128 + dk] = bf2f(WSB(WS_KG)[g]); QS[s * 128 + dk] = bf2f(WSB(WS_QG)[g]);
#pragma unroll
      for (int j = 0; j < 2; ++j) { const int e = tid + 512 * j, s2 = e >> 8, dv2 = e & 255; VSm[s2 * 256 + dv2] = bf2f(WSB(WS_VG)[(size_t)(RSAMP0 + db * 4 + s2) * 1024 + h * 256 + dv2]); } }
    const int dv = tid & 255, kh = tid >> 8;
    const unsigned voff = (unsigned)(kh * 64 * 256 + dv) * 4u;
    const unsigned char* sbase = (const unsigned char*)(IN_F(4) + (size_t)(db * 4 + h) * 128 * 256);
    __syncthreads();
    float S[64];
#pragma unroll
    for (int d4 = 0; d4 < 16; ++d4) { const GAS unsigned char* bp = (const GAS unsigned char*)sbase + d4 * 4096; asm volatile("" : "+s"(bp));
#pragma unroll
        for (int e = 0; e < 4; ++e) S[4 * d4 + e] = __builtin_nontemporal_load((const GAS float*)(bp + e * 1024 + voff)); }
#pragma unroll 1
    for (int s = 0; s < 4; ++s) {
        const float v = VSm[s * 256 + dv]; float o = 0.f;
#pragma unroll
        for (int d4 = 0; d4 < 16; ++d4) {
            if ((d4 & 3) == 0) __builtin_amdgcn_sched_barrier(0);
            const f32x4 av = *(const LAS f32x4*)(AS + s * 128 + kh * 64 + 4 * d4), kv = *(const LAS f32x4*)(KS + s * 128 + kh * 64 + 4 * d4), qv = *(const LAS f32x4*)(QS + s * 128 + kh * 64 + 4 * d4);
            S[4 * d4] = av.x * S[4 * d4] + kv.x * v; o += qv.x * S[4 * d4]; S[4 * d4 + 1] = av.y * S[4 * d4 + 1] + kv.y * v; o += qv.y * S[4 * d4 + 1];
            S[4 * d4 + 2] = av.z * S[4 * d4 + 2] + kv.z * v; o += qv.z * S[4 * d4 + 2]; S[4 * d4 + 3] = av.w * S[4 * d4 + 3] + kv.w * v; o += qv.w * S[4 * d4 + 3];
        }
        OS[(s * 2 + kh) * 256 + dv] = o;
    }
    unsigned char* obase = (unsigned char*)(a->out + O_GLAS + (size_t)(db * 4 + h) * 128 * 256);
#pragma unroll
    for (int d4 = 0; d4 < 16; ++d4) { GAS unsigned char* bp = (GAS unsigned char*)obase + d4 * 4096; asm volatile("" : "+s"(bp));
#pragma unroll
        for (int e = 0; e < 4; ++e) __builtin_nontemporal_store(S[4 * d4 + e], (GAS float*)(bp + e * 1024 + voff)); }
    __syncthreads();
#pragma unroll
    for (int j = 0; j < 2; ++j) { const int e = tid + 512 * j, s2 = e >> 8, dv2 = e & 255; WSB(WS_OGRAW)[((size_t)(h * 8 + (dv2 >> 5)) * RP + (RSAMP0 + db * 4 + s2)) * 32 + (dv2 & 31)] = (bf16)f2bf(OS[(s2 * 2) * 256 + dv2] + OS[(s2 * 2 + 1) * 256 + dv2]); }
    __syncthreads();
}
__device__ __forceinline__ void prep_phase(ArgsP a, LAS unsigned char* lds, int wave_id) {
    { PrepRegs R; if ((int)blockIdx.x < NITEM) prep_load(a, (int)blockIdx.x, fresh_tid(wave_id), R);
      for (int item = blockIdx.x; item < NITEM; item += gridDim.x) prep_item(a, item, item + (int)gridDim.x, R, lds, wave_id); }
}
constexpr int S_QIN = 0, S_KDT = 16384, S_AM = 32768, S_EL = 40960, S_VT = 41984, S_SLOT = S_VT + 4096;
constexpr int S_X = 3 * S_SLOT, S_END = S_X + 2 * 8192;
static_assert(S_END <= MISC_OFF, "scan ring + state exchange fit under the control words");
constexpr int NPIECE = 45, NHELP = 5, NDMA = (NPIECE + NHELP - 1) / NHELP;
__device__ __forceinline__ void scan_bh(ArgsP a, int bh, int part, LAS unsigned char* lds, int wave_id) {
    const int tid = fresh_tid(wave_id), lane = tid & 63, r32 = lane & 31, hi = lane >> 5; const int wid = wave_id;
    const int b = bh >> 2, h = bh & 3, ds = part;
    const unsigned char* const pq = (const unsigned char*)(WSB(WS_QINF) + (size_t)bh * NCH * 8192); const unsigned char* const pk = (const unsigned char*)(WSB(WS_KDTF) + (size_t)bh * NCH * 8192);
    const unsigned char* const pa = (const unsigned char*)(WSB(WS_AMF) + (size_t)bh * NCH * 4096); const unsigned char* const pe = (const unsigned char*)(WSF(WS_ELF) + (size_t)bh * NCH * 256);
    const unsigned char* const pv = (const unsigned char*)(WSB(WS_VTF) + (size_t)bh * NCH * 16384) + part * 4096;
    LAS unsigned char* const X = lds + S_X;
#define GLA_BAR() asm volatile("s_waitcnt lgkmcnt(0)\n\ts_barrier" ::: "memory")
#define GLA_QF(tt, k8) (*(const LAS bf16x8*)(sb + S_QIN + ((tt) * 8 + (k8)) * 1024 + lane * 16))
#define GLA_KF(T, s) (*(const LAS bf16x8*)(sb + S_KDT + ((T) * 4 + (s)) * 1024 + lane * 16))
#define GLA_AF(tt, s) (*(const LAS bf16x8*)(sb + S_AM + ((tt) * 4 + (s)) * 1024 + lane * 16))
    if (wid >= 3) {
#define GLA_DMA(c_, slot_) do { const size_t c64_ = (size_t)(c_); \
        _Pragma("unroll") for (int k_ = 0; k_ < NDMA; ++k_) { int i_ = (wid - 3) + NHELP * k_; i_ = i_ < NPIECE ? i_ : 40; const unsigned char* g_; int lo_; \
            if (i_ < 16) { g_ = pq + c64_ * 16384 + i_ * 1024; lo_ = S_QIN + i_ * 1024; } \
            else if (i_ < 32) { g_ = pk + c64_ * 16384 + (i_ - 16) * 1024; lo_ = S_KDT + (i_ - 16) * 1024; } \
            else if (i_ < 40) { g_ = pa + c64_ * 8192 + (i_ - 32) * 1024; lo_ = S_AM + (i_ - 32) * 1024; } \
            else if (i_ == 40) { g_ = pe + c64_ * 1024; lo_ = S_EL; } \
            else { g_ = pv + c64_ * 32768 + (i_ - 41) * 1024; lo_ = S_VT + (i_ - 41) * 1024; } \
            __builtin_amdgcn_global_load_lds((const unsigned*)(g_ + lane * 16), (LAS unsigned*)(lds + (slot_) * S_SLOT + lo_), 16, 0, 0); } } while (0)
        GLA_DMA(0, 0); GLA_DMA(1, 1);
        for (int c = 0; c < NCH; ++c) {
            if (c + 1 < NCH) asm volatile("s_waitcnt vmcnt(%0)" :: "n"(NDMA) : "memory"); else asm volatile("s_waitcnt vmcnt(0)" ::: "memory");
            GLA_BAR();
            if (c + 2 < NCH) GLA_DMA(c + 2, (c + 2) % 3);
        }
#undef GLA_DMA
    } else if (wid == 2) {
        f32x16 S[4]; S[0] = f32x16{}; S[1] = f32x16{}; S[2] = f32x16{}; S[3] = f32x16{};
#pragma unroll
        for (int k = 0; k < 8; ++k) *(LAS u32x4*)(X + k * 1024 + lane * 16) = (u32x4){0u, 0u, 0u, 0u};
        for (int c = 0; c < NCH; ++c) {
            GLA_BAR();
            const LAS unsigned char* sb = lds + (c % 3) * S_SLOT;
            bf16x8 vf[4];
#pragma unroll
            for (int s = 0; s < 4; ++s) vf[s] = *(const LAS bf16x8*)(sb + S_VT + s * 1024 + lane * 16);
            bf16x8 KA[4], KB[4];
#define GLA_LK(F, s) do { F[0] = GLA_KF(0, s); F[1] = GLA_KF(1, s); F[2] = GLA_KF(2, s); F[3] = GLA_KF(3, s); } while (0)
#define GLA_MK(F, s) do { _Pragma("unroll") for (int T = 0; T < 4; ++T) S[T] = __builtin_amdgcn_mfma_f32_32x32x16_bf16(F[T], vf[s], S[T], 0, 0, 0); } while (0)
            GLA_LK(KA, 0); GLA_LK(KB, 1);
#pragma unroll
            for (int T = 0; T < 4; ++T)
#pragma unroll
                for (int g = 0; g < 4; ++g) { const f32x4 e = *(const LAS f32x4*)(sb + S_EL + (32 * T + 8 * g + 4 * hi) * 4); S[T][4 * g] *= e.x; S[T][4 * g + 1] *= e.y; S[T][4 * g + 2] *= e.z; S[T][4 * g + 3] *= e.w; }
            __builtin_amdgcn_sched_barrier(0);
            GLA_MK(KA, 0); __builtin_amdgcn_sched_barrier(0); GLA_LK(KA, 2); __builtin_amdgcn_sched_barrier(0);
            GLA_MK(KB, 1); __builtin_amdgcn_sched_barrier(0); GLA_LK(KB, 3); __builtin_amdgcn_sched_barrier(0);
            GLA_MK(KA, 2); __builtin_amdgcn_sched_barrier(0); GLA_MK(KB, 3);
#undef GLA_LK
#undef GLA_MK
            if (c + 1 < NCH) {
                LAS unsigned char* xo = X + ((c + 1) & 1) * 8192 + lane * 16;
#pragma unroll
                for (int T = 0; T < 4; ++T)
#pragma unroll
                    for (int s = 0; s < 2; ++s) { u32x4 w;
#pragma unroll
                        for (int i = 0; i < 4; ++i) w[i] = cvtpk(S[T][8 * s + 2 * i], S[T][8 * s + 2 * i + 1]);
                        *(LAS u32x4*)(xo + (T * 2 + s) * 1024) = w; }
            }
        }
        float* outp = a->out + O_GLAP + (size_t)bh * 128 * 256 + ds * 32 + r32;
#pragma unroll
        for (int T = 0; T < 4; ++T)
#pragma unroll
            for (int r = 0; r < 16; ++r) outp[(size_t)(32 * T + crow(r, hi)) * 256] = S[T][r];
    } else {
        const int tt = wid;
        bf16* const ogbase = WSB(WS_OGRAW) + (size_t)(h * 8 + ds) * RP * 32 + r32;
        for (int c = 0; c < NCH; ++c) {
            GLA_BAR();
            const LAS unsigned char* sb = lds + (c % 3) * S_SLOT; const LAS unsigned char* xi = X + (c & 1) * 8192 + lane * 16;
            const LAS unsigned char* qp = sb + S_QIN + tt * 8192 + lane * 16; const LAS unsigned char* ap = sb + S_AM + tt * 4096 + lane * 16;
            bf16x8 vf[4], Sb[8], Q[8], A[4];
#pragma unroll
            for (int k = 0; k < 8; ++k) { Sb[k] = *(const LAS bf16x8*)(xi + k * 1024); Q[k] = *(const LAS bf16x8*)(qp + k * 1024); }
#pragma unroll
            for (int s = 0; s < 4; ++s) { vf[s] = *(const LAS bf16x8*)(sb + S_VT + s * 1024 + lane * 16); A[s] = *(const LAS bf16x8*)(ap + s * 1024); }
            f32x16 oa = f32x16{}, ob = f32x16{};
#pragma unroll
            for (int k = 0; k < 8; k += 2) { oa = __builtin_amdgcn_mfma_f32_32x32x16_bf16(Q[k], Sb[k], oa, 0, 0, 0); ob = __builtin_amdgcn_mfma_f32_32x32x16_bf16(Q[k + 1], Sb[k + 1], ob, 0, 0, 0); }
            oa = __builtin_amdgcn_mfma_f32_32x32x16_bf16(A[0], vf[0], oa, 0, 0, 0); ob = __builtin_amdgcn_mfma_f32_32x32x16_bf16(A[1], vf[1], ob, 0, 0, 0);
            if (tt == 1) { oa = __builtin_amdgcn_mfma_f32_32x32x16_bf16(A[2], vf[2], oa, 0, 0, 0); ob = __builtin_amdgcn_mfma_f32_32x32x16_bf16(A[3], vf[3], ob, 0, 0, 0); }
            const f32x16 o = oa + ob;
            bf16* og = ogbase;
#pragma unroll
            for (int r = 0; r < 16; ++r) { const int tok = tt * 32 + crow(r, hi); if (c > 0 || tok < NMETA) og[(size_t)chunk_row(b, c, tok) * 32] = (bf16)cvtpk(o[r], o[r]); }
        }
    }
    asm volatile("s_waitcnt vmcnt(0) lgkmcnt(0)\n\ts_barrier" ::: "memory");
#undef GLA_BAR
#undef GLA_QF
#undef GLA_KF
#undef GLA_AF
}
}

__device__ __forceinline__ bool relaunder(ArgsP& a) { asm volatile("" : "+s"(a)); return true; }
constexpr int NPHASE = 22;
__global__ void __launch_bounds__(512, 2) fwd(Args a_unused) {
    ArgsP a = (ArgsP)__builtin_amdgcn_kernarg_segment_ptr();
    extern __shared__ __attribute__((aligned(16))) unsigned char lds_raw[];
    LAS unsigned char* lds = (LAS unsigned char*)lds_raw;
    Ctx c; c.wave = __builtin_amdgcn_readfirstlane((int)threadIdx.x >> 6); c.tid = 0; c.lane = 0;
    c.gw = blockIdx.x * 8 + c.wave; c.ngw = gridDim.x * 8; c.gwT = c.wave * gridDim.x + blockIdx.x;
    volatile LAS unsigned* MISC = (volatile LAS unsigned*)(lds + MISC_OFF);
    if (threadIdx.x < 32) MISC[threadIdx.x] = 0u;
    __syncthreads();
    XcdBarrier bar; bar.bar = (unsigned*)(a->ws + WS_CTL) + CW_BAR; bar.x = 0; bar.st = nullptr;
    const bool one = (a->ph_hi - a->ph_lo) > 1;
    if (one) bar = xcd_barrier_post((unsigned*)(a->ws + WS_CTL) + CW_BAR, MISC + 8);
    const int lo = a->ph_lo, hi = a->ph_hi;
    unsigned long long tp0 = 0, tp1 = 0;
#define IN(k) (((PROBE_LO == (k)) ? (void)(tp0 = __builtin_amdgcn_s_memrealtime()) : (void)0), (lo <= (k) && (k) < hi && relaunder(a)))
#define INQ(k) (lo <= (k) && (k) < hi)
#define SEAM(k) do { if (INQ(k) && INQ((k) + 1)) xcd_barrier(bar, c.wave); if (PROBE_HI == (k)) tp1 = __builtin_amdgcn_s_memrealtime(); } while (0)
    if (IN(0)) { p_prep(a, c, lds); } SEAM(0);
    if (IN(1)) { if ((int)blockIdx.x < (RP / 256) * (NIN0 / 256)) gemm_p1(a, lds, c.wave); else p_side_tables(a, c, lds, (RP / 256) * (NIN0 / 256)); } SEAM(1);
    if (IN(2)) { if (USE_NAIVE_GEMM) p_mla_mid(a, c); }
    if (IN(3)) { gemm_p3(a, lds, c.wave); } SEAM(3);
    if (IN(4)) { if (USE_NAIVE_GEMM) { p_q_post(a, c); p_qlat(a, c); } }
    if (IN(5)) {
#if USE_NAIVE_ATTN
        p_attn_prompt_naive<false>(a, c);
#else
        if (((int)blockIdx.x >> 3) & 1) {
            dec::decode_phase(a, lds, c.wave);
            att::attn_phase(WSB(WS_QN), WSB(WS_QPE), WSB(WS_KNV), WSB(WS_KPE), WSB(WS_O), lds, c.wave);
        } else {
            att::attn_phase(WSB(WS_QN), WSB(WS_QPE), WSB(WS_KNV), WSB(WS_KPE), WSB(WS_O), lds, c.wave);
            dec::decode_phase(a, lds, c.wave);
        }
#endif
    } SEAM(5);
    if (IN(6)) {
#if USE_NAIVE_DECODE
        p_olat_up(a, c);
#else
        dec::combine_phase(a, c, lds);
#endif
    } SEAM(6);
    if (IN(7)) { gemm_n1024_tail<D, 8>(WSB(WS_O), WSB(WS_WO0), WSB(WS_M), WSF(WS_MT), lds, c.wave); } SEAM(7);
    if (IN(8)) { p_post_res<false, 8, true>(a, c, IN_F(8), IN_F(9)); } SEAM(8);
    if (IN(9)) { gemm_mfma8(WSB(WS_H), WSB(WS_WUP), RP, FF, D, (EpiRelu2{WSB(WS_U), FF}), lds, c.wave); p_late_weights(a, c, lds, (RP / 256) * (FF / 256) - 4 * (int)gridDim.x);     } SEAM(9);
    if (IN(10)) { gemm_n1024_tail<FF, 16>(WSB(WS_U), WSB(WS_WDN), WSB(WS_M), WSF(WS_MT), lds, c.wave); } SEAM(10);
    if (IN(11)) { p_post_res<false, 16>(a, c, IN_F(10), IN_F(7) + D); } SEAM(11);
    if (IN(12)) { gemm_mfma8(WSB(WS_H), WSB(WS_WGIN), RP, NGIN, D, (EpiGla{WSB(WS_QG), WSB(WS_KG), WSB(WS_VG), WSB(WS_RG), WSF(WS_GD)}), lds, c.wave); } SEAM(12);
    if (IN(13)) {
#if USE_NAIVE_GLA
        p_gate(a, c);
#else
        gla::prep_phase(a, lds, c.wave);
#endif
    } SEAM(13);
    if (IN(14)) {
#if !USE_NAIVE_GLA
        if ((int)blockIdx.x < NB * GH * gla::NSP) { const int w = (int)blockIdx.x, xcd = w & 7, j = w >> 3;
            gla::scan_bh(a, xcd * (NB * GH / 8) + j / gla::NSP, j % gla::NSP, lds, c.wave); }
        else for (int item = (int)blockIdx.x - NB * GH * gla::NSP; item < DB * GH; item += (int)gridDim.x - NB * GH * gla::NSP) gla::sample_item(a, item, lds, c.wave);
#else
        p_gla_naive(a, c);
#endif
    } SEAM(14);
    if (IN(15)) { p_gla_post(a, c); } SEAM(15);
    if (IN(16)) { gemm_n1024_tail<D, 8>(WSB(WS_OG), WSB(WS_WGO), WSB(WS_M), WSF(WS_MT), lds, c.wave); } SEAM(16);
    if (IN(17)) { p_post_res<false, 8>(a, c, IN_F(8) + D, IN_F(9) + D); } SEAM(17);
    if (IN(18)) { gemm_mfma8(WSB(WS_H), WSB(WS_WUP) + (size_t)FF * D, RP, FF, D, (EpiRelu2{WSB(WS_U), FF}), lds, c.wave); } SEAM(18);
    if (IN(19)) { gemm_n1024_tail<FF, 16>(WSB(WS_U), WSB(WS_WDN) + (size_t)D * FF, WSB(WS_M), WSF(WS_MT), lds, c.wave); } SEAM(19);
    if (IN(20)) { p_post_res<true, 16>(a, c, IN_F(10) + D, nullptr); }
    if (PROBE_LO >= 0 && blockIdx.x == 0) { const unsigned long long span = (tp1 - tp0) * 9ull, t0 = __builtin_amdgcn_s_memrealtime(); while (__builtin_amdgcn_s_memrealtime() - t0 < span) __builtin_amdgcn_s_sleep(8); }
#undef IN
#undef SEAM
}

extern "C" void kernel_launch(void* const* d_in, const int* in_sizes, int n_in, void* d_out, int out_size, void* d_ws, size_t ws_size, hipStream_t stream) {
    static int grid = 0;
    if (grid == 0) {
        if (n_in != 25 || out_size != (int)O_END || ws_size < WS_END) { fprintf(stderr, "kernel_launch: unexpected shapes n_in %d out %d ws %zu\n", n_in, out_size, ws_size); grid = -1; return; }
        int dev = 0, cus = 0, per_cu = 0;
        if (hipGetDevice(&dev) != hipSuccess || hipDeviceGetAttribute(&cus, hipDeviceAttributeMultiprocessorCount, dev) != hipSuccess) { grid = -1; return; }
        if (hipFuncSetAttribute((const void*)fwd, hipFuncAttributeMaxDynamicSharedMemorySize, LDS_BYTES) != hipSuccess) { fprintf(stderr, "kernel_launch: hipFuncSetAttribute failed\n"); grid = -1; return; }
        if (hipOccupancyMaxActiveBlocksPerMultiprocessor(&per_cu, (const void*)fwd, 512, LDS_BYTES) != hipSuccess || per_cu < 1) fprintf(stderr, "kernel_launch: occupancy query says %d\n", per_cu);
        (void)hipGetLastError();
        grid = cus;
    }
    if (grid < 0) return;
    if (hipMemsetAsync((char*)d_ws + WS_CTL, 0, CTL_ZERO_BYTES, stream) != hipSuccess) return;
    Args a{};
    for (int i = 0; i < 25; ++i) a.in[i] = d_in[i];
    a.out = (float*)d_out; a.ws = (unsigned char*)d_ws;
#if MK_ONE_LAUNCH
    a.ph_lo = 0; a.ph_hi = NPHASE;
    hipLaunchKernelGGL(fwd, dim3(grid), dim3(512), LDS_BYTES, stream, a);
#else
    for (int ph = 0; ph < NPHASE - 1; ++ph) { a.ph_lo = ph; a.ph_hi = ph + 1; hipLaunchKernelGGL(fwd, dim3(grid), dim3(512), LDS_BYTES, stream, a); }
#endif
}
```

```cpp
#include <hip/hip_runtime.h>
#include <cstdio>
#include <cstdint>
#include <cmath>

#ifndef MK_ONE_LAUNCH
#define MK_ONE_LAUNCH 1
#endif

constexpr int D = 1024, NB = 4, SEQ = 4096, NMETA = 16, TP = SEQ + NMETA;
constexpr int DB = 128, DS = 4, PAST = 8192, PAGE = 128, NPAGES = 64;
constexpr int NH = 16, QL = 256, KVL = 256, NOPE = 64, ROPE = 32, VH = 64;
constexpr int GH = 4, GDK = 128, GDV = 256, GR = 16;
constexpr int FF = 4096;
constexpr int RMAIN = NB * SEQ;
constexpr int RMETA0 = RMAIN;
constexpr int RSAMP0 = RMAIN + NB * NMETA;
constexpr int R = RSAMP0 + DB * DS;
constexpr int RPROMPT = RSAMP0;
constexpr int RP = 17152;
constexpr int NIN0 = 768, NUQ = 1536, NUKV = 2048, NGIN = 3328, NGIN_REAL = 3088;
constexpr float EPS = 1e-6f;
constexpr float MLA_SCALE = 0.10206207261596575f;
constexpr float GLA_SCALE = 0.08838834764831845f;
constexpr float QSCALE = 0.10206207261596575f * 1.4426950408889634f;

constexpr size_t O_YP = 0, O_YS = 16777216, O_CKVP = 17301504, O_KPEP = 21512192, O_CKVS = 22038528, O_KPES = 22169600, O_GLAP = 22185984, O_GLAS = 22710272, O_END = 39487488;

constexpr size_t MiB = 1u << 20;
constexpr size_t WS_CTL = 0, CTL_ZERO_BYTES = 1 * MiB;
constexpr size_t WS_WIN0 = 2 * MiB, WS_WUQ = 4 * MiB, WS_WUKV = 5 * MiB, WS_WO0 = 6 * MiB, WS_WUP = 8 * MiB, WS_WDN = 24 * MiB, WS_WGIN = 40 * MiB, WS_WGO = 47 * MiB;
constexpr size_t WS_X = 64 * MiB, WS_H = 132 * MiB, WS_M = 166 * MiB, WS_U = 234 * MiB, WS_A1 = 368 * MiB, WS_CQN = 419 * MiB, WS_CKVN = 428 * MiB, WS_KPE = 437 * MiB;
constexpr size_t WS_QRAW = 440 * MiB, WS_KNV = 541 * MiB, WS_QN = 608 * MiB, WS_QPE = 642 * MiB, WS_QLAT = 659 * MiB, WS_OLAT = 663 * MiB, WS_O = 671 * MiB;
constexpr size_t WS_QG = 705 * MiB, WS_KG = 722 * MiB, WS_VG = 739 * MiB, WS_RG = 773 * MiB, WS_GD = 807 * MiB, WS_LA = 809 * MiB, WS_EA = 843 * MiB, WS_OGRAW = 877 * MiB, WS_OG = 944 * MiB;
constexpr size_t WS_OPART = 978 * MiB, WS_MLP = 1012 * MiB;
constexpr size_t WS_QINF = 1014 * MiB, WS_KDTF = 1032 * MiB, WS_AMF = 1050 * MiB, WS_VTF = 1060 * MiB, WS_ELF = 1094 * MiB;
constexpr size_t WS_WUQL = 50 * MiB;
constexpr size_t WS_RSTD = 56 * MiB;
constexpr size_t WS_ROPE = 53 * MiB;
constexpr size_t WS_MT = 1096 * MiB;
constexpr size_t WS_END = 1144 * MiB;
constexpr int CW_BAR = 4096, CW_DEC = 8192;
namespace gla { constexpr int NSP = 8; static_assert(NSP == 8, "the scan's XCD mapping assumes 8 workgroups per (b, h)"); }

constexpr int LDS_BYTES = 163840;
constexpr int MISC_OFF = LDS_BYTES - 256;

#define GAS __attribute__((address_space(1)))
#define LAS __attribute__((address_space(3)))
typedef unsigned short bf16;
typedef float f32x4 __attribute__((ext_vector_type(4)));
typedef unsigned u32x4 __attribute__((ext_vector_type(4)));
typedef unsigned u32x2 __attribute__((ext_vector_type(2)));
#define LDS_WAIT() asm volatile("s_waitcnt lgkmcnt(0)" ::: "memory")

__device__ __forceinline__ unsigned f2bf(float f) { unsigned u = __builtin_bit_cast(unsigned, f); return (u + 0x7fffu + ((u >> 16) & 1u)) >> 16; }
__device__ __forceinline__ unsigned pk2(float lo, float hi) { return f2bf(lo) | (f2bf(hi) << 16); }
__device__ __forceinline__ float bflo(unsigned u) { return __builtin_bit_cast(float, u << 16); }
__device__ __forceinline__ float bfhi(unsigned u) { return __builtin_bit_cast(float, u & 0xffff0000u); }
__device__ __forceinline__ float bf2f(bf16 v) { return __builtin_bit_cast(float, (unsigned)v << 16); }
__device__ __forceinline__ float wave_sum(float v) {
#pragma unroll
    for (int o = 1; o < 64; o <<= 1) v += __shfl_xor(v, o);
    return v;
}
__device__ __forceinline__ int wave_max_i(int v) {
#pragma unroll
    for (int o = 1; o < 64; o <<= 1) { int t = __shfl_xor(v, o); v = t > v ? t : v; }
    return v;
}
__device__ __forceinline__ int fresh_tid(int wave) { int t = wave * 64 + (int)__builtin_amdgcn_mbcnt_hi(~0u, __builtin_amdgcn_mbcnt_lo(~0u, 0u)); asm volatile("" : "+v"(t)); return t; }
__device__ __forceinline__ float rdlane(float v, int l) { return __builtin_bit_cast(float, __builtin_amdgcn_readlane(__builtin_bit_cast(int, v), l)); }

#define XB_TMO      128
#define XB_XCNT(j)  (256  + 64 * (j))
#define XB_XSUB(j)  (1280 + 64 * (j))
#define XB_XGEN(j)  (2304 + 64 * (j))
#define XB_TOP      3328
#define XB_TOPGEN   3392
#define XCD_BAR_WORDS 3456
#define XB_SPIN_CAP (1u << 18)
__device__ __forceinline__ unsigned xb_ld(unsigned* p)              { return __hip_atomic_load(p, __ATOMIC_RELAXED, __HIP_MEMORY_SCOPE_AGENT); }
__device__ __forceinline__ unsigned xb_add(unsigned* p, unsigned v) { return __hip_atomic_fetch_add(p, v, __ATOMIC_RELAXED, __HIP_MEMORY_SCOPE_AGENT); }
__device__ __forceinline__ unsigned xb_xcc_id() { return (unsigned)__builtin_amdgcn_s_getreg((3 << 11) | 20) & 0xFu; }
#define XB_SPIN(cond, bar) do { unsigned _sp = 0; while (cond) { __builtin_amdgcn_s_sleep(1); \
    if ((++_sp & 255u) == 0u) { if (xb_ld(&(bar)[XB_TMO])) break; if (_sp > XB_SPIN_CAP) { atomicAdd(&(bar)[XB_TMO], 1u); break; } } } } while (0)
struct XcdBarrier { unsigned* bar; unsigned x; volatile LAS unsigned* st; };
__device__ __forceinline__ XcdBarrier xcd_barrier_post(unsigned* bar, volatile LAS unsigned* st) {
    XcdBarrier b; b.bar = bar; b.x = xb_xcc_id(); b.st = st;
    if (threadIdx.x == 0) (void)xb_add(&bar[XB_XCNT(b.x)], 1u);
    return b;
}
__device__ __forceinline__ void xcd_barrier_complete(unsigned* bar, unsigned x, unsigned& nloc, unsigned& nx) {
    const unsigned G = gridDim.x * gridDim.y * gridDim.z;
    unsigned sum, cnt, mine, sp = 0u;
    for (;;) {
        sum = 0u; cnt = 0u; mine = 0u;
#pragma unroll
        for (unsigned j = 0; j < 16; ++j) { const unsigned c = xb_ld(&bar[XB_XCNT(j)]); sum += c; cnt += (c > 0u) ? 1u : 0u; mine = (j == x) ? c : mine; }
        if (sum == G) break;
        __builtin_amdgcn_s_sleep(1);
        if ((++sp & 255u) == 0u) { if (xb_ld(&bar[XB_TMO])) break; if (sp > XB_SPIN_CAP) { atomicAdd(&bar[XB_TMO], 1u); break; } }
    }
    nloc = mine > 0u ? mine : 1u; nx = cnt > 0u ? cnt : 1u;
}
__device__ __forceinline__ void xcd_barrier(const XcdBarrier& b, int wave_id) {
    asm volatile("s_waitcnt vmcnt(0)" ::: "memory");
    __syncthreads();
    if (fresh_tid(wave_id) == 0) {
        unsigned* bar = b.bar;
        __builtin_amdgcn_s_waitcnt(0);
        unsigned nloc = b.st[0], nx = b.st[1];
        if (nloc == 0u) { xcd_barrier_complete(bar, b.x, nloc, nx); b.st[0] = nloc; b.st[1] = nx; }
        const unsigned old = xb_add(&bar[XB_XSUB(b.x)], 1u);
        const unsigned gen = old / nloc;
        if (old + 1u == (gen + 1u) * nloc) {
            __builtin_amdgcn_fence(__ATOMIC_RELEASE, "agent");
            asm volatile("s_waitcnt vmcnt(0)" ::: "memory");
            const unsigned og = xb_add(&bar[XB_TOP], 1u);
            const unsigned tg = og / nx;
            if (og + 1u == (tg + 1u) * nx) xb_add(&bar[XB_TOPGEN], 1u);
            else XB_SPIN(xb_ld(&bar[XB_TOPGEN]) == tg, bar);
            __builtin_amdgcn_fence(__ATOMIC_ACQUIRE, "agent");
            xb_add(&bar[XB_XGEN(b.x)], 1u);
            asm volatile("s_waitcnt vmcnt(0)" ::: "memory");
        } else {
            XB_SPIN(xb_ld(&bar[XB_XGEN(b.x)]) == gen, bar);
            __builtin_amdgcn_fence(__ATOMIC_ACQUIRE, "agent");
            asm volatile("s_waitcnt vmcnt(0)" ::: "memory");
        }
    }
    __syncthreads();
}

namespace pg8 {
#define PG8_LAS __attribute__((address_space(3)))
typedef unsigned short bf16_t;
typedef short bf16x8 __attribute__((ext_vector_type(8)));
typedef float f32x4 __attribute__((ext_vector_type(4)));
typedef unsigned u32x4 __attribute__((ext_vector_type(4)));
constexpr int BM = 256, BK = 64, HALF = 128, HTB = HALF * BK * 2  , STAGE_BYTES = 8 * HTB, NXCD = 8, WGM = 8;

__host__ __device__ __forceinline__ int lds_byte(int r, int c) { const int st = (r >> 4) * 2 + (c >> 5), rr = r & 15, cc = c & 31, ob = rr * 64 + cc * 2; return st * 1024 + (ob ^ (((ob >> 9) & 1) << 5)); }
__host__ __device__ __forceinline__ void stage_rc(int b, int& R, int& C) { const int st = b / 1024, sb = b % 1024, swz = sb ^ (((sb >> 9) & 1) << 5); R = (st >> 1) * 16 + swz / 64; C = (st & 1) * 32 + (swz % 64) / 2; }
__host__ __device__ __forceinline__ int perm32(int rho) { const int n = rho >> 4, i = rho & 15; return 8 * (i >> 2) + 4 * n + (i & 3); }

struct Unit { int pm, pn, k0, prob; long aoff, boff; };
struct Gemm { const bf16_t* A; const bf16_t* Bt; int M, N, K, ld; };

struct StaticOrder {
    int nM, nN, nwg, G, c;
    __host__ __device__ void init(int M, int N, int G_, int c_) { nM = M / BM; nN = N / BM; nwg = nM * nN; G = G_; c = c_; }
    __host__ __device__ bool next(int i, Unit& u) const {
        const long L = (long)i * G + c; if (L >= nwg) return false;
        int wgid = (int)L; { const int q = nwg / NXCD, r = nwg % NXCD, xcd = wgid % NXCD, off = wgid / NXCD; wgid = (xcd < r ? xcd * (q + 1) : r * (q + 1) + (xcd - r) * q) + off; }
        const int nig = WGM * nN, gid = wgid / nig, fm = gid * WGM, gsz = (nM - fm) < WGM ? (nM - fm) : WGM;
        u.pm = fm + ((wgid % nig) % gsz); u.pn = (wgid % nig) / gsz; u.k0 = 0; u.prob = 0; u.aoff = 0; u.boff = 0; return true;
    }
    __device__ __forceinline__ void a_ready(const Unit&) const {}
    __device__ __forceinline__ void done(const Unit&) const {}
};

__device__ __forceinline__ unsigned cvt_pk_bf16(float lo, float hi) { unsigned r; asm volatile("v_cvt_pk_bf16_f32 %0, %1, %2" : "=v"(r) : "v"(lo), "v"(hi)); return r; }
template <class Epi, class Sched, bool ALIGN_EPI = false, bool SP2 = false>
__device__ __forceinline__ void gemm_phase(PG8_LAS unsigned char* lds, const Gemm g, const Sched& S, const Epi& E, int wave_id) {
    const int tid = fresh_tid(wave_id), wid = wave_id, lane = tid & 63, wr = wid >> 2, wc = wid & 3, fr = lane & 15, fq = lane >> 4;
    const int K = g.K, nt = K / BK;
    unsigned voffA[2], voffB[2];
#pragma unroll
    for (int i = 0; i < 2; ++i) { int R, C; stage_rc(tid * 16 + i * 8192, R, C); const int Rb = Epi::PERM ? ((R & ~31) + perm32(R & 31)) : R;
        voffA[i] = (unsigned)(R * g.ld + C) * 2u; voffB[i] = (unsigned)(Rb * g.ld + C) * 2u; }
    const size_t kstep = (size_t)(BK * 2);
    const size_t hstep = (size_t)HALF * g.ld * 2;
    const size_t tstep = 2 * hstep;
    const unsigned ldsw = (unsigned)wid * 1024u;
    const int aoff = lds_byte(wr * 64 + fr, fq * 8), boff = lds_byte(wc * 32 + fr, fq * 8);
#define PG8_SA(b, h) (((b) * 2 + (h)) * HTB)
#define PG8_SB(b, h) ((4 + (b) * 2 + (h)) * HTB)
#define PG8_STAGE(bufoff, gbase, voff) do { _Pragma("unroll") for (int _i = 0; _i < 2; ++_i) \
        __builtin_amdgcn_global_load_lds((const unsigned*)((const char*)(gbase) + (voff)[_i]), (PG8_LAS unsigned*)(lds + (bufoff) + ldsw + _i * 8192), 16, 0, 0); } while (0)
#define PG8_LDA(dst, b, h) do { _Pragma("unroll") for (int m = 0; m < 4; ++m) _Pragma("unroll") for (int k = 0; k < 2; ++k) dst[m][k] = *(const PG8_LAS bf16x8*)(lds + PG8_SA(b, h) + aoff + m * 2048 + k * 1024); } while (0)
#define PG8_LDB(dst, b, h) do { _Pragma("unroll") for (int n = 0; n < 2; ++n) _Pragma("unroll") for (int k = 0; k < 2; ++k) dst[n][k] = *(const PG8_LAS bf16x8*)(lds + PG8_SB(b, h) + boff + n * 2048 + k * 1024); } while (0)
#define PG8_MMA(ai, bj, At, Bt) do { __builtin_amdgcn_s_setprio(1); _Pragma("unroll") for (int m = 0; m < 4; ++m) _Pragma("unroll") for (int n = 0; n < 2; ++n) _Pragma("unroll") for (int k = 0; k < 2; ++k) \
        acc[ai][bj][m][n] = __builtin_amdgcn_mfma_f32_16x16x32_bf16(Bt[n][k], At[m][k], acc[ai][bj][m][n], 0, 0, 0); __builtin_amdgcn_s_setprio(0); } while (0)
#define PG8_WAIT_V(n) asm volatile("s_waitcnt vmcnt(" #n ")" ::: "memory")
#define PG8_WAIT_L(n) asm volatile("s_waitcnt lgkmcnt(" #n ")" ::: "memory")
#define PG8_BAR __builtin_amdgcn_s_barrier()
#define PG8_SCHED __builtin_amdgcn_sched_barrier(0)
    Unit cur, nxt; int ui = 0;
    if (!S.next(0, cur)) return;
    f32x4 acc[2][2][4][2];
#pragma unroll
    for (int a = 0; a < 2; ++a)
#pragma unroll
        for (int b = 0; b < 2; ++b)
#pragma unroll
            for (int m = 0; m < 4; ++m)
#pragma unroll
                for (int n = 0; n < 2; ++n) acc[a][b][m][n] = (f32x4){0.f, 0.f, 0.f, 0.f};
    bf16x8 At[4][2], B0[2][2], B1[2][2];
    const char* cA = (const char*)g.A + (size_t)cur.pm * tstep + (size_t)cur.k0 * 2 + cur.aoff; const char* cB = (const char*)g.Bt + (size_t)cur.pn * tstep + (size_t)cur.k0 * 2 + cur.boff;
    S.a_ready(cur);
    if constexpr (SP2) {
        PG8_STAGE(PG8_SB(0, 0), cB, voffB); PG8_STAGE(PG8_SB(0, 1), cB + hstep, voffB); PG8_STAGE(PG8_SA(0, 0), cA, voffA); PG8_STAGE(PG8_SA(0, 1), cA + hstep, voffA);
        if (wr == 1) PG8_BAR;
        PG8_WAIT_V(2); PG8_BAR;
        PG8_STAGE(PG8_SB(1, 0), cB + kstep, voffB); PG8_STAGE(PG8_SA(1, 0), cA + kstep, voffA); PG8_STAGE(PG8_SB(1, 1), cB + hstep + kstep, voffB);
        PG8_WAIT_V(6); PG8_BAR;
    } else {
        PG8_STAGE(PG8_SB(0, 0), cB, voffB); PG8_STAGE(PG8_SA(0, 0), cA, voffA); PG8_STAGE(PG8_SB(0, 1), cB + hstep, voffB); PG8_STAGE(PG8_SA(0, 1), cA + hstep, voffA);
        if (wr == 1) PG8_BAR;
        PG8_WAIT_V(4); PG8_BAR;
        PG8_STAGE(PG8_SB(1, 0), cB + kstep, voffB); PG8_STAGE(PG8_SA(1, 0), cA + kstep, voffA); PG8_STAGE(PG8_SB(1, 1), cB + hstep + kstep, voffB);
        PG8_WAIT_V(6); PG8_BAR;
    }
    for (;;) {
        const bool has_next = S.next(ui + 1, nxt);
        const char* nA = has_next ? (const char*)g.A + (size_t)nxt.pm * tstep + (size_t)nxt.k0 * 2 + nxt.aoff : cA; const char* nB = has_next ? (const char*)g.Bt + (size_t)nxt.pn * tstep + (size_t)nxt.k0 * 2 + nxt.boff : cB;
        for (int t = 0; t < nt; t += 2) {
            const bool last = (t == nt - 2);
            const char* a1 = cA + (size_t)(t + 1) * kstep;
            const char* a2 = last ? nA : cA + (size_t)(t + 2) * kstep; const char* b2 = last ? nB : cB + (size_t)(t + 2) * kstep;
            const char* a3 = a2 + kstep; const char* b3 = b2 + kstep;
            if (last && has_next) S.a_ready(nxt);
            if constexpr (SP2) {
            PG8_LDB(B0, 0, 0); PG8_LDB(B1, 0, 1); PG8_SCHED; PG8_LDA(At, 0, 0); PG8_STAGE(PG8_SA(1, 1), a1 + hstep, voffA);
            PG8_WAIT_V(8); PG8_WAIT_L(0); PG8_BAR; PG8_MMA(0, 0, At, B0); PG8_MMA(0, 1, At, B1); PG8_BAR; PG8_SCHED;
            PG8_LDA(At, 0, 1); PG8_STAGE(PG8_SB(0, 0), b2, voffB); PG8_STAGE(PG8_SB(0, 1), b2 + hstep, voffB); PG8_STAGE(PG8_SA(0, 0), a2, voffA);
            PG8_WAIT_V(8); PG8_WAIT_L(0); PG8_BAR; PG8_MMA(1, 0, At, B0); PG8_MMA(1, 1, At, B1); PG8_BAR; PG8_SCHED;
            PG8_LDB(B0, 1, 0); PG8_LDB(B1, 1, 1); PG8_SCHED; PG8_LDA(At, 1, 0); PG8_STAGE(PG8_SA(0, 1), a2 + hstep, voffA);
            PG8_WAIT_V(8); PG8_WAIT_L(0); PG8_BAR; PG8_MMA(0, 0, At, B0); PG8_MMA(0, 1, At, B1); PG8_BAR; PG8_SCHED;
            PG8_LDA(At, 1, 1); PG8_STAGE(PG8_SB(1, 0), b3, voffB); PG8_STAGE(PG8_SB(1, 1), b3 + hstep, voffB); PG8_STAGE(PG8_SA(1, 0), a3, voffA);
            PG8_WAIT_V(8); PG8_WAIT_L(0); PG8_BAR; PG8_MMA(1, 0, At, B0); PG8_MMA(1, 1, At, B1); PG8_BAR; PG8_SCHED;
            } else {
            PG8_LDB(B0, 0, 0); PG8_SCHED; PG8_LDA(At, 0, 0); PG8_STAGE(PG8_SA(1, 1), a1 + hstep, voffA);
            PG8_WAIT_L(8); PG8_BAR; PG8_WAIT_L(0); PG8_MMA(0, 0, At, B0); PG8_BAR; PG8_SCHED;
            PG8_LDB(B1, 0, 1); PG8_STAGE(PG8_SB(0, 0), b2, voffB);
            PG8_BAR; PG8_WAIT_L(0); PG8_MMA(0, 1, At, B1); PG8_BAR;
            PG8_LDA(At, 0, 1); PG8_STAGE(PG8_SA(0, 0), a2, voffA);
            PG8_BAR; PG8_WAIT_L(0); PG8_MMA(1, 0, At, B0); PG8_BAR; PG8_SCHED;
            PG8_STAGE(PG8_SB(0, 1), b2 + hstep, voffB);
            PG8_WAIT_V(6); PG8_BAR; PG8_MMA(1, 1, At, B1); PG8_BAR;
            PG8_LDB(B0, 1, 0); PG8_SCHED; PG8_LDA(At, 1, 0); PG8_STAGE(PG8_SA(0, 1), a2 + hstep, voffA);
            PG8_WAIT_L(8); PG8_BAR; PG8_WAIT_L(0); PG8_MMA(0, 0, At, B0); PG8_BAR; PG8_SCHED;
            PG8_LDB(B1, 1, 1); PG8_STAGE(PG8_SB(1, 0), b3, voffB);
            PG8_BAR; PG8_WAIT_L(0); PG8_MMA(0, 1, At, B1); PG8_BAR;
            PG8_LDA(At, 1, 1); PG8_STAGE(PG8_SA(1, 0), a3, voffA);
            PG8_BAR; PG8_WAIT_L(0); PG8_MMA(1, 0, At, B0); PG8_BAR; PG8_SCHED;
            PG8_STAGE(PG8_SB(1, 1), b3 + hstep, voffB);
            PG8_WAIT_V(6); PG8_BAR; PG8_MMA(1, 1, At, B1); PG8_BAR;
            }
        }
        if constexpr (ALIGN_EPI) { if (wr == 0) PG8_BAR; }
        if constexpr (!Epi::AFTER_DRAIN) { E(acc, cur, wr, wc, fr, fq); S.done(cur); }
        if (!has_next) break;
#pragma unroll
        for (int a = 0; a < 2; ++a)
#pragma unroll
            for (int b = 0; b < 2; ++b)
#pragma unroll
                for (int m = 0; m < 4; ++m)
#pragma unroll
                    for (int n = 0; n < 2; ++n) acc[a][b][m][n] = (f32x4){0.f, 0.f, 0.f, 0.f};
        cur = nxt; cA = nA; cB = nB; ++ui;
        if constexpr (ALIGN_EPI) { if (wr == 1) PG8_BAR; }
    }
    PG8_WAIT_V(0);
    if constexpr (!ALIGN_EPI) { if (wr == 0) PG8_BAR; }
    PG8_BAR;
    if constexpr (Epi::AFTER_DRAIN) { E.fused(acc, cur, wr, wc, fr, fq, lds, wid, lane); S.done(cur); }
#undef PG8_SA
#undef PG8_SB
#undef PG8_STAGE
#undef PG8_LDA
#undef PG8_LDB
#undef PG8_MMA
#undef PG8_WAIT_V
#undef PG8_WAIT_L
#undef PG8_BAR
#undef PG8_SCHED
}
}

struct Args { const void* in[25]; float* out; unsigned char* ws; int ph_lo, ph_hi; };
typedef const __attribute__((address_space(4))) Args* ArgsP;
#define IN_F(k) ((const float*)a->in[k])
#define WSB(off) ((bf16*)(a->ws + (off)))
#define WSF(off) ((float*)(a->ws + (off)))

struct Ctx { int tid, lane, wave, gw, ngw, gwT; };
__device__ __forceinline__ Ctx refresh(const Ctx& c0) { Ctx c = c0; c.tid = fresh_tid(c0.wave); c.lane = c.tid & 63; return c; }

__device__ __forceinline__ int row_pos(int r) { return r < RMAIN ? (r & 4095) + NMETA : (r < RSAMP0 ? ((r - RMAIN) & 15) : PAST + ((r - RSAMP0) & 3)); }
__device__ __forceinline__ float rope_inv(int j) { return exp2f(-(float)j * (13.287712379549449f / 16.0f)); }
__device__ __forceinline__ void rope_cs(int pos, int j, float& c, float& s) {
    const float ang = (float)pos * rope_inv(j);
    const double x = (double)ang; const double n = rint(x * 0.15915494309189535); const float r = (float)(x - n * 6.283185307179586);
    c = cosf(r); s = sinf(r);
}

struct RmId { int off; __device__ __forceinline__ int operator()(int n) const { return off + n; } };
struct RmUq { __device__ __forceinline__ int operator()(int n) const { const int h = n / 96, j = n % 96; if (j < 64) return h * 64 + j; const int jj = j - 64; return 1024 + h * 32 + (jj < 16 ? 2 * jj : 2 * (jj - 16) + 1); } };
template <class RM>
__device__ __forceinline__ void tr_item(const float* W, int ldw, int nblk, int item, bf16* WT, int ldt, RM rm, LAS float* scr, int lane, const float* gk = nullptr) {
    const int kb = item / nblk, nb = item % nblk, k0 = 64 * kb, n0 = 32 * nb;
#pragma unroll
    for (int i = 0; i < 8; ++i) { const int kk = 8 * i + (lane >> 3), c4 = (lane & 7) * 4; f32x4 v = __builtin_nontemporal_load((const f32x4*)(W + (size_t)(k0 + kk) * ldw + n0 + c4));
        if (gk) v = v * gk[k0 + kk];
        scr[kk * 33 + c4] = v.x; scr[kk * 33 + c4 + 1] = v.y; scr[kk * 33 + c4 + 2] = v.z; scr[kk * 33 + c4 + 3] = v.w; }
    LDS_WAIT();
    const int c = lane & 7;
#pragma unroll
    for (int j = 0; j < 4; ++j) { const int n = (lane >> 3) + 8 * j; const LAS float* s = scr + (8 * c) * 33 + n;
        u32x4 o; o.x = pk2(s[0 * 33], s[1 * 33]); o.y = pk2(s[2 * 33], s[3 * 33]); o.z = pk2(s[4 * 33], s[5 * 33]); o.w = pk2(s[6 * 33], s[7 * 33]);
        *(u32x4*)(WT + (size_t)rm(n0 + n) * ldt + k0 + 8 * c) = o; }
    LDS_WAIT();
}
__device__ __forceinline__ void norm_row_bf16(const float* xrow, const float* g, float* xcopy, bf16* hrow, int lane) {
    f32x4 v[4]; float s = 0.f;
#pragma unroll
    for (int j = 0; j < 4; ++j) { v[j] = *(const f32x4*)(xrow + 4 * lane + 256 * j); s += (v[j].x * v[j].x + v[j].y * v[j].y) + (v[j].z * v[j].z + v[j].w * v[j].w); }
    const float rs = 1.0f / sqrtf(wave_sum(s) * (1.f / D) + EPS);
#pragma unroll
    for (int j = 0; j < 4; ++j) { const f32x4 gg = *(const f32x4*)(g + 4 * lane + 256 * j);
        if (xcopy) *(f32x4*)(xcopy + 4 * lane + 256 * j) = v[j];
        u32x2 o; o.x = pk2(v[j].x * rs * gg.x, v[j].y * rs * gg.y); o.y = pk2(v[j].z * rs * gg.z, v[j].w * rs * gg.w);
        *(u32x2*)(hrow + 4 * lane + 256 * j) = o; }
}
__device__ __forceinline__ void p_prep(ArgsP a, const Ctx& c0, LAS unsigned char* lds) {
    const Ctx c = refresh(c0);
    LAS float* scr = (LAS float*)(lds + c.wave * 16384);
    constexpr int I0 = 16 * 17, I1 = 4 * 48, I2 = 4 * 32, I3 = 4 * 32, I4 = 16 * 32, I7 = 16 * 128, I9 = 64 * 32;
    constexpr int NIT = I0 + I1 + I2 + I3 + I4 + I7 + I9;
    for (int it = c.gw; it < NIT; it += c.ngw) {
        int r = it;
        if (r < I0) { tr_item(IN_F(11), 544, 17, r, WSB(WS_WIN0), 1024, RmId{0}, scr, c.lane, IN_F(7)); continue; } r -= I0;
        if (r < I1) { tr_item(IN_F(13), 1536, 48, r, WSB(WS_WUQ), 256, RmUq{}, scr, c.lane); continue; } r -= I1;
        if (r < I2) { tr_item(IN_F(15), 1024, 32, r, WSB(WS_WUKV), 256, RmId{0}, scr, c.lane); continue; } r -= I2;
        if (r < I3) { tr_item(IN_F(16), 1024, 32, r, WSB(WS_WUKV), 256, RmId{1024}, scr, c.lane); continue; } r -= I3;
        if (r < I4) { tr_item(IN_F(17), 1024, 32, r, WSB(WS_WO0), 1024, RmId{0}, scr, c.lane); continue; } r -= I4;
        if (r < I7) { tr_item(IN_F(23), 4096, 128, r, WSB(WS_WUP), 1024, RmId{0}, scr, c.lane, IN_F(9)); continue; } r -= I7;
        tr_item(IN_F(24), 1024, 32, r, WSB(WS_WDN), 4096, RmId{0}, scr, c.lane);
    }
    const int gt = c.gw * 64 + c.lane, ngt = c.ngw * 64;
    for (int i = gt; i < (NIN0 - 544) * 1024 / 2; i += ngt) ((unsigned*)(WSB(WS_WIN0) + (size_t)544 * 1024))[i] = 0u;
    for (int i = c.gw * 64 + c.lane; i < R * 16; i += c.ngw * 64) { const int r = i >> 4, j = i & 15; float cs, sn; rope_cs(row_pos(r), j, cs, sn); WSF(WS_ROPE)[(size_t)r * 32 + j] = cs; WSF(WS_ROPE)[(size_t)r * 32 + 16 + j] = sn; }
    {
        const float* xp = IN_F(0); const float* xm = IN_F(6); const float* xsm = IN_F(1); bf16* X = WSB(WS_X); float* RS = WSF(WS_RSTD);
        constexpr int NR = 4;
        for (int r0 = c.gw; r0 < R; r0 += NR * c.ngw) {
            f32x4 v[NR][4]; float s[NR];
#pragma unroll
            for (int q = 0; q < NR; ++q) { const int r = r0 + q * c.ngw < R ? r0 + q * c.ngw : r0;
                const float* xs = r < RMAIN ? xp + (size_t)r * D : (r < RSAMP0 ? xm + (size_t)((r - RMAIN) & 15) * D : xsm + (size_t)(r - RSAMP0) * D);
                s[q] = 0.f;
#pragma unroll
                for (int j = 0; j < 4; ++j) { v[q][j] = *(const f32x4*)(xs + 4 * c.lane + 256 * j); s[q] += (v[q][j].x * v[q][j].x + v[q][j].y * v[q][j].y) + (v[q][j].z * v[q][j].z + v[q][j].w * v[q][j].w); } }
#pragma unroll
            for (int sh = 1; sh < 64; sh <<= 1) {
#pragma unroll
                for (int q = 0; q < NR; ++q) s[q] += __shfl_xor(s[q], sh); }
#pragma unroll
            for (int q = 0; q < NR; ++q) { const int r = r0 + q * c.ngw < R ? r0 + q * c.ngw : r0; const float rs = 1.0f / sqrtf(s[q] * (1.f / D) + EPS);
                if (c.lane == 0) RS[r] = rs;
#pragma unroll
                for (int j = 0; j < 4; ++j) { u32x2 xo; xo.x = pk2(v[q][j].x, v[q][j].y); xo.y = pk2(v[q][j].z, v[q][j].w); *(u32x2*)(X + (size_t)r * D + 4 * c.lane + 256 * j) = xo; } }
        }
        for (int r = R + gt; r < RP; r += ngt) RS[r] = 0.f;
    }
}

__device__ __forceinline__ void p_late_weights(ArgsP a, const Ctx& c0, LAS unsigned char* lds, int wg0) {
    const Ctx c = refresh(c0);
    const int bx = (int)blockIdx.x - wg0; if (bx < 0) return;
    const int gw = bx * 8 + c.wave, ngw = ((int)gridDim.x - wg0) * 8;
    LAS float* scr = (LAS float*)(lds + c.wave * 16384);
    constexpr int I5 = 16 * 96, I6 = 16 * 32, I8 = 16 * 128, I10 = 64 * 32, NIT = I5 + I6 + I8 + I10;
    for (int it = gw; it < NIT; it += ngw) {
        int r = it;
        if (r < I5) { tr_item(IN_F(18), 3088, 96, r, WSB(WS_WGIN), 1024, RmId{0}, scr, c.lane, IN_F(7) + D); continue; } r -= I5;
        if (r < I6) { tr_item(IN_F(22), 1024, 32, r, WSB(WS_WGO), 1024, RmId{0}, scr, c.lane); continue; } r -= I6;
        if (r < I8) { tr_item(IN_F(23) + (size_t)1024 * 4096, 4096, 128, r, WSB(WS_WUP) + (size_t)4096 * 1024, 1024, RmId{0}, scr, c.lane, IN_F(9) + D); continue; } r -= I8;
        tr_item(IN_F(24) + (size_t)4096 * 1024, 1024, 32, r, WSB(WS_WDN) + (size_t)1024 * 4096, 4096, RmId{0}, scr, c.lane);
    }
    const int gt = gw * 64 + c.lane, ngt = ngw * 64;
    for (int i = gt; i < (NGIN - NGIN_REAL) * 1024 / 2; i += ngt) ((unsigned*)(WSB(WS_WGIN) + (size_t)NGIN_REAL * 1024))[i] = 0u;
    for (int i = gt; i < 16 * 1024; i += ngt) { const int n = i >> 10, k = i & 1023; WSB(WS_WGIN)[(size_t)(3072 + n) * 1024 + k] = (bf16)f2bf(IN_F(18)[(size_t)k * 3088 + 3072 + n] * IN_F(7)[D + k]); }
}
struct EpiF32 { float* C; int ldc; __device__ __forceinline__ void store4(int row, int col, f32x4 v) const { *(f32x4*)(C + (size_t)row * ldc + col) = v; } };
struct EpiBf16 { bf16* C; int ldc;
    __device__ __forceinline__ void store8(int row, int col, f32x4 a, f32x4 b) const { u32x4 o; o.x = pk2(a.x, a.y); o.y = pk2(a.z, a.w); o.z = pk2(b.x, b.y); o.w = pk2(b.z, b.w); *(u32x4*)(C + (size_t)row * ldc + col) = o; }
    __device__ __forceinline__ void store4(int row, int col, f32x4 v) const { u32x2 o; o.x = pk2(v.x, v.y); o.y = pk2(v.z, v.w); *(u32x2*)(C + (size_t)row * ldc + col) = o; } };
struct EpiRelu2 { bf16* C; int ldc;
    __device__ __forceinline__ void store8(int row, int col, f32x4 a, f32x4 b) const {
        f32x4 r; r.x = fmaxf(a.x, 0.f); r.y = fmaxf(a.y, 0.f); r.z = fmaxf(a.z, 0.f); r.w = fmaxf(a.w, 0.f); r = r * r;
        f32x4 s; s.x = fmaxf(b.x, 0.f); s.y = fmaxf(b.y, 0.f); s.z = fmaxf(b.z, 0.f); s.w = fmaxf(b.w, 0.f); s = s * s;
        u32x4 o; o.x = pk2(r.x, r.y); o.y = pk2(r.z, r.w); o.z = pk2(s.x, s.y); o.w = pk2(s.z, s.w); *(u32x4*)(C + (size_t)row * ldc + col) = o; }
    __device__ __forceinline__ void store4(int row, int col, f32x4 v) const {
    f32x4 r; r.x = fmaxf(v.x, 0.f); r.y = fmaxf(v.y, 0.f); r.z = fmaxf(v.z, 0.f); r.w = fmaxf(v.w, 0.f); r = r * r;
    u32x2 o; o.x = pk2(r.x, r.y); o.y = pk2(r.z, r.w); *(u32x2*)(C + (size_t)row * ldc + col) = o; } };
struct EpiQ { bf16* QN; bf16* QPE; const float* ROPE;
    __device__ __forceinline__ void store8(int row, int col, f32x4 a, f32x4 b) const {
        if (col < 1024) { u32x4 o; o.x = pk2(a.x * QSCALE, a.y * QSCALE); o.y = pk2(a.z * QSCALE, a.w * QSCALE); o.z = pk2(b.x * QSCALE, b.y * QSCALE); o.w = pk2(b.z * QSCALE, b.w * QSCALE); *(u32x4*)(QN + (size_t)row * 1024 + col) = o; }
        else { store4(row, col, a); store4(row, col + 4, b); }
    }
    __device__ __forceinline__ void store4(int row, int col, f32x4 v) const {
        if (col < 1024) { u32x2 o; o.x = pk2(v.x * QSCALE, v.y * QSCALE); o.y = pk2(v.z * QSCALE, v.w * QSCALE); *(u32x2*)(QN + (size_t)row * 1024 + col) = o; }
        else { const int p0 = (col - 1024) >> 1; const float* rt = ROPE + (size_t)row * 32;
#pragma unroll
            for (int e = 0; e < 2; ++e) { const int p = p0 + e, h = p >> 4, jj = p & 15; const float x1 = e ? v.z : v.x, x2 = e ? v.w : v.y, cs = rt[jj], sn = rt[16 + jj];
                QPE[(size_t)row * 512 + h * 32 + jj] = (bf16)f2bf((x1 * cs - x2 * sn) * QSCALE); QPE[(size_t)row * 512 + h * 32 + 16 + jj] = (bf16)f2bf((x1 * sn + x2 * cs) * QSCALE); } }
    } };
struct EpiBf16S { bf16* C; int ldc; float s;
    __device__ __forceinline__ void store8(int row, int col, f32x4 a, f32x4 b) const { u32x4 o; o.x = pk2(a.x * s, a.y * s); o.y = pk2(a.z * s, a.w * s); o.z = pk2(b.x * s, b.y * s); o.w = pk2(b.z * s, b.w * s); *(u32x4*)(C + (size_t)row * ldc + col) = o; }
    __device__ __forceinline__ void store4(int row, int col, f32x4 v) const { u32x2 o; o.x = pk2(v.x * s, v.y * s); o.y = pk2(v.z * s, v.w * s); *(u32x2*)(C + (size_t)row * ldc + col) = o; } };
struct EpiGla { bf16 *QG, *KG, *VG, *RG; float* GD;
    __device__ __forceinline__ void store8(int row, int col, f32x4 a, f32x4 b) const {
        if (col < 3072) { bf16* dst; int cc;
            if (col < 512) { dst = QG + (size_t)row * 512; cc = col; a = a * GLA_SCALE; b = b * GLA_SCALE; }
            else if (col < 1024) { dst = KG + (size_t)row * 512; cc = col - 512; }
            else if (col < 2048) { dst = VG + (size_t)row * 1024; cc = col - 1024; }
            else { dst = RG + (size_t)row * 1024; cc = col - 2048; }
            u32x4 o; o.x = pk2(a.x, a.y); o.y = pk2(a.z, a.w); o.z = pk2(b.x, b.y); o.w = pk2(b.z, b.w); *(u32x4*)(dst + cc) = o;
        } else if (col < 3088) { *(f32x4*)(GD + (size_t)row * 16 + (col - 3072)) = a; *(f32x4*)(GD + (size_t)row * 16 + (col - 3072) + 4) = b; }
    }
    __device__ __forceinline__ void store4(int row, int col, f32x4 v) const {
        if (col < 3072) { bf16* dst; int cc;
            if (col < 512) { dst = QG + (size_t)row * 512; cc = col; v = v * GLA_SCALE; }
            else if (col < 1024) { dst = KG + (size_t)row * 512; cc = col - 512; }
            else if (col < 2048) { dst = VG + (size_t)row * 1024; cc = col - 1024; }
            else { dst = RG + (size_t)row * 1024; cc = col - 2048; }
            u32x2 o; o.x = pk2(v.x, v.y); o.y = pk2(v.z, v.w); *(u32x2*)(dst + cc) = o;
        } else if (col < 3088) { *(f32x4*)(GD + (size_t)row * 16 + (col - 3072)) = v; }
    } };
template <class Epi>
__device__ __forceinline__ void gemm_naive(const bf16* A, const bf16* Bt, int M, int N, int K, const Epi& E, LAS unsigned char* lds, int tid) {
    LAS float* As = (LAS float*)lds;
    LAS float* Bs = As + 32 * 68;
    const int ntm = M / 64, ntn = N / 128, ty = tid >> 5, tx = tid & 31;
    for (int tile = blockIdx.x; tile < ntm * ntn; tile += gridDim.x) {
        const int tm = tile / ntn, tn = tile % ntn;
        f32x4 acc[4];
#pragma unroll
        for (int i = 0; i < 4; ++i) acc[i] = (f32x4){0.f, 0.f, 0.f, 0.f};
        for (int k0 = 0; k0 < K; k0 += 32) {
            { const int row = tid >> 3, kq = (tid & 7) * 4; const u32x2 v = *(const u32x2*)(A + (size_t)(tm * 64 + row) * K + k0 + kq);
              As[(kq + 0) * 68 + row] = bflo(v.x); As[(kq + 1) * 68 + row] = bfhi(v.x); As[(kq + 2) * 68 + row] = bflo(v.y); As[(kq + 3) * 68 + row] = bfhi(v.y); }
            { const int row = tid >> 2, kq = (tid & 3) * 8; const u32x4 v = *(const u32x4*)(Bt + (size_t)(tn * 128 + row) * K + k0 + kq);
              Bs[(kq + 0) * 132 + row] = bflo(v.x); Bs[(kq + 1) * 132 + row] = bfhi(v.x); Bs[(kq + 2) * 132 + row] = bflo(v.y); Bs[(kq + 3) * 132 + row] = bfhi(v.y);
              Bs[(kq + 4) * 132 + row] = bflo(v.z); Bs[(kq + 5) * 132 + row] = bfhi(v.z); Bs[(kq + 6) * 132 + row] = bflo(v.w); Bs[(kq + 7) * 132 + row] = bfhi(v.w); }
            __syncthreads();
#pragma unroll 8
            for (int k = 0; k < 32; ++k) {
                const f32x4 av = *(const LAS f32x4*)(As + k * 68 + 4 * ty); const f32x4 bv = *(const LAS f32x4*)(Bs + k * 132 + 4 * tx);
                acc[0] += av.x * bv; acc[1] += av.y * bv; acc[2] += av.z * bv; acc[3] += av.w * bv;
            }
            __syncthreads();
        }
#pragma unroll
        for (int i = 0; i < 4; ++i) E.store4(tm * 64 + 4 * ty + i, tn * 128 + 4 * tx, acc[i]);
    }
}


template <class E> struct EpiWrap {
    static constexpr bool PERM = false, AFTER_DRAIN = false; E e;
    __device__ __forceinline__ void operator()(const pg8::f32x4 (&acc)[2][2][4][2], const pg8::Unit& u, int wr, int wc, int fr, int fq) const {
#pragma unroll
        for (int ai = 0; ai < 2; ++ai)
#pragma unroll
            for (int m = 0; m < 4; ++m) { const int row = u.pm * 256 + ai * 128 + wr * 64 + m * 16 + fr;
#pragma unroll
                for (int bj = 0; bj < 2; ++bj)
#pragma unroll
                    for (int n = 0; n < 2; ++n) e.store4(row, u.pn * 256 + bj * 128 + wc * 32 + n * 16 + 4 * fq, acc[ai][bj][m][n]); }
    }
};
template <int KSUB> struct EpiSlab {
    static constexpr bool PERM = false, AFTER_DRAIN = false; float* MT;
    __device__ __forceinline__ void operator()(const pg8::f32x4 (&acc)[2][2][4][2], const pg8::Unit& u, int wr, int wc, int fr, int fq) const {
        float* base = MT + ((size_t)(u.k0 / KSUB) * (RP - RMAIN) + (size_t)(u.pm * 256 - RMAIN)) * D + u.pn * 256 + wc * 32 + 4 * fq;
#pragma unroll
        for (int ai = 0; ai < 2; ++ai)
#pragma unroll
            for (int m = 0; m < 4; ++m) { float* rp = base + (size_t)(ai * 128 + wr * 64 + m * 16 + fr) * D;
#pragma unroll
                for (int bj = 0; bj < 2; ++bj)
#pragma unroll
                    for (int n = 0; n < 2; ++n) *(f32x4*)(rp + bj * 128 + n * 16) = acc[ai][bj][m][n]; }
    }
};
template <class E> struct EpiWrap8 {
    static constexpr bool PERM = true, AFTER_DRAIN = false; E e;
    __device__ __forceinline__ void operator()(const pg8::f32x4 (&acc)[2][2][4][2], const pg8::Unit& u, int wr, int wc, int fr, int fq) const {
#pragma unroll
        for (int ai = 0; ai < 2; ++ai)
#pragma unroll
            for (int m = 0; m < 4; ++m) { const int row = u.pm * 256 + ai * 128 + wr * 64 + m * 16 + fr;
#pragma unroll
                for (int bj = 0; bj < 2; ++bj) e.store8(row, u.pn * 256 + bj * 128 + wc * 32 + 8 * fq, acc[ai][bj][m][0], acc[ai][bj][m][1]); }
    }
};
template <class E> struct EpiWrap8S {
    static constexpr bool PERM = true, AFTER_DRAIN = false; E e; const float* rs;
    __device__ __forceinline__ void operator()(const pg8::f32x4 (&acc)[2][2][4][2], const pg8::Unit& u, int wr, int wc, int fr, int fq) const {
#pragma unroll
        for (int ai = 0; ai < 2; ++ai)
#pragma unroll
            for (int m = 0; m < 4; ++m) { const int row = u.pm * 256 + ai * 128 + wr * 64 + m * 16 + fr; const float s = rs[row];
#pragma unroll
                for (int bj = 0; bj < 2; ++bj) e.store8(row, u.pn * 256 + bj * 128 + wc * 32 + 8 * fq, acc[ai][bj][m][0] * s, acc[ai][bj][m][1] * s); }
    }
};
template <class E>
__device__ __forceinline__ void gemm_mfma8(const bf16* A, const float* rs, const bf16* Bt, int M, int N, int K, const E& e, LAS unsigned char* lds, int wave) {
    pg8::Gemm g{A, Bt, M, N, K, K}; pg8::StaticOrder S; S.init(M, N, (int)gridDim.x, (int)blockIdx.x);
    EpiWrap8S<E> W{e, rs};
    pg8::gemm_phase<EpiWrap8S<E>, pg8::StaticOrder, true, true>(lds, g, S, W, wave);
}
template <class E>
__device__ __forceinline__ void gemm_mfma(const bf16* A, const bf16* Bt, int M, int N, int K, const E& e, LAS unsigned char* lds, int wave) {
    pg8::Gemm g{A, Bt, M, N, K, K}; pg8::StaticOrder S; S.init(M, N, (int)gridDim.x, (int)blockIdx.x);
    EpiWrap<E> W{e};
    pg8::gemm_phase<EpiWrap<E>, pg8::StaticOrder, true, true>(lds, g, S, W, wave);
}
template <int SPLIT, int NN, int KSUB, int PM0, int NUNITS> struct TailOrder {
    int G, c;
    __device__ __forceinline__ bool next(int i, pg8::Unit& u) const { const int L = i * G + c; if (L >= NUNITS) return false; const int ks = L % SPLIT, t = L / SPLIT; u.pn = t % NN; u.pm = PM0 + t / NN; u.k0 = ks * KSUB; u.prob = 0; u.aoff = 0; u.boff = 0; return true; }
    __device__ __forceinline__ void a_ready(const pg8::Unit&) const {}
    __device__ __forceinline__ void done(const pg8::Unit&) const {}
};
struct EpiAtomicF32 { float* C; int ldc; __device__ __forceinline__ void store4(int row, int col, f32x4 v) const { float* p = C + (size_t)row * ldc + col;
    __hip_atomic_fetch_add(p, v.x, __ATOMIC_RELAXED, __HIP_MEMORY_SCOPE_AGENT); __hip_atomic_fetch_add(p + 1, v.y, __ATOMIC_RELAXED, __HIP_MEMORY_SCOPE_AGENT);
    __hip_atomic_fetch_add(p + 2, v.z, __ATOMIC_RELAXED, __HIP_MEMORY_SCOPE_AGENT); __hip_atomic_fetch_add(p + 3, v.w, __ATOMIC_RELAXED, __HIP_MEMORY_SCOPE_AGENT); } };
template <int K, int SPLIT>
__device__ __forceinline__ void gemm_n1024_tail(const bf16* A, const bf16* Bt, bf16* C, float* MT, LAS unsigned char* lds, int wave) {
    { pg8::Gemm g{A, Bt, RMAIN, D, K, K}; pg8::StaticOrder S; S.init(RMAIN, D, (int)gridDim.x, (int)blockIdx.x); EpiWrap8<EpiBf16> W{EpiBf16{C, D}};
      pg8::gemm_phase<EpiWrap8<EpiBf16>, pg8::StaticOrder, true, true>(lds, g, S, W, wave); }
    { typedef TailOrder<SPLIT, D / 256, K / SPLIT, RMAIN / 256, (RP - RMAIN) / 256 * (D / 256) * SPLIT> TO;
      pg8::Gemm g{A, Bt, RP, D, K / SPLIT, K}; TO S{(int)gridDim.x, (int)blockIdx.x}; EpiSlab<K / SPLIT> W{MT};
      pg8::gemm_phase<EpiSlab<K / SPLIT>, TO, false, true>(lds, g, S, W, wave); }
}

struct P3Order {
    int G, c;
    static constexpr int NQ = (RP / 256) * (NUQ / 256), NL = (DB * DS / 256) * (NH * KVL / 256), NK = (RP / 256) * (NUKV / 256);
    __device__ __forceinline__ bool next(int i, pg8::Unit& u) const {
        int L = i * G + c; u.k0 = 0;
        if (L < NK) { u.prob = 2; u.pm = L / (NUKV / 256); u.pn = L % (NUKV / 256); u.aoff = (long)(WS_CKVN - WS_CQN); u.boff = (long)(WS_WUKV - WS_WUQ); return true; } L -= NK;
        if (L < NQ) { u.prob = 0; u.pm = L / (NUQ / 256); u.pn = L % (NUQ / 256); u.aoff = 0; u.boff = 0; return true; } L -= NQ;
        if (L < NL) { u.prob = 1; u.pm = L / (NH * KVL / 256); u.pn = L % (NH * KVL / 256); u.aoff = (long)RSAMP0 * QL * 2; u.boff = (long)(WS_WUQL - WS_WUQ); return true; }
        return false;
    }
    __device__ __forceinline__ void a_ready(const pg8::Unit&) const {}
    __device__ __forceinline__ void done(const pg8::Unit&) const {}
};
struct EpiP3 {
    static constexpr bool PERM = true, AFTER_DRAIN = false; EpiQ eq; EpiBf16S el; EpiBf16 ek;
    __device__ __forceinline__ void operator()(const pg8::f32x4 (&acc)[2][2][4][2], const pg8::Unit& u, int wr, int wc, int fr, int fq) const {
        asm volatile("" : "+v"(fr), "+v"(fq));
        if (u.prob == 0) { EpiWrap8<EpiQ> w{eq}; w(acc, u, wr, wc, fr, fq); }
        else if (u.prob == 1) { EpiWrap8<EpiBf16S> w{el}; w(acc, u, wr, wc, fr, fq); }
        else { EpiWrap8<EpiBf16> w{ek}; w(acc, u, wr, wc, fr, fq); }
    }
};
__device__ __forceinline__ void gemm_p3(ArgsP a, LAS unsigned char* lds, int wave) {
    pg8::Gemm g{WSB(WS_CQN), WSB(WS_WUQ), RP, NUQ, QL, QL}; P3Order S{(int)gridDim.x, (int)blockIdx.x};
    EpiP3 E{EpiQ{WSB(WS_QN), WSB(WS_QPE), WSF(WS_ROPE)}, EpiBf16S{WSB(WS_QLAT), NH * KVL, QSCALE}, EpiBf16{WSB(WS_KNV), NUKV}};
    pg8::gemm_phase<EpiP3, P3Order, false, true>(lds, g, S, E, wave);
}

struct EpiMlaIn {
    static constexpr bool PERM = false, AFTER_DRAIN = true;
    bf16 *CQN, *CKVN, *KPEB; const float *qg, *kg, *ROPE, *RS; float* out;
    __device__ __forceinline__ void fused(pg8::f32x4 (&acc)[2][2][4][2], const pg8::Unit& u, int wr, int wc, int fr, int fq, PG8_LAS unsigned char* lds, int wid, int lane) const {
        asm volatile("" : "+v"(fr), "+v"(fq));
#pragma unroll
        for (int ai = 0; ai < 2; ++ai)
#pragma unroll
            for (int m = 0; m < 4; ++m) { const float sr = RS[u.pm * 256 + ai * 128 + wr * 64 + m * 16 + fr];
#pragma unroll
                for (int bj = 0; bj < 2; ++bj)
#pragma unroll
                    for (int n = 0; n < 2; ++n) acc[ai][bj][m][n] = acc[ai][bj][m][n] * sr; }
        if (u.pn < 2) {
            PG8_LAS float* P = (PG8_LAS float*)lds;
            float s[2][4];
#pragma unroll
            for (int ai = 0; ai < 2; ++ai)
#pragma unroll
                for (int m = 0; m < 4; ++m) { float t = 0.f;
#pragma unroll
                    for (int bj = 0; bj < 2; ++bj)
#pragma unroll
                        for (int n = 0; n < 2; ++n) { const pg8::f32x4 x = acc[ai][bj][m][n]; t += (x[0] * x[0] + x[1] * x[1]) + (x[2] * x[2] + x[3] * x[3]); }
                    t += __shfl_xor(t, 16); t += __shfl_xor(t, 32);
                    if (fq == 0) P[(ai * 128 + wr * 64 + m * 16 + fr) * 4 + wc] = t; }
            asm volatile("s_waitcnt lgkmcnt(0)\n\ts_barrier" ::: "memory");
#pragma unroll
            for (int ai = 0; ai < 2; ++ai)
#pragma unroll
                for (int m = 0; m < 4; ++m) { const pg8::f32x4 p4 = *(const PG8_LAS pg8::f32x4*)(P + (ai * 128 + wr * 64 + m * 16 + fr) * 4); s[ai][m] = 1.0f / sqrtf(((p4[0] + p4[1]) + (p4[2] + p4[3])) * (1.f / 256) + EPS); }
            const float* g = u.pn == 0 ? qg : kg; bf16* dst = u.pn == 0 ? CQN : CKVN;
#pragma unroll
            for (int bj = 0; bj < 2; ++bj)
#pragma unroll
                for (int n = 0; n < 2; ++n) { const int col = bj * 128 + wc * 32 + n * 16 + 4 * fq; const pg8::f32x4 gv = *(const pg8::f32x4*)(g + col);
#pragma unroll
                    for (int ai = 0; ai < 2; ++ai)
#pragma unroll
                        for (int m = 0; m < 4; ++m) { const int row = u.pm * 256 + ai * 128 + wr * 64 + m * 16 + fr; if (row >= R) continue;
                            const pg8::f32x4 y = acc[ai][bj][m][n] * s[ai][m] * gv;
                            u32x2 o; o.x = pk2(y[0], y[1]); o.y = pk2(y[2], y[3]); *(u32x2*)(dst + (size_t)row * 256 + col) = o;
                            if (u.pn == 1) { const int pos = row_pos(row); float* oc = row < RSAMP0 ? out + O_CKVP + ((size_t)(row < RMAIN ? (row >> 12) : ((row - RMAIN) >> 4)) * TP + pos) * 256 : out + O_CKVS + (size_t)(row - RSAMP0) * 256;
                                *(pg8::f32x4*)(oc + col) = y; } } }
        } else if (wc == 0) {
#pragma unroll
            for (int ai = 0; ai < 2; ++ai)
#pragma unroll
                for (int m = 0; m < 4; ++m) { const int row = u.pm * 256 + ai * 128 + wr * 64 + m * 16 + fr; if (row >= R) continue;
                    const int pos = row_pos(row); const float* rt = ROPE + (size_t)row * 32 + 4 * fq; const pg8::f32x4 cs = *(const pg8::f32x4*)rt, sn = *(const pg8::f32x4*)(rt + 16);
                    const pg8::f32x4 x1 = acc[ai][0][m][0], x2 = acc[ai][0][m][1]; const pg8::f32x4 o1 = x1 * cs - x2 * sn, o2 = x1 * sn + x2 * cs;
                    float* ok = row < RSAMP0 ? out + O_KPEP + ((size_t)(row < RMAIN ? (row >> 12) : ((row - RMAIN) >> 4)) * TP + pos) * 32 : out + O_KPES + (size_t)(row - RSAMP0) * 32;
                    *(pg8::f32x4*)(ok + 4 * fq) = o1; *(pg8::f32x4*)(ok + 16 + 4 * fq) = o2;
                    u32x2 w; w.x = pk2(o1[0], o1[1]); w.y = pk2(o1[2], o1[3]); *(u32x2*)(KPEB + (size_t)row * 32 + 4 * fq) = w; w.x = pk2(o2[0], o2[1]); w.y = pk2(o2[2], o2[3]); *(u32x2*)(KPEB + (size_t)row * 32 + 16 + 4 * fq) = w; }
        }
    }
};
__device__ __forceinline__ void gemm_p1(ArgsP a, LAS unsigned char* lds, int wave) {
    pg8::Gemm g{WSB(WS_X), WSB(WS_WIN0), RP, NIN0, D, D}; pg8::StaticOrder S; S.init(RP, NIN0, (int)gridDim.x, (int)blockIdx.x);
    EpiMlaIn E{WSB(WS_CQN), WSB(WS_CKVN), WSB(WS_KPE), IN_F(12), IN_F(14), WSF(WS_ROPE), WSF(WS_RSTD), a->out};
    pg8::gemm_phase<EpiMlaIn, pg8::StaticOrder, false, true>(lds, g, S, E, wave);
}
#ifndef USE_NAIVE_ATTN
#define USE_NAIVE_ATTN 0
#endif
#ifndef USE_NAIVE_DECODE
#define USE_NAIVE_DECODE 0
#endif
#ifndef USE_NAIVE_GLA
#define USE_NAIVE_GLA 0
#endif
#ifndef PROBE
#define PROBE 0
#endif
#ifndef PROBE_LO
#define PROBE_LO -1
#define PROBE_HI -1
#endif
#ifndef USE_NAIVE_GEMM
#define USE_NAIVE_GEMM 0
#endif
#if USE_NAIVE_GEMM
#define GEMM(A, Bt, M, N, K, E) gemm_naive(A, Bt, M, N, K, E, lds, fresh_tid(c.wave))
#else
#define GEMM(A, Bt, M, N, K, E) gemm_mfma(A, Bt, M, N, K, E, lds, c.wave)
#endif


namespace att {
typedef short bf16x8 __attribute__((ext_vector_type(8)));
typedef short s16x4 __attribute__((ext_vector_type(4)));
typedef float f32x16 __attribute__((ext_vector_type(16)));
constexpr int KSLOT = 12288, VSLOT = 8192, LDS_K = 0, LDS_V = 2 * KSLOT, LDS_WS = LDS_V + 2 * VSLOT, LDS_OST = LDS_WS + 8 * 256, LDS_TOTAL = LDS_OST + 8 * 4096;
__device__ __forceinline__ int crow(int r, int hi) { return (r & 3) + 8 * (r >> 2) + 4 * hi; }
typedef float f32x2_t __attribute__((ext_vector_type(2))); typedef __bf16 bf16x2_t __attribute__((ext_vector_type(2)));
__device__ __forceinline__ unsigned cvtpk(float lo, float hi) { f32x2_t v = {lo, hi}; bf16x2_t b = __builtin_convertvector(v, bf16x2_t); return __builtin_bit_cast(unsigned, b); }
__device__ __forceinline__ s16x4 vtr(const LAS unsigned char* p) { typedef short v4i16_t __attribute__((ext_vector_type(4))); return __builtin_bit_cast(s16x4, __builtin_amdgcn_ds_read_tr16_b64_v4i16((LAS v4i16_t*)p)); }
__device__ __forceinline__ float pmax32(float m) { auto rr = __builtin_amdgcn_permlane32_swap(__float_as_uint(m), __float_as_uint(m), false, false); return fmaxf(__uint_as_float(rr[0]), __uint_as_float(rr[1])); }
__device__ __forceinline__ float psum32(float m) { auto rr = __builtin_amdgcn_permlane32_swap(__float_as_uint(m), __float_as_uint(m), false, false); return __uint_as_float(rr[0]) + __uint_as_float(rr[1]); }
#define ATT_WAIT_BAR() asm volatile("s_waitcnt vmcnt(0) lgkmcnt(0)\n\ts_barrier" ::: "memory")
__device__ __forceinline__ void glds16(const void* gsrc, unsigned lds_dst) { unsigned keep;
    asm volatile("s_mov_b32 %0, m0\n\ts_mov_b32 m0, %2\n\ts_nop 0\n\tglobal_load_lds_dwordx4 %1, off\n\ts_mov_b32 m0, %0" : "=&s"(keep) : "v"(gsrc), "s"(lds_dst) : "memory"); }

__device__ __forceinline__ void attn_unit(int b, int h, int qb, const bf16* QN, const bf16* QPE, const bf16* KNV, const bf16* KPE, bf16* O, LAS unsigned char* lds, int wave_id) {
    const int tid = fresh_tid(wave_id), lane = tid & 63, r32 = lane & 31, hi = lane >> 5; const int wid = wave_id;
    const int rowbase = b * SEQ, q0 = qb * 256, qrow = rowbase + q0 + wid * 32 + r32, qrel = q0 + wid * 32 + r32;
    bf16x8 qr[6];
#pragma unroll
    for (int d0 = 0; d0 < 4; ++d0) qr[d0] = *(const bf16x8*)(QN + (size_t)qrow * 1024 + h * 64 + d0 * 16 + hi * 8);
#pragma unroll
    for (int d0 = 0; d0 < 2; ++d0) qr[4 + d0] = *(const bf16x8*)(QPE + (size_t)qrow * 512 + h * 32 + d0 * 16 + hi * 8);
    LAS float* wsf = (LAS float*)(lds + LDS_WS) + wid * 64;
    const int NT = 4 * qb + 4;
#define ATT_DMA(t, slot) do { const size_t row0_ = (t) == 0 ? (size_t)(RMAIN + 16 * b) : (size_t)(rowbase + 64 * ((t) - 1)); \
        __builtin_amdgcn_global_load_lds((const unsigned*)(KNV + (row0_ + lane) * 2048 + h * 64 + wid * 8), (LAS unsigned*)(lds + LDS_K + (slot) * KSLOT + wid * 1024), 16, 0, 0); \
        if (wid < 4) __builtin_amdgcn_global_load_lds((const unsigned*)(KPE + (row0_ + lane) * 32 + wid * 8), (LAS unsigned*)(lds + LDS_K + (slot) * KSLOT + (8 + wid) * 1024), 16, 0, 0); \
        __builtin_amdgcn_global_load_lds((const unsigned*)(KNV + (row0_ + 16 * (wid & 3) + (lane >> 2)) * 2048 + 1024 + h * 64 + (wid >> 2) * 32 + (lane & 3) * 8), (LAS unsigned*)(lds + LDS_V + (slot) * VSLOT + wid * 1024), 16, 0, 0); } while (0)
    f32x16 o[2]; o[0] = f32x16{}; o[1] = f32x16{};
    float mref = -INFINITY, l = 0.f;
    ATT_DMA(0, 0);
    for (int t = 0; t <= NT; ++t) {
        ATT_WAIT_BAR();
        const int slot = t & 1;
        if (t < NT) ATT_DMA(t + 1, slot ^ 1);
        const int kt0 = 64 * (t - 1);
        if (t > 0 && kt0 > q0 + wid * 32 + 31) continue;
        f32x16 p0 = f32x16{}, p1 = f32x16{};
        const LAS unsigned char* kb = lds + LDS_K + slot * KSLOT + hi * 1024 + r32 * 16;
#pragma unroll
        for (int d0 = 0; d0 < 6; ++d0) {
            const bf16x8 b0 = *(const LAS bf16x8*)(kb + d0 * 2048), b1 = *(const LAS bf16x8*)(kb + d0 * 2048 + 512);
            p0 = __builtin_amdgcn_mfma_f32_32x32x16_bf16(b0, qr[d0], p0, 0, 0, 0);
            p1 = __builtin_amdgcn_mfma_f32_32x32x16_bf16(b1, qr[d0], p1, 0, 0, 0);
        }
        if (t == 0) {
#pragma unroll
            for (int r = 0; r < 16; ++r) { if (crow(r, hi) >= NMETA) p0[r] = -INFINITY; p1[r] = -INFINITY; }
        } else if (kt0 + 63 > q0 + wid * 32) {
#pragma unroll
            for (int r = 0; r < 16; ++r) { const int kv = kt0 + crow(r, hi); if (kv > qrel) p0[r] = -INFINITY; if (kv + 32 > qrel) p1[r] = -INFINITY; }
        }
        float rm = fmaxf(p0[0], p1[0]);
#pragma unroll
        for (int r = 1; r < 16; ++r) rm = fmaxf(rm, fmaxf(p0[r], p1[r]));
        rm = pmax32(rm);
        if (__any(rm > mref + 8.0f)) {
            const float mnew = fmaxf(mref, rm); const float f = __builtin_amdgcn_exp2f(mref - mnew);
            mref = mnew; l *= f;
            if (hi == 0) wsf[r32] = f;
            LDS_WAIT();
#pragma unroll
            for (int r = 0; r < 16; ++r) { const float fr = wsf[crow(r, hi)]; o[0][r] *= fr; o[1][r] *= fr; }
        }
        float sacc = 0.f;
#pragma unroll
        for (int r = 0; r < 16; ++r) { p0[r] = __builtin_amdgcn_exp2f(p0[r] - mref); p1[r] = __builtin_amdgcn_exp2f(p1[r] - mref); sacc += p0[r] + p1[r]; }
        l += sacc;
        u32x4 pw[4];
#pragma unroll
        for (int i = 0; i < 4; ++i) { pw[0][i] = cvtpk(p0[2 * i], p0[2 * i + 1]); pw[1][i] = cvtpk(p0[8 + 2 * i], p0[8 + 2 * i + 1]); pw[2][i] = cvtpk(p1[2 * i], p1[2 * i + 1]); pw[3][i] = cvtpk(p1[8 + 2 * i], p1[8 + 2 * i + 1]); }
        const LAS unsigned char* vb = lds + LDS_V + slot * VSLOT + ((lane >> 4) & 1) * 32 + (lane & 3) * 8 + (4 * hi + ((lane & 15) >> 2)) * 64;
#pragma unroll
        for (int d0 = 0; d0 < 2; ++d0)
#pragma unroll
            for (int ks = 0; ks < 4; ++ks) {
                const s16x4 vlo = vtr(vb + d0 * 4096 + ks * 1024), vhi = vtr(vb + d0 * 4096 + ks * 1024 + 512);
                const bf16x8 vf = (bf16x8){vlo[0], vlo[1], vlo[2], vlo[3], vhi[0], vhi[1], vhi[2], vhi[3]};
                o[d0] = __builtin_amdgcn_mfma_f32_32x32x16_bf16(__builtin_bit_cast(bf16x8, pw[ks]), vf, o[d0], 0, 0, 0);
            }
    }
    l = psum32(l);
    if (hi == 0) wsf[32 + r32] = l;
    LDS_WAIT();
    bf16* Ow = O + (size_t)(rowbase + q0 + wid * 32) * 1024 + h * 64;
    LAS bf16* stg = (LAS bf16*)(lds + LDS_OST) + wid * 2048;
#pragma unroll
    for (int r = 0; r < 16; ++r) { const int orow = crow(r, hi); const float il = 1.0f / wsf[32 + orow];
        stg[orow * 64 + r32] = (bf16)f2bf(o[0][r] * il); stg[orow * 64 + 32 + r32] = (bf16)f2bf(o[1][r] * il); }
    LDS_WAIT();
#pragma unroll
    for (int i = 0; i < 4; ++i) { const int row = i * 8 + (lane >> 3), ch = lane & 7; const u32x4 v = *(const LAS u32x4*)(stg + row * 64 + ch * 8); *(u32x4*)(Ow + (size_t)row * 1024 + ch * 8) = v; }
    ATT_WAIT_BAR();
#undef ATT_DMA
}
constexpr int P_LDS_K = 0, P_LDS_V = 3 * KSLOT, P_LDS_WS = P_LDS_V + 2 * VSLOT, P_LDS_OST = P_LDS_WS + 8 * 256, P_LDS_TOTAL = P_LDS_OST + 8 * 4096;
__device__ __forceinline__ void attn_unit2(int b, int h, int qb, const bf16* QN, const bf16* QPE, const bf16* KNV, const bf16* KPE, bf16* O, LAS unsigned char* lds, int wave_id) {
    const int tid = fresh_tid(wave_id), lane = tid & 63, r32 = lane & 31, hi = lane >> 5; const int wid = wave_id;
    const bool meta = qb < 0;
    const int rowbase = b * SEQ, q0 = meta ? 0 : qb * 256, qrow = meta ? RMAIN + 16 * b + (r32 & 15) : rowbase + q0 + wid * 32 + r32, qrel = meta ? (r32 & 15) : q0 + wid * 32 + r32;
    bf16x8 qr[6];
#pragma unroll
    for (int d0 = 0; d0 < 4; ++d0) qr[d0] = *(const bf16x8*)(QN + (size_t)qrow * 1024 + h * 64 + d0 * 16 + hi * 8);
#pragma unroll
    for (int d0 = 0; d0 < 2; ++d0) qr[4 + d0] = *(const bf16x8*)(QPE + (size_t)qrow * 512 + h * 32 + d0 * 16 + hi * 8);
    LAS float* wsf = (LAS float*)(lds + P_LDS_WS) + wid * 64;
    const unsigned lds0 = (unsigned)(size_t)lds;
    const int NT = meta ? 0 : 4 * qb + 4;
#define A2_ROW0(t) ((t) == 0 ? (size_t)(RMAIN + 16 * b) : (size_t)(rowbase + 64 * ((t) - 1)))
#define A2_DMA_K(t, ks) do { const size_t row0_ = A2_ROW0(t); \
        glds16(KNV + (row0_ + lane) * 2048 + h * 64 + wid * 8, (unsigned)__builtin_amdgcn_readfirstlane((int)(lds0 + P_LDS_K + (ks) * KSLOT + wid * 1024))); \
        if (wid < 4) glds16(KPE + (row0_ + lane) * 32 + wid * 8, (unsigned)__builtin_amdgcn_readfirstlane((int)(lds0 + P_LDS_K + (ks) * KSLOT + (8 + wid) * 1024))); } while (0)
#define A2_DMA_V(t, vs) do { const size_t row0_ = A2_ROW0(t); \
        glds16(KNV + (row0_ + 16 * (wid & 3) + (lane >> 2)) * 2048 + 1024 + h * 64 + (wid >> 2) * 32 + (lane & 3) * 8, (unsigned)__builtin_amdgcn_readfirstlane((int)(lds0 + P_LDS_V + (vs) * VSLOT + wid * 1024))); } while (0)
#define A2_QKT(P0, P1, ks) do { P0 = f32x16{}; P1 = f32x16{}; const LAS unsigned char* kb_ = lds + P_LDS_K + (ks) * KSLOT + hi * 1024 + r32 * 16; \
        _Pragma("unroll") for (int d0 = 0; d0 < 6; ++d0) { const bf16x8 b0_ = *(const LAS bf16x8*)(kb_ + d0 * 2048), b1_ = *(const LAS bf16x8*)(kb_ + d0 * 2048 + 512); \
            P0 = __builtin_amdgcn_mfma_f32_32x32x16_bf16(b0_, qr[d0], P0, 0, 0, 0); P1 = __builtin_amdgcn_mfma_f32_32x32x16_bf16(b1_, qr[d0], P1, 0, 0, 0); } } while (0)
    f32x16 o[2]; o[0] = f32x16{}; o[1] = f32x16{};
    float mref = -INFINITY, l = 0.f;
#define A2_TILE(P0, P1, t, vs) do { \
        if ((t) == 0) { const int qlim_ = meta ? (r32 & 15) : NMETA - 1; _Pragma("unroll") for (int r = 0; r < 16; ++r) { if (crow(r, hi) > qlim_) P0[r] = -INFINITY; P1[r] = -INFINITY; } } \
        else { const int kt0_ = 64 * ((t) - 1); if (kt0_ + 63 > q0 + wid * 32) { _Pragma("unroll") for (int r = 0; r < 16; ++r) { const int kv = kt0_ + crow(r, hi); if (kv > qrel) P0[r] = -INFINITY; if (kv + 32 > qrel) P1[r] = -INFINITY; } } } \
        float rm_ = fmaxf(P0[0], P1[0]); \
        _Pragma("unroll") for (int r = 1; r < 16; ++r) rm_ = fmaxf(rm_, fmaxf(P0[r], P1[r])); \
        rm_ = pmax32(rm_); \
        if (__any(rm_ > mref + 8.0f)) { const float mnew = fmaxf(mref, rm_); const float f = __builtin_amdgcn_exp2f(mref - mnew); mref = mnew; l *= f; \
            if (hi == 0) wsf[r32] = f; LDS_WAIT(); \
            _Pragma("unroll") for (int r = 0; r < 16; ++r) { const float fr = wsf[crow(r, hi)]; o[0][r] *= fr; o[1][r] *= fr; } } \
        float sacc_ = 0.f; \
        _Pragma("unroll") for (int r = 0; r < 16; ++r) { P0[r] = __builtin_amdgcn_exp2f(P0[r] - mref); P1[r] = __builtin_amdgcn_exp2f(P1[r] - mref); sacc_ += P0[r] + P1[r]; } \
        l += sacc_; \
        u32x4 pw_[4]; \
        _Pragma("unroll") for (int i = 0; i < 4; ++i) { pw_[0][i] = cvtpk(P0[2 * i], P0[2 * i + 1]); pw_[1][i] = cvtpk(P0[8 + 2 * i], P0[8 + 2 * i + 1]); pw_[2][i] = cvtpk(P1[2 * i], P1[2 * i + 1]); pw_[3][i] = cvtpk(P1[8 + 2 * i], P1[8 + 2 * i + 1]); } \
        const LAS unsigned char* vb_ = lds + P_LDS_V + (vs) * VSLOT + ((lane >> 4) & 1) * 32 + (lane & 3) * 8 + (4 * hi + ((lane & 15) >> 2)) * 64; \
        _Pragma("unroll") for (int d0 = 0; d0 < 2; ++d0) _Pragma("unroll") for (int ks = 0; ks < 4; ++ks) { \
            const s16x4 vlo = vtr(vb_ + d0 * 4096 + ks * 1024), vhi = vtr(vb_ + d0 * 4096 + ks * 1024 + 512); \
            const bf16x8 vf = (bf16x8){vlo[0], vlo[1], vlo[2], vlo[3], vhi[0], vhi[1], vhi[2], vhi[3]}; \
            o[d0] = __builtin_amdgcn_mfma_f32_32x32x16_bf16(__builtin_bit_cast(bf16x8, pw_[ks]), vf, o[d0], 0, 0, 0); } } while (0)
    f32x16 pA0, pA1, pB0, pB1;
    A2_DMA_K(0, 0); A2_DMA_V(0, 0); if (NT >= 1) A2_DMA_K(1, 1);
    ATT_WAIT_BAR();
    A2_QKT(pA0, pA1, 0);
    int kc = 0, vc = 0, t = 0;
#define A2_STEP(PC0, PC1, PN0, PN1) do { \
        if (t > 0) ATT_WAIT_BAR(); \
        const int kn_ = kc == 2 ? 0 : kc + 1, k2_ = kn_ == 2 ? 0 : kn_ + 1; \
        if (t + 2 <= NT) A2_DMA_K(t + 2, k2_); \
        if (t + 1 <= NT) { A2_DMA_V(t + 1, vc ^ 1); A2_QKT(PN0, PN1, kn_); } \
        A2_TILE(PC0, PC1, t, vc); \
        kc = kn_; vc ^= 1; ++t; } while (0)
    while (t + 1 <= NT) { A2_STEP(pA0, pA1, pB0, pB1); A2_STEP(pB0, pB1, pA0, pA1); }
    A2_STEP(pA0, pA1, pB0, pB1);
    l = psum32(l);
    if (hi == 0) wsf[32 + r32] = l;
    LDS_WAIT();
    bf16* Ow = O + (size_t)(meta ? RMAIN + 16 * b : rowbase + q0 + wid * 32) * 1024 + h * 64;
    LAS bf16* stg = (LAS bf16*)(lds + P_LDS_OST) + wid * 2048;
#pragma unroll
    for (int r = 0; r < 16; ++r) { const int orow = crow(r, hi); const float il = 1.0f / wsf[32 + orow];
        stg[orow * 64 + r32] = (bf16)f2bf(o[0][r] * il); stg[orow * 64 + 32 + r32] = (bf16)f2bf(o[1][r] * il); }
    LDS_WAIT();
#pragma unroll
    for (int i = 0; i < 4; ++i) { const int row = i * 8 + (lane >> 3), ch = lane & 7; const u32x4 v = *(const LAS u32x4*)(stg + row * 64 + ch * 8); if (!meta || (wid == 0 && row < NMETA)) *(u32x4*)(Ow + (size_t)row * 1024 + ch * 8) = v; }
    ATT_WAIT_BAR();
#undef A2_ROW0
#undef A2_DMA_K
#undef A2_DMA_V
#undef A2_QKT
#undef A2_TILE
#undef A2_STEP
}
__device__ __forceinline__ void attn_phase(const bf16* QN, const bf16* QPE, const bf16* KNV, const bf16* KPE, bf16* O, LAS unsigned char* lds, int wave_id) {
    const int G = gridDim.x, bx = blockIdx.x; const int vcu = (G % 8 == 0) ? (bx % 8) * (G / 8) + bx / 8 : bx;
    for (int v = vcu; v < NB * NH * 4; v += G) {
        const int bh = v >> 2, s0 = v & 3;
#pragma unroll 1
        for (int i = 0; i < 4; ++i) { const int qb = (i == 0) ? 15 - s0 : (i == 1) ? 11 - s0 : (i == 2) ? 4 + s0 : s0; attn_unit2(bh >> 4, bh & 15, qb, QN, QPE, KNV, KPE, O, lds, wave_id); }
        if (v < NB * NH) attn_unit2(v >> 4, v & 15, -1, QN, QPE, KNV, KPE, O, lds, wave_id);
    }
}
}


namespace dec {
using att::bf16x8; using att::s16x4; using att::f32x16; using att::crow; using att::cvtpk; using att::vtr; using att::pmax32; using att::psum32;
constexpr int KST = 592, KBUF = 64 * KST, LDS_K = 0, LDS_Q = 2 * KBUF, LDS_WS = LDS_Q + 64 * KST, LDS_TOTAL = LDS_WS + 8 * 256;
constexpr int NSTAGE = 64;
__device__ __forceinline__ void decode_unit(int db, int sp, ArgsP a, LAS unsigned char* lds, int wave_id) {
    const int tid = fresh_tid(wave_id), lane = tid & 63, r32 = lane & 31, hi = lane >> 5; const int wid = wave_id;
    const int qh = wid & 1, kh = (wid >> 1) & 1, dh = wid >> 2;
    const float* cckv = IN_F(2); const float* ckpe = IN_F(3); const int* pt = (const int*)a->in[5] + db * NPAGES + sp * 32;
    for (int i = tid; i < 64 * 36; i += 512) { const int q = i / 36, ch = i % 36, t = q >> 4, h = q & 15;
        const bf16* src = ch < 32 ? WSB(WS_QLAT) + ((size_t)(db * 4 + t) * 16 + h) * 256 + ch * 8 : WSB(WS_QPE) + (size_t)(RSAMP0 + db * 4 + t) * 512 + h * 32 + (ch - 32) * 8;
        *(LAS u32x4*)(lds + LDS_Q + q * KST + ch * 16) = *(const u32x4*)src; }
    f32x4 cv[8], kv, cw[8], kw;
#define DEC_LOAD(CV, KV, s) do { const int page_ = __builtin_amdgcn_readfirstlane(pt[(s) >> 1]); const size_t k0_ = (size_t)page_ * PAGE + ((s) & 1) * 64; \
        _Pragma("unroll") for (int j = 0; j < 8; ++j) CV[j] = __builtin_nontemporal_load((const f32x4*)(cckv + (k0_ + wid + 8 * j) * 256 + 4 * lane));     \
        KV = __builtin_nontemporal_load((const f32x4*)(ckpe + (k0_ + (tid >> 3)) * 32 + 4 * (tid & 7))); } while (0)
#define DEC_WRITE(CV, KV, buf) do { LAS unsigned char* kb_ = lds + LDS_K + (buf) * KBUF; \
        _Pragma("unroll") for (int j = 0; j < 8; ++j) { u32x2 w_; w_.x = cvtpk(CV[j].x, CV[j].y); w_.y = cvtpk(CV[j].z, CV[j].w); *(LAS u32x2*)(kb_ + (wid + 8 * j) * KST + lane * 8) = w_; } \
        { u32x2 w_; w_.x = cvtpk(KV.x, KV.y); w_.y = cvtpk(KV.z, KV.w); *(LAS u32x2*)(kb_ + (tid >> 3) * KST + 512 + (tid & 7) * 8) = w_; } } while (0)
    LAS float* wsf = (LAS float*)(lds + LDS_WS) + wid * 64;
    f32x16 o[4]; o[0] = f32x16{}; o[1] = f32x16{}; o[2] = f32x16{}; o[3] = f32x16{};
    float mref = -INFINITY, l = 0.f;
#define DEC_BAR() asm volatile("s_waitcnt lgkmcnt(0)\n\ts_barrier" ::: "memory")
    DEC_LOAD(cv, kv, 0); DEC_WRITE(cv, kv, 0); DEC_LOAD(cv, kv, 1); DEC_LOAD(cw, kw, 2);
    DEC_BAR();
#define DEC_COMPUTE(BUF) do { \
        const LAS unsigned char* kimg = lds + LDS_K + (BUF) * KBUF; \
        f32x16 p = f32x16{}; \
        { const LAS unsigned char* kb = kimg + (kh * 32 + r32) * KST + hi * 16; const LAS unsigned char* qb = lds + LDS_Q + (qh * 32 + r32) * KST + hi * 16; \
        _Pragma("unroll") \
          for (int s2 = 0; s2 < 18; ++s2) p = __builtin_amdgcn_mfma_f32_32x32x16_bf16(*(const LAS bf16x8*)(kb + s2 * 32), *(const LAS bf16x8*)(qb + s2 * 32), p, 0, 0, 0); } \
        float rm = p[0]; \
        _Pragma("unroll") \
        for (int r = 1; r < 16; ++r) rm = fmaxf(rm, p[r]); \
        rm = pmax32(rm); \
        if (__any(rm > mref + 8.0f)) { \
            const float mnew = fmaxf(mref, rm); const float f = __builtin_amdgcn_exp2f(mref - mnew); \
            mref = mnew; l *= f; \
            if (hi == 0) wsf[r32] = f; \
            LDS_WAIT(); \
        _Pragma("unroll") \
            for (int r = 0; r < 16; ++r) { const float fr = wsf[crow(r, hi)]; o[0][r] *= fr; o[1][r] *= fr; o[2][r] *= fr; o[3][r] *= fr; } \
        } \
        float sacc = 0.f; \
        _Pragma("unroll") \
        for (int r = 0; r < 16; ++r) { p[r] = __builtin_amdgcn_exp2f(p[r] - mref); sacc += p[r]; } \
        l += sacc; \
        u32x4 pw[2]; \
        _Pragma("unroll") \
        for (int i = 0; i < 4; ++i) { pw[0][i] = cvtpk(p[2 * i], p[2 * i + 1]); pw[1][i] = cvtpk(p[8 + 2 * i], p[8 + 2 * i + 1]); } \
        const LAS unsigned char* vb = kimg + (kh * 32 + 4 * hi + ((lane & 15) >> 2)) * KST + (dh * 128 + 16 * ((lane >> 4) & 1) + 4 * (lane & 3)) * 2; \
        _Pragma("unroll") \
        for (int dt = 0; dt < 4; ++dt) \
        _Pragma("unroll") \
            for (int ks = 0; ks < 2; ++ks) { \
                const s16x4 vlo = vtr(vb + (ks * 16) * KST + dt * 64), vhi = vtr(vb + (ks * 16 + 8) * KST + dt * 64); \
                const bf16x8 vf = (bf16x8){vlo[0], vlo[1], vlo[2], vlo[3], vhi[0], vhi[1], vhi[2], vhi[3]}; \
                o[dt] = __builtin_amdgcn_mfma_f32_32x32x16_bf16(__builtin_bit_cast(bf16x8, pw[ks]), vf, o[dt], 0, 0, 0); \
            } \
    } while (0)
    static_assert(NSTAGE % 2 == 0, "stage loop is unrolled by two");
    for (int s = 0; s < NSTAGE; s += 2) {
        DEC_COMPUTE(0);
        DEC_WRITE(cv, kv, 1); DEC_LOAD(cv, kv, (s + 3 < NSTAGE ? s + 3 : NSTAGE - 1));
        DEC_BAR();
        DEC_COMPUTE(1);
        DEC_WRITE(cw, kw, 0); DEC_LOAD(cw, kw, (s + 4 < NSTAGE ? s + 4 : NSTAGE - 1));
        DEC_BAR();
    }
#undef DEC_COMPUTE
#undef DEC_BAR
    const int part = (db * 2 + sp) * 2 + kh;
    float* op = WSF(WS_OPART) + (size_t)part * 64 * 256;
#pragma unroll
    for (int dt = 0; dt < 4; ++dt)
#pragma unroll
        for (int r = 0; r < 16; ++r) op[(size_t)(qh * 32 + crow(r, hi)) * 256 + dh * 128 + dt * 32 + r32] = o[dt][r];
    l = psum32(l);
    if (dh == 0 && hi == 0) { float* mp = WSF(WS_MLP) + (size_t)part * 128 + (qh * 32 + r32) * 2; mp[0] = mref; mp[1] = l; }
#undef DEC_LOAD
#undef DEC_WRITE
}
struct LaneCtx { int lane, wave; };
__device__ __forceinline__ void combine_item(ArgsP a, int db, int h, const LaneCtx c, LAS unsigned char* lds) {
    {
        f32x4 cn[4]; float en[4];
#pragma unroll
        for (int s2 = 0; s2 < 4; ++s2) { const int kr = RSAMP0 + db * 4 + s2;
            const u32x2 v = *(const u32x2*)(WSB(WS_CKVN) + (size_t)kr * 256 + 4 * c.lane); cn[s2] = (f32x4){bflo(v.x), bfhi(v.x), bflo(v.y), bfhi(v.y)};
            en[s2] = c.lane < 32 ? bf2f(WSB(WS_KPE)[(size_t)kr * 32 + c.lane]) : 0.f; }
        f32x4 res[4];
#pragma unroll
        for (int t = 0; t < 4; ++t) {
            const int i = db * 4 + t, q = t * 16 + h;
            const u32x2 qv = *(const u32x2*)(WSB(WS_QLAT) + ((size_t)i * 16 + h) * 256 + 4 * c.lane); const f32x4 ql = (f32x4){bflo(qv.x), bfhi(qv.x), bflo(qv.y), bfhi(qv.y)};
            const float qp = c.lane < 32 ? bf2f(WSB(WS_QPE)[(size_t)(RSAMP0 + i) * 512 + h * 32 + c.lane]) : 0.f;
            float mp[4], lp[4], dn[4]; float mg = -INFINITY;
#pragma unroll
            for (int p = 0; p < 4; ++p) { const float* ml = WSF(WS_MLP) + (size_t)(db * 4 + p) * 128 + q * 2; mp[p] = ml[0]; lp[p] = ml[1]; mg = fmaxf(mg, mp[p]); }
#pragma unroll
            for (int s2 = 0; s2 < 4; ++s2) {
                float d = (ql.x * cn[s2].x + ql.y * cn[s2].y) + (ql.z * cn[s2].z + ql.w * cn[s2].w) + qp * en[s2];
                d = wave_sum(d); dn[s2] = s2 <= t ? d : -INFINITY; mg = fmaxf(mg, dn[s2]);
            }
            f32x4 acc = (f32x4){0.f, 0.f, 0.f, 0.f}; float L = 0.f;
#pragma unroll
            for (int p = 0; p < 4; ++p) { const float w = exp2f(mp[p] - mg); L += w * lp[p]; acc += w * *(const f32x4*)(WSF(WS_OPART) + ((size_t)(db * 4 + p) * 64 + q) * 256 + 4 * c.lane); }
#pragma unroll
            for (int s2 = 0; s2 < 4; ++s2) { const float w = exp2f(dn[s2] - mg); L += w; acc += w * cn[s2]; }
            res[t] = acc * (1.0f / L);
            __builtin_amdgcn_sched_barrier(0);
        }
        LAS bf16* rt = (LAS bf16*)(lds + 8 * 256 + c.wave * 2048);
#pragma unroll
        for (int t = 0; t < 4; ++t) { u32x2 w; w.x = pk2(res[t].x, res[t].y); w.y = pk2(res[t].z, res[t].w); *(LAS u32x2*)(rt + t * 256 + 4 * c.lane) = w; }
        LDS_WAIT();
        const int r32 = c.lane & 31, hi = c.lane >> 5;
        att::f32x16 o0 = att::f32x16{}, o1 = att::f32x16{};
        const bf16* wb = WSB(WS_WUKV) + (size_t)(1024 + h * 64 + r32) * 256 + 8 * hi;
#pragma unroll
        for (int s = 0; s < 16; ++s) {
            att::bf16x8 af = att::bf16x8{}; if (r32 < 4) af = *(const LAS att::bf16x8*)(rt + r32 * 256 + 16 * s + 8 * hi);
            const att::bf16x8 b0 = *(const att::bf16x8*)(wb + 16 * s), b1 = *(const att::bf16x8*)(wb + 32 * 256 + 16 * s);
            o0 = __builtin_amdgcn_mfma_f32_32x32x16_bf16(af, b0, o0, 0, 0, 0); o1 = __builtin_amdgcn_mfma_f32_32x32x16_bf16(af, b1, o1, 0, 0, 0);
        }
        if (hi == 0) {
#pragma unroll
            for (int t = 0; t < 4; ++t) { bf16* op = WSB(WS_O) + (size_t)(RSAMP0 + db * 4 + t) * 1024 + h * 64 + r32; op[0] = (bf16)f2bf(o0[t]); op[32] = (bf16)f2bf(o1[t]); }
        }
        LDS_WAIT();
    }
}
__device__ __forceinline__ void combine_phase(ArgsP a, const Ctx& c0, LAS unsigned char* lds) {
    const Ctx c = refresh(c0);
    for (int it = c.gw; it < DB * NH; it += c.ngw) combine_item(a, it >> 4, it & 15, LaneCtx{c.lane, c.wave}, lds);
}
__device__ __forceinline__ void decode_phase(ArgsP a, LAS unsigned char* lds, int wave_id) {
    for (int u = blockIdx.x; u < DB * 2; u += gridDim.x) { decode_unit(u >> 1, u & 1, a, lds, wave_id); __syncthreads(); }
}
}

__device__ __forceinline__ void p_side_tables(ArgsP a, const Ctx& c0, LAS unsigned char* lds, int wg0) {
    const Ctx c = refresh(c0);
    const int nwg = (int)gridDim.x - wg0, bx = (int)blockIdx.x - wg0;
    if (bx < 0) return;
    const int gt = (bx * 8 + c.wave) * 64 + c.lane, ngt = nwg * 512;
    {
        const int r32 = c.lane & 31, hi = c.lane >> 5;
        for (int it = bx * 8 + c.wave; it < NH * 64; it += nwg * 8) {
            const int h = it >> 6, ct = (it >> 3) & 7, kt = it & 7;
            const float* ap = IN_F(15) + (size_t)(ct * 32 + r32) * 1024 + h * 64 + 8 * hi;
            const float* bp = IN_F(13) + (size_t)(kt * 32 + r32) * 1536 + h * 96 + 8 * hi;
            att::f32x16 acc = att::f32x16{};
#pragma unroll
            for (int s = 0; s < 4; ++s) {
                const f32x4 a0 = *(const f32x4*)(ap + 16 * s), a1 = *(const f32x4*)(ap + 16 * s + 4), b0 = *(const f32x4*)(bp + 16 * s), b1 = *(const f32x4*)(bp + 16 * s + 4);
                const u32x4 aw = (u32x4){pk2(a0.x, a0.y), pk2(a0.z, a0.w), pk2(a1.x, a1.y), pk2(a1.z, a1.w)}, bw = (u32x4){pk2(b0.x, b0.y), pk2(b0.z, b0.w), pk2(b1.x, b1.y), pk2(b1.z, b1.w)};
                acc = __builtin_amdgcn_mfma_f32_32x32x16_bf16(__builtin_bit_cast(att::bf16x8, aw), __builtin_bit_cast(att::bf16x8, bw), acc, 0, 0, 0);
            }
            bf16* op = WSB(WS_WUQL) + (size_t)(h * 256 + ct * 32) * 256 + kt * 32 + r32;
#pragma unroll
            for (int r = 0; r < 16; ++r) op[(size_t)att::crow(r, hi) * 256] = (bf16)f2bf(acc[r]);
        }
    }
}
__device__ __forceinline__ void p_mla_mid(ArgsP a, const Ctx& c0) {
    const Ctx c = refresh(c0);
    const float* A1 = WSF(WS_A1); bf16* CQN = WSB(WS_CQN); bf16* CKVN = WSB(WS_CKVN); bf16* KPEB = WSB(WS_KPE); const float* ROPE = WSF(WS_ROPE); float* out = a->out;
    const f32x4 gq = *(const f32x4*)(IN_F(12) + 4 * c.lane), gk = *(const f32x4*)(IN_F(14) + 4 * c.lane);
    constexpr int NR = 4;
    for (int r0 = c.gw; r0 < R; r0 += NR * c.ngw) {
        f32x4 cq[NR], ck[NR]; float sq[NR], sk[NR], x1[NR], x2[NR], cs[NR], sn[NR];
#pragma unroll
        for (int q = 0; q < NR; ++q) { const int r = r0 + q * c.ngw < R ? r0 + q * c.ngw : r0; const float* row = A1 + (size_t)r * NIN0;
            cq[q] = *(const f32x4*)(row + 4 * c.lane); ck[q] = *(const f32x4*)(row + 256 + 4 * c.lane);
            const int j = c.lane & 15; x1[q] = row[512 + j]; x2[q] = row[528 + j]; cs[q] = ROPE[(size_t)r * 32 + j]; sn[q] = ROPE[(size_t)r * 32 + 16 + j];
            sq[q] = (cq[q].x * cq[q].x + cq[q].y * cq[q].y) + (cq[q].z * cq[q].z + cq[q].w * cq[q].w); sk[q] = (ck[q].x * ck[q].x + ck[q].y * ck[q].y) + (ck[q].z * ck[q].z + ck[q].w * ck[q].w); }
#pragma unroll
        for (int sh = 1; sh < 64; sh <<= 1) {
#pragma unroll
            for (int q = 0; q < NR; ++q) { sq[q] += __shfl_xor(sq[q], sh); sk[q] += __shfl_xor(sk[q], sh); } }
#pragma unroll
        for (int q = 0; q < NR; ++q) { const int r = r0 + q * c.ngw < R ? r0 + q * c.ngw : r0; const int pos = row_pos(r);
            const float rq = 1.0f / sqrtf(sq[q] * (1.f / 256) + EPS), rk = 1.0f / sqrtf(sk[q] * (1.f / 256) + EPS);
            const f32x4 qn = cq[q] * rq * gq, kn = ck[q] * rk * gk;
            u32x2 o; o.x = pk2(qn.x, qn.y); o.y = pk2(qn.z, qn.w); *(u32x2*)(CQN + (size_t)r * 256 + 4 * c.lane) = o;
            o.x = pk2(kn.x, kn.y); o.y = pk2(kn.z, kn.w); *(u32x2*)(CKVN + (size_t)r * 256 + 4 * c.lane) = o;
            float* ockv; float* okpe;
            if (r < RSAMP0) { const int b = r < RMAIN ? (r >> 12) : ((r - RMAIN) >> 4); ockv = out + O_CKVP + ((size_t)b * TP + pos) * 256; okpe = out + O_KPEP + ((size_t)b * TP + pos) * 32; }
            else { ockv = out + O_CKVS + (size_t)(r - RSAMP0) * 256; okpe = out + O_KPES + (size_t)(r - RSAMP0) * 32; }
            *(f32x4*)(ockv + 4 * c.lane) = kn;
            if (c.lane < 16) { const int j = c.lane; const float o1 = x1[q] * cs[q] - x2[q] * sn[q], o2 = x1[q] * sn[q] + x2[q] * cs[q]; okpe[j] = o1; okpe[16 + j] = o2;
                KPEB[(size_t)r * 32 + j] = (bf16)f2bf(o1); KPEB[(size_t)r * 32 + 16 + j] = (bf16)f2bf(o2); } }
    }
}
__device__ __forceinline__ void p_q_post(ArgsP a, const Ctx& c0) {
    const Ctx c = refresh(c0);
    for (int r = c.gw; r < R; r += c.ngw) {
        const float* row = WSF(WS_QRAW) + (size_t)r * NUQ; const int pos = row_pos(r);
        const float qs = QSCALE;
#pragma unroll
        for (int j = 0; j < 4; ++j) { const f32x4 v = *(const f32x4*)(row + 4 * c.lane + 256 * j) * qs; u32x2 o; o.x = pk2(v.x, v.y); o.y = pk2(v.z, v.w); *(u32x2*)(WSB(WS_QN) + (size_t)r * 1024 + 4 * c.lane + 256 * j) = o; }
#pragma unroll
        for (int j = 0; j < 4; ++j) { const int p = c.lane + 64 * j, h = p >> 4, jj = p & 15; const float x1 = row[1024 + 2 * p], x2 = row[1024 + 2 * p + 1]; float cs, sn; rope_cs(pos, jj, cs, sn);
            WSB(WS_QPE)[(size_t)r * 512 + h * 32 + jj] = (bf16)f2bf((x1 * cs - x2 * sn) * qs); WSB(WS_QPE)[(size_t)r * 512 + h * 32 + 16 + jj] = (bf16)f2bf((x1 * sn + x2 * cs) * qs); }
    }
}
__device__ __forceinline__ void p_qlat(ArgsP a, const Ctx& c0) {
    const Ctx c = refresh(c0);
    const float* wuk = IN_F(15);
    for (int it = c.gw; it < DB * DS * NH; it += c.ngw) {
        const int i = it >> 4, h = it & 15;
        const float q = WSF(WS_QRAW)[(size_t)(RSAMP0 + i) * NUQ + h * 64 + c.lane];
        float acc[4] = {0.f, 0.f, 0.f, 0.f};
#pragma unroll 8
        for (int n = 0; n < 64; ++n) { const float qn = __shfl(q, n);
#pragma unroll
            for (int k = 0; k < 4; ++k) acc[k] += qn * wuk[(size_t)(c.lane + 64 * k) * 1024 + h * 64 + n]; }
#pragma unroll
        for (int k = 0; k < 4; ++k) WSB(WS_QLAT)[((size_t)i * 16 + h) * 256 + c.lane + 64 * k] = (bf16)f2bf(acc[k] * QSCALE);
    }
}
template <bool META_ONLY>
__device__ __forceinline__ void p_attn_prompt_naive(ArgsP a, const Ctx& c0) {
    const Ctx c = refresh(c0);
    const bf16* QN = WSB(WS_QN); const bf16* QPE = WSB(WS_QPE); const bf16* KNV = WSB(WS_KNV); const bf16* KPE = WSB(WS_KPE);
    for (int item = c.gw + (META_ONLY ? (RMAIN / 64) * NH : 0); item < (RPROMPT / 64) * NH; item += c.ngw) {
        const int rb = item >> 4, h = item & 15, r = rb * 64 + c.lane;
        int b, nk;
        if (r < RMAIN) { b = r >> 12; nk = NMETA + (r & 4095) + 1; } else { const int i = r - RMAIN; b = i >> 4; nk = (i & 15) + 1; }
        const int mbase = RMAIN + 16 * b, tbase = 4096 * b;
        float qn[64], qp[32], o[64];
#pragma unroll
        for (int j = 0; j < 8; ++j) { const u32x4 v = *(const u32x4*)(QN + (size_t)r * 1024 + h * 64 + 8 * j);
            qn[8 * j] = bflo(v.x); qn[8 * j + 1] = bfhi(v.x); qn[8 * j + 2] = bflo(v.y); qn[8 * j + 3] = bfhi(v.y); qn[8 * j + 4] = bflo(v.z); qn[8 * j + 5] = bfhi(v.z); qn[8 * j + 6] = bflo(v.w); qn[8 * j + 7] = bfhi(v.w); }
#pragma unroll
        for (int j = 0; j < 4; ++j) { const u32x4 v = *(const u32x4*)(QPE + (size_t)r * 512 + h * 32 + 8 * j);
            qp[8 * j] = bflo(v.x); qp[8 * j + 1] = bfhi(v.x); qp[8 * j + 2] = bflo(v.y); qp[8 * j + 3] = bfhi(v.y); qp[8 * j + 4] = bflo(v.z); qp[8 * j + 5] = bfhi(v.z); qp[8 * j + 6] = bflo(v.w); qp[8 * j + 7] = bfhi(v.w); }
#pragma unroll
        for (int j = 0; j < 64; ++j) o[j] = 0.f;
        float m = -INFINITY, l = 0.f;
        const int nkmax = wave_max_i(nk);
        for (int kk = 0; kk < nkmax; ++kk) {
            if (kk < nk) {
                const int kr = kk < NMETA ? mbase + kk : tbase + kk - NMETA;
                const bf16* kn = KNV + (size_t)kr * 2048 + h * 64; const bf16* kp = KPE + (size_t)kr * 32; const bf16* vv = kn + 1024;
                float s = 0.f;
#pragma unroll
                for (int j = 0; j < 8; ++j) { const u32x4 v = *(const u32x4*)(kn + 8 * j);
                    s += qn[8 * j] * bflo(v.x) + qn[8 * j + 1] * bfhi(v.x) + qn[8 * j + 2] * bflo(v.y) + qn[8 * j + 3] * bfhi(v.y) + qn[8 * j + 4] * bflo(v.z) + qn[8 * j + 5] * bfhi(v.z) + qn[8 * j + 6] * bflo(v.w) + qn[8 * j + 7] * bfhi(v.w); }
#pragma unroll
                for (int j = 0; j < 4; ++j) { const u32x4 v = *(const u32x4*)(kp + 8 * j);
                    s += qp[8 * j] * bflo(v.x) + qp[8 * j + 1] * bfhi(v.x) + qp[8 * j + 2] * bflo(v.y) + qp[8 * j + 3] * bfhi(v.y) + qp[8 * j + 4] * bflo(v.z) + qp[8 * j + 5] * bfhi(v.z) + qp[8 * j + 6] * bflo(v.w) + qp[8 * j + 7] * bfhi(v.w); }
                const float mn = fmaxf(m, s), corr = exp2f(m - mn), p = exp2f(s - mn);
                l = l * corr + p; m = mn;
#pragma unroll
                for (int j = 0; j < 8; ++j) { const u32x4 v = *(const u32x4*)(vv + 8 * j);
                    o[8 * j] = o[8 * j] * corr + p * bflo(v.x); o[8 * j + 1] = o[8 * j + 1] * corr + p * bfhi(v.x); o[8 * j + 2] = o[8 * j + 2] * corr + p * bflo(v.y); o[8 * j + 3] = o[8 * j + 3] * corr + p * bfhi(v.y);
                    o[8 * j + 4] = o[8 * j + 4] * corr + p * bflo(v.z); o[8 * j + 5] = o[8 * j + 5] * corr + p * bfhi(v.z); o[8 * j + 6] = o[8 * j + 6] * corr + p * bflo(v.w); o[8 * j + 7] = o[8 * j + 7] * corr + p * bfhi(v.w); }
            }
        }
        const float il = 1.0f / l;
#pragma unroll
        for (int j = 0; j < 8; ++j) { u32x4 w; w.x = pk2(o[8 * j] * il, o[8 * j + 1] * il); w.y = pk2(o[8 * j + 2] * il, o[8 * j + 3] * il); w.z = pk2(o[8 * j + 4] * il, o[8 * j + 5] * il); w.w = pk2(o[8 * j + 6] * il, o[8 * j + 7] * il);
            *(u32x4*)(WSB(WS_O) + (size_t)r * 1024 + h * 64 + 8 * j) = w; }
    }
}
__device__ __forceinline__ void p_attn_decode_naive(ArgsP a, const Ctx& c0) {
    const Ctx c = refresh(c0);
    const float* cckv = IN_F(2); const float* ckpe = IN_F(3); const int* pt = (const int*)a->in[5];
    for (int item = c.gw; item < DB * NH; item += c.ngw) {
        const int db = item >> 4, h = item & 15;
        f32x4 ql[4]; float qp[4], m[4], l[4]; f32x4 o[4];
#pragma unroll
        for (int t = 0; t < 4; ++t) { const u32x2 v = *(const u32x2*)(WSB(WS_QLAT) + ((size_t)(db * 4 + t) * 16 + h) * 256 + 4 * c.lane);
            ql[t] = (f32x4){bflo(v.x), bfhi(v.x), bflo(v.y), bfhi(v.y)};
            qp[t] = c.lane < 32 ? bf2f(WSB(WS_QPE)[(size_t)(RSAMP0 + db * 4 + t) * 512 + h * 32 + c.lane]) : 0.f;
            m[t] = -INFINITY; l[t] = 0.f; o[t] = (f32x4){0.f, 0.f, 0.f, 0.f}; }
        for (int p = 0; p < NPAGES; ++p) {
            const int page = pt[db * NPAGES + p];
            for (int k = 0; k < PAGE; ++k) {
                const size_t kr = (size_t)page * PAGE + k;
                const f32x4 cv = *(const f32x4*)(cckv + kr * 256 + 4 * c.lane); const float e = c.lane < 32 ? ckpe[kr * 32 + c.lane] : 0.f;
#pragma unroll
                for (int t = 0; t < 4; ++t) {
                    float d = (ql[t].x * cv.x + ql[t].y * cv.y) + (ql[t].z * cv.z + ql[t].w * cv.w) + qp[t] * e;
                    d = wave_sum(d);
                    const float mn = fmaxf(m[t], d), corr = exp2f(m[t] - mn), pp = exp2f(d - mn);
                    l[t] = l[t] * corr + pp; m[t] = mn; o[t] = o[t] * corr + pp * cv;
                }
            }
        }
#pragma unroll
        for (int s2 = 0; s2 < 4; ++s2) {
            const int kr = RSAMP0 + db * 4 + s2;
            const u32x2 v = *(const u32x2*)(WSB(WS_CKVN) + (size_t)kr * 256 + 4 * c.lane); const f32x4 cv = (f32x4){bflo(v.x), bfhi(v.x), bflo(v.y), bfhi(v.y)};
            const float e = c.lane < 32 ? bf2f(WSB(WS_KPE)[(size_t)kr * 32 + c.lane]) : 0.f;
#pragma unroll
            for (int t = 0; t < 4; ++t) if (t >= s2) {
                float d = (ql[t].x * cv.x + ql[t].y * cv.y) + (ql[t].z * cv.z + ql[t].w * cv.w) + qp[t] * e;
                d = wave_sum(d);
                const float mn = fmaxf(m[t], d), corr = exp2f(m[t] - mn), pp = exp2f(d - mn);
                l[t] = l[t] * corr + pp; m[t] = mn; o[t] = o[t] * corr + pp * cv;
            }
        }
#pragma unroll
        for (int t = 0; t < 4; ++t) *(f32x4*)(WSF(WS_OLAT) + ((size_t)(db * 4 + t) * 16 + h) * 256 + 4 * c.lane) = o[t] * (1.0f / l[t]);
    }
}
__device__ __forceinline__ void p_olat_up(ArgsP a, const Ctx& c0) {
    const Ctx c = refresh(c0);
    const float* wuv = IN_F(16);
    for (int it = c.gw; it < DB * DS * NH; it += c.ngw) {
        const int i = it >> 4, h = it & 15; const float* ol = WSF(WS_OLAT) + ((size_t)i * 16 + h) * 256;
        float acc = 0.f;
#pragma unroll 8
        for (int cc = 0; cc < 256; ++cc) acc += ol[cc] * wuv[(size_t)cc * 1024 + h * 64 + c.lane];
        WSB(WS_O)[(size_t)(RSAMP0 + i) * 1024 + h * 64 + c.lane] = (bf16)f2bf(acc);
    }
}
template <bool FINAL, int NSPLIT, bool FIRST = false>
__device__ __forceinline__ void p_post_res(ArgsP a, const Ctx& c0, const float* gpost, const float* gnext) {
    const Ctx c = refresh(c0);
    const bf16* Mb = WSB(WS_M); bf16* X = WSB(WS_X); float* RS = WSF(WS_RSTD); const float* MT = WSF(WS_MT); const float* xin = IN_F(0); float* out = a->out;
    f32x4 gp[4];
#pragma unroll
    for (int j = 0; j < 4; ++j) gp[j] = *(const f32x4*)(gpost + 4 * c.lane + 256 * j);
    constexpr int NR = 4;
    for (int r0 = c.gw; r0 < RMAIN; r0 += NR * c.ngw) {
        f32x4 mv[NR][4], xv[NR][4]; float s[NR], s2[NR];
#pragma unroll
        for (int q = 0; q < NR; ++q) { const int r = r0 + q * c.ngw < RMAIN ? r0 + q * c.ngw : r0;
            s[q] = 0.f;
#pragma unroll
            for (int j = 0; j < 4; ++j) { const u32x2 mb = __builtin_nontemporal_load((const u32x2*)(Mb + (size_t)r * D + 4 * c.lane + 256 * j)); mv[q][j] = (f32x4){bflo(mb.x), bfhi(mb.x), bflo(mb.y), bfhi(mb.y)};
                if (FIRST) xv[q][j] = *(const f32x4*)(xin + (size_t)r * D + 4 * c.lane + 256 * j); else { const u32x2 xb = *(const u32x2*)(X + (size_t)r * D + 4 * c.lane + 256 * j); xv[q][j] = (f32x4){bflo(xb.x), bfhi(xb.x), bflo(xb.y), bfhi(xb.y)}; }
                s[q] += (mv[q][j].x * mv[q][j].x + mv[q][j].y * mv[q][j].y) + (mv[q][j].z * mv[q][j].z + mv[q][j].w * mv[q][j].w); } }
#pragma unroll
        for (int o = 1; o < 64; o <<= 1) {
#pragma unroll
            for (int q = 0; q < NR; ++q) s[q] += __shfl_xor(s[q], o); }
#pragma unroll
        for (int q = 0; q < NR; ++q) { const float rm = 1.0f / sqrtf(s[q] * (1.f / D) + EPS); s2[q] = 0.f;
#pragma unroll
            for (int j = 0; j < 4; ++j) { xv[q][j] = xv[q][j] + mv[q][j] * rm * gp[j]; s2[q] += (xv[q][j].x * xv[q][j].x + xv[q][j].y * xv[q][j].y) + (xv[q][j].z * xv[q][j].z + xv[q][j].w * xv[q][j].w); } }
        if (!FINAL) {
#pragma unroll
            for (int o = 1; o < 64; o <<= 1) {
#pragma unroll
                for (int q = 0; q < NR; ++q) s2[q] += __shfl_xor(s2[q], o); }
        }
#pragma unroll
        for (int q = 0; q < NR; ++q) { const int r = r0 + q * c.ngw < RMAIN ? r0 + q * c.ngw : r0;
            if (FINAL) {
#pragma unroll
                for (int j = 0; j < 4; ++j) __builtin_nontemporal_store(xv[q][j], (f32x4*)(out + O_YP + (size_t)r * D + 4 * c.lane + 256 * j));
            } else { const float rx = 1.0f / sqrtf(s2[q] * (1.f / D) + EPS);
                if (c.lane == 0) RS[r] = rx;
#pragma unroll
                for (int j = 0; j < 4; ++j) { u32x2 xo; xo.x = pk2(xv[q][j].x, xv[q][j].y); xo.y = pk2(xv[q][j].z, xv[q][j].w); *(u32x2*)(X + (size_t)r * D + 4 * c.lane + 256 * j) = xo; } } }
    }
    for (int r = RMAIN + c.gw; r < R; r += c.ngw) {
        bf16* xrow = X + (size_t)r * D;
        f32x4 mv[4], xv[4]; float s = 0.f;
#pragma unroll
        for (int j = 0; j < 4; ++j) { mv[j] = (f32x4){0.f, 0.f, 0.f, 0.f};
#pragma unroll
            for (int h8 = 0; h8 < NSPLIT; h8 += 8) { f32x4 part[8];
#pragma unroll
                for (int sp = 0; sp < 8; ++sp) part[sp] = *(const f32x4*)(MT + ((size_t)(h8 + sp) * (RP - RMAIN) + (r - RMAIN)) * D + 4 * c.lane + 256 * j);
#pragma unroll
                for (int sp = 0; sp < 8; ++sp) mv[j] += part[sp]; }
            { const u32x2 xb = *(const u32x2*)(xrow + 4 * c.lane + 256 * j); xv[j] = (f32x4){bflo(xb.x), bfhi(xb.x), bflo(xb.y), bfhi(xb.y)}; } s += (mv[j].x * mv[j].x + mv[j].y * mv[j].y) + (mv[j].z * mv[j].z + mv[j].w * mv[j].w); }
        const float rm = 1.0f / sqrtf(wave_sum(s) * (1.f / D) + EPS); float s2 = 0.f;
#pragma unroll
        for (int j = 0; j < 4; ++j) { xv[j] = xv[j] + mv[j] * rm * gp[j]; s2 += (xv[j].x * xv[j].x + xv[j].y * xv[j].y) + (xv[j].z * xv[j].z + xv[j].w * xv[j].w); }
        if (FINAL) {
            if (r < RSAMP0) continue;
#pragma unroll
            for (int j = 0; j < 4; ++j) *(f32x4*)(out + O_YS + (size_t)(r - RSAMP0) * D + 4 * c.lane + 256 * j) = xv[j];
        } else {
            const float rx = 1.0f / sqrtf(wave_sum(s2) * (1.f / D) + EPS);
            if (c.lane == 0) RS[r] = rx;
#pragma unroll
            for (int j = 0; j < 4; ++j) { u32x2 xo; xo.x = pk2(xv[j].x, xv[j].y); xo.y = pk2(xv[j].z, xv[j].w); *(u32x2*)(xrow + 4 * c.lane + 256 * j) = xo; }
        }
    }
}

__device__ __forceinline__ void p_gate(ArgsP a, const Ctx& c0) {
    const Ctx c = refresh(c0);
    const float* wg = IN_F(19); const float* bg = IN_F(20);
    const size_t gt = (size_t)c.gw * 64 + c.lane, ngt = (size_t)c.ngw * 64;
    for (size_t i = gt + (size_t)(USE_NAIVE_GLA ? 0 : RSAMP0) * 512; i < (size_t)R * 512; i += ngt) {
        const int r = (int)(i >> 9), col = (int)(i & 511); const float* gd = WSF(WS_GD) + (size_t)r * 16;
        float x = bg[col];
#pragma unroll
        for (int j = 0; j < 16; ++j) x += gd[j] * wg[j * 512 + col];
        const float ls = fminf(x, 0.f) - log1pf(__expf(-fabsf(x)));
        const float la = ls * (1.0f / 16.0f);
        WSF(WS_LA)[i] = la; WSF(WS_EA)[i] = __expf(la);
    }
}
__device__ __forceinline__ void gla_step(float (&S)[128], float& o, float a0, float a1, float k0, float k1, float q0, float q1, float v) {
    o = 0.f;
#pragma unroll
    for (int d = 0; d < 64; ++d) { const float ad = rdlane(a0, d), kd = rdlane(k0, d), qd = rdlane(q0, d); S[d] = ad * S[d] + kd * v; o += qd * S[d]; }
#pragma unroll
    for (int d = 0; d < 64; ++d) { const float ad = rdlane(a1, d), kd = rdlane(k1, d), qd = rdlane(q1, d); S[64 + d] = ad * S[64 + d] + kd * v; o += qd * S[64 + d]; }
}
__device__ __forceinline__ void p_gla_naive(ArgsP a, const Ctx& c0) {
    const Ctx c = refresh(c0);
    const float* EA = WSF(WS_EA); const bf16* KG = WSB(WS_KG); const bf16* QG = WSB(WS_QG); const bf16* VG = WSB(WS_VG); float* OGR = WSF(WS_OGRAW);
    for (int item = c.gwT; item < (USE_NAIVE_GLA ? NB * GH * 4 : 0); item += c.ngw) {
        const int b = item >> 4, h = (item >> 2) & 3, dv = (item & 3) * 64 + c.lane;
        float S[128];
#pragma unroll
        for (int d = 0; d < 128; ++d) S[d] = 0.f;
        for (int tt = 0; tt < TP; ++tt) {
            const int row = tt < NMETA ? RMAIN + 16 * b + tt : 4096 * b + tt - NMETA;
            const size_t g = (size_t)row * 512 + h * 128;
            const float a0 = EA[g + c.lane], a1 = EA[g + 64 + c.lane], k0 = bf2f(KG[g + c.lane]), k1 = bf2f(KG[g + 64 + c.lane]), q0 = bf2f(QG[g + c.lane]), q1 = bf2f(QG[g + 64 + c.lane]);
            const float v = bf2f(VG[(size_t)row * 1024 + h * 256 + dv]);
            float o; gla_step(S, o, a0, a1, k0, k1, q0, q1, v);
            OGR[(size_t)row * 1024 + h * 256 + dv] = o;
        }
        float* outp = a->out + O_GLAP + ((size_t)(b * 4 + h) * 128) * 256 + dv;
#pragma unroll
        for (int d = 0; d < 128; ++d) outp[(size_t)d * 256] = S[d];
    }
    const int wg0 = USE_NAIVE_GLA ? 0 : NB * GH * gla::NSP; if ((int)blockIdx.x < wg0) return;
    for (int item = c.wave * ((int)gridDim.x - wg0) + ((int)blockIdx.x - wg0); item < DB * GH * 4; item += c.ngw - wg0 * 8) {
        const int db = item >> 4, h = (item >> 2) & 3, dv = (item & 3) * 64 + c.lane;
        const float* sp = IN_F(4) + ((size_t)(db * 4 + h) * 128) * 256 + dv;
        float S[128];
#pragma unroll
        for (int d = 0; d < 128; ++d) S[d] = sp[(size_t)d * 256];
#pragma unroll 1
        for (int s = 0; s < DS; ++s) {
            const int row = RSAMP0 + db * 4 + s; const size_t g = (size_t)row * 512 + h * 128;
            const float a0 = EA[g + c.lane], a1 = EA[g + 64 + c.lane], k0 = bf2f(KG[g + c.lane]), k1 = bf2f(KG[g + 64 + c.lane]), q0 = bf2f(QG[g + c.lane]), q1 = bf2f(QG[g + 64 + c.lane]);
            const float v = bf2f(VG[(size_t)row * 1024 + h * 256 + dv]);
            float o; gla_step(S, o, a0, a1, k0, k1, q0, q1, v);
            OGR[(size_t)row * 1024 + h * 256 + dv] = o;
        }
        float* outp = a->out + O_GLAS + ((size_t)(db * 4 + h) * 128) * 256 + dv;
#pragma unroll
        for (int d = 0; d < 128; ++d) outp[(size_t)d * 256] = S[d];
    }
}
__device__ __forceinline__ void p_gla_post(ArgsP a, const Ctx& c0) {
    const Ctx c = refresh(c0);
    const bf16* OGR = WSB(WS_OGRAW); const bf16* RG = WSB(WS_RG); bf16* OG = WSB(WS_OG);
    const f32x4 g = *(const f32x4*)(IN_F(21) + 4 * c.lane);
    constexpr int NR = 2;
    static_assert(R % NR == 0, "row groups are whole");
    for (int r0 = NR * c.gw; r0 < R; r0 += NR * c.ngw) {
        f32x4 o[NR][4]; u32x2 rv[NR][4]; float s[NR][4];
#pragma unroll
        for (int q = 0; q < NR; ++q) { const int r = r0 + q;
#pragma unroll
            for (int h = 0; h < 4; ++h) { const size_t off = (size_t)r * 1024 + h * 256 + 4 * c.lane;
                const u32x2 ob = __builtin_nontemporal_load((const u32x2*)(OGR + ((size_t)(h * 8 + (c.lane >> 3)) * RP + r) * 32 + 4 * (c.lane & 7))); o[q][h] = (f32x4){bflo(ob.x), bfhi(ob.x), bflo(ob.y), bfhi(ob.y)}; rv[q][h] = __builtin_nontemporal_load((const u32x2*)(RG + off));
                s[q][h] = (o[q][h].x * o[q][h].x + o[q][h].y * o[q][h].y) + (o[q][h].z * o[q][h].z + o[q][h].w * o[q][h].w); } }
#pragma unroll
        for (int sh = 1; sh < 64; sh <<= 1) {
#pragma unroll
            for (int q = 0; q < NR; ++q)
#pragma unroll
                for (int h = 0; h < 4; ++h) s[q][h] += __shfl_xor(s[q][h], sh); }
#pragma unroll
        for (int q = 0; q < NR; ++q) { const int r = r0 + q;
#pragma unroll
            for (int h = 0; h < 4; ++h) { const size_t off = (size_t)r * 1024 + h * 256 + 4 * c.lane;
                const float rs = 1.0f / sqrtf(s[q][h] * (1.f / 256) + EPS);
                const f32x4 rr = (f32x4){bflo(rv[q][h].x), bfhi(rv[q][h].x), bflo(rv[q][h].y), bfhi(rv[q][h].y)};
                f32x4 sl; sl.x = rr.x / (1.f + __expf(-rr.x)); sl.y = rr.y / (1.f + __expf(-rr.y)); sl.z = rr.z / (1.f + __expf(-rr.z)); sl.w = rr.w / (1.f + __expf(-rr.w));
                const f32x4 y = o[q][h] * rs * g * sl;
                u32x2 w; w.x = pk2(y.x, y.y); w.y = pk2(y.z, y.w); *(u32x2*)(OG + off) = w; } }
    }
}


namespace gla {
using att::bf16x8; using att::f32x16; using att::crow; using att::cvtpk;
constexpr int NCH = 65, NITEM = NB * GH * NCH;
constexpr int P_GD = 0, P_GSUM = 4096, P_QL = 6144, P_KL = P_QL + 64 * 272, P_VS = P_KL + 64 * 272, P_AL = P_VS + 64 * 528, P_END = P_AL + 64 * 144;
__device__ __forceinline__ int chunk_row(int b, int c, int tok) { return c == 0 ? RMAIN + 16 * b + tok : 4096 * b + 64 * (c - 1) + tok; }
__device__ __forceinline__ float logsig16(float x) { return (fminf(x, 0.f) - __logf(1.0f + __expf(-fabsf(x)))) * (1.0f / 16.0f); }
struct PrepRegs { u32x4 q[2], k[2], v[4]; f32x4 gd; };
__device__ __forceinline__ void prep_load(ArgsP a, int item, int tid, PrepRegs& R) {
    const int bh = item / NCH, c = item % NCH, b = bh >> 2, h = bh & 3; const int nvalid = c == 0 ? NMETA : 64;
    const u32x4 z4 = (u32x4){0u, 0u, 0u, 0u};
#pragma unroll
    for (int j = 0; j < 2; ++j) { const int idx = tid + 512 * j, row = idx >> 4, ch = idx & 15; const bool ok = row < nvalid; const size_t g = (size_t)chunk_row(b, c, ok ? row : 0) * 512 + h * 128 + ch * 8;
        R.q[j] = ok ? __builtin_nontemporal_load((const u32x4*)(WSB(WS_QG) + g)) : z4; R.k[j] = ok ? __builtin_nontemporal_load((const u32x4*)(WSB(WS_KG) + g)) : z4; }
#pragma unroll
    for (int j = 0; j < 4; ++j) { const int idx = tid + 512 * j, row = idx >> 5, ch = idx & 31; const bool ok = row < nvalid;
        R.v[j] = ok ? __builtin_nontemporal_load((const u32x4*)(WSB(WS_VG) + (size_t)chunk_row(b, c, ok ? row : 0) * 1024 + h * 256 + ch * 8)) : z4; }
    { const int row = (tid & 255) >> 2, ch = tid & 3; const bool ok = row < nvalid; R.gd = ok ? *(const f32x4*)(WSF(WS_GD) + (size_t)chunk_row(b, c, ok ? row : 0) * 16 + ch * 4) : (f32x4){0.f, 0.f, 0.f, 0.f}; }
}
#define PREP_BAR() asm volatile("s_waitcnt lgkmcnt(0)\n\ts_barrier" ::: "memory")
__device__ __forceinline__ void prep_item(ArgsP a, int item, int next_item, PrepRegs& R, LAS unsigned char* lds, int wave_id) {
    const int tid = fresh_tid(wave_id), lane = tid & 63, r32 = lane & 31, hi = lane >> 5; const int wid = wave_id;
    const int bh = item / NCH, c = item % NCH, b = bh >> 2, h = bh & 3;
    const int nvalid = c == 0 ? NMETA : 64;
    bf16* QINF = WSB(WS_QINF) + (size_t)item * 8192; bf16* KDTF = WSB(WS_KDTF) + (size_t)item * 8192; bf16* AMF = WSB(WS_AMF) + (size_t)item * 4096; bf16* VTF = WSB(WS_VTF) + (size_t)item * 16384; float* ELF = WSF(WS_ELF) + (size_t)item * 256;
    LAS float* GDL = (LAS float*)(lds + P_GD); LAS float* GSUM = (LAS float*)(lds + P_GSUM); LAS bf16* QL = (LAS bf16*)(lds + P_QL); LAS bf16* KL = (LAS bf16*)(lds + P_KL); LAS bf16* VS = (LAS bf16*)(lds + P_VS); LAS bf16* AL = (LAS bf16*)(lds + P_AL);
#pragma unroll
    for (int j = 0; j < 2; ++j) { const int idx = tid + 512 * j, row = idx >> 4, ch = idx & 15; *(LAS u32x4*)(QL + row * 136 + ch * 8) = R.q[j]; *(LAS u32x4*)(KL + row * 136 + ch * 8) = R.k[j]; }
#pragma unroll
    for (int j = 0; j < 4; ++j) { const int idx = tid + 512 * j, row = idx >> 5, ch = idx & 31; *(LAS u32x4*)(VS + row * 264 + ch * 8) = R.v[j]; }
    if (tid < 256) { const int row = tid >> 2, ch = tid & 3; *(LAS f32x4*)(GDL + row * 16 + ch * 4) = R.gd; }
    if (next_item < NITEM) prep_load(a, next_item, tid, R);
    PREP_BAR();
    const int dk = tid & 127, tg = tid >> 7;
    float bloc[16];
    {
        float w[16]; const float* wg = IN_F(19) + h * 128 + dk;
#pragma unroll
        for (int j = 0; j < 16; ++j) w[j] = wg[j * 512];
        const float bg = IN_F(20)[h * 128 + dk];
        float run = 0.f;
#pragma unroll
        for (int i = 0; i < 16; ++i) {
            const int tok = tg * 16 + i; float x = bg;
#pragma unroll
            for (int j4 = 0; j4 < 4; ++j4) { const f32x4 gd = *(const LAS f32x4*)(GDL + tok * 16 + j4 * 4); x += gd.x * w[4 * j4] + gd.y * w[4 * j4 + 1] + gd.z * w[4 * j4 + 2] + gd.w * w[4 * j4 + 3]; }
            const float g = tok < nvalid ? logsig16(x) : 0.f;
            run += g; bloc[i] = run;
        }
        GSUM[tg * 128 + dk] = run;
    }
    PREP_BAR();
    float off = 0.f, blast = 0.f;
#pragma unroll
    for (int t = 0; t < 4; ++t) { const float s = GSUM[t * 128 + dk]; if (t < tg) off += s; blast += s; }
    {
        unsigned kdp[8];
#pragma unroll
        for (int i = 0; i < 16; i += 2) {
            float kd2[2];
#pragma unroll
            for (int e = 0; e < 2; ++e) {
                const int tok = tg * 16 + i + e; const float bb = bloc[i + e] + off; const float q = bf2f(QL[tok * 136 + dk]), k = bf2f(KL[tok * 136 + dk]);
                QL[tok * 136 + dk] = (bf16)f2bf(q * __expf(bb)); KL[tok * 136 + dk] = (bf16)f2bf(k * __expf(-bb)); kd2[e] = k * __expf(blast - bb);
            }
            kdp[i >> 1] = pk2(kd2[0], kd2[1]);
        }
        bf16* kp = KDTF + ((size_t)(((dk >> 5) * 4 + tg) * 64) + (dk & 31)) * 8;
        *(u32x4*)(kp) = (u32x4){kdp[0], kdp[1], kdp[2], kdp[3]}; *(u32x4*)(kp + 32 * 8) = (u32x4){kdp[4], kdp[5], kdp[6], kdp[7]};
        if (tg == 0) ELF[dk] = __expf(blast);
    }
    {
        const int dv = tid & 255, half = tid >> 8;
#pragma unroll
        for (int u = 0; u < 4; ++u) {
            unsigned pk[4];
#pragma unroll
            for (int e = 0; e < 4; ++e) { const int tok = half * 32 + u * 8 + e * 2; pk[e] = (unsigned)VS[tok * 264 + dv] | ((unsigned)VS[(tok + 1) * 264 + dv] << 16); }
            const int s = 2 * half + (u >> 1), uh = u & 1;
            *(u32x4*)(VTF + ((size_t)(((dv >> 5) * 4 + s) * 64) + uh * 32 + (dv & 31)) * 8) = (u32x4){pk[0], pk[1], pk[2], pk[3]};
        }
    }
    PREP_BAR();
#pragma unroll
    for (int uu = 0; uu < 2; ++uu) {
        const int U = tid + 512 * uu, lp = U & 63, s8 = (U >> 6) & 7, tt = U >> 9; const int tok = tt * 32 + (lp & 31), hh = lp >> 5;
        const u32x2 lo = *(const LAS u32x2*)(QL + tok * 136 + 16 * s8 + 4 * hh), hi2 = *(const LAS u32x2*)(QL + tok * 136 + 16 * s8 + 8 + 4 * hh);
        *(u32x4*)(QINF + (size_t)U * 8) = (u32x4){lo.x, lo.y, hi2.x, hi2.y};
    }
    if (wid < 3) {
        const int tt = wid == 0 ? 0 : 1, tp = wid == 2 ? 1 : 0;
        f32x16 acc = f32x16{};
#pragma unroll
        for (int s = 0; s < 8; ++s) {
            const bf16x8 af = *(const LAS bf16x8*)(QL + (tt * 32 + r32) * 136 + 16 * s + 8 * hi), bfr = *(const LAS bf16x8*)(KL + (tp * 32 + r32) * 136 + 16 * s + 8 * hi);
            acc = __builtin_amdgcn_mfma_f32_32x32x16_bf16(af, bfr, acc, 0, 0, 0);
        }
#pragma unroll
        for (int r = 0; r < 16; ++r) { const int tok = tt * 32 + crow(r, hi), tk = tp * 32 + r32; AL[tok * 72 + tk] = (bf16)f2bf(tk <= tok ? acc[r] : 0.f); }
    } else if (wid == 3) {
#pragma unroll
        for (int r = 0; r < 16; ++r) AL[crow(r, hi) * 72 + 32 + r32] = 0;
    }
    PREP_BAR();
    { const int U = tid, lp = U & 63, s = (U >> 6) & 3, tt = U >> 8; const int tok = tt * 32 + (lp & 31), hh = lp >> 5;
      *(u32x4*)(AMF + (size_t)U * 8) = *(const LAS u32x4*)(AL + tok * 72 + 16 * s + 8 * hh); }
    PREP_BAR();
}
constexpr int SM_A = 0, SM_K = 2048, SM_Q = 4096, SM_V = 6144, SM_O = 10240, SM_END = SM_O + 4 * 2 * 256 * 4;
__device__ __forceinline__ void sample_item(ArgsP a, int item, LAS unsigned char* lds, int wave_id) {
    const int tid = fresh_tid(wave_id);
    const int db = item >> 2, h = item & 3;
    LAS float* AS = (LAS float*)(lds + SM_A); LAS float* KS = (LAS float*)(lds + SM_K); LAS float* QS = (LAS float*)(lds + SM_Q); LAS float* VSm = (LAS float*)(lds + SM_V); LAS float* OS = (LAS float*)(lds + SM_O);
    { const int s = tid >> 7, dk = tid & 127, row = RSAMP0 + db * 4 + s; const float* gd = WSF(WS_GD) + (size_t)row * 16; const float* wg = IN_F(19) + h * 128 + dk;
      float x = IN_F(20)[h * 128 + dk];
#pragma unroll
      for (int j = 0; j < 16; ++j) x += gd[j] * wg[j * 512];
      AS[s * 128 + dk] = __expf(logsig16(x));
      const size_t g = (size_t)row * 512 + h * 128 + dk; KS[s * 128 + dk] = bf2f(WSB(WS_KG)[g]); QS[s * 128 + dk] = bf2f(WSB(WS_QG)[g]);
#pragma unroll
      for (int j = 0; j < 2; ++j) { const int e = tid + 512 * j, s2 = e >> 8, dv2 = e & 255; VSm[s2 * 256 + dv2] = bf2f(WSB(WS_VG)[(size_t)(RSAMP0 + db * 4 + s2) * 1024 + h * 256 + dv2]); } }
    const int dv = tid & 255, kh = tid >> 8;
    const unsigned voff = (unsigned)(kh * 64 * 256 + dv) * 4u;
    const unsigned char* sbase = (const unsigned char*)(IN_F(4) + (size_t)(db * 4 + h) * 128 * 256);
    __syncthreads();
    float S[64];
#pragma unroll
    for (int d4 = 0; d4 < 16; ++d4) { const GAS unsigned char* bp = (const GAS unsigned char*)sbase + d4 * 4096; asm volatile("" : "+s"(bp));
#pragma unroll
        for (int e = 0; e < 4; ++e) S[4 * d4 + e] = __builtin_nontemporal_load((const GAS float*)(bp + e * 1024 + voff)); }
#pragma unroll 1
    for (int s = 0; s < 4; ++s) {
        const float v = VSm[s * 256 + dv]; float o = 0.f;
#pragma unroll
        for (int d4 = 0; d4 < 16; ++d4) {
            if ((d4 & 3) == 0) __builtin_amdgcn_sched_barrier(0);
            const f32x4 av = *(const LAS f32x4*)(AS + s * 128 + kh * 64 + 4 * d4), kv = *(const LAS f32x4*)(KS + s * 128 + kh * 64 + 4 * d4), qv = *(const LAS f32x4*)(QS + s * 128 + kh * 64 + 4 * d4);
            S[4 * d4] = av.x * S[4 * d4] + kv.x * v; o += qv.x * S[4 * d4]; S[4 * d4 + 1] = av.y * S[4 * d4 + 1] + kv.y * v; o += qv.y * S[4 * d4 + 1];
            S[4 * d4 + 2] = av.z * S[4 * d4 + 2] + kv.z * v; o += qv.z * S[4 * d4 + 2]; S[4 * d4 + 3] = av.w * S[4 * d4 + 3] + kv.w * v; o += qv.w * S[4 * d4 + 3];
        }
        OS[(s * 2 + kh) * 256 + dv] = o;
    }
    unsigned char* obase = (unsigned char*)(a->out + O_GLAS + (size_t)(db * 4 + h) * 128 * 256);
#pragma unroll
    for (int d4 = 0; d4 < 16; ++d4) { GAS unsigned char* bp = (GAS unsigned char*)obase + d4 * 4096; asm volatile("" : "+s"(bp));
#pragma unroll
        for (int e = 0; e < 4; ++e) __builtin_nontemporal_store(S[4 * d4 + e], (GAS float*)(bp + e * 1024 + voff)); }
    __syncthreads();
#pragma unroll
    for (int j = 0; j < 2; ++j) { const int e = tid + 512 * j, s2 = e >> 8, dv2 = e & 255; WSB(WS_OGRAW)[((size_t)(h * 8 + (dv2 >> 5)) * RP + (RSAMP0 + db * 4 + s2)) * 32 + (dv2 & 31)] = (bf16)f2bf(OS[(s2 * 2) * 256 + dv2] + OS[(s2 * 2 + 1) * 256 + dv2]); }
    __syncthreads();
}
__device__ __forceinline__ void prep_phase(ArgsP a, LAS unsigned char* lds, int wave_id) {
    { PrepRegs R; if ((int)blockIdx.x < NITEM) prep_load(a, (int)blockIdx.x, fresh_tid(wave_id), R);
      for (int item = blockIdx.x; item < NITEM; item += gridDim.x) prep_item(a, item, item + (int)gridDim.x, R, lds, wave_id); }
}
constexpr int S_QIN = 0, S_KDT = 16384, S_AM = 32768, S_EL = 40960, S_VT = 41984, S_SLOT = S_VT + 4096;
constexpr int S_X = 3 * S_SLOT, S_END = S_X + 2 * 8192;
static_assert(S_END <= MISC_OFF, "scan ring + state exchange fit under the control words");
constexpr int NPIECE = 45, NHELP = 5, NDMA = (NPIECE + NHELP - 1) / NHELP;
__device__ __forceinline__ void scan_bh(ArgsP a, int bh, int part, LAS unsigned char* lds, int wave_id) {
    const int tid = fresh_tid(wave_id), lane = tid & 63, r32 = lane & 31, hi = lane >> 5; const int wid = wave_id;
    const int b = bh >> 2, h = bh & 3, ds = part;
    const unsigned char* const pq = (const unsigned char*)(WSB(WS_QINF) + (size_t)bh * NCH * 8192); const unsigned char* const pk = (const unsigned char*)(WSB(WS_KDTF) + (size_t)bh * NCH * 8192);
    const unsigned char* const pa = (const unsigned char*)(WSB(WS_AMF) + (size_t)bh * NCH * 4096); const unsigned char* const pe = (const unsigned char*)(WSF(WS_ELF) + (size_t)bh * NCH * 256);
    const unsigned char* const pv = (const unsigned char*)(WSB(WS_VTF) + (size_t)bh * NCH * 16384) + part * 4096;
    LAS unsigned char* const X = lds + S_X;
#define GLA_BAR() asm volatile("s_waitcnt lgkmcnt(0)\n\ts_barrier" ::: "memory")
#define GLA_QF(tt, k8) (*(const LAS bf16x8*)(sb + S_QIN + ((tt) * 8 + (k8)) * 1024 + lane * 16))
#define GLA_KF(T, s) (*(const LAS bf16x8*)(sb + S_KDT + ((T) * 4 + (s)) * 1024 + lane * 16))
#define GLA_AF(tt, s) (*(const LAS bf16x8*)(sb + S_AM + ((tt) * 4 + (s)) * 1024 + lane * 16))
    if (wid >= 3) {
#define GLA_DMA(c_, slot_) do { const size_t c64_ = (size_t)(c_); \
        _Pragma("unroll") for (int k_ = 0; k_ < NDMA; ++k_) { int i_ = (wid - 3) + NHELP * k_; i_ = i_ < NPIECE ? i_ : 40; const unsigned char* g_; int lo_; \
            if (i_ < 16) { g_ = pq + c64_ * 16384 + i_ * 1024; lo_ = S_QIN + i_ * 1024; } \
            else if (i_ < 32) { g_ = pk + c64_ * 16384 + (i_ - 16) * 1024; lo_ = S_KDT + (i_ - 16) * 1024; } \
            else if (i_ < 40) { g_ = pa + c64_ * 8192 + (i_ - 32) * 1024; lo_ = S_AM + (i_ - 32) * 1024; } \
            else if (i_ == 40) { g_ = pe + c64_ * 1024; lo_ = S_EL; } \
            else { g_ = pv + c64_ * 32768 + (i_ - 41) * 1024; lo_ = S_VT + (i_ - 41) * 1024; } \
            __builtin_amdgcn_global_load_lds((const unsigned*)(g_ + lane * 16), (LAS unsigned*)(lds + (slot_) * S_SLOT + lo_), 16, 0, 0); } } while (0)
        GLA_DMA(0, 0); GLA_DMA(1, 1);
        for (int c = 0; c < NCH; ++c) {
            if (c + 1 < NCH) asm volatile("s_waitcnt vmcnt(%0)" :: "n"(NDMA) : "memory"); else asm volatile("s_waitcnt vmcnt(0)" ::: "memory");
            GLA_BAR();
            if (c + 2 < NCH) GLA_DMA(c + 2, (c + 2) % 3);
        }
#undef GLA_DMA
    } else if (wid == 2) {
        f32x16 S[4]; S[0] = f32x16{}; S[1] = f32x16{}; S[2] = f32x16{}; S[3] = f32x16{};
#pragma unroll
        for (int k = 0; k < 8; ++k) *(LAS u32x4*)(X + k * 1024 + lane * 16) = (u32x4){0u, 0u, 0u, 0u};
        for (int c = 0; c < NCH; ++c) {
            GLA_BAR();
            const LAS unsigned char* sb = lds + (c % 3) * S_SLOT;
            bf16x8 vf[4];
#pragma unroll
            for (int s = 0; s < 4; ++s) vf[s] = *(const LAS bf16x8*)(sb + S_VT + s * 1024 + lane * 16);
            bf16x8 KA[4], KB[4];
#define GLA_LK(F, s) do { F[0] = GLA_KF(0, s); F[1] = GLA_KF(1, s); F[2] = GLA_KF(2, s); F[3] = GLA_KF(3, s); } while (0)
#define GLA_MK(F, s) do { _Pragma("unroll") for (int T = 0; T < 4; ++T) S[T] = __builtin_amdgcn_mfma_f32_32x32x16_bf16(F[T], vf[s], S[T], 0, 0, 0); } while (0)
            GLA_LK(KA, 0); GLA_LK(KB, 1);
#pragma unroll
            for (int T = 0; T < 4; ++T)
#pragma unroll
                for (int g = 0; g < 4; ++g) { const f32x4 e = *(const LAS f32x4*)(sb + S_EL + (32 * T + 8 * g + 4 * hi) * 4); S[T][4 * g] *= e.x; S[T][4 * g + 1] *= e.y; S[T][4 * g + 2] *= e.z; S[T][4 * g + 3] *= e.w; }
            __builtin_amdgcn_sched_barrier(0);
            GLA_MK(KA, 0); __builtin_amdgcn_sched_barrier(0); GLA_LK(KA, 2); __builtin_amdgcn_sched_barrier(0);
            GLA_MK(KB, 1); __builtin_amdgcn_sched_barrier(0); GLA_LK(KB, 3); __builtin_amdgcn_sched_barrier(0);
            GLA_MK(KA, 2); __builtin_amdgcn_sched_barrier(0); GLA_MK(KB, 3);
#undef GLA_LK
#undef GLA_MK
            if (c + 1 < NCH) {
                LAS unsigned char* xo = X + ((c + 1) & 1) * 8192 + lane * 16;
#pragma unroll
                for (int T = 0; T < 4; ++T)
#pragma unroll
                    for (int s = 0; s < 2; ++s) { u32x4 w;
#pragma unroll
                        for (int i = 0; i < 4; ++i) w[i] = cvtpk(S[T][8 * s + 2 * i], S[T][8 * s + 2 * i + 1]);
                        *(LAS u32x4*)(xo + (T * 2 + s) * 1024) = w; }
            }
        }
        float* outp = a->out + O_GLAP + (size_t)bh * 128 * 256 + ds * 32 + r32;
#pragma unroll
        for (int T = 0; T < 4; ++T)
#pragma unroll
            for (int r = 0; r < 16; ++r) outp[(size_t)(32 * T + crow(r, hi)) * 256] = S[T][r];
    } else {
        const int tt = wid;
        bf16* const ogbase = WSB(WS_OGRAW) + (size_t)(h * 8 + ds) * RP * 32 + r32;
        for (int c = 0; c < NCH; ++c) {
            GLA_BAR();
            const LAS unsigned char* sb = lds + (c % 3) * S_SLOT; const LAS unsigned char* xi = X + (c & 1) * 8192 + lane * 16;
            const LAS unsigned char* qp = sb + S_QIN + tt * 8192 + lane * 16; const LAS unsigned char* ap = sb + S_AM + tt * 4096 + lane * 16;
            bf16x8 vf[4], Sb[8], Q[8], A[4];
#pragma unroll
            for (int k = 0; k < 8; ++k) { Sb[k] = *(const LAS bf16x8*)(xi + k * 1024); Q[k] = *(const LAS bf16x8*)(qp + k * 1024); }
#pragma unroll
            for (int s = 0; s < 4; ++s) { vf[s] = *(const LAS bf16x8*)(sb + S_VT + s * 1024 + lane * 16); A[s] = *(const LAS bf16x8*)(ap + s * 1024); }
            f32x16 oa = f32x16{}, ob = f32x16{};
#pragma unroll
            for (int k = 0; k < 8; k += 2) { oa = __builtin_amdgcn_mfma_f32_32x32x16_bf16(Q[k], Sb[k], oa, 0, 0, 0); ob = __builtin_amdgcn_mfma_f32_32x32x16_bf16(Q[k + 1], Sb[k + 1], ob, 0, 0, 0); }
            oa = __builtin_amdgcn_mfma_f32_32x32x16_bf16(A[0], vf[0], oa, 0, 0, 0); ob = __builtin_amdgcn_mfma_f32_32x32x16_bf16(A[1], vf[1], ob, 0, 0, 0);
            if (tt == 1) { oa = __builtin_amdgcn_mfma_f32_32x32x16_bf16(A[2], vf[2], oa, 0, 0, 0); ob = __builtin_amdgcn_mfma_f32_32x32x16_bf16(A[3], vf[3], ob, 0, 0, 0); }
            const f32x16 o = oa + ob;
            bf16* og = ogbase;
#pragma unroll
            for (int r = 0; r < 16; ++r) { const int tok = tt * 32 + crow(r, hi); if (c > 0 || tok < NMETA) og[(size_t)chunk_row(b, c, tok) * 32] = (bf16)cvtpk(o[r], o[r]); }
        }
    }
    asm volatile("s_waitcnt vmcnt(0) lgkmcnt(0)\n\ts_barrier" ::: "memory");
#undef GLA_BAR
#undef GLA_QF
#undef GLA_KF
#undef GLA_AF
}
}

__device__ __forceinline__ bool relaunder(ArgsP& a) { asm volatile("" : "+s"(a)); return true; }
constexpr int NPHASE = 22;
__global__ void __launch_bounds__(512, 2) fwd(Args a_unused) {
    ArgsP a = (ArgsP)__builtin_amdgcn_kernarg_segment_ptr();
    extern __shared__ __attribute__((aligned(16))) unsigned char lds_raw[];
    LAS unsigned char* lds = (LAS unsigned char*)lds_raw;
    Ctx c; c.wave = __builtin_amdgcn_readfirstlane((int)threadIdx.x >> 6); c.tid = 0; c.lane = 0;
    c.gw = blockIdx.x * 8 + c.wave; c.ngw = gridDim.x * 8; c.gwT = c.wave * gridDim.x + blockIdx.x;
    volatile LAS unsigned* MISC = (volatile LAS unsigned*)(lds + MISC_OFF);
    if (threadIdx.x < 32) MISC[threadIdx.x] = 0u;
    __syncthreads();
    XcdBarrier bar; bar.bar = (unsigned*)(a->ws + WS_CTL) + CW_BAR; bar.x = 0; bar.st = nullptr;
    const bool one = (a->ph_hi - a->ph_lo) > 1;
    if (one) bar = xcd_barrier_post((unsigned*)(a->ws + WS_CTL) + CW_BAR, MISC + 8);
    const int lo = a->ph_lo, hi = a->ph_hi;
    unsigned long long tp0 = 0, tp1 = 0;
#define IN(k) (((PROBE_LO == (k)) ? (void)(tp0 = __builtin_amdgcn_s_memrealtime()) : (void)0), (lo <= (k) && (k) < hi && relaunder(a)))
#define INQ(k) (lo <= (k) && (k) < hi)
#define SEAM(k) do { if (INQ(k) && INQ((k) + 1)) xcd_barrier(bar, c.wave); if (PROBE_HI == (k)) tp1 = __builtin_amdgcn_s_memrealtime(); } while (0)
    if (IN(0)) { p_prep(a, c, lds); } SEAM(0);
    if (IN(1)) { if ((int)blockIdx.x < (RP / 256) * (NIN0 / 256)) gemm_p1(a, lds, c.wave); else p_side_tables(a, c, lds, (RP / 256) * (NIN0 / 256)); } SEAM(1);
    if (IN(2)) { if (USE_NAIVE_GEMM) p_mla_mid(a, c); }
    if (IN(3)) { gemm_p3(a, lds, c.wave); } SEAM(3);
    if (IN(4)) { if (USE_NAIVE_GEMM) { p_q_post(a, c); p_qlat(a, c); } }
    if (IN(5)) {
#if USE_NAIVE_ATTN
        p_attn_prompt_naive<false>(a, c);
#else
        if (((int)blockIdx.x >> 3) & 1) {
            dec::decode_phase(a, lds, c.wave);
            att::attn_phase(WSB(WS_QN), WSB(WS_QPE), WSB(WS_KNV), WSB(WS_KPE), WSB(WS_O), lds, c.wave);
        } else {
            att::attn_phase(WSB(WS_QN), WSB(WS_QPE), WSB(WS_KNV), WSB(WS_KPE), WSB(WS_O), lds, c.wave);
            dec::decode_phase(a, lds, c.wave);
        }
#endif
    } SEAM(5);
    if (IN(6)) {
#if USE_NAIVE_DECODE
        p_olat_up(a, c);
#else
        dec::combine_phase(a, c, lds);
#endif
    } SEAM(6);
    if (IN(7)) { gemm_n1024_tail<D, 8>(WSB(WS_O), WSB(WS_WO0), WSB(WS_M), WSF(WS_MT), lds, c.wave); } SEAM(7);
    if (IN(8)) { p_post_res<false, 8>(a, c, IN_F(8), IN_F(9)); } SEAM(8);
    if (IN(9)) { gemm_mfma8(WSB(WS_X), WSF(WS_RSTD), WSB(WS_WUP), RP, FF, D, (EpiRelu2{WSB(WS_U), FF}), lds, c.wave); p_late_weights(a, c, lds, (RP / 256) * (FF / 256) - 4 * (int)gridDim.x);     } SEAM(9);
    if (IN(10)) { gemm_n1024_tail<FF, 16>(WSB(WS_U), WSB(WS_WDN), WSB(WS_M), WSF(WS_MT), lds, c.wave); } SEAM(10);
    if (IN(11)) { p_post_res<false, 16>(a, c, IN_F(10), IN_F(7) + D); } SEAM(11);
    if (IN(12)) { gemm_mfma8(WSB(WS_X), WSF(WS_RSTD), WSB(WS_WGIN), RP, NGIN, D, (EpiGla{WSB(WS_QG), WSB(WS_KG), WSB(WS_VG), WSB(WS_RG), WSF(WS_GD)}), lds, c.wave); } SEAM(12);
    if (IN(13)) {
#if USE_NAIVE_GLA
        p_gate(a, c);
#else
        gla::prep_phase(a, lds, c.wave);
#endif
    } SEAM(13);
    if (IN(14)) {
#if !USE_NAIVE_GLA
        if ((int)blockIdx.x < NB * GH * gla::NSP) { const int w = (int)blockIdx.x, xcd = w & 7, j = w >> 3;
            gla::scan_bh(a, xcd * (NB * GH / 8) + j / gla::NSP, j % gla::NSP, lds, c.wave); }
        else for (int item = (int)blockIdx.x - NB * GH * gla::NSP; item < DB * GH; item += (int)gridDim.x - NB * GH * gla::NSP) gla::sample_item(a, item, lds, c.wave);
#else
        p_gla_naive(a, c);
#endif
    } SEAM(14);
    if (IN(15)) { p_gla_post(a, c); } SEAM(15);
    if (IN(16)) { gemm_n1024_tail<D, 8>(WSB(WS_OG), WSB(WS_WGO), WSB(WS_M), WSF(WS_MT), lds, c.wave); } SEAM(16);
    if (IN(17)) { p_post_res<false, 8>(a, c, IN_F(8) + D, IN_F(9) + D); } SEAM(17);
    if (IN(18)) { gemm_mfma8(WSB(WS_X), WSF(WS_RSTD), WSB(WS_WUP) + (size_t)FF * D, RP, FF, D, (EpiRelu2{WSB(WS_U), FF}), lds, c.wave); } SEAM(18);
    if (IN(19)) { gemm_n1024_tail<FF, 16>(WSB(WS_U), WSB(WS_WDN) + (size_t)D * FF, WSB(WS_M), WSF(WS_MT), lds, c.wave); } SEAM(19);
    if (IN(20)) { p_post_res<true, 16>(a, c, IN_F(10) + D, nullptr); }
    if (PROBE_LO >= 0 && blockIdx.x == 0) { const unsigned long long span = (tp1 - tp0) * 9ull, t0 = __builtin_amdgcn_s_memrealtime(); while (__builtin_amdgcn_s_memrealtime() - t0 < span) __builtin_amdgcn_s_sleep(8); }
#undef IN
#undef SEAM
}

extern "C" void kernel_launch(void* const* d_in, const int* in_sizes, int n_in, void* d_out, int out_size, void* d_ws, size_t ws_size, hipStream_t stream) {
    static int grid = 0;
    if (grid == 0) {
        if (n_in != 25 || out_size != (int)O_END || ws_size < WS_END) { fprintf(stderr, "kernel_launch: unexpected shapes n_in %d out %d ws %zu\n", n_in, out_size, ws_size); grid = -1; return; }
        int dev = 0, cus = 0, per_cu = 0;
        if (hipGetDevice(&dev) != hipSuccess || hipDeviceGetAttribute(&cus, hipDeviceAttributeMultiprocessorCount, dev) != hipSuccess) { grid = -1; return; }
        if (hipFuncSetAttribute((const void*)fwd, hipFuncAttributeMaxDynamicSharedMemorySize, LDS_BYTES) != hipSuccess) { fprintf(stderr, "kernel_launch: hipFuncSetAttribute failed\n"); grid = -1; return; }
        if (hipOccupancyMaxActiveBlocksPerMultiprocessor(&per_cu, (const void*)fwd, 512, LDS_BYTES) != hipSuccess || per_cu < 1) fprintf(stderr, "kernel_launch: occupancy query says %d\n", per_cu);
        (void)hipGetLastError();
        grid = cus;
    }
    if (grid < 0) return;
    if (hipMemsetAsync((char*)d_ws + WS_CTL, 0, CTL_ZERO_BYTES, stream) != hipSuccess) return;
    Args a{};
    for (int i = 0; i < 25; ++i) a.in[i] = d_in[i];
    a.out = (float*)d_out; a.ws = (unsigned char*)d_ws;
#if MK_ONE_LAUNCH
    a.ph_lo = 0; a.ph_hi = NPHASE;
    hipLaunchKernelGGL(fwd, dim3(grid), dim3(512), LDS_BYTES, stream, a);
#else
    for (int ph = 0; ph < NPHASE - 1; ++ph) { a.ph_lo = ph; a.ph_hi = ph + 1; hipLaunchKernelGGL(fwd, dim3(grid), dim3(512), LDS_BYTES, stream, a); }
#endif
}
```
